# Optimizing an MI355X kernel written in HIP

```python
import math
import jax, jax.numpy as jnp
from jax import lax
import numpy as np

D_MODEL = 1024
BATCH = 2
SEQ = 8192
DEPTH = 1

GDN_HEADS = 4
GDN_HEAD_DIM = 128
GDN_WIDTH = GDN_HEADS * GDN_HEAD_DIM
GDN_CHUNK = 64
CONV_WIDTH = 4
SGU_GROUPS = 4
SGU_GROUP_DIM = 128
SGU_WIDTH = SGU_GROUPS * SGU_GROUP_DIM
SGU_CHUNK = 128
N_MEM = 256
XATTN_HEADS = 4
XATTN_HEAD_DIM = 128
XATTN_WIDTH = XATTN_HEADS * XATTN_HEAD_DIM
N_BRANCHES = 3
SPLITS = [3 * GDN_WIDTH,
          4 * GDN_WIDTH,
          4 * GDN_WIDTH + 2 * GDN_HEADS,
          4 * GDN_WIDTH + 2 * GDN_HEADS + 2 * SGU_WIDTH,
          4 * GDN_WIDTH + 2 * GDN_HEADS + 2 * SGU_WIDTH + XATTN_WIDTH]
D_IN_PROJ = SPLITS[-1] + N_BRANCHES * D_MODEL
N_EXPERTS = 256
TOP_K = 8
N_GROUPS = 8
TOPK_GROUPS = 4
D_EXPERT = 256
D_SHARED = 256
ROUTED_SCALE = 2.5
MOE_BLOCK = 128
LN_EPS = 1e-5
RMS_EPS = 1e-6
DEEPNORM_ALPHA = (2.0 * DEPTH) ** 0.25
DEEPNORM_BETA = (8.0 * DEPTH) ** -0.25

kernel_name = "hybrid_gdn_sgu_memxattn_moe_deepnorm"


def _layer_norm(x, g, b):
    xf = x.astype(jnp.float32)
    mu = xf.mean(-1, keepdims=True)
    var = jnp.square(xf - mu).mean(-1, keepdims=True)
    return ((xf - mu) * lax.rsqrt(var + LN_EPS) * g.astype(jnp.float32) + b.astype(jnp.float32)).astype(x.dtype)


def _causal_conv_silu(x, w):
    c = x.shape[-1]
    y = lax.conv_general_dilated(x, w[:, None, :].astype(x.dtype), window_strides=(1,),
                                 padding=[(CONV_WIDTH - 1, 0)],
                                 dimension_numbers=('NWC', 'WIO', 'NWC'), feature_group_count=c)
    return jax.nn.silu(y)


def _gated_delta_net(q, k, v, a, b, a_log, dt_bias):
    f32 = jnp.float32
    bsz, s, h, dk = q.shape
    dv = v.shape[-1]
    q, k, v = q.astype(f32), k.astype(f32), v.astype(f32)
    q = q * lax.rsqrt(jnp.sum(q * q, -1, keepdims=True) + RMS_EPS) * (dk ** -0.5)
    k = k * lax.rsqrt(jnp.sum(k * k, -1, keepdims=True) + RMS_EPS)
    beta = jax.nn.sigmoid(b.astype(f32))
    g = -jnp.exp(a_log.astype(f32)) * jax.nn.softplus(a.astype(f32) + dt_bias.astype(f32))
    n, c = s // GDN_CHUNK, GDN_CHUNK

    def chunk(t):
        return t.reshape(bsz, n, c, h, -1).transpose(0, 1, 3, 2, 4)

    q, k, v = chunk(q), chunk(k), chunk(v)
    beta = beta.reshape(bsz, n, c, h).transpose(0, 1, 3, 2)
    gc = jnp.cumsum(g.reshape(bsz, n, c, h).transpose(0, 1, 3, 2), axis=-1)
    causal = jnp.tril(jnp.ones((c, c), bool))
    strict = jnp.tril(jnp.ones((c, c), bool), -1)
    decay = jnp.exp(jnp.where(causal, gc[..., :, None] - gc[..., None, :], -jnp.inf))
    kb = k * beta[..., None]
    lmat = jnp.where(strict, jnp.einsum('bnhid,bnhjd->bnhij', kb, k) * decay, 0.0)
    eye = jnp.eye(c, dtype=f32)
    rhs = jnp.concatenate([v * beta[..., None], kb * jnp.exp(gc)[..., None]], axis=-1)
    sol = lax.linalg.triangular_solve(eye + lmat, rhs, left_side=True, lower=True, unit_diagonal=True)
    u, w = sol[..., :dv], sol[..., dv:]
    attn = jnp.einsum('bnhid,bnhjd->bnhij', q, k) * decay
    q_dec = q * jnp.exp(gc)[..., None]
    k_dec = k * jnp.exp(gc[..., -1:] - gc)[..., None]
    g_last = jnp.exp(gc[..., -1])

    def step(state, xs):
        q_c, k_c, u_c, w_c, a_c, gl = xs
        v_new = u_c - jnp.einsum('bhcd,bhde->bhce', w_c, state)
        o = jnp.einsum('bhcd,bhde->bhce', q_c, state) + jnp.einsum('bhij,bhje->bhie', a_c, v_new)
        state = state * gl[..., None, None] + jnp.einsum('bhcd,bhce->bhde', k_c, v_new)
        return state, o

    xs = tuple(jnp.moveaxis(t, 1, 0) for t in (q_dec, k_dec, u, w, attn, g_last))
    _, o = lax.scan(step, jnp.zeros((bsz, h, dk, dv), f32), xs)
    return o.transpose(1, 0, 3, 2, 4).reshape(bsz, s, h, dv)


def _spatial_gating(uv, ln_g, ln_b, w_s, b_s):
    uv = jax.nn.gelu(uv)
    u, v = jnp.split(uv, 2, axis=-1)
    v = _layer_norm(v, ln_g, ln_b)
    bsz, s, _ = v.shape
    v = v.reshape(bsz, s // SGU_CHUNK, SGU_CHUNK, SGU_GROUPS, SGU_GROUP_DIM)
    w = jnp.where(jnp.tril(jnp.ones((SGU_CHUNK, SGU_CHUNK), bool)), w_s, 0.0).astype(v.dtype)
    sg = jnp.einsum('gij,bnjgc->bnigc', w, v) + b_s.T[:, :, None].astype(v.dtype)
    return u * sg.reshape(bsz, s, SGU_WIDTH)


def _memory_attention(xq, mem, w_mem_kv):
    bsz, s, _ = xq.shape
    q = xq.reshape(bsz, s, XATTN_HEADS, XATTN_HEAD_DIM)
    k, v = jnp.split(mem @ w_mem_kv, 2, axis=-1)
    k = k.reshape(bsz, -1, XATTN_HEADS, XATTN_HEAD_DIM)
    v = v.reshape(bsz, -1, XATTN_HEADS, XATTN_HEAD_DIM)
    sc = jnp.einsum('bshd,bmhd->bhsm', q, k).astype(jnp.float32) * (XATTN_HEAD_DIM ** -0.5)
    p = jax.nn.softmax(sc, axis=-1).astype(v.dtype)
    return jnp.einsum('bhsm,bmhd->bshd', p, v).reshape(bsz, s, XATTN_WIDTH)


def _route(h, router_w, router_bias):
    t = h.shape[0]
    scores = jax.nn.sigmoid((h @ router_w).astype(jnp.float32))
    biased = scores + router_bias.astype(jnp.float32)
    grp = biased.reshape(t, N_GROUPS, N_EXPERTS // N_GROUPS)
    grp_score = lax.top_k(grp, 2)[0].sum(-1)
    _, grp_idx = lax.top_k(grp_score, TOPK_GROUPS)
    grp_mask = jnp.any(grp_idx[:, :, None] == jnp.arange(N_GROUPS)[None, None, :], axis=1)
    expert_mask = jnp.repeat(grp_mask, N_EXPERTS // N_GROUPS, axis=1)
    _, idx = lax.top_k(jnp.where(expert_mask, biased, -jnp.inf), TOP_K)
    wts = jnp.take_along_axis(scores, idx, axis=-1)
    wts = wts / wts.sum(-1, keepdims=True) * ROUTED_SCALE
    return idx, wts


def _routed_experts(h, idx, wts, w_gate, w_up, w_down):
    t, d = h.shape
    n_assign = t * TOP_K
    flat_e = idx.reshape(-1)
    flat_w = wts.reshape(-1)
    order = jnp.argsort(flat_e)
    sorted_e = flat_e[order]
    counts = jnp.bincount(flat_e, length=N_EXPERTS)
    padded = (counts + MOE_BLOCK - 1) // MOE_BLOCK * MOE_BLOCK
    pad_end = jnp.cumsum(padded)
    pad_start = pad_end - padded
    start = jnp.cumsum(counts) - counts
    dest = pad_start[sorted_e] + jnp.arange(n_assign, dtype=jnp.int32) - start[sorted_e]
    n_blocks = (n_assign + N_EXPERTS * (MOE_BLOCK - 1) + MOE_BLOCK - 1) // MOE_BLOCK
    n_slots = n_blocks * MOE_BLOCK
    slot_tok = jnp.full((n_slots,), t, jnp.int32).at[dest].set((order // TOP_K).astype(jnp.int32))
    slot_w = jnp.zeros((n_slots,), h.dtype).at[dest].set(flat_w[order].astype(h.dtype))
    block_starts = jnp.arange(n_blocks, dtype=jnp.int32) * MOE_BLOCK
    block_e = jnp.minimum(jnp.searchsorted(pad_end, block_starts, side='right'), N_EXPERTS - 1)
    h_pad = jnp.concatenate([h, jnp.zeros((1, d), h.dtype)], axis=0)

    def step(acc, xs):
        tok, wb, e = xs
        xb = h_pad[tok]
        act = jax.nn.silu(xb @ w_gate[e]) * (xb @ w_up[e])
        yb = ((act @ w_down[e]) * wb[:, None]).astype(acc.dtype)
        return acc.at[tok].add(yb), None

    acc, _ = lax.scan(step, jnp.zeros((t + 1, d), h.dtype),
                      (slot_tok.reshape(n_blocks, MOE_BLOCK), slot_w.reshape(n_blocks, MOE_BLOCK), block_e))
    return acc[:t]


def setup_inputs(seed: int = 0) -> dict:
    key = jax.random.key(seed)
    ks = iter(jax.random.split(key, 40))
    f32 = jnp.float32
    L = DEPTH

    def nrm(shape, scale):
        return jax.random.normal(next(ks), shape, f32) * scale

    x = nrm((BATCH, SEQ, D_MODEL), 1.0)
    mem = nrm((BATCH, N_MEM, D_MODEL), 1.0)
    w_in = nrm((L, D_MODEL, D_IN_PROJ), D_MODEL ** -0.5)
    conv_w = nrm((L, CONV_WIDTH, 3 * GDN_WIDTH), 0.5)
    a_log = jnp.log(jax.random.uniform(next(ks), (L, GDN_HEADS), f32, 1.0, 16.0))
    dt = jnp.exp(jax.random.uniform(next(ks), (L, GDN_HEADS), f32) * (math.log(0.1) - math.log(0.001)) + math.log(0.001))
    dt_bias = dt + jnp.log(-jnp.expm1(-dt))
    gdn_norm_g = 1.0 + nrm((L, GDN_HEAD_DIM), 0.02)
    w_a = nrm((L, GDN_WIDTH, D_MODEL), GDN_WIDTH ** -0.5)
    sgu_ln_g = 1.0 + nrm((L, SGU_WIDTH), 0.02)
    sgu_ln_b = nrm((L, SGU_WIDTH), 0.02)
    sgu_w = nrm((L, SGU_GROUPS, SGU_CHUNK, SGU_CHUNK), SGU_CHUNK ** -0.5)
    sgu_b = 1.0 + nrm((L, SGU_GROUPS, SGU_CHUNK), 0.1)
    w_b = nrm((L, SGU_WIDTH, D_MODEL), SGU_WIDTH ** -0.5)
    w_mem_kv = nrm((L, D_MODEL, 2 * XATTN_WIDTH), D_MODEL ** -0.5)
    w_c = nrm((L, XATTN_WIDTH, D_MODEL), XATTN_WIDTH ** -0.5)
    w_o = nrm((L, D_MODEL, D_MODEL), D_MODEL ** -0.5 * DEEPNORM_BETA)
    ln1_g = 1.0 + nrm((L, D_MODEL), 0.02)
    ln1_b = nrm((L, D_MODEL), 0.02)
    router_w = nrm((L, D_MODEL, N_EXPERTS), D_MODEL ** -0.5)
    router_bias = nrm((L, N_EXPERTS), 0.01)
    w_gate = nrm((L, N_EXPERTS, D_MODEL, D_EXPERT), D_MODEL ** -0.5)
    w_up = nrm((L, N_EXPERTS, D_MODEL, D_EXPERT), D_MODEL ** -0.5)
    w_down = nrm((L, N_EXPERTS, D_EXPERT, D_MODEL), D_EXPERT ** -0.5 * DEEPNORM_BETA)
    ws_gate = nrm((L, D_MODEL, D_SHARED), D_MODEL ** -0.5)
    ws_up = nrm((L, D_MODEL, D_SHARED), D_MODEL ** -0.5)
    ws_down = nrm((L, D_SHARED, D_MODEL), D_SHARED ** -0.5 * DEEPNORM_BETA)
    ln2_g = 1.0 + nrm((L, D_MODEL), 0.02)
    ln2_b = nrm((L, D_MODEL), 0.02)
    return {"x": x, "mem": mem, "w_in": w_in, "conv_w": conv_w, "a_log": a_log, "dt_bias": dt_bias,
            "gdn_norm_g": gdn_norm_g, "w_a": w_a, "sgu_ln_g": sgu_ln_g, "sgu_ln_b": sgu_ln_b,
            "sgu_w": sgu_w, "sgu_b": sgu_b, "w_b": w_b, "w_mem_kv": w_mem_kv, "w_c": w_c, "w_o": w_o,
            "ln1_g": ln1_g, "ln1_b": ln1_b, "router_w": router_w, "router_bias": router_bias,
            "w_gate": w_gate, "w_up": w_up, "w_down": w_down, "ws_gate": ws_gate, "ws_up": ws_up,
            "ws_down": ws_down, "ln2_g": ln2_g, "ln2_b": ln2_b}


def reference(x, mem, w_in, conv_w, a_log, dt_bias, gdn_norm_g, w_a, sgu_ln_g, sgu_ln_b, sgu_w, sgu_b, w_b,
              w_mem_kv, w_c, w_o, ln1_g, ln1_b, router_w, router_bias, w_gate, w_up, w_down, ws_gate, ws_up,
              ws_down, ln2_g, ln2_b):
    bsz, s, d = x.shape
    for l in range(DEPTH):
        proj = x @ w_in[l]
        qkv, z, ab, uv, xq, gate_logits = jnp.split(proj, SPLITS, axis=-1)
        qkv = _causal_conv_silu(qkv, conv_w[l])
        q, k, v = (t.reshape(bsz, s, GDN_HEADS, GDN_HEAD_DIM) for t in jnp.split(qkv, 3, axis=-1))
        o = _gated_delta_net(q, k, v, ab[..., :GDN_HEADS], ab[..., GDN_HEADS:], a_log[l], dt_bias[l])
        zf = z.reshape(bsz, s, GDN_HEADS, GDN_HEAD_DIM).astype(jnp.float32)
        o = o * lax.rsqrt(jnp.mean(o * o, -1, keepdims=True) + RMS_EPS) * gdn_norm_g[l].astype(jnp.float32) * jax.nn.silu(zf)
        br_a = o.astype(x.dtype).reshape(bsz, s, GDN_WIDTH) @ w_a[l]
        br_b = _spatial_gating(uv, sgu_ln_g[l], sgu_ln_b[l], sgu_w[l], sgu_b[l]) @ w_b[l]
        br_c = _memory_attention(xq, mem, w_mem_kv[l]) @ w_c[l]
        gates = jax.nn.sigmoid(gate_logits).reshape(bsz, s, N_BRANCHES, d)
        merged = gates[:, :, 0] * br_a + gates[:, :, 1] * br_b + gates[:, :, 2] * br_c
        x = _layer_norm(DEEPNORM_ALPHA * x + merged @ w_o[l], ln1_g[l], ln1_b[l])
        h = x.reshape(bsz * s, d)
        idx, wts = _route(h, router_w[l], router_bias[l])
        routed = _routed_experts(h, idx, wts, w_gate[l], w_up[l], w_down[l])
        shared = (jax.nn.silu(h @ ws_gate[l]) * (h @ ws_up[l])) @ ws_down[l]
        moe = (routed + shared).reshape(bsz, s, d)
        x = _layer_norm(DEEPNORM_ALPHA * x + moe, ln2_g[l], ln2_b[l])
    return x
```

```cpp
#include <hip/hip_runtime.h>
#include <hip/hip_cooperative_groups.h>
#include <stdint.h>
#include <stdio.h>
namespace cg = cooperative_groups;

#define DI __device__ __forceinline__
typedef unsigned short bf16_t;
typedef short bf16x8 __attribute__((ext_vector_type(8)));
typedef float f32x4 __attribute__((ext_vector_type(4)));
typedef unsigned u32x4 __attribute__((ext_vector_type(4)));
typedef unsigned u32x2 __attribute__((ext_vector_type(2)));

constexpr int NTHR = 512;
constexpr int T = 16384, SEQ = 8192, D = 1024;
constexpr int NPROJ = 6656;
constexpr int DIN = 6664;
constexpr int NEXP = 256, DEXP = 256;
constexpr int MAXSLOT = 131072 + 256 * 128;
constexpr float ALPHA = 1.189207115002721f;
constexpr int LDS_BYTES = 157696;

constexpr size_t MB = 1u << 20;
constexpr size_t O_WGU = 0;
constexpr size_t O_WD = 256 * MB;
constexpr size_t O_WSGU = 384 * MB;
constexpr size_t O_WSD = 385 * MB;
constexpr size_t O_ROUT = 385 * MB + 512 * 1024;
constexpr size_t O_CTRL = 386 * MB;
constexpr size_t O_X1 = 387 * MB;
constexpr size_t O_X1B = 451 * MB;
constexpr size_t R0 = 483 * MB;
constexpr size_t O_XB = R0 + 0;
constexpr size_t O_ST = R0 + 0;
constexpr size_t O_WINT = R0 + 32 * MB;
constexpr size_t O_WAT = R0 + 45 * MB;
constexpr size_t O_WBT = R0 + 46 * MB;
constexpr size_t O_WCT = R0 + 47 * MB;
constexpr size_t O_WOT = R0 + 48 * MB;
constexpr size_t O_WMKV = R0 + 50 * MB;
constexpr size_t O_MEMB = R0 + 52 * MB;
constexpr size_t O_SGUW = R0 + 53 * MB;
constexpr size_t O_AB = R0 + 53 * MB + 512 * 1024;
constexpr size_t O_MEMK = R0 + 54 * MB;
constexpr size_t O_MEMVT = R0 + 54 * MB + 512 * 1024;
constexpr size_t O_QKV = R0 + 55 * MB;
constexpr size_t O_PART = R0 + 55 * MB;
constexpr size_t O_ZS = R0 + 103 * MB;
constexpr size_t O_UVG = R0 + 119 * MB;
constexpr size_t O_MERGED = R0 + 119 * MB;
constexpr size_t O_XQ = R0 + 151 * MB;
constexpr size_t O_GATES = R0 + 167 * MB;
constexpr size_t O_MP = R0 + 263 * MB;
constexpr size_t O_BC = R0 + 295 * MB;
constexpr size_t O_O0 = R0 + 359 * MB;
constexpr size_t O_QP = R0 + 391 * MB;
constexpr size_t O_GL = R0 + 407 * MB;
constexpr size_t O_GDNO = R0 + 408 * MB;
constexpr size_t O_SGUO = R0 + 424 * MB;
constexpr size_t O_XATO = R0 + 440 * MB;
constexpr size_t O_LOGITS = R0 + 0;
constexpr size_t O_TKIDX = R0 + 16 * MB;
constexpr size_t O_TKW = R0 + 16 * MB + 512 * 1024;
constexpr size_t O_TKPOS = R0 + 17 * MB;
constexpr size_t O_TOKSLOT = R0 + 17 * MB + 512 * 1024;
constexpr size_t O_SLOTTOK = R0 + 18 * MB;
constexpr size_t O_SLOTW = R0 + 19 * MB;
constexpr size_t O_ACT = R0 + 20 * MB;
constexpr size_t O_ACTSH = R0 + 100 * MB;
constexpr size_t O_YSH = R0 + 108 * MB;
constexpr size_t O_Y = R0 + 140 * MB;
constexpr size_t WS_NEED = R0 + 460 * MB;

struct Params {
  const float* in[28];
  float* out;
  unsigned char* ws;
};
enum { I_X = 0, I_MEM, I_WIN, I_CONVW, I_ALOG, I_DTB, I_GNG, I_WA, I_SLNG, I_SLNB, I_SGUW, I_SGUB, I_WB, I_WMKV, I_WC, I_WO,
       I_LN1G, I_LN1B, I_RW, I_RB, I_WG, I_WU, I_WDN, I_WSG, I_WSU, I_WSD, I_LN2G, I_LN2B };

DI float bf2f(bf16_t h) { return __uint_as_float(((unsigned)h) << 16); }
DI bf16_t f2bf(float f) { unsigned u = __float_as_uint(f); u += 0x7fffu + ((u >> 16) & 1u); return (bf16_t)(u >> 16); }
DI unsigned pk2(float lo, float hi) { return (unsigned)f2bf(lo) | ((unsigned)f2bf(hi) << 16); }
DI float lo2f(unsigned u) { return __uint_as_float(u << 16); }
DI float hi2f(unsigned u) { return __uint_as_float(u & 0xffff0000u); }
DI float sigmoidf_(float x) { return 1.f / (1.f + __expf(-x)); }
DI float siluf_(float x) { return x / (1.f + __expf(-x)); }
DI float geluf_(float x) { float u = 0.7978845608028654f * (x + 0.044715f * x * x * x); float t = 1.f - 2.f / (__expf(2.f * u) + 1.f); return 0.5f * x * (1.f + t); }
DI float softplusf_(float x) { return fmaxf(x, 0.f) + log1pf(__expf(-fabsf(x))); }
DI float wave_sum(float v) {
#pragma unroll
  for (int o = 32; o; o >>= 1) v += __shfl_xor(v, o);
  return v;
}
DI f32x4 mfma16(bf16x8 a, bf16x8 b, f32x4 c) { return __builtin_amdgcn_mfma_f32_16x16x32_bf16(a, b, c, 0, 0, 0); }
DI bf16x8 ldfrag(const void* p) { return __builtin_bit_cast(bf16x8, *(const u32x4*)p); }
DI bf16x8 pack8(f32x4 a, f32x4 b) { u32x4 r = {pk2(a[0], a[1]), pk2(a[2], a[3]), pk2(b[0], b[1]), pk2(b[2], b[3])}; return __builtin_bit_cast(bf16x8, r); }
DI u32x2 pack4(f32x4 a) { u32x2 r = {pk2(a[0], a[1]), pk2(a[2], a[3])}; return r; }
DI int sw128(int row, int chunk) { return row * 128 + ((chunk ^ (row & 7)) << 4); }
DI int sw256(int row, int chunk) { return row * 256 + ((chunk ^ (row & 15)) << 4); }

template <bool GATHER>
DI void gemm_mainloop(unsigned char* smem, const bf16_t* __restrict__ A, int lda, const int* arow, int m0,
                      const bf16_t* __restrict__ Bt, int ldb, int n0, int K, f32x4 (&acc)[2][4]) {
  const int tid = threadIdx.x, lane = tid & 63, wave = tid >> 6;
  const int wm = wave & 3, wn = wave >> 2, fr = lane & 15, fq = lane >> 4;
  const int lr = tid >> 3, lc = tid & 7;
  __syncthreads();
  const size_t r0 = GATHER ? (size_t)arow[lr] : (size_t)(m0 + lr);
  const size_t r1 = GATHER ? (size_t)arow[lr + 64] : (size_t)(m0 + lr + 64);
  const bf16_t* pa0 = A + r0 * lda + lc * 8;
  const bf16_t* pa1 = A + r1 * lda + lc * 8;
  const bf16_t* pb0 = Bt + (size_t)(n0 + lr) * ldb + lc * 8;
  const bf16_t* pb1 = Bt + (size_t)(n0 + lr + 64) * ldb + lc * 8;
  const int w0 = sw128(lr, lc), w1 = sw128(lr + 64, lc);
  u32x4 va0 = *(const u32x4*)pa0, va1 = *(const u32x4*)pa1, vb0 = *(const u32x4*)pb0, vb1 = *(const u32x4*)pb1;
  *(u32x4*)(smem + w0) = va0; *(u32x4*)(smem + w1) = va1;
  *(u32x4*)(smem + 16384 + w0) = vb0; *(u32x4*)(smem + 16384 + w1) = vb1;
  __syncthreads();
  const int nk = K >> 6;
  for (int kt = 0; kt < nk; ++kt) {
    unsigned char* sA = smem + (kt & 1) * 32768;
    unsigned char* sB = sA + 16384;
    const bool more = (kt + 1 < nk);
    if (more) {
      const int ko = (kt + 1) * 64;
      va0 = *(const u32x4*)(pa0 + ko); va1 = *(const u32x4*)(pa1 + ko);
      vb0 = *(const u32x4*)(pb0 + ko); vb1 = *(const u32x4*)(pb1 + ko);
    }
#pragma unroll
    for (int ks = 0; ks < 2; ++ks) {
      bf16x8 af[2], bfr[4];
#pragma unroll
      for (int i = 0; i < 2; ++i) af[i] = ldfrag(sA + sw128(32 * wm + 16 * i + fr, 4 * ks + fq));
#pragma unroll
      for (int j = 0; j < 4; ++j) bfr[j] = ldfrag(sB + sw128(64 * wn + 16 * j + fr, 4 * ks + fq));
#pragma unroll
      for (int i = 0; i < 2; ++i)
#pragma unroll
        for (int j = 0; j < 4; ++j) acc[i][j] = mfma16(bfr[j], af[i], acc[i][j]);
    }
    if (more) {
      unsigned char* dA = smem + ((kt + 1) & 1) * 32768;
      *(u32x4*)(dA + w0) = va0; *(u32x4*)(dA + w1) = va1;
      *(u32x4*)(dA + 16384 + w0) = vb0; *(u32x4*)(dA + 16384 + w1) = vb1;
    }
    __syncthreads();
  }
}
DI void zero_acc(f32x4 (&acc)[2][4]) {
#pragma unroll
  for (int i = 0; i < 2; ++i)
#pragma unroll
    for (int j = 0; j < 4; ++j) acc[i][j] = (f32x4){0.f, 0.f, 0.f, 0.f};
}
DI void tile_mn(int t, int ntn, int& mt, int& nt) { const int pg = 16 * ntn; const int g = t / pg, r = t - g * pg; nt = r >> 4; mt = g * 16 + (r & 15); }

DI void transpose_tile(float* tile, const float* s0, const float* s1, const float* s2, const float* s3, int ld, bf16_t* dst, int ldd) {
  const int tid = threadIdx.x;
  const int kr = tid >> 4, nc = tid & 15, sg = nc >> 2;
  const float* sp = sg == 0 ? s0 : sg == 1 ? s1 : sg == 2 ? s2 : s3;
  const f32x4 v0 = *(const f32x4*)(sp + (size_t)kr * ld + 4 * (nc & 3));
  const f32x4 v1 = *(const f32x4*)(sp + (size_t)(kr + 32) * ld + 4 * (nc & 3));
  __syncthreads();
  float* t0 = tile + kr * 65 + 4 * nc;
  float* t1 = tile + (kr + 32) * 65 + 4 * nc;
  t0[0] = v0[0]; t0[1] = v0[1]; t0[2] = v0[2]; t0[3] = v0[3];
  t1[0] = v1[0]; t1[1] = v1[1]; t1[2] = v1[2]; t1[3] = v1[3];
  __syncthreads();
  const int n = tid >> 3, kc = tid & 7;
  float e[8];
#pragma unroll
  for (int j = 0; j < 8; ++j) e[j] = tile[(8 * kc + j) * 65 + n];
  u32x4 o = {pk2(e[0], e[1]), pk2(e[2], e[3]), pk2(e[4], e[5]), pk2(e[6], e[7])};
  *(u32x4*)(dst + (size_t)n * ldd + 8 * kc) = o;
}

DI void phase0(const Params& p, unsigned char* smem, int bid, int nb) {
  const int tid = threadIdx.x, lane = tid & 63, wave = tid >> 6;
  unsigned char* ws = p.ws;
  if (bid == 0 && tid < 256) ((int*)(ws + O_CTRL))[tid] = 0;
  {
    float* wabT = (float*)smem;
    const float* win = p.in[I_WIN];
    for (int i = tid; i < 8192; i += NTHR) { const int k = i >> 3, j = i & 7; wabT[j * 1024 + k] = win[(size_t)k * DIN + 2048 + j]; }
    __syncthreads();
    const float* x = p.in[I_X];
    bf16_t* xb = (bf16_t*)(ws + O_XB);
    float* ab = (float*)(ws + O_AB);
    for (int row = bid * 8 + wave; row < T; row += nb * 8) {
      float s[8];
#pragma unroll
      for (int j = 0; j < 8; ++j) s[j] = 0.f;
#pragma unroll
      for (int i = 0; i < 4; ++i) {
        const int k = 256 * i + 4 * lane;
        const f32x4 v = *(const f32x4*)(x + (size_t)row * D + k);
        *(u32x2*)(xb + (size_t)row * D + k) = pack4(v);
#pragma unroll
        for (int j = 0; j < 8; ++j) { const f32x4 w = *(const f32x4*)(wabT + j * 1024 + k); s[j] += v[0] * w[0] + v[1] * w[1] + v[2] * w[2] + v[3] * w[3]; }
      }
#pragma unroll
      for (int j = 0; j < 8; ++j) s[j] = wave_sum(s[j]);
      if (lane == 0) { *(f32x4*)(ab + (size_t)row * 8) = (f32x4){s[0], s[1], s[2], s[3]}; *(f32x4*)(ab + (size_t)row * 8 + 4) = (f32x4){s[4], s[5], s[6], s[7]}; }
    }
    const float* mem = p.in[I_MEM];
    bf16_t* memb = (bf16_t*)(ws + O_MEMB);
    for (int row = bid * 8 + wave; row < 512; row += nb * 8) {
#pragma unroll
      for (int i = 0; i < 4; ++i) { const int k = 256 * i + 4 * lane; *(u32x2*)(memb + (size_t)row * D + k) = pack4(*(const f32x4*)(mem + (size_t)row * D + k)); }
    }
    const float* sw = p.in[I_SGUW];
    bf16_t* sguw = (bf16_t*)(ws + O_SGUW);
    for (int i = bid * NTHR + tid; i < 16384; i += nb * NTHR) {
      const int e0 = i * 4; const int col = e0 & 127, rowi = (e0 >> 7) & 127;
      f32x4 v = *(const f32x4*)(sw + e0);
#pragma unroll
      for (int c = 0; c < 4; ++c) if (col + c > rowi) v[c] = 0.f;
      *(u32x2*)(sguw + e0) = pack4(v);
    }
    __syncthreads();
  }
  {
    float* tile = (float*)smem;
    constexpr int J0 = 1664, J1 = J0 + 128, J2 = J1 + 128, J3 = J2 + 128, J4 = J3 + 256, J5 = J4 + 256, J6 = J5 + 64, J7 = J6 + 128, J8 = J7 + 64,
                  J9 = J8 + 32768, J10 = J9 + 16384;
    for (int it = bid; it < J10; it += nb) {
      const float *s0, *s1, *s2, *s3; int ld, ldd; bf16_t* dst;
      if (it < J0) {
        const int kt = it & 15, nt = it >> 4; const int n0 = nt * 64; const int c0 = n0 + (n0 >= 2048 ? 8 : 0);
        const float* b = p.in[I_WIN] + (size_t)kt * 64 * DIN + c0; s0 = b; s1 = b + 16; s2 = b + 32; s3 = b + 48; ld = DIN; ldd = 1024;
        dst = (bf16_t*)(ws + O_WINT) + (size_t)n0 * 1024 + kt * 64;
      } else if (it < J3) {
        const int which = (it - J0) >> 7, r = (it - J0) & 127; const int kt = r & 7, nt = r >> 3;
        const float* src = p.in[which == 0 ? I_WA : which == 1 ? I_WB : I_WC];
        const float* b = src + (size_t)kt * 64 * 1024 + nt * 64; s0 = b; s1 = b + 16; s2 = b + 32; s3 = b + 48; ld = 1024; ldd = 512;
        dst = (bf16_t*)(ws + (which == 0 ? O_WAT : which == 1 ? O_WBT : O_WCT)) + (size_t)nt * 64 * 512 + kt * 64;
      } else if (it < J5) {
        const int which = (it - J3) >> 8, r = (it - J3) & 255; const int kt = r & 15, nt = r >> 4;
        const float* b = p.in[which == 0 ? I_WO : I_WMKV] + (size_t)kt * 64 * 1024 + nt * 64; s0 = b; s1 = b + 16; s2 = b + 32; s3 = b + 48; ld = 1024; ldd = 1024;
        dst = (bf16_t*)(ws + (which == 0 ? O_WOT : O_WMKV)) + (size_t)nt * 64 * 1024 + kt * 64;
      } else if (it < J6) {
        const int r = it - J5; const int kt = r & 15, nt = r >> 4;
        const float* b = p.in[I_RW] + (size_t)kt * 64 * 256 + nt * 64; s0 = b; s1 = b + 16; s2 = b + 32; s3 = b + 48; ld = 256; ldd = 1024;
        dst = (bf16_t*)(ws + O_ROUT) + (size_t)nt * 64 * 1024 + kt * 64;
      } else if (it < J7) {
        const int r = it - J6; const int kt = r & 15, nt = r >> 4;
        const float* g = p.in[I_WSG] + (size_t)kt * 64 * 256 + nt * 32; const float* u = p.in[I_WSU] + (size_t)kt * 64 * 256 + nt * 32;
        s0 = g; s1 = u; s2 = g + 16; s3 = u + 16; ld = 256; ldd = 1024;
        dst = (bf16_t*)(ws + O_WSGU) + (size_t)nt * 64 * 1024 + kt * 64;
      } else if (it < J8) {
        const int r = it - J7; const int kt = r & 3, nt = r >> 2;
        const float* b = p.in[I_WSD] + (size_t)kt * 64 * 1024 + nt * 64; s0 = b; s1 = b + 16; s2 = b + 32; s3 = b + 48; ld = 1024; ldd = 256;
        dst = (bf16_t*)(ws + O_WSD) + (size_t)nt * 64 * 256 + kt * 64;
      } else if (it < J9) {
        const int r = it - J8; const int e = r >> 7, q = r & 127; const int kt = q & 15, nt = q >> 4;
        const float* g = p.in[I_WG] + (size_t)e * 262144 + (size_t)kt * 64 * 256 + nt * 32; const float* u = p.in[I_WU] + (size_t)e * 262144 + (size_t)kt * 64 * 256 + nt * 32;
        s0 = g; s1 = u; s2 = g + 16; s3 = u + 16; ld = 256; ldd = 1024;
        dst = (bf16_t*)(ws + O_WGU) + (size_t)e * 524288 + (size_t)nt * 64 * 1024 + kt * 64;
      } else {
        const int r = it - J9; const int e = r >> 6, q = r & 63; const int kt = q & 3, nt = q >> 2;
        const float* b = p.in[I_WDN] + (size_t)e * 262144 + (size_t)kt * 64 * 1024 + nt * 64; s0 = b; s1 = b + 16; s2 = b + 32; s3 = b + 48; ld = 1024; ldd = 256;
        dst = (bf16_t*)(ws + O_WD) + (size_t)e * 262144 + (size_t)nt * 64 * 256 + kt * 64;
      }
      transpose_tile(tile, s0, s1, s2, s3, ld, dst, ldd);
    }
  }
}

DI void phase1(const Params& p, unsigned char* smem, int bid, int nb) {
  const int tid = threadIdx.x, lane = tid & 63, wave = tid >> 6;
  const int wm = wave & 3, wn = wave >> 2, fr = lane & 15, fq = lane >> 4;
  unsigned char* ws = p.ws;
  const bf16_t* xb = (const bf16_t*)(ws + O_XB);
  const bf16_t* wint = (const bf16_t*)(ws + O_WINT);
  constexpr int NTN = NPROJ / 128;
  constexpr int NT1 = 128 * NTN;
  for (int t = bid; t < NT1 + 32; t += nb) {
    f32x4 acc[2][4]; zero_acc(acc);
    if (t < NT1) {
      int mt, nt; tile_mn(t, NTN, mt, nt);
      const int m0 = mt * 128, n0 = nt * 128;
      gemm_mainloop<false>(smem, xb, 1024, nullptr, m0, wint, 1024, n0, 1024, acc);
#pragma unroll
      for (int i = 0; i < 2; ++i) {
        const size_t row = m0 + 32 * wm + 16 * i + fr;
#pragma unroll
        for (int j = 0; j < 4; ++j) {
          const int col = n0 + 64 * wn + 16 * j + 4 * fq;
          f32x4 v = acc[i][j];
          if (n0 < 1536) { *(u32x2*)((bf16_t*)(ws + O_QKV) + row * 1536 + col) = pack4(v); }
          else if (n0 < 2048) {
#pragma unroll
            for (int c = 0; c < 4; ++c) v[c] = siluf_(v[c]);
            *(u32x2*)((bf16_t*)(ws + O_ZS) + row * 512 + (col - 1536)) = pack4(v);
          } else if (n0 < 3072) {
#pragma unroll
            for (int c = 0; c < 4; ++c) v[c] = geluf_(v[c]);
            *(u32x2*)((bf16_t*)(ws + O_UVG) + row * 1024 + (col - 2048)) = pack4(v);
          } else if (n0 < 3584) {
#pragma unroll
            for (int c = 0; c < 4; ++c) v[c] *= 0.08838834764831845f;
            *(u32x2*)((bf16_t*)(ws + O_XQ) + row * 512 + (col - 3072)) = pack4(v);
          } else {
#pragma unroll
            for (int c = 0; c < 4; ++c) v[c] = sigmoidf_(v[c]);
            *(u32x2*)((bf16_t*)(ws + O_GATES) + row * 3072 + (col - 3584)) = pack4(v);
          }
        }
      }
    } else {
      const int r = t - NT1; const int mt = r & 3, nt = r >> 2;
      const int m0 = mt * 128, n0 = nt * 128;
      gemm_mainloop<false>(smem, (const bf16_t*)(ws + O_MEMB), 1024, nullptr, m0, (const bf16_t*)(ws + O_WMKV), 1024, n0, 1024, acc);
#pragma unroll
      for (int i = 0; i < 2; ++i) {
        const int row = m0 + 32 * wm + 16 * i + fr; const int b = row >> 8, key = row & 255;
#pragma unroll
        for (int j = 0; j < 4; ++j) {
          const int col = n0 + 64 * wn + 16 * j + 4 * fq;
          const f32x4 v = acc[i][j];
          if (col < 512) { const int h = col >> 7, d = col & 127; *(u32x2*)((bf16_t*)(ws + O_MEMK) + ((size_t)((b * 4 + h) * 256 + key)) * 128 + d) = pack4(v); }
          else {
            const int c2 = col - 512; const int h = c2 >> 7, d = c2 & 127;
            const int pos = 32 * (key >> 5) + 8 * ((key >> 2) & 3) + 4 * ((key >> 4) & 1) + (key & 3);
            bf16_t* vt = (bf16_t*)(ws + O_MEMVT) + ((size_t)((b * 4 + h) * 128 + d)) * 256 + pos;
#pragma unroll
            for (int c = 0; c < 4; ++c) vt[(size_t)c * 256] = f2bf(v[c]);
          }
        }
      }
    }
  }
}

constexpr int G_KF = 0, G_VF = 32768, G_QB = 65536, G_KB = 81920, G_UT = 81920  , G_L = 98304, G_ATT = 114688, G_KDT = 122880, G_WT = 139264, G_SM = 155648;

DI void gdn_prep_item(const Params& p, unsigned char* smem, int item) {
  int tid = threadIdx.x; asm volatile("" : "+v"(tid));
  const int lane = tid & 63, wave = __builtin_amdgcn_readfirstlane(tid >> 6), fr = lane & 15, fq = lane >> 4;
  unsigned char* ws = p.ws;
  const int h = item & 3, cn = item >> 2;
  const int bidx = cn >> 7, n = cn & 127;
  const size_t t0 = (size_t)bidx * SEQ + (size_t)n * 64;
  float* kf = (float*)(smem + G_KF); float* vf = (float*)(smem + G_VF); float* Lm = (float*)(smem + G_L);
  float* sbeta = (float*)(smem + G_SM); float* sgc = sbeta + 64; float* segc = sbeta + 128;
  __syncthreads();
  {
    const bf16_t* qkv = (const bf16_t*)(ws + O_QKV);
    const float* cw = p.in[I_CONVW];
    const int tl0 = wave * 8;
#pragma unroll
    for (int sect = 0; sect < 3; ++sect) {
      const int cb = sect * 512 + h * 128 + 2 * lane;
      float w0[4], w1[4];
#pragma unroll
      for (int i = 0; i < 4; ++i) { w0[i] = cw[i * 1536 + cb]; w1[i] = cw[i * 1536 + cb + 1]; }
      float xa[11], xc[11];
#pragma unroll
      for (int r = 0; r < 11; ++r) {
        const int s = n * 64 + tl0 + r - 3;
        unsigned u = 0u;
        if (s >= 0) u = *(const unsigned*)(qkv + ((size_t)bidx * SEQ + s) * 1536 + cb);
        xa[r] = lo2f(u); xc[r] = hi2f(u);
      }
#pragma unroll
      for (int r = 0; r < 8; ++r) {
        float y0 = w0[0] * xa[r] + w0[1] * xa[r + 1] + w0[2] * xa[r + 2] + w0[3] * xa[r + 3];
        float y1 = w1[0] * xc[r] + w1[1] * xc[r + 1] + w1[2] * xc[r + 2] + w1[3] * xc[r + 3];
        y0 = siluf_(y0); y1 = siluf_(y1);
        const int tl = tl0 + r;
        if (sect == 2) { vf[tl * 128 + 2 * lane] = y0; vf[tl * 128 + 2 * lane + 1] = y1; }
        else {
          const float ss = wave_sum(y0 * y0 + y1 * y1);
          const float sc = rsqrtf(ss + 1e-6f) * (sect == 0 ? 0.08838834764831845f : 1.0f);
          y0 *= sc; y1 *= sc;
          const int off = sw256(tl, lane >> 2) + (lane & 3) * 4;
          if (sect == 0) *(unsigned*)(smem + G_QB + off) = pk2(y0, y1);
          else { *(unsigned*)(smem + G_KB + off) = pk2(y0, y1); kf[tl * 128 + 2 * lane] = y0; kf[tl * 128 + 2 * lane + 1] = y1; }
        }
      }
    }
    if (wave == 0) {
      const float* ab = (const float*)(ws + O_AB) + (t0 + lane) * 8;
      const float a = ab[h], bb = ab[4 + h];
      const float beta = sigmoidf_(bb);
      float g = -__expf(p.in[I_ALOG][h]) * softplusf_(a + p.in[I_DTB][h]);
#pragma unroll
      for (int o = 1; o < 64; o <<= 1) { const float y = __shfl_up(g, o); if (lane >= o) g += y; }
      sbeta[lane] = beta; sgc[lane] = g; segc[lane] = __expf(g);
      if (lane == 63) ((float*)(ws + O_GL))[item] = __expf(g);
    }
  }
  __syncthreads();
  {
#pragma unroll
    for (int q = 0; q < 4; ++q) {
      const int idx = wave * 4 + q; const int isq = idx >> 4, ti = (idx >> 2) & 3, tj = idx & 3;
      f32x4 acc = {0.f, 0.f, 0.f, 0.f};
      if (tj <= ti) {
#pragma unroll
        for (int ks = 0; ks < 4; ++ks) {
          const bf16x8 ai = ldfrag(smem + (isq ? G_QB : G_KB) + sw256(16 * ti + fr, 4 * ks + fq));
          const bf16x8 bj = ldfrag(smem + G_KB + sw256(16 * tj + fr, 4 * ks + fq));
          acc = isq ? mfma16(bj, ai, acc) : mfma16(ai, bj, acc);
        }
      }
      if (isq) {
        const int i = 16 * ti + fr, j0 = 16 * tj + 4 * fq;
        const float gi = sgc[i];
        f32x4 o;
#pragma unroll
        for (int r = 0; r < 4; ++r) { const int j = j0 + r; o[r] = (j <= i) ? acc[r] * __expf(gi - sgc[j]) : 0.f; }
        *(u32x2*)(smem + G_ATT + sw128(i, j0 >> 3) + (j0 & 7) * 2) = pack4(o);
      } else {
        const int j = 16 * tj + fr, i0 = 16 * ti + 4 * fq;
        const float gj = sgc[j];
        f32x4 o;
#pragma unroll
        for (int r = 0; r < 4; ++r) { const int i = i0 + r; o[r] = (j < i) ? acc[r] * __expf(sgc[i] - gj) * sbeta[i] : 0.f; }
        *(f32x4*)(Lm + j * 64 + i0) = o;
      }
    }
  }
  {
    const float gl_ = sgc[63];
    const int d = tid & 127, tg = tid >> 7;
#pragma unroll
    for (int c = 0; c < 2; ++c) {
      float e[8];
#pragma unroll
      for (int j = 0; j < 8; ++j) { const int t = 16 * tg + 8 * c + j; e[j] = kf[t * 128 + d] * __expf(gl_ - sgc[t]); }
      u32x4 o = {pk2(e[0], e[1]), pk2(e[2], e[3]), pk2(e[4], e[5]), pk2(e[6], e[7])};
      *(u32x4*)(smem + G_KDT + sw128(d, 2 * tg + c)) = o;
    }
  }
  __syncthreads();
  if (tid < 256) {
    const bool isw = tid >= 128;
    float* X = isw ? (kf + (tid - 128)) : (vf + tid);
    unsigned char* dstT = smem + (isw ? G_WT : G_UT);
    const int rowc = tid & 127;
#pragma unroll
    for (int b = 0; b < 4; ++b) {
      float xr[16];
#pragma unroll
      for (int r = 0; r < 16; ++r) { const int t = 16 * b + r; float sc = sbeta[t]; if (isw) sc *= segc[t]; xr[r] = X[t * 128] * sc; }
#pragma unroll 2
      for (int j = 0; j < 16 * b; ++j) {
        const float xj = X[j * 128];
        const float* lt = Lm + j * 64 + 16 * b;
        const f32x4 l0 = *(const f32x4*)lt, l1 = *(const f32x4*)(lt + 4), l2 = *(const f32x4*)(lt + 8), l3 = *(const f32x4*)(lt + 12);
#pragma unroll
        for (int r = 0; r < 4; ++r) { xr[r] -= l0[r] * xj; xr[4 + r] -= l1[r] * xj; xr[8 + r] -= l2[r] * xj; xr[12 + r] -= l3[r] * xj; }
      }
#pragma unroll
      for (int q = 0; q < 15; ++q) {
        const float* lt = Lm + (16 * b + q) * 64 + 16 * b;
        float l[16];
#pragma unroll
        for (int g4 = 0; g4 < 4; ++g4) if (4 * g4 + 3 > q) { const f32x4 t4 = *(const f32x4*)(lt + 4 * g4); l[4 * g4] = t4[0]; l[4 * g4 + 1] = t4[1]; l[4 * g4 + 2] = t4[2]; l[4 * g4 + 3] = t4[3]; }
#pragma unroll
        for (int r = q + 1; r < 16; ++r) xr[r] -= l[r] * xr[q];
      }
#pragma unroll
      for (int r = 0; r < 16; ++r) X[(16 * b + r) * 128] = xr[r];
      u32x4 o0 = {pk2(xr[0], xr[1]), pk2(xr[2], xr[3]), pk2(xr[4], xr[5]), pk2(xr[6], xr[7])};
      u32x4 o1 = {pk2(xr[8], xr[9]), pk2(xr[10], xr[11]), pk2(xr[12], xr[13]), pk2(xr[14], xr[15])};
      *(u32x4*)(dstT + sw128(rowc, 2 * b)) = o0;
      *(u32x4*)(dstT + sw128(rowc, 2 * b + 1)) = o1;
    }
  }
  __syncthreads();
  {
    bf16x8 ak[2];
#pragma unroll
    for (int ks = 0; ks < 2; ++ks) ak[ks] = ldfrag(smem + G_KDT + sw128(16 * wave + fr, 4 * ks + fq));
    bf16_t* mp = (bf16_t*)(ws + O_MP) + (size_t)item * 16384;
    float* bc = (float*)(ws + O_BC) + (size_t)item * 16384;
#pragma unroll
    for (int tj = 0; tj < 8; ++tj) {
      f32x4 am = {0.f, 0.f, 0.f, 0.f}, ab_ = {0.f, 0.f, 0.f, 0.f};
#pragma unroll
      for (int ks = 0; ks < 2; ++ks) {
        const bf16x8 bw = ldfrag(smem + G_WT + sw128(16 * tj + fr, 4 * ks + fq));
        const bf16x8 bu = ldfrag(smem + G_UT + sw128(16 * tj + fr, 4 * ks + fq));
        am = mfma16(bw, ak[ks], am);
        ab_ = mfma16(ak[ks], bu, ab_);
      }
      f32x4 nm = {-am[0], -am[1], -am[2], -am[3]};
      *(u32x2*)(mp + ((size_t)((wave * 4 + (tj >> 1)) * 64 + lane)) * 8 + (tj & 1) * 4) = pack4(nm);
      *(f32x4*)(bc + ((size_t)((tj * 8 + wave) * 64 + lane)) * 4) = ab_;
    }
    const int tt = wave & 3, hf = wave >> 2;
    bf16x8 aa[2];
#pragma unroll
    for (int ks = 0; ks < 2; ++ks) aa[ks] = ldfrag(smem + G_ATT + sw128(16 * tt + fr, 4 * ks + fq));
    const int trow = 16 * tt + fr;
    const float eg = segc[trow];
    float* o0 = (float*)(ws + O_O0) + (t0 + trow) * 512 + h * 128;
    bf16_t* qp = (bf16_t*)(ws + O_QP) + (size_t)item * 8192 + trow * 128;
#pragma unroll
    for (int q = 0; q < 4; ++q) {
      const int te = hf * 4 + q;
      f32x4 ao = {0.f, 0.f, 0.f, 0.f}, aw = {0.f, 0.f, 0.f, 0.f};
#pragma unroll
      for (int ks = 0; ks < 2; ++ks) {
        const bf16x8 bu = ldfrag(smem + G_UT + sw128(16 * te + fr, 4 * ks + fq));
        const bf16x8 bw = ldfrag(smem + G_WT + sw128(16 * te + fr, 4 * ks + fq));
        ao = mfma16(bu, aa[ks], ao);
        aw = mfma16(bw, aa[ks], aw);
      }
      const int e0 = 16 * te + 4 * fq;
      *(f32x4*)(o0 + e0) = ao;
      const u32x2 qv = *(const u32x2*)(smem + G_QB + sw256(trow, e0 >> 3) + (e0 & 7) * 2);
      f32x4 qd = {lo2f(qv[0]) * eg - aw[0], hi2f(qv[0]) * eg - aw[1], lo2f(qv[1]) * eg - aw[2], hi2f(qv[1]) * eg - aw[3]};
      *(u32x2*)(qp + e0) = pack4(qd);
    }
  }
}

DI void sgu_item(const Params& p, unsigned char* smem, int item) {
  int tid = threadIdx.x; asm volatile("" : "+v"(tid));
  const int lane = tid & 63, wave = __builtin_amdgcn_readfirstlane(tid >> 6), fr = lane & 15, fq = lane >> 4;
  unsigned char* ws = p.ws;
  const int g = item & 3, cn = item >> 2;
  const size_t t0 = (size_t)cn * 128;
  const bf16_t* uvg = (const bf16_t*)(ws + O_UVG);
  __syncthreads();
  {
    const float* lng = p.in[I_SLNG]; const float* lnb = p.in[I_SLNB];
    const int cl0 = 8 * (lane & 15);
    float gg[8], bb[8];
#pragma unroll
    for (int e = 0; e < 8; ++e) { gg[e] = lng[128 * g + cl0 + e]; bb[e] = lnb[128 * g + cl0 + e]; }
    for (int jj = 0; jj < 16; ++jj) {
      const int j = 16 * wave + jj;
      const u32x4 raw = *(const u32x4*)(uvg + (t0 + j) * 1024 + 512 + 8 * lane);
      float v[8];
#pragma unroll
      for (int e = 0; e < 4; ++e) { v[2 * e] = lo2f(raw[e]); v[2 * e + 1] = hi2f(raw[e]); }
      float s = 0.f;
#pragma unroll
      for (int e = 0; e < 8; ++e) s += v[e];
      const float mean = wave_sum(s) * (1.f / 512.f);
      float q = 0.f;
#pragma unroll
      for (int e = 0; e < 8; ++e) { const float d = v[e] - mean; q += d * d; }
      const float rstd = rsqrtf(wave_sum(q) * (1.f / 512.f) + 1e-5f);
      if ((lane >> 4) == g) {
#pragma unroll
        for (int e = 0; e < 8; ++e) {
          const int c = cl0 + e;
          const float y = (v[e] - mean) * rstd * gg[e] + bb[e];
          *(bf16_t*)(smem + sw256(c, j >> 3) + (j & 7) * 2) = f2bf(y);
        }
      }
    }
  }
  __syncthreads();
  {
    const bf16_t* wg = (const bf16_t*)(ws + O_SGUW) + (size_t)g * 16384;
    const int i = 16 * wave + fr;
    bf16x8 af[4];
#pragma unroll
    for (int ks = 0; ks < 4; ++ks) af[ks] = ldfrag(wg + i * 128 + 32 * ks + 8 * fq);
    const float bias = p.in[I_SGUB][g * 128 + i];
    bf16_t* out = (bf16_t*)(ws + O_SGUO) + (t0 + i) * 512 + 128 * g;
    const bf16_t* urow = uvg + (t0 + i) * 1024 + 128 * g;
#pragma unroll
    for (int jt = 0; jt < 8; ++jt) {
      f32x4 acc = {0.f, 0.f, 0.f, 0.f};
#pragma unroll
      for (int ks = 0; ks < 4; ++ks) acc = mfma16(ldfrag(smem + sw256(16 * jt + fr, 4 * ks + fq)), af[ks], acc);
      const int c0 = 16 * jt + 4 * fq;
      const u32x2 uu = *(const u32x2*)(urow + c0);
      f32x4 o = {lo2f(uu[0]) * (acc[0] + bias), hi2f(uu[0]) * (acc[1] + bias), lo2f(uu[1]) * (acc[2] + bias), hi2f(uu[1]) * (acc[3] + bias)};
      *(u32x2*)(out + c0) = pack4(o);
    }
  }
}

DI void xattn_item(const Params& p, int item) {
  int tid = threadIdx.x; asm volatile("" : "+v"(tid));
  const int lane = tid & 63, wave = __builtin_amdgcn_readfirstlane(tid >> 6), fr = lane & 15, fq = lane >> 4;
  unsigned char* ws = p.ws;
  const int h = item & 3, qt = item >> 2;
  const size_t trow = (size_t)qt * 128 + 16 * wave + fr;
  const int b = (qt * 128) >> 13;
  const bf16_t* xq = (const bf16_t*)(ws + O_XQ) + trow * 512 + h * 128;
  const bf16_t* mk = (const bf16_t*)(ws + O_MEMK) + (size_t)(b * 4 + h) * 32768;
  const bf16_t* mv = (const bf16_t*)(ws + O_MEMVT) + (size_t)(b * 4 + h) * 32768;
  bf16x8 qf[4];
#pragma unroll
  for (int ds = 0; ds < 4; ++ds) qf[ds] = ldfrag(xq + 32 * ds + 8 * fq);
  f32x4 sc[16];
#pragma unroll
  for (int kt = 0; kt < 16; ++kt) {
    f32x4 a = {0.f, 0.f, 0.f, 0.f};
#pragma unroll
    for (int ds = 0; ds < 4; ++ds) a = mfma16(ldfrag(mk + (16 * kt + fr) * 128 + 32 * ds + 8 * fq), qf[ds], a);
    sc[kt] = a;
  }
  float m = -1e30f;
#pragma unroll
  for (int kt = 0; kt < 16; ++kt)
#pragma unroll
    for (int r = 0; r < 4; ++r) m = fmaxf(m, sc[kt][r]);
  m = fmaxf(m, __shfl_xor(m, 16)); m = fmaxf(m, __shfl_xor(m, 32));
  float l = 0.f;
#pragma unroll
  for (int kt = 0; kt < 16; ++kt)
#pragma unroll
    for (int r = 0; r < 4; ++r) { const float e = __expf(sc[kt][r] - m); sc[kt][r] = e; l += e; }
  l += __shfl_xor(l, 16); l += __shfl_xor(l, 32);
  const float inv = 1.f / l;
  bf16x8 pf[8];
#pragma unroll
  for (int s = 0; s < 8; ++s) pf[s] = pack8(sc[2 * s], sc[2 * s + 1]);
  bf16_t* out = (bf16_t*)(ws + O_XATO) + trow * 512 + h * 128;
#pragma unroll
  for (int dt = 0; dt < 8; ++dt) {
    f32x4 a = {0.f, 0.f, 0.f, 0.f};
#pragma unroll
    for (int s = 0; s < 8; ++s) a = mfma16(ldfrag(mv + (16 * dt + fr) * 256 + 32 * s + 8 * fq), pf[s], a);
    f32x4 o = {a[0] * inv, a[1] * inv, a[2] * inv, a[3] * inv};
    *(u32x2*)(out + 16 * dt + 4 * fq) = pack4(o);
  }
}

DI void phase2(const Params& p, unsigned char* smem, int bid, int nb) {
  for (int it = bid; it < 2048; it += nb) {
    if (it < 1024) gdn_prep_item(p, smem, it);
    else if (it < 1536) sgu_item(p, smem, it - 1024);
    else xattn_item(p, it - 1536);
  }
}

DI void gdn_scan(const Params& p, int sb, int w) {
  const int lane = threadIdx.x & 63;
  unsigned char* ws = p.ws;
  const int bh = sb >> 1, es = 4 * (sb & 1) + w;
  const int b = bh >> 2, h = bh & 3;
  f32x4 acc[8];
#pragma unroll
  for (int t = 0; t < 8; ++t) acc[t] = (f32x4){0.f, 0.f, 0.f, 0.f};
  const int fr = lane & 15, fq = lane >> 4;
  for (int n = 0; n < 128; ++n) {
    const size_t item = (size_t)(b * 128 + n) * 4 + h;
    const bf16_t* mp = (const bf16_t*)(ws + O_MP) + item * 16384 + lane * 8;
    const float* bc = (const float*)(ws + O_BC) + item * 16384 + (size_t)es * 2048 + lane * 4;
    bf16_t* st = (bf16_t*)(ws + O_ST) + item * 16384 + (size_t)(16 * es + fr) * 128 + 4 * fq;
    const float gl = ((const float*)(ws + O_GL))[item];
    bf16x8 bfr[4];
#pragma unroll
    for (int s = 0; s < 4; ++s) {
      const u32x2 lo = pack4(acc[2 * s]), hi = pack4(acc[2 * s + 1]);
      *(u32x2*)(st + 32 * s) = lo; *(u32x2*)(st + 32 * s + 16) = hi;
      u32x4 v = {lo[0], lo[1], hi[0], hi[1]};
      bfr[s] = __builtin_bit_cast(bf16x8, v);
    }
#pragma unroll
    for (int t = 0; t < 8; ++t) {
      const f32x4 c0 = *(const f32x4*)(bc + t * 256);
      f32x4 a = {gl * acc[t][0] + c0[0], gl * acc[t][1] + c0[1], gl * acc[t][2] + c0[2], gl * acc[t][3] + c0[3]};
#pragma unroll
      for (int s = 0; s < 4; ++s) a = mfma16(ldfrag(mp + (t * 4 + s) * 512), bfr[s], a);
      acc[t] = a;
    }
  }
}

DI void part_tile(const Params& p, unsigned char* smem, int t) {
  const int tid = threadIdx.x, lane = tid & 63, wave = tid >> 6;
  const int wm = wave & 3, wn = wave >> 2, fr = lane & 15, fq = lane >> 4;
  unsigned char* ws = p.ws;
  int mt, nt; tile_mn(t, 8, mt, nt);
  const int m0 = mt * 128, n0 = nt * 128;
  f32x4 acc[2][4], acc2[2][4]; zero_acc(acc); zero_acc(acc2);
  gemm_mainloop<false>(smem, (const bf16_t*)(ws + O_SGUO), 512, nullptr, m0, (const bf16_t*)(ws + O_WBT), 512, n0, 512, acc);
  gemm_mainloop<false>(smem, (const bf16_t*)(ws + O_XATO), 512, nullptr, m0, (const bf16_t*)(ws + O_WCT), 512, n0, 512, acc2);
  const bf16_t* gates = (const bf16_t*)(ws + O_GATES);
  bf16_t* part = (bf16_t*)(ws + O_PART);
#pragma unroll
  for (int i = 0; i < 2; ++i) {
    const size_t row = m0 + 32 * wm + 16 * i + fr;
#pragma unroll
    for (int j = 0; j < 4; ++j) {
      const int col = n0 + 64 * wn + 16 * j + 4 * fq;
      const u32x2 g1 = *(const u32x2*)(gates + row * 3072 + 1024 + col);
      const u32x2 g2 = *(const u32x2*)(gates + row * 3072 + 2048 + col);
      f32x4 o = {lo2f(g1[0]) * acc[i][j][0] + lo2f(g2[0]) * acc2[i][j][0], hi2f(g1[0]) * acc[i][j][1] + hi2f(g2[0]) * acc2[i][j][1],
                 lo2f(g1[1]) * acc[i][j][2] + lo2f(g2[1]) * acc2[i][j][2], hi2f(g1[1]) * acc[i][j][3] + hi2f(g2[1]) * acc2[i][j][3]};
      *(u32x2*)(part + row * 1024 + col) = pack4(o);
    }
  }
}

DI void phase3(const Params& p, unsigned char* smem, int bid, int nb) {
  if (bid < 16) {
    const int wave = threadIdx.x >> 6;
    if (wave < 4) gdn_scan(p, bid, wave);
  } else {
    for (int t = bid - 16; t < 1024; t += nb - 16) part_tile(p, smem, t);
  }
}

DI void phase4(const Params& p, int bid, int nb) {
  const int tid = threadIdx.x, lane = tid & 63, wave = tid >> 6, fr = lane & 15, fq = lane >> 4;
  unsigned char* ws = p.ws;
  for (int it = bid; it < 512; it += nb) {
    const int item = it * 2 + (wave >> 2), tt = wave & 3;
    const int h = item & 3, cn = item >> 2;
    const size_t trow = (size_t)cn * 64 + 16 * tt + fr;
    const bf16_t* qp = (const bf16_t*)(ws + O_QP) + (size_t)item * 8192 + (16 * tt + fr) * 128;
    const bf16_t* st = (const bf16_t*)(ws + O_ST) + (size_t)item * 16384;
    const float* o0 = (const float*)(ws + O_O0) + trow * 512 + h * 128;
    bf16x8 af[4];
#pragma unroll
    for (int ks = 0; ks < 4; ++ks) af[ks] = ldfrag(qp + 32 * ks + 8 * fq);
    f32x4 acc[8];
    float ss = 0.f;
#pragma unroll
    for (int j = 0; j < 8; ++j) {
      f32x4 a = *(const f32x4*)(o0 + 16 * j + 4 * fq);
#pragma unroll
      for (int ks = 0; ks < 4; ++ks) a = mfma16(ldfrag(st + (16 * j + fr) * 128 + 32 * ks + 8 * fq), af[ks], a);
      acc[j] = a;
      ss += a[0] * a[0] + a[1] * a[1] + a[2] * a[2] + a[3] * a[3];
    }
    ss += __shfl_xor(ss, 16); ss += __shfl_xor(ss, 32);
    const float rms = rsqrtf(ss * (1.f / 128.f) + 1e-6f);
    const float* ng = p.in[I_GNG];
    const bf16_t* zs = (const bf16_t*)(ws + O_ZS) + trow * 512 + h * 128;
    bf16_t* out = (bf16_t*)(ws + O_GDNO) + trow * 512 + h * 128;
#pragma unroll
    for (int j = 0; j < 8; ++j) {
      const int e0 = 16 * j + 4 * fq;
      const f32x4 g = *(const f32x4*)(ng + e0);
      const u32x2 z = *(const u32x2*)(zs + e0);
      f32x4 o = {acc[j][0] * rms * g[0] * lo2f(z[0]), acc[j][1] * rms * g[1] * hi2f(z[0]), acc[j][2] * rms * g[2] * lo2f(z[1]), acc[j][3] * rms * g[3] * hi2f(z[1])};
      *(u32x2*)(out + e0) = pack4(o);
    }
  }
}

DI void phase5(const Params& p, unsigned char* smem, int bid, int nb) {
  const int tid = threadIdx.x, lane = tid & 63, wave = tid >> 6;
  const int wm = wave & 3, wn = wave >> 2, fr = lane & 15, fq = lane >> 4;
  unsigned char* ws = p.ws;
  for (int t = bid; t < 1024; t += nb) {
    int mt, nt; tile_mn(t, 8, mt, nt);
    const int m0 = mt * 128, n0 = nt * 128;
    f32x4 acc[2][4]; zero_acc(acc);
    gemm_mainloop<false>(smem, (const bf16_t*)(ws + O_GDNO), 512, nullptr, m0, (const bf16_t*)(ws + O_WAT), 512, n0, 512, acc);
    const bf16_t* gates = (const bf16_t*)(ws + O_GATES);
    const bf16_t* part = (const bf16_t*)(ws + O_PART);
    bf16_t* merged = (bf16_t*)(ws + O_MERGED);
#pragma unroll
    for (int i = 0; i < 2; ++i) {
      const size_t row = m0 + 32 * wm + 16 * i + fr;
#pragma unroll
      for (int j = 0; j < 4; ++j) {
        const int col = n0 + 64 * wn + 16 * j + 4 * fq;
        const u32x2 g0 = *(const u32x2*)(gates + row * 3072 + col);
        const u32x2 pp = *(const u32x2*)(part + row * 1024 + col);
        f32x4 o = {lo2f(pp[0]) + lo2f(g0[0]) * acc[i][j][0], hi2f(pp[0]) + hi2f(g0[0]) * acc[i][j][1],
                   lo2f(pp[1]) + lo2f(g0[1]) * acc[i][j][2], hi2f(pp[1]) + hi2f(g0[1]) * acc[i][j][3]};
        *(u32x2*)(merged + row * 1024 + col) = pack4(o);
      }
    }
  }
}
DI void phase6(const Params& p, unsigned char* smem, int bid, int nb) {
  const int tid = threadIdx.x, lane = tid & 63, wave = tid >> 6;
  const int wm = wave & 3, wn = wave >> 2, fr = lane & 15, fq = lane >> 4;
  unsigned char* ws = p.ws;
  const float* x = p.in[I_X];
  float* x1 = (float*)(ws + O_X1);
  for (int t = bid; t < 1024; t += nb) {
    int mt, nt; tile_mn(t, 8, mt, nt);
    const int m0 = mt * 128, n0 = nt * 128;
    f32x4 acc[2][4]; zero_acc(acc);
    gemm_mainloop<false>(smem, (const bf16_t*)(ws + O_MERGED), 1024, nullptr, m0, (const bf16_t*)(ws + O_WOT), 1024, n0, 1024, acc);
#pragma unroll
    for (int i = 0; i < 2; ++i) {
      const size_t row = m0 + 32 * wm + 16 * i + fr;
#pragma unroll
      for (int j = 0; j < 4; ++j) {
        const int col = n0 + 64 * wn + 16 * j + 4 * fq;
        const f32x4 xv = *(const f32x4*)(x + row * 1024 + col);
        f32x4 o = {ALPHA * xv[0] + acc[i][j][0], ALPHA * xv[1] + acc[i][j][1], ALPHA * xv[2] + acc[i][j][2], ALPHA * xv[3] + acc[i][j][3]};
        *(f32x4*)(x1 + row * 1024 + col) = o;
      }
    }
  }
}

DI void ln_row(const float* src, const float* g, const float* b, float (&v)[16], int lane) {
  float s = 0.f;
#pragma unroll
  for (int i = 0; i < 16; ++i) s += v[i];
  const float mean = wave_sum(s) * (1.f / 1024.f);
  float q = 0.f;
#pragma unroll
  for (int i = 0; i < 16; ++i) { const float d = v[i] - mean; q += d * d; }
  const float rstd = rsqrtf(wave_sum(q) * (1.f / 1024.f) + 1e-5f);
#pragma unroll
  for (int i = 0; i < 4; ++i) {
    const int k = 256 * i + 4 * lane;
    const f32x4 gg = *(const f32x4*)(g + k), bb = *(const f32x4*)(b + k);
#pragma unroll
    for (int c = 0; c < 4; ++c) v[4 * i + c] = (v[4 * i + c] - mean) * rstd * gg[c] + bb[c];
  }
}
DI void phase7(const Params& p, int bid, int nb) {
  const int tid = threadIdx.x, lane = tid & 63, wave = tid >> 6;
  unsigned char* ws = p.ws;
  float* x1 = (float*)(ws + O_X1);
  bf16_t* x1b = (bf16_t*)(ws + O_X1B);
  for (int row = bid * 8 + wave; row < T; row += nb * 8) {
    float v[16];
#pragma unroll
    for (int i = 0; i < 4; ++i) { const f32x4 t = *(const f32x4*)(x1 + (size_t)row * D + 256 * i + 4 * lane); v[4 * i] = t[0]; v[4 * i + 1] = t[1]; v[4 * i + 2] = t[2]; v[4 * i + 3] = t[3]; }
    ln_row(nullptr, p.in[I_LN1G], p.in[I_LN1B], v, lane);
#pragma unroll
    for (int i = 0; i < 4; ++i) {
      const f32x4 o = {v[4 * i], v[4 * i + 1], v[4 * i + 2], v[4 * i + 3]};
      *(f32x4*)(x1 + (size_t)row * D + 256 * i + 4 * lane) = o;
      *(u32x2*)(x1b + (size_t)row * D + 256 * i + 4 * lane) = pack4(o);
    }
  }
}
DI void phase8(const Params& p, unsigned char* smem, int bid, int nb) {
  const int tid = threadIdx.x, lane = tid & 63, wave = tid >> 6;
  const int wm = wave & 3, wn = wave >> 2, fr = lane & 15, fq = lane >> 4;
  unsigned char* ws = p.ws;
  float* logits = (float*)(ws + O_LOGITS);
  for (int t = bid; t < 256; t += nb) {
    const int mt = t >> 1, nt = t & 1;
    const int m0 = mt * 128, n0 = nt * 128;
    f32x4 acc[2][4]; zero_acc(acc);
    gemm_mainloop<false>(smem, (const bf16_t*)(ws + O_X1B), 1024, nullptr, m0, (const bf16_t*)(ws + O_ROUT), 1024, n0, 1024, acc);
#pragma unroll
    for (int i = 0; i < 2; ++i) {
      const size_t row = m0 + 32 * wm + 16 * i + fr;
#pragma unroll
      for (int j = 0; j < 4; ++j) *(f32x4*)(logits + row * 256 + n0 + 64 * wn + 16 * j + 4 * fq) = acc[i][j];
    }
  }
}
DI void phase9(const Params& p, int bid, int nb) {
  const int tid = threadIdx.x, lane = tid & 63, wave = tid >> 6;
  unsigned char* ws = p.ws;
  const float* logits = (const float*)(ws + O_LOGITS);
  int* counts = (int*)(ws + O_CTRL);
  const f32x4 bias = *(const f32x4*)(p.in[I_RB] + 4 * lane);
  const float NEG = -__builtin_inff();
  for (int tok = bid * 8 + wave; tok < T; tok += nb * 8) {
    const f32x4 lg = *(const f32x4*)(logits + (size_t)tok * 256 + 4 * lane);
    float sc[4], mv[4];
#pragma unroll
    for (int c = 0; c < 4; ++c) { sc[c] = sigmoidf_(lg[c]); mv[c] = sc[c] + bias[c]; }
    float m1 = NEG, m2 = NEG;
#pragma unroll
    for (int c = 0; c < 4; ++c) { const float v = mv[c]; if (v > m1) { m2 = m1; m1 = v; } else if (v > m2) m2 = v; }
#pragma unroll
    for (int o = 1; o < 8; o <<= 1) {
      const float o1 = __shfl_xor(m1, o), o2 = __shfl_xor(m2, o);
      const float n1 = fmaxf(m1, o1), n2 = fmaxf(fminf(m1, o1), fmaxf(m2, o2));
      m1 = n1; m2 = n2;
    }
    const float gs = m1 + m2;
    const int g = lane >> 3;
    int rank = 0;
#pragma unroll
    for (int gg = 0; gg < 8; ++gg) { const float og = __shfl(gs, gg * 8); rank += ((og > gs) || (og == gs && gg < g)) ? 1 : 0; }
    if (rank >= 4) {
#pragma unroll
      for (int c = 0; c < 4; ++c) mv[c] = NEG;
    }
    int myidx = 0; float mysc = 0.f, ssum = 0.f;
#pragma unroll
    for (int k = 0; k < 8; ++k) {
      float bv = mv[0]; int bi = 0;
#pragma unroll
      for (int c = 1; c < 4; ++c) if (mv[c] > bv) { bv = mv[c]; bi = c; }
      float rv = bv; int ri = lane * 4 + bi;
#pragma unroll
      for (int o = 32; o; o >>= 1) {
        const float ov = __shfl_xor(rv, o); const int oi = __shfl_xor(ri, o);
        if (ov > rv || (ov == rv && oi < ri)) { rv = ov; ri = oi; }
      }
      const int wl = ri >> 2, wc = ri & 3;
      const float mine = wc == 0 ? sc[0] : wc == 1 ? sc[1] : wc == 2 ? sc[2] : sc[3];
      const float wsc = __shfl(mine, wl);
      if (lane == wl) {
#pragma unroll
        for (int c = 0; c < 4; ++c) if (c == wc) mv[c] = NEG;
      }
      ssum += wsc;
      if (lane == k) { myidx = ri; mysc = wsc; }
    }
    if (lane < 8) {
      const int pos = atomicAdd(&counts[myidx], 1);
      ((int*)(ws + O_TKIDX))[(size_t)tok * 8 + lane] = myidx;
      ((float*)(ws + O_TKW))[(size_t)tok * 8 + lane] = mysc / ssum * 2.5f;
      ((int*)(ws + O_TKPOS))[(size_t)tok * 8 + lane] = pos;
    }
  }
}
DI void build_tile_start(const Params& p, int* ts) {
  const int tid = threadIdx.x;
  const int* counts = (const int*)(p.ws + O_CTRL);
  __syncthreads();
  if (tid < 256) ts[300 + tid] = (counts[tid] + 127) >> 7;
  __syncthreads();
  if (tid == 0) { int s = 0; for (int e = 0; e < 256; ++e) { ts[e] = s; s += ts[300 + e]; } ts[256] = s; }
  __syncthreads();
}
DI void phase10(const Params& p, unsigned char* smem, int bid, int nb) {
  int* ts = (int*)smem;
  build_tile_start(p, ts);
  unsigned char* ws = p.ws;
  const int* tkidx = (const int*)(ws + O_TKIDX); const int* tkpos = (const int*)(ws + O_TKPOS); const float* tkw = (const float*)(ws + O_TKW);
  int* slottok = (int*)(ws + O_SLOTTOK); float* slotw = (float*)(ws + O_SLOTW); int* tokslot = (int*)(ws + O_TOKSLOT);
  for (int i = bid * NTHR + threadIdx.x; i < T * 8; i += nb * NTHR) {
    const int e = tkidx[i];
    const int slot = ts[e] * 128 + tkpos[i];
    slottok[slot] = i >> 3; slotw[slot] = tkw[i]; tokslot[i] = slot;
  }
}

DI int find_expert(const int* ts, int ti) { int lo = 0, hi = 255; while (lo < hi) { const int mid = (lo + hi + 1) >> 1; if (ts[mid] <= ti) lo = mid; else hi = mid - 1; } return lo; }

DI void phase11(const Params& p, unsigned char* smem, int bid, int nb) {
  const int tid = threadIdx.x, lane = tid & 63, wave = tid >> 6;
  const int wm = wave & 3, wn = wave >> 2, fr = lane & 15, fq = lane >> 4;
  unsigned char* ws = p.ws;
  int* ts = (int*)(smem + 65536);
  int* arow = (int*)(smem + 65536 + 4096);
  build_tile_start(p, ts);
  const int ntile = ts[256];
  const int* counts = (const int*)(ws + O_CTRL);
  const int* slottok = (const int*)(ws + O_SLOTTOK);
  const int nitem = ntile * 4 + 128 * 4;
  for (int it = bid; it < nitem; it += nb) {
    f32x4 acc[2][4]; zero_acc(acc);
    int m0, n0; bf16_t* actp;
    if (it < ntile * 4) {
      const int ti = it >> 2, nt = it & 3;
      const int e = find_expert(ts, ti);
      const int valid = counts[e] - 128 * (ti - ts[e]);
      m0 = ti * 128; n0 = nt * 128;
      __syncthreads();
      if (tid < 128) arow[tid] = (tid < valid) ? slottok[m0 + tid] : 0;
      gemm_mainloop<true>(smem, (const bf16_t*)(ws + O_X1B), 1024, arow, m0, (const bf16_t*)(ws + O_WGU) + (size_t)e * 524288, 1024, n0, 1024, acc);
      actp = (bf16_t*)(ws + O_ACT);
    } else {
      const int r = it - ntile * 4; const int mt = r >> 2, nt = r & 3;
      m0 = mt * 128; n0 = nt * 128;
      gemm_mainloop<false>(smem, (const bf16_t*)(ws + O_X1B), 1024, nullptr, m0, (const bf16_t*)(ws + O_WSGU), 1024, n0, 1024, acc);
      actp = (bf16_t*)(ws + O_ACTSH);
    }
#pragma unroll
    for (int i = 0; i < 2; ++i) {
      const size_t row = m0 + 32 * wm + 16 * i + fr;
#pragma unroll
      for (int jj = 0; jj < 2; ++jj) {
        const int rowg = n0 + 64 * wn + 32 * jj;
        const int acol = (rowg >> 5) * 16 + 4 * fq;
        const f32x4 g = acc[i][2 * jj], u = acc[i][2 * jj + 1];
        f32x4 o = {siluf_(g[0]) * u[0], siluf_(g[1]) * u[1], siluf_(g[2]) * u[2], siluf_(g[3]) * u[3]};
        *(u32x2*)(actp + row * 256 + acol) = pack4(o);
      }
    }
  }
}
DI void phase12(const Params& p, unsigned char* smem, int bid, int nb) {
  const int tid = threadIdx.x, lane = tid & 63, wave = tid >> 6;
  const int wm = wave & 3, wn = wave >> 2, fr = lane & 15, fq = lane >> 4;
  unsigned char* ws = p.ws;
  int* ts = (int*)(smem + 65536);
  build_tile_start(p, ts);
  const int ntile = ts[256];
  const float* slotw = (const float*)(ws + O_SLOTW);
  const int nitem = ntile * 8 + 128 * 8;
  for (int it = bid; it < nitem; it += nb) {
    f32x4 acc[2][4]; zero_acc(acc);
    if (it < ntile * 8) {
      const int ti = it >> 3, nt = it & 7;
      const int e = find_expert(ts, ti);
      const int m0 = ti * 128, n0 = nt * 128;
      gemm_mainloop<false>(smem, (const bf16_t*)(ws + O_ACT), 256, nullptr, m0, (const bf16_t*)(ws + O_WD) + (size_t)e * 262144, 256, n0, 256, acc);
      bf16_t* y = (bf16_t*)(ws + O_Y);
#pragma unroll
      for (int i = 0; i < 2; ++i) {
        const size_t row = m0 + 32 * wm + 16 * i + fr;
        const float w = slotw[row];
#pragma unroll
        for (int j = 0; j < 4; ++j) {
          f32x4 o = {acc[i][j][0] * w, acc[i][j][1] * w, acc[i][j][2] * w, acc[i][j][3] * w};
          *(u32x2*)(y + row * 1024 + n0 + 64 * wn + 16 * j + 4 * fq) = pack4(o);
        }
      }
    } else {
      const int r = it - ntile * 8; const int mt = r >> 3, nt = r & 7;
      const int m0 = mt * 128, n0 = nt * 128;
      gemm_mainloop<false>(smem, (const bf16_t*)(ws + O_ACTSH), 256, nullptr, m0, (const bf16_t*)(ws + O_WSD), 256, n0, 256, acc);
      bf16_t* y = (bf16_t*)(ws + O_YSH);
#pragma unroll
      for (int i = 0; i < 2; ++i) {
        const size_t row = m0 + 32 * wm + 16 * i + fr;
#pragma unroll
        for (int j = 0; j < 4; ++j) *(u32x2*)(y + row * 1024 + n0 + 64 * wn + 16 * j + 4 * fq) = pack4(acc[i][j]);
      }
    }
  }
}
DI void phase13(const Params& p, int bid, int nb) {
  const int tid = threadIdx.x, lane = tid & 63, wave = tid >> 6;
  unsigned char* ws = p.ws;
  const float* x1 = (const float*)(ws + O_X1);
  const bf16_t* ysh = (const bf16_t*)(ws + O_YSH);
  const bf16_t* y = (const bf16_t*)(ws + O_Y);
  const int* tokslot = (const int*)(ws + O_TOKSLOT);
  for (int row = bid * 8 + wave; row < T; row += nb * 8) {
    float v[16];
#pragma unroll
    for (int i = 0; i < 4; ++i) {
      const int k = 256 * i + 4 * lane;
      const f32x4 t = *(const f32x4*)(x1 + (size_t)row * D + k);
      const u32x2 s = *(const u32x2*)(ysh + (size_t)row * D + k);
      v[4 * i] = ALPHA * t[0] + lo2f(s[0]); v[4 * i + 1] = ALPHA * t[1] + hi2f(s[0]); v[4 * i + 2] = ALPHA * t[2] + lo2f(s[1]); v[4 * i + 3] = ALPHA * t[3] + hi2f(s[1]);
    }
#pragma unroll
    for (int k8 = 0; k8 < 8; ++k8) {
      const size_t slot = (size_t)tokslot[(size_t)row * 8 + k8];
#pragma unroll
      for (int i = 0; i < 4; ++i) {
        const u32x2 s = *(const u32x2*)(y + slot * 1024 + 256 * i + 4 * lane);
        v[4 * i] += lo2f(s[0]); v[4 * i + 1] += hi2f(s[0]); v[4 * i + 2] += lo2f(s[1]); v[4 * i + 3] += hi2f(s[1]);
      }
    }
    ln_row(nullptr, p.in[I_LN2G], p.in[I_LN2B], v, lane);
#pragma unroll
    for (int i = 0; i < 4; ++i) { const f32x4 o = {v[4 * i], v[4 * i + 1], v[4 * i + 2], v[4 * i + 3]}; *(f32x4*)(p.out + (size_t)row * D + 256 * i + 4 * lane) = o; }
  }
}

__global__ void __launch_bounds__(NTHR) mega_kernel(Params p) {
  extern __shared__ __attribute__((aligned(16))) unsigned char smem[];
  cg::grid_group grid = cg::this_grid();
  const int bid = blockIdx.x, nb = gridDim.x;
  phase0(p, smem, bid, nb); grid.sync();
  phase1(p, smem, bid, nb); grid.sync();
  phase2(p, smem, bid, nb); grid.sync();
  phase3(p, smem, bid, nb); grid.sync();
  phase4(p, bid, nb); grid.sync();
  phase5(p, smem, bid, nb); grid.sync();
  phase6(p, smem, bid, nb); grid.sync();
  phase7(p, bid, nb); grid.sync();
  phase8(p, smem, bid, nb); grid.sync();
  phase9(p, bid, nb); grid.sync();
  phase10(p, smem, bid, nb); grid.sync();
  phase11(p, smem, bid, nb); grid.sync();
  phase12(p, smem, bid, nb); grid.sync();
  phase13(p, bid, nb);
}

extern "C" void kernel_launch(void* const* d_in, const int* in_sizes, int n_in, void* d_out, int out_size, void* d_ws, size_t ws_size, hipStream_t stream) {
  if (n_in != 28 || ws_size < WS_NEED) { fprintf(stderr, "kernel_launch: unexpected inputs (%d) or workspace (%zu < %zu)\n", n_in, ws_size, (size_t)WS_NEED); return; }
  static int grid_blocks = 0;
  if (!grid_blocks) {
    int dev = 0, cus = 0, per_cu = 0;
    (void)hipGetDevice(&dev);
    (void)hipDeviceGetAttribute(&cus, hipDeviceAttributeMultiprocessorCount, dev);
    (void)hipFuncSetAttribute((const void*)mega_kernel, hipFuncAttributeMaxDynamicSharedMemorySize, LDS_BYTES);
    (void)hipOccupancyMaxActiveBlocksPerMultiprocessor(&per_cu, (const void*)mega_kernel, NTHR, LDS_BYTES);
    if (per_cu < 1) per_cu = 1;
    if (per_cu > 1) per_cu = 1;
    grid_blocks = cus * per_cu;
    if (grid_blocks < 32) grid_blocks = 32;
  }
  Params p{};
  for (int i = 0; i < 28; ++i) p.in[i] = (const float*)d_in[i];
  p.out = (float*)d_out; p.ws = (unsigned char*)d_ws;
  void* args[] = {&p};
  hipError_t e = hipLaunchCooperativeKernel((const void*)mega_kernel, dim3(grid_blocks), dim3(NTHR), args, LDS_BYTES, stream);
  if (e != hipSuccess) fprintf(stderr, "cooperative launch failed: %s (grid %d)\n", hipGetErrorString(e), grid_blocks);
}
```

```cpp
#include <hip/hip_runtime.h>
#include <hip/hip_cooperative_groups.h>
#include <stdint.h>
#include <stdio.h>
namespace cg = cooperative_groups;

#define DI __device__ __forceinline__
typedef unsigned short bf16_t;
typedef short bf16x8 __attribute__((ext_vector_type(8)));
typedef float f32x4 __attribute__((ext_vector_type(4)));
typedef unsigned u32x4 __attribute__((ext_vector_type(4)));
typedef unsigned u32x2 __attribute__((ext_vector_type(2)));

constexpr int NTHR = 512;
constexpr int T = 16384, SEQ = 8192, D = 1024;
constexpr int NPROJ = 6656;
constexpr int DIN = 6664;
constexpr int NEXP = 256, DEXP = 256;
constexpr int MAXSLOT = 131072 + 256 * 128;
constexpr float ALPHA = 1.189207115002721f;
constexpr int LDS_BYTES = 157696;

constexpr size_t MB = 1u << 20;
constexpr size_t O_WGU = 0;
constexpr size_t O_WD = 256 * MB;
constexpr size_t O_WSGU = 384 * MB;
constexpr size_t O_WSD = 385 * MB;
constexpr size_t O_ROUT = 385 * MB + 512 * 1024;
constexpr size_t O_CTRL = 386 * MB;
constexpr size_t O_BAR = 386 * MB + 128 * 1024;
constexpr int CSTR = 64;
constexpr size_t O_X1 = 387 * MB;
constexpr size_t O_X1B = 451 * MB;
constexpr size_t R0 = 483 * MB;
constexpr size_t O_XB = R0 + 0;
constexpr size_t O_ST = R0 + 0;
constexpr size_t O_WINT = R0 + 32 * MB;
constexpr size_t O_WAT = R0 + 45 * MB;
constexpr size_t O_WBT = R0 + 46 * MB;
constexpr size_t O_WCT = R0 + 47 * MB;
constexpr size_t O_WOT = R0 + 48 * MB;
constexpr size_t O_WMKV = R0 + 50 * MB;
constexpr size_t O_MEMB = R0 + 52 * MB;
constexpr size_t O_SGUW = R0 + 53 * MB;
constexpr size_t O_AB = R0 + 53 * MB + 512 * 1024;
constexpr size_t O_MEMK = R0 + 54 * MB;
constexpr size_t O_MEMVT = R0 + 54 * MB + 512 * 1024;
constexpr size_t O_QKV = R0 + 55 * MB;
constexpr size_t O_PART = R0 + 55 * MB;
constexpr size_t O_ZS = R0 + 103 * MB;
constexpr size_t O_UVG = R0 + 119 * MB;
constexpr size_t O_MERGED = R0 + 119 * MB;
constexpr size_t O_XQ = R0 + 151 * MB;
constexpr size_t O_GATES = R0 + 167 * MB;
constexpr size_t O_MP = R0 + 263 * MB;
constexpr size_t O_BC = R0 + 295 * MB;
constexpr size_t O_O0 = R0 + 359 * MB;
constexpr size_t O_QP = R0 + 391 * MB;
constexpr size_t O_GL = R0 + 407 * MB;
constexpr size_t O_GDNO = R0 + 408 * MB;
constexpr size_t O_SGUO = R0 + 424 * MB;
constexpr size_t O_XATO = R0 + 440 * MB;
constexpr size_t O_LOGITS = R0 + 0;
constexpr size_t O_TKIDX = R0 + 16 * MB;
constexpr size_t O_TKW = R0 + 16 * MB + 512 * 1024;
constexpr size_t O_TKPOS = R0 + 17 * MB;
constexpr size_t O_TOKSLOT = R0 + 17 * MB + 512 * 1024;
constexpr size_t O_SLOTTOK = R0 + 18 * MB;
constexpr size_t O_SLOTW = R0 + 19 * MB;
constexpr size_t O_ACT = R0 + 20 * MB;
constexpr size_t O_ACTSH = R0 + 100 * MB;
constexpr size_t O_YSH = R0 + 108 * MB;
constexpr size_t O_Y = R0 + 140 * MB;
constexpr size_t WS_NEED = R0 + 460 * MB;

struct Params {
  const float* in[28];
  float* out;
  unsigned char* ws;
};
enum { I_X = 0, I_MEM, I_WIN, I_CONVW, I_ALOG, I_DTB, I_GNG, I_WA, I_SLNG, I_SLNB, I_SGUW, I_SGUB, I_WB, I_WMKV, I_WC, I_WO,
       I_LN1G, I_LN1B, I_RW, I_RB, I_WG, I_WU, I_WDN, I_WSG, I_WSU, I_WSD, I_LN2G, I_LN2B };

DI float bf2f(bf16_t h) { return __uint_as_float(((unsigned)h) << 16); }
DI bf16_t f2bf(float f) { unsigned u = __float_as_uint(f); u += 0x7fffu + ((u >> 16) & 1u); return (bf16_t)(u >> 16); }
DI unsigned pk2(float lo, float hi) { return (unsigned)f2bf(lo) | ((unsigned)f2bf(hi) << 16); }
DI float lo2f(unsigned u) { return __uint_as_float(u << 16); }
DI float hi2f(unsigned u) { return __uint_as_float(u & 0xffff0000u); }
DI float sigmoidf_(float x) { return 1.f / (1.f + __expf(-x)); }
DI float siluf_(float x) { return x / (1.f + __expf(-x)); }
DI float geluf_(float x) { float u = 0.7978845608028654f * (x + 0.044715f * x * x * x); float t = 1.f - 2.f / (__expf(2.f * u) + 1.f); return 0.5f * x * (1.f + t); }
DI float softplusf_(float x) { return fmaxf(x, 0.f) + log1pf(__expf(-fabsf(x))); }
DI float wave_sum(float v) {
#pragma unroll
  for (int o = 32; o; o >>= 1) v += __shfl_xor(v, o);
  return v;
}
DI f32x4 mfma16(bf16x8 a, bf16x8 b, f32x4 c) { return __builtin_amdgcn_mfma_f32_16x16x32_bf16(a, b, c, 0, 0, 0); }
DI bf16x8 ldfrag(const void* p) { return __builtin_bit_cast(bf16x8, *(const u32x4*)p); }
DI bf16x8 pack8(f32x4 a, f32x4 b) { u32x4 r = {pk2(a[0], a[1]), pk2(a[2], a[3]), pk2(b[0], b[1]), pk2(b[2], b[3])}; return __builtin_bit_cast(bf16x8, r); }
DI u32x2 pack4(f32x4 a) { u32x2 r = {pk2(a[0], a[1]), pk2(a[2], a[3])}; return r; }
DI int sw128(int row, int chunk) { return row * 128 + ((chunk ^ (row & 7)) << 4); }
DI int sw256(int row, int chunk) { return row * 256 + ((chunk ^ (row & 15)) << 4); }

template <bool GATHER>
DI void gemm_mainloop(unsigned char* smem, const bf16_t* __restrict__ A, int lda, const int* arow, int m0,
                      const bf16_t* __restrict__ Bt, int ldb, int n0, int K, f32x4 (&acc)[2][4]) {
  const int tid = threadIdx.x, lane = tid & 63, wave = tid >> 6;
  const int wm = wave & 3, wn = wave >> 2, fr = lane & 15, fq = lane >> 4;
  const int lr = tid >> 3, lc = tid & 7;
  __syncthreads();
  const size_t r0 = GATHER ? (size_t)arow[lr] : (size_t)(m0 + lr);
  const size_t r1 = GATHER ? (size_t)arow[lr + 64] : (size_t)(m0 + lr + 64);
  const bf16_t* pa0 = A + r0 * lda + lc * 8;
  const bf16_t* pa1 = A + r1 * lda + lc * 8;
  const bf16_t* pb0 = Bt + (size_t)(n0 + lr) * ldb + lc * 8;
  const bf16_t* pb1 = Bt + (size_t)(n0 + lr + 64) * ldb + lc * 8;
  const int w0 = sw128(lr, lc), w1 = sw128(lr + 64, lc);
  u32x4 va0 = *(const u32x4*)pa0, va1 = *(const u32x4*)pa1, vb0 = *(const u32x4*)pb0, vb1 = *(const u32x4*)pb1;
  *(u32x4*)(smem + w0) = va0; *(u32x4*)(smem + w1) = va1;
  *(u32x4*)(smem + 16384 + w0) = vb0; *(u32x4*)(smem + 16384 + w1) = vb1;
  __syncthreads();
  const int nk = K >> 6;
  for (int kt = 0; kt < nk; ++kt) {
    unsigned char* sA = smem + (kt & 1) * 32768;
    unsigned char* sB = sA + 16384;
    const bool more = (kt + 1 < nk);
    if (more) {
      const int ko = (kt + 1) * 64;
      va0 = *(const u32x4*)(pa0 + ko); va1 = *(const u32x4*)(pa1 + ko);
      vb0 = *(const u32x4*)(pb0 + ko); vb1 = *(const u32x4*)(pb1 + ko);
    }
#pragma unroll
    for (int ks = 0; ks < 2; ++ks) {
      bf16x8 af[2], bfr[4];
#pragma unroll
      for (int i = 0; i < 2; ++i) af[i] = ldfrag(sA + sw128(32 * wm + 16 * i + fr, 4 * ks + fq));
#pragma unroll
      for (int j = 0; j < 4; ++j) bfr[j] = ldfrag(sB + sw128(64 * wn + 16 * j + fr, 4 * ks + fq));
#pragma unroll
      for (int i = 0; i < 2; ++i)
#pragma unroll
        for (int j = 0; j < 4; ++j) acc[i][j] = mfma16(bfr[j], af[i], acc[i][j]);
    }
    if (more) {
      unsigned char* dA = smem + ((kt + 1) & 1) * 32768;
      *(u32x4*)(dA + w0) = va0; *(u32x4*)(dA + w1) = va1;
      *(u32x4*)(dA + 16384 + w0) = vb0; *(u32x4*)(dA + 16384 + w1) = vb1;
    }
    __syncthreads();
  }
}
DI void zero_acc(f32x4 (&acc)[2][4]) {
#pragma unroll
  for (int i = 0; i < 2; ++i)
#pragma unroll
    for (int j = 0; j < 4; ++j) acc[i][j] = (f32x4){0.f, 0.f, 0.f, 0.f};
}
DI void tile_mn(int t, int ntn, int& mt, int& nt) { const int pg = 16 * ntn; const int g = t / pg, r = t - g * pg; nt = r >> 4; mt = g * 16 + (r & 15); }


#define LAS __attribute__((address_space(3)))
#define XB_TMO      128
#define XB_XCNT(j)  (256  + 64 * (j))
#define XB_XSUB(j)  (1280 + 64 * (j))
#define XB_XGEN(j)  (2304 + 64 * (j))
#define XB_TOP      3328
#define XB_TOPGEN   3392
#define XCD_BAR_WORDS 3456
#define XB_SPIN_CAP (1u << 22)
DI unsigned xb_ld(unsigned* p)              { return __hip_atomic_load(p, __ATOMIC_RELAXED, __HIP_MEMORY_SCOPE_AGENT); }
DI unsigned xb_add(unsigned* p, unsigned v) { return __hip_atomic_fetch_add(p, v, __ATOMIC_RELAXED, __HIP_MEMORY_SCOPE_AGENT); }
DI unsigned xb_xcc_id() { return (unsigned)__builtin_amdgcn_s_getreg((3 << 11) | 20) & 0xFu; }
#define XB_SPIN(cond, bar) do { unsigned _sp = 0; while (cond) { __builtin_amdgcn_s_sleep(1); \
    if ((++_sp & 255u) == 0u) { if (xb_ld(&(bar)[XB_TMO])) break; if (_sp > XB_SPIN_CAP) { atomicAdd(&(bar)[XB_TMO], 1u); break; } } } } while (0)
struct XcdBarrier { unsigned* bar; unsigned x; volatile LAS unsigned* st; };
DI XcdBarrier xcd_barrier_post(unsigned* bar, volatile LAS unsigned* st) {
  XcdBarrier b; b.bar = bar; b.x = xb_xcc_id(); b.st = st;
  if (threadIdx.x == 0) (void)xb_add(&bar[XB_XCNT(b.x)], 1u);
  return b;
}
DI void xcd_barrier_complete(unsigned* bar, unsigned x, unsigned& nloc, unsigned& nx) {
  const unsigned G = gridDim.x * gridDim.y * gridDim.z;
  unsigned sum, cnt, mine, sp = 0u;
  for (;;) {
    sum = 0u; cnt = 0u; mine = 0u;
#pragma unroll
    for (unsigned j = 0; j < 16; ++j) { const unsigned c = xb_ld(&bar[XB_XCNT(j)]); sum += c; cnt += (c > 0u) ? 1u : 0u; mine = (j == x) ? c : mine; }
    if (sum == G) break;
    __builtin_amdgcn_s_sleep(1);
    if ((++sp & 255u) == 0u) { if (xb_ld(&bar[XB_TMO])) break; if (sp > XB_SPIN_CAP) { atomicAdd(&bar[XB_TMO], 1u); break; } }
  }
  nloc = mine > 0u ? mine : 1u; nx = cnt > 0u ? cnt : 1u;
}
DI void xcd_barrier(const XcdBarrier& b) {
  asm volatile("s_waitcnt vmcnt(0)" ::: "memory");
  __syncthreads();
  if (threadIdx.x == 0) {
    unsigned* bar = b.bar;
    __builtin_amdgcn_s_waitcnt(0);
    unsigned nloc = b.st[0], nx = b.st[1];
    if (nloc == 0u) { xcd_barrier_complete(bar, b.x, nloc, nx); b.st[0] = nloc; b.st[1] = nx; }
    const unsigned old = xb_add(&bar[XB_XSUB(b.x)], 1u);
    const unsigned gen = old / nloc;
    if (old + 1u == (gen + 1u) * nloc) {
      __builtin_amdgcn_fence(__ATOMIC_RELEASE, "agent");
      asm volatile("s_waitcnt vmcnt(0)" ::: "memory");
      const unsigned og = xb_add(&bar[XB_TOP], 1u);
      const unsigned tg = og / nx;
      if (og + 1u == (tg + 1u) * nx) xb_add(&bar[XB_TOPGEN], 1u);
      else XB_SPIN(xb_ld(&bar[XB_TOPGEN]) == tg, bar);
      __builtin_amdgcn_fence(__ATOMIC_ACQUIRE, "agent");
      xb_add(&bar[XB_XGEN(b.x)], 1u);
      asm volatile("s_waitcnt vmcnt(0)" ::: "memory");
    } else {
      XB_SPIN(xb_ld(&bar[XB_XGEN(b.x)]) == gen, bar);
      __builtin_amdgcn_fence(__ATOMIC_ACQUIRE, "agent");
      asm volatile("s_waitcnt vmcnt(0)" ::: "memory");
    }
  }
  __syncthreads();
}

DI void transpose_tile(float* tile, const float* s0, const float* s1, const float* s2, const float* s3, int ld, bf16_t* dst, int ldd) {
  const int tid = threadIdx.x;
  const int kr = tid >> 4, nc = tid & 15, sg = nc >> 2;
  const float* sp = sg == 0 ? s0 : sg == 1 ? s1 : sg == 2 ? s2 : s3;
  const f32x4 v0 = *(const f32x4*)(sp + (size_t)kr * ld + 4 * (nc & 3));
  const f32x4 v1 = *(const f32x4*)(sp + (size_t)(kr + 32) * ld + 4 * (nc & 3));
  __syncthreads();
  float* t0 = tile + kr * 65 + 4 * nc;
  float* t1 = tile + (kr + 32) * 65 + 4 * nc;
  t0[0] = v0[0]; t0[1] = v0[1]; t0[2] = v0[2]; t0[3] = v0[3];
  t1[0] = v1[0]; t1[1] = v1[1]; t1[2] = v1[2]; t1[3] = v1[3];
  __syncthreads();
  const int n = tid >> 3, kc = tid & 7;
  float e[8];
#pragma unroll
  for (int j = 0; j < 8; ++j) e[j] = tile[(8 * kc + j) * 65 + n];
  u32x4 o = {pk2(e[0], e[1]), pk2(e[2], e[3]), pk2(e[4], e[5]), pk2(e[6], e[7])};
  *(u32x4*)(dst + (size_t)n * ldd + 8 * kc) = o;
}

DI void phase0(const Params& p, unsigned char* smem, int bid, int nb) {
  const int tid = threadIdx.x, lane = tid & 63, wave = tid >> 6;
  unsigned char* ws = p.ws;
  if (bid == 0 && tid < 256) ((int*)(ws + O_CTRL))[tid * CSTR] = 0;
  {
    float* wabT = (float*)smem;
    const float* win = p.in[I_WIN];
    for (int i = tid; i < 8192; i += NTHR) { const int k = i >> 3, j = i & 7; wabT[j * 1024 + k] = win[(size_t)k * DIN + 2048 + j]; }
    __syncthreads();
    const float* x = p.in[I_X];
    bf16_t* xb = (bf16_t*)(ws + O_XB);
    float* ab = (float*)(ws + O_AB);
    for (int row = bid * 8 + wave; row < T; row += nb * 8) {
      float s[8];
#pragma unroll
      for (int j = 0; j < 8; ++j) s[j] = 0.f;
#pragma unroll
      for (int i = 0; i < 4; ++i) {
        const int k = 256 * i + 4 * lane;
        const f32x4 v = *(const f32x4*)(x + (size_t)row * D + k);
        *(u32x2*)(xb + (size_t)row * D + k) = pack4(v);
#pragma unroll
        for (int j = 0; j < 8; ++j) { const f32x4 w = *(const f32x4*)(wabT + j * 1024 + k); s[j] += v[0] * w[0] + v[1] * w[1] + v[2] * w[2] + v[3] * w[3]; }
      }
#pragma unroll
      for (int j = 0; j < 8; ++j) s[j] = wave_sum(s[j]);
      if (lane == 0) { *(f32x4*)(ab + (size_t)row * 8) = (f32x4){s[0], s[1], s[2], s[3]}; *(f32x4*)(ab + (size_t)row * 8 + 4) = (f32x4){s[4], s[5], s[6], s[7]}; }
    }
    const float* mem = p.in[I_MEM];
    bf16_t* memb = (bf16_t*)(ws + O_MEMB);
    for (int row = bid * 8 + wave; row < 512; row += nb * 8) {
#pragma unroll
      for (int i = 0; i < 4; ++i) { const int k = 256 * i + 4 * lane; *(u32x2*)(memb + (size_t)row * D + k) = pack4(*(const f32x4*)(mem + (size_t)row * D + k)); }
    }
    const float* sw = p.in[I_SGUW];
    bf16_t* sguw = (bf16_t*)(ws + O_SGUW);
    for (int i = bid * NTHR + tid; i < 16384; i += nb * NTHR) {
      const int e0 = i * 4; const int col = e0 & 127, rowi = (e0 >> 7) & 127;
      f32x4 v = *(const f32x4*)(sw + e0);
#pragma unroll
      for (int c = 0; c < 4; ++c) if (col + c > rowi) v[c] = 0.f;
      *(u32x2*)(sguw + e0) = pack4(v);
    }
    __syncthreads();
  }
  {
    float* tile = (float*)smem;
    constexpr int J0 = 1664, J1 = J0 + 128, J2 = J1 + 128, J3 = J2 + 128, J4 = J3 + 256, J5 = J4 + 256, J6 = J5 + 64, J7 = J6 + 128, J8 = J7 + 64,
                  J9 = J8 + 32768, J10 = J9 + 16384;
    for (int it = bid; it < J10; it += nb) {
      const float *s0, *s1, *s2, *s3; int ld, ldd; bf16_t* dst;
      if (it < J0) {
        const int kt = it & 15, nt = it >> 4; const int n0 = nt * 64; const int c0 = n0 + (n0 >= 2048 ? 8 : 0);
        const float* b = p.in[I_WIN] + (size_t)kt * 64 * DIN + c0; s0 = b; s1 = b + 16; s2 = b + 32; s3 = b + 48; ld = DIN; ldd = 1024;
        dst = (bf16_t*)(ws + O_WINT) + (size_t)n0 * 1024 + kt * 64;
      } else if (it < J3) {
        const int which = (it - J0) >> 7, r = (it - J0) & 127; const int kt = r & 7, nt = r >> 3;
        const float* src = p.in[which == 0 ? I_WA : which == 1 ? I_WB : I_WC];
        const float* b = src + (size_t)kt * 64 * 1024 + nt * 64; s0 = b; s1 = b + 16; s2 = b + 32; s3 = b + 48; ld = 1024; ldd = 512;
        dst = (bf16_t*)(ws + (which == 0 ? O_WAT : which == 1 ? O_WBT : O_WCT)) + (size_t)nt * 64 * 512 + kt * 64;
      } else if (it < J5) {
        const int which = (it - J3) >> 8, r = (it - J3) & 255; const int kt = r & 15, nt = r >> 4;
        const float* b = p.in[which == 0 ? I_WO : I_WMKV] + (size_t)kt * 64 * 1024 + nt * 64; s0 = b; s1 = b + 16; s2 = b + 32; s3 = b + 48; ld = 1024; ldd = 1024;
        dst = (bf16_t*)(ws + (which == 0 ? O_WOT : O_WMKV)) + (size_t)nt * 64 * 1024 + kt * 64;
      } else if (it < J6) {
        const int r = it - J5; const int kt = r & 15, nt = r >> 4;
        const float* b = p.in[I_RW] + (size_t)kt * 64 * 256 + nt * 64; s0 = b; s1 = b + 16; s2 = b + 32; s3 = b + 48; ld = 256; ldd = 1024;
        dst = (bf16_t*)(ws + O_ROUT) + (size_t)nt * 64 * 1024 + kt * 64;
      } else if (it < J7) {
        const int r = it - J6; const int kt = r & 15, nt = r >> 4;
        const float* g = p.in[I_WSG] + (size_t)kt * 64 * 256 + nt * 32; const float* u = p.in[I_WSU] + (size_t)kt * 64 * 256 + nt * 32;
        s0 = g; s1 = u; s2 = g + 16; s3 = u + 16; ld = 256; ldd = 1024;
        dst = (bf16_t*)(ws + O_WSGU) + (size_t)nt * 64 * 1024 + kt * 64;
      } else if (it < J8) {
        const int r = it - J7; const int kt = r & 3, nt = r >> 2;
        const float* b = p.in[I_WSD] + (size_t)kt * 64 * 1024 + nt * 64; s0 = b; s1 = b + 16; s2 = b + 32; s3 = b + 48; ld = 1024; ldd = 256;
        dst = (bf16_t*)(ws + O_WSD) + (size_t)nt * 64 * 256 + kt * 64;
      } else if (it < J9) {
        const int r = it - J8; const int e = r >> 7, q = r & 127; const int kt = q & 15, nt = q >> 4;
        const float* g = p.in[I_WG] + (size_t)e * 262144 + (size_t)kt * 64 * 256 + nt * 32; const float* u = p.in[I_WU] + (size_t)e * 262144 + (size_t)kt * 64 * 256 + nt * 32;
        s0 = g; s1 = u; s2 = g + 16; s3 = u + 16; ld = 256; ldd = 1024;
        dst = (bf16_t*)(ws + O_WGU) + (size_t)e * 524288 + (size_t)nt * 64 * 1024 + kt * 64;
      } else {
        const int r = it - J9; const int e = r >> 6, q = r & 63; const int kt = q & 3, nt = q >> 2;
        const float* b = p.in[I_WDN] + (size_t)e * 262144 + (size_t)kt * 64 * 1024 + nt * 64; s0 = b; s1 = b + 16; s2 = b + 32; s3 = b + 48; ld = 1024; ldd = 256;
        dst = (bf16_t*)(ws + O_WD) + (size_t)e * 262144 + (size_t)nt * 64 * 256 + kt * 64;
      }
      transpose_tile(tile, s0, s1, s2, s3, ld, dst, ldd);
    }
  }
}

DI void phase1(const Params& p, unsigned char* smem, int bid, int nb) {
  const int tid = threadIdx.x, lane = tid & 63, wave = tid >> 6;
  const int wm = wave & 3, wn = wave >> 2, fr = lane & 15, fq = lane >> 4;
  unsigned char* ws = p.ws;
  const bf16_t* xb = (const bf16_t*)(ws + O_XB);
  const bf16_t* wint = (const bf16_t*)(ws + O_WINT);
  constexpr int NTN = NPROJ / 128;
  constexpr int NT1 = 128 * NTN;
  for (int t = bid; t < NT1 + 32; t += nb) {
    f32x4 acc[2][4]; zero_acc(acc);
    if (t < NT1) {
      int mt, nt; tile_mn(t, NTN, mt, nt);
      const int m0 = mt * 128, n0 = nt * 128;
      gemm_mainloop<false>(smem, xb, 1024, nullptr, m0, wint, 1024, n0, 1024, acc);
#pragma unroll
      for (int i = 0; i < 2; ++i) {
        const size_t row = m0 + 32 * wm + 16 * i + fr;
#pragma unroll
        for (int j = 0; j < 4; ++j) {
          const int col = n0 + 64 * wn + 16 * j + 4 * fq;
          f32x4 v = acc[i][j];
          if (n0 < 1536) { *(u32x2*)((bf16_t*)(ws + O_QKV) + row * 1536 + col) = pack4(v); }
          else if (n0 < 2048) {
#pragma unroll
            for (int c = 0; c < 4; ++c) v[c] = siluf_(v[c]);
            *(u32x2*)((bf16_t*)(ws + O_ZS) + row * 512 + (col - 1536)) = pack4(v);
          } else if (n0 < 3072) {
#pragma unroll
            for (int c = 0; c < 4; ++c) v[c] = geluf_(v[c]);
            *(u32x2*)((bf16_t*)(ws + O_UVG) + row * 1024 + (col - 2048)) = pack4(v);
          } else if (n0 < 3584) {
#pragma unroll
            for (int c = 0; c < 4; ++c) v[c] *= 0.08838834764831845f;
            *(u32x2*)((bf16_t*)(ws + O_XQ) + row * 512 + (col - 3072)) = pack4(v);
          } else {
#pragma unroll
            for (int c = 0; c < 4; ++c) v[c] = sigmoidf_(v[c]);
            *(u32x2*)((bf16_t*)(ws + O_GATES) + row * 3072 + (col - 3584)) = pack4(v);
          }
        }
      }
    } else {
      const int r = t - NT1; const int mt = r & 3, nt = r >> 2;
      const int m0 = mt * 128, n0 = nt * 128;
      gemm_mainloop<false>(smem, (const bf16_t*)(ws + O_MEMB), 1024, nullptr, m0, (const bf16_t*)(ws + O_WMKV), 1024, n0, 1024, acc);
#pragma unroll
      for (int i = 0; i < 2; ++i) {
        const int row = m0 + 32 * wm + 16 * i + fr; const int b = row >> 8, key = row & 255;
#pragma unroll
        for (int j = 0; j < 4; ++j) {
          const int col = n0 + 64 * wn + 16 * j + 4 * fq;
          const f32x4 v = acc[i][j];
          if (col < 512) { const int h = col >> 7, d = col & 127; *(u32x2*)((bf16_t*)(ws + O_MEMK) + ((size_t)((b * 4 + h) * 256 + key)) * 128 + d) = pack4(v); }
          else {
            const int c2 = col - 512; const int h = c2 >> 7, d = c2 & 127;
            const int pos = 32 * (key >> 5) + 8 * ((key >> 2) & 3) + 4 * ((key >> 4) & 1) + (key & 3);
            bf16_t* vt = (bf16_t*)(ws + O_MEMVT) + ((size_t)((b * 4 + h) * 128 + d)) * 256 + pos;
#pragma unroll
            for (int c = 0; c < 4; ++c) vt[(size_t)c * 256] = f2bf(v[c]);
          }
        }
      }
    }
  }
}

constexpr int G_KF = 0, G_VF = 32768, G_QB = 65536, G_KB = 81920, G_UT = 81920  , G_L = 98304, G_ATT = 114688, G_KDT = 122880, G_WT = 139264, G_SM = 155648;

DI void gdn_prep_item(const Params& p, unsigned char* smem, int item) {
  int tid = threadIdx.x; asm volatile("" : "+v"(tid));
  const int lane = tid & 63, wave = __builtin_amdgcn_readfirstlane(tid >> 6), fr = lane & 15, fq = lane >> 4;
  unsigned char* ws = p.ws;
  const int h = item & 3, cn = item >> 2;
  const int bidx = cn >> 7, n = cn & 127;
  const size_t t0 = (size_t)bidx * SEQ + (size_t)n * 64;
  float* kf = (float*)(smem + G_KF); float* vf = (float*)(smem + G_VF); float* Lm = (float*)(smem + G_L);
  float* sbeta = (float*)(smem + G_SM); float* sgc = sbeta + 64; float* segc = sbeta + 128;
  __syncthreads();
  {
    const bf16_t* qkv = (const bf16_t*)(ws + O_QKV);
    const float* cw = p.in[I_CONVW];
    const int tl0 = wave * 8;
#pragma unroll
    for (int sect = 0; sect < 3; ++sect) {
      const int cb = sect * 512 + h * 128 + 2 * lane;
      float w0[4], w1[4];
#pragma unroll
      for (int i = 0; i < 4; ++i) { w0[i] = cw[i * 1536 + cb]; w1[i] = cw[i * 1536 + cb + 1]; }
      float xa[11], xc[11];
#pragma unroll
      for (int r = 0; r < 11; ++r) {
        const int s = n * 64 + tl0 + r - 3;
        unsigned u = 0u;
        if (s >= 0) u = *(const unsigned*)(qkv + ((size_t)bidx * SEQ + s) * 1536 + cb);
        xa[r] = lo2f(u); xc[r] = hi2f(u);
      }
#pragma unroll
      for (int r = 0; r < 8; ++r) {
        float y0 = w0[0] * xa[r] + w0[1] * xa[r + 1] + w0[2] * xa[r + 2] + w0[3] * xa[r + 3];
        float y1 = w1[0] * xc[r] + w1[1] * xc[r + 1] + w1[2] * xc[r + 2] + w1[3] * xc[r + 3];
        y0 = siluf_(y0); y1 = siluf_(y1);
        const int tl = tl0 + r;
        if (sect == 2) { vf[tl * 128 + 2 * lane] = y0; vf[tl * 128 + 2 * lane + 1] = y1; }
        else {
          const float ss = wave_sum(y0 * y0 + y1 * y1);
          const float sc = rsqrtf(ss + 1e-6f) * (sect == 0 ? 0.08838834764831845f : 1.0f);
          y0 *= sc; y1 *= sc;
          const int off = sw256(tl, lane >> 2) + (lane & 3) * 4;
          if (sect == 0) *(unsigned*)(smem + G_QB + off) = pk2(y0, y1);
          else { *(unsigned*)(smem + G_KB + off) = pk2(y0, y1); kf[tl * 128 + 2 * lane] = y0; kf[tl * 128 + 2 * lane + 1] = y1; }
        }
      }
    }
    if (wave == 0) {
      const float* ab = (const float*)(ws + O_AB) + (t0 + lane) * 8;
      const float a = ab[h], bb = ab[4 + h];
      const float beta = sigmoidf_(bb);
      float g = -__expf(p.in[I_ALOG][h]) * softplusf_(a + p.in[I_DTB][h]);
#pragma unroll
      for (int o = 1; o < 64; o <<= 1) { const float y = __shfl_up(g, o); if (lane >= o) g += y; }
      sbeta[lane] = beta; sgc[lane] = g; segc[lane] = __expf(g);
      if (lane == 63) ((float*)(ws + O_GL))[item] = __expf(g);
    }
  }
  __syncthreads();
  {
#pragma unroll
    for (int q = 0; q < 4; ++q) {
      const int idx = wave * 4 + q; const int isq = idx >> 4, ti = (idx >> 2) & 3, tj = idx & 3;
      f32x4 acc = {0.f, 0.f, 0.f, 0.f};
      if (tj <= ti) {
#pragma unroll
        for (int ks = 0; ks < 4; ++ks) {
          const bf16x8 ai = ldfrag(smem + (isq ? G_QB : G_KB) + sw256(16 * ti + fr, 4 * ks + fq));
          const bf16x8 bj = ldfrag(smem + G_KB + sw256(16 * tj + fr, 4 * ks + fq));
          acc = isq ? mfma16(bj, ai, acc) : mfma16(ai, bj, acc);
        }
      }
      if (isq) {
        const int i = 16 * ti + fr, j0 = 16 * tj + 4 * fq;
        const float gi = sgc[i];
        f32x4 o;
#pragma unroll
        for (int r = 0; r < 4; ++r) { const int j = j0 + r; o[r] = (j <= i) ? acc[r] * __expf(gi - sgc[j]) : 0.f; }
        *(u32x2*)(smem + G_ATT + sw128(i, j0 >> 3) + (j0 & 7) * 2) = pack4(o);
      } else {
        const int j = 16 * tj + fr, i0 = 16 * ti + 4 * fq;
        const float gj = sgc[j];
        f32x4 o;
#pragma unroll
        for (int r = 0; r < 4; ++r) { const int i = i0 + r; o[r] = (j < i) ? acc[r] * __expf(sgc[i] - gj) * sbeta[i] : 0.f; }
        *(f32x4*)(Lm + j * 64 + i0) = o;
      }
    }
  }
  {
    const float gl_ = sgc[63];
    const int d = tid & 127, tg = tid >> 7;
#pragma unroll
    for (int c = 0; c < 2; ++c) {
      float e[8];
#pragma unroll
      for (int j = 0; j < 8; ++j) { const int t = 16 * tg + 8 * c + j; e[j] = kf[t * 128 + d] * __expf(gl_ - sgc[t]); }
      u32x4 o = {pk2(e[0], e[1]), pk2(e[2], e[3]), pk2(e[4], e[5]), pk2(e[6], e[7])};
      *(u32x4*)(smem + G_KDT + sw128(d, 2 * tg + c)) = o;
    }
  }
  __syncthreads();
  if (tid < 256) {
    const bool isw = tid >= 128;
    float* X = isw ? (kf + (tid - 128)) : (vf + tid);
    unsigned char* dstT = smem + (isw ? G_WT : G_UT);
    const int rowc = tid & 127;
#pragma unroll
    for (int b = 0; b < 4; ++b) {
      float xr[16];
#pragma unroll
      for (int r = 0; r < 16; ++r) { const int t = 16 * b + r; float sc = sbeta[t]; if (isw) sc *= segc[t]; xr[r] = X[t * 128] * sc; }
#pragma unroll 2
      for (int j = 0; j < 16 * b; ++j) {
        const float xj = X[j * 128];
        const float* lt = Lm + j * 64 + 16 * b;
        const f32x4 l0 = *(const f32x4*)lt, l1 = *(const f32x4*)(lt + 4), l2 = *(const f32x4*)(lt + 8), l3 = *(const f32x4*)(lt + 12);
#pragma unroll
        for (int r = 0; r < 4; ++r) { xr[r] -= l0[r] * xj; xr[4 + r] -= l1[r] * xj; xr[8 + r] -= l2[r] * xj; xr[12 + r] -= l3[r] * xj; }
      }
#pragma unroll
      for (int q = 0; q < 15; ++q) {
        const float* lt = Lm + (16 * b + q) * 64 + 16 * b;
        float l[16];
#pragma unroll
        for (int g4 = 0; g4 < 4; ++g4) if (4 * g4 + 3 > q) { const f32x4 t4 = *(const f32x4*)(lt + 4 * g4); l[4 * g4] = t4[0]; l[4 * g4 + 1] = t4[1]; l[4 * g4 + 2] = t4[2]; l[4 * g4 + 3] = t4[3]; }
#pragma unroll
        for (int r = q + 1; r < 16; ++r) xr[r] -= l[r] * xr[q];
      }
#pragma unroll
      for (int r = 0; r < 16; ++r) X[(16 * b + r) * 128] = xr[r];
      u32x4 o0 = {pk2(xr[0], xr[1]), pk2(xr[2], xr[3]), pk2(xr[4], xr[5]), pk2(xr[6], xr[7])};
      u32x4 o1 = {pk2(xr[8], xr[9]), pk2(xr[10], xr[11]), pk2(xr[12], xr[13]), pk2(xr[14], xr[15])};
      *(u32x4*)(dstT + sw128(rowc, 2 * b)) = o0;
      *(u32x4*)(dstT + sw128(rowc, 2 * b + 1)) = o1;
    }
  }
  __syncthreads();
  {
    bf16x8 ak[2];
#pragma unroll
    for (int ks = 0; ks < 2; ++ks) ak[ks] = ldfrag(smem + G_KDT + sw128(16 * wave + fr, 4 * ks + fq));
    bf16_t* mp = (bf16_t*)(ws + O_MP) + (size_t)item * 16384;
    float* bc = (float*)(ws + O_BC) + (size_t)item * 16384;
#pragma unroll
    for (int tj = 0; tj < 8; ++tj) {
      f32x4 am = {0.f, 0.f, 0.f, 0.f}, ab_ = {0.f, 0.f, 0.f, 0.f};
#pragma unroll
      for (int ks = 0; ks < 2; ++ks) {
        const bf16x8 bw = ldfrag(smem + G_WT + sw128(16 * tj + fr, 4 * ks + fq));
        const bf16x8 bu = ldfrag(smem + G_UT + sw128(16 * tj + fr, 4 * ks + fq));
        am = mfma16(bw, ak[ks], am);
        ab_ = mfma16(ak[ks], bu, ab_);
      }
      f32x4 nm = {-am[0], -am[1], -am[2], -am[3]};
      *(u32x2*)(mp + ((size_t)((wave * 4 + (tj >> 1)) * 64 + lane)) * 8 + (tj & 1) * 4) = pack4(nm);
      *(f32x4*)(bc + ((size_t)((tj * 8 + wave) * 64 + lane)) * 4) = ab_;
    }
    const int tt = wave & 3, hf = wave >> 2;
    bf16x8 aa[2];
#pragma unroll
    for (int ks = 0; ks < 2; ++ks) aa[ks] = ldfrag(smem + G_ATT + sw128(16 * tt + fr, 4 * ks + fq));
    const int trow = 16 * tt + fr;
    const float eg = segc[trow];
    float* o0 = (float*)(ws + O_O0) + (t0 + trow) * 512 + h * 128;
    bf16_t* qp = (bf16_t*)(ws + O_QP) + (size_t)item * 8192 + trow * 128;
#pragma unroll
    for (int q = 0; q < 4; ++q) {
      const int te = hf * 4 + q;
      f32x4 ao = {0.f, 0.f, 0.f, 0.f}, aw = {0.f, 0.f, 0.f, 0.f};
#pragma unroll
      for (int ks = 0; ks < 2; ++ks) {
        const bf16x8 bu = ldfrag(smem + G_UT + sw128(16 * te + fr, 4 * ks + fq));
        const bf16x8 bw = ldfrag(smem + G_WT + sw128(16 * te + fr, 4 * ks + fq));
        ao = mfma16(bu, aa[ks], ao);
        aw = mfma16(bw, aa[ks], aw);
      }
      const int e0 = 16 * te + 4 * fq;
      *(f32x4*)(o0 + e0) = ao;
      const u32x2 qv = *(const u32x2*)(smem + G_QB + sw256(trow, e0 >> 3) + (e0 & 7) * 2);
      f32x4 qd = {lo2f(qv[0]) * eg - aw[0], hi2f(qv[0]) * eg - aw[1], lo2f(qv[1]) * eg - aw[2], hi2f(qv[1]) * eg - aw[3]};
      *(u32x2*)(qp + e0) = pack4(qd);
    }
  }
}

DI void sgu_item(const Params& p, unsigned char* smem, int item) {
  int tid = threadIdx.x; asm volatile("" : "+v"(tid));
  const int lane = tid & 63, wave = __builtin_amdgcn_readfirstlane(tid >> 6), fr = lane & 15, fq = lane >> 4;
  unsigned char* ws = p.ws;
  const int g = item & 3, cn = item >> 2;
  const size_t t0 = (size_t)cn * 128;
  const bf16_t* uvg = (const bf16_t*)(ws + O_UVG);
  __syncthreads();
  {
    const float* lng = p.in[I_SLNG]; const float* lnb = p.in[I_SLNB];
    const int cl0 = 8 * (lane & 15);
    float gg[8], bb[8];
#pragma unroll
    for (int e = 0; e < 8; ++e) { gg[e] = lng[128 * g + cl0 + e]; bb[e] = lnb[128 * g + cl0 + e]; }
    for (int jj = 0; jj < 16; ++jj) {
      const int j = 16 * wave + jj;
      const u32x4 raw = *(const u32x4*)(uvg + (t0 + j) * 1024 + 512 + 8 * lane);
      float v[8];
#pragma unroll
      for (int e = 0; e < 4; ++e) { v[2 * e] = lo2f(raw[e]); v[2 * e + 1] = hi2f(raw[e]); }
      float s = 0.f;
#pragma unroll
      for (int e = 0; e < 8; ++e) s += v[e];
      const float mean = wave_sum(s) * (1.f / 512.f);
      float q = 0.f;
#pragma unroll
      for (int e = 0; e < 8; ++e) { const float d = v[e] - mean; q += d * d; }
      const float rstd = rsqrtf(wave_sum(q) * (1.f / 512.f) + 1e-5f);
      if ((lane >> 4) == g) {
#pragma unroll
        for (int e = 0; e < 8; ++e) {
          const int c = cl0 + e;
          const float y = (v[e] - mean) * rstd * gg[e] + bb[e];
          *(bf16_t*)(smem + sw256(c, j >> 3) + (j & 7) * 2) = f2bf(y);
        }
      }
    }
  }
  __syncthreads();
  {
    const bf16_t* wg = (const bf16_t*)(ws + O_SGUW) + (size_t)g * 16384;
    const int i = 16 * wave + fr;
    bf16x8 af[4];
#pragma unroll
    for (int ks = 0; ks < 4; ++ks) af[ks] = ldfrag(wg + i * 128 + 32 * ks + 8 * fq);
    const float bias = p.in[I_SGUB][g * 128 + i];
    bf16_t* out = (bf16_t*)(ws + O_SGUO) + (t0 + i) * 512 + 128 * g;
    const bf16_t* urow = uvg + (t0 + i) * 1024 + 128 * g;
#pragma unroll
    for (int jt = 0; jt < 8; ++jt) {
      f32x4 acc = {0.f, 0.f, 0.f, 0.f};
#pragma unroll
      for (int ks = 0; ks < 4; ++ks) acc = mfma16(ldfrag(smem + sw256(16 * jt + fr, 4 * ks + fq)), af[ks], acc);
      const int c0 = 16 * jt + 4 * fq;
      const u32x2 uu = *(const u32x2*)(urow + c0);
      f32x4 o = {lo2f(uu[0]) * (acc[0] + bias), hi2f(uu[0]) * (acc[1] + bias), lo2f(uu[1]) * (acc[2] + bias), hi2f(uu[1]) * (acc[3] + bias)};
      *(u32x2*)(out + c0) = pack4(o);
    }
  }
}

DI void xattn_item(const Params& p, int item) {
  int tid = threadIdx.x; asm volatile("" : "+v"(tid));
  const int lane = tid & 63, wave = __builtin_amdgcn_readfirstlane(tid >> 6), fr = lane & 15, fq = lane >> 4;
  unsigned char* ws = p.ws;
  const int h = item & 3, qt = item >> 2;
  const size_t trow = (size_t)qt * 128 + 16 * wave + fr;
  const int b = (qt * 128) >> 13;
  const bf16_t* xq = (const bf16_t*)(ws + O_XQ) + trow * 512 + h * 128;
  const bf16_t* mk = (const bf16_t*)(ws + O_MEMK) + (size_t)(b * 4 + h) * 32768;
  const bf16_t* mv = (const bf16_t*)(ws + O_MEMVT) + (size_t)(b * 4 + h) * 32768;
  bf16x8 qf[4];
#pragma unroll
  for (int ds = 0; ds < 4; ++ds) qf[ds] = ldfrag(xq + 32 * ds + 8 * fq);
  f32x4 sc[16];
#pragma unroll
  for (int kt = 0; kt < 16; ++kt) {
    f32x4 a = {0.f, 0.f, 0.f, 0.f};
#pragma unroll
    for (int ds = 0; ds < 4; ++ds) a = mfma16(ldfrag(mk + (16 * kt + fr) * 128 + 32 * ds + 8 * fq), qf[ds], a);
    sc[kt] = a;
  }
  float m = -1e30f;
#pragma unroll
  for (int kt = 0; kt < 16; ++kt)
#pragma unroll
    for (int r = 0; r < 4; ++r) m = fmaxf(m, sc[kt][r]);
  m = fmaxf(m, __shfl_xor(m, 16)); m = fmaxf(m, __shfl_xor(m, 32));
  float l = 0.f;
#pragma unroll
  for (int kt = 0; kt < 16; ++kt)
#pragma unroll
    for (int r = 0; r < 4; ++r) { const float e = __expf(sc[kt][r] - m); sc[kt][r] = e; l += e; }
  l += __shfl_xor(l, 16); l += __shfl_xor(l, 32);
  const float inv = 1.f / l;
  bf16x8 pf[8];
#pragma unroll
  for (int s = 0; s < 8; ++s) pf[s] = pack8(sc[2 * s], sc[2 * s + 1]);
  bf16_t* out = (bf16_t*)(ws + O_XATO) + trow * 512 + h * 128;
#pragma unroll
  for (int dt = 0; dt < 8; ++dt) {
    f32x4 a = {0.f, 0.f, 0.f, 0.f};
#pragma unroll
    for (int s = 0; s < 8; ++s) a = mfma16(ldfrag(mv + (16 * dt + fr) * 256 + 32 * s + 8 * fq), pf[s], a);
    f32x4 o = {a[0] * inv, a[1] * inv, a[2] * inv, a[3] * inv};
    *(u32x2*)(out + 16 * dt + 4 * fq) = pack4(o);
  }
}

DI void phase2(const Params& p, unsigned char* smem, int bid, int nb) {
  for (int it = bid; it < 2048; it += nb) {
    if (it < 1024) gdn_prep_item(p, smem, it);
    else if (it < 1536) sgu_item(p, smem, it - 1024);
    else xattn_item(p, it - 1536);
  }
}

DI void gdn_scan(const Params& p, int sb, int w) {
  const int lane = threadIdx.x & 63;
  unsigned char* ws = p.ws;
  const int bh = sb >> 1, es = 4 * (sb & 1) + w;
  const int b = bh >> 2, h = bh & 3;
  f32x4 acc[8];
#pragma unroll
  for (int t = 0; t < 8; ++t) acc[t] = (f32x4){0.f, 0.f, 0.f, 0.f};
  const int fr = lane & 15, fq = lane >> 4;
  const size_t item0 = (size_t)(b * 128) * 4 + h;
  const bf16_t* mp = (const bf16_t*)(ws + O_MP) + item0 * 16384 + lane * 8;
  const float* bc = (const float*)(ws + O_BC) + item0 * 16384 + (size_t)es * 2048 + lane * 4;
  bf16_t* st = (bf16_t*)(ws + O_ST) + item0 * 16384 + (size_t)(16 * es + fr) * 128 + 4 * fq;
  const float* glp = (const float*)(ws + O_GL) + item0;
  constexpr size_t ISTR = 4 * 16384;
  bf16x8 A[32]; f32x4 C[8]; float gl;
#pragma unroll
  for (int i = 0; i < 32; ++i) A[i] = ldfrag(mp + i * 512);
#pragma unroll
  for (int t = 0; t < 8; ++t) C[t] = *(const f32x4*)(bc + t * 256);
  gl = glp[0];
  for (int n = 0; n < 128; ++n) {
    const int nn = (n < 127) ? n + 1 : n;
    const bf16_t* mpn = mp + (size_t)nn * ISTR;
    const float* bcn = bc + (size_t)nn * ISTR;
    bf16_t* stn = st + (size_t)n * ISTR;
    bf16x8 bfr[4];
#pragma unroll
    for (int s = 0; s < 4; ++s) {
      const u32x2 lo = pack4(acc[2 * s]), hi = pack4(acc[2 * s + 1]);
      *(u32x2*)(stn + 32 * s) = lo; *(u32x2*)(stn + 32 * s + 16) = hi;
      u32x4 v = {lo[0], lo[1], hi[0], hi[1]};
      bfr[s] = __builtin_bit_cast(bf16x8, v);
    }
    const float gcur = gl;
    gl = glp[(size_t)nn * 4];
#pragma unroll
    for (int t = 0; t < 8; ++t) {
      f32x4 a = {gcur * acc[t][0] + C[t][0], gcur * acc[t][1] + C[t][1], gcur * acc[t][2] + C[t][2], gcur * acc[t][3] + C[t][3]};
      C[t] = *(const f32x4*)(bcn + t * 256);
#pragma unroll
      for (int s = 0; s < 4; ++s) { a = mfma16(A[t * 4 + s], bfr[s], a); A[t * 4 + s] = ldfrag(mpn + (t * 4 + s) * 512); }
      acc[t] = a;
    }
  }
}

DI void part_tile(const Params& p, unsigned char* smem, int t) {
  const int tid = threadIdx.x, lane = tid & 63, wave = tid >> 6;
  const int wm = wave & 3, wn = wave >> 2, fr = lane & 15, fq = lane >> 4;
  unsigned char* ws = p.ws;
  int mt, nt; tile_mn(t, 8, mt, nt);
  const int m0 = mt * 128, n0 = nt * 128;
  f32x4 acc[2][4], acc2[2][4]; zero_acc(acc); zero_acc(acc2);
  gemm_mainloop<false>(smem, (const bf16_t*)(ws + O_SGUO), 512, nullptr, m0, (const bf16_t*)(ws + O_WBT), 512, n0, 512, acc);
  gemm_mainloop<false>(smem, (const bf16_t*)(ws + O_XATO), 512, nullptr, m0, (const bf16_t*)(ws + O_WCT), 512, n0, 512, acc2);
  const bf16_t* gates = (const bf16_t*)(ws + O_GATES);
  bf16_t* part = (bf16_t*)(ws + O_PART);
#pragma unroll
  for (int i = 0; i < 2; ++i) {
    const size_t row = m0 + 32 * wm + 16 * i + fr;
#pragma unroll
    for (int j = 0; j < 4; ++j) {
      const int col = n0 + 64 * wn + 16 * j + 4 * fq;
      const u32x2 g1 = *(const u32x2*)(gates + row * 3072 + 1024 + col);
      const u32x2 g2 = *(const u32x2*)(gates + row * 3072 + 2048 + col);
      f32x4 o = {lo2f(g1[0]) * acc[i][j][0] + lo2f(g2[0]) * acc2[i][j][0], hi2f(g1[0]) * acc[i][j][1] + hi2f(g2[0]) * acc2[i][j][1],
                 lo2f(g1[1]) * acc[i][j][2] + lo2f(g2[1]) * acc2[i][j][2], hi2f(g1[1]) * acc[i][j][3] + hi2f(g2[1]) * acc2[i][j][3]};
      *(u32x2*)(part + row * 1024 + col) = pack4(o);
    }
  }
}

DI void phase3(const Params& p, unsigned char* smem, int bid, int nb) {
  if (bid < 16) {
    const int wave = threadIdx.x >> 6;
    if (wave < 4) gdn_scan(p, bid, wave);
  } else {
    for (int t = bid - 16; t < 1024; t += nb - 16) part_tile(p, smem, t);
  }
}

DI void phase4(const Params& p, int bid, int nb) {
  const int tid = threadIdx.x, lane = tid & 63, wave = tid >> 6, fr = lane & 15, fq = lane >> 4;
  unsigned char* ws = p.ws;
  for (int it = bid; it < 512; it += nb) {
    const int item = it * 2 + (wave >> 2), tt = wave & 3;
    const int h = item & 3, cn = item >> 2;
    const size_t trow = (size_t)cn * 64 + 16 * tt + fr;
    const bf16_t* qp = (const bf16_t*)(ws + O_QP) + (size_t)item * 8192 + (16 * tt + fr) * 128;
    const bf16_t* st = (const bf16_t*)(ws + O_ST) + (size_t)item * 16384;
    const float* o0 = (const float*)(ws + O_O0) + trow * 512 + h * 128;
    bf16x8 af[4];
#pragma unroll
    for (int ks = 0; ks < 4; ++ks) af[ks] = ldfrag(qp + 32 * ks + 8 * fq);
    f32x4 acc[8];
    float ss = 0.f;
#pragma unroll
    for (int j = 0; j < 8; ++j) {
      f32x4 a = *(const f32x4*)(o0 + 16 * j + 4 * fq);
#pragma unroll
      for (int ks = 0; ks < 4; ++ks) a = mfma16(ldfrag(st + (16 * j + fr) * 128 + 32 * ks + 8 * fq), af[ks], a);
      acc[j] = a;
      ss += a[0] * a[0] + a[1] * a[1] + a[2] * a[2] + a[3] * a[3];
    }
    ss += __shfl_xor(ss, 16); ss += __shfl_xor(ss, 32);
    const float rms = rsqrtf(ss * (1.f / 128.f) + 1e-6f);
    const float* ng = p.in[I_GNG];
    const bf16_t* zs = (const bf16_t*)(ws + O_ZS) + trow * 512 + h * 128;
    bf16_t* out = (bf16_t*)(ws + O_GDNO) + trow * 512 + h * 128;
#pragma unroll
    for (int j = 0; j < 8; ++j) {
      const int e0 = 16 * j + 4 * fq;
      const f32x4 g = *(const f32x4*)(ng + e0);
      const u32x2 z = *(const u32x2*)(zs + e0);
      f32x4 o = {acc[j][0] * rms * g[0] * lo2f(z[0]), acc[j][1] * rms * g[1] * hi2f(z[0]), acc[j][2] * rms * g[2] * lo2f(z[1]), acc[j][3] * rms * g[3] * hi2f(z[1])};
      *(u32x2*)(out + e0) = pack4(o);
    }
  }
}

DI void phase5(const Params& p, unsigned char* smem, int bid, int nb) {
  const int tid = threadIdx.x, lane = tid & 63, wave = tid >> 6;
  const int wm = wave & 3, wn = wave >> 2, fr = lane & 15, fq = lane >> 4;
  unsigned char* ws = p.ws;
  for (int t = bid; t < 1024; t += nb) {
    int mt, nt; tile_mn(t, 8, mt, nt);
    const int m0 = mt * 128, n0 = nt * 128;
    f32x4 acc[2][4]; zero_acc(acc);
    gemm_mainloop<false>(smem, (const bf16_t*)(ws + O_GDNO), 512, nullptr, m0, (const bf16_t*)(ws + O_WAT), 512, n0, 512, acc);
    const bf16_t* gates = (const bf16_t*)(ws + O_GATES);
    const bf16_t* part = (const bf16_t*)(ws + O_PART);
    bf16_t* merged = (bf16_t*)(ws + O_MERGED);
#pragma unroll
    for (int i = 0; i < 2; ++i) {
      const size_t row = m0 + 32 * wm + 16 * i + fr;
#pragma unroll
      for (int j = 0; j < 4; ++j) {
        const int col = n0 + 64 * wn + 16 * j + 4 * fq;
        const u32x2 g0 = *(const u32x2*)(gates + row * 3072 + col);
        const u32x2 pp = *(const u32x2*)(part + row * 1024 + col);
        f32x4 o = {lo2f(pp[0]) + lo2f(g0[0]) * acc[i][j][0], hi2f(pp[0]) + hi2f(g0[0]) * acc[i][j][1],
                   lo2f(pp[1]) + lo2f(g0[1]) * acc[i][j][2], hi2f(pp[1]) + hi2f(g0[1]) * acc[i][j][3]};
        *(u32x2*)(merged + row * 1024 + col) = pack4(o);
      }
    }
  }
}
DI void phase6(const Params& p, unsigned char* smem, int bid, int nb) {
  const int tid = threadIdx.x, lane = tid & 63, wave = tid >> 6;
  const int wm = wave & 3, wn = wave >> 2, fr = lane & 15, fq = lane >> 4;
  unsigned char* ws = p.ws;
  const float* x = p.in[I_X];
  float* x1 = (float*)(ws + O_X1);
  for (int t = bid; t < 1024; t += nb) {
    int mt, nt; tile_mn(t, 8, mt, nt);
    const int m0 = mt * 128, n0 = nt * 128;
    f32x4 acc[2][4]; zero_acc(acc);
    gemm_mainloop<false>(smem, (const bf16_t*)(ws + O_MERGED), 1024, nullptr, m0, (const bf16_t*)(ws + O_WOT), 1024, n0, 1024, acc);
#pragma unroll
    for (int i = 0; i < 2; ++i) {
      const size_t row = m0 + 32 * wm + 16 * i + fr;
#pragma unroll
      for (int j = 0; j < 4; ++j) {
        const int col = n0 + 64 * wn + 16 * j + 4 * fq;
        const f32x4 xv = *(const f32x4*)(x + row * 1024 + col);
        f32x4 o = {ALPHA * xv[0] + acc[i][j][0], ALPHA * xv[1] + acc[i][j][1], ALPHA * xv[2] + acc[i][j][2], ALPHA * xv[3] + acc[i][j][3]};
        *(f32x4*)(x1 + row * 1024 + col) = o;
      }
    }
  }
}

DI void ln_row(const float* src, const float* g, const float* b, float (&v)[16], int lane) {
  float s = 0.f;
#pragma unroll
  for (int i = 0; i < 16; ++i) s += v[i];
  const float mean = wave_sum(s) * (1.f / 1024.f);
  float q = 0.f;
#pragma unroll
  for (int i = 0; i < 16; ++i) { const float d = v[i] - mean; q += d * d; }
  const float rstd = rsqrtf(wave_sum(q) * (1.f / 1024.f) + 1e-5f);
#pragma unroll
  for (int i = 0; i < 4; ++i) {
    const int k = 256 * i + 4 * lane;
    const f32x4 gg = *(const f32x4*)(g + k), bb = *(const f32x4*)(b + k);
#pragma unroll
    for (int c = 0; c < 4; ++c) v[4 * i + c] = (v[4 * i + c] - mean) * rstd * gg[c] + bb[c];
  }
}
DI void phase7(const Params& p, int bid, int nb) {
  const int tid = threadIdx.x, lane = tid & 63, wave = tid >> 6;
  unsigned char* ws = p.ws;
  float* x1 = (float*)(ws + O_X1);
  bf16_t* x1b = (bf16_t*)(ws + O_X1B);
  for (int row = bid * 8 + wave; row < T; row += nb * 8) {
    float v[16];
#pragma unroll
    for (int i = 0; i < 4; ++i) { const f32x4 t = *(const f32x4*)(x1 + (size_t)row * D + 256 * i + 4 * lane); v[4 * i] = t[0]; v[4 * i + 1] = t[1]; v[4 * i + 2] = t[2]; v[4 * i + 3] = t[3]; }
    ln_row(nullptr, p.in[I_LN1G], p.in[I_LN1B], v, lane);
#pragma unroll
    for (int i = 0; i < 4; ++i) {
      const f32x4 o = {v[4 * i], v[4 * i + 1], v[4 * i + 2], v[4 * i + 3]};
      *(f32x4*)(x1 + (size_t)row * D + 256 * i + 4 * lane) = o;
      *(u32x2*)(x1b + (size_t)row * D + 256 * i + 4 * lane) = pack4(o);
    }
  }
}
DI void phase8(const Params& p, unsigned char* smem, int bid, int nb) {
  const int tid = threadIdx.x, lane = tid & 63, wave = tid >> 6;
  const int wm = wave & 3, wn = wave >> 2, fr = lane & 15, fq = lane >> 4;
  unsigned char* ws = p.ws;
  float* logits = (float*)(ws + O_LOGITS);
  for (int t = bid; t < 256; t += nb) {
    const int mt = t >> 1, nt = t & 1;
    const int m0 = mt * 128, n0 = nt * 128;
    f32x4 acc[2][4]; zero_acc(acc);
    gemm_mainloop<false>(smem, (const bf16_t*)(ws + O_X1B), 1024, nullptr, m0, (const bf16_t*)(ws + O_ROUT), 1024, n0, 1024, acc);
#pragma unroll
    for (int i = 0; i < 2; ++i) {
      const size_t row = m0 + 32 * wm + 16 * i + fr;
#pragma unroll
      for (int j = 0; j < 4; ++j) *(f32x4*)(logits + row * 256 + n0 + 64 * wn + 16 * j + 4 * fq) = acc[i][j];
    }
  }
}
DI void phase9(const Params& p, int bid, int nb) {
  const int tid = threadIdx.x, lane = tid & 63, wave = tid >> 6;
  unsigned char* ws = p.ws;
  const float* logits = (const float*)(ws + O_LOGITS);
  int* counts = (int*)(ws + O_CTRL);
  const f32x4 bias = *(const f32x4*)(p.in[I_RB] + 4 * lane);
  const float NEG = -__builtin_inff();
  for (int tok = bid * 8 + wave; tok < T; tok += nb * 8) {
    const f32x4 lg = *(const f32x4*)(logits + (size_t)tok * 256 + 4 * lane);
    float sc[4], mv[4];
#pragma unroll
    for (int c = 0; c < 4; ++c) { sc[c] = sigmoidf_(lg[c]); mv[c] = sc[c] + bias[c]; }
    float m1 = NEG, m2 = NEG;
#pragma unroll
    for (int c = 0; c < 4; ++c) { const float v = mv[c]; if (v > m1) { m2 = m1; m1 = v; } else if (v > m2) m2 = v; }
#pragma unroll
    for (int o = 1; o < 8; o <<= 1) {
      const float o1 = __shfl_xor(m1, o), o2 = __shfl_xor(m2, o);
      const float n1 = fmaxf(m1, o1), n2 = fmaxf(fminf(m1, o1), fmaxf(m2, o2));
      m1 = n1; m2 = n2;
    }
    const float gs = m1 + m2;
    const int g = lane >> 3;
    int rank = 0;
#pragma unroll
    for (int gg = 0; gg < 8; ++gg) { const float og = __shfl(gs, gg * 8); rank += ((og > gs) || (og == gs && gg < g)) ? 1 : 0; }
    if (rank >= 4) {
#pragma unroll
      for (int c = 0; c < 4; ++c) mv[c] = NEG;
    }
    int myidx = 0; float mysc = 0.f, ssum = 0.f;
#pragma unroll
    for (int k = 0; k < 8; ++k) {
      float bv = mv[0]; int bi = 0;
#pragma unroll
      for (int c = 1; c < 4; ++c) if (mv[c] > bv) { bv = mv[c]; bi = c; }
      float rv = bv; int ri = lane * 4 + bi;
#pragma unroll
      for (int o = 32; o; o >>= 1) {
        const float ov = __shfl_xor(rv, o); const int oi = __shfl_xor(ri, o);
        if (ov > rv || (ov == rv && oi < ri)) { rv = ov; ri = oi; }
      }
      const int wl = ri >> 2, wc = ri & 3;
      const float mine = wc == 0 ? sc[0] : wc == 1 ? sc[1] : wc == 2 ? sc[2] : sc[3];
      const float wsc = __shfl(mine, wl);
      if (lane == wl) {
#pragma unroll
        for (int c = 0; c < 4; ++c) if (c == wc) mv[c] = NEG;
      }
      ssum += wsc;
      if (lane == k) { myidx = ri; mysc = wsc; }
    }
    if (lane < 8) {
      const int pos = atomicAdd(&counts[myidx * CSTR], 1);
      ((int*)(ws + O_TKIDX))[(size_t)tok * 8 + lane] = myidx;
      ((float*)(ws + O_TKW))[(size_t)tok * 8 + lane] = mysc / ssum * 2.5f;
      ((int*)(ws + O_TKPOS))[(size_t)tok * 8 + lane] = pos;
    }
  }
}
DI void build_tile_start(const Params& p, int* ts) {
  const int tid = threadIdx.x;
  const int* counts = (const int*)(p.ws + O_CTRL);
  __syncthreads();
  if (tid < 256) ts[300 + tid] = (counts[tid * CSTR] + 127) >> 7;
  __syncthreads();
  if (tid == 0) { int s = 0; for (int e = 0; e < 256; ++e) { ts[e] = s; s += ts[300 + e]; } ts[256] = s; }
  __syncthreads();
}
DI void phase10(const Params& p, unsigned char* smem, int bid, int nb) {
  int* ts = (int*)smem;
  build_tile_start(p, ts);
  unsigned char* ws = p.ws;
  const int* tkidx = (const int*)(ws + O_TKIDX); const int* tkpos = (const int*)(ws + O_TKPOS); const float* tkw = (const float*)(ws + O_TKW);
  int* slottok = (int*)(ws + O_SLOTTOK); float* slotw = (float*)(ws + O_SLOTW); int* tokslot = (int*)(ws + O_TOKSLOT);
  for (int i = bid * NTHR + threadIdx.x; i < T * 8; i += nb * NTHR) {
    const int e = tkidx[i];
    const int slot = ts[e] * 128 + tkpos[i];
    slottok[slot] = i >> 3; slotw[slot] = tkw[i]; tokslot[i] = slot;
  }
}

DI int find_expert(const int* ts, int ti) { int lo = 0, hi = 255; while (lo < hi) { const int mid = (lo + hi + 1) >> 1; if (ts[mid] <= ti) lo = mid; else hi = mid - 1; } return lo; }

DI void phase11(const Params& p, unsigned char* smem, int bid, int nb) {
  const int tid = threadIdx.x, lane = tid & 63, wave = tid >> 6;
  const int wm = wave & 3, wn = wave >> 2, fr = lane & 15, fq = lane >> 4;
  unsigned char* ws = p.ws;
  int* ts = (int*)(smem + 65536);
  int* arow = (int*)(smem + 65536 + 4096);
  build_tile_start(p, ts);
  const int ntile = ts[256];
  const int* counts = (const int*)(ws + O_CTRL);
  const int* slottok = (const int*)(ws + O_SLOTTOK);
  const int nitem = ntile * 4 + 128 * 4;
  for (int it = bid; it < nitem; it += nb) {
    f32x4 acc[2][4]; zero_acc(acc);
    int m0, n0; bf16_t* actp;
    if (it < ntile * 4) {
      const int ti = it >> 2, nt = it & 3;
      const int e = find_expert(ts, ti);
      const int valid = counts[e * CSTR] - 128 * (ti - ts[e]);
      m0 = ti * 128; n0 = nt * 128;
      __syncthreads();
      if (tid < 128) arow[tid] = (tid < valid) ? slottok[m0 + tid] : 0;
      gemm_mainloop<true>(smem, (const bf16_t*)(ws + O_X1B), 1024, arow, m0, (const bf16_t*)(ws + O_WGU) + (size_t)e * 524288, 1024, n0, 1024, acc);
      actp = (bf16_t*)(ws + O_ACT);
    } else {
      const int r = it - ntile * 4; const int mt = r >> 2, nt = r & 3;
      m0 = mt * 128; n0 = nt * 128;
      gemm_mainloop<false>(smem, (const bf16_t*)(ws + O_X1B), 1024, nullptr, m0, (const bf16_t*)(ws + O_WSGU), 1024, n0, 1024, acc);
      actp = (bf16_t*)(ws + O_ACTSH);
    }
#pragma unroll
    for (int i = 0; i < 2; ++i) {
      const size_t row = m0 + 32 * wm + 16 * i + fr;
#pragma unroll
      for (int jj = 0; jj < 2; ++jj) {
        const int rowg = n0 + 64 * wn + 32 * jj;
        const int acol = (rowg >> 5) * 16 + 4 * fq;
        const f32x4 g = acc[i][2 * jj], u = acc[i][2 * jj + 1];
        f32x4 o = {siluf_(g[0]) * u[0], siluf_(g[1]) * u[1], siluf_(g[2]) * u[2], siluf_(g[3]) * u[3]};
        *(u32x2*)(actp + row * 256 + acol) = pack4(o);
      }
    }
  }
}
DI void phase12(const Params& p, unsigned char* smem, int bid, int nb) {
  const int tid = threadIdx.x, lane = tid & 63, wave = tid >> 6;
  const int wm = wave & 3, wn = wave >> 2, fr = lane & 15, fq = lane >> 4;
  unsigned char* ws = p.ws;
  int* ts = (int*)(smem + 65536);
  build_tile_start(p, ts);
  const int ntile = ts[256];
  const float* slotw = (const float*)(ws + O_SLOTW);
  const int nitem = ntile * 8 + 128 * 8;
  for (int it = bid; it < nitem; it += nb) {
    f32x4 acc[2][4]; zero_acc(acc);
    if (it < ntile * 8) {
      const int ti = it >> 3, nt = it & 7;
      const int e = find_expert(ts, ti);
      const int m0 = ti * 128, n0 = nt * 128;
      gemm_mainloop<false>(smem, (const bf16_t*)(ws + O_ACT), 256, nullptr, m0, (const bf16_t*)(ws + O_WD) + (size_t)e * 262144, 256, n0, 256, acc);
      bf16_t* y = (bf16_t*)(ws + O_Y);
#pragma unroll
      for (int i = 0; i < 2; ++i) {
        const size_t row = m0 + 32 * wm + 16 * i + fr;
        const float w = slotw[row];
#pragma unroll
        for (int j = 0; j < 4; ++j) {
          f32x4 o = {acc[i][j][0] * w, acc[i][j][1] * w, acc[i][j][2] * w, acc[i][j][3] * w};
          *(u32x2*)(y + row * 1024 + n0 + 64 * wn + 16 * j + 4 * fq) = pack4(o);
        }
      }
    } else {
      const int r = it - ntile * 8; const int mt = r >> 3, nt = r & 7;
      const int m0 = mt * 128, n0 = nt * 128;
      gemm_mainloop<false>(smem, (const bf16_t*)(ws + O_ACTSH), 256, nullptr, m0, (const bf16_t*)(ws + O_WSD), 256, n0, 256, acc);
      bf16_t* y = (bf16_t*)(ws + O_YSH);
#pragma unroll
      for (int i = 0; i < 2; ++i) {
        const size_t row = m0 + 32 * wm + 16 * i + fr;
#pragma unroll
        for (int j = 0; j < 4; ++j) *(u32x2*)(y + row * 1024 + n0 + 64 * wn + 16 * j + 4 * fq) = pack4(acc[i][j]);
      }
    }
  }
}
DI void phase13(const Params& p, int bid, int nb) {
  const int tid = threadIdx.x, lane = tid & 63, wave = tid >> 6;
  unsigned char* ws = p.ws;
  const float* x1 = (const float*)(ws + O_X1);
  const bf16_t* ysh = (const bf16_t*)(ws + O_YSH);
  const bf16_t* y = (const bf16_t*)(ws + O_Y);
  const int* tokslot = (const int*)(ws + O_TOKSLOT);
  for (int row = bid * 8 + wave; row < T; row += nb * 8) {
    float v[16];
#pragma unroll
    for (int i = 0; i < 4; ++i) {
      const int k = 256 * i + 4 * lane;
      const f32x4 t = *(const f32x4*)(x1 + (size_t)row * D + k);
      const u32x2 s = *(const u32x2*)(ysh + (size_t)row * D + k);
      v[4 * i] = ALPHA * t[0] + lo2f(s[0]); v[4 * i + 1] = ALPHA * t[1] + hi2f(s[0]); v[4 * i + 2] = ALPHA * t[2] + lo2f(s[1]); v[4 * i + 3] = ALPHA * t[3] + hi2f(s[1]);
    }
#pragma unroll
    for (int k8 = 0; k8 < 8; ++k8) {
      const size_t slot = (size_t)tokslot[(size_t)row * 8 + k8];
#pragma unroll
      for (int i = 0; i < 4; ++i) {
        const u32x2 s = *(const u32x2*)(y + slot * 1024 + 256 * i + 4 * lane);
        v[4 * i] += lo2f(s[0]); v[4 * i + 1] += hi2f(s[0]); v[4 * i + 2] += lo2f(s[1]); v[4 * i + 3] += hi2f(s[1]);
      }
    }
    ln_row(nullptr, p.in[I_LN2G], p.in[I_LN2B], v, lane);
#pragma unroll
    for (int i = 0; i < 4; ++i) { const f32x4 o = {v[4 * i], v[4 * i + 1], v[4 * i + 2], v[4 * i + 3]}; *(f32x4*)(p.out + (size_t)row * D + 256 * i + 4 * lane) = o; }
  }
}

#ifndef DUPMASK
#define DUPMASK 0
#endif
__global__ void __launch_bounds__(NTHR) mega_kernel(Params p) {
  extern __shared__ __attribute__((aligned(16))) unsigned char smem[];
  cg::grid_group grid = cg::this_grid();
  const int bid = blockIdx.x, nb = gridDim.x;
  volatile LAS unsigned* bst = (volatile LAS unsigned*)(smem + LDS_BYTES - 16);
  if (threadIdx.x < 4) bst[threadIdx.x] = 0u;
  __syncthreads();
  XcdBarrier xb = xcd_barrier_post((unsigned*)(p.ws + O_BAR), bst);
#define GSYNC() xcd_barrier(xb)
#define RUNP(k, call) do { call; GSYNC(); if (DUPMASK & (1 << (k))) { call; GSYNC(); } } while (0)
  phase0(p, smem, bid, nb); grid.sync();
  if (DUPMASK & 1) { phase0(p, smem, bid, nb); GSYNC(); }
  RUNP(1, phase1(p, smem, bid, nb));
  RUNP(2, phase2(p, smem, bid, nb));
  RUNP(3, phase3(p, smem, bid, nb));
  RUNP(4, phase4(p, bid, nb));
  RUNP(5, phase5(p, smem, bid, nb));
  if (DUPMASK & (1 << 6)) { phase6(p, smem, bid, nb); GSYNC(); phase7(p, bid, nb); GSYNC(); }
  RUNP(14, phase6(p, smem, bid, nb));
  RUNP(14, phase7(p, bid, nb));
  RUNP(8, phase8(p, smem, bid, nb));
  RUNP(14, phase9(p, bid, nb));
  RUNP(10, phase10(p, smem, bid, nb));
  RUNP(11, phase11(p, smem, bid, nb));
  RUNP(12, phase12(p, smem, bid, nb));
  if (DUPMASK & (1 << 13)) { phase13(p, bid, nb); GSYNC(); }
  if (DUPMASK & (1 << 15)) { for (int i = 0; i < 10; ++i) GSYNC(); }
  phase13(p, bid, nb);
}

extern "C" void kernel_launch(void* const* d_in, const int* in_sizes, int n_in, void* d_out, int out_size, void* d_ws, size_t ws_size, hipStream_t stream) {
  if (n_in != 28 || ws_size < WS_NEED) { fprintf(stderr, "kernel_launch: unexpected inputs (%d) or workspace (%zu < %zu)\n", n_in, ws_size, (size_t)WS_NEED); return; }
  static int grid_blocks = 0;
  if (!grid_blocks) {
    int dev = 0, cus = 0, per_cu = 0;
    (void)hipGetDevice(&dev);
    (void)hipDeviceGetAttribute(&cus, hipDeviceAttributeMultiprocessorCount, dev);
    (void)hipFuncSetAttribute((const void*)mega_kernel, hipFuncAttributeMaxDynamicSharedMemorySize, LDS_BYTES);
    (void)hipOccupancyMaxActiveBlocksPerMultiprocessor(&per_cu, (const void*)mega_kernel, NTHR, LDS_BYTES);
    if (per_cu < 1) per_cu = 1;
    if (per_cu > 1) per_cu = 1;
    grid_blocks = cus * per_cu;
    if (grid_blocks < 32) grid_blocks = 32;
  }
  Params p{};
  for (int i = 0; i < 28; ++i) p.in[i] = (const float*)d_in[i];
  p.out = (float*)d_out; p.ws = (unsigned char*)d_ws;
  (void)hipMemsetAsync((unsigned char*)d_ws + O_BAR, 0, XCD_BAR_WORDS * 4, stream);
  void* args[] = {&p};
  hipError_t e = hipLaunchCooperativeKernel((const void*)mega_kernel, dim3(grid_blocks), dim3(NTHR), args, LDS_BYTES, stream);
  if (e != hipSuccess) fprintf(stderr, "cooperative launch failed: %s (grid %d)\n", hipGetErrorString(e), grid_blocks);
}
```

```cpp
#include <hip/hip_runtime.h>
#include <hip/hip_cooperative_groups.h>
#include <stdint.h>
#include <stdio.h>
namespace cg = cooperative_groups;

#define DI __device__ __forceinline__
typedef unsigned short bf16_t;
typedef short bf16x8 __attribute__((ext_vector_type(8)));
typedef float f32x4 __attribute__((ext_vector_type(4)));
typedef unsigned u32x4 __attribute__((ext_vector_type(4)));
typedef unsigned u32x2 __attribute__((ext_vector_type(2)));

constexpr int NTHR = 512;
constexpr int T = 16384, SEQ = 8192, D = 1024;
constexpr int NPROJ = 6656;
constexpr int DIN = 6664;
constexpr int NEXP = 256, DEXP = 256;
constexpr int MAXSLOT = 131072 + 256 * 128;
constexpr float ALPHA = 1.189207115002721f;
constexpr int LDS_BYTES = 157696;

constexpr size_t MB = 1u << 20;
constexpr size_t O_WGU = 0;
constexpr size_t O_WD = 256 * MB;
constexpr size_t O_WSGU = 384 * MB;
constexpr size_t O_WSD = 385 * MB;
constexpr size_t O_ROUT = 385 * MB + 512 * 1024;
constexpr size_t O_CTRL = 386 * MB;
constexpr size_t O_BAR = 386 * MB + 128 * 1024;
constexpr int CSTR = 64;
constexpr size_t O_X1 = 387 * MB;
constexpr size_t O_X1B = 451 * MB;
constexpr size_t R0 = 483 * MB;
constexpr size_t O_XB = R0 + 0;
constexpr size_t O_ST = R0 + 0;
constexpr size_t O_WINT = R0 + 32 * MB;
constexpr size_t O_WAT = R0 + 45 * MB;
constexpr size_t O_WBT = R0 + 46 * MB;
constexpr size_t O_WCT = R0 + 47 * MB;
constexpr size_t O_WOT = R0 + 48 * MB;
constexpr size_t O_WMKV = R0 + 50 * MB;
constexpr size_t O_MEMB = R0 + 52 * MB;
constexpr size_t O_SGUW = R0 + 53 * MB;
constexpr size_t O_AB = R0 + 53 * MB + 512 * 1024;
constexpr size_t O_MEMK = R0 + 54 * MB;
constexpr size_t O_MEMVT = R0 + 54 * MB + 512 * 1024;
constexpr size_t O_QKV = R0 + 55 * MB;
constexpr size_t O_PART = R0 + 55 * MB;
constexpr size_t O_ZS = R0 + 103 * MB;
constexpr size_t O_UVG = R0 + 119 * MB;
constexpr size_t O_MERGED = R0 + 119 * MB;
constexpr size_t O_XQ = R0 + 151 * MB;
constexpr size_t O_GATES = R0 + 167 * MB;
constexpr size_t O_MP = R0 + 263 * MB;
constexpr size_t O_BC = R0 + 295 * MB;
constexpr size_t O_O0 = R0 + 359 * MB;
constexpr size_t O_QP = R0 + 391 * MB;
constexpr size_t O_GL = R0 + 407 * MB;
constexpr size_t O_GDNO = R0 + 408 * MB;
constexpr size_t O_SGUO = R0 + 424 * MB;
constexpr size_t O_XATO = R0 + 440 * MB;
constexpr size_t O_LOGITS = R0 + 0;
constexpr size_t O_TKIDX = R0 + 16 * MB;
constexpr size_t O_TKW = R0 + 16 * MB + 512 * 1024;
constexpr size_t O_TKPOS = R0 + 17 * MB;
constexpr size_t O_TOKSLOT = R0 + 17 * MB + 512 * 1024;
constexpr size_t O_SLOTTOK = R0 + 18 * MB;
constexpr size_t O_SLOTW = R0 + 19 * MB;
constexpr size_t O_ACT = R0 + 20 * MB;
constexpr size_t O_ACTSH = R0 + 100 * MB;
constexpr size_t O_YSH = R0 + 108 * MB;
constexpr size_t O_Y = R0 + 140 * MB;
constexpr size_t WS_NEED = R0 + 460 * MB;

struct Params {
  const float* in[28];
  float* out;
  unsigned char* ws;
};
enum { I_X = 0, I_MEM, I_WIN, I_CONVW, I_ALOG, I_DTB, I_GNG, I_WA, I_SLNG, I_SLNB, I_SGUW, I_SGUB, I_WB, I_WMKV, I_WC, I_WO,
       I_LN1G, I_LN1B, I_RW, I_RB, I_WG, I_WU, I_WDN, I_WSG, I_WSU, I_WSD, I_LN2G, I_LN2B };

DI float bf2f(bf16_t h) { return __uint_as_float(((unsigned)h) << 16); }
DI bf16_t f2bf(float f) { unsigned u = __float_as_uint(f); u += 0x7fffu + ((u >> 16) & 1u); return (bf16_t)(u >> 16); }
DI unsigned pk2(float lo, float hi) { return (unsigned)f2bf(lo) | ((unsigned)f2bf(hi) << 16); }
DI float lo2f(unsigned u) { return __uint_as_float(u << 16); }
DI float hi2f(unsigned u) { return __uint_as_float(u & 0xffff0000u); }
DI float sigmoidf_(float x) { return 1.f / (1.f + __expf(-x)); }
DI float siluf_(float x) { return x / (1.f + __expf(-x)); }
DI float geluf_(float x) { float u = 0.7978845608028654f * (x + 0.044715f * x * x * x); float t = 1.f - 2.f / (__expf(2.f * u) + 1.f); return 0.5f * x * (1.f + t); }
DI float softplusf_(float x) { return fmaxf(x, 0.f) + log1pf(__expf(-fabsf(x))); }
DI float wave_sum(float v) {
#pragma unroll
  for (int o = 32; o; o >>= 1) v += __shfl_xor(v, o);
  return v;
}
DI f32x4 mfma16(bf16x8 a, bf16x8 b, f32x4 c) { return __builtin_amdgcn_mfma_f32_16x16x32_bf16(a, b, c, 0, 0, 0); }
DI bf16x8 ldfrag(const void* p) { return __builtin_bit_cast(bf16x8, *(const u32x4*)p); }
DI bf16x8 pack8(f32x4 a, f32x4 b) { u32x4 r = {pk2(a[0], a[1]), pk2(a[2], a[3]), pk2(b[0], b[1]), pk2(b[2], b[3])}; return __builtin_bit_cast(bf16x8, r); }
DI u32x2 pack4(f32x4 a) { u32x2 r = {pk2(a[0], a[1]), pk2(a[2], a[3])}; return r; }
DI int sw128(int row, int chunk) { return row * 128 + ((chunk ^ (row & 7)) << 4); }
DI int sw256(int row, int chunk) { return row * 256 + ((chunk ^ (row & 15)) << 4); }

template <bool GATHER>
DI void gemm_mainloop(unsigned char* smem, const bf16_t* __restrict__ A, int lda, const int* arow, int m0,
                      const bf16_t* __restrict__ Bt, int ldb, int n0, int K, f32x4 (&acc)[2][4]) {
  const int tid = threadIdx.x, lane = tid & 63, wave = tid >> 6;
  const int wm = wave & 3, wn = wave >> 2, fr = lane & 15, fq = lane >> 4;
  const int lr = tid >> 3, lc = tid & 7;
  __syncthreads();
  const size_t r0 = GATHER ? (size_t)arow[lr] : (size_t)(m0 + lr);
  const size_t r1 = GATHER ? (size_t)arow[lr + 64] : (size_t)(m0 + lr + 64);
  const bf16_t* pa0 = A + r0 * lda + lc * 8;
  const bf16_t* pa1 = A + r1 * lda + lc * 8;
  const bf16_t* pb0 = Bt + (size_t)(n0 + lr) * ldb + lc * 8;
  const bf16_t* pb1 = Bt + (size_t)(n0 + lr + 64) * ldb + lc * 8;
  const int w0 = sw128(lr, lc), w1 = sw128(lr + 64, lc);
  u32x4 va0 = *(const u32x4*)pa0, va1 = *(const u32x4*)pa1, vb0 = *(const u32x4*)pb0, vb1 = *(const u32x4*)pb1;
  *(u32x4*)(smem + w0) = va0; *(u32x4*)(smem + w1) = va1;
  *(u32x4*)(smem + 16384 + w0) = vb0; *(u32x4*)(smem + 16384 + w1) = vb1;
  __syncthreads();
  const int nk = K >> 6;
  for (int kt = 0; kt < nk; ++kt) {
    unsigned char* sA = smem + (kt & 1) * 32768;
    unsigned char* sB = sA + 16384;
    const bool more = (kt + 1 < nk);
    if (more) {
      const int ko = (kt + 1) * 64;
      va0 = *(const u32x4*)(pa0 + ko); va1 = *(const u32x4*)(pa1 + ko);
      vb0 = *(const u32x4*)(pb0 + ko); vb1 = *(const u32x4*)(pb1 + ko);
    }
#pragma unroll
    for (int ks = 0; ks < 2; ++ks) {
      bf16x8 af[2], bfr[4];
#pragma unroll
      for (int i = 0; i < 2; ++i) af[i] = ldfrag(sA + sw128(32 * wm + 16 * i + fr, 4 * ks + fq));
#pragma unroll
      for (int j = 0; j < 4; ++j) bfr[j] = ldfrag(sB + sw128(64 * wn + 16 * j + fr, 4 * ks + fq));
#pragma unroll
      for (int i = 0; i < 2; ++i)
#pragma unroll
        for (int j = 0; j < 4; ++j) acc[i][j] = mfma16(bfr[j], af[i], acc[i][j]);
    }
    if (more) {
      unsigned char* dA = smem + ((kt + 1) & 1) * 32768;
      *(u32x4*)(dA + w0) = va0; *(u32x4*)(dA + w1) = va1;
      *(u32x4*)(dA + 16384 + w0) = vb0; *(u32x4*)(dA + 16384 + w1) = vb1;
    }
    __syncthreads();
  }
}
DI void zero_acc(f32x4 (&acc)[2][4]) {
#pragma unroll
  for (int i = 0; i < 2; ++i)
#pragma unroll
    for (int j = 0; j < 4; ++j) acc[i][j] = (f32x4){0.f, 0.f, 0.f, 0.f};
}
DI void tile_mn(int t, int ntn, int& mt, int& nt) { const int pg = 16 * ntn; const int g = t / pg, r = t - g * pg; nt = r >> 4; mt = g * 16 + (r & 15); }


#define LAS __attribute__((address_space(3)))
#define XB_TMO      128
#define XB_XCNT(j)  (256  + 64 * (j))
#define XB_XSUB(j)  (1280 + 64 * (j))
#define XB_XGEN(j)  (2304 + 64 * (j))
#define XB_TOP      3328
#define XB_TOPGEN   3392
#define XCD_BAR_WORDS 3456
#define XB_SPIN_CAP (1u << 22)
DI unsigned xb_ld(unsigned* p)              { return __hip_atomic_load(p, __ATOMIC_RELAXED, __HIP_MEMORY_SCOPE_AGENT); }
DI unsigned xb_add(unsigned* p, unsigned v) { return __hip_atomic_fetch_add(p, v, __ATOMIC_RELAXED, __HIP_MEMORY_SCOPE_AGENT); }
DI unsigned xb_xcc_id() { return (unsigned)__builtin_amdgcn_s_getreg((3 << 11) | 20) & 0xFu; }
#define XB_SPIN(cond, bar) do { unsigned _sp = 0; while (cond) { __builtin_amdgcn_s_sleep(1); \
    if ((++_sp & 255u) == 0u) { if (xb_ld(&(bar)[XB_TMO])) break; if (_sp > XB_SPIN_CAP) { atomicAdd(&(bar)[XB_TMO], 1u); break; } } } } while (0)
struct XcdBarrier { unsigned* bar; unsigned x; volatile LAS unsigned* st; };
DI XcdBarrier xcd_barrier_post(unsigned* bar, volatile LAS unsigned* st) {
  XcdBarrier b; b.bar = bar; b.x = xb_xcc_id(); b.st = st;
  if (threadIdx.x == 0) (void)xb_add(&bar[XB_XCNT(b.x)], 1u);
  return b;
}
DI void xcd_barrier_complete(unsigned* bar, unsigned x, unsigned& nloc, unsigned& nx) {
  const unsigned G = gridDim.x * gridDim.y * gridDim.z;
  unsigned sum, cnt, mine, sp = 0u;
  for (;;) {
    sum = 0u; cnt = 0u; mine = 0u;
#pragma unroll
    for (unsigned j = 0; j < 16; ++j) { const unsigned c = xb_ld(&bar[XB_XCNT(j)]); sum += c; cnt += (c > 0u) ? 1u : 0u; mine = (j == x) ? c : mine; }
    if (sum == G) break;
    __builtin_amdgcn_s_sleep(1);
    if ((++sp & 255u) == 0u) { if (xb_ld(&bar[XB_TMO])) break; if (sp > XB_SPIN_CAP) { atomicAdd(&bar[XB_TMO], 1u); break; } }
  }
  nloc = mine > 0u ? mine : 1u; nx = cnt > 0u ? cnt : 1u;
}
DI void xcd_barrier(const XcdBarrier& b) {
  asm volatile("s_waitcnt vmcnt(0)" ::: "memory");
  __syncthreads();
  if (threadIdx.x == 0) {
    unsigned* bar = b.bar;
    __builtin_amdgcn_s_waitcnt(0);
    unsigned nloc = b.st[0], nx = b.st[1];
    if (nloc == 0u) { xcd_barrier_complete(bar, b.x, nloc, nx); b.st[0] = nloc; b.st[1] = nx; }
    const unsigned old = xb_add(&bar[XB_XSUB(b.x)], 1u);
    const unsigned gen = old / nloc;
    if (old + 1u == (gen + 1u) * nloc) {
      __builtin_amdgcn_fence(__ATOMIC_RELEASE, "agent");
      asm volatile("s_waitcnt vmcnt(0)" ::: "memory");
      const unsigned og = xb_add(&bar[XB_TOP], 1u);
      const unsigned tg = og / nx;
      if (og + 1u == (tg + 1u) * nx) xb_add(&bar[XB_TOPGEN], 1u);
      else XB_SPIN(xb_ld(&bar[XB_TOPGEN]) == tg, bar);
      __builtin_amdgcn_fence(__ATOMIC_ACQUIRE, "agent");
      xb_add(&bar[XB_XGEN(b.x)], 1u);
      asm volatile("s_waitcnt vmcnt(0)" ::: "memory");
    } else {
      XB_SPIN(xb_ld(&bar[XB_XGEN(b.x)]) == gen, bar);
      __builtin_amdgcn_fence(__ATOMIC_ACQUIRE, "agent");
      asm volatile("s_waitcnt vmcnt(0)" ::: "memory");
    }
  }
  __syncthreads();
}

DI void transpose_tile(float* tile, const float* s0, const float* s1, const float* s2, const float* s3, int ld, bf16_t* dst, int ldd) {
  const int tid = threadIdx.x;
  const int kr = tid >> 4, nc = tid & 15, sg = nc >> 2;
  const float* sp = sg == 0 ? s0 : sg == 1 ? s1 : sg == 2 ? s2 : s3;
  const f32x4 v0 = *(const f32x4*)(sp + (size_t)kr * ld + 4 * (nc & 3));
  const f32x4 v1 = *(const f32x4*)(sp + (size_t)(kr + 32) * ld + 4 * (nc & 3));
  __syncthreads();
  float* t0 = tile + kr * 65 + 4 * nc;
  float* t1 = tile + (kr + 32) * 65 + 4 * nc;
  t0[0] = v0[0]; t0[1] = v0[1]; t0[2] = v0[2]; t0[3] = v0[3];
  t1[0] = v1[0]; t1[1] = v1[1]; t1[2] = v1[2]; t1[3] = v1[3];
  __syncthreads();
  const int n = tid >> 3, kc = tid & 7;
  float e[8];
#pragma unroll
  for (int j = 0; j < 8; ++j) e[j] = tile[(8 * kc + j) * 65 + n];
  u32x4 o = {pk2(e[0], e[1]), pk2(e[2], e[3]), pk2(e[4], e[5]), pk2(e[6], e[7])};
  *(u32x4*)(dst + (size_t)n * ldd + 8 * kc) = o;
}

DI void phase0(const Params& p, unsigned char* smem, int bid, int nb) {
  const int tid = threadIdx.x, lane = tid & 63, wave = tid >> 6;
  unsigned char* ws = p.ws;
  if (bid == 0 && tid < 256) ((int*)(ws + O_CTRL))[tid * CSTR] = 0;
  {
    float* wabT = (float*)smem;
    const float* win = p.in[I_WIN];
    for (int i = tid; i < 8192; i += NTHR) { const int k = i >> 3, j = i & 7; wabT[j * 1024 + k] = win[(size_t)k * DIN + 2048 + j]; }
    __syncthreads();
    const float* x = p.in[I_X];
    bf16_t* xb = (bf16_t*)(ws + O_XB);
    float* ab = (float*)(ws + O_AB);
    for (int row = bid * 8 + wave; row < T; row += nb * 8) {
      float s[8];
#pragma unroll
      for (int j = 0; j < 8; ++j) s[j] = 0.f;
#pragma unroll
      for (int i = 0; i < 4; ++i) {
        const int k = 256 * i + 4 * lane;
        const f32x4 v = *(const f32x4*)(x + (size_t)row * D + k);
        *(u32x2*)(xb + (size_t)row * D + k) = pack4(v);
#pragma unroll
        for (int j = 0; j < 8; ++j) { const f32x4 w = *(const f32x4*)(wabT + j * 1024 + k); s[j] += v[0] * w[0] + v[1] * w[1] + v[2] * w[2] + v[3] * w[3]; }
      }
#pragma unroll
      for (int j = 0; j < 8; ++j) s[j] = wave_sum(s[j]);
      if (lane == 0) { *(f32x4*)(ab + (size_t)row * 8) = (f32x4){s[0], s[1], s[2], s[3]}; *(f32x4*)(ab + (size_t)row * 8 + 4) = (f32x4){s[4], s[5], s[6], s[7]}; }
    }
    const float* mem = p.in[I_MEM];
    bf16_t* memb = (bf16_t*)(ws + O_MEMB);
    for (int row = bid * 8 + wave; row < 512; row += nb * 8) {
#pragma unroll
      for (int i = 0; i < 4; ++i) { const int k = 256 * i + 4 * lane; *(u32x2*)(memb + (size_t)row * D + k) = pack4(*(const f32x4*)(mem + (size_t)row * D + k)); }
    }
    const float* sw = p.in[I_SGUW];
    bf16_t* sguw = (bf16_t*)(ws + O_SGUW);
    for (int i = bid * NTHR + tid; i < 16384; i += nb * NTHR) {
      const int e0 = i * 4; const int col = e0 & 127, rowi = (e0 >> 7) & 127;
      f32x4 v = *(const f32x4*)(sw + e0);
#pragma unroll
      for (int c = 0; c < 4; ++c) if (col + c > rowi) v[c] = 0.f;
      *(u32x2*)(sguw + e0) = pack4(v);
    }
    __syncthreads();
  }
  {
    float* tile = (float*)smem;
    constexpr int J0 = 1664, J1 = J0 + 128, J2 = J1 + 128, J3 = J2 + 128, J4 = J3 + 256, J5 = J4 + 256, J6 = J5 + 64, J7 = J6 + 128, J8 = J7 + 64,
                  J9 = J8 + 32768, J10 = J9 + 16384;
    for (int it = bid; it < J10; it += nb) {
      const float *s0, *s1, *s2, *s3; int ld, ldd; bf16_t* dst;
      if (it < J0) {
        const int kt = it & 15, nt = it >> 4; const int n0 = nt * 64; const int c0 = n0 + (n0 >= 2048 ? 8 : 0);
        const float* b = p.in[I_WIN] + (size_t)kt * 64 * DIN + c0; s0 = b; s1 = b + 16; s2 = b + 32; s3 = b + 48; ld = DIN; ldd = 1024;
        dst = (bf16_t*)(ws + O_WINT) + (size_t)n0 * 1024 + kt * 64;
      } else if (it < J3) {
        const int which = (it - J0) >> 7, r = (it - J0) & 127; const int kt = r & 7, nt = r >> 3;
        const float* src = p.in[which == 0 ? I_WA : which == 1 ? I_WB : I_WC];
        const float* b = src + (size_t)kt * 64 * 1024 + nt * 64; s0 = b; s1 = b + 16; s2 = b + 32; s3 = b + 48; ld = 1024; ldd = 512;
        dst = (bf16_t*)(ws + (which == 0 ? O_WAT : which == 1 ? O_WBT : O_WCT)) + (size_t)nt * 64 * 512 + kt * 64;
      } else if (it < J5) {
        const int which = (it - J3) >> 8, r = (it - J3) & 255; const int kt = r & 15, nt = r >> 4;
        const float* b = p.in[which == 0 ? I_WO : I_WMKV] + (size_t)kt * 64 * 1024 + nt * 64; s0 = b; s1 = b + 16; s2 = b + 32; s3 = b + 48; ld = 1024; ldd = 1024;
        dst = (bf16_t*)(ws + (which == 0 ? O_WOT : O_WMKV)) + (size_t)nt * 64 * 1024 + kt * 64;
      } else if (it < J6) {
        const int r = it - J5; const int kt = r & 15, nt = r >> 4;
        const float* b = p.in[I_RW] + (size_t)kt * 64 * 256 + nt * 64; s0 = b; s1 = b + 16; s2 = b + 32; s3 = b + 48; ld = 256; ldd = 1024;
        dst = (bf16_t*)(ws + O_ROUT) + (size_t)nt * 64 * 1024 + kt * 64;
      } else if (it < J7) {
        const int r = it - J6; const int kt = r & 15, nt = r >> 4;
        const float* g = p.in[I_WSG] + (size_t)kt * 64 * 256 + nt * 32; const float* u = p.in[I_WSU] + (size_t)kt * 64 * 256 + nt * 32;
        s0 = g; s1 = u; s2 = g + 16; s3 = u + 16; ld = 256; ldd = 1024;
        dst = (bf16_t*)(ws + O_WSGU) + (size_t)nt * 64 * 1024 + kt * 64;
      } else if (it < J8) {
        const int r = it - J7; const int kt = r & 3, nt = r >> 2;
        const float* b = p.in[I_WSD] + (size_t)kt * 64 * 1024 + nt * 64; s0 = b; s1 = b + 16; s2 = b + 32; s3 = b + 48; ld = 1024; ldd = 256;
        dst = (bf16_t*)(ws + O_WSD) + (size_t)nt * 64 * 256 + kt * 64;
      } else if (it < J9) {
        const int r = it - J8; const int e = r >> 7, q = r & 127; const int kt = q & 15, nt = q >> 4;
        const float* g = p.in[I_WG] + (size_t)e * 262144 + (size_t)kt * 64 * 256 + nt * 32; const float* u = p.in[I_WU] + (size_t)e * 262144 + (size_t)kt * 64 * 256 + nt * 32;
        s0 = g; s1 = u; s2 = g + 16; s3 = u + 16; ld = 256; ldd = 1024;
        dst = (bf16_t*)(ws + O_WGU) + (size_t)e * 524288 + (size_t)nt * 64 * 1024 + kt * 64;
      } else {
        const int r = it - J9; const int e = r >> 6, q = r & 63; const int kt = q & 3, nt = q >> 2;
        const float* b = p.in[I_WDN] + (size_t)e * 262144 + (size_t)kt * 64 * 1024 + nt * 64; s0 = b; s1 = b + 16; s2 = b + 32; s3 = b + 48; ld = 1024; ldd = 256;
        dst = (bf16_t*)(ws + O_WD) + (size_t)e * 262144 + (size_t)nt * 64 * 256 + kt * 64;
      }
      transpose_tile(tile, s0, s1, s2, s3, ld, dst, ldd);
    }
  }
}

DI void phase1(const Params& p, unsigned char* smem, int bid, int nb) {
  const int tid = threadIdx.x, lane = tid & 63, wave = tid >> 6;
  const int wm = wave & 3, wn = wave >> 2, fr = lane & 15, fq = lane >> 4;
  unsigned char* ws = p.ws;
  const bf16_t* xb = (const bf16_t*)(ws + O_XB);
  const bf16_t* wint = (const bf16_t*)(ws + O_WINT);
  constexpr int NTN = NPROJ / 128;
  constexpr int NT1 = 128 * NTN;
  for (int t = bid; t < NT1 + 32; t += nb) {
    f32x4 acc[2][4]; zero_acc(acc);
    if (t < NT1) {
      int mt, nt; tile_mn(t, NTN, mt, nt);
      const int m0 = mt * 128, n0 = nt * 128;
      gemm_mainloop<false>(smem, xb, 1024, nullptr, m0, wint, 1024, n0, 1024, acc);
#pragma unroll
      for (int i = 0; i < 2; ++i) {
        const size_t row = m0 + 32 * wm + 16 * i + fr;
#pragma unroll
        for (int j = 0; j < 4; ++j) {
          const int col = n0 + 64 * wn + 16 * j + 4 * fq;
          f32x4 v = acc[i][j];
          if (n0 < 1536) { *(u32x2*)((bf16_t*)(ws + O_QKV) + row * 1536 + col) = pack4(v); }
          else if (n0 < 2048) {
#pragma unroll
            for (int c = 0; c < 4; ++c) v[c] = siluf_(v[c]);
            *(u32x2*)((bf16_t*)(ws + O_ZS) + row * 512 + (col - 1536)) = pack4(v);
          } else if (n0 < 3072) {
#pragma unroll
            for (int c = 0; c < 4; ++c) v[c] = geluf_(v[c]);
            *(u32x2*)((bf16_t*)(ws + O_UVG) + row * 1024 + (col - 2048)) = pack4(v);
          } else if (n0 < 3584) {
#pragma unroll
            for (int c = 0; c < 4; ++c) v[c] *= 0.08838834764831845f;
            *(u32x2*)((bf16_t*)(ws + O_XQ) + row * 512 + (col - 3072)) = pack4(v);
          } else {
#pragma unroll
            for (int c = 0; c < 4; ++c) v[c] = sigmoidf_(v[c]);
            *(u32x2*)((bf16_t*)(ws + O_GATES) + row * 3072 + (col - 3584)) = pack4(v);
          }
        }
      }
    } else {
      const int r = t - NT1; const int mt = r & 3, nt = r >> 2;
      const int m0 = mt * 128, n0 = nt * 128;
      gemm_mainloop<false>(smem, (const bf16_t*)(ws + O_MEMB), 1024, nullptr, m0, (const bf16_t*)(ws + O_WMKV), 1024, n0, 1024, acc);
#pragma unroll
      for (int i = 0; i < 2; ++i) {
        const int row = m0 + 32 * wm + 16 * i + fr; const int b = row >> 8, key = row & 255;
#pragma unroll
        for (int j = 0; j < 4; ++j) {
          const int col = n0 + 64 * wn + 16 * j + 4 * fq;
          const f32x4 v = acc[i][j];
          if (col < 512) { const int h = col >> 7, d = col & 127; *(u32x2*)((bf16_t*)(ws + O_MEMK) + ((size_t)((b * 4 + h) * 256 + key)) * 128 + d) = pack4(v); }
          else {
            const int c2 = col - 512; const int h = c2 >> 7, d = c2 & 127;
            const int pos = 32 * (key >> 5) + 8 * ((key >> 2) & 3) + 4 * ((key >> 4) & 1) + (key & 3);
            bf16_t* vt = (bf16_t*)(ws + O_MEMVT) + ((size_t)((b * 4 + h) * 128 + d)) * 256 + pos;
#pragma unroll
            for (int c = 0; c < 4; ++c) vt[(size_t)c * 256] = f2bf(v[c]);
          }
        }
      }
    }
  }
}

constexpr int G_KF = 0, G_VF = 32768, G_QB = 65536, G_KB = 81920, G_UT = 81920  , G_L = 98304, G_ATT = 114688, G_KDT = 122880, G_WT = 139264, G_SM = 155648;

DI void gdn_prep_item(const Params& p, unsigned char* smem, int item) {
  int tid = threadIdx.x; asm volatile("" : "+v"(tid));
  const int lane = tid & 63, wave = __builtin_amdgcn_readfirstlane(tid >> 6), fr = lane & 15, fq = lane >> 4;
  unsigned char* ws = p.ws;
  const int h = item & 3, cn = item >> 2;
  const int bidx = cn >> 7, n = cn & 127;
  const size_t t0 = (size_t)bidx * SEQ + (size_t)n * 64;
  float* kf = (float*)(smem + G_KF); float* vf = (float*)(smem + G_VF); float* Lm = (float*)(smem + G_L);
  float* sbeta = (float*)(smem + G_SM); float* sgc = sbeta + 64; float* segc = sbeta + 128;
  __syncthreads();
  {
    const bf16_t* qkv = (const bf16_t*)(ws + O_QKV);
    const float* cw = p.in[I_CONVW];
    const int tl0 = wave * 8;
#pragma unroll
    for (int sect = 0; sect < 3; ++sect) {
      const int cb = sect * 512 + h * 128 + 2 * lane;
      float w0[4], w1[4];
#pragma unroll
      for (int i = 0; i < 4; ++i) { w0[i] = cw[i * 1536 + cb]; w1[i] = cw[i * 1536 + cb + 1]; }
      float xa[11], xc[11];
#pragma unroll
      for (int r = 0; r < 11; ++r) {
        const int s = n * 64 + tl0 + r - 3;
        unsigned u = 0u;
        if (s >= 0) u = *(const unsigned*)(qkv + ((size_t)bidx * SEQ + s) * 1536 + cb);
        xa[r] = lo2f(u); xc[r] = hi2f(u);
      }
#pragma unroll
      for (int r = 0; r < 8; ++r) {
        float y0 = w0[0] * xa[r] + w0[1] * xa[r + 1] + w0[2] * xa[r + 2] + w0[3] * xa[r + 3];
        float y1 = w1[0] * xc[r] + w1[1] * xc[r + 1] + w1[2] * xc[r + 2] + w1[3] * xc[r + 3];
        y0 = siluf_(y0); y1 = siluf_(y1);
        const int tl = tl0 + r;
        if (sect == 2) { vf[tl * 128 + 2 * lane] = y0; vf[tl * 128 + 2 * lane + 1] = y1; }
        else {
          const float ss = wave_sum(y0 * y0 + y1 * y1);
          const float sc = rsqrtf(ss + 1e-6f) * (sect == 0 ? 0.08838834764831845f : 1.0f);
          y0 *= sc; y1 *= sc;
          const int off = sw256(tl, lane >> 2) + (lane & 3) * 4;
          if (sect == 0) *(unsigned*)(smem + G_QB + off) = pk2(y0, y1);
          else { *(unsigned*)(smem + G_KB + off) = pk2(y0, y1); kf[tl * 128 + 2 * lane] = y0; kf[tl * 128 + 2 * lane + 1] = y1; }
        }
      }
    }
    if (wave == 0) {
      const float* ab = (const float*)(ws + O_AB) + (t0 + lane) * 8;
      const float a = ab[h], bb = ab[4 + h];
      const float beta = sigmoidf_(bb);
      float g = -__expf(p.in[I_ALOG][h]) * softplusf_(a + p.in[I_DTB][h]);
#pragma unroll
      for (int o = 1; o < 64; o <<= 1) { const float y = __shfl_up(g, o); if (lane >= o) g += y; }
      sbeta[lane] = beta; sgc[lane] = g; segc[lane] = __expf(g);
      if (lane == 63) ((float*)(ws + O_GL))[item] = __expf(g);
    }
  }
  __syncthreads();
  {
#pragma unroll
    for (int q = 0; q < 4; ++q) {
      const int idx = wave * 4 + q; const int isq = idx >> 4, ti = (idx >> 2) & 3, tj = idx & 3;
      f32x4 acc = {0.f, 0.f, 0.f, 0.f};
      if (tj <= ti) {
#pragma unroll
        for (int ks = 0; ks < 4; ++ks) {
          const bf16x8 ai = ldfrag(smem + (isq ? G_QB : G_KB) + sw256(16 * ti + fr, 4 * ks + fq));
          const bf16x8 bj = ldfrag(smem + G_KB + sw256(16 * tj + fr, 4 * ks + fq));
          acc = isq ? mfma16(bj, ai, acc) : mfma16(ai, bj, acc);
        }
      }
      if (isq) {
        const int i = 16 * ti + fr, j0 = 16 * tj + 4 * fq;
        const float gi = sgc[i];
        f32x4 o;
#pragma unroll
        for (int r = 0; r < 4; ++r) { const int j = j0 + r; o[r] = (j <= i) ? acc[r] * __expf(gi - sgc[j]) : 0.f; }
        *(u32x2*)(smem + G_ATT + sw128(i, j0 >> 3) + (j0 & 7) * 2) = pack4(o);
      } else {
        const int j = 16 * tj + fr, i0 = 16 * ti + 4 * fq;
        const float gj = sgc[j];
        f32x4 o;
#pragma unroll
        for (int r = 0; r < 4; ++r) { const int i = i0 + r; o[r] = (j < i) ? acc[r] * __expf(sgc[i] - gj) * sbeta[i] : 0.f; }
        *(f32x4*)(Lm + j * 64 + i0) = o;
      }
    }
  }
  {
    const float gl_ = sgc[63];
    const int d = tid & 127, tg = tid >> 7;
#pragma unroll
    for (int c = 0; c < 2; ++c) {
      float e[8];
#pragma unroll
      for (int j = 0; j < 8; ++j) { const int t = 16 * tg + 8 * c + j; e[j] = kf[t * 128 + d] * __expf(gl_ - sgc[t]); }
      u32x4 o = {pk2(e[0], e[1]), pk2(e[2], e[3]), pk2(e[4], e[5]), pk2(e[6], e[7])};
      *(u32x4*)(smem + G_KDT + sw128(d, 2 * tg + c)) = o;
    }
  }
  __syncthreads();
  if (tid < 256) {
    const bool isw = tid >= 128;
    float* X = isw ? (kf + (tid - 128)) : (vf + tid);
    unsigned char* dstT = smem + (isw ? G_WT : G_UT);
    const int rowc = tid & 127;
#pragma unroll
    for (int b = 0; b < 4; ++b) {
      float xr[16];
#pragma unroll
      for (int r = 0; r < 16; ++r) { const int t = 16 * b + r; float sc = sbeta[t]; if (isw) sc *= segc[t]; xr[r] = X[t * 128] * sc; }
#pragma unroll 2
      for (int j = 0; j < 16 * b; ++j) {
        const float xj = X[j * 128];
        const float* lt = Lm + j * 64 + 16 * b;
        const f32x4 l0 = *(const f32x4*)lt, l1 = *(const f32x4*)(lt + 4), l2 = *(const f32x4*)(lt + 8), l3 = *(const f32x4*)(lt + 12);
#pragma unroll
        for (int r = 0; r < 4; ++r) { xr[r] -= l0[r] * xj; xr[4 + r] -= l1[r] * xj; xr[8 + r] -= l2[r] * xj; xr[12 + r] -= l3[r] * xj; }
      }
#pragma unroll
      for (int q = 0; q < 15; ++q) {
        const float* lt = Lm + (16 * b + q) * 64 + 16 * b;
        float l[16];
#pragma unroll
        for (int g4 = 0; g4 < 4; ++g4) if (4 * g4 + 3 > q) { const f32x4 t4 = *(const f32x4*)(lt + 4 * g4); l[4 * g4] = t4[0]; l[4 * g4 + 1] = t4[1]; l[4 * g4 + 2] = t4[2]; l[4 * g4 + 3] = t4[3]; }
#pragma unroll
        for (int r = q + 1; r < 16; ++r) xr[r] -= l[r] * xr[q];
      }
#pragma unroll
      for (int r = 0; r < 16; ++r) X[(16 * b + r) * 128] = xr[r];
      u32x4 o0 = {pk2(xr[0], xr[1]), pk2(xr[2], xr[3]), pk2(xr[4], xr[5]), pk2(xr[6], xr[7])};
      u32x4 o1 = {pk2(xr[8], xr[9]), pk2(xr[10], xr[11]), pk2(xr[12], xr[13]), pk2(xr[14], xr[15])};
      *(u32x4*)(dstT + sw128(rowc, 2 * b)) = o0;
      *(u32x4*)(dstT + sw128(rowc, 2 * b + 1)) = o1;
    }
  }
  __syncthreads();
  {
    bf16x8 ak[2];
#pragma unroll
    for (int ks = 0; ks < 2; ++ks) ak[ks] = ldfrag(smem + G_KDT + sw128(16 * wave + fr, 4 * ks + fq));
    bf16_t* mp = (bf16_t*)(ws + O_MP) + (size_t)item * 16384;
    float* bc = (float*)(ws + O_BC) + (size_t)item * 16384;
#pragma unroll
    for (int tj = 0; tj < 8; ++tj) {
      f32x4 am = {0.f, 0.f, 0.f, 0.f}, ab_ = {0.f, 0.f, 0.f, 0.f};
#pragma unroll
      for (int ks = 0; ks < 2; ++ks) {
        const bf16x8 bw = ldfrag(smem + G_WT + sw128(16 * tj + fr, 4 * ks + fq));
        const bf16x8 bu = ldfrag(smem + G_UT + sw128(16 * tj + fr, 4 * ks + fq));
        am = mfma16(bw, ak[ks], am);
        ab_ = mfma16(ak[ks], bu, ab_);
      }
      f32x4 nm = {-am[0], -am[1], -am[2], -am[3]};
      *(u32x2*)(mp + ((size_t)((wave * 4 + (tj >> 1)) * 64 + lane)) * 8 + (tj & 1) * 4) = pack4(nm);
      *(f32x4*)(bc + ((size_t)((tj * 8 + wave) * 64 + lane)) * 4) = ab_;
    }
    const int tt = wave & 3, hf = wave >> 2;
    bf16x8 aa[2];
#pragma unroll
    for (int ks = 0; ks < 2; ++ks) aa[ks] = ldfrag(smem + G_ATT + sw128(16 * tt + fr, 4 * ks + fq));
    const int trow = 16 * tt + fr;
    const float eg = segc[trow];
    float* o0 = (float*)(ws + O_O0) + (t0 + trow) * 512 + h * 128;
    bf16_t* qp = (bf16_t*)(ws + O_QP) + (size_t)item * 8192 + trow * 128;
#pragma unroll
    for (int q = 0; q < 4; ++q) {
      const int te = hf * 4 + q;
      f32x4 ao = {0.f, 0.f, 0.f, 0.f}, aw = {0.f, 0.f, 0.f, 0.f};
#pragma unroll
      for (int ks = 0; ks < 2; ++ks) {
        const bf16x8 bu = ldfrag(smem + G_UT + sw128(16 * te + fr, 4 * ks + fq));
        const bf16x8 bw = ldfrag(smem + G_WT + sw128(16 * te + fr, 4 * ks + fq));
        ao = mfma16(bu, aa[ks], ao);
        aw = mfma16(bw, aa[ks], aw);
      }
      const int e0 = 16 * te + 4 * fq;
      *(f32x4*)(o0 + e0) = ao;
      const u32x2 qv = *(const u32x2*)(smem + G_QB + sw256(trow, e0 >> 3) + (e0 & 7) * 2);
      f32x4 qd = {lo2f(qv[0]) * eg - aw[0], hi2f(qv[0]) * eg - aw[1], lo2f(qv[1]) * eg - aw[2], hi2f(qv[1]) * eg - aw[3]};
      *(u32x2*)(qp + e0) = pack4(qd);
    }
  }
}

DI void sgu_item(const Params& p, unsigned char* smem, int item) {
  int tid = threadIdx.x; asm volatile("" : "+v"(tid));
  const int lane = tid & 63, wave = __builtin_amdgcn_readfirstlane(tid >> 6), fr = lane & 15, fq = lane >> 4;
  unsigned char* ws = p.ws;
  const int g = item & 3, cn = item >> 2;
  const size_t t0 = (size_t)cn * 128;
  const bf16_t* uvg = (const bf16_t*)(ws + O_UVG);
  __syncthreads();
  {
    const float* lng = p.in[I_SLNG]; const float* lnb = p.in[I_SLNB];
    const int cl0 = 8 * (lane & 15);
    float gg[8], bb[8];
#pragma unroll
    for (int e = 0; e < 8; ++e) { gg[e] = lng[128 * g + cl0 + e]; bb[e] = lnb[128 * g + cl0 + e]; }
    for (int jj = 0; jj < 16; ++jj) {
      const int j = 16 * wave + jj;
      const u32x4 raw = *(const u32x4*)(uvg + (t0 + j) * 1024 + 512 + 8 * lane);
      float v[8];
#pragma unroll
      for (int e = 0; e < 4; ++e) { v[2 * e] = lo2f(raw[e]); v[2 * e + 1] = hi2f(raw[e]); }
      float s = 0.f;
#pragma unroll
      for (int e = 0; e < 8; ++e) s += v[e];
      const float mean = wave_sum(s) * (1.f / 512.f);
      float q = 0.f;
#pragma unroll
      for (int e = 0; e < 8; ++e) { const float d = v[e] - mean; q += d * d; }
      const float rstd = rsqrtf(wave_sum(q) * (1.f / 512.f) + 1e-5f);
      if ((lane >> 4) == g) {
#pragma unroll
        for (int e = 0; e < 8; ++e) {
          const int c = cl0 + e;
          const float y = (v[e] - mean) * rstd * gg[e] + bb[e];
          *(bf16_t*)(smem + sw256(c, j >> 3) + (j & 7) * 2) = f2bf(y);
        }
      }
    }
  }
  __syncthreads();
  {
    const bf16_t* wg = (const bf16_t*)(ws + O_SGUW) + (size_t)g * 16384;
    const int i = 16 * wave + fr;
    bf16x8 af[4];
#pragma unroll
    for (int ks = 0; ks < 4; ++ks) af[ks] = ldfrag(wg + i * 128 + 32 * ks + 8 * fq);
    const float bias = p.in[I_SGUB][g * 128 + i];
    bf16_t* out = (bf16_t*)(ws + O_SGUO) + (t0 + i) * 512 + 128 * g;
    const bf16_t* urow = uvg + (t0 + i) * 1024 + 128 * g;
#pragma unroll
    for (int jt = 0; jt < 8; ++jt) {
      f32x4 acc = {0.f, 0.f, 0.f, 0.f};
#pragma unroll
      for (int ks = 0; ks < 4; ++ks) acc = mfma16(ldfrag(smem + sw256(16 * jt + fr, 4 * ks + fq)), af[ks], acc);
      const int c0 = 16 * jt + 4 * fq;
      const u32x2 uu = *(const u32x2*)(urow + c0);
      f32x4 o = {lo2f(uu[0]) * (acc[0] + bias), hi2f(uu[0]) * (acc[1] + bias), lo2f(uu[1]) * (acc[2] + bias), hi2f(uu[1]) * (acc[3] + bias)};
      *(u32x2*)(out + c0) = pack4(o);
    }
  }
}

DI void xattn_item(const Params& p, int item) {
  int tid = threadIdx.x; asm volatile("" : "+v"(tid));
  const int lane = tid & 63, wave = __builtin_amdgcn_readfirstlane(tid >> 6), fr = lane & 15, fq = lane >> 4;
  unsigned char* ws = p.ws;
  const int h = item & 3, qt = item >> 2;
  const size_t trow = (size_t)qt * 128 + 16 * wave + fr;
  const int b = (qt * 128) >> 13;
  const bf16_t* xq = (const bf16_t*)(ws + O_XQ) + trow * 512 + h * 128;
  const bf16_t* mk = (const bf16_t*)(ws + O_MEMK) + (size_t)(b * 4 + h) * 32768;
  const bf16_t* mv = (const bf16_t*)(ws + O_MEMVT) + (size_t)(b * 4 + h) * 32768;
  bf16x8 qf[4];
#pragma unroll
  for (int ds = 0; ds < 4; ++ds) qf[ds] = ldfrag(xq + 32 * ds + 8 * fq);
  f32x4 sc[16];
#pragma unroll
  for (int kt = 0; kt < 16; ++kt) {
    f32x4 a = {0.f, 0.f, 0.f, 0.f};
#pragma unroll
    for (int ds = 0; ds < 4; ++ds) a = mfma16(ldfrag(mk + (16 * kt + fr) * 128 + 32 * ds + 8 * fq), qf[ds], a);
    sc[kt] = a;
  }
  float m = -1e30f;
#pragma unroll
  for (int kt = 0; kt < 16; ++kt)
#pragma unroll
    for (int r = 0; r < 4; ++r) m = fmaxf(m, sc[kt][r]);
  m = fmaxf(m, __shfl_xor(m, 16)); m = fmaxf(m, __shfl_xor(m, 32));
  float l = 0.f;
#pragma unroll
  for (int kt = 0; kt < 16; ++kt)
#pragma unroll
    for (int r = 0; r < 4; ++r) { const float e = __expf(sc[kt][r] - m); sc[kt][r] = e; l += e; }
  l += __shfl_xor(l, 16); l += __shfl_xor(l, 32);
  const float inv = 1.f / l;
  bf16x8 pf[8];
#pragma unroll
  for (int s = 0; s < 8; ++s) pf[s] = pack8(sc[2 * s], sc[2 * s + 1]);
  bf16_t* out = (bf16_t*)(ws + O_XATO) + trow * 512 + h * 128;
#pragma unroll
  for (int dt = 0; dt < 8; ++dt) {
    f32x4 a = {0.f, 0.f, 0.f, 0.f};
#pragma unroll
    for (int s = 0; s < 8; ++s) a = mfma16(ldfrag(mv + (16 * dt + fr) * 256 + 32 * s + 8 * fq), pf[s], a);
    f32x4 o = {a[0] * inv, a[1] * inv, a[2] * inv, a[3] * inv};
    *(u32x2*)(out + 16 * dt + 4 * fq) = pack4(o);
  }
}

DI void phase2(const Params& p, unsigned char* smem, int bid, int nb) {
  for (int it = bid; it < 2048; it += nb) {
    if (it < 1024) gdn_prep_item(p, smem, it);
    else if (it < 1536) sgu_item(p, smem, it - 1024);
    else xattn_item(p, it - 1536);
  }
}

DI void gdn_scan(const Params& p, int bh, int es) {
  const int lane = threadIdx.x & 63;
  unsigned char* ws = p.ws;
  const int b = bh >> 2, h = bh & 3;
  f32x4 acc[8];
#pragma unroll
  for (int t = 0; t < 8; ++t) acc[t] = (f32x4){0.f, 0.f, 0.f, 0.f};
  const int fr = lane & 15, fq = lane >> 4;
  const size_t item0 = (size_t)(b * 128) * 4 + h;
  const bf16_t* mp = (const bf16_t*)(ws + O_MP) + item0 * 16384 + lane * 8;
  const float* bc = (const float*)(ws + O_BC) + item0 * 16384 + (size_t)es * 2048 + lane * 4;
  bf16_t* st = (bf16_t*)(ws + O_ST) + item0 * 16384 + (size_t)(16 * es + fr) * 128 + 4 * fq;
  const float* glp = (const float*)(ws + O_GL) + item0;
  constexpr size_t ISTR = 4 * 16384;
  bf16x8 A[32]; f32x4 C[8]; float gl;
#pragma unroll
  for (int i = 0; i < 32; ++i) A[i] = ldfrag(mp + i * 512);
#pragma unroll
  for (int t = 0; t < 8; ++t) C[t] = *(const f32x4*)(bc + t * 256);
  gl = glp[0];
  for (int n = 0; n < 128; ++n) {
    const int nn = (n < 127) ? n + 1 : n;
    const bf16_t* mpn = mp + (size_t)nn * ISTR;
    const float* bcn = bc + (size_t)nn * ISTR;
    bf16_t* stn = st + (size_t)n * ISTR;
    bf16x8 bfr[4];
#pragma unroll
    for (int s = 0; s < 4; ++s) {
      const u32x2 lo = pack4(acc[2 * s]), hi = pack4(acc[2 * s + 1]);
      *(u32x2*)(stn + 32 * s) = lo; *(u32x2*)(stn + 32 * s + 16) = hi;
      u32x4 v = {lo[0], lo[1], hi[0], hi[1]};
      bfr[s] = __builtin_bit_cast(bf16x8, v);
    }
    const float gcur = gl;
    gl = glp[(size_t)nn * 4];
#pragma unroll
    for (int t = 0; t < 8; ++t) {
      f32x4 a = {gcur * acc[t][0] + C[t][0], gcur * acc[t][1] + C[t][1], gcur * acc[t][2] + C[t][2], gcur * acc[t][3] + C[t][3]};
      C[t] = *(const f32x4*)(bcn + t * 256);
#pragma unroll
      for (int s = 0; s < 4; ++s) { a = mfma16(A[t * 4 + s], bfr[s], a); A[t * 4 + s] = ldfrag(mpn + (t * 4 + s) * 512); }
      acc[t] = a;
    }
  }
}

DI void part_tile(const Params& p, unsigned char* smem, int t) {
  const int tid = threadIdx.x, lane = tid & 63, wave = tid >> 6;
  const int wm = wave & 3, wn = wave >> 2, fr = lane & 15, fq = lane >> 4;
  unsigned char* ws = p.ws;
  int mt, nt; tile_mn(t, 8, mt, nt);
  const int m0 = mt * 128, n0 = nt * 128;
  f32x4 acc[2][4], acc2[2][4]; zero_acc(acc); zero_acc(acc2);
  gemm_mainloop<false>(smem, (const bf16_t*)(ws + O_SGUO), 512, nullptr, m0, (const bf16_t*)(ws + O_WBT), 512, n0, 512, acc);
  gemm_mainloop<false>(smem, (const bf16_t*)(ws + O_XATO), 512, nullptr, m0, (const bf16_t*)(ws + O_WCT), 512, n0, 512, acc2);
  const bf16_t* gates = (const bf16_t*)(ws + O_GATES);
  bf16_t* part = (bf16_t*)(ws + O_PART);
#pragma unroll
  for (int i = 0; i < 2; ++i) {
    const size_t row = m0 + 32 * wm + 16 * i + fr;
#pragma unroll
    for (int j = 0; j < 4; ++j) {
      const int col = n0 + 64 * wn + 16 * j + 4 * fq;
      const u32x2 g1 = *(const u32x2*)(gates + row * 3072 + 1024 + col);
      const u32x2 g2 = *(const u32x2*)(gates + row * 3072 + 2048 + col);
      f32x4 o = {lo2f(g1[0]) * acc[i][j][0] + lo2f(g2[0]) * acc2[i][j][0], hi2f(g1[0]) * acc[i][j][1] + hi2f(g2[0]) * acc2[i][j][1],
                 lo2f(g1[1]) * acc[i][j][2] + lo2f(g2[1]) * acc2[i][j][2], hi2f(g1[1]) * acc[i][j][3] + hi2f(g2[1]) * acc2[i][j][3]};
      *(u32x2*)(part + row * 1024 + col) = pack4(o);
    }
  }
}

DI void phase3(const Params& p, unsigned char* smem, int bid, int nb) {
  if (bid < 64) {
    const int wave = threadIdx.x >> 6;
    if (wave == 0) gdn_scan(p, bid & 7, bid >> 3);
  } else {
    for (int t = bid - 64; t < 1024; t += nb - 64) part_tile(p, smem, t);
  }
}

DI void phase4(const Params& p, int bid, int nb) {
  const int tid = threadIdx.x, lane = tid & 63, wave = tid >> 6, fr = lane & 15, fq = lane >> 4;
  unsigned char* ws = p.ws;
  for (int it = bid; it < 512; it += nb) {
    const int item = it * 2 + (wave >> 2), tt = wave & 3;
    const int h = item & 3, cn = item >> 2;
    const size_t trow = (size_t)cn * 64 + 16 * tt + fr;
    const bf16_t* qp = (const bf16_t*)(ws + O_QP) + (size_t)item * 8192 + (16 * tt + fr) * 128;
    const bf16_t* st = (const bf16_t*)(ws + O_ST) + (size_t)item * 16384;
    const float* o0 = (const float*)(ws + O_O0) + trow * 512 + h * 128;
    bf16x8 af[4];
#pragma unroll
    for (int ks = 0; ks < 4; ++ks) af[ks] = ldfrag(qp + 32 * ks + 8 * fq);
    f32x4 acc[8];
    float ss = 0.f;
#pragma unroll
    for (int j = 0; j < 8; ++j) {
      f32x4 a = *(const f32x4*)(o0 + 16 * j + 4 * fq);
#pragma unroll
      for (int ks = 0; ks < 4; ++ks) a = mfma16(ldfrag(st + (16 * j + fr) * 128 + 32 * ks + 8 * fq), af[ks], a);
      acc[j] = a;
      ss += a[0] * a[0] + a[1] * a[1] + a[2] * a[2] + a[3] * a[3];
    }
    ss += __shfl_xor(ss, 16); ss += __shfl_xor(ss, 32);
    const float rms = rsqrtf(ss * (1.f / 128.f) + 1e-6f);
    const float* ng = p.in[I_GNG];
    const bf16_t* zs = (const bf16_t*)(ws + O_ZS) + trow * 512 + h * 128;
    bf16_t* out = (bf16_t*)(ws + O_GDNO) + trow * 512 + h * 128;
#pragma unroll
    for (int j = 0; j < 8; ++j) {
      const int e0 = 16 * j + 4 * fq;
      const f32x4 g = *(const f32x4*)(ng + e0);
      const u32x2 z = *(const u32x2*)(zs + e0);
      f32x4 o = {acc[j][0] * rms * g[0] * lo2f(z[0]), acc[j][1] * rms * g[1] * hi2f(z[0]), acc[j][2] * rms * g[2] * lo2f(z[1]), acc[j][3] * rms * g[3] * hi2f(z[1])};
      *(u32x2*)(out + e0) = pack4(o);
    }
  }
}

DI void phase5(const Params& p, unsigned char* smem, int bid, int nb) {
  const int tid = threadIdx.x, lane = tid & 63, wave = tid >> 6;
  const int wm = wave & 3, wn = wave >> 2, fr = lane & 15, fq = lane >> 4;
  unsigned char* ws = p.ws;
  for (int t = bid; t < 1024; t += nb) {
    int mt, nt; tile_mn(t, 8, mt, nt);
    const int m0 = mt * 128, n0 = nt * 128;
    f32x4 acc[2][4]; zero_acc(acc);
    gemm_mainloop<false>(smem, (const bf16_t*)(ws + O_GDNO), 512, nullptr, m0, (const bf16_t*)(ws + O_WAT), 512, n0, 512, acc);
    const bf16_t* gates = (const bf16_t*)(ws + O_GATES);
    const bf16_t* part = (const bf16_t*)(ws + O_PART);
    bf16_t* merged = (bf16_t*)(ws + O_MERGED);
#pragma unroll
    for (int i = 0; i < 2; ++i) {
      const size_t row = m0 + 32 * wm + 16 * i + fr;
#pragma unroll
      for (int j = 0; j < 4; ++j) {
        const int col = n0 + 64 * wn + 16 * j + 4 * fq;
        const u32x2 g0 = *(const u32x2*)(gates + row * 3072 + col);
        const u32x2 pp = *(const u32x2*)(part + row * 1024 + col);
        f32x4 o = {lo2f(pp[0]) + lo2f(g0[0]) * acc[i][j][0], hi2f(pp[0]) + hi2f(g0[0]) * acc[i][j][1],
                   lo2f(pp[1]) + lo2f(g0[1]) * acc[i][j][2], hi2f(pp[1]) + hi2f(g0[1]) * acc[i][j][3]};
        *(u32x2*)(merged + row * 1024 + col) = pack4(o);
      }
    }
  }
}
DI void phase6(const Params& p, unsigned char* smem, int bid, int nb) {
  const int tid = threadIdx.x, lane = tid & 63, wave = tid >> 6;
  const int wm = wave & 3, wn = wave >> 2, fr = lane & 15, fq = lane >> 4;
  unsigned char* ws = p.ws;
  const float* x = p.in[I_X];
  float* x1 = (float*)(ws + O_X1);
  for (int t = bid; t < 1024; t += nb) {
    int mt, nt; tile_mn(t, 8, mt, nt);
    const int m0 = mt * 128, n0 = nt * 128;
    f32x4 acc[2][4]; zero_acc(acc);
    gemm_mainloop<false>(smem, (const bf16_t*)(ws + O_MERGED), 1024, nullptr, m0, (const bf16_t*)(ws + O_WOT), 1024, n0, 1024, acc);
#pragma unroll
    for (int i = 0; i < 2; ++i) {
      const size_t row = m0 + 32 * wm + 16 * i + fr;
#pragma unroll
      for (int j = 0; j < 4; ++j) {
        const int col = n0 + 64 * wn + 16 * j + 4 * fq;
        const f32x4 xv = *(const f32x4*)(x + row * 1024 + col);
        f32x4 o = {ALPHA * xv[0] + acc[i][j][0], ALPHA * xv[1] + acc[i][j][1], ALPHA * xv[2] + acc[i][j][2], ALPHA * xv[3] + acc[i][j][3]};
        *(f32x4*)(x1 + row * 1024 + col) = o;
      }
    }
  }
}

DI void ln_row(const float* src, const float* g, const float* b, float (&v)[16], int lane) {
  float s = 0.f;
#pragma unroll
  for (int i = 0; i < 16; ++i) s += v[i];
  const float mean = wave_sum(s) * (1.f / 1024.f);
  float q = 0.f;
#pragma unroll
  for (int i = 0; i < 16; ++i) { const float d = v[i] - mean; q += d * d; }
  const float rstd = rsqrtf(wave_sum(q) * (1.f / 1024.f) + 1e-5f);
#pragma unroll
  for (int i = 0; i < 4; ++i) {
    const int k = 256 * i + 4 * lane;
    const f32x4 gg = *(const f32x4*)(g + k), bb = *(const f32x4*)(b + k);
#pragma unroll
    for (int c = 0; c < 4; ++c) v[4 * i + c] = (v[4 * i + c] - mean) * rstd * gg[c] + bb[c];
  }
}
DI void phase7(const Params& p, int bid, int nb) {
  const int tid = threadIdx.x, lane = tid & 63, wave = tid >> 6;
  unsigned char* ws = p.ws;
  float* x1 = (float*)(ws + O_X1);
  bf16_t* x1b = (bf16_t*)(ws + O_X1B);
  for (int row = bid * 8 + wave; row < T; row += nb * 8) {
    float v[16];
#pragma unroll
    for (int i = 0; i < 4; ++i) { const f32x4 t = *(const f32x4*)(x1 + (size_t)row * D + 256 * i + 4 * lane); v[4 * i] = t[0]; v[4 * i + 1] = t[1]; v[4 * i + 2] = t[2]; v[4 * i + 3] = t[3]; }
    ln_row(nullptr, p.in[I_LN1G], p.in[I_LN1B], v, lane);
#pragma unroll
    for (int i = 0; i < 4; ++i) {
      const f32x4 o = {v[4 * i], v[4 * i + 1], v[4 * i + 2], v[4 * i + 3]};
      *(f32x4*)(x1 + (size_t)row * D + 256 * i + 4 * lane) = o;
      *(u32x2*)(x1b + (size_t)row * D + 256 * i + 4 * lane) = pack4(o);
    }
  }
}
DI void phase8(const Params& p, unsigned char* smem, int bid, int nb) {
  const int tid = threadIdx.x, lane = tid & 63, wave = tid >> 6;
  const int wm = wave & 3, wn = wave >> 2, fr = lane & 15, fq = lane >> 4;
  unsigned char* ws = p.ws;
  float* logits = (float*)(ws + O_LOGITS);
  for (int t = bid; t < 256; t += nb) {
    const int mt = t >> 1, nt = t & 1;
    const int m0 = mt * 128, n0 = nt * 128;
    f32x4 acc[2][4]; zero_acc(acc);
    gemm_mainloop<false>(smem, (const bf16_t*)(ws + O_X1B), 1024, nullptr, m0, (const bf16_t*)(ws + O_ROUT), 1024, n0, 1024, acc);
#pragma unroll
    for (int i = 0; i < 2; ++i) {
      const size_t row = m0 + 32 * wm + 16 * i + fr;
#pragma unroll
      for (int j = 0; j < 4; ++j) *(f32x4*)(logits + row * 256 + n0 + 64 * wn + 16 * j + 4 * fq) = acc[i][j];
    }
  }
}
DI void phase9(const Params& p, int bid, int nb) {
  const int tid = threadIdx.x, lane = tid & 63, wave = tid >> 6;
  unsigned char* ws = p.ws;
  const float* logits = (const float*)(ws + O_LOGITS);
  int* counts = (int*)(ws + O_CTRL);
  const f32x4 bias = *(const f32x4*)(p.in[I_RB] + 4 * lane);
  const float NEG = -__builtin_inff();
  for (int tok = bid * 8 + wave; tok < T; tok += nb * 8) {
    const f32x4 lg = *(const f32x4*)(logits + (size_t)tok * 256 + 4 * lane);
    float sc[4], mv[4];
#pragma unroll
    for (int c = 0; c < 4; ++c) { sc[c] = sigmoidf_(lg[c]); mv[c] = sc[c] + bias[c]; }
    float m1 = NEG, m2 = NEG;
#pragma unroll
    for (int c = 0; c < 4; ++c) { const float v = mv[c]; if (v > m1) { m2 = m1; m1 = v; } else if (v > m2) m2 = v; }
#pragma unroll
    for (int o = 1; o < 8; o <<= 1) {
      const float o1 = __shfl_xor(m1, o), o2 = __shfl_xor(m2, o);
      const float n1 = fmaxf(m1, o1), n2 = fmaxf(fminf(m1, o1), fmaxf(m2, o2));
      m1 = n1; m2 = n2;
    }
    const float gs = m1 + m2;
    const int g = lane >> 3;
    int rank = 0;
#pragma unroll
    for (int gg = 0; gg < 8; ++gg) { const float og = __shfl(gs, gg * 8); rank += ((og > gs) || (og == gs && gg < g)) ? 1 : 0; }
    if (rank >= 4) {
#pragma unroll
      for (int c = 0; c < 4; ++c) mv[c] = NEG;
    }
    int myidx = 0; float mysc = 0.f, ssum = 0.f;
#pragma unroll
    for (int k = 0; k < 8; ++k) {
      float bv = mv[0]; int bi = 0;
#pragma unroll
      for (int c = 1; c < 4; ++c) if (mv[c] > bv) { bv = mv[c]; bi = c; }
      float rv = bv; int ri = lane * 4 + bi;
#pragma unroll
      for (int o = 32; o; o >>= 1) {
        const float ov = __shfl_xor(rv, o); const int oi = __shfl_xor(ri, o);
        if (ov > rv || (ov == rv && oi < ri)) { rv = ov; ri = oi; }
      }
      const int wl = ri >> 2, wc = ri & 3;
      const float mine = wc == 0 ? sc[0] : wc == 1 ? sc[1] : wc == 2 ? sc[2] : sc[3];
      const float wsc = __shfl(mine, wl);
      if (lane == wl) {
#pragma unroll
        for (int c = 0; c < 4; ++c) if (c == wc) mv[c] = NEG;
      }
      ssum += wsc;
      if (lane == k) { myidx = ri; mysc = wsc; }
    }
    if (lane < 8) {
      const int pos = atomicAdd(&counts[myidx * CSTR], 1);
      ((int*)(ws + O_TKIDX))[(size_t)tok * 8 + lane] = myidx;
      ((float*)(ws + O_TKW))[(size_t)tok * 8 + lane] = mysc / ssum * 2.5f;
      ((int*)(ws + O_TKPOS))[(size_t)tok * 8 + lane] = pos;
    }
  }
}
DI void build_tile_start(const Params& p, int* ts) {
  const int tid = threadIdx.x;
  const int* counts = (const int*)(p.ws + O_CTRL);
  __syncthreads();
  if (tid < 256) ts[300 + tid] = (counts[tid * CSTR] + 127) >> 7;
  __syncthreads();
  if (tid == 0) { int s = 0; for (int e = 0; e < 256; ++e) { ts[e] = s; s += ts[300 + e]; } ts[256] = s; }
  __syncthreads();
}
DI void phase10(const Params& p, unsigned char* smem, int bid, int nb) {
  int* ts = (int*)smem;
  build_tile_start(p, ts);
  unsigned char* ws = p.ws;
  const int* tkidx = (const int*)(ws + O_TKIDX); const int* tkpos = (const int*)(ws + O_TKPOS); const float* tkw = (const float*)(ws + O_TKW);
  int* slottok = (int*)(ws + O_SLOTTOK); float* slotw = (float*)(ws + O_SLOTW); int* tokslot = (int*)(ws + O_TOKSLOT);
  for (int i = bid * NTHR + threadIdx.x; i < T * 8; i += nb * NTHR) {
    const int e = tkidx[i];
    const int slot = ts[e] * 128 + tkpos[i];
    slottok[slot] = i >> 3; slotw[slot] = tkw[i]; tokslot[i] = slot;
  }
}

DI int find_expert(const int* ts, int ti) { int lo = 0, hi = 255; while (lo < hi) { const int mid = (lo + hi + 1) >> 1; if (ts[mid] <= ti) lo = mid; else hi = mid - 1; } return lo; }

DI void phase11(const Params& p, unsigned char* smem, int bid, int nb) {
  const int tid = threadIdx.x, lane = tid & 63, wave = tid >> 6;
  const int wm = wave & 3, wn = wave >> 2, fr = lane & 15, fq = lane >> 4;
  unsigned char* ws = p.ws;
  int* ts = (int*)(smem + 65536);
  int* arow = (int*)(smem + 65536 + 4096);
  build_tile_start(p, ts);
  const int ntile = ts[256];
  const int* counts = (const int*)(ws + O_CTRL);
  const int* slottok = (const int*)(ws + O_SLOTTOK);
  const int nitem = ntile * 4 + 128 * 4;
  for (int it = bid; it < nitem; it += nb) {
    f32x4 acc[2][4]; zero_acc(acc);
    int m0, n0; bf16_t* actp;
    if (it < ntile * 4) {
      const int ti = it >> 2, nt = it & 3;
      const int e = find_expert(ts, ti);
      const int valid = counts[e * CSTR] - 128 * (ti - ts[e]);
      m0 = ti * 128; n0 = nt * 128;
      __syncthreads();
      if (tid < 128) arow[tid] = (tid < valid) ? slottok[m0 + tid] : 0;
      gemm_mainloop<true>(smem, (const bf16_t*)(ws + O_X1B), 1024, arow, m0, (const bf16_t*)(ws + O_WGU) + (size_t)e * 524288, 1024, n0, 1024, acc);
      actp = (bf16_t*)(ws + O_ACT);
    } else {
      const int r = it - ntile * 4; const int mt = r >> 2, nt = r & 3;
      m0 = mt * 128; n0 = nt * 128;
      gemm_mainloop<false>(smem, (const bf16_t*)(ws + O_X1B), 1024, nullptr, m0, (const bf16_t*)(ws + O_WSGU), 1024, n0, 1024, acc);
      actp = (bf16_t*)(ws + O_ACTSH);
    }
#pragma unroll
    for (int i = 0; i < 2; ++i) {
      const size_t row = m0 + 32 * wm + 16 * i + fr;
#pragma unroll
      for (int jj = 0; jj < 2; ++jj) {
        const int rowg = n0 + 64 * wn + 32 * jj;
        const int acol = (rowg >> 5) * 16 + 4 * fq;
        const f32x4 g = acc[i][2 * jj], u = acc[i][2 * jj + 1];
        f32x4 o = {siluf_(g[0]) * u[0], siluf_(g[1]) * u[1], siluf_(g[2]) * u[2], siluf_(g[3]) * u[3]};
        *(u32x2*)(actp + row * 256 + acol) = pack4(o);
      }
    }
  }
}
DI void phase12(const Params& p, unsigned char* smem, int bid, int nb) {
  const int tid = threadIdx.x, lane = tid & 63, wave = tid >> 6;
  const int wm = wave & 3, wn = wave >> 2, fr = lane & 15, fq = lane >> 4;
  unsigned char* ws = p.ws;
  int* ts = (int*)(smem + 65536);
  build_tile_start(p, ts);
  const int ntile = ts[256];
  const float* slotw = (const float*)(ws + O_SLOTW);
  const int nitem = ntile * 8 + 128 * 8;
  for (int it = bid; it < nitem; it += nb) {
    f32x4 acc[2][4]; zero_acc(acc);
    if (it < ntile * 8) {
      const int ti = it >> 3, nt = it & 7;
      const int e = find_expert(ts, ti);
      const int m0 = ti * 128, n0 = nt * 128;
      gemm_mainloop<false>(smem, (const bf16_t*)(ws + O_ACT), 256, nullptr, m0, (const bf16_t*)(ws + O_WD) + (size_t)e * 262144, 256, n0, 256, acc);
      bf16_t* y = (bf16_t*)(ws + O_Y);
#pragma unroll
      for (int i = 0; i < 2; ++i) {
        const size_t row = m0 + 32 * wm + 16 * i + fr;
        const float w = slotw[row];
#pragma unroll
        for (int j = 0; j < 4; ++j) {
          f32x4 o = {acc[i][j][0] * w, acc[i][j][1] * w, acc[i][j][2] * w, acc[i][j][3] * w};
          *(u32x2*)(y + row * 1024 + n0 + 64 * wn + 16 * j + 4 * fq) = pack4(o);
        }
      }
    } else {
      const int r = it - ntile * 8; const int mt = r >> 3, nt = r & 7;
      const int m0 = mt * 128, n0 = nt * 128;
      gemm_mainloop<false>(smem, (const bf16_t*)(ws + O_ACTSH), 256, nullptr, m0, (const bf16_t*)(ws + O_WSD), 256, n0, 256, acc);
      bf16_t* y = (bf16_t*)(ws + O_YSH);
#pragma unroll
      for (int i = 0; i < 2; ++i) {
        const size_t row = m0 + 32 * wm + 16 * i + fr;
#pragma unroll
        for (int j = 0; j < 4; ++j) *(u32x2*)(y + row * 1024 + n0 + 64 * wn + 16 * j + 4 * fq) = pack4(acc[i][j]);
      }
    }
  }
}
DI void phase13(const Params& p, int bid, int nb) {
  const int tid = threadIdx.x, lane = tid & 63, wave = tid >> 6;
  unsigned char* ws = p.ws;
  const float* x1 = (const float*)(ws + O_X1);
  const bf16_t* ysh = (const bf16_t*)(ws + O_YSH);
  const bf16_t* y = (const bf16_t*)(ws + O_Y);
  const int* tokslot = (const int*)(ws + O_TOKSLOT);
  for (int row = bid * 8 + wave; row < T; row += nb * 8) {
    float v[16];
#pragma unroll
    for (int i = 0; i < 4; ++i) {
      const int k = 256 * i + 4 * lane;
      const f32x4 t = *(const f32x4*)(x1 + (size_t)row * D + k);
      const u32x2 s = *(const u32x2*)(ysh + (size_t)row * D + k);
      v[4 * i] = ALPHA * t[0] + lo2f(s[0]); v[4 * i + 1] = ALPHA * t[1] + hi2f(s[0]); v[4 * i + 2] = ALPHA * t[2] + lo2f(s[1]); v[4 * i + 3] = ALPHA * t[3] + hi2f(s[1]);
    }
#pragma unroll
    for (int k8 = 0; k8 < 8; ++k8) {
      const size_t slot = (size_t)tokslot[(size_t)row * 8 + k8];
#pragma unroll
      for (int i = 0; i < 4; ++i) {
        const u32x2 s = *(const u32x2*)(y + slot * 1024 + 256 * i + 4 * lane);
        v[4 * i] += lo2f(s[0]); v[4 * i + 1] += hi2f(s[0]); v[4 * i + 2] += lo2f(s[1]); v[4 * i + 3] += hi2f(s[1]);
      }
    }
    ln_row(nullptr, p.in[I_LN2G], p.in[I_LN2B], v, lane);
#pragma unroll
    for (int i = 0; i < 4; ++i) { const f32x4 o = {v[4 * i], v[4 * i + 1], v[4 * i + 2], v[4 * i + 3]}; *(f32x4*)(p.out + (size_t)row * D + 256 * i + 4 * lane) = o; }
  }
}

#ifndef DUPMASK
#define DUPMASK 0
#endif
__global__ void __launch_bounds__(NTHR) mega_kernel(Params p) {
  extern __shared__ __attribute__((aligned(16))) unsigned char smem[];
  cg::grid_group grid = cg::this_grid();
  const int bid = blockIdx.x, nb = gridDim.x;
  volatile LAS unsigned* bst = (volatile LAS unsigned*)(smem + LDS_BYTES - 16);
  if (threadIdx.x < 4) bst[threadIdx.x] = 0u;
  __syncthreads();
  XcdBarrier xb = xcd_barrier_post((unsigned*)(p.ws + O_BAR), bst);
#define GSYNC() xcd_barrier(xb)
#define RUNP(k, call) do { call; GSYNC(); if (DUPMASK & (1 << (k))) { call; GSYNC(); } } while (0)
  phase0(p, smem, bid, nb); grid.sync();
  if (DUPMASK & 1) { phase0(p, smem, bid, nb); GSYNC(); }
  RUNP(1, phase1(p, smem, bid, nb));
  RUNP(2, phase2(p, smem, bid, nb));
  RUNP(3, phase3(p, smem, bid, nb));
  RUNP(4, phase4(p, bid, nb));
  RUNP(5, phase5(p, smem, bid, nb));
  if (DUPMASK & (1 << 6)) { phase6(p, smem, bid, nb); GSYNC(); phase7(p, bid, nb); GSYNC(); }
  RUNP(14, phase6(p, smem, bid, nb));
  RUNP(14, phase7(p, bid, nb));
  RUNP(8, phase8(p, smem, bid, nb));
  RUNP(14, phase9(p, bid, nb));
  RUNP(10, phase10(p, smem, bid, nb));
  RUNP(11, phase11(p, smem, bid, nb));
  RUNP(12, phase12(p, smem, bid, nb));
  if (DUPMASK & (1 << 13)) { phase13(p, bid, nb); GSYNC(); }
  if (DUPMASK & (1 << 15)) { for (int i = 0; i < 10; ++i) GSYNC(); }
  phase13(p, bid, nb);
}

extern "C" void kernel_launch(void* const* d_in, const int* in_sizes, int n_in, void* d_out, int out_size, void* d_ws, size_t ws_size, hipStream_t stream) {
  if (n_in != 28 || ws_size < WS_NEED) { fprintf(stderr, "kernel_launch: unexpected inputs (%d) or workspace (%zu < %zu)\n", n_in, ws_size, (size_t)WS_NEED); return; }
  static int grid_blocks = 0;
  if (!grid_blocks) {
    int dev = 0, cus = 0, per_cu = 0;
    (void)hipGetDevice(&dev);
    (void)hipDeviceGetAttribute(&cus, hipDeviceAttributeMultiprocessorCount, dev);
    (void)hipFuncSetAttribute((const void*)mega_kernel, hipFuncAttributeMaxDynamicSharedMemorySize, LDS_BYTES);
    (void)hipOccupancyMaxActiveBlocksPerMultiprocessor(&per_cu, (const void*)mega_kernel, NTHR, LDS_BYTES);
    if (per_cu < 1) per_cu = 1;
    if (per_cu > 1) per_cu = 1;
    grid_blocks = cus * per_cu;
    if (grid_blocks < 32) grid_blocks = 32;
  }
  Params p{};
  for (int i = 0; i < 28; ++i) p.in[i] = (const float*)d_in[i];
  p.out = (float*)d_out; p.ws = (unsigned char*)d_ws;
  (void)hipMemsetAsync((unsigned char*)d_ws + O_BAR, 0, XCD_BAR_WORDS * 4, stream);
  void* args[] = {&p};
  hipError_t e = hipLaunchCooperativeKernel((const void*)mega_kernel, dim3(grid_blocks), dim3(NTHR), args, LDS_BYTES, stream);
  if (e != hipSuccess) fprintf(stderr, "cooperative launch failed: %s (grid %d)\n", hipGetErrorString(e), grid_blocks);
}
```

```cpp
#include <hip/hip_runtime.h>
#include <hip/hip_cooperative_groups.h>
#include <stdint.h>
#include <stdio.h>
namespace cg = cooperative_groups;

#define DI __device__ __forceinline__
#define LAS __attribute__((address_space(3)))
typedef unsigned short bf16_t;
typedef short bf16x8 __attribute__((ext_vector_type(8)));
typedef float f32x4 __attribute__((ext_vector_type(4)));
typedef unsigned u32x4 __attribute__((ext_vector_type(4)));
typedef unsigned u32x2 __attribute__((ext_vector_type(2)));

constexpr int NTHR = 512;
constexpr int T = 16384, SEQ = 8192, D = 1024;
constexpr int NPROJ = 6656;
constexpr int DIN = 6664;
constexpr int NEXP = 256, DEXP = 256;
constexpr int MAXSLOT = 131072 + 256 * 256;
constexpr float ALPHA = 1.189207115002721f;
constexpr int LDS_BYTES = 157696;

constexpr size_t MB = 1u << 20;
constexpr size_t O_WGU = 0;
constexpr size_t O_WD = 256 * MB;
constexpr size_t O_WSGU = 384 * MB;
constexpr size_t O_WSD = 385 * MB;
constexpr size_t O_ROUT = 385 * MB + 512 * 1024;
constexpr size_t O_CTRL = 386 * MB;
constexpr size_t O_BAR = 386 * MB + 128 * 1024;
constexpr int CSTR = 64;
constexpr size_t O_IDENT = 386 * MB + 256 * 1024;
constexpr size_t O_X1 = 387 * MB;
constexpr size_t O_X1B = 451 * MB;
constexpr size_t R0 = 483 * MB;
constexpr size_t O_XB = R0 + 0;
constexpr size_t O_ST = R0 + 0;
constexpr size_t O_WINT = R0 + 32 * MB;
constexpr size_t O_WAT = R0 + 45 * MB;
constexpr size_t O_WBT = R0 + 46 * MB;
constexpr size_t O_WCT = R0 + 47 * MB;
constexpr size_t O_WOT = R0 + 48 * MB;
constexpr size_t O_WMKV = R0 + 50 * MB;
constexpr size_t O_MEMB = R0 + 52 * MB;
constexpr size_t O_SGUW = R0 + 53 * MB;
constexpr size_t O_AB = R0 + 53 * MB + 512 * 1024;
constexpr size_t O_MEMK = R0 + 54 * MB;
constexpr size_t O_MEMVT = R0 + 54 * MB + 512 * 1024;
constexpr size_t O_QKV = R0 + 55 * MB;
constexpr size_t O_PART = R0 + 55 * MB;
constexpr size_t O_ZS = R0 + 103 * MB;
constexpr size_t O_UVG = R0 + 119 * MB;
constexpr size_t O_MERGED = R0 + 119 * MB;
constexpr size_t O_XQ = R0 + 151 * MB;
constexpr size_t O_GATES = R0 + 167 * MB;
constexpr size_t O_MP = R0 + 263 * MB;
constexpr size_t O_BC = R0 + 295 * MB;
constexpr size_t O_O0 = R0 + 359 * MB;
constexpr size_t O_QP = R0 + 391 * MB;
constexpr size_t O_GL = R0 + 407 * MB;
constexpr size_t O_GDNO = R0 + 408 * MB;
constexpr size_t O_SGUO = R0 + 424 * MB;
constexpr size_t O_XATO = R0 + 440 * MB;
constexpr size_t O_LOGITS = R0 + 0;
constexpr size_t O_TKIDX = R0 + 16 * MB;
constexpr size_t O_TKW = R0 + 16 * MB + 512 * 1024;
constexpr size_t O_TKPOS = R0 + 17 * MB;
constexpr size_t O_SLOTTOK = R0 + 18 * MB;
constexpr size_t O_SLOTW = R0 + 19 * MB;
constexpr size_t O_SLOTAID = R0 + 20 * MB;
constexpr size_t O_ACT = R0 + 21 * MB;
constexpr size_t O_ACTSH = R0 + 117 * MB;
constexpr size_t O_YSH = R0 + 125 * MB;
constexpr size_t O_Y = R0 + 157 * MB;
constexpr size_t WS_NEED = R0 + 456 * MB;

struct Params {
  const float* in[28];
  float* out;
  unsigned char* ws;
};
enum { I_X = 0, I_MEM, I_WIN, I_CONVW, I_ALOG, I_DTB, I_GNG, I_WA, I_SLNG, I_SLNB, I_SGUW, I_SGUB, I_WB, I_WMKV, I_WC, I_WO,
       I_LN1G, I_LN1B, I_RW, I_RB, I_WG, I_WU, I_WDN, I_WSG, I_WSU, I_WSD, I_LN2G, I_LN2B };

constexpr int PTAB_OFF = 156672;
DI float bf2f(bf16_t h) { return __uint_as_float(((unsigned)h) << 16); }
DI bf16_t f2bf(float f) { unsigned u = __float_as_uint(f); u += 0x7fffu + ((u >> 16) & 1u); return (bf16_t)(u >> 16); }
DI unsigned pk2(float lo, float hi) { unsigned r; asm("v_cvt_pk_bf16_f32 %0, %1, %2" : "=v"(r) : "v"(lo), "v"(hi)); return r; }
DI float lo2f(unsigned u) { return __uint_as_float(u << 16); }
DI float hi2f(unsigned u) { return __uint_as_float(u & 0xffff0000u); }
DI float sigmoidf_(float x) { return 1.f / (1.f + __expf(-x)); }
DI float siluf_(float x) { return x / (1.f + __expf(-x)); }
DI float geluf_(float x) { float u = 0.7978845608028654f * (x + 0.044715f * x * x * x); float t = 1.f - 2.f / (__expf(2.f * u) + 1.f); return 0.5f * x * (1.f + t); }
DI float softplusf_(float x) { return fmaxf(x, 0.f) + log1pf(__expf(-fabsf(x))); }
DI float wave_sum(float v) {
#pragma unroll
  for (int o = 32; o; o >>= 1) v += __shfl_xor(v, o);
  return v;
}
DI f32x4 mfma16(bf16x8 a, bf16x8 b, f32x4 c) { return __builtin_amdgcn_mfma_f32_16x16x32_bf16(a, b, c, 0, 0, 0); }
DI bf16x8 ldfrag(const void* p) { return __builtin_bit_cast(bf16x8, *(const u32x4*)p); }
DI bf16x8 pack8(f32x4 a, f32x4 b) { u32x4 r = {pk2(a[0], a[1]), pk2(a[2], a[3]), pk2(b[0], b[1]), pk2(b[2], b[3])}; return __builtin_bit_cast(bf16x8, r); }
DI u32x2 pack4(f32x4 a) { u32x2 r = {pk2(a[0], a[1]), pk2(a[2], a[3])}; return r; }
DI int sw128(int row, int chunk) { return row * 128 + ((chunk ^ (row & 7)) << 4); }
DI int sw256(int row, int chunk) { return row * 256 + ((chunk ^ (row & 15)) << 4); }

namespace pg {
#define PG_LAS __attribute__((address_space(3)))
constexpr int BM = 256, BK = 64, HALF = 128, HTB = HALF * BK * 2, NXCD = 8, WGM = 8;
DI int lds_byte(int r, int c) { const int st = (r >> 4) * 2 + (c >> 5), rr = r & 15, cc = c & 31, ob = rr * 64 + cc * 2; return st * 1024 + (ob ^ (((ob >> 9) & 1) << 5)); }
DI void stage_rc(int b, int& R, int& C) { const int st = b / 1024, sb = b % 1024, swz = sb ^ (((sb >> 9) & 1) << 5); R = (st >> 1) * 16 + swz / 64; C = (st & 1) * 32 + (swz % 64) / 2; }

struct Unit { const char* a; const char* b; const int* rows; int pm, pn, e; };

struct DenseOrder {
  const char* A; const char* B; int nM, nN, nwg, G, c; size_t tstep;
  DI void init(const void* A_, const void* B_, int M, int N, int K, int G_, int c_) { A = (const char*)A_; B = (const char*)B_; nM = M / BM; nN = N / BM; nwg = nM * nN; G = G_; c = c_; tstep = (size_t)BM * K * 2; }
  DI bool next(int i, Unit& u) const {
    const long L = (long)i * G + c; if (L >= nwg) return false;
    int wgid = (int)L; { const int q = nwg / NXCD, r = nwg % NXCD, xcd = wgid % NXCD, off = wgid / NXCD; wgid = (xcd < r ? xcd * (q + 1) : r * (q + 1) + (xcd - r) * q) + off; }
    const int nig = WGM * nN, gid = wgid / nig, fm = gid * WGM, gsz = (nM - fm) < WGM ? (nM - fm) : WGM;
    u.pm = fm + ((wgid % nig) % gsz); u.pn = (wgid % nig) / gsz; u.e = 0; u.rows = nullptr;
    u.a = A + (size_t)u.pm * tstep; u.b = B + (size_t)u.pn * tstep; return true;
  }
};

template <class Epi, class Sched, bool GATHER, bool ALIGN_EPI>
DI void gemm_phase(PG_LAS unsigned char* lds, const int K, const Sched& S, const Epi& E) {
  int tid = threadIdx.x; asm volatile("" : "+v"(tid));
  const int wid = __builtin_amdgcn_readfirstlane(tid >> 6), lane = tid & 63, wr = wid >> 2, wc = wid & 3, fr = lane & 15, fq = lane >> 4;
  const int nt = K / BK;
  int Rr[2], Cc[2];
  unsigned voffB[2];
#pragma unroll
  for (int i = 0; i < 2; ++i) { stage_rc(tid * 16 + i * 8192, Rr[i], Cc[i]); voffB[i] = (unsigned)(Rr[i] * K + Cc[i]) * 2u; }
  const size_t kstep = (size_t)(BK * 2);
  const size_t hstep = (size_t)HALF * K * 2;
  const unsigned ldsw = (unsigned)wid * 1024u;
  const int aoff = lds_byte(wr * 64 + fr, fq * 8), boff = lds_byte(wc * 32 + fr, fq * 8);
#define PG_SA(b, h) (((b) * 2 + (h)) * HTB)
#define PG_SB(b, h) ((4 + (b) * 2 + (h)) * HTB)
#define PG_STAGE(bufoff, gbase, v0, v1) do { \
    __builtin_amdgcn_global_load_lds((const unsigned*)((const char*)(gbase) + (v0)), (PG_LAS unsigned*)(lds + (bufoff) + ldsw), 16, 0, 0); \
    __builtin_amdgcn_global_load_lds((const unsigned*)((const char*)(gbase) + (v1)), (PG_LAS unsigned*)(lds + (bufoff) + ldsw + 8192), 16, 0, 0); } while (0)
#define PG_LDA(dst, b, h) do { _Pragma("unroll") for (int m = 0; m < 4; ++m) _Pragma("unroll") for (int k = 0; k < 2; ++k) dst[m][k] = *(const PG_LAS bf16x8*)(lds + PG_SA(b, h) + aoff + m * 2048 + k * 1024); } while (0)
#define PG_LDB(dst, b, h) do { _Pragma("unroll") for (int n = 0; n < 2; ++n) _Pragma("unroll") for (int k = 0; k < 2; ++k) dst[n][k] = *(const PG_LAS bf16x8*)(lds + PG_SB(b, h) + boff + n * 2048 + k * 1024); } while (0)
#define PG_MMA(ai, bj, At, Bt) do { __builtin_amdgcn_s_setprio(1); _Pragma("unroll") for (int m = 0; m < 4; ++m) _Pragma("unroll") for (int n = 0; n < 2; ++n) _Pragma("unroll") for (int k = 0; k < 2; ++k) \
    acc[ai][bj][m][n] = __builtin_amdgcn_mfma_f32_16x16x32_bf16(Bt[n][k], At[m][k], acc[ai][bj][m][n], 0, 0, 0); __builtin_amdgcn_s_setprio(0); } while (0)
#define PG_WAIT_V(n) asm volatile("s_waitcnt vmcnt(" #n ")" ::: "memory")
#define PG_WAIT_L(n) asm volatile("s_waitcnt lgkmcnt(" #n ")" ::: "memory")
#define PG_BAR __builtin_amdgcn_s_barrier()
#define PG_SCHED __builtin_amdgcn_sched_barrier(0)
#define PG_AOFFS(u, o00, o01, o10, o11) do { if (GATHER) { \
      o00 = (unsigned)(u).rows[Rr[0]] * (unsigned)(K * 2) + (unsigned)Cc[0] * 2u; o01 = (unsigned)(u).rows[Rr[1]] * (unsigned)(K * 2) + (unsigned)Cc[1] * 2u; \
      o10 = (unsigned)(u).rows[128 + Rr[0]] * (unsigned)(K * 2) + (unsigned)Cc[0] * 2u; o11 = (unsigned)(u).rows[128 + Rr[1]] * (unsigned)(K * 2) + (unsigned)Cc[1] * 2u; \
    } else { o00 = voffB[0]; o01 = voffB[1]; o10 = voffB[0] + (unsigned)hstep; o11 = voffB[1] + (unsigned)hstep; } } while (0)
  Unit cur, nxt; int ui = 0;
  if (!S.next(0, cur)) return;
  f32x4 acc[2][2][4][2];
#pragma unroll
  for (int a = 0; a < 2; ++a)
#pragma unroll
    for (int b = 0; b < 2; ++b)
#pragma unroll
      for (int m = 0; m < 4; ++m)
#pragma unroll
        for (int n = 0; n < 2; ++n) acc[a][b][m][n] = (f32x4){0.f, 0.f, 0.f, 0.f};
  bf16x8 At[4][2], B0[2][2], B1[2][2];
  const char* cA = cur.a; const char* cB = cur.b;
  unsigned c00, c01, c10, c11;
  PG_AOFFS(cur, c00, c01, c10, c11);
  const unsigned vb0 = voffB[0], vb1 = voffB[1];
  PG_STAGE(PG_SB(0, 0), cB, vb0, vb1); PG_STAGE(PG_SB(0, 1), cB + hstep, vb0, vb1); PG_STAGE(PG_SA(0, 0), cA, c00, c01); PG_STAGE(PG_SA(0, 1), cA, c10, c11);
  if (wr == 1) PG_BAR;
  PG_WAIT_V(2); PG_BAR;
  PG_STAGE(PG_SB(1, 0), cB + kstep, vb0, vb1); PG_STAGE(PG_SA(1, 0), cA + kstep, c00, c01); PG_STAGE(PG_SB(1, 1), cB + hstep + kstep, vb0, vb1);
  PG_WAIT_V(6); PG_BAR;
  for (;;) {
    const bool has_next = S.next(ui + 1, nxt);
    const char* nA = has_next ? nxt.a : cA; const char* nB = has_next ? nxt.b : cB;
    unsigned n00 = c00, n01 = c01, n10 = c10, n11 = c11;
    if (has_next) PG_AOFFS(nxt, n00, n01, n10, n11);
#pragma unroll 1
    for (int t = 0; t < nt; t += 2) {
      const bool last = (t == nt - 2);
      const char* a1 = cA + (size_t)(t + 1) * kstep;
      const char* a2 = last ? nA : cA + (size_t)(t + 2) * kstep; const char* b2 = last ? nB : cB + (size_t)(t + 2) * kstep;
      const char* a3 = a2 + kstep; const char* b3 = b2 + kstep;
      const unsigned o00 = last ? n00 : c00, o01 = last ? n01 : c01, o10 = last ? n10 : c10, o11 = last ? n11 : c11;
      PG_LDB(B0, 0, 0); PG_LDB(B1, 0, 1); PG_SCHED; PG_LDA(At, 0, 0); PG_STAGE(PG_SA(1, 1), a1, c10, c11);
      PG_WAIT_V(8); PG_WAIT_L(0); PG_BAR; PG_MMA(0, 0, At, B0); PG_MMA(0, 1, At, B1); PG_BAR; PG_SCHED;
      PG_LDA(At, 0, 1); PG_STAGE(PG_SB(0, 0), b2, vb0, vb1); PG_STAGE(PG_SB(0, 1), b2 + hstep, vb0, vb1); PG_STAGE(PG_SA(0, 0), a2, o00, o01);
      PG_WAIT_V(8); PG_WAIT_L(0); PG_BAR; PG_MMA(1, 0, At, B0); PG_MMA(1, 1, At, B1); PG_BAR; PG_SCHED;
      PG_LDB(B0, 1, 0); PG_LDB(B1, 1, 1); PG_SCHED; PG_LDA(At, 1, 0); PG_STAGE(PG_SA(0, 1), a2, o10, o11);
      PG_WAIT_V(8); PG_WAIT_L(0); PG_BAR; PG_MMA(0, 0, At, B0); PG_MMA(0, 1, At, B1); PG_BAR; PG_SCHED;
      PG_LDA(At, 1, 1); PG_STAGE(PG_SB(1, 0), b3, vb0, vb1); PG_STAGE(PG_SB(1, 1), b3 + hstep, vb0, vb1); PG_STAGE(PG_SA(1, 0), a3, o00, o01);
      PG_WAIT_V(8); PG_WAIT_L(0); PG_BAR; PG_MMA(1, 0, At, B0); PG_MMA(1, 1, At, B1); PG_BAR; PG_SCHED;
    }
    if constexpr (ALIGN_EPI) { if (wr == 0) PG_BAR; }
    E(acc, cur, wr, wc, fr, fq);
    if (!has_next) break;
#pragma unroll
    for (int a = 0; a < 2; ++a)
#pragma unroll
      for (int b = 0; b < 2; ++b)
#pragma unroll
        for (int m = 0; m < 4; ++m)
#pragma unroll
          for (int n = 0; n < 2; ++n) acc[a][b][m][n] = (f32x4){0.f, 0.f, 0.f, 0.f};
    cur = nxt; cA = nA; cB = nB; c00 = n00; c01 = n01; c10 = n10; c11 = n11; ++ui;
    if constexpr (ALIGN_EPI) { if (wr == 1) PG_BAR; }
  }
  PG_WAIT_V(0);
  if constexpr (!ALIGN_EPI) { if (wr == 0) PG_BAR; }
  PG_BAR;
#undef PG_SA
#undef PG_SB
#undef PG_STAGE
#undef PG_LDA
#undef PG_LDB
#undef PG_MMA
#undef PG_WAIT_V
#undef PG_WAIT_L
#undef PG_BAR
#undef PG_SCHED
#undef PG_AOFFS
}
}

#define XB_TMO      128
#define XB_XCNT(j)  (256  + 64 * (j))
#define XB_XSUB(j)  (1280 + 64 * (j))
#define XB_XGEN(j)  (2304 + 64 * (j))
#define XB_TOP      3328
#define XB_TOPGEN   3392
#define XCD_BAR_WORDS 3456
#define XB_SPIN_CAP (1u << 22)
DI unsigned xb_ld(unsigned* p)              { return __hip_atomic_load(p, __ATOMIC_RELAXED, __HIP_MEMORY_SCOPE_AGENT); }
DI unsigned xb_add(unsigned* p, unsigned v) { return __hip_atomic_fetch_add(p, v, __ATOMIC_RELAXED, __HIP_MEMORY_SCOPE_AGENT); }
DI unsigned xb_xcc_id() { return (unsigned)__builtin_amdgcn_s_getreg((3 << 11) | 20) & 0xFu; }
#define XB_SPIN(cond, bar) do { unsigned _sp = 0; while (cond) { __builtin_amdgcn_s_sleep(1); \
    if ((++_sp & 255u) == 0u) { if (xb_ld(&(bar)[XB_TMO])) break; if (_sp > XB_SPIN_CAP) { atomicAdd(&(bar)[XB_TMO], 1u); break; } } } } while (0)
struct XcdBarrier { unsigned* bar; unsigned x; volatile LAS unsigned* st; };
DI XcdBarrier xcd_barrier_post(unsigned* bar, volatile LAS unsigned* st) {
  XcdBarrier b; b.bar = bar; b.x = xb_xcc_id(); b.st = st;
  if (threadIdx.x == 0) (void)xb_add(&bar[XB_XCNT(b.x)], 1u);
  return b;
}
DI void xcd_barrier_complete(unsigned* bar, unsigned x, unsigned& nloc, unsigned& nx) {
  const unsigned G = gridDim.x * gridDim.y * gridDim.z;
  unsigned sum, cnt, mine, sp = 0u;
  for (;;) {
    sum = 0u; cnt = 0u; mine = 0u;
#pragma unroll
    for (unsigned j = 0; j < 16; ++j) { const unsigned c = xb_ld(&bar[XB_XCNT(j)]); sum += c; cnt += (c > 0u) ? 1u : 0u; mine = (j == x) ? c : mine; }
    if (sum == G) break;
    __builtin_amdgcn_s_sleep(1);
    if ((++sp & 255u) == 0u) { if (xb_ld(&bar[XB_TMO])) break; if (sp > XB_SPIN_CAP) { atomicAdd(&bar[XB_TMO], 1u); break; } }
  }
  nloc = mine > 0u ? mine : 1u; nx = cnt > 0u ? cnt : 1u;
}
DI void xcd_barrier(const XcdBarrier& b) {
  asm volatile("s_waitcnt vmcnt(0)" ::: "memory");
  __syncthreads();
  if (threadIdx.x == 0) {
    unsigned* bar = b.bar;
    __builtin_amdgcn_s_waitcnt(0);
    unsigned nloc = b.st[0], nx = b.st[1];
    if (nloc == 0u) { xcd_barrier_complete(bar, b.x, nloc, nx); b.st[0] = nloc; b.st[1] = nx; }
    const unsigned old = xb_add(&bar[XB_XSUB(b.x)], 1u);
    const unsigned gen = old / nloc;
    if (old + 1u == (gen + 1u) * nloc) {
      __builtin_amdgcn_fence(__ATOMIC_RELEASE, "agent");
      asm volatile("s_waitcnt vmcnt(0)" ::: "memory");
      const unsigned og = xb_add(&bar[XB_TOP], 1u);
      const unsigned tg = og / nx;
      if (og + 1u == (tg + 1u) * nx) xb_add(&bar[XB_TOPGEN], 1u);
      else XB_SPIN(xb_ld(&bar[XB_TOPGEN]) == tg, bar);
      __builtin_amdgcn_fence(__ATOMIC_ACQUIRE, "agent");
      xb_add(&bar[XB_XGEN(b.x)], 1u);
      asm volatile("s_waitcnt vmcnt(0)" ::: "memory");
    } else {
      XB_SPIN(xb_ld(&bar[XB_XGEN(b.x)]) == gen, bar);
      __builtin_amdgcn_fence(__ATOMIC_ACQUIRE, "agent");
      asm volatile("s_waitcnt vmcnt(0)" ::: "memory");
    }
  }
  __syncthreads();
}

DI void transpose_tile(float* tile, const float* s0, const float* s1, const float* s2, const float* s3, int ld, bf16_t* dst, int ldd) {
  int tid = threadIdx.x; asm volatile("" : "+v"(tid));
  const int kr = tid >> 4, nc = tid & 15, sg = nc >> 2;
  const float* sp = sg == 0 ? s0 : sg == 1 ? s1 : sg == 2 ? s2 : s3;
  const f32x4 v0 = *(const f32x4*)(sp + (size_t)kr * ld + 4 * (nc & 3));
  const f32x4 v1 = *(const f32x4*)(sp + (size_t)(kr + 32) * ld + 4 * (nc & 3));
  __syncthreads();
  float* t0 = tile + kr * 65 + 4 * nc;
  float* t1 = tile + (kr + 32) * 65 + 4 * nc;
  t0[0] = v0[0]; t0[1] = v0[1]; t0[2] = v0[2]; t0[3] = v0[3];
  t1[0] = v1[0]; t1[1] = v1[1]; t1[2] = v1[2]; t1[3] = v1[3];
  __syncthreads();
  const int n = tid >> 3, kc = tid & 7;
  float e[8];
#pragma unroll
  for (int j = 0; j < 8; ++j) e[j] = tile[(8 * kc + j) * 65 + n];
  u32x4 o = {pk2(e[0], e[1]), pk2(e[2], e[3]), pk2(e[4], e[5]), pk2(e[6], e[7])};
  *(u32x4*)(dst + (size_t)n * ldd + 8 * kc) = o;
}

DI void phase0(const Params& p, unsigned char* smem, int bid, int nb) {
  int tid = threadIdx.x; asm volatile("" : "+v"(tid));
  const int lane = tid & 63, wave = tid >> 6;
  unsigned char* ws = p.ws;
  if (bid == 0 && tid < 256) ((int*)(ws + O_CTRL))[tid * CSTR] = 0;
  for (int i = bid * NTHR + tid; i < T; i += nb * NTHR) ((int*)(ws + O_IDENT))[i] = i;
  {
    float* wabT = (float*)smem;
    const float* win = p.in[I_WIN];
    for (int i = tid; i < 8192; i += NTHR) { const int k = i >> 3, j = i & 7; wabT[j * 1024 + k] = win[(size_t)k * DIN + 2048 + j]; }
    __syncthreads();
    const float* x = p.in[I_X];
    bf16_t* xb = (bf16_t*)(ws + O_XB);
    float* ab = (float*)(ws + O_AB);
    for (int row = bid * 8 + wave; row < T; row += nb * 8) {
      float s[8];
#pragma unroll
      for (int j = 0; j < 8; ++j) s[j] = 0.f;
#pragma unroll
      for (int i = 0; i < 4; ++i) {
        const int k = 256 * i + 4 * lane;
        const f32x4 v = *(const f32x4*)(x + (size_t)row * D + k);
        *(u32x2*)(xb + (size_t)row * D + k) = pack4(v);
#pragma unroll
        for (int j = 0; j < 8; ++j) { const f32x4 w = *(const f32x4*)(wabT + j * 1024 + k); s[j] += v[0] * w[0] + v[1] * w[1] + v[2] * w[2] + v[3] * w[3]; }
      }
#pragma unroll
      for (int j = 0; j < 8; ++j) s[j] = wave_sum(s[j]);
      if (lane == 0) { *(f32x4*)(ab + (size_t)row * 8) = (f32x4){s[0], s[1], s[2], s[3]}; *(f32x4*)(ab + (size_t)row * 8 + 4) = (f32x4){s[4], s[5], s[6], s[7]}; }
    }
    const float* mem = p.in[I_MEM];
    bf16_t* memb = (bf16_t*)(ws + O_MEMB);
    for (int row = bid * 8 + wave; row < 512; row += nb * 8) {
#pragma unroll
      for (int i = 0; i < 4; ++i) { const int k = 256 * i + 4 * lane; *(u32x2*)(memb + (size_t)row * D + k) = pack4(*(const f32x4*)(mem + (size_t)row * D + k)); }
    }
    const float* sw = p.in[I_SGUW];
    bf16_t* sguw = (bf16_t*)(ws + O_SGUW);
    for (int i = bid * NTHR + tid; i < 16384; i += nb * NTHR) {
      const int e0 = i * 4; const int col = e0 & 127, rowi = (e0 >> 7) & 127;
      f32x4 v = *(const f32x4*)(sw + e0);
#pragma unroll
      for (int c = 0; c < 4; ++c) if (col + c > rowi) v[c] = 0.f;
      *(u32x2*)(sguw + e0) = pack4(v);
    }
    __syncthreads();
  }
  {
    float* tile = (float*)smem;
    const float *pwa = p.in[I_WA], *pwb = p.in[I_WB], *pwc = p.in[I_WC], *pwo = p.in[I_WO], *pwmkv = p.in[I_WMKV];
    asm volatile("" : "+s"(pwa), "+s"(pwb), "+s"(pwc), "+s"(pwo), "+s"(pwmkv));
    constexpr int J0 = 1664, J1 = J0 + 128, J2 = J1 + 128, J3 = J2 + 128, J4 = J3 + 256, J5 = J4 + 256, J6 = J5 + 64, J7 = J6 + 128, J8 = J7 + 64,
                  J9 = J8 + 32768, J10 = J9 + 16384;
    for (int it = bid; it < J10; it += nb) {
      const float *s0, *s1, *s2, *s3; int ld, ldd; bf16_t* dst;
      if (it < J0) {
        const int kt = it & 15, nt = it >> 4; const int n0 = nt * 64; const int c0 = n0 + (n0 >= 2048 ? 8 : 0);
        const float* b = p.in[I_WIN] + (size_t)kt * 64 * DIN + c0; s0 = b; s1 = b + 16; s2 = b + 32; s3 = b + 48; ld = DIN; ldd = 1024;
        dst = (bf16_t*)(ws + O_WINT) + (size_t)n0 * 1024 + kt * 64;
      } else if (it < J3) {
        const int which = (it - J0) >> 7, r = (it - J0) & 127; const int kt = r & 7, nt = r >> 3;
        const float* src = which == 0 ? pwa : which == 1 ? pwb : pwc;
        const float* b = src + (size_t)kt * 64 * 1024 + nt * 64; s0 = b; s1 = b + 16; s2 = b + 32; s3 = b + 48; ld = 1024; ldd = 512;
        dst = (bf16_t*)(ws + (which == 0 ? O_WAT : which == 1 ? O_WBT : O_WCT)) + (size_t)nt * 64 * 512 + kt * 64;
      } else if (it < J5) {
        const int which = (it - J3) >> 8, r = (it - J3) & 255; const int kt = r & 15, nt = r >> 4;
        const float* b = (which == 0 ? pwo : pwmkv) + (size_t)kt * 64 * 1024 + nt * 64; s0 = b; s1 = b + 16; s2 = b + 32; s3 = b + 48; ld = 1024; ldd = 1024;
        dst = (bf16_t*)(ws + (which == 0 ? O_WOT : O_WMKV)) + (size_t)nt * 64 * 1024 + kt * 64;
      } else if (it < J6) {
        const int r = it - J5; const int kt = r & 15, nt = r >> 4;
        const float* b = p.in[I_RW] + (size_t)kt * 64 * 256 + nt * 64; s0 = b; s1 = b + 16; s2 = b + 32; s3 = b + 48; ld = 256; ldd = 1024;
        dst = (bf16_t*)(ws + O_ROUT) + (size_t)nt * 64 * 1024 + kt * 64;
      } else if (it < J7) {
        const int r = it - J6; const int kt = r & 15, nt = r >> 4;
        const float* g = p.in[I_WSG] + (size_t)kt * 64 * 256 + nt * 32; const float* u = p.in[I_WSU] + (size_t)kt * 64 * 256 + nt * 32;
        s0 = g; s1 = u; s2 = g + 16; s3 = u + 16; ld = 256; ldd = 1024;
        dst = (bf16_t*)(ws + O_WSGU) + (size_t)nt * 64 * 1024 + kt * 64;
      } else if (it < J8) {
        const int r = it - J7; const int kt = r & 3, nt = r >> 2;
        const float* b = p.in[I_WSD] + (size_t)kt * 64 * 1024 + nt * 64; s0 = b; s1 = b + 16; s2 = b + 32; s3 = b + 48; ld = 1024; ldd = 256;
        dst = (bf16_t*)(ws + O_WSD) + (size_t)nt * 64 * 256 + kt * 64;
      } else if (it < J9) {
        const int r = it - J8; const int e = r >> 7, q = r & 127; const int kt = q & 15, nt = q >> 4;
        const float* g = p.in[I_WG] + (size_t)e * 262144 + (size_t)kt * 64 * 256 + nt * 32; const float* u = p.in[I_WU] + (size_t)e * 262144 + (size_t)kt * 64 * 256 + nt * 32;
        s0 = g; s1 = u; s2 = g + 16; s3 = u + 16; ld = 256; ldd = 1024;
        dst = (bf16_t*)(ws + O_WGU) + (size_t)e * 524288 + (size_t)nt * 64 * 1024 + kt * 64;
      } else {
        const int r = it - J9; const int e = r >> 6, q = r & 63; const int kt = q & 3, nt = q >> 2;
        const float* b = p.in[I_WDN] + (size_t)e * 262144 + (size_t)kt * 64 * 1024 + nt * 64; s0 = b; s1 = b + 16; s2 = b + 32; s3 = b + 48; ld = 1024; ldd = 256;
        dst = (bf16_t*)(ws + O_WD) + (size_t)e * 262144 + (size_t)nt * 64 * 256 + kt * 64;
      }
      transpose_tile(tile, s0, s1, s2, s3, ld, dst, ldd);
    }
  }
}

#define EPI_ROWS(u) const int row_ = (u).pm * 256 + 64 * wr + fr
struct EpiInProj {
  unsigned char* ws;
  DI void operator()(const f32x4 (&acc)[2][2][4][2], const pg::Unit& u, int wr, int wc, int fr, int fq) const {
    const int colt = u.pn * 256;
#pragma unroll
    for (int ai = 0; ai < 2; ++ai)
#pragma unroll
      for (int m = 0; m < 4; ++m) {
        const size_t row = (size_t)u.pm * 256 + 128 * ai + 64 * wr + 16 * m + fr;
#pragma unroll
        for (int bj = 0; bj < 2; ++bj)
#pragma unroll
          for (int n = 0; n < 2; ++n) {
            const int col = colt + 128 * bj + 32 * wc + 16 * n + 4 * fq;
            f32x4 v = acc[ai][bj][m][n];
            if (colt < 1536) { *(u32x2*)((bf16_t*)(ws + O_QKV) + row * 1536 + col) = pack4(v); }
            else if (colt < 2048) {
#pragma unroll
              for (int c = 0; c < 4; ++c) v[c] = siluf_(v[c]);
              *(u32x2*)((bf16_t*)(ws + O_ZS) + row * 512 + (col - 1536)) = pack4(v);
            } else if (colt < 3072) {
#pragma unroll
              for (int c = 0; c < 4; ++c) v[c] = geluf_(v[c]);
              *(u32x2*)((bf16_t*)(ws + O_UVG) + row * 1024 + (col - 2048)) = pack4(v);
            } else if (colt < 3584) {
#pragma unroll
              for (int c = 0; c < 4; ++c) v[c] *= 0.08838834764831845f;
              *(u32x2*)((bf16_t*)(ws + O_XQ) + row * 512 + (col - 3072)) = pack4(v);
            } else {
#pragma unroll
              for (int c = 0; c < 4; ++c) v[c] = sigmoidf_(v[c]);
              *(u32x2*)((bf16_t*)(ws + O_GATES) + row * 3072 + (col - 3584)) = pack4(v);
            }
          }
      }
  }
};
struct EpiMemKV {
  unsigned char* ws;
  DI void operator()(const f32x4 (&acc)[2][2][4][2], const pg::Unit& u, int wr, int wc, int fr, int fq) const {
#pragma unroll
    for (int ai = 0; ai < 2; ++ai)
#pragma unroll
      for (int m = 0; m < 4; ++m) {
        const int row = u.pm * 256 + 128 * ai + 64 * wr + 16 * m + fr; const int b = row >> 8, key = row & 255;
#pragma unroll
        for (int bj = 0; bj < 2; ++bj)
#pragma unroll
          for (int n = 0; n < 2; ++n) {
            const int col = u.pn * 256 + 128 * bj + 32 * wc + 16 * n + 4 * fq;
            const f32x4 v = acc[ai][bj][m][n];
            if (col < 512) { const int h = col >> 7, d = col & 127; *(u32x2*)((bf16_t*)(ws + O_MEMK) + ((size_t)((b * 4 + h) * 256 + key)) * 128 + d) = pack4(v); }
            else {
              const int c2 = col - 512; const int h = c2 >> 7, d = c2 & 127;
              const int pos = 32 * (key >> 5) + 8 * ((key >> 2) & 3) + 4 * ((key >> 4) & 1) + (key & 3);
              bf16_t* vt = (bf16_t*)(ws + O_MEMVT) + ((size_t)((b * 4 + h) * 128 + d)) * 256 + pos;
#pragma unroll
              for (int c = 0; c < 4; ++c) vt[(size_t)c * 256] = f2bf(v[c]);
            }
          }
      }
  }
};
DI void phase1(const Params& p, unsigned char* smem, int bid, int nb) {
  unsigned char* ws = p.ws;
  PG_LAS unsigned char* lds = (PG_LAS unsigned char*)smem;
  __syncthreads();
  { pg::DenseOrder S; S.init(ws + O_XB, ws + O_WINT, T, NPROJ, 1024, nb, bid); EpiInProj E{ws}; pg::gemm_phase<EpiInProj, pg::DenseOrder, false, true>(lds, 1024, S, E); }
  __syncthreads();
  { pg::DenseOrder S; S.init(ws + O_MEMB, ws + O_WMKV, 512, 1024, 1024, nb, bid); EpiMemKV E{ws}; pg::gemm_phase<EpiMemKV, pg::DenseOrder, false, true>(lds, 1024, S, E); }
}

constexpr int G_KF = 0, G_VF = 32768, G_QB = 65536, G_KB = 81920, G_UT = 81920  , G_L = 98304, G_ATT = 114688, G_KDT = 122880, G_WT = 139264, G_SM = 155648;

DI void gdn_prep_item(const Params& p, unsigned char* smem_, int item) {
  unsigned char* smem; { LAS unsigned char* l_ = (LAS unsigned char*)smem_; asm volatile("" : "+v"(l_)); smem = (unsigned char*)l_; }
  int tid = threadIdx.x; asm volatile("" : "+v"(tid));
  const int lane = tid & 63, wave = tid >> 6, fr = lane & 15, fq = lane >> 4;
  unsigned char* ws = p.ws; asm volatile("" : "+s"(ws));
  const int h = item & 3, cn = item >> 2;
  const int bidx = cn >> 7, n = cn & 127;
  const size_t t0 = (size_t)bidx * SEQ + (size_t)n * 64;
  float* kf = (float*)(smem + G_KF); float* vf = (float*)(smem + G_VF); float* Lm = (float*)(smem + G_L);
  float* sbeta = (float*)(smem + G_SM); float* sgc = sbeta + 64; float* segc = sbeta + 128;
  __syncthreads();
  {
    const bf16_t* qkv = (const bf16_t*)(ws + O_QKV);
    const float* cw = p.in[I_CONVW];
    const int tl0 = wave * 8;
#pragma unroll
    for (int sect = 0; sect < 3; ++sect) {
      const int cb = sect * 512 + h * 128 + 2 * lane;
      float w0[4], w1[4];
#pragma unroll
      for (int i = 0; i < 4; ++i) { w0[i] = cw[i * 1536 + cb]; w1[i] = cw[i * 1536 + cb + 1]; }
      float xa[11], xc[11];
#pragma unroll
      for (int r = 0; r < 11; ++r) {
        const int s = n * 64 + tl0 + r - 3;
        unsigned u = 0u;
        if (s >= 0) u = *(const unsigned*)(qkv + ((size_t)bidx * SEQ + s) * 1536 + cb);
        xa[r] = lo2f(u); xc[r] = hi2f(u);
      }
#pragma unroll
      for (int r = 0; r < 8; ++r) {
        float y0 = w0[0] * xa[r] + w0[1] * xa[r + 1] + w0[2] * xa[r + 2] + w0[3] * xa[r + 3];
        float y1 = w1[0] * xc[r] + w1[1] * xc[r + 1] + w1[2] * xc[r + 2] + w1[3] * xc[r + 3];
        y0 = siluf_(y0); y1 = siluf_(y1);
        const int tl = tl0 + r;
        if (sect == 2) { vf[tl * 128 + 2 * lane] = y0; vf[tl * 128 + 2 * lane + 1] = y1; }
        else {
          const float ss = wave_sum(y0 * y0 + y1 * y1);
          const float sc = rsqrtf(ss + 1e-6f) * (sect == 0 ? 0.08838834764831845f : 1.0f);
          y0 *= sc; y1 *= sc;
          const int off = sw256(tl, lane >> 2) + (lane & 3) * 4;
          if (sect == 0) *(unsigned*)(smem + G_QB + off) = pk2(y0, y1);
          else { *(unsigned*)(smem + G_KB + off) = pk2(y0, y1); kf[tl * 128 + 2 * lane] = y0; kf[tl * 128 + 2 * lane + 1] = y1; }
        }
      }
    }
    if (wave == 0) {
      const float* ab = (const float*)(ws + O_AB) + (t0 + lane) * 8;
      const float a = ab[h], bb = ab[4 + h];
      const float beta = sigmoidf_(bb);
      float g = -__expf(p.in[I_ALOG][h]) * softplusf_(a + p.in[I_DTB][h]);
#pragma unroll
      for (int o = 1; o < 64; o <<= 1) { const float y = __shfl_up(g, o); if (lane >= o) g += y; }
      sbeta[lane] = beta; sgc[lane] = g; segc[lane] = __expf(g);
      if (lane == 63) ((float*)(ws + O_GL))[item] = __expf(g);
    }
  }
  __syncthreads();
  {
#pragma unroll
    for (int q = 0; q < 4; ++q) {
      const int idx = wave * 4 + q; const int isq = idx >> 4, ti = (idx >> 2) & 3, tj = idx & 3;
      f32x4 acc = {0.f, 0.f, 0.f, 0.f};
      if (tj <= ti) {
#pragma unroll
        for (int ks = 0; ks < 4; ++ks) {
          const bf16x8 ai = ldfrag(smem + (isq ? G_QB : G_KB) + sw256(16 * ti + fr, 4 * ks + fq));
          const bf16x8 bj = ldfrag(smem + G_KB + sw256(16 * tj + fr, 4 * ks + fq));
          acc = isq ? mfma16(bj, ai, acc) : mfma16(ai, bj, acc);
        }
      }
      if (isq) {
        const int i = 16 * ti + fr, j0 = 16 * tj + 4 * fq;
        const float gi = sgc[i];
        f32x4 o;
#pragma unroll
        for (int r = 0; r < 4; ++r) { const int j = j0 + r; o[r] = (j <= i) ? acc[r] * __expf(gi - sgc[j]) : 0.f; }
        *(u32x2*)(smem + G_ATT + sw128(i, j0 >> 3) + (j0 & 7) * 2) = pack4(o);
      } else {
        const int j = 16 * tj + fr, i0 = 16 * ti + 4 * fq;
        const float gj = sgc[j];
        f32x4 o;
#pragma unroll
        for (int r = 0; r < 4; ++r) { const int i = i0 + r; o[r] = (j < i) ? acc[r] * __expf(sgc[i] - gj) * sbeta[i] : 0.f; }
        *(f32x4*)(Lm + j * 64 + i0) = o;
      }
    }
  }
  {
    const float gl_ = sgc[63];
    const int d = tid & 127, tg = tid >> 7;
#pragma unroll
    for (int c = 0; c < 2; ++c) {
      float e[8];
#pragma unroll
      for (int j = 0; j < 8; ++j) { const int t = 16 * tg + 8 * c + j; e[j] = kf[t * 128 + d] * __expf(gl_ - sgc[t]); }
      u32x4 o = {pk2(e[0], e[1]), pk2(e[2], e[3]), pk2(e[4], e[5]), pk2(e[6], e[7])};
      *(u32x4*)(smem + G_KDT + sw128(d, 2 * tg + c)) = o;
    }
  }
  __syncthreads();
  if (tid < 256) {
    const bool isw = tid >= 128;
    float* X = isw ? (kf + (tid - 128)) : (vf + tid);
    unsigned char* dstT = smem + (isw ? G_WT : G_UT);
    const int rowc = tid & 127;
#pragma unroll
    for (int b = 0; b < 4; ++b) {
      float xr[16];
#pragma unroll
      for (int r = 0; r < 16; ++r) { const int t = 16 * b + r; float sc = sbeta[t]; if (isw) sc *= segc[t]; xr[r] = X[t * 128] * sc; }
#pragma unroll 2
      for (int j = 0; j < 16 * b; ++j) {
        const float xj = X[j * 128];
        const float* lt = Lm + j * 64 + 16 * b;
        const f32x4 l0 = *(const f32x4*)lt, l1 = *(const f32x4*)(lt + 4), l2 = *(const f32x4*)(lt + 8), l3 = *(const f32x4*)(lt + 12);
#pragma unroll
        for (int r = 0; r < 4; ++r) { xr[r] -= l0[r] * xj; xr[4 + r] -= l1[r] * xj; xr[8 + r] -= l2[r] * xj; xr[12 + r] -= l3[r] * xj; }
      }
#pragma unroll
      for (int q = 0; q < 15; ++q) {
        const float* lt = Lm + (16 * b + q) * 64 + 16 * b;
        float l[16];
#pragma unroll
        for (int g4 = 0; g4 < 4; ++g4) if (4 * g4 + 3 > q) { const f32x4 t4 = *(const f32x4*)(lt + 4 * g4); l[4 * g4] = t4[0]; l[4 * g4 + 1] = t4[1]; l[4 * g4 + 2] = t4[2]; l[4 * g4 + 3] = t4[3]; }
#pragma unroll
        for (int r = q + 1; r < 16; ++r) xr[r] -= l[r] * xr[q];
      }
#pragma unroll
      for (int r = 0; r < 16; ++r) X[(16 * b + r) * 128] = xr[r];
      u32x4 o0 = {pk2(xr[0], xr[1]), pk2(xr[2], xr[3]), pk2(xr[4], xr[5]), pk2(xr[6], xr[7])};
      u32x4 o1 = {pk2(xr[8], xr[9]), pk2(xr[10], xr[11]), pk2(xr[12], xr[13]), pk2(xr[14], xr[15])};
      *(u32x4*)(dstT + sw128(rowc, 2 * b)) = o0;
      *(u32x4*)(dstT + sw128(rowc, 2 * b + 1)) = o1;
    }
  }
  __syncthreads();
  {
    bf16x8 ak[2];
#pragma unroll
    for (int ks = 0; ks < 2; ++ks) ak[ks] = ldfrag(smem + G_KDT + sw128(16 * wave + fr, 4 * ks + fq));
    bf16_t* mp = (bf16_t*)(ws + O_MP) + (size_t)item * 16384;
    float* bc = (float*)(ws + O_BC) + (size_t)item * 16384;
#pragma unroll
    for (int tj = 0; tj < 8; ++tj) {
      f32x4 am = {0.f, 0.f, 0.f, 0.f}, ab_ = {0.f, 0.f, 0.f, 0.f};
#pragma unroll
      for (int ks = 0; ks < 2; ++ks) {
        const bf16x8 bw = ldfrag(smem + G_WT + sw128(16 * tj + fr, 4 * ks + fq));
        const bf16x8 bu = ldfrag(smem + G_UT + sw128(16 * tj + fr, 4 * ks + fq));
        am = mfma16(bw, ak[ks], am);
        ab_ = mfma16(ak[ks], bu, ab_);
      }
      f32x4 nm = {-am[0], -am[1], -am[2], -am[3]};
      *(u32x2*)(mp + ((size_t)((wave * 4 + (tj >> 1)) * 64 + lane)) * 8 + (tj & 1) * 4) = pack4(nm);
      *(f32x4*)(bc + ((size_t)((tj * 8 + wave) * 64 + lane)) * 4) = ab_;
    }
    const int tt = wave & 3, hf = wave >> 2;
    bf16x8 aa[2];
#pragma unroll
    for (int ks = 0; ks < 2; ++ks) aa[ks] = ldfrag(smem + G_ATT + sw128(16 * tt + fr, 4 * ks + fq));
    const int trow = 16 * tt + fr;
    const float eg = segc[trow];
    float* o0 = (float*)(ws + O_O0) + (t0 + trow) * 512 + h * 128;
    bf16_t* qp = (bf16_t*)(ws + O_QP) + (size_t)item * 8192 + trow * 128;
#pragma unroll
    for (int q = 0; q < 4; ++q) {
      const int te = hf * 4 + q;
      f32x4 ao = {0.f, 0.f, 0.f, 0.f}, aw = {0.f, 0.f, 0.f, 0.f};
#pragma unroll
      for (int ks = 0; ks < 2; ++ks) {
        const bf16x8 bu = ldfrag(smem + G_UT + sw128(16 * te + fr, 4 * ks + fq));
        const bf16x8 bw = ldfrag(smem + G_WT + sw128(16 * te + fr, 4 * ks + fq));
        ao = mfma16(bu, aa[ks], ao);
        aw = mfma16(bw, aa[ks], aw);
      }
      const int e0 = 16 * te + 4 * fq;
      *(f32x4*)(o0 + e0) = ao;
      const u32x2 qv = *(const u32x2*)(smem + G_QB + sw256(trow, e0 >> 3) + (e0 & 7) * 2);
      f32x4 qd = {lo2f(qv[0]) * eg - aw[0], hi2f(qv[0]) * eg - aw[1], lo2f(qv[1]) * eg - aw[2], hi2f(qv[1]) * eg - aw[3]};
      *(u32x2*)(qp + e0) = pack4(qd);
    }
  }
}

DI void sgu_item(const Params& p, unsigned char* smem_, int item) {
  unsigned char* smem; { LAS unsigned char* l_ = (LAS unsigned char*)smem_; asm volatile("" : "+v"(l_)); smem = (unsigned char*)l_; }
  int tid = threadIdx.x; asm volatile("" : "+v"(tid));
  const int lane = tid & 63, wave = __builtin_amdgcn_readfirstlane(tid >> 6), fr = lane & 15, fq = lane >> 4;
  unsigned char* ws = p.ws; asm volatile("" : "+s"(ws));
  const int g = item & 3, cn = item >> 2;
  const size_t t0 = (size_t)cn * 128;
  const bf16_t* uvg = (const bf16_t*)(ws + O_UVG);
  __syncthreads();
  {
    const float* lng = p.in[I_SLNG]; const float* lnb = p.in[I_SLNB];
    const int cl0 = 8 * (lane & 15);
    float gg[8], bb[8];
#pragma unroll
    for (int e = 0; e < 8; ++e) { gg[e] = lng[128 * g + cl0 + e]; bb[e] = lnb[128 * g + cl0 + e]; }
    for (int jj = 0; jj < 16; ++jj) {
      const int j = 16 * wave + jj;
      const u32x4 raw = *(const u32x4*)(uvg + (t0 + j) * 1024 + 512 + 8 * lane);
      float v[8];
#pragma unroll
      for (int e = 0; e < 4; ++e) { v[2 * e] = lo2f(raw[e]); v[2 * e + 1] = hi2f(raw[e]); }
      float s = 0.f;
#pragma unroll
      for (int e = 0; e < 8; ++e) s += v[e];
      const float mean = wave_sum(s) * (1.f / 512.f);
      float q = 0.f;
#pragma unroll
      for (int e = 0; e < 8; ++e) { const float d = v[e] - mean; q += d * d; }
      const float rstd = rsqrtf(wave_sum(q) * (1.f / 512.f) + 1e-5f);
      if ((lane >> 4) == g) {
#pragma unroll
        for (int e = 0; e < 8; ++e) {
          const int c = cl0 + e;
          const float y = (v[e] - mean) * rstd * gg[e] + bb[e];
          *(bf16_t*)(smem + sw256(c, j >> 3) + (j & 7) * 2) = f2bf(y);
        }
      }
    }
  }
  __syncthreads();
  {
    const bf16_t* wg = (const bf16_t*)(ws + O_SGUW) + (size_t)g * 16384;
    const int i = 16 * wave + fr;
    bf16x8 af[4];
#pragma unroll
    for (int ks = 0; ks < 4; ++ks) af[ks] = ldfrag(wg + i * 128 + 32 * ks + 8 * fq);
    const float bias = p.in[I_SGUB][g * 128 + i];
    bf16_t* out = (bf16_t*)(ws + O_SGUO) + (t0 + i) * 512 + 128 * g;
    const bf16_t* urow = uvg + (t0 + i) * 1024 + 128 * g;
#pragma unroll
    for (int jt = 0; jt < 8; ++jt) {
      f32x4 acc = {0.f, 0.f, 0.f, 0.f};
#pragma unroll
      for (int ks = 0; ks < 4; ++ks) acc = mfma16(ldfrag(smem + sw256(16 * jt + fr, 4 * ks + fq)), af[ks], acc);
      const int c0 = 16 * jt + 4 * fq;
      const u32x2 uu = *(const u32x2*)(urow + c0);
      f32x4 o = {lo2f(uu[0]) * (acc[0] + bias), hi2f(uu[0]) * (acc[1] + bias), lo2f(uu[1]) * (acc[2] + bias), hi2f(uu[1]) * (acc[3] + bias)};
      *(u32x2*)(out + c0) = pack4(o);
    }
  }
}

DI void xattn_item(const Params& p, int item) {
  int tid = threadIdx.x; asm volatile("" : "+v"(tid));
  const int lane = tid & 63, wave = __builtin_amdgcn_readfirstlane(tid >> 6), fr = lane & 15, fq = lane >> 4;
  unsigned char* ws = p.ws; asm volatile("" : "+s"(ws));
  const int h = item & 3, qt = item >> 2;
  const size_t trow = (size_t)qt * 128 + 16 * wave + fr;
  const int b = (qt * 128) >> 13;
  const bf16_t* xq = (const bf16_t*)(ws + O_XQ) + trow * 512 + h * 128;
  const bf16_t* mk = (const bf16_t*)(ws + O_MEMK) + (size_t)(b * 4 + h) * 32768;
  const bf16_t* mv = (const bf16_t*)(ws + O_MEMVT) + (size_t)(b * 4 + h) * 32768;
  bf16x8 qf[4];
#pragma unroll
  for (int ds = 0; ds < 4; ++ds) qf[ds] = ldfrag(xq + 32 * ds + 8 * fq);
  f32x4 sc[16];
#pragma unroll
  for (int kt = 0; kt < 16; ++kt) {
    f32x4 a = {0.f, 0.f, 0.f, 0.f};
#pragma unroll
    for (int ds = 0; ds < 4; ++ds) a = mfma16(ldfrag(mk + (16 * kt + fr) * 128 + 32 * ds + 8 * fq), qf[ds], a);
    sc[kt] = a;
  }
  float m = -1e30f;
#pragma unroll
  for (int kt = 0; kt < 16; ++kt)
#pragma unroll
    for (int r = 0; r < 4; ++r) m = fmaxf(m, sc[kt][r]);
  m = fmaxf(m, __shfl_xor(m, 16)); m = fmaxf(m, __shfl_xor(m, 32));
  float l = 0.f;
#pragma unroll
  for (int kt = 0; kt < 16; ++kt)
#pragma unroll
    for (int r = 0; r < 4; ++r) { const float e = __expf(sc[kt][r] - m); sc[kt][r] = e; l += e; }
  l += __shfl_xor(l, 16); l += __shfl_xor(l, 32);
  const float inv = 1.f / l;
  bf16x8 pf[8];
#pragma unroll
  for (int s = 0; s < 8; ++s) pf[s] = pack8(sc[2 * s], sc[2 * s + 1]);
  bf16_t* out = (bf16_t*)(ws + O_XATO) + trow * 512 + h * 128;
#pragma unroll
  for (int dt = 0; dt < 8; ++dt) {
    f32x4 a = {0.f, 0.f, 0.f, 0.f};
#pragma unroll
    for (int s = 0; s < 8; ++s) a = mfma16(ldfrag(mv + (16 * dt + fr) * 256 + 32 * s + 8 * fq), pf[s], a);
    f32x4 o = {a[0] * inv, a[1] * inv, a[2] * inv, a[3] * inv};
    *(u32x2*)(out + 16 * dt + 4 * fq) = pack4(o);
  }
}

DI void phase2(const Params& p, unsigned char* smem, int bid, int nb) {
  for (int it = bid; it < 1024; it += nb) gdn_prep_item(p, smem, it);
  for (int it = bid; it < 512; it += nb) sgu_item(p, smem, it);
  for (int it = bid; it < 512; it += nb) xattn_item(p, it);
}

DI void gdn_scan(const Params& p, int bh, int es) {
  int tid = threadIdx.x; asm volatile("" : "+v"(tid));
  const int lane = tid & 63;
  unsigned char* ws = p.ws;
  const int b = bh >> 2, h = bh & 3;
  f32x4 acc[8];
#pragma unroll
  for (int t = 0; t < 8; ++t) acc[t] = (f32x4){0.f, 0.f, 0.f, 0.f};
  const int fr = lane & 15, fq = lane >> 4;
  const size_t item0 = (size_t)(b * 128) * 4 + h;
  const bf16_t* mp = (const bf16_t*)(ws + O_MP) + item0 * 16384 + lane * 8;
  const float* bc = (const float*)(ws + O_BC) + item0 * 16384 + (size_t)es * 2048 + lane * 4;
  bf16_t* st = (bf16_t*)(ws + O_ST) + item0 * 16384 + (size_t)(16 * es + fr) * 128 + 4 * fq;
  const float* glp = (const float*)(ws + O_GL) + item0;
  constexpr size_t ISTR = 4 * 16384;
  bf16x8 A[32]; f32x4 C[8]; float gl;
#pragma unroll
  for (int i = 0; i < 32; ++i) A[i] = ldfrag(mp + i * 512);
#pragma unroll
  for (int t = 0; t < 8; ++t) C[t] = *(const f32x4*)(bc + t * 256);
  gl = glp[0];
  for (int n = 0; n < 128; ++n) {
    const int nn = (n < 127) ? n + 1 : n;
    const bf16_t* mpn = mp + (size_t)nn * ISTR;
    const float* bcn = bc + (size_t)nn * ISTR;
    bf16_t* stn = st + (size_t)n * ISTR;
    bf16x8 bfr[4];
#pragma unroll
    for (int s = 0; s < 4; ++s) {
      const u32x2 lo = pack4(acc[2 * s]), hi = pack4(acc[2 * s + 1]);
      *(u32x2*)(stn + 32 * s) = lo; *(u32x2*)(stn + 32 * s + 16) = hi;
      u32x4 v = {lo[0], lo[1], hi[0], hi[1]};
      bfr[s] = __builtin_bit_cast(bf16x8, v);
    }
    const float gcur = gl;
    gl = glp[(size_t)nn * 4];
#pragma unroll
    for (int t = 0; t < 8; ++t) {
      f32x4 a = {gcur * acc[t][0] + C[t][0], gcur * acc[t][1] + C[t][1], gcur * acc[t][2] + C[t][2], gcur * acc[t][3] + C[t][3]};
      C[t] = *(const f32x4*)(bcn + t * 256);
#pragma unroll
      for (int s = 0; s < 4; ++s) { a = mfma16(A[t * 4 + s], bfr[s], a); A[t * 4 + s] = ldfrag(mpn + (t * 4 + s) * 512); }
      acc[t] = a;
    }
  }
}

struct EpiGate {
  const bf16_t* gates; int goff; const bf16_t* src; bf16_t* dst;
  DI void operator()(const f32x4 (&acc)[2][2][4][2], const pg::Unit& u, int wr, int wc, int fr, int fq) const {
#pragma unroll
    for (int ai = 0; ai < 2; ++ai)
#pragma unroll
      for (int m = 0; m < 4; ++m) {
        const size_t row = (size_t)u.pm * 256 + 128 * ai + 64 * wr + 16 * m + fr;
#pragma unroll
        for (int bj = 0; bj < 2; ++bj)
#pragma unroll
          for (int n = 0; n < 2; ++n) {
            const int col = u.pn * 256 + 128 * bj + 32 * wc + 16 * n + 4 * fq;
            const f32x4 v = acc[ai][bj][m][n];
            const u32x2 g = *(const u32x2*)(gates + row * 3072 + goff + col);
            f32x4 o = {lo2f(g[0]) * v[0], hi2f(g[0]) * v[1], lo2f(g[1]) * v[2], hi2f(g[1]) * v[3]};
            if (src) { const u32x2 s = *(const u32x2*)(src + row * 1024 + col); o[0] += lo2f(s[0]); o[1] += hi2f(s[0]); o[2] += lo2f(s[1]); o[3] += hi2f(s[1]); }
            *(u32x2*)(dst + row * 1024 + col) = pack4(o);
          }
      }
  }
};
DI void phase3(const Params& p, unsigned char* smem, int bid, int nb) {
  unsigned char* ws = p.ws;
  if (bid < 64) {
    const int wave = threadIdx.x >> 6;
    if (wave == 0) gdn_scan(p, bid & 7, bid >> 3);
  } else {
    PG_LAS unsigned char* lds = (PG_LAS unsigned char*)smem;
    const bf16_t* gates = (const bf16_t*)(ws + O_GATES);
    bf16_t* part = (bf16_t*)(ws + O_PART);
    __syncthreads();
    { pg::DenseOrder S; S.init(ws + O_SGUO, ws + O_WBT, T, 1024, 512, nb - 64, bid - 64); EpiGate E{gates, 1024, nullptr, part}; pg::gemm_phase<EpiGate, pg::DenseOrder, false, true>(lds, 512, S, E); }
    asm volatile("s_waitcnt vmcnt(0)" ::: "memory");
    __builtin_amdgcn_fence(__ATOMIC_ACQUIRE, "agent");
    asm volatile("s_waitcnt vmcnt(0)" ::: "memory");
    __syncthreads();
    { pg::DenseOrder S; S.init(ws + O_XATO, ws + O_WCT, T, 1024, 512, nb - 64, bid - 64); EpiGate E{gates, 2048, part, part}; pg::gemm_phase<EpiGate, pg::DenseOrder, false, true>(lds, 512, S, E); }
  }
}

DI void phase4(const Params& p, int bid, int nb) {
  int tid = threadIdx.x; asm volatile("" : "+v"(tid));
  const int lane = tid & 63, wave = tid >> 6, fr = lane & 15, fq = lane >> 4;
  unsigned char* ws = p.ws;
  for (int it = bid; it < 512; it += nb) {
    const int item = it * 2 + (wave >> 2), tt = wave & 3;
    const int h = item & 3, cn = item >> 2;
    const size_t trow = (size_t)cn * 64 + 16 * tt + fr;
    const bf16_t* qp = (const bf16_t*)(ws + O_QP) + (size_t)item * 8192 + (16 * tt + fr) * 128;
    const bf16_t* st = (const bf16_t*)(ws + O_ST) + (size_t)item * 16384;
    const float* o0 = (const float*)(ws + O_O0) + trow * 512 + h * 128;
    bf16x8 af[4];
#pragma unroll
    for (int ks = 0; ks < 4; ++ks) af[ks] = ldfrag(qp + 32 * ks + 8 * fq);
    f32x4 acc[8];
    float ss = 0.f;
#pragma unroll
    for (int j = 0; j < 8; ++j) {
      f32x4 a = *(const f32x4*)(o0 + 16 * j + 4 * fq);
#pragma unroll
      for (int ks = 0; ks < 4; ++ks) a = mfma16(ldfrag(st + (16 * j + fr) * 128 + 32 * ks + 8 * fq), af[ks], a);
      acc[j] = a;
      ss += a[0] * a[0] + a[1] * a[1] + a[2] * a[2] + a[3] * a[3];
    }
    ss += __shfl_xor(ss, 16); ss += __shfl_xor(ss, 32);
    const float rms = rsqrtf(ss * (1.f / 128.f) + 1e-6f);
    const float* ng = p.in[I_GNG];
    const bf16_t* zs = (const bf16_t*)(ws + O_ZS) + trow * 512 + h * 128;
    bf16_t* out = (bf16_t*)(ws + O_GDNO) + trow * 512 + h * 128;
#pragma unroll
    for (int j = 0; j < 8; ++j) {
      const int e0 = 16 * j + 4 * fq;
      const f32x4 g = *(const f32x4*)(ng + e0);
      const u32x2 z = *(const u32x2*)(zs + e0);
      f32x4 o = {acc[j][0] * rms * g[0] * lo2f(z[0]), acc[j][1] * rms * g[1] * hi2f(z[0]), acc[j][2] * rms * g[2] * lo2f(z[1]), acc[j][3] * rms * g[3] * hi2f(z[1])};
      *(u32x2*)(out + e0) = pack4(o);
    }
  }
}

DI void phase5(const Params& p, unsigned char* smem, int bid, int nb) {
  unsigned char* ws = p.ws;
  PG_LAS unsigned char* lds = (PG_LAS unsigned char*)smem;
  __syncthreads();
  pg::DenseOrder S; S.init(ws + O_GDNO, ws + O_WAT, T, 1024, 512, nb, bid);
  EpiGate E{(const bf16_t*)(ws + O_GATES), 0, (const bf16_t*)(ws + O_PART), (bf16_t*)(ws + O_MERGED)};
  pg::gemm_phase<EpiGate, pg::DenseOrder, false, true>(lds, 512, S, E);
}
struct EpiX1 {
  const float* x; float* x1;
  DI void operator()(const f32x4 (&acc)[2][2][4][2], const pg::Unit& u, int wr, int wc, int fr, int fq) const {
#pragma unroll
    for (int ai = 0; ai < 2; ++ai)
#pragma unroll
      for (int m = 0; m < 4; ++m) {
        const size_t row = (size_t)u.pm * 256 + 128 * ai + 64 * wr + 16 * m + fr;
#pragma unroll
        for (int bj = 0; bj < 2; ++bj)
#pragma unroll
          for (int n = 0; n < 2; ++n) {
            const int col = u.pn * 256 + 128 * bj + 32 * wc + 16 * n + 4 * fq;
            const f32x4 v = acc[ai][bj][m][n];
            const f32x4 xv = *(const f32x4*)(x + row * 1024 + col);
            f32x4 o = {ALPHA * xv[0] + v[0], ALPHA * xv[1] + v[1], ALPHA * xv[2] + v[2], ALPHA * xv[3] + v[3]};
            *(f32x4*)(x1 + row * 1024 + col) = o;
          }
      }
  }
};
DI void phase6(const Params& p, unsigned char* smem, int bid, int nb) {
  unsigned char* ws = p.ws;
  PG_LAS unsigned char* lds = (PG_LAS unsigned char*)smem;
  __syncthreads();
  pg::DenseOrder S; S.init(ws + O_MERGED, ws + O_WOT, T, 1024, 1024, nb, bid);
  EpiX1 E{p.in[I_X], (float*)(ws + O_X1)};
  pg::gemm_phase<EpiX1, pg::DenseOrder, false, false>(lds, 1024, S, E);
}

DI void ln_row(const float* src, const float* g, const float* b, float (&v)[16], int lane) {
  float s = 0.f;
#pragma unroll
  for (int i = 0; i < 16; ++i) s += v[i];
  const float mean = wave_sum(s) * (1.f / 1024.f);
  float q = 0.f;
#pragma unroll
  for (int i = 0; i < 16; ++i) { const float d = v[i] - mean; q += d * d; }
  const float rstd = rsqrtf(wave_sum(q) * (1.f / 1024.f) + 1e-5f);
#pragma unroll
  for (int i = 0; i < 4; ++i) {
    const int k = 256 * i + 4 * lane;
    const f32x4 gg = *(const f32x4*)(g + k), bb = *(const f32x4*)(b + k);
#pragma unroll
    for (int c = 0; c < 4; ++c) v[4 * i + c] = (v[4 * i + c] - mean) * rstd * gg[c] + bb[c];
  }
}
DI void phase7(const Params& p, int bid, int nb) {
  int tid = threadIdx.x; asm volatile("" : "+v"(tid));
  const int lane = tid & 63, wave = tid >> 6;
  unsigned char* ws = p.ws;
  for (int i = bid * NTHR + tid; i < MAXSLOT; i += nb * NTHR) { ((int*)(ws + O_SLOTTOK))[i] = 0; ((int*)(ws + O_SLOTAID))[i] = -1; }
  float* x1 = (float*)(ws + O_X1);
  bf16_t* x1b = (bf16_t*)(ws + O_X1B);
  for (int row = bid * 8 + wave; row < T; row += nb * 8) {
    float v[16];
#pragma unroll
    for (int i = 0; i < 4; ++i) { const f32x4 t = *(const f32x4*)(x1 + (size_t)row * D + 256 * i + 4 * lane); v[4 * i] = t[0]; v[4 * i + 1] = t[1]; v[4 * i + 2] = t[2]; v[4 * i + 3] = t[3]; }
    ln_row(nullptr, p.in[I_LN1G], p.in[I_LN1B], v, lane);
#pragma unroll
    for (int i = 0; i < 4; ++i) {
      const f32x4 o = {v[4 * i], v[4 * i + 1], v[4 * i + 2], v[4 * i + 3]};
      *(f32x4*)(x1 + (size_t)row * D + 256 * i + 4 * lane) = o;
      *(u32x2*)(x1b + (size_t)row * D + 256 * i + 4 * lane) = pack4(o);
    }
  }
}
struct EpiLogits {
  float* logits;
  DI void operator()(const f32x4 (&acc)[2][2][4][2], const pg::Unit& u, int wr, int wc, int fr, int fq) const {
#pragma unroll
    for (int ai = 0; ai < 2; ++ai)
#pragma unroll
      for (int m = 0; m < 4; ++m) {
        const size_t row = (size_t)u.pm * 256 + 128 * ai + 64 * wr + 16 * m + fr;
#pragma unroll
        for (int bj = 0; bj < 2; ++bj)
#pragma unroll
          for (int n = 0; n < 2; ++n) *(f32x4*)(logits + row * 256 + 128 * bj + 32 * wc + 16 * n + 4 * fq) = acc[ai][bj][m][n];
      }
  }
};
DI void phase8(const Params& p, unsigned char* smem, int bid, int nb) {
  unsigned char* ws = p.ws;
  PG_LAS unsigned char* lds = (PG_LAS unsigned char*)smem;
  __syncthreads();
  pg::DenseOrder S; S.init(ws + O_X1B, ws + O_ROUT, T, 256, 1024, nb, bid);
  EpiLogits E{(float*)(ws + O_LOGITS)};
  pg::gemm_phase<EpiLogits, pg::DenseOrder, false, false>(lds, 1024, S, E);
}
DI void phase9(const Params& p, int bid, int nb) {
  int tid = threadIdx.x; asm volatile("" : "+v"(tid));
  const int lane = tid & 63, wave = tid >> 6;
  unsigned char* ws = p.ws;
  const float* logits = (const float*)(ws + O_LOGITS);
  int* counts = (int*)(ws + O_CTRL);
  const f32x4 bias = *(const f32x4*)(p.in[I_RB] + 4 * lane);
  const float NEG = -__builtin_inff();
  for (int tok = bid * 8 + wave; tok < T; tok += nb * 8) {
    const f32x4 lg = *(const f32x4*)(logits + (size_t)tok * 256 + 4 * lane);
    float sc[4], mv[4];
#pragma unroll
    for (int c = 0; c < 4; ++c) { sc[c] = sigmoidf_(lg[c]); mv[c] = sc[c] + bias[c]; }
    float m1 = NEG, m2 = NEG;
#pragma unroll
    for (int c = 0; c < 4; ++c) { const float v = mv[c]; if (v > m1) { m2 = m1; m1 = v; } else if (v > m2) m2 = v; }
#pragma unroll
    for (int o = 1; o < 8; o <<= 1) {
      const float o1 = __shfl_xor(m1, o), o2 = __shfl_xor(m2, o);
      const float n1 = fmaxf(m1, o1), n2 = fmaxf(fminf(m1, o1), fmaxf(m2, o2));
      m1 = n1; m2 = n2;
    }
    const float gs = m1 + m2;
    const int g = lane >> 3;
    int rank = 0;
#pragma unroll
    for (int gg = 0; gg < 8; ++gg) { const float og = __shfl(gs, gg * 8); rank += ((og > gs) || (og == gs && gg < g)) ? 1 : 0; }
    if (rank >= 4) {
#pragma unroll
      for (int c = 0; c < 4; ++c) mv[c] = NEG;
    }
    int myidx = 0; float mysc = 0.f, ssum = 0.f;
#pragma unroll
    for (int k = 0; k < 8; ++k) {
      float bv = mv[0]; int bi = 0;
#pragma unroll
      for (int c = 1; c < 4; ++c) if (mv[c] > bv) { bv = mv[c]; bi = c; }
      float rv = bv; int ri = lane * 4 + bi;
#pragma unroll
      for (int o = 32; o; o >>= 1) {
        const float ov = __shfl_xor(rv, o); const int oi = __shfl_xor(ri, o);
        if (ov > rv || (ov == rv && oi < ri)) { rv = ov; ri = oi; }
      }
      const int wl = ri >> 2, wc = ri & 3;
      const float mine = wc == 0 ? sc[0] : wc == 1 ? sc[1] : wc == 2 ? sc[2] : sc[3];
      const float wsc = __shfl(mine, wl);
      if (lane == wl) {
#pragma unroll
        for (int c = 0; c < 4; ++c) if (c == wc) mv[c] = NEG;
      }
      ssum += wsc;
      if (lane == k) { myidx = ri; mysc = wsc; }
    }
    if (lane < 8) {
      const int pos = atomicAdd(&counts[myidx * CSTR], 1);
      ((int*)(ws + O_TKIDX))[(size_t)tok * 8 + lane] = myidx;
      ((float*)(ws + O_TKW))[(size_t)tok * 8 + lane] = mysc / ssum * 2.5f;
      ((int*)(ws + O_TKPOS))[(size_t)tok * 8 + lane] = pos;
    }
  }
}
DI void build_tile_start(const Params& p, int* ts) {
  const int tid = threadIdx.x;
  const int* counts = (const int*)(p.ws + O_CTRL);
  __syncthreads();
  if (tid < 256) ts[300 + tid] = (counts[tid * CSTR] + 255) >> 8;
  __syncthreads();
  if (tid == 0) { int s = 0; for (int e = 0; e < 256; ++e) { ts[e] = s; s += ts[300 + e]; } ts[256] = s; }
  __syncthreads();
}
DI void phase10(const Params& p, unsigned char* smem, int bid, int nb) {
  int* ts = (int*)smem;
  build_tile_start(p, ts);
  unsigned char* ws = p.ws;
  const int* tkidx = (const int*)(ws + O_TKIDX); const int* tkpos = (const int*)(ws + O_TKPOS); const float* tkw = (const float*)(ws + O_TKW);
  int* slottok = (int*)(ws + O_SLOTTOK); float* slotw = (float*)(ws + O_SLOTW); int* slotaid = (int*)(ws + O_SLOTAID);
  for (int i = bid * NTHR + threadIdx.x; i < T * 8; i += nb * NTHR) {
    const int e = tkidx[i];
    const int slot = ts[e] * 256 + tkpos[i];
    slottok[slot] = i >> 3; slotw[slot] = tkw[i]; slotaid[slot] = i;
  }
}

DI int find_expert(const int* ts, int ti) { int lo = 0, hi = 255; while (lo < hi) { const int mid = (lo + hi + 1) >> 1; if (ts[mid] <= ti) lo = mid; else hi = mid - 1; } return lo; }

template <int NPN, bool UP>
struct MoeOrder {
  const int* ts; unsigned char* ws; int ntile, G, c;
  DI bool next(int i, pg::Unit& u) const {
    const int L = i * G + c;
    if (L >= ntile * NPN) return false;
    const int ti = L / NPN, pn = L - ti * NPN;
    const int e = find_expert(ts, ti);
    u.pm = ti; u.pn = pn; u.e = e;
    if (UP) { u.a = (const char*)(ws + O_X1B); u.rows = (const int*)(ws + O_SLOTTOK) + ti * 256; u.b = (const char*)(ws + O_WGU) + (size_t)e * 1048576 + (size_t)pn * 524288; }
    else    { u.a = (const char*)(ws + O_ACT) + (size_t)ti * 131072; u.rows = nullptr; u.b = (const char*)(ws + O_WD) + (size_t)e * 524288 + (size_t)pn * 131072; }
    return true;
  }
};
struct EpiAct {
  bf16_t* actp;
  DI void operator()(const f32x4 (&acc)[2][2][4][2], const pg::Unit& u, int wr, int wc, int fr, int fq) const {
#pragma unroll
    for (int ai = 0; ai < 2; ++ai)
#pragma unroll
      for (int m = 0; m < 4; ++m) {
        const size_t row = (size_t)u.pm * 256 + 128 * ai + 64 * wr + 16 * m + fr;
#pragma unroll
        for (int bj = 0; bj < 2; ++bj) {
          const int blk = 8 * u.pn + 4 * bj + wc;
          const f32x4 g = acc[ai][bj][m][0], uu = acc[ai][bj][m][1];
          f32x4 o = {siluf_(g[0]) * uu[0], siluf_(g[1]) * uu[1], siluf_(g[2]) * uu[2], siluf_(g[3]) * uu[3]};
          *(u32x2*)(actp + row * 256 + blk * 16 + 4 * fq) = pack4(o);
        }
      }
  }
};
struct EpiBf16Out {
  bf16_t* dst;
  DI void operator()(const f32x4 (&acc)[2][2][4][2], const pg::Unit& u, int wr, int wc, int fr, int fq) const {
#pragma unroll
    for (int ai = 0; ai < 2; ++ai)
#pragma unroll
      for (int m = 0; m < 4; ++m) {
        const size_t row = (size_t)u.pm * 256 + 128 * ai + 64 * wr + 16 * m + fr;
#pragma unroll
        for (int bj = 0; bj < 2; ++bj)
#pragma unroll
          for (int n = 0; n < 2; ++n) *(u32x2*)(dst + row * 1024 + u.pn * 256 + 128 * bj + 32 * wc + 16 * n + 4 * fq) = pack4(acc[ai][bj][m][n]);
      }
  }
};
struct EpiDown {
  const int* slotaid; const float* slotw; unsigned char* ybase;
  DI void operator()(const f32x4 (&acc)[2][2][4][2], const pg::Unit& u, int wr, int wc, int fr, int fq) const {
    const unsigned row0 = (unsigned)u.pm * 256u + 64u * wr + fr;
    const unsigned colb = ((unsigned)u.pn * 256u + 32u * wc + 4u * fq) * 2u;
#pragma unroll
    for (int ai = 0; ai < 2; ++ai) {
#pragma unroll
      for (int m = 0; m < 4; ++m) {
        const unsigned row = row0 + 128u * ai + 16u * m;
        const int aid = slotaid[row]; const float ww = slotw[row];
        if (aid >= 0) {
          const unsigned off = (unsigned)aid * 2048u + colb;
#pragma unroll
          for (int bj = 0; bj < 2; ++bj)
#pragma unroll
            for (int n = 0; n < 2; ++n) {
              const f32x4 v = acc[ai][bj][m][n];
              f32x4 o = {v[0] * ww, v[1] * ww, v[2] * ww, v[3] * ww};
              *(u32x2*)(ybase + (size_t)(off + (unsigned)(256 * bj + 32 * n))) = pack4(o);
            }
        }
      }
      asm volatile("" ::: "memory");
    }
  }
};
DI void phase11(const Params& p, unsigned char* smem, int bid, int nb) {
  unsigned char* ws = p.ws;
  int* ts = (int*)(smem + 131072);
  build_tile_start(p, ts);
  PG_LAS unsigned char* lds = (PG_LAS unsigned char*)smem;
  { MoeOrder<2, true> S{ts, ws, ts[256], nb, bid}; EpiAct E{(bf16_t*)(ws + O_ACT)}; pg::gemm_phase<EpiAct, MoeOrder<2, true>, true, true>(lds, 1024, S, E); }
  __syncthreads();
  { pg::DenseOrder S; S.init(ws + O_X1B, ws + O_WSGU, T, 512, 1024, nb, bid); EpiAct E{(bf16_t*)(ws + O_ACTSH)}; pg::gemm_phase<EpiAct, pg::DenseOrder, false, true>(lds, 1024, S, E); }
}
DI void phase12(const Params& p, unsigned char* smem, int bid, int nb) {
  unsigned char* ws = p.ws;
  int* ts = (int*)(smem + 131072);
  build_tile_start(p, ts);
  PG_LAS unsigned char* lds = (PG_LAS unsigned char*)smem;
  { MoeOrder<4, false> S{ts, ws, ts[256], nb, bid}; EpiDown E{(const int*)(ws + O_SLOTAID), (const float*)(ws + O_SLOTW), ws + O_Y}; pg::gemm_phase<EpiDown, MoeOrder<4, false>, false, true>(lds, 256, S, E); }
  __syncthreads();
  { pg::DenseOrder S; S.init(ws + O_ACTSH, ws + O_WSD, T, 1024, 256, nb, bid); EpiBf16Out E{(bf16_t*)(ws + O_YSH)}; pg::gemm_phase<EpiBf16Out, pg::DenseOrder, false, true>(lds, 256, S, E); }
}
DI void phase13(const Params& p, int bid, int nb) {
  int tid = threadIdx.x; asm volatile("" : "+v"(tid));
  const int lane = tid & 63, wave = tid >> 6;
  unsigned char* ws = p.ws;
  const float* x1 = (const float*)(ws + O_X1);
  const bf16_t* ysh = (const bf16_t*)(ws + O_YSH);
  const bf16_t* y = (const bf16_t*)(ws + O_Y);
  for (int row = bid * 8 + wave; row < T; row += nb * 8) {
    float v[16];
#pragma unroll
    for (int i = 0; i < 4; ++i) {
      const int k = 256 * i + 4 * lane;
      const f32x4 t = *(const f32x4*)(x1 + (size_t)row * D + k);
      const u32x2 s = *(const u32x2*)(ysh + (size_t)row * D + k);
      v[4 * i] = ALPHA * t[0] + lo2f(s[0]); v[4 * i + 1] = ALPHA * t[1] + hi2f(s[0]); v[4 * i + 2] = ALPHA * t[2] + lo2f(s[1]); v[4 * i + 3] = ALPHA * t[3] + hi2f(s[1]);
    }
#pragma unroll
    for (int k8 = 0; k8 < 8; ++k8) {
#pragma unroll
      for (int i = 0; i < 4; ++i) {
        const u32x2 s = *(const u32x2*)(y + ((size_t)row * 8 + k8) * 1024 + 256 * i + 4 * lane);
        v[4 * i] += lo2f(s[0]); v[4 * i + 1] += hi2f(s[0]); v[4 * i + 2] += lo2f(s[1]); v[4 * i + 3] += hi2f(s[1]);
      }
    }
    ln_row(nullptr, p.in[I_LN2G], p.in[I_LN2B], v, lane);
#pragma unroll
    for (int i = 0; i < 4; ++i) { const f32x4 o = {v[4 * i], v[4 * i + 1], v[4 * i + 2], v[4 * i + 3]}; *(f32x4*)(p.out + (size_t)row * D + 256 * i + 4 * lane) = o; }
  }
}

DI void load_params(Params& lp, const unsigned char* smem) {
  const unsigned* t = (const unsigned*)(smem + PTAB_OFF);
#pragma unroll
  for (int i = 0; i < 28; ++i) lp.in[i] = (const float*)(((unsigned long long)(unsigned)__builtin_amdgcn_readfirstlane((int)t[2 * i + 1]) << 32) | (unsigned)__builtin_amdgcn_readfirstlane((int)t[2 * i]));
  lp.out = (float*)(((unsigned long long)(unsigned)__builtin_amdgcn_readfirstlane((int)t[57]) << 32) | (unsigned)__builtin_amdgcn_readfirstlane((int)t[56]));
  lp.ws = (unsigned char*)(((unsigned long long)(unsigned)__builtin_amdgcn_readfirstlane((int)t[59]) << 32) | (unsigned)__builtin_amdgcn_readfirstlane((int)t[58]));
}
#ifndef DUPMASK
#define DUPMASK 0
#endif
__global__ void __launch_bounds__(NTHR) mega_kernel(Params pk) {
  extern __shared__ __attribute__((aligned(16))) unsigned char smem[];
  cg::grid_group grid = cg::this_grid();
  const int bid = blockIdx.x, nb = gridDim.x;
  volatile LAS unsigned* bst = (volatile LAS unsigned*)(smem + LDS_BYTES - 16);
  if (threadIdx.x < 4) bst[threadIdx.x] = 0u;
  if (threadIdx.x < 30) {
    const __attribute__((address_space(4))) unsigned long long* ka = (const __attribute__((address_space(4))) unsigned long long*)__builtin_amdgcn_kernarg_segment_ptr();
    ((unsigned long long*)(smem + PTAB_OFF))[threadIdx.x] = ka[threadIdx.x];
  }
  unsigned* barw = (unsigned*)(pk.ws + O_BAR);
  __syncthreads();
  XcdBarrier xb = xcd_barrier_post(barw, bst);
#define GSYNC() xcd_barrier(xb)
#define RUNP(k, call) do { { Params p; load_params(p, smem); call; } GSYNC(); if (DUPMASK & (1 << (k))) { { Params p; load_params(p, smem); call; } GSYNC(); } } while (0)
  { Params p; load_params(p, smem); phase0(p, smem, bid, nb); } grid.sync();
  RUNP(1, phase1(p, smem, bid, nb));
  RUNP(2, phase2(p, smem, bid, nb));
  RUNP(3, phase3(p, smem, bid, nb));
  RUNP(4, phase4(p, bid, nb));
  RUNP(5, phase5(p, smem, bid, nb));
  RUNP(14, phase6(p, smem, bid, nb));
  RUNP(14, phase7(p, bid, nb));
  RUNP(8, phase8(p, smem, bid, nb));
  RUNP(14, phase9(p, bid, nb));
  RUNP(10, phase10(p, smem, bid, nb));
  RUNP(11, phase11(p, smem, bid, nb));
  RUNP(12, phase12(p, smem, bid, nb));
  { Params p; load_params(p, smem); phase13(p, bid, nb); }
  if (DUPMASK & (1 << 13)) { GSYNC(); Params p; load_params(p, smem); phase13(p, bid, nb); }
  if (DUPMASK & (1 << 15)) { for (int i = 0; i < 10; ++i) GSYNC(); }
}

extern "C" void kernel_launch(void* const* d_in, const int* in_sizes, int n_in, void* d_out, int out_size, void* d_ws, size_t ws_size, hipStream_t stream) {
  if (n_in != 28 || ws_size < WS_NEED) { fprintf(stderr, "kernel_launch: unexpected inputs (%d) or workspace (%zu < %zu)\n", n_in, ws_size, (size_t)WS_NEED); return; }
  static int grid_blocks = 0;
  if (!grid_blocks) {
    int dev = 0, cus = 0, per_cu = 0;
    (void)hipGetDevice(&dev);
    (void)hipDeviceGetAttribute(&cus, hipDeviceAttributeMultiprocessorCount, dev);
    (void)hipFuncSetAttribute((const void*)mega_kernel, hipFuncAttributeMaxDynamicSharedMemorySize, LDS_BYTES);
    (void)hipOccupancyMaxActiveBlocksPerMultiprocessor(&per_cu, (const void*)mega_kernel, NTHR, LDS_BYTES);
    if (per_cu < 1) per_cu = 1;
    if (per_cu > 1) per_cu = 1;
    grid_blocks = cus * per_cu;
    if (grid_blocks < 32) grid_blocks = 32;
  }
  Params p{};
  for (int i = 0; i < 28; ++i) p.in[i] = (const float*)d_in[i];
  p.out = (float*)d_out; p.ws = (unsigned char*)d_ws;
  (void)hipMemsetAsync((unsigned char*)d_ws + O_BAR, 0, XCD_BAR_WORDS * 4, stream);
  void* args[] = {&p};
  hipError_t e = hipLaunchCooperativeKernel((const void*)mega_kernel, dim3(grid_blocks), dim3(NTHR), args, LDS_BYTES, stream);
  if (e != hipSuccess) fprintf(stderr, "cooperative launch failed: %s (grid %d)\n", hipGetErrorString(e), grid_blocks);
}
```

```cpp
#include <hip/hip_runtime.h>
#include <hip/hip_cooperative_groups.h>
#include <stdint.h>
#include <stdio.h>
namespace cg = cooperative_groups;

#define DI __device__ __forceinline__
#define LAS __attribute__((address_space(3)))
typedef unsigned short bf16_t;
typedef short bf16x8 __attribute__((ext_vector_type(8)));
typedef float f32x4 __attribute__((ext_vector_type(4)));
typedef unsigned u32x4 __attribute__((ext_vector_type(4)));
typedef unsigned u32x2 __attribute__((ext_vector_type(2)));

#ifndef DUPMASK
#define DUPMASK 0
#endif
constexpr int NTHR = 512;
constexpr int T = 16384, SEQ = 8192, D = 1024;
constexpr int NPROJ = 6656;
constexpr int DIN = 6664;
constexpr int NEXP = 256, DEXP = 256;
constexpr int MAXSLOT = 131072 + 256 * 256;
constexpr float ALPHA = 1.189207115002721f;
constexpr int LDS_BYTES = 157696;

constexpr size_t MB = 1u << 20;
constexpr size_t O_WGU = 0;
constexpr size_t O_WD = 256 * MB;
constexpr size_t O_WSGU = 384 * MB;
constexpr size_t O_WSD = 385 * MB;
constexpr size_t O_ROUT = 385 * MB + 512 * 1024;
constexpr size_t O_CTRL = 386 * MB;
constexpr size_t O_BAR = 386 * MB + 128 * 1024;
constexpr int CSTR = 64;
constexpr size_t O_IDENT = 386 * MB + 256 * 1024;
constexpr size_t O_X1 = 387 * MB;
constexpr size_t O_X1B = 451 * MB;
constexpr size_t R0 = 483 * MB;
constexpr size_t O_XB = R0 + 0;
constexpr size_t O_ST = R0 + 0;
constexpr size_t O_WINT = R0 + 32 * MB;
constexpr size_t O_WAT = R0 + 45 * MB;
constexpr size_t O_WBT = R0 + 46 * MB;
constexpr size_t O_WCT = R0 + 47 * MB;
constexpr size_t O_WOT = R0 + 48 * MB;
constexpr size_t O_WMKV = R0 + 50 * MB;
constexpr size_t O_MEMB = R0 + 52 * MB;
constexpr size_t O_SGUW = R0 + 53 * MB;
constexpr size_t O_AB = R0 + 53 * MB + 512 * 1024;
constexpr size_t O_MEMK = R0 + 54 * MB;
constexpr size_t O_MEMVT = R0 + 54 * MB + 512 * 1024;
constexpr size_t O_QKV = R0 + 55 * MB;
constexpr size_t O_PART = R0 + 55 * MB;
constexpr size_t O_ZS = R0 + 103 * MB;
constexpr size_t O_UVG = R0 + 119 * MB;
constexpr size_t O_MERGED = R0 + 119 * MB;
constexpr size_t O_XQ = R0 + 151 * MB;
constexpr size_t O_GATES = R0 + 167 * MB;
constexpr size_t O_MP = R0 + 263 * MB;
constexpr size_t O_BC = R0 + 295 * MB;
constexpr size_t O_O0 = R0 + 359 * MB;
constexpr size_t O_QP = R0 + 391 * MB;
constexpr size_t O_GL = R0 + 407 * MB;
constexpr size_t O_GDNO = R0 + 408 * MB;
constexpr size_t O_SGUO = R0 + 424 * MB;
constexpr size_t O_XATO = R0 + 440 * MB;
constexpr size_t O_LOGITS = R0 + 0;
constexpr size_t O_TKIDX = R0 + 16 * MB;
constexpr size_t O_TKW = R0 + 16 * MB + 512 * 1024;
constexpr size_t O_TKPOS = R0 + 17 * MB;
constexpr size_t O_SLOTTOK = R0 + 18 * MB;
constexpr size_t O_SLOTW = R0 + 19 * MB;
constexpr size_t O_SLOTAID = R0 + 20 * MB;
constexpr size_t O_ACT = R0 + 21 * MB;
constexpr size_t O_ACTSH = R0 + 117 * MB;
constexpr size_t O_YSH = R0 + 125 * MB;
constexpr size_t O_Y = R0 + 157 * MB;
constexpr size_t WS_NEED = R0 + 456 * MB;

struct Params {
  const float* in[28];
  float* out;
  unsigned char* ws;
};
enum { I_X = 0, I_MEM, I_WIN, I_CONVW, I_ALOG, I_DTB, I_GNG, I_WA, I_SLNG, I_SLNB, I_SGUW, I_SGUB, I_WB, I_WMKV, I_WC, I_WO,
       I_LN1G, I_LN1B, I_RW, I_RB, I_WG, I_WU, I_WDN, I_WSG, I_WSU, I_WSD, I_LN2G, I_LN2B };

constexpr int PTAB_OFF = 156672;
DI float bf2f(bf16_t h) { return __uint_as_float(((unsigned)h) << 16); }
DI bf16_t f2bf(float f) { unsigned u = __float_as_uint(f); u += 0x7fffu + ((u >> 16) & 1u); return (bf16_t)(u >> 16); }
typedef float f32x2_ __attribute__((ext_vector_type(2)));
typedef __bf16 bf16x2_ __attribute__((ext_vector_type(2)));
DI unsigned pk2(float lo, float hi) { f32x2_ v = {lo, hi}; return __builtin_bit_cast(unsigned, __builtin_convertvector(v, bf16x2_)); }
DI float lo2f(unsigned u) { return __uint_as_float(u << 16); }
DI float hi2f(unsigned u) { return __uint_as_float(u & 0xffff0000u); }
DI float sigmoidf_(float x) { return 1.f / (1.f + __expf(-x)); }
DI float siluf_(float x) { return x / (1.f + __expf(-x)); }
DI float geluf_(float x) { float u = 0.7978845608028654f * (x + 0.044715f * x * x * x); float t = 1.f - 2.f / (__expf(2.f * u) + 1.f); return 0.5f * x * (1.f + t); }
DI float softplusf_(float x) { return fmaxf(x, 0.f) + log1pf(__expf(-fabsf(x))); }
DI float wave_sum(float v) {
#pragma unroll
  for (int o = 32; o; o >>= 1) v += __shfl_xor(v, o);
  return v;
}
DI f32x4 mfma16(bf16x8 a, bf16x8 b, f32x4 c) { return __builtin_amdgcn_mfma_f32_16x16x32_bf16(a, b, c, 0, 0, 0); }
DI bf16x8 ldfrag(const void* p) { return __builtin_bit_cast(bf16x8, *(const u32x4*)p); }
DI bf16x8 pack8(f32x4 a, f32x4 b) { u32x4 r = {pk2(a[0], a[1]), pk2(a[2], a[3]), pk2(b[0], b[1]), pk2(b[2], b[3])}; return __builtin_bit_cast(bf16x8, r); }
DI u32x2 pack4(f32x4 a) { u32x2 r = {pk2(a[0], a[1]), pk2(a[2], a[3])}; return r; }
DI int sw128(int row, int chunk) { return row * 128 + ((chunk ^ (row & 7)) << 4); }
DI int sw256(int row, int chunk) { return row * 256 + ((chunk ^ (row & 15)) << 4); }

namespace pg {
#define PG_LAS __attribute__((address_space(3)))
constexpr int BM = 256, BK = 64, HALF = 128, HTB = HALF * BK * 2, NXCD = 8, WGM = 8;
DI int lds_byte(int r, int c) { const int st = (r >> 4) * 2 + (c >> 5), rr = r & 15, cc = c & 31, ob = rr * 64 + cc * 2; return st * 1024 + (ob ^ (((ob >> 9) & 1) << 5)); }
DI void stage_rc(int b, int& R, int& C) { const int st = b / 1024, sb = b % 1024, swz = sb ^ (((sb >> 9) & 1) << 5); R = (st >> 1) * 16 + swz / 64; C = (st & 1) * 32 + (swz % 64) / 2; }

struct Unit { const char* a; const char* b; const int* rows; int pm, pn, e; };

struct DenseOrder {
  const char* A; const char* B; int nM, nN, nwg, G, c; size_t tstep;
  DI void init(const void* A_, const void* B_, int M, int N, int K, int G_, int c_) { A = (const char*)A_; B = (const char*)B_; nM = M / BM; nN = N / BM; nwg = nM * nN; G = G_; c = c_; tstep = (size_t)BM * K * 2; }
  DI bool next(int i, Unit& u) const {
    const long L = (long)i * G + c; if (L >= nwg) return false;
    int wgid = (int)L; { const int q = nwg / NXCD, r = nwg % NXCD, xcd = wgid % NXCD, off = wgid / NXCD; wgid = (xcd < r ? xcd * (q + 1) : r * (q + 1) + (xcd - r) * q) + off; }
    const int nig = WGM * nN, gid = wgid / nig, fm = gid * WGM, gsz = (nM - fm) < WGM ? (nM - fm) : WGM;
    u.pm = fm + ((wgid % nig) % gsz); u.pn = (wgid % nig) / gsz; u.e = 0; u.rows = nullptr;
    u.a = A + (size_t)u.pm * tstep; u.b = B + (size_t)u.pn * tstep; return true;
  }
};

template <class Epi, class Sched, bool GATHER, bool ALIGN_EPI>
DI void gemm_phase(PG_LAS unsigned char* lds, const int K, const Sched& S, const Epi& E) {
  int tid = threadIdx.x; asm volatile("" : "+v"(tid));
  const int wid = __builtin_amdgcn_readfirstlane(tid >> 6), lane = tid & 63, wr = wid >> 2, wc = wid & 3, fr = lane & 15, fq = lane >> 4;
  const int nt = K / BK;
  int Rr[2], Cc[2];
  unsigned voffB[2];
#pragma unroll
  for (int i = 0; i < 2; ++i) { stage_rc(tid * 16 + i * 8192, Rr[i], Cc[i]); voffB[i] = (unsigned)(Rr[i] * K + Cc[i]) * 2u; }
  const size_t kstep = (size_t)(BK * 2);
  const size_t hstep = (size_t)HALF * K * 2;
  const unsigned ldsw = (unsigned)wid * 1024u;
  const int aoff = lds_byte(wr * 64 + fr, fq * 8), boff = lds_byte(wc * 32 + fr, fq * 8);
#define PG_SA(b, h) (((b) * 2 + (h)) * HTB)
#define PG_SB(b, h) ((4 + (b) * 2 + (h)) * HTB)
#define PG_STAGE(bufoff, gbase, v0, v1) do { \
    __builtin_amdgcn_global_load_lds((const unsigned*)((const char*)(gbase) + (v0)), (PG_LAS unsigned*)(lds + (bufoff) + ldsw), 16, 0, 0); \
    __builtin_amdgcn_global_load_lds((const unsigned*)((const char*)(gbase) + (v1)), (PG_LAS unsigned*)(lds + (bufoff) + ldsw + 8192), 16, 0, 0); } while (0)
#define PG_LDA(dst, b, h) do { _Pragma("unroll") for (int m = 0; m < 4; ++m) _Pragma("unroll") for (int k = 0; k < 2; ++k) dst[m][k] = *(const PG_LAS bf16x8*)(lds + PG_SA(b, h) + aoff + m * 2048 + k * 1024); } while (0)
#define PG_LDB(dst, b, h) do { _Pragma("unroll") for (int n = 0; n < 2; ++n) _Pragma("unroll") for (int k = 0; k < 2; ++k) dst[n][k] = *(const PG_LAS bf16x8*)(lds + PG_SB(b, h) + boff + n * 2048 + k * 1024); } while (0)
#define PG_MMA(ai, bj, At, Bt) do { __builtin_amdgcn_s_setprio(1); _Pragma("unroll") for (int m = 0; m < 4; ++m) _Pragma("unroll") for (int n = 0; n < 2; ++n) _Pragma("unroll") for (int k = 0; k < 2; ++k) \
    acc[ai][bj][m][n] = __builtin_amdgcn_mfma_f32_16x16x32_bf16(Bt[n][k], At[m][k], acc[ai][bj][m][n], 0, 0, 0); __builtin_amdgcn_s_setprio(0); } while (0)
#define PG_WAIT_V(n) asm volatile("s_waitcnt vmcnt(" #n ")" ::: "memory")
#define PG_WAIT_L(n) asm volatile("s_waitcnt lgkmcnt(" #n ")" ::: "memory")
#define PG_BAR __builtin_amdgcn_s_barrier()
#define PG_SCHED __builtin_amdgcn_sched_barrier(0)
#define PG_AOFFS(u, o00, o01, o10, o11) do { if (GATHER) { \
      o00 = (unsigned)(u).rows[Rr[0]] * (unsigned)(K * 2) + (unsigned)Cc[0] * 2u; o01 = (unsigned)(u).rows[Rr[1]] * (unsigned)(K * 2) + (unsigned)Cc[1] * 2u; \
      o10 = (unsigned)(u).rows[128 + Rr[0]] * (unsigned)(K * 2) + (unsigned)Cc[0] * 2u; o11 = (unsigned)(u).rows[128 + Rr[1]] * (unsigned)(K * 2) + (unsigned)Cc[1] * 2u; \
    } else { o00 = voffB[0]; o01 = voffB[1]; o10 = voffB[0] + (unsigned)hstep; o11 = voffB[1] + (unsigned)hstep; } } while (0)
  Unit cur, nxt; int ui = 0;
  if (!S.next(0, cur)) return;
  f32x4 acc[2][2][4][2];
#pragma unroll
  for (int a = 0; a < 2; ++a)
#pragma unroll
    for (int b = 0; b < 2; ++b)
#pragma unroll
      for (int m = 0; m < 4; ++m)
#pragma unroll
        for (int n = 0; n < 2; ++n) acc[a][b][m][n] = (f32x4){0.f, 0.f, 0.f, 0.f};
  bf16x8 At[4][2], B0[2][2], B1[2][2];
  const char* cA = cur.a; const char* cB = cur.b;
  unsigned c00, c01, c10, c11;
  PG_AOFFS(cur, c00, c01, c10, c11);
  const unsigned vb0 = voffB[0], vb1 = voffB[1];
  PG_STAGE(PG_SB(0, 0), cB, vb0, vb1); PG_STAGE(PG_SB(0, 1), cB + hstep, vb0, vb1); PG_STAGE(PG_SA(0, 0), cA, c00, c01); PG_STAGE(PG_SA(0, 1), cA, c10, c11);
  if (wr == 1) PG_BAR;
  PG_WAIT_V(2); PG_BAR;
  PG_STAGE(PG_SB(1, 0), cB + kstep, vb0, vb1); PG_STAGE(PG_SA(1, 0), cA + kstep, c00, c01); PG_STAGE(PG_SB(1, 1), cB + hstep + kstep, vb0, vb1);
  PG_WAIT_V(6); PG_BAR;
  for (;;) {
    const bool has_next = S.next(ui + 1, nxt);
    const char* nA = has_next ? nxt.a : cA; const char* nB = has_next ? nxt.b : cB;
    unsigned n00 = c00, n01 = c01, n10 = c10, n11 = c11;
    if (has_next) PG_AOFFS(nxt, n00, n01, n10, n11);
#pragma unroll 1
    for (int t = 0; t < nt; t += 2) {
      const bool last = (t == nt - 2);
      const char* a1 = cA + (size_t)(t + 1) * kstep;
      const char* a2 = last ? nA : cA + (size_t)(t + 2) * kstep; const char* b2 = last ? nB : cB + (size_t)(t + 2) * kstep;
      const char* a3 = a2 + kstep; const char* b3 = b2 + kstep;
      const unsigned o00 = last ? n00 : c00, o01 = last ? n01 : c01, o10 = last ? n10 : c10, o11 = last ? n11 : c11;
      PG_LDB(B0, 0, 0); PG_LDB(B1, 0, 1); PG_SCHED; PG_LDA(At, 0, 0); PG_STAGE(PG_SA(1, 1), a1, c10, c11);
      PG_WAIT_V(8); PG_WAIT_L(0); PG_BAR; PG_MMA(0, 0, At, B0); PG_MMA(0, 1, At, B1); PG_BAR; PG_SCHED;
      PG_LDA(At, 0, 1); PG_STAGE(PG_SB(0, 0), b2, vb0, vb1); PG_STAGE(PG_SB(0, 1), b2 + hstep, vb0, vb1); PG_STAGE(PG_SA(0, 0), a2, o00, o01);
      PG_WAIT_V(8); PG_WAIT_L(0); PG_BAR; PG_MMA(1, 0, At, B0); PG_MMA(1, 1, At, B1); PG_BAR; PG_SCHED;
      PG_LDB(B0, 1, 0); PG_LDB(B1, 1, 1); PG_SCHED; PG_LDA(At, 1, 0); PG_STAGE(PG_SA(0, 1), a2, o10, o11);
      PG_WAIT_V(8); PG_WAIT_L(0); PG_BAR; PG_MMA(0, 0, At, B0); PG_MMA(0, 1, At, B1); PG_BAR; PG_SCHED;
      PG_LDA(At, 1, 1); PG_STAGE(PG_SB(1, 0), b3, vb0, vb1); PG_STAGE(PG_SB(1, 1), b3 + hstep, vb0, vb1); PG_STAGE(PG_SA(1, 0), a3, o00, o01);
      PG_WAIT_V(8); PG_WAIT_L(0); PG_BAR; PG_MMA(1, 0, At, B0); PG_MMA(1, 1, At, B1); PG_BAR; PG_SCHED;
    }
    if constexpr (ALIGN_EPI) { if (wr == 0) PG_BAR; }
    E(acc, cur, wr, wc, fr, fq);
    if (!has_next) break;
#pragma unroll
    for (int a = 0; a < 2; ++a)
#pragma unroll
      for (int b = 0; b < 2; ++b)
#pragma unroll
        for (int m = 0; m < 4; ++m)
#pragma unroll
          for (int n = 0; n < 2; ++n) acc[a][b][m][n] = (f32x4){0.f, 0.f, 0.f, 0.f};
    cur = nxt; cA = nA; cB = nB; c00 = n00; c01 = n01; c10 = n10; c11 = n11; ++ui;
    if constexpr (ALIGN_EPI) { if (wr == 1) PG_BAR; }
  }
  PG_WAIT_V(0);
  if constexpr (!ALIGN_EPI) { if (wr == 0) PG_BAR; }
  PG_BAR;
#undef PG_SA
#undef PG_SB
#undef PG_STAGE
#undef PG_LDA
#undef PG_LDB
#undef PG_MMA
#undef PG_WAIT_V
#undef PG_WAIT_L
#undef PG_BAR
#undef PG_SCHED
#undef PG_AOFFS
}
}

#define XB_TMO      128
#define XB_XCNT(j)  (256  + 64 * (j))
#define XB_XSUB(j)  (1280 + 64 * (j))
#define XB_XGEN(j)  (2304 + 64 * (j))
#define XB_TOP      3328
#define XB_TOPGEN   3392
#define XCD_BAR_WORDS 3456
#define XB_SPIN_CAP (1u << 22)
DI unsigned xb_ld(unsigned* p)              { return __hip_atomic_load(p, __ATOMIC_RELAXED, __HIP_MEMORY_SCOPE_AGENT); }
DI unsigned xb_add(unsigned* p, unsigned v) { return __hip_atomic_fetch_add(p, v, __ATOMIC_RELAXED, __HIP_MEMORY_SCOPE_AGENT); }
DI unsigned xb_xcc_id() { return (unsigned)__builtin_amdgcn_s_getreg((3 << 11) | 20) & 0xFu; }
#define XB_SPIN(cond, bar) do { unsigned _sp = 0; while (cond) { __builtin_amdgcn_s_sleep(1); \
    if ((++_sp & 255u) == 0u) { if (xb_ld(&(bar)[XB_TMO])) break; if (_sp > XB_SPIN_CAP) { atomicAdd(&(bar)[XB_TMO], 1u); break; } } } } while (0)
struct XcdBarrier { unsigned* bar; unsigned x; volatile LAS unsigned* st; };
DI XcdBarrier xcd_barrier_post(unsigned* bar, volatile LAS unsigned* st) {
  XcdBarrier b; b.bar = bar; b.x = xb_xcc_id(); b.st = st;
  if (threadIdx.x == 0) (void)xb_add(&bar[XB_XCNT(b.x)], 1u);
  return b;
}
DI void xcd_barrier_complete(unsigned* bar, unsigned x, unsigned& nloc, unsigned& nx) {
  const unsigned G = gridDim.x * gridDim.y * gridDim.z;
  unsigned sum, cnt, mine, sp = 0u;
  for (;;) {
    sum = 0u; cnt = 0u; mine = 0u;
#pragma unroll
    for (unsigned j = 0; j < 16; ++j) { const unsigned c = xb_ld(&bar[XB_XCNT(j)]); sum += c; cnt += (c > 0u) ? 1u : 0u; mine = (j == x) ? c : mine; }
    if (sum == G) break;
    __builtin_amdgcn_s_sleep(1);
    if ((++sp & 255u) == 0u) { if (xb_ld(&bar[XB_TMO])) break; if (sp > XB_SPIN_CAP) { atomicAdd(&bar[XB_TMO], 1u); break; } }
  }
  nloc = mine > 0u ? mine : 1u; nx = cnt > 0u ? cnt : 1u;
}
DI void xcd_barrier(const XcdBarrier& b) {
  asm volatile("s_waitcnt vmcnt(0)" ::: "memory");
  __syncthreads();
  if (threadIdx.x == 0) {
    unsigned* bar = b.bar;
    __builtin_amdgcn_s_waitcnt(0);
    unsigned nloc = b.st[0], nx = b.st[1];
    if (nloc == 0u) { xcd_barrier_complete(bar, b.x, nloc, nx); b.st[0] = nloc; b.st[1] = nx; }
    const unsigned old = xb_add(&bar[XB_XSUB(b.x)], 1u);
    const unsigned gen = old / nloc;
    if (old + 1u == (gen + 1u) * nloc) {
      __builtin_amdgcn_fence(__ATOMIC_RELEASE, "agent");
      asm volatile("s_waitcnt vmcnt(0)" ::: "memory");
      const unsigned og = xb_add(&bar[XB_TOP], 1u);
      const unsigned tg = og / nx;
      if (og + 1u == (tg + 1u) * nx) xb_add(&bar[XB_TOPGEN], 1u);
      else XB_SPIN(xb_ld(&bar[XB_TOPGEN]) == tg, bar);
      __builtin_amdgcn_fence(__ATOMIC_ACQUIRE, "agent");
      xb_add(&bar[XB_XGEN(b.x)], 1u);
      asm volatile("s_waitcnt vmcnt(0)" ::: "memory");
    } else {
      XB_SPIN(xb_ld(&bar[XB_XGEN(b.x)]) == gen, bar);
      __builtin_amdgcn_fence(__ATOMIC_ACQUIRE, "agent");
      asm volatile("s_waitcnt vmcnt(0)" ::: "memory");
    }
  }
  __syncthreads();
}

DI void transpose_tile(float* tile, const float* s0, const float* s1, const float* s2, const float* s3, int ld, bf16_t* dst, int ldd) {
  int tid = threadIdx.x; asm volatile("" : "+v"(tid));
  const int kr = tid >> 4, nc = tid & 15, sg = nc >> 2;
  const float* sp = sg == 0 ? s0 : sg == 1 ? s1 : sg == 2 ? s2 : s3;
  const f32x4 v0 = *(const f32x4*)(sp + (size_t)kr * ld + 4 * (nc & 3));
  const f32x4 v1 = *(const f32x4*)(sp + (size_t)(kr + 32) * ld + 4 * (nc & 3));
  __syncthreads();
  float* t0 = tile + kr * 65 + 4 * nc;
  float* t1 = tile + (kr + 32) * 65 + 4 * nc;
  t0[0] = v0[0]; t0[1] = v0[1]; t0[2] = v0[2]; t0[3] = v0[3];
  t1[0] = v1[0]; t1[1] = v1[1]; t1[2] = v1[2]; t1[3] = v1[3];
  __syncthreads();
  const int n = tid >> 3, kc = tid & 7;
  float e[8];
#pragma unroll
  for (int j = 0; j < 8; ++j) e[j] = tile[(8 * kc + j) * 65 + n];
  u32x4 o = {pk2(e[0], e[1]), pk2(e[2], e[3]), pk2(e[4], e[5]), pk2(e[6], e[7])};
  *(u32x4*)(dst + (size_t)n * ldd + 8 * kc) = o;
}

DI void phase0(const Params& p, unsigned char* smem, int bid, int nb) {
  int tid = threadIdx.x; asm volatile("" : "+v"(tid));
  const int lane = tid & 63, wave = tid >> 6;
  unsigned char* ws = p.ws;
  if (bid == 0 && tid < 256) ((int*)(ws + O_CTRL))[tid * CSTR] = 0;
  for (int i = bid * NTHR + tid; i < T; i += nb * NTHR) ((int*)(ws + O_IDENT))[i] = i;
  {
    float* wabT = (float*)smem;
    const float* win = p.in[I_WIN];
    for (int i = tid; i < 8192; i += NTHR) { const int k = i >> 3, j = i & 7; wabT[j * 1024 + k] = win[(size_t)k * DIN + 2048 + j]; }
    __syncthreads();
    const float* x = p.in[I_X];
    bf16_t* xb = (bf16_t*)(ws + O_XB);
    float* ab = (float*)(ws + O_AB);
    for (int row = bid * 8 + wave; row < T; row += nb * 8) {
      float s[8];
#pragma unroll
      for (int j = 0; j < 8; ++j) s[j] = 0.f;
#pragma unroll
      for (int i = 0; i < 4; ++i) {
        const int k = 256 * i + 4 * lane;
        const f32x4 v = *(const f32x4*)(x + (size_t)row * D + k);
        *(u32x2*)(xb + (size_t)row * D + k) = pack4(v);
#pragma unroll
        for (int j = 0; j < 8; ++j) { const f32x4 w = *(const f32x4*)(wabT + j * 1024 + k); s[j] += v[0] * w[0] + v[1] * w[1] + v[2] * w[2] + v[3] * w[3]; }
      }
#pragma unroll
      for (int j = 0; j < 8; ++j) s[j] = wave_sum(s[j]);
      if (lane == 0) { *(f32x4*)(ab + (size_t)row * 8) = (f32x4){s[0], s[1], s[2], s[3]}; *(f32x4*)(ab + (size_t)row * 8 + 4) = (f32x4){s[4], s[5], s[6], s[7]}; }
    }
    const float* mem = p.in[I_MEM];
    bf16_t* memb = (bf16_t*)(ws + O_MEMB);
    for (int row = bid * 8 + wave; row < 512; row += nb * 8) {
#pragma unroll
      for (int i = 0; i < 4; ++i) { const int k = 256 * i + 4 * lane; *(u32x2*)(memb + (size_t)row * D + k) = pack4(*(const f32x4*)(mem + (size_t)row * D + k)); }
    }
    const float* sw = p.in[I_SGUW];
    bf16_t* sguw = (bf16_t*)(ws + O_SGUW);
    for (int i = bid * NTHR + tid; i < 16384; i += nb * NTHR) {
      const int e0 = i * 4; const int col = e0 & 127, rowi = (e0 >> 7) & 127;
      f32x4 v = *(const f32x4*)(sw + e0);
#pragma unroll
      for (int c = 0; c < 4; ++c) if (col + c > rowi) v[c] = 0.f;
      *(u32x2*)(sguw + e0) = pack4(v);
    }
    __syncthreads();
  }
  {
    float* tile = (float*)smem;
    const float *pwa = p.in[I_WA], *pwb = p.in[I_WB], *pwc = p.in[I_WC], *pwo = p.in[I_WO], *pwmkv = p.in[I_WMKV];
    asm volatile("" : "+s"(pwa), "+s"(pwb), "+s"(pwc), "+s"(pwo), "+s"(pwmkv));
    constexpr int J0 = 1664, J1 = J0 + 128, J2 = J1 + 128, J3 = J2 + 128, J4 = J3 + 256, J5 = J4 + 256, J6 = J5 + 64, J7 = J6 + 128, J8 = J7 + 64,
                  J9 = J8 + 32768, J10 = J9 + 16384;
    for (int it = bid; it < J10; it += nb) {
      const float *s0, *s1, *s2, *s3; int ld, ldd; bf16_t* dst;
      if (it < J0) {
        const int kt = it & 15, nt = it >> 4; const int n0 = nt * 64; const int c0 = n0 + (n0 >= 2048 ? 8 : 0);
        const float* b = p.in[I_WIN] + (size_t)kt * 64 * DIN + c0; s0 = b; s1 = b + 16; s2 = b + 32; s3 = b + 48; ld = DIN; ldd = 1024;
        dst = (bf16_t*)(ws + O_WINT) + (size_t)n0 * 1024 + kt * 64;
      } else if (it < J3) {
        const int which = (it - J0) >> 7, r = (it - J0) & 127; const int kt = r & 7, nt = r >> 3;
        const float* src = which == 0 ? pwa : which == 1 ? pwb : pwc;
        const float* b = src + (size_t)kt * 64 * 1024 + nt * 64; s0 = b; s1 = b + 16; s2 = b + 32; s3 = b + 48; ld = 1024; ldd = 512;
        dst = (bf16_t*)(ws + (which == 0 ? O_WAT : which == 1 ? O_WBT : O_WCT)) + (size_t)nt * 64 * 512 + kt * 64;
      } else if (it < J5) {
        const int which = (it - J3) >> 8, r = (it - J3) & 255; const int kt = r & 15, nt = r >> 4;
        const float* b = (which == 0 ? pwo : pwmkv) + (size_t)kt * 64 * 1024 + nt * 64; s0 = b; s1 = b + 16; s2 = b + 32; s3 = b + 48; ld = 1024; ldd = 1024;
        dst = (bf16_t*)(ws + (which == 0 ? O_WOT : O_WMKV)) + (size_t)nt * 64 * 1024 + kt * 64;
      } else if (it < J6) {
        const int r = it - J5; const int kt = r & 15, nt = r >> 4;
        const float* b = p.in[I_RW] + (size_t)kt * 64 * 256 + nt * 64; s0 = b; s1 = b + 16; s2 = b + 32; s3 = b + 48; ld = 256; ldd = 1024;
        dst = (bf16_t*)(ws + O_ROUT) + (size_t)nt * 64 * 1024 + kt * 64;
      } else if (it < J7) {
        const int r = it - J6; const int kt = r & 15, nt = r >> 4;
        const float* g = p.in[I_WSG] + (size_t)kt * 64 * 256 + nt * 32; const float* u = p.in[I_WSU] + (size_t)kt * 64 * 256 + nt * 32;
        s0 = g; s1 = u; s2 = g + 16; s3 = u + 16; ld = 256; ldd = 1024;
        dst = (bf16_t*)(ws + O_WSGU) + (size_t)nt * 64 * 1024 + kt * 64;
      } else if (it < J8) {
        const int r = it - J7; const int kt = r & 3, nt = r >> 2;
        const float* b = p.in[I_WSD] + (size_t)kt * 64 * 1024 + nt * 64; s0 = b; s1 = b + 16; s2 = b + 32; s3 = b + 48; ld = 1024; ldd = 256;
        dst = (bf16_t*)(ws + O_WSD) + (size_t)nt * 64 * 256 + kt * 64;
      } else if (it < J9) {
        const int r = it - J8; const int e = r >> 7, q = r & 127; const int kt = q & 15, nt = q >> 4;
        const float* g = p.in[I_WG] + (size_t)e * 262144 + (size_t)kt * 64 * 256 + nt * 32; const float* u = p.in[I_WU] + (size_t)e * 262144 + (size_t)kt * 64 * 256 + nt * 32;
        s0 = g; s1 = u; s2 = g + 16; s3 = u + 16; ld = 256; ldd = 1024;
        dst = (bf16_t*)(ws + O_WGU) + (size_t)e * 524288 + (size_t)nt * 64 * 1024 + kt * 64;
      } else {
        const int r = it - J9; const int e = r >> 6, q = r & 63; const int kt = q & 3, nt = q >> 2;
        const float* b = p.in[I_WDN] + (size_t)e * 262144 + (size_t)kt * 64 * 1024 + nt * 64; s0 = b; s1 = b + 16; s2 = b + 32; s3 = b + 48; ld = 1024; ldd = 256;
        dst = (bf16_t*)(ws + O_WD) + (size_t)e * 262144 + (size_t)nt * 64 * 256 + kt * 64;
      }
      transpose_tile(tile, s0, s1, s2, s3, ld, dst, ldd);
    }
  }
}

#define EPI_ROWS(u) const int row_ = (u).pm * 256 + 64 * wr + fr
struct EpiInProj {
  unsigned char* ws;
  DI void operator()(const f32x4 (&acc)[2][2][4][2], const pg::Unit& u, int wr, int wc, int fr, int fq) const {
    const int colt = u.pn * 256;
#pragma unroll
    for (int ai = 0; ai < 2; ++ai)
#pragma unroll
      for (int m = 0; m < 4; ++m) {
        const size_t row = (size_t)u.pm * 256 + 128 * ai + 64 * wr + 16 * m + fr;
#pragma unroll
        for (int bj = 0; bj < 2; ++bj)
#pragma unroll
          for (int n = 0; n < 2; ++n) {
            const int col = colt + 128 * bj + 32 * wc + 16 * n + 4 * fq;
            f32x4 v = acc[ai][bj][m][n];
            if (colt < 1536) { *(u32x2*)((bf16_t*)(ws + O_QKV) + row * 1536 + col) = pack4(v); }
            else if (colt < 2048) {
#pragma unroll
              for (int c = 0; c < 4; ++c) v[c] = siluf_(v[c]);
              *(u32x2*)((bf16_t*)(ws + O_ZS) + row * 512 + (col - 1536)) = pack4(v);
            } else if (colt < 3072) {
#pragma unroll
              for (int c = 0; c < 4; ++c) v[c] = geluf_(v[c]);
              *(u32x2*)((bf16_t*)(ws + O_UVG) + row * 1024 + (col - 2048)) = pack4(v);
            } else if (colt < 3584) {
#pragma unroll
              for (int c = 0; c < 4; ++c) v[c] *= 0.08838834764831845f;
              *(u32x2*)((bf16_t*)(ws + O_XQ) + row * 512 + (col - 3072)) = pack4(v);
            } else {
#pragma unroll
              for (int c = 0; c < 4; ++c) v[c] = sigmoidf_(v[c]);
              *(u32x2*)((bf16_t*)(ws + O_GATES) + row * 3072 + (col - 3584)) = pack4(v);
            }
          }
      }
  }
};
struct EpiMemKV {
  unsigned char* ws;
  DI void operator()(const f32x4 (&acc)[2][2][4][2], const pg::Unit& u, int wr, int wc, int fr, int fq) const {
#pragma unroll
    for (int ai = 0; ai < 2; ++ai)
#pragma unroll
      for (int m = 0; m < 4; ++m) {
        const int row = u.pm * 256 + 128 * ai + 64 * wr + 16 * m + fr; const int b = row >> 8, key = row & 255;
#pragma unroll
        for (int bj = 0; bj < 2; ++bj)
#pragma unroll
          for (int n = 0; n < 2; ++n) {
            const int col = u.pn * 256 + 128 * bj + 32 * wc + 16 * n + 4 * fq;
            const f32x4 v = acc[ai][bj][m][n];
            if (col < 512) { const int h = col >> 7, d = col & 127; *(u32x2*)((bf16_t*)(ws + O_MEMK) + ((size_t)((b * 4 + h) * 256 + key)) * 128 + d) = pack4(v); }
            else {
              const int c2 = col - 512; const int h = c2 >> 7, d = c2 & 127;
              const int pos = 32 * (key >> 5) + 8 * ((key >> 2) & 3) + 4 * ((key >> 4) & 1) + (key & 3);
              bf16_t* vt = (bf16_t*)(ws + O_MEMVT) + ((size_t)((b * 4 + h) * 128 + d)) * 256 + pos;
#pragma unroll
              for (int c = 0; c < 4; ++c) vt[(size_t)c * 256] = f2bf(v[c]);
            }
          }
      }
  }
};
DI void phase1(const Params& p, unsigned char* smem, int bid, int nb) {
  unsigned char* ws = p.ws;
  PG_LAS unsigned char* lds = (PG_LAS unsigned char*)smem;
  __syncthreads();
  { pg::DenseOrder S; S.init(ws + O_XB, ws + O_WINT, T, NPROJ, 1024, nb, bid); EpiInProj E{ws}; pg::gemm_phase<EpiInProj, pg::DenseOrder, false, true>(lds, 1024, S, E); }
  __syncthreads();
  { pg::DenseOrder S; S.init(ws + O_MEMB, ws + O_WMKV, 512, 1024, 1024, nb, bid); EpiMemKV E{ws}; pg::gemm_phase<EpiMemKV, pg::DenseOrder, false, true>(lds, 1024, S, E); }
}

constexpr int G_KF = 0, G_VF = 32768, G_QB = 65536, G_KB = 81920, G_UT = 81920  , G_L = 98304, G_ATT = 114688, G_KDT = 122880, G_WT = 139264, G_SM = 155648;

DI void gdn_prep_item(const Params& p, unsigned char* smem_, int item) {
  unsigned char* smem; { LAS unsigned char* l_ = (LAS unsigned char*)smem_; asm volatile("" : "+v"(l_)); smem = (unsigned char*)l_; }
  int tid = threadIdx.x; asm volatile("" : "+v"(tid));
  const int lane = tid & 63, wave = tid >> 6, fr = lane & 15, fq = lane >> 4;
  unsigned char* ws = p.ws; asm volatile("" : "+s"(ws));
  const int h = item & 3, cn = item >> 2;
  const int bidx = cn >> 7, n = cn & 127;
  const size_t t0 = (size_t)bidx * SEQ + (size_t)n * 64;
  float* kf = (float*)(smem + G_KF); float* vf = (float*)(smem + G_VF); float* Lm = (float*)(smem + G_L);
  float* sbeta = (float*)(smem + G_SM); float* sgc = sbeta + 64; float* segc = sbeta + 128;
  __syncthreads();
  {
    const bf16_t* qkv = (const bf16_t*)(ws + O_QKV);
    const float* cw = p.in[I_CONVW];
    const int tl0 = wave * 8;
#pragma unroll
    for (int sect = 0; sect < 3; ++sect) {
      const int cb = sect * 512 + h * 128 + 2 * lane;
      float w0[4], w1[4];
#pragma unroll
      for (int i = 0; i < 4; ++i) { w0[i] = cw[i * 1536 + cb]; w1[i] = cw[i * 1536 + cb + 1]; }
      float xa[11], xc[11];
#pragma unroll
      for (int r = 0; r < 11; ++r) {
        const int s = n * 64 + tl0 + r - 3;
        unsigned u = 0u;
        if (s >= 0) u = *(const unsigned*)(qkv + ((size_t)bidx * SEQ + s) * 1536 + cb);
        xa[r] = lo2f(u); xc[r] = hi2f(u);
      }
#pragma unroll
      for (int r = 0; r < 8; ++r) {
        float y0 = w0[0] * xa[r] + w0[1] * xa[r + 1] + w0[2] * xa[r + 2] + w0[3] * xa[r + 3];
        float y1 = w1[0] * xc[r] + w1[1] * xc[r + 1] + w1[2] * xc[r + 2] + w1[3] * xc[r + 3];
        y0 = siluf_(y0); y1 = siluf_(y1);
        const int tl = tl0 + r;
        if (sect == 2) { vf[tl * 128 + 2 * lane] = y0; vf[tl * 128 + 2 * lane + 1] = y1; }
        else {
          const float ss = wave_sum(y0 * y0 + y1 * y1);
          const float sc = rsqrtf(ss + 1e-6f) * (sect == 0 ? 0.08838834764831845f : 1.0f);
          y0 *= sc; y1 *= sc;
          const int off = sw256(tl, lane >> 2) + (lane & 3) * 4;
          if (sect == 0) *(unsigned*)(smem + G_QB + off) = pk2(y0, y1);
          else { *(unsigned*)(smem + G_KB + off) = pk2(y0, y1); kf[tl * 128 + 2 * lane] = y0; kf[tl * 128 + 2 * lane + 1] = y1; }
        }
      }
    }
    if (wave == 0) {
      const float* ab = (const float*)(ws + O_AB) + (t0 + lane) * 8;
      const float a = ab[h], bb = ab[4 + h];
      const float beta = sigmoidf_(bb);
      float g = -__expf(p.in[I_ALOG][h]) * softplusf_(a + p.in[I_DTB][h]);
#pragma unroll
      for (int o = 1; o < 64; o <<= 1) { const float y = __shfl_up(g, o); if (lane >= o) g += y; }
      sbeta[lane] = beta; sgc[lane] = g; segc[lane] = __expf(g);
      if (lane == 63) ((float*)(ws + O_GL))[item] = __expf(g);
    }
  }
  __syncthreads();
  {
#pragma unroll
    for (int q = 0; q < 4; ++q) {
      const int idx = wave * 4 + q; const int isq = idx >> 4, ti = (idx >> 2) & 3, tj = idx & 3;
      f32x4 acc = {0.f, 0.f, 0.f, 0.f};
      if (tj <= ti) {
#pragma unroll
        for (int ks = 0; ks < 4; ++ks) {
          const bf16x8 ai = ldfrag(smem + (isq ? G_QB : G_KB) + sw256(16 * ti + fr, 4 * ks + fq));
          const bf16x8 bj = ldfrag(smem + G_KB + sw256(16 * tj + fr, 4 * ks + fq));
          acc = isq ? mfma16(bj, ai, acc) : mfma16(ai, bj, acc);
        }
      }
      if (isq) {
        const int i = 16 * ti + fr, j0 = 16 * tj + 4 * fq;
        const float gi = sgc[i];
        f32x4 o;
#pragma unroll
        for (int r = 0; r < 4; ++r) { const int j = j0 + r; o[r] = (j <= i) ? acc[r] * __expf(gi - sgc[j]) : 0.f; }
        *(u32x2*)(smem + G_ATT + sw128(i, j0 >> 3) + (j0 & 7) * 2) = pack4(o);
      } else {
        const int j = 16 * tj + fr, i0 = 16 * ti + 4 * fq;
        const float gj = sgc[j];
        f32x4 o;
#pragma unroll
        for (int r = 0; r < 4; ++r) { const int i = i0 + r; o[r] = (j < i) ? acc[r] * __expf(sgc[i] - gj) * sbeta[i] : 0.f; }
        *(f32x4*)(Lm + j * 64 + i0) = o;
      }
    }
  }
  {
    const float gl_ = sgc[63];
    const int d = tid & 127, tg = tid >> 7;
#pragma unroll
    for (int c = 0; c < 2; ++c) {
      float e[8];
#pragma unroll
      for (int j = 0; j < 8; ++j) { const int t = 16 * tg + 8 * c + j; e[j] = kf[t * 128 + d] * __expf(gl_ - sgc[t]); }
      u32x4 o = {pk2(e[0], e[1]), pk2(e[2], e[3]), pk2(e[4], e[5]), pk2(e[6], e[7])};
      *(u32x4*)(smem + G_KDT + sw128(d, 2 * tg + c)) = o;
    }
  }
  __syncthreads();
  if (tid < 256) {
    const bool isw = tid >= 128;
    float* X = isw ? (kf + (tid - 128)) : (vf + tid);
    unsigned char* dstT = smem + (isw ? G_WT : G_UT);
    const int rowc = tid & 127;
#pragma unroll
    for (int b = 0; b < 4; ++b) {
      float xr[16];
#pragma unroll
      for (int r = 0; r < 16; ++r) { const int t = 16 * b + r; float sc = sbeta[t]; if (isw) sc *= segc[t]; xr[r] = X[t * 128] * sc; }
#pragma unroll 2
      for (int j = 0; j < 16 * b; ++j) {
        const float xj = X[j * 128];
        const float* lt = Lm + j * 64 + 16 * b;
        const f32x4 l0 = *(const f32x4*)lt, l1 = *(const f32x4*)(lt + 4), l2 = *(const f32x4*)(lt + 8), l3 = *(const f32x4*)(lt + 12);
#pragma unroll
        for (int r = 0; r < 4; ++r) { xr[r] -= l0[r] * xj; xr[4 + r] -= l1[r] * xj; xr[8 + r] -= l2[r] * xj; xr[12 + r] -= l3[r] * xj; }
      }
#pragma unroll
      for (int q = 0; q < 15; ++q) {
        const float* lt = Lm + (16 * b + q) * 64 + 16 * b;
        float l[16];
#pragma unroll
        for (int g4 = 0; g4 < 4; ++g4) if (4 * g4 + 3 > q) { const f32x4 t4 = *(const f32x4*)(lt + 4 * g4); l[4 * g4] = t4[0]; l[4 * g4 + 1] = t4[1]; l[4 * g4 + 2] = t4[2]; l[4 * g4 + 3] = t4[3]; }
#pragma unroll
        for (int r = q + 1; r < 16; ++r) xr[r] -= l[r] * xr[q];
      }
#pragma unroll
      for (int r = 0; r < 16; ++r) X[(16 * b + r) * 128] = xr[r];
      u32x4 o0 = {pk2(xr[0], xr[1]), pk2(xr[2], xr[3]), pk2(xr[4], xr[5]), pk2(xr[6], xr[7])};
      u32x4 o1 = {pk2(xr[8], xr[9]), pk2(xr[10], xr[11]), pk2(xr[12], xr[13]), pk2(xr[14], xr[15])};
      *(u32x4*)(dstT + sw128(rowc, 2 * b)) = o0;
      *(u32x4*)(dstT + sw128(rowc, 2 * b + 1)) = o1;
    }
  }
  __syncthreads();
  {
    bf16x8 ak[2];
#pragma unroll
    for (int ks = 0; ks < 2; ++ks) ak[ks] = ldfrag(smem + G_KDT + sw128(16 * wave + fr, 4 * ks + fq));
    bf16_t* mp = (bf16_t*)(ws + O_MP) + (size_t)item * 16384;
    float* bc = (float*)(ws + O_BC) + (size_t)item * 16384;
#pragma unroll
    for (int tj = 0; tj < 8; ++tj) {
      f32x4 am = {0.f, 0.f, 0.f, 0.f}, ab_ = {0.f, 0.f, 0.f, 0.f};
#pragma unroll
      for (int ks = 0; ks < 2; ++ks) {
        const bf16x8 bw = ldfrag(smem + G_WT + sw128(16 * tj + fr, 4 * ks + fq));
        const bf16x8 bu = ldfrag(smem + G_UT + sw128(16 * tj + fr, 4 * ks + fq));
        am = mfma16(bw, ak[ks], am);
        ab_ = mfma16(ak[ks], bu, ab_);
      }
      f32x4 nm = {-am[0], -am[1], -am[2], -am[3]};
      *(u32x2*)(mp + ((size_t)((wave * 4 + (tj >> 1)) * 64 + lane)) * 8 + (tj & 1) * 4) = pack4(nm);
      *(f32x4*)(bc + ((size_t)((tj * 8 + wave) * 64 + lane)) * 4) = ab_;
    }
    const int tt = wave & 3, hf = wave >> 2;
    bf16x8 aa[2];
#pragma unroll
    for (int ks = 0; ks < 2; ++ks) aa[ks] = ldfrag(smem + G_ATT + sw128(16 * tt + fr, 4 * ks + fq));
    const int trow = 16 * tt + fr;
    const float eg = segc[trow];
    float* o0 = (float*)(ws + O_O0) + (t0 + trow) * 512 + h * 128;
    bf16_t* qp = (bf16_t*)(ws + O_QP) + (size_t)item * 8192 + trow * 128;
#pragma unroll
    for (int q = 0; q < 4; ++q) {
      const int te = hf * 4 + q;
      f32x4 ao = {0.f, 0.f, 0.f, 0.f}, aw = {0.f, 0.f, 0.f, 0.f};
#pragma unroll
      for (int ks = 0; ks < 2; ++ks) {
        const bf16x8 bu = ldfrag(smem + G_UT + sw128(16 * te + fr, 4 * ks + fq));
        const bf16x8 bw = ldfrag(smem + G_WT + sw128(16 * te + fr, 4 * ks + fq));
        ao = mfma16(bu, aa[ks], ao);
        aw = mfma16(bw, aa[ks], aw);
      }
      const int e0 = 16 * te + 4 * fq;
      *(f32x4*)(o0 + e0) = ao;
      const u32x2 qv = *(const u32x2*)(smem + G_QB + sw256(trow, e0 >> 3) + (e0 & 7) * 2);
      f32x4 qd = {lo2f(qv[0]) * eg - aw[0], hi2f(qv[0]) * eg - aw[1], lo2f(qv[1]) * eg - aw[2], hi2f(qv[1]) * eg - aw[3]};
      *(u32x2*)(qp + e0) = pack4(qd);
    }
  }
}

DI void sgu_item(const Params& p, unsigned char* smem_, int item) {
  unsigned char* smem; { LAS unsigned char* l_ = (LAS unsigned char*)smem_; asm volatile("" : "+v"(l_)); smem = (unsigned char*)l_; }
  int tid = threadIdx.x; asm volatile("" : "+v"(tid));
  const int lane = tid & 63, wave = __builtin_amdgcn_readfirstlane(tid >> 6), fr = lane & 15, fq = lane >> 4;
  unsigned char* ws = p.ws; asm volatile("" : "+s"(ws));
  const int g = item & 3, cn = item >> 2;
  const size_t t0 = (size_t)cn * 128;
  const bf16_t* uvg = (const bf16_t*)(ws + O_UVG);
  __syncthreads();
  {
    const float* lng = p.in[I_SLNG]; const float* lnb = p.in[I_SLNB];
    const int cl0 = 8 * (lane & 15);
    float gg[8], bb[8];
#pragma unroll
    for (int e = 0; e < 8; ++e) { gg[e] = lng[128 * g + cl0 + e]; bb[e] = lnb[128 * g + cl0 + e]; }
    for (int jj = 0; jj < 16; ++jj) {
      const int j = 16 * wave + jj;
      const u32x4 raw = *(const u32x4*)(uvg + (t0 + j) * 1024 + 512 + 8 * lane);
      float v[8];
#pragma unroll
      for (int e = 0; e < 4; ++e) { v[2 * e] = lo2f(raw[e]); v[2 * e + 1] = hi2f(raw[e]); }
      float s = 0.f;
#pragma unroll
      for (int e = 0; e < 8; ++e) s += v[e];
      const float mean = wave_sum(s) * (1.f / 512.f);
      float q = 0.f;
#pragma unroll
      for (int e = 0; e < 8; ++e) { const float d = v[e] - mean; q += d * d; }
      const float rstd = rsqrtf(wave_sum(q) * (1.f / 512.f) + 1e-5f);
      if ((lane >> 4) == g) {
#pragma unroll
        for (int e = 0; e < 8; ++e) {
          const int c = cl0 + e;
          const float y = (v[e] - mean) * rstd * gg[e] + bb[e];
          *(bf16_t*)(smem + sw256(c, j >> 3) + (j & 7) * 2) = f2bf(y);
        }
      }
    }
  }
  __syncthreads();
  {
    const bf16_t* wg = (const bf16_t*)(ws + O_SGUW) + (size_t)g * 16384;
    const int i = 16 * wave + fr;
    bf16x8 af[4];
#pragma unroll
    for (int ks = 0; ks < 4; ++ks) af[ks] = ldfrag(wg + i * 128 + 32 * ks + 8 * fq);
    const float bias = p.in[I_SGUB][g * 128 + i];
    bf16_t* out = (bf16_t*)(ws + O_SGUO) + (t0 + i) * 512 + 128 * g;
    const bf16_t* urow = uvg + (t0 + i) * 1024 + 128 * g;
#pragma unroll
    for (int jt = 0; jt < 8; ++jt) {
      f32x4 acc = {0.f, 0.f, 0.f, 0.f};
#pragma unroll
      for (int ks = 0; ks < 4; ++ks) acc = mfma16(ldfrag(smem + sw256(16 * jt + fr, 4 * ks + fq)), af[ks], acc);
      const int c0 = 16 * jt + 4 * fq;
      const u32x2 uu = *(const u32x2*)(urow + c0);
      f32x4 o = {lo2f(uu[0]) * (acc[0] + bias), hi2f(uu[0]) * (acc[1] + bias), lo2f(uu[1]) * (acc[2] + bias), hi2f(uu[1]) * (acc[3] + bias)};
      *(u32x2*)(out + c0) = pack4(o);
    }
  }
}

DI void xattn_item(const Params& p, int item) {
  int tid = threadIdx.x; asm volatile("" : "+v"(tid));
  const int lane = tid & 63, wave = __builtin_amdgcn_readfirstlane(tid >> 6), fr = lane & 15, fq = lane >> 4;
  unsigned char* ws = p.ws; asm volatile("" : "+s"(ws));
  const int h = item & 3, qt = item >> 2;
  const size_t trow = (size_t)qt * 128 + 16 * wave + fr;
  const int b = (qt * 128) >> 13;
  const bf16_t* xq = (const bf16_t*)(ws + O_XQ) + trow * 512 + h * 128;
  const bf16_t* mk = (const bf16_t*)(ws + O_MEMK) + (size_t)(b * 4 + h) * 32768;
  const bf16_t* mv = (const bf16_t*)(ws + O_MEMVT) + (size_t)(b * 4 + h) * 32768;
  bf16x8 qf[4];
#pragma unroll
  for (int ds = 0; ds < 4; ++ds) qf[ds] = ldfrag(xq + 32 * ds + 8 * fq);
  f32x4 sc[16];
#pragma unroll
  for (int kt = 0; kt < 16; ++kt) {
    f32x4 a = {0.f, 0.f, 0.f, 0.f};
#pragma unroll
    for (int ds = 0; ds < 4; ++ds) a = mfma16(ldfrag(mk + (16 * kt + fr) * 128 + 32 * ds + 8 * fq), qf[ds], a);
    sc[kt] = a;
  }
  float m = -1e30f;
#pragma unroll
  for (int kt = 0; kt < 16; ++kt)
#pragma unroll
    for (int r = 0; r < 4; ++r) m = fmaxf(m, sc[kt][r]);
  m = fmaxf(m, __shfl_xor(m, 16)); m = fmaxf(m, __shfl_xor(m, 32));
  float l = 0.f;
#pragma unroll
  for (int kt = 0; kt < 16; ++kt)
#pragma unroll
    for (int r = 0; r < 4; ++r) { const float e = __expf(sc[kt][r] - m); sc[kt][r] = e; l += e; }
  l += __shfl_xor(l, 16); l += __shfl_xor(l, 32);
  const float inv = 1.f / l;
  bf16x8 pf[8];
#pragma unroll
  for (int s = 0; s < 8; ++s) pf[s] = pack8(sc[2 * s], sc[2 * s + 1]);
  bf16_t* out = (bf16_t*)(ws + O_XATO) + trow * 512 + h * 128;
#pragma unroll
  for (int dt = 0; dt < 8; ++dt) {
    f32x4 a = {0.f, 0.f, 0.f, 0.f};
#pragma unroll
    for (int s = 0; s < 8; ++s) a = mfma16(ldfrag(mv + (16 * dt + fr) * 256 + 32 * s + 8 * fq), pf[s], a);
    f32x4 o = {a[0] * inv, a[1] * inv, a[2] * inv, a[3] * inv};
    *(u32x2*)(out + 16 * dt + 4 * fq) = pack4(o);
  }
}

DI void phase2(const Params& p, unsigned char* smem, int bid, int nb) {
  for (int rep = 0; rep < ((DUPMASK >> 20) & 1) + 1; ++rep) for (int it = bid; it < 1024; it += nb) gdn_prep_item(p, smem, it);
  for (int rep = 0; rep < ((DUPMASK >> 21) & 1) + 1; ++rep) for (int it = bid; it < 512; it += nb) sgu_item(p, smem, it);
  for (int rep = 0; rep < ((DUPMASK >> 22) & 1) + 1; ++rep) for (int it = bid; it < 512; it += nb) xattn_item(p, it);
}

DI void gdn_scan4(const Params& p, unsigned char* smem_, int bh, int es) {
  int tid = threadIdx.x; asm volatile("" : "+v"(tid));
  unsigned char* smem; { LAS unsigned char* l_ = (LAS unsigned char*)smem_; asm volatile("" : "+v"(l_)); smem = (unsigned char*)l_; }
  const int lane = tid & 63, w = __builtin_amdgcn_readfirstlane(tid >> 6);
  if (w >= 4) {
    for (int n = 0; n < 128; ++n) __builtin_amdgcn_s_barrier();
    return;
  }
  unsigned char* ws = p.ws;
  const int b = bh >> 2, h = bh & 3;
  const int fr = lane & 15, fq = lane >> 4;
  const size_t item0 = (size_t)(b * 128) * 4 + h;
  constexpr size_t ISTR = 4 * 16384;
  const bf16_t* mp = (const bf16_t*)(ws + O_MP) + item0 * 16384 + (size_t)(2 * w) * 2048 + lane * 8;
  const float* bc = (const float*)(ws + O_BC) + item0 * 16384 + (size_t)es * 2048 + (size_t)(2 * w) * 256 + lane * 4;
  bf16_t* st = (bf16_t*)(ws + O_ST) + item0 * 16384 + (size_t)(16 * es + fr) * 128 + 32 * w + 4 * fq;
  const float* glp = (const float*)(ws + O_GL) + item0;
  asm volatile("" : "+v"(glp));
  f32x4 acc0 = {0.f, 0.f, 0.f, 0.f}, acc1 = {0.f, 0.f, 0.f, 0.f};
  constexpr int PD = 2;
  bf16x8 A[PD][8]; f32x4 C[PD][2]; float G[PD];
#pragma unroll
  for (int d = 0; d < PD; ++d) {
#pragma unroll
    for (int i = 0; i < 8; ++i) A[d][i] = ldfrag(mp + (size_t)d * ISTR + i * 512);
    C[d][0] = *(const f32x4*)(bc + (size_t)d * ISTR); C[d][1] = *(const f32x4*)(bc + (size_t)d * ISTR + 256);
    G[d] = glp[d * 4];
  }
  unsigned char* xch = smem;
  for (int n0 = 0; n0 < 128; n0 += PD) {
#pragma unroll
    for (int d = 0; d < PD; ++d) {
      const int n = n0 + d;
      const int np = (n + PD < 128) ? n + PD : n;
      const u32x2 lo = pack4(acc0), hi = pack4(acc1);
      bf16_t* stn = st + (size_t)n * ISTR;
      *(u32x2*)(stn) = lo; *(u32x2*)(stn + 16) = hi;
      const u32x4 mine = {lo[0], lo[1], hi[0], hi[1]};
      *(u32x4*)(xch + ((n & 1) * 4 + w) * 1024 + lane * 16) = mine;
      asm volatile("s_waitcnt lgkmcnt(0)" ::: "memory");
      __builtin_amdgcn_s_barrier();
      asm volatile("" ::: "memory");
      bf16x8 bfr[4];
#pragma unroll
      for (int s = 0; s < 4; ++s) bfr[s] = ldfrag(xch + ((n & 1) * 4 + s) * 1024 + lane * 16);
      const float g = G[d];
      f32x4 a0 = {g * acc0[0] + C[d][0][0], g * acc0[1] + C[d][0][1], g * acc0[2] + C[d][0][2], g * acc0[3] + C[d][0][3]};
      f32x4 a1 = {g * acc1[0] + C[d][1][0], g * acc1[1] + C[d][1][1], g * acc1[2] + C[d][1][2], g * acc1[3] + C[d][1][3]};
#pragma unroll
      for (int s = 0; s < 4; ++s) { a0 = mfma16(A[d][s], bfr[s], a0); a1 = mfma16(A[d][4 + s], bfr[s], a1); }
      acc0 = a0; acc1 = a1;
#pragma unroll
      for (int i = 0; i < 8; ++i) A[d][i] = ldfrag(mp + (size_t)np * ISTR + i * 512);
      C[d][0] = *(const f32x4*)(bc + (size_t)np * ISTR); C[d][1] = *(const f32x4*)(bc + (size_t)np * ISTR + 256);
      G[d] = glp[(size_t)np * 4];
    }
  }
}

struct EpiGate {
  const bf16_t* gates; int goff; const bf16_t* src; bf16_t* dst;
  DI void operator()(const f32x4 (&acc)[2][2][4][2], const pg::Unit& u, int wr, int wc, int fr, int fq) const {
#pragma unroll
    for (int ai = 0; ai < 2; ++ai)
#pragma unroll
      for (int m = 0; m < 4; ++m) {
        const size_t row = (size_t)u.pm * 256 + 128 * ai + 64 * wr + 16 * m + fr;
#pragma unroll
        for (int bj = 0; bj < 2; ++bj)
#pragma unroll
          for (int n = 0; n < 2; ++n) {
            const int col = u.pn * 256 + 128 * bj + 32 * wc + 16 * n + 4 * fq;
            const f32x4 v = acc[ai][bj][m][n];
            const u32x2 g = *(const u32x2*)(gates + row * 3072 + goff + col);
            f32x4 o = {lo2f(g[0]) * v[0], hi2f(g[0]) * v[1], lo2f(g[1]) * v[2], hi2f(g[1]) * v[3]};
            if (src) { const u32x2 s = *(const u32x2*)(src + row * 1024 + col); o[0] += lo2f(s[0]); o[1] += hi2f(s[0]); o[2] += lo2f(s[1]); o[3] += hi2f(s[1]); }
            *(u32x2*)(dst + row * 1024 + col) = pack4(o);
          }
      }
  }
};
DI void phase3(const Params& p, unsigned char* smem, int bid, int nb) {
  unsigned char* ws = p.ws;
  if (bid < 64) {
    __syncthreads();
    gdn_scan4(p, smem, bid & 7, bid >> 3);
  } else {
    PG_LAS unsigned char* lds = (PG_LAS unsigned char*)smem;
    const bf16_t* gates = (const bf16_t*)(ws + O_GATES);
    bf16_t* part = (bf16_t*)(ws + O_PART);
    __syncthreads();
    { pg::DenseOrder S; S.init(ws + O_SGUO, ws + O_WBT, T, 1024, 512, nb - 64, bid - 64); EpiGate E{gates, 1024, nullptr, part}; pg::gemm_phase<EpiGate, pg::DenseOrder, false, true>(lds, 512, S, E); }
    asm volatile("s_waitcnt vmcnt(0)" ::: "memory");
    __builtin_amdgcn_fence(__ATOMIC_ACQUIRE, "agent");
    asm volatile("s_waitcnt vmcnt(0)" ::: "memory");
    __syncthreads();
    { pg::DenseOrder S; S.init(ws + O_XATO, ws + O_WCT, T, 1024, 512, nb - 64, bid - 64); EpiGate E{gates, 2048, part, part}; pg::gemm_phase<EpiGate, pg::DenseOrder, false, true>(lds, 512, S, E); }
  }
}

DI void phase4(const Params& p, int bid, int nb) {
  int tid = threadIdx.x; asm volatile("" : "+v"(tid));
  const int lane = tid & 63, wave = tid >> 6, fr = lane & 15, fq = lane >> 4;
  unsigned char* ws = p.ws;
  for (int it = bid; it < 512; it += nb) {
    const int item = it * 2 + (wave >> 2), tt = wave & 3;
    const int h = item & 3, cn = item >> 2;
    const size_t trow = (size_t)cn * 64 + 16 * tt + fr;
    const bf16_t* qp = (const bf16_t*)(ws + O_QP) + (size_t)item * 8192 + (16 * tt + fr) * 128;
    const bf16_t* st = (const bf16_t*)(ws + O_ST) + (size_t)item * 16384;
    const float* o0 = (const float*)(ws + O_O0) + trow * 512 + h * 128;
    bf16x8 af[4];
#pragma unroll
    for (int ks = 0; ks < 4; ++ks) af[ks] = ldfrag(qp + 32 * ks + 8 * fq);
    f32x4 acc[8];
    float ss = 0.f;
#pragma unroll
    for (int j = 0; j < 8; ++j) {
      f32x4 a = *(const f32x4*)(o0 + 16 * j + 4 * fq);
#pragma unroll
      for (int ks = 0; ks < 4; ++ks) a = mfma16(ldfrag(st + (16 * j + fr) * 128 + 32 * ks + 8 * fq), af[ks], a);
      acc[j] = a;
      ss += a[0] * a[0] + a[1] * a[1] + a[2] * a[2] + a[3] * a[3];
    }
    ss += __shfl_xor(ss, 16); ss += __shfl_xor(ss, 32);
    const float rms = rsqrtf(ss * (1.f / 128.f) + 1e-6f);
    const float* ng = p.in[I_GNG];
    const bf16_t* zs = (const bf16_t*)(ws + O_ZS) + trow * 512 + h * 128;
    bf16_t* out = (bf16_t*)(ws + O_GDNO) + trow * 512 + h * 128;
#pragma unroll
    for (int j = 0; j < 8; ++j) {
      const int e0 = 16 * j + 4 * fq;
      const f32x4 g = *(const f32x4*)(ng + e0);
      const u32x2 z = *(const u32x2*)(zs + e0);
      f32x4 o = {acc[j][0] * rms * g[0] * lo2f(z[0]), acc[j][1] * rms * g[1] * hi2f(z[0]), acc[j][2] * rms * g[2] * lo2f(z[1]), acc[j][3] * rms * g[3] * hi2f(z[1])};
      *(u32x2*)(out + e0) = pack4(o);
    }
  }
}

DI void phase5(const Params& p, unsigned char* smem, int bid, int nb) {
  unsigned char* ws = p.ws;
  PG_LAS unsigned char* lds = (PG_LAS unsigned char*)smem;
  __syncthreads();
  pg::DenseOrder S; S.init(ws + O_GDNO, ws + O_WAT, T, 1024, 512, nb, bid);
  EpiGate E{(const bf16_t*)(ws + O_GATES), 0, (const bf16_t*)(ws + O_PART), (bf16_t*)(ws + O_MERGED)};
  pg::gemm_phase<EpiGate, pg::DenseOrder, false, true>(lds, 512, S, E);
}
struct EpiX1 {
  const float* x; float* x1;
  DI void operator()(const f32x4 (&acc)[2][2][4][2], const pg::Unit& u, int wr, int wc, int fr, int fq) const {
#pragma unroll
    for (int ai = 0; ai < 2; ++ai)
#pragma unroll
      for (int m = 0; m < 4; ++m) {
        const size_t row = (size_t)u.pm * 256 + 128 * ai + 64 * wr + 16 * m + fr;
#pragma unroll
        for (int bj = 0; bj < 2; ++bj)
#pragma unroll
          for (int n = 0; n < 2; ++n) {
            const int col = u.pn * 256 + 128 * bj + 32 * wc + 16 * n + 4 * fq;
            const f32x4 v = acc[ai][bj][m][n];
            const f32x4 xv = *(const f32x4*)(x + row * 1024 + col);
            f32x4 o = {ALPHA * xv[0] + v[0], ALPHA * xv[1] + v[1], ALPHA * xv[2] + v[2], ALPHA * xv[3] + v[3]};
            *(f32x4*)(x1 + row * 1024 + col) = o;
          }
      }
  }
};
DI void phase6(const Params& p, unsigned char* smem, int bid, int nb) {
  unsigned char* ws = p.ws;
  PG_LAS unsigned char* lds = (PG_LAS unsigned char*)smem;
  __syncthreads();
  pg::DenseOrder S; S.init(ws + O_MERGED, ws + O_WOT, T, 1024, 1024, nb, bid);
  EpiX1 E{p.in[I_X], (float*)(ws + O_X1)};
  pg::gemm_phase<EpiX1, pg::DenseOrder, false, false>(lds, 1024, S, E);
}

DI void ln_row(const float* src, const float* g, const float* b, float (&v)[16], int lane) {
  float s = 0.f;
#pragma unroll
  for (int i = 0; i < 16; ++i) s += v[i];
  const float mean = wave_sum(s) * (1.f / 1024.f);
  float q = 0.f;
#pragma unroll
  for (int i = 0; i < 16; ++i) { const float d = v[i] - mean; q += d * d; }
  const float rstd = rsqrtf(wave_sum(q) * (1.f / 1024.f) + 1e-5f);
#pragma unroll
  for (int i = 0; i < 4; ++i) {
    const int k = 256 * i + 4 * lane;
    const f32x4 gg = *(const f32x4*)(g + k), bb = *(const f32x4*)(b + k);
#pragma unroll
    for (int c = 0; c < 4; ++c) v[4 * i + c] = (v[4 * i + c] - mean) * rstd * gg[c] + bb[c];
  }
}
DI void phase7(const Params& p, int bid, int nb) {
  int tid = threadIdx.x; asm volatile("" : "+v"(tid));
  const int lane = tid & 63, wave = tid >> 6;
  unsigned char* ws = p.ws;
  for (int i = bid * NTHR + tid; i < MAXSLOT; i += nb * NTHR) { ((int*)(ws + O_SLOTTOK))[i] = 0; ((int*)(ws + O_SLOTAID))[i] = -1; }
  float* x1 = (float*)(ws + O_X1);
  bf16_t* x1b = (bf16_t*)(ws + O_X1B);
  for (int row = bid * 8 + wave; row < T; row += nb * 8) {
    float v[16];
#pragma unroll
    for (int i = 0; i < 4; ++i) { const f32x4 t = *(const f32x4*)(x1 + (size_t)row * D + 256 * i + 4 * lane); v[4 * i] = t[0]; v[4 * i + 1] = t[1]; v[4 * i + 2] = t[2]; v[4 * i + 3] = t[3]; }
    ln_row(nullptr, p.in[I_LN1G], p.in[I_LN1B], v, lane);
#pragma unroll
    for (int i = 0; i < 4; ++i) {
      const f32x4 o = {v[4 * i], v[4 * i + 1], v[4 * i + 2], v[4 * i + 3]};
      *(f32x4*)(x1 + (size_t)row * D + 256 * i + 4 * lane) = o;
      *(u32x2*)(x1b + (size_t)row * D + 256 * i + 4 * lane) = pack4(o);
    }
  }
}
struct EpiLogits {
  float* logits;
  DI void operator()(const f32x4 (&acc)[2][2][4][2], const pg::Unit& u, int wr, int wc, int fr, int fq) const {
#pragma unroll
    for (int ai = 0; ai < 2; ++ai)
#pragma unroll
      for (int m = 0; m < 4; ++m) {
        const size_t row = (size_t)u.pm * 256 + 128 * ai + 64 * wr + 16 * m + fr;
#pragma unroll
        for (int bj = 0; bj < 2; ++bj)
#pragma unroll
          for (int n = 0; n < 2; ++n) *(f32x4*)(logits + row * 256 + 128 * bj + 32 * wc + 16 * n + 4 * fq) = acc[ai][bj][m][n];
      }
  }
};
DI void phase8(const Params& p, unsigned char* smem, int bid, int nb) {
  unsigned char* ws = p.ws;
  PG_LAS unsigned char* lds = (PG_LAS unsigned char*)smem;
  __syncthreads();
  pg::DenseOrder S; S.init(ws + O_X1B, ws + O_ROUT, T, 256, 1024, nb, bid);
  EpiLogits E{(float*)(ws + O_LOGITS)};
  pg::gemm_phase<EpiLogits, pg::DenseOrder, false, false>(lds, 1024, S, E);
}
DI void phase9(const Params& p, int bid, int nb) {
  int tid = threadIdx.x; asm volatile("" : "+v"(tid));
  const int lane = tid & 63, wave = tid >> 6;
  unsigned char* ws = p.ws;
  const float* logits = (const float*)(ws + O_LOGITS);
  int* counts = (int*)(ws + O_CTRL);
  const f32x4 bias = *(const f32x4*)(p.in[I_RB] + 4 * lane);
  const float NEG = -__builtin_inff();
  for (int tok = bid * 8 + wave; tok < T; tok += nb * 8) {
    const f32x4 lg = *(const f32x4*)(logits + (size_t)tok * 256 + 4 * lane);
    float sc[4], mv[4];
#pragma unroll
    for (int c = 0; c < 4; ++c) { sc[c] = sigmoidf_(lg[c]); mv[c] = sc[c] + bias[c]; }
    float m1 = NEG, m2 = NEG;
#pragma unroll
    for (int c = 0; c < 4; ++c) { const float v = mv[c]; if (v > m1) { m2 = m1; m1 = v; } else if (v > m2) m2 = v; }
#pragma unroll
    for (int o = 1; o < 8; o <<= 1) {
      const float o1 = __shfl_xor(m1, o), o2 = __shfl_xor(m2, o);
      const float n1 = fmaxf(m1, o1), n2 = fmaxf(fminf(m1, o1), fmaxf(m2, o2));
      m1 = n1; m2 = n2;
    }
    const float gs = m1 + m2;
    const int g = lane >> 3;
    int rank = 0;
#pragma unroll
    for (int gg = 0; gg < 8; ++gg) { const float og = __shfl(gs, gg * 8); rank += ((og > gs) || (og == gs && gg < g)) ? 1 : 0; }
    if (rank >= 4) {
#pragma unroll
      for (int c = 0; c < 4; ++c) mv[c] = NEG;
    }
    int myidx = 0; float mysc = 0.f, ssum = 0.f;
#pragma unroll
    for (int k = 0; k < 8; ++k) {
      float bv = mv[0]; int bi = 0;
#pragma unroll
      for (int c = 1; c < 4; ++c) if (mv[c] > bv) { bv = mv[c]; bi = c; }
      float rv = bv; int ri = lane * 4 + bi;
#pragma unroll
      for (int o = 32; o; o >>= 1) {
        const float ov = __shfl_xor(rv, o); const int oi = __shfl_xor(ri, o);
        if (ov > rv || (ov == rv && oi < ri)) { rv = ov; ri = oi; }
      }
      const int wl = ri >> 2, wc = ri & 3;
      const float mine = wc == 0 ? sc[0] : wc == 1 ? sc[1] : wc == 2 ? sc[2] : sc[3];
      const float wsc = __shfl(mine, wl);
      if (lane == wl) {
#pragma unroll
        for (int c = 0; c < 4; ++c) if (c == wc) mv[c] = NEG;
      }
      ssum += wsc;
      if (lane == k) { myidx = ri; mysc = wsc; }
    }
    if (lane < 8) {
      const int pos = atomicAdd(&counts[myidx * CSTR], 1);
      ((int*)(ws + O_TKIDX))[(size_t)tok * 8 + lane] = myidx;
      ((float*)(ws + O_TKW))[(size_t)tok * 8 + lane] = mysc / ssum * 2.5f;
      ((int*)(ws + O_TKPOS))[(size_t)tok * 8 + lane] = pos;
    }
  }
}
DI void build_tile_start(const Params& p, int* ts) {
  const int tid = threadIdx.x;
  const int* counts = (const int*)(p.ws + O_CTRL);
  __syncthreads();
  if (tid < 256) ts[300 + tid] = (counts[tid * CSTR] + 255) >> 8;
  __syncthreads();
  if (tid == 0) { int s = 0; for (int e = 0; e < 256; ++e) { ts[e] = s; s += ts[300 + e]; } ts[256] = s; }
  __syncthreads();
}
DI void phase10(const Params& p, unsigned char* smem, int bid, int nb) {
  int* ts = (int*)smem;
  build_tile_start(p, ts);
  unsigned char* ws = p.ws;
  const int* tkidx = (const int*)(ws + O_TKIDX); const int* tkpos = (const int*)(ws + O_TKPOS); const float* tkw = (const float*)(ws + O_TKW);
  int* slottok = (int*)(ws + O_SLOTTOK); float* slotw = (float*)(ws + O_SLOTW); int* slotaid = (int*)(ws + O_SLOTAID);
  for (int i = bid * NTHR + threadIdx.x; i < T * 8; i += nb * NTHR) {
    const int e = tkidx[i];
    const int slot = ts[e] * 256 + tkpos[i];
    slottok[slot] = i >> 3; slotw[slot] = tkw[i]; slotaid[slot] = i;
  }
}

DI int find_expert(const int* ts, int ti) { int lo = 0, hi = 255; while (lo < hi) { const int mid = (lo + hi + 1) >> 1; if (ts[mid] <= ti) lo = mid; else hi = mid - 1; } return lo; }

template <int NPN, bool UP>
struct MoeOrder {
  const int* ts; unsigned char* ws; int ntile, G, c;
  DI bool next(int i, pg::Unit& u) const {
    const int L = i * G + c;
    if (L >= ntile * NPN) return false;
    const int ti = L / NPN, pn = L - ti * NPN;
    const int e = find_expert(ts, ti);
    u.pm = ti; u.pn = pn; u.e = e;
    if (UP) { u.a = (const char*)(ws + O_X1B); u.rows = (const int*)(ws + O_SLOTTOK) + ti * 256; u.b = (const char*)(ws + O_WGU) + (size_t)e * 1048576 + (size_t)pn * 524288; }
    else    { u.a = (const char*)(ws + O_ACT) + (size_t)ti * 131072; u.rows = nullptr; u.b = (const char*)(ws + O_WD) + (size_t)e * 524288 + (size_t)pn * 131072; }
    return true;
  }
};
struct EpiAct {
  bf16_t* actp;
  DI void operator()(const f32x4 (&acc)[2][2][4][2], const pg::Unit& u, int wr, int wc, int fr, int fq) const {
#pragma unroll
    for (int ai = 0; ai < 2; ++ai)
#pragma unroll
      for (int m = 0; m < 4; ++m) {
        const size_t row = (size_t)u.pm * 256 + 128 * ai + 64 * wr + 16 * m + fr;
#pragma unroll
        for (int bj = 0; bj < 2; ++bj) {
          const int blk = 8 * u.pn + 4 * bj + wc;
          const f32x4 g = acc[ai][bj][m][0], uu = acc[ai][bj][m][1];
          f32x4 o = {siluf_(g[0]) * uu[0], siluf_(g[1]) * uu[1], siluf_(g[2]) * uu[2], siluf_(g[3]) * uu[3]};
          *(u32x2*)(actp + row * 256 + blk * 16 + 4 * fq) = pack4(o);
        }
      }
  }
};
struct EpiBf16Out {
  bf16_t* dst;
  DI void operator()(const f32x4 (&acc)[2][2][4][2], const pg::Unit& u, int wr, int wc, int fr, int fq) const {
#pragma unroll
    for (int ai = 0; ai < 2; ++ai)
#pragma unroll
      for (int m = 0; m < 4; ++m) {
        const size_t row = (size_t)u.pm * 256 + 128 * ai + 64 * wr + 16 * m + fr;
#pragma unroll
        for (int bj = 0; bj < 2; ++bj)
#pragma unroll
          for (int n = 0; n < 2; ++n) *(u32x2*)(dst + row * 1024 + u.pn * 256 + 128 * bj + 32 * wc + 16 * n + 4 * fq) = pack4(acc[ai][bj][m][n]);
      }
  }
};
struct EpiDown {
  const int* slotaid; const float* slotw; unsigned char* ybase;
  DI void operator()(const f32x4 (&acc)[2][2][4][2], const pg::Unit& u, int wr, int wc, int fr, int fq) const {
    const unsigned row0 = (unsigned)u.pm * 256u + 64u * wr + fr;
    const unsigned colb = ((unsigned)u.pn * 256u + 32u * wc + 4u * fq) * 2u;
#pragma unroll
    for (int ai = 0; ai < 2; ++ai) {
#pragma unroll
      for (int m = 0; m < 4; ++m) {
        const unsigned row = row0 + 128u * ai + 16u * m;
        const int aid = slotaid[row]; const float ww = slotw[row];
        if (aid >= 0) {
          const unsigned off = (unsigned)aid * 2048u + colb;
#pragma unroll
          for (int bj = 0; bj < 2; ++bj)
#pragma unroll
            for (int n = 0; n < 2; ++n) {
              const f32x4 v = acc[ai][bj][m][n];
              f32x4 o = {v[0] * ww, v[1] * ww, v[2] * ww, v[3] * ww};
              *(u32x2*)(ybase + (size_t)(off + (unsigned)(256 * bj + 32 * n))) = pack4(o);
            }
        }
      }
      asm volatile("" ::: "memory");
    }
  }
};
DI void phase11(const Params& p, unsigned char* smem, int bid, int nb) {
  unsigned char* ws = p.ws;
  int* ts = (int*)(smem + 131072);
  build_tile_start(p, ts);
  PG_LAS unsigned char* lds = (PG_LAS unsigned char*)smem;
  { MoeOrder<2, true> S{ts, ws, ts[256], nb, bid}; EpiAct E{(bf16_t*)(ws + O_ACT)}; pg::gemm_phase<EpiAct, MoeOrder<2, true>, true, true>(lds, 1024, S, E); }
  __syncthreads();
  { pg::DenseOrder S; S.init(ws + O_X1B, ws + O_WSGU, T, 512, 1024, nb, bid); EpiAct E{(bf16_t*)(ws + O_ACTSH)}; pg::gemm_phase<EpiAct, pg::DenseOrder, false, true>(lds, 1024, S, E); }
}
DI void phase12(const Params& p, unsigned char* smem, int bid, int nb) {
  unsigned char* ws = p.ws;
  int* ts = (int*)(smem + 131072);
  build_tile_start(p, ts);
  PG_LAS unsigned char* lds = (PG_LAS unsigned char*)smem;
  { MoeOrder<4, false> S{ts, ws, ts[256], nb, bid}; EpiDown E{(const int*)(ws + O_SLOTAID), (const float*)(ws + O_SLOTW), ws + O_Y}; pg::gemm_phase<EpiDown, MoeOrder<4, false>, false, true>(lds, 256, S, E); }
  __syncthreads();
  { pg::DenseOrder S; S.init(ws + O_ACTSH, ws + O_WSD, T, 1024, 256, nb, bid); EpiBf16Out E{(bf16_t*)(ws + O_YSH)}; pg::gemm_phase<EpiBf16Out, pg::DenseOrder, false, true>(lds, 256, S, E); }
}
DI void phase13(const Params& p, int bid, int nb) {
  int tid = threadIdx.x; asm volatile("" : "+v"(tid));
  const int lane = tid & 63, wave = tid >> 6;
  unsigned char* ws = p.ws;
  const float* x1 = (const float*)(ws + O_X1);
  const bf16_t* ysh = (const bf16_t*)(ws + O_YSH);
  const bf16_t* y = (const bf16_t*)(ws + O_Y);
  for (int row = bid * 8 + wave; row < T; row += nb * 8) {
    float v[16];
#pragma unroll
    for (int i = 0; i < 4; ++i) {
      const int k = 256 * i + 4 * lane;
      const f32x4 t = *(const f32x4*)(x1 + (size_t)row * D + k);
      const u32x2 s = *(const u32x2*)(ysh + (size_t)row * D + k);
      v[4 * i] = ALPHA * t[0] + lo2f(s[0]); v[4 * i + 1] = ALPHA * t[1] + hi2f(s[0]); v[4 * i + 2] = ALPHA * t[2] + lo2f(s[1]); v[4 * i + 3] = ALPHA * t[3] + hi2f(s[1]);
    }
#pragma unroll
    for (int k8 = 0; k8 < 8; ++k8) {
#pragma unroll
      for (int i = 0; i < 4; ++i) {
        const u32x2 s = *(const u32x2*)(y + ((size_t)row * 8 + k8) * 1024 + 256 * i + 4 * lane);
        v[4 * i] += lo2f(s[0]); v[4 * i + 1] += hi2f(s[0]); v[4 * i + 2] += lo2f(s[1]); v[4 * i + 3] += hi2f(s[1]);
      }
    }
    ln_row(nullptr, p.in[I_LN2G], p.in[I_LN2B], v, lane);
#pragma unroll
    for (int i = 0; i < 4; ++i) { const f32x4 o = {v[4 * i], v[4 * i + 1], v[4 * i + 2], v[4 * i + 3]}; *(f32x4*)(p.out + (size_t)row * D + 256 * i + 4 * lane) = o; }
  }
}

DI void load_params(Params& lp, const unsigned char* smem) {
  const unsigned* t = (const unsigned*)(smem + PTAB_OFF);
#pragma unroll
  for (int i = 0; i < 28; ++i) lp.in[i] = (const float*)(((unsigned long long)(unsigned)__builtin_amdgcn_readfirstlane((int)t[2 * i + 1]) << 32) | (unsigned)__builtin_amdgcn_readfirstlane((int)t[2 * i]));
  lp.out = (float*)(((unsigned long long)(unsigned)__builtin_amdgcn_readfirstlane((int)t[57]) << 32) | (unsigned)__builtin_amdgcn_readfirstlane((int)t[56]));
  lp.ws = (unsigned char*)(((unsigned long long)(unsigned)__builtin_amdgcn_readfirstlane((int)t[59]) << 32) | (unsigned)__builtin_amdgcn_readfirstlane((int)t[58]));
}
__global__ void __launch_bounds__(NTHR) mega_kernel(Params pk) {
  extern __shared__ __attribute__((aligned(16))) unsigned char smem[];
  cg::grid_group grid = cg::this_grid();
  const int bid = blockIdx.x, nb = gridDim.x;
  volatile LAS unsigned* bst = (volatile LAS unsigned*)(smem + LDS_BYTES - 16);
  if (threadIdx.x < 4) bst[threadIdx.x] = 0u;
  if (threadIdx.x < 30) {
    const __attribute__((address_space(4))) unsigned long long* ka = (const __attribute__((address_space(4))) unsigned long long*)__builtin_amdgcn_kernarg_segment_ptr();
    ((unsigned long long*)(smem + PTAB_OFF))[threadIdx.x] = ka[threadIdx.x];
  }
  unsigned* barw = (unsigned*)(pk.ws + O_BAR);
  __syncthreads();
  XcdBarrier xb = xcd_barrier_post(barw, bst);
#define GSYNC() xcd_barrier(xb)
#define RUNP(k, call) do { { Params p; load_params(p, smem); call; } GSYNC(); if (DUPMASK & (1 << (k))) { { Params p; load_params(p, smem); call; } GSYNC(); } } while (0)
  { Params p; load_params(p, smem); phase0(p, smem, bid, nb); } grid.sync();
  RUNP(1, phase1(p, smem, bid, nb));
  RUNP(2, phase2(p, smem, bid, nb));
  RUNP(3, phase3(p, smem, bid, nb));
  RUNP(4, phase4(p, bid, nb));
  RUNP(5, phase5(p, smem, bid, nb));
  RUNP(14, phase6(p, smem, bid, nb));
  RUNP(14, phase7(p, bid, nb));
  RUNP(8, phase8(p, smem, bid, nb));
  RUNP(14, phase9(p, bid, nb));
  RUNP(10, phase10(p, smem, bid, nb));
  RUNP(11, phase11(p, smem, bid, nb));
  RUNP(12, phase12(p, smem, bid, nb));
  { Params p; load_params(p, smem); phase13(p, bid, nb); }
  if (DUPMASK & (1 << 13)) { GSYNC(); Params p; load_params(p, smem); phase13(p, bid, nb); }
  if (DUPMASK & (1 << 15)) { for (int i = 0; i < 10; ++i) GSYNC(); }
}

extern "C" void kernel_launch(void* const* d_in, const int* in_sizes, int n_in, void* d_out, int out_size, void* d_ws, size_t ws_size, hipStream_t stream) {
  if (n_in != 28 || ws_size < WS_NEED) { fprintf(stderr, "kernel_launch: unexpected inputs (%d) or workspace (%zu < %zu)\n", n_in, ws_size, (size_t)WS_NEED); return; }
  static int grid_blocks = 0;
  if (!grid_blocks) {
    int dev = 0, cus = 0, per_cu = 0;
    (void)hipGetDevice(&dev);
    (void)hipDeviceGetAttribute(&cus, hipDeviceAttributeMultiprocessorCount, dev);
    (void)hipFuncSetAttribute((const void*)mega_kernel, hipFuncAttributeMaxDynamicSharedMemorySize, LDS_BYTES);
    (void)hipOccupancyMaxActiveBlocksPerMultiprocessor(&per_cu, (const void*)mega_kernel, NTHR, LDS_BYTES);
    if (per_cu < 1) per_cu = 1;
    if (per_cu > 1) per_cu = 1;
    grid_blocks = cus * per_cu;
    if (grid_blocks < 32) grid_blocks = 32;
  }
  Params p{};
  for (int i = 0; i < 28; ++i) p.in[i] = (const float*)d_in[i];
  p.out = (float*)d_out; p.ws = (unsigned char*)d_ws;
  (void)hipMemsetAsync((unsigned char*)d_ws + O_BAR, 0, XCD_BAR_WORDS * 4, stream);
  void* args[] = {&p};
  hipError_t e = hipLaunchCooperativeKernel((const void*)mega_kernel, dim3(grid_blocks), dim3(NTHR), args, LDS_BYTES, stream);
  if (e != hipSuccess) fprintf(stderr, "cooperative launch failed: %s (grid %d)\n", hipGetErrorString(e), grid_blocks);
}
```

```cpp
#include <hip/hip_runtime.h>
#include <hip/hip_cooperative_groups.h>
#include <stdint.h>
#include <stdio.h>
namespace cg = cooperative_groups;

#define DI __device__ __forceinline__
#define LAS __attribute__((address_space(3)))
typedef unsigned short bf16_t;
typedef short bf16x8 __attribute__((ext_vector_type(8)));
typedef float f32x4 __attribute__((ext_vector_type(4)));
typedef unsigned u32x4 __attribute__((ext_vector_type(4)));
typedef unsigned u32x2 __attribute__((ext_vector_type(2)));

#ifndef DUPMASK
#define DUPMASK 0
#endif
constexpr int NTHR = 512;
constexpr int T = 16384, SEQ = 8192, D = 1024;
constexpr int NPROJ = 6656;
constexpr int DIN = 6664;
constexpr int NEXP = 256, DEXP = 256;
constexpr int MAXSLOT = 131072 + 256 * 256;
constexpr float ALPHA = 1.189207115002721f;
constexpr int LDS_BYTES = 157696;

constexpr size_t MB = 1u << 20;
constexpr size_t O_WGU = 0;
constexpr size_t O_WD = 256 * MB;
constexpr size_t O_WSGU = 384 * MB;
constexpr size_t O_WSD = 385 * MB;
constexpr size_t O_ROUT = 385 * MB + 512 * 1024;
constexpr size_t O_CTRL = 386 * MB;
constexpr size_t O_BAR = 386 * MB + 128 * 1024;
constexpr int CSTR = 64;
constexpr size_t O_IDENT = 386 * MB + 256 * 1024;
constexpr size_t O_X1 = 387 * MB;
constexpr size_t O_X1B = 451 * MB;
constexpr size_t R0 = 483 * MB;
constexpr size_t O_XB = R0 + 0;
constexpr size_t O_ST = R0 + 0;
constexpr size_t O_WINT = R0 + 32 * MB;
constexpr size_t O_WAT = R0 + 45 * MB;
constexpr size_t O_WBT = R0 + 46 * MB;
constexpr size_t O_WCT = R0 + 47 * MB;
constexpr size_t O_WOT = R0 + 48 * MB;
constexpr size_t O_WMKV = R0 + 50 * MB;
constexpr size_t O_MEMB = R0 + 52 * MB;
constexpr size_t O_SGUW = R0 + 53 * MB;
constexpr size_t O_AB = R0 + 53 * MB + 512 * 1024;
constexpr size_t O_MEMK = R0 + 54 * MB;
constexpr size_t O_MEMVT = R0 + 54 * MB + 512 * 1024;
constexpr size_t O_QKV = R0 + 55 * MB;
constexpr size_t O_PART = R0 + 55 * MB;
constexpr size_t O_ZS = R0 + 103 * MB;
constexpr size_t O_UVG = R0 + 119 * MB;
constexpr size_t O_MERGED = R0 + 119 * MB;
constexpr size_t O_XQ = R0 + 151 * MB;
constexpr size_t O_GATES = R0 + 167 * MB;
constexpr size_t O_MP = R0 + 263 * MB;
constexpr size_t O_BC = R0 + 295 * MB;
constexpr size_t O_O0 = R0 + 359 * MB;
constexpr size_t O_QP = R0 + 391 * MB;
constexpr size_t O_GL = R0 + 407 * MB;
constexpr size_t O_GDNO = R0 + 408 * MB;
constexpr size_t O_SGUO = R0 + 424 * MB;
constexpr size_t O_XATO = R0 + 440 * MB;
constexpr size_t O_LOGITS = R0 + 0;
constexpr size_t O_TKIDX = R0 + 16 * MB;
constexpr size_t O_TKW = R0 + 16 * MB + 512 * 1024;
constexpr size_t O_TKPOS = R0 + 17 * MB;
constexpr size_t O_SLOTTOK = R0 + 18 * MB;
constexpr size_t O_SLOTW = R0 + 19 * MB;
constexpr size_t O_SLOTAID = R0 + 20 * MB;
constexpr size_t O_ACT = R0 + 21 * MB;
constexpr size_t O_ACTSH = R0 + 117 * MB;
constexpr size_t O_YSH = R0 + 125 * MB;
constexpr size_t O_Y = R0 + 157 * MB;
constexpr size_t WS_NEED = R0 + 456 * MB;

struct Params {
  const float* in[28];
  float* out;
  unsigned char* ws;
};
enum { I_X = 0, I_MEM, I_WIN, I_CONVW, I_ALOG, I_DTB, I_GNG, I_WA, I_SLNG, I_SLNB, I_SGUW, I_SGUB, I_WB, I_WMKV, I_WC, I_WO,
       I_LN1G, I_LN1B, I_RW, I_RB, I_WG, I_WU, I_WDN, I_WSG, I_WSU, I_WSD, I_LN2G, I_LN2B };

constexpr int PTAB_OFF = 156672;
DI float bf2f(bf16_t h) { return __uint_as_float(((unsigned)h) << 16); }
DI bf16_t f2bf(float f) { unsigned u = __float_as_uint(f); u += 0x7fffu + ((u >> 16) & 1u); return (bf16_t)(u >> 16); }
typedef float f32x2_ __attribute__((ext_vector_type(2)));
typedef __bf16 bf16x2_ __attribute__((ext_vector_type(2)));
DI unsigned pk2(float lo, float hi) { f32x2_ v = {lo, hi}; return __builtin_bit_cast(unsigned, __builtin_convertvector(v, bf16x2_)); }
DI float lo2f(unsigned u) { return __uint_as_float(u << 16); }
DI float hi2f(unsigned u) { return __uint_as_float(u & 0xffff0000u); }
DI float sigmoidf_(float x) { return 1.f / (1.f + __expf(-x)); }
DI float siluf_(float x) { return x / (1.f + __expf(-x)); }
DI float geluf_(float x) { float u = 0.7978845608028654f * (x + 0.044715f * x * x * x); float t = 1.f - 2.f / (__expf(2.f * u) + 1.f); return 0.5f * x * (1.f + t); }
DI float softplusf_(float x) { return fmaxf(x, 0.f) + log1pf(__expf(-fabsf(x))); }
DI float wave_sum(float v) {
#pragma unroll
  for (int o = 32; o; o >>= 1) v += __shfl_xor(v, o);
  return v;
}
DI f32x4 mfma16(bf16x8 a, bf16x8 b, f32x4 c) { return __builtin_amdgcn_mfma_f32_16x16x32_bf16(a, b, c, 0, 0, 0); }
DI bf16x8 ldfrag(const void* p) { return __builtin_bit_cast(bf16x8, *(const u32x4*)p); }
DI bf16x8 pack8(f32x4 a, f32x4 b) { u32x4 r = {pk2(a[0], a[1]), pk2(a[2], a[3]), pk2(b[0], b[1]), pk2(b[2], b[3])}; return __builtin_bit_cast(bf16x8, r); }
DI u32x2 pack4(f32x4 a) { u32x2 r = {pk2(a[0], a[1]), pk2(a[2], a[3])}; return r; }
DI int sw128(int row, int chunk) { return row * 128 + ((chunk ^ (row & 7)) << 4); }
DI int sw256(int row, int chunk) { return row * 256 + ((chunk ^ (row & 15)) << 4); }

namespace pg {
#define PG_LAS __attribute__((address_space(3)))
constexpr int BM = 256, BK = 64, HALF = 128, HTB = HALF * BK * 2, NXCD = 8, WGM = 8;
DI int lds_byte(int r, int c) { const int st = (r >> 4) * 2 + (c >> 5), rr = r & 15, cc = c & 31, ob = rr * 64 + cc * 2; return st * 1024 + (ob ^ (((ob >> 9) & 1) << 5)); }
DI void stage_rc(int b, int& R, int& C) { const int st = b / 1024, sb = b % 1024, swz = sb ^ (((sb >> 9) & 1) << 5); R = (st >> 1) * 16 + swz / 64; C = (st & 1) * 32 + (swz % 64) / 2; }

struct Unit { const char* a; const char* b; const int* rows; int pm, pn, e; };

struct DenseOrder {
  const char* A; const char* B; int nM, nN, nwg, G, c; size_t tstep;
  DI void init(const void* A_, const void* B_, int M, int N, int K, int G_, int c_) { A = (const char*)A_; B = (const char*)B_; nM = M / BM; nN = N / BM; nwg = nM * nN; G = G_; c = c_; tstep = (size_t)BM * K * 2; }
  DI bool next(int i, Unit& u) const {
    const long L = (long)i * G + c; if (L >= nwg) return false;
    int wgid = (int)L; { const int q = nwg / NXCD, r = nwg % NXCD, xcd = wgid % NXCD, off = wgid / NXCD; wgid = (xcd < r ? xcd * (q + 1) : r * (q + 1) + (xcd - r) * q) + off; }
    const int nig = WGM * nN, gid = wgid / nig, fm = gid * WGM, gsz = (nM - fm) < WGM ? (nM - fm) : WGM;
    u.pm = fm + ((wgid % nig) % gsz); u.pn = (wgid % nig) / gsz; u.e = 0; u.rows = nullptr;
    u.a = A + (size_t)u.pm * tstep; u.b = B + (size_t)u.pn * tstep; return true;
  }
};

template <class Epi, class Sched, bool GATHER, bool ALIGN_EPI>
DI void gemm_phase(PG_LAS unsigned char* lds, const int K, const Sched& S, const Epi& E) {
  int tid = threadIdx.x; asm volatile("" : "+v"(tid));
  const int wid = __builtin_amdgcn_readfirstlane(tid >> 6), lane = tid & 63, wr = wid >> 2, wc = wid & 3, fr = lane & 15, fq = lane >> 4;
  const int nt = K / BK;
  int Rr[2], Cc[2];
  unsigned voffB[2];
#pragma unroll
  for (int i = 0; i < 2; ++i) { stage_rc(tid * 16 + i * 8192, Rr[i], Cc[i]); voffB[i] = (unsigned)(Rr[i] * K + Cc[i]) * 2u; }
  const size_t kstep = (size_t)(BK * 2);
  const size_t hstep = (size_t)HALF * K * 2;
  const unsigned ldsw = (unsigned)wid * 1024u;
  const int aoff = lds_byte(wr * 64 + fr, fq * 8), boff = lds_byte(wc * 32 + fr, fq * 8);
#define PG_SA(b, h) (((b) * 2 + (h)) * HTB)
#define PG_SB(b, h) ((4 + (b) * 2 + (h)) * HTB)
#define PG_STAGE(bufoff, gbase, v0, v1) do { \
    __builtin_amdgcn_global_load_lds((const unsigned*)((const char*)(gbase) + (v0)), (PG_LAS unsigned*)(lds + (bufoff) + ldsw), 16, 0, 0); \
    __builtin_amdgcn_global_load_lds((const unsigned*)((const char*)(gbase) + (v1)), (PG_LAS unsigned*)(lds + (bufoff) + ldsw + 8192), 16, 0, 0); } while (0)
#define PG_LDA(dst, b, h) do { _Pragma("unroll") for (int m = 0; m < 4; ++m) _Pragma("unroll") for (int k = 0; k < 2; ++k) dst[m][k] = *(const PG_LAS bf16x8*)(lds + PG_SA(b, h) + aoff + m * 2048 + k * 1024); } while (0)
#define PG_LDB(dst, b, h) do { _Pragma("unroll") for (int n = 0; n < 2; ++n) _Pragma("unroll") for (int k = 0; k < 2; ++k) dst[n][k] = *(const PG_LAS bf16x8*)(lds + PG_SB(b, h) + boff + n * 2048 + k * 1024); } while (0)
#define PG_MMA(ai, bj, At, Bt) do { __builtin_amdgcn_s_setprio(1); _Pragma("unroll") for (int m = 0; m < 4; ++m) _Pragma("unroll") for (int n = 0; n < 2; ++n) _Pragma("unroll") for (int k = 0; k < 2; ++k) \
    acc[ai][bj][m][n] = __builtin_amdgcn_mfma_f32_16x16x32_bf16(Bt[n][k], At[m][k], acc[ai][bj][m][n], 0, 0, 0); __builtin_amdgcn_s_setprio(0); } while (0)
#define PG_WAIT_V(n) asm volatile("s_waitcnt vmcnt(" #n ")" ::: "memory")
#define PG_WAIT_L(n) asm volatile("s_waitcnt lgkmcnt(" #n ")" ::: "memory")
#define PG_BAR __builtin_amdgcn_s_barrier()
#define PG_SCHED __builtin_amdgcn_sched_barrier(0)
#define PG_AOFFS(u, o00, o01, o10, o11) do { if (GATHER) { \
      o00 = (unsigned)(u).rows[Rr[0]] * (unsigned)(K * 2) + (unsigned)Cc[0] * 2u; o01 = (unsigned)(u).rows[Rr[1]] * (unsigned)(K * 2) + (unsigned)Cc[1] * 2u; \
      o10 = (unsigned)(u).rows[128 + Rr[0]] * (unsigned)(K * 2) + (unsigned)Cc[0] * 2u; o11 = (unsigned)(u).rows[128 + Rr[1]] * (unsigned)(K * 2) + (unsigned)Cc[1] * 2u; \
    } else { o00 = voffB[0]; o01 = voffB[1]; o10 = voffB[0] + (unsigned)hstep; o11 = voffB[1] + (unsigned)hstep; } } while (0)
  Unit cur, nxt; int ui = 0;
  if (!S.next(0, cur)) return;
  f32x4 acc[2][2][4][2];
#pragma unroll
  for (int a = 0; a < 2; ++a)
#pragma unroll
    for (int b = 0; b < 2; ++b)
#pragma unroll
      for (int m = 0; m < 4; ++m)
#pragma unroll
        for (int n = 0; n < 2; ++n) acc[a][b][m][n] = (f32x4){0.f, 0.f, 0.f, 0.f};
  bf16x8 At[4][2], B0[2][2], B1[2][2];
  const char* cA = cur.a; const char* cB = cur.b;
  unsigned c00, c01, c10, c11;
  PG_AOFFS(cur, c00, c01, c10, c11);
  const unsigned vb0 = voffB[0], vb1 = voffB[1];
  PG_STAGE(PG_SB(0, 0), cB, vb0, vb1); PG_STAGE(PG_SB(0, 1), cB + hstep, vb0, vb1); PG_STAGE(PG_SA(0, 0), cA, c00, c01); PG_STAGE(PG_SA(0, 1), cA, c10, c11);
  if (wr == 1) PG_BAR;
  PG_WAIT_V(2); PG_BAR;
  PG_STAGE(PG_SB(1, 0), cB + kstep, vb0, vb1); PG_STAGE(PG_SA(1, 0), cA + kstep, c00, c01); PG_STAGE(PG_SB(1, 1), cB + hstep + kstep, vb0, vb1);
  PG_WAIT_V(6); PG_BAR;
  for (;;) {
    const bool has_next = S.next(ui + 1, nxt);
    const char* nA = has_next ? nxt.a : cA; const char* nB = has_next ? nxt.b : cB;
    unsigned n00 = c00, n01 = c01, n10 = c10, n11 = c11;
    if (has_next) PG_AOFFS(nxt, n00, n01, n10, n11);
#pragma unroll 1
    for (int t = 0; t < nt; t += 2) {
      const bool last = (t == nt - 2);
      const char* a1 = cA + (size_t)(t + 1) * kstep;
      const char* a2 = last ? nA : cA + (size_t)(t + 2) * kstep; const char* b2 = last ? nB : cB + (size_t)(t + 2) * kstep;
      const char* a3 = a2 + kstep; const char* b3 = b2 + kstep;
      const unsigned o00 = last ? n00 : c00, o01 = last ? n01 : c01, o10 = last ? n10 : c10, o11 = last ? n11 : c11;
      PG_LDB(B0, 0, 0); PG_LDB(B1, 0, 1); PG_SCHED; PG_LDA(At, 0, 0); PG_STAGE(PG_SA(1, 1), a1, c10, c11);
      PG_WAIT_V(8); PG_WAIT_L(0); PG_BAR; PG_MMA(0, 0, At, B0); PG_MMA(0, 1, At, B1); PG_BAR; PG_SCHED;
      PG_LDA(At, 0, 1); PG_STAGE(PG_SB(0, 0), b2, vb0, vb1); PG_STAGE(PG_SB(0, 1), b2 + hstep, vb0, vb1); PG_STAGE(PG_SA(0, 0), a2, o00, o01);
      PG_WAIT_V(8); PG_WAIT_L(0); PG_BAR; PG_MMA(1, 0, At, B0); PG_MMA(1, 1, At, B1); PG_BAR; PG_SCHED;
      PG_LDB(B0, 1, 0); PG_LDB(B1, 1, 1); PG_SCHED; PG_LDA(At, 1, 0); PG_STAGE(PG_SA(0, 1), a2, o10, o11);
      PG_WAIT_V(8); PG_WAIT_L(0); PG_BAR; PG_MMA(0, 0, At, B0); PG_MMA(0, 1, At, B1); PG_BAR; PG_SCHED;
      PG_LDA(At, 1, 1); PG_STAGE(PG_SB(1, 0), b3, vb0, vb1); PG_STAGE(PG_SB(1, 1), b3 + hstep, vb0, vb1); PG_STAGE(PG_SA(1, 0), a3, o00, o01);
      PG_WAIT_V(8); PG_WAIT_L(0); PG_BAR; PG_MMA(1, 0, At, B0); PG_MMA(1, 1, At, B1); PG_BAR; PG_SCHED;
    }
    if constexpr (ALIGN_EPI) { if (wr == 0) PG_BAR; }
    E(acc, cur, wr, wc, fr, fq);
    if (!has_next) break;
#pragma unroll
    for (int a = 0; a < 2; ++a)
#pragma unroll
      for (int b = 0; b < 2; ++b)
#pragma unroll
        for (int m = 0; m < 4; ++m)
#pragma unroll
          for (int n = 0; n < 2; ++n) acc[a][b][m][n] = (f32x4){0.f, 0.f, 0.f, 0.f};
    cur = nxt; cA = nA; cB = nB; c00 = n00; c01 = n01; c10 = n10; c11 = n11; ++ui;
    if constexpr (ALIGN_EPI) { if (wr == 1) PG_BAR; }
  }
  PG_WAIT_V(0);
  if constexpr (!ALIGN_EPI) { if (wr == 0) PG_BAR; }
  PG_BAR;
#undef PG_SA
#undef PG_SB
#undef PG_STAGE
#undef PG_LDA
#undef PG_LDB
#undef PG_MMA
#undef PG_WAIT_V
#undef PG_WAIT_L
#undef PG_BAR
#undef PG_SCHED
#undef PG_AOFFS
}
}

#define XB_TMO      128
#define XB_XCNT(j)  (256  + 64 * (j))
#define XB_XSUB(j)  (1280 + 64 * (j))
#define XB_XGEN(j)  (2304 + 64 * (j))
#define XB_TOP      3328
#define XB_TOPGEN   3392
#define XCD_BAR_WORDS 3456
#define XB_SPIN_CAP (1u << 22)
DI unsigned xb_ld(unsigned* p)              { return __hip_atomic_load(p, __ATOMIC_RELAXED, __HIP_MEMORY_SCOPE_AGENT); }
DI unsigned xb_add(unsigned* p, unsigned v) { return __hip_atomic_fetch_add(p, v, __ATOMIC_RELAXED, __HIP_MEMORY_SCOPE_AGENT); }
DI unsigned xb_xcc_id() { return (unsigned)__builtin_amdgcn_s_getreg((3 << 11) | 20) & 0xFu; }
#define XB_SPIN(cond, bar) do { unsigned _sp = 0; while (cond) { __builtin_amdgcn_s_sleep(1); \
    if ((++_sp & 255u) == 0u) { if (xb_ld(&(bar)[XB_TMO])) break; if (_sp > XB_SPIN_CAP) { atomicAdd(&(bar)[XB_TMO], 1u); break; } } } } while (0)
struct XcdBarrier { unsigned* bar; unsigned x; volatile LAS unsigned* st; };
DI XcdBarrier xcd_barrier_post(unsigned* bar, volatile LAS unsigned* st) {
  XcdBarrier b; b.bar = bar; b.x = xb_xcc_id(); b.st = st;
  if (threadIdx.x == 0) (void)xb_add(&bar[XB_XCNT(b.x)], 1u);
  return b;
}
DI void xcd_barrier_complete(unsigned* bar, unsigned x, unsigned& nloc, unsigned& nx) {
  const unsigned G = gridDim.x * gridDim.y * gridDim.z;
  unsigned sum, cnt, mine, sp = 0u;
  for (;;) {
    sum = 0u; cnt = 0u; mine = 0u;
#pragma unroll
    for (unsigned j = 0; j < 16; ++j) { const unsigned c = xb_ld(&bar[XB_XCNT(j)]); sum += c; cnt += (c > 0u) ? 1u : 0u; mine = (j == x) ? c : mine; }
    if (sum == G) break;
    __builtin_amdgcn_s_sleep(1);
    if ((++sp & 255u) == 0u) { if (xb_ld(&bar[XB_TMO])) break; if (sp > XB_SPIN_CAP) { atomicAdd(&bar[XB_TMO], 1u); break; } }
  }
  nloc = mine > 0u ? mine : 1u; nx = cnt > 0u ? cnt : 1u;
}
DI void xcd_barrier(const XcdBarrier& b) {
  asm volatile("s_waitcnt vmcnt(0)" ::: "memory");
  __syncthreads();
  if (threadIdx.x == 0) {
    unsigned* bar = b.bar;
    __builtin_amdgcn_s_waitcnt(0);
    unsigned nloc = b.st[0], nx = b.st[1];
    if (nloc == 0u) { xcd_barrier_complete(bar, b.x, nloc, nx); b.st[0] = nloc; b.st[1] = nx; }
    const unsigned old = xb_add(&bar[XB_XSUB(b.x)], 1u);
    const unsigned gen = old / nloc;
    if (old + 1u == (gen + 1u) * nloc) {
      __builtin_amdgcn_fence(__ATOMIC_RELEASE, "agent");
      asm volatile("s_waitcnt vmcnt(0)" ::: "memory");
      const unsigned og = xb_add(&bar[XB_TOP], 1u);
      const unsigned tg = og / nx;
      if (og + 1u == (tg + 1u) * nx) xb_add(&bar[XB_TOPGEN], 1u);
      else XB_SPIN(xb_ld(&bar[XB_TOPGEN]) == tg, bar);
      __builtin_amdgcn_fence(__ATOMIC_ACQUIRE, "agent");
      xb_add(&bar[XB_XGEN(b.x)], 1u);
      asm volatile("s_waitcnt vmcnt(0)" ::: "memory");
    } else {
      XB_SPIN(xb_ld(&bar[XB_XGEN(b.x)]) == gen, bar);
      __builtin_amdgcn_fence(__ATOMIC_ACQUIRE, "agent");
      asm volatile("s_waitcnt vmcnt(0)" ::: "memory");
    }
  }
  __syncthreads();
}

DI void phase0(const Params& p, unsigned char* smem, int bid, int nb) {
  int tid = threadIdx.x; asm volatile("" : "+v"(tid));
  const int lane = tid & 63, wave = tid >> 6;
  unsigned char* ws = p.ws;
  if (bid == 0 && tid < 256) ((int*)(ws + O_CTRL))[tid * CSTR] = 0;
  for (int i = bid * NTHR + tid; i < T; i += nb * NTHR) ((int*)(ws + O_IDENT))[i] = i;
  {
    float* wabT = (float*)smem;
    const float* win = p.in[I_WIN];
    for (int i = tid; i < 8192; i += NTHR) { const int k = i >> 3, j = i & 7; wabT[j * 1024 + k] = win[(size_t)k * DIN + 2048 + j]; }
    __syncthreads();
    const float* x = p.in[I_X];
    bf16_t* xb = (bf16_t*)(ws + O_XB);
    float* ab = (float*)(ws + O_AB);
    for (int row = bid * 8 + wave; row < T; row += nb * 8) {
      float s[8];
#pragma unroll
      for (int j = 0; j < 8; ++j) s[j] = 0.f;
#pragma unroll
      for (int i = 0; i < 4; ++i) {
        const int k = 256 * i + 4 * lane;
        const f32x4 v = *(const f32x4*)(x + (size_t)row * D + k);
        *(u32x2*)(xb + (size_t)row * D + k) = pack4(v);
#pragma unroll
        for (int j = 0; j < 8; ++j) { const f32x4 w = *(const f32x4*)(wabT + j * 1024 + k); s[j] += v[0] * w[0] + v[1] * w[1] + v[2] * w[2] + v[3] * w[3]; }
      }
#pragma unroll
      for (int j = 0; j < 8; ++j) s[j] = wave_sum(s[j]);
      if (lane == 0) { *(f32x4*)(ab + (size_t)row * 8) = (f32x4){s[0], s[1], s[2], s[3]}; *(f32x4*)(ab + (size_t)row * 8 + 4) = (f32x4){s[4], s[5], s[6], s[7]}; }
    }
    const float* mem = p.in[I_MEM];
    bf16_t* memb = (bf16_t*)(ws + O_MEMB);
    for (int row = bid * 8 + wave; row < 512; row += nb * 8) {
#pragma unroll
      for (int i = 0; i < 4; ++i) { const int k = 256 * i + 4 * lane; *(u32x2*)(memb + (size_t)row * D + k) = pack4(*(const f32x4*)(mem + (size_t)row * D + k)); }
    }
    const float* sw = p.in[I_SGUW];
    bf16_t* sguw = (bf16_t*)(ws + O_SGUW);
    for (int i = bid * NTHR + tid; i < 16384; i += nb * NTHR) {
      const int e0 = i * 4; const int col = e0 & 127, rowi = (e0 >> 7) & 127;
      f32x4 v = *(const f32x4*)(sw + e0);
#pragma unroll
      for (int c = 0; c < 4; ++c) if (col + c > rowi) v[c] = 0.f;
      *(u32x2*)(sguw + e0) = pack4(v);
    }
    __syncthreads();
  }
  {
    float* tile = (float*)smem;
    const float *pwin = p.in[I_WIN], *pwa = p.in[I_WA], *pwb = p.in[I_WB], *pwc = p.in[I_WC], *pwo = p.in[I_WO], *pwmkv = p.in[I_WMKV], *prw = p.in[I_RW],
                *pwsg = p.in[I_WSG], *pwsu = p.in[I_WSU], *pwsd = p.in[I_WSD], *pwg = p.in[I_WG], *pwu = p.in[I_WU], *pwdn = p.in[I_WDN];
    asm volatile("" : "+s"(pwa), "+s"(pwb), "+s"(pwc), "+s"(pwo), "+s"(pwmkv));
    constexpr int J0 = 1664, J1 = J0 + 128, J2 = J1 + 128, J3 = J2 + 128, J4 = J3 + 256, J5 = J4 + 256, J6 = J5 + 64, J7 = J6 + 128, J8 = J7 + 64,
                  J9 = J8 + 32768, J10 = J9 + 16384;
    const int kr = tid >> 4, nc = tid & 15, sg = nc >> 2;
    const int tn = tid >> 3, tkc = tid & 7;
#define P0_DECODE_LOAD(it0, dp, v0, v1) do { const float* sp[4]; int ld[4]; \
      _Pragma("unroll") \
      for (int q = 0; q < 4; ++q) { \
        const int it = (it0 + q < J10) ? it0 + q : J10 - 1;      \
        const float *s0, *s1, *s2, *s3; int ldd; bf16_t* dst; \
        if (it < J0) {           \
          const int kt = it & 15, nt = it >> 4; const int n0 = nt * 64; const int c0 = n0 + (n0 >= 2048 ? 8 : 0); \
          const float* b = pwin + (size_t)kt * 64 * DIN + c0; s0 = b; s1 = b + 16; s2 = b + 32; s3 = b + 48; ld[q] = DIN; ldd = 1024; \
          dst = (bf16_t*)(ws + O_WINT) + (size_t)n0 * 1024 + kt * 64; \
        } else if (it < J3) {    \
          const int which = (it - J0) >> 7, r = (it - J0) & 127; const int kt = r & 7, nt = r >> 3; \
          const float* src = which == 0 ? pwa : which == 1 ? pwb : pwc; \
          const float* b = src + (size_t)kt * 64 * 1024 + nt * 64; s0 = b; s1 = b + 16; s2 = b + 32; s3 = b + 48; ld[q] = 1024; ldd = 512; \
          dst = (bf16_t*)(ws + (which == 0 ? O_WAT : which == 1 ? O_WBT : O_WCT)) + (size_t)nt * 64 * 512 + kt * 64; \
        } else if (it < J5) {    \
          const int which = (it - J3) >> 8, r = (it - J3) & 255; const int kt = r & 15, nt = r >> 4; \
          const float* b = (which == 0 ? pwo : pwmkv) + (size_t)kt * 64 * 1024 + nt * 64; s0 = b; s1 = b + 16; s2 = b + 32; s3 = b + 48; ld[q] = 1024; ldd = 1024; \
          dst = (bf16_t*)(ws + (which == 0 ? O_WOT : O_WMKV)) + (size_t)nt * 64 * 1024 + kt * 64; \
        } else if (it < J6) {    \
          const int r = it - J5; const int kt = r & 15, nt = r >> 4; \
          const float* b = prw + (size_t)kt * 64 * 256 + nt * 64; s0 = b; s1 = b + 16; s2 = b + 32; s3 = b + 48; ld[q] = 256; ldd = 1024; \
          dst = (bf16_t*)(ws + O_ROUT) + (size_t)nt * 64 * 1024 + kt * 64; \
        } else if (it < J7) {    \
          const int r = it - J6; const int kt = r & 15, nt = r >> 4; \
          const float* g = pwsg + (size_t)kt * 64 * 256 + nt * 32; const float* u = pwsu + (size_t)kt * 64 * 256 + nt * 32; \
          s0 = g; s1 = u; s2 = g + 16; s3 = u + 16; ld[q] = 256; ldd = 1024; \
          dst = (bf16_t*)(ws + O_WSGU) + (size_t)nt * 64 * 1024 + kt * 64; \
        } else if (it < J8) {    \
          const int r = it - J7; const int kt = r & 3, nt = r >> 2; \
          const float* b = pwsd + (size_t)kt * 64 * 1024 + nt * 64; s0 = b; s1 = b + 16; s2 = b + 32; s3 = b + 48; ld[q] = 1024; ldd = 256; \
          dst = (bf16_t*)(ws + O_WSD) + (size_t)nt * 64 * 256 + kt * 64; \
        } else if (it < J9) {    \
          const int r = it - J8; const int e = r >> 7, qq = r & 127; const int kt = qq & 15, nt = qq >> 4; \
          const float* g = pwg + (size_t)e * 262144 + (size_t)kt * 64 * 256 + nt * 32; const float* u = pwu + (size_t)e * 262144 + (size_t)kt * 64 * 256 + nt * 32; \
          s0 = g; s1 = u; s2 = g + 16; s3 = u + 16; ld[q] = 256; ldd = 1024; \
          dst = (bf16_t*)(ws + O_WGU) + (size_t)e * 524288 + (size_t)nt * 64 * 1024 + kt * 64; \
        } else {                 \
          const int r = it - J9; const int e = r >> 6, qq = r & 63; const int kt = qq & 3, nt = qq >> 2; \
          const float* b = pwdn + (size_t)e * 262144 + (size_t)kt * 64 * 1024 + nt * 64; s0 = b; s1 = b + 16; s2 = b + 32; s3 = b + 48; ld[q] = 1024; ldd = 256; \
          dst = (bf16_t*)(ws + O_WD) + (size_t)e * 262144 + (size_t)nt * 64 * 256 + kt * 64; \
        } \
        sp[q] = (sg == 0 ? s0 : sg == 1 ? s1 : sg == 2 ? s2 : s3) + (size_t)kr * ld[q] + 4 * (nc & 3); \
        dp[q] = dst + (size_t)tn * ldd + 8 * tkc; \
      } \
      _Pragma("unroll") \
      for (int q = 0; q < 4; ++q) { v0[q] = __builtin_nontemporal_load((const f32x4*)(sp[q])); v1[q] = __builtin_nontemporal_load((const f32x4*)(sp[q] + (size_t)32 * ld[q])); } } while (0)
    bf16_t* dpn[4]; f32x4 v0n[4], v1n[4];
    int it0 = bid * 4;
    if (it0 < J10) P0_DECODE_LOAD(it0, dpn, v0n, v1n);
    for (; it0 < J10; it0 += nb * 4) {
      bf16_t* dp[4]; f32x4 v0[4], v1[4];
#pragma unroll
      for (int q = 0; q < 4; ++q) { dp[q] = dpn[q]; v0[q] = v0n[q]; v1[q] = v1n[q]; }
      if (it0 + nb * 4 < J10) P0_DECODE_LOAD(it0 + nb * 4, dpn, v0n, v1n);
      asm volatile("s_waitcnt lgkmcnt(0)" ::: "memory"); __builtin_amdgcn_s_barrier(); asm volatile("" ::: "memory");
#pragma unroll
      for (int q = 0; q < 4; ++q) {
        float* t0 = tile + q * 4160 + kr * 65 + 4 * nc;
        float* t1 = t0 + 32 * 65;
        t0[0] = v0[q][0]; t0[1] = v0[q][1]; t0[2] = v0[q][2]; t0[3] = v0[q][3];
        t1[0] = v1[q][0]; t1[1] = v1[q][1]; t1[2] = v1[q][2]; t1[3] = v1[q][3];
      }
      asm volatile("s_waitcnt lgkmcnt(0)" ::: "memory"); __builtin_amdgcn_s_barrier(); asm volatile("" ::: "memory");
#pragma unroll
      for (int q = 0; q < 4; ++q) {
        float e[8];
#pragma unroll
        for (int j = 0; j < 8; ++j) e[j] = tile[q * 4160 + (8 * tkc + j) * 65 + tn];
        u32x4 o = {pk2(e[0], e[1]), pk2(e[2], e[3]), pk2(e[4], e[5]), pk2(e[6], e[7])};
        *(u32x4*)(dp[q]) = o;
      }
    }
#undef P0_DECODE_LOAD
  }
}

#define EPI_ROWS(u) const int row_ = (u).pm * 256 + 64 * wr + fr
struct EpiInProj {
  unsigned char* ws;
  DI void operator()(const f32x4 (&acc)[2][2][4][2], const pg::Unit& u, int wr, int wc, int fr, int fq) const {
    const int colt = u.pn * 256;
#pragma unroll
    for (int ai = 0; ai < 2; ++ai)
#pragma unroll
      for (int m = 0; m < 4; ++m) {
        const size_t row = (size_t)u.pm * 256 + 128 * ai + 64 * wr + 16 * m + fr;
#pragma unroll
        for (int bj = 0; bj < 2; ++bj)
#pragma unroll
          for (int n = 0; n < 2; ++n) {
            const int col = colt + 128 * bj + 32 * wc + 16 * n + 4 * fq;
            f32x4 v = acc[ai][bj][m][n];
            if (colt < 1536) { *(u32x2*)((bf16_t*)(ws + O_QKV) + row * 1536 + col) = pack4(v); }
            else if (colt < 2048) {
#pragma unroll
              for (int c = 0; c < 4; ++c) v[c] = siluf_(v[c]);
              *(u32x2*)((bf16_t*)(ws + O_ZS) + row * 512 + (col - 1536)) = pack4(v);
            } else if (colt < 3072) {
#pragma unroll
              for (int c = 0; c < 4; ++c) v[c] = geluf_(v[c]);
              *(u32x2*)((bf16_t*)(ws + O_UVG) + row * 1024 + (col - 2048)) = pack4(v);
            } else if (colt < 3584) {
#pragma unroll
              for (int c = 0; c < 4; ++c) v[c] *= 0.08838834764831845f;
              *(u32x2*)((bf16_t*)(ws + O_XQ) + row * 512 + (col - 3072)) = pack4(v);
            } else {
#pragma unroll
              for (int c = 0; c < 4; ++c) v[c] = sigmoidf_(v[c]);
              *(u32x2*)((bf16_t*)(ws + O_GATES) + row * 3072 + (col - 3584)) = pack4(v);
            }
          }
      }
  }
};
struct EpiMemKV {
  unsigned char* ws;
  DI void operator()(const f32x4 (&acc)[2][2][4][2], const pg::Unit& u, int wr, int wc, int fr, int fq) const {
#pragma unroll
    for (int ai = 0; ai < 2; ++ai)
#pragma unroll
      for (int m = 0; m < 4; ++m) {
        const int row = u.pm * 256 + 128 * ai + 64 * wr + 16 * m + fr; const int b = row >> 8, key = row & 255;
#pragma unroll
        for (int bj = 0; bj < 2; ++bj)
#pragma unroll
          for (int n = 0; n < 2; ++n) {
            const int col = u.pn * 256 + 128 * bj + 32 * wc + 16 * n + 4 * fq;
            const f32x4 v = acc[ai][bj][m][n];
            if (col < 512) { const int h = col >> 7, d = col & 127; *(u32x2*)((bf16_t*)(ws + O_MEMK) + ((size_t)((b * 4 + h) * 256 + key)) * 128 + d) = pack4(v); }
            else {
              const int c2 = col - 512; const int h = c2 >> 7, d = c2 & 127;
              const int pos = 32 * (key >> 5) + 8 * ((key >> 2) & 3) + 4 * ((key >> 4) & 1) + (key & 3);
              bf16_t* vt = (bf16_t*)(ws + O_MEMVT) + ((size_t)((b * 4 + h) * 128 + d)) * 256 + pos;
#pragma unroll
              for (int c = 0; c < 4; ++c) vt[(size_t)c * 256] = f2bf(v[c]);
            }
          }
      }
  }
};
DI void phase1(const Params& p, unsigned char* smem, int bid, int nb) {
  unsigned char* ws = p.ws;
  PG_LAS unsigned char* lds = (PG_LAS unsigned char*)smem;
  __syncthreads();
  { pg::DenseOrder S; S.init(ws + O_XB, ws + O_WINT, T, NPROJ, 1024, nb, bid); EpiInProj E{ws}; pg::gemm_phase<EpiInProj, pg::DenseOrder, false, true>(lds, 1024, S, E); }
  __syncthreads();
  { pg::DenseOrder S; S.init(ws + O_MEMB, ws + O_WMKV, 512, 1024, 1024, nb, bid); EpiMemKV E{ws}; pg::gemm_phase<EpiMemKV, pg::DenseOrder, false, true>(lds, 1024, S, E); }
}

constexpr int G_KF = 0, G_VF = 32768, G_QB = 65536, G_KB = 81920, G_UT = 81920  , G_L = 98304, G_ATT = 114688, G_KDT = 122880, G_WT = 139264, G_SM = 155648;

DI void gdn_prep_item(const Params& p, unsigned char* smem_, int item) {
  unsigned char* smem; { LAS unsigned char* l_ = (LAS unsigned char*)smem_; asm volatile("" : "+v"(l_)); smem = (unsigned char*)l_; }
  int tid = threadIdx.x; asm volatile("" : "+v"(tid));
  const int lane = tid & 63, wave = tid >> 6, fr = lane & 15, fq = lane >> 4;
  unsigned char* ws = p.ws; asm volatile("" : "+s"(ws));
  const int h = item & 3, cn = item >> 2;
  const int bidx = cn >> 7, n = cn & 127;
  const size_t t0 = (size_t)bidx * SEQ + (size_t)n * 64;
  float* kf = (float*)(smem + G_KF); float* vf = (float*)(smem + G_VF); float* Lm = (float*)(smem + G_L);
  float* sbeta = (float*)(smem + G_SM); float* sgc = sbeta + 64; float* segc = sbeta + 128;
  __syncthreads();
  {
    const bf16_t* qkv = (const bf16_t*)(ws + O_QKV);
    const float* cw = p.in[I_CONVW];
    const int tl0 = wave * 8;
#pragma unroll
    for (int sect = 0; sect < 3; ++sect) {
      const int cb = sect * 512 + h * 128 + 2 * lane;
      float w0[4], w1[4];
#pragma unroll
      for (int i = 0; i < 4; ++i) { w0[i] = cw[i * 1536 + cb]; w1[i] = cw[i * 1536 + cb + 1]; }
      float xa[11], xc[11];
#pragma unroll
      for (int r = 0; r < 11; ++r) {
        const int s = n * 64 + tl0 + r - 3;
        unsigned u = 0u;
        if (s >= 0) u = *(const unsigned*)(qkv + ((size_t)bidx * SEQ + s) * 1536 + cb);
        xa[r] = lo2f(u); xc[r] = hi2f(u);
      }
#pragma unroll
      for (int r = 0; r < 8; ++r) {
        float y0 = w0[0] * xa[r] + w0[1] * xa[r + 1] + w0[2] * xa[r + 2] + w0[3] * xa[r + 3];
        float y1 = w1[0] * xc[r] + w1[1] * xc[r + 1] + w1[2] * xc[r + 2] + w1[3] * xc[r + 3];
        y0 = siluf_(y0); y1 = siluf_(y1);
        const int tl = tl0 + r;
        if (sect == 2) { vf[tl * 128 + 2 * lane] = y0; vf[tl * 128 + 2 * lane + 1] = y1; }
        else {
          const float ss = wave_sum(y0 * y0 + y1 * y1);
          const float sc = rsqrtf(ss + 1e-6f) * (sect == 0 ? 0.08838834764831845f : 1.0f);
          y0 *= sc; y1 *= sc;
          const int off = sw256(tl, lane >> 2) + (lane & 3) * 4;
          if (sect == 0) *(unsigned*)(smem + G_QB + off) = pk2(y0, y1);
          else { *(unsigned*)(smem + G_KB + off) = pk2(y0, y1); kf[tl * 128 + 2 * lane] = y0; kf[tl * 128 + 2 * lane + 1] = y1; }
        }
      }
    }
    if (wave == 0) {
      const float* ab = (const float*)(ws + O_AB) + (t0 + lane) * 8;
      const float a = ab[h], bb = ab[4 + h];
      const float beta = sigmoidf_(bb);
      float g = -__expf(p.in[I_ALOG][h]) * softplusf_(a + p.in[I_DTB][h]);
#pragma unroll
      for (int o = 1; o < 64; o <<= 1) { const float y = __shfl_up(g, o); if (lane >= o) g += y; }
      sbeta[lane] = beta; sgc[lane] = g; segc[lane] = __expf(g);
      if (lane == 63) ((float*)(ws + O_GL))[item] = __expf(g);
    }
  }
  __syncthreads();
  {
#pragma unroll
    for (int q = 0; q < 4; ++q) {
      const int idx = wave * 4 + q; const int isq = idx >> 4, ti = (idx >> 2) & 3, tj = idx & 3;
      f32x4 acc = {0.f, 0.f, 0.f, 0.f};
      if (tj <= ti) {
#pragma unroll
        for (int ks = 0; ks < 4; ++ks) {
          const bf16x8 ai = ldfrag(smem + (isq ? G_QB : G_KB) + sw256(16 * ti + fr, 4 * ks + fq));
          const bf16x8 bj = ldfrag(smem + G_KB + sw256(16 * tj + fr, 4 * ks + fq));
          acc = isq ? mfma16(bj, ai, acc) : mfma16(ai, bj, acc);
        }
      }
      if (isq) {
        const int i = 16 * ti + fr, j0 = 16 * tj + 4 * fq;
        const float gi = sgc[i];
        f32x4 o;
#pragma unroll
        for (int r = 0; r < 4; ++r) { const int j = j0 + r; o[r] = (j <= i) ? acc[r] * __expf(gi - sgc[j]) : 0.f; }
        *(u32x2*)(smem + G_ATT + sw128(i, j0 >> 3) + (j0 & 7) * 2) = pack4(o);
      } else {
        const int j = 16 * tj + fr, i0 = 16 * ti + 4 * fq;
        const float gj = sgc[j];
        f32x4 o;
#pragma unroll
        for (int r = 0; r < 4; ++r) { const int i = i0 + r; o[r] = (j < i) ? acc[r] * __expf(sgc[i] - gj) * sbeta[i] : 0.f; }
        *(f32x4*)(Lm + j * 64 + i0) = o;
      }
    }
  }
  {
    const float gl_ = sgc[63];
    const int d = tid & 127, tg = tid >> 7;
#pragma unroll
    for (int c = 0; c < 2; ++c) {
      float e[8];
#pragma unroll
      for (int j = 0; j < 8; ++j) { const int t = 16 * tg + 8 * c + j; e[j] = kf[t * 128 + d] * __expf(gl_ - sgc[t]); }
      u32x4 o = {pk2(e[0], e[1]), pk2(e[2], e[3]), pk2(e[4], e[5]), pk2(e[6], e[7])};
      *(u32x4*)(smem + G_KDT + sw128(d, 2 * tg + c)) = o;
    }
  }
  __syncthreads();
  if (tid < 256) {
    const bool isw = tid >= 128;
    float* X = isw ? (kf + (tid - 128)) : (vf + tid);
    unsigned char* dstT = smem + (isw ? G_WT : G_UT);
    const int rowc = tid & 127;
#pragma unroll
    for (int b = 0; b < 4; ++b) {
      float xr[16];
#pragma unroll
      for (int r = 0; r < 16; ++r) { const int t = 16 * b + r; float sc = sbeta[t]; if (isw) sc *= segc[t]; xr[r] = X[t * 128] * sc; }
#pragma unroll 2
      for (int j = 0; j < 16 * b; ++j) {
        const float xj = X[j * 128];
        const float* lt = Lm + j * 64 + 16 * b;
        const f32x4 l0 = *(const f32x4*)lt, l1 = *(const f32x4*)(lt + 4), l2 = *(const f32x4*)(lt + 8), l3 = *(const f32x4*)(lt + 12);
#pragma unroll
        for (int r = 0; r < 4; ++r) { xr[r] -= l0[r] * xj; xr[4 + r] -= l1[r] * xj; xr[8 + r] -= l2[r] * xj; xr[12 + r] -= l3[r] * xj; }
      }
#pragma unroll
      for (int q = 0; q < 15; ++q) {
        const float* lt = Lm + (16 * b + q) * 64 + 16 * b;
        float l[16];
#pragma unroll
        for (int g4 = 0; g4 < 4; ++g4) if (4 * g4 + 3 > q) { const f32x4 t4 = *(const f32x4*)(lt + 4 * g4); l[4 * g4] = t4[0]; l[4 * g4 + 1] = t4[1]; l[4 * g4 + 2] = t4[2]; l[4 * g4 + 3] = t4[3]; }
#pragma unroll
        for (int r = q + 1; r < 16; ++r) xr[r] -= l[r] * xr[q];
      }
#pragma unroll
      for (int r = 0; r < 16; ++r) X[(16 * b + r) * 128] = xr[r];
      u32x4 o0 = {pk2(xr[0], xr[1]), pk2(xr[2], xr[3]), pk2(xr[4], xr[5]), pk2(xr[6], xr[7])};
      u32x4 o1 = {pk2(xr[8], xr[9]), pk2(xr[10], xr[11]), pk2(xr[12], xr[13]), pk2(xr[14], xr[15])};
      *(u32x4*)(dstT + sw128(rowc, 2 * b)) = o0;
      *(u32x4*)(dstT + sw128(rowc, 2 * b + 1)) = o1;
    }
  }
  __syncthreads();
  {
    bf16x8 ak[2];
#pragma unroll
    for (int ks = 0; ks < 2; ++ks) ak[ks] = ldfrag(smem + G_KDT + sw128(16 * wave + fr, 4 * ks + fq));
    bf16_t* mp = (bf16_t*)(ws + O_MP) + (size_t)item * 16384;
    float* bc = (float*)(ws + O_BC) + (size_t)item * 16384;
#pragma unroll
    for (int tj = 0; tj < 8; ++tj) {
      f32x4 am = {0.f, 0.f, 0.f, 0.f}, ab_ = {0.f, 0.f, 0.f, 0.f};
#pragma unroll
      for (int ks = 0; ks < 2; ++ks) {
        const bf16x8 bw = ldfrag(smem + G_WT + sw128(16 * tj + fr, 4 * ks + fq));
        const bf16x8 bu = ldfrag(smem + G_UT + sw128(16 * tj + fr, 4 * ks + fq));
        am = mfma16(bw, ak[ks], am);
        ab_ = mfma16(ak[ks], bu, ab_);
      }
      f32x4 nm = {-am[0], -am[1], -am[2], -am[3]};
      *(u32x2*)(mp + ((size_t)((wave * 4 + (tj >> 1)) * 64 + lane)) * 8 + (tj & 1) * 4) = pack4(nm);
      *(f32x4*)(bc + ((size_t)((tj * 8 + wave) * 64 + lane)) * 4) = ab_;
    }
    const int tt = wave & 3, hf = wave >> 2;
    bf16x8 aa[2];
#pragma unroll
    for (int ks = 0; ks < 2; ++ks) aa[ks] = ldfrag(smem + G_ATT + sw128(16 * tt + fr, 4 * ks + fq));
    const int trow = 16 * tt + fr;
    const float eg = segc[trow];
    float* o0 = (float*)(ws + O_O0) + (t0 + trow) * 512 + h * 128;
    bf16_t* qp = (bf16_t*)(ws + O_QP) + (size_t)item * 8192 + trow * 128;
#pragma unroll
    for (int q = 0; q < 4; ++q) {
      const int te = hf * 4 + q;
      f32x4 ao = {0.f, 0.f, 0.f, 0.f}, aw = {0.f, 0.f, 0.f, 0.f};
#pragma unroll
      for (int ks = 0; ks < 2; ++ks) {
        const bf16x8 bu = ldfrag(smem + G_UT + sw128(16 * te + fr, 4 * ks + fq));
        const bf16x8 bw = ldfrag(smem + G_WT + sw128(16 * te + fr, 4 * ks + fq));
        ao = mfma16(bu, aa[ks], ao);
        aw = mfma16(bw, aa[ks], aw);
      }
      const int e0 = 16 * te + 4 * fq;
      *(f32x4*)(o0 + e0) = ao;
      const u32x2 qv = *(const u32x2*)(smem + G_QB + sw256(trow, e0 >> 3) + (e0 & 7) * 2);
      f32x4 qd = {lo2f(qv[0]) * eg - aw[0], hi2f(qv[0]) * eg - aw[1], lo2f(qv[1]) * eg - aw[2], hi2f(qv[1]) * eg - aw[3]};
      *(u32x2*)(qp + e0) = pack4(qd);
    }
  }
}

DI void sgu_item(const Params& p, unsigned char* smem_, int item) {
  unsigned char* smem; { LAS unsigned char* l_ = (LAS unsigned char*)smem_; asm volatile("" : "+v"(l_)); smem = (unsigned char*)l_; }
  int tid = threadIdx.x; asm volatile("" : "+v"(tid));
  const int lane = tid & 63, wave = __builtin_amdgcn_readfirstlane(tid >> 6), fr = lane & 15, fq = lane >> 4;
  unsigned char* ws = p.ws; asm volatile("" : "+s"(ws));
  const int g = item & 3, cn = item >> 2;
  const size_t t0 = (size_t)cn * 128;
  const bf16_t* uvg = (const bf16_t*)(ws + O_UVG);
  __syncthreads();
  {
    const float* lng = p.in[I_SLNG]; const float* lnb = p.in[I_SLNB];
    const int cl0 = 8 * (lane & 15);
    float gg[8], bb[8];
#pragma unroll
    for (int e = 0; e < 8; ++e) { gg[e] = lng[128 * g + cl0 + e]; bb[e] = lnb[128 * g + cl0 + e]; }
    for (int jj = 0; jj < 16; ++jj) {
      const int j = 16 * wave + jj;
      const u32x4 raw = *(const u32x4*)(uvg + (t0 + j) * 1024 + 512 + 8 * lane);
      float v[8];
#pragma unroll
      for (int e = 0; e < 4; ++e) { v[2 * e] = lo2f(raw[e]); v[2 * e + 1] = hi2f(raw[e]); }
      float s = 0.f;
#pragma unroll
      for (int e = 0; e < 8; ++e) s += v[e];
      const float mean = wave_sum(s) * (1.f / 512.f);
      float q = 0.f;
#pragma unroll
      for (int e = 0; e < 8; ++e) { const float d = v[e] - mean; q += d * d; }
      const float rstd = rsqrtf(wave_sum(q) * (1.f / 512.f) + 1e-5f);
      if ((lane >> 4) == g) {
#pragma unroll
        for (int e = 0; e < 8; ++e) {
          const int c = cl0 + e;
          const float y = (v[e] - mean) * rstd * gg[e] + bb[e];
          *(bf16_t*)(smem + sw256(c, j >> 3) + (j & 7) * 2) = f2bf(y);
        }
      }
    }
  }
  __syncthreads();
  {
    const bf16_t* wg = (const bf16_t*)(ws + O_SGUW) + (size_t)g * 16384;
    const int i = 16 * wave + fr;
    bf16x8 af[4];
#pragma unroll
    for (int ks = 0; ks < 4; ++ks) af[ks] = ldfrag(wg + i * 128 + 32 * ks + 8 * fq);
    const float bias = p.in[I_SGUB][g * 128 + i];
    bf16_t* out = (bf16_t*)(ws + O_SGUO) + (t0 + i) * 512 + 128 * g;
    const bf16_t* urow = uvg + (t0 + i) * 1024 + 128 * g;
#pragma unroll
    for (int jt = 0; jt < 8; ++jt) {
      f32x4 acc = {0.f, 0.f, 0.f, 0.f};
#pragma unroll
      for (int ks = 0; ks < 4; ++ks) acc = mfma16(ldfrag(smem + sw256(16 * jt + fr, 4 * ks + fq)), af[ks], acc);
      const int c0 = 16 * jt + 4 * fq;
      const u32x2 uu = *(const u32x2*)(urow + c0);
      f32x4 o = {lo2f(uu[0]) * (acc[0] + bias), hi2f(uu[0]) * (acc[1] + bias), lo2f(uu[1]) * (acc[2] + bias), hi2f(uu[1]) * (acc[3] + bias)};
      *(u32x2*)(out + c0) = pack4(o);
    }
  }
}

DI void xattn_item(const Params& p, int item) {
  int tid = threadIdx.x; asm volatile("" : "+v"(tid));
  const int lane = tid & 63, wave = __builtin_amdgcn_readfirstlane(tid >> 6), fr = lane & 15, fq = lane >> 4;
  unsigned char* ws = p.ws; asm volatile("" : "+s"(ws));
  const int h = item & 3, qt = item >> 2;
  const size_t trow = (size_t)qt * 128 + 16 * wave + fr;
  const int b = (qt * 128) >> 13;
  const bf16_t* xq = (const bf16_t*)(ws + O_XQ) + trow * 512 + h * 128;
  const bf16_t* mk = (const bf16_t*)(ws + O_MEMK) + (size_t)(b * 4 + h) * 32768;
  const bf16_t* mv = (const bf16_t*)(ws + O_MEMVT) + (size_t)(b * 4 + h) * 32768;
  bf16x8 qf[4];
#pragma unroll
  for (int ds = 0; ds < 4; ++ds) qf[ds] = ldfrag(xq + 32 * ds + 8 * fq);
  f32x4 sc[16];
#pragma unroll
  for (int kt = 0; kt < 16; ++kt) {
    f32x4 a = {0.f, 0.f, 0.f, 0.f};
#pragma unroll
    for (int ds = 0; ds < 4; ++ds) a = mfma16(ldfrag(mk + (16 * kt + fr) * 128 + 32 * ds + 8 * fq), qf[ds], a);
    sc[kt] = a;
  }
  float m = -1e30f;
#pragma unroll
  for (int kt = 0; kt < 16; ++kt)
#pragma unroll
    for (int r = 0; r < 4; ++r) m = fmaxf(m, sc[kt][r]);
  m = fmaxf(m, __shfl_xor(m, 16)); m = fmaxf(m, __shfl_xor(m, 32));
  float l = 0.f;
#pragma unroll
  for (int kt = 0; kt < 16; ++kt)
#pragma unroll
    for (int r = 0; r < 4; ++r) { const float e = __expf(sc[kt][r] - m); sc[kt][r] = e; l += e; }
  l += __shfl_xor(l, 16); l += __shfl_xor(l, 32);
  const float inv = 1.f / l;
  bf16x8 pf[8];
#pragma unroll
  for (int s = 0; s < 8; ++s) pf[s] = pack8(sc[2 * s], sc[2 * s + 1]);
  bf16_t* out = (bf16_t*)(ws + O_XATO) + trow * 512 + h * 128;
#pragma unroll
  for (int dt = 0; dt < 8; ++dt) {
    f32x4 a = {0.f, 0.f, 0.f, 0.f};
#pragma unroll
    for (int s = 0; s < 8; ++s) a = mfma16(ldfrag(mv + (16 * dt + fr) * 256 + 32 * s + 8 * fq), pf[s], a);
    f32x4 o = {a[0] * inv, a[1] * inv, a[2] * inv, a[3] * inv};
    *(u32x2*)(out + 16 * dt + 4 * fq) = pack4(o);
  }
}

DI void phase2(const Params& p, unsigned char* smem, int bid, int nb) {
  for (int rep = 0; rep < ((DUPMASK >> 20) & 1) + 1; ++rep) for (int it = bid; it < 1024; it += nb) gdn_prep_item(p, smem, it);
  for (int rep = 0; rep < ((DUPMASK >> 21) & 1) + 1; ++rep) for (int it = bid; it < 512; it += nb) sgu_item(p, smem, it);
  for (int rep = 0; rep < ((DUPMASK >> 22) & 1) + 1; ++rep) for (int it = bid; it < 512; it += nb) xattn_item(p, it);
}

DI void gdn_scan4(const Params& p, unsigned char* smem_, int bh, int es) {
  int tid = threadIdx.x; asm volatile("" : "+v"(tid));
  unsigned char* smem; { LAS unsigned char* l_ = (LAS unsigned char*)smem_; asm volatile("" : "+v"(l_)); smem = (unsigned char*)l_; }
  const int lane = tid & 63, w = __builtin_amdgcn_readfirstlane(tid >> 6);
  if (w >= 4) {
    for (int n = 0; n < 128; ++n) __builtin_amdgcn_s_barrier();
    return;
  }
  unsigned char* ws = p.ws;
  const int b = bh >> 2, h = bh & 3;
  const int fr = lane & 15, fq = lane >> 4;
  const size_t item0 = (size_t)(b * 128) * 4 + h;
  constexpr size_t ISTR = 4 * 16384;
  const bf16_t* mp = (const bf16_t*)(ws + O_MP) + item0 * 16384 + (size_t)(2 * w) * 2048 + lane * 8;
  const float* bc = (const float*)(ws + O_BC) + item0 * 16384 + (size_t)es * 2048 + (size_t)(2 * w) * 256 + lane * 4;
  bf16_t* st = (bf16_t*)(ws + O_ST) + item0 * 16384 + (size_t)(16 * es + fr) * 128 + 32 * w + 4 * fq;
  const float* glp = (const float*)(ws + O_GL) + item0;
  asm volatile("" : "+v"(glp));
  f32x4 acc0 = {0.f, 0.f, 0.f, 0.f}, acc1 = {0.f, 0.f, 0.f, 0.f};
  constexpr int PD = 2;
  bf16x8 A[PD][8]; f32x4 C[PD][2]; float G[PD];
#pragma unroll
  for (int d = 0; d < PD; ++d) {
#pragma unroll
    for (int i = 0; i < 8; ++i) A[d][i] = ldfrag(mp + (size_t)d * ISTR + i * 512);
    C[d][0] = *(const f32x4*)(bc + (size_t)d * ISTR); C[d][1] = *(const f32x4*)(bc + (size_t)d * ISTR + 256);
    G[d] = glp[d * 4];
  }
  unsigned char* xch = smem;
  for (int n0 = 0; n0 < 128; n0 += PD) {
#pragma unroll
    for (int d = 0; d < PD; ++d) {
      const int n = n0 + d;
      const int np = (n + PD < 128) ? n + PD : n;
      const u32x2 lo = pack4(acc0), hi = pack4(acc1);
      bf16_t* stn = st + (size_t)n * ISTR;
      *(u32x2*)(stn) = lo; *(u32x2*)(stn + 16) = hi;
      const u32x4 mine = {lo[0], lo[1], hi[0], hi[1]};
      *(u32x4*)(xch + ((n & 1) * 4 + w) * 1024 + lane * 16) = mine;
      asm volatile("s_waitcnt lgkmcnt(0)" ::: "memory");
      __builtin_amdgcn_s_barrier();
      asm volatile("" ::: "memory");
      bf16x8 bfr[4];
#pragma unroll
      for (int s = 0; s < 4; ++s) bfr[s] = ldfrag(xch + ((n & 1) * 4 + s) * 1024 + lane * 16);
      const float g = G[d];
      f32x4 a0 = {g * acc0[0] + C[d][0][0], g * acc0[1] + C[d][0][1], g * acc0[2] + C[d][0][2], g * acc0[3] + C[d][0][3]};
      f32x4 a1 = {g * acc1[0] + C[d][1][0], g * acc1[1] + C[d][1][1], g * acc1[2] + C[d][1][2], g * acc1[3] + C[d][1][3]};
#pragma unroll
      for (int s = 0; s < 4; ++s) { a0 = mfma16(A[d][s], bfr[s], a0); a1 = mfma16(A[d][4 + s], bfr[s], a1); }
      acc0 = a0; acc1 = a1;
#pragma unroll
      for (int i = 0; i < 8; ++i) A[d][i] = ldfrag(mp + (size_t)np * ISTR + i * 512);
      C[d][0] = *(const f32x4*)(bc + (size_t)np * ISTR); C[d][1] = *(const f32x4*)(bc + (size_t)np * ISTR + 256);
      G[d] = glp[(size_t)np * 4];
    }
  }
}

struct EpiGate {
  const bf16_t* gates; int goff; const bf16_t* src; bf16_t* dst;
  DI void operator()(const f32x4 (&acc)[2][2][4][2], const pg::Unit& u, int wr, int wc, int fr, int fq) const {
#pragma unroll
    for (int ai = 0; ai < 2; ++ai)
#pragma unroll
      for (int m = 0; m < 4; ++m) {
        const size_t row = (size_t)u.pm * 256 + 128 * ai + 64 * wr + 16 * m + fr;
#pragma unroll
        for (int bj = 0; bj < 2; ++bj)
#pragma unroll
          for (int n = 0; n < 2; ++n) {
            const int col = u.pn * 256 + 128 * bj + 32 * wc + 16 * n + 4 * fq;
            const f32x4 v = acc[ai][bj][m][n];
            const u32x2 g = *(const u32x2*)(gates + row * 3072 + goff + col);
            f32x4 o = {lo2f(g[0]) * v[0], hi2f(g[0]) * v[1], lo2f(g[1]) * v[2], hi2f(g[1]) * v[3]};
            if (src) { const u32x2 s = *(const u32x2*)(src + row * 1024 + col); o[0] += lo2f(s[0]); o[1] += hi2f(s[0]); o[2] += lo2f(s[1]); o[3] += hi2f(s[1]); }
            *(u32x2*)(dst + row * 1024 + col) = pack4(o);
          }
      }
  }
};
DI void phase3(const Params& p, unsigned char* smem, int bid, int nb) {
  unsigned char* ws = p.ws;
  if (bid < 64) {
    __syncthreads();
    gdn_scan4(p, smem, bid & 7, bid >> 3);
  } else {
    PG_LAS unsigned char* lds = (PG_LAS unsigned char*)smem;
    const bf16_t* gates = (const bf16_t*)(ws + O_GATES);
    bf16_t* part = (bf16_t*)(ws + O_PART);
    __syncthreads();
    { pg::DenseOrder S; S.init(ws + O_SGUO, ws + O_WBT, T, 1024, 512, nb - 64, bid - 64); EpiGate E{gates, 1024, nullptr, part}; pg::gemm_phase<EpiGate, pg::DenseOrder, false, true>(lds, 512, S, E); }
    asm volatile("s_waitcnt vmcnt(0)" ::: "memory");
    __builtin_amdgcn_fence(__ATOMIC_ACQUIRE, "agent");
    asm volatile("s_waitcnt vmcnt(0)" ::: "memory");
    __syncthreads();
    { pg::DenseOrder S; S.init(ws + O_XATO, ws + O_WCT, T, 1024, 512, nb - 64, bid - 64); EpiGate E{gates, 2048, part, part}; pg::gemm_phase<EpiGate, pg::DenseOrder, false, true>(lds, 512, S, E); }
  }
}

DI void phase4(const Params& p, int bid, int nb) {
  int tid = threadIdx.x; asm volatile("" : "+v"(tid));
  const int lane = tid & 63, wave = tid >> 6, fr = lane & 15, fq = lane >> 4;
  unsigned char* ws = p.ws;
  for (int it = bid; it < 512; it += nb) {
    const int item = it * 2 + (wave >> 2), tt = wave & 3;
    const int h = item & 3, cn = item >> 2;
    const size_t trow = (size_t)cn * 64 + 16 * tt + fr;
    const bf16_t* qp = (const bf16_t*)(ws + O_QP) + (size_t)item * 8192 + (16 * tt + fr) * 128;
    const bf16_t* st = (const bf16_t*)(ws + O_ST) + (size_t)item * 16384;
    const float* o0 = (const float*)(ws + O_O0) + trow * 512 + h * 128;
    bf16x8 af[4];
#pragma unroll
    for (int ks = 0; ks < 4; ++ks) af[ks] = ldfrag(qp + 32 * ks + 8 * fq);
    f32x4 acc[8];
    float ss = 0.f;
#pragma unroll
    for (int j = 0; j < 8; ++j) {
      f32x4 a = *(const f32x4*)(o0 + 16 * j + 4 * fq);
#pragma unroll
      for (int ks = 0; ks < 4; ++ks) a = mfma16(ldfrag(st + (16 * j + fr) * 128 + 32 * ks + 8 * fq), af[ks], a);
      acc[j] = a;
      ss += a[0] * a[0] + a[1] * a[1] + a[2] * a[2] + a[3] * a[3];
    }
    ss += __shfl_xor(ss, 16); ss += __shfl_xor(ss, 32);
    const float rms = rsqrtf(ss * (1.f / 128.f) + 1e-6f);
    const float* ng = p.in[I_GNG];
    const bf16_t* zs = (const bf16_t*)(ws + O_ZS) + trow * 512 + h * 128;
    bf16_t* out = (bf16_t*)(ws + O_GDNO) + trow * 512 + h * 128;
#pragma unroll
    for (int j = 0; j < 8; ++j) {
      const int e0 = 16 * j + 4 * fq;
      const f32x4 g = *(const f32x4*)(ng + e0);
      const u32x2 z = *(const u32x2*)(zs + e0);
      f32x4 o = {acc[j][0] * rms * g[0] * lo2f(z[0]), acc[j][1] * rms * g[1] * hi2f(z[0]), acc[j][2] * rms * g[2] * lo2f(z[1]), acc[j][3] * rms * g[3] * hi2f(z[1])};
      *(u32x2*)(out + e0) = pack4(o);
    }
  }
}

DI void phase5(const Params& p, unsigned char* smem, int bid, int nb) {
  unsigned char* ws = p.ws;
  PG_LAS unsigned char* lds = (PG_LAS unsigned char*)smem;
  __syncthreads();
  pg::DenseOrder S; S.init(ws + O_GDNO, ws + O_WAT, T, 1024, 512, nb, bid);
  EpiGate E{(const bf16_t*)(ws + O_GATES), 0, (const bf16_t*)(ws + O_PART), (bf16_t*)(ws + O_MERGED)};
  pg::gemm_phase<EpiGate, pg::DenseOrder, false, true>(lds, 512, S, E);
}
struct EpiX1 {
  const float* x; float* x1;
  DI void operator()(const f32x4 (&acc)[2][2][4][2], const pg::Unit& u, int wr, int wc, int fr, int fq) const {
#pragma unroll
    for (int ai = 0; ai < 2; ++ai)
#pragma unroll
      for (int m = 0; m < 4; ++m) {
        const size_t row = (size_t)u.pm * 256 + 128 * ai + 64 * wr + 16 * m + fr;
#pragma unroll
        for (int bj = 0; bj < 2; ++bj)
#pragma unroll
          for (int n = 0; n < 2; ++n) {
            const int col = u.pn * 256 + 128 * bj + 32 * wc + 16 * n + 4 * fq;
            const f32x4 v = acc[ai][bj][m][n];
            const f32x4 xv = *(const f32x4*)(x + row * 1024 + col);
            f32x4 o = {ALPHA * xv[0] + v[0], ALPHA * xv[1] + v[1], ALPHA * xv[2] + v[2], ALPHA * xv[3] + v[3]};
            *(f32x4*)(x1 + row * 1024 + col) = o;
          }
      }
  }
};
DI void phase6(const Params& p, unsigned char* smem, int bid, int nb) {
  unsigned char* ws = p.ws;
  PG_LAS unsigned char* lds = (PG_LAS unsigned char*)smem;
  __syncthreads();
  pg::DenseOrder S; S.init(ws + O_MERGED, ws + O_WOT, T, 1024, 1024, nb, bid);
  EpiX1 E{p.in[I_X], (float*)(ws + O_X1)};
  pg::gemm_phase<EpiX1, pg::DenseOrder, false, false>(lds, 1024, S, E);
}

DI void ln_row(const float* src, const float* g, const float* b, float (&v)[16], int lane) {
  float s = 0.f;
#pragma unroll
  for (int i = 0; i < 16; ++i) s += v[i];
  const float mean = wave_sum(s) * (1.f / 1024.f);
  float q = 0.f;
#pragma unroll
  for (int i = 0; i < 16; ++i) { const float d = v[i] - mean; q += d * d; }
  const float rstd = rsqrtf(wave_sum(q) * (1.f / 1024.f) + 1e-5f);
#pragma unroll
  for (int i = 0; i < 4; ++i) {
    const int k = 256 * i + 4 * lane;
    const f32x4 gg = *(const f32x4*)(g + k), bb = *(const f32x4*)(b + k);
#pragma unroll
    for (int c = 0; c < 4; ++c) v[4 * i + c] = (v[4 * i + c] - mean) * rstd * gg[c] + bb[c];
  }
}
DI void phase7(const Params& p, int bid, int nb) {
  int tid = threadIdx.x; asm volatile("" : "+v"(tid));
  const int lane = tid & 63, wave = tid >> 6;
  unsigned char* ws = p.ws;
  for (int i = bid * NTHR + tid; i < MAXSLOT; i += nb * NTHR) { ((int*)(ws + O_SLOTTOK))[i] = 0; ((int*)(ws + O_SLOTAID))[i] = -1; }
  float* x1 = (float*)(ws + O_X1);
  bf16_t* x1b = (bf16_t*)(ws + O_X1B);
  for (int row = bid * 8 + wave; row < T; row += nb * 8) {
    float v[16];
#pragma unroll
    for (int i = 0; i < 4; ++i) { const f32x4 t = *(const f32x4*)(x1 + (size_t)row * D + 256 * i + 4 * lane); v[4 * i] = t[0]; v[4 * i + 1] = t[1]; v[4 * i + 2] = t[2]; v[4 * i + 3] = t[3]; }
    ln_row(nullptr, p.in[I_LN1G], p.in[I_LN1B], v, lane);
#pragma unroll
    for (int i = 0; i < 4; ++i) {
      const f32x4 o = {v[4 * i], v[4 * i + 1], v[4 * i + 2], v[4 * i + 3]};
      *(f32x4*)(x1 + (size_t)row * D + 256 * i + 4 * lane) = o;
      *(u32x2*)(x1b + (size_t)row * D + 256 * i + 4 * lane) = pack4(o);
    }
  }
}
struct EpiLogits {
  float* logits;
  DI void operator()(const f32x4 (&acc)[2][2][4][2], const pg::Unit& u, int wr, int wc, int fr, int fq) const {
#pragma unroll
    for (int ai = 0; ai < 2; ++ai)
#pragma unroll
      for (int m = 0; m < 4; ++m) {
        const size_t row = (size_t)u.pm * 256 + 128 * ai + 64 * wr + 16 * m + fr;
#pragma unroll
        for (int bj = 0; bj < 2; ++bj)
#pragma unroll
          for (int n = 0; n < 2; ++n) *(f32x4*)(logits + row * 256 + 128 * bj + 32 * wc + 16 * n + 4 * fq) = acc[ai][bj][m][n];
      }
  }
};
DI void phase8(const Params& p, unsigned char* smem, int bid, int nb) {
  unsigned char* ws = p.ws;
  PG_LAS unsigned char* lds = (PG_LAS unsigned char*)smem;
  __syncthreads();
  pg::DenseOrder S; S.init(ws + O_X1B, ws + O_ROUT, T, 256, 1024, nb, bid);
  EpiLogits E{(float*)(ws + O_LOGITS)};
  pg::gemm_phase<EpiLogits, pg::DenseOrder, false, false>(lds, 1024, S, E);
}
DI void phase9(const Params& p, int bid, int nb) {
  int tid = threadIdx.x; asm volatile("" : "+v"(tid));
  const int lane = tid & 63, wave = tid >> 6;
  unsigned char* ws = p.ws;
  const float* logits = (const float*)(ws + O_LOGITS);
  int* counts = (int*)(ws + O_CTRL);
  const f32x4 bias = *(const f32x4*)(p.in[I_RB] + 4 * lane);
  const float NEG = -__builtin_inff();
  for (int tok = bid * 8 + wave; tok < T; tok += nb * 8) {
    const f32x4 lg = *(const f32x4*)(logits + (size_t)tok * 256 + 4 * lane);
    float sc[4], mv[4];
#pragma unroll
    for (int c = 0; c < 4; ++c) { sc[c] = sigmoidf_(lg[c]); mv[c] = sc[c] + bias[c]; }
    float m1 = NEG, m2 = NEG;
#pragma unroll
    for (int c = 0; c < 4; ++c) { const float v = mv[c]; if (v > m1) { m2 = m1; m1 = v; } else if (v > m2) m2 = v; }
#pragma unroll
    for (int o = 1; o < 8; o <<= 1) {
      const float o1 = __shfl_xor(m1, o), o2 = __shfl_xor(m2, o);
      const float n1 = fmaxf(m1, o1), n2 = fmaxf(fminf(m1, o1), fmaxf(m2, o2));
      m1 = n1; m2 = n2;
    }
    const float gs = m1 + m2;
    const int g = lane >> 3;
    int rank = 0;
#pragma unroll
    for (int gg = 0; gg < 8; ++gg) { const float og = __shfl(gs, gg * 8); rank += ((og > gs) || (og == gs && gg < g)) ? 1 : 0; }
    if (rank >= 4) {
#pragma unroll
      for (int c = 0; c < 4; ++c) mv[c] = NEG;
    }
    int myidx = 0; float mysc = 0.f, ssum = 0.f;
#pragma unroll
    for (int k = 0; k < 8; ++k) {
      float bv = mv[0]; int bi = 0;
#pragma unroll
      for (int c = 1; c < 4; ++c) if (mv[c] > bv) { bv = mv[c]; bi = c; }
      float rv = bv; int ri = lane * 4 + bi;
#pragma unroll
      for (int o = 32; o; o >>= 1) {
        const float ov = __shfl_xor(rv, o); const int oi = __shfl_xor(ri, o);
        if (ov > rv || (ov == rv && oi < ri)) { rv = ov; ri = oi; }
      }
      const int wl = ri >> 2, wc = ri & 3;
      const float mine = wc == 0 ? sc[0] : wc == 1 ? sc[1] : wc == 2 ? sc[2] : sc[3];
      const float wsc = __shfl(mine, wl);
      if (lane == wl) {
#pragma unroll
        for (int c = 0; c < 4; ++c) if (c == wc) mv[c] = NEG;
      }
      ssum += wsc;
      if (lane == k) { myidx = ri; mysc = wsc; }
    }
    if (lane < 8) {
      const int pos = atomicAdd(&counts[myidx * CSTR], 1);
      ((int*)(ws + O_TKIDX))[(size_t)tok * 8 + lane] = myidx;
      ((float*)(ws + O_TKW))[(size_t)tok * 8 + lane] = mysc / ssum * 2.5f;
      ((int*)(ws + O_TKPOS))[(size_t)tok * 8 + lane] = pos;
    }
  }
}
DI void build_tile_start(const Params& p, int* ts) {
  const int tid = threadIdx.x;
  const int* counts = (const int*)(p.ws + O_CTRL);
  __syncthreads();
  if (tid < 256) ts[300 + tid] = (counts[tid * CSTR] + 255) >> 8;
  __syncthreads();
  if (tid == 0) { int s = 0; for (int e = 0; e < 256; ++e) { ts[e] = s; s += ts[300 + e]; } ts[256] = s; }
  __syncthreads();
}
DI void phase10(const Params& p, unsigned char* smem, int bid, int nb) {
  int* ts = (int*)smem;
  build_tile_start(p, ts);
  unsigned char* ws = p.ws;
  const int* tkidx = (const int*)(ws + O_TKIDX); const int* tkpos = (const int*)(ws + O_TKPOS); const float* tkw = (const float*)(ws + O_TKW);
  int* slottok = (int*)(ws + O_SLOTTOK); float* slotw = (float*)(ws + O_SLOTW); int* slotaid = (int*)(ws + O_SLOTAID);
  for (int i = bid * NTHR + threadIdx.x; i < T * 8; i += nb * NTHR) {
    const int e = tkidx[i];
    const int slot = ts[e] * 256 + tkpos[i];
    slottok[slot] = i >> 3; slotw[slot] = tkw[i]; slotaid[slot] = i;
  }
}

DI int find_expert(const int* ts, int ti) { int lo = 0, hi = 255; while (lo < hi) { const int mid = (lo + hi + 1) >> 1; if (ts[mid] <= ti) lo = mid; else hi = mid - 1; } return lo; }

template <int NPN, bool UP>
struct MoeOrder {
  const int* ts; unsigned char* ws; int ntile, G, c;
  DI bool next(int i, pg::Unit& u) const {
    const int L = i * G + c;
    if (L >= ntile * NPN) return false;
    const int ti = L / NPN, pn = L - ti * NPN;
    const int e = find_expert(ts, ti);
    u.pm = ti; u.pn = pn; u.e = e;
    if (UP) { u.a = (const char*)(ws + O_X1B); u.rows = (const int*)(ws + O_SLOTTOK) + ti * 256; u.b = (const char*)(ws + O_WGU) + (size_t)e * 1048576 + (size_t)pn * 524288; }
    else    { u.a = (const char*)(ws + O_ACT) + (size_t)ti * 131072; u.rows = nullptr; u.b = (const char*)(ws + O_WD) + (size_t)e * 524288 + (size_t)pn * 131072; }
    return true;
  }
};
struct EpiAct {
  bf16_t* actp;
  DI void operator()(const f32x4 (&acc)[2][2][4][2], const pg::Unit& u, int wr, int wc, int fr, int fq) const {
#pragma unroll
    for (int ai = 0; ai < 2; ++ai)
#pragma unroll
      for (int m = 0; m < 4; ++m) {
        const size_t row = (size_t)u.pm * 256 + 128 * ai + 64 * wr + 16 * m + fr;
#pragma unroll
        for (int bj = 0; bj < 2; ++bj) {
          const int blk = 8 * u.pn + 4 * bj + wc;
          const f32x4 g = acc[ai][bj][m][0], uu = acc[ai][bj][m][1];
          f32x4 o = {siluf_(g[0]) * uu[0], siluf_(g[1]) * uu[1], siluf_(g[2]) * uu[2], siluf_(g[3]) * uu[3]};
          *(u32x2*)(actp + row * 256 + blk * 16 + 4 * fq) = pack4(o);
        }
      }
  }
};
struct EpiBf16Out {
  bf16_t* dst;
  DI void operator()(const f32x4 (&acc)[2][2][4][2], const pg::Unit& u, int wr, int wc, int fr, int fq) const {
#pragma unroll
    for (int ai = 0; ai < 2; ++ai)
#pragma unroll
      for (int m = 0; m < 4; ++m) {
        const size_t row = (size_t)u.pm * 256 + 128 * ai + 64 * wr + 16 * m + fr;
#pragma unroll
        for (int bj = 0; bj < 2; ++bj)
#pragma unroll
          for (int n = 0; n < 2; ++n) *(u32x2*)(dst + row * 1024 + u.pn * 256 + 128 * bj + 32 * wc + 16 * n + 4 * fq) = pack4(acc[ai][bj][m][n]);
      }
  }
};
struct EpiDown {
  const int* slotaid; const float* slotw; unsigned char* ybase;
  DI void operator()(const f32x4 (&acc)[2][2][4][2], const pg::Unit& u, int wr, int wc, int fr, int fq) const {
    const unsigned row0 = (unsigned)u.pm * 256u + 64u * wr + fr;
    const unsigned colb = ((unsigned)u.pn * 256u + 32u * wc + 4u * fq) * 2u;
#pragma unroll
    for (int ai = 0; ai < 2; ++ai) {
#pragma unroll
      for (int m = 0; m < 4; ++m) {
        const unsigned row = row0 + 128u * ai + 16u * m;
        const int aid = slotaid[row]; const float ww = slotw[row];
        if (aid >= 0) {
          const unsigned off = (unsigned)aid * 2048u + colb;
#pragma unroll
          for (int bj = 0; bj < 2; ++bj)
#pragma unroll
            for (int n = 0; n < 2; ++n) {
              const f32x4 v = acc[ai][bj][m][n];
              f32x4 o = {v[0] * ww, v[1] * ww, v[2] * ww, v[3] * ww};
              *(u32x2*)(ybase + (size_t)(off + (unsigned)(256 * bj + 32 * n))) = pack4(o);
            }
        }
      }
      asm volatile("" ::: "memory");
    }
  }
};
DI void phase11(const Params& p, unsigned char* smem, int bid, int nb) {
  unsigned char* ws = p.ws;
  int* ts = (int*)(smem + 131072);
  build_tile_start(p, ts);
  PG_LAS unsigned char* lds = (PG_LAS unsigned char*)smem;
  { MoeOrder<2, true> S{ts, ws, ts[256], nb, bid}; EpiAct E{(bf16_t*)(ws + O_ACT)}; pg::gemm_phase<EpiAct, MoeOrder<2, true>, true, true>(lds, 1024, S, E); }
  __syncthreads();
  { pg::DenseOrder S; S.init(ws + O_X1B, ws + O_WSGU, T, 512, 1024, nb, bid); EpiAct E{(bf16_t*)(ws + O_ACTSH)}; pg::gemm_phase<EpiAct, pg::DenseOrder, false, true>(lds, 1024, S, E); }
}
DI void phase12(const Params& p, unsigned char* smem, int bid, int nb) {
  unsigned char* ws = p.ws;
  int* ts = (int*)(smem + 131072);
  build_tile_start(p, ts);
  PG_LAS unsigned char* lds = (PG_LAS unsigned char*)smem;
  { MoeOrder<4, false> S{ts, ws, ts[256], nb, bid}; EpiDown E{(const int*)(ws + O_SLOTAID), (const float*)(ws + O_SLOTW), ws + O_Y}; pg::gemm_phase<EpiDown, MoeOrder<4, false>, false, true>(lds, 256, S, E); }
  __syncthreads();
  { pg::DenseOrder S; S.init(ws + O_ACTSH, ws + O_WSD, T, 1024, 256, nb, bid); EpiBf16Out E{(bf16_t*)(ws + O_YSH)}; pg::gemm_phase<EpiBf16Out, pg::DenseOrder, false, true>(lds, 256, S, E); }
}
DI void phase13(const Params& p, int bid, int nb) {
  int tid = threadIdx.x; asm volatile("" : "+v"(tid));
  const int lane = tid & 63, wave = tid >> 6;
  unsigned char* ws = p.ws;
  const float* x1 = (const float*)(ws + O_X1);
  const bf16_t* ysh = (const bf16_t*)(ws + O_YSH);
  const bf16_t* y = (const bf16_t*)(ws + O_Y);
  for (int row = bid * 8 + wave; row < T; row += nb * 8) {
    float v[16];
#pragma unroll
    for (int i = 0; i < 4; ++i) {
      const int k = 256 * i + 4 * lane;
      const f32x4 t = *(const f32x4*)(x1 + (size_t)row * D + k);
      const u32x2 s = *(const u32x2*)(ysh + (size_t)row * D + k);
      v[4 * i] = ALPHA * t[0] + lo2f(s[0]); v[4 * i + 1] = ALPHA * t[1] + hi2f(s[0]); v[4 * i + 2] = ALPHA * t[2] + lo2f(s[1]); v[4 * i + 3] = ALPHA * t[3] + hi2f(s[1]);
    }
#pragma unroll
    for (int k8 = 0; k8 < 8; ++k8) {
#pragma unroll
      for (int i = 0; i < 4; ++i) {
        const u32x2 s = *(const u32x2*)(y + ((size_t)row * 8 + k8) * 1024 + 256 * i + 4 * lane);
        v[4 * i] += lo2f(s[0]); v[4 * i + 1] += hi2f(s[0]); v[4 * i + 2] += lo2f(s[1]); v[4 * i + 3] += hi2f(s[1]);
      }
    }
    ln_row(nullptr, p.in[I_LN2G], p.in[I_LN2B], v, lane);
#pragma unroll
    for (int i = 0; i < 4; ++i) { const f32x4 o = {v[4 * i], v[4 * i + 1], v[4 * i + 2], v[4 * i + 3]}; *(f32x4*)(p.out + (size_t)row * D + 256 * i + 4 * lane) = o; }
  }
}

DI void load_params(Params& lp, const unsigned char* smem) {
  const unsigned* t = (const unsigned*)(smem + PTAB_OFF);
#pragma unroll
  for (int i = 0; i < 28; ++i) lp.in[i] = (const float*)(((unsigned long long)(unsigned)__builtin_amdgcn_readfirstlane((int)t[2 * i + 1]) << 32) | (unsigned)__builtin_amdgcn_readfirstlane((int)t[2 * i]));
  lp.out = (float*)(((unsigned long long)(unsigned)__builtin_amdgcn_readfirstlane((int)t[57]) << 32) | (unsigned)__builtin_amdgcn_readfirstlane((int)t[56]));
  lp.ws = (unsigned char*)(((unsigned long long)(unsigned)__builtin_amdgcn_readfirstlane((int)t[59]) << 32) | (unsigned)__builtin_amdgcn_readfirstlane((int)t[58]));
}
__global__ void __launch_bounds__(NTHR) mega_kernel(Params pk) {
  extern __shared__ __attribute__((aligned(16))) unsigned char smem[];
  cg::grid_group grid = cg::this_grid();
  const int bid = blockIdx.x, nb = gridDim.x;
  volatile LAS unsigned* bst = (volatile LAS unsigned*)(smem + LDS_BYTES - 16);
  if (threadIdx.x < 4) bst[threadIdx.x] = 0u;
  if (threadIdx.x < 30) {
    const __attribute__((address_space(4))) unsigned long long* ka = (const __attribute__((address_space(4))) unsigned long long*)__builtin_amdgcn_kernarg_segment_ptr();
    ((unsigned long long*)(smem + PTAB_OFF))[threadIdx.x] = ka[threadIdx.x];
  }
  unsigned* barw = (unsigned*)(pk.ws + O_BAR);
  __syncthreads();
  XcdBarrier xb = xcd_barrier_post(barw, bst);
#define GSYNC() xcd_barrier(xb)
#define RUNP(k, call) do { { Params p; load_params(p, smem); call; } GSYNC(); if (DUPMASK & (1 << (k))) { { Params p; load_params(p, smem); call; } GSYNC(); } } while (0)
  { Params p; load_params(p, smem); phase0(p, smem, bid, nb); } grid.sync();
  RUNP(1, phase1(p, smem, bid, nb));
  RUNP(2, phase2(p, smem, bid, nb));
  RUNP(3, phase3(p, smem, bid, nb));
  RUNP(4, phase4(p, bid, nb));
  RUNP(5, phase5(p, smem, bid, nb));
  RUNP(6, phase6(p, smem, bid, nb));
  RUNP(14, phase7(p, bid, nb));
  if (DUPMASK & (1 << 7)) { { Params p; load_params(p, smem); phase6(p, smem, bid, nb); } GSYNC(); { Params p; load_params(p, smem); phase7(p, bid, nb); } GSYNC(); }
  RUNP(8, phase8(p, smem, bid, nb));
  RUNP(14, phase9(p, bid, nb));
  if (DUPMASK & (1 << 9)) { { Params p; load_params(p, smem); if (bid == 0 && threadIdx.x < 256) ((int*)(p.ws + O_CTRL))[threadIdx.x * CSTR] = 0; } GSYNC(); { Params p; load_params(p, smem); phase9(p, bid, nb); } GSYNC(); }
  RUNP(10, phase10(p, smem, bid, nb));
  RUNP(11, phase11(p, smem, bid, nb));
  RUNP(12, phase12(p, smem, bid, nb));
  { Params p; load_params(p, smem); phase13(p, bid, nb); }
  if (DUPMASK & (1 << 13)) { GSYNC(); Params p; load_params(p, smem); phase13(p, bid, nb); }
  if (DUPMASK & (1 << 15)) { for (int i = 0; i < 10; ++i) GSYNC(); }
}

extern "C" void kernel_launch(void* const* d_in, const int* in_sizes, int n_in, void* d_out, int out_size, void* d_ws, size_t ws_size, hipStream_t stream) {
  if (n_in != 28 || ws_size < WS_NEED) { fprintf(stderr, "kernel_launch: unexpected inputs (%d) or workspace (%zu < %zu)\n", n_in, ws_size, (size_t)WS_NEED); return; }
  static int grid_blocks = 0;
  if (!grid_blocks) {
    int dev = 0, cus = 0, per_cu = 0;
    (void)hipGetDevice(&dev);
    (void)hipDeviceGetAttribute(&cus, hipDeviceAttributeMultiprocessorCount, dev);
    (void)hipFuncSetAttribute((const void*)mega_kernel, hipFuncAttributeMaxDynamicSharedMemorySize, LDS_BYTES);
    (void)hipOccupancyMaxActiveBlocksPerMultiprocessor(&per_cu, (const void*)mega_kernel, NTHR, LDS_BYTES);
    if (per_cu < 1) per_cu = 1;
    if (per_cu > 1) per_cu = 1;
    grid_blocks = cus * per_cu;
    if (grid_blocks < 32) grid_blocks = 32;
  }
  Params p{};
  for (int i = 0; i < 28; ++i) p.in[i] = (const float*)d_in[i];
  p.out = (float*)d_out; p.ws = (unsigned char*)d_ws;
  (void)hipMemsetAsync((unsigned char*)d_ws + O_BAR, 0, XCD_BAR_WORDS * 4, stream);
  void* args[] = {&p};
  hipError_t e = hipLaunchCooperativeKernel((const void*)mega_kernel, dim3(grid_blocks), dim3(NTHR), args, LDS_BYTES, stream);
  if (e != hipSuccess) fprintf(stderr, "cooperative launch failed: %s (grid %d)\n", hipGetErrorString(e), grid_blocks);
}
```

```cpp
#include <hip/hip_runtime.h>
#include <hip/hip_cooperative_groups.h>
#include <stdint.h>
#include <stdio.h>
namespace cg = cooperative_groups;

#define DI __device__ __forceinline__
#define LAS __attribute__((address_space(3)))
#define GAS __attribute__((address_space(1)))
typedef unsigned short bf16_t;
typedef short bf16x8 __attribute__((ext_vector_type(8)));
typedef float f32x4 __attribute__((ext_vector_type(4)));
typedef unsigned u32x4 __attribute__((ext_vector_type(4)));
typedef unsigned u32x2 __attribute__((ext_vector_type(2)));

#ifndef DUPMASK
#define DUPMASK 0
#endif
constexpr int NTHR = 512;
constexpr int T = 16384, SEQ = 8192, D = 1024;
constexpr int NPROJ = 6656;
constexpr int DIN = 6664;
constexpr int NEXP = 256, DEXP = 256;
constexpr int MAXSLOT = 131072 + 256 * 128;
constexpr float ALPHA = 1.189207115002721f;
constexpr int LDS_BYTES = 157696;

constexpr size_t MB = 1u << 20;
constexpr size_t O_WGU = 0;
constexpr size_t O_WD = 256 * MB;
constexpr size_t O_WSGU = 384 * MB;
constexpr size_t O_WSD = 385 * MB;
constexpr size_t O_ROUT = 385 * MB + 512 * 1024;
constexpr size_t O_CTRL = 386 * MB;
constexpr size_t O_BAR = 386 * MB + 128 * 1024;
constexpr int CSTR = 64;
constexpr size_t O_IDENT = 386 * MB + 256 * 1024;
constexpr size_t O_X1 = 387 * MB;
constexpr size_t O_X1B = 451 * MB;
constexpr size_t R0 = 483 * MB;
constexpr size_t O_XB = R0 + 0;
constexpr size_t O_ST = R0 + 0;
constexpr size_t O_WINT = R0 + 32 * MB;
constexpr size_t O_WAT = R0 + 45 * MB;
constexpr size_t O_WBT = R0 + 46 * MB;
constexpr size_t O_WCT = R0 + 47 * MB;
constexpr size_t O_WOT = R0 + 48 * MB;
constexpr size_t O_WMKV = R0 + 50 * MB;
constexpr size_t O_MEMB = R0 + 52 * MB;
constexpr size_t O_SGUW = R0 + 53 * MB;
constexpr size_t O_AB = R0 + 53 * MB + 512 * 1024;
constexpr size_t O_MEMK = R0 + 54 * MB;
constexpr size_t O_MEMVT = R0 + 54 * MB + 512 * 1024;
constexpr size_t O_QKV = R0 + 55 * MB;
constexpr size_t O_PART = R0 + 55 * MB;
constexpr size_t O_ZS = R0 + 103 * MB;
constexpr size_t O_UVG = R0 + 119 * MB;
constexpr size_t O_MERGED = R0 + 119 * MB;
constexpr size_t O_XQ = R0 + 151 * MB;
constexpr size_t O_GATES = R0 + 167 * MB;
constexpr size_t O_MP = R0 + 263 * MB;
constexpr size_t O_BC = R0 + 295 * MB;
constexpr size_t O_O0 = R0 + 359 * MB;
constexpr size_t O_QP = R0 + 391 * MB;
constexpr size_t O_GL = R0 + 407 * MB;
constexpr size_t O_GDNO = R0 + 408 * MB;
constexpr size_t O_SGUO = R0 + 424 * MB;
constexpr size_t O_XATO = R0 + 440 * MB;
constexpr size_t O_LOGITS = R0 + 0;
constexpr size_t O_TKIDX = R0 + 16 * MB;
constexpr size_t O_TKW = R0 + 16 * MB + 512 * 1024;
constexpr size_t O_TKPOS = R0 + 17 * MB;
constexpr size_t O_SLOTTOK = R0 + 18 * MB;
constexpr size_t O_SLOTW = R0 + 19 * MB;
constexpr size_t O_SLOTAID = R0 + 20 * MB;
constexpr size_t O_ACT = R0 + 21 * MB;
constexpr size_t O_ACTSH = R0 + 117 * MB;
constexpr size_t O_YSH = R0 + 125 * MB;
constexpr size_t O_Y = R0 + 157 * MB;
constexpr size_t WS_NEED = R0 + 456 * MB;

struct Params {
  const float* in[28];
  float* out;
  unsigned char* ws;
};
enum { I_X = 0, I_MEM, I_WIN, I_CONVW, I_ALOG, I_DTB, I_GNG, I_WA, I_SLNG, I_SLNB, I_SGUW, I_SGUB, I_WB, I_WMKV, I_WC, I_WO,
       I_LN1G, I_LN1B, I_RW, I_RB, I_WG, I_WU, I_WDN, I_WSG, I_WSU, I_WSD, I_LN2G, I_LN2B };

constexpr int PTAB_OFF = 156672;
DI float bf2f(bf16_t h) { return __uint_as_float(((unsigned)h) << 16); }
DI bf16_t f2bf(float f) { unsigned u = __float_as_uint(f); u += 0x7fffu + ((u >> 16) & 1u); return (bf16_t)(u >> 16); }
typedef float f32x2_ __attribute__((ext_vector_type(2)));
typedef __bf16 bf16x2_ __attribute__((ext_vector_type(2)));
DI unsigned pk2(float lo, float hi) { f32x2_ v = {lo, hi}; return __builtin_bit_cast(unsigned, __builtin_convertvector(v, bf16x2_)); }
DI float lo2f(unsigned u) { return __uint_as_float(u << 16); }
DI float hi2f(unsigned u) { return __uint_as_float(u & 0xffff0000u); }
DI float sigmoidf_(float x) { return 1.f / (1.f + __expf(-x)); }
DI float siluf_(float x) { return x / (1.f + __expf(-x)); }
DI float geluf_(float x) { float u = 0.7978845608028654f * (x + 0.044715f * x * x * x); float t = 1.f - 2.f / (__expf(2.f * u) + 1.f); return 0.5f * x * (1.f + t); }
DI float softplusf_(float x) { return fmaxf(x, 0.f) + log1pf(__expf(-fabsf(x))); }
DI float wave_sum(float v) {
#pragma unroll
  for (int o = 32; o; o >>= 1) v += __shfl_xor(v, o);
  return v;
}
DI f32x4 mfma16(bf16x8 a, bf16x8 b, f32x4 c) { return __builtin_amdgcn_mfma_f32_16x16x32_bf16(a, b, c, 0, 0, 0); }
DI bf16x8 ldfrag(const void* p) { return __builtin_bit_cast(bf16x8, *(const u32x4*)p); }
DI bf16x8 pack8(f32x4 a, f32x4 b) { u32x4 r = {pk2(a[0], a[1]), pk2(a[2], a[3]), pk2(b[0], b[1]), pk2(b[2], b[3])}; return __builtin_bit_cast(bf16x8, r); }
DI u32x2 pack4(f32x4 a) { u32x2 r = {pk2(a[0], a[1]), pk2(a[2], a[3])}; return r; }
DI int sw128(int row, int chunk) { return row * 128 + ((chunk ^ (row & 7)) << 4); }
DI int sw256(int row, int chunk) { return row * 256 + ((chunk ^ (row & 15)) << 4); }

namespace pg {
#define PG_LAS __attribute__((address_space(3)))
constexpr int BM = 256, BK = 64, HALF = 128, HTB = HALF * BK * 2, NXCD = 8, WGM = 8;
DI int lds_byte(int r, int c) { const int st = (r >> 4) * 2 + (c >> 5), rr = r & 15, cc = c & 31, ob = rr * 64 + cc * 2; return st * 1024 + (ob ^ (((ob >> 9) & 1) << 5)); }
DI void stage_rc(int b, int& R, int& C) { const int st = b / 1024, sb = b % 1024, swz = sb ^ (((sb >> 9) & 1) << 5); R = (st >> 1) * 16 + swz / 64; C = (st & 1) * 32 + (swz % 64) / 2; }

struct Unit { const char* a; const char* b; const int* rows; int pm, pn, e; };

struct DenseOrder {
  const char* A; const char* B; int nM, nN, nwg, G, c; size_t tstep;
  DI void init(const void* A_, const void* B_, int M, int N, int K, int G_, int c_) { A = (const char*)A_; B = (const char*)B_; nM = M / BM; nN = N / BM; nwg = nM * nN; G = G_; c = c_; tstep = (size_t)BM * K * 2; }
  DI bool next(int i, Unit& u) const {
    const long L = (long)i * G + c; if (L >= nwg) return false;
    int wgid = (int)L; { const int q = nwg / NXCD, r = nwg % NXCD, xcd = wgid % NXCD, off = wgid / NXCD; wgid = (xcd < r ? xcd * (q + 1) : r * (q + 1) + (xcd - r) * q) + off; }
    const int nig = WGM * nN, gid = wgid / nig, fm = gid * WGM, gsz = (nM - fm) < WGM ? (nM - fm) : WGM;
    u.pm = fm + ((wgid % nig) % gsz); u.pn = (wgid % nig) / gsz; u.e = 0; u.rows = nullptr;
    u.a = A + (size_t)u.pm * tstep; u.b = B + (size_t)u.pn * tstep; return true;
  }
};

template <class Epi, class Sched, bool GATHER, bool ALIGN_EPI>
DI void gemm_phase(PG_LAS unsigned char* lds, const int K, const Sched& S, const Epi& E) {
  int tid = threadIdx.x; asm volatile("" : "+v"(tid));
  const int wid = __builtin_amdgcn_readfirstlane(tid >> 6), lane = tid & 63, wr = wid >> 2, wc = wid & 3, fr = lane & 15, fq = lane >> 4;
  const int nt = K / BK;
  int Rr[2], Cc[2];
  unsigned voffB[2];
#pragma unroll
  for (int i = 0; i < 2; ++i) { stage_rc(tid * 16 + i * 8192, Rr[i], Cc[i]); voffB[i] = (unsigned)(Rr[i] * K + Cc[i]) * 2u; }
  const size_t kstep = (size_t)(BK * 2);
  const size_t hstep = (size_t)HALF * K * 2;
  const unsigned ldsw = (unsigned)wid * 1024u;
  const int aoff = lds_byte(wr * 64 + fr, fq * 8), boff = lds_byte(wc * 32 + fr, fq * 8);
#define PG_SA(b, h) (((b) * 2 + (h)) * HTB)
#define PG_SB(b, h) ((4 + (b) * 2 + (h)) * HTB)
#define PG_STAGE(bufoff, gbase, v0, v1) do { \
    __builtin_amdgcn_global_load_lds((const unsigned*)((const char*)(gbase) + (v0)), (PG_LAS unsigned*)(lds + (bufoff) + ldsw), 16, 0, 0); \
    __builtin_amdgcn_global_load_lds((const unsigned*)((const char*)(gbase) + (v1)), (PG_LAS unsigned*)(lds + (bufoff) + ldsw + 8192), 16, 0, 0); } while (0)
#define PG_LDA(dst, b, h) do { _Pragma("unroll") for (int m = 0; m < 4; ++m) _Pragma("unroll") for (int k = 0; k < 2; ++k) dst[m][k] = *(const PG_LAS bf16x8*)(lds + PG_SA(b, h) + aoff + m * 2048 + k * 1024); } while (0)
#define PG_LDB(dst, b, h) do { _Pragma("unroll") for (int n = 0; n < 2; ++n) _Pragma("unroll") for (int k = 0; k < 2; ++k) dst[n][k] = *(const PG_LAS bf16x8*)(lds + PG_SB(b, h) + boff + n * 2048 + k * 1024); } while (0)
#define PG_MMA(ai, bj, At, Bt) do { __builtin_amdgcn_s_setprio(1); _Pragma("unroll") for (int m = 0; m < 4; ++m) _Pragma("unroll") for (int n = 0; n < 2; ++n) _Pragma("unroll") for (int k = 0; k < 2; ++k) \
    acc[ai][bj][m][n] = __builtin_amdgcn_mfma_f32_16x16x32_bf16(Bt[n][k], At[m][k], acc[ai][bj][m][n], 0, 0, 0); __builtin_amdgcn_s_setprio(0); } while (0)
#define PG_WAIT_V(n) asm volatile("s_waitcnt vmcnt(" #n ")" ::: "memory")
#define PG_WAIT_L(n) asm volatile("s_waitcnt lgkmcnt(" #n ")" ::: "memory")
#define PG_BAR __builtin_amdgcn_s_barrier()
#define PG_SCHED __builtin_amdgcn_sched_barrier(0)
#define PG_AOFFS(u, o00, o01, o10, o11) do { if (GATHER) { \
      o00 = (unsigned)(u).rows[Rr[0]] * (unsigned)(K * 2) + (unsigned)Cc[0] * 2u; o01 = (unsigned)(u).rows[Rr[1]] * (unsigned)(K * 2) + (unsigned)Cc[1] * 2u; \
      o10 = (unsigned)(u).rows[128 + Rr[0]] * (unsigned)(K * 2) + (unsigned)Cc[0] * 2u; o11 = (unsigned)(u).rows[128 + Rr[1]] * (unsigned)(K * 2) + (unsigned)Cc[1] * 2u; \
    } else { o00 = voffB[0]; o01 = voffB[1]; o10 = voffB[0] + (unsigned)hstep; o11 = voffB[1] + (unsigned)hstep; } } while (0)
  Unit cur, nxt; int ui = 0;
  if (!S.next(0, cur)) return;
  f32x4 acc[2][2][4][2];
#pragma unroll
  for (int a = 0; a < 2; ++a)
#pragma unroll
    for (int b = 0; b < 2; ++b)
#pragma unroll
      for (int m = 0; m < 4; ++m)
#pragma unroll
        for (int n = 0; n < 2; ++n) acc[a][b][m][n] = (f32x4){0.f, 0.f, 0.f, 0.f};
  bf16x8 At[4][2], B0[2][2], B1[2][2];
  const char* cA = cur.a; const char* cB = cur.b;
  unsigned c00, c01, c10, c11;
  PG_AOFFS(cur, c00, c01, c10, c11);
  const unsigned vb0 = voffB[0], vb1 = voffB[1];
  PG_STAGE(PG_SB(0, 0), cB, vb0, vb1); PG_STAGE(PG_SB(0, 1), cB + hstep, vb0, vb1); PG_STAGE(PG_SA(0, 0), cA, c00, c01); PG_STAGE(PG_SA(0, 1), cA, c10, c11);
  if (wr == 1) PG_BAR;
  PG_WAIT_V(2); PG_BAR;
  PG_STAGE(PG_SB(1, 0), cB + kstep, vb0, vb1); PG_STAGE(PG_SA(1, 0), cA + kstep, c00, c01); PG_STAGE(PG_SB(1, 1), cB + hstep + kstep, vb0, vb1);
  PG_WAIT_V(6); PG_BAR;
  for (;;) {
    const bool has_next = S.next(ui + 1, nxt);
    const char* nA = has_next ? nxt.a : cA; const char* nB = has_next ? nxt.b : cB;
    unsigned n00 = c00, n01 = c01, n10 = c10, n11 = c11;
    if (has_next) PG_AOFFS(nxt, n00, n01, n10, n11);
#pragma unroll 1
    for (int t = 0; t < nt; t += 2) {
      const bool last = (t == nt - 2);
      const char* a1 = cA + (size_t)(t + 1) * kstep;
      const char* a2 = last ? nA : cA + (size_t)(t + 2) * kstep; const char* b2 = last ? nB : cB + (size_t)(t + 2) * kstep;
      const char* a3 = a2 + kstep; const char* b3 = b2 + kstep;
      const unsigned o00 = last ? n00 : c00, o01 = last ? n01 : c01, o10 = last ? n10 : c10, o11 = last ? n11 : c11;
      PG_LDB(B0, 0, 0); PG_LDB(B1, 0, 1); PG_SCHED; PG_LDA(At, 0, 0); PG_STAGE(PG_SA(1, 1), a1, c10, c11);
      PG_WAIT_V(8); PG_WAIT_L(0); PG_BAR; PG_MMA(0, 0, At, B0); PG_MMA(0, 1, At, B1); PG_BAR; PG_SCHED;
      PG_LDA(At, 0, 1); PG_STAGE(PG_SB(0, 0), b2, vb0, vb1); PG_STAGE(PG_SB(0, 1), b2 + hstep, vb0, vb1); PG_STAGE(PG_SA(0, 0), a2, o00, o01);
      PG_WAIT_V(8); PG_WAIT_L(0); PG_BAR; PG_MMA(1, 0, At, B0); PG_MMA(1, 1, At, B1); PG_BAR; PG_SCHED;
      PG_LDB(B0, 1, 0); PG_LDB(B1, 1, 1); PG_SCHED; PG_LDA(At, 1, 0); PG_STAGE(PG_SA(0, 1), a2, o10, o11);
      PG_WAIT_V(8); PG_WAIT_L(0); PG_BAR; PG_MMA(0, 0, At, B0); PG_MMA(0, 1, At, B1); PG_BAR; PG_SCHED;
      PG_LDA(At, 1, 1); PG_STAGE(PG_SB(1, 0), b3, vb0, vb1); PG_STAGE(PG_SB(1, 1), b3 + hstep, vb0, vb1); PG_STAGE(PG_SA(1, 0), a3, o00, o01);
      PG_WAIT_V(8); PG_WAIT_L(0); PG_BAR; PG_MMA(1, 0, At, B0); PG_MMA(1, 1, At, B1); PG_BAR; PG_SCHED;
    }
    if constexpr (ALIGN_EPI) { if (wr == 0) PG_BAR; }
    E(acc, cur, wr, wc, fr, fq);
    if (!has_next) break;
#pragma unroll
    for (int a = 0; a < 2; ++a)
#pragma unroll
      for (int b = 0; b < 2; ++b)
#pragma unroll
        for (int m = 0; m < 4; ++m)
#pragma unroll
          for (int n = 0; n < 2; ++n) acc[a][b][m][n] = (f32x4){0.f, 0.f, 0.f, 0.f};
    cur = nxt; cA = nA; cB = nB; c00 = n00; c01 = n01; c10 = n10; c11 = n11; ++ui;
    if constexpr (ALIGN_EPI) { if (wr == 1) PG_BAR; }
  }
  PG_WAIT_V(0);
  if constexpr (!ALIGN_EPI) { if (wr == 0) PG_BAR; }
  PG_BAR;
#undef PG_SA
#undef PG_SB
#undef PG_STAGE
#undef PG_LDA
#undef PG_LDB
#undef PG_MMA
#undef PG_WAIT_V
#undef PG_WAIT_L
#undef PG_BAR
#undef PG_SCHED
#undef PG_AOFFS
}
}


struct UnitF { const bf16_t* A; const int* rows; const float* W0; const float* W1; int m0, pn, e; };

template <bool INTER, class Epi, class Sched>
DI void gemmF_phase(unsigned char* smem_, const int K, const int lda, const int ldw, const Sched& S, const Epi& E) {
  int tid = threadIdx.x; asm volatile("" : "+v"(tid));
  unsigned char* smem; { LAS unsigned char* l_ = (LAS unsigned char*)smem_; asm volatile("" : "+v"(l_)); smem = (unsigned char*)l_; }
  const int lane = tid & 63, wid = tid >> 6, wr = wid >> 2, wc = wid & 3, fr = lane & 15, fq = lane >> 4;
  const int nk = K >> 6;
  const int ar0 = tid >> 3, ac = tid & 7;
  const int q = tid & 63, half = q >> 5, g0 = 4 * (q & 31);
  int vrow[4];
#pragma unroll
  for (int i = 0; i < 4; ++i) { const int g = g0 + i; vrow[i] = INTER ? (64 * (g >> 5) + 32 * half + (g & 31)) : (128 * half + g); }
  const int aw0 = sw128(ar0, ac), aw1 = sw128(ar0 + 64, ac);
  UnitF cur, nxt; int ui = 0;
  if (!S.next(0, cur)) return;
  f32x4 acc[4][4];
#pragma unroll
  for (int m = 0; m < 4; ++m)
#pragma unroll
    for (int n = 0; n < 4; ++n) acc[m][n] = (f32x4){0.f, 0.f, 0.f, 0.f};
  size_t r0 = cur.rows ? (size_t)cur.rows[ar0] : (size_t)(cur.m0 + ar0), r1 = cur.rows ? (size_t)cur.rows[ar0 + 64] : (size_t)(cur.m0 + ar0 + 64);
  bool has_next = S.next(1, nxt);
  size_t nr0 = 0, nr1 = 0;
  if (has_next) { nr0 = nxt.rows ? (size_t)nxt.rows[ar0] : (size_t)(nxt.m0 + ar0); nr1 = nxt.rows ? (size_t)nxt.rows[ar0 + 64] : (size_t)(nxt.m0 + ar0 + 64); }
  u32x4 va0, va1; f32x4 vw[8];
#define F_LOAD(u, rr0, rr1, kt) do { \
    va0 = *(const u32x4*)((u).A + (rr0) * lda + (kt) * 64 + ac * 8); va1 = *(const u32x4*)((u).A + (rr1) * lda + (kt) * 64 + ac * 8); \
    const float* wp_ = (half ? (u).W1 : (u).W0) + (size_t)((kt) * 64 + 8 * wid) * ldw + g0; \
    _Pragma("unroll") for (int j = 0; j < 8; ++j) vw[j] = *(const f32x4*)(wp_ + (size_t)j * ldw); } while (0)
#define F_STORE(st) do { unsigned char* sa_ = smem + (st) * 49152; \
    *(u32x4*)(sa_ + aw0) = va0; *(u32x4*)(sa_ + aw1) = va1; \
    _Pragma("unroll") for (int i = 0; i < 4; ++i) { \
      u32x4 o_ = {pk2(vw[0][i], vw[1][i]), pk2(vw[2][i], vw[3][i]), pk2(vw[4][i], vw[5][i]), pk2(vw[6][i], vw[7][i])}; \
      *(u32x4*)(sa_ + 16384 + sw128(vrow[i], wid)) = o_; } } while (0)
  F_LOAD(cur, r0, r1, 0);
  __syncthreads();
  F_STORE(0);
  __syncthreads();
  int kt = 0, st = 0;
  for (;;) {
    const bool lastk = (kt == nk - 1);
    const bool more = !lastk || has_next;
    if (more) { if (!lastk) F_LOAD(cur, r0, r1, kt + 1); else F_LOAD(nxt, nr0, nr1, 0); }
    {
      const unsigned char* sA = smem + st * 49152; const unsigned char* sB = sA + 16384;
#pragma unroll
      for (int ks = 0; ks < 2; ++ks) {
        bf16x8 af[4], bfr[4];
#pragma unroll
        for (int m = 0; m < 4; ++m) af[m] = ldfrag(sA + sw128(64 * wr + 16 * m + fr, 4 * ks + fq));
#pragma unroll
        for (int n = 0; n < 4; ++n) bfr[n] = ldfrag(sB + sw128(64 * wc + 16 * n + fr, 4 * ks + fq));
#pragma unroll
        for (int m = 0; m < 4; ++m)
#pragma unroll
          for (int n = 0; n < 4; ++n) acc[m][n] = mfma16(bfr[n], af[m], acc[m][n]);
      }
    }
    if (lastk) {
      E(acc, cur, wr, wc, fr, fq);
#pragma unroll
      for (int m = 0; m < 4; ++m)
#pragma unroll
        for (int n = 0; n < 4; ++n) acc[m][n] = (f32x4){0.f, 0.f, 0.f, 0.f};
    }
    if (!more) break;
    F_STORE(st ^ 1);
    __syncthreads();
    st ^= 1;
    if (lastk) {
      cur = nxt; r0 = nr0; r1 = nr1; kt = 0; ++ui;
      has_next = S.next(ui + 1, nxt);
      if (has_next) { nr0 = nxt.rows ? (size_t)nxt.rows[ar0] : (size_t)(nxt.m0 + ar0); nr1 = nxt.rows ? (size_t)nxt.rows[ar0 + 64] : (size_t)(nxt.m0 + ar0 + 64); }
    } else ++kt;
  }
#undef F_LOAD
#undef F_STORE
}

#define XB_TMO      128
#define XB_XCNT(j)  (256  + 64 * (j))
#define XB_XSUB(j)  (1280 + 64 * (j))
#define XB_XGEN(j)  (2304 + 64 * (j))
#define XB_TOP      3328
#define XB_TOPGEN   3392
#define XCD_BAR_WORDS 3456
#define XB_SPIN_CAP (1u << 22)
DI unsigned xb_ld(unsigned* p)              { return __hip_atomic_load(p, __ATOMIC_RELAXED, __HIP_MEMORY_SCOPE_AGENT); }
DI unsigned xb_add(unsigned* p, unsigned v) { return __hip_atomic_fetch_add(p, v, __ATOMIC_RELAXED, __HIP_MEMORY_SCOPE_AGENT); }
DI unsigned xb_xcc_id() { return (unsigned)__builtin_amdgcn_s_getreg((3 << 11) | 20) & 0xFu; }
#define XB_SPIN(cond, bar) do { unsigned _sp = 0; while (cond) { __builtin_amdgcn_s_sleep(1); \
    if ((++_sp & 255u) == 0u) { if (xb_ld(&(bar)[XB_TMO])) break; if (_sp > XB_SPIN_CAP) { atomicAdd(&(bar)[XB_TMO], 1u); break; } } } } while (0)
struct XcdBarrier { unsigned* bar; unsigned x; volatile LAS unsigned* st; };
DI XcdBarrier xcd_barrier_post(unsigned* bar, volatile LAS unsigned* st) {
  XcdBarrier b; b.bar = bar; b.x = xb_xcc_id(); b.st = st;
  if (threadIdx.x == 0) (void)xb_add(&bar[XB_XCNT(b.x)], 1u);
  return b;
}
DI void xcd_barrier_complete(unsigned* bar, unsigned x, unsigned& nloc, unsigned& nx) {
  const unsigned G = gridDim.x * gridDim.y * gridDim.z;
  unsigned sum, cnt, mine, sp = 0u;
  for (;;) {
    sum = 0u; cnt = 0u; mine = 0u;
#pragma unroll
    for (unsigned j = 0; j < 16; ++j) { const unsigned c = xb_ld(&bar[XB_XCNT(j)]); sum += c; cnt += (c > 0u) ? 1u : 0u; mine = (j == x) ? c : mine; }
    if (sum == G) break;
    __builtin_amdgcn_s_sleep(1);
    if ((++sp & 255u) == 0u) { if (xb_ld(&bar[XB_TMO])) break; if (sp > XB_SPIN_CAP) { atomicAdd(&bar[XB_TMO], 1u); break; } }
  }
  nloc = mine > 0u ? mine : 1u; nx = cnt > 0u ? cnt : 1u;
}
DI void xcd_barrier(const XcdBarrier& b) {
  asm volatile("s_waitcnt vmcnt(0)" ::: "memory");
  __syncthreads();
  if (threadIdx.x == 0) {
    unsigned* bar = b.bar;
    __builtin_amdgcn_s_waitcnt(0);
    unsigned nloc = b.st[0], nx = b.st[1];
    if (nloc == 0u) { xcd_barrier_complete(bar, b.x, nloc, nx); b.st[0] = nloc; b.st[1] = nx; }
    const unsigned old = xb_add(&bar[XB_XSUB(b.x)], 1u);
    const unsigned gen = old / nloc;
    if (old + 1u == (gen + 1u) * nloc) {
      __builtin_amdgcn_fence(__ATOMIC_RELEASE, "agent");
      asm volatile("s_waitcnt vmcnt(0)" ::: "memory");
      const unsigned og = xb_add(&bar[XB_TOP], 1u);
      const unsigned tg = og / nx;
      if (og + 1u == (tg + 1u) * nx) xb_add(&bar[XB_TOPGEN], 1u);
      else XB_SPIN(xb_ld(&bar[XB_TOPGEN]) == tg, bar);
      __builtin_amdgcn_fence(__ATOMIC_ACQUIRE, "agent");
      xb_add(&bar[XB_XGEN(b.x)], 1u);
      asm volatile("s_waitcnt vmcnt(0)" ::: "memory");
    } else {
      XB_SPIN(xb_ld(&bar[XB_XGEN(b.x)]) == gen, bar);
      __builtin_amdgcn_fence(__ATOMIC_ACQUIRE, "agent");
      asm volatile("s_waitcnt vmcnt(0)" ::: "memory");
    }
  }
  __syncthreads();
}

DI void phase0(const Params& p, unsigned char* smem, int bid, int nb) {
  int tid = threadIdx.x; asm volatile("" : "+v"(tid));
  const int lane = tid & 63, wave = tid >> 6;
  unsigned char* ws = p.ws;
  if (bid == 0 && tid < 256) ((int*)(ws + O_CTRL))[tid * CSTR] = 0;
  for (int i = bid * NTHR + tid; i < T; i += nb * NTHR) ((int*)(ws + O_IDENT))[i] = i;
  {
    float* wabT = (float*)smem;
    const float* win = p.in[I_WIN];
    for (int i = tid; i < 8192; i += NTHR) { const int k = i >> 3, j = i & 7; wabT[j * 1024 + k] = win[(size_t)k * DIN + 2048 + j]; }
    __syncthreads();
    const float* x = p.in[I_X];
    bf16_t* xb = (bf16_t*)(ws + O_XB);
    float* ab = (float*)(ws + O_AB);
    for (int row = bid * 8 + wave; row < T; row += nb * 8) {
      float s[8];
#pragma unroll
      for (int j = 0; j < 8; ++j) s[j] = 0.f;
#pragma unroll
      for (int i = 0; i < 4; ++i) {
        const int k = 256 * i + 4 * lane;
        const f32x4 v = *(const f32x4*)(x + (size_t)row * D + k);
        *(u32x2*)(xb + (size_t)row * D + k) = pack4(v);
#pragma unroll
        for (int j = 0; j < 8; ++j) { const f32x4 w = *(const f32x4*)(wabT + j * 1024 + k); s[j] += v[0] * w[0] + v[1] * w[1] + v[2] * w[2] + v[3] * w[3]; }
      }
#pragma unroll
      for (int j = 0; j < 8; ++j) s[j] = wave_sum(s[j]);
      if (lane == 0) { *(f32x4*)(ab + (size_t)row * 8) = (f32x4){s[0], s[1], s[2], s[3]}; *(f32x4*)(ab + (size_t)row * 8 + 4) = (f32x4){s[4], s[5], s[6], s[7]}; }
    }
    const float* mem = p.in[I_MEM];
    bf16_t* memb = (bf16_t*)(ws + O_MEMB);
    for (int row = bid * 8 + wave; row < 512; row += nb * 8) {
#pragma unroll
      for (int i = 0; i < 4; ++i) { const int k = 256 * i + 4 * lane; *(u32x2*)(memb + (size_t)row * D + k) = pack4(*(const f32x4*)(mem + (size_t)row * D + k)); }
    }
    const float* sw = p.in[I_SGUW];
    bf16_t* sguw = (bf16_t*)(ws + O_SGUW);
    for (int i = bid * NTHR + tid; i < 16384; i += nb * NTHR) {
      const int e0 = i * 4; const int col = e0 & 127, rowi = (e0 >> 7) & 127;
      f32x4 v = *(const f32x4*)(sw + e0);
#pragma unroll
      for (int c = 0; c < 4; ++c) if (col + c > rowi) v[c] = 0.f;
      *(u32x2*)(sguw + e0) = pack4(v);
    }
    __syncthreads();
  }
  {
    float* tile = (float*)smem;
    const float *pwin = p.in[I_WIN], *pwa = p.in[I_WA], *pwb = p.in[I_WB], *pwc = p.in[I_WC], *pwo = p.in[I_WO], *pwmkv = p.in[I_WMKV], *prw = p.in[I_RW],
                *pwsg = p.in[I_WSG], *pwsu = p.in[I_WSU], *pwsd = p.in[I_WSD], *pwg = p.in[I_WG], *pwu = p.in[I_WU], *pwdn = p.in[I_WDN];
    { GAS const float *a_ = (GAS const float*)pwa, *b_ = (GAS const float*)pwb, *c_ = (GAS const float*)pwc, *o_ = (GAS const float*)pwo, *m_ = (GAS const float*)pwmkv;
      asm volatile("" : "+s"(a_), "+s"(b_), "+s"(c_), "+s"(o_), "+s"(m_));
      pwa = (const float*)a_; pwb = (const float*)b_; pwc = (const float*)c_; pwo = (const float*)o_; pwmkv = (const float*)m_; }
    constexpr int J0 = 1664, J1 = J0 + 128, J2 = J1 + 128, J3 = J2 + 128, J4 = J3 + 256, J5 = J4 + 256, J6 = J5 + 64, J7 = J6 + 128, J8 = J7 + 64,
                  J9 = J8, J10 = J8;
    const int kr = tid >> 4, nc = tid & 15, sg = nc >> 2;
    const int tn = tid >> 3, tkc = tid & 7;
#define P0_DECODE_LOAD(it0, dp, v0, v1) do { const float* sp[4]; int ld[4]; \
      _Pragma("unroll") \
      for (int q = 0; q < 4; ++q) { \
        const int it = (it0 + q < J10) ? it0 + q : J10 - 1;      \
        const float *s0, *s1, *s2, *s3; int ldd; bf16_t* dst; \
        if (it < J0) {           \
          const int kt = it & 15, nt = it >> 4; const int n0 = nt * 64; const int c0 = n0 + (n0 >= 2048 ? 8 : 0); \
          const float* b = pwin + (size_t)kt * 64 * DIN + c0; s0 = b; s1 = b + 16; s2 = b + 32; s3 = b + 48; ld[q] = DIN; ldd = 1024; \
          dst = (bf16_t*)(ws + O_WINT) + (size_t)n0 * 1024 + kt * 64; \
        } else if (it < J3) {    \
          const int which = (it - J0) >> 7, r = (it - J0) & 127; const int kt = r & 7, nt = r >> 3; \
          const float* src = which == 0 ? pwa : which == 1 ? pwb : pwc; \
          const float* b = src + (size_t)kt * 64 * 1024 + nt * 64; s0 = b; s1 = b + 16; s2 = b + 32; s3 = b + 48; ld[q] = 1024; ldd = 512; \
          dst = (bf16_t*)(ws + (which == 0 ? O_WAT : which == 1 ? O_WBT : O_WCT)) + (size_t)nt * 64 * 512 + kt * 64; \
        } else if (it < J5) {    \
          const int which = (it - J3) >> 8, r = (it - J3) & 255; const int kt = r & 15, nt = r >> 4; \
          const float* b = (which == 0 ? pwo : pwmkv) + (size_t)kt * 64 * 1024 + nt * 64; s0 = b; s1 = b + 16; s2 = b + 32; s3 = b + 48; ld[q] = 1024; ldd = 1024; \
          dst = (bf16_t*)(ws + (which == 0 ? O_WOT : O_WMKV)) + (size_t)nt * 64 * 1024 + kt * 64; \
        } else if (it < J6) {    \
          const int r = it - J5; const int kt = r & 15, nt = r >> 4; \
          const float* b = prw + (size_t)kt * 64 * 256 + nt * 64; s0 = b; s1 = b + 16; s2 = b + 32; s3 = b + 48; ld[q] = 256; ldd = 1024; \
          dst = (bf16_t*)(ws + O_ROUT) + (size_t)nt * 64 * 1024 + kt * 64; \
        } else if (it < J7) {    \
          const int r = it - J6; const int kt = r & 15, nt = r >> 4; \
          const float* g = pwsg + (size_t)kt * 64 * 256 + nt * 32; const float* u = pwsu + (size_t)kt * 64 * 256 + nt * 32; \
          s0 = g; s1 = u; s2 = g + 16; s3 = u + 16; ld[q] = 256; ldd = 1024; \
          dst = (bf16_t*)(ws + O_WSGU) + (size_t)nt * 64 * 1024 + kt * 64; \
        } else if (it < J8) {    \
          const int r = it - J7; const int kt = r & 3, nt = r >> 2; \
          const float* b = pwsd + (size_t)kt * 64 * 1024 + nt * 64; s0 = b; s1 = b + 16; s2 = b + 32; s3 = b + 48; ld[q] = 1024; ldd = 256; \
          dst = (bf16_t*)(ws + O_WSD) + (size_t)nt * 64 * 256 + kt * 64; \
        } else if (it < J9) {    \
          const int r = it - J8; const int e = r >> 7, qq = r & 127; const int kt = qq & 15, nt = qq >> 4; \
          const float* g = pwg + (size_t)e * 262144 + (size_t)kt * 64 * 256 + nt * 32; const float* u = pwu + (size_t)e * 262144 + (size_t)kt * 64 * 256 + nt * 32; \
          s0 = g; s1 = u; s2 = g + 16; s3 = u + 16; ld[q] = 256; ldd = 1024; \
          dst = (bf16_t*)(ws + O_WGU) + (size_t)e * 524288 + (size_t)nt * 64 * 1024 + kt * 64; \
        } else {                 \
          const int r = it - J9; const int e = r >> 6, qq = r & 63; const int kt = qq & 3, nt = qq >> 2; \
          const float* b = pwdn + (size_t)e * 262144 + (size_t)kt * 64 * 1024 + nt * 64; s0 = b; s1 = b + 16; s2 = b + 32; s3 = b + 48; ld[q] = 1024; ldd = 256; \
          dst = (bf16_t*)(ws + O_WD) + (size_t)e * 262144 + (size_t)nt * 64 * 256 + kt * 64; \
        } \
        sp[q] = (sg == 0 ? s0 : sg == 1 ? s1 : sg == 2 ? s2 : s3) + (size_t)kr * ld[q] + 4 * (nc & 3); \
        dp[q] = dst + (size_t)tn * ldd + 8 * tkc; \
      } \
      _Pragma("unroll") \
      for (int q = 0; q < 4; ++q) { v0[q] = __builtin_nontemporal_load((const f32x4*)(sp[q])); v1[q] = __builtin_nontemporal_load((const f32x4*)(sp[q] + (size_t)32 * ld[q])); } } while (0)
    bf16_t* dpn[4]; f32x4 v0n[4], v1n[4];
    int it0 = bid * 4;
    if (it0 < J10) P0_DECODE_LOAD(it0, dpn, v0n, v1n);
    for (; it0 < J10; it0 += nb * 4) {
      bf16_t* dp[4]; f32x4 v0[4], v1[4];
#pragma unroll
      for (int q = 0; q < 4; ++q) { dp[q] = dpn[q]; v0[q] = v0n[q]; v1[q] = v1n[q]; }
      if (it0 + nb * 4 < J10) P0_DECODE_LOAD(it0 + nb * 4, dpn, v0n, v1n);
      asm volatile("s_waitcnt lgkmcnt(0)" ::: "memory"); __builtin_amdgcn_s_barrier(); asm volatile("" ::: "memory");
#pragma unroll
      for (int q = 0; q < 4; ++q) {
        float* t0 = tile + q * 4160 + kr * 65 + 4 * nc;
        float* t1 = t0 + 32 * 65;
        t0[0] = v0[q][0]; t0[1] = v0[q][1]; t0[2] = v0[q][2]; t0[3] = v0[q][3];
        t1[0] = v1[q][0]; t1[1] = v1[q][1]; t1[2] = v1[q][2]; t1[3] = v1[q][3];
      }
      asm volatile("s_waitcnt lgkmcnt(0)" ::: "memory"); __builtin_amdgcn_s_barrier(); asm volatile("" ::: "memory");
#pragma unroll
      for (int q = 0; q < 4; ++q) {
        float e[8];
#pragma unroll
        for (int j = 0; j < 8; ++j) e[j] = tile[q * 4160 + (8 * tkc + j) * 65 + tn];
        u32x4 o = {pk2(e[0], e[1]), pk2(e[2], e[3]), pk2(e[4], e[5]), pk2(e[6], e[7])};
        *(u32x4*)(dp[q]) = o;
      }
    }
#undef P0_DECODE_LOAD
  }
}

#define EPI_ROWS(u) const int row_ = (u).pm * 256 + 64 * wr + fr
struct EpiInProj {
  unsigned char* ws;
  DI void operator()(const f32x4 (&acc)[2][2][4][2], const pg::Unit& u, int wr, int wc, int fr, int fq) const {
    const int colt = u.pn * 256;
#pragma unroll
    for (int ai = 0; ai < 2; ++ai)
#pragma unroll
      for (int m = 0; m < 4; ++m) {
        const size_t row = (size_t)u.pm * 256 + 128 * ai + 64 * wr + 16 * m + fr;
#pragma unroll
        for (int bj = 0; bj < 2; ++bj)
#pragma unroll
          for (int n = 0; n < 2; ++n) {
            const int col = colt + 128 * bj + 32 * wc + 16 * n + 4 * fq;
            f32x4 v = acc[ai][bj][m][n];
            if (colt < 1536) { *(u32x2*)((bf16_t*)(ws + O_QKV) + row * 1536 + col) = pack4(v); }
            else if (colt < 2048) {
#pragma unroll
              for (int c = 0; c < 4; ++c) v[c] = siluf_(v[c]);
              *(u32x2*)((bf16_t*)(ws + O_ZS) + row * 512 + (col - 1536)) = pack4(v);
            } else if (colt < 3072) {
#pragma unroll
              for (int c = 0; c < 4; ++c) v[c] = geluf_(v[c]);
              *(u32x2*)((bf16_t*)(ws + O_UVG) + row * 1024 + (col - 2048)) = pack4(v);
            } else if (colt < 3584) {
#pragma unroll
              for (int c = 0; c < 4; ++c) v[c] *= 0.08838834764831845f;
              *(u32x2*)((bf16_t*)(ws + O_XQ) + row * 512 + (col - 3072)) = pack4(v);
            } else {
#pragma unroll
              for (int c = 0; c < 4; ++c) v[c] = sigmoidf_(v[c]);
              *(u32x2*)((bf16_t*)(ws + O_GATES) + row * 3072 + (col - 3584)) = pack4(v);
            }
          }
      }
  }
};
struct EpiMemKV {
  unsigned char* ws;
  DI void operator()(const f32x4 (&acc)[2][2][4][2], const pg::Unit& u, int wr, int wc, int fr, int fq) const {
#pragma unroll
    for (int ai = 0; ai < 2; ++ai)
#pragma unroll
      for (int m = 0; m < 4; ++m) {
        const int row = u.pm * 256 + 128 * ai + 64 * wr + 16 * m + fr; const int b = row >> 8, key = row & 255;
#pragma unroll
        for (int bj = 0; bj < 2; ++bj)
#pragma unroll
          for (int n = 0; n < 2; ++n) {
            const int col = u.pn * 256 + 128 * bj + 32 * wc + 16 * n + 4 * fq;
            const f32x4 v = acc[ai][bj][m][n];
            if (col < 512) { const int h = col >> 7, d = col & 127; *(u32x2*)((bf16_t*)(ws + O_MEMK) + ((size_t)((b * 4 + h) * 256 + key)) * 128 + d) = pack4(v); }
            else {
              const int c2 = col - 512; const int h = c2 >> 7, d = c2 & 127;
              const int pos = 32 * (key >> 5) + 8 * ((key >> 2) & 3) + 4 * ((key >> 4) & 1) + (key & 3);
              bf16_t* vt = (bf16_t*)(ws + O_MEMVT) + ((size_t)((b * 4 + h) * 128 + d)) * 256 + pos;
#pragma unroll
              for (int c = 0; c < 4; ++c) vt[(size_t)c * 256] = f2bf(v[c]);
            }
          }
      }
  }
};
DI void phase1(const Params& p, unsigned char* smem, int bid, int nb) {
  unsigned char* ws = p.ws;
  PG_LAS unsigned char* lds = (PG_LAS unsigned char*)smem;
  __syncthreads();
  { pg::DenseOrder S; S.init(ws + O_XB, ws + O_WINT, T, NPROJ, 1024, nb, bid); EpiInProj E{ws}; pg::gemm_phase<EpiInProj, pg::DenseOrder, false, true>(lds, 1024, S, E); }
  __syncthreads();
  { pg::DenseOrder S; S.init(ws + O_MEMB, ws + O_WMKV, 512, 1024, 1024, nb, bid); EpiMemKV E{ws}; pg::gemm_phase<EpiMemKV, pg::DenseOrder, false, true>(lds, 1024, S, E); }
}

constexpr int G_KF = 0, G_VF = 32768, G_QB = 65536, G_KB = 81920, G_UT = 81920  , G_L = 98304, G_ATT = 114688, G_KDT = 122880, G_WT = 139264, G_SM = 155648;

DI void gdn_prep_item(const Params& p, unsigned char* smem_, int item) {
  unsigned char* smem; { LAS unsigned char* l_ = (LAS unsigned char*)smem_; asm volatile("" : "+v"(l_)); smem = (unsigned char*)l_; }
  int tid = threadIdx.x; asm volatile("" : "+v"(tid));
  const int lane = tid & 63, wave = tid >> 6, fr = lane & 15, fq = lane >> 4;
  unsigned char* ws; { GAS unsigned char* g_ = (GAS unsigned char*)p.ws; asm volatile("" : "+s"(g_)); ws = (unsigned char*)g_; }
  const int h = item & 3, cn = item >> 2;
  const int bidx = cn >> 7, n = cn & 127;
  const size_t t0 = (size_t)bidx * SEQ + (size_t)n * 64;
  float* kf = (float*)(smem + G_KF); float* vf = (float*)(smem + G_VF); float* Lm = (float*)(smem + G_L);
  float* sbeta = (float*)(smem + G_SM); float* sgc = sbeta + 64; float* segc = sbeta + 128;
  __syncthreads();
  {
    const bf16_t* qkv = (const bf16_t*)(ws + O_QKV);
    const float* cw = p.in[I_CONVW];
    const int tl0 = wave * 8;
#pragma unroll
    for (int sect = 0; sect < 3; ++sect) {
      const int cb = sect * 512 + h * 128 + 2 * lane;
      float w0[4], w1[4];
#pragma unroll
      for (int i = 0; i < 4; ++i) { w0[i] = cw[i * 1536 + cb]; w1[i] = cw[i * 1536 + cb + 1]; }
      float xa[11], xc[11];
#pragma unroll
      for (int r = 0; r < 11; ++r) {
        const int s = n * 64 + tl0 + r - 3;
        unsigned u = 0u;
        if (s >= 0) u = *(const unsigned*)(qkv + ((size_t)bidx * SEQ + s) * 1536 + cb);
        xa[r] = lo2f(u); xc[r] = hi2f(u);
      }
#pragma unroll
      for (int r = 0; r < 8; ++r) {
        float y0 = w0[0] * xa[r] + w0[1] * xa[r + 1] + w0[2] * xa[r + 2] + w0[3] * xa[r + 3];
        float y1 = w1[0] * xc[r] + w1[1] * xc[r + 1] + w1[2] * xc[r + 2] + w1[3] * xc[r + 3];
        y0 = siluf_(y0); y1 = siluf_(y1);
        const int tl = tl0 + r;
        if (sect == 2) { vf[tl * 128 + 2 * lane] = y0; vf[tl * 128 + 2 * lane + 1] = y1; }
        else {
          const float ss = wave_sum(y0 * y0 + y1 * y1);
          const float sc = rsqrtf(ss + 1e-6f) * (sect == 0 ? 0.08838834764831845f : 1.0f);
          y0 *= sc; y1 *= sc;
          const int off = sw256(tl, lane >> 2) + (lane & 3) * 4;
          if (sect == 0) *(unsigned*)(smem + G_QB + off) = pk2(y0, y1);
          else { *(unsigned*)(smem + G_KB + off) = pk2(y0, y1); kf[tl * 128 + 2 * lane] = y0; kf[tl * 128 + 2 * lane + 1] = y1; }
        }
      }
    }
    if (wave == 0) {
      const float* ab = (const float*)(ws + O_AB) + (t0 + lane) * 8;
      const float a = ab[h], bb = ab[4 + h];
      const float beta = sigmoidf_(bb);
      float g = -__expf(p.in[I_ALOG][h]) * softplusf_(a + p.in[I_DTB][h]);
#pragma unroll
      for (int o = 1; o < 64; o <<= 1) { const float y = __shfl_up(g, o); if (lane >= o) g += y; }
      sbeta[lane] = beta; sgc[lane] = g; segc[lane] = __expf(g);
      if (lane == 63) ((float*)(ws + O_GL))[item] = __expf(g);
    }
  }
  __syncthreads();
  {
#pragma unroll
    for (int q = 0; q < 4; ++q) {
      const int idx = wave * 4 + q; const int isq = idx >> 4, ti = (idx >> 2) & 3, tj = idx & 3;
      f32x4 acc = {0.f, 0.f, 0.f, 0.f};
      if (tj <= ti) {
#pragma unroll
        for (int ks = 0; ks < 4; ++ks) {
          const bf16x8 ai = ldfrag(smem + (isq ? G_QB : G_KB) + sw256(16 * ti + fr, 4 * ks + fq));
          const bf16x8 bj = ldfrag(smem + G_KB + sw256(16 * tj + fr, 4 * ks + fq));
          acc = isq ? mfma16(bj, ai, acc) : mfma16(ai, bj, acc);
        }
      }
      if (isq) {
        const int i = 16 * ti + fr, j0 = 16 * tj + 4 * fq;
        const float gi = sgc[i];
        f32x4 o;
#pragma unroll
        for (int r = 0; r < 4; ++r) { const int j = j0 + r; o[r] = (j <= i) ? acc[r] * __expf(gi - sgc[j]) : 0.f; }
        *(u32x2*)(smem + G_ATT + sw128(i, j0 >> 3) + (j0 & 7) * 2) = pack4(o);
      } else {
        const int j = 16 * tj + fr, i0 = 16 * ti + 4 * fq;
        const float gj = sgc[j];
        f32x4 o;
#pragma unroll
        for (int r = 0; r < 4; ++r) { const int i = i0 + r; o[r] = (j < i) ? acc[r] * __expf(sgc[i] - gj) * sbeta[i] : 0.f; }
        *(f32x4*)(Lm + j * 64 + i0) = o;
      }
    }
  }
  {
    const float gl_ = sgc[63];
    const int d = tid & 127, tg = tid >> 7;
#pragma unroll
    for (int c = 0; c < 2; ++c) {
      float e[8];
#pragma unroll
      for (int j = 0; j < 8; ++j) { const int t = 16 * tg + 8 * c + j; e[j] = kf[t * 128 + d] * __expf(gl_ - sgc[t]); }
      u32x4 o = {pk2(e[0], e[1]), pk2(e[2], e[3]), pk2(e[4], e[5]), pk2(e[6], e[7])};
      *(u32x4*)(smem + G_KDT + sw128(d, 2 * tg + c)) = o;
    }
  }
  __syncthreads();
  if (tid < 256) {
    const bool isw = tid >= 128;
    float* X = isw ? (kf + (tid - 128)) : (vf + tid);
    unsigned char* dstT = smem + (isw ? G_WT : G_UT);
    const int rowc = tid & 127;
#pragma unroll
    for (int b = 0; b < 4; ++b) {
      float xr[16];
#pragma unroll
      for (int r = 0; r < 16; ++r) { const int t = 16 * b + r; float sc = sbeta[t]; if (isw) sc *= segc[t]; xr[r] = X[t * 128] * sc; }
#pragma unroll 2
      for (int j = 0; j < 16 * b; ++j) {
        const float xj = X[j * 128];
        const float* lt = Lm + j * 64 + 16 * b;
        const f32x4 l0 = *(const f32x4*)lt, l1 = *(const f32x4*)(lt + 4), l2 = *(const f32x4*)(lt + 8), l3 = *(const f32x4*)(lt + 12);
#pragma unroll
        for (int r = 0; r < 4; ++r) { xr[r] -= l0[r] * xj; xr[4 + r] -= l1[r] * xj; xr[8 + r] -= l2[r] * xj; xr[12 + r] -= l3[r] * xj; }
      }
#pragma unroll
      for (int q = 0; q < 15; ++q) {
        const float* lt = Lm + (16 * b + q) * 64 + 16 * b;
        float l[16];
#pragma unroll
        for (int g4 = 0; g4 < 4; ++g4) if (4 * g4 + 3 > q) { const f32x4 t4 = *(const f32x4*)(lt + 4 * g4); l[4 * g4] = t4[0]; l[4 * g4 + 1] = t4[1]; l[4 * g4 + 2] = t4[2]; l[4 * g4 + 3] = t4[3]; }
#pragma unroll
        for (int r = q + 1; r < 16; ++r) xr[r] -= l[r] * xr[q];
      }
#pragma unroll
      for (int r = 0; r < 16; ++r) X[(16 * b + r) * 128] = xr[r];
      u32x4 o0 = {pk2(xr[0], xr[1]), pk2(xr[2], xr[3]), pk2(xr[4], xr[5]), pk2(xr[6], xr[7])};
      u32x4 o1 = {pk2(xr[8], xr[9]), pk2(xr[10], xr[11]), pk2(xr[12], xr[13]), pk2(xr[14], xr[15])};
      *(u32x4*)(dstT + sw128(rowc, 2 * b)) = o0;
      *(u32x4*)(dstT + sw128(rowc, 2 * b + 1)) = o1;
    }
  }
  __syncthreads();
  {
    bf16x8 ak[2];
#pragma unroll
    for (int ks = 0; ks < 2; ++ks) ak[ks] = ldfrag(smem + G_KDT + sw128(16 * wave + fr, 4 * ks + fq));
    bf16_t* mp = (bf16_t*)(ws + O_MP) + (size_t)item * 16384;
    float* bc = (float*)(ws + O_BC) + (size_t)item * 16384;
#pragma unroll
    for (int tj = 0; tj < 8; ++tj) {
      f32x4 am = {0.f, 0.f, 0.f, 0.f}, ab_ = {0.f, 0.f, 0.f, 0.f};
#pragma unroll
      for (int ks = 0; ks < 2; ++ks) {
        const bf16x8 bw = ldfrag(smem + G_WT + sw128(16 * tj + fr, 4 * ks + fq));
        const bf16x8 bu = ldfrag(smem + G_UT + sw128(16 * tj + fr, 4 * ks + fq));
        am = mfma16(bw, ak[ks], am);
        ab_ = mfma16(ak[ks], bu, ab_);
      }
      f32x4 nm = {-am[0], -am[1], -am[2], -am[3]};
      *(u32x2*)(mp + ((size_t)((wave * 4 + (tj >> 1)) * 64 + lane)) * 8 + (tj & 1) * 4) = pack4(nm);
      *(f32x4*)(bc + ((size_t)((tj * 8 + wave) * 64 + lane)) * 4) = ab_;
    }
    const int tt = wave & 3, hf = wave >> 2;
    bf16x8 aa[2];
#pragma unroll
    for (int ks = 0; ks < 2; ++ks) aa[ks] = ldfrag(smem + G_ATT + sw128(16 * tt + fr, 4 * ks + fq));
    const int trow = 16 * tt + fr;
    const float eg = segc[trow];
    float* o0 = (float*)(ws + O_O0) + (t0 + trow) * 512 + h * 128;
    bf16_t* qp = (bf16_t*)(ws + O_QP) + (size_t)item * 8192 + trow * 128;
#pragma unroll
    for (int q = 0; q < 4; ++q) {
      const int te = hf * 4 + q;
      f32x4 ao = {0.f, 0.f, 0.f, 0.f}, aw = {0.f, 0.f, 0.f, 0.f};
#pragma unroll
      for (int ks = 0; ks < 2; ++ks) {
        const bf16x8 bu = ldfrag(smem + G_UT + sw128(16 * te + fr, 4 * ks + fq));
        const bf16x8 bw = ldfrag(smem + G_WT + sw128(16 * te + fr, 4 * ks + fq));
        ao = mfma16(bu, aa[ks], ao);
        aw = mfma16(bw, aa[ks], aw);
      }
      const int e0 = 16 * te + 4 * fq;
      *(f32x4*)(o0 + e0) = ao;
      const u32x2 qv = *(const u32x2*)(smem + G_QB + sw256(trow, e0 >> 3) + (e0 & 7) * 2);
      f32x4 qd = {lo2f(qv[0]) * eg - aw[0], hi2f(qv[0]) * eg - aw[1], lo2f(qv[1]) * eg - aw[2], hi2f(qv[1]) * eg - aw[3]};
      *(u32x2*)(qp + e0) = pack4(qd);
    }
  }
}

DI void sgu_item(const Params& p, unsigned char* smem_, int item) {
  unsigned char* smem; { LAS unsigned char* l_ = (LAS unsigned char*)smem_; asm volatile("" : "+v"(l_)); smem = (unsigned char*)l_; }
  int tid = threadIdx.x; asm volatile("" : "+v"(tid));
  const int lane = tid & 63, wave = __builtin_amdgcn_readfirstlane(tid >> 6), fr = lane & 15, fq = lane >> 4;
  unsigned char* ws; { GAS unsigned char* g_ = (GAS unsigned char*)p.ws; asm volatile("" : "+s"(g_)); ws = (unsigned char*)g_; }
  const int g = item & 3, cn = item >> 2;
  const size_t t0 = (size_t)cn * 128;
  const bf16_t* uvg = (const bf16_t*)(ws + O_UVG);
  __syncthreads();
  {
    const float* lng = p.in[I_SLNG]; const float* lnb = p.in[I_SLNB];
    const int cl0 = 8 * (lane & 15);
    float gg[8], bb[8];
#pragma unroll
    for (int e = 0; e < 8; ++e) { gg[e] = lng[128 * g + cl0 + e]; bb[e] = lnb[128 * g + cl0 + e]; }
    for (int jj = 0; jj < 16; ++jj) {
      const int j = 16 * wave + jj;
      const u32x4 raw = *(const u32x4*)(uvg + (t0 + j) * 1024 + 512 + 8 * lane);
      float v[8];
#pragma unroll
      for (int e = 0; e < 4; ++e) { v[2 * e] = lo2f(raw[e]); v[2 * e + 1] = hi2f(raw[e]); }
      float s = 0.f;
#pragma unroll
      for (int e = 0; e < 8; ++e) s += v[e];
      const float mean = wave_sum(s) * (1.f / 512.f);
      float q = 0.f;
#pragma unroll
      for (int e = 0; e < 8; ++e) { const float d = v[e] - mean; q += d * d; }
      const float rstd = rsqrtf(wave_sum(q) * (1.f / 512.f) + 1e-5f);
      if ((lane >> 4) == g) {
#pragma unroll
        for (int e = 0; e < 8; ++e) {
          const int c = cl0 + e;
          const float y = (v[e] - mean) * rstd * gg[e] + bb[e];
          *(bf16_t*)(smem + sw256(c, j >> 3) + (j & 7) * 2) = f2bf(y);
        }
      }
    }
  }
  __syncthreads();
  {
    const bf16_t* wg = (const bf16_t*)(ws + O_SGUW) + (size_t)g * 16384;
    const int i = 16 * wave + fr;
    bf16x8 af[4];
#pragma unroll
    for (int ks = 0; ks < 4; ++ks) af[ks] = ldfrag(wg + i * 128 + 32 * ks + 8 * fq);
    const float bias = p.in[I_SGUB][g * 128 + i];
    bf16_t* out = (bf16_t*)(ws + O_SGUO) + (t0 + i) * 512 + 128 * g;
    const bf16_t* urow = uvg + (t0 + i) * 1024 + 128 * g;
#pragma unroll
    for (int jt = 0; jt < 8; ++jt) {
      f32x4 acc = {0.f, 0.f, 0.f, 0.f};
#pragma unroll
      for (int ks = 0; ks < 4; ++ks) acc = mfma16(ldfrag(smem + sw256(16 * jt + fr, 4 * ks + fq)), af[ks], acc);
      const int c0 = 16 * jt + 4 * fq;
      const u32x2 uu = *(const u32x2*)(urow + c0);
      f32x4 o = {lo2f(uu[0]) * (acc[0] + bias), hi2f(uu[0]) * (acc[1] + bias), lo2f(uu[1]) * (acc[2] + bias), hi2f(uu[1]) * (acc[3] + bias)};
      *(u32x2*)(out + c0) = pack4(o);
    }
  }
}

DI void xattn_item(const Params& p, int item) {
  int tid = threadIdx.x; asm volatile("" : "+v"(tid));
  const int lane = tid & 63, wave = __builtin_amdgcn_readfirstlane(tid >> 6), fr = lane & 15, fq = lane >> 4;
  unsigned char* ws; { GAS unsigned char* g_ = (GAS unsigned char*)p.ws; asm volatile("" : "+s"(g_)); ws = (unsigned char*)g_; }
  const int h = item & 3, qt = item >> 2;
  const size_t trow = (size_t)qt * 128 + 16 * wave + fr;
  const int b = (qt * 128) >> 13;
  const bf16_t* xq = (const bf16_t*)(ws + O_XQ) + trow * 512 + h * 128;
  const bf16_t* mk = (const bf16_t*)(ws + O_MEMK) + (size_t)(b * 4 + h) * 32768;
  const bf16_t* mv = (const bf16_t*)(ws + O_MEMVT) + (size_t)(b * 4 + h) * 32768;
  bf16x8 qf[4];
#pragma unroll
  for (int ds = 0; ds < 4; ++ds) qf[ds] = ldfrag(xq + 32 * ds + 8 * fq);
  f32x4 sc[16];
#pragma unroll
  for (int kt = 0; kt < 16; ++kt) {
    f32x4 a = {0.f, 0.f, 0.f, 0.f};
#pragma unroll
    for (int ds = 0; ds < 4; ++ds) a = mfma16(ldfrag(mk + (16 * kt + fr) * 128 + 32 * ds + 8 * fq), qf[ds], a);
    sc[kt] = a;
  }
  float m = -1e30f;
#pragma unroll
  for (int kt = 0; kt < 16; ++kt)
#pragma unroll
    for (int r = 0; r < 4; ++r) m = fmaxf(m, sc[kt][r]);
  m = fmaxf(m, __shfl_xor(m, 16)); m = fmaxf(m, __shfl_xor(m, 32));
  float l = 0.f;
#pragma unroll
  for (int kt = 0; kt < 16; ++kt)
#pragma unroll
    for (int r = 0; r < 4; ++r) { const float e = __expf(sc[kt][r] - m); sc[kt][r] = e; l += e; }
  l += __shfl_xor(l, 16); l += __shfl_xor(l, 32);
  const float inv = 1.f / l;
  bf16x8 pf[8];
#pragma unroll
  for (int s = 0; s < 8; ++s) pf[s] = pack8(sc[2 * s], sc[2 * s + 1]);
  bf16_t* out = (bf16_t*)(ws + O_XATO) + trow * 512 + h * 128;
#pragma unroll
  for (int dt = 0; dt < 8; ++dt) {
    f32x4 a = {0.f, 0.f, 0.f, 0.f};
#pragma unroll
    for (int s = 0; s < 8; ++s) a = mfma16(ldfrag(mv + (16 * dt + fr) * 256 + 32 * s + 8 * fq), pf[s], a);
    f32x4 o = {a[0] * inv, a[1] * inv, a[2] * inv, a[3] * inv};
    *(u32x2*)(out + 16 * dt + 4 * fq) = pack4(o);
  }
}

DI void phase2(const Params& p, unsigned char* smem, int bid, int nb) {
  for (int rep = 0; rep < ((DUPMASK >> 20) & 1) + 1; ++rep) for (int it = bid; it < 1024; it += nb) gdn_prep_item(p, smem, it);
  for (int rep = 0; rep < ((DUPMASK >> 21) & 1) + 1; ++rep) for (int it = bid; it < 512; it += nb) sgu_item(p, smem, it);
  for (int rep = 0; rep < ((DUPMASK >> 22) & 1) + 1; ++rep) for (int it = bid; it < 512; it += nb) xattn_item(p, it);
}

DI void gdn_scan4(const Params& p, unsigned char* smem_, int bh, int es) {
  int tid = threadIdx.x; asm volatile("" : "+v"(tid));
  unsigned char* smem; { LAS unsigned char* l_ = (LAS unsigned char*)smem_; asm volatile("" : "+v"(l_)); smem = (unsigned char*)l_; }
  const int lane = tid & 63, w = __builtin_amdgcn_readfirstlane(tid >> 6);
  if (w >= 4) {
    for (int n = 0; n < 128; ++n) __builtin_amdgcn_s_barrier();
    return;
  }
  unsigned char* ws = p.ws;
  const int b = bh >> 2, h = bh & 3;
  const int fr = lane & 15, fq = lane >> 4;
  const size_t item0 = (size_t)(b * 128) * 4 + h;
  constexpr size_t ISTR = 4 * 16384;
  const bf16_t* mp = (const bf16_t*)(ws + O_MP) + item0 * 16384 + (size_t)(2 * w) * 2048 + lane * 8;
  const float* bc = (const float*)(ws + O_BC) + item0 * 16384 + (size_t)es * 2048 + (size_t)(2 * w) * 256 + lane * 4;
  bf16_t* st = (bf16_t*)(ws + O_ST) + item0 * 16384 + (size_t)(16 * es + fr) * 128 + 32 * w + 4 * fq;
  const float* glp = (const float*)(ws + O_GL) + item0;
  { GAS const float* g_ = (GAS const float*)glp; asm volatile("" : "+v"(g_)); glp = (const float*)g_; }
  f32x4 acc0 = {0.f, 0.f, 0.f, 0.f}, acc1 = {0.f, 0.f, 0.f, 0.f};
  constexpr int PD = 2;
  bf16x8 A[PD][8]; f32x4 C[PD][2]; float G[PD];
#pragma unroll
  for (int d = 0; d < PD; ++d) {
#pragma unroll
    for (int i = 0; i < 8; ++i) A[d][i] = ldfrag(mp + (size_t)d * ISTR + i * 512);
    C[d][0] = *(const f32x4*)(bc + (size_t)d * ISTR); C[d][1] = *(const f32x4*)(bc + (size_t)d * ISTR + 256);
    G[d] = glp[d * 4];
  }
  unsigned char* xch = smem;
  for (int n0 = 0; n0 < 128; n0 += PD) {
#pragma unroll
    for (int d = 0; d < PD; ++d) {
      const int n = n0 + d;
      const int np = (n + PD < 128) ? n + PD : n;
      const u32x2 lo = pack4(acc0), hi = pack4(acc1);
      bf16_t* stn = st + (size_t)n * ISTR;
      *(u32x2*)(stn) = lo; *(u32x2*)(stn + 16) = hi;
      const u32x4 mine = {lo[0], lo[1], hi[0], hi[1]};
      *(u32x4*)(xch + ((n & 1) * 4 + w) * 1024 + lane * 16) = mine;
      asm volatile("s_waitcnt lgkmcnt(0)" ::: "memory");
      __builtin_amdgcn_s_barrier();
      asm volatile("" ::: "memory");
      bf16x8 bfr[4];
#pragma unroll
      for (int s = 0; s < 4; ++s) bfr[s] = ldfrag(xch + ((n & 1) * 4 + s) * 1024 + lane * 16);
      const float g = G[d];
      f32x4 a0 = {g * acc0[0] + C[d][0][0], g * acc0[1] + C[d][0][1], g * acc0[2] + C[d][0][2], g * acc0[3] + C[d][0][3]};
      f32x4 a1 = {g * acc1[0] + C[d][1][0], g * acc1[1] + C[d][1][1], g * acc1[2] + C[d][1][2], g * acc1[3] + C[d][1][3]};
#pragma unroll
      for (int s = 0; s < 4; ++s) { a0 = mfma16(A[d][s], bfr[s], a0); a1 = mfma16(A[d][4 + s], bfr[s], a1); }
      acc0 = a0; acc1 = a1;
#pragma unroll
      for (int i = 0; i < 8; ++i) A[d][i] = ldfrag(mp + (size_t)np * ISTR + i * 512);
      C[d][0] = *(const f32x4*)(bc + (size_t)np * ISTR); C[d][1] = *(const f32x4*)(bc + (size_t)np * ISTR + 256);
      G[d] = glp[(size_t)np * 4];
    }
  }
}

struct EpiGate {
  const bf16_t* gates; int goff; const bf16_t* src; bf16_t* dst;
  DI void operator()(const f32x4 (&acc)[2][2][4][2], const pg::Unit& u, int wr, int wc, int fr, int fq) const {
#pragma unroll
    for (int ai = 0; ai < 2; ++ai)
#pragma unroll
      for (int m = 0; m < 4; ++m) {
        const size_t row = (size_t)u.pm * 256 + 128 * ai + 64 * wr + 16 * m + fr;
#pragma unroll
        for (int bj = 0; bj < 2; ++bj)
#pragma unroll
          for (int n = 0; n < 2; ++n) {
            const int col = u.pn * 256 + 128 * bj + 32 * wc + 16 * n + 4 * fq;
            const f32x4 v = acc[ai][bj][m][n];
            const u32x2 g = *(const u32x2*)(gates + row * 3072 + goff + col);
            f32x4 o = {lo2f(g[0]) * v[0], hi2f(g[0]) * v[1], lo2f(g[1]) * v[2], hi2f(g[1]) * v[3]};
            if (src) { const u32x2 s = *(const u32x2*)(src + row * 1024 + col); o[0] += lo2f(s[0]); o[1] += hi2f(s[0]); o[2] += lo2f(s[1]); o[3] += hi2f(s[1]); }
            *(u32x2*)(dst + row * 1024 + col) = pack4(o);
          }
      }
  }
};
DI void phase3(const Params& p, unsigned char* smem, int bid, int nb) {
  unsigned char* ws = p.ws;
  if (bid < 64) {
    __syncthreads();
    gdn_scan4(p, smem, bid & 7, bid >> 3);
  } else {
    PG_LAS unsigned char* lds = (PG_LAS unsigned char*)smem;
    const bf16_t* gates = (const bf16_t*)(ws + O_GATES);
    bf16_t* part = (bf16_t*)(ws + O_PART);
    __syncthreads();
    { pg::DenseOrder S; S.init(ws + O_SGUO, ws + O_WBT, T, 1024, 512, nb - 64, bid - 64); EpiGate E{gates, 1024, nullptr, part}; pg::gemm_phase<EpiGate, pg::DenseOrder, false, true>(lds, 512, S, E); }
    asm volatile("s_waitcnt vmcnt(0)" ::: "memory");
    __builtin_amdgcn_fence(__ATOMIC_ACQUIRE, "agent");
    asm volatile("s_waitcnt vmcnt(0)" ::: "memory");
    __syncthreads();
    { pg::DenseOrder S; S.init(ws + O_XATO, ws + O_WCT, T, 1024, 512, nb - 64, bid - 64); EpiGate E{gates, 2048, part, part}; pg::gemm_phase<EpiGate, pg::DenseOrder, false, true>(lds, 512, S, E); }
  }
}

DI void phase4(const Params& p, int bid, int nb) {
  int tid = threadIdx.x; asm volatile("" : "+v"(tid));
  const int lane = tid & 63, wave = tid >> 6, fr = lane & 15, fq = lane >> 4;
  unsigned char* ws = p.ws;
  for (int it = bid; it < 512; it += nb) {
    const int item = it * 2 + (wave >> 2), tt = wave & 3;
    const int h = item & 3, cn = item >> 2;
    const size_t trow = (size_t)cn * 64 + 16 * tt + fr;
    const bf16_t* qp = (const bf16_t*)(ws + O_QP) + (size_t)item * 8192 + (16 * tt + fr) * 128;
    const bf16_t* st = (const bf16_t*)(ws + O_ST) + (size_t)item * 16384;
    const float* o0 = (const float*)(ws + O_O0) + trow * 512 + h * 128;
    bf16x8 af[4];
#pragma unroll
    for (int ks = 0; ks < 4; ++ks) af[ks] = ldfrag(qp + 32 * ks + 8 * fq);
    f32x4 acc[8];
    float ss = 0.f;
#pragma unroll
    for (int j = 0; j < 8; ++j) {
      f32x4 a = *(const f32x4*)(o0 + 16 * j + 4 * fq);
#pragma unroll
      for (int ks = 0; ks < 4; ++ks) a = mfma16(ldfrag(st + (16 * j + fr) * 128 + 32 * ks + 8 * fq), af[ks], a);
      acc[j] = a;
      ss += a[0] * a[0] + a[1] * a[1] + a[2] * a[2] + a[3] * a[3];
    }
    ss += __shfl_xor(ss, 16); ss += __shfl_xor(ss, 32);
    const float rms = rsqrtf(ss * (1.f / 128.f) + 1e-6f);
    const float* ng = p.in[I_GNG];
    const bf16_t* zs = (const bf16_t*)(ws + O_ZS) + trow * 512 + h * 128;
    bf16_t* out = (bf16_t*)(ws + O_GDNO) + trow * 512 + h * 128;
#pragma unroll
    for (int j = 0; j < 8; ++j) {
      const int e0 = 16 * j + 4 * fq;
      const f32x4 g = *(const f32x4*)(ng + e0);
      const u32x2 z = *(const u32x2*)(zs + e0);
      f32x4 o = {acc[j][0] * rms * g[0] * lo2f(z[0]), acc[j][1] * rms * g[1] * hi2f(z[0]), acc[j][2] * rms * g[2] * lo2f(z[1]), acc[j][3] * rms * g[3] * hi2f(z[1])};
      *(u32x2*)(out + e0) = pack4(o);
    }
  }
}

DI void phase5(const Params& p, unsigned char* smem, int bid, int nb) {
  unsigned char* ws = p.ws;
  PG_LAS unsigned char* lds = (PG_LAS unsigned char*)smem;
  __syncthreads();
  pg::DenseOrder S; S.init(ws + O_GDNO, ws + O_WAT, T, 1024, 512, nb, bid);
  EpiGate E{(const bf16_t*)(ws + O_GATES), 0, (const bf16_t*)(ws + O_PART), (bf16_t*)(ws + O_MERGED)};
  pg::gemm_phase<EpiGate, pg::DenseOrder, false, true>(lds, 512, S, E);
}
struct EpiX1 {
  const float* x; float* x1;
  DI void operator()(const f32x4 (&acc)[2][2][4][2], const pg::Unit& u, int wr, int wc, int fr, int fq) const {
#pragma unroll
    for (int ai = 0; ai < 2; ++ai)
#pragma unroll
      for (int m = 0; m < 4; ++m) {
        const size_t row = (size_t)u.pm * 256 + 128 * ai + 64 * wr + 16 * m + fr;
#pragma unroll
        for (int bj = 0; bj < 2; ++bj)
#pragma unroll
          for (int n = 0; n < 2; ++n) {
            const int col = u.pn * 256 + 128 * bj + 32 * wc + 16 * n + 4 * fq;
            const f32x4 v = acc[ai][bj][m][n];
            const f32x4 xv = *(const f32x4*)(x + row * 1024 + col);
            f32x4 o = {ALPHA * xv[0] + v[0], ALPHA * xv[1] + v[1], ALPHA * xv[2] + v[2], ALPHA * xv[3] + v[3]};
            *(f32x4*)(x1 + row * 1024 + col) = o;
          }
      }
  }
};
DI void phase6(const Params& p, unsigned char* smem, int bid, int nb) {
  unsigned char* ws = p.ws;
  PG_LAS unsigned char* lds = (PG_LAS unsigned char*)smem;
  __syncthreads();
  pg::DenseOrder S; S.init(ws + O_MERGED, ws + O_WOT, T, 1024, 1024, nb, bid);
  EpiX1 E{p.in[I_X], (float*)(ws + O_X1)};
  pg::gemm_phase<EpiX1, pg::DenseOrder, false, false>(lds, 1024, S, E);
}

DI void ln_row(const float* src, const float* g, const float* b, float (&v)[16], int lane) {
  float s = 0.f;
#pragma unroll
  for (int i = 0; i < 16; ++i) s += v[i];
  const float mean = wave_sum(s) * (1.f / 1024.f);
  float q = 0.f;
#pragma unroll
  for (int i = 0; i < 16; ++i) { const float d = v[i] - mean; q += d * d; }
  const float rstd = rsqrtf(wave_sum(q) * (1.f / 1024.f) + 1e-5f);
#pragma unroll
  for (int i = 0; i < 4; ++i) {
    const int k = 256 * i + 4 * lane;
    const f32x4 gg = *(const f32x4*)(g + k), bb = *(const f32x4*)(b + k);
#pragma unroll
    for (int c = 0; c < 4; ++c) v[4 * i + c] = (v[4 * i + c] - mean) * rstd * gg[c] + bb[c];
  }
}
DI void phase7(const Params& p, int bid, int nb) {
  int tid = threadIdx.x; asm volatile("" : "+v"(tid));
  const int lane = tid & 63, wave = tid >> 6;
  unsigned char* ws = p.ws;
  for (int i = bid * NTHR + tid; i < MAXSLOT; i += nb * NTHR) { ((int*)(ws + O_SLOTTOK))[i] = 0; ((int*)(ws + O_SLOTAID))[i] = -1; }
  float* x1 = (float*)(ws + O_X1);
  bf16_t* x1b = (bf16_t*)(ws + O_X1B);
  for (int row = bid * 8 + wave; row < T; row += nb * 8) {
    float v[16];
#pragma unroll
    for (int i = 0; i < 4; ++i) { const f32x4 t = *(const f32x4*)(x1 + (size_t)row * D + 256 * i + 4 * lane); v[4 * i] = t[0]; v[4 * i + 1] = t[1]; v[4 * i + 2] = t[2]; v[4 * i + 3] = t[3]; }
    ln_row(nullptr, p.in[I_LN1G], p.in[I_LN1B], v, lane);
#pragma unroll
    for (int i = 0; i < 4; ++i) {
      const f32x4 o = {v[4 * i], v[4 * i + 1], v[4 * i + 2], v[4 * i + 3]};
      *(f32x4*)(x1 + (size_t)row * D + 256 * i + 4 * lane) = o;
      *(u32x2*)(x1b + (size_t)row * D + 256 * i + 4 * lane) = pack4(o);
    }
  }
}
struct EpiLogits {
  float* logits;
  DI void operator()(const f32x4 (&acc)[2][2][4][2], const pg::Unit& u, int wr, int wc, int fr, int fq) const {
#pragma unroll
    for (int ai = 0; ai < 2; ++ai)
#pragma unroll
      for (int m = 0; m < 4; ++m) {
        const size_t row = (size_t)u.pm * 256 + 128 * ai + 64 * wr + 16 * m + fr;
#pragma unroll
        for (int bj = 0; bj < 2; ++bj)
#pragma unroll
          for (int n = 0; n < 2; ++n) *(f32x4*)(logits + row * 256 + 128 * bj + 32 * wc + 16 * n + 4 * fq) = acc[ai][bj][m][n];
      }
  }
};
DI void phase8(const Params& p, unsigned char* smem, int bid, int nb) {
  unsigned char* ws = p.ws;
  PG_LAS unsigned char* lds = (PG_LAS unsigned char*)smem;
  __syncthreads();
  pg::DenseOrder S; S.init(ws + O_X1B, ws + O_ROUT, T, 256, 1024, nb, bid);
  EpiLogits E{(float*)(ws + O_LOGITS)};
  pg::gemm_phase<EpiLogits, pg::DenseOrder, false, false>(lds, 1024, S, E);
}
DI void phase9(const Params& p, int bid, int nb) {
  int tid = threadIdx.x; asm volatile("" : "+v"(tid));
  const int lane = tid & 63, wave = tid >> 6;
  unsigned char* ws = p.ws;
  const float* logits = (const float*)(ws + O_LOGITS);
  int* counts = (int*)(ws + O_CTRL);
  const f32x4 bias = *(const f32x4*)(p.in[I_RB] + 4 * lane);
  const float NEG = -__builtin_inff();
  for (int tok = bid * 8 + wave; tok < T; tok += nb * 8) {
    const f32x4 lg = *(const f32x4*)(logits + (size_t)tok * 256 + 4 * lane);
    float sc[4], mv[4];
#pragma unroll
    for (int c = 0; c < 4; ++c) { sc[c] = sigmoidf_(lg[c]); mv[c] = sc[c] + bias[c]; }
    float m1 = NEG, m2 = NEG;
#pragma unroll
    for (int c = 0; c < 4; ++c) { const float v = mv[c]; if (v > m1) { m2 = m1; m1 = v; } else if (v > m2) m2 = v; }
#pragma unroll
    for (int o = 1; o < 8; o <<= 1) {
      const float o1 = __shfl_xor(m1, o), o2 = __shfl_xor(m2, o);
      const float n1 = fmaxf(m1, o1), n2 = fmaxf(fminf(m1, o1), fmaxf(m2, o2));
      m1 = n1; m2 = n2;
    }
    const float gs = m1 + m2;
    const int g = lane >> 3;
    int rank = 0;
#pragma unroll
    for (int gg = 0; gg < 8; ++gg) { const float og = __shfl(gs, gg * 8); rank += ((og > gs) || (og == gs && gg < g)) ? 1 : 0; }
    if (rank >= 4) {
#pragma unroll
      for (int c = 0; c < 4; ++c) mv[c] = NEG;
    }
    int myidx = 0; float mysc = 0.f, ssum = 0.f;
#pragma unroll
    for (int k = 0; k < 8; ++k) {
      float bv = mv[0]; int bi = 0;
#pragma unroll
      for (int c = 1; c < 4; ++c) if (mv[c] > bv) { bv = mv[c]; bi = c; }
      float rv = bv; int ri = lane * 4 + bi;
#pragma unroll
      for (int o = 32; o; o >>= 1) {
        const float ov = __shfl_xor(rv, o); const int oi = __shfl_xor(ri, o);
        if (ov > rv || (ov == rv && oi < ri)) { rv = ov; ri = oi; }
      }
      const int wl = ri >> 2, wc = ri & 3;
      const float mine = wc == 0 ? sc[0] : wc == 1 ? sc[1] : wc == 2 ? sc[2] : sc[3];
      const float wsc = __shfl(mine, wl);
      if (lane == wl) {
#pragma unroll
        for (int c = 0; c < 4; ++c) if (c == wc) mv[c] = NEG;
      }
      ssum += wsc;
      if (lane == k) { myidx = ri; mysc = wsc; }
    }
    if (lane < 8) {
      const int pos = atomicAdd(&counts[myidx * CSTR], 1);
      ((int*)(ws + O_TKIDX))[(size_t)tok * 8 + lane] = myidx;
      ((float*)(ws + O_TKW))[(size_t)tok * 8 + lane] = mysc / ssum * 2.5f;
      ((int*)(ws + O_TKPOS))[(size_t)tok * 8 + lane] = pos;
    }
  }
}
DI void build_tile_start(const Params& p, int* ts) {
  const int tid = threadIdx.x;
  const int* counts = (const int*)(p.ws + O_CTRL);
  __syncthreads();
  if (tid < 256) ts[300 + tid] = (counts[tid * CSTR] + 127) >> 7;
  __syncthreads();
  if (tid == 0) { int s = 0; for (int e = 0; e < 256; ++e) { ts[e] = s; s += ts[300 + e]; } ts[256] = s; }
  __syncthreads();
}
DI void phase10(const Params& p, unsigned char* smem, int bid, int nb) {
  int* ts = (int*)smem;
  build_tile_start(p, ts);
  unsigned char* ws = p.ws;
  const int* tkidx = (const int*)(ws + O_TKIDX); const int* tkpos = (const int*)(ws + O_TKPOS); const float* tkw = (const float*)(ws + O_TKW);
  int* slottok = (int*)(ws + O_SLOTTOK); float* slotw = (float*)(ws + O_SLOTW); int* slotaid = (int*)(ws + O_SLOTAID);
  for (int i = bid * NTHR + threadIdx.x; i < T * 8; i += nb * NTHR) {
    const int e = tkidx[i];
    const int slot = ts[e] * 128 + tkpos[i];
    slottok[slot] = i >> 3; slotw[slot] = tkw[i]; slotaid[slot] = i;
  }
}

DI int find_expert(const int* ts, int ti) { int lo = 0, hi = 255; while (lo < hi) { const int mid = (lo + hi + 1) >> 1; if (ts[mid] <= ti) lo = mid; else hi = mid - 1; } return lo; }

struct MoeUpF {
  const int* ts; unsigned char* ws; const float* wg; const float* wu; int ntile, G, c;
  DI bool next(int i, UnitF& u) const {
    const int L = i * G + (((G & 7) == 0) ? (c & 7) * (G >> 3) + (c >> 3) : c);
    if (L >= ntile * 2) return false;
    const int pn = L / ntile, ti = L - pn * ntile;
    const int e = find_expert(ts, ti);
    u.A = (const bf16_t*)(ws + O_X1B); u.rows = (const int*)(ws + O_SLOTTOK) + ti * 128; u.m0 = ti * 128; u.pn = pn; u.e = e;
    u.W0 = wg + (size_t)e * 262144 + 128 * pn; u.W1 = wu + (size_t)e * 262144 + 128 * pn;
    return true;
  }
};
struct MoeDownF {
  const int* ts; unsigned char* ws; const float* wd; int ntile, G, c;
  DI bool next(int i, UnitF& u) const {
    const int L = i * G + (((G & 7) == 0) ? (c & 7) * (G >> 3) + (c >> 3) : c);
    if (L >= ntile * 4) return false;
    const int pn = L / ntile, ti = L - pn * ntile;
    const int e = find_expert(ts, ti);
    u.A = (const bf16_t*)(ws + O_ACT); u.rows = nullptr; u.m0 = ti * 128; u.pn = pn; u.e = e;
    u.W0 = wd + (size_t)e * 262144 + 256 * pn; u.W1 = u.W0 + 128;
    return true;
  }
};
struct EpiActF {
  bf16_t* actp;
  DI void operator()(const f32x4 (&acc)[4][4], const UnitF& u, int wr, int wc, int fr, int fq) const {
#pragma unroll
    for (int m = 0; m < 4; ++m) {
      const size_t row = (size_t)u.m0 + 64 * wr + 16 * m + fr;
#pragma unroll
      for (int n = 0; n < 2; ++n) {
        const f32x4 g = acc[m][n], uu = acc[m][n + 2];
        f32x4 o = {siluf_(g[0]) * uu[0], siluf_(g[1]) * uu[1], siluf_(g[2]) * uu[2], siluf_(g[3]) * uu[3]};
        *(u32x2*)(actp + row * 256 + 128 * u.pn + 32 * wc + 16 * n + 4 * fq) = pack4(o);
      }
    }
  }
};
struct EpiDownF {
  const int* slotaid; const float* slotw; unsigned char* ybase;
  DI void operator()(const f32x4 (&acc)[4][4], const UnitF& u, int wr, int wc, int fr, int fq) const {
    const unsigned colb = ((unsigned)u.pn * 256u + 64u * wc + 4u * fq) * 2u;
#pragma unroll
    for (int m = 0; m < 4; ++m) {
      const unsigned slot = (unsigned)u.m0 + 64u * wr + 16u * m + fr;
      const int aid = slotaid[slot]; const float ww = slotw[slot];
      if (aid >= 0) {
        const unsigned off = (unsigned)aid * 2048u + colb;
#pragma unroll
        for (int n = 0; n < 4; ++n) {
          const f32x4 v = acc[m][n];
          f32x4 o = {v[0] * ww, v[1] * ww, v[2] * ww, v[3] * ww};
          *(u32x2*)(ybase + (size_t)(off + (unsigned)(32 * n))) = pack4(o);
        }
      }
    }
  }
};
struct EpiAct {
  bf16_t* actp;
  DI void operator()(const f32x4 (&acc)[2][2][4][2], const pg::Unit& u, int wr, int wc, int fr, int fq) const {
#pragma unroll
    for (int ai = 0; ai < 2; ++ai)
#pragma unroll
      for (int m = 0; m < 4; ++m) {
        const size_t row = (size_t)u.pm * 256 + 128 * ai + 64 * wr + 16 * m + fr;
#pragma unroll
        for (int bj = 0; bj < 2; ++bj) {
          const int blk = 8 * u.pn + 4 * bj + wc;
          const f32x4 g = acc[ai][bj][m][0], uu = acc[ai][bj][m][1];
          f32x4 o = {siluf_(g[0]) * uu[0], siluf_(g[1]) * uu[1], siluf_(g[2]) * uu[2], siluf_(g[3]) * uu[3]};
          *(u32x2*)(actp + row * 256 + blk * 16 + 4 * fq) = pack4(o);
        }
      }
  }
};
struct EpiBf16Out {
  bf16_t* dst;
  DI void operator()(const f32x4 (&acc)[2][2][4][2], const pg::Unit& u, int wr, int wc, int fr, int fq) const {
#pragma unroll
    for (int ai = 0; ai < 2; ++ai)
#pragma unroll
      for (int m = 0; m < 4; ++m) {
        const size_t row = (size_t)u.pm * 256 + 128 * ai + 64 * wr + 16 * m + fr;
#pragma unroll
        for (int bj = 0; bj < 2; ++bj)
#pragma unroll
          for (int n = 0; n < 2; ++n) *(u32x2*)(dst + row * 1024 + u.pn * 256 + 128 * bj + 32 * wc + 16 * n + 4 * fq) = pack4(acc[ai][bj][m][n]);
      }
  }
};
DI void phase11(const Params& p, unsigned char* smem, int bid, int nb) {
  unsigned char* ws = p.ws;
  int* ts = (int*)(smem + 131072);
  build_tile_start(p, ts);
  { MoeUpF S{ts, ws, p.in[I_WG], p.in[I_WU], ts[256], nb, bid}; EpiActF E{(bf16_t*)(ws + O_ACT)}; gemmF_phase<true, EpiActF, MoeUpF>(smem, 1024, 1024, 256, S, E); }
  __syncthreads();
  PG_LAS unsigned char* lds = (PG_LAS unsigned char*)smem;
  { pg::DenseOrder S; S.init(ws + O_X1B, ws + O_WSGU, T, 512, 1024, nb, bid); EpiAct E{(bf16_t*)(ws + O_ACTSH)}; pg::gemm_phase<EpiAct, pg::DenseOrder, false, true>(lds, 1024, S, E); }
}
DI void phase12(const Params& p, unsigned char* smem, int bid, int nb) {
  unsigned char* ws = p.ws;
  int* ts = (int*)(smem + 131072);
  build_tile_start(p, ts);
  { MoeDownF S{ts, ws, p.in[I_WDN], ts[256], nb, bid}; EpiDownF E{(const int*)(ws + O_SLOTAID), (const float*)(ws + O_SLOTW), ws + O_Y}; gemmF_phase<false, EpiDownF, MoeDownF>(smem, 256, 256, 1024, S, E); }
  __syncthreads();
  PG_LAS unsigned char* lds = (PG_LAS unsigned char*)smem;
  { pg::DenseOrder S; S.init(ws + O_ACTSH, ws + O_WSD, T, 1024, 256, nb, bid); EpiBf16Out E{(bf16_t*)(ws + O_YSH)}; pg::gemm_phase<EpiBf16Out, pg::DenseOrder, false, true>(lds, 256, S, E); }
}
DI void phase13(const Params& p, int bid, int nb) {
  int tid = threadIdx.x; asm volatile("" : "+v"(tid));
  const int lane = tid & 63, wave = tid >> 6;
  unsigned char* ws = p.ws;
  const float* x1 = (const float*)(ws + O_X1);
  const bf16_t* ysh = (const bf16_t*)(ws + O_YSH);
  const bf16_t* y = (const bf16_t*)(ws + O_Y);
  for (int row = bid * 8 + wave; row < T; row += nb * 8) {
    float v[16];
#pragma unroll
    for (int i = 0; i < 4; ++i) {
      const int k = 256 * i + 4 * lane;
      const f32x4 t = *(const f32x4*)(x1 + (size_t)row * D + k);
      const u32x2 s = *(const u32x2*)(ysh + (size_t)row * D + k);
      v[4 * i] = ALPHA * t[0] + lo2f(s[0]); v[4 * i + 1] = ALPHA * t[1] + hi2f(s[0]); v[4 * i + 2] = ALPHA * t[2] + lo2f(s[1]); v[4 * i + 3] = ALPHA * t[3] + hi2f(s[1]);
    }
#pragma unroll
    for (int k8 = 0; k8 < 8; ++k8) {
#pragma unroll
      for (int i = 0; i < 4; ++i) {
        const u32x2 s = *(const u32x2*)(y + ((size_t)row * 8 + k8) * 1024 + 256 * i + 4 * lane);
        v[4 * i] += lo2f(s[0]); v[4 * i + 1] += hi2f(s[0]); v[4 * i + 2] += lo2f(s[1]); v[4 * i + 3] += hi2f(s[1]);
      }
    }
    ln_row(nullptr, p.in[I_LN2G], p.in[I_LN2B], v, lane);
#pragma unroll
    for (int i = 0; i < 4; ++i) { const f32x4 o = {v[4 * i], v[4 * i + 1], v[4 * i + 2], v[4 * i + 3]}; *(f32x4*)(p.out + (size_t)row * D + 256 * i + 4 * lane) = o; }
  }
}

DI void load_params(Params& lp, const unsigned char* smem) {
  const unsigned* t = (const unsigned*)(smem + PTAB_OFF);
#pragma unroll
  for (int i = 0; i < 28; ++i) lp.in[i] = (const float*)(GAS const float*)(((unsigned long long)(unsigned)__builtin_amdgcn_readfirstlane((int)t[2 * i + 1]) << 32) | (unsigned)__builtin_amdgcn_readfirstlane((int)t[2 * i]));
  lp.out = (float*)(GAS float*)(((unsigned long long)(unsigned)__builtin_amdgcn_readfirstlane((int)t[57]) << 32) | (unsigned)__builtin_amdgcn_readfirstlane((int)t[56]));
  lp.ws = (unsigned char*)(GAS unsigned char*)(((unsigned long long)(unsigned)__builtin_amdgcn_readfirstlane((int)t[59]) << 32) | (unsigned)__builtin_amdgcn_readfirstlane((int)t[58]));
}
__global__ void __launch_bounds__(NTHR) mega_kernel(Params pk) {
  extern __shared__ __attribute__((aligned(16))) unsigned char smem[];
  cg::grid_group grid = cg::this_grid();
  const int bid = blockIdx.x, nb = gridDim.x;
  volatile LAS unsigned* bst = (volatile LAS unsigned*)(smem + LDS_BYTES - 16);
  if (threadIdx.x < 4) bst[threadIdx.x] = 0u;
  if (threadIdx.x < 30) {
    const __attribute__((address_space(4))) unsigned long long* ka = (const __attribute__((address_space(4))) unsigned long long*)__builtin_amdgcn_kernarg_segment_ptr();
    ((unsigned long long*)(smem + PTAB_OFF))[threadIdx.x] = ka[threadIdx.x];
  }
  unsigned* barw = (unsigned*)(pk.ws + O_BAR);
  __syncthreads();
  XcdBarrier xb = xcd_barrier_post(barw, bst);
#define GSYNC() xcd_barrier(xb)
#define RUNP(k, call) do { { Params p; load_params(p, smem); call; } GSYNC(); if (DUPMASK & (1 << (k))) { { Params p; load_params(p, smem); call; } GSYNC(); } } while (0)
  { Params p; load_params(p, smem); phase0(p, smem, bid, nb); } grid.sync();
  RUNP(1, phase1(p, smem, bid, nb));
  RUNP(2, phase2(p, smem, bid, nb));
  RUNP(3, phase3(p, smem, bid, nb));
  RUNP(4, phase4(p, bid, nb));
  RUNP(5, phase5(p, smem, bid, nb));
  RUNP(6, phase6(p, smem, bid, nb));
  RUNP(14, phase7(p, bid, nb));
  if (DUPMASK & (1 << 7)) { { Params p; load_params(p, smem); phase6(p, smem, bid, nb); } GSYNC(); { Params p; load_params(p, smem); phase7(p, bid, nb); } GSYNC(); }
  RUNP(8, phase8(p, smem, bid, nb));
  RUNP(14, phase9(p, bid, nb));
  if (DUPMASK & (1 << 9)) { { Params p; load_params(p, smem); if (bid == 0 && threadIdx.x < 256) ((int*)(p.ws + O_CTRL))[threadIdx.x * CSTR] = 0; } GSYNC(); { Params p; load_params(p, smem); phase9(p, bid, nb); } GSYNC(); }
  RUNP(10, phase10(p, smem, bid, nb));
  RUNP(11, phase11(p, smem, bid, nb));
  RUNP(12, phase12(p, smem, bid, nb));
  { Params p; load_params(p, smem); phase13(p, bid, nb); }
  if (DUPMASK & (1 << 13)) { GSYNC(); Params p; load_params(p, smem); phase13(p, bid, nb); }
  if (DUPMASK & (1 << 15)) { for (int i = 0; i < 10; ++i) GSYNC(); }
}

extern "C" void kernel_launch(void* const* d_in, const int* in_sizes, int n_in, void* d_out, int out_size, void* d_ws, size_t ws_size, hipStream_t stream) {
  if (n_in != 28 || ws_size < WS_NEED) { fprintf(stderr, "kernel_launch: unexpected inputs (%d) or workspace (%zu < %zu)\n", n_in, ws_size, (size_t)WS_NEED); return; }
  static int grid_blocks = 0;
  if (!grid_blocks) {
    int dev = 0, cus = 0, per_cu = 0;
    (void)hipGetDevice(&dev);
    (void)hipDeviceGetAttribute(&cus, hipDeviceAttributeMultiprocessorCount, dev);
    (void)hipFuncSetAttribute((const void*)mega_kernel, hipFuncAttributeMaxDynamicSharedMemorySize, LDS_BYTES);
    (void)hipOccupancyMaxActiveBlocksPerMultiprocessor(&per_cu, (const void*)mega_kernel, NTHR, LDS_BYTES);
    if (per_cu < 1) per_cu = 1;
    if (per_cu > 1) per_cu = 1;
    grid_blocks = cus * per_cu;
    if (grid_blocks < 32) grid_blocks = 32;
  }
  Params p{};
  for (int i = 0; i < 28; ++i) p.in[i] = (const float*)d_in[i];
  p.out = (float*)d_out; p.ws = (unsigned char*)d_ws;
  (void)hipMemsetAsync((unsigned char*)d_ws + O_BAR, 0, XCD_BAR_WORDS * 4, stream);
  void* args[] = {&p};
  hipError_t e = hipLaunchCooperativeKernel((const void*)mega_kernel, dim3(grid_blocks), dim3(NTHR), args, LDS_BYTES, stream);
  if (e != hipSuccess) fprintf(stderr, "cooperative launch failed: %s (grid %d)\n", hipGetErrorString(e), grid_blocks);
}
```

```cpp
#include <hip/hip_runtime.h>
#include <hip/hip_cooperative_groups.h>
#include <stdint.h>
#include <stdio.h>
namespace cg = cooperative_groups;

#define DI __device__ __forceinline__
#define LAS __attribute__((address_space(3)))
#define GAS __attribute__((address_space(1)))
typedef unsigned short bf16_t;
typedef short bf16x8 __attribute__((ext_vector_type(8)));
typedef float f32x4 __attribute__((ext_vector_type(4)));
typedef unsigned u32x4 __attribute__((ext_vector_type(4)));
typedef unsigned u32x2 __attribute__((ext_vector_type(2)));

#ifndef DUPMASK
#define DUPMASK 0
#endif
constexpr int NTHR = 512;
constexpr int T = 16384, SEQ = 8192, D = 1024;
constexpr int NPROJ = 6656;
constexpr int DIN = 6664;
constexpr int NEXP = 256, DEXP = 256;
constexpr int MAXSLOT = 131072 + 256 * 128;
constexpr float ALPHA = 1.189207115002721f;
constexpr int LDS_BYTES = 157696;

constexpr size_t MB = 1u << 20;
constexpr size_t O_WGU = 0;
constexpr size_t O_WD = 256 * MB;
constexpr size_t O_WSGU = 384 * MB;
constexpr size_t O_WSD = 385 * MB;
constexpr size_t O_ROUT = 385 * MB + 512 * 1024;
constexpr size_t O_CTRL = 386 * MB;
constexpr size_t O_BAR = 386 * MB + 128 * 1024;
constexpr int CSTR = 64;
constexpr size_t O_IDENT = 386 * MB + 256 * 1024;
constexpr size_t O_X1 = 387 * MB;
constexpr size_t O_X1B = 451 * MB;
constexpr size_t R0 = 483 * MB;
constexpr size_t O_XB = R0 + 0;
constexpr size_t O_ST = R0 + 0;
constexpr size_t O_WINT = R0 + 32 * MB;
constexpr size_t O_WAT = R0 + 45 * MB;
constexpr size_t O_WBT = R0 + 46 * MB;
constexpr size_t O_WCT = R0 + 47 * MB;
constexpr size_t O_WOT = R0 + 48 * MB;
constexpr size_t O_WMKV = R0 + 50 * MB;
constexpr size_t O_MEMB = R0 + 52 * MB;
constexpr size_t O_SGUW = R0 + 53 * MB;
constexpr size_t O_AB = R0 + 53 * MB + 512 * 1024;
constexpr size_t O_MEMK = R0 + 54 * MB;
constexpr size_t O_MEMVT = R0 + 54 * MB + 512 * 1024;
constexpr size_t O_QKV = R0 + 55 * MB;
constexpr size_t O_PART = R0 + 55 * MB;
constexpr size_t O_ZS = R0 + 103 * MB;
constexpr size_t O_UVG = R0 + 119 * MB;
constexpr size_t O_MERGED = R0 + 119 * MB;
constexpr size_t O_XQ = R0 + 151 * MB;
constexpr size_t O_GATES = R0 + 167 * MB;
constexpr size_t O_MP = R0 + 263 * MB;
constexpr size_t O_BC = R0 + 295 * MB;
constexpr size_t O_O0 = R0 + 359 * MB;
constexpr size_t O_QP = R0 + 391 * MB;
constexpr size_t O_GL = R0 + 407 * MB;
constexpr size_t O_GDNO = R0 + 408 * MB;
constexpr size_t O_SGUO = R0 + 424 * MB;
constexpr size_t O_XATO = R0 + 440 * MB;
constexpr size_t O_LOGITS = R0 + 0;
constexpr size_t O_TKIDX = R0 + 16 * MB;
constexpr size_t O_TKW = R0 + 16 * MB + 512 * 1024;
constexpr size_t O_TKPOS = R0 + 17 * MB;
constexpr size_t O_SLOTTOK = R0 + 18 * MB;
constexpr size_t O_SLOTW = R0 + 19 * MB;
constexpr size_t O_SLOTAID = R0 + 20 * MB;
constexpr size_t O_ACT = R0 + 21 * MB;
constexpr size_t O_ACTSH = R0 + 181 * MB;
constexpr size_t O_YSH = R0 + 189 * MB;
constexpr size_t O_Y = R0 + 221 * MB;
constexpr size_t WS_NEED = R0 + 477 * MB;

struct Params {
  const float* in[28];
  float* out;
  unsigned char* ws;
};
enum { I_X = 0, I_MEM, I_WIN, I_CONVW, I_ALOG, I_DTB, I_GNG, I_WA, I_SLNG, I_SLNB, I_SGUW, I_SGUB, I_WB, I_WMKV, I_WC, I_WO,
       I_LN1G, I_LN1B, I_RW, I_RB, I_WG, I_WU, I_WDN, I_WSG, I_WSU, I_WSD, I_LN2G, I_LN2B };

constexpr int PTAB_OFF = 156672;
DI float bf2f(bf16_t h) { return __uint_as_float(((unsigned)h) << 16); }
DI bf16_t f2bf(float f) { unsigned u = __float_as_uint(f); u += 0x7fffu + ((u >> 16) & 1u); return (bf16_t)(u >> 16); }
typedef float f32x2_ __attribute__((ext_vector_type(2)));
typedef __bf16 bf16x2_ __attribute__((ext_vector_type(2)));
DI unsigned pk2(float lo, float hi) { f32x2_ v = {lo, hi}; return __builtin_bit_cast(unsigned, __builtin_convertvector(v, bf16x2_)); }
DI float lo2f(unsigned u) { return __uint_as_float(u << 16); }
DI float hi2f(unsigned u) { return __uint_as_float(u & 0xffff0000u); }
DI float sigmoidf_(float x) { return 1.f / (1.f + __expf(-x)); }
DI float siluf_(float x) { return x / (1.f + __expf(-x)); }
DI float geluf_(float x) { float u = 0.7978845608028654f * (x + 0.044715f * x * x * x); float t = 1.f - 2.f / (__expf(2.f * u) + 1.f); return 0.5f * x * (1.f + t); }
DI float softplusf_(float x) { return fmaxf(x, 0.f) + log1pf(__expf(-fabsf(x))); }
DI float wave_sum(float v) {
#pragma unroll
  for (int o = 32; o; o >>= 1) v += __shfl_xor(v, o);
  return v;
}
DI f32x4 mfma16(bf16x8 a, bf16x8 b, f32x4 c) { return __builtin_amdgcn_mfma_f32_16x16x32_bf16(a, b, c, 0, 0, 0); }
DI bf16x8 ldfrag(const void* p) { return __builtin_bit_cast(bf16x8, *(const u32x4*)p); }
DI bf16x8 pack8(f32x4 a, f32x4 b) { u32x4 r = {pk2(a[0], a[1]), pk2(a[2], a[3]), pk2(b[0], b[1]), pk2(b[2], b[3])}; return __builtin_bit_cast(bf16x8, r); }
DI u32x2 pack4(f32x4 a) { u32x2 r = {pk2(a[0], a[1]), pk2(a[2], a[3])}; return r; }
DI int sw128(int row, int chunk) { return row * 128 + ((chunk ^ (row & 7)) << 4); }
DI int sw256(int row, int chunk) { return row * 256 + ((chunk ^ (row & 15)) << 4); }

namespace pg {
#define PG_LAS __attribute__((address_space(3)))
constexpr int BM = 256, BK = 64, HALF = 128, HTB = HALF * BK * 2, NXCD = 8, WGM = 8;
DI int lds_byte(int r, int c) { const int st = (r >> 4) * 2 + (c >> 5), rr = r & 15, cc = c & 31, ob = rr * 64 + cc * 2; return st * 1024 + (ob ^ (((ob >> 9) & 1) << 5)); }
DI void stage_rc(int b, int& R, int& C) { const int st = b / 1024, sb = b % 1024, swz = sb ^ (((sb >> 9) & 1) << 5); R = (st >> 1) * 16 + swz / 64; C = (st & 1) * 32 + (swz % 64) / 2; }

struct Unit { const char* a; const char* b; const int* rows; int pm, pn, e; };

struct DenseOrder {
  const char* A; const char* B; int nM, nN, nwg, G, c; size_t tstep;
  DI void init(const void* A_, const void* B_, int M, int N, int K, int G_, int c_) { A = (const char*)A_; B = (const char*)B_; nM = M / BM; nN = N / BM; nwg = nM * nN; G = G_; c = c_; tstep = (size_t)BM * K * 2; }
  DI bool next(int i, Unit& u) const {
    const long L = (long)i * G + c; if (L >= nwg) return false;
    int wgid = (int)L; { const int q = nwg / NXCD, r = nwg % NXCD, xcd = wgid % NXCD, off = wgid / NXCD; wgid = (xcd < r ? xcd * (q + 1) : r * (q + 1) + (xcd - r) * q) + off; }
    const int nig = WGM * nN, gid = wgid / nig, fm = gid * WGM, gsz = (nM - fm) < WGM ? (nM - fm) : WGM;
    u.pm = fm + ((wgid % nig) % gsz); u.pn = (wgid % nig) / gsz; u.e = 0; u.rows = nullptr;
    u.a = A + (size_t)u.pm * tstep; u.b = B + (size_t)u.pn * tstep; return true;
  }
};

template <class Epi, class Sched, bool GATHER, bool ALIGN_EPI>
DI void gemm_phase(PG_LAS unsigned char* lds, const int K, const Sched& S, const Epi& E) {
  int tid = threadIdx.x; asm volatile("" : "+v"(tid));
  const int wid = __builtin_amdgcn_readfirstlane(tid >> 6), lane = tid & 63, wr = wid >> 2, wc = wid & 3, fr = lane & 15, fq = lane >> 4;
  const int nt = K / BK;
  int Rr[2], Cc[2];
  unsigned voffB[2];
#pragma unroll
  for (int i = 0; i < 2; ++i) { stage_rc(tid * 16 + i * 8192, Rr[i], Cc[i]); voffB[i] = (unsigned)(Rr[i] * K + Cc[i]) * 2u; }
  const size_t kstep = (size_t)(BK * 2);
  const size_t hstep = (size_t)HALF * K * 2;
  const unsigned ldsw = (unsigned)wid * 1024u;
  const int aoff = lds_byte(wr * 64 + fr, fq * 8), boff = lds_byte(wc * 32 + fr, fq * 8);
#define PG_SA(b, h) (((b) * 2 + (h)) * HTB)
#define PG_SB(b, h) ((4 + (b) * 2 + (h)) * HTB)
#define PG_STAGE(bufoff, gbase, v0, v1) do { \
    __builtin_amdgcn_global_load_lds((const unsigned*)((const char*)(gbase) + (v0)), (PG_LAS unsigned*)(lds + (bufoff) + ldsw), 16, 0, 0); \
    __builtin_amdgcn_global_load_lds((const unsigned*)((const char*)(gbase) + (v1)), (PG_LAS unsigned*)(lds + (bufoff) + ldsw + 8192), 16, 0, 0); } while (0)
#define PG_LDA(dst, b, h) do { _Pragma("unroll") for (int m = 0; m < 4; ++m) _Pragma("unroll") for (int k = 0; k < 2; ++k) dst[m][k] = *(const PG_LAS bf16x8*)(lds + PG_SA(b, h) + aoff + m * 2048 + k * 1024); } while (0)
#define PG_LDB(dst, b, h) do { _Pragma("unroll") for (int n = 0; n < 2; ++n) _Pragma("unroll") for (int k = 0; k < 2; ++k) dst[n][k] = *(const PG_LAS bf16x8*)(lds + PG_SB(b, h) + boff + n * 2048 + k * 1024); } while (0)
#define PG_MMA(ai, bj, At, Bt) do { __builtin_amdgcn_s_setprio(1); _Pragma("unroll") for (int m = 0; m < 4; ++m) _Pragma("unroll") for (int n = 0; n < 2; ++n) _Pragma("unroll") for (int k = 0; k < 2; ++k) \
    acc[ai][bj][m][n] = __builtin_amdgcn_mfma_f32_16x16x32_bf16(Bt[n][k], At[m][k], acc[ai][bj][m][n], 0, 0, 0); __builtin_amdgcn_s_setprio(0); } while (0)
#define PG_WAIT_V(n) asm volatile("s_waitcnt vmcnt(" #n ")" ::: "memory")
#define PG_WAIT_L(n) asm volatile("s_waitcnt lgkmcnt(" #n ")" ::: "memory")
#define PG_BAR __builtin_amdgcn_s_barrier()
#define PG_SCHED __builtin_amdgcn_sched_barrier(0)
#define PG_AOFFS(u, o00, o01, o10, o11) do { if (GATHER) { \
      o00 = (unsigned)(u).rows[Rr[0]] * (unsigned)(K * 2) + (unsigned)Cc[0] * 2u; o01 = (unsigned)(u).rows[Rr[1]] * (unsigned)(K * 2) + (unsigned)Cc[1] * 2u; \
      o10 = (unsigned)(u).rows[128 + Rr[0]] * (unsigned)(K * 2) + (unsigned)Cc[0] * 2u; o11 = (unsigned)(u).rows[128 + Rr[1]] * (unsigned)(K * 2) + (unsigned)Cc[1] * 2u; \
    } else { o00 = voffB[0]; o01 = voffB[1]; o10 = voffB[0] + (unsigned)hstep; o11 = voffB[1] + (unsigned)hstep; } } while (0)
  Unit cur, nxt; int ui = 0;
  if (!S.next(0, cur)) return;
  f32x4 acc[2][2][4][2];
#pragma unroll
  for (int a = 0; a < 2; ++a)
#pragma unroll
    for (int b = 0; b < 2; ++b)
#pragma unroll
      for (int m = 0; m < 4; ++m)
#pragma unroll
        for (int n = 0; n < 2; ++n) acc[a][b][m][n] = (f32x4){0.f, 0.f, 0.f, 0.f};
  bf16x8 At[4][2], B0[2][2], B1[2][2];
  const char* cA = cur.a; const char* cB = cur.b;
  unsigned c00, c01, c10, c11;
  PG_AOFFS(cur, c00, c01, c10, c11);
  const unsigned vb0 = voffB[0], vb1 = voffB[1];
  PG_STAGE(PG_SB(0, 0), cB, vb0, vb1); PG_STAGE(PG_SB(0, 1), cB + hstep, vb0, vb1); PG_STAGE(PG_SA(0, 0), cA, c00, c01); PG_STAGE(PG_SA(0, 1), cA, c10, c11);
  if (wr == 1) PG_BAR;
  PG_WAIT_V(2); PG_BAR;
  PG_STAGE(PG_SB(1, 0), cB + kstep, vb0, vb1); PG_STAGE(PG_SA(1, 0), cA + kstep, c00, c01); PG_STAGE(PG_SB(1, 1), cB + hstep + kstep, vb0, vb1);
  PG_WAIT_V(6); PG_BAR;
  for (;;) {
    const bool has_next = S.next(ui + 1, nxt);
    const char* nA = has_next ? nxt.a : cA; const char* nB = has_next ? nxt.b : cB;
    unsigned n00 = c00, n01 = c01, n10 = c10, n11 = c11;
    if (has_next) PG_AOFFS(nxt, n00, n01, n10, n11);
#pragma unroll 1
    for (int t = 0; t < nt; t += 2) {
      const bool last = (t == nt - 2);
      const char* a1 = cA + (size_t)(t + 1) * kstep;
      const char* a2 = last ? nA : cA + (size_t)(t + 2) * kstep; const char* b2 = last ? nB : cB + (size_t)(t + 2) * kstep;
      const char* a3 = a2 + kstep; const char* b3 = b2 + kstep;
      const unsigned o00 = last ? n00 : c00, o01 = last ? n01 : c01, o10 = last ? n10 : c10, o11 = last ? n11 : c11;
      PG_LDB(B0, 0, 0); PG_LDB(B1, 0, 1); PG_SCHED; PG_LDA(At, 0, 0); PG_STAGE(PG_SA(1, 1), a1, c10, c11);
      PG_WAIT_V(8); PG_WAIT_L(0); PG_BAR; PG_MMA(0, 0, At, B0); PG_MMA(0, 1, At, B1); PG_BAR; PG_SCHED;
      PG_LDA(At, 0, 1); PG_STAGE(PG_SB(0, 0), b2, vb0, vb1); PG_STAGE(PG_SB(0, 1), b2 + hstep, vb0, vb1); PG_STAGE(PG_SA(0, 0), a2, o00, o01);
      PG_WAIT_V(8); PG_WAIT_L(0); PG_BAR; PG_MMA(1, 0, At, B0); PG_MMA(1, 1, At, B1); PG_BAR; PG_SCHED;
      PG_LDB(B0, 1, 0); PG_LDB(B1, 1, 1); PG_SCHED; PG_LDA(At, 1, 0); PG_STAGE(PG_SA(0, 1), a2, o10, o11);
      PG_WAIT_V(8); PG_WAIT_L(0); PG_BAR; PG_MMA(0, 0, At, B0); PG_MMA(0, 1, At, B1); PG_BAR; PG_SCHED;
      PG_LDA(At, 1, 1); PG_STAGE(PG_SB(1, 0), b3, vb0, vb1); PG_STAGE(PG_SB(1, 1), b3 + hstep, vb0, vb1); PG_STAGE(PG_SA(1, 0), a3, o00, o01);
      PG_WAIT_V(8); PG_WAIT_L(0); PG_BAR; PG_MMA(1, 0, At, B0); PG_MMA(1, 1, At, B1); PG_BAR; PG_SCHED;
    }
    if constexpr (ALIGN_EPI) { if (wr == 0) PG_BAR; }
    E(acc, cur, wr, wc, fr, fq);
    if (!has_next) break;
#pragma unroll
    for (int a = 0; a < 2; ++a)
#pragma unroll
      for (int b = 0; b < 2; ++b)
#pragma unroll
        for (int m = 0; m < 4; ++m)
#pragma unroll
          for (int n = 0; n < 2; ++n) acc[a][b][m][n] = (f32x4){0.f, 0.f, 0.f, 0.f};
    cur = nxt; cA = nA; cB = nB; c00 = n00; c01 = n01; c10 = n10; c11 = n11; ++ui;
    if constexpr (ALIGN_EPI) { if (wr == 1) PG_BAR; }
  }
  PG_WAIT_V(0);
  if constexpr (!ALIGN_EPI) { if (wr == 0) PG_BAR; }
  PG_BAR;
#undef PG_SA
#undef PG_SB
#undef PG_STAGE
#undef PG_LDA
#undef PG_LDB
#undef PG_MMA
#undef PG_WAIT_V
#undef PG_WAIT_L
#undef PG_BAR
#undef PG_SCHED
#undef PG_AOFFS
}
}


struct UnitF { const bf16_t* A; const int* rows; const float* W0; const float* W1; int m0, pn, e; };

template <bool AMUL, class Epi, class Sched>
DI void gemmF_phase(unsigned char* smem_, const int K, const int lda, const int ldw, const Sched& S, const Epi& E) {
  int tid = threadIdx.x; asm volatile("" : "+v"(tid));
  unsigned char* smem; { LAS unsigned char* l_ = (LAS unsigned char*)smem_; asm volatile("" : "+v"(l_)); smem = (unsigned char*)l_; }
  const int lane = tid & 63, wid = tid >> 6, wr = wid >> 2, wc = wid & 3, fr = lane & 15, fq = lane >> 4;
  const int nk = K >> 6;
  const int ar0 = tid >> 3, ac = tid & 7;
  const int q = tid & 63, half = q >> 5, g0 = 4 * (q & 31);
  int vrow[4];
#pragma unroll
  for (int i = 0; i < 4; ++i) vrow[i] = 64 * (q >> 4) + 16 * i + (q & 15);
  const int aw0 = sw128(ar0, ac), aw1 = sw128(ar0 + 64, ac);
#define F_ROWS(u, rr0, rr1) do { rr0 = (u).rows ? (size_t)(u).rows[ar0] : (size_t)((u).m0 + ar0); rr1 = (u).rows ? (size_t)(u).rows[ar0 + 64] : (size_t)((u).m0 + ar0 + 64); } while (0)
#define F_LOAD(A_, W0_, W1_, rr0_, rr1_, kk_, va0, va1, vb0, vb1, vw) do { \
    va0 = *(const u32x4*)((A_) + (rr0_) * lda + (kk_) * 64 + ac * 8); va1 = *(const u32x4*)((A_) + (rr1_) * lda + (kk_) * 64 + ac * 8); \
    if (AMUL) { vb0 = *(const u32x4*)((A_) + (rr0_) * lda + 256 + (kk_) * 64 + ac * 8); vb1 = *(const u32x4*)((A_) + (rr1_) * lda + 256 + (kk_) * 64 + ac * 8); } \
    const float* wp_ = (half ? (W1_) : (W0_)) + (size_t)((kk_) * 64 + 8 * wid) * ldw + g0; \
    _Pragma("unroll") for (int j = 0; j < 8; ++j) vw[j] = *(const f32x4*)(wp_ + (size_t)j * ldw); } while (0)
#define F_LOADX(kx, va0, va1, vb0, vb1, vw) do { const bool nx_ = (kx) >= nk; const int kk2_ = nx_ ? (kx) - nk : (kx); \
    const bf16_t* A2_ = nx_ ? nxt.A : cur.A; const float* W02_ = nx_ ? nxt.W0 : cur.W0; const float* W12_ = nx_ ? nxt.W1 : cur.W1; \
    const size_t q0_ = nx_ ? nr0 : r0, q1_ = nx_ ? nr1 : r1; \
    F_LOAD(A2_, W02_, W12_, q0_, q1_, kk2_, va0, va1, vb0, vb1, vw); } while (0)
#define F_STORE(st, va0, va1, vb0, vb1, vw) do { unsigned char* sa_ = smem + (st) * 49152; \
    if (AMUL) { _Pragma("unroll") for (int e_ = 0; e_ < 4; ++e_) { va0[e_] = pk2(lo2f(va0[e_]) * lo2f(vb0[e_]), hi2f(va0[e_]) * hi2f(vb0[e_])); va1[e_] = pk2(lo2f(va1[e_]) * lo2f(vb1[e_]), hi2f(va1[e_]) * hi2f(vb1[e_])); } } \
    *(u32x4*)(sa_ + aw0) = va0; *(u32x4*)(sa_ + aw1) = va1; \
    _Pragma("unroll") for (int i = 0; i < 4; ++i) { \
      u32x4 o_ = {pk2(vw[0][i], vw[1][i]), pk2(vw[2][i], vw[3][i]), pk2(vw[4][i], vw[5][i]), pk2(vw[6][i], vw[7][i])}; \
      *(u32x4*)(sa_ + 16384 + sw128(vrow[i], wid)) = o_; } } while (0)
#define F_LBAR() do { asm volatile("s_waitcnt lgkmcnt(0)" ::: "memory"); __builtin_amdgcn_s_barrier(); asm volatile("" ::: "memory"); } while (0)
#define F_COMPUTE(st) do { const unsigned char* sA = smem + (st) * 49152; const unsigned char* sB = sA + 16384; \
    _Pragma("unroll") for (int ks = 0; ks < 2; ++ks) { bf16x8 af[4], bfr[4]; \
      _Pragma("unroll") for (int m = 0; m < 4; ++m) af[m] = ldfrag(sA + sw128(64 * wr + 16 * m + fr, 4 * ks + fq)); \
      _Pragma("unroll") for (int n = 0; n < 4; ++n) bfr[n] = ldfrag(sB + sw128(64 * wc + 16 * n + fr, 4 * ks + fq)); \
      _Pragma("unroll") for (int m = 0; m < 4; ++m) _Pragma("unroll") for (int n = 0; n < 4; ++n) acc[m][n] = mfma16(bfr[n], af[m], acc[m][n]); } } while (0)
  UnitF cur, nxt; int ui = 0;
  if (!S.next(0, cur)) return;
  size_t r0, r1, nr0, nr1;
  F_ROWS(cur, r0, r1);
  bool has_next = S.next(1, nxt);
  if (has_next) F_ROWS(nxt, nr0, nr1); else { nxt = cur; nr0 = r0; nr1 = r1; }
  f32x4 acc[4][4];
#pragma unroll
  for (int m = 0; m < 4; ++m)
#pragma unroll
    for (int n = 0; n < 4; ++n) acc[m][n] = (f32x4){0.f, 0.f, 0.f, 0.f};
  u32x4 xa0, xa1, ya0, ya1, xb0, xb1, yb0, yb1; f32x4 xw[8], yw[8];
  xb0 = xb1 = yb0 = yb1 = (u32x4){0u, 0u, 0u, 0u};
  F_LOAD(cur.A, cur.W0, cur.W1, r0, r1, 0, xa0, xa1, xb0, xb1, xw);
  F_LOAD(cur.A, cur.W0, cur.W1, r0, r1, 1, ya0, ya1, yb0, yb1, yw);
  __syncthreads();
  F_STORE(0, xa0, xa1, xb0, xb1, xw);
  F_LBAR();
  int st = 0;
  for (;;) {
    typename Epi::Pre pre; E.prefetch(cur, wr, fr, pre);
#pragma unroll 1
    for (int kt = 0; kt < nk; kt += 2) {
      F_LOADX(kt + 2, xa0, xa1, xb0, xb1, xw);
      F_COMPUTE(st);
      F_STORE(st ^ 1, ya0, ya1, yb0, yb1, yw);
      F_LBAR();
      F_LOADX(kt + 3, ya0, ya1, yb0, yb1, yw);
      F_COMPUTE(st ^ 1);
      F_STORE(st, xa0, xa1, xb0, xb1, xw);
      F_LBAR();
    }
    E(acc, cur, wr, wc, fr, fq, pre);
#pragma unroll
    for (int m = 0; m < 4; ++m)
#pragma unroll
      for (int n = 0; n < 4; ++n) acc[m][n] = (f32x4){0.f, 0.f, 0.f, 0.f};
    if (!has_next) break;
    cur = nxt; r0 = nr0; r1 = nr1; ++ui;
    has_next = S.next(ui + 1, nxt);
    if (has_next) F_ROWS(nxt, nr0, nr1); else { nxt = cur; nr0 = r0; nr1 = r1; }
  }
  asm volatile("s_waitcnt vmcnt(0)" ::: "memory");
  __syncthreads();
#undef F_ROWS
#undef F_LOAD
#undef F_LOADX
#undef F_STORE
#undef F_LBAR
#undef F_COMPUTE
}

#define XB_TMO      128
#define XB_XCNT(j)  (256  + 64 * (j))
#define XB_XSUB(j)  (1280 + 64 * (j))
#define XB_XGEN(j)  (2304 + 64 * (j))
#define XB_TOP      3328
#define XB_TOPGEN   3392
#define XCD_BAR_WORDS 3456
#define XB_SPIN_CAP (1u << 22)
DI unsigned xb_ld(unsigned* p)              { return __hip_atomic_load(p, __ATOMIC_RELAXED, __HIP_MEMORY_SCOPE_AGENT); }
DI unsigned xb_add(unsigned* p, unsigned v) { return __hip_atomic_fetch_add(p, v, __ATOMIC_RELAXED, __HIP_MEMORY_SCOPE_AGENT); }
DI unsigned xb_xcc_id() { return (unsigned)__builtin_amdgcn_s_getreg((3 << 11) | 20) & 0xFu; }
#define XB_SPIN(cond, bar) do { unsigned _sp = 0; while (cond) { __builtin_amdgcn_s_sleep(1); \
    if ((++_sp & 255u) == 0u) { if (xb_ld(&(bar)[XB_TMO])) break; if (_sp > XB_SPIN_CAP) { atomicAdd(&(bar)[XB_TMO], 1u); break; } } } } while (0)
struct XcdBarrier { unsigned* bar; unsigned x; volatile LAS unsigned* st; };
DI XcdBarrier xcd_barrier_post(unsigned* bar, volatile LAS unsigned* st) {
  XcdBarrier b; b.bar = bar; b.x = xb_xcc_id(); b.st = st;
  if (threadIdx.x == 0) (void)xb_add(&bar[XB_XCNT(b.x)], 1u);
  return b;
}
DI void xcd_barrier_complete(unsigned* bar, unsigned x, unsigned& nloc, unsigned& nx) {
  const unsigned G = gridDim.x * gridDim.y * gridDim.z;
  unsigned sum, cnt, mine, sp = 0u;
  for (;;) {
    sum = 0u; cnt = 0u; mine = 0u;
#pragma unroll
    for (unsigned j = 0; j < 16; ++j) { const unsigned c = xb_ld(&bar[XB_XCNT(j)]); sum += c; cnt += (c > 0u) ? 1u : 0u; mine = (j == x) ? c : mine; }
    if (sum == G) break;
    __builtin_amdgcn_s_sleep(1);
    if ((++sp & 255u) == 0u) { if (xb_ld(&bar[XB_TMO])) break; if (sp > XB_SPIN_CAP) { atomicAdd(&bar[XB_TMO], 1u); break; } }
  }
  nloc = mine > 0u ? mine : 1u; nx = cnt > 0u ? cnt : 1u;
}
DI void xcd_barrier(const XcdBarrier& b) {
  asm volatile("s_waitcnt vmcnt(0)" ::: "memory");
  __syncthreads();
  if (threadIdx.x == 0) {
    unsigned* bar = b.bar;
    __builtin_amdgcn_s_waitcnt(0);
    unsigned nloc = b.st[0], nx = b.st[1];
    if (nloc == 0u) { xcd_barrier_complete(bar, b.x, nloc, nx); b.st[0] = nloc; b.st[1] = nx; }
    const unsigned old = xb_add(&bar[XB_XSUB(b.x)], 1u);
    const unsigned gen = old / nloc;
    if (old + 1u == (gen + 1u) * nloc) {
      __builtin_amdgcn_fence(__ATOMIC_RELEASE, "agent");
      asm volatile("s_waitcnt vmcnt(0)" ::: "memory");
      const unsigned og = xb_add(&bar[XB_TOP], 1u);
      const unsigned tg = og / nx;
      if (og + 1u == (tg + 1u) * nx) xb_add(&bar[XB_TOPGEN], 1u);
      else XB_SPIN(xb_ld(&bar[XB_TOPGEN]) == tg, bar);
      __builtin_amdgcn_fence(__ATOMIC_ACQUIRE, "agent");
      xb_add(&bar[XB_XGEN(b.x)], 1u);
      asm volatile("s_waitcnt vmcnt(0)" ::: "memory");
    } else {
      XB_SPIN(xb_ld(&bar[XB_XGEN(b.x)]) == gen, bar);
      __builtin_amdgcn_fence(__ATOMIC_ACQUIRE, "agent");
      asm volatile("s_waitcnt vmcnt(0)" ::: "memory");
    }
  }
  __syncthreads();
}

DI void phase0(const Params& p, unsigned char* smem, int bid, int nb) {
  int tid = threadIdx.x; asm volatile("" : "+v"(tid));
  const int lane = tid & 63, wave = tid >> 6;
  unsigned char* ws = p.ws;
  if (bid == 0 && tid < 256) ((int*)(ws + O_CTRL))[tid * CSTR] = 0;
  for (int i = bid * NTHR + tid; i < T; i += nb * NTHR) ((int*)(ws + O_IDENT))[i] = i;
  {
    float* wabT = (float*)smem;
    const float* win = p.in[I_WIN];
    for (int i = tid; i < 8192; i += NTHR) { const int k = i >> 3, j = i & 7; wabT[j * 1024 + k] = win[(size_t)k * DIN + 2048 + j]; }
    __syncthreads();
    const float* x = p.in[I_X];
    bf16_t* xb = (bf16_t*)(ws + O_XB);
    float* ab = (float*)(ws + O_AB);
    for (int row = bid * 8 + wave; row < T; row += nb * 8) {
      float s[8];
#pragma unroll
      for (int j = 0; j < 8; ++j) s[j] = 0.f;
#pragma unroll
      for (int i = 0; i < 4; ++i) {
        const int k = 256 * i + 4 * lane;
        const f32x4 v = *(const f32x4*)(x + (size_t)row * D + k);
        *(u32x2*)(xb + (size_t)row * D + k) = pack4(v);
#pragma unroll
        for (int j = 0; j < 8; ++j) { const f32x4 w = *(const f32x4*)(wabT + j * 1024 + k); s[j] += v[0] * w[0] + v[1] * w[1] + v[2] * w[2] + v[3] * w[3]; }
      }
#pragma unroll
      for (int j = 0; j < 8; ++j) s[j] = wave_sum(s[j]);
      if (lane == 0) { *(f32x4*)(ab + (size_t)row * 8) = (f32x4){s[0], s[1], s[2], s[3]}; *(f32x4*)(ab + (size_t)row * 8 + 4) = (f32x4){s[4], s[5], s[6], s[7]}; }
    }
    const float* mem = p.in[I_MEM];
    bf16_t* memb = (bf16_t*)(ws + O_MEMB);
    for (int row = bid * 8 + wave; row < 512; row += nb * 8) {
#pragma unroll
      for (int i = 0; i < 4; ++i) { const int k = 256 * i + 4 * lane; *(u32x2*)(memb + (size_t)row * D + k) = pack4(*(const f32x4*)(mem + (size_t)row * D + k)); }
    }
    const float* sw = p.in[I_SGUW];
    bf16_t* sguw = (bf16_t*)(ws + O_SGUW);
    for (int i = bid * NTHR + tid; i < 16384; i += nb * NTHR) {
      const int e0 = i * 4; const int col = e0 & 127, rowi = (e0 >> 7) & 127;
      f32x4 v = *(const f32x4*)(sw + e0);
#pragma unroll
      for (int c = 0; c < 4; ++c) if (col + c > rowi) v[c] = 0.f;
      *(u32x2*)(sguw + e0) = pack4(v);
    }
    __syncthreads();
  }
  {
    float* tile = (float*)smem;
    const float *pwin = p.in[I_WIN], *pwa = p.in[I_WA], *pwb = p.in[I_WB], *pwc = p.in[I_WC], *pwo = p.in[I_WO], *pwmkv = p.in[I_WMKV], *prw = p.in[I_RW],
                *pwsg = p.in[I_WSG], *pwsu = p.in[I_WSU], *pwsd = p.in[I_WSD], *pwg = p.in[I_WG], *pwu = p.in[I_WU], *pwdn = p.in[I_WDN];
    { GAS const float *a_ = (GAS const float*)pwa, *b_ = (GAS const float*)pwb, *c_ = (GAS const float*)pwc, *o_ = (GAS const float*)pwo, *m_ = (GAS const float*)pwmkv;
      asm volatile("" : "+s"(a_), "+s"(b_), "+s"(c_), "+s"(o_), "+s"(m_));
      pwa = (const float*)a_; pwb = (const float*)b_; pwc = (const float*)c_; pwo = (const float*)o_; pwmkv = (const float*)m_; }
    constexpr int J0 = 1664, J1 = J0 + 128, J2 = J1 + 128, J3 = J2 + 128, J4 = J3 + 256, J5 = J4 + 256, J6 = J5 + 64, J7 = J6 + 128, J8 = J7 + 64,
                  J9 = J8, J10 = J8;
    const int kr = tid >> 4, nc = tid & 15, sg = nc >> 2;
    const int tn = tid >> 3, tkc = tid & 7;
#define P0_DECODE_LOAD(it0, dp, v0, v1) do { const float* sp[4]; int ld[4]; \
      _Pragma("unroll") \
      for (int q = 0; q < 4; ++q) { \
        const int it = (it0 + q < J10) ? it0 + q : J10 - 1;      \
        const float *s0, *s1, *s2, *s3; int ldd; bf16_t* dst; \
        if (it < J0) {           \
          const int kt = it & 15, nt = it >> 4; const int n0 = nt * 64; const int c0 = n0 + (n0 >= 2048 ? 8 : 0); \
          const float* b = pwin + (size_t)kt * 64 * DIN + c0; s0 = b; s1 = b + 16; s2 = b + 32; s3 = b + 48; ld[q] = DIN; ldd = 1024; \
          dst = (bf16_t*)(ws + O_WINT) + (size_t)n0 * 1024 + kt * 64; \
        } else if (it < J3) {    \
          const int which = (it - J0) >> 7, r = (it - J0) & 127; const int kt = r & 7, nt = r >> 3; \
          const float* src = which == 0 ? pwa : which == 1 ? pwb : pwc; \
          const float* b = src + (size_t)kt * 64 * 1024 + nt * 64; s0 = b; s1 = b + 16; s2 = b + 32; s3 = b + 48; ld[q] = 1024; ldd = 512; \
          dst = (bf16_t*)(ws + (which == 0 ? O_WAT : which == 1 ? O_WBT : O_WCT)) + (size_t)nt * 64 * 512 + kt * 64; \
        } else if (it < J5) {    \
          const int which = (it - J3) >> 8, r = (it - J3) & 255; const int kt = r & 15, nt = r >> 4; \
          const float* b = (which == 0 ? pwo : pwmkv) + (size_t)kt * 64 * 1024 + nt * 64; s0 = b; s1 = b + 16; s2 = b + 32; s3 = b + 48; ld[q] = 1024; ldd = 1024; \
          dst = (bf16_t*)(ws + (which == 0 ? O_WOT : O_WMKV)) + (size_t)nt * 64 * 1024 + kt * 64; \
        } else if (it < J6) {    \
          const int r = it - J5; const int kt = r & 15, nt = r >> 4; \
          const float* b = prw + (size_t)kt * 64 * 256 + nt * 64; s0 = b; s1 = b + 16; s2 = b + 32; s3 = b + 48; ld[q] = 256; ldd = 1024; \
          dst = (bf16_t*)(ws + O_ROUT) + (size_t)nt * 64 * 1024 + kt * 64; \
        } else if (it < J7) {    \
          const int r = it - J6; const int kt = r & 15, nt = r >> 4; \
          const float* g = pwsg + (size_t)kt * 64 * 256 + nt * 32; const float* u = pwsu + (size_t)kt * 64 * 256 + nt * 32; \
          s0 = g; s1 = u; s2 = g + 16; s3 = u + 16; ld[q] = 256; ldd = 1024; \
          dst = (bf16_t*)(ws + O_WSGU) + (size_t)nt * 64 * 1024 + kt * 64; \
        } else if (it < J8) {    \
          const int r = it - J7; const int kt = r & 3, nt = r >> 2; \
          const float* b = pwsd + (size_t)kt * 64 * 1024 + nt * 64; s0 = b; s1 = b + 16; s2 = b + 32; s3 = b + 48; ld[q] = 1024; ldd = 256; \
          dst = (bf16_t*)(ws + O_WSD) + (size_t)nt * 64 * 256 + kt * 64; \
        } else if (it < J9) {    \
          const int r = it - J8; const int e = r >> 7, qq = r & 127; const int kt = qq & 15, nt = qq >> 4; \
          const float* g = pwg + (size_t)e * 262144 + (size_t)kt * 64 * 256 + nt * 32; const float* u = pwu + (size_t)e * 262144 + (size_t)kt * 64 * 256 + nt * 32; \
          s0 = g; s1 = u; s2 = g + 16; s3 = u + 16; ld[q] = 256; ldd = 1024; \
          dst = (bf16_t*)(ws + O_WGU) + (size_t)e * 524288 + (size_t)nt * 64 * 1024 + kt * 64; \
        } else {                 \
          const int r = it - J9; const int e = r >> 6, qq = r & 63; const int kt = qq & 3, nt = qq >> 2; \
          const float* b = pwdn + (size_t)e * 262144 + (size_t)kt * 64 * 1024 + nt * 64; s0 = b; s1 = b + 16; s2 = b + 32; s3 = b + 48; ld[q] = 1024; ldd = 256; \
          dst = (bf16_t*)(ws + O_WD) + (size_t)e * 262144 + (size_t)nt * 64 * 256 + kt * 64; \
        } \
        sp[q] = (sg == 0 ? s0 : sg == 1 ? s1 : sg == 2 ? s2 : s3) + (size_t)kr * ld[q] + 4 * (nc & 3); \
        dp[q] = dst + (size_t)tn * ldd + 8 * tkc; \
      } \
      _Pragma("unroll") \
      for (int q = 0; q < 4; ++q) { v0[q] = __builtin_nontemporal_load((const f32x4*)(sp[q])); v1[q] = __builtin_nontemporal_load((const f32x4*)(sp[q] + (size_t)32 * ld[q])); } } while (0)
    bf16_t* dpn[4]; f32x4 v0n[4], v1n[4];
    int it0 = bid * 4;
    if (it0 < J10) P0_DECODE_LOAD(it0, dpn, v0n, v1n);
    for (; it0 < J10; it0 += nb * 4) {
      bf16_t* dp[4]; f32x4 v0[4], v1[4];
#pragma unroll
      for (int q = 0; q < 4; ++q) { dp[q] = dpn[q]; v0[q] = v0n[q]; v1[q] = v1n[q]; }
      if (it0 + nb * 4 < J10) P0_DECODE_LOAD(it0 + nb * 4, dpn, v0n, v1n);
      asm volatile("s_waitcnt lgkmcnt(0)" ::: "memory"); __builtin_amdgcn_s_barrier(); asm volatile("" ::: "memory");
#pragma unroll
      for (int q = 0; q < 4; ++q) {
        float* t0 = tile + q * 4160 + kr * 65 + 4 * nc;
        float* t1 = t0 + 32 * 65;
        t0[0] = v0[q][0]; t0[1] = v0[q][1]; t0[2] = v0[q][2]; t0[3] = v0[q][3];
        t1[0] = v1[q][0]; t1[1] = v1[q][1]; t1[2] = v1[q][2]; t1[3] = v1[q][3];
      }
      asm volatile("s_waitcnt lgkmcnt(0)" ::: "memory"); __builtin_amdgcn_s_barrier(); asm volatile("" ::: "memory");
#pragma unroll
      for (int q = 0; q < 4; ++q) {
        float e[8];
#pragma unroll
        for (int j = 0; j < 8; ++j) e[j] = tile[q * 4160 + (8 * tkc + j) * 65 + tn];
        u32x4 o = {pk2(e[0], e[1]), pk2(e[2], e[3]), pk2(e[4], e[5]), pk2(e[6], e[7])};
        *(u32x4*)(dp[q]) = o;
      }
    }
#undef P0_DECODE_LOAD
  }
}

#define EPI_ROWS(u) const int row_ = (u).pm * 256 + 64 * wr + fr
struct EpiInProj {
  unsigned char* ws;
  DI void operator()(const f32x4 (&acc)[2][2][4][2], const pg::Unit& u, int wr, int wc, int fr, int fq) const {
    const int colt = u.pn * 256;
#pragma unroll
    for (int ai = 0; ai < 2; ++ai)
#pragma unroll
      for (int m = 0; m < 4; ++m) {
        const size_t row = (size_t)u.pm * 256 + 128 * ai + 64 * wr + 16 * m + fr;
#pragma unroll
        for (int bj = 0; bj < 2; ++bj)
#pragma unroll
          for (int n = 0; n < 2; ++n) {
            const int col = colt + 128 * bj + 32 * wc + 16 * n + 4 * fq;
            f32x4 v = acc[ai][bj][m][n];
            if (colt < 1536) { *(u32x2*)((bf16_t*)(ws + O_QKV) + row * 1536 + col) = pack4(v); }
            else if (colt < 2048) {
#pragma unroll
              for (int c = 0; c < 4; ++c) v[c] = siluf_(v[c]);
              *(u32x2*)((bf16_t*)(ws + O_ZS) + row * 512 + (col - 1536)) = pack4(v);
            } else if (colt < 3072) {
#pragma unroll
              for (int c = 0; c < 4; ++c) v[c] = geluf_(v[c]);
              *(u32x2*)((bf16_t*)(ws + O_UVG) + row * 1024 + (col - 2048)) = pack4(v);
            } else if (colt < 3584) {
#pragma unroll
              for (int c = 0; c < 4; ++c) v[c] *= 0.08838834764831845f;
              *(u32x2*)((bf16_t*)(ws + O_XQ) + row * 512 + (col - 3072)) = pack4(v);
            } else {
#pragma unroll
              for (int c = 0; c < 4; ++c) v[c] = sigmoidf_(v[c]);
              *(u32x2*)((bf16_t*)(ws + O_GATES) + row * 3072 + (col - 3584)) = pack4(v);
            }
          }
      }
  }
};
struct EpiMemKV {
  unsigned char* ws;
  DI void operator()(const f32x4 (&acc)[2][2][4][2], const pg::Unit& u, int wr, int wc, int fr, int fq) const {
#pragma unroll
    for (int ai = 0; ai < 2; ++ai)
#pragma unroll
      for (int m = 0; m < 4; ++m) {
        const int row = u.pm * 256 + 128 * ai + 64 * wr + 16 * m + fr; const int b = row >> 8, key = row & 255;
#pragma unroll
        for (int bj = 0; bj < 2; ++bj)
#pragma unroll
          for (int n = 0; n < 2; ++n) {
            const int col = u.pn * 256 + 128 * bj + 32 * wc + 16 * n + 4 * fq;
            const f32x4 v = acc[ai][bj][m][n];
            if (col < 512) { const int h = col >> 7, d = col & 127; *(u32x2*)((bf16_t*)(ws + O_MEMK) + ((size_t)((b * 4 + h) * 256 + key)) * 128 + d) = pack4(v); }
            else {
              const int c2 = col - 512; const int h = c2 >> 7, d = c2 & 127;
              const int pos = 32 * (key >> 5) + 8 * ((key >> 2) & 3) + 4 * ((key >> 4) & 1) + (key & 3);
              bf16_t* vt = (bf16_t*)(ws + O_MEMVT) + ((size_t)((b * 4 + h) * 128 + d)) * 256 + pos;
#pragma unroll
              for (int c = 0; c < 4; ++c) vt[(size_t)c * 256] = f2bf(v[c]);
            }
          }
      }
  }
};
DI void phase1(const Params& p, unsigned char* smem, int bid, int nb) {
  unsigned char* ws = p.ws;
  PG_LAS unsigned char* lds = (PG_LAS unsigned char*)smem;
  __syncthreads();
  { pg::DenseOrder S; S.init(ws + O_XB, ws + O_WINT, T, NPROJ, 1024, nb, bid); EpiInProj E{ws}; pg::gemm_phase<EpiInProj, pg::DenseOrder, false, true>(lds, 1024, S, E); }
  __syncthreads();
  { pg::DenseOrder S; S.init(ws + O_MEMB, ws + O_WMKV, 512, 1024, 1024, nb, bid); EpiMemKV E{ws}; pg::gemm_phase<EpiMemKV, pg::DenseOrder, false, true>(lds, 1024, S, E); }
}

constexpr int G_KF = 0, G_VF = 32768, G_QB = 65536, G_KB = 81920, G_UT = 81920  , G_L = 98304, G_ATT = 114688, G_KDT = 122880, G_WT = 139264, G_SM = 155648;

DI void gdn_prep_item(const Params& p, unsigned char* smem_, int item) {
  unsigned char* smem; { LAS unsigned char* l_ = (LAS unsigned char*)smem_; asm volatile("" : "+v"(l_)); smem = (unsigned char*)l_; }
  int tid = threadIdx.x; asm volatile("" : "+v"(tid));
  const int lane = tid & 63, wave = tid >> 6, fr = lane & 15, fq = lane >> 4;
  unsigned char* ws; { GAS unsigned char* g_ = (GAS unsigned char*)p.ws; asm volatile("" : "+s"(g_)); ws = (unsigned char*)g_; }
  const int h = item & 3, cn = item >> 2;
  const int bidx = cn >> 7, n = cn & 127;
  const size_t t0 = (size_t)bidx * SEQ + (size_t)n * 64;
  float* kf = (float*)(smem + G_KF); float* vf = (float*)(smem + G_VF); float* Lm = (float*)(smem + G_L);
  float* sbeta = (float*)(smem + G_SM); float* sgc = sbeta + 64; float* segc = sbeta + 128;
  __syncthreads();
  {
    const bf16_t* qkv = (const bf16_t*)(ws + O_QKV);
    const float* cw = p.in[I_CONVW];
    const int tl0 = wave * 8;
#pragma unroll
    for (int sect = 0; sect < 3; ++sect) {
      const int cb = sect * 512 + h * 128 + 2 * lane;
      float w0[4], w1[4];
#pragma unroll
      for (int i = 0; i < 4; ++i) { w0[i] = cw[i * 1536 + cb]; w1[i] = cw[i * 1536 + cb + 1]; }
      float xa[11], xc[11];
#pragma unroll
      for (int r = 0; r < 11; ++r) {
        const int s = n * 64 + tl0 + r - 3;
        unsigned u = 0u;
        if (s >= 0) u = *(const unsigned*)(qkv + ((size_t)bidx * SEQ + s) * 1536 + cb);
        xa[r] = lo2f(u); xc[r] = hi2f(u);
      }
#pragma unroll
      for (int r = 0; r < 8; ++r) {
        float y0 = w0[0] * xa[r] + w0[1] * xa[r + 1] + w0[2] * xa[r + 2] + w0[3] * xa[r + 3];
        float y1 = w1[0] * xc[r] + w1[1] * xc[r + 1] + w1[2] * xc[r + 2] + w1[3] * xc[r + 3];
        y0 = siluf_(y0); y1 = siluf_(y1);
        const int tl = tl0 + r;
        if (sect == 2) { vf[tl * 128 + 2 * lane] = y0; vf[tl * 128 + 2 * lane + 1] = y1; }
        else {
          const float ss = wave_sum(y0 * y0 + y1 * y1);
          const float sc = rsqrtf(ss + 1e-6f) * (sect == 0 ? 0.08838834764831845f : 1.0f);
          y0 *= sc; y1 *= sc;
          const int off = sw256(tl, lane >> 2) + (lane & 3) * 4;
          if (sect == 0) *(unsigned*)(smem + G_QB + off) = pk2(y0, y1);
          else { *(unsigned*)(smem + G_KB + off) = pk2(y0, y1); kf[tl * 128 + 2 * lane] = y0; kf[tl * 128 + 2 * lane + 1] = y1; }
        }
      }
    }
    if (wave == 0) {
      const float* ab = (const float*)(ws + O_AB) + (t0 + lane) * 8;
      const float a = ab[h], bb = ab[4 + h];
      const float beta = sigmoidf_(bb);
      float g = -__expf(p.in[I_ALOG][h]) * softplusf_(a + p.in[I_DTB][h]);
#pragma unroll
      for (int o = 1; o < 64; o <<= 1) { const float y = __shfl_up(g, o); if (lane >= o) g += y; }
      sbeta[lane] = beta; sgc[lane] = g; segc[lane] = __expf(g);
      if (lane == 63) ((float*)(ws + O_GL))[item] = __expf(g);
    }
  }
  __syncthreads();
  {
#pragma unroll
    for (int q = 0; q < 4; ++q) {
      const int idx = wave * 4 + q; const int isq = idx >> 4, ti = (idx >> 2) & 3, tj = idx & 3;
      f32x4 acc = {0.f, 0.f, 0.f, 0.f};
      if (tj <= ti) {
#pragma unroll
        for (int ks = 0; ks < 4; ++ks) {
          const bf16x8 ai = ldfrag(smem + (isq ? G_QB : G_KB) + sw256(16 * ti + fr, 4 * ks + fq));
          const bf16x8 bj = ldfrag(smem + G_KB + sw256(16 * tj + fr, 4 * ks + fq));
          acc = isq ? mfma16(bj, ai, acc) : mfma16(ai, bj, acc);
        }
      }
      if (isq) {
        const int i = 16 * ti + fr, j0 = 16 * tj + 4 * fq;
        const float gi = sgc[i];
        f32x4 o;
#pragma unroll
        for (int r = 0; r < 4; ++r) { const int j = j0 + r; o[r] = (j <= i) ? acc[r] * __expf(gi - sgc[j]) : 0.f; }
        *(u32x2*)(smem + G_ATT + sw128(i, j0 >> 3) + (j0 & 7) * 2) = pack4(o);
      } else {
        const int j = 16 * tj + fr, i0 = 16 * ti + 4 * fq;
        const float gj = sgc[j];
        f32x4 o;
#pragma unroll
        for (int r = 0; r < 4; ++r) { const int i = i0 + r; o[r] = (j < i) ? acc[r] * __expf(sgc[i] - gj) * sbeta[i] : 0.f; }
        *(f32x4*)(Lm + j * 64 + i0) = o;
      }
    }
  }
  {
    const float gl_ = sgc[63];
    const int d = tid & 127, tg = tid >> 7;
#pragma unroll
    for (int c = 0; c < 2; ++c) {
      float e[8];
#pragma unroll
      for (int j = 0; j < 8; ++j) { const int t = 16 * tg + 8 * c + j; e[j] = kf[t * 128 + d] * __expf(gl_ - sgc[t]); }
      u32x4 o = {pk2(e[0], e[1]), pk2(e[2], e[3]), pk2(e[4], e[5]), pk2(e[6], e[7])};
      *(u32x4*)(smem + G_KDT + sw128(d, 2 * tg + c)) = o;
    }
  }
  __syncthreads();
  if (tid < 256) {
    const bool isw = tid >= 128;
    float* X = isw ? (kf + (tid - 128)) : (vf + tid);
    unsigned char* dstT = smem + (isw ? G_WT : G_UT);
    const int rowc = tid & 127;
#pragma unroll
    for (int b = 0; b < 4; ++b) {
      float xr[16];
#pragma unroll
      for (int r = 0; r < 16; ++r) { const int t = 16 * b + r; float sc = sbeta[t]; if (isw) sc *= segc[t]; xr[r] = X[t * 128] * sc; }
#pragma unroll 2
      for (int j = 0; j < 16 * b; ++j) {
        const float xj = X[j * 128];
        const float* lt = Lm + j * 64 + 16 * b;
        const f32x4 l0 = *(const f32x4*)lt, l1 = *(const f32x4*)(lt + 4), l2 = *(const f32x4*)(lt + 8), l3 = *(const f32x4*)(lt + 12);
#pragma unroll
        for (int r = 0; r < 4; ++r) { xr[r] -= l0[r] * xj; xr[4 + r] -= l1[r] * xj; xr[8 + r] -= l2[r] * xj; xr[12 + r] -= l3[r] * xj; }
      }
#pragma unroll
      for (int q = 0; q < 15; ++q) {
        const float* lt = Lm + (16 * b + q) * 64 + 16 * b;
        float l[16];
#pragma unroll
        for (int g4 = 0; g4 < 4; ++g4) if (4 * g4 + 3 > q) { const f32x4 t4 = *(const f32x4*)(lt + 4 * g4); l[4 * g4] = t4[0]; l[4 * g4 + 1] = t4[1]; l[4 * g4 + 2] = t4[2]; l[4 * g4 + 3] = t4[3]; }
#pragma unroll
        for (int r = q + 1; r < 16; ++r) xr[r] -= l[r] * xr[q];
      }
#pragma unroll
      for (int r = 0; r < 16; ++r) X[(16 * b + r) * 128] = xr[r];
      u32x4 o0 = {pk2(xr[0], xr[1]), pk2(xr[2], xr[3]), pk2(xr[4], xr[5]), pk2(xr[6], xr[7])};
      u32x4 o1 = {pk2(xr[8], xr[9]), pk2(xr[10], xr[11]), pk2(xr[12], xr[13]), pk2(xr[14], xr[15])};
      *(u32x4*)(dstT + sw128(rowc, 2 * b)) = o0;
      *(u32x4*)(dstT + sw128(rowc, 2 * b + 1)) = o1;
    }
  }
  __syncthreads();
  {
    bf16x8 ak[2];
#pragma unroll
    for (int ks = 0; ks < 2; ++ks) ak[ks] = ldfrag(smem + G_KDT + sw128(16 * wave + fr, 4 * ks + fq));
    bf16_t* mp = (bf16_t*)(ws + O_MP) + (size_t)item * 16384;
    float* bc = (float*)(ws + O_BC) + (size_t)item * 16384;
#pragma unroll
    for (int tj = 0; tj < 8; ++tj) {
      f32x4 am = {0.f, 0.f, 0.f, 0.f}, ab_ = {0.f, 0.f, 0.f, 0.f};
#pragma unroll
      for (int ks = 0; ks < 2; ++ks) {
        const bf16x8 bw = ldfrag(smem + G_WT + sw128(16 * tj + fr, 4 * ks + fq));
        const bf16x8 bu = ldfrag(smem + G_UT + sw128(16 * tj + fr, 4 * ks + fq));
        am = mfma16(bw, ak[ks], am);
        ab_ = mfma16(ak[ks], bu, ab_);
      }
      f32x4 nm = {-am[0], -am[1], -am[2], -am[3]};
      *(u32x2*)(mp + ((size_t)((wave * 4 + (tj >> 1)) * 64 + lane)) * 8 + (tj & 1) * 4) = pack4(nm);
      *(f32x4*)(bc + ((size_t)((tj * 8 + wave) * 64 + lane)) * 4) = ab_;
    }
    const int tt = wave & 3, hf = wave >> 2;
    bf16x8 aa[2];
#pragma unroll
    for (int ks = 0; ks < 2; ++ks) aa[ks] = ldfrag(smem + G_ATT + sw128(16 * tt + fr, 4 * ks + fq));
    const int trow = 16 * tt + fr;
    const float eg = segc[trow];
    float* o0 = (float*)(ws + O_O0) + (t0 + trow) * 512 + h * 128;
    bf16_t* qp = (bf16_t*)(ws + O_QP) + (size_t)item * 8192 + trow * 128;
#pragma unroll
    for (int q = 0; q < 4; ++q) {
      const int te = hf * 4 + q;
      f32x4 ao = {0.f, 0.f, 0.f, 0.f}, aw = {0.f, 0.f, 0.f, 0.f};
#pragma unroll
      for (int ks = 0; ks < 2; ++ks) {
        const bf16x8 bu = ldfrag(smem + G_UT + sw128(16 * te + fr, 4 * ks + fq));
        const bf16x8 bw = ldfrag(smem + G_WT + sw128(16 * te + fr, 4 * ks + fq));
        ao = mfma16(bu, aa[ks], ao);
        aw = mfma16(bw, aa[ks], aw);
      }
      const int e0 = 16 * te + 4 * fq;
      *(f32x4*)(o0 + e0) = ao;
      const u32x2 qv = *(const u32x2*)(smem + G_QB + sw256(trow, e0 >> 3) + (e0 & 7) * 2);
      f32x4 qd = {lo2f(qv[0]) * eg - aw[0], hi2f(qv[0]) * eg - aw[1], lo2f(qv[1]) * eg - aw[2], hi2f(qv[1]) * eg - aw[3]};
      *(u32x2*)(qp + e0) = pack4(qd);
    }
  }
}

DI void sgu_item(const Params& p, unsigned char* smem_, int item) {
  unsigned char* smem; { LAS unsigned char* l_ = (LAS unsigned char*)smem_; asm volatile("" : "+v"(l_)); smem = (unsigned char*)l_; }
  int tid = threadIdx.x; asm volatile("" : "+v"(tid));
  const int lane = tid & 63, wave = __builtin_amdgcn_readfirstlane(tid >> 6), fr = lane & 15, fq = lane >> 4;
  unsigned char* ws; { GAS unsigned char* g_ = (GAS unsigned char*)p.ws; asm volatile("" : "+s"(g_)); ws = (unsigned char*)g_; }
  const int g = item & 3, cn = item >> 2;
  const size_t t0 = (size_t)cn * 128;
  const bf16_t* uvg = (const bf16_t*)(ws + O_UVG);
  __syncthreads();
  {
    const float* lng = p.in[I_SLNG]; const float* lnb = p.in[I_SLNB];
    const int cl0 = 8 * (lane & 15);
    float gg[8], bb[8];
#pragma unroll
    for (int e = 0; e < 8; ++e) { gg[e] = lng[128 * g + cl0 + e]; bb[e] = lnb[128 * g + cl0 + e]; }
    for (int jj = 0; jj < 16; ++jj) {
      const int j = 16 * wave + jj;
      const u32x4 raw = *(const u32x4*)(uvg + (t0 + j) * 1024 + 512 + 8 * lane);
      float v[8];
#pragma unroll
      for (int e = 0; e < 4; ++e) { v[2 * e] = lo2f(raw[e]); v[2 * e + 1] = hi2f(raw[e]); }
      float s = 0.f;
#pragma unroll
      for (int e = 0; e < 8; ++e) s += v[e];
      const float mean = wave_sum(s) * (1.f / 512.f);
      float q = 0.f;
#pragma unroll
      for (int e = 0; e < 8; ++e) { const float d = v[e] - mean; q += d * d; }
      const float rstd = rsqrtf(wave_sum(q) * (1.f / 512.f) + 1e-5f);
      if ((lane >> 4) == g) {
#pragma unroll
        for (int e = 0; e < 8; ++e) {
          const int c = cl0 + e;
          const float y = (v[e] - mean) * rstd * gg[e] + bb[e];
          *(bf16_t*)(smem + sw256(c, j >> 3) + (j & 7) * 2) = f2bf(y);
        }
      }
    }
  }
  __syncthreads();
  {
    const bf16_t* wg = (const bf16_t*)(ws + O_SGUW) + (size_t)g * 16384;
    const int i = 16 * wave + fr;
    bf16x8 af[4];
#pragma unroll
    for (int ks = 0; ks < 4; ++ks) af[ks] = ldfrag(wg + i * 128 + 32 * ks + 8 * fq);
    const float bias = p.in[I_SGUB][g * 128 + i];
    bf16_t* out = (bf16_t*)(ws + O_SGUO) + (t0 + i) * 512 + 128 * g;
    const bf16_t* urow = uvg + (t0 + i) * 1024 + 128 * g;
#pragma unroll
    for (int jt = 0; jt < 8; ++jt) {
      f32x4 acc = {0.f, 0.f, 0.f, 0.f};
#pragma unroll
      for (int ks = 0; ks < 4; ++ks) acc = mfma16(ldfrag(smem + sw256(16 * jt + fr, 4 * ks + fq)), af[ks], acc);
      const int c0 = 16 * jt + 4 * fq;
      const u32x2 uu = *(const u32x2*)(urow + c0);
      f32x4 o = {lo2f(uu[0]) * (acc[0] + bias), hi2f(uu[0]) * (acc[1] + bias), lo2f(uu[1]) * (acc[2] + bias), hi2f(uu[1]) * (acc[3] + bias)};
      *(u32x2*)(out + c0) = pack4(o);
    }
  }
}

DI void xattn_item(const Params& p, int item) {
  int tid = threadIdx.x; asm volatile("" : "+v"(tid));
  const int lane = tid & 63, wave = __builtin_amdgcn_readfirstlane(tid >> 6), fr = lane & 15, fq = lane >> 4;
  unsigned char* ws; { GAS unsigned char* g_ = (GAS unsigned char*)p.ws; asm volatile("" : "+s"(g_)); ws = (unsigned char*)g_; }
  const int h = item & 3, qt = item >> 2;
  const size_t trow = (size_t)qt * 128 + 16 * wave + fr;
  const int b = (qt * 128) >> 13;
  const bf16_t* xq = (const bf16_t*)(ws + O_XQ) + trow * 512 + h * 128;
  const bf16_t* mk = (const bf16_t*)(ws + O_MEMK) + (size_t)(b * 4 + h) * 32768;
  const bf16_t* mv = (const bf16_t*)(ws + O_MEMVT) + (size_t)(b * 4 + h) * 32768;
  bf16x8 qf[4];
#pragma unroll
  for (int ds = 0; ds < 4; ++ds) qf[ds] = ldfrag(xq + 32 * ds + 8 * fq);
  f32x4 sc[16];
#pragma unroll
  for (int kt = 0; kt < 16; ++kt) {
    f32x4 a = {0.f, 0.f, 0.f, 0.f};
#pragma unroll
    for (int ds = 0; ds < 4; ++ds) a = mfma16(ldfrag(mk + (16 * kt + fr) * 128 + 32 * ds + 8 * fq), qf[ds], a);
    sc[kt] = a;
  }
  float m = -1e30f;
#pragma unroll
  for (int kt = 0; kt < 16; ++kt)
#pragma unroll
    for (int r = 0; r < 4; ++r) m = fmaxf(m, sc[kt][r]);
  m = fmaxf(m, __shfl_xor(m, 16)); m = fmaxf(m, __shfl_xor(m, 32));
  float l = 0.f;
#pragma unroll
  for (int kt = 0; kt < 16; ++kt)
#pragma unroll
    for (int r = 0; r < 4; ++r) { const float e = __expf(sc[kt][r] - m); sc[kt][r] = e; l += e; }
  l += __shfl_xor(l, 16); l += __shfl_xor(l, 32);
  const float inv = 1.f / l;
  bf16x8 pf[8];
#pragma unroll
  for (int s = 0; s < 8; ++s) pf[s] = pack8(sc[2 * s], sc[2 * s + 1]);
  bf16_t* out = (bf16_t*)(ws + O_XATO) + trow * 512 + h * 128;
#pragma unroll
  for (int dt = 0; dt < 8; ++dt) {
    f32x4 a = {0.f, 0.f, 0.f, 0.f};
#pragma unroll
    for (int s = 0; s < 8; ++s) a = mfma16(ldfrag(mv + (16 * dt + fr) * 256 + 32 * s + 8 * fq), pf[s], a);
    f32x4 o = {a[0] * inv, a[1] * inv, a[2] * inv, a[3] * inv};
    *(u32x2*)(out + 16 * dt + 4 * fq) = pack4(o);
  }
}

DI void phase2(const Params& p, unsigned char* smem, int bid, int nb) {
  for (int rep = 0; rep < ((DUPMASK >> 20) & 1) + 1; ++rep) for (int it = bid; it < 1024; it += nb) gdn_prep_item(p, smem, it);
  for (int rep = 0; rep < ((DUPMASK >> 21) & 1) + 1; ++rep) for (int it = bid; it < 512; it += nb) sgu_item(p, smem, it);
  for (int rep = 0; rep < ((DUPMASK >> 22) & 1) + 1; ++rep) for (int it = bid; it < 512; it += nb) xattn_item(p, it);
}

DI void gdn_scan4(const Params& p, unsigned char* smem_, int bh, int es) {
  int tid = threadIdx.x; asm volatile("" : "+v"(tid));
  unsigned char* smem; { LAS unsigned char* l_ = (LAS unsigned char*)smem_; asm volatile("" : "+v"(l_)); smem = (unsigned char*)l_; }
  const int lane = tid & 63, w = __builtin_amdgcn_readfirstlane(tid >> 6);
  if (w >= 4) {
    for (int n = 0; n < 128; ++n) __builtin_amdgcn_s_barrier();
    return;
  }
  unsigned char* ws = p.ws;
  const int b = bh >> 2, h = bh & 3;
  const int fr = lane & 15, fq = lane >> 4;
  const size_t item0 = (size_t)(b * 128) * 4 + h;
  constexpr size_t ISTR = 4 * 16384;
  const bf16_t* mp = (const bf16_t*)(ws + O_MP) + item0 * 16384 + (size_t)(2 * w) * 2048 + lane * 8;
  const float* bc = (const float*)(ws + O_BC) + item0 * 16384 + (size_t)es * 2048 + (size_t)(2 * w) * 256 + lane * 4;
  bf16_t* st = (bf16_t*)(ws + O_ST) + item0 * 16384 + (size_t)(16 * es + fr) * 128 + 32 * w + 4 * fq;
  const float* glp = (const float*)(ws + O_GL) + item0;
  { GAS const float* g_ = (GAS const float*)glp; asm volatile("" : "+v"(g_)); glp = (const float*)g_; }
  f32x4 acc0 = {0.f, 0.f, 0.f, 0.f}, acc1 = {0.f, 0.f, 0.f, 0.f};
  constexpr int PD = 2;
  bf16x8 A[PD][8]; f32x4 C[PD][2]; float G[PD];
#pragma unroll
  for (int d = 0; d < PD; ++d) {
#pragma unroll
    for (int i = 0; i < 8; ++i) A[d][i] = ldfrag(mp + (size_t)d * ISTR + i * 512);
    C[d][0] = *(const f32x4*)(bc + (size_t)d * ISTR); C[d][1] = *(const f32x4*)(bc + (size_t)d * ISTR + 256);
    G[d] = glp[d * 4];
  }
  unsigned char* xch = smem;
  for (int n0 = 0; n0 < 128; n0 += PD) {
#pragma unroll
    for (int d = 0; d < PD; ++d) {
      const int n = n0 + d;
      const int np = (n + PD < 128) ? n + PD : n;
      const u32x2 lo = pack4(acc0), hi = pack4(acc1);
      bf16_t* stn = st + (size_t)n * ISTR;
      *(u32x2*)(stn) = lo; *(u32x2*)(stn + 16) = hi;
      const u32x4 mine = {lo[0], lo[1], hi[0], hi[1]};
      *(u32x4*)(xch + ((n & 1) * 4 + w) * 1024 + lane * 16) = mine;
      asm volatile("s_waitcnt lgkmcnt(0)" ::: "memory");
      __builtin_amdgcn_s_barrier();
      asm volatile("" ::: "memory");
      bf16x8 bfr[4];
#pragma unroll
      for (int s = 0; s < 4; ++s) bfr[s] = ldfrag(xch + ((n & 1) * 4 + s) * 1024 + lane * 16);
      const float g = G[d];
      f32x4 a0 = {g * acc0[0] + C[d][0][0], g * acc0[1] + C[d][0][1], g * acc0[2] + C[d][0][2], g * acc0[3] + C[d][0][3]};
      f32x4 a1 = {g * acc1[0] + C[d][1][0], g * acc1[1] + C[d][1][1], g * acc1[2] + C[d][1][2], g * acc1[3] + C[d][1][3]};
#pragma unroll
      for (int s = 0; s < 4; ++s) { a0 = mfma16(A[d][s], bfr[s], a0); a1 = mfma16(A[d][4 + s], bfr[s], a1); }
      acc0 = a0; acc1 = a1;
#pragma unroll
      for (int i = 0; i < 8; ++i) A[d][i] = ldfrag(mp + (size_t)np * ISTR + i * 512);
      C[d][0] = *(const f32x4*)(bc + (size_t)np * ISTR); C[d][1] = *(const f32x4*)(bc + (size_t)np * ISTR + 256);
      G[d] = glp[(size_t)np * 4];
    }
  }
}

struct EpiGate {
  const bf16_t* gates; int goff; const bf16_t* src; bf16_t* dst;
  DI void operator()(const f32x4 (&acc)[2][2][4][2], const pg::Unit& u, int wr, int wc, int fr, int fq) const {
#pragma unroll
    for (int ai = 0; ai < 2; ++ai)
#pragma unroll
      for (int m = 0; m < 4; ++m) {
        const size_t row = (size_t)u.pm * 256 + 128 * ai + 64 * wr + 16 * m + fr;
#pragma unroll
        for (int bj = 0; bj < 2; ++bj)
#pragma unroll
          for (int n = 0; n < 2; ++n) {
            const int col = u.pn * 256 + 128 * bj + 32 * wc + 16 * n + 4 * fq;
            const f32x4 v = acc[ai][bj][m][n];
            const u32x2 g = *(const u32x2*)(gates + row * 3072 + goff + col);
            f32x4 o = {lo2f(g[0]) * v[0], hi2f(g[0]) * v[1], lo2f(g[1]) * v[2], hi2f(g[1]) * v[3]};
            if (src) { const u32x2 s = *(const u32x2*)(src + row * 1024 + col); o[0] += lo2f(s[0]); o[1] += hi2f(s[0]); o[2] += lo2f(s[1]); o[3] += hi2f(s[1]); }
            *(u32x2*)(dst + row * 1024 + col) = pack4(o);
          }
      }
  }
};
DI void phase3(const Params& p, unsigned char* smem, int bid, int nb) {
  unsigned char* ws = p.ws;
  if (bid < 64) {
    __syncthreads();
    gdn_scan4(p, smem, bid & 7, bid >> 3);
  } else {
    PG_LAS unsigned char* lds = (PG_LAS unsigned char*)smem;
    const bf16_t* gates = (const bf16_t*)(ws + O_GATES);
    bf16_t* part = (bf16_t*)(ws + O_PART);
    __syncthreads();
    { pg::DenseOrder S; S.init(ws + O_SGUO, ws + O_WBT, T, 1024, 512, nb - 64, bid - 64); EpiGate E{gates, 1024, nullptr, part}; pg::gemm_phase<EpiGate, pg::DenseOrder, false, true>(lds, 512, S, E); }
    asm volatile("s_waitcnt vmcnt(0)" ::: "memory");
    __builtin_amdgcn_fence(__ATOMIC_ACQUIRE, "agent");
    asm volatile("s_waitcnt vmcnt(0)" ::: "memory");
    __syncthreads();
    { pg::DenseOrder S; S.init(ws + O_XATO, ws + O_WCT, T, 1024, 512, nb - 64, bid - 64); EpiGate E{gates, 2048, part, part}; pg::gemm_phase<EpiGate, pg::DenseOrder, false, true>(lds, 512, S, E); }
  }
}

DI void phase4(const Params& p, int bid, int nb) {
  int tid = threadIdx.x; asm volatile("" : "+v"(tid));
  const int lane = tid & 63, wave = tid >> 6, fr = lane & 15, fq = lane >> 4;
  unsigned char* ws = p.ws;
  for (int it = bid; it < 512; it += nb) {
    const int item = it * 2 + (wave >> 2), tt = wave & 3;
    const int h = item & 3, cn = item >> 2;
    const size_t trow = (size_t)cn * 64 + 16 * tt + fr;
    const bf16_t* qp = (const bf16_t*)(ws + O_QP) + (size_t)item * 8192 + (16 * tt + fr) * 128;
    const bf16_t* st = (const bf16_t*)(ws + O_ST) + (size_t)item * 16384;
    const float* o0 = (const float*)(ws + O_O0) + trow * 512 + h * 128;
    bf16x8 af[4];
#pragma unroll
    for (int ks = 0; ks < 4; ++ks) af[ks] = ldfrag(qp + 32 * ks + 8 * fq);
    f32x4 acc[8];
    float ss = 0.f;
#pragma unroll
    for (int j = 0; j < 8; ++j) {
      f32x4 a = *(const f32x4*)(o0 + 16 * j + 4 * fq);
#pragma unroll
      for (int ks = 0; ks < 4; ++ks) a = mfma16(ldfrag(st + (16 * j + fr) * 128 + 32 * ks + 8 * fq), af[ks], a);
      acc[j] = a;
      ss += a[0] * a[0] + a[1] * a[1] + a[2] * a[2] + a[3] * a[3];
    }
    ss += __shfl_xor(ss, 16); ss += __shfl_xor(ss, 32);
    const float rms = rsqrtf(ss * (1.f / 128.f) + 1e-6f);
    const float* ng = p.in[I_GNG];
    const bf16_t* zs = (const bf16_t*)(ws + O_ZS) + trow * 512 + h * 128;
    bf16_t* out = (bf16_t*)(ws + O_GDNO) + trow * 512 + h * 128;
#pragma unroll
    for (int j = 0; j < 8; ++j) {
      const int e0 = 16 * j + 4 * fq;
      const f32x4 g = *(const f32x4*)(ng + e0);
      const u32x2 z = *(const u32x2*)(zs + e0);
      f32x4 o = {acc[j][0] * rms * g[0] * lo2f(z[0]), acc[j][1] * rms * g[1] * hi2f(z[0]), acc[j][2] * rms * g[2] * lo2f(z[1]), acc[j][3] * rms * g[3] * hi2f(z[1])};
      *(u32x2*)(out + e0) = pack4(o);
    }
  }
}

DI void phase5(const Params& p, unsigned char* smem, int bid, int nb) {
  unsigned char* ws = p.ws;
  PG_LAS unsigned char* lds = (PG_LAS unsigned char*)smem;
  __syncthreads();
  pg::DenseOrder S; S.init(ws + O_GDNO, ws + O_WAT, T, 1024, 512, nb, bid);
  EpiGate E{(const bf16_t*)(ws + O_GATES), 0, (const bf16_t*)(ws + O_PART), (bf16_t*)(ws + O_MERGED)};
  pg::gemm_phase<EpiGate, pg::DenseOrder, false, true>(lds, 512, S, E);
}
struct EpiX1 {
  const float* x; float* x1;
  DI void operator()(const f32x4 (&acc)[2][2][4][2], const pg::Unit& u, int wr, int wc, int fr, int fq) const {
#pragma unroll
    for (int ai = 0; ai < 2; ++ai)
#pragma unroll
      for (int m = 0; m < 4; ++m) {
        const size_t row = (size_t)u.pm * 256 + 128 * ai + 64 * wr + 16 * m + fr;
#pragma unroll
        for (int bj = 0; bj < 2; ++bj)
#pragma unroll
          for (int n = 0; n < 2; ++n) {
            const int col = u.pn * 256 + 128 * bj + 32 * wc + 16 * n + 4 * fq;
            const f32x4 v = acc[ai][bj][m][n];
            const f32x4 xv = *(const f32x4*)(x + row * 1024 + col);
            f32x4 o = {ALPHA * xv[0] + v[0], ALPHA * xv[1] + v[1], ALPHA * xv[2] + v[2], ALPHA * xv[3] + v[3]};
            *(f32x4*)(x1 + row * 1024 + col) = o;
          }
      }
  }
};
DI void phase6(const Params& p, unsigned char* smem, int bid, int nb) {
  unsigned char* ws = p.ws;
  PG_LAS unsigned char* lds = (PG_LAS unsigned char*)smem;
  __syncthreads();
  pg::DenseOrder S; S.init(ws + O_MERGED, ws + O_WOT, T, 1024, 1024, nb, bid);
  EpiX1 E{p.in[I_X], (float*)(ws + O_X1)};
  pg::gemm_phase<EpiX1, pg::DenseOrder, false, false>(lds, 1024, S, E);
}

DI void ln_row(const float* src, const float* g, const float* b, float (&v)[16], int lane) {
  float s = 0.f;
#pragma unroll
  for (int i = 0; i < 16; ++i) s += v[i];
  const float mean = wave_sum(s) * (1.f / 1024.f);
  float q = 0.f;
#pragma unroll
  for (int i = 0; i < 16; ++i) { const float d = v[i] - mean; q += d * d; }
  const float rstd = rsqrtf(wave_sum(q) * (1.f / 1024.f) + 1e-5f);
#pragma unroll
  for (int i = 0; i < 4; ++i) {
    const int k = 256 * i + 4 * lane;
    const f32x4 gg = *(const f32x4*)(g + k), bb = *(const f32x4*)(b + k);
#pragma unroll
    for (int c = 0; c < 4; ++c) v[4 * i + c] = (v[4 * i + c] - mean) * rstd * gg[c] + bb[c];
  }
}
DI void phase7(const Params& p, int bid, int nb) {
  int tid = threadIdx.x; asm volatile("" : "+v"(tid));
  const int lane = tid & 63, wave = tid >> 6;
  unsigned char* ws = p.ws;
  for (int i = bid * NTHR + tid; i < MAXSLOT; i += nb * NTHR) { ((int*)(ws + O_SLOTTOK))[i] = 0; ((int*)(ws + O_SLOTAID))[i] = -1; }
  float* x1 = (float*)(ws + O_X1);
  bf16_t* x1b = (bf16_t*)(ws + O_X1B);
  for (int row = bid * 8 + wave; row < T; row += nb * 8) {
    float v[16];
#pragma unroll
    for (int i = 0; i < 4; ++i) { const f32x4 t = *(const f32x4*)(x1 + (size_t)row * D + 256 * i + 4 * lane); v[4 * i] = t[0]; v[4 * i + 1] = t[1]; v[4 * i + 2] = t[2]; v[4 * i + 3] = t[3]; }
    ln_row(nullptr, p.in[I_LN1G], p.in[I_LN1B], v, lane);
#pragma unroll
    for (int i = 0; i < 4; ++i) {
      const f32x4 o = {v[4 * i], v[4 * i + 1], v[4 * i + 2], v[4 * i + 3]};
      *(f32x4*)(x1 + (size_t)row * D + 256 * i + 4 * lane) = o;
      *(u32x2*)(x1b + (size_t)row * D + 256 * i + 4 * lane) = pack4(o);
    }
  }
}
struct EpiLogits {
  float* logits;
  DI void operator()(const f32x4 (&acc)[2][2][4][2], const pg::Unit& u, int wr, int wc, int fr, int fq) const {
#pragma unroll
    for (int ai = 0; ai < 2; ++ai)
#pragma unroll
      for (int m = 0; m < 4; ++m) {
        const size_t row = (size_t)u.pm * 256 + 128 * ai + 64 * wr + 16 * m + fr;
#pragma unroll
        for (int bj = 0; bj < 2; ++bj)
#pragma unroll
          for (int n = 0; n < 2; ++n) *(f32x4*)(logits + row * 256 + 128 * bj + 32 * wc + 16 * n + 4 * fq) = acc[ai][bj][m][n];
      }
  }
};
DI void phase8(const Params& p, unsigned char* smem, int bid, int nb) {
  unsigned char* ws = p.ws;
  PG_LAS unsigned char* lds = (PG_LAS unsigned char*)smem;
  __syncthreads();
  pg::DenseOrder S; S.init(ws + O_X1B, ws + O_ROUT, T, 256, 1024, nb, bid);
  EpiLogits E{(float*)(ws + O_LOGITS)};
  pg::gemm_phase<EpiLogits, pg::DenseOrder, false, false>(lds, 1024, S, E);
}
DI void phase9(const Params& p, int bid, int nb) {
  int tid = threadIdx.x; asm volatile("" : "+v"(tid));
  const int lane = tid & 63, wave = tid >> 6;
  unsigned char* ws = p.ws;
  const float* logits = (const float*)(ws + O_LOGITS);
  int* counts = (int*)(ws + O_CTRL);
  const f32x4 bias = *(const f32x4*)(p.in[I_RB] + 4 * lane);
  const float NEG = -__builtin_inff();
  for (int tok = bid * 8 + wave; tok < T; tok += nb * 8) {
    const f32x4 lg = *(const f32x4*)(logits + (size_t)tok * 256 + 4 * lane);
    float sc[4], mv[4];
#pragma unroll
    for (int c = 0; c < 4; ++c) { sc[c] = sigmoidf_(lg[c]); mv[c] = sc[c] + bias[c]; }
    float m1 = NEG, m2 = NEG;
#pragma unroll
    for (int c = 0; c < 4; ++c) { const float v = mv[c]; if (v > m1) { m2 = m1; m1 = v; } else if (v > m2) m2 = v; }
#pragma unroll
    for (int o = 1; o < 8; o <<= 1) {
      const float o1 = __shfl_xor(m1, o), o2 = __shfl_xor(m2, o);
      const float n1 = fmaxf(m1, o1), n2 = fmaxf(fminf(m1, o1), fmaxf(m2, o2));
      m1 = n1; m2 = n2;
    }
    const float gs = m1 + m2;
    const int g = lane >> 3;
    int rank = 0;
#pragma unroll
    for (int gg = 0; gg < 8; ++gg) { const float og = __shfl(gs, gg * 8); rank += ((og > gs) || (og == gs && gg < g)) ? 1 : 0; }
    if (rank >= 4) {
#pragma unroll
      for (int c = 0; c < 4; ++c) mv[c] = NEG;
    }
    int myidx = 0; float mysc = 0.f, ssum = 0.f;
#pragma unroll
    for (int k = 0; k < 8; ++k) {
      float bv = mv[0]; int bi = 0;
#pragma unroll
      for (int c = 1; c < 4; ++c) if (mv[c] > bv) { bv = mv[c]; bi = c; }
      float rv = bv; int ri = lane * 4 + bi;
#pragma unroll
      for (int o = 32; o; o >>= 1) {
        const float ov = __shfl_xor(rv, o); const int oi = __shfl_xor(ri, o);
        if (ov > rv || (ov == rv && oi < ri)) { rv = ov; ri = oi; }
      }
      const int wl = ri >> 2, wc = ri & 3;
      const float mine = wc == 0 ? sc[0] : wc == 1 ? sc[1] : wc == 2 ? sc[2] : sc[3];
      const float wsc = __shfl(mine, wl);
      if (lane == wl) {
#pragma unroll
        for (int c = 0; c < 4; ++c) if (c == wc) mv[c] = NEG;
      }
      ssum += wsc;
      if (lane == k) { myidx = ri; mysc = wsc; }
    }
    if (lane < 8) {
      const int pos = atomicAdd(&counts[myidx * CSTR], 1);
      ((int*)(ws + O_TKIDX))[(size_t)tok * 8 + lane] = myidx;
      ((float*)(ws + O_TKW))[(size_t)tok * 8 + lane] = mysc / ssum * 2.5f;
      ((int*)(ws + O_TKPOS))[(size_t)tok * 8 + lane] = pos;
    }
  }
}
DI void build_tile_start(const Params& p, int* ts) {
  const int tid = threadIdx.x;
  const int* counts = (const int*)(p.ws + O_CTRL);
  __syncthreads();
  if (tid < 256) ts[300 + tid] = (counts[tid * CSTR] + 127) >> 7;
  __syncthreads();
  if (tid == 0) { int s = 0; for (int e = 0; e < 256; ++e) { ts[e] = s; s += ts[300 + e]; } ts[256] = s; }
  __syncthreads();
}
DI void phase10(const Params& p, unsigned char* smem, int bid, int nb) {
  int* ts = (int*)smem;
  build_tile_start(p, ts);
  unsigned char* ws = p.ws;
  const int* tkidx = (const int*)(ws + O_TKIDX); const int* tkpos = (const int*)(ws + O_TKPOS); const float* tkw = (const float*)(ws + O_TKW);
  int* slottok = (int*)(ws + O_SLOTTOK); float* slotw = (float*)(ws + O_SLOTW); int* slotaid = (int*)(ws + O_SLOTAID);
  for (int i = bid * NTHR + threadIdx.x; i < T * 8; i += nb * NTHR) {
    const int e = tkidx[i];
    const int slot = ts[e] * 128 + tkpos[i];
    slottok[slot] = i >> 3; slotw[slot] = tkw[i]; slotaid[slot] = i;
  }
}

DI int find_expert(const int* ts, int ti) { int lo = 0, hi = 255; while (lo < hi) { const int mid = (lo + hi + 1) >> 1; if (ts[mid] <= ti) lo = mid; else hi = mid - 1; } return lo; }

struct MoeUpF {
  const int* ts; unsigned char* ws; const float* wg; const float* wu; int ntile, G, c;
  DI bool next(int i, UnitF& u) const {
    const int L = i * G + (((G & 7) == 0) ? (c & 7) * (G >> 3) + (c >> 3) : c);
    if (L >= ntile * 2) return false;
    const int pn = L / ntile, ti = L - pn * ntile;
    const int e = find_expert(ts, ti);
    u.A = (const bf16_t*)(ws + O_X1B); u.rows = (const int*)(ws + O_SLOTTOK) + ti * 128; u.m0 = ti * 128; u.pn = pn; u.e = e;
    u.W0 = (pn ? wu : wg) + (size_t)e * 262144; u.W1 = u.W0 + 128;
    return true;
  }
};
struct MoeDownF {
  const int* ts; unsigned char* ws; const float* wd; int ntile, G, c;
  DI bool next(int i, UnitF& u) const {
    const int L = i * G + (((G & 7) == 0) ? (c & 7) * (G >> 3) + (c >> 3) : c);
    if (L >= ntile * 4) return false;
    const int pn = L / ntile, ti = L - pn * ntile;
    const int e = find_expert(ts, ti);
    u.A = (const bf16_t*)(ws + O_ACT); u.rows = nullptr; u.m0 = ti * 128; u.pn = pn; u.e = e;
    u.W0 = wd + (size_t)e * 262144 + 256 * pn; u.W1 = u.W0 + 128;
    return true;
  }
};
struct EpiActF {
  bf16_t* gu;
  struct Pre { int dummy; };
  DI void prefetch(const UnitF&, int, int, Pre& p) const { p.dummy = 0; }
  DI void operator()(const f32x4 (&acc)[4][4], const UnitF& u, int wr, int wc, int fr, int fq, const Pre&) const {
#pragma unroll
    for (int m = 0; m < 4; ++m) {
      const size_t row = (size_t)u.m0 + 64 * wr + 16 * m + fr;
#pragma unroll
      for (int r = 0; r < 4; ++r) {
        f32x4 o = {acc[m][0][r], acc[m][1][r], acc[m][2][r], acc[m][3][r]};
        if (u.pn == 0) { o[0] = siluf_(o[0]); o[1] = siluf_(o[1]); o[2] = siluf_(o[2]); o[3] = siluf_(o[3]); }
        *(u32x2*)(gu + row * 512 + 256 * u.pn + 64 * wc + 16 * fq + 4 * r) = pack4(o);
      }
    }
  }
};
struct EpiDownF {
  const int* slotaid; const float* slotw; unsigned char* ybase;
  struct Pre { int aid[4]; float ww[4]; };
  DI void prefetch(const UnitF& u, int wr, int fr, Pre& p) const {
    const unsigned slot0 = (unsigned)u.m0 + 64u * wr + fr;
#pragma unroll
    for (int m = 0; m < 4; ++m) { p.aid[m] = slotaid[slot0 + 16u * m]; p.ww[m] = slotw[slot0 + 16u * m]; }
  }
  DI void operator()(const f32x4 (&acc)[4][4], const UnitF& u, int wr, int wc, int fr, int fq, const Pre& p) const {
    const unsigned colb = ((unsigned)u.pn * 256u + 64u * wc + 16u * fq) * 2u;
#pragma unroll
    for (int m = 0; m < 4; ++m) {
      if (p.aid[m] >= 0) {
        const unsigned off = (unsigned)p.aid[m] * 2048u + colb;
#pragma unroll
        for (int r = 0; r < 4; ++r) {
          f32x4 o = {acc[m][0][r] * p.ww[m], acc[m][1][r] * p.ww[m], acc[m][2][r] * p.ww[m], acc[m][3][r] * p.ww[m]};
          *(u32x2*)(ybase + (size_t)(off + (unsigned)(8 * r))) = pack4(o);
        }
      }
    }
  }
};
struct EpiAct {
  bf16_t* actp;
  DI void operator()(const f32x4 (&acc)[2][2][4][2], const pg::Unit& u, int wr, int wc, int fr, int fq) const {
#pragma unroll
    for (int ai = 0; ai < 2; ++ai)
#pragma unroll
      for (int m = 0; m < 4; ++m) {
        const size_t row = (size_t)u.pm * 256 + 128 * ai + 64 * wr + 16 * m + fr;
#pragma unroll
        for (int bj = 0; bj < 2; ++bj) {
          const int blk = 8 * u.pn + 4 * bj + wc;
          const f32x4 g = acc[ai][bj][m][0], uu = acc[ai][bj][m][1];
          f32x4 o = {siluf_(g[0]) * uu[0], siluf_(g[1]) * uu[1], siluf_(g[2]) * uu[2], siluf_(g[3]) * uu[3]};
          *(u32x2*)(actp + row * 256 + blk * 16 + 4 * fq) = pack4(o);
        }
      }
  }
};
struct EpiBf16Out {
  bf16_t* dst;
  DI void operator()(const f32x4 (&acc)[2][2][4][2], const pg::Unit& u, int wr, int wc, int fr, int fq) const {
#pragma unroll
    for (int ai = 0; ai < 2; ++ai)
#pragma unroll
      for (int m = 0; m < 4; ++m) {
        const size_t row = (size_t)u.pm * 256 + 128 * ai + 64 * wr + 16 * m + fr;
#pragma unroll
        for (int bj = 0; bj < 2; ++bj)
#pragma unroll
          for (int n = 0; n < 2; ++n) *(u32x2*)(dst + row * 1024 + u.pn * 256 + 128 * bj + 32 * wc + 16 * n + 4 * fq) = pack4(acc[ai][bj][m][n]);
      }
  }
};
DI void phase11(const Params& p, unsigned char* smem, int bid, int nb) {
  unsigned char* ws = p.ws;
  int* ts = (int*)(smem + 131072);
  build_tile_start(p, ts);
  { MoeUpF S{ts, ws, p.in[I_WG], p.in[I_WU], ts[256], nb, bid}; EpiActF E{(bf16_t*)(ws + O_ACT)}; gemmF_phase<false, EpiActF, MoeUpF>(smem, 1024, 1024, 256, S, E); }
  __syncthreads();
  PG_LAS unsigned char* lds = (PG_LAS unsigned char*)smem;
  { pg::DenseOrder S; S.init(ws + O_X1B, ws + O_WSGU, T, 512, 1024, nb, bid); EpiAct E{(bf16_t*)(ws + O_ACTSH)}; pg::gemm_phase<EpiAct, pg::DenseOrder, false, true>(lds, 1024, S, E); }
}
DI void phase12(const Params& p, unsigned char* smem, int bid, int nb) {
  unsigned char* ws = p.ws;
  int* ts = (int*)(smem + 131072);
  build_tile_start(p, ts);
  { MoeDownF S{ts, ws, p.in[I_WDN], ts[256], nb, bid}; EpiDownF E{(const int*)(ws + O_SLOTAID), (const float*)(ws + O_SLOTW), ws + O_Y}; gemmF_phase<true, EpiDownF, MoeDownF>(smem, 256, 512, 1024, S, E); }
  __syncthreads();
  PG_LAS unsigned char* lds = (PG_LAS unsigned char*)smem;
  { pg::DenseOrder S; S.init(ws + O_ACTSH, ws + O_WSD, T, 1024, 256, nb, bid); EpiBf16Out E{(bf16_t*)(ws + O_YSH)}; pg::gemm_phase<EpiBf16Out, pg::DenseOrder, false, true>(lds, 256, S, E); }
}
DI void phase13(const Params& p, int bid, int nb) {
  int tid = threadIdx.x; asm volatile("" : "+v"(tid));
  const int lane = tid & 63, wave = tid >> 6;
  unsigned char* ws = p.ws;
  const float* x1 = (const float*)(ws + O_X1);
  const bf16_t* ysh = (const bf16_t*)(ws + O_YSH);
  const bf16_t* y = (const bf16_t*)(ws + O_Y);
  for (int row = bid * 8 + wave; row < T; row += nb * 8) {
    float v[16];
#pragma unroll
    for (int i = 0; i < 4; ++i) {
      const int k = 256 * i + 4 * lane;
      const f32x4 t = *(const f32x4*)(x1 + (size_t)row * D + k);
      const u32x2 s = *(const u32x2*)(ysh + (size_t)row * D + k);
      v[4 * i] = ALPHA * t[0] + lo2f(s[0]); v[4 * i + 1] = ALPHA * t[1] + hi2f(s[0]); v[4 * i + 2] = ALPHA * t[2] + lo2f(s[1]); v[4 * i + 3] = ALPHA * t[3] + hi2f(s[1]);
    }
#pragma unroll
    for (int k8 = 0; k8 < 8; ++k8) {
#pragma unroll
      for (int i = 0; i < 4; ++i) {
        const u32x2 s = *(const u32x2*)(y + ((size_t)row * 8 + k8) * 1024 + 256 * i + 4 * lane);
        v[4 * i] += lo2f(s[0]); v[4 * i + 1] += hi2f(s[0]); v[4 * i + 2] += lo2f(s[1]); v[4 * i + 3] += hi2f(s[1]);
      }
    }
    ln_row(nullptr, p.in[I_LN2G], p.in[I_LN2B], v, lane);
#pragma unroll
    for (int i = 0; i < 4; ++i) { const f32x4 o = {v[4 * i], v[4 * i + 1], v[4 * i + 2], v[4 * i + 3]}; *(f32x4*)(p.out + (size_t)row * D + 256 * i + 4 * lane) = o; }
  }
}

DI void load_params(Params& lp, const unsigned char* smem) {
  const unsigned* t = (const unsigned*)(smem + PTAB_OFF);
#pragma unroll
  for (int i = 0; i < 28; ++i) lp.in[i] = (const float*)(GAS const float*)(((unsigned long long)(unsigned)__builtin_amdgcn_readfirstlane((int)t[2 * i + 1]) << 32) | (unsigned)__builtin_amdgcn_readfirstlane((int)t[2 * i]));
  lp.out = (float*)(GAS float*)(((unsigned long long)(unsigned)__builtin_amdgcn_readfirstlane((int)t[57]) << 32) | (unsigned)__builtin_amdgcn_readfirstlane((int)t[56]));
  lp.ws = (unsigned char*)(GAS unsigned char*)(((unsigned long long)(unsigned)__builtin_amdgcn_readfirstlane((int)t[59]) << 32) | (unsigned)__builtin_amdgcn_readfirstlane((int)t[58]));
}
__global__ void __launch_bounds__(NTHR) mega_kernel(Params pk) {
  extern __shared__ __attribute__((aligned(16))) unsigned char smem[];
  cg::grid_group grid = cg::this_grid();
  const int bid = blockIdx.x, nb = gridDim.x;
  volatile LAS unsigned* bst = (volatile LAS unsigned*)(smem + LDS_BYTES - 16);
  if (threadIdx.x < 4) bst[threadIdx.x] = 0u;
  if (threadIdx.x < 30) {
    const __attribute__((address_space(4))) unsigned long long* ka = (const __attribute__((address_space(4))) unsigned long long*)__builtin_amdgcn_kernarg_segment_ptr();
    ((unsigned long long*)(smem + PTAB_OFF))[threadIdx.x] = ka[threadIdx.x];
  }
  unsigned* barw = (unsigned*)(pk.ws + O_BAR);
  __syncthreads();
  XcdBarrier xb = xcd_barrier_post(barw, bst);
#define GSYNC() xcd_barrier(xb)
#define RUNP(k, call) do { { Params p; load_params(p, smem); call; } GSYNC(); if (DUPMASK & (1 << (k))) { { Params p; load_params(p, smem); call; } GSYNC(); } } while (0)
  { Params p; load_params(p, smem); phase0(p, smem, bid, nb); } grid.sync();
  RUNP(1, phase1(p, smem, bid, nb));
  RUNP(2, phase2(p, smem, bid, nb));
  RUNP(3, phase3(p, smem, bid, nb));
  RUNP(4, phase4(p, bid, nb));
  RUNP(5, phase5(p, smem, bid, nb));
  RUNP(6, phase6(p, smem, bid, nb));
  RUNP(14, phase7(p, bid, nb));
  if (DUPMASK & (1 << 7)) { { Params p; load_params(p, smem); phase6(p, smem, bid, nb); } GSYNC(); { Params p; load_params(p, smem); phase7(p, bid, nb); } GSYNC(); }
  RUNP(8, phase8(p, smem, bid, nb));
  RUNP(14, phase9(p, bid, nb));
  if (DUPMASK & (1 << 9)) { { Params p; load_params(p, smem); if (bid == 0 && threadIdx.x < 256) ((int*)(p.ws + O_CTRL))[threadIdx.x * CSTR] = 0; } GSYNC(); { Params p; load_params(p, smem); phase9(p, bid, nb); } GSYNC(); }
  RUNP(10, phase10(p, smem, bid, nb));
  RUNP(11, phase11(p, smem, bid, nb));
  RUNP(12, phase12(p, smem, bid, nb));
  { Params p; load_params(p, smem); phase13(p, bid, nb); }
  if (DUPMASK & (1 << 13)) { GSYNC(); Params p; load_params(p, smem); phase13(p, bid, nb); }
  if (DUPMASK & (1 << 15)) { for (int i = 0; i < 10; ++i) GSYNC(); }
}

extern "C" void kernel_launch(void* const* d_in, const int* in_sizes, int n_in, void* d_out, int out_size, void* d_ws, size_t ws_size, hipStream_t stream) {
  if (n_in != 28 || ws_size < WS_NEED) { fprintf(stderr, "kernel_launch: unexpected inputs (%d) or workspace (%zu < %zu)\n", n_in, ws_size, (size_t)WS_NEED); return; }
  static int grid_blocks = 0;
  if (!grid_blocks) {
    int dev = 0, cus = 0, per_cu = 0;
    (void)hipGetDevice(&dev);
    (void)hipDeviceGetAttribute(&cus, hipDeviceAttributeMultiprocessorCount, dev);
    (void)hipFuncSetAttribute((const void*)mega_kernel, hipFuncAttributeMaxDynamicSharedMemorySize, LDS_BYTES);
    (void)hipOccupancyMaxActiveBlocksPerMultiprocessor(&per_cu, (const void*)mega_kernel, NTHR, LDS_BYTES);
    if (per_cu < 1) per_cu = 1;
    if (per_cu > 1) per_cu = 1;
    grid_blocks = cus * per_cu;
    if (grid_blocks < 32) grid_blocks = 32;
  }
  Params p{};
  for (int i = 0; i < 28; ++i) p.in[i] = (const float*)d_in[i];
  p.out = (float*)d_out; p.ws = (unsigned char*)d_ws;
  (void)hipMemsetAsync((unsigned char*)d_ws + O_BAR, 0, XCD_BAR_WORDS * 4, stream);
  void* args[] = {&p};
  hipError_t e = hipLaunchCooperativeKernel((const void*)mega_kernel, dim3(grid_blocks), dim3(NTHR), args, LDS_BYTES, stream);
  if (e != hipSuccess) fprintf(stderr, "cooperative launch failed: %s (grid %d)\n", hipGetErrorString(e), grid_blocks);
}
```

```cpp
#include <hip/hip_runtime.h>
#include <hip/hip_cooperative_groups.h>
#include <stdint.h>
#include <stdio.h>
namespace cg = cooperative_groups;

#define DI __device__ __forceinline__
#define LAS __attribute__((address_space(3)))
#define GAS __attribute__((address_space(1)))
typedef unsigned short bf16_t;
typedef short bf16x8 __attribute__((ext_vector_type(8)));
typedef float f32x4 __attribute__((ext_vector_type(4)));
typedef unsigned u32x4 __attribute__((ext_vector_type(4)));
typedef unsigned u32x2 __attribute__((ext_vector_type(2)));

#ifndef DUPMASK
#define DUPMASK 0
#endif
constexpr int NTHR = 512;
constexpr int T = 16384, SEQ = 8192, D = 1024;
constexpr int NPROJ = 6656;
constexpr int DIN = 6664;
constexpr int NEXP = 256, DEXP = 256;
constexpr int MAXSLOT = 131072 + 256 * 128;
constexpr float ALPHA = 1.189207115002721f;
constexpr int LDS_BYTES = 157696;

constexpr size_t MB = 1u << 20;
constexpr size_t O_WGU = 0;
constexpr size_t O_WD = 256 * MB;
constexpr size_t O_WSGU = 384 * MB;
constexpr size_t O_WSD = 385 * MB;
constexpr size_t O_ROUT = 385 * MB + 512 * 1024;
constexpr size_t O_CTRL = 386 * MB;
constexpr size_t O_BAR = 386 * MB + 128 * 1024;
constexpr int CSTR = 64;
constexpr size_t O_IDENT = 386 * MB + 256 * 1024;
constexpr size_t O_X1 = 387 * MB;
constexpr size_t O_X1B = 451 * MB;
constexpr size_t R0 = 483 * MB;
constexpr size_t O_XB = R0 + 0;
constexpr size_t O_ST = R0 + 0;
constexpr size_t O_WINT = R0 + 32 * MB;
constexpr size_t O_WAT = R0 + 45 * MB;
constexpr size_t O_WBT = R0 + 46 * MB;
constexpr size_t O_WCT = R0 + 47 * MB;
constexpr size_t O_WOT = R0 + 48 * MB;
constexpr size_t O_WMKV = R0 + 50 * MB;
constexpr size_t O_MEMB = R0 + 52 * MB;
constexpr size_t O_SGUW = R0 + 53 * MB;
constexpr size_t O_AB = R0 + 53 * MB + 512 * 1024;
constexpr size_t O_MEMK = R0 + 54 * MB;
constexpr size_t O_MEMVT = R0 + 54 * MB + 512 * 1024;
constexpr size_t O_QKV = R0 + 55 * MB;
constexpr size_t O_PART = R0 + 55 * MB;
constexpr size_t O_ZS = R0 + 103 * MB;
constexpr size_t O_UVG = R0 + 119 * MB;
constexpr size_t O_MERGED = R0 + 119 * MB;
constexpr size_t O_XQ = R0 + 151 * MB;
constexpr size_t O_GATES = R0 + 167 * MB;
constexpr size_t O_MP = R0 + 263 * MB;
constexpr size_t O_BC = R0 + 295 * MB;
constexpr size_t O_O0 = R0 + 359 * MB;
constexpr size_t O_QP = R0 + 391 * MB;
constexpr size_t O_GL = R0 + 407 * MB;
constexpr size_t O_GDNO = R0 + 408 * MB;
constexpr size_t O_SGUO = R0 + 424 * MB;
constexpr size_t O_XATO = R0 + 440 * MB;
constexpr size_t O_LOGITS = R0 + 0;
constexpr size_t O_TKIDX = R0 + 16 * MB;
constexpr size_t O_TKW = R0 + 16 * MB + 512 * 1024;
constexpr size_t O_TKPOS = R0 + 17 * MB;
constexpr size_t O_SLOTTOK = R0 + 18 * MB;
constexpr size_t O_SLOTW = R0 + 19 * MB;
constexpr size_t O_SLOTAID = R0 + 20 * MB;
constexpr size_t O_ACT = R0 + 21 * MB;
constexpr size_t O_ACTSH = R0 + 181 * MB;
constexpr size_t O_YSH = R0 + 189 * MB;
constexpr size_t O_Y = R0 + 221 * MB;
constexpr size_t WS_NEED = R0 + 477 * MB;

struct Params {
  const float* in[28];
  float* out;
  unsigned char* ws;
};
enum { I_X = 0, I_MEM, I_WIN, I_CONVW, I_ALOG, I_DTB, I_GNG, I_WA, I_SLNG, I_SLNB, I_SGUW, I_SGUB, I_WB, I_WMKV, I_WC, I_WO,
       I_LN1G, I_LN1B, I_RW, I_RB, I_WG, I_WU, I_WDN, I_WSG, I_WSU, I_WSD, I_LN2G, I_LN2B };

constexpr int PTAB_OFF = 156672;
DI float bf2f(bf16_t h) { return __uint_as_float(((unsigned)h) << 16); }
DI bf16_t f2bf(float f) { unsigned u = __float_as_uint(f); u += 0x7fffu + ((u >> 16) & 1u); return (bf16_t)(u >> 16); }
typedef float f32x2_ __attribute__((ext_vector_type(2)));
typedef __bf16 bf16x2_ __attribute__((ext_vector_type(2)));
DI unsigned pk2(float lo, float hi) { f32x2_ v = {lo, hi}; return __builtin_bit_cast(unsigned, __builtin_convertvector(v, bf16x2_)); }
DI float lo2f(unsigned u) { return __uint_as_float(u << 16); }
DI float hi2f(unsigned u) { return __uint_as_float(u & 0xffff0000u); }
DI float sigmoidf_(float x) { return 1.f / (1.f + __expf(-x)); }
DI float siluf_(float x) { return x / (1.f + __expf(-x)); }
DI float geluf_(float x) { float u = 0.7978845608028654f * (x + 0.044715f * x * x * x); float t = 1.f - 2.f / (__expf(2.f * u) + 1.f); return 0.5f * x * (1.f + t); }
DI float softplusf_(float x) { return fmaxf(x, 0.f) + log1pf(__expf(-fabsf(x))); }
DI float wave_sum(float v) {
#pragma unroll
  for (int o = 32; o; o >>= 1) v += __shfl_xor(v, o);
  return v;
}
DI f32x4 mfma16(bf16x8 a, bf16x8 b, f32x4 c) { return __builtin_amdgcn_mfma_f32_16x16x32_bf16(a, b, c, 0, 0, 0); }
DI bf16x8 ldfrag(const void* p) { return __builtin_bit_cast(bf16x8, *(const u32x4*)p); }
DI bf16x8 pack8(f32x4 a, f32x4 b) { u32x4 r = {pk2(a[0], a[1]), pk2(a[2], a[3]), pk2(b[0], b[1]), pk2(b[2], b[3])}; return __builtin_bit_cast(bf16x8, r); }
DI u32x2 pack4(f32x4 a) { u32x2 r = {pk2(a[0], a[1]), pk2(a[2], a[3])}; return r; }
DI int sw128(int row, int chunk) { return row * 128 + ((chunk ^ (row & 7)) << 4); }
DI int sw256(int row, int chunk) { return row * 256 + ((chunk ^ (row & 15)) << 4); }

namespace pg {
#define PG_LAS __attribute__((address_space(3)))
constexpr int BM = 256, BK = 64, HALF = 128, HTB = HALF * BK * 2, NXCD = 8, WGM = 8;
DI int lds_byte(int r, int c) { const int st = (r >> 4) * 2 + (c >> 5), rr = r & 15, cc = c & 31, ob = rr * 64 + cc * 2; return st * 1024 + (ob ^ (((ob >> 9) & 1) << 5)); }
DI void stage_rc(int b, int& R, int& C) { const int st = b / 1024, sb = b % 1024, swz = sb ^ (((sb >> 9) & 1) << 5); R = (st >> 1) * 16 + swz / 64; C = (st & 1) * 32 + (swz % 64) / 2; }

struct Unit { const char* a; const char* b; const int* rows; int pm, pn, e; };

struct DenseOrder {
  const char* A; const char* B; int nM, nN, nwg, G, c; size_t tstep;
  DI void init(const void* A_, const void* B_, int M, int N, int K, int G_, int c_) { A = (const char*)A_; B = (const char*)B_; nM = M / BM; nN = N / BM; nwg = nM * nN; G = G_; c = c_; tstep = (size_t)BM * K * 2; }
  DI bool next(int i, Unit& u) const {
    const long L = (long)i * G + c; if (L >= nwg) return false;
    int wgid = (int)L; { const int q = nwg / NXCD, r = nwg % NXCD, xcd = wgid % NXCD, off = wgid / NXCD; wgid = (xcd < r ? xcd * (q + 1) : r * (q + 1) + (xcd - r) * q) + off; }
    const int nig = WGM * nN, gid = wgid / nig, fm = gid * WGM, gsz = (nM - fm) < WGM ? (nM - fm) : WGM;
    u.pm = fm + ((wgid % nig) % gsz); u.pn = (wgid % nig) / gsz; u.e = 0; u.rows = nullptr;
    u.a = A + (size_t)u.pm * tstep; u.b = B + (size_t)u.pn * tstep; return true;
  }
};

template <class Epi, class Sched, bool GATHER, bool ALIGN_EPI>
DI void gemm_phase(PG_LAS unsigned char* lds, const int K, const Sched& S, const Epi& E) {
  int tid = threadIdx.x; asm volatile("" : "+v"(tid));
  const int wid = __builtin_amdgcn_readfirstlane(tid >> 6), lane = tid & 63, wr = wid >> 2, wc = wid & 3, fr = lane & 15, fq = lane >> 4;
  const int nt = K / BK;
  int Rr[2], Cc[2];
  unsigned voffB[2];
#pragma unroll
  for (int i = 0; i < 2; ++i) { stage_rc(tid * 16 + i * 8192, Rr[i], Cc[i]); voffB[i] = (unsigned)(Rr[i] * K + Cc[i]) * 2u; }
  const size_t kstep = (size_t)(BK * 2);
  const size_t hstep = (size_t)HALF * K * 2;
  const unsigned ldsw = (unsigned)wid * 1024u;
  const int aoff = lds_byte(wr * 64 + fr, fq * 8), boff = lds_byte(wc * 32 + fr, fq * 8);
#define PG_SA(b, h) (((b) * 2 + (h)) * HTB)
#define PG_SB(b, h) ((4 + (b) * 2 + (h)) * HTB)
#define PG_STAGE(bufoff, gbase, v0, v1) do { \
    __builtin_amdgcn_global_load_lds((const unsigned*)((const char*)(gbase) + (v0)), (PG_LAS unsigned*)(lds + (bufoff) + ldsw), 16, 0, 0); \
    __builtin_amdgcn_global_load_lds((const unsigned*)((const char*)(gbase) + (v1)), (PG_LAS unsigned*)(lds + (bufoff) + ldsw + 8192), 16, 0, 0); } while (0)
#define PG_LDA(dst, b, h) do { _Pragma("unroll") for (int m = 0; m < 4; ++m) _Pragma("unroll") for (int k = 0; k < 2; ++k) dst[m][k] = *(const PG_LAS bf16x8*)(lds + PG_SA(b, h) + aoff + m * 2048 + k * 1024); } while (0)
#define PG_LDB(dst, b, h) do { _Pragma("unroll") for (int n = 0; n < 2; ++n) _Pragma("unroll") for (int k = 0; k < 2; ++k) dst[n][k] = *(const PG_LAS bf16x8*)(lds + PG_SB(b, h) + boff + n * 2048 + k * 1024); } while (0)
#define PG_MMA(ai, bj, At, Bt) do { __builtin_amdgcn_s_setprio(1); _Pragma("unroll") for (int m = 0; m < 4; ++m) _Pragma("unroll") for (int n = 0; n < 2; ++n) _Pragma("unroll") for (int k = 0; k < 2; ++k) \
    acc[ai][bj][m][n] = __builtin_amdgcn_mfma_f32_16x16x32_bf16(Bt[n][k], At[m][k], acc[ai][bj][m][n], 0, 0, 0); __builtin_amdgcn_s_setprio(0); } while (0)
#define PG_WAIT_V(n) asm volatile("s_waitcnt vmcnt(" #n ")" ::: "memory")
#define PG_WAIT_L(n) asm volatile("s_waitcnt lgkmcnt(" #n ")" ::: "memory")
#define PG_BAR __builtin_amdgcn_s_barrier()
#define PG_SCHED __builtin_amdgcn_sched_barrier(0)
#define PG_AOFFS(u, o00, o01, o10, o11) do { if (GATHER) { \
      o00 = (unsigned)(u).rows[Rr[0]] * (unsigned)(K * 2) + (unsigned)Cc[0] * 2u; o01 = (unsigned)(u).rows[Rr[1]] * (unsigned)(K * 2) + (unsigned)Cc[1] * 2u; \
      o10 = (unsigned)(u).rows[128 + Rr[0]] * (unsigned)(K * 2) + (unsigned)Cc[0] * 2u; o11 = (unsigned)(u).rows[128 + Rr[1]] * (unsigned)(K * 2) + (unsigned)Cc[1] * 2u; \
    } else { o00 = voffB[0]; o01 = voffB[1]; o10 = voffB[0] + (unsigned)hstep; o11 = voffB[1] + (unsigned)hstep; } } while (0)
  Unit cur, nxt; int ui = 0;
  if (!S.next(0, cur)) return;
  f32x4 acc[2][2][4][2];
#pragma unroll
  for (int a = 0; a < 2; ++a)
#pragma unroll
    for (int b = 0; b < 2; ++b)
#pragma unroll
      for (int m = 0; m < 4; ++m)
#pragma unroll
        for (int n = 0; n < 2; ++n) acc[a][b][m][n] = (f32x4){0.f, 0.f, 0.f, 0.f};
  bf16x8 At[4][2], B0[2][2], B1[2][2];
  const char* cA = cur.a; const char* cB = cur.b;
  unsigned c00, c01, c10, c11;
  PG_AOFFS(cur, c00, c01, c10, c11);
  const unsigned vb0 = voffB[0], vb1 = voffB[1];
  PG_STAGE(PG_SB(0, 0), cB, vb0, vb1); PG_STAGE(PG_SB(0, 1), cB + hstep, vb0, vb1); PG_STAGE(PG_SA(0, 0), cA, c00, c01); PG_STAGE(PG_SA(0, 1), cA, c10, c11);
  if (wr == 1) PG_BAR;
  PG_WAIT_V(2); PG_BAR;
  PG_STAGE(PG_SB(1, 0), cB + kstep, vb0, vb1); PG_STAGE(PG_SA(1, 0), cA + kstep, c00, c01); PG_STAGE(PG_SB(1, 1), cB + hstep + kstep, vb0, vb1);
  PG_WAIT_V(6); PG_BAR;
  for (;;) {
    const bool has_next = S.next(ui + 1, nxt);
    const char* nA = has_next ? nxt.a : cA; const char* nB = has_next ? nxt.b : cB;
    unsigned n00 = c00, n01 = c01, n10 = c10, n11 = c11;
    if (has_next) PG_AOFFS(nxt, n00, n01, n10, n11);
#pragma unroll 1
    for (int t = 0; t < nt; t += 2) {
      const bool last = (t == nt - 2);
      const char* a1 = cA + (size_t)(t + 1) * kstep;
      const char* a2 = last ? nA : cA + (size_t)(t + 2) * kstep; const char* b2 = last ? nB : cB + (size_t)(t + 2) * kstep;
      const char* a3 = a2 + kstep; const char* b3 = b2 + kstep;
      const unsigned o00 = last ? n00 : c00, o01 = last ? n01 : c01, o10 = last ? n10 : c10, o11 = last ? n11 : c11;
      PG_LDB(B0, 0, 0); PG_LDB(B1, 0, 1); PG_SCHED; PG_LDA(At, 0, 0); PG_STAGE(PG_SA(1, 1), a1, c10, c11);
      PG_WAIT_V(8); PG_WAIT_L(0); PG_BAR; PG_MMA(0, 0, At, B0); PG_MMA(0, 1, At, B1); PG_BAR; PG_SCHED;
      PG_LDA(At, 0, 1); PG_STAGE(PG_SB(0, 0), b2, vb0, vb1); PG_STAGE(PG_SB(0, 1), b2 + hstep, vb0, vb1); PG_STAGE(PG_SA(0, 0), a2, o00, o01);
      PG_WAIT_V(8); PG_WAIT_L(0); PG_BAR; PG_MMA(1, 0, At, B0); PG_MMA(1, 1, At, B1); PG_BAR; PG_SCHED;
      PG_LDB(B0, 1, 0); PG_LDB(B1, 1, 1); PG_SCHED; PG_LDA(At, 1, 0); PG_STAGE(PG_SA(0, 1), a2, o10, o11);
      PG_WAIT_V(8); PG_WAIT_L(0); PG_BAR; PG_MMA(0, 0, At, B0); PG_MMA(0, 1, At, B1); PG_BAR; PG_SCHED;
      PG_LDA(At, 1, 1); PG_STAGE(PG_SB(1, 0), b3, vb0, vb1); PG_STAGE(PG_SB(1, 1), b3 + hstep, vb0, vb1); PG_STAGE(PG_SA(1, 0), a3, o00, o01);
      PG_WAIT_V(8); PG_WAIT_L(0); PG_BAR; PG_MMA(1, 0, At, B0); PG_MMA(1, 1, At, B1); PG_BAR; PG_SCHED;
    }
    if constexpr (ALIGN_EPI) { if (wr == 0) PG_BAR; }
    E(acc, cur, wr, wc, fr, fq);
    if (!has_next) break;
#pragma unroll
    for (int a = 0; a < 2; ++a)
#pragma unroll
      for (int b = 0; b < 2; ++b)
#pragma unroll
        for (int m = 0; m < 4; ++m)
#pragma unroll
          for (int n = 0; n < 2; ++n) acc[a][b][m][n] = (f32x4){0.f, 0.f, 0.f, 0.f};
    cur = nxt; cA = nA; cB = nB; c00 = n00; c01 = n01; c10 = n10; c11 = n11; ++ui;
    if constexpr (ALIGN_EPI) { if (wr == 1) PG_BAR; }
  }
  PG_WAIT_V(0);
  if constexpr (!ALIGN_EPI) { if (wr == 0) PG_BAR; }
  PG_BAR;
#undef PG_SA
#undef PG_SB
#undef PG_STAGE
#undef PG_LDA
#undef PG_LDB
#undef PG_MMA
#undef PG_WAIT_V
#undef PG_WAIT_L
#undef PG_BAR
#undef PG_SCHED
#undef PG_AOFFS
}
}


struct UnitF { const bf16_t* A; const int* rows; const float* W0; const float* W1; int m0, pn, e; };

template <bool AMUL, class Epi, class Sched, int ABL = 0>
DI void gemmF_phase(unsigned char* smem_, const int K, const int lda, const int ldw, const Sched& S, const Epi& E) {
  int tid = threadIdx.x; asm volatile("" : "+v"(tid));
  unsigned char* smem; { LAS unsigned char* l_ = (LAS unsigned char*)smem_; asm volatile("" : "+v"(l_)); smem = (unsigned char*)l_; }
  const int lane = tid & 63, wid = tid >> 6, wr = wid >> 2, wc = wid & 3, fr = lane & 15, fq = lane >> 4;
  const int nk = K >> 6;
  const int ar0 = tid >> 3, ac = tid & 7;
  const int q = tid & 63, half = q >> 5, g0 = 4 * (q & 31);
  int vrow[4];
#pragma unroll
  for (int i = 0; i < 4; ++i) vrow[i] = 64 * (q >> 4) + 16 * i + (q & 15);
  const int aw0 = sw128(ar0, ac), aw1 = sw128(ar0 + 64, ac);
#define F_ROWS(u, rr0, rr1) do { rr0 = (u).rows ? (size_t)(u).rows[ar0] : (size_t)((u).m0 + ar0); rr1 = (u).rows ? (size_t)(u).rows[ar0 + 64] : (size_t)((u).m0 + ar0 + 64); } while (0)
#define F_LOAD(A_, W0_, W1_, rr0_, rr1_, kk_, va0, va1, vb0, vb1, vw) do { \
    va0 = *(const u32x4*)((A_) + (rr0_) * lda + (kk_) * 64 + ac * 8); va1 = *(const u32x4*)((A_) + (rr1_) * lda + (kk_) * 64 + ac * 8); \
    if (AMUL) { vb0 = *(const u32x4*)((A_) + (rr0_) * lda + 256 + (kk_) * 64 + ac * 8); vb1 = *(const u32x4*)((A_) + (rr1_) * lda + 256 + (kk_) * 64 + ac * 8); } \
    const float* wp_ = (half ? (W1_) : (W0_)) + (size_t)((kk_) * 64 + 8 * wid) * ldw + g0; \
    if (ABL != 1) { _Pragma("unroll") for (int j = 0; j < 8; ++j) vw[j] = *(const f32x4*)(wp_ + (size_t)j * ldw); } } while (0)
#define F_LOADX(kx, va0, va1, vb0, vb1, vw) do { const bool nx_ = (kx) >= nk; const int kk2_ = nx_ ? (kx) - nk : (kx); \
    const bf16_t* A2_ = nx_ ? nxt.A : cur.A; const float* W02_ = nx_ ? nxt.W0 : cur.W0; const float* W12_ = nx_ ? nxt.W1 : cur.W1; \
    const size_t q0_ = nx_ ? nr0 : r0, q1_ = nx_ ? nr1 : r1; \
    F_LOAD(A2_, W02_, W12_, q0_, q1_, kk2_, va0, va1, vb0, vb1, vw); } while (0)
#define F_STORE(st, va0, va1, vb0, vb1, vw) do { unsigned char* sa_ = smem + (st) * 49152; \
    if (AMUL) { _Pragma("unroll") for (int e_ = 0; e_ < 4; ++e_) { va0[e_] = pk2(lo2f(va0[e_]) * lo2f(vb0[e_]), hi2f(va0[e_]) * hi2f(vb0[e_])); va1[e_] = pk2(lo2f(va1[e_]) * lo2f(vb1[e_]), hi2f(va1[e_]) * hi2f(vb1[e_])); } } \
    *(u32x4*)(sa_ + aw0) = va0; *(u32x4*)(sa_ + aw1) = va1; \
    if (ABL != 3) { _Pragma("unroll") for (int i = 0; i < 4; ++i) { \
      u32x4 o_ = {pk2(vw[0][i], vw[1][i]), pk2(vw[2][i], vw[3][i]), pk2(vw[4][i], vw[5][i]), pk2(vw[6][i], vw[7][i])}; \
      *(u32x4*)(sa_ + 16384 + sw128(vrow[i], wid)) = o_; } } else { _Pragma("unroll") for (int j = 0; j < 8; ++j) asm volatile("" :: "v"(vw[j])); } } while (0)
#define F_LBAR() do { asm volatile("s_waitcnt lgkmcnt(0)" ::: "memory"); __builtin_amdgcn_s_barrier(); asm volatile("" ::: "memory"); } while (0)
#define F_COMPUTE(st) do { const unsigned char* sA = smem + (st) * 49152; const unsigned char* sB = sA + 16384; \
    _Pragma("unroll") for (int ks = 0; ks < 2; ++ks) { bf16x8 af[4], bfr[4]; \
      _Pragma("unroll") for (int m = 0; m < 4; ++m) af[m] = ldfrag(sA + sw128(64 * wr + 16 * m + fr, 4 * ks + fq)); \
      _Pragma("unroll") for (int n = 0; n < 4; ++n) bfr[n] = ldfrag(sB + sw128(64 * wc + 16 * n + fr, 4 * ks + fq)); \
      if (ABL != 2) { _Pragma("unroll") for (int m = 0; m < 4; ++m) _Pragma("unroll") for (int n = 0; n < 4; ++n) acc[m][n] = mfma16(bfr[n], af[m], acc[m][n]); } \
      else { _Pragma("unroll") for (int m = 0; m < 4; ++m) _Pragma("unroll") for (int n = 0; n < 4; ++n) asm volatile("" :: "v"(af[m]), "v"(bfr[n])); } } } while (0)
  UnitF cur, nxt; int ui = 0;
  if (!S.next(0, cur)) return;
  size_t r0, r1, nr0, nr1;
  F_ROWS(cur, r0, r1);
  bool has_next = S.next(1, nxt);
  if (has_next) F_ROWS(nxt, nr0, nr1); else { nxt = cur; nr0 = r0; nr1 = r1; }
  f32x4 acc[4][4];
#pragma unroll
  for (int m = 0; m < 4; ++m)
#pragma unroll
    for (int n = 0; n < 4; ++n) acc[m][n] = (f32x4){0.f, 0.f, 0.f, 0.f};
  u32x4 xa0, xa1, ya0, ya1, xb0, xb1, yb0, yb1; f32x4 xw[8], yw[8];
  xb0 = xb1 = yb0 = yb1 = (u32x4){0u, 0u, 0u, 0u};
  if (ABL == 1) { _Pragma("unroll") for (int j = 0; j < 8; ++j) { xw[j] = (f32x4){0.f, 0.f, 0.f, 0.f}; yw[j] = xw[j]; } }
  F_LOAD(cur.A, cur.W0, cur.W1, r0, r1, 0, xa0, xa1, xb0, xb1, xw);
  F_LOAD(cur.A, cur.W0, cur.W1, r0, r1, 1, ya0, ya1, yb0, yb1, yw);
  __syncthreads();
  F_STORE(0, xa0, xa1, xb0, xb1, xw);
  F_LBAR();
  int st = 0;
  for (;;) {
    typename Epi::Pre pre; E.prefetch(cur, wr, fr, pre);
#pragma unroll 1
    for (int kt = 0; kt < nk; kt += 2) {
      F_LOADX(kt + 2, xa0, xa1, xb0, xb1, xw);
      F_COMPUTE(st);
      F_STORE(st ^ 1, ya0, ya1, yb0, yb1, yw);
      F_LBAR();
      F_LOADX(kt + 3, ya0, ya1, yb0, yb1, yw);
      F_COMPUTE(st ^ 1);
      F_STORE(st, xa0, xa1, xb0, xb1, xw);
      F_LBAR();
    }
    E(acc, cur, wr, wc, fr, fq, pre);
#pragma unroll
    for (int m = 0; m < 4; ++m)
#pragma unroll
      for (int n = 0; n < 4; ++n) acc[m][n] = (f32x4){0.f, 0.f, 0.f, 0.f};
    if (!has_next) break;
    cur = nxt; r0 = nr0; r1 = nr1; ++ui;
    has_next = S.next(ui + 1, nxt);
    if (has_next) F_ROWS(nxt, nr0, nr1); else { nxt = cur; nr0 = r0; nr1 = r1; }
  }
  asm volatile("s_waitcnt vmcnt(0)" ::: "memory");
  __syncthreads();
#undef F_ROWS
#undef F_LOAD
#undef F_LOADX
#undef F_STORE
#undef F_LBAR
#undef F_COMPUTE
}

#define XB_TMO      128
#define XB_XCNT(j)  (256  + 64 * (j))
#define XB_XSUB(j)  (1280 + 64 * (j))
#define XB_XGEN(j)  (2304 + 64 * (j))
#define XB_TOP      3328
#define XB_TOPGEN   3392
#define XCD_BAR_WORDS 3456
#define XB_SPIN_CAP (1u << 22)
DI unsigned xb_ld(unsigned* p)              { return __hip_atomic_load(p, __ATOMIC_RELAXED, __HIP_MEMORY_SCOPE_AGENT); }
DI unsigned xb_add(unsigned* p, unsigned v) { return __hip_atomic_fetch_add(p, v, __ATOMIC_RELAXED, __HIP_MEMORY_SCOPE_AGENT); }
DI unsigned xb_xcc_id() { return (unsigned)__builtin_amdgcn_s_getreg((3 << 11) | 20) & 0xFu; }
#define XB_SPIN(cond, bar) do { unsigned _sp = 0; while (cond) { __builtin_amdgcn_s_sleep(1); \
    if ((++_sp & 255u) == 0u) { if (xb_ld(&(bar)[XB_TMO])) break; if (_sp > XB_SPIN_CAP) { atomicAdd(&(bar)[XB_TMO], 1u); break; } } } } while (0)
struct XcdBarrier { unsigned* bar; unsigned x; volatile LAS unsigned* st; };
DI XcdBarrier xcd_barrier_post(unsigned* bar, volatile LAS unsigned* st) {
  XcdBarrier b; b.bar = bar; b.x = xb_xcc_id(); b.st = st;
  if (threadIdx.x == 0) (void)xb_add(&bar[XB_XCNT(b.x)], 1u);
  return b;
}
DI void xcd_barrier_complete(unsigned* bar, unsigned x, unsigned& nloc, unsigned& nx) {
  const unsigned G = gridDim.x * gridDim.y * gridDim.z;
  unsigned sum, cnt, mine, sp = 0u;
  for (;;) {
    sum = 0u; cnt = 0u; mine = 0u;
#pragma unroll
    for (unsigned j = 0; j < 16; ++j) { const unsigned c = xb_ld(&bar[XB_XCNT(j)]); sum += c; cnt += (c > 0u) ? 1u : 0u; mine = (j == x) ? c : mine; }
    if (sum == G) break;
    __builtin_amdgcn_s_sleep(1);
    if ((++sp & 255u) == 0u) { if (xb_ld(&bar[XB_TMO])) break; if (sp > XB_SPIN_CAP) { atomicAdd(&bar[XB_TMO], 1u); break; } }
  }
  nloc = mine > 0u ? mine : 1u; nx = cnt > 0u ? cnt : 1u;
}
DI void xcd_barrier(const XcdBarrier& b) {
  asm volatile("s_waitcnt vmcnt(0)" ::: "memory");
  __syncthreads();
  if (threadIdx.x == 0) {
    unsigned* bar = b.bar;
    __builtin_amdgcn_s_waitcnt(0);
    unsigned nloc = b.st[0], nx = b.st[1];
    if (nloc == 0u) { xcd_barrier_complete(bar, b.x, nloc, nx); b.st[0] = nloc; b.st[1] = nx; }
    const unsigned old = xb_add(&bar[XB_XSUB(b.x)], 1u);
    const unsigned gen = old / nloc;
    if (old + 1u == (gen + 1u) * nloc) {
      __builtin_amdgcn_fence(__ATOMIC_RELEASE, "agent");
      asm volatile("s_waitcnt vmcnt(0)" ::: "memory");
      const unsigned og = xb_add(&bar[XB_TOP], 1u);
      const unsigned tg = og / nx;
      if (og + 1u == (tg + 1u) * nx) xb_add(&bar[XB_TOPGEN], 1u);
      else XB_SPIN(xb_ld(&bar[XB_TOPGEN]) == tg, bar);
      __builtin_amdgcn_fence(__ATOMIC_ACQUIRE, "agent");
      xb_add(&bar[XB_XGEN(b.x)], 1u);
      asm volatile("s_waitcnt vmcnt(0)" ::: "memory");
    } else {
      XB_SPIN(xb_ld(&bar[XB_XGEN(b.x)]) == gen, bar);
      __builtin_amdgcn_fence(__ATOMIC_ACQUIRE, "agent");
      asm volatile("s_waitcnt vmcnt(0)" ::: "memory");
    }
  }
  __syncthreads();
}

DI void phase0(const Params& p, unsigned char* smem, int bid, int nb) {
  int tid = threadIdx.x; asm volatile("" : "+v"(tid));
  const int lane = tid & 63, wave = tid >> 6;
  unsigned char* ws = p.ws;
  if (bid == 0 && tid < 256) ((int*)(ws + O_CTRL))[tid * CSTR] = 0;
  for (int i = bid * NTHR + tid; i < T; i += nb * NTHR) ((int*)(ws + O_IDENT))[i] = i;
  {
    float* wabT = (float*)smem;
    const float* win = p.in[I_WIN];
    for (int i = tid; i < 8192; i += NTHR) { const int k = i >> 3, j = i & 7; wabT[j * 1024 + k] = win[(size_t)k * DIN + 2048 + j]; }
    __syncthreads();
    const float* x = p.in[I_X];
    bf16_t* xb = (bf16_t*)(ws + O_XB);
    float* ab = (float*)(ws + O_AB);
    for (int row = bid * 8 + wave; row < T; row += nb * 8) {
      float s[8];
#pragma unroll
      for (int j = 0; j < 8; ++j) s[j] = 0.f;
#pragma unroll
      for (int i = 0; i < 4; ++i) {
        const int k = 256 * i + 4 * lane;
        const f32x4 v = *(const f32x4*)(x + (size_t)row * D + k);
        *(u32x2*)(xb + (size_t)row * D + k) = pack4(v);
#pragma unroll
        for (int j = 0; j < 8; ++j) { const f32x4 w = *(const f32x4*)(wabT + j * 1024 + k); s[j] += v[0] * w[0] + v[1] * w[1] + v[2] * w[2] + v[3] * w[3]; }
      }
#pragma unroll
      for (int j = 0; j < 8; ++j) s[j] = wave_sum(s[j]);
      if (lane == 0) { *(f32x4*)(ab + (size_t)row * 8) = (f32x4){s[0], s[1], s[2], s[3]}; *(f32x4*)(ab + (size_t)row * 8 + 4) = (f32x4){s[4], s[5], s[6], s[7]}; }
    }
    const float* mem = p.in[I_MEM];
    bf16_t* memb = (bf16_t*)(ws + O_MEMB);
    for (int row = bid * 8 + wave; row < 512; row += nb * 8) {
#pragma unroll
      for (int i = 0; i < 4; ++i) { const int k = 256 * i + 4 * lane; *(u32x2*)(memb + (size_t)row * D + k) = pack4(*(const f32x4*)(mem + (size_t)row * D + k)); }
    }
    const float* sw = p.in[I_SGUW];
    bf16_t* sguw = (bf16_t*)(ws + O_SGUW);
    for (int i = bid * NTHR + tid; i < 16384; i += nb * NTHR) {
      const int e0 = i * 4; const int col = e0 & 127, rowi = (e0 >> 7) & 127;
      f32x4 v = *(const f32x4*)(sw + e0);
#pragma unroll
      for (int c = 0; c < 4; ++c) if (col + c > rowi) v[c] = 0.f;
      *(u32x2*)(sguw + e0) = pack4(v);
    }
    __syncthreads();
  }
  {
    float* tile = (float*)smem;
    const float *pwin = p.in[I_WIN], *pwa = p.in[I_WA], *pwb = p.in[I_WB], *pwc = p.in[I_WC], *pwo = p.in[I_WO], *pwmkv = p.in[I_WMKV], *prw = p.in[I_RW],
                *pwsg = p.in[I_WSG], *pwsu = p.in[I_WSU], *pwsd = p.in[I_WSD], *pwg = p.in[I_WG], *pwu = p.in[I_WU], *pwdn = p.in[I_WDN];
    { GAS const float *a_ = (GAS const float*)pwa, *b_ = (GAS const float*)pwb, *c_ = (GAS const float*)pwc, *o_ = (GAS const float*)pwo, *m_ = (GAS const float*)pwmkv;
      asm volatile("" : "+s"(a_), "+s"(b_), "+s"(c_), "+s"(o_), "+s"(m_));
      pwa = (const float*)a_; pwb = (const float*)b_; pwc = (const float*)c_; pwo = (const float*)o_; pwmkv = (const float*)m_; }
    constexpr int J0 = 1664, J1 = J0 + 128, J2 = J1 + 128, J3 = J2 + 128, J4 = J3 + 256, J5 = J4 + 256, J6 = J5 + 64, J7 = J6 + 128, J8 = J7 + 64,
                  J9 = J8, J10 = J8;
    const int kr = tid >> 4, nc = tid & 15, sg = nc >> 2;
    const int tn = tid >> 3, tkc = tid & 7;
#define P0_DECODE_LOAD(it0, dp, v0, v1) do { const float* sp[4]; int ld[4]; \
      _Pragma("unroll") \
      for (int q = 0; q < 4; ++q) { \
        const int it = (it0 + q < J10) ? it0 + q : J10 - 1;      \
        const float *s0, *s1, *s2, *s3; int ldd; bf16_t* dst; \
        if (it < J0) {           \
          const int kt = it & 15, nt = it >> 4; const int n0 = nt * 64; const int c0 = n0 + (n0 >= 2048 ? 8 : 0); \
          const float* b = pwin + (size_t)kt * 64 * DIN + c0; s0 = b; s1 = b + 16; s2 = b + 32; s3 = b + 48; ld[q] = DIN; ldd = 1024; \
          dst = (bf16_t*)(ws + O_WINT) + (size_t)n0 * 1024 + kt * 64; \
        } else if (it < J3) {    \
          const int which = (it - J0) >> 7, r = (it - J0) & 127; const int kt = r & 7, nt = r >> 3; \
          const float* src = which == 0 ? pwa : which == 1 ? pwb : pwc; \
          const float* b = src + (size_t)kt * 64 * 1024 + nt * 64; s0 = b; s1 = b + 16; s2 = b + 32; s3 = b + 48; ld[q] = 1024; ldd = 512; \
          dst = (bf16_t*)(ws + (which == 0 ? O_WAT : which == 1 ? O_WBT : O_WCT)) + (size_t)nt * 64 * 512 + kt * 64; \
        } else if (it < J5) {    \
          const int which = (it - J3) >> 8, r = (it - J3) & 255; const int kt = r & 15, nt = r >> 4; \
          const float* b = (which == 0 ? pwo : pwmkv) + (size_t)kt * 64 * 1024 + nt * 64; s0 = b; s1 = b + 16; s2 = b + 32; s3 = b + 48; ld[q] = 1024; ldd = 1024; \
          dst = (bf16_t*)(ws + (which == 0 ? O_WOT : O_WMKV)) + (size_t)nt * 64 * 1024 + kt * 64; \
        } else if (it < J6) {    \
          const int r = it - J5; const int kt = r & 15, nt = r >> 4; \
          const float* b = prw + (size_t)kt * 64 * 256 + nt * 64; s0 = b; s1 = b + 16; s2 = b + 32; s3 = b + 48; ld[q] = 256; ldd = 1024; \
          dst = (bf16_t*)(ws + O_ROUT) + (size_t)nt * 64 * 1024 + kt * 64; \
        } else if (it < J7) {    \
          const int r = it - J6; const int kt = r & 15, nt = r >> 4; \
          const float* g = pwsg + (size_t)kt * 64 * 256 + nt * 32; const float* u = pwsu + (size_t)kt * 64 * 256 + nt * 32; \
          s0 = g; s1 = u; s2 = g + 16; s3 = u + 16; ld[q] = 256; ldd = 1024; \
          dst = (bf16_t*)(ws + O_WSGU) + (size_t)nt * 64 * 1024 + kt * 64; \
        } else if (it < J8) {    \
          const int r = it - J7; const int kt = r & 3, nt = r >> 2; \
          const float* b = pwsd + (size_t)kt * 64 * 1024 + nt * 64; s0 = b; s1 = b + 16; s2 = b + 32; s3 = b + 48; ld[q] = 1024; ldd = 256; \
          dst = (bf16_t*)(ws + O_WSD) + (size_t)nt * 64 * 256 + kt * 64; \
        } else if (it < J9) {    \
          const int r = it - J8; const int e = r >> 7, qq = r & 127; const int kt = qq & 15, nt = qq >> 4; \
          const float* g = pwg + (size_t)e * 262144 + (size_t)kt * 64 * 256 + nt * 32; const float* u = pwu + (size_t)e * 262144 + (size_t)kt * 64 * 256 + nt * 32; \
          s0 = g; s1 = u; s2 = g + 16; s3 = u + 16; ld[q] = 256; ldd = 1024; \
          dst = (bf16_t*)(ws + O_WGU) + (size_t)e * 524288 + (size_t)nt * 64 * 1024 + kt * 64; \
        } else {                 \
          const int r = it - J9; const int e = r >> 6, qq = r & 63; const int kt = qq & 3, nt = qq >> 2; \
          const float* b = pwdn + (size_t)e * 262144 + (size_t)kt * 64 * 1024 + nt * 64; s0 = b; s1 = b + 16; s2 = b + 32; s3 = b + 48; ld[q] = 1024; ldd = 256; \
          dst = (bf16_t*)(ws + O_WD) + (size_t)e * 262144 + (size_t)nt * 64 * 256 + kt * 64; \
        } \
        sp[q] = (sg == 0 ? s0 : sg == 1 ? s1 : sg == 2 ? s2 : s3) + (size_t)kr * ld[q] + 4 * (nc & 3); \
        dp[q] = dst + (size_t)tn * ldd + 8 * tkc; \
      } \
      _Pragma("unroll") \
      for (int q = 0; q < 4; ++q) { v0[q] = __builtin_nontemporal_load((const f32x4*)(sp[q])); v1[q] = __builtin_nontemporal_load((const f32x4*)(sp[q] + (size_t)32 * ld[q])); } } while (0)
    bf16_t* dpn[4]; f32x4 v0n[4], v1n[4];
    int it0 = bid * 4;
    if (it0 < J10) P0_DECODE_LOAD(it0, dpn, v0n, v1n);
    for (; it0 < J10; it0 += nb * 4) {
      bf16_t* dp[4]; f32x4 v0[4], v1[4];
#pragma unroll
      for (int q = 0; q < 4; ++q) { dp[q] = dpn[q]; v0[q] = v0n[q]; v1[q] = v1n[q]; }
      if (it0 + nb * 4 < J10) P0_DECODE_LOAD(it0 + nb * 4, dpn, v0n, v1n);
      asm volatile("s_waitcnt lgkmcnt(0)" ::: "memory"); __builtin_amdgcn_s_barrier(); asm volatile("" ::: "memory");
#pragma unroll
      for (int q = 0; q < 4; ++q) {
        float* t0 = tile + q * 4160 + kr * 65 + 4 * nc;
        float* t1 = t0 + 32 * 65;
        t0[0] = v0[q][0]; t0[1] = v0[q][1]; t0[2] = v0[q][2]; t0[3] = v0[q][3];
        t1[0] = v1[q][0]; t1[1] = v1[q][1]; t1[2] = v1[q][2]; t1[3] = v1[q][3];
      }
      asm volatile("s_waitcnt lgkmcnt(0)" ::: "memory"); __builtin_amdgcn_s_barrier(); asm volatile("" ::: "memory");
#pragma unroll
      for (int q = 0; q < 4; ++q) {
        float e[8];
#pragma unroll
        for (int j = 0; j < 8; ++j) e[j] = tile[q * 4160 + (8 * tkc + j) * 65 + tn];
        u32x4 o = {pk2(e[0], e[1]), pk2(e[2], e[3]), pk2(e[4], e[5]), pk2(e[6], e[7])};
        *(u32x4*)(dp[q]) = o;
      }
    }
#undef P0_DECODE_LOAD
  }
}

#define EPI_ROWS(u) const int row_ = (u).pm * 256 + 64 * wr + fr
struct EpiInProj {
  unsigned char* ws;
  DI void operator()(const f32x4 (&acc)[2][2][4][2], const pg::Unit& u, int wr, int wc, int fr, int fq) const {
    const int colt = u.pn * 256;
#pragma unroll
    for (int ai = 0; ai < 2; ++ai)
#pragma unroll
      for (int m = 0; m < 4; ++m) {
        const size_t row = (size_t)u.pm * 256 + 128 * ai + 64 * wr + 16 * m + fr;
#pragma unroll
        for (int bj = 0; bj < 2; ++bj)
#pragma unroll
          for (int n = 0; n < 2; ++n) {
            const int col = colt + 128 * bj + 32 * wc + 16 * n + 4 * fq;
            f32x4 v = acc[ai][bj][m][n];
            if (colt < 1536) { *(u32x2*)((bf16_t*)(ws + O_QKV) + row * 1536 + col) = pack4(v); }
            else if (colt < 2048) {
#pragma unroll
              for (int c = 0; c < 4; ++c) v[c] = siluf_(v[c]);
              *(u32x2*)((bf16_t*)(ws + O_ZS) + row * 512 + (col - 1536)) = pack4(v);
            } else if (colt < 3072) {
#pragma unroll
              for (int c = 0; c < 4; ++c) v[c] = geluf_(v[c]);
              *(u32x2*)((bf16_t*)(ws + O_UVG) + row * 1024 + (col - 2048)) = pack4(v);
            } else if (colt < 3584) {
#pragma unroll
              for (int c = 0; c < 4; ++c) v[c] *= 0.08838834764831845f;
              *(u32x2*)((bf16_t*)(ws + O_XQ) + row * 512 + (col - 3072)) = pack4(v);
            } else {
#pragma unroll
              for (int c = 0; c < 4; ++c) v[c] = sigmoidf_(v[c]);
              *(u32x2*)((bf16_t*)(ws + O_GATES) + row * 3072 + (col - 3584)) = pack4(v);
            }
          }
      }
  }
};
struct EpiMemKV {
  unsigned char* ws;
  DI void operator()(const f32x4 (&acc)[2][2][4][2], const pg::Unit& u, int wr, int wc, int fr, int fq) const {
#pragma unroll
    for (int ai = 0; ai < 2; ++ai)
#pragma unroll
      for (int m = 0; m < 4; ++m) {
        const int row = u.pm * 256 + 128 * ai + 64 * wr + 16 * m + fr; const int b = row >> 8, key = row & 255;
#pragma unroll
        for (int bj = 0; bj < 2; ++bj)
#pragma unroll
          for (int n = 0; n < 2; ++n) {
            const int col = u.pn * 256 + 128 * bj + 32 * wc + 16 * n + 4 * fq;
            const f32x4 v = acc[ai][bj][m][n];
            if (col < 512) { const int h = col >> 7, d = col & 127; *(u32x2*)((bf16_t*)(ws + O_MEMK) + ((size_t)((b * 4 + h) * 256 + key)) * 128 + d) = pack4(v); }
            else {
              const int c2 = col - 512; const int h = c2 >> 7, d = c2 & 127;
              const int pos = 32 * (key >> 5) + 8 * ((key >> 2) & 3) + 4 * ((key >> 4) & 1) + (key & 3);
              bf16_t* vt = (bf16_t*)(ws + O_MEMVT) + ((size_t)((b * 4 + h) * 128 + d)) * 256 + pos;
#pragma unroll
              for (int c = 0; c < 4; ++c) vt[(size_t)c * 256] = f2bf(v[c]);
            }
          }
      }
  }
};
DI void phase1(const Params& p, unsigned char* smem, int bid, int nb) {
  unsigned char* ws = p.ws;
  PG_LAS unsigned char* lds = (PG_LAS unsigned char*)smem;
  __syncthreads();
  { pg::DenseOrder S; S.init(ws + O_XB, ws + O_WINT, T, NPROJ, 1024, nb, bid); EpiInProj E{ws}; pg::gemm_phase<EpiInProj, pg::DenseOrder, false, true>(lds, 1024, S, E); }
  __syncthreads();
  { pg::DenseOrder S; S.init(ws + O_MEMB, ws + O_WMKV, 512, 1024, 1024, nb, bid); EpiMemKV E{ws}; pg::gemm_phase<EpiMemKV, pg::DenseOrder, false, true>(lds, 1024, S, E); }
}

constexpr int G_KF = 0, G_VF = 32768, G_QB = 65536, G_KB = 81920, G_UT = 81920  , G_L = 98304, G_ATT = 114688, G_KDT = 122880, G_WT = 139264, G_SM = 155648;

DI void gdn_prep_item(const Params& p, unsigned char* smem_, int item) {
  unsigned char* smem; { LAS unsigned char* l_ = (LAS unsigned char*)smem_; asm volatile("" : "+v"(l_)); smem = (unsigned char*)l_; }
  int tid = threadIdx.x; asm volatile("" : "+v"(tid));
  const int lane = tid & 63, wave = tid >> 6, fr = lane & 15, fq = lane >> 4;
  unsigned char* ws; { GAS unsigned char* g_ = (GAS unsigned char*)p.ws; asm volatile("" : "+s"(g_)); ws = (unsigned char*)g_; }
  const int h = item & 3, cn = item >> 2;
  const int bidx = cn >> 7, n = cn & 127;
  const size_t t0 = (size_t)bidx * SEQ + (size_t)n * 64;
  float* kf = (float*)(smem + G_KF); float* vf = (float*)(smem + G_VF); float* Lm = (float*)(smem + G_L);
  float* sbeta = (float*)(smem + G_SM); float* sgc = sbeta + 64; float* segc = sbeta + 128;
  __syncthreads();
  {
    const bf16_t* qkv = (const bf16_t*)(ws + O_QKV);
    const float* cw = p.in[I_CONVW];
    const int tl0 = wave * 8;
#pragma unroll
    for (int sect = 0; sect < 3; ++sect) {
      const int cb = sect * 512 + h * 128 + 2 * lane;
      float w0[4], w1[4];
#pragma unroll
      for (int i = 0; i < 4; ++i) { w0[i] = cw[i * 1536 + cb]; w1[i] = cw[i * 1536 + cb + 1]; }
      float xa[11], xc[11];
#pragma unroll
      for (int r = 0; r < 11; ++r) {
        const int s = n * 64 + tl0 + r - 3;
        unsigned u = 0u;
        if (s >= 0) u = *(const unsigned*)(qkv + ((size_t)bidx * SEQ + s) * 1536 + cb);
        xa[r] = lo2f(u); xc[r] = hi2f(u);
      }
#pragma unroll
      for (int r = 0; r < 8; ++r) {
        float y0 = w0[0] * xa[r] + w0[1] * xa[r + 1] + w0[2] * xa[r + 2] + w0[3] * xa[r + 3];
        float y1 = w1[0] * xc[r] + w1[1] * xc[r + 1] + w1[2] * xc[r + 2] + w1[3] * xc[r + 3];
        y0 = siluf_(y0); y1 = siluf_(y1);
        const int tl = tl0 + r;
        if (sect == 2) { vf[tl * 128 + 2 * lane] = y0; vf[tl * 128 + 2 * lane + 1] = y1; }
        else {
          const float ss = wave_sum(y0 * y0 + y1 * y1);
          const float sc = rsqrtf(ss + 1e-6f) * (sect == 0 ? 0.08838834764831845f : 1.0f);
          y0 *= sc; y1 *= sc;
          const int off = sw256(tl, lane >> 2) + (lane & 3) * 4;
          if (sect == 0) *(unsigned*)(smem + G_QB + off) = pk2(y0, y1);
          else { *(unsigned*)(smem + G_KB + off) = pk2(y0, y1); kf[tl * 128 + 2 * lane] = y0; kf[tl * 128 + 2 * lane + 1] = y1; }
        }
      }
    }
    if (wave == 0) {
      const float* ab = (const float*)(ws + O_AB) + (t0 + lane) * 8;
      const float a = ab[h], bb = ab[4 + h];
      const float beta = sigmoidf_(bb);
      float g = -__expf(p.in[I_ALOG][h]) * softplusf_(a + p.in[I_DTB][h]);
#pragma unroll
      for (int o = 1; o < 64; o <<= 1) { const float y = __shfl_up(g, o); if (lane >= o) g += y; }
      sbeta[lane] = beta; sgc[lane] = g; segc[lane] = __expf(g);
      if (lane == 63) ((float*)(ws + O_GL))[item] = __expf(g);
    }
  }
  __syncthreads();
  {
#pragma unroll
    for (int q = 0; q < 4; ++q) {
      const int idx = wave * 4 + q; const int isq = idx >> 4, ti = (idx >> 2) & 3, tj = idx & 3;
      f32x4 acc = {0.f, 0.f, 0.f, 0.f};
      if (tj <= ti) {
#pragma unroll
        for (int ks = 0; ks < 4; ++ks) {
          const bf16x8 ai = ldfrag(smem + (isq ? G_QB : G_KB) + sw256(16 * ti + fr, 4 * ks + fq));
          const bf16x8 bj = ldfrag(smem + G_KB + sw256(16 * tj + fr, 4 * ks + fq));
          acc = isq ? mfma16(bj, ai, acc) : mfma16(ai, bj, acc);
        }
      }
      if (isq) {
        const int i = 16 * ti + fr, j0 = 16 * tj + 4 * fq;
        const float gi = sgc[i];
        f32x4 o;
#pragma unroll
        for (int r = 0; r < 4; ++r) { const int j = j0 + r; o[r] = (j <= i) ? acc[r] * __expf(gi - sgc[j]) : 0.f; }
        *(u32x2*)(smem + G_ATT + sw128(i, j0 >> 3) + (j0 & 7) * 2) = pack4(o);
      } else {
        const int j = 16 * tj + fr, i0 = 16 * ti + 4 * fq;
        const float gj = sgc[j];
        f32x4 o;
#pragma unroll
        for (int r = 0; r < 4; ++r) { const int i = i0 + r; o[r] = (j < i) ? acc[r] * __expf(sgc[i] - gj) * sbeta[i] : 0.f; }
        *(f32x4*)(Lm + j * 64 + i0) = o;
      }
    }
  }
  {
    const float gl_ = sgc[63];
    const int d = tid & 127, tg = tid >> 7;
#pragma unroll
    for (int c = 0; c < 2; ++c) {
      float e[8];
#pragma unroll
      for (int j = 0; j < 8; ++j) { const int t = 16 * tg + 8 * c + j; e[j] = kf[t * 128 + d] * __expf(gl_ - sgc[t]); }
      u32x4 o = {pk2(e[0], e[1]), pk2(e[2], e[3]), pk2(e[4], e[5]), pk2(e[6], e[7])};
      *(u32x4*)(smem + G_KDT + sw128(d, 2 * tg + c)) = o;
    }
  }
  __syncthreads();
  if (tid < 256) {
    const bool isw = tid >= 128;
    float* X = isw ? (kf + (tid - 128)) : (vf + tid);
    unsigned char* dstT = smem + (isw ? G_WT : G_UT);
    const int rowc = tid & 127;
#pragma unroll
    for (int b = 0; b < 4; ++b) {
      float xr[16];
#pragma unroll
      for (int r = 0; r < 16; ++r) { const int t = 16 * b + r; float sc = sbeta[t]; if (isw) sc *= segc[t]; xr[r] = X[t * 128] * sc; }
#pragma unroll 2
      for (int j = 0; j < 16 * b; ++j) {
        const float xj = X[j * 128];
        const float* lt = Lm + j * 64 + 16 * b;
        const f32x4 l0 = *(const f32x4*)lt, l1 = *(const f32x4*)(lt + 4), l2 = *(const f32x4*)(lt + 8), l3 = *(const f32x4*)(lt + 12);
#pragma unroll
        for (int r = 0; r < 4; ++r) { xr[r] -= l0[r] * xj; xr[4 + r] -= l1[r] * xj; xr[8 + r] -= l2[r] * xj; xr[12 + r] -= l3[r] * xj; }
      }
#pragma unroll
      for (int q = 0; q < 15; ++q) {
        const float* lt = Lm + (16 * b + q) * 64 + 16 * b;
        float l[16];
#pragma unroll
        for (int g4 = 0; g4 < 4; ++g4) if (4 * g4 + 3 > q) { const f32x4 t4 = *(const f32x4*)(lt + 4 * g4); l[4 * g4] = t4[0]; l[4 * g4 + 1] = t4[1]; l[4 * g4 + 2] = t4[2]; l[4 * g4 + 3] = t4[3]; }
#pragma unroll
        for (int r = q + 1; r < 16; ++r) xr[r] -= l[r] * xr[q];
      }
#pragma unroll
      for (int r = 0; r < 16; ++r) X[(16 * b + r) * 128] = xr[r];
      u32x4 o0 = {pk2(xr[0], xr[1]), pk2(xr[2], xr[3]), pk2(xr[4], xr[5]), pk2(xr[6], xr[7])};
      u32x4 o1 = {pk2(xr[8], xr[9]), pk2(xr[10], xr[11]), pk2(xr[12], xr[13]), pk2(xr[14], xr[15])};
      *(u32x4*)(dstT + sw128(rowc, 2 * b)) = o0;
      *(u32x4*)(dstT + sw128(rowc, 2 * b + 1)) = o1;
    }
  }
  __syncthreads();
  {
    bf16x8 ak[2];
#pragma unroll
    for (int ks = 0; ks < 2; ++ks) ak[ks] = ldfrag(smem + G_KDT + sw128(16 * wave + fr, 4 * ks + fq));
    bf16_t* mp = (bf16_t*)(ws + O_MP) + (size_t)item * 16384;
    float* bc = (float*)(ws + O_BC) + (size_t)item * 16384;
#pragma unroll
    for (int tj = 0; tj < 8; ++tj) {
      f32x4 am = {0.f, 0.f, 0.f, 0.f}, ab_ = {0.f, 0.f, 0.f, 0.f};
#pragma unroll
      for (int ks = 0; ks < 2; ++ks) {
        const bf16x8 bw = ldfrag(smem + G_WT + sw128(16 * tj + fr, 4 * ks + fq));
        const bf16x8 bu = ldfrag(smem + G_UT + sw128(16 * tj + fr, 4 * ks + fq));
        am = mfma16(bw, ak[ks], am);
        ab_ = mfma16(ak[ks], bu, ab_);
      }
      f32x4 nm = {-am[0], -am[1], -am[2], -am[3]};
      *(u32x2*)(mp + ((size_t)((wave * 4 + (tj >> 1)) * 64 + lane)) * 8 + (tj & 1) * 4) = pack4(nm);
      *(f32x4*)(bc + ((size_t)((tj * 8 + wave) * 64 + lane)) * 4) = ab_;
    }
    const int tt = wave & 3, hf = wave >> 2;
    bf16x8 aa[2];
#pragma unroll
    for (int ks = 0; ks < 2; ++ks) aa[ks] = ldfrag(smem + G_ATT + sw128(16 * tt + fr, 4 * ks + fq));
    const int trow = 16 * tt + fr;
    const float eg = segc[trow];
    float* o0 = (float*)(ws + O_O0) + (t0 + trow) * 512 + h * 128;
    bf16_t* qp = (bf16_t*)(ws + O_QP) + (size_t)item * 8192 + trow * 128;
#pragma unroll
    for (int q = 0; q < 4; ++q) {
      const int te = hf * 4 + q;
      f32x4 ao = {0.f, 0.f, 0.f, 0.f}, aw = {0.f, 0.f, 0.f, 0.f};
#pragma unroll
      for (int ks = 0; ks < 2; ++ks) {
        const bf16x8 bu = ldfrag(smem + G_UT + sw128(16 * te + fr, 4 * ks + fq));
        const bf16x8 bw = ldfrag(smem + G_WT + sw128(16 * te + fr, 4 * ks + fq));
        ao = mfma16(bu, aa[ks], ao);
        aw = mfma16(bw, aa[ks], aw);
      }
      const int e0 = 16 * te + 4 * fq;
      *(f32x4*)(o0 + e0) = ao;
      const u32x2 qv = *(const u32x2*)(smem + G_QB + sw256(trow, e0 >> 3) + (e0 & 7) * 2);
      f32x4 qd = {lo2f(qv[0]) * eg - aw[0], hi2f(qv[0]) * eg - aw[1], lo2f(qv[1]) * eg - aw[2], hi2f(qv[1]) * eg - aw[3]};
      *(u32x2*)(qp + e0) = pack4(qd);
    }
  }
}

DI void sgu_item(const Params& p, unsigned char* smem_, int item) {
  unsigned char* smem; { LAS unsigned char* l_ = (LAS unsigned char*)smem_; asm volatile("" : "+v"(l_)); smem = (unsigned char*)l_; }
  int tid = threadIdx.x; asm volatile("" : "+v"(tid));
  const int lane = tid & 63, wave = __builtin_amdgcn_readfirstlane(tid >> 6), fr = lane & 15, fq = lane >> 4;
  unsigned char* ws; { GAS unsigned char* g_ = (GAS unsigned char*)p.ws; asm volatile("" : "+s"(g_)); ws = (unsigned char*)g_; }
  const int g = item & 3, cn = item >> 2;
  const size_t t0 = (size_t)cn * 128;
  const bf16_t* uvg = (const bf16_t*)(ws + O_UVG);
  __syncthreads();
  {
    const float* lng = p.in[I_SLNG]; const float* lnb = p.in[I_SLNB];
    const int cl0 = 8 * (lane & 15);
    float gg[8], bb[8];
#pragma unroll
    for (int e = 0; e < 8; ++e) { gg[e] = lng[128 * g + cl0 + e]; bb[e] = lnb[128 * g + cl0 + e]; }
    for (int jj = 0; jj < 16; ++jj) {
      const int j = 16 * wave + jj;
      const u32x4 raw = *(const u32x4*)(uvg + (t0 + j) * 1024 + 512 + 8 * lane);
      float v[8];
#pragma unroll
      for (int e = 0; e < 4; ++e) { v[2 * e] = lo2f(raw[e]); v[2 * e + 1] = hi2f(raw[e]); }
      float s = 0.f;
#pragma unroll
      for (int e = 0; e < 8; ++e) s += v[e];
      const float mean = wave_sum(s) * (1.f / 512.f);
      float q = 0.f;
#pragma unroll
      for (int e = 0; e < 8; ++e) { const float d = v[e] - mean; q += d * d; }
      const float rstd = rsqrtf(wave_sum(q) * (1.f / 512.f) + 1e-5f);
      if ((lane >> 4) == g) {
#pragma unroll
        for (int e = 0; e < 8; ++e) {
          const int c = cl0 + e;
          const float y = (v[e] - mean) * rstd * gg[e] + bb[e];
          *(bf16_t*)(smem + sw256(c, j >> 3) + (j & 7) * 2) = f2bf(y);
        }
      }
    }
  }
  __syncthreads();
  {
    const bf16_t* wg = (const bf16_t*)(ws + O_SGUW) + (size_t)g * 16384;
    const int i = 16 * wave + fr;
    bf16x8 af[4];
#pragma unroll
    for (int ks = 0; ks < 4; ++ks) af[ks] = ldfrag(wg + i * 128 + 32 * ks + 8 * fq);
    const float bias = p.in[I_SGUB][g * 128 + i];
    bf16_t* out = (bf16_t*)(ws + O_SGUO) + (t0 + i) * 512 + 128 * g;
    const bf16_t* urow = uvg + (t0 + i) * 1024 + 128 * g;
#pragma unroll
    for (int jt = 0; jt < 8; ++jt) {
      f32x4 acc = {0.f, 0.f, 0.f, 0.f};
#pragma unroll
      for (int ks = 0; ks < 4; ++ks) acc = mfma16(ldfrag(smem + sw256(16 * jt + fr, 4 * ks + fq)), af[ks], acc);
      const int c0 = 16 * jt + 4 * fq;
      const u32x2 uu = *(const u32x2*)(urow + c0);
      f32x4 o = {lo2f(uu[0]) * (acc[0] + bias), hi2f(uu[0]) * (acc[1] + bias), lo2f(uu[1]) * (acc[2] + bias), hi2f(uu[1]) * (acc[3] + bias)};
      *(u32x2*)(out + c0) = pack4(o);
    }
  }
}

DI void xattn_item(const Params& p, unsigned char* smem_, int item) {
  int tid = threadIdx.x; asm volatile("" : "+v"(tid));
  unsigned char* smem; { LAS unsigned char* l_ = (LAS unsigned char*)smem_; asm volatile("" : "+v"(l_)); smem = (unsigned char*)l_; }
  const int lane = tid & 63, wave = tid >> 6, fr = lane & 15, fq = lane >> 4;
  unsigned char* ws; { GAS unsigned char* g_ = (GAS unsigned char*)p.ws; asm volatile("" : "+s"(g_)); ws = (unsigned char*)g_; }
  const int bh = item & 7, qb = item >> 3;
  const int b = bh >> 2, h = bh & 3;
  const bf16_t* mk = (const bf16_t*)(ws + O_MEMK) + (size_t)bh * 32768;
  const bf16_t* mv = (const bf16_t*)(ws + O_MEMVT) + (size_t)bh * 32768;
  __syncthreads();
#pragma unroll 2
  for (int j = 0; j < 8; ++j) {
    const int c = tid + 512 * j;
    const int rk = c >> 4, ck = c & 15;
    *(u32x4*)(smem + sw256(rk, ck)) = *(const u32x4*)(mk + (size_t)c * 8);
    const int rv = c >> 5, cv = c & 31;
    *(u32x4*)(smem + 65536 + rv * 512 + ((cv ^ (rv & 15)) << 4)) = *(const u32x4*)(mv + (size_t)c * 8);
  }
  __syncthreads();
  const unsigned char* kbase[4]; const unsigned char* vbase[8];
#pragma unroll
  for (int ds = 0; ds < 4; ++ds) kbase[ds] = smem + fr * 256 + (((4 * ds + fq) ^ fr) << 4);
#pragma unroll
  for (int s = 0; s < 8; ++s) vbase[s] = smem + 65536 + fr * 512 + (((4 * s + fq) ^ fr) << 4);
#pragma unroll 1
  for (int half = 0; half < 2; ++half) {
    const size_t trow = (size_t)b * SEQ + (size_t)qb * 256 + half * 128 + 16 * wave + fr;
    const bf16_t* xq = (const bf16_t*)(ws + O_XQ) + trow * 512 + h * 128;
    bf16x8 qf[4];
#pragma unroll
    for (int ds = 0; ds < 4; ++ds) qf[ds] = ldfrag(xq + 32 * ds + 8 * fq);
    f32x4 sc[16];
#pragma unroll
    for (int kt = 0; kt < 16; ++kt) {
      f32x4 a = {0.f, 0.f, 0.f, 0.f};
#pragma unroll
      for (int ds = 0; ds < 4; ++ds) a = mfma16(ldfrag(kbase[ds] + kt * 4096), qf[ds], a);
      sc[kt] = a;
      if (kt & 1) __builtin_amdgcn_sched_barrier(0);
    }
    float m = -1e30f;
#pragma unroll
    for (int kt = 0; kt < 16; ++kt)
#pragma unroll
      for (int r = 0; r < 4; ++r) m = fmaxf(m, sc[kt][r]);
    m = fmaxf(m, __shfl_xor(m, 16)); m = fmaxf(m, __shfl_xor(m, 32));
    float l = 0.f;
#pragma unroll
    for (int kt = 0; kt < 16; ++kt)
#pragma unroll
      for (int r = 0; r < 4; ++r) { const float e = __expf(sc[kt][r] - m); sc[kt][r] = e; l += e; }
    l += __shfl_xor(l, 16); l += __shfl_xor(l, 32);
    const float inv = 1.f / l;
    bf16x8 pf[8];
#pragma unroll
    for (int s = 0; s < 8; ++s) pf[s] = pack8(sc[2 * s], sc[2 * s + 1]);
    bf16_t* out = (bf16_t*)(ws + O_XATO) + trow * 512 + h * 128;
#pragma unroll
    for (int dt = 0; dt < 8; ++dt) {
      f32x4 a = {0.f, 0.f, 0.f, 0.f};
#pragma unroll
      for (int s = 0; s < 8; ++s) a = mfma16(ldfrag(vbase[s] + dt * 8192), pf[s], a);
      __builtin_amdgcn_sched_barrier(0);
      f32x4 o = {a[0] * inv, a[1] * inv, a[2] * inv, a[3] * inv};
      *(u32x2*)(out + 16 * dt + 4 * fq) = pack4(o);
    }
  }
}

DI void phase2(const Params& p, unsigned char* smem, int bid, int nb) {
  for (int rep = 0; rep < ((DUPMASK >> 20) & 1) + 1; ++rep) for (int it = bid; it < 1024; it += nb) gdn_prep_item(p, smem, it);
  for (int rep = 0; rep < ((DUPMASK >> 21) & 1) + 1; ++rep) for (int it = bid; it < 512; it += nb) sgu_item(p, smem, it);
  for (int rep = 0; rep < ((DUPMASK >> 22) & 1) + 1; ++rep) for (int it = bid; it < 256; it += nb) xattn_item(p, smem, it);
}

DI void gdn_scan4(const Params& p, unsigned char* smem_, int bh, int es) {
  int tid = threadIdx.x; asm volatile("" : "+v"(tid));
  unsigned char* smem; { LAS unsigned char* l_ = (LAS unsigned char*)smem_; asm volatile("" : "+v"(l_)); smem = (unsigned char*)l_; }
  const int lane = tid & 63, w = __builtin_amdgcn_readfirstlane(tid >> 6);
  if (w >= 4) {
    for (int n = 0; n < 128; ++n) __builtin_amdgcn_s_barrier();
    return;
  }
  unsigned char* ws = p.ws;
  const int b = bh >> 2, h = bh & 3;
  const int fr = lane & 15, fq = lane >> 4;
  const size_t item0 = (size_t)(b * 128) * 4 + h;
  constexpr size_t ISTR = 4 * 16384;
  const bf16_t* mp = (const bf16_t*)(ws + O_MP) + item0 * 16384 + (size_t)(2 * w) * 2048 + lane * 8;
  const float* bc = (const float*)(ws + O_BC) + item0 * 16384 + (size_t)es * 2048 + (size_t)(2 * w) * 256 + lane * 4;
  bf16_t* st = (bf16_t*)(ws + O_ST) + item0 * 16384 + (size_t)(16 * es + fr) * 128 + 32 * w + 4 * fq;
  const float* glp = (const float*)(ws + O_GL) + item0;
  { GAS const float* g_ = (GAS const float*)glp; asm volatile("" : "+v"(g_)); glp = (const float*)g_; }
  f32x4 acc0 = {0.f, 0.f, 0.f, 0.f}, acc1 = {0.f, 0.f, 0.f, 0.f};
  constexpr int PD = 2;
  bf16x8 A[PD][8]; f32x4 C[PD][2]; float G[PD];
#pragma unroll
  for (int d = 0; d < PD; ++d) {
#pragma unroll
    for (int i = 0; i < 8; ++i) A[d][i] = ldfrag(mp + (size_t)d * ISTR + i * 512);
    C[d][0] = *(const f32x4*)(bc + (size_t)d * ISTR); C[d][1] = *(const f32x4*)(bc + (size_t)d * ISTR + 256);
    G[d] = glp[d * 4];
  }
  unsigned char* xch = smem;
  for (int n0 = 0; n0 < 128; n0 += PD) {
#pragma unroll
    for (int d = 0; d < PD; ++d) {
      const int n = n0 + d;
      const int np = (n + PD < 128) ? n + PD : n;
      const u32x2 lo = pack4(acc0), hi = pack4(acc1);
      bf16_t* stn = st + (size_t)n * ISTR;
      *(u32x2*)(stn) = lo; *(u32x2*)(stn + 16) = hi;
      const u32x4 mine = {lo[0], lo[1], hi[0], hi[1]};
      *(u32x4*)(xch + ((n & 1) * 4 + w) * 1024 + lane * 16) = mine;
      asm volatile("s_waitcnt lgkmcnt(0)" ::: "memory");
      __builtin_amdgcn_s_barrier();
      asm volatile("" ::: "memory");
      bf16x8 bfr[4];
#pragma unroll
      for (int s = 0; s < 4; ++s) bfr[s] = ldfrag(xch + ((n & 1) * 4 + s) * 1024 + lane * 16);
      const float g = G[d];
      f32x4 a0 = {g * acc0[0] + C[d][0][0], g * acc0[1] + C[d][0][1], g * acc0[2] + C[d][0][2], g * acc0[3] + C[d][0][3]};
      f32x4 a1 = {g * acc1[0] + C[d][1][0], g * acc1[1] + C[d][1][1], g * acc1[2] + C[d][1][2], g * acc1[3] + C[d][1][3]};
#pragma unroll
      for (int s = 0; s < 4; ++s) { a0 = mfma16(A[d][s], bfr[s], a0); a1 = mfma16(A[d][4 + s], bfr[s], a1); }
      acc0 = a0; acc1 = a1;
#pragma unroll
      for (int i = 0; i < 8; ++i) A[d][i] = ldfrag(mp + (size_t)np * ISTR + i * 512);
      C[d][0] = *(const f32x4*)(bc + (size_t)np * ISTR); C[d][1] = *(const f32x4*)(bc + (size_t)np * ISTR + 256);
      G[d] = glp[(size_t)np * 4];
    }
  }
}

struct EpiGate {
  const bf16_t* gates; int goff; const bf16_t* src; bf16_t* dst;
  DI void operator()(const f32x4 (&acc)[2][2][4][2], const pg::Unit& u, int wr, int wc, int fr, int fq) const {
#pragma unroll
    for (int ai = 0; ai < 2; ++ai)
#pragma unroll
      for (int m = 0; m < 4; ++m) {
        const size_t row = (size_t)u.pm * 256 + 128 * ai + 64 * wr + 16 * m + fr;
#pragma unroll
        for (int bj = 0; bj < 2; ++bj)
#pragma unroll
          for (int n = 0; n < 2; ++n) {
            const int col = u.pn * 256 + 128 * bj + 32 * wc + 16 * n + 4 * fq;
            const f32x4 v = acc[ai][bj][m][n];
            const u32x2 g = *(const u32x2*)(gates + row * 3072 + goff + col);
            f32x4 o = {lo2f(g[0]) * v[0], hi2f(g[0]) * v[1], lo2f(g[1]) * v[2], hi2f(g[1]) * v[3]};
            if (src) { const u32x2 s = *(const u32x2*)(src + row * 1024 + col); o[0] += lo2f(s[0]); o[1] += hi2f(s[0]); o[2] += lo2f(s[1]); o[3] += hi2f(s[1]); }
            *(u32x2*)(dst + row * 1024 + col) = pack4(o);
          }
      }
  }
};
DI void phase3(const Params& p, unsigned char* smem, int bid, int nb) {
  unsigned char* ws = p.ws;
  if (bid < 64) {
    __syncthreads();
    gdn_scan4(p, smem, bid & 7, bid >> 3);
  } else {
    PG_LAS unsigned char* lds = (PG_LAS unsigned char*)smem;
    const bf16_t* gates = (const bf16_t*)(ws + O_GATES);
    bf16_t* part = (bf16_t*)(ws + O_PART);
    __syncthreads();
    { pg::DenseOrder S; S.init(ws + O_SGUO, ws + O_WBT, T, 1024, 512, nb - 64, bid - 64); EpiGate E{gates, 1024, nullptr, part}; pg::gemm_phase<EpiGate, pg::DenseOrder, false, true>(lds, 512, S, E); }
    asm volatile("s_waitcnt vmcnt(0)" ::: "memory");
    __builtin_amdgcn_fence(__ATOMIC_ACQUIRE, "agent");
    asm volatile("s_waitcnt vmcnt(0)" ::: "memory");
    __syncthreads();
    { pg::DenseOrder S; S.init(ws + O_XATO, ws + O_WCT, T, 1024, 512, nb - 64, bid - 64); EpiGate E{gates, 2048, part, part}; pg::gemm_phase<EpiGate, pg::DenseOrder, false, true>(lds, 512, S, E); }
  }
}

DI void phase4(const Params& p, int bid, int nb) {
  int tid = threadIdx.x; asm volatile("" : "+v"(tid));
  const int lane = tid & 63, wave = tid >> 6, fr = lane & 15, fq = lane >> 4;
  unsigned char* ws = p.ws;
  for (int it = bid; it < 512; it += nb) {
    const int item = it * 2 + (wave >> 2), tt = wave & 3;
    const int h = item & 3, cn = item >> 2;
    const size_t trow = (size_t)cn * 64 + 16 * tt + fr;
    const bf16_t* qp = (const bf16_t*)(ws + O_QP) + (size_t)item * 8192 + (16 * tt + fr) * 128;
    const bf16_t* st = (const bf16_t*)(ws + O_ST) + (size_t)item * 16384;
    const float* o0 = (const float*)(ws + O_O0) + trow * 512 + h * 128;
    bf16x8 af[4];
#pragma unroll
    for (int ks = 0; ks < 4; ++ks) af[ks] = ldfrag(qp + 32 * ks + 8 * fq);
    f32x4 acc[8];
    float ss = 0.f;
#pragma unroll
    for (int j = 0; j < 8; ++j) {
      f32x4 a = *(const f32x4*)(o0 + 16 * j + 4 * fq);
#pragma unroll
      for (int ks = 0; ks < 4; ++ks) a = mfma16(ldfrag(st + (16 * j + fr) * 128 + 32 * ks + 8 * fq), af[ks], a);
      acc[j] = a;
      ss += a[0] * a[0] + a[1] * a[1] + a[2] * a[2] + a[3] * a[3];
    }
    ss += __shfl_xor(ss, 16); ss += __shfl_xor(ss, 32);
    const float rms = rsqrtf(ss * (1.f / 128.f) + 1e-6f);
    const float* ng = p.in[I_GNG];
    const bf16_t* zs = (const bf16_t*)(ws + O_ZS) + trow * 512 + h * 128;
    bf16_t* out = (bf16_t*)(ws + O_GDNO) + trow * 512 + h * 128;
#pragma unroll
    for (int j = 0; j < 8; ++j) {
      const int e0 = 16 * j + 4 * fq;
      const f32x4 g = *(const f32x4*)(ng + e0);
      const u32x2 z = *(const u32x2*)(zs + e0);
      f32x4 o = {acc[j][0] * rms * g[0] * lo2f(z[0]), acc[j][1] * rms * g[1] * hi2f(z[0]), acc[j][2] * rms * g[2] * lo2f(z[1]), acc[j][3] * rms * g[3] * hi2f(z[1])};
      *(u32x2*)(out + e0) = pack4(o);
    }
  }
}

DI void phase5(const Params& p, unsigned char* smem, int bid, int nb) {
  unsigned char* ws = p.ws;
  PG_LAS unsigned char* lds = (PG_LAS unsigned char*)smem;
  __syncthreads();
  pg::DenseOrder S; S.init(ws + O_GDNO, ws + O_WAT, T, 1024, 512, nb, bid);
  EpiGate E{(const bf16_t*)(ws + O_GATES), 0, (const bf16_t*)(ws + O_PART), (bf16_t*)(ws + O_MERGED)};
  pg::gemm_phase<EpiGate, pg::DenseOrder, false, true>(lds, 512, S, E);
}
struct EpiX1 {
  const float* x; float* x1;
  DI void operator()(const f32x4 (&acc)[2][2][4][2], const pg::Unit& u, int wr, int wc, int fr, int fq) const {
#pragma unroll
    for (int ai = 0; ai < 2; ++ai)
#pragma unroll
      for (int m = 0; m < 4; ++m) {
        const size_t row = (size_t)u.pm * 256 + 128 * ai + 64 * wr + 16 * m + fr;
#pragma unroll
        for (int bj = 0; bj < 2; ++bj)
#pragma unroll
          for (int n = 0; n < 2; ++n) {
            const int col = u.pn * 256 + 128 * bj + 32 * wc + 16 * n + 4 * fq;
            const f32x4 v = acc[ai][bj][m][n];
            const f32x4 xv = *(const f32x4*)(x + row * 1024 + col);
            f32x4 o = {ALPHA * xv[0] + v[0], ALPHA * xv[1] + v[1], ALPHA * xv[2] + v[2], ALPHA * xv[3] + v[3]};
            *(f32x4*)(x1 + row * 1024 + col) = o;
          }
      }
  }
};
DI void phase6(const Params& p, unsigned char* smem, int bid, int nb) {
  unsigned char* ws = p.ws;
  PG_LAS unsigned char* lds = (PG_LAS unsigned char*)smem;
  __syncthreads();
  pg::DenseOrder S; S.init(ws + O_MERGED, ws + O_WOT, T, 1024, 1024, nb, bid);
  EpiX1 E{p.in[I_X], (float*)(ws + O_X1)};
  pg::gemm_phase<EpiX1, pg::DenseOrder, false, false>(lds, 1024, S, E);
}

DI void ln_row(const float* src, const float* g, const float* b, float (&v)[16], int lane) {
  float s = 0.f;
#pragma unroll
  for (int i = 0; i < 16; ++i) s += v[i];
  const float mean = wave_sum(s) * (1.f / 1024.f);
  float q = 0.f;
#pragma unroll
  for (int i = 0; i < 16; ++i) { const float d = v[i] - mean; q += d * d; }
  const float rstd = rsqrtf(wave_sum(q) * (1.f / 1024.f) + 1e-5f);
#pragma unroll
  for (int i = 0; i < 4; ++i) {
    const int k = 256 * i + 4 * lane;
    const f32x4 gg = *(const f32x4*)(g + k), bb = *(const f32x4*)(b + k);
#pragma unroll
    for (int c = 0; c < 4; ++c) v[4 * i + c] = (v[4 * i + c] - mean) * rstd * gg[c] + bb[c];
  }
}
DI void phase7(const Params& p, int bid, int nb) {
  int tid = threadIdx.x; asm volatile("" : "+v"(tid));
  const int lane = tid & 63, wave = tid >> 6;
  unsigned char* ws = p.ws;
  for (int i = bid * NTHR + tid; i < MAXSLOT; i += nb * NTHR) { ((int*)(ws + O_SLOTTOK))[i] = 0; ((int*)(ws + O_SLOTAID))[i] = -1; }
  float* x1 = (float*)(ws + O_X1);
  bf16_t* x1b = (bf16_t*)(ws + O_X1B);
  for (int row = bid * 8 + wave; row < T; row += nb * 8) {
    float v[16];
#pragma unroll
    for (int i = 0; i < 4; ++i) { const f32x4 t = *(const f32x4*)(x1 + (size_t)row * D + 256 * i + 4 * lane); v[4 * i] = t[0]; v[4 * i + 1] = t[1]; v[4 * i + 2] = t[2]; v[4 * i + 3] = t[3]; }
    ln_row(nullptr, p.in[I_LN1G], p.in[I_LN1B], v, lane);
#pragma unroll
    for (int i = 0; i < 4; ++i) {
      const f32x4 o = {v[4 * i], v[4 * i + 1], v[4 * i + 2], v[4 * i + 3]};
      *(f32x4*)(x1 + (size_t)row * D + 256 * i + 4 * lane) = o;
      *(u32x2*)(x1b + (size_t)row * D + 256 * i + 4 * lane) = pack4(o);
    }
  }
}
struct EpiLogits {
  float* logits;
  DI void operator()(const f32x4 (&acc)[2][2][4][2], const pg::Unit& u, int wr, int wc, int fr, int fq) const {
#pragma unroll
    for (int ai = 0; ai < 2; ++ai)
#pragma unroll
      for (int m = 0; m < 4; ++m) {
        const size_t row = (size_t)u.pm * 256 + 128 * ai + 64 * wr + 16 * m + fr;
#pragma unroll
        for (int bj = 0; bj < 2; ++bj)
#pragma unroll
          for (int n = 0; n < 2; ++n) *(f32x4*)(logits + row * 256 + 128 * bj + 32 * wc + 16 * n + 4 * fq) = acc[ai][bj][m][n];
      }
  }
};
DI void phase8(const Params& p, unsigned char* smem, int bid, int nb) {
  unsigned char* ws = p.ws;
  PG_LAS unsigned char* lds = (PG_LAS unsigned char*)smem;
  __syncthreads();
  pg::DenseOrder S; S.init(ws + O_X1B, ws + O_ROUT, T, 256, 1024, nb, bid);
  EpiLogits E{(float*)(ws + O_LOGITS)};
  pg::gemm_phase<EpiLogits, pg::DenseOrder, false, false>(lds, 1024, S, E);
}
DI void phase9(const Params& p, int bid, int nb) {
  int tid = threadIdx.x; asm volatile("" : "+v"(tid));
  const int lane = tid & 63, wave = tid >> 6;
  unsigned char* ws = p.ws;
  const float* logits = (const float*)(ws + O_LOGITS);
  int* counts = (int*)(ws + O_CTRL);
  const int g = lane & 7, tsub = lane >> 3;
  const float NEG = -__builtin_inff();
  float bias[32];
#pragma unroll
  for (int j4 = 0; j4 < 8; ++j4) { const f32x4 b4 = *(const f32x4*)(p.in[I_RB] + 32 * g + 4 * j4); bias[4 * j4] = b4[0]; bias[4 * j4 + 1] = b4[1]; bias[4 * j4 + 2] = b4[2]; bias[4 * j4 + 3] = b4[3]; }
  for (int tok0 = (bid * 8 + wave) * 8; tok0 < T; tok0 += nb * 64) {
    const int tok = tok0 + tsub;
    float sc[32], bz[32];
#pragma unroll
    for (int j4 = 0; j4 < 8; ++j4) {
      const f32x4 l4 = *(const f32x4*)(logits + (size_t)tok * 256 + 32 * g + 4 * j4);
#pragma unroll
      for (int c = 0; c < 4; ++c) { sc[4 * j4 + c] = sigmoidf_(l4[c]); bz[4 * j4 + c] = sc[4 * j4 + c] + bias[4 * j4 + c]; }
    }
    float m1 = NEG, m2 = NEG;
#pragma unroll
    for (int j = 0; j < 32; ++j) { const float v = bz[j]; if (v > m1) { m2 = m1; m1 = v; } else if (v > m2) m2 = v; }
    const float gs = m1 + m2;
    int rank = 0;
#pragma unroll
    for (int gg = 0; gg < 8; ++gg) { const float og = __shfl(gs, (lane & ~7) | gg); rank += ((og > gs) || (og == gs && gg < g)) ? 1 : 0; }
    if (rank >= 4) {
#pragma unroll
      for (int j = 0; j < 32; ++j) bz[j] = NEG;
    }
    int myidx = 0; float mysc = 0.f, ssum = 0.f;
#pragma unroll 1
    for (int k = 0; k < 8; ++k) {
      float bv = bz[0], bs = sc[0]; int bi = 0;
#pragma unroll
      for (int j = 1; j < 32; ++j) if (bz[j] > bv) { bv = bz[j]; bi = j; bs = sc[j]; }
      float rv = bv, rs = bs; int ri = 32 * g + bi;
#pragma unroll
      for (int o = 1; o < 8; o <<= 1) {
        const float ov = __shfl_xor(rv, o), os = __shfl_xor(rs, o); const int oi = __shfl_xor(ri, o);
        if (ov > rv || (ov == rv && oi < ri)) { rv = ov; ri = oi; rs = os; }
      }
      if ((ri >> 5) == g) {
        const int wj = ri & 31;
#pragma unroll
        for (int j = 0; j < 32; ++j) if (j == wj) bz[j] = NEG;
      }
      ssum += rs;
      if (g == k) { myidx = ri; mysc = rs; }
    }
    const int pos = atomicAdd(&counts[myidx * CSTR], 1);
    ((int*)(ws + O_TKIDX))[(size_t)tok * 8 + g] = myidx;
    ((float*)(ws + O_TKW))[(size_t)tok * 8 + g] = mysc / ssum * 2.5f;
    ((int*)(ws + O_TKPOS))[(size_t)tok * 8 + g] = pos;
  }
}
DI void build_tile_start(const Params& p, int* ts) {
  const int tid = threadIdx.x;
  const int* counts = (const int*)(p.ws + O_CTRL);
  __syncthreads();
  if (tid < 256) ts[300 + tid] = (counts[tid * CSTR] + 127) >> 7;
  __syncthreads();
  if (tid == 0) { int s = 0; for (int e = 0; e < 256; ++e) { ts[e] = s; s += ts[300 + e]; } ts[256] = s; }
  __syncthreads();
}
DI void phase10(const Params& p, unsigned char* smem, int bid, int nb) {
  int* ts = (int*)smem;
  build_tile_start(p, ts);
  unsigned char* ws = p.ws;
  const int* tkidx = (const int*)(ws + O_TKIDX); const int* tkpos = (const int*)(ws + O_TKPOS); const float* tkw = (const float*)(ws + O_TKW);
  int* slottok = (int*)(ws + O_SLOTTOK); float* slotw = (float*)(ws + O_SLOTW); int* slotaid = (int*)(ws + O_SLOTAID);
  for (int i = bid * NTHR + threadIdx.x; i < T * 8; i += nb * NTHR) {
    const int e = tkidx[i];
    const int slot = ts[e] * 128 + tkpos[i];
    slottok[slot] = i >> 3; slotw[slot] = tkw[i]; slotaid[slot] = i;
  }
}

DI int find_expert(const int* ts, int ti) { int lo = 0, hi = 255; while (lo < hi) { const int mid = (lo + hi + 1) >> 1; if (ts[mid] <= ti) lo = mid; else hi = mid - 1; } return lo; }

struct MoeUpF {
  const int* ts; unsigned char* ws; const float* wg; const float* wu; int ntile, G, c;
  DI bool next(int i, UnitF& u) const {
    const int L = i * G + (((G & 7) == 0) ? (c & 7) * (G >> 3) + (c >> 3) : c);
    if (L >= ntile * 2) return false;
    const int pn = L / ntile, ti = L - pn * ntile;
    const int e = find_expert(ts, ti);
    u.A = (const bf16_t*)(ws + O_X1B); u.rows = (const int*)(ws + O_SLOTTOK) + ti * 128; u.m0 = ti * 128; u.pn = pn; u.e = e;
    u.W0 = (pn ? wu : wg) + (size_t)e * 262144; u.W1 = u.W0 + 128;
    return true;
  }
};
struct MoeDownF {
  const int* ts; unsigned char* ws; const float* wd; int ntile, G, c;
  DI bool next(int i, UnitF& u) const {
    const int L = i * G + (((G & 7) == 0) ? (c & 7) * (G >> 3) + (c >> 3) : c);
    if (L >= ntile * 4) return false;
    const int pn = L / ntile, ti = L - pn * ntile;
    const int e = find_expert(ts, ti);
    u.A = (const bf16_t*)(ws + O_ACT); u.rows = nullptr; u.m0 = ti * 128; u.pn = pn; u.e = e;
    u.W0 = wd + (size_t)e * 262144 + 256 * pn; u.W1 = u.W0 + 128;
    return true;
  }
};
struct EpiActF {
  bf16_t* gu;
  struct Pre { int dummy; };
  DI void prefetch(const UnitF&, int, int, Pre& p) const { p.dummy = 0; }
  DI void operator()(const f32x4 (&acc)[4][4], const UnitF& u, int wr, int wc, int fr, int fq, const Pre&) const {
#pragma unroll
    for (int m = 0; m < 4; ++m) {
      const size_t row = (size_t)u.m0 + 64 * wr + 16 * m + fr;
#pragma unroll
      for (int r = 0; r < 4; ++r) {
        f32x4 o = {acc[m][0][r], acc[m][1][r], acc[m][2][r], acc[m][3][r]};
        if (u.pn == 0) { o[0] = siluf_(o[0]); o[1] = siluf_(o[1]); o[2] = siluf_(o[2]); o[3] = siluf_(o[3]); }
        *(u32x2*)(gu + row * 512 + 256 * u.pn + 64 * wc + 16 * fq + 4 * r) = pack4(o);
      }
    }
  }
};
struct EpiDownF {
  const int* slotaid; const float* slotw; unsigned char* ybase;
  struct Pre { int aid[4]; float ww[4]; };
  DI void prefetch(const UnitF& u, int wr, int fr, Pre& p) const {
    const unsigned slot0 = (unsigned)u.m0 + 64u * wr + fr;
#pragma unroll
    for (int m = 0; m < 4; ++m) { p.aid[m] = slotaid[slot0 + 16u * m]; p.ww[m] = slotw[slot0 + 16u * m]; }
  }
  DI void operator()(const f32x4 (&acc)[4][4], const UnitF& u, int wr, int wc, int fr, int fq, const Pre& p) const {
    const unsigned colb = ((unsigned)u.pn * 256u + 64u * wc + 16u * fq) * 2u;
#pragma unroll
    for (int m = 0; m < 4; ++m) {
      if (p.aid[m] >= 0) {
        const unsigned off = (unsigned)p.aid[m] * 2048u + colb;
#pragma unroll
        for (int r = 0; r < 4; ++r) {
          f32x4 o = {acc[m][0][r] * p.ww[m], acc[m][1][r] * p.ww[m], acc[m][2][r] * p.ww[m], acc[m][3][r] * p.ww[m]};
          *(u32x2*)(ybase + (size_t)(off + (unsigned)(8 * r))) = pack4(o);
        }
      }
    }
  }
};
struct EpiAct {
  bf16_t* actp;
  DI void operator()(const f32x4 (&acc)[2][2][4][2], const pg::Unit& u, int wr, int wc, int fr, int fq) const {
#pragma unroll
    for (int ai = 0; ai < 2; ++ai)
#pragma unroll
      for (int m = 0; m < 4; ++m) {
        const size_t row = (size_t)u.pm * 256 + 128 * ai + 64 * wr + 16 * m + fr;
#pragma unroll
        for (int bj = 0; bj < 2; ++bj) {
          const int blk = 8 * u.pn + 4 * bj + wc;
          const f32x4 g = acc[ai][bj][m][0], uu = acc[ai][bj][m][1];
          f32x4 o = {siluf_(g[0]) * uu[0], siluf_(g[1]) * uu[1], siluf_(g[2]) * uu[2], siluf_(g[3]) * uu[3]};
          *(u32x2*)(actp + row * 256 + blk * 16 + 4 * fq) = pack4(o);
        }
      }
  }
};
struct EpiBf16Out {
  bf16_t* dst;
  DI void operator()(const f32x4 (&acc)[2][2][4][2], const pg::Unit& u, int wr, int wc, int fr, int fq) const {
#pragma unroll
    for (int ai = 0; ai < 2; ++ai)
#pragma unroll
      for (int m = 0; m < 4; ++m) {
        const size_t row = (size_t)u.pm * 256 + 128 * ai + 64 * wr + 16 * m + fr;
#pragma unroll
        for (int bj = 0; bj < 2; ++bj)
#pragma unroll
          for (int n = 0; n < 2; ++n) *(u32x2*)(dst + row * 1024 + u.pn * 256 + 128 * bj + 32 * wc + 16 * n + 4 * fq) = pack4(acc[ai][bj][m][n]);
      }
  }
};
DI void phase11(const Params& p, unsigned char* smem, int bid, int nb) {
  unsigned char* ws = p.ws;
  int* ts = (int*)(smem + 131072);
  build_tile_start(p, ts);
  { MoeUpF S{ts, ws, p.in[I_WG], p.in[I_WU], ts[256], nb, bid}; EpiActF E{(bf16_t*)(ws + O_ACT)}; gemmF_phase<false, EpiActF, MoeUpF>(smem, 1024, 1024, 256, S, E); }
  __syncthreads();
  PG_LAS unsigned char* lds = (PG_LAS unsigned char*)smem;
  { pg::DenseOrder S; S.init(ws + O_X1B, ws + O_WSGU, T, 512, 1024, nb, bid); EpiAct E{(bf16_t*)(ws + O_ACTSH)}; pg::gemm_phase<EpiAct, pg::DenseOrder, false, true>(lds, 1024, S, E); }
}
DI void phase12(const Params& p, unsigned char* smem, int bid, int nb) {
  unsigned char* ws = p.ws;
  int* ts = (int*)(smem + 131072);
  build_tile_start(p, ts);
  { MoeDownF S{ts, ws, p.in[I_WDN], ts[256], nb, bid}; EpiDownF E{(const int*)(ws + O_SLOTAID), (const float*)(ws + O_SLOTW), ws + O_Y}; gemmF_phase<true, EpiDownF, MoeDownF>(smem, 256, 512, 1024, S, E); }
  __syncthreads();
  PG_LAS unsigned char* lds = (PG_LAS unsigned char*)smem;
  { pg::DenseOrder S; S.init(ws + O_ACTSH, ws + O_WSD, T, 1024, 256, nb, bid); EpiBf16Out E{(bf16_t*)(ws + O_YSH)}; pg::gemm_phase<EpiBf16Out, pg::DenseOrder, false, true>(lds, 256, S, E); }
}
DI void phase13(const Params& p, int bid, int nb) {
  int tid = threadIdx.x; asm volatile("" : "+v"(tid));
  const int lane = tid & 63, wave = tid >> 6;
  unsigned char* ws = p.ws;
  const float* x1 = (const float*)(ws + O_X1);
  const bf16_t* ysh = (const bf16_t*)(ws + O_YSH);
  const bf16_t* y = (const bf16_t*)(ws + O_Y);
  for (int row = bid * 8 + wave; row < T; row += nb * 8) {
    float v[16];
#pragma unroll
    for (int i = 0; i < 4; ++i) {
      const int k = 256 * i + 4 * lane;
      const f32x4 t = *(const f32x4*)(x1 + (size_t)row * D + k);
      const u32x2 s = *(const u32x2*)(ysh + (size_t)row * D + k);
      v[4 * i] = ALPHA * t[0] + lo2f(s[0]); v[4 * i + 1] = ALPHA * t[1] + hi2f(s[0]); v[4 * i + 2] = ALPHA * t[2] + lo2f(s[1]); v[4 * i + 3] = ALPHA * t[3] + hi2f(s[1]);
    }
#pragma unroll
    for (int k8 = 0; k8 < 8; ++k8) {
#pragma unroll
      for (int i = 0; i < 4; ++i) {
        const u32x2 s = *(const u32x2*)(y + ((size_t)row * 8 + k8) * 1024 + 256 * i + 4 * lane);
        v[4 * i] += lo2f(s[0]); v[4 * i + 1] += hi2f(s[0]); v[4 * i + 2] += lo2f(s[1]); v[4 * i + 3] += hi2f(s[1]);
      }
    }
    ln_row(nullptr, p.in[I_LN2G], p.in[I_LN2B], v, lane);
#pragma unroll
    for (int i = 0; i < 4; ++i) { const f32x4 o = {v[4 * i], v[4 * i + 1], v[4 * i + 2], v[4 * i + 3]}; *(f32x4*)(p.out + (size_t)row * D + 256 * i + 4 * lane) = o; }
  }
}

DI void load_params(Params& lp, const unsigned char* smem) {
  const unsigned* t = (const unsigned*)(smem + PTAB_OFF);
#pragma unroll
  for (int i = 0; i < 28; ++i) lp.in[i] = (const float*)(GAS const float*)(((unsigned long long)(unsigned)__builtin_amdgcn_readfirstlane((int)t[2 * i + 1]) << 32) | (unsigned)__builtin_amdgcn_readfirstlane((int)t[2 * i]));
  lp.out = (float*)(GAS float*)(((unsigned long long)(unsigned)__builtin_amdgcn_readfirstlane((int)t[57]) << 32) | (unsigned)__builtin_amdgcn_readfirstlane((int)t[56]));
  lp.ws = (unsigned char*)(GAS unsigned char*)(((unsigned long long)(unsigned)__builtin_amdgcn_readfirstlane((int)t[59]) << 32) | (unsigned)__builtin_amdgcn_readfirstlane((int)t[58]));
}
__global__ void __launch_bounds__(NTHR) mega_kernel(Params pk) {
  extern __shared__ __attribute__((aligned(16))) unsigned char smem[];
  cg::grid_group grid = cg::this_grid();
  const int bid = blockIdx.x, nb = gridDim.x;
  volatile LAS unsigned* bst = (volatile LAS unsigned*)(smem + LDS_BYTES - 16);
  if (threadIdx.x < 4) bst[threadIdx.x] = 0u;
  if (threadIdx.x < 30) {
    const __attribute__((address_space(4))) unsigned long long* ka = (const __attribute__((address_space(4))) unsigned long long*)__builtin_amdgcn_kernarg_segment_ptr();
    ((unsigned long long*)(smem + PTAB_OFF))[threadIdx.x] = ka[threadIdx.x];
  }
  unsigned* barw = (unsigned*)(pk.ws + O_BAR);
  __syncthreads();
  XcdBarrier xb = xcd_barrier_post(barw, bst);
#define GSYNC() xcd_barrier(xb)
#define RUNP(k, call) do { { Params p; load_params(p, smem); call; } GSYNC(); if (DUPMASK & (1 << (k))) { { Params p; load_params(p, smem); call; } GSYNC(); } } while (0)
  { Params p; load_params(p, smem); phase0(p, smem, bid, nb); } grid.sync();
  RUNP(1, phase1(p, smem, bid, nb));
  RUNP(2, phase2(p, smem, bid, nb));
  RUNP(3, phase3(p, smem, bid, nb));
  RUNP(4, phase4(p, bid, nb));
  RUNP(5, phase5(p, smem, bid, nb));
  RUNP(6, phase6(p, smem, bid, nb));
  RUNP(14, phase7(p, bid, nb));
  if (DUPMASK & (1 << 7)) { { Params p; load_params(p, smem); phase6(p, smem, bid, nb); } GSYNC(); { Params p; load_params(p, smem); phase7(p, bid, nb); } GSYNC(); }
  RUNP(8, phase8(p, smem, bid, nb));
  RUNP(14, phase9(p, bid, nb));
  if (DUPMASK & (1 << 9)) { { Params p; load_params(p, smem); if (bid == 0 && threadIdx.x < 256) ((int*)(p.ws + O_CTRL))[threadIdx.x * CSTR] = 0; } GSYNC(); { Params p; load_params(p, smem); phase9(p, bid, nb); } GSYNC(); }
  RUNP(10, phase10(p, smem, bid, nb));
  RUNP(11, phase11(p, smem, bid, nb));
#ifdef SHADOW
  { Params p; load_params(p, smem); unsigned char* ws = p.ws; int* ts = (int*)(smem + 131072); build_tile_start(p, ts);
    MoeUpF S{ts, ws, p.in[I_WG], p.in[I_WU], ts[256], nb, bid}; EpiActF E{(bf16_t*)(ws + O_Y)};
    gemmF_phase<false, EpiActF, MoeUpF, SHADOW>(smem, 1024, 1024, 256, S, E); }
  GSYNC();
#endif
  RUNP(12, phase12(p, smem, bid, nb));
  { Params p; load_params(p, smem); phase13(p, bid, nb); }
  if (DUPMASK & (1 << 13)) { GSYNC(); Params p; load_params(p, smem); phase13(p, bid, nb); }
  if (DUPMASK & (1 << 15)) { for (int i = 0; i < 10; ++i) GSYNC(); }
}

extern "C" void kernel_launch(void* const* d_in, const int* in_sizes, int n_in, void* d_out, int out_size, void* d_ws, size_t ws_size, hipStream_t stream) {
  if (n_in != 28 || ws_size < WS_NEED) { fprintf(stderr, "kernel_launch: unexpected inputs (%d) or workspace (%zu < %zu)\n", n_in, ws_size, (size_t)WS_NEED); return; }
  static int grid_blocks = 0;
  if (!grid_blocks) {
    int dev = 0, cus = 0, per_cu = 0;
    (void)hipGetDevice(&dev);
    (void)hipDeviceGetAttribute(&cus, hipDeviceAttributeMultiprocessorCount, dev);
    (void)hipFuncSetAttribute((const void*)mega_kernel, hipFuncAttributeMaxDynamicSharedMemorySize, LDS_BYTES);
    (void)hipOccupancyMaxActiveBlocksPerMultiprocessor(&per_cu, (const void*)mega_kernel, NTHR, LDS_BYTES);
    if (per_cu < 1) per_cu = 1;
    if (per_cu > 1) per_cu = 1;
    grid_blocks = cus * per_cu;
    if (grid_blocks < 32) grid_blocks = 32;
  }
  Params p{};
  for (int i = 0; i < 28; ++i) p.in[i] = (const float*)d_in[i];
  p.out = (float*)d_out; p.ws = (unsigned char*)d_ws;
  (void)hipMemsetAsync((unsigned char*)d_ws + O_BAR, 0, XCD_BAR_WORDS * 4, stream);
  void* args[] = {&p};
  hipError_t e = hipLaunchCooperativeKernel((const void*)mega_kernel, dim3(grid_blocks), dim3(NTHR), args, LDS_BYTES, stream);
  if (e != hipSuccess) fprintf(stderr, "cooperative launch failed: %s (grid %d)\n", hipGetErrorString(e), grid_blocks);
}
```

```cpp
#include <hip/hip_runtime.h>
#include <hip/hip_cooperative_groups.h>
#include <stdint.h>
#include <stdio.h>
namespace cg = cooperative_groups;

#define DI __device__ __forceinline__
#define LAS __attribute__((address_space(3)))
#define GAS __attribute__((address_space(1)))
typedef unsigned short bf16_t;
typedef short bf16x8 __attribute__((ext_vector_type(8)));
typedef float f32x4 __attribute__((ext_vector_type(4)));
typedef unsigned u32x4 __attribute__((ext_vector_type(4)));
typedef unsigned u32x2 __attribute__((ext_vector_type(2)));

#ifndef DUPMASK
#define DUPMASK 0
#endif
constexpr int NTHR = 512;
constexpr int T = 16384, SEQ = 8192, D = 1024;
constexpr int NPROJ = 6656;
constexpr int DIN = 6664;
constexpr int NEXP = 256, DEXP = 256;
constexpr int MAXSLOT = 131072 + 256 * 128;
constexpr float ALPHA = 1.189207115002721f;
constexpr int LDS_BYTES = 157696;

constexpr size_t MB = 1u << 20;
constexpr size_t O_WGU = 0;
constexpr size_t O_WD = 256 * MB;
constexpr size_t O_WSGU = 384 * MB;
constexpr size_t O_WSD = 385 * MB;
constexpr size_t O_ROUT = 385 * MB + 512 * 1024;
constexpr size_t O_CTRL = 386 * MB;
constexpr size_t O_BAR = 386 * MB + 128 * 1024;
constexpr int CSTR = 64;
constexpr size_t O_SUBBAR = 386 * MB + 128 * 1024 + 16384;
constexpr size_t O_IDENT = 386 * MB + 256 * 1024;
constexpr size_t O_X1 = 387 * MB;
constexpr size_t O_X1B = 451 * MB;
constexpr size_t R0 = 483 * MB;
constexpr size_t O_XB = R0 + 0;
constexpr size_t O_ST = R0 + 0;
constexpr size_t O_WINT = R0 + 32 * MB;
constexpr size_t O_WAT = R0 + 45 * MB;
constexpr size_t O_WBT = R0 + 46 * MB;
constexpr size_t O_WCT = R0 + 47 * MB;
constexpr size_t O_WOT = R0 + 48 * MB;
constexpr size_t O_WMKV = R0 + 50 * MB;
constexpr size_t O_MEMB = R0 + 52 * MB;
constexpr size_t O_SGUW = R0 + 53 * MB;
constexpr size_t O_AB = R0 + 53 * MB + 512 * 1024;
constexpr size_t O_MEMK = R0 + 54 * MB;
constexpr size_t O_MEMVT = R0 + 54 * MB + 512 * 1024;
constexpr size_t O_QKV = R0 + 55 * MB;
constexpr size_t O_PART = R0 + 55 * MB;
constexpr size_t O_ZS = R0 + 103 * MB;
constexpr size_t O_UVG = R0 + 119 * MB;
constexpr size_t O_MERGED = R0 + 119 * MB;
constexpr size_t O_XQ = R0 + 151 * MB;
constexpr size_t O_GATES = R0 + 167 * MB;
constexpr size_t O_MP = R0 + 263 * MB;
constexpr size_t O_BC = R0 + 295 * MB;
constexpr size_t O_O0 = R0 + 359 * MB;
constexpr size_t O_QP = R0 + 391 * MB;
constexpr size_t O_GL = R0 + 407 * MB;
constexpr size_t O_GDNO = R0 + 408 * MB;
constexpr size_t O_SGUO = R0 + 424 * MB;
constexpr size_t O_XATO = R0 + 440 * MB;
constexpr size_t O_LOGITS = R0 + 0;
constexpr size_t O_TKIDX = R0 + 16 * MB;
constexpr size_t O_TKW = R0 + 16 * MB + 512 * 1024;
constexpr size_t O_TKPOS = R0 + 17 * MB;
constexpr size_t O_SLOTTOK = R0 + 18 * MB;
constexpr size_t O_SLOTW = R0 + 19 * MB;
constexpr size_t O_SLOTAID = R0 + 20 * MB;
constexpr size_t O_ACT = R0 + 21 * MB;
constexpr size_t O_ACTSH = R0 + 181 * MB;
constexpr size_t O_YSH = R0 + 189 * MB;
constexpr size_t O_Y = R0 + 221 * MB;
constexpr size_t WS_NEED = R0 + 477 * MB;

struct Params {
  const float* in[28];
  float* out;
  unsigned char* ws;
};
enum { I_X = 0, I_MEM, I_WIN, I_CONVW, I_ALOG, I_DTB, I_GNG, I_WA, I_SLNG, I_SLNB, I_SGUW, I_SGUB, I_WB, I_WMKV, I_WC, I_WO,
       I_LN1G, I_LN1B, I_RW, I_RB, I_WG, I_WU, I_WDN, I_WSG, I_WSU, I_WSD, I_LN2G, I_LN2B };

constexpr int PTAB_OFF = 156672;
DI float bf2f(bf16_t h) { return __uint_as_float(((unsigned)h) << 16); }
DI bf16_t f2bf(float f) { unsigned u = __float_as_uint(f); u += 0x7fffu + ((u >> 16) & 1u); return (bf16_t)(u >> 16); }
typedef float f32x2_ __attribute__((ext_vector_type(2)));
typedef __bf16 bf16x2_ __attribute__((ext_vector_type(2)));
DI unsigned pk2(float lo, float hi) { f32x2_ v = {lo, hi}; return __builtin_bit_cast(unsigned, __builtin_convertvector(v, bf16x2_)); }
DI float lo2f(unsigned u) { return __uint_as_float(u << 16); }
DI float hi2f(unsigned u) { return __uint_as_float(u & 0xffff0000u); }
DI float sigmoidf_(float x) { return 1.f / (1.f + __expf(-x)); }
DI float siluf_(float x) { return x / (1.f + __expf(-x)); }
DI float geluf_(float x) { float u = 0.7978845608028654f * (x + 0.044715f * x * x * x); float t = 1.f - 2.f / (__expf(2.f * u) + 1.f); return 0.5f * x * (1.f + t); }
DI float softplusf_(float x) { return fmaxf(x, 0.f) + log1pf(__expf(-fabsf(x))); }
DI float wave_sum(float v) {
#pragma unroll
  for (int o = 32; o; o >>= 1) v += __shfl_xor(v, o);
  return v;
}
DI f32x4 mfma16(bf16x8 a, bf16x8 b, f32x4 c) { return __builtin_amdgcn_mfma_f32_16x16x32_bf16(a, b, c, 0, 0, 0); }
DI bf16x8 ldfrag(const void* p) { return __builtin_bit_cast(bf16x8, *(const u32x4*)p); }
DI bf16x8 pack8(f32x4 a, f32x4 b) { u32x4 r = {pk2(a[0], a[1]), pk2(a[2], a[3]), pk2(b[0], b[1]), pk2(b[2], b[3])}; return __builtin_bit_cast(bf16x8, r); }
DI u32x2 pack4(f32x4 a) { u32x2 r = {pk2(a[0], a[1]), pk2(a[2], a[3])}; return r; }
DI int sw128(int row, int chunk) { return row * 128 + ((chunk ^ (row & 7)) << 4); }
DI int sw256(int row, int chunk) { return row * 256 + ((chunk ^ (row & 15)) << 4); }

namespace pg {
#define PG_LAS __attribute__((address_space(3)))
constexpr int BM = 256, BK = 64, HALF = 128, HTB = HALF * BK * 2, NXCD = 8, WGM = 8;
DI int lds_byte(int r, int c) { const int st = (r >> 4) * 2 + (c >> 5), rr = r & 15, cc = c & 31, ob = rr * 64 + cc * 2; return st * 1024 + (ob ^ (((ob >> 9) & 1) << 5)); }
DI void stage_rc(int b, int& R, int& C) { const int st = b / 1024, sb = b % 1024, swz = sb ^ (((sb >> 9) & 1) << 5); R = (st >> 1) * 16 + swz / 64; C = (st & 1) * 32 + (swz % 64) / 2; }

struct Unit { const char* a; const char* b; const int* rows; int pm, pn, e; };

struct DenseOrder {
  const char* A; const char* B; int nM, nN, nwg, G, c; size_t tstep;
  DI void init(const void* A_, const void* B_, int M, int N, int K, int G_, int c_) { A = (const char*)A_; B = (const char*)B_; nM = M / BM; nN = N / BM; nwg = nM * nN; G = G_; c = c_; tstep = (size_t)BM * K * 2; }
  DI bool next(int i, Unit& u) const {
    const long L = (long)i * G + c; if (L >= nwg) return false;
    int wgid = (int)L; { const int q = nwg / NXCD, r = nwg % NXCD, xcd = wgid % NXCD, off = wgid / NXCD; wgid = (xcd < r ? xcd * (q + 1) : r * (q + 1) + (xcd - r) * q) + off; }
    const int nig = WGM * nN, gid = wgid / nig, fm = gid * WGM, gsz = (nM - fm) < WGM ? (nM - fm) : WGM;
    u.pm = fm + ((wgid % nig) % gsz); u.pn = (wgid % nig) / gsz; u.e = 0; u.rows = nullptr;
    u.a = A + (size_t)u.pm * tstep; u.b = B + (size_t)u.pn * tstep; return true;
  }
};

template <class Epi, class Sched, bool GATHER, bool ALIGN_EPI>
DI void gemm_phase(PG_LAS unsigned char* lds, const int K, const Sched& S, const Epi& E) {
  int tid = threadIdx.x; asm volatile("" : "+v"(tid));
  const int wid = __builtin_amdgcn_readfirstlane(tid >> 6), lane = tid & 63, wr = wid >> 2, wc = wid & 3, fr = lane & 15, fq = lane >> 4;
  const int nt = K / BK;
  int Rr[2], Cc[2];
  unsigned voffB[2];
#pragma unroll
  for (int i = 0; i < 2; ++i) { stage_rc(tid * 16 + i * 8192, Rr[i], Cc[i]); voffB[i] = (unsigned)(Rr[i] * K + Cc[i]) * 2u; }
  const size_t kstep = (size_t)(BK * 2);
  const size_t hstep = (size_t)HALF * K * 2;
  const unsigned ldsw = (unsigned)wid * 1024u;
  const int aoff = lds_byte(wr * 64 + fr, fq * 8), boff = lds_byte(wc * 32 + fr, fq * 8);
#define PG_SA(b, h) (((b) * 2 + (h)) * HTB)
#define PG_SB(b, h) ((4 + (b) * 2 + (h)) * HTB)
#define PG_STAGE(bufoff, gbase, v0, v1) do { \
    __builtin_amdgcn_global_load_lds((const unsigned*)((const char*)(gbase) + (v0)), (PG_LAS unsigned*)(lds + (bufoff) + ldsw), 16, 0, 0); \
    __builtin_amdgcn_global_load_lds((const unsigned*)((const char*)(gbase) + (v1)), (PG_LAS unsigned*)(lds + (bufoff) + ldsw + 8192), 16, 0, 0); } while (0)
#define PG_LDA(dst, b, h) do { _Pragma("unroll") for (int m = 0; m < 4; ++m) _Pragma("unroll") for (int k = 0; k < 2; ++k) dst[m][k] = *(const PG_LAS bf16x8*)(lds + PG_SA(b, h) + aoff + m * 2048 + k * 1024); } while (0)
#define PG_LDB(dst, b, h) do { _Pragma("unroll") for (int n = 0; n < 2; ++n) _Pragma("unroll") for (int k = 0; k < 2; ++k) dst[n][k] = *(const PG_LAS bf16x8*)(lds + PG_SB(b, h) + boff + n * 2048 + k * 1024); } while (0)
#define PG_MMA(ai, bj, At, Bt) do { __builtin_amdgcn_s_setprio(1); _Pragma("unroll") for (int m = 0; m < 4; ++m) _Pragma("unroll") for (int n = 0; n < 2; ++n) _Pragma("unroll") for (int k = 0; k < 2; ++k) \
    acc[ai][bj][m][n] = __builtin_amdgcn_mfma_f32_16x16x32_bf16(Bt[n][k], At[m][k], acc[ai][bj][m][n], 0, 0, 0); __builtin_amdgcn_s_setprio(0); } while (0)
#define PG_WAIT_V(n) asm volatile("s_waitcnt vmcnt(" #n ")" ::: "memory")
#define PG_WAIT_L(n) asm volatile("s_waitcnt lgkmcnt(" #n ")" ::: "memory")
#define PG_BAR __builtin_amdgcn_s_barrier()
#define PG_SCHED __builtin_amdgcn_sched_barrier(0)
#define PG_AOFFS(u, o00, o01, o10, o11) do { if (GATHER) { \
      o00 = (unsigned)(u).rows[Rr[0]] * (unsigned)(K * 2) + (unsigned)Cc[0] * 2u; o01 = (unsigned)(u).rows[Rr[1]] * (unsigned)(K * 2) + (unsigned)Cc[1] * 2u; \
      o10 = (unsigned)(u).rows[128 + Rr[0]] * (unsigned)(K * 2) + (unsigned)Cc[0] * 2u; o11 = (unsigned)(u).rows[128 + Rr[1]] * (unsigned)(K * 2) + (unsigned)Cc[1] * 2u; \
    } else { o00 = voffB[0]; o01 = voffB[1]; o10 = voffB[0] + (unsigned)hstep; o11 = voffB[1] + (unsigned)hstep; } } while (0)
  Unit cur, nxt; int ui = 0;
  if (!S.next(0, cur)) return;
  f32x4 acc[2][2][4][2];
#pragma unroll
  for (int a = 0; a < 2; ++a)
#pragma unroll
    for (int b = 0; b < 2; ++b)
#pragma unroll
      for (int m = 0; m < 4; ++m)
#pragma unroll
        for (int n = 0; n < 2; ++n) acc[a][b][m][n] = (f32x4){0.f, 0.f, 0.f, 0.f};
  bf16x8 At[4][2], B0[2][2], B1[2][2];
  const char* cA = cur.a; const char* cB = cur.b;
  unsigned c00, c01, c10, c11;
  PG_AOFFS(cur, c00, c01, c10, c11);
  const unsigned vb0 = voffB[0], vb1 = voffB[1];
  PG_STAGE(PG_SB(0, 0), cB, vb0, vb1); PG_STAGE(PG_SB(0, 1), cB + hstep, vb0, vb1); PG_STAGE(PG_SA(0, 0), cA, c00, c01); PG_STAGE(PG_SA(0, 1), cA, c10, c11);
  if (wr == 1) PG_BAR;
  PG_WAIT_V(2); PG_BAR;
  PG_STAGE(PG_SB(1, 0), cB + kstep, vb0, vb1); PG_STAGE(PG_SA(1, 0), cA + kstep, c00, c01); PG_STAGE(PG_SB(1, 1), cB + hstep + kstep, vb0, vb1);
  PG_WAIT_V(6); PG_BAR;
  for (;;) {
    const bool has_next = S.next(ui + 1, nxt);
    const char* nA = has_next ? nxt.a : cA; const char* nB = has_next ? nxt.b : cB;
    unsigned n00 = c00, n01 = c01, n10 = c10, n11 = c11;
    if (has_next) PG_AOFFS(nxt, n00, n01, n10, n11);
#pragma unroll 1
    for (int t = 0; t < nt; t += 2) {
      const bool last = (t == nt - 2);
      const char* a1 = cA + (size_t)(t + 1) * kstep;
      const char* a2 = last ? nA : cA + (size_t)(t + 2) * kstep; const char* b2 = last ? nB : cB + (size_t)(t + 2) * kstep;
      const char* a3 = a2 + kstep; const char* b3 = b2 + kstep;
      const unsigned o00 = last ? n00 : c00, o01 = last ? n01 : c01, o10 = last ? n10 : c10, o11 = last ? n11 : c11;
      PG_LDB(B0, 0, 0); PG_LDB(B1, 0, 1); PG_SCHED; PG_LDA(At, 0, 0); PG_STAGE(PG_SA(1, 1), a1, c10, c11);
      PG_WAIT_V(8); PG_WAIT_L(0); PG_BAR; PG_MMA(0, 0, At, B0); PG_MMA(0, 1, At, B1); PG_BAR; PG_SCHED;
      PG_LDA(At, 0, 1); PG_STAGE(PG_SB(0, 0), b2, vb0, vb1); PG_STAGE(PG_SB(0, 1), b2 + hstep, vb0, vb1); PG_STAGE(PG_SA(0, 0), a2, o00, o01);
      PG_WAIT_V(8); PG_WAIT_L(0); PG_BAR; PG_MMA(1, 0, At, B0); PG_MMA(1, 1, At, B1); PG_BAR; PG_SCHED;
      PG_LDB(B0, 1, 0); PG_LDB(B1, 1, 1); PG_SCHED; PG_LDA(At, 1, 0); PG_STAGE(PG_SA(0, 1), a2, o10, o11);
      PG_WAIT_V(8); PG_WAIT_L(0); PG_BAR; PG_MMA(0, 0, At, B0); PG_MMA(0, 1, At, B1); PG_BAR; PG_SCHED;
      PG_LDA(At, 1, 1); PG_STAGE(PG_SB(1, 0), b3, vb0, vb1); PG_STAGE(PG_SB(1, 1), b3 + hstep, vb0, vb1); PG_STAGE(PG_SA(1, 0), a3, o00, o01);
      PG_WAIT_V(8); PG_WAIT_L(0); PG_BAR; PG_MMA(1, 0, At, B0); PG_MMA(1, 1, At, B1); PG_BAR; PG_SCHED;
    }
    if constexpr (ALIGN_EPI) { if (wr == 0) PG_BAR; }
    E(acc, cur, wr, wc, fr, fq);
    if (!has_next) break;
#pragma unroll
    for (int a = 0; a < 2; ++a)
#pragma unroll
      for (int b = 0; b < 2; ++b)
#pragma unroll
        for (int m = 0; m < 4; ++m)
#pragma unroll
          for (int n = 0; n < 2; ++n) acc[a][b][m][n] = (f32x4){0.f, 0.f, 0.f, 0.f};
    cur = nxt; cA = nA; cB = nB; c00 = n00; c01 = n01; c10 = n10; c11 = n11; ++ui;
    if constexpr (ALIGN_EPI) { if (wr == 1) PG_BAR; }
  }
  PG_WAIT_V(0);
  if constexpr (!ALIGN_EPI) { if (wr == 0) PG_BAR; }
  PG_BAR;
#undef PG_SA
#undef PG_SB
#undef PG_STAGE
#undef PG_LDA
#undef PG_LDB
#undef PG_MMA
#undef PG_WAIT_V
#undef PG_WAIT_L
#undef PG_BAR
#undef PG_SCHED
#undef PG_AOFFS
}
}


struct UnitF { const bf16_t* A; const int* rows; const float* W0; const float* W1; int m0, pn, e; };

template <bool AMUL, class Epi, class Sched, int ABL = 0>
DI void gemmF_phase(unsigned char* smem_, const int K, const int lda, const int ldw, const Sched& S, const Epi& E) {
  int tid = threadIdx.x; asm volatile("" : "+v"(tid));
  unsigned char* smem; { LAS unsigned char* l_ = (LAS unsigned char*)smem_; asm volatile("" : "+v"(l_)); smem = (unsigned char*)l_; }
  const int lane = tid & 63, wid = tid >> 6, wr = wid >> 2, wc = wid & 3, fr = lane & 15, fq = lane >> 4;
  const int nk = K >> 6;
  const int ar0 = tid >> 3, ac = tid & 7;
  const int q = tid & 63, half = q >> 5, g0 = 4 * (q & 31);
  int vrow[4];
#pragma unroll
  for (int i = 0; i < 4; ++i) vrow[i] = 64 * (q >> 4) + 16 * i + (q & 15);
  const int aw0 = sw128(ar0, ac), aw1 = sw128(ar0 + 64, ac);
#define F_ROWS(u, rr0, rr1) do { rr0 = (u).rows ? (size_t)(u).rows[ar0] : (size_t)((u).m0 + ar0); rr1 = (u).rows ? (size_t)(u).rows[ar0 + 64] : (size_t)((u).m0 + ar0 + 64); } while (0)
#define F_LOAD(A_, W0_, W1_, rr0_, rr1_, kk_, va0, va1, vb0, vb1, vw) do { \
    va0 = *(const u32x4*)((A_) + (rr0_) * lda + (kk_) * 64 + ac * 8); va1 = *(const u32x4*)((A_) + (rr1_) * lda + (kk_) * 64 + ac * 8); \
    if (AMUL) { vb0 = *(const u32x4*)((A_) + (rr0_) * lda + 256 + (kk_) * 64 + ac * 8); vb1 = *(const u32x4*)((A_) + (rr1_) * lda + 256 + (kk_) * 64 + ac * 8); } \
    const float* wp_ = (half ? (W1_) : (W0_)) + (size_t)((kk_) * 64 + 8 * wid) * ldw + g0; \
    if (ABL != 1) { _Pragma("unroll") for (int j = 0; j < 8; ++j) vw[j] = *(const f32x4*)(wp_ + (size_t)j * ldw); } } while (0)
#define F_LOADX(kx, va0, va1, vb0, vb1, vw) do { const bool nx_ = (kx) >= nk; const int kk2_ = nx_ ? (kx) - nk : (kx); \
    const bf16_t* A2_ = nx_ ? nxt.A : cur.A; const float* W02_ = nx_ ? nxt.W0 : cur.W0; const float* W12_ = nx_ ? nxt.W1 : cur.W1; \
    const size_t q0_ = nx_ ? nr0 : r0, q1_ = nx_ ? nr1 : r1; \
    F_LOAD(A2_, W02_, W12_, q0_, q1_, kk2_, va0, va1, vb0, vb1, vw); } while (0)
#define F_STORE(st, va0, va1, vb0, vb1, vw) do { unsigned char* sa_ = smem + (st) * 49152; \
    if (AMUL) { _Pragma("unroll") for (int e_ = 0; e_ < 4; ++e_) { va0[e_] = pk2(lo2f(va0[e_]) * lo2f(vb0[e_]), hi2f(va0[e_]) * hi2f(vb0[e_])); va1[e_] = pk2(lo2f(va1[e_]) * lo2f(vb1[e_]), hi2f(va1[e_]) * hi2f(vb1[e_])); } } \
    *(u32x4*)(sa_ + aw0) = va0; *(u32x4*)(sa_ + aw1) = va1; \
    if (ABL != 3) { _Pragma("unroll") for (int i = 0; i < 4; ++i) { \
      u32x4 o_ = {pk2(vw[0][i], vw[1][i]), pk2(vw[2][i], vw[3][i]), pk2(vw[4][i], vw[5][i]), pk2(vw[6][i], vw[7][i])}; \
      *(u32x4*)(sa_ + 16384 + sw128(vrow[i], wid)) = o_; } } else { _Pragma("unroll") for (int j = 0; j < 8; ++j) asm volatile("" :: "v"(vw[j])); } } while (0)
#define F_LBAR() do { asm volatile("s_waitcnt lgkmcnt(0)" ::: "memory"); __builtin_amdgcn_s_barrier(); asm volatile("" ::: "memory"); } while (0)
#define F_COMPUTE(st) do { const unsigned char* sA = smem + (st) * 49152; const unsigned char* sB = sA + 16384; \
    _Pragma("unroll") for (int ks = 0; ks < 2; ++ks) { bf16x8 af[4], bfr[4]; \
      _Pragma("unroll") for (int m = 0; m < 4; ++m) af[m] = ldfrag(sA + sw128(64 * wr + 16 * m + fr, 4 * ks + fq)); \
      _Pragma("unroll") for (int n = 0; n < 4; ++n) bfr[n] = ldfrag(sB + sw128(64 * wc + 16 * n + fr, 4 * ks + fq)); \
      if (ABL != 2) { _Pragma("unroll") for (int m = 0; m < 4; ++m) _Pragma("unroll") for (int n = 0; n < 4; ++n) acc[m][n] = mfma16(bfr[n], af[m], acc[m][n]); } \
      else { _Pragma("unroll") for (int m = 0; m < 4; ++m) _Pragma("unroll") for (int n = 0; n < 4; ++n) asm volatile("" :: "v"(af[m]), "v"(bfr[n])); } } } while (0)
  UnitF cur, nxt; int ui = 0;
  if (!S.next(0, cur)) return;
  size_t r0, r1, nr0, nr1;
  F_ROWS(cur, r0, r1);
  bool has_next = S.next(1, nxt);
  if (has_next) F_ROWS(nxt, nr0, nr1); else { nxt = cur; nr0 = r0; nr1 = r1; }
  f32x4 acc[4][4];
#pragma unroll
  for (int m = 0; m < 4; ++m)
#pragma unroll
    for (int n = 0; n < 4; ++n) acc[m][n] = (f32x4){0.f, 0.f, 0.f, 0.f};
  u32x4 xa0, xa1, ya0, ya1, xb0, xb1, yb0, yb1; f32x4 xw[8], yw[8];
  xb0 = xb1 = yb0 = yb1 = (u32x4){0u, 0u, 0u, 0u};
  if (ABL == 1) { _Pragma("unroll") for (int j = 0; j < 8; ++j) { xw[j] = (f32x4){0.f, 0.f, 0.f, 0.f}; yw[j] = xw[j]; } }
  F_LOAD(cur.A, cur.W0, cur.W1, r0, r1, 0, xa0, xa1, xb0, xb1, xw);
  F_LOAD(cur.A, cur.W0, cur.W1, r0, r1, 1, ya0, ya1, yb0, yb1, yw);
  __syncthreads();
  F_STORE(0, xa0, xa1, xb0, xb1, xw);
  F_LBAR();
  int st = 0;
  for (;;) {
    typename Epi::Pre pre; E.prefetch(cur, wr, fr, pre);
#pragma unroll 1
    for (int kt = 0; kt < nk; kt += 2) {
      F_LOADX(kt + 2, xa0, xa1, xb0, xb1, xw);
      F_COMPUTE(st);
      F_STORE(st ^ 1, ya0, ya1, yb0, yb1, yw);
      F_LBAR();
      F_LOADX(kt + 3, ya0, ya1, yb0, yb1, yw);
      F_COMPUTE(st ^ 1);
      F_STORE(st, xa0, xa1, xb0, xb1, xw);
      F_LBAR();
    }
    if (ABL != 4) E(acc, cur, wr, wc, fr, fq, pre); else { _Pragma("unroll") for (int m = 0; m < 4; ++m) _Pragma("unroll") for (int n = 0; n < 4; ++n) asm volatile("" :: "v"(acc[m][n])); }
#pragma unroll
    for (int m = 0; m < 4; ++m)
#pragma unroll
      for (int n = 0; n < 4; ++n) acc[m][n] = (f32x4){0.f, 0.f, 0.f, 0.f};
    if (!has_next) break;
    cur = nxt; r0 = nr0; r1 = nr1; ++ui;
    has_next = S.next(ui + 1, nxt);
    if (has_next) F_ROWS(nxt, nr0, nr1); else { nxt = cur; nr0 = r0; nr1 = r1; }
  }
  asm volatile("s_waitcnt vmcnt(0)" ::: "memory");
  __syncthreads();
#undef F_ROWS
#undef F_LOAD
#undef F_LOADX
#undef F_STORE
#undef F_LBAR
#undef F_COMPUTE
}

#define XB_TMO      128
#define XB_XCNT(j)  (256  + 64 * (j))
#define XB_XSUB(j)  (1280 + 64 * (j))
#define XB_XGEN(j)  (2304 + 64 * (j))
#define XB_TOP      3328
#define XB_TOPGEN   3392
#define XCD_BAR_WORDS 3456
#define XB_SPIN_CAP (1u << 22)
DI unsigned xb_ld(unsigned* p)              { return __hip_atomic_load(p, __ATOMIC_RELAXED, __HIP_MEMORY_SCOPE_AGENT); }
DI unsigned xb_add(unsigned* p, unsigned v) { return __hip_atomic_fetch_add(p, v, __ATOMIC_RELAXED, __HIP_MEMORY_SCOPE_AGENT); }
DI unsigned xb_xcc_id() { return (unsigned)__builtin_amdgcn_s_getreg((3 << 11) | 20) & 0xFu; }
#define XB_SPIN(cond, bar) do { unsigned _sp = 0; while (cond) { __builtin_amdgcn_s_sleep(1); \
    if ((++_sp & 255u) == 0u) { if (xb_ld(&(bar)[XB_TMO])) break; if (_sp > XB_SPIN_CAP) { atomicAdd(&(bar)[XB_TMO], 1u); break; } } } } while (0)
struct XcdBarrier { unsigned* bar; unsigned x; volatile LAS unsigned* st; };
DI XcdBarrier xcd_barrier_post(unsigned* bar, volatile LAS unsigned* st) {
  XcdBarrier b; b.bar = bar; b.x = xb_xcc_id(); b.st = st;
  if (threadIdx.x == 0) (void)xb_add(&bar[XB_XCNT(b.x)], 1u);
  return b;
}
DI void xcd_barrier_complete(unsigned* bar, unsigned x, unsigned& nloc, unsigned& nx) {
  const unsigned G = gridDim.x * gridDim.y * gridDim.z;
  unsigned sum, cnt, mine, sp = 0u;
  for (;;) {
    sum = 0u; cnt = 0u; mine = 0u;
#pragma unroll
    for (unsigned j = 0; j < 16; ++j) { const unsigned c = xb_ld(&bar[XB_XCNT(j)]); sum += c; cnt += (c > 0u) ? 1u : 0u; mine = (j == x) ? c : mine; }
    if (sum == G) break;
    __builtin_amdgcn_s_sleep(1);
    if ((++sp & 255u) == 0u) { if (xb_ld(&bar[XB_TMO])) break; if (sp > XB_SPIN_CAP) { atomicAdd(&bar[XB_TMO], 1u); break; } }
  }
  nloc = mine > 0u ? mine : 1u; nx = cnt > 0u ? cnt : 1u;
}
DI void xcd_barrier(const XcdBarrier& b) {
  asm volatile("s_waitcnt vmcnt(0)" ::: "memory");
  __syncthreads();
  if (threadIdx.x == 0) {
    unsigned* bar = b.bar;
    __builtin_amdgcn_s_waitcnt(0);
    unsigned nloc = b.st[0], nx = b.st[1];
    if (nloc == 0u) { xcd_barrier_complete(bar, b.x, nloc, nx); b.st[0] = nloc; b.st[1] = nx; }
    const unsigned old = xb_add(&bar[XB_XSUB(b.x)], 1u);
    const unsigned gen = old / nloc;
    if (old + 1u == (gen + 1u) * nloc) {
      __builtin_amdgcn_fence(__ATOMIC_RELEASE, "agent");
      asm volatile("s_waitcnt vmcnt(0)" ::: "memory");
      const unsigned og = xb_add(&bar[XB_TOP], 1u);
      const unsigned tg = og / nx;
      if (og + 1u == (tg + 1u) * nx) xb_add(&bar[XB_TOPGEN], 1u);
      else XB_SPIN(xb_ld(&bar[XB_TOPGEN]) == tg, bar);
      __builtin_amdgcn_fence(__ATOMIC_ACQUIRE, "agent");
      xb_add(&bar[XB_XGEN(b.x)], 1u);
      asm volatile("s_waitcnt vmcnt(0)" ::: "memory");
    } else {
      XB_SPIN(xb_ld(&bar[XB_XGEN(b.x)]) == gen, bar);
      __builtin_amdgcn_fence(__ATOMIC_ACQUIRE, "agent");
      asm volatile("s_waitcnt vmcnt(0)" ::: "memory");
    }
  }
  __syncthreads();
}

DI void phase0(const Params& p, unsigned char* smem, int bid, int nb) {
  int tid = threadIdx.x; asm volatile("" : "+v"(tid));
  const int lane = tid & 63, wave = tid >> 6;
  unsigned char* ws = p.ws;
  if (bid == 0 && tid < 256) ((int*)(ws + O_CTRL))[tid * CSTR] = 0;
  for (int i = bid * NTHR + tid; i < T; i += nb * NTHR) ((int*)(ws + O_IDENT))[i] = i;
  {
    float* wabT = (float*)smem;
    const float* win = p.in[I_WIN];
    for (int i = tid; i < 8192; i += NTHR) { const int k = i >> 3, j = i & 7; wabT[j * 1024 + k] = win[(size_t)k * DIN + 2048 + j]; }
    __syncthreads();
    const float* x = p.in[I_X];
    bf16_t* xb = (bf16_t*)(ws + O_XB);
    float* ab = (float*)(ws + O_AB);
    for (int row = bid * 8 + wave; row < T; row += nb * 8) {
      float s[8];
#pragma unroll
      for (int j = 0; j < 8; ++j) s[j] = 0.f;
#pragma unroll
      for (int i = 0; i < 4; ++i) {
        const int k = 256 * i + 4 * lane;
        const f32x4 v = *(const f32x4*)(x + (size_t)row * D + k);
        *(u32x2*)(xb + (size_t)row * D + k) = pack4(v);
#pragma unroll
        for (int j = 0; j < 8; ++j) { const f32x4 w = *(const f32x4*)(wabT + j * 1024 + k); s[j] += v[0] * w[0] + v[1] * w[1] + v[2] * w[2] + v[3] * w[3]; }
      }
#pragma unroll
      for (int j = 0; j < 8; ++j) s[j] = wave_sum(s[j]);
      if (lane == 0) { *(f32x4*)(ab + (size_t)row * 8) = (f32x4){s[0], s[1], s[2], s[3]}; *(f32x4*)(ab + (size_t)row * 8 + 4) = (f32x4){s[4], s[5], s[6], s[7]}; }
    }
    const float* mem = p.in[I_MEM];
    bf16_t* memb = (bf16_t*)(ws + O_MEMB);
    for (int row = bid * 8 + wave; row < 512; row += nb * 8) {
#pragma unroll
      for (int i = 0; i < 4; ++i) { const int k = 256 * i + 4 * lane; *(u32x2*)(memb + (size_t)row * D + k) = pack4(*(const f32x4*)(mem + (size_t)row * D + k)); }
    }
    const float* sw = p.in[I_SGUW];
    bf16_t* sguw = (bf16_t*)(ws + O_SGUW);
    for (int i = bid * NTHR + tid; i < 16384; i += nb * NTHR) {
      const int e0 = i * 4; const int col = e0 & 127, rowi = (e0 >> 7) & 127;
      f32x4 v = *(const f32x4*)(sw + e0);
#pragma unroll
      for (int c = 0; c < 4; ++c) if (col + c > rowi) v[c] = 0.f;
      *(u32x2*)(sguw + e0) = pack4(v);
    }
    __syncthreads();
  }
  {
    float* tile = (float*)smem;
    const float *pwin = p.in[I_WIN], *pwa = p.in[I_WA], *pwb = p.in[I_WB], *pwc = p.in[I_WC], *pwo = p.in[I_WO], *pwmkv = p.in[I_WMKV], *prw = p.in[I_RW],
                *pwsg = p.in[I_WSG], *pwsu = p.in[I_WSU], *pwsd = p.in[I_WSD], *pwg = p.in[I_WG], *pwu = p.in[I_WU], *pwdn = p.in[I_WDN];
    { GAS const float *a_ = (GAS const float*)pwa, *b_ = (GAS const float*)pwb, *c_ = (GAS const float*)pwc, *o_ = (GAS const float*)pwo, *m_ = (GAS const float*)pwmkv;
      asm volatile("" : "+s"(a_), "+s"(b_), "+s"(c_), "+s"(o_), "+s"(m_));
      pwa = (const float*)a_; pwb = (const float*)b_; pwc = (const float*)c_; pwo = (const float*)o_; pwmkv = (const float*)m_; }
    constexpr int J0 = 1664, J1 = J0 + 128, J2 = J1 + 128, J3 = J2 + 128, J4 = J3 + 256, J5 = J4 + 256, J6 = J5 + 64, J7 = J6 + 128, J8 = J7 + 64,
                  J9 = J8, J10 = J8;
    const int kr = tid >> 4, nc = tid & 15, sg = nc >> 2;
    const int tn = tid >> 3, tkc = tid & 7;
#define P0_DECODE_LOAD(it0, dp, v0, v1) do { const float* sp[4]; int ld[4]; \
      _Pragma("unroll") \
      for (int q = 0; q < 4; ++q) { \
        const int it = (it0 + q < J10) ? it0 + q : J10 - 1;      \
        const float *s0, *s1, *s2, *s3; int ldd; bf16_t* dst; \
        if (it < J0) {           \
          const int kt = it & 15, nt = it >> 4; const int n0 = nt * 64; const int c0 = n0 + (n0 >= 2048 ? 8 : 0); \
          const float* b = pwin + (size_t)kt * 64 * DIN + c0; s0 = b; s1 = b + 16; s2 = b + 32; s3 = b + 48; ld[q] = DIN; ldd = 1024; \
          dst = (bf16_t*)(ws + O_WINT) + (size_t)n0 * 1024 + kt * 64; \
        } else if (it < J3) {    \
          const int which = (it - J0) >> 7, r = (it - J0) & 127; const int kt = r & 7, nt = r >> 3; \
          const float* src = which == 0 ? pwa : which == 1 ? pwb : pwc; \
          const float* b = src + (size_t)kt * 64 * 1024 + nt * 64; s0 = b; s1 = b + 16; s2 = b + 32; s3 = b + 48; ld[q] = 1024; ldd = 512; \
          dst = (bf16_t*)(ws + (which == 0 ? O_WAT : which == 1 ? O_WBT : O_WCT)) + (size_t)nt * 64 * 512 + kt * 64; \
        } else if (it < J5) {    \
          const int which = (it - J3) >> 8, r = (it - J3) & 255; const int kt = r & 15, nt = r >> 4; \
          const float* b = (which == 0 ? pwo : pwmkv) + (size_t)kt * 64 * 1024 + nt * 64; s0 = b; s1 = b + 16; s2 = b + 32; s3 = b + 48; ld[q] = 1024; ldd = 1024; \
          dst = (bf16_t*)(ws + (which == 0 ? O_WOT : O_WMKV)) + (size_t)nt * 64 * 1024 + kt * 64; \
        } else if (it < J6) {    \
          const int r = it - J5; const int kt = r & 15, nt = r >> 4; \
          const float* b = prw + (size_t)kt * 64 * 256 + nt * 64; s0 = b; s1 = b + 16; s2 = b + 32; s3 = b + 48; ld[q] = 256; ldd = 1024; \
          dst = (bf16_t*)(ws + O_ROUT) + (size_t)nt * 64 * 1024 + kt * 64; \
        } else if (it < J7) {    \
          const int r = it - J6; const int kt = r & 15, nt = r >> 4; \
          const float* g = pwsg + (size_t)kt * 64 * 256 + nt * 32; const float* u = pwsu + (size_t)kt * 64 * 256 + nt * 32; \
          s0 = g; s1 = u; s2 = g + 16; s3 = u + 16; ld[q] = 256; ldd = 1024; \
          dst = (bf16_t*)(ws + O_WSGU) + (size_t)nt * 64 * 1024 + kt * 64; \
        } else if (it < J8) {    \
          const int r = it - J7; const int kt = r & 3, nt = r >> 2; \
          const float* b = pwsd + (size_t)kt * 64 * 1024 + nt * 64; s0 = b; s1 = b + 16; s2 = b + 32; s3 = b + 48; ld[q] = 1024; ldd = 256; \
          dst = (bf16_t*)(ws + O_WSD) + (size_t)nt * 64 * 256 + kt * 64; \
        } else if (it < J9) {    \
          const int r = it - J8; const int e = r >> 7, qq = r & 127; const int kt = qq & 15, nt = qq >> 4; \
          const float* g = pwg + (size_t)e * 262144 + (size_t)kt * 64 * 256 + nt * 32; const float* u = pwu + (size_t)e * 262144 + (size_t)kt * 64 * 256 + nt * 32; \
          s0 = g; s1 = u; s2 = g + 16; s3 = u + 16; ld[q] = 256; ldd = 1024; \
          dst = (bf16_t*)(ws + O_WGU) + (size_t)e * 524288 + (size_t)nt * 64 * 1024 + kt * 64; \
        } else {                 \
          const int r = it - J9; const int e = r >> 6, qq = r & 63; const int kt = qq & 3, nt = qq >> 2; \
          const float* b = pwdn + (size_t)e * 262144 + (size_t)kt * 64 * 1024 + nt * 64; s0 = b; s1 = b + 16; s2 = b + 32; s3 = b + 48; ld[q] = 1024; ldd = 256; \
          dst = (bf16_t*)(ws + O_WD) + (size_t)e * 262144 + (size_t)nt * 64 * 256 + kt * 64; \
        } \
        sp[q] = (sg == 0 ? s0 : sg == 1 ? s1 : sg == 2 ? s2 : s3) + (size_t)kr * ld[q] + 4 * (nc & 3); \
        dp[q] = dst + (size_t)tn * ldd + 8 * tkc; \
      } \
      _Pragma("unroll") \
      for (int q = 0; q < 4; ++q) { v0[q] = __builtin_nontemporal_load((const f32x4*)(sp[q])); v1[q] = __builtin_nontemporal_load((const f32x4*)(sp[q] + (size_t)32 * ld[q])); } } while (0)
    bf16_t* dpn[4]; f32x4 v0n[4], v1n[4];
    int it0 = bid * 4;
    if (it0 < J10) P0_DECODE_LOAD(it0, dpn, v0n, v1n);
    for (; it0 < J10; it0 += nb * 4) {
      bf16_t* dp[4]; f32x4 v0[4], v1[4];
#pragma unroll
      for (int q = 0; q < 4; ++q) { dp[q] = dpn[q]; v0[q] = v0n[q]; v1[q] = v1n[q]; }
      if (it0 + nb * 4 < J10) P0_DECODE_LOAD(it0 + nb * 4, dpn, v0n, v1n);
      asm volatile("s_waitcnt lgkmcnt(0)" ::: "memory"); __builtin_amdgcn_s_barrier(); asm volatile("" ::: "memory");
#pragma unroll
      for (int q = 0; q < 4; ++q) {
        float* t0 = tile + q * 4160 + kr * 65 + 4 * nc;
        float* t1 = t0 + 32 * 65;
        t0[0] = v0[q][0]; t0[1] = v0[q][1]; t0[2] = v0[q][2]; t0[3] = v0[q][3];
        t1[0] = v1[q][0]; t1[1] = v1[q][1]; t1[2] = v1[q][2]; t1[3] = v1[q][3];
      }
      asm volatile("s_waitcnt lgkmcnt(0)" ::: "memory"); __builtin_amdgcn_s_barrier(); asm volatile("" ::: "memory");
#pragma unroll
      for (int q = 0; q < 4; ++q) {
        float e[8];
#pragma unroll
        for (int j = 0; j < 8; ++j) e[j] = tile[q * 4160 + (8 * tkc + j) * 65 + tn];
        u32x4 o = {pk2(e[0], e[1]), pk2(e[2], e[3]), pk2(e[4], e[5]), pk2(e[6], e[7])};
        *(u32x4*)(dp[q]) = o;
      }
    }
#undef P0_DECODE_LOAD
  }
}

#define EPI_ROWS(u) const int row_ = (u).pm * 256 + 64 * wr + fr
struct EpiInProj {
  unsigned char* ws;
  DI void operator()(const f32x4 (&acc)[2][2][4][2], const pg::Unit& u, int wr, int wc, int fr, int fq) const {
    const int colt = u.pn * 256;
#pragma unroll
    for (int ai = 0; ai < 2; ++ai)
#pragma unroll
      for (int m = 0; m < 4; ++m) {
        const size_t row = (size_t)u.pm * 256 + 128 * ai + 64 * wr + 16 * m + fr;
#pragma unroll
        for (int bj = 0; bj < 2; ++bj)
#pragma unroll
          for (int n = 0; n < 2; ++n) {
            const int col = colt + 128 * bj + 32 * wc + 16 * n + 4 * fq;
            f32x4 v = acc[ai][bj][m][n];
            if (colt < 1536) { *(u32x2*)((bf16_t*)(ws + O_QKV) + row * 1536 + col) = pack4(v); }
            else if (colt < 2048) {
#pragma unroll
              for (int c = 0; c < 4; ++c) v[c] = siluf_(v[c]);
              *(u32x2*)((bf16_t*)(ws + O_ZS) + row * 512 + (col - 1536)) = pack4(v);
            } else if (colt < 3072) {
#pragma unroll
              for (int c = 0; c < 4; ++c) v[c] = geluf_(v[c]);
              *(u32x2*)((bf16_t*)(ws + O_UVG) + row * 1024 + (col - 2048)) = pack4(v);
            } else if (colt < 3584) {
#pragma unroll
              for (int c = 0; c < 4; ++c) v[c] *= 0.08838834764831845f;
              *(u32x2*)((bf16_t*)(ws + O_XQ) + row * 512 + (col - 3072)) = pack4(v);
            } else {
#pragma unroll
              for (int c = 0; c < 4; ++c) v[c] = sigmoidf_(v[c]);
              *(u32x2*)((bf16_t*)(ws + O_GATES) + row * 3072 + (col - 3584)) = pack4(v);
            }
          }
      }
  }
};
struct EpiMemKV {
  unsigned char* ws;
  DI void operator()(const f32x4 (&acc)[2][2][4][2], const pg::Unit& u, int wr, int wc, int fr, int fq) const {
#pragma unroll
    for (int ai = 0; ai < 2; ++ai)
#pragma unroll
      for (int m = 0; m < 4; ++m) {
        const int row = u.pm * 256 + 128 * ai + 64 * wr + 16 * m + fr; const int b = row >> 8, key = row & 255;
#pragma unroll
        for (int bj = 0; bj < 2; ++bj)
#pragma unroll
          for (int n = 0; n < 2; ++n) {
            const int col = u.pn * 256 + 128 * bj + 32 * wc + 16 * n + 4 * fq;
            const f32x4 v = acc[ai][bj][m][n];
            if (col < 512) { const int h = col >> 7, d = col & 127; *(u32x2*)((bf16_t*)(ws + O_MEMK) + ((size_t)((b * 4 + h) * 256 + key)) * 128 + d) = pack4(v); }
            else {
              const int c2 = col - 512; const int h = c2 >> 7, d = c2 & 127;
              const int pos = 32 * (key >> 5) + 8 * ((key >> 2) & 3) + 4 * ((key >> 4) & 1) + (key & 3);
              bf16_t* vt = (bf16_t*)(ws + O_MEMVT) + ((size_t)((b * 4 + h) * 128 + d)) * 256 + pos;
#pragma unroll
              for (int c = 0; c < 4; ++c) vt[(size_t)c * 256] = f2bf(v[c]);
            }
          }
      }
  }
};
DI void phase1(const Params& p, unsigned char* smem, int bid, int nb) {
  unsigned char* ws = p.ws;
  PG_LAS unsigned char* lds = (PG_LAS unsigned char*)smem;
  __syncthreads();
  { pg::DenseOrder S; S.init(ws + O_XB, ws + O_WINT, T, NPROJ, 1024, nb, bid); EpiInProj E{ws}; pg::gemm_phase<EpiInProj, pg::DenseOrder, false, true>(lds, 1024, S, E); }
  __syncthreads();
  { pg::DenseOrder S; S.init(ws + O_MEMB, ws + O_WMKV, 512, 1024, 1024, nb, bid); EpiMemKV E{ws}; pg::gemm_phase<EpiMemKV, pg::DenseOrder, false, true>(lds, 1024, S, E); }
}

constexpr int G_KF = 0, G_VF = 32768, G_QB = 65536, G_KB = 81920, G_UT = 81920  , G_L = 98304, G_ATT = 114688, G_KDT = 122880, G_WT = 139264, G_SM = 155648;

DI void gdn_prep_item(const Params& p, unsigned char* smem_, int item) {
  unsigned char* smem; { LAS unsigned char* l_ = (LAS unsigned char*)smem_; asm volatile("" : "+v"(l_)); smem = (unsigned char*)l_; }
  int tid = threadIdx.x; asm volatile("" : "+v"(tid));
  const int lane = tid & 63, wave = tid >> 6, fr = lane & 15, fq = lane >> 4;
  unsigned char* ws; { GAS unsigned char* g_ = (GAS unsigned char*)p.ws; asm volatile("" : "+s"(g_)); ws = (unsigned char*)g_; }
  const int h = item & 3, cn = item >> 2;
  const int bidx = cn >> 7, n = cn & 127;
  const size_t t0 = (size_t)bidx * SEQ + (size_t)n * 64;
  float* kf = (float*)(smem + G_KF); float* vf = (float*)(smem + G_VF); float* Lm = (float*)(smem + G_L);
  float* sbeta = (float*)(smem + G_SM); float* sgc = sbeta + 64; float* segc = sbeta + 128;
  __syncthreads();
  {
    const bf16_t* qkv = (const bf16_t*)(ws + O_QKV);
    const float* cw = p.in[I_CONVW];
    const int tl0 = wave * 8;
#pragma unroll
    for (int sect = 0; sect < 3; ++sect) {
      const int cb = sect * 512 + h * 128 + 2 * lane;
      float w0[4], w1[4];
#pragma unroll
      for (int i = 0; i < 4; ++i) { w0[i] = cw[i * 1536 + cb]; w1[i] = cw[i * 1536 + cb + 1]; }
      float xa[11], xc[11];
#pragma unroll
      for (int r = 0; r < 11; ++r) {
        const int s = n * 64 + tl0 + r - 3;
        unsigned u = 0u;
        if (s >= 0) u = *(const unsigned*)(qkv + ((size_t)bidx * SEQ + s) * 1536 + cb);
        xa[r] = lo2f(u); xc[r] = hi2f(u);
      }
#pragma unroll
      for (int r = 0; r < 8; ++r) {
        float y0 = w0[0] * xa[r] + w0[1] * xa[r + 1] + w0[2] * xa[r + 2] + w0[3] * xa[r + 3];
        float y1 = w1[0] * xc[r] + w1[1] * xc[r + 1] + w1[2] * xc[r + 2] + w1[3] * xc[r + 3];
        y0 = siluf_(y0); y1 = siluf_(y1);
        const int tl = tl0 + r;
        if (sect == 2) { vf[tl * 128 + 2 * lane] = y0; vf[tl * 128 + 2 * lane + 1] = y1; }
        else {
          const float ss = wave_sum(y0 * y0 + y1 * y1);
          const float sc = rsqrtf(ss + 1e-6f) * (sect == 0 ? 0.08838834764831845f : 1.0f);
          y0 *= sc; y1 *= sc;
          const int off = sw256(tl, lane >> 2) + (lane & 3) * 4;
          if (sect == 0) *(unsigned*)(smem + G_QB + off) = pk2(y0, y1);
          else { *(unsigned*)(smem + G_KB + off) = pk2(y0, y1); kf[tl * 128 + 2 * lane] = y0; kf[tl * 128 + 2 * lane + 1] = y1; }
        }
      }
    }
    if (wave == 0) {
      const float* ab = (const float*)(ws + O_AB) + (t0 + lane) * 8;
      const float a = ab[h], bb = ab[4 + h];
      const float beta = sigmoidf_(bb);
      float g = -__expf(p.in[I_ALOG][h]) * softplusf_(a + p.in[I_DTB][h]);
#pragma unroll
      for (int o = 1; o < 64; o <<= 1) { const float y = __shfl_up(g, o); if (lane >= o) g += y; }
      sbeta[lane] = beta; sgc[lane] = g; segc[lane] = __expf(g);
      if (lane == 63) ((float*)(ws + O_GL))[item] = __expf(g);
    }
  }
  __syncthreads();
  {
#pragma unroll
    for (int q = 0; q < 4; ++q) {
      const int idx = wave * 4 + q; const int isq = idx >> 4, ti = (idx >> 2) & 3, tj = idx & 3;
      f32x4 acc = {0.f, 0.f, 0.f, 0.f};
      if (tj <= ti) {
#pragma unroll
        for (int ks = 0; ks < 4; ++ks) {
          const bf16x8 ai = ldfrag(smem + (isq ? G_QB : G_KB) + sw256(16 * ti + fr, 4 * ks + fq));
          const bf16x8 bj = ldfrag(smem + G_KB + sw256(16 * tj + fr, 4 * ks + fq));
          acc = isq ? mfma16(bj, ai, acc) : mfma16(ai, bj, acc);
        }
      }
      if (isq) {
        const int i = 16 * ti + fr, j0 = 16 * tj + 4 * fq;
        const float gi = sgc[i];
        f32x4 o;
#pragma unroll
        for (int r = 0; r < 4; ++r) { const int j = j0 + r; o[r] = (j <= i) ? acc[r] * __expf(gi - sgc[j]) : 0.f; }
        *(u32x2*)(smem + G_ATT + sw128(i, j0 >> 3) + (j0 & 7) * 2) = pack4(o);
      } else {
        const int j = 16 * tj + fr, i0 = 16 * ti + 4 * fq;
        const float gj = sgc[j];
        f32x4 o;
#pragma unroll
        for (int r = 0; r < 4; ++r) { const int i = i0 + r; o[r] = (j < i) ? acc[r] * __expf(sgc[i] - gj) * sbeta[i] : 0.f; }
        *(f32x4*)(Lm + j * 64 + i0) = o;
      }
    }
  }
  {
    const float gl_ = sgc[63];
    const int d = tid & 127, tg = tid >> 7;
#pragma unroll
    for (int c = 0; c < 2; ++c) {
      float e[8];
#pragma unroll
      for (int j = 0; j < 8; ++j) { const int t = 16 * tg + 8 * c + j; e[j] = kf[t * 128 + d] * __expf(gl_ - sgc[t]); }
      u32x4 o = {pk2(e[0], e[1]), pk2(e[2], e[3]), pk2(e[4], e[5]), pk2(e[6], e[7])};
      *(u32x4*)(smem + G_KDT + sw128(d, 2 * tg + c)) = o;
    }
  }
  __syncthreads();
  if (tid < 256) {
    const bool isw = tid >= 128;
    float* X = isw ? (kf + (tid - 128)) : (vf + tid);
    unsigned char* dstT = smem + (isw ? G_WT : G_UT);
    const int rowc = tid & 127;
#pragma unroll
    for (int b = 0; b < 4; ++b) {
      float xr[16];
#pragma unroll
      for (int r = 0; r < 16; ++r) { const int t = 16 * b + r; float sc = sbeta[t]; if (isw) sc *= segc[t]; xr[r] = X[t * 128] * sc; }
#pragma unroll 2
      for (int j = 0; j < 16 * b; ++j) {
        const float xj = X[j * 128];
        const float* lt = Lm + j * 64 + 16 * b;
        const f32x4 l0 = *(const f32x4*)lt, l1 = *(const f32x4*)(lt + 4), l2 = *(const f32x4*)(lt + 8), l3 = *(const f32x4*)(lt + 12);
#pragma unroll
        for (int r = 0; r < 4; ++r) { xr[r] -= l0[r] * xj; xr[4 + r] -= l1[r] * xj; xr[8 + r] -= l2[r] * xj; xr[12 + r] -= l3[r] * xj; }
      }
#pragma unroll
      for (int q = 0; q < 15; ++q) {
        const float* lt = Lm + (16 * b + q) * 64 + 16 * b;
        float l[16];
#pragma unroll
        for (int g4 = 0; g4 < 4; ++g4) if (4 * g4 + 3 > q) { const f32x4 t4 = *(const f32x4*)(lt + 4 * g4); l[4 * g4] = t4[0]; l[4 * g4 + 1] = t4[1]; l[4 * g4 + 2] = t4[2]; l[4 * g4 + 3] = t4[3]; }
#pragma unroll
        for (int r = q + 1; r < 16; ++r) xr[r] -= l[r] * xr[q];
      }
#pragma unroll
      for (int r = 0; r < 16; ++r) X[(16 * b + r) * 128] = xr[r];
      u32x4 o0 = {pk2(xr[0], xr[1]), pk2(xr[2], xr[3]), pk2(xr[4], xr[5]), pk2(xr[6], xr[7])};
      u32x4 o1 = {pk2(xr[8], xr[9]), pk2(xr[10], xr[11]), pk2(xr[12], xr[13]), pk2(xr[14], xr[15])};
      *(u32x4*)(dstT + sw128(rowc, 2 * b)) = o0;
      *(u32x4*)(dstT + sw128(rowc, 2 * b + 1)) = o1;
    }
  }
  __syncthreads();
  {
    bf16x8 ak[2];
#pragma unroll
    for (int ks = 0; ks < 2; ++ks) ak[ks] = ldfrag(smem + G_KDT + sw128(16 * wave + fr, 4 * ks + fq));
    bf16_t* mp = (bf16_t*)(ws + O_MP) + (size_t)item * 16384;
    float* bc = (float*)(ws + O_BC) + (size_t)item * 16384;
#pragma unroll
    for (int tj = 0; tj < 8; ++tj) {
      f32x4 am = {0.f, 0.f, 0.f, 0.f}, ab_ = {0.f, 0.f, 0.f, 0.f};
#pragma unroll
      for (int ks = 0; ks < 2; ++ks) {
        const bf16x8 bw = ldfrag(smem + G_WT + sw128(16 * tj + fr, 4 * ks + fq));
        const bf16x8 bu = ldfrag(smem + G_UT + sw128(16 * tj + fr, 4 * ks + fq));
        am = mfma16(bw, ak[ks], am);
        ab_ = mfma16(ak[ks], bu, ab_);
      }
      f32x4 nm = {-am[0], -am[1], -am[2], -am[3]};
      *(u32x2*)(mp + ((size_t)((wave * 4 + (tj >> 1)) * 64 + lane)) * 8 + (tj & 1) * 4) = pack4(nm);
      *(f32x4*)(bc + ((size_t)((tj * 8 + wave) * 64 + lane)) * 4) = ab_;
    }
    const int tt = wave & 3, hf = wave >> 2;
    bf16x8 aa[2];
#pragma unroll
    for (int ks = 0; ks < 2; ++ks) aa[ks] = ldfrag(smem + G_ATT + sw128(16 * tt + fr, 4 * ks + fq));
    const int trow = 16 * tt + fr;
    const float eg = segc[trow];
    float* o0 = (float*)(ws + O_O0) + (t0 + trow) * 512 + h * 128;
    bf16_t* qp = (bf16_t*)(ws + O_QP) + (size_t)item * 8192 + trow * 128;
#pragma unroll
    for (int q = 0; q < 4; ++q) {
      const int te = hf * 4 + q;
      f32x4 ao = {0.f, 0.f, 0.f, 0.f}, aw = {0.f, 0.f, 0.f, 0.f};
#pragma unroll
      for (int ks = 0; ks < 2; ++ks) {
        const bf16x8 bu = ldfrag(smem + G_UT + sw128(16 * te + fr, 4 * ks + fq));
        const bf16x8 bw = ldfrag(smem + G_WT + sw128(16 * te + fr, 4 * ks + fq));
        ao = mfma16(bu, aa[ks], ao);
        aw = mfma16(bw, aa[ks], aw);
      }
      const int e0 = 16 * te + 4 * fq;
      *(f32x4*)(o0 + e0) = ao;
      const u32x2 qv = *(const u32x2*)(smem + G_QB + sw256(trow, e0 >> 3) + (e0 & 7) * 2);
      f32x4 qd = {lo2f(qv[0]) * eg - aw[0], hi2f(qv[0]) * eg - aw[1], lo2f(qv[1]) * eg - aw[2], hi2f(qv[1]) * eg - aw[3]};
      *(u32x2*)(qp + e0) = pack4(qd);
    }
  }
}

typedef short s16x4 __attribute__((ext_vector_type(4)));
DI bf16x8 tr_frag(const unsigned char* p0, const unsigned char* p1) {
  const s16x4 a = __builtin_amdgcn_ds_read_tr16_b64_v4i16((LAS s16x4*)p0), b = __builtin_amdgcn_ds_read_tr16_b64_v4i16((LAS s16x4*)p1);
  bf16x8 r; r[0] = a[0]; r[1] = a[1]; r[2] = a[2]; r[3] = a[3]; r[4] = b[0]; r[5] = b[1]; r[6] = b[2]; r[7] = b[3]; return r;
}
DI void sgu_item(const Params& p, unsigned char* smem_, int item) {
  unsigned char* smem; { LAS unsigned char* l_ = (LAS unsigned char*)smem_; asm volatile("" : "+v"(l_)); smem = (unsigned char*)l_; }
  int tid = threadIdx.x; asm volatile("" : "+v"(tid));
  const int lane = tid & 63, wave = __builtin_amdgcn_readfirstlane(tid >> 6), fr = lane & 15, fq = lane >> 4;
  unsigned char* ws; { GAS unsigned char* g_ = (GAS unsigned char*)p.ws; asm volatile("" : "+s"(g_)); ws = (unsigned char*)g_; }
  const int gp = item & 1, cn = item >> 1;
  const size_t t0 = (size_t)cn * 128;
  const bf16_t* uvg = (const bf16_t*)(ws + O_UVG);
  constexpr int VS = 544;
  __syncthreads();
  {
    const float* lng = p.in[I_SLNG]; const float* lnb = p.in[I_SLNB];
    float gg[8], bb[8];
#pragma unroll
    for (int e = 0; e < 8; ++e) { gg[e] = lng[8 * lane + e]; bb[e] = lnb[8 * lane + e]; }
#pragma unroll 2
    for (int jj = 0; jj < 16; ++jj) {
      const int j = 16 * wave + jj;
      const u32x4 raw = *(const u32x4*)(uvg + (t0 + j) * 1024 + 512 + 8 * lane);
      float v[8];
#pragma unroll
      for (int e = 0; e < 4; ++e) { v[2 * e] = lo2f(raw[e]); v[2 * e + 1] = hi2f(raw[e]); }
      float s = 0.f, q2 = 0.f;
#pragma unroll
      for (int e = 0; e < 8; ++e) { s += v[e]; q2 += v[e] * v[e]; }
      s = wave_sum(s); q2 = wave_sum(q2);
      const float mean = s * (1.f / 512.f);
      const float rstd = rsqrtf(fmaxf(q2 * (1.f / 512.f) - mean * mean, 0.f) + 1e-5f);
      if ((lane >> 5) == gp) {
        float y[8];
#pragma unroll
        for (int e = 0; e < 8; ++e) y[e] = (v[e] - mean) * rstd * gg[e] + bb[e];
        u32x4 o = {pk2(y[0], y[1]), pk2(y[2], y[3]), pk2(y[4], y[5]), pk2(y[6], y[7])};
        *(u32x4*)(smem + j * VS + (lane & 31) * 16) = o;
      }
    }
  }
  __syncthreads();
  {
    const int i = 16 * wave + fr;
    const int q = (lane & 15) >> 2, pp = lane & 3;
    const unsigned char* vb = smem + (8 * fq + q) * VS + 8 * pp;
#pragma unroll 1
    for (int gl = 0; gl < 2; ++gl) {
      const int g = 2 * gp + gl;
      const bf16_t* wg = (const bf16_t*)(ws + O_SGUW) + (size_t)g * 16384;
      bf16x8 af[4];
#pragma unroll
      for (int ks = 0; ks < 4; ++ks) af[ks] = ldfrag(wg + i * 128 + 32 * ks + 8 * fq);
      const float bias = p.in[I_SGUB][g * 128 + i];
      bf16_t* out = (bf16_t*)(ws + O_SGUO) + (t0 + i) * 512 + 128 * g;
      const bf16_t* urow = uvg + (t0 + i) * 1024 + 128 * g;
#pragma unroll
      for (int jt = 0; jt < 8; ++jt) {
        f32x4 acc = {0.f, 0.f, 0.f, 0.f};
#pragma unroll
        for (int ks = 0; ks < 4; ++ks) {
          const unsigned char* a0 = vb + ks * 32 * VS + (128 * gl + 16 * jt) * 2;
          acc = mfma16(tr_frag(a0, a0 + 4 * VS), af[ks], acc);
        }
        const int c0 = 16 * jt + 4 * fq;
        const u32x2 uu = *(const u32x2*)(urow + c0);
        f32x4 o = {lo2f(uu[0]) * (acc[0] + bias), hi2f(uu[0]) * (acc[1] + bias), lo2f(uu[1]) * (acc[2] + bias), hi2f(uu[1]) * (acc[3] + bias)};
        *(u32x2*)(out + c0) = pack4(o);
        if (jt & 1) __builtin_amdgcn_sched_barrier(0);
      }
    }
  }
}

DI void xattn_item(const Params& p, unsigned char* smem_, int item) {
  int tid = threadIdx.x; asm volatile("" : "+v"(tid));
  unsigned char* smem; { LAS unsigned char* l_ = (LAS unsigned char*)smem_; asm volatile("" : "+v"(l_)); smem = (unsigned char*)l_; }
  const int lane = tid & 63, wave = tid >> 6, fr = lane & 15, fq = lane >> 4;
  unsigned char* ws; { GAS unsigned char* g_ = (GAS unsigned char*)p.ws; asm volatile("" : "+s"(g_)); ws = (unsigned char*)g_; }
  const int bh = item & 7, qb = item >> 3;
  const int b = bh >> 2, h = bh & 3;
  const bf16_t* mk = (const bf16_t*)(ws + O_MEMK) + (size_t)bh * 32768;
  const bf16_t* mv = (const bf16_t*)(ws + O_MEMVT) + (size_t)bh * 32768;
  __syncthreads();
#pragma unroll 2
  for (int j = 0; j < 8; ++j) {
    const int c = tid + 512 * j;
    const int rk = c >> 4, ck = c & 15;
    *(u32x4*)(smem + sw256(rk, ck)) = *(const u32x4*)(mk + (size_t)c * 8);
    const int rv = c >> 5, cv = c & 31;
    *(u32x4*)(smem + 65536 + rv * 512 + ((cv ^ (rv & 15)) << 4)) = *(const u32x4*)(mv + (size_t)c * 8);
  }
  __syncthreads();
  const unsigned char* kbase[4]; const unsigned char* vbase[8];
#pragma unroll
  for (int ds = 0; ds < 4; ++ds) kbase[ds] = smem + fr * 256 + (((4 * ds + fq) ^ fr) << 4);
#pragma unroll
  for (int s = 0; s < 8; ++s) vbase[s] = smem + 65536 + fr * 512 + (((4 * s + fq) ^ fr) << 4);
#pragma unroll 1
  for (int half = 0; half < 2; ++half) {
    const size_t trow = (size_t)b * SEQ + (size_t)qb * 256 + half * 128 + 16 * wave + fr;
    const bf16_t* xq = (const bf16_t*)(ws + O_XQ) + trow * 512 + h * 128;
    bf16x8 qf[4];
#pragma unroll
    for (int ds = 0; ds < 4; ++ds) qf[ds] = ldfrag(xq + 32 * ds + 8 * fq);
    f32x4 sc[16];
#pragma unroll
    for (int kt = 0; kt < 16; ++kt) {
      f32x4 a = {0.f, 0.f, 0.f, 0.f};
#pragma unroll
      for (int ds = 0; ds < 4; ++ds) a = mfma16(ldfrag(kbase[ds] + kt * 4096), qf[ds], a);
      sc[kt] = a;
      if (kt & 1) __builtin_amdgcn_sched_barrier(0);
    }
    float m = -1e30f;
#pragma unroll
    for (int kt = 0; kt < 16; ++kt)
#pragma unroll
      for (int r = 0; r < 4; ++r) m = fmaxf(m, sc[kt][r]);
    m = fmaxf(m, __shfl_xor(m, 16)); m = fmaxf(m, __shfl_xor(m, 32));
    float l = 0.f;
#pragma unroll
    for (int kt = 0; kt < 16; ++kt)
#pragma unroll
      for (int r = 0; r < 4; ++r) { const float e = __expf(sc[kt][r] - m); sc[kt][r] = e; l += e; }
    l += __shfl_xor(l, 16); l += __shfl_xor(l, 32);
    const float inv = 1.f / l;
    bf16x8 pf[8];
#pragma unroll
    for (int s = 0; s < 8; ++s) pf[s] = pack8(sc[2 * s], sc[2 * s + 1]);
    bf16_t* out = (bf16_t*)(ws + O_XATO) + trow * 512 + h * 128;
#pragma unroll
    for (int dt = 0; dt < 8; ++dt) {
      f32x4 a = {0.f, 0.f, 0.f, 0.f};
#pragma unroll
      for (int s = 0; s < 8; ++s) a = mfma16(ldfrag(vbase[s] + dt * 8192), pf[s], a);
      __builtin_amdgcn_sched_barrier(0);
      f32x4 o = {a[0] * inv, a[1] * inv, a[2] * inv, a[3] * inv};
      *(u32x2*)(out + 16 * dt + 4 * fq) = pack4(o);
    }
  }
}

DI void phase2(const Params& p, unsigned char* smem, int bid, int nb) {
  for (int rep = 0; rep < ((DUPMASK >> 20) & 1) + 1; ++rep) for (int it = bid; it < 1024; it += nb) gdn_prep_item(p, smem, it);
  for (int rep = 0; rep < ((DUPMASK >> 21) & 1) + 1; ++rep) for (int it = bid; it < 256; it += nb) sgu_item(p, smem, it);
  for (int rep = 0; rep < ((DUPMASK >> 22) & 1) + 1; ++rep) for (int it = bid; it < 256; it += nb) xattn_item(p, smem, it);
}

DI void gdn_scan4(const Params& p, unsigned char* smem_, int bh, int es) {
  int tid = threadIdx.x; asm volatile("" : "+v"(tid));
  unsigned char* smem; { LAS unsigned char* l_ = (LAS unsigned char*)smem_; asm volatile("" : "+v"(l_)); smem = (unsigned char*)l_; }
  const int lane = tid & 63, w = __builtin_amdgcn_readfirstlane(tid >> 6);
  if (w >= 4) {
    for (int n = 0; n < 128; ++n) __builtin_amdgcn_s_barrier();
    return;
  }
  unsigned char* ws = p.ws;
  const int b = bh >> 2, h = bh & 3;
  const int fr = lane & 15, fq = lane >> 4;
  const size_t item0 = (size_t)(b * 128) * 4 + h;
  constexpr size_t ISTR = 4 * 16384;
  const bf16_t* mp = (const bf16_t*)(ws + O_MP) + item0 * 16384 + (size_t)(2 * w) * 2048 + lane * 8;
  const float* bc = (const float*)(ws + O_BC) + item0 * 16384 + (size_t)es * 2048 + (size_t)(2 * w) * 256 + lane * 4;
  bf16_t* st = (bf16_t*)(ws + O_ST) + item0 * 16384 + (size_t)(16 * es + fr) * 128 + 32 * w + 4 * fq;
  const float* glp = (const float*)(ws + O_GL) + item0;
  { GAS const float* g_ = (GAS const float*)glp; asm volatile("" : "+v"(g_)); glp = (const float*)g_; }
  f32x4 acc0 = {0.f, 0.f, 0.f, 0.f}, acc1 = {0.f, 0.f, 0.f, 0.f};
  constexpr int PD = 2;
  bf16x8 A[PD][8]; f32x4 C[PD][2]; float G[PD];
#pragma unroll
  for (int d = 0; d < PD; ++d) {
#pragma unroll
    for (int i = 0; i < 8; ++i) A[d][i] = ldfrag(mp + (size_t)d * ISTR + i * 512);
    C[d][0] = *(const f32x4*)(bc + (size_t)d * ISTR); C[d][1] = *(const f32x4*)(bc + (size_t)d * ISTR + 256);
    G[d] = glp[d * 4];
  }
  unsigned char* xch = smem;
  for (int n0 = 0; n0 < 128; n0 += PD) {
#pragma unroll
    for (int d = 0; d < PD; ++d) {
      const int n = n0 + d;
      const int np = (n + PD < 128) ? n + PD : n;
      const u32x2 lo = pack4(acc0), hi = pack4(acc1);
      bf16_t* stn = st + (size_t)n * ISTR;
      *(u32x2*)(stn) = lo; *(u32x2*)(stn + 16) = hi;
      const u32x4 mine = {lo[0], lo[1], hi[0], hi[1]};
      *(u32x4*)(xch + ((n & 1) * 4 + w) * 1024 + lane * 16) = mine;
      asm volatile("s_waitcnt lgkmcnt(0)" ::: "memory");
      __builtin_amdgcn_s_barrier();
      asm volatile("" ::: "memory");
      bf16x8 bfr[4];
#pragma unroll
      for (int s = 0; s < 4; ++s) bfr[s] = ldfrag(xch + ((n & 1) * 4 + s) * 1024 + lane * 16);
      const float g = G[d];
      f32x4 a0 = {g * acc0[0] + C[d][0][0], g * acc0[1] + C[d][0][1], g * acc0[2] + C[d][0][2], g * acc0[3] + C[d][0][3]};
      f32x4 a1 = {g * acc1[0] + C[d][1][0], g * acc1[1] + C[d][1][1], g * acc1[2] + C[d][1][2], g * acc1[3] + C[d][1][3]};
#pragma unroll
      for (int s = 0; s < 4; ++s) { a0 = mfma16(A[d][s], bfr[s], a0); a1 = mfma16(A[d][4 + s], bfr[s], a1); }
      acc0 = a0; acc1 = a1;
#pragma unroll
      for (int i = 0; i < 8; ++i) A[d][i] = ldfrag(mp + (size_t)np * ISTR + i * 512);
      C[d][0] = *(const f32x4*)(bc + (size_t)np * ISTR); C[d][1] = *(const f32x4*)(bc + (size_t)np * ISTR + 256);
      G[d] = glp[(size_t)np * 4];
    }
  }
}

struct EpiGate {
  const bf16_t* gates; int goff; const bf16_t* src; bf16_t* dst;
  DI void operator()(const f32x4 (&acc)[2][2][4][2], const pg::Unit& u, int wr, int wc, int fr, int fq) const {
#pragma unroll
    for (int ai = 0; ai < 2; ++ai)
#pragma unroll
      for (int m = 0; m < 4; ++m) {
        const size_t row = (size_t)u.pm * 256 + 128 * ai + 64 * wr + 16 * m + fr;
#pragma unroll
        for (int bj = 0; bj < 2; ++bj)
#pragma unroll
          for (int n = 0; n < 2; ++n) {
            const int col = u.pn * 256 + 128 * bj + 32 * wc + 16 * n + 4 * fq;
            const f32x4 v = acc[ai][bj][m][n];
            const u32x2 g = *(const u32x2*)(gates + row * 3072 + goff + col);
            f32x4 o = {lo2f(g[0]) * v[0], hi2f(g[0]) * v[1], lo2f(g[1]) * v[2], hi2f(g[1]) * v[3]};
            if (src) { const u32x2 s = *(const u32x2*)(src + row * 1024 + col); o[0] += lo2f(s[0]); o[1] += hi2f(s[0]); o[2] += lo2f(s[1]); o[3] += hi2f(s[1]); }
            *(u32x2*)(dst + row * 1024 + col) = pack4(o);
          }
      }
  }
};
DI void phase3(const Params& p, unsigned char* smem, int bid, int nb) {
  unsigned char* ws = p.ws;
  if (bid < 64) {
    __syncthreads();
    gdn_scan4(p, smem, bid & 7, bid >> 3);
  } else {
    PG_LAS unsigned char* lds = (PG_LAS unsigned char*)smem;
    const bf16_t* gates = (const bf16_t*)(ws + O_GATES);
    bf16_t* part = (bf16_t*)(ws + O_PART);
    __syncthreads();
    { pg::DenseOrder S; S.init(ws + O_SGUO, ws + O_WBT, T, 1024, 512, nb - 64, bid - 64); EpiGate E{gates, 1024, nullptr, part}; pg::gemm_phase<EpiGate, pg::DenseOrder, false, true>(lds, 512, S, E); }
    asm volatile("s_waitcnt vmcnt(0)" ::: "memory");
    __builtin_amdgcn_fence(__ATOMIC_ACQUIRE, "agent");
    asm volatile("s_waitcnt vmcnt(0)" ::: "memory");
    __syncthreads();
    { pg::DenseOrder S; S.init(ws + O_XATO, ws + O_WCT, T, 1024, 512, nb - 64, bid - 64); EpiGate E{gates, 2048, part, part}; pg::gemm_phase<EpiGate, pg::DenseOrder, false, true>(lds, 512, S, E); }
  }
}

DI void phase4(const Params& p, int bid, int nb) {
  int tid = threadIdx.x; asm volatile("" : "+v"(tid));
  const int lane = tid & 63, wave = tid >> 6, fr = lane & 15, fq = lane >> 4;
  unsigned char* ws = p.ws;
  for (int it = bid; it < 512; it += nb) {
    const int item = it * 2 + (wave >> 2), tt = wave & 3;
    const int h = item & 3, cn = item >> 2;
    const size_t trow = (size_t)cn * 64 + 16 * tt + fr;
    const bf16_t* qp = (const bf16_t*)(ws + O_QP) + (size_t)item * 8192 + (16 * tt + fr) * 128;
    const bf16_t* st = (const bf16_t*)(ws + O_ST) + (size_t)item * 16384;
    const float* o0 = (const float*)(ws + O_O0) + trow * 512 + h * 128;
    bf16x8 af[4];
#pragma unroll
    for (int ks = 0; ks < 4; ++ks) af[ks] = ldfrag(qp + 32 * ks + 8 * fq);
    f32x4 acc[8];
    float ss = 0.f;
#pragma unroll
    for (int j = 0; j < 8; ++j) {
      f32x4 a = *(const f32x4*)(o0 + 16 * j + 4 * fq);
#pragma unroll
      for (int ks = 0; ks < 4; ++ks) a = mfma16(ldfrag(st + (16 * j + fr) * 128 + 32 * ks + 8 * fq), af[ks], a);
      acc[j] = a;
      ss += a[0] * a[0] + a[1] * a[1] + a[2] * a[2] + a[3] * a[3];
    }
    ss += __shfl_xor(ss, 16); ss += __shfl_xor(ss, 32);
    const float rms = rsqrtf(ss * (1.f / 128.f) + 1e-6f);
    const float* ng = p.in[I_GNG];
    const bf16_t* zs = (const bf16_t*)(ws + O_ZS) + trow * 512 + h * 128;
    bf16_t* out = (bf16_t*)(ws + O_GDNO) + trow * 512 + h * 128;
#pragma unroll
    for (int j = 0; j < 8; ++j) {
      const int e0 = 16 * j + 4 * fq;
      const f32x4 g = *(const f32x4*)(ng + e0);
      const u32x2 z = *(const u32x2*)(zs + e0);
      f32x4 o = {acc[j][0] * rms * g[0] * lo2f(z[0]), acc[j][1] * rms * g[1] * hi2f(z[0]), acc[j][2] * rms * g[2] * lo2f(z[1]), acc[j][3] * rms * g[3] * hi2f(z[1])};
      *(u32x2*)(out + e0) = pack4(o);
    }
  }
}

DI void phase5(const Params& p, unsigned char* smem, int bid, int nb) {
  unsigned char* ws = p.ws;
  PG_LAS unsigned char* lds = (PG_LAS unsigned char*)smem;
  __syncthreads();
  pg::DenseOrder S; S.init(ws + O_GDNO, ws + O_WAT, T, 1024, 512, nb, bid);
  EpiGate E{(const bf16_t*)(ws + O_GATES), 0, (const bf16_t*)(ws + O_PART), (bf16_t*)(ws + O_MERGED)};
  pg::gemm_phase<EpiGate, pg::DenseOrder, false, true>(lds, 512, S, E);
}
struct EpiX1 {
  const float* x; float* x1;
  DI void operator()(const f32x4 (&acc)[2][2][4][2], const pg::Unit& u, int wr, int wc, int fr, int fq) const {
#pragma unroll
    for (int ai = 0; ai < 2; ++ai)
#pragma unroll
      for (int m = 0; m < 4; ++m) {
        const size_t row = (size_t)u.pm * 256 + 128 * ai + 64 * wr + 16 * m + fr;
#pragma unroll
        for (int bj = 0; bj < 2; ++bj)
#pragma unroll
          for (int n = 0; n < 2; ++n) {
            const int col = u.pn * 256 + 128 * bj + 32 * wc + 16 * n + 4 * fq;
            const f32x4 v = acc[ai][bj][m][n];
            const f32x4 xv = *(const f32x4*)(x + row * 1024 + col);
            f32x4 o = {ALPHA * xv[0] + v[0], ALPHA * xv[1] + v[1], ALPHA * xv[2] + v[2], ALPHA * xv[3] + v[3]};
            *(f32x4*)(x1 + row * 1024 + col) = o;
          }
      }
  }
};
DI void phase6(const Params& p, unsigned char* smem, int bid, int nb) {
  unsigned char* ws = p.ws;
  PG_LAS unsigned char* lds = (PG_LAS unsigned char*)smem;
  __syncthreads();
  pg::DenseOrder S; S.init(ws + O_MERGED, ws + O_WOT, T, 1024, 1024, nb, bid);
  EpiX1 E{p.in[I_X], (float*)(ws + O_X1)};
  pg::gemm_phase<EpiX1, pg::DenseOrder, false, false>(lds, 1024, S, E);
}

DI void ln_row(const float* src, const float* g, const float* b, float (&v)[16], int lane) {
  float s = 0.f;
#pragma unroll
  for (int i = 0; i < 16; ++i) s += v[i];
  const float mean = wave_sum(s) * (1.f / 1024.f);
  float q = 0.f;
#pragma unroll
  for (int i = 0; i < 16; ++i) { const float d = v[i] - mean; q += d * d; }
  const float rstd = rsqrtf(wave_sum(q) * (1.f / 1024.f) + 1e-5f);
#pragma unroll
  for (int i = 0; i < 4; ++i) {
    const int k = 256 * i + 4 * lane;
    const f32x4 gg = *(const f32x4*)(g + k), bb = *(const f32x4*)(b + k);
#pragma unroll
    for (int c = 0; c < 4; ++c) v[4 * i + c] = (v[4 * i + c] - mean) * rstd * gg[c] + bb[c];
  }
}
DI void phase7(const Params& p, int bid, int nb) {
  int tid = threadIdx.x; asm volatile("" : "+v"(tid));
  const int lane = tid & 63, wave = tid >> 6;
  unsigned char* ws = p.ws;
  for (int i = bid * NTHR + tid; i < MAXSLOT; i += nb * NTHR) { ((int*)(ws + O_SLOTTOK))[i] = 0; ((int*)(ws + O_SLOTAID))[i] = -1; }
  float* x1 = (float*)(ws + O_X1);
  bf16_t* x1b = (bf16_t*)(ws + O_X1B);
  for (int row = bid * 8 + wave; row < T; row += nb * 8) {
    float v[16];
#pragma unroll
    for (int i = 0; i < 4; ++i) { const f32x4 t = *(const f32x4*)(x1 + (size_t)row * D + 256 * i + 4 * lane); v[4 * i] = t[0]; v[4 * i + 1] = t[1]; v[4 * i + 2] = t[2]; v[4 * i + 3] = t[3]; }
    ln_row(nullptr, p.in[I_LN1G], p.in[I_LN1B], v, lane);
#pragma unroll
    for (int i = 0; i < 4; ++i) {
      const f32x4 o = {v[4 * i], v[4 * i + 1], v[4 * i + 2], v[4 * i + 3]};
      *(f32x4*)(x1 + (size_t)row * D + 256 * i + 4 * lane) = o;
      *(u32x2*)(x1b + (size_t)row * D + 256 * i + 4 * lane) = pack4(o);
    }
  }
}
struct EpiLogits {
  float* logits;
  DI void operator()(const f32x4 (&acc)[2][2][4][2], const pg::Unit& u, int wr, int wc, int fr, int fq) const {
#pragma unroll
    for (int ai = 0; ai < 2; ++ai)
#pragma unroll
      for (int m = 0; m < 4; ++m) {
        const size_t row = (size_t)u.pm * 256 + 128 * ai + 64 * wr + 16 * m + fr;
#pragma unroll
        for (int bj = 0; bj < 2; ++bj)
#pragma unroll
          for (int n = 0; n < 2; ++n) *(f32x4*)(logits + row * 256 + 128 * bj + 32 * wc + 16 * n + 4 * fq) = acc[ai][bj][m][n];
      }
  }
};
DI void phase8(const Params& p, unsigned char* smem, int bid, int nb) {
  unsigned char* ws = p.ws;
  PG_LAS unsigned char* lds = (PG_LAS unsigned char*)smem;
  __syncthreads();
  pg::DenseOrder S; S.init(ws + O_X1B, ws + O_ROUT, T, 256, 1024, nb, bid);
  EpiLogits E{(float*)(ws + O_LOGITS)};
  pg::gemm_phase<EpiLogits, pg::DenseOrder, false, false>(lds, 1024, S, E);
}
DI void phase9(const Params& p, int bid, int nb) {
  int tid = threadIdx.x; asm volatile("" : "+v"(tid));
  const int lane = tid & 63, wave = tid >> 6;
  unsigned char* ws = p.ws;
  const float* logits = (const float*)(ws + O_LOGITS);
  int* counts = (int*)(ws + O_CTRL);
  const int g = lane & 7, tsub = lane >> 3;
  const float NEG = -__builtin_inff();
  float bias[32];
#pragma unroll
  for (int j4 = 0; j4 < 8; ++j4) { const f32x4 b4 = *(const f32x4*)(p.in[I_RB] + 32 * g + 4 * j4); bias[4 * j4] = b4[0]; bias[4 * j4 + 1] = b4[1]; bias[4 * j4 + 2] = b4[2]; bias[4 * j4 + 3] = b4[3]; }
  for (int tok0 = (bid * 8 + wave) * 8; tok0 < T; tok0 += nb * 64) {
    const int tok = tok0 + tsub;
    float sc[32], bz[32];
#pragma unroll
    for (int j4 = 0; j4 < 8; ++j4) {
      const f32x4 l4 = *(const f32x4*)(logits + (size_t)tok * 256 + 32 * g + 4 * j4);
#pragma unroll
      for (int c = 0; c < 4; ++c) { sc[4 * j4 + c] = sigmoidf_(l4[c]); bz[4 * j4 + c] = sc[4 * j4 + c] + bias[4 * j4 + c]; }
    }
    float m1 = NEG, m2 = NEG;
#pragma unroll
    for (int j = 0; j < 32; ++j) { const float v = bz[j]; if (v > m1) { m2 = m1; m1 = v; } else if (v > m2) m2 = v; }
    const float gs = m1 + m2;
    int rank = 0;
#pragma unroll
    for (int gg = 0; gg < 8; ++gg) { const float og = __shfl(gs, (lane & ~7) | gg); rank += ((og > gs) || (og == gs && gg < g)) ? 1 : 0; }
    if (rank >= 4) {
#pragma unroll
      for (int j = 0; j < 32; ++j) bz[j] = NEG;
    }
    int myidx = 0; float mysc = 0.f, ssum = 0.f;
#pragma unroll 1
    for (int k = 0; k < 8; ++k) {
      float bv = bz[0], bs = sc[0]; int bi = 0;
#pragma unroll
      for (int j = 1; j < 32; ++j) if (bz[j] > bv) { bv = bz[j]; bi = j; bs = sc[j]; }
      float rv = bv, rs = bs; int ri = 32 * g + bi;
#pragma unroll
      for (int o = 1; o < 8; o <<= 1) {
        const float ov = __shfl_xor(rv, o), os = __shfl_xor(rs, o); const int oi = __shfl_xor(ri, o);
        if (ov > rv || (ov == rv && oi < ri)) { rv = ov; ri = oi; rs = os; }
      }
      if ((ri >> 5) == g) {
        const int wj = ri & 31;
#pragma unroll
        for (int j = 0; j < 32; ++j) if (j == wj) bz[j] = NEG;
      }
      ssum += rs;
      if (g == k) { myidx = ri; mysc = rs; }
    }
    const int pos = atomicAdd(&counts[myidx * CSTR], 1);
    ((int*)(ws + O_TKIDX))[(size_t)tok * 8 + g] = myidx;
    ((float*)(ws + O_TKW))[(size_t)tok * 8 + g] = mysc / ssum * 2.5f;
    ((int*)(ws + O_TKPOS))[(size_t)tok * 8 + g] = pos;
  }
}
DI void build_tile_start(const Params& p, int* ts) {
  const int tid = threadIdx.x;
  const int* counts = (const int*)(p.ws + O_CTRL);
  __syncthreads();
  if (tid < 256) ts[300 + tid] = (counts[tid * CSTR] + 127) >> 7;
  __syncthreads();
  if (tid == 0) { int s = 0; for (int e = 0; e < 256; ++e) { ts[e] = s; s += ts[300 + e]; } ts[256] = s; }
  __syncthreads();
}
DI void phase10(const Params& p, unsigned char* smem, int bid, int nb) {
  int* ts = (int*)smem;
  build_tile_start(p, ts);
  unsigned char* ws = p.ws;
  const int* tkidx = (const int*)(ws + O_TKIDX); const int* tkpos = (const int*)(ws + O_TKPOS); const float* tkw = (const float*)(ws + O_TKW);
  int* slottok = (int*)(ws + O_SLOTTOK); float* slotw = (float*)(ws + O_SLOTW); int* slotaid = (int*)(ws + O_SLOTAID);
  for (int i = bid * NTHR + threadIdx.x; i < T * 8; i += nb * NTHR) {
    const int e = tkidx[i];
    const int slot = ts[e] * 128 + tkpos[i];
    slottok[slot] = i >> 3; slotw[slot] = tkw[i]; slotaid[slot] = i;
  }
}

DI int find_expert(const int* ts, int ti) { int lo = 0, hi = 255; while (lo < hi) { const int mid = (lo + hi + 1) >> 1; if (ts[mid] <= ti) lo = mid; else hi = mid - 1; } return lo; }

struct MoeUpF {
  const int* ts; unsigned char* ws; const float* wg; const float* wu; int ntile, G, c;
  DI bool next(int i, UnitF& u) const {
    const int L = i * G + (((G & 7) == 0) ? (c & 7) * (G >> 3) + (c >> 3) : c);
    if (L >= ntile * 2) return false;
    const int pn = L / ntile, ti = L - pn * ntile;
    const int e = find_expert(ts, ti);
    u.A = (const bf16_t*)(ws + O_X1B); u.rows = (const int*)(ws + O_SLOTTOK) + ti * 128; u.m0 = ti * 128; u.pn = pn; u.e = e;
    u.W0 = (pn ? wu : wg) + (size_t)e * 262144; u.W1 = u.W0 + 128;
    return true;
  }
};
struct MoeDownF {
  const int* ts; unsigned char* ws; const float* wd; int ntile, G, c;
  DI bool next(int i, UnitF& u) const {
    const int L = i * G + (((G & 7) == 0) ? (c & 7) * (G >> 3) + (c >> 3) : c);
    if (L >= ntile * 4) return false;
    const int pn = L / ntile, ti = L - pn * ntile;
    const int e = find_expert(ts, ti);
    u.A = (const bf16_t*)(ws + O_ACT); u.rows = nullptr; u.m0 = ti * 128; u.pn = pn; u.e = e;
    u.W0 = wd + (size_t)e * 262144 + 256 * pn; u.W1 = u.W0 + 128;
    return true;
  }
};
struct EpiActF {
  bf16_t* gu;
  struct Pre { int dummy; };
  DI void prefetch(const UnitF&, int, int, Pre& p) const { p.dummy = 0; }
  DI void operator()(const f32x4 (&acc)[4][4], const UnitF& u, int wr, int wc, int fr, int fq, const Pre&) const {
#pragma unroll
    for (int m = 0; m < 4; ++m) {
      const size_t row = (size_t)u.m0 + 64 * wr + 16 * m + fr;
#pragma unroll
      for (int r = 0; r < 4; ++r) {
        f32x4 o = {acc[m][0][r], acc[m][1][r], acc[m][2][r], acc[m][3][r]};
        if (u.pn == 0) { o[0] = siluf_(o[0]); o[1] = siluf_(o[1]); o[2] = siluf_(o[2]); o[3] = siluf_(o[3]); }
        *(u32x2*)(gu + row * 512 + 256 * u.pn + 64 * wc + 16 * fq + 4 * r) = pack4(o);
      }
    }
  }
};
struct EpiDownF {
  const int* slotaid; const float* slotw; unsigned char* ybase;
  struct Pre { int aid[4]; float ww[4]; };
  DI void prefetch(const UnitF& u, int wr, int fr, Pre& p) const {
    const unsigned slot0 = (unsigned)u.m0 + 64u * wr + fr;
#pragma unroll
    for (int m = 0; m < 4; ++m) { p.aid[m] = slotaid[slot0 + 16u * m]; p.ww[m] = slotw[slot0 + 16u * m]; }
  }
  DI void operator()(const f32x4 (&acc)[4][4], const UnitF& u, int wr, int wc, int fr, int fq, const Pre& p) const {
    const unsigned colb = (unsigned)u.pn * 256u + 64u * wc + 16u * fq;
#pragma unroll
    for (int m = 0; m < 4; ++m) {
      if (p.aid[m] >= 0) {
        const unsigned off = (unsigned)p.aid[m] * 1024u + colb;
        const float sw = p.ww[m] * 64.0f;
        u32x4 o;
#pragma unroll
        for (int r = 0; r < 4; ++r) {
          unsigned w_ = 0u;
          w_ = __builtin_amdgcn_cvt_pk_fp8_f32(acc[m][0][r] * sw, acc[m][1][r] * sw, w_, false);
          w_ = __builtin_amdgcn_cvt_pk_fp8_f32(acc[m][2][r] * sw, acc[m][3][r] * sw, w_, true);
          o[r] = w_;
        }
        *(u32x4*)(ybase + (size_t)off) = o;
      }
    }
  }
};
struct EpiAct {
  bf16_t* actp;
  DI void operator()(const f32x4 (&acc)[2][2][4][2], const pg::Unit& u, int wr, int wc, int fr, int fq) const {
#pragma unroll
    for (int ai = 0; ai < 2; ++ai)
#pragma unroll
      for (int m = 0; m < 4; ++m) {
        const size_t row = (size_t)u.pm * 256 + 128 * ai + 64 * wr + 16 * m + fr;
#pragma unroll
        for (int bj = 0; bj < 2; ++bj) {
          const int blk = 8 * u.pn + 4 * bj + wc;
          const f32x4 g = acc[ai][bj][m][0], uu = acc[ai][bj][m][1];
          f32x4 o = {siluf_(g[0]) * uu[0], siluf_(g[1]) * uu[1], siluf_(g[2]) * uu[2], siluf_(g[3]) * uu[3]};
          *(u32x2*)(actp + row * 256 + blk * 16 + 4 * fq) = pack4(o);
        }
      }
  }
};
struct EpiBf16Out {
  bf16_t* dst;
  DI void operator()(const f32x4 (&acc)[2][2][4][2], const pg::Unit& u, int wr, int wc, int fr, int fq) const {
#pragma unroll
    for (int ai = 0; ai < 2; ++ai)
#pragma unroll
      for (int m = 0; m < 4; ++m) {
        const size_t row = (size_t)u.pm * 256 + 128 * ai + 64 * wr + 16 * m + fr;
#pragma unroll
        for (int bj = 0; bj < 2; ++bj)
#pragma unroll
          for (int n = 0; n < 2; ++n) *(u32x2*)(dst + row * 1024 + u.pn * 256 + 128 * bj + 32 * wc + 16 * n + 4 * fq) = pack4(acc[ai][bj][m][n]);
      }
  }
};
DI void phase11(const Params& p, unsigned char* smem, int bid, int nb) {
  unsigned char* ws = p.ws;
  int* ts = (int*)(smem + 131072);
  build_tile_start(p, ts);
  { MoeUpF S{ts, ws, p.in[I_WG], p.in[I_WU], ts[256], nb, bid}; EpiActF E{(bf16_t*)(ws + O_ACT)}; gemmF_phase<false, EpiActF, MoeUpF>(smem, 1024, 1024, 256, S, E); }
  __syncthreads();
  PG_LAS unsigned char* lds = (PG_LAS unsigned char*)smem;
  { pg::DenseOrder S; S.init(ws + O_X1B, ws + O_WSGU, T, 512, 1024, nb, bid); EpiAct E{(bf16_t*)(ws + O_ACTSH)}; pg::gemm_phase<EpiAct, pg::DenseOrder, false, true>(lds, 1024, S, E); }
}
DI void phase12(const Params& p, unsigned char* smem, int bid, int nb) {
  unsigned char* ws = p.ws;
  int* ts = (int*)(smem + 131072);
  build_tile_start(p, ts);
  { MoeDownF S{ts, ws, p.in[I_WDN], ts[256], nb, bid}; EpiDownF E{(const int*)(ws + O_SLOTAID), (const float*)(ws + O_SLOTW), ws + O_Y}; gemmF_phase<true, EpiDownF, MoeDownF>(smem, 256, 512, 1024, S, E); }
  __syncthreads();
  PG_LAS unsigned char* lds = (PG_LAS unsigned char*)smem;
  { pg::DenseOrder S; S.init(ws + O_ACTSH, ws + O_WSD, T, 1024, 256, nb, bid); EpiBf16Out E{(bf16_t*)(ws + O_YSH)}; pg::gemm_phase<EpiBf16Out, pg::DenseOrder, false, true>(lds, 256, S, E); }
}
DI void phase13(const Params& p, int bid, int nb) {
  int tid = threadIdx.x; asm volatile("" : "+v"(tid));
  const int lane = tid & 63, wave = tid >> 6;
  unsigned char* ws = p.ws;
  const float* x1 = (const float*)(ws + O_X1);
  const bf16_t* ysh = (const bf16_t*)(ws + O_YSH);
  const unsigned char* y8 = ws + O_Y;
  for (int row = bid * 8 + wave; row < T; row += nb * 8) {
    float v[16];
#pragma unroll
    for (int i = 0; i < 4; ++i) {
      const int k = 256 * i + 4 * lane;
      const f32x4 t = *(const f32x4*)(x1 + (size_t)row * D + k);
      const u32x2 s = *(const u32x2*)(ysh + (size_t)row * D + k);
      v[4 * i] = ALPHA * t[0] + lo2f(s[0]); v[4 * i + 1] = ALPHA * t[1] + hi2f(s[0]); v[4 * i + 2] = ALPHA * t[2] + lo2f(s[1]); v[4 * i + 3] = ALPHA * t[3] + hi2f(s[1]);
    }
    float rs[16];
#pragma unroll
    for (int i = 0; i < 16; ++i) rs[i] = 0.f;
#pragma unroll
    for (int k8 = 0; k8 < 8; ++k8) {
#pragma unroll
      for (int i = 0; i < 4; ++i) {
        const unsigned s = *(const unsigned*)(y8 + ((size_t)row * 8 + k8) * 1024 + 256 * i + 4 * lane);
        const f32x2_ lo = __builtin_amdgcn_cvt_pk_f32_fp8(s, false), hi = __builtin_amdgcn_cvt_pk_f32_fp8(s, true);
        rs[4 * i] += lo[0]; rs[4 * i + 1] += lo[1]; rs[4 * i + 2] += hi[0]; rs[4 * i + 3] += hi[1];
      }
    }
#pragma unroll
    for (int i = 0; i < 16; ++i) v[i] += rs[i] * (1.0f / 64.0f);
    ln_row(nullptr, p.in[I_LN2G], p.in[I_LN2B], v, lane);
#pragma unroll
    for (int i = 0; i < 4; ++i) { const f32x4 o = {v[4 * i], v[4 * i + 1], v[4 * i + 2], v[4 * i + 3]}; *(f32x4*)(p.out + (size_t)row * D + 256 * i + 4 * lane) = o; }
  }
}

DI void load_params(Params& lp, const unsigned char* smem) {
  const unsigned* t = (const unsigned*)(smem + PTAB_OFF);
#pragma unroll
  for (int i = 0; i < 28; ++i) lp.in[i] = (const float*)(GAS const float*)(((unsigned long long)(unsigned)__builtin_amdgcn_readfirstlane((int)t[2 * i + 1]) << 32) | (unsigned)__builtin_amdgcn_readfirstlane((int)t[2 * i]));
  lp.out = (float*)(GAS float*)(((unsigned long long)(unsigned)__builtin_amdgcn_readfirstlane((int)t[57]) << 32) | (unsigned)__builtin_amdgcn_readfirstlane((int)t[56]));
  lp.ws = (unsigned char*)(GAS unsigned char*)(((unsigned long long)(unsigned)__builtin_amdgcn_readfirstlane((int)t[59]) << 32) | (unsigned)__builtin_amdgcn_readfirstlane((int)t[58]));
}
__global__ void __launch_bounds__(NTHR) mega_kernel(Params pk) {
  extern __shared__ __attribute__((aligned(16))) unsigned char smem[];
  cg::grid_group grid = cg::this_grid();
  const int bid = blockIdx.x, nb = gridDim.x;
  volatile LAS unsigned* bst = (volatile LAS unsigned*)(smem + LDS_BYTES - 16);
  if (threadIdx.x < 4) bst[threadIdx.x] = 0u;
  if (threadIdx.x < 30) {
    const __attribute__((address_space(4))) unsigned long long* ka = (const __attribute__((address_space(4))) unsigned long long*)__builtin_amdgcn_kernarg_segment_ptr();
    ((unsigned long long*)(smem + PTAB_OFF))[threadIdx.x] = ka[threadIdx.x];
  }
  unsigned* barw = (unsigned*)(pk.ws + O_BAR);
  __syncthreads();
  XcdBarrier xb = xcd_barrier_post(barw, bst);
#define GSYNC() xcd_barrier(xb)
#define RUNP(k, call) do { { Params p; load_params(p, smem); call; } GSYNC(); if (DUPMASK & (1 << (k))) { { Params p; load_params(p, smem); call; } GSYNC(); } } while (0)
  { Params p; load_params(p, smem); phase0(p, smem, bid, nb); } grid.sync();
  RUNP(1, phase1(p, smem, bid, nb));
  RUNP(2, phase2(p, smem, bid, nb));
  RUNP(3, phase3(p, smem, bid, nb));
  RUNP(4, phase4(p, bid, nb));
  RUNP(5, phase5(p, smem, bid, nb));
  RUNP(6, phase6(p, smem, bid, nb));
  RUNP(14, phase7(p, bid, nb));
  if (DUPMASK & (1 << 7)) { { Params p; load_params(p, smem); phase6(p, smem, bid, nb); } GSYNC(); { Params p; load_params(p, smem); phase7(p, bid, nb); } GSYNC(); }
  RUNP(8, phase8(p, smem, bid, nb));
  RUNP(14, phase9(p, bid, nb));
  if (DUPMASK & (1 << 9)) { { Params p; load_params(p, smem); if (bid == 0 && threadIdx.x < 256) ((int*)(p.ws + O_CTRL))[threadIdx.x * CSTR] = 0; } GSYNC(); { Params p; load_params(p, smem); phase9(p, bid, nb); } GSYNC(); }
  RUNP(10, phase10(p, smem, bid, nb));
  RUNP(11, phase11(p, smem, bid, nb));
#ifdef SHADOW
  { Params p; load_params(p, smem); unsigned char* ws = p.ws; int* ts = (int*)(smem + 131072); build_tile_start(p, ts);
    MoeUpF S{ts, ws, p.in[I_WG], p.in[I_WU], ts[256], nb, bid}; EpiActF E{(bf16_t*)(ws + O_Y)};
    gemmF_phase<false, EpiActF, MoeUpF, SHADOW>(smem, 1024, 1024, 256, S, E); }
  GSYNC();
#endif
  RUNP(12, phase12(p, smem, bid, nb));
  { Params p; load_params(p, smem); phase13(p, bid, nb); }
  if (DUPMASK & (1 << 13)) { GSYNC(); Params p; load_params(p, smem); phase13(p, bid, nb); }
  if (DUPMASK & (1 << 15)) { for (int i = 0; i < 10; ++i) GSYNC(); }
}

extern "C" void kernel_launch(void* const* d_in, const int* in_sizes, int n_in, void* d_out, int out_size, void* d_ws, size_t ws_size, hipStream_t stream) {
  if (n_in != 28 || ws_size < WS_NEED) { fprintf(stderr, "kernel_launch: unexpected inputs (%d) or workspace (%zu < %zu)\n", n_in, ws_size, (size_t)WS_NEED); return; }
  static int grid_blocks = 0;
  if (!grid_blocks) {
    int dev = 0, cus = 0, per_cu = 0;
    (void)hipGetDevice(&dev);
    (void)hipDeviceGetAttribute(&cus, hipDeviceAttributeMultiprocessorCount, dev);
    (void)hipFuncSetAttribute((const void*)mega_kernel, hipFuncAttributeMaxDynamicSharedMemorySize, LDS_BYTES);
    (void)hipOccupancyMaxActiveBlocksPerMultiprocessor(&per_cu, (const void*)mega_kernel, NTHR, LDS_BYTES);
    if (per_cu < 1) per_cu = 1;
    if (per_cu > 1) per_cu = 1;
    grid_blocks = cus * per_cu;
    if (grid_blocks < 32) grid_blocks = 32;
  }
  Params p{};
  for (int i = 0; i < 28; ++i) p.in[i] = (const float*)d_in[i];
  p.out = (float*)d_out; p.ws = (unsigned char*)d_ws;
  (void)hipMemsetAsync((unsigned char*)d_ws + O_BAR, 0, 16384 + 256, stream);
  void* args[] = {&p};
  hipError_t e = hipLaunchCooperativeKernel((const void*)mega_kernel, dim3(grid_blocks), dim3(NTHR), args, LDS_BYTES, stream);
  if (e != hipSuccess) fprintf(stderr, "cooperative launch failed: %s (grid %d)\n", hipGetErrorString(e), grid_blocks);
}
```

```cpp
#include <hip/hip_runtime.h>
#include <hip/hip_cooperative_groups.h>
#include <stdint.h>
#include <stdio.h>
namespace cg = cooperative_groups;

#define DI __device__ __forceinline__
#define LAS __attribute__((address_space(3)))
#define GAS __attribute__((address_space(1)))
typedef unsigned short bf16_t;
typedef short bf16x8 __attribute__((ext_vector_type(8)));
typedef float f32x4 __attribute__((ext_vector_type(4)));
typedef unsigned u32x4 __attribute__((ext_vector_type(4)));
typedef unsigned u32x2 __attribute__((ext_vector_type(2)));

#ifndef DUPMASK
#define DUPMASK 0
#endif
constexpr int NTHR = 512;
constexpr int T = 16384, SEQ = 8192, D = 1024;
constexpr int NPROJ = 6656;
constexpr int DIN = 6664;
constexpr int NEXP = 256, DEXP = 256;
constexpr int MAXSLOT = 131072 + 256 * 128;
constexpr float ALPHA = 1.189207115002721f;
constexpr int LDS_BYTES = 157696;

constexpr size_t MB = 1u << 20;
constexpr size_t O_WGU = 0;
constexpr size_t O_WD = 256 * MB;
constexpr size_t O_WSGU = 384 * MB;
constexpr size_t O_WSD = 385 * MB;
constexpr size_t O_ROUT = 385 * MB + 512 * 1024;
constexpr size_t O_CTRL = 386 * MB;
constexpr size_t O_BAR = 386 * MB + 128 * 1024;
constexpr int CSTR = 64;
constexpr size_t O_SUBBAR = 386 * MB + 128 * 1024 + 16384;
constexpr size_t O_IDENT = 386 * MB + 256 * 1024;
constexpr size_t O_X1 = 387 * MB;
constexpr size_t O_X1B = 451 * MB;
constexpr size_t R0 = 483 * MB;
constexpr size_t O_XB = R0 + 0;
constexpr size_t O_ST = R0 + 0;
constexpr size_t O_WINT = R0 + 32 * MB;
constexpr size_t O_WAT = R0 + 45 * MB;
constexpr size_t O_WBT = R0 + 46 * MB;
constexpr size_t O_WCT = R0 + 47 * MB;
constexpr size_t O_WOT = R0 + 48 * MB;
constexpr size_t O_WMKV = R0 + 50 * MB;
constexpr size_t O_MEMB = R0 + 52 * MB;
constexpr size_t O_SGUW = R0 + 53 * MB;
constexpr size_t O_AB = R0 + 53 * MB + 512 * 1024;
constexpr size_t O_MEMK = R0 + 54 * MB;
constexpr size_t O_MEMVT = R0 + 54 * MB + 512 * 1024;
constexpr size_t O_QKV = R0 + 55 * MB;
constexpr size_t O_PART = R0 + 55 * MB;
constexpr size_t O_ZS = R0 + 103 * MB;
constexpr size_t O_UVG = R0 + 119 * MB;
constexpr size_t O_MERGED = R0 + 119 * MB;
constexpr size_t O_XQ = R0 + 151 * MB;
constexpr size_t O_GATES = R0 + 167 * MB;
constexpr size_t O_MP = R0 + 263 * MB;
constexpr size_t O_BC = R0 + 295 * MB;
constexpr size_t O_O0 = R0 + 359 * MB;
constexpr size_t O_QP = R0 + 391 * MB;
constexpr size_t O_GL = R0 + 407 * MB;
constexpr size_t O_GDNO = R0 + 408 * MB;
constexpr size_t O_SGUO = R0 + 424 * MB;
constexpr size_t O_XATO = R0 + 440 * MB;
constexpr size_t O_LOGITS = R0 + 0;
constexpr size_t O_TKIDX = R0 + 16 * MB;
constexpr size_t O_TKW = R0 + 16 * MB + 512 * 1024;
constexpr size_t O_TKPOS = R0 + 17 * MB;
constexpr size_t O_SLOTTOK = R0 + 18 * MB;
constexpr size_t O_SLOTW = R0 + 19 * MB;
constexpr size_t O_SLOTAID = R0 + 20 * MB;
constexpr size_t O_ACT = R0 + 21 * MB;
constexpr size_t O_ACTSH = R0 + 181 * MB;
constexpr size_t O_YSH = R0 + 189 * MB;
constexpr size_t O_Y = R0 + 221 * MB;
constexpr size_t WS_NEED = R0 + 477 * MB;

struct Params {
  const float* in[28];
  float* out;
  unsigned char* ws;
};
enum { I_X = 0, I_MEM, I_WIN, I_CONVW, I_ALOG, I_DTB, I_GNG, I_WA, I_SLNG, I_SLNB, I_SGUW, I_SGUB, I_WB, I_WMKV, I_WC, I_WO,
       I_LN1G, I_LN1B, I_RW, I_RB, I_WG, I_WU, I_WDN, I_WSG, I_WSU, I_WSD, I_LN2G, I_LN2B };

constexpr int PTAB_OFF = 156672;
DI float bf2f(bf16_t h) { return __uint_as_float(((unsigned)h) << 16); }
DI bf16_t f2bf(float f) { unsigned u = __float_as_uint(f); u += 0x7fffu + ((u >> 16) & 1u); return (bf16_t)(u >> 16); }
typedef float f32x2_ __attribute__((ext_vector_type(2)));
typedef __bf16 bf16x2_ __attribute__((ext_vector_type(2)));
DI unsigned pk2(float lo, float hi) { f32x2_ v = {lo, hi}; return __builtin_bit_cast(unsigned, __builtin_convertvector(v, bf16x2_)); }
DI float lo2f(unsigned u) { return __uint_as_float(u << 16); }
DI float hi2f(unsigned u) { return __uint_as_float(u & 0xffff0000u); }
DI float sigmoidf_(float x) { return 1.f / (1.f + __expf(-x)); }
DI float siluf_(float x) { return x / (1.f + __expf(-x)); }
DI float geluf_(float x) { float u = 0.7978845608028654f * (x + 0.044715f * x * x * x); float t = 1.f - 2.f / (__expf(2.f * u) + 1.f); return 0.5f * x * (1.f + t); }
DI float softplusf_(float x) { return fmaxf(x, 0.f) + log1pf(__expf(-fabsf(x))); }
DI float wave_sum(float v) {
#pragma unroll
  for (int o = 32; o; o >>= 1) v += __shfl_xor(v, o);
  return v;
}
DI f32x4 mfma16(bf16x8 a, bf16x8 b, f32x4 c) { return __builtin_amdgcn_mfma_f32_16x16x32_bf16(a, b, c, 0, 0, 0); }
DI bf16x8 ldfrag(const void* p) { return __builtin_bit_cast(bf16x8, *(const u32x4*)p); }
DI bf16x8 pack8(f32x4 a, f32x4 b) { u32x4 r = {pk2(a[0], a[1]), pk2(a[2], a[3]), pk2(b[0], b[1]), pk2(b[2], b[3])}; return __builtin_bit_cast(bf16x8, r); }
DI u32x2 pack4(f32x4 a) { u32x2 r = {pk2(a[0], a[1]), pk2(a[2], a[3])}; return r; }
DI int sw128(int row, int chunk) { return row * 128 + ((chunk ^ (row & 7)) << 4); }
DI int sw256(int row, int chunk) { return row * 256 + ((chunk ^ (row & 15)) << 4); }

namespace pg {
#define PG_LAS __attribute__((address_space(3)))
constexpr int BM = 256, BK = 64, HALF = 128, HTB = HALF * BK * 2, NXCD = 8, WGM = 8;
DI int lds_byte(int r, int c) { const int st = (r >> 4) * 2 + (c >> 5), rr = r & 15, cc = c & 31, ob = rr * 64 + cc * 2; return st * 1024 + (ob ^ (((ob >> 9) & 1) << 5)); }
DI void stage_rc(int b, int& R, int& C) { const int st = b / 1024, sb = b % 1024, swz = sb ^ (((sb >> 9) & 1) << 5); R = (st >> 1) * 16 + swz / 64; C = (st & 1) * 32 + (swz % 64) / 2; }

struct Unit { const char* a; const char* b; const int* rows; int pm, pn, e; };

struct DenseOrder {
  const char* A; const char* B; int nM, nN, nwg, G, c; size_t tstep;
  DI void init(const void* A_, const void* B_, int M, int N, int K, int G_, int c_) { A = (const char*)A_; B = (const char*)B_; nM = M / BM; nN = N / BM; nwg = nM * nN; G = G_; c = c_; tstep = (size_t)BM * K * 2; }
  DI bool next(int i, Unit& u) const {
    const long L = (long)i * G + c; if (L >= nwg) return false;
    int wgid = (int)L; { const int q = nwg / NXCD, r = nwg % NXCD, xcd = wgid % NXCD, off = wgid / NXCD; wgid = (xcd < r ? xcd * (q + 1) : r * (q + 1) + (xcd - r) * q) + off; }
    const int nig = WGM * nN, gid = wgid / nig, fm = gid * WGM, gsz = (nM - fm) < WGM ? (nM - fm) : WGM;
    u.pm = fm + ((wgid % nig) % gsz); u.pn = (wgid % nig) / gsz; u.e = 0; u.rows = nullptr;
    u.a = A + (size_t)u.pm * tstep; u.b = B + (size_t)u.pn * tstep; return true;
  }
};

template <class Epi, class Sched, bool GATHER, bool ALIGN_EPI>
DI void gemm_phase(PG_LAS unsigned char* lds, const int K, const Sched& S, const Epi& E) {
  int tid = threadIdx.x; asm volatile("" : "+v"(tid));
  const int wid = __builtin_amdgcn_readfirstlane(tid >> 6), lane = tid & 63, wr = wid >> 2, wc = wid & 3, fr = lane & 15, fq = lane >> 4;
  const int nt = K / BK;
  int Rr[2], Cc[2];
  unsigned voffB[2];
#pragma unroll
  for (int i = 0; i < 2; ++i) { stage_rc(tid * 16 + i * 8192, Rr[i], Cc[i]); voffB[i] = (unsigned)(Rr[i] * K + Cc[i]) * 2u; }
  const size_t kstep = (size_t)(BK * 2);
  const size_t hstep = (size_t)HALF * K * 2;
  const unsigned ldsw = (unsigned)wid * 1024u;
  const int aoff = lds_byte(wr * 64 + fr, fq * 8), boff = lds_byte(wc * 32 + fr, fq * 8);
#define PG_SA(b, h) (((b) * 2 + (h)) * HTB)
#define PG_SB(b, h) ((4 + (b) * 2 + (h)) * HTB)
#define PG_STAGE(bufoff, gbase, v0, v1) do { \
    __builtin_amdgcn_global_load_lds((const unsigned*)((const char*)(gbase) + (v0)), (PG_LAS unsigned*)(lds + (bufoff) + ldsw), 16, 0, 0); \
    __builtin_amdgcn_global_load_lds((const unsigned*)((const char*)(gbase) + (v1)), (PG_LAS unsigned*)(lds + (bufoff) + ldsw + 8192), 16, 0, 0); } while (0)
#define PG_LDA(dst, b, h) do { _Pragma("unroll") for (int m = 0; m < 4; ++m) _Pragma("unroll") for (int k = 0; k < 2; ++k) dst[m][k] = *(const PG_LAS bf16x8*)(lds + PG_SA(b, h) + aoff + m * 2048 + k * 1024); } while (0)
#define PG_LDB(dst, b, h) do { _Pragma("unroll") for (int n = 0; n < 2; ++n) _Pragma("unroll") for (int k = 0; k < 2; ++k) dst[n][k] = *(const PG_LAS bf16x8*)(lds + PG_SB(b, h) + boff + n * 2048 + k * 1024); } while (0)
#define PG_MMA(ai, bj, At, Bt) do { __builtin_amdgcn_s_setprio(1); _Pragma("unroll") for (int m = 0; m < 4; ++m) _Pragma("unroll") for (int n = 0; n < 2; ++n) _Pragma("unroll") for (int k = 0; k < 2; ++k) \
    acc[ai][bj][m][n] = __builtin_amdgcn_mfma_f32_16x16x32_bf16(Bt[n][k], At[m][k], acc[ai][bj][m][n], 0, 0, 0); __builtin_amdgcn_s_setprio(0); } while (0)
#define PG_WAIT_V(n) asm volatile("s_waitcnt vmcnt(" #n ")" ::: "memory")
#define PG_WAIT_L(n) asm volatile("s_waitcnt lgkmcnt(" #n ")" ::: "memory")
#define PG_BAR __builtin_amdgcn_s_barrier()
#define PG_SCHED __builtin_amdgcn_sched_barrier(0)
#define PG_AOFFS(u, o00, o01, o10, o11) do { if (GATHER) { \
      o00 = (unsigned)(u).rows[Rr[0]] * (unsigned)(K * 2) + (unsigned)Cc[0] * 2u; o01 = (unsigned)(u).rows[Rr[1]] * (unsigned)(K * 2) + (unsigned)Cc[1] * 2u; \
      o10 = (unsigned)(u).rows[128 + Rr[0]] * (unsigned)(K * 2) + (unsigned)Cc[0] * 2u; o11 = (unsigned)(u).rows[128 + Rr[1]] * (unsigned)(K * 2) + (unsigned)Cc[1] * 2u; \
    } else { o00 = voffB[0]; o01 = voffB[1]; o10 = voffB[0] + (unsigned)hstep; o11 = voffB[1] + (unsigned)hstep; } } while (0)
  Unit cur, nxt; int ui = 0;
  if (!S.next(0, cur)) return;
  f32x4 acc[2][2][4][2];
#pragma unroll
  for (int a = 0; a < 2; ++a)
#pragma unroll
    for (int b = 0; b < 2; ++b)
#pragma unroll
      for (int m = 0; m < 4; ++m)
#pragma unroll
        for (int n = 0; n < 2; ++n) acc[a][b][m][n] = (f32x4){0.f, 0.f, 0.f, 0.f};
  bf16x8 At[4][2], B0[2][2], B1[2][2];
  const char* cA = cur.a; const char* cB = cur.b;
  unsigned c00, c01, c10, c11;
  PG_AOFFS(cur, c00, c01, c10, c11);
  const unsigned vb0 = voffB[0], vb1 = voffB[1];
  PG_STAGE(PG_SB(0, 0), cB, vb0, vb1); PG_STAGE(PG_SB(0, 1), cB + hstep, vb0, vb1); PG_STAGE(PG_SA(0, 0), cA, c00, c01); PG_STAGE(PG_SA(0, 1), cA, c10, c11);
  if (wr == 1) PG_BAR;
  PG_WAIT_V(2); PG_BAR;
  PG_STAGE(PG_SB(1, 0), cB + kstep, vb0, vb1); PG_STAGE(PG_SA(1, 0), cA + kstep, c00, c01); PG_STAGE(PG_SB(1, 1), cB + hstep + kstep, vb0, vb1);
  PG_WAIT_V(6); PG_BAR;
  for (;;) {
    const bool has_next = S.next(ui + 1, nxt);
    const char* nA = has_next ? nxt.a : cA; const char* nB = has_next ? nxt.b : cB;
    unsigned n00 = c00, n01 = c01, n10 = c10, n11 = c11;
    if (has_next) PG_AOFFS(nxt, n00, n01, n10, n11);
#pragma unroll 1
    for (int t = 0; t < nt; t += 2) {
      const bool last = (t == nt - 2);
      const char* a1 = cA + (size_t)(t + 1) * kstep;
      const char* a2 = last ? nA : cA + (size_t)(t + 2) * kstep; const char* b2 = last ? nB : cB + (size_t)(t + 2) * kstep;
      const char* a3 = a2 + kstep; const char* b3 = b2 + kstep;
      const unsigned o00 = last ? n00 : c00, o01 = last ? n01 : c01, o10 = last ? n10 : c10, o11 = last ? n11 : c11;
      PG_LDB(B0, 0, 0); PG_LDB(B1, 0, 1); PG_SCHED; PG_LDA(At, 0, 0); PG_STAGE(PG_SA(1, 1), a1, c10, c11);
      PG_WAIT_V(8); PG_WAIT_L(0); PG_BAR; PG_MMA(0, 0, At, B0); PG_MMA(0, 1, At, B1); PG_BAR; PG_SCHED;
      PG_LDA(At, 0, 1); PG_STAGE(PG_SB(0, 0), b2, vb0, vb1); PG_STAGE(PG_SB(0, 1), b2 + hstep, vb0, vb1); PG_STAGE(PG_SA(0, 0), a2, o00, o01);
      PG_WAIT_V(8); PG_WAIT_L(0); PG_BAR; PG_MMA(1, 0, At, B0); PG_MMA(1, 1, At, B1); PG_BAR; PG_SCHED;
      PG_LDB(B0, 1, 0); PG_LDB(B1, 1, 1); PG_SCHED; PG_LDA(At, 1, 0); PG_STAGE(PG_SA(0, 1), a2, o10, o11);
      PG_WAIT_V(8); PG_WAIT_L(0); PG_BAR; PG_MMA(0, 0, At, B0); PG_MMA(0, 1, At, B1); PG_BAR; PG_SCHED;
      PG_LDA(At, 1, 1); PG_STAGE(PG_SB(1, 0), b3, vb0, vb1); PG_STAGE(PG_SB(1, 1), b3 + hstep, vb0, vb1); PG_STAGE(PG_SA(1, 0), a3, o00, o01);
      PG_WAIT_V(8); PG_WAIT_L(0); PG_BAR; PG_MMA(1, 0, At, B0); PG_MMA(1, 1, At, B1); PG_BAR; PG_SCHED;
    }
    if constexpr (ALIGN_EPI) { if (wr == 0) PG_BAR; }
    E(acc, cur, wr, wc, fr, fq);
    if (!has_next) break;
#pragma unroll
    for (int a = 0; a < 2; ++a)
#pragma unroll
      for (int b = 0; b < 2; ++b)
#pragma unroll
        for (int m = 0; m < 4; ++m)
#pragma unroll
          for (int n = 0; n < 2; ++n) acc[a][b][m][n] = (f32x4){0.f, 0.f, 0.f, 0.f};
    cur = nxt; cA = nA; cB = nB; c00 = n00; c01 = n01; c10 = n10; c11 = n11; ++ui;
    if constexpr (ALIGN_EPI) { if (wr == 1) PG_BAR; }
  }
  PG_WAIT_V(0);
  if constexpr (!ALIGN_EPI) { if (wr == 0) PG_BAR; }
  PG_BAR;
#undef PG_SA
#undef PG_SB
#undef PG_STAGE
#undef PG_LDA
#undef PG_LDB
#undef PG_MMA
#undef PG_WAIT_V
#undef PG_WAIT_L
#undef PG_BAR
#undef PG_SCHED
#undef PG_AOFFS
}
}


struct UnitF { const bf16_t* A; const int* rows; const float* W0; const float* W1; int m0, pn, e; };

template <bool AMUL, class Epi, class Sched, int ABL = 0>
DI void gemmF_phase(unsigned char* smem_, const int K, const int lda, const int ldw, const Sched& S, const Epi& E) {
  int tid = threadIdx.x; asm volatile("" : "+v"(tid));
  unsigned char* smem; { LAS unsigned char* l_ = (LAS unsigned char*)smem_; asm volatile("" : "+v"(l_)); smem = (unsigned char*)l_; }
  const int lane = tid & 63, wid = tid >> 6, wr = wid >> 2, wc = wid & 3, fr = lane & 15, fq = lane >> 4;
  const int nk = K >> 6;
  const int ar0 = tid >> 3, ac = tid & 7;
  const int q = tid & 63, half = q >> 5, g0 = 4 * (q & 31);
  int vrow[4];
#pragma unroll
  for (int i = 0; i < 4; ++i) vrow[i] = 64 * (q >> 4) + 16 * i + (q & 15);
  const int aw0 = sw128(ar0, ac), aw1 = sw128(ar0 + 64, ac);
#define F_ROWS(u, rr0, rr1) do { rr0 = (u).rows ? (size_t)(u).rows[ar0] : (size_t)((u).m0 + ar0); rr1 = (u).rows ? (size_t)(u).rows[ar0 + 64] : (size_t)((u).m0 + ar0 + 64); } while (0)
#define F_LOAD(A_, W0_, W1_, rr0_, rr1_, kk_, va0, va1, vb0, vb1, vw) do { \
    va0 = *(const u32x4*)((A_) + (rr0_) * lda + (kk_) * 64 + ac * 8); va1 = *(const u32x4*)((A_) + (rr1_) * lda + (kk_) * 64 + ac * 8); \
    if (AMUL) { vb0 = *(const u32x4*)((A_) + (rr0_) * lda + 256 + (kk_) * 64 + ac * 8); vb1 = *(const u32x4*)((A_) + (rr1_) * lda + 256 + (kk_) * 64 + ac * 8); } \
    const float* wp_ = (half ? (W1_) : (W0_)) + (size_t)((kk_) * 64 + 8 * wid) * ldw + g0; \
    if (ABL != 1) { _Pragma("unroll") for (int j = 0; j < 8; ++j) vw[j] = *(const f32x4*)(wp_ + (size_t)j * ldw); } } while (0)
#define F_LOADX(kx, va0, va1, vb0, vb1, vw) do { const bool nx_ = (kx) >= nk; const int kk2_ = nx_ ? (kx) - nk : (kx); \
    const bf16_t* A2_ = nx_ ? nxt.A : cur.A; const float* W02_ = nx_ ? nxt.W0 : cur.W0; const float* W12_ = nx_ ? nxt.W1 : cur.W1; \
    const size_t q0_ = nx_ ? nr0 : r0, q1_ = nx_ ? nr1 : r1; \
    F_LOAD(A2_, W02_, W12_, q0_, q1_, kk2_, va0, va1, vb0, vb1, vw); } while (0)
#define F_STORE(st, va0, va1, vb0, vb1, vw) do { unsigned char* sa_ = smem + (st) * 49152; \
    if (AMUL) { _Pragma("unroll") for (int e_ = 0; e_ < 4; ++e_) { va0[e_] = pk2(lo2f(va0[e_]) * lo2f(vb0[e_]), hi2f(va0[e_]) * hi2f(vb0[e_])); va1[e_] = pk2(lo2f(va1[e_]) * lo2f(vb1[e_]), hi2f(va1[e_]) * hi2f(vb1[e_])); } } \
    *(u32x4*)(sa_ + aw0) = va0; *(u32x4*)(sa_ + aw1) = va1; \
    if (ABL != 3) { _Pragma("unroll") for (int i = 0; i < 4; ++i) { \
      u32x4 o_ = {pk2(vw[0][i], vw[1][i]), pk2(vw[2][i], vw[3][i]), pk2(vw[4][i], vw[5][i]), pk2(vw[6][i], vw[7][i])}; \
      *(u32x4*)(sa_ + 16384 + sw128(vrow[i], wid)) = o_; } } else { _Pragma("unroll") for (int j = 0; j < 8; ++j) asm volatile("" :: "v"(vw[j])); } } while (0)
#define F_LBAR() do { asm volatile("s_waitcnt lgkmcnt(0)" ::: "memory"); __builtin_amdgcn_s_barrier(); asm volatile("" ::: "memory"); } while (0)
#define F_COMPUTE(st) do { const unsigned char* sA = smem + (st) * 49152; const unsigned char* sB = sA + 16384; \
    _Pragma("unroll") for (int ks = 0; ks < 2; ++ks) { bf16x8 af[4], bfr[4]; \
      _Pragma("unroll") for (int m = 0; m < 4; ++m) af[m] = ldfrag(sA + sw128(64 * wr + 16 * m + fr, 4 * ks + fq)); \
      _Pragma("unroll") for (int n = 0; n < 4; ++n) bfr[n] = ldfrag(sB + sw128(64 * wc + 16 * n + fr, 4 * ks + fq)); \
      if (ABL != 2) { _Pragma("unroll") for (int m = 0; m < 4; ++m) _Pragma("unroll") for (int n = 0; n < 4; ++n) acc[m][n] = mfma16(bfr[n], af[m], acc[m][n]); } \
      else { _Pragma("unroll") for (int m = 0; m < 4; ++m) _Pragma("unroll") for (int n = 0; n < 4; ++n) asm volatile("" :: "v"(af[m]), "v"(bfr[n])); } } } while (0)
  UnitF cur, nxt; int ui = 0;
  if (!S.next(0, cur)) return;
  size_t r0, r1, nr0, nr1;
  F_ROWS(cur, r0, r1);
  bool has_next = S.next(1, nxt);
  if (has_next) F_ROWS(nxt, nr0, nr1); else { nxt = cur; nr0 = r0; nr1 = r1; }
  f32x4 acc[4][4];
#pragma unroll
  for (int m = 0; m < 4; ++m)
#pragma unroll
    for (int n = 0; n < 4; ++n) acc[m][n] = (f32x4){0.f, 0.f, 0.f, 0.f};
  u32x4 xa0, xa1, ya0, ya1, xb0, xb1, yb0, yb1; f32x4 xw[8], yw[8];
  xb0 = xb1 = yb0 = yb1 = (u32x4){0u, 0u, 0u, 0u};
  if (ABL == 1) { _Pragma("unroll") for (int j = 0; j < 8; ++j) { xw[j] = (f32x4){0.f, 0.f, 0.f, 0.f}; yw[j] = xw[j]; } }
  F_LOAD(cur.A, cur.W0, cur.W1, r0, r1, 0, xa0, xa1, xb0, xb1, xw);
  F_LOAD(cur.A, cur.W0, cur.W1, r0, r1, 1, ya0, ya1, yb0, yb1, yw);
  __syncthreads();
  F_STORE(0, xa0, xa1, xb0, xb1, xw);
  F_LBAR();
  int st = 0;
  for (;;) {
    typename Epi::Pre pre; E.prefetch(cur, wr, fr, pre);
#pragma unroll 1
    for (int kt = 0; kt < nk; kt += 2) {
      F_LOADX(kt + 2, xa0, xa1, xb0, xb1, xw);
      F_COMPUTE(st);
      F_STORE(st ^ 1, ya0, ya1, yb0, yb1, yw);
      F_LBAR();
      F_LOADX(kt + 3, ya0, ya1, yb0, yb1, yw);
      F_COMPUTE(st ^ 1);
      F_STORE(st, xa0, xa1, xb0, xb1, xw);
      F_LBAR();
    }
    if (ABL != 4) E(acc, cur, wr, wc, fr, fq, pre, smem + (st ^ 1) * 49152); else { _Pragma("unroll") for (int m = 0; m < 4; ++m) _Pragma("unroll") for (int n = 0; n < 4; ++n) asm volatile("" :: "v"(acc[m][n])); }
#pragma unroll
    for (int m = 0; m < 4; ++m)
#pragma unroll
      for (int n = 0; n < 4; ++n) acc[m][n] = (f32x4){0.f, 0.f, 0.f, 0.f};
    if (!has_next) break;
    cur = nxt; r0 = nr0; r1 = nr1; ++ui;
    has_next = S.next(ui + 1, nxt);
    if (has_next) F_ROWS(nxt, nr0, nr1); else { nxt = cur; nr0 = r0; nr1 = r1; }
  }
  asm volatile("s_waitcnt vmcnt(0)" ::: "memory");
  __syncthreads();
#undef F_ROWS
#undef F_LOAD
#undef F_LOADX
#undef F_STORE
#undef F_LBAR
#undef F_COMPUTE
}

#define XB_TMO      128
#define XB_XCNT(j)  (256  + 64 * (j))
#define XB_XSUB(j)  (1280 + 64 * (j))
#define XB_XGEN(j)  (2304 + 64 * (j))
#define XB_TOP      3328
#define XB_TOPGEN   3392
#define XCD_BAR_WORDS 3456
#define XB_SPIN_CAP (1u << 22)
DI unsigned xb_ld(unsigned* p)              { return __hip_atomic_load(p, __ATOMIC_RELAXED, __HIP_MEMORY_SCOPE_AGENT); }
DI unsigned xb_add(unsigned* p, unsigned v) { return __hip_atomic_fetch_add(p, v, __ATOMIC_RELAXED, __HIP_MEMORY_SCOPE_AGENT); }
DI unsigned xb_xcc_id() { return (unsigned)__builtin_amdgcn_s_getreg((3 << 11) | 20) & 0xFu; }
#define XB_SPIN(cond, bar) do { unsigned _sp = 0; while (cond) { __builtin_amdgcn_s_sleep(1); \
    if ((++_sp & 255u) == 0u) { if (xb_ld(&(bar)[XB_TMO])) break; if (_sp > XB_SPIN_CAP) { atomicAdd(&(bar)[XB_TMO], 1u); break; } } } } while (0)
struct XcdBarrier { unsigned* bar; unsigned x; volatile LAS unsigned* st; };
DI XcdBarrier xcd_barrier_post(unsigned* bar, volatile LAS unsigned* st) {
  XcdBarrier b; b.bar = bar; b.x = xb_xcc_id(); b.st = st;
  if (threadIdx.x == 0) (void)xb_add(&bar[XB_XCNT(b.x)], 1u);
  return b;
}
DI void xcd_barrier_complete(unsigned* bar, unsigned x, unsigned& nloc, unsigned& nx) {
  const unsigned G = gridDim.x * gridDim.y * gridDim.z;
  unsigned sum, cnt, mine, sp = 0u;
  for (;;) {
    sum = 0u; cnt = 0u; mine = 0u;
#pragma unroll
    for (unsigned j = 0; j < 16; ++j) { const unsigned c = xb_ld(&bar[XB_XCNT(j)]); sum += c; cnt += (c > 0u) ? 1u : 0u; mine = (j == x) ? c : mine; }
    if (sum == G) break;
    __builtin_amdgcn_s_sleep(1);
    if ((++sp & 255u) == 0u) { if (xb_ld(&bar[XB_TMO])) break; if (sp > XB_SPIN_CAP) { atomicAdd(&bar[XB_TMO], 1u); break; } }
  }
  nloc = mine > 0u ? mine : 1u; nx = cnt > 0u ? cnt : 1u;
}
DI void xcd_barrier(const XcdBarrier& b) {
  asm volatile("s_waitcnt vmcnt(0)" ::: "memory");
  __syncthreads();
  if (threadIdx.x == 0) {
    unsigned* bar = b.bar;
    __builtin_amdgcn_s_waitcnt(0);
    unsigned nloc = b.st[0], nx = b.st[1];
    if (nloc == 0u) { xcd_barrier_complete(bar, b.x, nloc, nx); b.st[0] = nloc; b.st[1] = nx; }
    const unsigned old = xb_add(&bar[XB_XSUB(b.x)], 1u);
    const unsigned gen = old / nloc;
    if (old + 1u == (gen + 1u) * nloc) {
      __builtin_amdgcn_fence(__ATOMIC_RELEASE, "agent");
      asm volatile("s_waitcnt vmcnt(0)" ::: "memory");
      const unsigned og = xb_add(&bar[XB_TOP], 1u);
      const unsigned tg = og / nx;
      if (og + 1u == (tg + 1u) * nx) xb_add(&bar[XB_TOPGEN], 1u);
      else XB_SPIN(xb_ld(&bar[XB_TOPGEN]) == tg, bar);
      __builtin_amdgcn_fence(__ATOMIC_ACQUIRE, "agent");
      xb_add(&bar[XB_XGEN(b.x)], 1u);
      asm volatile("s_waitcnt vmcnt(0)" ::: "memory");
    } else {
      XB_SPIN(xb_ld(&bar[XB_XGEN(b.x)]) == gen, bar);
      __builtin_amdgcn_fence(__ATOMIC_ACQUIRE, "agent");
      asm volatile("s_waitcnt vmcnt(0)" ::: "memory");
    }
  }
  __syncthreads();
}

DI void phase0(const Params& p, unsigned char* smem, int bid, int nb) {
  int tid = threadIdx.x; asm volatile("" : "+v"(tid));
  const int lane = tid & 63, wave = tid >> 6;
  unsigned char* ws = p.ws;
  if (bid == 0 && tid < 256) ((int*)(ws + O_CTRL))[tid * CSTR] = 0;
  for (int i = bid * NTHR + tid; i < T; i += nb * NTHR) ((int*)(ws + O_IDENT))[i] = i;
  {
    float* wabT = (float*)smem;
    const float* win = p.in[I_WIN];
    for (int i = tid; i < 8192; i += NTHR) { const int k = i >> 3, j = i & 7; wabT[j * 1024 + k] = win[(size_t)k * DIN + 2048 + j]; }
    __syncthreads();
    const float* x = p.in[I_X];
    bf16_t* xb = (bf16_t*)(ws + O_XB);
    float* ab = (float*)(ws + O_AB);
    for (int row = bid * 8 + wave; row < T; row += nb * 8) {
      float s[8];
#pragma unroll
      for (int j = 0; j < 8; ++j) s[j] = 0.f;
#pragma unroll
      for (int i = 0; i < 4; ++i) {
        const int k = 256 * i + 4 * lane;
        const f32x4 v = *(const f32x4*)(x + (size_t)row * D + k);
        *(u32x2*)(xb + (size_t)row * D + k) = pack4(v);
#pragma unroll
        for (int j = 0; j < 8; ++j) { const f32x4 w = *(const f32x4*)(wabT + j * 1024 + k); s[j] += v[0] * w[0] + v[1] * w[1] + v[2] * w[2] + v[3] * w[3]; }
      }
#pragma unroll
      for (int j = 0; j < 8; ++j) s[j] = wave_sum(s[j]);
      if (lane == 0) { *(f32x4*)(ab + (size_t)row * 8) = (f32x4){s[0], s[1], s[2], s[3]}; *(f32x4*)(ab + (size_t)row * 8 + 4) = (f32x4){s[4], s[5], s[6], s[7]}; }
    }
    const float* mem = p.in[I_MEM];
    bf16_t* memb = (bf16_t*)(ws + O_MEMB);
    for (int row = bid * 8 + wave; row < 512; row += nb * 8) {
#pragma unroll
      for (int i = 0; i < 4; ++i) { const int k = 256 * i + 4 * lane; *(u32x2*)(memb + (size_t)row * D + k) = pack4(*(const f32x4*)(mem + (size_t)row * D + k)); }
    }
    const float* sw = p.in[I_SGUW];
    bf16_t* sguw = (bf16_t*)(ws + O_SGUW);
    for (int i = bid * NTHR + tid; i < 16384; i += nb * NTHR) {
      const int e0 = i * 4; const int col = e0 & 127, rowi = (e0 >> 7) & 127;
      f32x4 v = *(const f32x4*)(sw + e0);
#pragma unroll
      for (int c = 0; c < 4; ++c) if (col + c > rowi) v[c] = 0.f;
      *(u32x2*)(sguw + e0) = pack4(v);
    }
    __syncthreads();
  }
  {
    float* tile = (float*)smem;
    const float *pwin = p.in[I_WIN], *pwa = p.in[I_WA], *pwb = p.in[I_WB], *pwc = p.in[I_WC], *pwo = p.in[I_WO], *pwmkv = p.in[I_WMKV], *prw = p.in[I_RW],
                *pwsg = p.in[I_WSG], *pwsu = p.in[I_WSU], *pwsd = p.in[I_WSD], *pwg = p.in[I_WG], *pwu = p.in[I_WU], *pwdn = p.in[I_WDN];
    { GAS const float *a_ = (GAS const float*)pwa, *b_ = (GAS const float*)pwb, *c_ = (GAS const float*)pwc, *o_ = (GAS const float*)pwo, *m_ = (GAS const float*)pwmkv;
      asm volatile("" : "+s"(a_), "+s"(b_), "+s"(c_), "+s"(o_), "+s"(m_));
      pwa = (const float*)a_; pwb = (const float*)b_; pwc = (const float*)c_; pwo = (const float*)o_; pwmkv = (const float*)m_; }
    constexpr int J0 = 1664, J1 = J0 + 128, J2 = J1 + 128, J3 = J2 + 128, J4 = J3 + 256, J5 = J4 + 256, J6 = J5 + 64, J7 = J6 + 128, J8 = J7 + 64,
                  J9 = J8, J10 = J8;
    const int kr = tid >> 4, nc = tid & 15, sg = nc >> 2;
    const int tn = tid >> 3, tkc = tid & 7;
#define P0_DECODE_LOAD(it0, dp, v0, v1) do { const float* sp[4]; int ld[4]; \
      _Pragma("unroll") \
      for (int q = 0; q < 4; ++q) { \
        const int it = (it0 + q < J10) ? it0 + q : J10 - 1;      \
        const float *s0, *s1, *s2, *s3; int ldd; bf16_t* dst; \
        if (it < J0) {           \
          const int kt = it & 15, nt = it >> 4; const int n0 = nt * 64; const int c0 = n0 + (n0 >= 2048 ? 8 : 0); \
          const float* b = pwin + (size_t)kt * 64 * DIN + c0; s0 = b; s1 = b + 16; s2 = b + 32; s3 = b + 48; ld[q] = DIN; ldd = 1024; \
          dst = (bf16_t*)(ws + O_WINT) + (size_t)n0 * 1024 + kt * 64; \
        } else if (it < J3) {    \
          const int which = (it - J0) >> 7, r = (it - J0) & 127; const int kt = r & 7, nt = r >> 3; \
          const float* src = which == 0 ? pwa : which == 1 ? pwb : pwc; \
          const float* b = src + (size_t)kt * 64 * 1024 + nt * 64; s0 = b; s1 = b + 16; s2 = b + 32; s3 = b + 48; ld[q] = 1024; ldd = 512; \
          dst = (bf16_t*)(ws + (which == 0 ? O_WAT : which == 1 ? O_WBT : O_WCT)) + (size_t)nt * 64 * 512 + kt * 64; \
        } else if (it < J5) {    \
          const int which = (it - J3) >> 8, r = (it - J3) & 255; const int kt = r & 15, nt = r >> 4; \
          const float* b = (which == 0 ? pwo : pwmkv) + (size_t)kt * 64 * 1024 + nt * 64; s0 = b; s1 = b + 16; s2 = b + 32; s3 = b + 48; ld[q] = 1024; ldd = 1024; \
          dst = (bf16_t*)(ws + (which == 0 ? O_WOT : O_WMKV)) + (size_t)nt * 64 * 1024 + kt * 64; \
        } else if (it < J6) {    \
          const int r = it - J5; const int kt = r & 15, nt = r >> 4; \
          const float* b = prw + (size_t)kt * 64 * 256 + nt * 64; s0 = b; s1 = b + 16; s2 = b + 32; s3 = b + 48; ld[q] = 256; ldd = 1024; \
          dst = (bf16_t*)(ws + O_ROUT) + (size_t)nt * 64 * 1024 + kt * 64; \
        } else if (it < J7) {    \
          const int r = it - J6; const int kt = r & 15, nt = r >> 4; \
          const float* g = pwsg + (size_t)kt * 64 * 256 + nt * 32; const float* u = pwsu + (size_t)kt * 64 * 256 + nt * 32; \
          s0 = g; s1 = u; s2 = g + 16; s3 = u + 16; ld[q] = 256; ldd = 1024; \
          dst = (bf16_t*)(ws + O_WSGU) + (size_t)nt * 64 * 1024 + kt * 64; \
        } else if (it < J8) {    \
          const int r = it - J7; const int kt = r & 3, nt = r >> 2; \
          const float* b = pwsd + (size_t)kt * 64 * 1024 + nt * 64; s0 = b; s1 = b + 16; s2 = b + 32; s3 = b + 48; ld[q] = 1024; ldd = 256; \
          dst = (bf16_t*)(ws + O_WSD) + (size_t)nt * 64 * 256 + kt * 64; \
        } else if (it < J9) {    \
          const int r = it - J8; const int e = r >> 7, qq = r & 127; const int kt = qq & 15, nt = qq >> 4; \
          const float* g = pwg + (size_t)e * 262144 + (size_t)kt * 64 * 256 + nt * 32; const float* u = pwu + (size_t)e * 262144 + (size_t)kt * 64 * 256 + nt * 32; \
          s0 = g; s1 = u; s2 = g + 16; s3 = u + 16; ld[q] = 256; ldd = 1024; \
          dst = (bf16_t*)(ws + O_WGU) + (size_t)e * 524288 + (size_t)nt * 64 * 1024 + kt * 64; \
        } else {                 \
          const int r = it - J9; const int e = r >> 6, qq = r & 63; const int kt = qq & 3, nt = qq >> 2; \
          const float* b = pwdn + (size_t)e * 262144 + (size_t)kt * 64 * 1024 + nt * 64; s0 = b; s1 = b + 16; s2 = b + 32; s3 = b + 48; ld[q] = 1024; ldd = 256; \
          dst = (bf16_t*)(ws + O_WD) + (size_t)e * 262144 + (size_t)nt * 64 * 256 + kt * 64; \
        } \
        sp[q] = (sg == 0 ? s0 : sg == 1 ? s1 : sg == 2 ? s2 : s3) + (size_t)kr * ld[q] + 4 * (nc & 3); \
        dp[q] = dst + (size_t)tn * ldd + 8 * tkc; \
      } \
      _Pragma("unroll") \
      for (int q = 0; q < 4; ++q) { v0[q] = __builtin_nontemporal_load((const f32x4*)(sp[q])); v1[q] = __builtin_nontemporal_load((const f32x4*)(sp[q] + (size_t)32 * ld[q])); } } while (0)
    bf16_t* dpn[4]; f32x4 v0n[4], v1n[4];
    int it0 = bid * 4;
    if (it0 < J10) P0_DECODE_LOAD(it0, dpn, v0n, v1n);
    for (; it0 < J10; it0 += nb * 4) {
      bf16_t* dp[4]; f32x4 v0[4], v1[4];
#pragma unroll
      for (int q = 0; q < 4; ++q) { dp[q] = dpn[q]; v0[q] = v0n[q]; v1[q] = v1n[q]; }
      if (it0 + nb * 4 < J10) P0_DECODE_LOAD(it0 + nb * 4, dpn, v0n, v1n);
      asm volatile("s_waitcnt lgkmcnt(0)" ::: "memory"); __builtin_amdgcn_s_barrier(); asm volatile("" ::: "memory");
#pragma unroll
      for (int q = 0; q < 4; ++q) {
        float* t0 = tile + q * 4160 + kr * 65 + 4 * nc;
        float* t1 = t0 + 32 * 65;
        t0[0] = v0[q][0]; t0[1] = v0[q][1]; t0[2] = v0[q][2]; t0[3] = v0[q][3];
        t1[0] = v1[q][0]; t1[1] = v1[q][1]; t1[2] = v1[q][2]; t1[3] = v1[q][3];
      }
      asm volatile("s_waitcnt lgkmcnt(0)" ::: "memory"); __builtin_amdgcn_s_barrier(); asm volatile("" ::: "memory");
#pragma unroll
      for (int q = 0; q < 4; ++q) {
        float e[8];
#pragma unroll
        for (int j = 0; j < 8; ++j) e[j] = tile[q * 4160 + (8 * tkc + j) * 65 + tn];
        u32x4 o = {pk2(e[0], e[1]), pk2(e[2], e[3]), pk2(e[4], e[5]), pk2(e[6], e[7])};
        *(u32x4*)(dp[q]) = o;
      }
    }
#undef P0_DECODE_LOAD
  }
}

#define EPI_ROWS(u) const int row_ = (u).pm * 256 + 64 * wr + fr
struct EpiInProj {
  unsigned char* ws;
  DI void operator()(const f32x4 (&acc)[2][2][4][2], const pg::Unit& u, int wr, int wc, int fr, int fq) const {
    const int colt = u.pn * 256;
#pragma unroll
    for (int ai = 0; ai < 2; ++ai)
#pragma unroll
      for (int m = 0; m < 4; ++m) {
        const size_t row = (size_t)u.pm * 256 + 128 * ai + 64 * wr + 16 * m + fr;
#pragma unroll
        for (int bj = 0; bj < 2; ++bj)
#pragma unroll
          for (int n = 0; n < 2; ++n) {
            const int col = colt + 128 * bj + 32 * wc + 16 * n + 4 * fq;
            f32x4 v = acc[ai][bj][m][n];
            if (colt < 1536) { *(u32x2*)((bf16_t*)(ws + O_QKV) + row * 1536 + col) = pack4(v); }
            else if (colt < 2048) {
#pragma unroll
              for (int c = 0; c < 4; ++c) v[c] = siluf_(v[c]);
              *(u32x2*)((bf16_t*)(ws + O_ZS) + row * 512 + (col - 1536)) = pack4(v);
            } else if (colt < 3072) {
#pragma unroll
              for (int c = 0; c < 4; ++c) v[c] = geluf_(v[c]);
              *(u32x2*)((bf16_t*)(ws + O_UVG) + row * 1024 + (col - 2048)) = pack4(v);
            } else if (colt < 3584) {
#pragma unroll
              for (int c = 0; c < 4; ++c) v[c] *= 0.08838834764831845f;
              *(u32x2*)((bf16_t*)(ws + O_XQ) + row * 512 + (col - 3072)) = pack4(v);
            } else {
#pragma unroll
              for (int c = 0; c < 4; ++c) v[c] = sigmoidf_(v[c]);
              *(u32x2*)((bf16_t*)(ws + O_GATES) + row * 3072 + (col - 3584)) = pack4(v);
            }
          }
      }
  }
};
struct EpiMemKV {
  unsigned char* ws;
  DI void operator()(const f32x4 (&acc)[2][2][4][2], const pg::Unit& u, int wr, int wc, int fr, int fq) const {
#pragma unroll
    for (int ai = 0; ai < 2; ++ai)
#pragma unroll
      for (int m = 0; m < 4; ++m) {
        const int row = u.pm * 256 + 128 * ai + 64 * wr + 16 * m + fr; const int b = row >> 8, key = row & 255;
#pragma unroll
        for (int bj = 0; bj < 2; ++bj)
#pragma unroll
          for (int n = 0; n < 2; ++n) {
            const int col = u.pn * 256 + 128 * bj + 32 * wc + 16 * n + 4 * fq;
            const f32x4 v = acc[ai][bj][m][n];
            if (col < 512) { const int h = col >> 7, d = col & 127; *(u32x2*)((bf16_t*)(ws + O_MEMK) + ((size_t)((b * 4 + h) * 256 + key)) * 128 + d) = pack4(v); }
            else {
              const int c2 = col - 512; const int h = c2 >> 7, d = c2 & 127;
              const int pos = 32 * (key >> 5) + 8 * ((key >> 2) & 3) + 4 * ((key >> 4) & 1) + (key & 3);
              bf16_t* vt = (bf16_t*)(ws + O_MEMVT) + ((size_t)((b * 4 + h) * 128 + d)) * 256 + pos;
#pragma unroll
              for (int c = 0; c < 4; ++c) vt[(size_t)c * 256] = f2bf(v[c]);
            }
          }
      }
  }
};
DI void phase1(const Params& p, unsigned char* smem, int bid, int nb) {
  unsigned char* ws = p.ws;
  PG_LAS unsigned char* lds = (PG_LAS unsigned char*)smem;
  __syncthreads();
  { pg::DenseOrder S; S.init(ws + O_XB, ws + O_WINT, T, NPROJ, 1024, nb, bid); EpiInProj E{ws}; pg::gemm_phase<EpiInProj, pg::DenseOrder, false, true>(lds, 1024, S, E); }
  __syncthreads();
  { pg::DenseOrder S; S.init(ws + O_MEMB, ws + O_WMKV, 512, 1024, 1024, nb, bid); EpiMemKV E{ws}; pg::gemm_phase<EpiMemKV, pg::DenseOrder, false, true>(lds, 1024, S, E); }
}

constexpr int G_KF = 0, G_VF = 32768, G_QB = 65536, G_KB = 81920, G_UT = 81920  , G_L = 98304, G_ATT = 114688, G_KDT = 122880, G_WT = 139264, G_SM = 155648;

DI void gdn_prep_item(const Params& p, unsigned char* smem_, int item) {
  unsigned char* smem; { LAS unsigned char* l_ = (LAS unsigned char*)smem_; asm volatile("" : "+v"(l_)); smem = (unsigned char*)l_; }
  int tid = threadIdx.x; asm volatile("" : "+v"(tid));
  const int lane = tid & 63, wave = tid >> 6, fr = lane & 15, fq = lane >> 4;
  unsigned char* ws; { GAS unsigned char* g_ = (GAS unsigned char*)p.ws; asm volatile("" : "+s"(g_)); ws = (unsigned char*)g_; }
  const int h = item & 3, cn = item >> 2;
  const int bidx = cn >> 7, n = cn & 127;
  const size_t t0 = (size_t)bidx * SEQ + (size_t)n * 64;
  float* kf = (float*)(smem + G_KF); float* vf = (float*)(smem + G_VF); float* Lm = (float*)(smem + G_L);
  float* sbeta = (float*)(smem + G_SM); float* sgc = sbeta + 64; float* segc = sbeta + 128;
  __syncthreads();
  {
    const bf16_t* qkv = (const bf16_t*)(ws + O_QKV);
    const float* cw = p.in[I_CONVW];
    const int tl0 = wave * 8;
#pragma unroll
    for (int sect = 0; sect < 3; ++sect) {
      const int cb = sect * 512 + h * 128 + 2 * lane;
      float w0[4], w1[4];
#pragma unroll
      for (int i = 0; i < 4; ++i) { w0[i] = cw[i * 1536 + cb]; w1[i] = cw[i * 1536 + cb + 1]; }
      float xa[11], xc[11];
#pragma unroll
      for (int r = 0; r < 11; ++r) {
        const int s = n * 64 + tl0 + r - 3;
        unsigned u = 0u;
        if (s >= 0) u = *(const unsigned*)(qkv + ((size_t)bidx * SEQ + s) * 1536 + cb);
        xa[r] = lo2f(u); xc[r] = hi2f(u);
      }
#pragma unroll
      for (int r = 0; r < 8; ++r) {
        float y0 = w0[0] * xa[r] + w0[1] * xa[r + 1] + w0[2] * xa[r + 2] + w0[3] * xa[r + 3];
        float y1 = w1[0] * xc[r] + w1[1] * xc[r + 1] + w1[2] * xc[r + 2] + w1[3] * xc[r + 3];
        y0 = siluf_(y0); y1 = siluf_(y1);
        const int tl = tl0 + r;
        if (sect == 2) { vf[tl * 128 + 2 * lane] = y0; vf[tl * 128 + 2 * lane + 1] = y1; }
        else {
          const float ss = wave_sum(y0 * y0 + y1 * y1);
          const float sc = rsqrtf(ss + 1e-6f) * (sect == 0 ? 0.08838834764831845f : 1.0f);
          y0 *= sc; y1 *= sc;
          const int off = sw256(tl, lane >> 2) + (lane & 3) * 4;
          if (sect == 0) *(unsigned*)(smem + G_QB + off) = pk2(y0, y1);
          else { *(unsigned*)(smem + G_KB + off) = pk2(y0, y1); kf[tl * 128 + 2 * lane] = y0; kf[tl * 128 + 2 * lane + 1] = y1; }
        }
      }
    }
    if (wave == 0) {
      const float* ab = (const float*)(ws + O_AB) + (t0 + lane) * 8;
      const float a = ab[h], bb = ab[4 + h];
      const float beta = sigmoidf_(bb);
      float g = -__expf(p.in[I_ALOG][h]) * softplusf_(a + p.in[I_DTB][h]);
#pragma unroll
      for (int o = 1; o < 64; o <<= 1) { const float y = __shfl_up(g, o); if (lane >= o) g += y; }
      sbeta[lane] = beta; sgc[lane] = g; segc[lane] = __expf(g);
      if (lane == 63) ((float*)(ws + O_GL))[item] = __expf(g);
    }
  }
  __syncthreads();
  {
#pragma unroll
    for (int q = 0; q < 4; ++q) {
      const int idx = wave * 4 + q; const int isq = idx >> 4, ti = (idx >> 2) & 3, tj = idx & 3;
      f32x4 acc = {0.f, 0.f, 0.f, 0.f};
      if (tj <= ti) {
#pragma unroll
        for (int ks = 0; ks < 4; ++ks) {
          const bf16x8 ai = ldfrag(smem + (isq ? G_QB : G_KB) + sw256(16 * ti + fr, 4 * ks + fq));
          const bf16x8 bj = ldfrag(smem + G_KB + sw256(16 * tj + fr, 4 * ks + fq));
          acc = isq ? mfma16(bj, ai, acc) : mfma16(ai, bj, acc);
        }
      }
      if (isq) {
        const int i = 16 * ti + fr, j0 = 16 * tj + 4 * fq;
        const float gi = sgc[i];
        f32x4 o;
#pragma unroll
        for (int r = 0; r < 4; ++r) { const int j = j0 + r; o[r] = (j <= i) ? acc[r] * __expf(gi - sgc[j]) : 0.f; }
        *(u32x2*)(smem + G_ATT + sw128(i, j0 >> 3) + (j0 & 7) * 2) = pack4(o);
      } else {
        const int j = 16 * tj + fr, i0 = 16 * ti + 4 * fq;
        const float gj = sgc[j];
        f32x4 o;
#pragma unroll
        for (int r = 0; r < 4; ++r) { const int i = i0 + r; o[r] = (j < i) ? acc[r] * __expf(sgc[i] - gj) * sbeta[i] : 0.f; }
        *(f32x4*)(Lm + j * 64 + i0) = o;
      }
    }
  }
  {
    const float gl_ = sgc[63];
    const int d = tid & 127, tg = tid >> 7;
#pragma unroll
    for (int c = 0; c < 2; ++c) {
      float e[8];
#pragma unroll
      for (int j = 0; j < 8; ++j) { const int t = 16 * tg + 8 * c + j; e[j] = kf[t * 128 + d] * __expf(gl_ - sgc[t]); }
      u32x4 o = {pk2(e[0], e[1]), pk2(e[2], e[3]), pk2(e[4], e[5]), pk2(e[6], e[7])};
      *(u32x4*)(smem + G_KDT + sw128(d, 2 * tg + c)) = o;
    }
  }
  __syncthreads();
  if (tid < 256) {
    const bool isw = tid >= 128;
    float* X = isw ? (kf + (tid - 128)) : (vf + tid);
    unsigned char* dstT = smem + (isw ? G_WT : G_UT);
    const int rowc = tid & 127;
#pragma unroll
    for (int b = 0; b < 4; ++b) {
      float xr[16];
#pragma unroll
      for (int r = 0; r < 16; ++r) { const int t = 16 * b + r; float sc = sbeta[t]; if (isw) sc *= segc[t]; xr[r] = X[t * 128] * sc; }
#pragma unroll 2
      for (int j = 0; j < 16 * b; ++j) {
        const float xj = X[j * 128];
        const float* lt = Lm + j * 64 + 16 * b;
        const f32x4 l0 = *(const f32x4*)lt, l1 = *(const f32x4*)(lt + 4), l2 = *(const f32x4*)(lt + 8), l3 = *(const f32x4*)(lt + 12);
#pragma unroll
        for (int r = 0; r < 4; ++r) { xr[r] -= l0[r] * xj; xr[4 + r] -= l1[r] * xj; xr[8 + r] -= l2[r] * xj; xr[12 + r] -= l3[r] * xj; }
      }
#pragma unroll
      for (int q = 0; q < 15; ++q) {
        const float* lt = Lm + (16 * b + q) * 64 + 16 * b;
        float l[16];
#pragma unroll
        for (int g4 = 0; g4 < 4; ++g4) if (4 * g4 + 3 > q) { const f32x4 t4 = *(const f32x4*)(lt + 4 * g4); l[4 * g4] = t4[0]; l[4 * g4 + 1] = t4[1]; l[4 * g4 + 2] = t4[2]; l[4 * g4 + 3] = t4[3]; }
#pragma unroll
        for (int r = q + 1; r < 16; ++r) xr[r] -= l[r] * xr[q];
      }
#pragma unroll
      for (int r = 0; r < 16; ++r) X[(16 * b + r) * 128] = xr[r];
      u32x4 o0 = {pk2(xr[0], xr[1]), pk2(xr[2], xr[3]), pk2(xr[4], xr[5]), pk2(xr[6], xr[7])};
      u32x4 o1 = {pk2(xr[8], xr[9]), pk2(xr[10], xr[11]), pk2(xr[12], xr[13]), pk2(xr[14], xr[15])};
      *(u32x4*)(dstT + sw128(rowc, 2 * b)) = o0;
      *(u32x4*)(dstT + sw128(rowc, 2 * b + 1)) = o1;
    }
  }
  __syncthreads();
  {
    bf16x8 ak[2];
#pragma unroll
    for (int ks = 0; ks < 2; ++ks) ak[ks] = ldfrag(smem + G_KDT + sw128(16 * wave + fr, 4 * ks + fq));
    bf16_t* mp = (bf16_t*)(ws + O_MP) + (size_t)item * 16384;
    bf16_t* bc = (bf16_t*)(ws + O_BC) + (size_t)item * 16384;
#pragma unroll
    for (int tj = 0; tj < 8; ++tj) {
      f32x4 am = {0.f, 0.f, 0.f, 0.f}, ab_ = {0.f, 0.f, 0.f, 0.f};
#pragma unroll
      for (int ks = 0; ks < 2; ++ks) {
        const bf16x8 bw = ldfrag(smem + G_WT + sw128(16 * tj + fr, 4 * ks + fq));
        const bf16x8 bu = ldfrag(smem + G_UT + sw128(16 * tj + fr, 4 * ks + fq));
        am = mfma16(bw, ak[ks], am);
        ab_ = mfma16(ak[ks], bu, ab_);
      }
      f32x4 nm = {-am[0], -am[1], -am[2], -am[3]};
      *(u32x2*)(mp + ((size_t)((wave * 4 + (tj >> 1)) * 64 + lane)) * 8 + (tj & 1) * 4) = pack4(nm);
      *(u32x2*)(bc + ((size_t)((tj * 4 + (wave >> 1)) * 64 + lane)) * 8 + (wave & 1) * 4) = pack4(ab_);
    }
    const int tt = wave & 3, hf = wave >> 2;
    bf16x8 aa[2];
#pragma unroll
    for (int ks = 0; ks < 2; ++ks) aa[ks] = ldfrag(smem + G_ATT + sw128(16 * tt + fr, 4 * ks + fq));
    const int trow = 16 * tt + fr;
    const float eg = segc[trow];
    float* o0 = (float*)(ws + O_O0) + (t0 + trow) * 512 + h * 128;
    bf16_t* qp = (bf16_t*)(ws + O_QP) + (size_t)item * 8192 + trow * 128;
#pragma unroll
    for (int q = 0; q < 4; ++q) {
      const int te = hf * 4 + q;
      f32x4 ao = {0.f, 0.f, 0.f, 0.f}, aw = {0.f, 0.f, 0.f, 0.f};
#pragma unroll
      for (int ks = 0; ks < 2; ++ks) {
        const bf16x8 bu = ldfrag(smem + G_UT + sw128(16 * te + fr, 4 * ks + fq));
        const bf16x8 bw = ldfrag(smem + G_WT + sw128(16 * te + fr, 4 * ks + fq));
        ao = mfma16(bu, aa[ks], ao);
        aw = mfma16(bw, aa[ks], aw);
      }
      const int e0 = 16 * te + 4 * fq;
      *(f32x4*)(o0 + e0) = ao;
      const u32x2 qv = *(const u32x2*)(smem + G_QB + sw256(trow, e0 >> 3) + (e0 & 7) * 2);
      f32x4 qd = {lo2f(qv[0]) * eg - aw[0], hi2f(qv[0]) * eg - aw[1], lo2f(qv[1]) * eg - aw[2], hi2f(qv[1]) * eg - aw[3]};
      *(u32x2*)(qp + e0) = pack4(qd);
    }
  }
}

typedef short s16x4 __attribute__((ext_vector_type(4)));
DI bf16x8 tr_frag(const unsigned char* p0, const unsigned char* p1) {
  const s16x4 a = __builtin_amdgcn_ds_read_tr16_b64_v4i16((LAS s16x4*)p0), b = __builtin_amdgcn_ds_read_tr16_b64_v4i16((LAS s16x4*)p1);
  bf16x8 r; r[0] = a[0]; r[1] = a[1]; r[2] = a[2]; r[3] = a[3]; r[4] = b[0]; r[5] = b[1]; r[6] = b[2]; r[7] = b[3]; return r;
}
DI void sgu_item(const Params& p, unsigned char* smem_, int item) {
  unsigned char* smem; { LAS unsigned char* l_ = (LAS unsigned char*)smem_; asm volatile("" : "+v"(l_)); smem = (unsigned char*)l_; }
  int tid = threadIdx.x; asm volatile("" : "+v"(tid));
  const int lane = tid & 63, wave = __builtin_amdgcn_readfirstlane(tid >> 6), fr = lane & 15, fq = lane >> 4;
  unsigned char* ws; { GAS unsigned char* g_ = (GAS unsigned char*)p.ws; asm volatile("" : "+s"(g_)); ws = (unsigned char*)g_; }
  const int gp = item & 1, cn = item >> 1;
  const size_t t0 = (size_t)cn * 128;
  const bf16_t* uvg = (const bf16_t*)(ws + O_UVG);
  constexpr int VS = 544;
  __syncthreads();
  {
    const float* lng = p.in[I_SLNG]; const float* lnb = p.in[I_SLNB];
    float gg[8], bb[8];
#pragma unroll
    for (int e = 0; e < 8; ++e) { gg[e] = lng[8 * lane + e]; bb[e] = lnb[8 * lane + e]; }
#pragma unroll 2
    for (int jj = 0; jj < 16; ++jj) {
      const int j = 16 * wave + jj;
      const u32x4 raw = *(const u32x4*)(uvg + (t0 + j) * 1024 + 512 + 8 * lane);
      float v[8];
#pragma unroll
      for (int e = 0; e < 4; ++e) { v[2 * e] = lo2f(raw[e]); v[2 * e + 1] = hi2f(raw[e]); }
      float s = 0.f, q2 = 0.f;
#pragma unroll
      for (int e = 0; e < 8; ++e) { s += v[e]; q2 += v[e] * v[e]; }
      s = wave_sum(s); q2 = wave_sum(q2);
      const float mean = s * (1.f / 512.f);
      const float rstd = rsqrtf(fmaxf(q2 * (1.f / 512.f) - mean * mean, 0.f) + 1e-5f);
      if ((lane >> 5) == gp) {
        float y[8];
#pragma unroll
        for (int e = 0; e < 8; ++e) y[e] = (v[e] - mean) * rstd * gg[e] + bb[e];
        u32x4 o = {pk2(y[0], y[1]), pk2(y[2], y[3]), pk2(y[4], y[5]), pk2(y[6], y[7])};
        *(u32x4*)(smem + j * VS + (lane & 31) * 16) = o;
      }
    }
  }
  __syncthreads();
  {
    const int i = 16 * wave + fr;
    const int q = (lane & 15) >> 2, pp = lane & 3;
    const unsigned char* vb = smem + (8 * fq + q) * VS + 8 * pp;
#pragma unroll 1
    for (int gl = 0; gl < 2; ++gl) {
      const int g = 2 * gp + gl;
      const bf16_t* wg = (const bf16_t*)(ws + O_SGUW) + (size_t)g * 16384;
      bf16x8 af[4];
#pragma unroll
      for (int ks = 0; ks < 4; ++ks) af[ks] = ldfrag(wg + i * 128 + 32 * ks + 8 * fq);
      const float bias = p.in[I_SGUB][g * 128 + i];
      bf16_t* out = (bf16_t*)(ws + O_SGUO) + (t0 + i) * 512 + 128 * g;
      const bf16_t* urow = uvg + (t0 + i) * 1024 + 128 * g;
#pragma unroll
      for (int jt = 0; jt < 8; ++jt) {
        f32x4 acc = {0.f, 0.f, 0.f, 0.f};
#pragma unroll
        for (int ks = 0; ks < 4; ++ks) {
          const unsigned char* a0 = vb + ks * 32 * VS + (128 * gl + 16 * jt) * 2;
          acc = mfma16(tr_frag(a0, a0 + 4 * VS), af[ks], acc);
        }
        const int c0 = 16 * jt + 4 * fq;
        const u32x2 uu = *(const u32x2*)(urow + c0);
        f32x4 o = {lo2f(uu[0]) * (acc[0] + bias), hi2f(uu[0]) * (acc[1] + bias), lo2f(uu[1]) * (acc[2] + bias), hi2f(uu[1]) * (acc[3] + bias)};
        *(u32x2*)(out + c0) = pack4(o);
        if (jt & 1) __builtin_amdgcn_sched_barrier(0);
      }
    }
  }
}

DI void xattn_item(const Params& p, unsigned char* smem_, int item) {
  int tid = threadIdx.x; asm volatile("" : "+v"(tid));
  unsigned char* smem; { LAS unsigned char* l_ = (LAS unsigned char*)smem_; asm volatile("" : "+v"(l_)); smem = (unsigned char*)l_; }
  const int lane = tid & 63, wave = tid >> 6, fr = lane & 15, fq = lane >> 4;
  unsigned char* ws; { GAS unsigned char* g_ = (GAS unsigned char*)p.ws; asm volatile("" : "+s"(g_)); ws = (unsigned char*)g_; }
  const int bh = item & 7, qb = item >> 3;
  const int b = bh >> 2, h = bh & 3;
  const bf16_t* mk = (const bf16_t*)(ws + O_MEMK) + (size_t)bh * 32768;
  const bf16_t* mv = (const bf16_t*)(ws + O_MEMVT) + (size_t)bh * 32768;
  __syncthreads();
#pragma unroll 2
  for (int j = 0; j < 8; ++j) {
    const int c = tid + 512 * j;
    const int rk = c >> 4, ck = c & 15;
    *(u32x4*)(smem + sw256(rk, ck)) = *(const u32x4*)(mk + (size_t)c * 8);
    const int rv = c >> 5, cv = c & 31;
    *(u32x4*)(smem + 65536 + rv * 512 + ((cv ^ (rv & 15)) << 4)) = *(const u32x4*)(mv + (size_t)c * 8);
  }
  __syncthreads();
  const unsigned char* kbase[4]; const unsigned char* vbase[8];
#pragma unroll
  for (int ds = 0; ds < 4; ++ds) kbase[ds] = smem + fr * 256 + (((4 * ds + fq) ^ fr) << 4);
#pragma unroll
  for (int s = 0; s < 8; ++s) vbase[s] = smem + 65536 + fr * 512 + (((4 * s + fq) ^ fr) << 4);
#pragma unroll 1
  for (int half = 0; half < 2; ++half) {
    const size_t trow = (size_t)b * SEQ + (size_t)qb * 256 + half * 128 + 16 * wave + fr;
    const bf16_t* xq = (const bf16_t*)(ws + O_XQ) + trow * 512 + h * 128;
    bf16x8 qf[4];
#pragma unroll
    for (int ds = 0; ds < 4; ++ds) qf[ds] = ldfrag(xq + 32 * ds + 8 * fq);
    f32x4 sc[16];
#pragma unroll
    for (int kt = 0; kt < 16; ++kt) {
      f32x4 a = {0.f, 0.f, 0.f, 0.f};
#pragma unroll
      for (int ds = 0; ds < 4; ++ds) a = mfma16(ldfrag(kbase[ds] + kt * 4096), qf[ds], a);
      sc[kt] = a;
      if (kt & 1) __builtin_amdgcn_sched_barrier(0);
    }
    float m = -1e30f;
#pragma unroll
    for (int kt = 0; kt < 16; ++kt)
#pragma unroll
      for (int r = 0; r < 4; ++r) m = fmaxf(m, sc[kt][r]);
    m = fmaxf(m, __shfl_xor(m, 16)); m = fmaxf(m, __shfl_xor(m, 32));
    float l = 0.f;
#pragma unroll
    for (int kt = 0; kt < 16; ++kt)
#pragma unroll
      for (int r = 0; r < 4; ++r) { const float e = __expf(sc[kt][r] - m); sc[kt][r] = e; l += e; }
    l += __shfl_xor(l, 16); l += __shfl_xor(l, 32);
    const float inv = 1.f / l;
    bf16x8 pf[8];
#pragma unroll
    for (int s = 0; s < 8; ++s) pf[s] = pack8(sc[2 * s], sc[2 * s + 1]);
    bf16_t* out = (bf16_t*)(ws + O_XATO) + trow * 512 + h * 128;
#pragma unroll
    for (int dt = 0; dt < 8; ++dt) {
      f32x4 a = {0.f, 0.f, 0.f, 0.f};
#pragma unroll
      for (int s = 0; s < 8; ++s) a = mfma16(ldfrag(vbase[s] + dt * 8192), pf[s], a);
      __builtin_amdgcn_sched_barrier(0);
      f32x4 o = {a[0] * inv, a[1] * inv, a[2] * inv, a[3] * inv};
      *(u32x2*)(out + 16 * dt + 4 * fq) = pack4(o);
    }
  }
}

DI void phase2(const Params& p, unsigned char* smem, int bid, int nb) {
  for (int rep = 0; rep < ((DUPMASK >> 20) & 1) + 1; ++rep) for (int it = bid; it < 1024; it += nb) gdn_prep_item(p, smem, it);
  for (int rep = 0; rep < ((DUPMASK >> 21) & 1) + 1; ++rep) for (int it = bid; it < 256; it += nb) sgu_item(p, smem, it);
  for (int rep = 0; rep < ((DUPMASK >> 22) & 1) + 1; ++rep) for (int it = bid; it < 256; it += nb) xattn_item(p, smem, it);
}

DI void gdn_scan4(const Params& p, unsigned char* smem_, int bh, int es) {
  int tid = threadIdx.x; asm volatile("" : "+v"(tid));
  unsigned char* smem; { LAS unsigned char* l_ = (LAS unsigned char*)smem_; asm volatile("" : "+v"(l_)); smem = (unsigned char*)l_; }
  const int lane = tid & 63, w = __builtin_amdgcn_readfirstlane(tid >> 6);
  if (w >= 4) {
    for (int n = 0; n < 128; ++n) __builtin_amdgcn_s_barrier();
    return;
  }
  unsigned char* ws = p.ws;
  const int b = bh >> 2, h = bh & 3;
  const int fr = lane & 15, fq = lane >> 4;
  const size_t item0 = (size_t)(b * 128) * 4 + h;
  constexpr size_t ISTR = 4 * 16384;
  const bf16_t* mp = (const bf16_t*)(ws + O_MP) + item0 * 16384 + (size_t)(2 * w) * 2048 + lane * 8;
  const bf16_t* bc = (const bf16_t*)(ws + O_BC) + item0 * 16384 + (size_t)es * 2048 + (size_t)w * 512 + lane * 8;
  bf16_t* st = (bf16_t*)(ws + O_ST) + item0 * 16384 + (size_t)(16 * es + fr) * 128 + 32 * w + 4 * fq;
  const float* glp = (const float*)(ws + O_GL) + item0;
  { GAS const float* g_ = (GAS const float*)glp; asm volatile("" : "+v"(g_)); glp = (const float*)g_; }
  f32x4 acc0 = {0.f, 0.f, 0.f, 0.f}, acc1 = {0.f, 0.f, 0.f, 0.f};
  constexpr int PD = 4;
  bf16x8 A[PD][8]; u32x4 C[PD]; float G[PD];
#pragma unroll
  for (int d = 0; d < PD; ++d) {
#pragma unroll
    for (int i = 0; i < 8; ++i) A[d][i] = ldfrag(mp + (size_t)d * ISTR + i * 512);
    C[d] = *(const u32x4*)(bc + (size_t)d * ISTR);
    G[d] = glp[d * 4];
  }
  unsigned char* xch = smem;
  for (int n0 = 0; n0 < 128; n0 += PD) {
#pragma unroll
    for (int d = 0; d < PD; ++d) {
      const int n = n0 + d;
      const int np = (n + PD < 128) ? n + PD : n;
      const u32x2 lo = pack4(acc0), hi = pack4(acc1);
      bf16_t* stn = st + (size_t)n * ISTR;
      *(u32x2*)(stn) = lo; *(u32x2*)(stn + 16) = hi;
      const u32x4 mine = {lo[0], lo[1], hi[0], hi[1]};
      *(u32x4*)(xch + ((n & 1) * 4 + w) * 1024 + lane * 16) = mine;
      asm volatile("s_waitcnt lgkmcnt(0)" ::: "memory");
      __builtin_amdgcn_s_barrier();
      asm volatile("" ::: "memory");
      bf16x8 bfr[4];
#pragma unroll
      for (int s = 0; s < 4; ++s) bfr[s] = ldfrag(xch + ((n & 1) * 4 + s) * 1024 + lane * 16);
      const float g = G[d];
      f32x4 a0 = {g * acc0[0] + lo2f(C[d][0]), g * acc0[1] + hi2f(C[d][0]), g * acc0[2] + lo2f(C[d][1]), g * acc0[3] + hi2f(C[d][1])};
      f32x4 a1 = {g * acc1[0] + lo2f(C[d][2]), g * acc1[1] + hi2f(C[d][2]), g * acc1[2] + lo2f(C[d][3]), g * acc1[3] + hi2f(C[d][3])};
#pragma unroll
      for (int s = 0; s < 4; ++s) { a0 = mfma16(A[d][s], bfr[s], a0); a1 = mfma16(A[d][4 + s], bfr[s], a1); }
      acc0 = a0; acc1 = a1;
#pragma unroll
      for (int i = 0; i < 8; ++i) A[d][i] = ldfrag(mp + (size_t)np * ISTR + i * 512);
      C[d] = *(const u32x4*)(bc + (size_t)np * ISTR);
      G[d] = glp[(size_t)np * 4];
    }
  }
}

struct EpiGate {
  const bf16_t* gates; int goff; const bf16_t* src; bf16_t* dst;
  DI void operator()(const f32x4 (&acc)[2][2][4][2], const pg::Unit& u, int wr, int wc, int fr, int fq) const {
#pragma unroll
    for (int ai = 0; ai < 2; ++ai)
#pragma unroll
      for (int m = 0; m < 4; ++m) {
        const size_t row = (size_t)u.pm * 256 + 128 * ai + 64 * wr + 16 * m + fr;
#pragma unroll
        for (int bj = 0; bj < 2; ++bj)
#pragma unroll
          for (int n = 0; n < 2; ++n) {
            const int col = u.pn * 256 + 128 * bj + 32 * wc + 16 * n + 4 * fq;
            const f32x4 v = acc[ai][bj][m][n];
            const u32x2 g = *(const u32x2*)(gates + row * 3072 + goff + col);
            f32x4 o = {lo2f(g[0]) * v[0], hi2f(g[0]) * v[1], lo2f(g[1]) * v[2], hi2f(g[1]) * v[3]};
            if (src) { const u32x2 s = *(const u32x2*)(src + row * 1024 + col); o[0] += lo2f(s[0]); o[1] += hi2f(s[0]); o[2] += lo2f(s[1]); o[3] += hi2f(s[1]); }
            *(u32x2*)(dst + row * 1024 + col) = pack4(o);
          }
      }
  }
};
DI void phase3(const Params& p, unsigned char* smem, int bid, int nb) {
  unsigned char* ws = p.ws;
  if (bid < 64) {
    __syncthreads();
    gdn_scan4(p, smem, bid & 7, bid >> 3);
  } else {
    PG_LAS unsigned char* lds = (PG_LAS unsigned char*)smem;
    const bf16_t* gates = (const bf16_t*)(ws + O_GATES);
    bf16_t* part = (bf16_t*)(ws + O_PART);
    __syncthreads();
    { pg::DenseOrder S; S.init(ws + O_SGUO, ws + O_WBT, T, 1024, 512, nb - 64, bid - 64); EpiGate E{gates, 1024, nullptr, part}; pg::gemm_phase<EpiGate, pg::DenseOrder, false, true>(lds, 512, S, E); }
    asm volatile("s_waitcnt vmcnt(0)" ::: "memory");
    __builtin_amdgcn_fence(__ATOMIC_ACQUIRE, "agent");
    asm volatile("s_waitcnt vmcnt(0)" ::: "memory");
    __syncthreads();
    { pg::DenseOrder S; S.init(ws + O_XATO, ws + O_WCT, T, 1024, 512, nb - 64, bid - 64); EpiGate E{gates, 2048, part, part}; pg::gemm_phase<EpiGate, pg::DenseOrder, false, true>(lds, 512, S, E); }
  }
}

DI void phase4(const Params& p, int bid, int nb) {
  int tid = threadIdx.x; asm volatile("" : "+v"(tid));
  const int lane = tid & 63, wave = tid >> 6, fr = lane & 15, fq = lane >> 4;
  unsigned char* ws = p.ws;
  for (int it = bid; it < 512; it += nb) {
    const int item = it * 2 + (wave >> 2), tt = wave & 3;
    const int h = item & 3, cn = item >> 2;
    const size_t trow = (size_t)cn * 64 + 16 * tt + fr;
    const bf16_t* qp = (const bf16_t*)(ws + O_QP) + (size_t)item * 8192 + (16 * tt + fr) * 128;
    const bf16_t* st = (const bf16_t*)(ws + O_ST) + (size_t)item * 16384;
    const float* o0 = (const float*)(ws + O_O0) + trow * 512 + h * 128;
    bf16x8 af[4];
#pragma unroll
    for (int ks = 0; ks < 4; ++ks) af[ks] = ldfrag(qp + 32 * ks + 8 * fq);
    f32x4 acc[8];
    float ss = 0.f;
#pragma unroll
    for (int j = 0; j < 8; ++j) {
      f32x4 a = *(const f32x4*)(o0 + 16 * j + 4 * fq);
#pragma unroll
      for (int ks = 0; ks < 4; ++ks) a = mfma16(ldfrag(st + (16 * j + fr) * 128 + 32 * ks + 8 * fq), af[ks], a);
      acc[j] = a;
      ss += a[0] * a[0] + a[1] * a[1] + a[2] * a[2] + a[3] * a[3];
    }
    ss += __shfl_xor(ss, 16); ss += __shfl_xor(ss, 32);
    const float rms = rsqrtf(ss * (1.f / 128.f) + 1e-6f);
    const float* ng = p.in[I_GNG];
    const bf16_t* zs = (const bf16_t*)(ws + O_ZS) + trow * 512 + h * 128;
    bf16_t* out = (bf16_t*)(ws + O_GDNO) + trow * 512 + h * 128;
#pragma unroll
    for (int j = 0; j < 8; ++j) {
      const int e0 = 16 * j + 4 * fq;
      const f32x4 g = *(const f32x4*)(ng + e0);
      const u32x2 z = *(const u32x2*)(zs + e0);
      f32x4 o = {acc[j][0] * rms * g[0] * lo2f(z[0]), acc[j][1] * rms * g[1] * hi2f(z[0]), acc[j][2] * rms * g[2] * lo2f(z[1]), acc[j][3] * rms * g[3] * hi2f(z[1])};
      *(u32x2*)(out + e0) = pack4(o);
    }
  }
}

DI void phase5(const Params& p, unsigned char* smem, int bid, int nb) {
  unsigned char* ws = p.ws;
  PG_LAS unsigned char* lds = (PG_LAS unsigned char*)smem;
  __syncthreads();
  pg::DenseOrder S; S.init(ws + O_GDNO, ws + O_WAT, T, 1024, 512, nb, bid);
  EpiGate E{(const bf16_t*)(ws + O_GATES), 0, (const bf16_t*)(ws + O_PART), (bf16_t*)(ws + O_MERGED)};
  pg::gemm_phase<EpiGate, pg::DenseOrder, false, true>(lds, 512, S, E);
}
struct EpiX1 {
  const float* x; float* x1;
  DI void operator()(const f32x4 (&acc)[2][2][4][2], const pg::Unit& u, int wr, int wc, int fr, int fq) const {
#pragma unroll
    for (int ai = 0; ai < 2; ++ai)
#pragma unroll
      for (int m = 0; m < 4; ++m) {
        const size_t row = (size_t)u.pm * 256 + 128 * ai + 64 * wr + 16 * m + fr;
#pragma unroll
        for (int bj = 0; bj < 2; ++bj)
#pragma unroll
          for (int n = 0; n < 2; ++n) {
            const int col = u.pn * 256 + 128 * bj + 32 * wc + 16 * n + 4 * fq;
            const f32x4 v = acc[ai][bj][m][n];
            const f32x4 xv = *(const f32x4*)(x + row * 1024 + col);
            f32x4 o = {ALPHA * xv[0] + v[0], ALPHA * xv[1] + v[1], ALPHA * xv[2] + v[2], ALPHA * xv[3] + v[3]};
            *(f32x4*)(x1 + row * 1024 + col) = o;
          }
      }
  }
};
DI void phase6(const Params& p, unsigned char* smem, int bid, int nb) {
  unsigned char* ws = p.ws;
  PG_LAS unsigned char* lds = (PG_LAS unsigned char*)smem;
  __syncthreads();
  pg::DenseOrder S; S.init(ws + O_MERGED, ws + O_WOT, T, 1024, 1024, nb, bid);
  EpiX1 E{p.in[I_X], (float*)(ws + O_X1)};
  pg::gemm_phase<EpiX1, pg::DenseOrder, false, false>(lds, 1024, S, E);
}

DI void ln_row(const float* src, const float* g, const float* b, float (&v)[16], int lane) {
  float s = 0.f;
#pragma unroll
  for (int i = 0; i < 16; ++i) s += v[i];
  const float mean = wave_sum(s) * (1.f / 1024.f);
  float q = 0.f;
#pragma unroll
  for (int i = 0; i < 16; ++i) { const float d = v[i] - mean; q += d * d; }
  const float rstd = rsqrtf(wave_sum(q) * (1.f / 1024.f) + 1e-5f);
#pragma unroll
  for (int i = 0; i < 4; ++i) {
    const int k = 256 * i + 4 * lane;
    const f32x4 gg = *(const f32x4*)(g + k), bb = *(const f32x4*)(b + k);
#pragma unroll
    for (int c = 0; c < 4; ++c) v[4 * i + c] = (v[4 * i + c] - mean) * rstd * gg[c] + bb[c];
  }
}
DI void phase7(const Params& p, int bid, int nb) {
  int tid = threadIdx.x; asm volatile("" : "+v"(tid));
  const int lane = tid & 63, wave = tid >> 6;
  unsigned char* ws = p.ws;
  for (int i = bid * NTHR + tid; i < MAXSLOT; i += nb * NTHR) { ((int*)(ws + O_SLOTTOK))[i] = 0; ((int*)(ws + O_SLOTAID))[i] = -1; }
  float* x1 = (float*)(ws + O_X1);
  bf16_t* x1b = (bf16_t*)(ws + O_X1B);
  for (int row = bid * 8 + wave; row < T; row += nb * 8) {
    float v[16];
#pragma unroll
    for (int i = 0; i < 4; ++i) { const f32x4 t = *(const f32x4*)(x1 + (size_t)row * D + 256 * i + 4 * lane); v[4 * i] = t[0]; v[4 * i + 1] = t[1]; v[4 * i + 2] = t[2]; v[4 * i + 3] = t[3]; }
    ln_row(nullptr, p.in[I_LN1G], p.in[I_LN1B], v, lane);
#pragma unroll
    for (int i = 0; i < 4; ++i) {
      const f32x4 o = {v[4 * i], v[4 * i + 1], v[4 * i + 2], v[4 * i + 3]};
      *(f32x4*)(x1 + (size_t)row * D + 256 * i + 4 * lane) = o;
      *(u32x2*)(x1b + (size_t)row * D + 256 * i + 4 * lane) = pack4(o);
    }
  }
}
struct EpiLogits {
  float* logits;
  DI void operator()(const f32x4 (&acc)[2][2][4][2], const pg::Unit& u, int wr, int wc, int fr, int fq) const {
#pragma unroll
    for (int ai = 0; ai < 2; ++ai)
#pragma unroll
      for (int m = 0; m < 4; ++m) {
        const size_t row = (size_t)u.pm * 256 + 128 * ai + 64 * wr + 16 * m + fr;
#pragma unroll
        for (int bj = 0; bj < 2; ++bj)
#pragma unroll
          for (int n = 0; n < 2; ++n) *(f32x4*)(logits + row * 256 + 128 * bj + 32 * wc + 16 * n + 4 * fq) = acc[ai][bj][m][n];
      }
  }
};
DI void phase8(const Params& p, unsigned char* smem, int bid, int nb) {
  unsigned char* ws = p.ws;
  PG_LAS unsigned char* lds = (PG_LAS unsigned char*)smem;
  __syncthreads();
  pg::DenseOrder S; S.init(ws + O_X1B, ws + O_ROUT, T, 256, 1024, nb, bid);
  EpiLogits E{(float*)(ws + O_LOGITS)};
  pg::gemm_phase<EpiLogits, pg::DenseOrder, false, false>(lds, 1024, S, E);
}
DI void phase9(const Params& p, int bid, int nb) {
  int tid = threadIdx.x; asm volatile("" : "+v"(tid));
  const int lane = tid & 63, wave = tid >> 6;
  unsigned char* ws = p.ws;
  const float* logits = (const float*)(ws + O_LOGITS);
  int* counts = (int*)(ws + O_CTRL);
  const int g = lane & 7, tsub = lane >> 3;
  const float NEG = -__builtin_inff();
  float bias[32];
#pragma unroll
  for (int j4 = 0; j4 < 8; ++j4) { const f32x4 b4 = *(const f32x4*)(p.in[I_RB] + 32 * g + 4 * j4); bias[4 * j4] = b4[0]; bias[4 * j4 + 1] = b4[1]; bias[4 * j4 + 2] = b4[2]; bias[4 * j4 + 3] = b4[3]; }
  for (int tok0 = (bid * 8 + wave) * 8; tok0 < T; tok0 += nb * 64) {
    const int tok = tok0 + tsub;
    float sc[32], bz[32];
#pragma unroll
    for (int j4 = 0; j4 < 8; ++j4) {
      const f32x4 l4 = *(const f32x4*)(logits + (size_t)tok * 256 + 32 * g + 4 * j4);
#pragma unroll
      for (int c = 0; c < 4; ++c) { sc[4 * j4 + c] = sigmoidf_(l4[c]); bz[4 * j4 + c] = sc[4 * j4 + c] + bias[4 * j4 + c]; }
    }
    float m1 = NEG, m2 = NEG;
#pragma unroll
    for (int j = 0; j < 32; ++j) { const float v = bz[j]; if (v > m1) { m2 = m1; m1 = v; } else if (v > m2) m2 = v; }
    const float gs = m1 + m2;
    int rank = 0;
#pragma unroll
    for (int gg = 0; gg < 8; ++gg) { const float og = __shfl(gs, (lane & ~7) | gg); rank += ((og > gs) || (og == gs && gg < g)) ? 1 : 0; }
    if (rank >= 4) {
#pragma unroll
      for (int j = 0; j < 32; ++j) bz[j] = NEG;
    }
    int myidx = 0; float mysc = 0.f, ssum = 0.f;
#pragma unroll 1
    for (int k = 0; k < 8; ++k) {
      float bv = bz[0], bs = sc[0]; int bi = 0;
#pragma unroll
      for (int j = 1; j < 32; ++j) if (bz[j] > bv) { bv = bz[j]; bi = j; bs = sc[j]; }
      float rv = bv, rs = bs; int ri = 32 * g + bi;
#pragma unroll
      for (int o = 1; o < 8; o <<= 1) {
        const float ov = __shfl_xor(rv, o), os = __shfl_xor(rs, o); const int oi = __shfl_xor(ri, o);
        if (ov > rv || (ov == rv && oi < ri)) { rv = ov; ri = oi; rs = os; }
      }
      if ((ri >> 5) == g) {
        const int wj = ri & 31;
#pragma unroll
        for (int j = 0; j < 32; ++j) if (j == wj) bz[j] = NEG;
      }
      ssum += rs;
      if (g == k) { myidx = ri; mysc = rs; }
    }
    const int pos = atomicAdd(&counts[myidx * CSTR], 1);
    ((int*)(ws + O_TKIDX))[(size_t)tok * 8 + g] = myidx;
    ((float*)(ws + O_TKW))[(size_t)tok * 8 + g] = mysc / ssum * 2.5f;
    ((int*)(ws + O_TKPOS))[(size_t)tok * 8 + g] = pos;
  }
}
DI void build_tile_start(const Params& p, int* ts) {
  const int tid = threadIdx.x;
  const int* counts = (const int*)(p.ws + O_CTRL);
  __syncthreads();
  if (tid < 256) ts[300 + tid] = (counts[tid * CSTR] + 127) >> 7;
  __syncthreads();
  if (tid == 0) { int s = 0; for (int e = 0; e < 256; ++e) { ts[e] = s; s += ts[300 + e]; } ts[256] = s; }
  __syncthreads();
}
DI void phase10(const Params& p, unsigned char* smem, int bid, int nb) {
  int* ts = (int*)smem;
  build_tile_start(p, ts);
  unsigned char* ws = p.ws;
  const int* tkidx = (const int*)(ws + O_TKIDX); const int* tkpos = (const int*)(ws + O_TKPOS); const float* tkw = (const float*)(ws + O_TKW);
  int* slottok = (int*)(ws + O_SLOTTOK); float* slotw = (float*)(ws + O_SLOTW); int* slotaid = (int*)(ws + O_SLOTAID);
  for (int i = bid * NTHR + threadIdx.x; i < T * 8; i += nb * NTHR) {
    const int e = tkidx[i];
    const int slot = ts[e] * 128 + tkpos[i];
    slottok[slot] = i >> 3; slotw[slot] = tkw[i]; slotaid[slot] = i;
  }
}

DI int find_expert(const int* ts, int ti) { int lo = 0, hi = 255; while (lo < hi) { const int mid = (lo + hi + 1) >> 1; if (ts[mid] <= ti) lo = mid; else hi = mid - 1; } return lo; }

struct MoeUpF {
  const int* ts; unsigned char* ws; const float* wg; const float* wu; int ntile, G, c;
  DI bool next(int i, UnitF& u) const {
    const int L = i * G + (((G & 7) == 0) ? (c & 7) * (G >> 3) + (c >> 3) : c);
    if (L >= ntile * 2) return false;
    const int pn = L / ntile, ti = L - pn * ntile;
    const int e = find_expert(ts, ti);
    u.A = (const bf16_t*)(ws + O_X1B); u.rows = (const int*)(ws + O_SLOTTOK) + ti * 128; u.m0 = ti * 128; u.pn = pn; u.e = e;
    u.W0 = wg + (size_t)e * 262144 + 128 * pn; u.W1 = wu + (size_t)e * 262144 + 128 * pn;
    return true;
  }
};
struct MoeDownF {
  const int* ts; unsigned char* ws; const float* wd; int ntile, G, c;
  DI bool next(int i, UnitF& u) const {
    const int L = i * G + (((G & 7) == 0) ? (c & 7) * (G >> 3) + (c >> 3) : c);
    if (L >= ntile * 4) return false;
    const int pn = L / ntile, ti = L - pn * ntile;
    const int e = find_expert(ts, ti);
    u.A = (const bf16_t*)(ws + O_ACT); u.rows = nullptr; u.m0 = ti * 128; u.pn = pn; u.e = e;
    u.W0 = wd + (size_t)e * 262144 + 256 * pn; u.W1 = u.W0 + 128;
    return true;
  }
};
struct EpiActF {
  bf16_t* actp;
  struct Pre { int dummy; };
  DI void prefetch(const UnitF&, int, int, Pre& p) const { p.dummy = 0; }
  DI void operator()(const f32x4 (&acc)[4][4], const UnitF& u, int wr, int wc, int fr, int fq, const Pre&, unsigned char* xch) const {
    if (wc >= 2) {
#pragma unroll
      for (int m = 0; m < 4; ++m) {
        unsigned char* dst = xch + (64 * wr + 16 * m + fr) * 256 + (((8 * (wc & 1) + 2 * fq) ^ (2 * (fr & 7))) << 4);
        u32x4 o0 = {pk2(acc[m][0][0], acc[m][1][0]), pk2(acc[m][2][0], acc[m][3][0]), pk2(acc[m][0][1], acc[m][1][1]), pk2(acc[m][2][1], acc[m][3][1])};
        u32x4 o1 = {pk2(acc[m][0][2], acc[m][1][2]), pk2(acc[m][2][2], acc[m][3][2]), pk2(acc[m][0][3], acc[m][1][3]), pk2(acc[m][2][3], acc[m][3][3])};
        *(u32x4*)dst = o0; *(u32x4*)(dst + 16) = o1;
      }
    }
    asm volatile("s_waitcnt lgkmcnt(0)" ::: "memory"); __builtin_amdgcn_s_barrier(); asm volatile("" ::: "memory");
    if (wc < 2) {
#pragma unroll
      for (int m = 0; m < 4; ++m) {
        const unsigned char* srcp = xch + (64 * wr + 16 * m + fr) * 256 + (((8 * wc + 2 * fq) ^ (2 * (fr & 7))) << 4);
        const u32x4 u0 = *(const u32x4*)srcp, u1 = *(const u32x4*)(srcp + 16);
        const size_t row = (size_t)u.m0 + 64 * wr + 16 * m + fr;
        u32x4 o0, o1;
#pragma unroll
        for (int r = 0; r < 2; ++r) {
          o0[2 * r] = pk2(siluf_(acc[m][0][r]) * lo2f(u0[2 * r]), siluf_(acc[m][1][r]) * hi2f(u0[2 * r]));
          o0[2 * r + 1] = pk2(siluf_(acc[m][2][r]) * lo2f(u0[2 * r + 1]), siluf_(acc[m][3][r]) * hi2f(u0[2 * r + 1]));
          o1[2 * r] = pk2(siluf_(acc[m][0][2 + r]) * lo2f(u1[2 * r]), siluf_(acc[m][1][2 + r]) * hi2f(u1[2 * r]));
          o1[2 * r + 1] = pk2(siluf_(acc[m][2][2 + r]) * lo2f(u1[2 * r + 1]), siluf_(acc[m][3][2 + r]) * hi2f(u1[2 * r + 1]));
        }
        bf16_t* dst = actp + row * 256 + 128 * u.pn + 64 * wc + 16 * fq;
        *(u32x4*)dst = o0; *(u32x4*)(dst + 8) = o1;
      }
    }
    asm volatile("s_waitcnt lgkmcnt(0)" ::: "memory"); __builtin_amdgcn_s_barrier(); asm volatile("" ::: "memory");
  }
};
struct EpiDownF {
  const int* slotaid; const float* slotw; unsigned char* ybase;
  struct Pre { int aid[4]; float ww[4]; };
  DI void prefetch(const UnitF& u, int wr, int fr, Pre& p) const {
    const unsigned slot0 = (unsigned)u.m0 + 64u * wr + fr;
#pragma unroll
    for (int m = 0; m < 4; ++m) { p.aid[m] = slotaid[slot0 + 16u * m]; p.ww[m] = slotw[slot0 + 16u * m]; }
  }
  DI void operator()(const f32x4 (&acc)[4][4], const UnitF& u, int wr, int wc, int fr, int fq, const Pre& p, unsigned char*) const {
    const unsigned colb = (unsigned)u.pn * 256u + 64u * wc + 16u * fq;
#pragma unroll
    for (int m = 0; m < 4; ++m) {
      if (p.aid[m] >= 0) {
        const unsigned off = (unsigned)p.aid[m] * 1024u + colb;
        const float sw = p.ww[m] * 64.0f;
        u32x4 o;
#pragma unroll
        for (int r = 0; r < 4; ++r) {
          unsigned w_ = 0u;
          w_ = __builtin_amdgcn_cvt_pk_fp8_f32(acc[m][0][r] * sw, acc[m][1][r] * sw, w_, false);
          w_ = __builtin_amdgcn_cvt_pk_fp8_f32(acc[m][2][r] * sw, acc[m][3][r] * sw, w_, true);
          o[r] = w_;
        }
        *(u32x4*)(ybase + (size_t)off) = o;
      }
    }
  }
};
struct EpiAct {
  bf16_t* actp;
  DI void operator()(const f32x4 (&acc)[2][2][4][2], const pg::Unit& u, int wr, int wc, int fr, int fq) const {
#pragma unroll
    for (int ai = 0; ai < 2; ++ai)
#pragma unroll
      for (int m = 0; m < 4; ++m) {
        const size_t row = (size_t)u.pm * 256 + 128 * ai + 64 * wr + 16 * m + fr;
#pragma unroll
        for (int bj = 0; bj < 2; ++bj) {
          const int blk = 8 * u.pn + 4 * bj + wc;
          const f32x4 g = acc[ai][bj][m][0], uu = acc[ai][bj][m][1];
          f32x4 o = {siluf_(g[0]) * uu[0], siluf_(g[1]) * uu[1], siluf_(g[2]) * uu[2], siluf_(g[3]) * uu[3]};
          *(u32x2*)(actp + row * 256 + blk * 16 + 4 * fq) = pack4(o);
        }
      }
  }
};
struct EpiBf16Out {
  bf16_t* dst;
  DI void operator()(const f32x4 (&acc)[2][2][4][2], const pg::Unit& u, int wr, int wc, int fr, int fq) const {
#pragma unroll
    for (int ai = 0; ai < 2; ++ai)
#pragma unroll
      for (int m = 0; m < 4; ++m) {
        const size_t row = (size_t)u.pm * 256 + 128 * ai + 64 * wr + 16 * m + fr;
#pragma unroll
        for (int bj = 0; bj < 2; ++bj)
#pragma unroll
          for (int n = 0; n < 2; ++n) *(u32x2*)(dst + row * 1024 + u.pn * 256 + 128 * bj + 32 * wc + 16 * n + 4 * fq) = pack4(acc[ai][bj][m][n]);
      }
  }
};
DI void phase11(const Params& p, unsigned char* smem, int bid, int nb) {
  unsigned char* ws = p.ws;
  int* ts = (int*)(smem + 131072);
  build_tile_start(p, ts);
  { MoeUpF S{ts, ws, p.in[I_WG], p.in[I_WU], ts[256], nb, bid}; EpiActF E{(bf16_t*)(ws + O_ACT)}; gemmF_phase<false, EpiActF, MoeUpF>(smem, 1024, 1024, 256, S, E); }
  __syncthreads();
  PG_LAS unsigned char* lds = (PG_LAS unsigned char*)smem;
  { pg::DenseOrder S; S.init(ws + O_X1B, ws + O_WSGU, T, 512, 1024, nb, bid); EpiAct E{(bf16_t*)(ws + O_ACTSH)}; pg::gemm_phase<EpiAct, pg::DenseOrder, false, true>(lds, 1024, S, E); }
}
DI void phase12(const Params& p, unsigned char* smem, int bid, int nb) {
  unsigned char* ws = p.ws;
  int* ts = (int*)(smem + 131072);
  build_tile_start(p, ts);
  { MoeDownF S{ts, ws, p.in[I_WDN], ts[256], nb, bid}; EpiDownF E{(const int*)(ws + O_SLOTAID), (const float*)(ws + O_SLOTW), ws + O_Y}; gemmF_phase<false, EpiDownF, MoeDownF>(smem, 256, 256, 1024, S, E); }
  __syncthreads();
  PG_LAS unsigned char* lds = (PG_LAS unsigned char*)smem;
  { pg::DenseOrder S; S.init(ws + O_ACTSH, ws + O_WSD, T, 1024, 256, nb, bid); EpiBf16Out E{(bf16_t*)(ws + O_YSH)}; pg::gemm_phase<EpiBf16Out, pg::DenseOrder, false, true>(lds, 256, S, E); }
}
DI void phase13(const Params& p, int bid, int nb) {
  int tid = threadIdx.x; asm volatile("" : "+v"(tid));
  const int lane = tid & 63, wave = tid >> 6;
  unsigned char* ws = p.ws;
  const float* x1 = (const float*)(ws + O_X1);
  const bf16_t* ysh = (const bf16_t*)(ws + O_YSH);
  const unsigned char* y8 = ws + O_Y;
  for (int row = bid * 8 + wave; row < T; row += nb * 8) {
    float v[16];
#pragma unroll
    for (int i = 0; i < 4; ++i) {
      const int k = 256 * i + 4 * lane;
      const f32x4 t = *(const f32x4*)(x1 + (size_t)row * D + k);
      const u32x2 s = *(const u32x2*)(ysh + (size_t)row * D + k);
      v[4 * i] = ALPHA * t[0] + lo2f(s[0]); v[4 * i + 1] = ALPHA * t[1] + hi2f(s[0]); v[4 * i + 2] = ALPHA * t[2] + lo2f(s[1]); v[4 * i + 3] = ALPHA * t[3] + hi2f(s[1]);
    }
    float rs[16];
#pragma unroll
    for (int i = 0; i < 16; ++i) rs[i] = 0.f;
#pragma unroll
    for (int k8 = 0; k8 < 8; ++k8) {
#pragma unroll
      for (int i = 0; i < 4; ++i) {
        const unsigned s = *(const unsigned*)(y8 + ((size_t)row * 8 + k8) * 1024 + 256 * i + 4 * lane);
        const f32x2_ lo = __builtin_amdgcn_cvt_pk_f32_fp8(s, false), hi = __builtin_amdgcn_cvt_pk_f32_fp8(s, true);
        rs[4 * i] += lo[0]; rs[4 * i + 1] += lo[1]; rs[4 * i + 2] += hi[0]; rs[4 * i + 3] += hi[1];
      }
    }
#pragma unroll
    for (int i = 0; i < 16; ++i) v[i] += rs[i] * (1.0f / 64.0f);
    ln_row(nullptr, p.in[I_LN2G], p.in[I_LN2B], v, lane);
#pragma unroll
    for (int i = 0; i < 4; ++i) { const f32x4 o = {v[4 * i], v[4 * i + 1], v[4 * i + 2], v[4 * i + 3]}; *(f32x4*)(p.out + (size_t)row * D + 256 * i + 4 * lane) = o; }
  }
}

DI void load_params(Params& lp, const unsigned char* smem) {
  const unsigned* t = (const unsigned*)(smem + PTAB_OFF);
#pragma unroll
  for (int i = 0; i < 28; ++i) lp.in[i] = (const float*)(GAS const float*)(((unsigned long long)(unsigned)__builtin_amdgcn_readfirstlane((int)t[2 * i + 1]) << 32) | (unsigned)__builtin_amdgcn_readfirstlane((int)t[2 * i]));
  lp.out = (float*)(GAS float*)(((unsigned long long)(unsigned)__builtin_amdgcn_readfirstlane((int)t[57]) << 32) | (unsigned)__builtin_amdgcn_readfirstlane((int)t[56]));
  lp.ws = (unsigned char*)(GAS unsigned char*)(((unsigned long long)(unsigned)__builtin_amdgcn_readfirstlane((int)t[59]) << 32) | (unsigned)__builtin_amdgcn_readfirstlane((int)t[58]));
}
__global__ void __launch_bounds__(NTHR) mega_kernel(Params pk) {
  extern __shared__ __attribute__((aligned(16))) unsigned char smem[];
  cg::grid_group grid = cg::this_grid();
  const int bid = blockIdx.x, nb = gridDim.x;
  volatile LAS unsigned* bst = (volatile LAS unsigned*)(smem + LDS_BYTES - 16);
  if (threadIdx.x < 4) bst[threadIdx.x] = 0u;
  if (threadIdx.x < 30) {
    const __attribute__((address_space(4))) unsigned long long* ka = (const __attribute__((address_space(4))) unsigned long long*)__builtin_amdgcn_kernarg_segment_ptr();
    ((unsigned long long*)(smem + PTAB_OFF))[threadIdx.x] = ka[threadIdx.x];
  }
  unsigned* barw = (unsigned*)(pk.ws + O_BAR);
  __syncthreads();
  XcdBarrier xb = xcd_barrier_post(barw, bst);
#define GSYNC() xcd_barrier(xb)
#define RUNP(k, call) do { { Params p; load_params(p, smem); call; } GSYNC(); if (DUPMASK & (1 << (k))) { { Params p; load_params(p, smem); call; } GSYNC(); } } while (0)
  { Params p; load_params(p, smem); phase0(p, smem, bid, nb); } grid.sync();
  RUNP(1, phase1(p, smem, bid, nb));
  RUNP(2, phase2(p, smem, bid, nb));
  RUNP(3, phase3(p, smem, bid, nb));
  RUNP(4, phase4(p, bid, nb));
  RUNP(5, phase5(p, smem, bid, nb));
  RUNP(6, phase6(p, smem, bid, nb));
  RUNP(14, phase7(p, bid, nb));
  if (DUPMASK & (1 << 7)) { { Params p; load_params(p, smem); phase6(p, smem, bid, nb); } GSYNC(); { Params p; load_params(p, smem); phase7(p, bid, nb); } GSYNC(); }
  RUNP(8, phase8(p, smem, bid, nb));
  RUNP(14, phase9(p, bid, nb));
  if (DUPMASK & (1 << 9)) { { Params p; load_params(p, smem); if (bid == 0 && threadIdx.x < 256) ((int*)(p.ws + O_CTRL))[threadIdx.x * CSTR] = 0; } GSYNC(); { Params p; load_params(p, smem); phase9(p, bid, nb); } GSYNC(); }
  RUNP(10, phase10(p, smem, bid, nb));
  RUNP(11, phase11(p, smem, bid, nb));
  RUNP(12, phase12(p, smem, bid, nb));
  { Params p; load_params(p, smem); phase13(p, bid, nb); }
  if (DUPMASK & (1 << 13)) { GSYNC(); Params p; load_params(p, smem); phase13(p, bid, nb); }
  if (DUPMASK & (1 << 15)) { for (int i = 0; i < 10; ++i) GSYNC(); }
}

extern "C" void kernel_launch(void* const* d_in, const int* in_sizes, int n_in, void* d_out, int out_size, void* d_ws, size_t ws_size, hipStream_t stream) {
  if (n_in != 28 || ws_size < WS_NEED) { fprintf(stderr, "kernel_launch: unexpected inputs (%d) or workspace (%zu < %zu)\n", n_in, ws_size, (size_t)WS_NEED); return; }
  static int grid_blocks = 0;
  if (!grid_blocks) {
    int dev = 0, cus = 0, per_cu = 0;
    (void)hipGetDevice(&dev);
    (void)hipDeviceGetAttribute(&cus, hipDeviceAttributeMultiprocessorCount, dev);
    (void)hipFuncSetAttribute((const void*)mega_kernel, hipFuncAttributeMaxDynamicSharedMemorySize, LDS_BYTES);
    (void)hipOccupancyMaxActiveBlocksPerMultiprocessor(&per_cu, (const void*)mega_kernel, NTHR, LDS_BYTES);
    if (per_cu < 1) per_cu = 1;
    if (per_cu > 1) per_cu = 1;
    grid_blocks = cus * per_cu;
    if (grid_blocks < 32) grid_blocks = 32;
  }
  Params p{};
  for (int i = 0; i < 28; ++i) p.in[i] = (const float*)d_in[i];
  p.out = (float*)d_out; p.ws = (unsigned char*)d_ws;
  (void)hipMemsetAsync((unsigned char*)d_ws + O_BAR, 0, 16384 + 256, stream);
  void* args[] = {&p};
  hipError_t e = hipLaunchCooperativeKernel((const void*)mega_kernel, dim3(grid_blocks), dim3(NTHR), args, LDS_BYTES, stream);
  if (e != hipSuccess) fprintf(stderr, "cooperative launch failed: %s (grid %d)\n", hipGetErrorString(e), grid_blocks);
}
```

```cpp
#include <hip/hip_runtime.h>
#include <hip/hip_cooperative_groups.h>
#include <stdint.h>
#include <stdio.h>
namespace cg = cooperative_groups;

#define DI __device__ __forceinline__
#define LAS __attribute__((address_space(3)))
#define GAS __attribute__((address_space(1)))
typedef unsigned short bf16_t;
typedef short bf16x8 __attribute__((ext_vector_type(8)));
typedef float f32x4 __attribute__((ext_vector_type(4)));
typedef unsigned u32x4 __attribute__((ext_vector_type(4)));
typedef unsigned u32x2 __attribute__((ext_vector_type(2)));

#ifndef DUPMASK
#define DUPMASK 0
#endif
constexpr int NTHR = 512;
constexpr int T = 16384, SEQ = 8192, D = 1024;
constexpr int NPROJ = 6656;
constexpr int DIN = 6664;
constexpr int NEXP = 256, DEXP = 256;
constexpr int MAXSLOT = 131072 + 256 * 128;
constexpr float ALPHA = 1.189207115002721f;
constexpr int LDS_BYTES = 157696;

constexpr size_t MB = 1u << 20;
constexpr size_t O_WGU = 0;
constexpr size_t O_WD = 256 * MB;
constexpr size_t O_WSGU = 384 * MB;
constexpr size_t O_WSD = 385 * MB;
constexpr size_t O_ROUT = 385 * MB + 512 * 1024;
constexpr size_t O_CTRL = 386 * MB;
constexpr size_t O_BAR = 386 * MB + 128 * 1024;
constexpr int CSTR = 64;
constexpr size_t O_SUBBAR = 386 * MB + 128 * 1024 + 16384;
constexpr size_t O_IDENT = 386 * MB + 256 * 1024;
constexpr size_t O_X1 = 387 * MB;
constexpr size_t O_X1B = 451 * MB;
constexpr size_t R0 = 483 * MB;
constexpr size_t O_XB = R0 + 0;
constexpr size_t O_ST = R0 + 0;
constexpr size_t O_WINT = R0 + 32 * MB;
constexpr size_t O_WAT = R0 + 45 * MB;
constexpr size_t O_WBT = R0 + 46 * MB;
constexpr size_t O_WCT = R0 + 47 * MB;
constexpr size_t O_WOT = R0 + 48 * MB;
constexpr size_t O_WMKV = R0 + 50 * MB;
constexpr size_t O_MEMB = R0 + 52 * MB;
constexpr size_t O_SGUW = R0 + 53 * MB;
constexpr size_t O_AB = R0 + 53 * MB + 512 * 1024;
constexpr size_t O_MEMK = R0 + 54 * MB;
constexpr size_t O_MEMVT = R0 + 54 * MB + 512 * 1024;
constexpr size_t O_QKV = R0 + 55 * MB;
constexpr size_t O_PART = R0 + 55 * MB;
constexpr size_t O_ZS = R0 + 103 * MB;
constexpr size_t O_UVG = R0 + 119 * MB;
constexpr size_t O_MERGED = R0 + 119 * MB;
constexpr size_t O_XQ = R0 + 151 * MB;
constexpr size_t O_GATES = R0 + 167 * MB;
constexpr size_t O_MP = R0 + 263 * MB;
constexpr size_t O_BC = R0 + 295 * MB;
constexpr size_t O_O0 = R0 + 359 * MB;
constexpr size_t O_QP = R0 + 391 * MB;
constexpr size_t O_GL = R0 + 407 * MB;
constexpr size_t O_GDNO = R0 + 408 * MB;
constexpr size_t O_SGUO = R0 + 424 * MB;
constexpr size_t O_XATO = R0 + 440 * MB;
constexpr size_t O_LOGITS = R0 + 0;
constexpr size_t O_TKIDX = R0 + 16 * MB;
constexpr size_t O_TKW = R0 + 16 * MB + 512 * 1024;
constexpr size_t O_TKPOS = R0 + 17 * MB;
constexpr size_t O_SLOTTOK = R0 + 18 * MB;
constexpr size_t O_SLOTW = R0 + 19 * MB;
constexpr size_t O_SLOTAID = R0 + 20 * MB;
constexpr size_t O_ACT = R0 + 21 * MB;
constexpr size_t O_ACTSH = R0 + 181 * MB;
constexpr size_t O_YSH = R0 + 189 * MB;
constexpr size_t O_Y = R0 + 221 * MB;
constexpr size_t WS_NEED = R0 + 477 * MB;

struct Params {
  const float* in[28];
  float* out;
  unsigned char* ws;
};
enum { I_X = 0, I_MEM, I_WIN, I_CONVW, I_ALOG, I_DTB, I_GNG, I_WA, I_SLNG, I_SLNB, I_SGUW, I_SGUB, I_WB, I_WMKV, I_WC, I_WO,
       I_LN1G, I_LN1B, I_RW, I_RB, I_WG, I_WU, I_WDN, I_WSG, I_WSU, I_WSD, I_LN2G, I_LN2B };

constexpr int PTAB_OFF = 156672;
DI float bf2f(bf16_t h) { return __uint_as_float(((unsigned)h) << 16); }
DI bf16_t f2bf(float f) { unsigned u = __float_as_uint(f); u += 0x7fffu + ((u >> 16) & 1u); return (bf16_t)(u >> 16); }
typedef float f32x2_ __attribute__((ext_vector_type(2)));
typedef __bf16 bf16x2_ __attribute__((ext_vector_type(2)));
DI unsigned pk2(float lo, float hi) { f32x2_ v = {lo, hi}; return __builtin_bit_cast(unsigned, __builtin_convertvector(v, bf16x2_)); }
DI float lo2f(unsigned u) { return __uint_as_float(u << 16); }
DI float hi2f(unsigned u) { return __uint_as_float(u & 0xffff0000u); }
DI float sigmoidf_(float x) { return 1.f / (1.f + __expf(-x)); }
DI float siluf_(float x) { return x / (1.f + __expf(-x)); }
DI float geluf_(float x) { float u = 0.7978845608028654f * (x + 0.044715f * x * x * x); float t = 1.f - 2.f / (__expf(2.f * u) + 1.f); return 0.5f * x * (1.f + t); }
DI float softplusf_(float x) { return fmaxf(x, 0.f) + log1pf(__expf(-fabsf(x))); }
DI float wave_sum(float v) {
#pragma unroll
  for (int o = 32; o; o >>= 1) v += __shfl_xor(v, o);
  return v;
}
DI f32x4 mfma16(bf16x8 a, bf16x8 b, f32x4 c) { return __builtin_amdgcn_mfma_f32_16x16x32_bf16(a, b, c, 0, 0, 0); }
DI bf16x8 ldfrag(const void* p) { return __builtin_bit_cast(bf16x8, *(const u32x4*)p); }
DI bf16x8 pack8(f32x4 a, f32x4 b) { u32x4 r = {pk2(a[0], a[1]), pk2(a[2], a[3]), pk2(b[0], b[1]), pk2(b[2], b[3])}; return __builtin_bit_cast(bf16x8, r); }
DI u32x2 pack4(f32x4 a) { u32x2 r = {pk2(a[0], a[1]), pk2(a[2], a[3])}; return r; }
DI int sw128(int row, int chunk) { return row * 128 + ((chunk ^ (row & 7)) << 4); }
DI int sw256(int row, int chunk) { return row * 256 + ((chunk ^ (row & 15)) << 4); }

namespace pg {
#define PG_LAS __attribute__((address_space(3)))
constexpr int BM = 256, BK = 64, HALF = 128, HTB = HALF * BK * 2, NXCD = 8, WGM = 8;
DI int lds_byte(int r, int c) { const int st = (r >> 4) * 2 + (c >> 5), rr = r & 15, cc = c & 31, ob = rr * 64 + cc * 2; return st * 1024 + (ob ^ (((ob >> 9) & 1) << 5)); }
DI void stage_rc(int b, int& R, int& C) { const int st = b / 1024, sb = b % 1024, swz = sb ^ (((sb >> 9) & 1) << 5); R = (st >> 1) * 16 + swz / 64; C = (st & 1) * 32 + (swz % 64) / 2; }

struct Unit { const char* a; const char* b; const int* rows; int pm, pn, e; };

struct DenseOrder {
  const char* A; const char* B; int nM, nN, nwg, G, c; size_t tstep;
  DI void init(const void* A_, const void* B_, int M, int N, int K, int G_, int c_) { A = (const char*)A_; B = (const char*)B_; nM = M / BM; nN = N / BM; nwg = nM * nN; G = G_; c = c_; tstep = (size_t)BM * K * 2; }
  DI bool next(int i, Unit& u) const {
    const long L = (long)i * G + c; if (L >= nwg) return false;
    int wgid = (int)L; { const int q = nwg / NXCD, r = nwg % NXCD, xcd = wgid % NXCD, off = wgid / NXCD; wgid = (xcd < r ? xcd * (q + 1) : r * (q + 1) + (xcd - r) * q) + off; }
    const int nig = WGM * nN, gid = wgid / nig, fm = gid * WGM, gsz = (nM - fm) < WGM ? (nM - fm) : WGM;
    u.pm = fm + ((wgid % nig) % gsz); u.pn = (wgid % nig) / gsz; u.e = 0; u.rows = nullptr;
    u.a = A + (size_t)u.pm * tstep; u.b = B + (size_t)u.pn * tstep; return true;
  }
};

template <class Epi, class Sched, bool GATHER, bool ALIGN_EPI>
DI void gemm_phase(PG_LAS unsigned char* lds, const int K, const Sched& S, const Epi& E) {
  int tid = threadIdx.x; asm volatile("" : "+v"(tid));
  const int wid = __builtin_amdgcn_readfirstlane(tid >> 6), lane = tid & 63, wr = wid >> 2, wc = wid & 3, fr = lane & 15, fq = lane >> 4;
  const int nt = K / BK;
  int Rr[2], Cc[2];
  unsigned voffB[2];
#pragma unroll
  for (int i = 0; i < 2; ++i) { stage_rc(tid * 16 + i * 8192, Rr[i], Cc[i]); voffB[i] = (unsigned)(Rr[i] * K + Cc[i]) * 2u; }
  const size_t kstep = (size_t)(BK * 2);
  const size_t hstep = (size_t)HALF * K * 2;
  const unsigned ldsw = (unsigned)wid * 1024u;
  const int aoff = lds_byte(wr * 64 + fr, fq * 8), boff = lds_byte(wc * 32 + fr, fq * 8);
#define PG_SA(b, h) (((b) * 2 + (h)) * HTB)
#define PG_SB(b, h) ((4 + (b) * 2 + (h)) * HTB)
#define PG_STAGE(bufoff, gbase, v0, v1) do { \
    __builtin_amdgcn_global_load_lds((const unsigned*)((const char*)(gbase) + (v0)), (PG_LAS unsigned*)(lds + (bufoff) + ldsw), 16, 0, 0); \
    __builtin_amdgcn_global_load_lds((const unsigned*)((const char*)(gbase) + (v1)), (PG_LAS unsigned*)(lds + (bufoff) + ldsw + 8192), 16, 0, 0); } while (0)
#define PG_LDA(dst, b, h) do { _Pragma("unroll") for (int m = 0; m < 4; ++m) _Pragma("unroll") for (int k = 0; k < 2; ++k) dst[m][k] = *(const PG_LAS bf16x8*)(lds + PG_SA(b, h) + aoff + m * 2048 + k * 1024); } while (0)
#define PG_LDB(dst, b, h) do { _Pragma("unroll") for (int n = 0; n < 2; ++n) _Pragma("unroll") for (int k = 0; k < 2; ++k) dst[n][k] = *(const PG_LAS bf16x8*)(lds + PG_SB(b, h) + boff + n * 2048 + k * 1024); } while (0)
#define PG_MMA(ai, bj, At, Bt) do { __builtin_amdgcn_s_setprio(1); _Pragma("unroll") for (int m = 0; m < 4; ++m) _Pragma("unroll") for (int n = 0; n < 2; ++n) _Pragma("unroll") for (int k = 0; k < 2; ++k) \
    acc[ai][bj][m][n] = __builtin_amdgcn_mfma_f32_16x16x32_bf16(Bt[n][k], At[m][k], acc[ai][bj][m][n], 0, 0, 0); __builtin_amdgcn_s_setprio(0); } while (0)
#define PG_WAIT_V(n) asm volatile("s_waitcnt vmcnt(" #n ")" ::: "memory")
#define PG_WAIT_L(n) asm volatile("s_waitcnt lgkmcnt(" #n ")" ::: "memory")
#define PG_BAR __builtin_amdgcn_s_barrier()
#define PG_SCHED __builtin_amdgcn_sched_barrier(0)
#define PG_AOFFS(u, o00, o01, o10, o11) do { if (GATHER) { \
      o00 = (unsigned)(u).rows[Rr[0]] * (unsigned)(K * 2) + (unsigned)Cc[0] * 2u; o01 = (unsigned)(u).rows[Rr[1]] * (unsigned)(K * 2) + (unsigned)Cc[1] * 2u; \
      o10 = (unsigned)(u).rows[128 + Rr[0]] * (unsigned)(K * 2) + (unsigned)Cc[0] * 2u; o11 = (unsigned)(u).rows[128 + Rr[1]] * (unsigned)(K * 2) + (unsigned)Cc[1] * 2u; \
    } else { o00 = voffB[0]; o01 = voffB[1]; o10 = voffB[0] + (unsigned)hstep; o11 = voffB[1] + (unsigned)hstep; } } while (0)
  Unit cur, nxt; int ui = 0;
  if (!S.next(0, cur)) return;
  f32x4 acc[2][2][4][2];
#pragma unroll
  for (int a = 0; a < 2; ++a)
#pragma unroll
    for (int b = 0; b < 2; ++b)
#pragma unroll
      for (int m = 0; m < 4; ++m)
#pragma unroll
        for (int n = 0; n < 2; ++n) acc[a][b][m][n] = (f32x4){0.f, 0.f, 0.f, 0.f};
  bf16x8 At[4][2], B0[2][2], B1[2][2];
  const char* cA = cur.a; const char* cB = cur.b;
  unsigned c00, c01, c10, c11;
  PG_AOFFS(cur, c00, c01, c10, c11);
  const unsigned vb0 = voffB[0], vb1 = voffB[1];
  PG_STAGE(PG_SB(0, 0), cB, vb0, vb1); PG_STAGE(PG_SB(0, 1), cB + hstep, vb0, vb1); PG_STAGE(PG_SA(0, 0), cA, c00, c01); PG_STAGE(PG_SA(0, 1), cA, c10, c11);
  if (wr == 1) PG_BAR;
  PG_WAIT_V(2); PG_BAR;
  PG_STAGE(PG_SB(1, 0), cB + kstep, vb0, vb1); PG_STAGE(PG_SA(1, 0), cA + kstep, c00, c01); PG_STAGE(PG_SB(1, 1), cB + hstep + kstep, vb0, vb1);
  PG_WAIT_V(6); PG_BAR;
  for (;;) {
    const bool has_next = S.next(ui + 1, nxt);
    const char* nA = has_next ? nxt.a : cA; const char* nB = has_next ? nxt.b : cB;
    unsigned n00 = c00, n01 = c01, n10 = c10, n11 = c11;
    if (has_next) PG_AOFFS(nxt, n00, n01, n10, n11);
#pragma unroll 1
    for (int t = 0; t < nt; t += 2) {
      const bool last = (t == nt - 2);
      const char* a1 = cA + (size_t)(t + 1) * kstep;
      const char* a2 = last ? nA : cA + (size_t)(t + 2) * kstep; const char* b2 = last ? nB : cB + (size_t)(t + 2) * kstep;
      const char* a3 = a2 + kstep; const char* b3 = b2 + kstep;
      const unsigned o00 = last ? n00 : c00, o01 = last ? n01 : c01, o10 = last ? n10 : c10, o11 = last ? n11 : c11;
      PG_LDB(B0, 0, 0); PG_LDB(B1, 0, 1); PG_SCHED; PG_LDA(At, 0, 0); PG_STAGE(PG_SA(1, 1), a1, c10, c11);
      PG_WAIT_V(8); PG_WAIT_L(0); PG_BAR; PG_MMA(0, 0, At, B0); PG_MMA(0, 1, At, B1); PG_BAR; PG_SCHED;
      PG_LDA(At, 0, 1); PG_STAGE(PG_SB(0, 0), b2, vb0, vb1); PG_STAGE(PG_SB(0, 1), b2 + hstep, vb0, vb1); PG_STAGE(PG_SA(0, 0), a2, o00, o01);
      PG_WAIT_V(8); PG_WAIT_L(0); PG_BAR; PG_MMA(1, 0, At, B0); PG_MMA(1, 1, At, B1); PG_BAR; PG_SCHED;
      PG_LDB(B0, 1, 0); PG_LDB(B1, 1, 1); PG_SCHED; PG_LDA(At, 1, 0); PG_STAGE(PG_SA(0, 1), a2, o10, o11);
      PG_WAIT_V(8); PG_WAIT_L(0); PG_BAR; PG_MMA(0, 0, At, B0); PG_MMA(0, 1, At, B1); PG_BAR; PG_SCHED;
      PG_LDA(At, 1, 1); PG_STAGE(PG_SB(1, 0), b3, vb0, vb1); PG_STAGE(PG_SB(1, 1), b3 + hstep, vb0, vb1); PG_STAGE(PG_SA(1, 0), a3, o00, o01);
      PG_WAIT_V(8); PG_WAIT_L(0); PG_BAR; PG_MMA(1, 0, At, B0); PG_MMA(1, 1, At, B1); PG_BAR; PG_SCHED;
    }
    if constexpr (ALIGN_EPI) { if (wr == 0) PG_BAR; }
    E(acc, cur, wr, wc, fr, fq);
    if (!has_next) break;
#pragma unroll
    for (int a = 0; a < 2; ++a)
#pragma unroll
      for (int b = 0; b < 2; ++b)
#pragma unroll
        for (int m = 0; m < 4; ++m)
#pragma unroll
          for (int n = 0; n < 2; ++n) acc[a][b][m][n] = (f32x4){0.f, 0.f, 0.f, 0.f};
    cur = nxt; cA = nA; cB = nB; c00 = n00; c01 = n01; c10 = n10; c11 = n11; ++ui;
    if constexpr (ALIGN_EPI) { if (wr == 1) PG_BAR; }
  }
  PG_WAIT_V(0);
  if constexpr (!ALIGN_EPI) { if (wr == 0) PG_BAR; }
  PG_BAR;
#undef PG_SA
#undef PG_SB
#undef PG_STAGE
#undef PG_LDA
#undef PG_LDB
#undef PG_MMA
#undef PG_WAIT_V
#undef PG_WAIT_L
#undef PG_BAR
#undef PG_SCHED
#undef PG_AOFFS
}
}


struct UnitF { const bf16_t* A; const int* rows; const float* W0; const float* W1; int m0, pn, e; };

template <bool AMUL, class Epi, class Sched, int ABL = 0>
DI void gemmF_phase(unsigned char* smem_, const int K, const int lda, const int ldw, const Sched& S, const Epi& E) {
  int tid = threadIdx.x; asm volatile("" : "+v"(tid));
  unsigned char* smem; { LAS unsigned char* l_ = (LAS unsigned char*)smem_; asm volatile("" : "+v"(l_)); smem = (unsigned char*)l_; }
  const int lane = tid & 63, wid = tid >> 6, wr = wid >> 2, wc = wid & 3, fr = lane & 15, fq = lane >> 4;
  const int nk = K >> 6;
  const int ar0 = tid >> 3, ac = tid & 7;
  const int q = tid & 63, half = q >> 5, g0 = 4 * (q & 31);
  int vrow[4];
#pragma unroll
  for (int i = 0; i < 4; ++i) vrow[i] = 64 * (q >> 4) + 16 * i + (q & 15);
  const int aw0 = sw128(ar0, ac), aw1 = sw128(ar0 + 64, ac);
#define F_ROWS(u, rr0, rr1) do { rr0 = (u).rows ? (size_t)(u).rows[ar0] : (size_t)((u).m0 + ar0); rr1 = (u).rows ? (size_t)(u).rows[ar0 + 64] : (size_t)((u).m0 + ar0 + 64); } while (0)
#define F_LOAD(A_, W0_, W1_, rr0_, rr1_, kk_, va0, va1, vb0, vb1, vw) do { \
    va0 = *(const u32x4*)((A_) + (rr0_) * lda + (kk_) * 64 + ac * 8); va1 = *(const u32x4*)((A_) + (rr1_) * lda + (kk_) * 64 + ac * 8); \
    if (AMUL) { vb0 = *(const u32x4*)((A_) + (rr0_) * lda + 256 + (kk_) * 64 + ac * 8); vb1 = *(const u32x4*)((A_) + (rr1_) * lda + 256 + (kk_) * 64 + ac * 8); } \
    const float* wp_ = (half ? (W1_) : (W0_)) + (size_t)((kk_) * 64 + 8 * wid) * ldw + g0; \
    if (ABL != 1) { _Pragma("unroll") for (int j = 0; j < 8; ++j) vw[j] = *(const f32x4*)(wp_ + (size_t)j * ldw); } } while (0)
#define F_LOADX(kx, va0, va1, vb0, vb1, vw) do { const bool nx_ = (kx) >= nk; const int kk2_ = nx_ ? (kx) - nk : (kx); \
    const bf16_t* A2_ = nx_ ? nxt.A : cur.A; const float* W02_ = nx_ ? nxt.W0 : cur.W0; const float* W12_ = nx_ ? nxt.W1 : cur.W1; \
    const size_t q0_ = nx_ ? nr0 : r0, q1_ = nx_ ? nr1 : r1; \
    F_LOAD(A2_, W02_, W12_, q0_, q1_, kk2_, va0, va1, vb0, vb1, vw); } while (0)
#define F_STORE(st, va0, va1, vb0, vb1, vw) do { unsigned char* sa_ = smem + (st) * 49152; \
    if (AMUL) { _Pragma("unroll") for (int e_ = 0; e_ < 4; ++e_) { va0[e_] = pk2(lo2f(va0[e_]) * lo2f(vb0[e_]), hi2f(va0[e_]) * hi2f(vb0[e_])); va1[e_] = pk2(lo2f(va1[e_]) * lo2f(vb1[e_]), hi2f(va1[e_]) * hi2f(vb1[e_])); } } \
    *(u32x4*)(sa_ + aw0) = va0; *(u32x4*)(sa_ + aw1) = va1; \
    if (ABL != 3) { _Pragma("unroll") for (int i = 0; i < 4; ++i) { \
      u32x4 o_ = {pk2(vw[0][i], vw[1][i]), pk2(vw[2][i], vw[3][i]), pk2(vw[4][i], vw[5][i]), pk2(vw[6][i], vw[7][i])}; \
      *(u32x4*)(sa_ + 16384 + sw128(vrow[i], wid)) = o_; } } else { _Pragma("unroll") for (int j = 0; j < 8; ++j) asm volatile("" :: "v"(vw[j])); } } while (0)
#define F_LBAR() do { asm volatile("s_waitcnt lgkmcnt(0)" ::: "memory"); __builtin_amdgcn_s_barrier(); asm volatile("" ::: "memory"); } while (0)
#define F_COMPUTE(st) do { const unsigned char* sA = smem + (st) * 49152; const unsigned char* sB = sA + 16384; \
    _Pragma("unroll") for (int ks = 0; ks < 2; ++ks) { bf16x8 af[4], bfr[4]; \
      _Pragma("unroll") for (int m = 0; m < 4; ++m) af[m] = ldfrag(sA + sw128(64 * wr + 16 * m + fr, 4 * ks + fq)); \
      _Pragma("unroll") for (int n = 0; n < 4; ++n) bfr[n] = ldfrag(sB + sw128(64 * wc + 16 * n + fr, 4 * ks + fq)); \
      if (ABL != 2) { _Pragma("unroll") for (int m = 0; m < 4; ++m) _Pragma("unroll") for (int n = 0; n < 4; ++n) acc[m][n] = mfma16(bfr[n], af[m], acc[m][n]); } \
      else { _Pragma("unroll") for (int m = 0; m < 4; ++m) _Pragma("unroll") for (int n = 0; n < 4; ++n) asm volatile("" :: "v"(af[m]), "v"(bfr[n])); } } } while (0)
  UnitF cur, nxt; int ui = 0;
  if (!S.next(0, cur)) return;
  size_t r0, r1, nr0, nr1;
  F_ROWS(cur, r0, r1);
  bool has_next = S.next(1, nxt);
  if (has_next) F_ROWS(nxt, nr0, nr1); else { nxt = cur; nr0 = r0; nr1 = r1; }
  f32x4 acc[4][4];
#pragma unroll
  for (int m = 0; m < 4; ++m)
#pragma unroll
    for (int n = 0; n < 4; ++n) acc[m][n] = (f32x4){0.f, 0.f, 0.f, 0.f};
  u32x4 xa0, xa1, ya0, ya1, xb0, xb1, yb0, yb1; f32x4 xw[8], yw[8];
  xb0 = xb1 = yb0 = yb1 = (u32x4){0u, 0u, 0u, 0u};
  if (ABL == 1) { _Pragma("unroll") for (int j = 0; j < 8; ++j) { xw[j] = (f32x4){0.f, 0.f, 0.f, 0.f}; yw[j] = xw[j]; } }
  F_LOAD(cur.A, cur.W0, cur.W1, r0, r1, 0, xa0, xa1, xb0, xb1, xw);
  F_LOAD(cur.A, cur.W0, cur.W1, r0, r1, 1, ya0, ya1, yb0, yb1, yw);
  __syncthreads();
  F_STORE(0, xa0, xa1, xb0, xb1, xw);
  F_LBAR();
  int st = 0;
  for (;;) {
    typename Epi::Pre pre; E.prefetch(cur, wr, fr, pre);
#pragma unroll 1
    for (int kt = 0; kt < nk; kt += 2) {
      F_LOADX(kt + 2, xa0, xa1, xb0, xb1, xw);
      F_COMPUTE(st);
      F_STORE(st ^ 1, ya0, ya1, yb0, yb1, yw);
      F_LBAR();
      F_LOADX(kt + 3, ya0, ya1, yb0, yb1, yw);
      F_COMPUTE(st ^ 1);
      F_STORE(st, xa0, xa1, xb0, xb1, xw);
      F_LBAR();
    }
    if (ABL != 4) E(acc, cur, wr, wc, fr, fq, pre, smem + (st ^ 1) * 49152); else { _Pragma("unroll") for (int m = 0; m < 4; ++m) _Pragma("unroll") for (int n = 0; n < 4; ++n) asm volatile("" :: "v"(acc[m][n])); }
#pragma unroll
    for (int m = 0; m < 4; ++m)
#pragma unroll
      for (int n = 0; n < 4; ++n) acc[m][n] = (f32x4){0.f, 0.f, 0.f, 0.f};
    if (!has_next) break;
    cur = nxt; r0 = nr0; r1 = nr1; ++ui;
    has_next = S.next(ui + 1, nxt);
    if (has_next) F_ROWS(nxt, nr0, nr1); else { nxt = cur; nr0 = r0; nr1 = r1; }
  }
  asm volatile("s_waitcnt vmcnt(0)" ::: "memory");
  __syncthreads();
#undef F_ROWS
#undef F_LOAD
#undef F_LOADX
#undef F_STORE
#undef F_LBAR
#undef F_COMPUTE
}

#define XB_TMO      128
#define XB_XCNT(j)  (256  + 64 * (j))
#define XB_XSUB(j)  (1280 + 64 * (j))
#define XB_XGEN(j)  (2304 + 64 * (j))
#define XB_TOP      3328
#define XB_TOPGEN   3392
#define XCD_BAR_WORDS 3456
#define XB_SPIN_CAP (1u << 22)
DI unsigned xb_ld(unsigned* p)              { return __hip_atomic_load(p, __ATOMIC_RELAXED, __HIP_MEMORY_SCOPE_AGENT); }
DI unsigned xb_add(unsigned* p, unsigned v) { return __hip_atomic_fetch_add(p, v, __ATOMIC_RELAXED, __HIP_MEMORY_SCOPE_AGENT); }
DI unsigned xb_xcc_id() { return (unsigned)__builtin_amdgcn_s_getreg((3 << 11) | 20) & 0xFu; }
#define XB_SPIN(cond, bar) do { unsigned _sp = 0; while (cond) { __builtin_amdgcn_s_sleep(1); \
    if ((++_sp & 255u) == 0u) { if (xb_ld(&(bar)[XB_TMO])) break; if (_sp > XB_SPIN_CAP) { atomicAdd(&(bar)[XB_TMO], 1u); break; } } } } while (0)
struct XcdBarrier { unsigned* bar; unsigned x; volatile LAS unsigned* st; };
DI XcdBarrier xcd_barrier_post(unsigned* bar, volatile LAS unsigned* st) {
  XcdBarrier b; b.bar = bar; b.x = xb_xcc_id(); b.st = st;
  if (threadIdx.x == 0) (void)xb_add(&bar[XB_XCNT(b.x)], 1u);
  return b;
}
DI void xcd_barrier_complete(unsigned* bar, unsigned x, unsigned& nloc, unsigned& nx) {
  const unsigned G = gridDim.x * gridDim.y * gridDim.z;
  unsigned sum, cnt, mine, sp = 0u;
  for (;;) {
    sum = 0u; cnt = 0u; mine = 0u;
#pragma unroll
    for (unsigned j = 0; j < 16; ++j) { const unsigned c = xb_ld(&bar[XB_XCNT(j)]); sum += c; cnt += (c > 0u) ? 1u : 0u; mine = (j == x) ? c : mine; }
    if (sum == G) break;
    __builtin_amdgcn_s_sleep(1);
    if ((++sp & 255u) == 0u) { if (xb_ld(&bar[XB_TMO])) break; if (sp > XB_SPIN_CAP) { atomicAdd(&bar[XB_TMO], 1u); break; } }
  }
  nloc = mine > 0u ? mine : 1u; nx = cnt > 0u ? cnt : 1u;
}
DI void xcd_barrier(const XcdBarrier& b) {
  asm volatile("s_waitcnt vmcnt(0)" ::: "memory");
  __syncthreads();
  if (threadIdx.x == 0) {
    unsigned* bar = b.bar;
    __builtin_amdgcn_s_waitcnt(0);
    unsigned nloc = b.st[0], nx = b.st[1];
    if (nloc == 0u) { xcd_barrier_complete(bar, b.x, nloc, nx); b.st[0] = nloc; b.st[1] = nx; }
    const unsigned old = xb_add(&bar[XB_XSUB(b.x)], 1u);
    const unsigned gen = old / nloc;
    if (old + 1u == (gen + 1u) * nloc) {
      __builtin_amdgcn_fence(__ATOMIC_RELEASE, "agent");
      asm volatile("s_waitcnt vmcnt(0)" ::: "memory");
      const unsigned og = xb_add(&bar[XB_TOP], 1u);
      const unsigned tg = og / nx;
      if (og + 1u == (tg + 1u) * nx) xb_add(&bar[XB_TOPGEN], 1u);
      else XB_SPIN(xb_ld(&bar[XB_TOPGEN]) == tg, bar);
      __builtin_amdgcn_fence(__ATOMIC_ACQUIRE, "agent");
      xb_add(&bar[XB_XGEN(b.x)], 1u);
      asm volatile("s_waitcnt vmcnt(0)" ::: "memory");
    } else {
      XB_SPIN(xb_ld(&bar[XB_XGEN(b.x)]) == gen, bar);
      __builtin_amdgcn_fence(__ATOMIC_ACQUIRE, "agent");
      asm volatile("s_waitcnt vmcnt(0)" ::: "memory");
    }
  }
  __syncthreads();
}

DI void phase0(const Params& p, unsigned char* smem, int bid, int nb) {
  int tid = threadIdx.x; asm volatile("" : "+v"(tid));
  const int lane = tid & 63, wave = tid >> 6;
  unsigned char* ws = p.ws;
  if (bid == 0 && tid < 256) ((int*)(ws + O_CTRL))[tid * CSTR] = 0;
  for (int i = bid * NTHR + tid; i < T; i += nb * NTHR) ((int*)(ws + O_IDENT))[i] = i;
  {
    float* wabT = (float*)smem;
    const float* win = p.in[I_WIN];
    for (int i = tid; i < 8192; i += NTHR) { const int k = i >> 3, j = i & 7; wabT[j * 1024 + k] = win[(size_t)k * DIN + 2048 + j]; }
    __syncthreads();
    const float* x = p.in[I_X];
    bf16_t* xb = (bf16_t*)(ws + O_XB);
    float* ab = (float*)(ws + O_AB);
    for (int row = bid * 8 + wave; row < T; row += nb * 8) {
      float s[8];
#pragma unroll
      for (int j = 0; j < 8; ++j) s[j] = 0.f;
#pragma unroll
      for (int i = 0; i < 4; ++i) {
        const int k = 256 * i + 4 * lane;
        const f32x4 v = *(const f32x4*)(x + (size_t)row * D + k);
        *(u32x2*)(xb + (size_t)row * D + k) = pack4(v);
#pragma unroll
        for (int j = 0; j < 8; ++j) { const f32x4 w = *(const f32x4*)(wabT + j * 1024 + k); s[j] += v[0] * w[0] + v[1] * w[1] + v[2] * w[2] + v[3] * w[3]; }
      }
#pragma unroll
      for (int j = 0; j < 8; ++j) s[j] = wave_sum(s[j]);
      if (lane == 0) { *(f32x4*)(ab + (size_t)row * 8) = (f32x4){s[0], s[1], s[2], s[3]}; *(f32x4*)(ab + (size_t)row * 8 + 4) = (f32x4){s[4], s[5], s[6], s[7]}; }
    }
    const float* mem = p.in[I_MEM];
    bf16_t* memb = (bf16_t*)(ws + O_MEMB);
    for (int row = bid * 8 + wave; row < 512; row += nb * 8) {
#pragma unroll
      for (int i = 0; i < 4; ++i) { const int k = 256 * i + 4 * lane; *(u32x2*)(memb + (size_t)row * D + k) = pack4(*(const f32x4*)(mem + (size_t)row * D + k)); }
    }
    const float* sw = p.in[I_SGUW];
    bf16_t* sguw = (bf16_t*)(ws + O_SGUW);
    for (int i = bid * NTHR + tid; i < 16384; i += nb * NTHR) {
      const int e0 = i * 4; const int col = e0 & 127, rowi = (e0 >> 7) & 127;
      f32x4 v = *(const f32x4*)(sw + e0);
#pragma unroll
      for (int c = 0; c < 4; ++c) if (col + c > rowi) v[c] = 0.f;
      *(u32x2*)(sguw + e0) = pack4(v);
    }
    __syncthreads();
  }
  {
    float* tile = (float*)smem;
    const float *pwin = p.in[I_WIN], *pwa = p.in[I_WA], *pwb = p.in[I_WB], *pwc = p.in[I_WC], *pwo = p.in[I_WO], *pwmkv = p.in[I_WMKV], *prw = p.in[I_RW],
                *pwsg = p.in[I_WSG], *pwsu = p.in[I_WSU], *pwsd = p.in[I_WSD], *pwg = p.in[I_WG], *pwu = p.in[I_WU], *pwdn = p.in[I_WDN];
    { GAS const float *a_ = (GAS const float*)pwa, *b_ = (GAS const float*)pwb, *c_ = (GAS const float*)pwc, *o_ = (GAS const float*)pwo, *m_ = (GAS const float*)pwmkv;
      asm volatile("" : "+s"(a_), "+s"(b_), "+s"(c_), "+s"(o_), "+s"(m_));
      pwa = (const float*)a_; pwb = (const float*)b_; pwc = (const float*)c_; pwo = (const float*)o_; pwmkv = (const float*)m_; }
    constexpr int J0 = 1664, J1 = J0 + 128, J2 = J1 + 128, J3 = J2 + 128, J4 = J3 + 256, J5 = J4 + 256, J6 = J5 + 64, J7 = J6 + 128, J8 = J7 + 64,
                  J9 = J8, J10 = J8;
    const int kr = tid >> 4, nc = tid & 15, sg = nc >> 2;
    const int tn = tid >> 3, tkc = tid & 7;
#define P0_DECODE_LOAD(it0, dp, v0, v1) do { const float* sp[4]; int ld[4]; \
      _Pragma("unroll") \
      for (int q = 0; q < 4; ++q) { \
        const int it = (it0 + q < J10) ? it0 + q : J10 - 1;      \
        const float *s0, *s1, *s2, *s3; int ldd; bf16_t* dst; \
        if (it < J0) {           \
          const int kt = it & 15, nt = it >> 4; const int n0 = nt * 64; const int c0 = n0 + (n0 >= 2048 ? 8 : 0); \
          const float* b = pwin + (size_t)kt * 64 * DIN + c0; s0 = b; s1 = b + 16; s2 = b + 32; s3 = b + 48; ld[q] = DIN; ldd = 1024; \
          dst = (bf16_t*)(ws + O_WINT) + (size_t)n0 * 1024 + kt * 64; \
        } else if (it < J3) {    \
          const int which = (it - J0) >> 7, r = (it - J0) & 127; const int kt = r & 7, nt = r >> 3; \
          const float* src = which == 0 ? pwa : which == 1 ? pwb : pwc; \
          const float* b = src + (size_t)kt * 64 * 1024 + nt * 64; s0 = b; s1 = b + 16; s2 = b + 32; s3 = b + 48; ld[q] = 1024; ldd = 512; \
          dst = (bf16_t*)(ws + (which == 0 ? O_WAT : which == 1 ? O_WBT : O_WCT)) + (size_t)nt * 64 * 512 + kt * 64; \
        } else if (it < J5) {    \
          const int which = (it - J3) >> 8, r = (it - J3) & 255; const int kt = r & 15, nt = r >> 4; \
          const float* b = (which == 0 ? pwo : pwmkv) + (size_t)kt * 64 * 1024 + nt * 64; s0 = b; s1 = b + 16; s2 = b + 32; s3 = b + 48; ld[q] = 1024; ldd = 1024; \
          dst = (bf16_t*)(ws + (which == 0 ? O_WOT : O_WMKV)) + (size_t)nt * 64 * 1024 + kt * 64; \
        } else if (it < J6) {    \
          const int r = it - J5; const int kt = r & 15, nt = r >> 4; \
          const float* b = prw + (size_t)kt * 64 * 256 + nt * 64; s0 = b; s1 = b + 16; s2 = b + 32; s3 = b + 48; ld[q] = 256; ldd = 1024; \
          dst = (bf16_t*)(ws + O_ROUT) + (size_t)nt * 64 * 1024 + kt * 64; \
        } else if (it < J7) {    \
          const int r = it - J6; const int kt = r & 15, nt = r >> 4; \
          const float* g = pwsg + (size_t)kt * 64 * 256 + nt * 32; const float* u = pwsu + (size_t)kt * 64 * 256 + nt * 32; \
          s0 = g; s1 = u; s2 = g + 16; s3 = u + 16; ld[q] = 256; ldd = 1024; \
          dst = (bf16_t*)(ws + O_WSGU) + (size_t)nt * 64 * 1024 + kt * 64; \
        } else if (it < J8) {    \
          const int r = it - J7; const int kt = r & 3, nt = r >> 2; \
          const float* b = pwsd + (size_t)kt * 64 * 1024 + nt * 64; s0 = b; s1 = b + 16; s2 = b + 32; s3 = b + 48; ld[q] = 1024; ldd = 256; \
          dst = (bf16_t*)(ws + O_WSD) + (size_t)nt * 64 * 256 + kt * 64; \
        } else if (it < J9) {    \
          const int r = it - J8; const int e = r >> 7, qq = r & 127; const int kt = qq & 15, nt = qq >> 4; \
          const float* g = pwg + (size_t)e * 262144 + (size_t)kt * 64 * 256 + nt * 32; const float* u = pwu + (size_t)e * 262144 + (size_t)kt * 64 * 256 + nt * 32; \
          s0 = g; s1 = u; s2 = g + 16; s3 = u + 16; ld[q] = 256; ldd = 1024; \
          dst = (bf16_t*)(ws + O_WGU) + (size_t)e * 524288 + (size_t)nt * 64 * 1024 + kt * 64; \
        } else {                 \
          const int r = it - J9; const int e = r >> 6, qq = r & 63; const int kt = qq & 3, nt = qq >> 2; \
          const float* b = pwdn + (size_t)e * 262144 + (size_t)kt * 64 * 1024 + nt * 64; s0 = b; s1 = b + 16; s2 = b + 32; s3 = b + 48; ld[q] = 1024; ldd = 256; \
          dst = (bf16_t*)(ws + O_WD) + (size_t)e * 262144 + (size_t)nt * 64 * 256 + kt * 64; \
        } \
        sp[q] = (sg == 0 ? s0 : sg == 1 ? s1 : sg == 2 ? s2 : s3) + (size_t)kr * ld[q] + 4 * (nc & 3); \
        dp[q] = dst + (size_t)tn * ldd + 8 * tkc; \
      } \
      _Pragma("unroll") \
      for (int q = 0; q < 4; ++q) { v0[q] = __builtin_nontemporal_load((const f32x4*)(sp[q])); v1[q] = __builtin_nontemporal_load((const f32x4*)(sp[q] + (size_t)32 * ld[q])); } } while (0)
    bf16_t* dpn[4]; f32x4 v0n[4], v1n[4];
    int it0 = bid * 4;
    if (it0 < J10) P0_DECODE_LOAD(it0, dpn, v0n, v1n);
    for (; it0 < J10; it0 += nb * 4) {
      bf16_t* dp[4]; f32x4 v0[4], v1[4];
#pragma unroll
      for (int q = 0; q < 4; ++q) { dp[q] = dpn[q]; v0[q] = v0n[q]; v1[q] = v1n[q]; }
      if (it0 + nb * 4 < J10) P0_DECODE_LOAD(it0 + nb * 4, dpn, v0n, v1n);
      asm volatile("s_waitcnt lgkmcnt(0)" ::: "memory"); __builtin_amdgcn_s_barrier(); asm volatile("" ::: "memory");
#pragma unroll
      for (int q = 0; q < 4; ++q) {
        float* t0 = tile + q * 4160 + kr * 65 + 4 * nc;
        float* t1 = t0 + 32 * 65;
        t0[0] = v0[q][0]; t0[1] = v0[q][1]; t0[2] = v0[q][2]; t0[3] = v0[q][3];
        t1[0] = v1[q][0]; t1[1] = v1[q][1]; t1[2] = v1[q][2]; t1[3] = v1[q][3];
      }
      asm volatile("s_waitcnt lgkmcnt(0)" ::: "memory"); __builtin_amdgcn_s_barrier(); asm volatile("" ::: "memory");
#pragma unroll
      for (int q = 0; q < 4; ++q) {
        float e[8];
#pragma unroll
        for (int j = 0; j < 8; ++j) e[j] = tile[q * 4160 + (8 * tkc + j) * 65 + tn];
        u32x4 o = {pk2(e[0], e[1]), pk2(e[2], e[3]), pk2(e[4], e[5]), pk2(e[6], e[7])};
        *(u32x4*)(dp[q]) = o;
      }
    }
#undef P0_DECODE_LOAD
  }
}

#define EPI_ROWS(u) const int row_ = (u).pm * 256 + 64 * wr + fr
struct EpiInProj {
  unsigned char* ws;
  DI void operator()(const f32x4 (&acc)[2][2][4][2], const pg::Unit& u, int wr, int wc, int fr, int fq) const {
    const int colt = u.pn * 256;
#pragma unroll
    for (int ai = 0; ai < 2; ++ai)
#pragma unroll
      for (int m = 0; m < 4; ++m) {
        const size_t row = (size_t)u.pm * 256 + 128 * ai + 64 * wr + 16 * m + fr;
#pragma unroll
        for (int bj = 0; bj < 2; ++bj)
#pragma unroll
          for (int n = 0; n < 2; ++n) {
            const int col = colt + 128 * bj + 32 * wc + 16 * n + 4 * fq;
            f32x4 v = acc[ai][bj][m][n];
            if (colt < 1536) { *(u32x2*)((bf16_t*)(ws + O_QKV) + row * 1536 + col) = pack4(v); }
            else if (colt < 2048) {
#pragma unroll
              for (int c = 0; c < 4; ++c) v[c] = siluf_(v[c]);
              *(u32x2*)((bf16_t*)(ws + O_ZS) + row * 512 + (col - 1536)) = pack4(v);
            } else if (colt < 3072) {
#pragma unroll
              for (int c = 0; c < 4; ++c) v[c] = geluf_(v[c]);
              *(u32x2*)((bf16_t*)(ws + O_UVG) + row * 1024 + (col - 2048)) = pack4(v);
            } else if (colt < 3584) {
#pragma unroll
              for (int c = 0; c < 4; ++c) v[c] *= 0.08838834764831845f;
              *(u32x2*)((bf16_t*)(ws + O_XQ) + row * 512 + (col - 3072)) = pack4(v);
            } else {
#pragma unroll
              for (int c = 0; c < 4; ++c) v[c] = sigmoidf_(v[c]);
              *(u32x2*)((bf16_t*)(ws + O_GATES) + row * 3072 + (col - 3584)) = pack4(v);
            }
          }
      }
  }
};
struct EpiMemKV {
  unsigned char* ws;
  DI void operator()(const f32x4 (&acc)[2][2][4][2], const pg::Unit& u, int wr, int wc, int fr, int fq) const {
#pragma unroll
    for (int ai = 0; ai < 2; ++ai)
#pragma unroll
      for (int m = 0; m < 4; ++m) {
        const int row = u.pm * 256 + 128 * ai + 64 * wr + 16 * m + fr; const int b = row >> 8, key = row & 255;
#pragma unroll
        for (int bj = 0; bj < 2; ++bj)
#pragma unroll
          for (int n = 0; n < 2; ++n) {
            const int col = u.pn * 256 + 128 * bj + 32 * wc + 16 * n + 4 * fq;
            const f32x4 v = acc[ai][bj][m][n];
            if (col < 512) { const int h = col >> 7, d = col & 127; *(u32x2*)((bf16_t*)(ws + O_MEMK) + ((size_t)((b * 4 + h) * 256 + key)) * 128 + d) = pack4(v); }
            else {
              const int c2 = col - 512; const int h = c2 >> 7, d = c2 & 127;
              const int pos = 32 * (key >> 5) + 8 * ((key >> 2) & 3) + 4 * ((key >> 4) & 1) + (key & 3);
              bf16_t* vt = (bf16_t*)(ws + O_MEMVT) + ((size_t)((b * 4 + h) * 128 + d)) * 256 + pos;
#pragma unroll
              for (int c = 0; c < 4; ++c) vt[(size_t)c * 256] = f2bf(v[c]);
            }
          }
      }
  }
};
DI void phase1(const Params& p, unsigned char* smem, int bid, int nb) {
  unsigned char* ws = p.ws;
  PG_LAS unsigned char* lds = (PG_LAS unsigned char*)smem;
  __syncthreads();
  { pg::DenseOrder S; S.init(ws + O_XB, ws + O_WINT, T, NPROJ, 1024, nb, bid); EpiInProj E{ws}; pg::gemm_phase<EpiInProj, pg::DenseOrder, false, true>(lds, 1024, S, E); }
  __syncthreads();
  { pg::DenseOrder S; S.init(ws + O_MEMB, ws + O_WMKV, 512, 1024, 1024, nb, bid); EpiMemKV E{ws}; pg::gemm_phase<EpiMemKV, pg::DenseOrder, false, true>(lds, 1024, S, E); }
}

constexpr int G_KF = 0, G_VF = 32768, G_QB = 65536, G_KB = 81920, G_UT = 81920  , G_L = 98304, G_ATT = 114688, G_KDT = 122880, G_WT = 139264, G_SM = 155648;

DI void gdn_prep_item(const Params& p, unsigned char* smem_, int item) {
  unsigned char* smem; { LAS unsigned char* l_ = (LAS unsigned char*)smem_; asm volatile("" : "+v"(l_)); smem = (unsigned char*)l_; }
  int tid = threadIdx.x; asm volatile("" : "+v"(tid));
  const int lane = tid & 63, wave = tid >> 6, fr = lane & 15, fq = lane >> 4;
  unsigned char* ws; { GAS unsigned char* g_ = (GAS unsigned char*)p.ws; asm volatile("" : "+s"(g_)); ws = (unsigned char*)g_; }
  const int h = item & 3, cn = item >> 2;
  const int bidx = cn >> 7, n = cn & 127;
  const size_t t0 = (size_t)bidx * SEQ + (size_t)n * 64;
  float* kf = (float*)(smem + G_KF); float* vf = (float*)(smem + G_VF); float* Lm = (float*)(smem + G_L);
  float* sbeta = (float*)(smem + G_SM); float* sgc = sbeta + 64; float* segc = sbeta + 128;
  __syncthreads();
  {
    const bf16_t* qkv = (const bf16_t*)(ws + O_QKV);
    const float* cw = p.in[I_CONVW];
    const int tl0 = wave * 8;
#pragma unroll
    for (int sect = 0; sect < 3; ++sect) {
      const int cb = sect * 512 + h * 128 + 2 * lane;
      float w0[4], w1[4];
#pragma unroll
      for (int i = 0; i < 4; ++i) { w0[i] = cw[i * 1536 + cb]; w1[i] = cw[i * 1536 + cb + 1]; }
      float xa[11], xc[11];
#pragma unroll
      for (int r = 0; r < 11; ++r) {
        const int s = n * 64 + tl0 + r - 3;
        unsigned u = 0u;
        if (s >= 0) u = *(const unsigned*)(qkv + ((size_t)bidx * SEQ + s) * 1536 + cb);
        xa[r] = lo2f(u); xc[r] = hi2f(u);
      }
#pragma unroll
      for (int r = 0; r < 8; ++r) {
        float y0 = w0[0] * xa[r] + w0[1] * xa[r + 1] + w0[2] * xa[r + 2] + w0[3] * xa[r + 3];
        float y1 = w1[0] * xc[r] + w1[1] * xc[r + 1] + w1[2] * xc[r + 2] + w1[3] * xc[r + 3];
        y0 = siluf_(y0); y1 = siluf_(y1);
        const int tl = tl0 + r;
        if (sect == 2) { vf[tl * 128 + 2 * lane] = y0; vf[tl * 128 + 2 * lane + 1] = y1; }
        else {
          const float ss = wave_sum(y0 * y0 + y1 * y1);
          const float sc = rsqrtf(ss + 1e-6f) * (sect == 0 ? 0.08838834764831845f : 1.0f);
          y0 *= sc; y1 *= sc;
          const int off = sw256(tl, lane >> 2) + (lane & 3) * 4;
          if (sect == 0) *(unsigned*)(smem + G_QB + off) = pk2(y0, y1);
          else { *(unsigned*)(smem + G_KB + off) = pk2(y0, y1); kf[tl * 128 + 2 * lane] = y0; kf[tl * 128 + 2 * lane + 1] = y1; }
        }
      }
    }
    if (wave == 0) {
      const float* ab = (const float*)(ws + O_AB) + (t0 + lane) * 8;
      const float a = ab[h], bb = ab[4 + h];
      const float beta = sigmoidf_(bb);
      float g = -__expf(p.in[I_ALOG][h]) * softplusf_(a + p.in[I_DTB][h]);
#pragma unroll
      for (int o = 1; o < 64; o <<= 1) { const float y = __shfl_up(g, o); if (lane >= o) g += y; }
      sbeta[lane] = beta; sgc[lane] = g; segc[lane] = __expf(g);
      if (lane == 63) ((float*)(ws + O_GL))[item] = __expf(g);
    }
  }
  __syncthreads();
  {
#pragma unroll
    for (int q = 0; q < 4; ++q) {
      const int idx = wave * 4 + q; const int isq = idx >> 4, ti = (idx >> 2) & 3, tj = idx & 3;
      f32x4 acc = {0.f, 0.f, 0.f, 0.f};
      if (tj <= ti) {
#pragma unroll
        for (int ks = 0; ks < 4; ++ks) {
          const bf16x8 ai = ldfrag(smem + (isq ? G_QB : G_KB) + sw256(16 * ti + fr, 4 * ks + fq));
          const bf16x8 bj = ldfrag(smem + G_KB + sw256(16 * tj + fr, 4 * ks + fq));
          acc = isq ? mfma16(bj, ai, acc) : mfma16(ai, bj, acc);
        }
      }
      if (isq) {
        const int i = 16 * ti + fr, j0 = 16 * tj + 4 * fq;
        const float gi = sgc[i];
        f32x4 o;
#pragma unroll
        for (int r = 0; r < 4; ++r) { const int j = j0 + r; o[r] = (j <= i) ? acc[r] * __expf(gi - sgc[j]) : 0.f; }
        *(u32x2*)(smem + G_ATT + sw128(i, j0 >> 3) + (j0 & 7) * 2) = pack4(o);
      } else {
        const int j = 16 * tj + fr, i0 = 16 * ti + 4 * fq;
        const float gj = sgc[j];
        f32x4 o;
#pragma unroll
        for (int r = 0; r < 4; ++r) { const int i = i0 + r; o[r] = (j < i) ? acc[r] * __expf(sgc[i] - gj) * sbeta[i] : 0.f; }
        *(f32x4*)(Lm + j * 64 + i0) = o;
      }
    }
  }
  {
    const float gl_ = sgc[63];
    const int d = tid & 127, tg = tid >> 7;
#pragma unroll
    for (int c = 0; c < 2; ++c) {
      float e[8];
#pragma unroll
      for (int j = 0; j < 8; ++j) { const int t = 16 * tg + 8 * c + j; e[j] = kf[t * 128 + d] * __expf(gl_ - sgc[t]); }
      u32x4 o = {pk2(e[0], e[1]), pk2(e[2], e[3]), pk2(e[4], e[5]), pk2(e[6], e[7])};
      *(u32x4*)(smem + G_KDT + sw128(d, 2 * tg + c)) = o;
    }
  }
  __syncthreads();
  {
#pragma unroll
    for (int i = 0; i < 32; ++i) {
      const int e = tid + 512 * i; const int t = e >> 8, c = e & 255;
      float* xp = (c < 128) ? (vf + t * 128 + c) : (kf + t * 128 + (c - 128));
      float sc = sbeta[t]; if (c >= 128) sc *= segc[t];
      *xp *= sc;
    }
    __syncthreads();
    const int ct0 = 2 * wave;
    float* xt0 = (ct0 < 8) ? (vf + 16 * ct0) : (kf + 16 * (ct0 - 8));
    float* xt1 = xt0 + 16;
#pragma unroll
    for (int b = 0; b < 4; ++b) {
      if (b > 0) {
        f32x4 a0 = {0.f, 0.f, 0.f, 0.f}, a1 = {0.f, 0.f, 0.f, 0.f};
#pragma unroll
        for (int ks = 0; ks < 4 * b; ++ks) {
          const int k = 4 * ks + fq;
          const float av = Lm[k * 64 + 16 * b + fr];
          a0 = __builtin_amdgcn_mfma_f32_16x16x4f32(av, xt0[k * 128 + fr], a0, 0, 0, 0);
          a1 = __builtin_amdgcn_mfma_f32_16x16x4f32(av, xt1[k * 128 + fr], a1, 0, 0, 0);
        }
#pragma unroll
        for (int r = 0; r < 4; ++r) { xt0[(16 * b + 4 * fq + r) * 128 + fr] -= a0[r]; xt1[(16 * b + 4 * fq + r) * 128 + fr] -= a1[r]; }
        __syncthreads();
      }
      if (tid < 256) {
        const bool isw = tid >= 128;
        float* X = isw ? (kf + (tid - 128)) : (vf + tid);
        float xr[16];
#pragma unroll
        for (int r = 0; r < 16; ++r) xr[r] = X[(16 * b + r) * 128];
#pragma unroll
        for (int q = 0; q < 15; ++q) {
          const float* lt = Lm + (16 * b + q) * 64 + 16 * b;
          float l[16];
#pragma unroll
          for (int g4 = 0; g4 < 4; ++g4) if (4 * g4 + 3 > q) { const f32x4 t4 = *(const f32x4*)(lt + 4 * g4); l[4 * g4] = t4[0]; l[4 * g4 + 1] = t4[1]; l[4 * g4 + 2] = t4[2]; l[4 * g4 + 3] = t4[3]; }
#pragma unroll
          for (int r = q + 1; r < 16; ++r) xr[r] -= l[r] * xr[q];
        }
#pragma unroll
        for (int r = 0; r < 16; ++r) X[(16 * b + r) * 128] = xr[r];
        unsigned char* dstT = smem + (isw ? G_WT : G_UT);
        const int rowc = tid & 127;
        u32x4 o0 = {pk2(xr[0], xr[1]), pk2(xr[2], xr[3]), pk2(xr[4], xr[5]), pk2(xr[6], xr[7])};
        u32x4 o1 = {pk2(xr[8], xr[9]), pk2(xr[10], xr[11]), pk2(xr[12], xr[13]), pk2(xr[14], xr[15])};
        *(u32x4*)(dstT + sw128(rowc, 2 * b)) = o0;
        *(u32x4*)(dstT + sw128(rowc, 2 * b + 1)) = o1;
      }
      if (b < 3) __syncthreads();
    }
  }
  __syncthreads();
  {
    bf16x8 ak[2];
#pragma unroll
    for (int ks = 0; ks < 2; ++ks) ak[ks] = ldfrag(smem + G_KDT + sw128(16 * wave + fr, 4 * ks + fq));
    bf16_t* mp = (bf16_t*)(ws + O_MP) + (size_t)item * 16384;
    bf16_t* bc = (bf16_t*)(ws + O_BC) + (size_t)item * 16384;
#pragma unroll
    for (int tj = 0; tj < 8; ++tj) {
      f32x4 am = {0.f, 0.f, 0.f, 0.f}, ab_ = {0.f, 0.f, 0.f, 0.f};
#pragma unroll
      for (int ks = 0; ks < 2; ++ks) {
        const bf16x8 bw = ldfrag(smem + G_WT + sw128(16 * tj + fr, 4 * ks + fq));
        const bf16x8 bu = ldfrag(smem + G_UT + sw128(16 * tj + fr, 4 * ks + fq));
        am = mfma16(bw, ak[ks], am);
        ab_ = mfma16(ak[ks], bu, ab_);
      }
      f32x4 nm = {-am[0], -am[1], -am[2], -am[3]};
      *(u32x2*)(mp + ((size_t)((wave * 4 + (tj >> 1)) * 64 + lane)) * 8 + (tj & 1) * 4) = pack4(nm);
      *(u32x2*)(bc + ((size_t)((tj * 4 + (wave >> 1)) * 64 + lane)) * 8 + (wave & 1) * 4) = pack4(ab_);
    }
    const int tt = wave & 3, hf = wave >> 2;
    bf16x8 aa[2];
#pragma unroll
    for (int ks = 0; ks < 2; ++ks) aa[ks] = ldfrag(smem + G_ATT + sw128(16 * tt + fr, 4 * ks + fq));
    const int trow = 16 * tt + fr;
    const float eg = segc[trow];
    float* o0 = (float*)(ws + O_O0) + (t0 + trow) * 512 + h * 128;
    bf16_t* qp = (bf16_t*)(ws + O_QP) + (size_t)item * 8192 + trow * 128;
#pragma unroll
    for (int q = 0; q < 4; ++q) {
      const int te = hf * 4 + q;
      f32x4 ao = {0.f, 0.f, 0.f, 0.f}, aw = {0.f, 0.f, 0.f, 0.f};
#pragma unroll
      for (int ks = 0; ks < 2; ++ks) {
        const bf16x8 bu = ldfrag(smem + G_UT + sw128(16 * te + fr, 4 * ks + fq));
        const bf16x8 bw = ldfrag(smem + G_WT + sw128(16 * te + fr, 4 * ks + fq));
        ao = mfma16(bu, aa[ks], ao);
        aw = mfma16(bw, aa[ks], aw);
      }
      const int e0 = 16 * te + 4 * fq;
      *(f32x4*)(o0 + e0) = ao;
      const u32x2 qv = *(const u32x2*)(smem + G_QB + sw256(trow, e0 >> 3) + (e0 & 7) * 2);
      f32x4 qd = {lo2f(qv[0]) * eg - aw[0], hi2f(qv[0]) * eg - aw[1], lo2f(qv[1]) * eg - aw[2], hi2f(qv[1]) * eg - aw[3]};
      *(u32x2*)(qp + e0) = pack4(qd);
    }
  }
}

typedef short s16x4 __attribute__((ext_vector_type(4)));
DI bf16x8 tr_frag(const unsigned char* p0, const unsigned char* p1) {
  const s16x4 a = __builtin_amdgcn_ds_read_tr16_b64_v4i16((LAS s16x4*)p0), b = __builtin_amdgcn_ds_read_tr16_b64_v4i16((LAS s16x4*)p1);
  bf16x8 r; r[0] = a[0]; r[1] = a[1]; r[2] = a[2]; r[3] = a[3]; r[4] = b[0]; r[5] = b[1]; r[6] = b[2]; r[7] = b[3]; return r;
}
DI void sgu_item(const Params& p, unsigned char* smem_, int item) {
  unsigned char* smem; { LAS unsigned char* l_ = (LAS unsigned char*)smem_; asm volatile("" : "+v"(l_)); smem = (unsigned char*)l_; }
  int tid = threadIdx.x; asm volatile("" : "+v"(tid));
  const int lane = tid & 63, wave = __builtin_amdgcn_readfirstlane(tid >> 6), fr = lane & 15, fq = lane >> 4;
  unsigned char* ws; { GAS unsigned char* g_ = (GAS unsigned char*)p.ws; asm volatile("" : "+s"(g_)); ws = (unsigned char*)g_; }
  const int gp = item & 1, cn = item >> 1;
  const size_t t0 = (size_t)cn * 128;
  const bf16_t* uvg = (const bf16_t*)(ws + O_UVG);
  constexpr int VS = 544;
  __syncthreads();
  {
    const float* lng = p.in[I_SLNG]; const float* lnb = p.in[I_SLNB];
    float gg[8], bb[8];
#pragma unroll
    for (int e = 0; e < 8; ++e) { gg[e] = lng[8 * lane + e]; bb[e] = lnb[8 * lane + e]; }
#pragma unroll 2
    for (int jj = 0; jj < 16; ++jj) {
      const int j = 16 * wave + jj;
      const u32x4 raw = *(const u32x4*)(uvg + (t0 + j) * 1024 + 512 + 8 * lane);
      float v[8];
#pragma unroll
      for (int e = 0; e < 4; ++e) { v[2 * e] = lo2f(raw[e]); v[2 * e + 1] = hi2f(raw[e]); }
      float s = 0.f, q2 = 0.f;
#pragma unroll
      for (int e = 0; e < 8; ++e) { s += v[e]; q2 += v[e] * v[e]; }
      s = wave_sum(s); q2 = wave_sum(q2);
      const float mean = s * (1.f / 512.f);
      const float rstd = rsqrtf(fmaxf(q2 * (1.f / 512.f) - mean * mean, 0.f) + 1e-5f);
      if ((lane >> 5) == gp) {
        float y[8];
#pragma unroll
        for (int e = 0; e < 8; ++e) y[e] = (v[e] - mean) * rstd * gg[e] + bb[e];
        u32x4 o = {pk2(y[0], y[1]), pk2(y[2], y[3]), pk2(y[4], y[5]), pk2(y[6], y[7])};
        *(u32x4*)(smem + j * VS + (lane & 31) * 16) = o;
      }
    }
  }
  __syncthreads();
  {
    const int i = 16 * wave + fr;
    const int q = (lane & 15) >> 2, pp = lane & 3;
    const unsigned char* vb = smem + (8 * fq + q) * VS + 8 * pp;
#pragma unroll 1
    for (int gl = 0; gl < 2; ++gl) {
      const int g = 2 * gp + gl;
      const bf16_t* wg = (const bf16_t*)(ws + O_SGUW) + (size_t)g * 16384;
      bf16x8 af[4];
#pragma unroll
      for (int ks = 0; ks < 4; ++ks) af[ks] = ldfrag(wg + i * 128 + 32 * ks + 8 * fq);
      const float bias = p.in[I_SGUB][g * 128 + i];
      bf16_t* out = (bf16_t*)(ws + O_SGUO) + (t0 + i) * 512 + 128 * g;
      const bf16_t* urow = uvg + (t0 + i) * 1024 + 128 * g;
#pragma unroll
      for (int jt = 0; jt < 8; ++jt) {
        f32x4 acc = {0.f, 0.f, 0.f, 0.f};
#pragma unroll
        for (int ks = 0; ks < 4; ++ks) {
          const unsigned char* a0 = vb + ks * 32 * VS + (128 * gl + 16 * jt) * 2;
          acc = mfma16(tr_frag(a0, a0 + 4 * VS), af[ks], acc);
        }
        const int c0 = 16 * jt + 4 * fq;
        const u32x2 uu = *(const u32x2*)(urow + c0);
        f32x4 o = {lo2f(uu[0]) * (acc[0] + bias), hi2f(uu[0]) * (acc[1] + bias), lo2f(uu[1]) * (acc[2] + bias), hi2f(uu[1]) * (acc[3] + bias)};
        *(u32x2*)(out + c0) = pack4(o);
        if (jt & 1) __builtin_amdgcn_sched_barrier(0);
      }
    }
  }
}

DI void xattn_item(const Params& p, unsigned char* smem_, int item) {
  int tid = threadIdx.x; asm volatile("" : "+v"(tid));
  unsigned char* smem; { LAS unsigned char* l_ = (LAS unsigned char*)smem_; asm volatile("" : "+v"(l_)); smem = (unsigned char*)l_; }
  const int lane = tid & 63, wave = tid >> 6, fr = lane & 15, fq = lane >> 4;
  unsigned char* ws; { GAS unsigned char* g_ = (GAS unsigned char*)p.ws; asm volatile("" : "+s"(g_)); ws = (unsigned char*)g_; }
  const int bh = item & 7, qb = item >> 3;
  const int b = bh >> 2, h = bh & 3;
  const bf16_t* mk = (const bf16_t*)(ws + O_MEMK) + (size_t)bh * 32768;
  const bf16_t* mv = (const bf16_t*)(ws + O_MEMVT) + (size_t)bh * 32768;
  __syncthreads();
#pragma unroll 2
  for (int j = 0; j < 8; ++j) {
    const int c = tid + 512 * j;
    const int rk = c >> 4, ck = c & 15;
    *(u32x4*)(smem + sw256(rk, ck)) = *(const u32x4*)(mk + (size_t)c * 8);
    const int rv = c >> 5, cv = c & 31;
    *(u32x4*)(smem + 65536 + rv * 512 + ((cv ^ (rv & 15)) << 4)) = *(const u32x4*)(mv + (size_t)c * 8);
  }
  __syncthreads();
  const unsigned char* kbase[4]; const unsigned char* vbase[8];
#pragma unroll
  for (int ds = 0; ds < 4; ++ds) kbase[ds] = smem + fr * 256 + (((4 * ds + fq) ^ fr) << 4);
#pragma unroll
  for (int s = 0; s < 8; ++s) vbase[s] = smem + 65536 + fr * 512 + (((4 * s + fq) ^ fr) << 4);
#pragma unroll 1
  for (int half = 0; half < 2; ++half) {
    const size_t trow = (size_t)b * SEQ + (size_t)qb * 256 + half * 128 + 16 * wave + fr;
    const bf16_t* xq = (const bf16_t*)(ws + O_XQ) + trow * 512 + h * 128;
    bf16x8 qf[4];
#pragma unroll
    for (int ds = 0; ds < 4; ++ds) qf[ds] = ldfrag(xq + 32 * ds + 8 * fq);
    f32x4 sc[16];
#pragma unroll
    for (int kt = 0; kt < 16; ++kt) {
      f32x4 a = {0.f, 0.f, 0.f, 0.f};
#pragma unroll
      for (int ds = 0; ds < 4; ++ds) a = mfma16(ldfrag(kbase[ds] + kt * 4096), qf[ds], a);
      sc[kt] = a;
      if (kt & 1) __builtin_amdgcn_sched_barrier(0);
    }
    float m = -1e30f;
#pragma unroll
    for (int kt = 0; kt < 16; ++kt)
#pragma unroll
      for (int r = 0; r < 4; ++r) m = fmaxf(m, sc[kt][r]);
    m = fmaxf(m, __shfl_xor(m, 16)); m = fmaxf(m, __shfl_xor(m, 32));
    float l = 0.f;
#pragma unroll
    for (int kt = 0; kt < 16; ++kt)
#pragma unroll
      for (int r = 0; r < 4; ++r) { const float e = __expf(sc[kt][r] - m); sc[kt][r] = e; l += e; }
    l += __shfl_xor(l, 16); l += __shfl_xor(l, 32);
    const float inv = 1.f / l;
    bf16x8 pf[8];
#pragma unroll
    for (int s = 0; s < 8; ++s) pf[s] = pack8(sc[2 * s], sc[2 * s + 1]);
    bf16_t* out = (bf16_t*)(ws + O_XATO) + trow * 512 + h * 128;
#pragma unroll
    for (int dt = 0; dt < 8; ++dt) {
      f32x4 a = {0.f, 0.f, 0.f, 0.f};
#pragma unroll
      for (int s = 0; s < 8; ++s) a = mfma16(ldfrag(vbase[s] + dt * 8192), pf[s], a);
      __builtin_amdgcn_sched_barrier(0);
      f32x4 o = {a[0] * inv, a[1] * inv, a[2] * inv, a[3] * inv};
      *(u32x2*)(out + 16 * dt + 4 * fq) = pack4(o);
    }
  }
}

DI void phase2(const Params& p, unsigned char* smem, int bid, int nb) {
  for (int rep = 0; rep < ((DUPMASK >> 20) & 1) + 1; ++rep) {
    if (nb == 256) {
      const int bh = bid & 7, k = bid >> 3;
      for (int j = 0; j < 4; ++j) { const int n = 127 - (k + 32 * j); gdn_prep_item(p, smem, (((bh >> 2) * 128 + n) << 2) + (bh & 3)); }
    } else {
      for (int it = bid; it < 1024; it += nb) gdn_prep_item(p, smem, it);
    }
  }
  for (int rep = 0; rep < ((DUPMASK >> 21) & 1) + 1; ++rep) for (int it = bid; it < 256; it += nb) sgu_item(p, smem, it);
  for (int rep = 0; rep < ((DUPMASK >> 22) & 1) + 1; ++rep) for (int it = bid; it < 256; it += nb) xattn_item(p, smem, it);
}

DI void gdn_scan4(const Params& p, unsigned char* smem_, int bh, int es) {
  int tid = threadIdx.x; asm volatile("" : "+v"(tid));
  unsigned char* smem; { LAS unsigned char* l_ = (LAS unsigned char*)smem_; asm volatile("" : "+v"(l_)); smem = (unsigned char*)l_; }
  const int lane = tid & 63, w = __builtin_amdgcn_readfirstlane(tid >> 6);
  if (w >= 4) {
    for (int n = 0; n < 128; ++n) __builtin_amdgcn_s_barrier();
    return;
  }
  unsigned char* ws = p.ws;
  const int b = bh >> 2, h = bh & 3;
  const int fr = lane & 15, fq = lane >> 4;
  const size_t item0 = (size_t)(b * 128) * 4 + h;
  constexpr size_t ISTR = 4 * 16384;
  const bf16_t* mp = (const bf16_t*)(ws + O_MP) + item0 * 16384 + (size_t)(2 * w) * 2048 + lane * 8;
  const bf16_t* bc = (const bf16_t*)(ws + O_BC) + item0 * 16384 + (size_t)es * 2048 + (size_t)w * 512 + lane * 8;
  bf16_t* st = (bf16_t*)(ws + O_ST) + item0 * 16384 + (size_t)(16 * es + fr) * 128 + 32 * w + 4 * fq;
  const float* glp = (const float*)(ws + O_GL) + item0;
  { GAS const float* g_ = (GAS const float*)glp; asm volatile("" : "+v"(g_)); glp = (const float*)g_; }
  f32x4 acc0 = {0.f, 0.f, 0.f, 0.f}, acc1 = {0.f, 0.f, 0.f, 0.f};
  constexpr int PD = 4;
  bf16x8 A[PD][8]; u32x4 C[PD]; float G[PD];
#pragma unroll
  for (int d = 0; d < PD; ++d) {
#pragma unroll
    for (int i = 0; i < 8; ++i) A[d][i] = ldfrag(mp + (size_t)d * ISTR + i * 512);
    C[d] = *(const u32x4*)(bc + (size_t)d * ISTR);
    G[d] = glp[d * 4];
  }
  unsigned char* xch = smem;
  for (int n0 = 0; n0 < 128; n0 += PD) {
#pragma unroll
    for (int d = 0; d < PD; ++d) {
      const int n = n0 + d;
      const int np = (n + PD < 128) ? n + PD : n;
      const u32x2 lo = pack4(acc0), hi = pack4(acc1);
      bf16_t* stn = st + (size_t)n * ISTR;
      *(u32x2*)(stn) = lo; *(u32x2*)(stn + 16) = hi;
      const u32x4 mine = {lo[0], lo[1], hi[0], hi[1]};
      *(u32x4*)(xch + ((n & 1) * 4 + w) * 1024 + lane * 16) = mine;
      asm volatile("s_waitcnt lgkmcnt(0)" ::: "memory");
      __builtin_amdgcn_s_barrier();
      asm volatile("" ::: "memory");
      bf16x8 bfr[4];
#pragma unroll
      for (int s = 0; s < 4; ++s) bfr[s] = ldfrag(xch + ((n & 1) * 4 + s) * 1024 + lane * 16);
      const float g = G[d];
      f32x4 a0 = {g * acc0[0] + lo2f(C[d][0]), g * acc0[1] + hi2f(C[d][0]), g * acc0[2] + lo2f(C[d][1]), g * acc0[3] + hi2f(C[d][1])};
      f32x4 a1 = {g * acc1[0] + lo2f(C[d][2]), g * acc1[1] + hi2f(C[d][2]), g * acc1[2] + lo2f(C[d][3]), g * acc1[3] + hi2f(C[d][3])};
#pragma unroll
      for (int s = 0; s < 4; ++s) { a0 = mfma16(A[d][s], bfr[s], a0); a1 = mfma16(A[d][4 + s], bfr[s], a1); }
      acc0 = a0; acc1 = a1;
#pragma unroll
      for (int i = 0; i < 8; ++i) A[d][i] = ldfrag(mp + (size_t)np * ISTR + i * 512);
      C[d] = *(const u32x4*)(bc + (size_t)np * ISTR);
      G[d] = glp[(size_t)np * 4];
    }
  }
}

struct EpiGate {
  const bf16_t* gates; int goff; const bf16_t* src; bf16_t* dst;
  DI void operator()(const f32x4 (&acc)[2][2][4][2], const pg::Unit& u, int wr, int wc, int fr, int fq) const {
#pragma unroll
    for (int ai = 0; ai < 2; ++ai)
#pragma unroll
      for (int m = 0; m < 4; ++m) {
        const size_t row = (size_t)u.pm * 256 + 128 * ai + 64 * wr + 16 * m + fr;
#pragma unroll
        for (int bj = 0; bj < 2; ++bj)
#pragma unroll
          for (int n = 0; n < 2; ++n) {
            const int col = u.pn * 256 + 128 * bj + 32 * wc + 16 * n + 4 * fq;
            const f32x4 v = acc[ai][bj][m][n];
            const u32x2 g = *(const u32x2*)(gates + row * 3072 + goff + col);
            f32x4 o = {lo2f(g[0]) * v[0], hi2f(g[0]) * v[1], lo2f(g[1]) * v[2], hi2f(g[1]) * v[3]};
            if (src) { const u32x2 s = *(const u32x2*)(src + row * 1024 + col); o[0] += lo2f(s[0]); o[1] += hi2f(s[0]); o[2] += lo2f(s[1]); o[3] += hi2f(s[1]); }
            *(u32x2*)(dst + row * 1024 + col) = pack4(o);
          }
      }
  }
};
DI void phase3(const Params& p, unsigned char* smem, int bid, int nb) {
  unsigned char* ws = p.ws;
  if (bid < 64) {
    __syncthreads();
    gdn_scan4(p, smem, bid & 7, bid >> 3);
  } else {
    PG_LAS unsigned char* lds = (PG_LAS unsigned char*)smem;
    const bf16_t* gates = (const bf16_t*)(ws + O_GATES);
    bf16_t* part = (bf16_t*)(ws + O_PART);
    __syncthreads();
    { pg::DenseOrder S; S.init(ws + O_SGUO, ws + O_WBT, T, 1024, 512, nb - 64, bid - 64); EpiGate E{gates, 1024, nullptr, part}; pg::gemm_phase<EpiGate, pg::DenseOrder, false, true>(lds, 512, S, E); }
    asm volatile("s_waitcnt vmcnt(0)" ::: "memory");
    __builtin_amdgcn_fence(__ATOMIC_ACQUIRE, "agent");
    asm volatile("s_waitcnt vmcnt(0)" ::: "memory");
    __syncthreads();
    { pg::DenseOrder S; S.init(ws + O_XATO, ws + O_WCT, T, 1024, 512, nb - 64, bid - 64); EpiGate E{gates, 2048, part, part}; pg::gemm_phase<EpiGate, pg::DenseOrder, false, true>(lds, 512, S, E); }
  }
}

DI void phase4(const Params& p, int bid, int nb) {
  int tid = threadIdx.x; asm volatile("" : "+v"(tid));
  const int lane = tid & 63, wave = tid >> 6, fr = lane & 15, fq = lane >> 4;
  unsigned char* ws = p.ws;
  for (int it = bid; it < 512; it += nb) {
    const int item = it * 2 + (wave >> 2), tt = wave & 3;
    const int h = item & 3, cn = item >> 2;
    const size_t trow = (size_t)cn * 64 + 16 * tt + fr;
    const bf16_t* qp = (const bf16_t*)(ws + O_QP) + (size_t)item * 8192 + (16 * tt + fr) * 128;
    const bf16_t* st = (const bf16_t*)(ws + O_ST) + (size_t)item * 16384;
    const float* o0 = (const float*)(ws + O_O0) + trow * 512 + h * 128;
    bf16x8 af[4];
#pragma unroll
    for (int ks = 0; ks < 4; ++ks) af[ks] = ldfrag(qp + 32 * ks + 8 * fq);
    f32x4 acc[8];
    float ss = 0.f;
#pragma unroll
    for (int j = 0; j < 8; ++j) {
      f32x4 a = *(const f32x4*)(o0 + 16 * j + 4 * fq);
#pragma unroll
      for (int ks = 0; ks < 4; ++ks) a = mfma16(ldfrag(st + (16 * j + fr) * 128 + 32 * ks + 8 * fq), af[ks], a);
      acc[j] = a;
      ss += a[0] * a[0] + a[1] * a[1] + a[2] * a[2] + a[3] * a[3];
    }
    ss += __shfl_xor(ss, 16); ss += __shfl_xor(ss, 32);
    const float rms = rsqrtf(ss * (1.f / 128.f) + 1e-6f);
    const float* ng = p.in[I_GNG];
    const bf16_t* zs = (const bf16_t*)(ws + O_ZS) + trow * 512 + h * 128;
    bf16_t* out = (bf16_t*)(ws + O_GDNO) + trow * 512 + h * 128;
#pragma unroll
    for (int j = 0; j < 8; ++j) {
      const int e0 = 16 * j + 4 * fq;
      const f32x4 g = *(const f32x4*)(ng + e0);
      const u32x2 z = *(const u32x2*)(zs + e0);
      f32x4 o = {acc[j][0] * rms * g[0] * lo2f(z[0]), acc[j][1] * rms * g[1] * hi2f(z[0]), acc[j][2] * rms * g[2] * lo2f(z[1]), acc[j][3] * rms * g[3] * hi2f(z[1])};
      *(u32x2*)(out + e0) = pack4(o);
    }
  }
}

DI void phase5(const Params& p, unsigned char* smem, int bid, int nb) {
  unsigned char* ws = p.ws;
  PG_LAS unsigned char* lds = (PG_LAS unsigned char*)smem;
  __syncthreads();
  pg::DenseOrder S; S.init(ws + O_GDNO, ws + O_WAT, T, 1024, 512, nb, bid);
  EpiGate E{(const bf16_t*)(ws + O_GATES), 0, (const bf16_t*)(ws + O_PART), (bf16_t*)(ws + O_MERGED)};
  pg::gemm_phase<EpiGate, pg::DenseOrder, false, true>(lds, 512, S, E);
}
struct EpiX1 {
  const float* x; float* x1;
  DI void operator()(const f32x4 (&acc)[2][2][4][2], const pg::Unit& u, int wr, int wc, int fr, int fq) const {
#pragma unroll
    for (int ai = 0; ai < 2; ++ai)
#pragma unroll
      for (int m = 0; m < 4; ++m) {
        const size_t row = (size_t)u.pm * 256 + 128 * ai + 64 * wr + 16 * m + fr;
#pragma unroll
        for (int bj = 0; bj < 2; ++bj)
#pragma unroll
          for (int n = 0; n < 2; ++n) {
            const int col = u.pn * 256 + 128 * bj + 32 * wc + 16 * n + 4 * fq;
            const f32x4 v = acc[ai][bj][m][n];
            const f32x4 xv = *(const f32x4*)(x + row * 1024 + col);
            f32x4 o = {ALPHA * xv[0] + v[0], ALPHA * xv[1] + v[1], ALPHA * xv[2] + v[2], ALPHA * xv[3] + v[3]};
            *(f32x4*)(x1 + row * 1024 + col) = o;
          }
      }
  }
};
DI void phase6(const Params& p, unsigned char* smem, int bid, int nb) {
  unsigned char* ws = p.ws;
  PG_LAS unsigned char* lds = (PG_LAS unsigned char*)smem;
  __syncthreads();
  pg::DenseOrder S; S.init(ws + O_MERGED, ws + O_WOT, T, 1024, 1024, nb, bid);
  EpiX1 E{p.in[I_X], (float*)(ws + O_X1)};
  pg::gemm_phase<EpiX1, pg::DenseOrder, false, false>(lds, 1024, S, E);
}

DI void ln_row(const float* src, const float* g, const float* b, float (&v)[16], int lane) {
  float s = 0.f;
#pragma unroll
  for (int i = 0; i < 16; ++i) s += v[i];
  const float mean = wave_sum(s) * (1.f / 1024.f);
  float q = 0.f;
#pragma unroll
  for (int i = 0; i < 16; ++i) { const float d = v[i] - mean; q += d * d; }
  const float rstd = rsqrtf(wave_sum(q) * (1.f / 1024.f) + 1e-5f);
#pragma unroll
  for (int i = 0; i < 4; ++i) {
    const int k = 256 * i + 4 * lane;
    const f32x4 gg = *(const f32x4*)(g + k), bb = *(const f32x4*)(b + k);
#pragma unroll
    for (int c = 0; c < 4; ++c) v[4 * i + c] = (v[4 * i + c] - mean) * rstd * gg[c] + bb[c];
  }
}
DI void phase7(const Params& p, int bid, int nb) {
  int tid = threadIdx.x; asm volatile("" : "+v"(tid));
  const int lane = tid & 63, wave = tid >> 6;
  unsigned char* ws = p.ws;
  for (int i = bid * NTHR + tid; i < MAXSLOT; i += nb * NTHR) { ((int*)(ws + O_SLOTTOK))[i] = 0; ((int*)(ws + O_SLOTAID))[i] = -1; }
  float* x1 = (float*)(ws + O_X1);
  bf16_t* x1b = (bf16_t*)(ws + O_X1B);
  for (int row = bid * 8 + wave; row < T; row += nb * 8) {
    float v[16];
#pragma unroll
    for (int i = 0; i < 4; ++i) { const f32x4 t = *(const f32x4*)(x1 + (size_t)row * D + 256 * i + 4 * lane); v[4 * i] = t[0]; v[4 * i + 1] = t[1]; v[4 * i + 2] = t[2]; v[4 * i + 3] = t[3]; }
    ln_row(nullptr, p.in[I_LN1G], p.in[I_LN1B], v, lane);
#pragma unroll
    for (int i = 0; i < 4; ++i) {
      const f32x4 o = {v[4 * i], v[4 * i + 1], v[4 * i + 2], v[4 * i + 3]};
      *(f32x4*)(x1 + (size_t)row * D + 256 * i + 4 * lane) = o;
      *(u32x2*)(x1b + (size_t)row * D + 256 * i + 4 * lane) = pack4(o);
    }
  }
}
struct EpiLogits {
  float* logits;
  DI void operator()(const f32x4 (&acc)[2][2][4][2], const pg::Unit& u, int wr, int wc, int fr, int fq) const {
#pragma unroll
    for (int ai = 0; ai < 2; ++ai)
#pragma unroll
      for (int m = 0; m < 4; ++m) {
        const size_t row = (size_t)u.pm * 256 + 128 * ai + 64 * wr + 16 * m + fr;
#pragma unroll
        for (int bj = 0; bj < 2; ++bj)
#pragma unroll
          for (int n = 0; n < 2; ++n) *(f32x4*)(logits + row * 256 + 128 * bj + 32 * wc + 16 * n + 4 * fq) = acc[ai][bj][m][n];
      }
  }
};
DI void phase8(const Params& p, unsigned char* smem, int bid, int nb) {
  unsigned char* ws = p.ws;
  PG_LAS unsigned char* lds = (PG_LAS unsigned char*)smem;
  __syncthreads();
  pg::DenseOrder S; S.init(ws + O_X1B, ws + O_ROUT, T, 256, 1024, nb, bid);
  EpiLogits E{(float*)(ws + O_LOGITS)};
  pg::gemm_phase<EpiLogits, pg::DenseOrder, false, false>(lds, 1024, S, E);
}
DI void phase9(const Params& p, int bid, int nb) {
  int tid = threadIdx.x; asm volatile("" : "+v"(tid));
  const int lane = tid & 63, wave = tid >> 6;
  unsigned char* ws = p.ws;
  const float* logits = (const float*)(ws + O_LOGITS);
  int* counts = (int*)(ws + O_CTRL);
  const int g = lane & 7, tsub = lane >> 3;
  const float NEG = -__builtin_inff();
  float bias[32];
#pragma unroll
  for (int j4 = 0; j4 < 8; ++j4) { const f32x4 b4 = *(const f32x4*)(p.in[I_RB] + 32 * g + 4 * j4); bias[4 * j4] = b4[0]; bias[4 * j4 + 1] = b4[1]; bias[4 * j4 + 2] = b4[2]; bias[4 * j4 + 3] = b4[3]; }
  for (int tok0 = (bid * 8 + wave) * 8; tok0 < T; tok0 += nb * 64) {
    const int tok = tok0 + tsub;
    float sc[32], bz[32];
#pragma unroll
    for (int j4 = 0; j4 < 8; ++j4) {
      const f32x4 l4 = *(const f32x4*)(logits + (size_t)tok * 256 + 32 * g + 4 * j4);
#pragma unroll
      for (int c = 0; c < 4; ++c) { sc[4 * j4 + c] = sigmoidf_(l4[c]); bz[4 * j4 + c] = sc[4 * j4 + c] + bias[4 * j4 + c]; }
    }
    float m1 = NEG, m2 = NEG;
#pragma unroll
    for (int j = 0; j < 32; ++j) { const float v = bz[j]; if (v > m1) { m2 = m1; m1 = v; } else if (v > m2) m2 = v; }
    const float gs = m1 + m2;
    int rank = 0;
#pragma unroll
    for (int gg = 0; gg < 8; ++gg) { const float og = __shfl(gs, (lane & ~7) | gg); rank += ((og > gs) || (og == gs && gg < g)) ? 1 : 0; }
    if (rank >= 4) {
#pragma unroll
      for (int j = 0; j < 32; ++j) bz[j] = NEG;
    }
    int myidx = 0; float mysc = 0.f, ssum = 0.f;
#pragma unroll 1
    for (int k = 0; k < 8; ++k) {
      float bv = bz[0], bs = sc[0]; int bi = 0;
#pragma unroll
      for (int j = 1; j < 32; ++j) if (bz[j] > bv) { bv = bz[j]; bi = j; bs = sc[j]; }
      float rv = bv, rs = bs; int ri = 32 * g + bi;
#pragma unroll
      for (int o = 1; o < 8; o <<= 1) {
        const float ov = __shfl_xor(rv, o), os = __shfl_xor(rs, o); const int oi = __shfl_xor(ri, o);
        if (ov > rv || (ov == rv && oi < ri)) { rv = ov; ri = oi; rs = os; }
      }
      if ((ri >> 5) == g) {
        const int wj = ri & 31;
#pragma unroll
        for (int j = 0; j < 32; ++j) if (j == wj) bz[j] = NEG;
      }
      ssum += rs;
      if (g == k) { myidx = ri; mysc = rs; }
    }
    const int pos = atomicAdd(&counts[myidx * CSTR], 1);
    ((int*)(ws + O_TKIDX))[(size_t)tok * 8 + g] = myidx;
    ((float*)(ws + O_TKW))[(size_t)tok * 8 + g] = mysc / ssum * 2.5f;
    ((int*)(ws + O_TKPOS))[(size_t)tok * 8 + g] = pos;
  }
}
DI void build_tile_start(const Params& p, int* ts) {
  const int tid = threadIdx.x;
  const int* counts = (const int*)(p.ws + O_CTRL);
  __syncthreads();
  if (tid < 256) ts[300 + tid] = (counts[tid * CSTR] + 127) >> 7;
  __syncthreads();
  if (tid == 0) { int s = 0; for (int e = 0; e < 256; ++e) { ts[e] = s; s += ts[300 + e]; } ts[256] = s; }
  __syncthreads();
}
DI void phase10(const Params& p, unsigned char* smem, int bid, int nb) {
  int* ts = (int*)smem;
  build_tile_start(p, ts);
  unsigned char* ws = p.ws;
  const int* tkidx = (const int*)(ws + O_TKIDX); const int* tkpos = (const int*)(ws + O_TKPOS); const float* tkw = (const float*)(ws + O_TKW);
  int* slottok = (int*)(ws + O_SLOTTOK); float* slotw = (float*)(ws + O_SLOTW); int* slotaid = (int*)(ws + O_SLOTAID);
  for (int i = bid * NTHR + threadIdx.x; i < T * 8; i += nb * NTHR) {
    const int e = tkidx[i];
    const int slot = ts[e] * 128 + tkpos[i];
    slottok[slot] = i >> 3; slotw[slot] = tkw[i]; slotaid[slot] = i;
  }
}

DI int find_expert(const int* ts, int ti) { int lo = 0, hi = 255; while (lo < hi) { const int mid = (lo + hi + 1) >> 1; if (ts[mid] <= ti) lo = mid; else hi = mid - 1; } return lo; }

struct MoeUpF {
  const int* ts; unsigned char* ws; const float* wg; const float* wu; int ntile, G, c;
  DI bool next(int i, UnitF& u) const {
    const int L = i * G + (((G & 7) == 0) ? (c & 7) * (G >> 3) + (c >> 3) : c);
    if (L >= ntile * 2) return false;
    const int pn = L / ntile, ti = L - pn * ntile;
    const int e = find_expert(ts, ti);
    u.A = (const bf16_t*)(ws + O_X1B); u.rows = (const int*)(ws + O_SLOTTOK) + ti * 128; u.m0 = ti * 128; u.pn = pn; u.e = e;
    u.W0 = wg + (size_t)e * 262144 + 128 * pn; u.W1 = wu + (size_t)e * 262144 + 128 * pn;
    return true;
  }
};
struct MoeDownF {
  const int* ts; unsigned char* ws; const float* wd; int ntile, G, c;
  DI bool next(int i, UnitF& u) const {
    const int L = i * G + (((G & 7) == 0) ? (c & 7) * (G >> 3) + (c >> 3) : c);
    if (L >= ntile * 4) return false;
    const int pn = L / ntile, ti = L - pn * ntile;
    const int e = find_expert(ts, ti);
    u.A = (const bf16_t*)(ws + O_ACT); u.rows = nullptr; u.m0 = ti * 128; u.pn = pn; u.e = e;
    u.W0 = wd + (size_t)e * 262144 + 256 * pn; u.W1 = u.W0 + 128;
    return true;
  }
};
struct EpiActF {
  bf16_t* actp;
  struct Pre { int dummy; };
  DI void prefetch(const UnitF&, int, int, Pre& p) const { p.dummy = 0; }
  DI void operator()(const f32x4 (&acc)[4][4], const UnitF& u, int wr, int wc, int fr, int fq, const Pre&, unsigned char* xch) const {
    if (wc >= 2) {
#pragma unroll
      for (int m = 0; m < 4; ++m) {
        unsigned char* dst = xch + (64 * wr + 16 * m + fr) * 256 + (((8 * (wc & 1) + 2 * fq) ^ (2 * (fr & 7))) << 4);
        u32x4 o0 = {pk2(acc[m][0][0], acc[m][1][0]), pk2(acc[m][2][0], acc[m][3][0]), pk2(acc[m][0][1], acc[m][1][1]), pk2(acc[m][2][1], acc[m][3][1])};
        u32x4 o1 = {pk2(acc[m][0][2], acc[m][1][2]), pk2(acc[m][2][2], acc[m][3][2]), pk2(acc[m][0][3], acc[m][1][3]), pk2(acc[m][2][3], acc[m][3][3])};
        *(u32x4*)dst = o0; *(u32x4*)(dst + 16) = o1;
      }
    }
    asm volatile("s_waitcnt lgkmcnt(0)" ::: "memory"); __builtin_amdgcn_s_barrier(); asm volatile("" ::: "memory");
    if (wc < 2) {
#pragma unroll
      for (int m = 0; m < 4; ++m) {
        const unsigned char* srcp = xch + (64 * wr + 16 * m + fr) * 256 + (((8 * wc + 2 * fq) ^ (2 * (fr & 7))) << 4);
        const u32x4 u0 = *(const u32x4*)srcp, u1 = *(const u32x4*)(srcp + 16);
        const size_t row = (size_t)u.m0 + 64 * wr + 16 * m + fr;
        u32x4 o0, o1;
#pragma unroll
        for (int r = 0; r < 2; ++r) {
          o0[2 * r] = pk2(siluf_(acc[m][0][r]) * lo2f(u0[2 * r]), siluf_(acc[m][1][r]) * hi2f(u0[2 * r]));
          o0[2 * r + 1] = pk2(siluf_(acc[m][2][r]) * lo2f(u0[2 * r + 1]), siluf_(acc[m][3][r]) * hi2f(u0[2 * r + 1]));
          o1[2 * r] = pk2(siluf_(acc[m][0][2 + r]) * lo2f(u1[2 * r]), siluf_(acc[m][1][2 + r]) * hi2f(u1[2 * r]));
          o1[2 * r + 1] = pk2(siluf_(acc[m][2][2 + r]) * lo2f(u1[2 * r + 1]), siluf_(acc[m][3][2 + r]) * hi2f(u1[2 * r + 1]));
        }
        bf16_t* dst = actp + row * 256 + 128 * u.pn + 64 * wc + 16 * fq;
        *(u32x4*)dst = o0; *(u32x4*)(dst + 8) = o1;
      }
    }
    asm volatile("s_waitcnt lgkmcnt(0)" ::: "memory"); __builtin_amdgcn_s_barrier(); asm volatile("" ::: "memory");
  }
};
struct EpiDownF {
  const int* slotaid; const float* slotw; unsigned char* ybase;
  struct Pre { int aid[4]; float ww[4]; };
  DI void prefetch(const UnitF& u, int wr, int fr, Pre& p) const {
    const unsigned slot0 = (unsigned)u.m0 + 64u * wr + fr;
#pragma unroll
    for (int m = 0; m < 4; ++m) { p.aid[m] = slotaid[slot0 + 16u * m]; p.ww[m] = slotw[slot0 + 16u * m]; }
  }
  DI void operator()(const f32x4 (&acc)[4][4], const UnitF& u, int wr, int wc, int fr, int fq, const Pre& p, unsigned char*) const {
    const unsigned colb = (unsigned)u.pn * 256u + 64u * wc + 16u * fq;
#pragma unroll
    for (int m = 0; m < 4; ++m) {
      if (p.aid[m] >= 0) {
        const unsigned off = (unsigned)p.aid[m] * 1024u + colb;
        const float sw = p.ww[m] * 64.0f;
        u32x4 o;
#pragma unroll
        for (int r = 0; r < 4; ++r) {
          unsigned w_ = 0u;
          w_ = __builtin_amdgcn_cvt_pk_fp8_f32(acc[m][0][r] * sw, acc[m][1][r] * sw, w_, false);
          w_ = __builtin_amdgcn_cvt_pk_fp8_f32(acc[m][2][r] * sw, acc[m][3][r] * sw, w_, true);
          o[r] = w_;
        }
        *(u32x4*)(ybase + (size_t)off) = o;
      }
    }
  }
};
struct EpiAct {
  bf16_t* actp;
  DI void operator()(const f32x4 (&acc)[2][2][4][2], const pg::Unit& u, int wr, int wc, int fr, int fq) const {
#pragma unroll
    for (int ai = 0; ai < 2; ++ai)
#pragma unroll
      for (int m = 0; m < 4; ++m) {
        const size_t row = (size_t)u.pm * 256 + 128 * ai + 64 * wr + 16 * m + fr;
#pragma unroll
        for (int bj = 0; bj < 2; ++bj) {
          const int blk = 8 * u.pn + 4 * bj + wc;
          const f32x4 g = acc[ai][bj][m][0], uu = acc[ai][bj][m][1];
          f32x4 o = {siluf_(g[0]) * uu[0], siluf_(g[1]) * uu[1], siluf_(g[2]) * uu[2], siluf_(g[3]) * uu[3]};
          *(u32x2*)(actp + row * 256 + blk * 16 + 4 * fq) = pack4(o);
        }
      }
  }
};
struct EpiBf16Out {
  bf16_t* dst;
  DI void operator()(const f32x4 (&acc)[2][2][4][2], const pg::Unit& u, int wr, int wc, int fr, int fq) const {
#pragma unroll
    for (int ai = 0; ai < 2; ++ai)
#pragma unroll
      for (int m = 0; m < 4; ++m) {
        const size_t row = (size_t)u.pm * 256 + 128 * ai + 64 * wr + 16 * m + fr;
#pragma unroll
        for (int bj = 0; bj < 2; ++bj)
#pragma unroll
          for (int n = 0; n < 2; ++n) *(u32x2*)(dst + row * 1024 + u.pn * 256 + 128 * bj + 32 * wc + 16 * n + 4 * fq) = pack4(acc[ai][bj][m][n]);
      }
  }
};
DI void phase11(const Params& p, unsigned char* smem, int bid, int nb) {
  unsigned char* ws = p.ws;
  int* ts = (int*)(smem + 131072);
  build_tile_start(p, ts);
  { MoeUpF S{ts, ws, p.in[I_WG], p.in[I_WU], ts[256], nb, bid}; EpiActF E{(bf16_t*)(ws + O_ACT)}; gemmF_phase<false, EpiActF, MoeUpF>(smem, 1024, 1024, 256, S, E); }
  __syncthreads();
  PG_LAS unsigned char* lds = (PG_LAS unsigned char*)smem;
  { pg::DenseOrder S; S.init(ws + O_X1B, ws + O_WSGU, T, 512, 1024, nb, bid); EpiAct E{(bf16_t*)(ws + O_ACTSH)}; pg::gemm_phase<EpiAct, pg::DenseOrder, false, true>(lds, 1024, S, E); }
}
DI void phase12(const Params& p, unsigned char* smem, int bid, int nb) {
  unsigned char* ws = p.ws;
  int* ts = (int*)(smem + 131072);
  build_tile_start(p, ts);
  { MoeDownF S{ts, ws, p.in[I_WDN], ts[256], nb, bid}; EpiDownF E{(const int*)(ws + O_SLOTAID), (const float*)(ws + O_SLOTW), ws + O_Y}; gemmF_phase<false, EpiDownF, MoeDownF>(smem, 256, 256, 1024, S, E); }
  __syncthreads();
  PG_LAS unsigned char* lds = (PG_LAS unsigned char*)smem;
  { pg::DenseOrder S; S.init(ws + O_ACTSH, ws + O_WSD, T, 1024, 256, nb, bid); EpiBf16Out E{(bf16_t*)(ws + O_YSH)}; pg::gemm_phase<EpiBf16Out, pg::DenseOrder, false, true>(lds, 256, S, E); }
}
DI void phase13(const Params& p, int bid, int nb) {
  int tid = threadIdx.x; asm volatile("" : "+v"(tid));
  const int lane = tid & 63, wave = tid >> 6;
  unsigned char* ws = p.ws;
  const float* x1 = (const float*)(ws + O_X1);
  const bf16_t* ysh = (const bf16_t*)(ws + O_YSH);
  const unsigned char* y8 = ws + O_Y;
  for (int row = bid * 8 + wave; row < T; row += nb * 8) {
    float v[16];
#pragma unroll
    for (int i = 0; i < 4; ++i) {
      const int k = 256 * i + 4 * lane;
      const f32x4 t = *(const f32x4*)(x1 + (size_t)row * D + k);
      const u32x2 s = *(const u32x2*)(ysh + (size_t)row * D + k);
      v[4 * i] = ALPHA * t[0] + lo2f(s[0]); v[4 * i + 1] = ALPHA * t[1] + hi2f(s[0]); v[4 * i + 2] = ALPHA * t[2] + lo2f(s[1]); v[4 * i + 3] = ALPHA * t[3] + hi2f(s[1]);
    }
    float rs[16];
#pragma unroll
    for (int i = 0; i < 16; ++i) rs[i] = 0.f;
#pragma unroll
    for (int k8 = 0; k8 < 8; ++k8) {
#pragma unroll
      for (int i = 0; i < 4; ++i) {
        const unsigned s = *(const unsigned*)(y8 + ((size_t)row * 8 + k8) * 1024 + 256 * i + 4 * lane);
        const f32x2_ lo = __builtin_amdgcn_cvt_pk_f32_fp8(s, false), hi = __builtin_amdgcn_cvt_pk_f32_fp8(s, true);
        rs[4 * i] += lo[0]; rs[4 * i + 1] += lo[1]; rs[4 * i + 2] += hi[0]; rs[4 * i + 3] += hi[1];
      }
    }
#pragma unroll
    for (int i = 0; i < 16; ++i) v[i] += rs[i] * (1.0f / 64.0f);
    ln_row(nullptr, p.in[I_LN2G], p.in[I_LN2B], v, lane);
#pragma unroll
    for (int i = 0; i < 4; ++i) { const f32x4 o = {v[4 * i], v[4 * i + 1], v[4 * i + 2], v[4 * i + 3]}; *(f32x4*)(p.out + (size_t)row * D + 256 * i + 4 * lane) = o; }
  }
}

DI void load_params(Params& lp, const unsigned char* smem) {
  const unsigned* t = (const unsigned*)(smem + PTAB_OFF);
#pragma unroll
  for (int i = 0; i < 28; ++i) lp.in[i] = (const float*)(GAS const float*)(((unsigned long long)(unsigned)__builtin_amdgcn_readfirstlane((int)t[2 * i + 1]) << 32) | (unsigned)__builtin_amdgcn_readfirstlane((int)t[2 * i]));
  lp.out = (float*)(GAS float*)(((unsigned long long)(unsigned)__builtin_amdgcn_readfirstlane((int)t[57]) << 32) | (unsigned)__builtin_amdgcn_readfirstlane((int)t[56]));
  lp.ws = (unsigned char*)(GAS unsigned char*)(((unsigned long long)(unsigned)__builtin_amdgcn_readfirstlane((int)t[59]) << 32) | (unsigned)__builtin_amdgcn_readfirstlane((int)t[58]));
}
__global__ void __launch_bounds__(NTHR) mega_kernel(Params pk) {
  extern __shared__ __attribute__((aligned(16))) unsigned char smem[];
  cg::grid_group grid = cg::this_grid();
  const int bid = blockIdx.x, nb = gridDim.x;
  volatile LAS unsigned* bst = (volatile LAS unsigned*)(smem + LDS_BYTES - 16);
  if (threadIdx.x < 4) bst[threadIdx.x] = 0u;
  if (threadIdx.x < 30) {
    const __attribute__((address_space(4))) unsigned long long* ka = (const __attribute__((address_space(4))) unsigned long long*)__builtin_amdgcn_kernarg_segment_ptr();
    ((unsigned long long*)(smem + PTAB_OFF))[threadIdx.x] = ka[threadIdx.x];
  }
  unsigned* barw = (unsigned*)(pk.ws + O_BAR);
  __syncthreads();
  XcdBarrier xb = xcd_barrier_post(barw, bst);
#define GSYNC() xcd_barrier(xb)
#define RUNP(k, call) do { { Params p; load_params(p, smem); call; } GSYNC(); if (DUPMASK & (1 << (k))) { { Params p; load_params(p, smem); call; } GSYNC(); } } while (0)
  { Params p; load_params(p, smem); phase0(p, smem, bid, nb); } grid.sync();
  RUNP(1, phase1(p, smem, bid, nb));
  RUNP(2, phase2(p, smem, bid, nb));
  RUNP(3, phase3(p, smem, bid, nb));
  RUNP(4, phase4(p, bid, nb));
  RUNP(5, phase5(p, smem, bid, nb));
  RUNP(6, phase6(p, smem, bid, nb));
  RUNP(14, phase7(p, bid, nb));
  if (DUPMASK & (1 << 7)) { { Params p; load_params(p, smem); phase6(p, smem, bid, nb); } GSYNC(); { Params p; load_params(p, smem); phase7(p, bid, nb); } GSYNC(); }
  RUNP(8, phase8(p, smem, bid, nb));
  RUNP(14, phase9(p, bid, nb));
  if (DUPMASK & (1 << 9)) { { Params p; load_params(p, smem); if (bid == 0 && threadIdx.x < 256) ((int*)(p.ws + O_CTRL))[threadIdx.x * CSTR] = 0; } GSYNC(); { Params p; load_params(p, smem); phase9(p, bid, nb); } GSYNC(); }
  RUNP(10, phase10(p, smem, bid, nb));
  RUNP(11, phase11(p, smem, bid, nb));
  RUNP(12, phase12(p, smem, bid, nb));
  { Params p; load_params(p, smem); phase13(p, bid, nb); }
  if (DUPMASK & (1 << 13)) { GSYNC(); Params p; load_params(p, smem); phase13(p, bid, nb); }
  if (DUPMASK & (1 << 15)) { for (int i = 0; i < 10; ++i) GSYNC(); }
}

extern "C" void kernel_launch(void* const* d_in, const int* in_sizes, int n_in, void* d_out, int out_size, void* d_ws, size_t ws_size, hipStream_t stream) {
  if (n_in != 28 || ws_size < WS_NEED) { fprintf(stderr, "kernel_launch: unexpected inputs (%d) or workspace (%zu < %zu)\n", n_in, ws_size, (size_t)WS_NEED); return; }
  static int grid_blocks = 0;
  if (!grid_blocks) {
    int dev = 0, cus = 0, per_cu = 0;
    (void)hipGetDevice(&dev);
    (void)hipDeviceGetAttribute(&cus, hipDeviceAttributeMultiprocessorCount, dev);
    (void)hipFuncSetAttribute((const void*)mega_kernel, hipFuncAttributeMaxDynamicSharedMemorySize, LDS_BYTES);
    (void)hipOccupancyMaxActiveBlocksPerMultiprocessor(&per_cu, (const void*)mega_kernel, NTHR, LDS_BYTES);
    if (per_cu < 1) per_cu = 1;
    if (per_cu > 1) per_cu = 1;
    grid_blocks = cus * per_cu;
    if (grid_blocks < 32) grid_blocks = 32;
  }
  Params p{};
  for (int i = 0; i < 28; ++i) p.in[i] = (const float*)d_in[i];
  p.out = (float*)d_out; p.ws = (unsigned char*)d_ws;
  (void)hipMemsetAsync((unsigned char*)d_ws + O_BAR, 0, 16384 + 256, stream);
  void* args[] = {&p};
  hipError_t e = hipLaunchCooperativeKernel((const void*)mega_kernel, dim3(grid_blocks), dim3(NTHR), args, LDS_BYTES, stream);
  if (e != hipSuccess) fprintf(stderr, "cooperative launch failed: %s (grid %d)\n", hipGetErrorString(e), grid_blocks);
}
```

```cpp
#include <hip/hip_runtime.h>
#include <hip/hip_cooperative_groups.h>
#include <stdint.h>
#include <stdio.h>
namespace cg = cooperative_groups;

#define DI __device__ __forceinline__
#define LAS __attribute__((address_space(3)))
#define GAS __attribute__((address_space(1)))
typedef unsigned short bf16_t;
typedef short bf16x8 __attribute__((ext_vector_type(8)));
typedef float f32x4 __attribute__((ext_vector_type(4)));
typedef unsigned u32x4 __attribute__((ext_vector_type(4)));
typedef unsigned u32x2 __attribute__((ext_vector_type(2)));

#ifndef DUPMASK
#define DUPMASK 0
#endif
constexpr int NTHR = 512;
constexpr int T = 16384, SEQ = 8192, D = 1024;
constexpr int NPROJ = 6656;
constexpr int DIN = 6664;
constexpr int NEXP = 256, DEXP = 256;
constexpr int MAXSLOT = 131072 + 256 * 128;
constexpr float ALPHA = 1.189207115002721f;
constexpr int LDS_BYTES = 157696;

constexpr size_t MB = 1u << 20;
constexpr size_t O_WGU = 0;
constexpr size_t O_WD = 256 * MB;
constexpr size_t O_WSGU = 384 * MB;
constexpr size_t O_WSD = 385 * MB;
constexpr size_t O_ROUT = 385 * MB + 512 * 1024;
constexpr size_t O_CTRL = 386 * MB;
constexpr size_t O_BAR = 386 * MB + 128 * 1024;
constexpr int CSTR = 64;
constexpr size_t O_SUBBAR = 386 * MB + 128 * 1024 + 16384;
constexpr size_t O_IDENT = 386 * MB + 256 * 1024;
constexpr size_t O_X1 = 387 * MB;
constexpr size_t O_X1B = 451 * MB;
constexpr size_t R0 = 483 * MB;
constexpr size_t O_XB = R0 + 0;
constexpr size_t O_ST = R0 + 0;
constexpr size_t O_WINT = R0 + 32 * MB;
constexpr size_t O_WAT = R0 + 45 * MB;
constexpr size_t O_WBT = R0 + 46 * MB;
constexpr size_t O_WCT = R0 + 47 * MB;
constexpr size_t O_WOT = R0 + 48 * MB;
constexpr size_t O_WMKV = R0 + 50 * MB;
constexpr size_t O_MEMB = R0 + 52 * MB;
constexpr size_t O_SGUW = R0 + 53 * MB;
constexpr size_t O_AB = R0 + 53 * MB + 512 * 1024;
constexpr size_t O_MEMK = R0 + 54 * MB;
constexpr size_t O_MEMVT = R0 + 54 * MB + 512 * 1024;
constexpr size_t O_QKV = R0 + 55 * MB;
constexpr size_t O_PART = R0 + 55 * MB;
constexpr size_t O_ZS = R0 + 103 * MB;
constexpr size_t O_UVG = R0 + 119 * MB;
constexpr size_t O_MERGED = R0 + 119 * MB;
constexpr size_t O_XQ = R0 + 151 * MB;
constexpr size_t O_GATES = R0 + 167 * MB;
constexpr size_t O_MP = R0 + 263 * MB;
constexpr size_t O_BC = R0 + 295 * MB;
constexpr size_t O_O0 = R0 + 359 * MB;
constexpr size_t O_QP = R0 + 391 * MB;
constexpr size_t O_GL = R0 + 407 * MB;
constexpr size_t O_GDNO = R0 + 408 * MB;
constexpr size_t O_SGUO = R0 + 424 * MB;
constexpr size_t O_XATO = R0 + 440 * MB;
constexpr size_t O_LOGITS = R0 + 0;
constexpr size_t O_TKIDX = R0 + 16 * MB;
constexpr size_t O_TKW = R0 + 16 * MB + 512 * 1024;
constexpr size_t O_TKPOS = R0 + 17 * MB;
constexpr size_t O_SLOTTOK = R0 + 18 * MB;
constexpr size_t O_SLOTW = R0 + 19 * MB;
constexpr size_t O_SLOTAID = R0 + 20 * MB;
constexpr size_t O_ACT = R0 + 21 * MB;
constexpr size_t O_ACTSH = R0 + 181 * MB;
constexpr size_t O_YSH = R0 + 189 * MB;
constexpr size_t O_Y = R0 + 221 * MB;
constexpr size_t WS_NEED = R0 + 477 * MB;

struct Params {
  const float* in[28];
  float* out;
  unsigned char* ws;
};
enum { I_X = 0, I_MEM, I_WIN, I_CONVW, I_ALOG, I_DTB, I_GNG, I_WA, I_SLNG, I_SLNB, I_SGUW, I_SGUB, I_WB, I_WMKV, I_WC, I_WO,
       I_LN1G, I_LN1B, I_RW, I_RB, I_WG, I_WU, I_WDN, I_WSG, I_WSU, I_WSD, I_LN2G, I_LN2B };

constexpr int PTAB_OFF = 156672;
DI float bf2f(bf16_t h) { return __uint_as_float(((unsigned)h) << 16); }
DI bf16_t f2bf(float f) { unsigned u = __float_as_uint(f); u += 0x7fffu + ((u >> 16) & 1u); return (bf16_t)(u >> 16); }
typedef float f32x2_ __attribute__((ext_vector_type(2)));
typedef __bf16 bf16x2_ __attribute__((ext_vector_type(2)));
DI unsigned pk2(float lo, float hi) { f32x2_ v = {lo, hi}; return __builtin_bit_cast(unsigned, __builtin_convertvector(v, bf16x2_)); }
DI float lo2f(unsigned u) { return __uint_as_float(u << 16); }
DI float hi2f(unsigned u) { return __uint_as_float(u & 0xffff0000u); }
DI float sigmoidf_(float x) { return __builtin_amdgcn_rcpf(1.f + __builtin_amdgcn_exp2f(-1.4426950408889634f * x)); }
DI float siluf_(float x) { return x * sigmoidf_(x); }
DI float geluf_(float x) { return x * sigmoidf_(1.5957691216057308f * (x + 0.044715f * x * x * x)); }
DI float softplusf_(float x) { return fmaxf(x, 0.f) + log1pf(__expf(-fabsf(x))); }
DI float wave_sum(float v) {
#pragma unroll
  for (int o = 32; o; o >>= 1) v += __shfl_xor(v, o);
  return v;
}
DI f32x4 mfma16(bf16x8 a, bf16x8 b, f32x4 c) { return __builtin_amdgcn_mfma_f32_16x16x32_bf16(a, b, c, 0, 0, 0); }
DI bf16x8 ldfrag(const void* p) { return __builtin_bit_cast(bf16x8, *(const u32x4*)p); }
DI bf16x8 pack8(f32x4 a, f32x4 b) { u32x4 r = {pk2(a[0], a[1]), pk2(a[2], a[3]), pk2(b[0], b[1]), pk2(b[2], b[3])}; return __builtin_bit_cast(bf16x8, r); }
DI u32x2 pack4(f32x4 a) { u32x2 r = {pk2(a[0], a[1]), pk2(a[2], a[3])}; return r; }
DI int sw128(int row, int chunk) { return row * 128 + ((chunk ^ (row & 7)) << 4); }
DI int sw256(int row, int chunk) { return row * 256 + ((chunk ^ (row & 15)) << 4); }

namespace pg {
#define PG_LAS __attribute__((address_space(3)))
constexpr int BM = 256, BK = 64, HALF = 128, HTB = HALF * BK * 2, NXCD = 8, WGM = 8;
DI int lds_byte(int r, int c) { const int st = (r >> 4) * 2 + (c >> 5), rr = r & 15, cc = c & 31, ob = rr * 64 + cc * 2; return st * 1024 + (ob ^ (((ob >> 9) & 1) << 5)); }
DI void stage_rc(int b, int& R, int& C) { const int st = b / 1024, sb = b % 1024, swz = sb ^ (((sb >> 9) & 1) << 5); R = (st >> 1) * 16 + swz / 64; C = (st & 1) * 32 + (swz % 64) / 2; }

struct Unit { const char* a; const char* b; const int* rows; int pm, pn, e; };

struct DenseOrder {
  const char* A; const char* B; int nM, nN, nwg, G, c; size_t tstep;
  DI void init(const void* A_, const void* B_, int M, int N, int K, int G_, int c_) { A = (const char*)A_; B = (const char*)B_; nM = M / BM; nN = N / BM; nwg = nM * nN; G = G_; c = c_; tstep = (size_t)BM * K * 2; }
  DI bool next(int i, Unit& u) const { const long L = (long)i * G + c; if (L >= nwg) return false; unit_of(L, u); return true; }
  DI void unit_of(long L, Unit& u) const {
    int wgid = (int)L; { const int q = nwg / NXCD, r = nwg % NXCD, xcd = wgid % NXCD, off = wgid / NXCD; wgid = (xcd < r ? xcd * (q + 1) : r * (q + 1) + (xcd - r) * q) + off; }
    const int nig = WGM * nN, gid = wgid / nig, fm = gid * WGM, gsz = (nM - fm) < WGM ? (nM - fm) : WGM;
    u.pm = fm + ((wgid % nig) % gsz); u.pn = (wgid % nig) / gsz; u.e = 0; u.rows = nullptr;
    u.a = A + (size_t)u.pm * tstep; u.b = B + (size_t)u.pn * tstep;
  }
};

template <class Epi, class Sched, bool GATHER, bool ALIGN_EPI>
DI void gemm_phase(PG_LAS unsigned char* lds, const int K, const Sched& S, const Epi& E) {
  int tid = threadIdx.x; asm volatile("" : "+v"(tid));
  const int wid = __builtin_amdgcn_readfirstlane(tid >> 6), lane = tid & 63, wr = wid >> 2, wc = wid & 3, fr = lane & 15, fq = lane >> 4;
  const int nt = K / BK;
  int Rr[2], Cc[2];
  unsigned voffB[2];
#pragma unroll
  for (int i = 0; i < 2; ++i) { stage_rc(tid * 16 + i * 8192, Rr[i], Cc[i]); voffB[i] = (unsigned)(Rr[i] * K + Cc[i]) * 2u; }
  const size_t kstep = (size_t)(BK * 2);
  const size_t hstep = (size_t)HALF * K * 2;
  const unsigned ldsw = (unsigned)wid * 1024u;
  const int aoff = lds_byte(wr * 64 + fr, fq * 8), boff = lds_byte(wc * 32 + fr, fq * 8);
#define PG_SA(b, h) (((b) * 2 + (h)) * HTB)
#define PG_SB(b, h) ((4 + (b) * 2 + (h)) * HTB)
#define PG_STAGE(bufoff, gbase, v0, v1) do { \
    __builtin_amdgcn_global_load_lds((const unsigned*)((const char*)(gbase) + (v0)), (PG_LAS unsigned*)(lds + (bufoff) + ldsw), 16, 0, 0); \
    __builtin_amdgcn_global_load_lds((const unsigned*)((const char*)(gbase) + (v1)), (PG_LAS unsigned*)(lds + (bufoff) + ldsw + 8192), 16, 0, 0); } while (0)
#define PG_LDA(dst, b, h) do { _Pragma("unroll") for (int m = 0; m < 4; ++m) _Pragma("unroll") for (int k = 0; k < 2; ++k) dst[m][k] = *(const PG_LAS bf16x8*)(lds + PG_SA(b, h) + aoff + m * 2048 + k * 1024); } while (0)
#define PG_LDB(dst, b, h) do { _Pragma("unroll") for (int n = 0; n < 2; ++n) _Pragma("unroll") for (int k = 0; k < 2; ++k) dst[n][k] = *(const PG_LAS bf16x8*)(lds + PG_SB(b, h) + boff + n * 2048 + k * 1024); } while (0)
#define PG_MMA(ai, bj, At, Bt) do { __builtin_amdgcn_s_setprio(1); _Pragma("unroll") for (int m = 0; m < 4; ++m) _Pragma("unroll") for (int n = 0; n < 2; ++n) _Pragma("unroll") for (int k = 0; k < 2; ++k) \
    acc[ai][bj][m][n] = __builtin_amdgcn_mfma_f32_16x16x32_bf16(Bt[n][k], At[m][k], acc[ai][bj][m][n], 0, 0, 0); __builtin_amdgcn_s_setprio(0); } while (0)
#define PG_WAIT_V(n) asm volatile("s_waitcnt vmcnt(" #n ")" ::: "memory")
#define PG_WAIT_L(n) asm volatile("s_waitcnt lgkmcnt(" #n ")" ::: "memory")
#define PG_BAR __builtin_amdgcn_s_barrier()
#define PG_SCHED __builtin_amdgcn_sched_barrier(0)
#define PG_AOFFS(u, o00, o01, o10, o11) do { if (GATHER) { \
      o00 = (unsigned)(u).rows[Rr[0]] * (unsigned)(K * 2) + (unsigned)Cc[0] * 2u; o01 = (unsigned)(u).rows[Rr[1]] * (unsigned)(K * 2) + (unsigned)Cc[1] * 2u; \
      o10 = (unsigned)(u).rows[128 + Rr[0]] * (unsigned)(K * 2) + (unsigned)Cc[0] * 2u; o11 = (unsigned)(u).rows[128 + Rr[1]] * (unsigned)(K * 2) + (unsigned)Cc[1] * 2u; \
    } else { o00 = voffB[0]; o01 = voffB[1]; o10 = voffB[0] + (unsigned)hstep; o11 = voffB[1] + (unsigned)hstep; } } while (0)
  Unit cur, nxt; int ui = 0;
  if (!S.next(0, cur)) return;
  f32x4 acc[2][2][4][2];
#pragma unroll
  for (int a = 0; a < 2; ++a)
#pragma unroll
    for (int b = 0; b < 2; ++b)
#pragma unroll
      for (int m = 0; m < 4; ++m)
#pragma unroll
        for (int n = 0; n < 2; ++n) acc[a][b][m][n] = (f32x4){0.f, 0.f, 0.f, 0.f};
  bf16x8 At[4][2], B0[2][2], B1[2][2];
  const char* cA = cur.a; const char* cB = cur.b;
  unsigned c00, c01, c10, c11;
  PG_AOFFS(cur, c00, c01, c10, c11);
  const unsigned vb0 = voffB[0], vb1 = voffB[1];
  PG_STAGE(PG_SB(0, 0), cB, vb0, vb1); PG_STAGE(PG_SB(0, 1), cB + hstep, vb0, vb1); PG_STAGE(PG_SA(0, 0), cA, c00, c01); PG_STAGE(PG_SA(0, 1), cA, c10, c11);
  if (wr == 1) PG_BAR;
  PG_WAIT_V(2); PG_BAR;
  PG_STAGE(PG_SB(1, 0), cB + kstep, vb0, vb1); PG_STAGE(PG_SA(1, 0), cA + kstep, c00, c01); PG_STAGE(PG_SB(1, 1), cB + hstep + kstep, vb0, vb1);
  PG_WAIT_V(6); PG_BAR;
  for (;;) {
    const bool has_next = S.next(ui + 1, nxt);
    const char* nA = has_next ? nxt.a : cA; const char* nB = has_next ? nxt.b : cB;
    unsigned n00 = c00, n01 = c01, n10 = c10, n11 = c11;
    if (has_next) PG_AOFFS(nxt, n00, n01, n10, n11);
#pragma unroll 1
    for (int t = 0; t < nt; t += 2) {
      const bool last = (t == nt - 2);
      const char* a1 = cA + (size_t)(t + 1) * kstep;
      const char* a2 = last ? nA : cA + (size_t)(t + 2) * kstep; const char* b2 = last ? nB : cB + (size_t)(t + 2) * kstep;
      const char* a3 = a2 + kstep; const char* b3 = b2 + kstep;
      const unsigned o00 = last ? n00 : c00, o01 = last ? n01 : c01, o10 = last ? n10 : c10, o11 = last ? n11 : c11;
      PG_LDB(B0, 0, 0); PG_LDB(B1, 0, 1); PG_SCHED; PG_LDA(At, 0, 0); PG_STAGE(PG_SA(1, 1), a1, c10, c11);
      PG_WAIT_V(8); PG_WAIT_L(0); PG_BAR; PG_MMA(0, 0, At, B0); PG_MMA(0, 1, At, B1); PG_BAR; PG_SCHED;
      PG_LDA(At, 0, 1); PG_STAGE(PG_SB(0, 0), b2, vb0, vb1); PG_STAGE(PG_SB(0, 1), b2 + hstep, vb0, vb1); PG_STAGE(PG_SA(0, 0), a2, o00, o01);
      PG_WAIT_V(8); PG_WAIT_L(0); PG_BAR; PG_MMA(1, 0, At, B0); PG_MMA(1, 1, At, B1); PG_BAR; PG_SCHED;
      PG_LDB(B0, 1, 0); PG_LDB(B1, 1, 1); PG_SCHED; PG_LDA(At, 1, 0); PG_STAGE(PG_SA(0, 1), a2, o10, o11);
      PG_WAIT_V(8); PG_WAIT_L(0); PG_BAR; PG_MMA(0, 0, At, B0); PG_MMA(0, 1, At, B1); PG_BAR; PG_SCHED;
      PG_LDA(At, 1, 1); PG_STAGE(PG_SB(1, 0), b3, vb0, vb1); PG_STAGE(PG_SB(1, 1), b3 + hstep, vb0, vb1); PG_STAGE(PG_SA(1, 0), a3, o00, o01);
      PG_WAIT_V(8); PG_WAIT_L(0); PG_BAR; PG_MMA(1, 0, At, B0); PG_MMA(1, 1, At, B1); PG_BAR; PG_SCHED;
    }
    if constexpr (ALIGN_EPI) { if (wr == 0) PG_BAR; }
    E(acc, cur, wr, wc, fr, fq);
    if (!has_next) break;
#pragma unroll
    for (int a = 0; a < 2; ++a)
#pragma unroll
      for (int b = 0; b < 2; ++b)
#pragma unroll
        for (int m = 0; m < 4; ++m)
#pragma unroll
          for (int n = 0; n < 2; ++n) acc[a][b][m][n] = (f32x4){0.f, 0.f, 0.f, 0.f};
    cur = nxt; cA = nA; cB = nB; c00 = n00; c01 = n01; c10 = n10; c11 = n11; ++ui;
    if constexpr (ALIGN_EPI) { if (wr == 1) PG_BAR; }
  }
  PG_WAIT_V(0);
  if constexpr (!ALIGN_EPI) { if (wr == 0) PG_BAR; }
  PG_BAR;
#undef PG_SA
#undef PG_SB
#undef PG_STAGE
#undef PG_LDA
#undef PG_LDB
#undef PG_MMA
#undef PG_WAIT_V
#undef PG_WAIT_L
#undef PG_BAR
#undef PG_SCHED
#undef PG_AOFFS
}
}


struct UnitF { const bf16_t* A; const int* rows; const float* W0; const float* W1; int m0, pn, e; };

template <bool AMUL, class Epi, class Sched, int ABL = 0>
DI void gemmF_phase(unsigned char* smem_, const int K, const int lda, const int ldw, const Sched& S, const Epi& E) {
  int tid = threadIdx.x; asm volatile("" : "+v"(tid));
  unsigned char* smem; { LAS unsigned char* l_ = (LAS unsigned char*)smem_; asm volatile("" : "+v"(l_)); smem = (unsigned char*)l_; }
  const int lane = tid & 63, wid = tid >> 6, wr = wid >> 2, wc = wid & 3, fr = lane & 15, fq = lane >> 4;
  const int nk = K >> 6;
  const int ar0 = tid >> 3, ac = tid & 7;
  const int q = tid & 63, half = q >> 5, g0 = 4 * (q & 31);
  int vrow[4];
#pragma unroll
  for (int i = 0; i < 4; ++i) vrow[i] = 64 * (q >> 4) + 16 * i + (q & 15);
  const int aw0 = sw128(ar0, ac), aw1 = sw128(ar0 + 64, ac);
#define F_ROWS(u, rr0, rr1) do { rr0 = (u).rows ? (size_t)(u).rows[ar0] : (size_t)((u).m0 + ar0); rr1 = (u).rows ? (size_t)(u).rows[ar0 + 64] : (size_t)((u).m0 + ar0 + 64); } while (0)
#define F_LOAD(A_, W0_, W1_, rr0_, rr1_, kk_, va0, va1, vb0, vb1, vw) do { \
    va0 = *(const u32x4*)((A_) + (rr0_) * lda + (kk_) * 64 + ac * 8); va1 = *(const u32x4*)((A_) + (rr1_) * lda + (kk_) * 64 + ac * 8); \
    if (AMUL) { vb0 = *(const u32x4*)((A_) + (rr0_) * lda + 256 + (kk_) * 64 + ac * 8); vb1 = *(const u32x4*)((A_) + (rr1_) * lda + 256 + (kk_) * 64 + ac * 8); } \
    const float* wp_ = (half ? (W1_) : (W0_)) + (size_t)((kk_) * 64 + 8 * wid) * ldw + g0; \
    if (ABL != 1) { _Pragma("unroll") for (int j = 0; j < 8; ++j) vw[j] = *(const f32x4*)(wp_ + (size_t)j * ldw); } } while (0)
#define F_LOADX(kx, va0, va1, vb0, vb1, vw) do { const bool nx_ = (kx) >= nk; const int kk2_ = nx_ ? (kx) - nk : (kx); \
    const bf16_t* A2_ = nx_ ? nxt.A : cur.A; const float* W02_ = nx_ ? nxt.W0 : cur.W0; const float* W12_ = nx_ ? nxt.W1 : cur.W1; \
    const size_t q0_ = nx_ ? nr0 : r0, q1_ = nx_ ? nr1 : r1; \
    F_LOAD(A2_, W02_, W12_, q0_, q1_, kk2_, va0, va1, vb0, vb1, vw); } while (0)
#define F_STORE(st, va0, va1, vb0, vb1, vw) do { unsigned char* sa_ = smem + (st) * 49152; \
    if (AMUL) { _Pragma("unroll") for (int e_ = 0; e_ < 4; ++e_) { va0[e_] = pk2(lo2f(va0[e_]) * lo2f(vb0[e_]), hi2f(va0[e_]) * hi2f(vb0[e_])); va1[e_] = pk2(lo2f(va1[e_]) * lo2f(vb1[e_]), hi2f(va1[e_]) * hi2f(vb1[e_])); } } \
    *(u32x4*)(sa_ + aw0) = va0; *(u32x4*)(sa_ + aw1) = va1; \
    if (ABL != 3) { _Pragma("unroll") for (int i = 0; i < 4; ++i) { \
      u32x4 o_ = {pk2(vw[0][i], vw[1][i]), pk2(vw[2][i], vw[3][i]), pk2(vw[4][i], vw[5][i]), pk2(vw[6][i], vw[7][i])}; \
      *(u32x4*)(sa_ + 16384 + sw128(vrow[i], wid)) = o_; } } else { _Pragma("unroll") for (int j = 0; j < 8; ++j) asm volatile("" :: "v"(vw[j])); } } while (0)
#define F_LBAR() do { asm volatile("s_waitcnt lgkmcnt(0)" ::: "memory"); __builtin_amdgcn_s_barrier(); asm volatile("" ::: "memory"); } while (0)
#define F_COMPUTE(st) do { const unsigned char* sA = smem + (st) * 49152; const unsigned char* sB = sA + 16384; \
    _Pragma("unroll") for (int ks = 0; ks < 2; ++ks) { bf16x8 af[4], bfr[4]; \
      _Pragma("unroll") for (int m = 0; m < 4; ++m) af[m] = ldfrag(sA + sw128(64 * wr + 16 * m + fr, 4 * ks + fq)); \
      _Pragma("unroll") for (int n = 0; n < 4; ++n) bfr[n] = ldfrag(sB + sw128(64 * wc + 16 * n + fr, 4 * ks + fq)); \
      if (ABL != 2) { _Pragma("unroll") for (int m = 0; m < 4; ++m) _Pragma("unroll") for (int n = 0; n < 4; ++n) acc[m][n] = mfma16(bfr[n], af[m], acc[m][n]); } \
      else { _Pragma("unroll") for (int m = 0; m < 4; ++m) _Pragma("unroll") for (int n = 0; n < 4; ++n) asm volatile("" :: "v"(af[m]), "v"(bfr[n])); } } } while (0)
  UnitF cur, nxt; int ui = 0;
  if (!S.next(0, cur)) return;
  size_t r0, r1, nr0, nr1;
  F_ROWS(cur, r0, r1);
  bool has_next = S.next(1, nxt);
  if (has_next) F_ROWS(nxt, nr0, nr1); else { nxt = cur; nr0 = r0; nr1 = r1; }
  f32x4 acc[4][4];
#pragma unroll
  for (int m = 0; m < 4; ++m)
#pragma unroll
    for (int n = 0; n < 4; ++n) acc[m][n] = (f32x4){0.f, 0.f, 0.f, 0.f};
  u32x4 xa0, xa1, ya0, ya1, xb0, xb1, yb0, yb1; f32x4 xw[8], yw[8];
  xb0 = xb1 = yb0 = yb1 = (u32x4){0u, 0u, 0u, 0u};
  if (ABL == 1) { _Pragma("unroll") for (int j = 0; j < 8; ++j) { xw[j] = (f32x4){0.f, 0.f, 0.f, 0.f}; yw[j] = xw[j]; } }
  F_LOAD(cur.A, cur.W0, cur.W1, r0, r1, 0, xa0, xa1, xb0, xb1, xw);
  F_LOAD(cur.A, cur.W0, cur.W1, r0, r1, 1, ya0, ya1, yb0, yb1, yw);
  __syncthreads();
  F_STORE(0, xa0, xa1, xb0, xb1, xw);
  F_LBAR();
  int st = 0;
  for (;;) {
    typename Epi::Pre pre; E.prefetch(cur, wr, fr, pre);
#pragma unroll 1
    for (int kt = 0; kt < nk; kt += 2) {
      F_LOADX(kt + 2, xa0, xa1, xb0, xb1, xw);
      F_COMPUTE(st);
      F_STORE(st ^ 1, ya0, ya1, yb0, yb1, yw);
      F_LBAR();
      F_LOADX(kt + 3, ya0, ya1, yb0, yb1, yw);
      F_COMPUTE(st ^ 1);
      F_STORE(st, xa0, xa1, xb0, xb1, xw);
      F_LBAR();
    }
    if (ABL != 4) E(acc, cur, wr, wc, fr, fq, pre, smem + (st ^ 1) * 49152); else { _Pragma("unroll") for (int m = 0; m < 4; ++m) _Pragma("unroll") for (int n = 0; n < 4; ++n) asm volatile("" :: "v"(acc[m][n])); }
#pragma unroll
    for (int m = 0; m < 4; ++m)
#pragma unroll
      for (int n = 0; n < 4; ++n) acc[m][n] = (f32x4){0.f, 0.f, 0.f, 0.f};
    if (!has_next) break;
    cur = nxt; r0 = nr0; r1 = nr1; ++ui;
    has_next = S.next(ui + 1, nxt);
    if (has_next) F_ROWS(nxt, nr0, nr1); else { nxt = cur; nr0 = r0; nr1 = r1; }
  }
  asm volatile("s_waitcnt vmcnt(0)" ::: "memory");
  __syncthreads();
#undef F_ROWS
#undef F_LOAD
#undef F_LOADX
#undef F_STORE
#undef F_LBAR
#undef F_COMPUTE
}

#define XB_TMO      128
#define XB_XCNT(j)  (256  + 64 * (j))
#define XB_XSUB(j)  (1280 + 64 * (j))
#define XB_XGEN(j)  (2304 + 64 * (j))
#define XB_TOP      3328
#define XB_TOPGEN   3392
#define XCD_BAR_WORDS 3456
#define XB_SPIN_CAP (1u << 22)
DI unsigned xb_ld(unsigned* p)              { return __hip_atomic_load(p, __ATOMIC_RELAXED, __HIP_MEMORY_SCOPE_AGENT); }
DI unsigned xb_add(unsigned* p, unsigned v) { return __hip_atomic_fetch_add(p, v, __ATOMIC_RELAXED, __HIP_MEMORY_SCOPE_AGENT); }
DI unsigned xb_xcc_id() { return (unsigned)__builtin_amdgcn_s_getreg((3 << 11) | 20) & 0xFu; }
#define XB_SPIN(cond, bar) do { unsigned _sp = 0; while (cond) { __builtin_amdgcn_s_sleep(1); \
    if ((++_sp & 255u) == 0u) { if (xb_ld(&(bar)[XB_TMO])) break; if (_sp > XB_SPIN_CAP) { atomicAdd(&(bar)[XB_TMO], 1u); break; } } } } while (0)
struct XcdBarrier { unsigned* bar; unsigned x; volatile LAS unsigned* st; };
DI XcdBarrier xcd_barrier_post(unsigned* bar, volatile LAS unsigned* st) {
  XcdBarrier b; b.bar = bar; b.x = xb_xcc_id(); b.st = st;
  if (threadIdx.x == 0) (void)xb_add(&bar[XB_XCNT(b.x)], 1u);
  return b;
}
DI void xcd_barrier_complete(unsigned* bar, unsigned x, unsigned& nloc, unsigned& nx) {
  const unsigned G = gridDim.x * gridDim.y * gridDim.z;
  unsigned sum, cnt, mine, sp = 0u;
  for (;;) {
    sum = 0u; cnt = 0u; mine = 0u;
#pragma unroll
    for (unsigned j = 0; j < 16; ++j) { const unsigned c = xb_ld(&bar[XB_XCNT(j)]); sum += c; cnt += (c > 0u) ? 1u : 0u; mine = (j == x) ? c : mine; }
    if (sum == G) break;
    __builtin_amdgcn_s_sleep(1);
    if ((++sp & 255u) == 0u) { if (xb_ld(&bar[XB_TMO])) break; if (sp > XB_SPIN_CAP) { atomicAdd(&bar[XB_TMO], 1u); break; } }
  }
  nloc = mine > 0u ? mine : 1u; nx = cnt > 0u ? cnt : 1u;
}
DI void xcd_barrier(const XcdBarrier& b) {
  asm volatile("s_waitcnt vmcnt(0)" ::: "memory");
  __syncthreads();
  if (threadIdx.x == 0) {
    unsigned* bar = b.bar;
    __builtin_amdgcn_s_waitcnt(0);
    unsigned nloc = b.st[0], nx = b.st[1];
    if (nloc == 0u) { xcd_barrier_complete(bar, b.x, nloc, nx); b.st[0] = nloc; b.st[1] = nx; }
    const unsigned old = xb_add(&bar[XB_XSUB(b.x)], 1u);
    const unsigned gen = old / nloc;
    if (old + 1u == (gen + 1u) * nloc) {
      __builtin_amdgcn_fence(__ATOMIC_RELEASE, "agent");
      asm volatile("s_waitcnt vmcnt(0)" ::: "memory");
      const unsigned og = xb_add(&bar[XB_TOP], 1u);
      const unsigned tg = og / nx;
      if (og + 1u == (tg + 1u) * nx) xb_add(&bar[XB_TOPGEN], 1u);
      else XB_SPIN(xb_ld(&bar[XB_TOPGEN]) == tg, bar);
      __builtin_amdgcn_fence(__ATOMIC_ACQUIRE, "agent");
      xb_add(&bar[XB_XGEN(b.x)], 1u);
      asm volatile("s_waitcnt vmcnt(0)" ::: "memory");
    } else {
      XB_SPIN(xb_ld(&bar[XB_XGEN(b.x)]) == gen, bar);
      __builtin_amdgcn_fence(__ATOMIC_ACQUIRE, "agent");
      asm volatile("s_waitcnt vmcnt(0)" ::: "memory");
    }
  }
  __syncthreads();
}

DI void phase0(const Params& p, unsigned char* smem, int bid, int nb) {
  int tid = threadIdx.x; asm volatile("" : "+v"(tid));
  const int lane = tid & 63, wave = tid >> 6;
  unsigned char* ws = p.ws;
  if (bid == 0 && tid < 256) ((int*)(ws + O_CTRL))[tid * CSTR] = 0;
  for (int i = bid * NTHR + tid; i < T; i += nb * NTHR) ((int*)(ws + O_IDENT))[i] = i;
  {
    float* wabT = (float*)smem;
    const float* win = p.in[I_WIN];
    for (int i = tid; i < 8192; i += NTHR) { const int k = i >> 3, j = i & 7; wabT[j * 1024 + k] = win[(size_t)k * DIN + 2048 + j]; }
    __syncthreads();
    const float* x = p.in[I_X];
    bf16_t* xb = (bf16_t*)(ws + O_XB);
    float* ab = (float*)(ws + O_AB);
    for (int row = bid * 8 + wave; row < T; row += nb * 8) {
      float s[8];
#pragma unroll
      for (int j = 0; j < 8; ++j) s[j] = 0.f;
#pragma unroll
      for (int i = 0; i < 4; ++i) {
        const int k = 256 * i + 4 * lane;
        const f32x4 v = *(const f32x4*)(x + (size_t)row * D + k);
        *(u32x2*)(xb + (size_t)row * D + k) = pack4(v);
#pragma unroll
        for (int j = 0; j < 8; ++j) { const f32x4 w = *(const f32x4*)(wabT + j * 1024 + k); s[j] += v[0] * w[0] + v[1] * w[1] + v[2] * w[2] + v[3] * w[3]; }
      }
#pragma unroll
      for (int j = 0; j < 8; ++j) s[j] = wave_sum(s[j]);
      if (lane == 0) { *(f32x4*)(ab + (size_t)row * 8) = (f32x4){s[0], s[1], s[2], s[3]}; *(f32x4*)(ab + (size_t)row * 8 + 4) = (f32x4){s[4], s[5], s[6], s[7]}; }
    }
    const float* mem = p.in[I_MEM];
    bf16_t* memb = (bf16_t*)(ws + O_MEMB);
    for (int row = bid * 8 + wave; row < 512; row += nb * 8) {
#pragma unroll
      for (int i = 0; i < 4; ++i) { const int k = 256 * i + 4 * lane; *(u32x2*)(memb + (size_t)row * D + k) = pack4(*(const f32x4*)(mem + (size_t)row * D + k)); }
    }
    const float* sw = p.in[I_SGUW];
    bf16_t* sguw = (bf16_t*)(ws + O_SGUW);
    for (int i = bid * NTHR + tid; i < 16384; i += nb * NTHR) {
      const int e0 = i * 4; const int col = e0 & 127, rowi = (e0 >> 7) & 127;
      f32x4 v = *(const f32x4*)(sw + e0);
#pragma unroll
      for (int c = 0; c < 4; ++c) if (col + c > rowi) v[c] = 0.f;
      *(u32x2*)(sguw + e0) = pack4(v);
    }
    __syncthreads();
  }
  {
    float* tile = (float*)smem;
    const float *pwin = p.in[I_WIN], *pwa = p.in[I_WA], *pwb = p.in[I_WB], *pwc = p.in[I_WC], *pwo = p.in[I_WO], *pwmkv = p.in[I_WMKV], *prw = p.in[I_RW],
                *pwsg = p.in[I_WSG], *pwsu = p.in[I_WSU], *pwsd = p.in[I_WSD], *pwg = p.in[I_WG], *pwu = p.in[I_WU], *pwdn = p.in[I_WDN];
    { GAS const float *a_ = (GAS const float*)pwa, *b_ = (GAS const float*)pwb, *c_ = (GAS const float*)pwc, *o_ = (GAS const float*)pwo, *m_ = (GAS const float*)pwmkv;
      asm volatile("" : "+s"(a_), "+s"(b_), "+s"(c_), "+s"(o_), "+s"(m_));
      pwa = (const float*)a_; pwb = (const float*)b_; pwc = (const float*)c_; pwo = (const float*)o_; pwmkv = (const float*)m_; }
    constexpr int J0 = 1664, J1 = J0 + 128, J2 = J1 + 128, J3 = J2 + 128, J4 = J3 + 256, J5 = J4 + 256, J6 = J5 + 64, J7 = J6 + 128, J8 = J7 + 64,
                  J9 = J8, J10 = J8;
    const int kr = tid >> 4, nc = tid & 15, sg = nc >> 2;
    const int tn = tid >> 3, tkc = tid & 7;
#define P0_DECODE_LOAD(it0, dp, v0, v1) do { const float* sp[4]; int ld[4]; \
      _Pragma("unroll") \
      for (int q = 0; q < 4; ++q) { \
        const int it = (it0 + q < J10) ? it0 + q : J10 - 1;      \
        const float *s0, *s1, *s2, *s3; int ldd; bf16_t* dst; \
        if (it < J0) {           \
          const int kt = it & 15, nt = it >> 4; const int n0 = nt * 64; const int c0 = n0 + (n0 >= 2048 ? 8 : 0); \
          const float* b = pwin + (size_t)kt * 64 * DIN + c0; s0 = b; s1 = b + 16; s2 = b + 32; s3 = b + 48; ld[q] = DIN; ldd = 1024; \
          dst = (bf16_t*)(ws + O_WINT) + (size_t)n0 * 1024 + kt * 64; \
        } else if (it < J3) {    \
          const int which = (it - J0) >> 7, r = (it - J0) & 127; const int kt = r & 7, nt = r >> 3; \
          const float* src = which == 0 ? pwa : which == 1 ? pwb : pwc; \
          const float* b = src + (size_t)kt * 64 * 1024 + nt * 64; s0 = b; s1 = b + 16; s2 = b + 32; s3 = b + 48; ld[q] = 1024; ldd = 512; \
          dst = (bf16_t*)(ws + (which == 0 ? O_WAT : which == 1 ? O_WBT : O_WCT)) + (size_t)nt * 64 * 512 + kt * 64; \
        } else if (it < J5) {    \
          const int which = (it - J3) >> 8, r = (it - J3) & 255; const int kt = r & 15, nt = r >> 4; \
          const float* b = (which == 0 ? pwo : pwmkv) + (size_t)kt * 64 * 1024 + nt * 64; s0 = b; s1 = b + 16; s2 = b + 32; s3 = b + 48; ld[q] = 1024; ldd = 1024; \
          dst = (bf16_t*)(ws + (which == 0 ? O_WOT : O_WMKV)) + (size_t)nt * 64 * 1024 + kt * 64; \
        } else if (it < J6) {    \
          const int r = it - J5; const int kt = r & 15, nt = r >> 4; \
          const float* b = prw + (size_t)kt * 64 * 256 + nt * 64; s0 = b; s1 = b + 16; s2 = b + 32; s3 = b + 48; ld[q] = 256; ldd = 1024; \
          dst = (bf16_t*)(ws + O_ROUT) + (size_t)nt * 64 * 1024 + kt * 64; \
        } else if (it < J7) {    \
          const int r = it - J6; const int kt = r & 15, nt = r >> 4; \
          const float* g = pwsg + (size_t)kt * 64 * 256 + nt * 32; const float* u = pwsu + (size_t)kt * 64 * 256 + nt * 32; \
          s0 = g; s1 = u; s2 = g + 16; s3 = u + 16; ld[q] = 256; ldd = 1024; \
          dst = (bf16_t*)(ws + O_WSGU) + (size_t)nt * 64 * 1024 + kt * 64; \
        } else if (it < J8) {    \
          const int r = it - J7; const int kt = r & 3, nt = r >> 2; \
          const float* b = pwsd + (size_t)kt * 64 * 1024 + nt * 64; s0 = b; s1 = b + 16; s2 = b + 32; s3 = b + 48; ld[q] = 1024; ldd = 256; \
          dst = (bf16_t*)(ws + O_WSD) + (size_t)nt * 64 * 256 + kt * 64; \
        } else if (it < J9) {    \
          const int r = it - J8; const int e = r >> 7, qq = r & 127; const int kt = qq & 15, nt = qq >> 4; \
          const float* g = pwg + (size_t)e * 262144 + (size_t)kt * 64 * 256 + nt * 32; const float* u = pwu + (size_t)e * 262144 + (size_t)kt * 64 * 256 + nt * 32; \
          s0 = g; s1 = u; s2 = g + 16; s3 = u + 16; ld[q] = 256; ldd = 1024; \
          dst = (bf16_t*)(ws + O_WGU) + (size_t)e * 524288 + (size_t)nt * 64 * 1024 + kt * 64; \
        } else {                 \
          const int r = it - J9; const int e = r >> 6, qq = r & 63; const int kt = qq & 3, nt = qq >> 2; \
          const float* b = pwdn + (size_t)e * 262144 + (size_t)kt * 64 * 1024 + nt * 64; s0 = b; s1 = b + 16; s2 = b + 32; s3 = b + 48; ld[q] = 1024; ldd = 256; \
          dst = (bf16_t*)(ws + O_WD) + (size_t)e * 262144 + (size_t)nt * 64 * 256 + kt * 64; \
        } \
        sp[q] = (sg == 0 ? s0 : sg == 1 ? s1 : sg == 2 ? s2 : s3) + (size_t)kr * ld[q] + 4 * (nc & 3); \
        dp[q] = dst + (size_t)tn * ldd + 8 * tkc; \
      } \
      _Pragma("unroll") \
      for (int q = 0; q < 4; ++q) { v0[q] = __builtin_nontemporal_load((const f32x4*)(sp[q])); v1[q] = __builtin_nontemporal_load((const f32x4*)(sp[q] + (size_t)32 * ld[q])); } } while (0)
    bf16_t* dpn[4]; f32x4 v0n[4], v1n[4];
    int it0 = bid * 4;
    if (it0 < J10) P0_DECODE_LOAD(it0, dpn, v0n, v1n);
    for (; it0 < J10; it0 += nb * 4) {
      bf16_t* dp[4]; f32x4 v0[4], v1[4];
#pragma unroll
      for (int q = 0; q < 4; ++q) { dp[q] = dpn[q]; v0[q] = v0n[q]; v1[q] = v1n[q]; }
      if (it0 + nb * 4 < J10) P0_DECODE_LOAD(it0 + nb * 4, dpn, v0n, v1n);
      asm volatile("s_waitcnt lgkmcnt(0)" ::: "memory"); __builtin_amdgcn_s_barrier(); asm volatile("" ::: "memory");
#pragma unroll
      for (int q = 0; q < 4; ++q) {
        float* t0 = tile + q * 4160 + kr * 65 + 4 * nc;
        float* t1 = t0 + 32 * 65;
        t0[0] = v0[q][0]; t0[1] = v0[q][1]; t0[2] = v0[q][2]; t0[3] = v0[q][3];
        t1[0] = v1[q][0]; t1[1] = v1[q][1]; t1[2] = v1[q][2]; t1[3] = v1[q][3];
      }
      asm volatile("s_waitcnt lgkmcnt(0)" ::: "memory"); __builtin_amdgcn_s_barrier(); asm volatile("" ::: "memory");
#pragma unroll
      for (int q = 0; q < 4; ++q) {
        float e[8];
#pragma unroll
        for (int j = 0; j < 8; ++j) e[j] = tile[q * 4160 + (8 * tkc + j) * 65 + tn];
        u32x4 o = {pk2(e[0], e[1]), pk2(e[2], e[3]), pk2(e[4], e[5]), pk2(e[6], e[7])};
        *(u32x4*)(dp[q]) = o;
      }
    }
#undef P0_DECODE_LOAD
  }
}

#define EPI_ROWS(u) const int row_ = (u).pm * 256 + 64 * wr + fr
struct EpiInProj {
  unsigned char* ws;
  DI void operator()(const f32x4 (&acc)[2][2][4][2], const pg::Unit& u, int wr, int wc, int fr, int fq) const {
    const int colt = u.pn * 256;
#pragma unroll
    for (int ai = 0; ai < 2; ++ai)
#pragma unroll
      for (int m = 0; m < 4; ++m) {
        const size_t row = (size_t)u.pm * 256 + 128 * ai + 64 * wr + 16 * m + fr;
#pragma unroll
        for (int bj = 0; bj < 2; ++bj)
#pragma unroll
          for (int n = 0; n < 2; ++n) {
            const int col = colt + 128 * bj + 32 * wc + 16 * n + 4 * fq;
            f32x4 v = acc[ai][bj][m][n];
            if (colt < 1536) { *(u32x2*)((bf16_t*)(ws + O_QKV) + row * 1536 + col) = pack4(v); }
            else if (colt < 2048) {
#pragma unroll
              for (int c = 0; c < 4; ++c) v[c] = siluf_(v[c]);
              *(u32x2*)((bf16_t*)(ws + O_ZS) + row * 512 + (col - 1536)) = pack4(v);
            } else if (colt < 3072) {
#pragma unroll
              for (int c = 0; c < 4; ++c) v[c] = geluf_(v[c]);
              *(u32x2*)((bf16_t*)(ws + O_UVG) + row * 1024 + (col - 2048)) = pack4(v);
            } else if (colt < 3584) {
#pragma unroll
              for (int c = 0; c < 4; ++c) v[c] *= 0.08838834764831845f;
              *(u32x2*)((bf16_t*)(ws + O_XQ) + row * 512 + (col - 3072)) = pack4(v);
            } else {
#pragma unroll
              for (int c = 0; c < 4; ++c) v[c] = sigmoidf_(v[c]);
              *(u32x2*)((bf16_t*)(ws + O_GATES) + row * 3072 + (col - 3584)) = pack4(v);
            }
          }
      }
  }
};
struct EpiMemKV {
  unsigned char* ws;
  DI void operator()(const f32x4 (&acc)[2][2][4][2], const pg::Unit& u, int wr, int wc, int fr, int fq) const {
#pragma unroll
    for (int ai = 0; ai < 2; ++ai)
#pragma unroll
      for (int m = 0; m < 4; ++m) {
        const int row = u.pm * 256 + 128 * ai + 64 * wr + 16 * m + fr; const int b = row >> 8, key = row & 255;
#pragma unroll
        for (int bj = 0; bj < 2; ++bj)
#pragma unroll
          for (int n = 0; n < 2; ++n) {
            const int col = u.pn * 256 + 128 * bj + 32 * wc + 16 * n + 4 * fq;
            const f32x4 v = acc[ai][bj][m][n];
            if (col < 512) { const int h = col >> 7, d = col & 127; *(u32x2*)((bf16_t*)(ws + O_MEMK) + ((size_t)((b * 4 + h) * 256 + key)) * 128 + d) = pack4(v); }
            else {
              const int c2 = col - 512; const int h = c2 >> 7, d = c2 & 127;
              const int pos = 32 * (key >> 5) + 8 * ((key >> 2) & 3) + 4 * ((key >> 4) & 1) + (key & 3);
              bf16_t* vt = (bf16_t*)(ws + O_MEMVT) + ((size_t)((b * 4 + h) * 128 + d)) * 256 + pos;
#pragma unroll
              for (int c = 0; c < 4; ++c) vt[(size_t)c * 256] = f2bf(v[c]);
            }
          }
      }
  }
};
struct P1Order {
  pg::DenseOrder D; const char* memb; const char* wmkv; int G, c;
  DI bool next(int i, pg::Unit& u) const {
    const long L = (long)i * G + c;
    if (L < D.nwg) { D.unit_of(L, u); u.e = 0; return true; }
    const int r = (int)(L - D.nwg); if (r >= 8) return false;
    u.pm = r & 1; u.pn = r >> 1; u.e = 1; u.rows = nullptr;
    u.a = memb + (size_t)u.pm * 524288; u.b = wmkv + (size_t)u.pn * 524288; return true;
  }
};
struct EpiP1 {
  EpiInProj a; EpiMemKV b;
  DI void operator()(const f32x4 (&acc)[2][2][4][2], const pg::Unit& u, int wr, int wc, int fr, int fq) const {
    asm volatile("" : "+v"(fr), "+v"(fq));
    if (u.e) b(acc, u, wr, wc, fr, fq); else a(acc, u, wr, wc, fr, fq);
  }
};
DI void phase1(const Params& p, unsigned char* smem, int bid, int nb) {
  unsigned char* ws = p.ws;
  PG_LAS unsigned char* lds = (PG_LAS unsigned char*)smem;
  __syncthreads();
  P1Order S; S.D.init(ws + O_XB, ws + O_WINT, T, NPROJ, 1024, nb, bid); S.memb = (const char*)(ws + O_MEMB); S.wmkv = (const char*)(ws + O_WMKV); S.G = nb; S.c = bid;
  EpiP1 E{EpiInProj{ws}, EpiMemKV{ws}};
  pg::gemm_phase<EpiP1, P1Order, false, true>(lds, 1024, S, E);
}

constexpr int G_KF = 0, G_VF = 32768, G_QB = 65536, G_KB = 81920, G_UT = 81920  , G_L = 98304, G_ATT = 114688, G_KDT = 122880, G_WT = 139264, G_SM = 155648;

DI void gdn_prep_item(const Params& p, unsigned char* smem_, int item) {
  unsigned char* smem; { LAS unsigned char* l_ = (LAS unsigned char*)smem_; asm volatile("" : "+v"(l_)); smem = (unsigned char*)l_; }
  int tid = threadIdx.x; asm volatile("" : "+v"(tid));
  const int lane = tid & 63, wave = tid >> 6, fr = lane & 15, fq = lane >> 4;
  unsigned char* ws; { GAS unsigned char* g_ = (GAS unsigned char*)p.ws; asm volatile("" : "+s"(g_)); ws = (unsigned char*)g_; }
  const int h = item & 3, cn = item >> 2;
  const int bidx = cn >> 7, n = cn & 127;
  const size_t t0 = (size_t)bidx * SEQ + (size_t)n * 64;
  float* kf = (float*)(smem + G_KF); float* vf = (float*)(smem + G_VF); float* Lm = (float*)(smem + G_L);
  float* sbeta = (float*)(smem + G_SM); float* sgc = sbeta + 64; float* segc = sbeta + 128;
  __syncthreads();
  {
    const bf16_t* qkv = (const bf16_t*)(ws + O_QKV);
    const float* cw = p.in[I_CONVW];
    const int tl0 = wave * 8;
#pragma unroll
    for (int sect = 0; sect < 3; ++sect) {
      const int cb = sect * 512 + h * 128 + 2 * lane;
      float w0[4], w1[4];
#pragma unroll
      for (int i = 0; i < 4; ++i) { w0[i] = cw[i * 1536 + cb]; w1[i] = cw[i * 1536 + cb + 1]; }
      float xa[11], xc[11];
#pragma unroll
      for (int r = 0; r < 11; ++r) {
        const int s = n * 64 + tl0 + r - 3;
        unsigned u = 0u;
        if (s >= 0) u = *(const unsigned*)(qkv + ((size_t)bidx * SEQ + s) * 1536 + cb);
        xa[r] = lo2f(u); xc[r] = hi2f(u);
      }
#pragma unroll
      for (int r = 0; r < 8; ++r) {
        float y0 = w0[0] * xa[r] + w0[1] * xa[r + 1] + w0[2] * xa[r + 2] + w0[3] * xa[r + 3];
        float y1 = w1[0] * xc[r] + w1[1] * xc[r + 1] + w1[2] * xc[r + 2] + w1[3] * xc[r + 3];
        y0 = siluf_(y0); y1 = siluf_(y1);
        const int tl = tl0 + r;
        if (sect == 2) { vf[tl * 128 + 2 * lane] = y0; vf[tl * 128 + 2 * lane + 1] = y1; }
        else {
          const float ss = wave_sum(y0 * y0 + y1 * y1);
          const float sc = rsqrtf(ss + 1e-6f) * (sect == 0 ? 0.08838834764831845f : 1.0f);
          y0 *= sc; y1 *= sc;
          const int off = sw256(tl, lane >> 2) + (lane & 3) * 4;
          if (sect == 0) *(unsigned*)(smem + G_QB + off) = pk2(y0, y1);
          else { *(unsigned*)(smem + G_KB + off) = pk2(y0, y1); kf[tl * 128 + 2 * lane] = y0; kf[tl * 128 + 2 * lane + 1] = y1; }
        }
      }
    }
    if (wave == 0) {
      const float* ab = (const float*)(ws + O_AB) + (t0 + lane) * 8;
      const float a = ab[h], bb = ab[4 + h];
      const float beta = sigmoidf_(bb);
      float g = -__expf(p.in[I_ALOG][h]) * softplusf_(a + p.in[I_DTB][h]);
#pragma unroll
      for (int o = 1; o < 64; o <<= 1) { const float y = __shfl_up(g, o); if (lane >= o) g += y; }
      sbeta[lane] = beta; sgc[lane] = g; segc[lane] = __expf(g);
      if (lane == 63) ((float*)(ws + O_GL))[item] = __expf(g);
    }
  }
  __syncthreads();
  {
#pragma unroll
    for (int q = 0; q < 4; ++q) {
      const int idx = wave * 4 + q; const int isq = idx >> 4, ti = (idx >> 2) & 3, tj = idx & 3;
      f32x4 acc = {0.f, 0.f, 0.f, 0.f};
      if (tj <= ti) {
#pragma unroll
        for (int ks = 0; ks < 4; ++ks) {
          const bf16x8 ai = ldfrag(smem + (isq ? G_QB : G_KB) + sw256(16 * ti + fr, 4 * ks + fq));
          const bf16x8 bj = ldfrag(smem + G_KB + sw256(16 * tj + fr, 4 * ks + fq));
          acc = isq ? mfma16(bj, ai, acc) : mfma16(ai, bj, acc);
        }
      }
      if (isq) {
        const int i = 16 * ti + fr, j0 = 16 * tj + 4 * fq;
        const float gi = sgc[i];
        f32x4 o;
#pragma unroll
        for (int r = 0; r < 4; ++r) { const int j = j0 + r; o[r] = (j <= i) ? acc[r] * __expf(gi - sgc[j]) : 0.f; }
        *(u32x2*)(smem + G_ATT + sw128(i, j0 >> 3) + (j0 & 7) * 2) = pack4(o);
      } else {
        const int j = 16 * tj + fr, i0 = 16 * ti + 4 * fq;
        const float gj = sgc[j];
        f32x4 o;
#pragma unroll
        for (int r = 0; r < 4; ++r) { const int i = i0 + r; o[r] = (j < i) ? acc[r] * __expf(sgc[i] - gj) * sbeta[i] : 0.f; }
        *(f32x4*)(Lm + j * 64 + i0) = o;
      }
    }
  }
  {
    const float gl_ = sgc[63];
    const int d = tid & 127, tg = tid >> 7;
#pragma unroll
    for (int c = 0; c < 2; ++c) {
      float e[8];
#pragma unroll
      for (int j = 0; j < 8; ++j) { const int t = 16 * tg + 8 * c + j; e[j] = kf[t * 128 + d] * __expf(gl_ - sgc[t]); }
      u32x4 o = {pk2(e[0], e[1]), pk2(e[2], e[3]), pk2(e[4], e[5]), pk2(e[6], e[7])};
      *(u32x4*)(smem + G_KDT + sw128(d, 2 * tg + c)) = o;
    }
  }
  __syncthreads();
  {
#pragma unroll
    for (int i = 0; i < 32; ++i) {
      const int e = tid + 512 * i; const int t = e >> 8, c = e & 255;
      float* xp = (c < 128) ? (vf + t * 128 + c) : (kf + t * 128 + (c - 128));
      float sc = sbeta[t]; if (c >= 128) sc *= segc[t];
      *xp *= sc;
    }
    __syncthreads();
    const int ct0 = 2 * wave;
    float* xt0 = (ct0 < 8) ? (vf + 16 * ct0) : (kf + 16 * (ct0 - 8));
    float* xt1 = xt0 + 16;
#pragma unroll
    for (int b = 0; b < 4; ++b) {
      if (b > 0) {
        f32x4 a0 = {0.f, 0.f, 0.f, 0.f}, a1 = {0.f, 0.f, 0.f, 0.f};
#pragma unroll
        for (int ks = 0; ks < 4 * b; ++ks) {
          const int k = 4 * ks + fq;
          const float av = Lm[k * 64 + 16 * b + fr];
          a0 = __builtin_amdgcn_mfma_f32_16x16x4f32(av, xt0[k * 128 + fr], a0, 0, 0, 0);
          a1 = __builtin_amdgcn_mfma_f32_16x16x4f32(av, xt1[k * 128 + fr], a1, 0, 0, 0);
        }
#pragma unroll
        for (int r = 0; r < 4; ++r) { xt0[(16 * b + 4 * fq + r) * 128 + fr] -= a0[r]; xt1[(16 * b + 4 * fq + r) * 128 + fr] -= a1[r]; }
        __syncthreads();
      }
      if (tid < 256) {
        const bool isw = tid >= 128;
        float* X = isw ? (kf + (tid - 128)) : (vf + tid);
        float xr[16];
#pragma unroll
        for (int r = 0; r < 16; ++r) xr[r] = X[(16 * b + r) * 128];
#pragma unroll
        for (int q = 0; q < 15; ++q) {
          const float* lt = Lm + (16 * b + q) * 64 + 16 * b;
          float l[16];
#pragma unroll
          for (int g4 = 0; g4 < 4; ++g4) if (4 * g4 + 3 > q) { const f32x4 t4 = *(const f32x4*)(lt + 4 * g4); l[4 * g4] = t4[0]; l[4 * g4 + 1] = t4[1]; l[4 * g4 + 2] = t4[2]; l[4 * g4 + 3] = t4[3]; }
#pragma unroll
          for (int r = q + 1; r < 16; ++r) xr[r] -= l[r] * xr[q];
        }
#pragma unroll
        for (int r = 0; r < 16; ++r) X[(16 * b + r) * 128] = xr[r];
        unsigned char* dstT = smem + (isw ? G_WT : G_UT);
        const int rowc = tid & 127;
        u32x4 o0 = {pk2(xr[0], xr[1]), pk2(xr[2], xr[3]), pk2(xr[4], xr[5]), pk2(xr[6], xr[7])};
        u32x4 o1 = {pk2(xr[8], xr[9]), pk2(xr[10], xr[11]), pk2(xr[12], xr[13]), pk2(xr[14], xr[15])};
        *(u32x4*)(dstT + sw128(rowc, 2 * b)) = o0;
        *(u32x4*)(dstT + sw128(rowc, 2 * b + 1)) = o1;
      }
      if (b < 3) __syncthreads();
    }
  }
  __syncthreads();
  {
    bf16x8 ak[2];
#pragma unroll
    for (int ks = 0; ks < 2; ++ks) ak[ks] = ldfrag(smem + G_KDT + sw128(16 * wave + fr, 4 * ks + fq));
    bf16_t* mp = (bf16_t*)(ws + O_MP) + (size_t)item * 16384;
    bf16_t* bc = (bf16_t*)(ws + O_BC) + (size_t)item * 16384;
#pragma unroll
    for (int tj = 0; tj < 8; ++tj) {
      f32x4 am = {0.f, 0.f, 0.f, 0.f}, ab_ = {0.f, 0.f, 0.f, 0.f};
#pragma unroll
      for (int ks = 0; ks < 2; ++ks) {
        const bf16x8 bw = ldfrag(smem + G_WT + sw128(16 * tj + fr, 4 * ks + fq));
        const bf16x8 bu = ldfrag(smem + G_UT + sw128(16 * tj + fr, 4 * ks + fq));
        am = mfma16(bw, ak[ks], am);
        ab_ = mfma16(ak[ks], bu, ab_);
      }
      f32x4 nm = {-am[0], -am[1], -am[2], -am[3]};
      *(u32x2*)(mp + ((size_t)((wave * 4 + (tj >> 1)) * 64 + lane)) * 8 + (tj & 1) * 4) = pack4(nm);
      *(u32x2*)(bc + ((size_t)((tj * 4 + (wave >> 1)) * 64 + lane)) * 8 + (wave & 1) * 4) = pack4(ab_);
    }
    const int tt = wave & 3, hf = wave >> 2;
    bf16x8 aa[2];
#pragma unroll
    for (int ks = 0; ks < 2; ++ks) aa[ks] = ldfrag(smem + G_ATT + sw128(16 * tt + fr, 4 * ks + fq));
    const int trow = 16 * tt + fr;
    const float eg = segc[trow];
    float* o0 = (float*)(ws + O_O0) + (t0 + trow) * 512 + h * 128;
    bf16_t* qp = (bf16_t*)(ws + O_QP) + (size_t)item * 8192 + trow * 128;
#pragma unroll
    for (int q = 0; q < 4; ++q) {
      const int te = hf * 4 + q;
      f32x4 ao = {0.f, 0.f, 0.f, 0.f}, aw = {0.f, 0.f, 0.f, 0.f};
#pragma unroll
      for (int ks = 0; ks < 2; ++ks) {
        const bf16x8 bu = ldfrag(smem + G_UT + sw128(16 * te + fr, 4 * ks + fq));
        const bf16x8 bw = ldfrag(smem + G_WT + sw128(16 * te + fr, 4 * ks + fq));
        ao = mfma16(bu, aa[ks], ao);
        aw = mfma16(bw, aa[ks], aw);
      }
      const int e0 = 16 * te + 4 * fq;
      *(f32x4*)(o0 + e0) = ao;
      const u32x2 qv = *(const u32x2*)(smem + G_QB + sw256(trow, e0 >> 3) + (e0 & 7) * 2);
      f32x4 qd = {lo2f(qv[0]) * eg - aw[0], hi2f(qv[0]) * eg - aw[1], lo2f(qv[1]) * eg - aw[2], hi2f(qv[1]) * eg - aw[3]};
      *(u32x2*)(qp + e0) = pack4(qd);
    }
  }
}

typedef short s16x4 __attribute__((ext_vector_type(4)));
DI bf16x8 tr_frag(const unsigned char* p0, const unsigned char* p1) {
  const s16x4 a = __builtin_amdgcn_ds_read_tr16_b64_v4i16((LAS s16x4*)p0), b = __builtin_amdgcn_ds_read_tr16_b64_v4i16((LAS s16x4*)p1);
  bf16x8 r; r[0] = a[0]; r[1] = a[1]; r[2] = a[2]; r[3] = a[3]; r[4] = b[0]; r[5] = b[1]; r[6] = b[2]; r[7] = b[3]; return r;
}
DI void sgu_item(const Params& p, unsigned char* smem_, int item) {
  unsigned char* smem; { LAS unsigned char* l_ = (LAS unsigned char*)smem_; asm volatile("" : "+v"(l_)); smem = (unsigned char*)l_; }
  int tid = threadIdx.x; asm volatile("" : "+v"(tid));
  const int lane = tid & 63, wave = __builtin_amdgcn_readfirstlane(tid >> 6), fr = lane & 15, fq = lane >> 4;
  unsigned char* ws; { GAS unsigned char* g_ = (GAS unsigned char*)p.ws; asm volatile("" : "+s"(g_)); ws = (unsigned char*)g_; }
  const int gp = item & 1, cn = item >> 1;
  const size_t t0 = (size_t)cn * 128;
  const bf16_t* uvg = (const bf16_t*)(ws + O_UVG);
  constexpr int VS = 544;
  __syncthreads();
  {
    const float* lng = p.in[I_SLNG]; const float* lnb = p.in[I_SLNB];
    float gg[8], bb[8];
#pragma unroll
    for (int e = 0; e < 8; ++e) { gg[e] = lng[8 * lane + e]; bb[e] = lnb[8 * lane + e]; }
#pragma unroll 2
    for (int jj = 0; jj < 16; ++jj) {
      const int j = 16 * wave + jj;
      const u32x4 raw = *(const u32x4*)(uvg + (t0 + j) * 1024 + 512 + 8 * lane);
      float v[8];
#pragma unroll
      for (int e = 0; e < 4; ++e) { v[2 * e] = lo2f(raw[e]); v[2 * e + 1] = hi2f(raw[e]); }
      float s = 0.f, q2 = 0.f;
#pragma unroll
      for (int e = 0; e < 8; ++e) { s += v[e]; q2 += v[e] * v[e]; }
      s = wave_sum(s); q2 = wave_sum(q2);
      const float mean = s * (1.f / 512.f);
      const float rstd = rsqrtf(fmaxf(q2 * (1.f / 512.f) - mean * mean, 0.f) + 1e-5f);
      if ((lane >> 5) == gp) {
        float y[8];
#pragma unroll
        for (int e = 0; e < 8; ++e) y[e] = (v[e] - mean) * rstd * gg[e] + bb[e];
        u32x4 o = {pk2(y[0], y[1]), pk2(y[2], y[3]), pk2(y[4], y[5]), pk2(y[6], y[7])};
        *(u32x4*)(smem + j * VS + (lane & 31) * 16) = o;
      }
    }
  }
  __syncthreads();
  {
    const int i = 16 * wave + fr;
    const int q = (lane & 15) >> 2, pp = lane & 3;
    const unsigned char* vb = smem + (8 * fq + q) * VS + 8 * pp;
#pragma unroll 1
    for (int gl = 0; gl < 2; ++gl) {
      const int g = 2 * gp + gl;
      const bf16_t* wg = (const bf16_t*)(ws + O_SGUW) + (size_t)g * 16384;
      bf16x8 af[4];
#pragma unroll
      for (int ks = 0; ks < 4; ++ks) af[ks] = ldfrag(wg + i * 128 + 32 * ks + 8 * fq);
      const float bias = p.in[I_SGUB][g * 128 + i];
      bf16_t* out = (bf16_t*)(ws + O_SGUO) + (t0 + i) * 512 + 128 * g;
      const bf16_t* urow = uvg + (t0 + i) * 1024 + 128 * g;
#pragma unroll
      for (int jt = 0; jt < 8; ++jt) {
        f32x4 acc = {0.f, 0.f, 0.f, 0.f};
#pragma unroll
        for (int ks = 0; ks < 4; ++ks) {
          const unsigned char* a0 = vb + ks * 32 * VS + (128 * gl + 16 * jt) * 2;
          acc = mfma16(tr_frag(a0, a0 + 4 * VS), af[ks], acc);
        }
        const int c0 = 16 * jt + 4 * fq;
        const u32x2 uu = *(const u32x2*)(urow + c0);
        f32x4 o = {lo2f(uu[0]) * (acc[0] + bias), hi2f(uu[0]) * (acc[1] + bias), lo2f(uu[1]) * (acc[2] + bias), hi2f(uu[1]) * (acc[3] + bias)};
        *(u32x2*)(out + c0) = pack4(o);
        if (jt & 1) __builtin_amdgcn_sched_barrier(0);
      }
    }
  }
}

DI void xattn_item(const Params& p, unsigned char* smem_, int item) {
  int tid = threadIdx.x; asm volatile("" : "+v"(tid));
  unsigned char* smem; { LAS unsigned char* l_ = (LAS unsigned char*)smem_; asm volatile("" : "+v"(l_)); smem = (unsigned char*)l_; }
  const int lane = tid & 63, wave = tid >> 6, fr = lane & 15, fq = lane >> 4;
  unsigned char* ws; { GAS unsigned char* g_ = (GAS unsigned char*)p.ws; asm volatile("" : "+s"(g_)); ws = (unsigned char*)g_; }
  const int bh = item & 7, qb = item >> 3;
  const int b = bh >> 2, h = bh & 3;
  const bf16_t* mk = (const bf16_t*)(ws + O_MEMK) + (size_t)bh * 32768;
  const bf16_t* mv = (const bf16_t*)(ws + O_MEMVT) + (size_t)bh * 32768;
  __syncthreads();
#pragma unroll 2
  for (int j = 0; j < 8; ++j) {
    const int c = tid + 512 * j;
    const int rk = c >> 4, ck = c & 15;
    *(u32x4*)(smem + sw256(rk, ck)) = *(const u32x4*)(mk + (size_t)c * 8);
    const int rv = c >> 5, cv = c & 31;
    *(u32x4*)(smem + 65536 + rv * 512 + ((cv ^ (rv & 15)) << 4)) = *(const u32x4*)(mv + (size_t)c * 8);
  }
  __syncthreads();
  const unsigned char* kbase[4]; const unsigned char* vbase[8];
#pragma unroll
  for (int ds = 0; ds < 4; ++ds) kbase[ds] = smem + fr * 256 + (((4 * ds + fq) ^ fr) << 4);
#pragma unroll
  for (int s = 0; s < 8; ++s) vbase[s] = smem + 65536 + fr * 512 + (((4 * s + fq) ^ fr) << 4);
#pragma unroll 1
  for (int half = 0; half < 2; ++half) {
    const size_t trow = (size_t)b * SEQ + (size_t)qb * 256 + half * 128 + 16 * wave + fr;
    const bf16_t* xq = (const bf16_t*)(ws + O_XQ) + trow * 512 + h * 128;
    bf16x8 qf[4];
#pragma unroll
    for (int ds = 0; ds < 4; ++ds) qf[ds] = ldfrag(xq + 32 * ds + 8 * fq);
    f32x4 sc[16];
#pragma unroll
    for (int kt = 0; kt < 16; ++kt) {
      f32x4 a = {0.f, 0.f, 0.f, 0.f};
#pragma unroll
      for (int ds = 0; ds < 4; ++ds) a = mfma16(ldfrag(kbase[ds] + kt * 4096), qf[ds], a);
      sc[kt] = a;
      if (kt & 1) __builtin_amdgcn_sched_barrier(0);
    }
    float m = -1e30f;
#pragma unroll
    for (int kt = 0; kt < 16; ++kt)
#pragma unroll
      for (int r = 0; r < 4; ++r) m = fmaxf(m, sc[kt][r]);
    m = fmaxf(m, __shfl_xor(m, 16)); m = fmaxf(m, __shfl_xor(m, 32));
    float l = 0.f;
#pragma unroll
    for (int kt = 0; kt < 16; ++kt)
#pragma unroll
      for (int r = 0; r < 4; ++r) { const float e = __expf(sc[kt][r] - m); sc[kt][r] = e; l += e; }
    l += __shfl_xor(l, 16); l += __shfl_xor(l, 32);
    const float inv = 1.f / l;
    bf16x8 pf[8];
#pragma unroll
    for (int s = 0; s < 8; ++s) pf[s] = pack8(sc[2 * s], sc[2 * s + 1]);
    bf16_t* out = (bf16_t*)(ws + O_XATO) + trow * 512 + h * 128;
#pragma unroll
    for (int dt = 0; dt < 8; ++dt) {
      f32x4 a = {0.f, 0.f, 0.f, 0.f};
#pragma unroll
      for (int s = 0; s < 8; ++s) a = mfma16(ldfrag(vbase[s] + dt * 8192), pf[s], a);
      __builtin_amdgcn_sched_barrier(0);
      f32x4 o = {a[0] * inv, a[1] * inv, a[2] * inv, a[3] * inv};
      *(u32x2*)(out + 16 * dt + 4 * fq) = pack4(o);
    }
  }
}

DI void phase2(const Params& p, unsigned char* smem, int bid, int nb) {
  for (int rep = 0; rep < ((DUPMASK >> 20) & 1) + 1; ++rep) {
    if (nb == 256) {
      const int bh = bid & 7, k = bid >> 3;
      for (int j = 0; j < 4; ++j) { const int n = 127 - (k + 32 * j); gdn_prep_item(p, smem, (((bh >> 2) * 128 + n) << 2) + (bh & 3)); }
    } else {
      for (int it = bid; it < 1024; it += nb) gdn_prep_item(p, smem, it);
    }
  }
  for (int rep = 0; rep < ((DUPMASK >> 21) & 1) + 1; ++rep) for (int it = bid; it < 256; it += nb) sgu_item(p, smem, it);
  for (int rep = 0; rep < ((DUPMASK >> 22) & 1) + 1; ++rep) for (int it = bid; it < 256; it += nb) xattn_item(p, smem, it);
}

DI void gdn_scan4(const Params& p, unsigned char* smem_, int bh, int es) {
  int tid = threadIdx.x; asm volatile("" : "+v"(tid));
  unsigned char* smem; { LAS unsigned char* l_ = (LAS unsigned char*)smem_; asm volatile("" : "+v"(l_)); smem = (unsigned char*)l_; }
  const int lane = tid & 63, w = __builtin_amdgcn_readfirstlane(tid >> 6);
  if (w >= 4) {
    for (int n = 0; n < 128; ++n) __builtin_amdgcn_s_barrier();
    return;
  }
  unsigned char* ws = p.ws;
  const int b = bh >> 2, h = bh & 3;
  const int fr = lane & 15, fq = lane >> 4;
  const size_t item0 = (size_t)(b * 128) * 4 + h;
  constexpr size_t ISTR = 4 * 16384;
  const bf16_t* mp = (const bf16_t*)(ws + O_MP) + item0 * 16384 + (size_t)(2 * w) * 2048 + lane * 8;
  const bf16_t* bc = (const bf16_t*)(ws + O_BC) + item0 * 16384 + (size_t)es * 2048 + (size_t)w * 512 + lane * 8;
  bf16_t* st = (bf16_t*)(ws + O_ST) + item0 * 16384 + (size_t)(16 * es + fr) * 128 + 32 * w + 4 * fq;
  const float* glp = (const float*)(ws + O_GL) + item0;
  { GAS const float* g_ = (GAS const float*)glp; asm volatile("" : "+v"(g_)); glp = (const float*)g_; }
  f32x4 acc0 = {0.f, 0.f, 0.f, 0.f}, acc1 = {0.f, 0.f, 0.f, 0.f};
  constexpr int PD = 4;
  bf16x8 A[PD][8]; u32x4 C[PD]; float G[PD];
#pragma unroll
  for (int d = 0; d < PD; ++d) {
#pragma unroll
    for (int i = 0; i < 8; ++i) A[d][i] = ldfrag(mp + (size_t)d * ISTR + i * 512);
    C[d] = *(const u32x4*)(bc + (size_t)d * ISTR);
    G[d] = glp[d * 4];
  }
  unsigned char* xch = smem;
  for (int n0 = 0; n0 < 128; n0 += PD) {
#pragma unroll
    for (int d = 0; d < PD; ++d) {
      const int n = n0 + d;
      const int np = (n + PD < 128) ? n + PD : n;
      const u32x2 lo = pack4(acc0), hi = pack4(acc1);
      bf16_t* stn = st + (size_t)n * ISTR;
      *(u32x2*)(stn) = lo; *(u32x2*)(stn + 16) = hi;
      const u32x4 mine = {lo[0], lo[1], hi[0], hi[1]};
      *(u32x4*)(xch + ((n & 1) * 4 + w) * 1024 + lane * 16) = mine;
      asm volatile("s_waitcnt lgkmcnt(0)" ::: "memory");
      __builtin_amdgcn_s_barrier();
      asm volatile("" ::: "memory");
      bf16x8 bfr[4];
#pragma unroll
      for (int s = 0; s < 4; ++s) bfr[s] = ldfrag(xch + ((n & 1) * 4 + s) * 1024 + lane * 16);
      const float g = G[d];
      f32x4 a0 = {g * acc0[0] + lo2f(C[d][0]), g * acc0[1] + hi2f(C[d][0]), g * acc0[2] + lo2f(C[d][1]), g * acc0[3] + hi2f(C[d][1])};
      f32x4 a1 = {g * acc1[0] + lo2f(C[d][2]), g * acc1[1] + hi2f(C[d][2]), g * acc1[2] + lo2f(C[d][3]), g * acc1[3] + hi2f(C[d][3])};
#pragma unroll
      for (int s = 0; s < 4; ++s) { a0 = mfma16(A[d][s], bfr[s], a0); a1 = mfma16(A[d][4 + s], bfr[s], a1); }
      acc0 = a0; acc1 = a1;
#pragma unroll
      for (int i = 0; i < 8; ++i) A[d][i] = ldfrag(mp + (size_t)np * ISTR + i * 512);
      C[d] = *(const u32x4*)(bc + (size_t)np * ISTR);
      G[d] = glp[(size_t)np * 4];
    }
  }
}

struct EpiGate {
  const bf16_t* gates; int goff; const bf16_t* src; bf16_t* dst;
  DI void operator()(const f32x4 (&acc)[2][2][4][2], const pg::Unit& u, int wr, int wc, int fr, int fq) const {
#pragma unroll
    for (int ai = 0; ai < 2; ++ai)
#pragma unroll
      for (int m = 0; m < 4; ++m) {
        const size_t row = (size_t)u.pm * 256 + 128 * ai + 64 * wr + 16 * m + fr;
#pragma unroll
        for (int bj = 0; bj < 2; ++bj)
#pragma unroll
          for (int n = 0; n < 2; ++n) {
            const int col = u.pn * 256 + 128 * bj + 32 * wc + 16 * n + 4 * fq;
            const f32x4 v = acc[ai][bj][m][n];
            const u32x2 g = *(const u32x2*)(gates + row * 3072 + goff + col);
            f32x4 o = {lo2f(g[0]) * v[0], hi2f(g[0]) * v[1], lo2f(g[1]) * v[2], hi2f(g[1]) * v[3]};
            if (src) { const u32x2 s = *(const u32x2*)(src + row * 1024 + col); o[0] += lo2f(s[0]); o[1] += hi2f(s[0]); o[2] += lo2f(s[1]); o[3] += hi2f(s[1]); }
            *(u32x2*)(dst + row * 1024 + col) = pack4(o);
          }
      }
  }
};
DI void phase3(const Params& p, unsigned char* smem, int bid, int nb) {
  unsigned char* ws = p.ws;
  if (bid < 64) {
    __syncthreads();
    gdn_scan4(p, smem, bid & 7, bid >> 3);
  } else {
    PG_LAS unsigned char* lds = (PG_LAS unsigned char*)smem;
    const bf16_t* gates = (const bf16_t*)(ws + O_GATES);
    bf16_t* part = (bf16_t*)(ws + O_PART);
    __syncthreads();
    { pg::DenseOrder S; S.init(ws + O_SGUO, ws + O_WBT, T, 1024, 512, nb - 64, bid - 64); EpiGate E{gates, 1024, nullptr, part}; pg::gemm_phase<EpiGate, pg::DenseOrder, false, true>(lds, 512, S, E); }
    asm volatile("s_waitcnt vmcnt(0)" ::: "memory");
    __builtin_amdgcn_fence(__ATOMIC_ACQUIRE, "agent");
    asm volatile("s_waitcnt vmcnt(0)" ::: "memory");
    __syncthreads();
    { pg::DenseOrder S; S.init(ws + O_XATO, ws + O_WCT, T, 1024, 512, nb - 64, bid - 64); EpiGate E{gates, 2048, part, part}; pg::gemm_phase<EpiGate, pg::DenseOrder, false, true>(lds, 512, S, E); }
  }
}

DI void phase4(const Params& p, int bid, int nb) {
  int tid = threadIdx.x; asm volatile("" : "+v"(tid));
  const int lane = tid & 63, wave = tid >> 6, fr = lane & 15, fq = lane >> 4;
  unsigned char* ws = p.ws;
  for (int it = bid; it < 512; it += nb) {
    const int item = it * 2 + (wave >> 2), tt = wave & 3;
    const int h = item & 3, cn = item >> 2;
    const size_t trow = (size_t)cn * 64 + 16 * tt + fr;
    const bf16_t* qp = (const bf16_t*)(ws + O_QP) + (size_t)item * 8192 + (16 * tt + fr) * 128;
    const bf16_t* st = (const bf16_t*)(ws + O_ST) + (size_t)item * 16384;
    const float* o0 = (const float*)(ws + O_O0) + trow * 512 + h * 128;
    bf16x8 af[4];
#pragma unroll
    for (int ks = 0; ks < 4; ++ks) af[ks] = ldfrag(qp + 32 * ks + 8 * fq);
    f32x4 acc[8];
    float ss = 0.f;
#pragma unroll
    for (int j = 0; j < 8; ++j) {
      f32x4 a = *(const f32x4*)(o0 + 16 * j + 4 * fq);
#pragma unroll
      for (int ks = 0; ks < 4; ++ks) a = mfma16(ldfrag(st + (16 * j + fr) * 128 + 32 * ks + 8 * fq), af[ks], a);
      acc[j] = a;
      ss += a[0] * a[0] + a[1] * a[1] + a[2] * a[2] + a[3] * a[3];
    }
    ss += __shfl_xor(ss, 16); ss += __shfl_xor(ss, 32);
    const float rms = rsqrtf(ss * (1.f / 128.f) + 1e-6f);
    const float* ng = p.in[I_GNG];
    const bf16_t* zs = (const bf16_t*)(ws + O_ZS) + trow * 512 + h * 128;
    bf16_t* out = (bf16_t*)(ws + O_GDNO) + trow * 512 + h * 128;
#pragma unroll
    for (int j = 0; j < 8; ++j) {
      const int e0 = 16 * j + 4 * fq;
      const f32x4 g = *(const f32x4*)(ng + e0);
      const u32x2 z = *(const u32x2*)(zs + e0);
      f32x4 o = {acc[j][0] * rms * g[0] * lo2f(z[0]), acc[j][1] * rms * g[1] * hi2f(z[0]), acc[j][2] * rms * g[2] * lo2f(z[1]), acc[j][3] * rms * g[3] * hi2f(z[1])};
      *(u32x2*)(out + e0) = pack4(o);
    }
  }
}

DI void phase5(const Params& p, unsigned char* smem, int bid, int nb) {
  unsigned char* ws = p.ws;
  PG_LAS unsigned char* lds = (PG_LAS unsigned char*)smem;
  __syncthreads();
  pg::DenseOrder S; S.init(ws + O_GDNO, ws + O_WAT, T, 1024, 512, nb, bid);
  EpiGate E{(const bf16_t*)(ws + O_GATES), 0, (const bf16_t*)(ws + O_PART), (bf16_t*)(ws + O_MERGED)};
  pg::gemm_phase<EpiGate, pg::DenseOrder, false, true>(lds, 512, S, E);
}
struct EpiX1 {
  const float* x; float* x1;
  DI void operator()(const f32x4 (&acc)[2][2][4][2], const pg::Unit& u, int wr, int wc, int fr, int fq) const {
#pragma unroll
    for (int ai = 0; ai < 2; ++ai)
#pragma unroll
      for (int m = 0; m < 4; ++m) {
        const size_t row = (size_t)u.pm * 256 + 128 * ai + 64 * wr + 16 * m + fr;
#pragma unroll
        for (int bj = 0; bj < 2; ++bj)
#pragma unroll
          for (int n = 0; n < 2; ++n) {
            const int col = u.pn * 256 + 128 * bj + 32 * wc + 16 * n + 4 * fq;
            const f32x4 v = acc[ai][bj][m][n];
            const f32x4 xv = *(const f32x4*)(x + row * 1024 + col);
            f32x4 o = {ALPHA * xv[0] + v[0], ALPHA * xv[1] + v[1], ALPHA * xv[2] + v[2], ALPHA * xv[3] + v[3]};
            *(f32x4*)(x1 + row * 1024 + col) = o;
          }
      }
  }
};
DI void phase6(const Params& p, unsigned char* smem, int bid, int nb) {
  unsigned char* ws = p.ws;
  PG_LAS unsigned char* lds = (PG_LAS unsigned char*)smem;
  __syncthreads();
  pg::DenseOrder S; S.init(ws + O_MERGED, ws + O_WOT, T, 1024, 1024, nb, bid);
  EpiX1 E{p.in[I_X], (float*)(ws + O_X1)};
  pg::gemm_phase<EpiX1, pg::DenseOrder, false, false>(lds, 1024, S, E);
}

DI void ln_row(const float* src, const float* g, const float* b, float (&v)[16], int lane) {
  float s = 0.f;
#pragma unroll
  for (int i = 0; i < 16; ++i) s += v[i];
  const float mean = wave_sum(s) * (1.f / 1024.f);
  float q = 0.f;
#pragma unroll
  for (int i = 0; i < 16; ++i) { const float d = v[i] - mean; q += d * d; }
  const float rstd = rsqrtf(wave_sum(q) * (1.f / 1024.f) + 1e-5f);
#pragma unroll
  for (int i = 0; i < 4; ++i) {
    const int k = 256 * i + 4 * lane;
    const f32x4 gg = *(const f32x4*)(g + k), bb = *(const f32x4*)(b + k);
#pragma unroll
    for (int c = 0; c < 4; ++c) v[4 * i + c] = (v[4 * i + c] - mean) * rstd * gg[c] + bb[c];
  }
}
DI void phase7(const Params& p, int bid, int nb) {
  int tid = threadIdx.x; asm volatile("" : "+v"(tid));
  const int lane = tid & 63, wave = tid >> 6;
  unsigned char* ws = p.ws;
  for (int i = bid * NTHR + tid; i < MAXSLOT; i += nb * NTHR) { ((int*)(ws + O_SLOTTOK))[i] = 0; ((int*)(ws + O_SLOTAID))[i] = -1; }
  float* x1 = (float*)(ws + O_X1);
  bf16_t* x1b = (bf16_t*)(ws + O_X1B);
  for (int row = bid * 8 + wave; row < T; row += nb * 8) {
    float v[16];
#pragma unroll
    for (int i = 0; i < 4; ++i) { const f32x4 t = *(const f32x4*)(x1 + (size_t)row * D + 256 * i + 4 * lane); v[4 * i] = t[0]; v[4 * i + 1] = t[1]; v[4 * i + 2] = t[2]; v[4 * i + 3] = t[3]; }
    ln_row(nullptr, p.in[I_LN1G], p.in[I_LN1B], v, lane);
#pragma unroll
    for (int i = 0; i < 4; ++i) {
      const f32x4 o = {v[4 * i], v[4 * i + 1], v[4 * i + 2], v[4 * i + 3]};
      *(f32x4*)(x1 + (size_t)row * D + 256 * i + 4 * lane) = o;
      *(u32x2*)(x1b + (size_t)row * D + 256 * i + 4 * lane) = pack4(o);
    }
  }
}
struct EpiLogits {
  float* logits;
  DI void operator()(const f32x4 (&acc)[2][2][4][2], const pg::Unit& u, int wr, int wc, int fr, int fq) const {
#pragma unroll
    for (int ai = 0; ai < 2; ++ai)
#pragma unroll
      for (int m = 0; m < 4; ++m) {
        const size_t row = (size_t)u.pm * 256 + 128 * ai + 64 * wr + 16 * m + fr;
#pragma unroll
        for (int bj = 0; bj < 2; ++bj)
#pragma unroll
          for (int n = 0; n < 2; ++n) *(f32x4*)(logits + row * 256 + 128 * bj + 32 * wc + 16 * n + 4 * fq) = acc[ai][bj][m][n];
      }
  }
};
DI void phase8(const Params& p, unsigned char* smem, int bid, int nb);
DI void phase9(const Params& p, int bid, int nb) {
  int tid = threadIdx.x; asm volatile("" : "+v"(tid));
  const int lane = tid & 63, wave = tid >> 6;
  unsigned char* ws = p.ws;
  const float* logits = (const float*)(ws + O_LOGITS);
  int* counts = (int*)(ws + O_CTRL);
  const int g = lane & 7, tsub = lane >> 3;
  const float NEG = -__builtin_inff();
  float bias[32];
#pragma unroll
  for (int j4 = 0; j4 < 8; ++j4) { const f32x4 b4 = *(const f32x4*)(p.in[I_RB] + 32 * g + 4 * j4); bias[4 * j4] = b4[0]; bias[4 * j4 + 1] = b4[1]; bias[4 * j4 + 2] = b4[2]; bias[4 * j4 + 3] = b4[3]; }
  for (int tok0 = (bid * 8 + wave) * 8; tok0 < T; tok0 += nb * 64) {
    const int tok = tok0 + tsub;
    float sc[32], bz[32];
#pragma unroll
    for (int j4 = 0; j4 < 8; ++j4) {
      const f32x4 l4 = *(const f32x4*)(logits + (size_t)tok * 256 + 32 * g + 4 * j4);
#pragma unroll
      for (int c = 0; c < 4; ++c) { sc[4 * j4 + c] = sigmoidf_(l4[c]); bz[4 * j4 + c] = sc[4 * j4 + c] + bias[4 * j4 + c]; }
    }
    float m1 = NEG, m2 = NEG;
#pragma unroll
    for (int j = 0; j < 32; ++j) { const float v = bz[j]; if (v > m1) { m2 = m1; m1 = v; } else if (v > m2) m2 = v; }
    const float gs = m1 + m2;
    int rank = 0;
#pragma unroll
    for (int gg = 0; gg < 8; ++gg) { const float og = __shfl(gs, (lane & ~7) | gg); rank += ((og > gs) || (og == gs && gg < g)) ? 1 : 0; }
    if (rank >= 4) {
#pragma unroll
      for (int j = 0; j < 32; ++j) bz[j] = NEG;
    }
    int myidx = 0; float mysc = 0.f, ssum = 0.f;
#pragma unroll 1
    for (int k = 0; k < 8; ++k) {
      float bv = bz[0], bs = sc[0]; int bi = 0;
#pragma unroll
      for (int j = 1; j < 32; ++j) if (bz[j] > bv) { bv = bz[j]; bi = j; bs = sc[j]; }
      float rv = bv, rs = bs; int ri = 32 * g + bi;
#pragma unroll
      for (int o = 1; o < 8; o <<= 1) {
        const float ov = __shfl_xor(rv, o), os = __shfl_xor(rs, o); const int oi = __shfl_xor(ri, o);
        if (ov > rv || (ov == rv && oi < ri)) { rv = ov; ri = oi; rs = os; }
      }
      if ((ri >> 5) == g) {
        const int wj = ri & 31;
#pragma unroll
        for (int j = 0; j < 32; ++j) if (j == wj) bz[j] = NEG;
      }
      ssum += rs;
      if (g == k) { myidx = ri; mysc = rs; }
    }
    const int pos = atomicAdd(&counts[myidx * CSTR], 1);
    ((int*)(ws + O_TKIDX))[(size_t)tok * 8 + g] = myidx;
    ((float*)(ws + O_TKW))[(size_t)tok * 8 + g] = mysc / ssum * 2.5f;
    ((int*)(ws + O_TKPOS))[(size_t)tok * 8 + g] = pos;
  }
}
DI void build_tile_start(const Params& p, int* ts) {
  const int tid = threadIdx.x;
  const int* counts = (const int*)(p.ws + O_CTRL);
  __syncthreads();
  if (tid < 256) ts[300 + tid] = (counts[tid * CSTR] + 127) >> 7;
  __syncthreads();
  if (tid == 0) { int s = 0; for (int e = 0; e < 256; ++e) { ts[e] = s; s += ts[300 + e]; } ts[256] = s; }
  __syncthreads();
}
DI void phase10(const Params& p, unsigned char* smem, int bid, int nb) {
  int* ts = (int*)smem;
  build_tile_start(p, ts);
  unsigned char* ws = p.ws;
  const int* tkidx = (const int*)(ws + O_TKIDX); const int* tkpos = (const int*)(ws + O_TKPOS); const float* tkw = (const float*)(ws + O_TKW);
  int* slottok = (int*)(ws + O_SLOTTOK); float* slotw = (float*)(ws + O_SLOTW); int* slotaid = (int*)(ws + O_SLOTAID);
  for (int i = bid * NTHR + threadIdx.x; i < T * 8; i += nb * NTHR) {
    const int e = tkidx[i];
    const int slot = ts[e] * 128 + tkpos[i];
    slottok[slot] = i >> 3; slotw[slot] = tkw[i]; slotaid[slot] = i;
  }
}

DI int find_expert(const int* ts, int ti) { int lo = 0, hi = 255; while (lo < hi) { const int mid = (lo + hi + 1) >> 1; if (ts[mid] <= ti) lo = mid; else hi = mid - 1; } return lo; }

struct MoeUpF {
  const int* ts; unsigned char* ws; const float* wg; const float* wu; const float* wsg; const float* wsu; int ntile, G, c;
  DI bool next(int i, UnitF& u) const {
    const int L = i * G + (((G & 7) == 0) ? (c & 7) * (G >> 3) + (c >> 3) : c);
    if (L >= ntile * 2) {
      const int r = L - ntile * 2; if (r >= 256) return false;
      const int pn = r >> 7, ti = r & 127;
      u.A = (const bf16_t*)(ws + O_X1B); u.rows = nullptr; u.m0 = ti * 128; u.pn = pn; u.e = 256;
      u.W0 = wsg + 128 * pn; u.W1 = wsu + 128 * pn;
      return true;
    }
    const int pn = L / ntile, ti = L - pn * ntile;
    const int e = find_expert(ts, ti);
    u.A = (const bf16_t*)(ws + O_X1B); u.rows = (const int*)(ws + O_SLOTTOK) + ti * 128; u.m0 = ti * 128; u.pn = pn; u.e = e;
    u.W0 = wg + (size_t)e * 262144 + 128 * pn; u.W1 = wu + (size_t)e * 262144 + 128 * pn;
    return true;
  }
};
struct MoeDownF {
  const int* ts; unsigned char* ws; const float* wd; const float* wsd; int ntile, G, c;
  DI bool next(int i, UnitF& u) const {
    const int L = i * G + (((G & 7) == 0) ? (c & 7) * (G >> 3) + (c >> 3) : c);
    if (L >= ntile * 4) {
      const int r = L - ntile * 4; if (r >= 512) return false;
      const int pn = r >> 7, ti = r & 127;
      u.A = (const bf16_t*)(ws + O_ACTSH); u.rows = nullptr; u.m0 = ti * 128; u.pn = pn; u.e = 256;
      u.W0 = wsd + 256 * pn; u.W1 = u.W0 + 128;
      return true;
    }
    const int pn = L / ntile, ti = L - pn * ntile;
    const int e = find_expert(ts, ti);
    u.A = (const bf16_t*)(ws + O_ACT); u.rows = nullptr; u.m0 = ti * 128; u.pn = pn; u.e = e;
    u.W0 = wd + (size_t)e * 262144 + 256 * pn; u.W1 = u.W0 + 128;
    return true;
  }
};
struct EpiActF {
  bf16_t* actp; bf16_t* actsh;
  struct Pre { int dummy; };
  DI void prefetch(const UnitF&, int, int, Pre& p) const { p.dummy = 0; }
  DI void operator()(const f32x4 (&acc)[4][4], const UnitF& u, int wr, int wc, int fr, int fq, const Pre&, unsigned char* xch) const {
    if (wc >= 2) {
#pragma unroll
      for (int m = 0; m < 4; ++m) {
        unsigned char* dst = xch + (64 * wr + 16 * m + fr) * 256 + (((8 * (wc & 1) + 2 * fq) ^ (2 * (fr & 7))) << 4);
        u32x4 o0 = {pk2(acc[m][0][0], acc[m][1][0]), pk2(acc[m][2][0], acc[m][3][0]), pk2(acc[m][0][1], acc[m][1][1]), pk2(acc[m][2][1], acc[m][3][1])};
        u32x4 o1 = {pk2(acc[m][0][2], acc[m][1][2]), pk2(acc[m][2][2], acc[m][3][2]), pk2(acc[m][0][3], acc[m][1][3]), pk2(acc[m][2][3], acc[m][3][3])};
        *(u32x4*)dst = o0; *(u32x4*)(dst + 16) = o1;
      }
    }
    asm volatile("s_waitcnt lgkmcnt(0)" ::: "memory"); __builtin_amdgcn_s_barrier(); asm volatile("" ::: "memory");
    if (wc < 2) {
#pragma unroll
      for (int m = 0; m < 4; ++m) {
        const unsigned char* srcp = xch + (64 * wr + 16 * m + fr) * 256 + (((8 * wc + 2 * fq) ^ (2 * (fr & 7))) << 4);
        const u32x4 u0 = *(const u32x4*)srcp, u1 = *(const u32x4*)(srcp + 16);
        const size_t row = (size_t)u.m0 + 64 * wr + 16 * m + fr;
        u32x4 o0, o1;
#pragma unroll
        for (int r = 0; r < 2; ++r) {
          o0[2 * r] = pk2(siluf_(acc[m][0][r]) * lo2f(u0[2 * r]), siluf_(acc[m][1][r]) * hi2f(u0[2 * r]));
          o0[2 * r + 1] = pk2(siluf_(acc[m][2][r]) * lo2f(u0[2 * r + 1]), siluf_(acc[m][3][r]) * hi2f(u0[2 * r + 1]));
          o1[2 * r] = pk2(siluf_(acc[m][0][2 + r]) * lo2f(u1[2 * r]), siluf_(acc[m][1][2 + r]) * hi2f(u1[2 * r]));
          o1[2 * r + 1] = pk2(siluf_(acc[m][2][2 + r]) * lo2f(u1[2 * r + 1]), siluf_(acc[m][3][2 + r]) * hi2f(u1[2 * r + 1]));
        }
        bf16_t* dst = (u.e == 256 ? actsh : actp) + row * 256 + 128 * u.pn + 64 * wc + 16 * fq;
        *(u32x4*)dst = o0; *(u32x4*)(dst + 8) = o1;
      }
    }
    asm volatile("s_waitcnt lgkmcnt(0)" ::: "memory"); __builtin_amdgcn_s_barrier(); asm volatile("" ::: "memory");
  }
};
struct EpiDownF {
  const int* slotaid; const float* slotw; unsigned char* ybase; bf16_t* ysh;
  struct Pre { int aid[4]; float ww[4]; };
  DI void prefetch(const UnitF& u, int wr, int fr, Pre& p) const {
    const unsigned slot0 = (unsigned)u.m0 + 64u * wr + fr;
    if (u.e == 256) {
#pragma unroll
      for (int m = 0; m < 4; ++m) { p.aid[m] = (int)(slot0 + 16u * m); p.ww[m] = 1.f; }
    } else {
#pragma unroll
      for (int m = 0; m < 4; ++m) { p.aid[m] = slotaid[slot0 + 16u * m]; p.ww[m] = slotw[slot0 + 16u * m]; }
    }
  }
  DI void operator()(const f32x4 (&acc)[4][4], const UnitF& u, int wr, int wc, int fr, int fq, const Pre& p, unsigned char*) const {
    const unsigned colb = (unsigned)u.pn * 256u + 64u * wc + 16u * fq;
    if (u.e == 256) {
#pragma unroll
      for (int m = 0; m < 4; ++m) {
        bf16_t* dst = ysh + (size_t)p.aid[m] * 1024 + colb;
        u32x4 o0 = {pk2(acc[m][0][0], acc[m][1][0]), pk2(acc[m][2][0], acc[m][3][0]), pk2(acc[m][0][1], acc[m][1][1]), pk2(acc[m][2][1], acc[m][3][1])};
        u32x4 o1 = {pk2(acc[m][0][2], acc[m][1][2]), pk2(acc[m][2][2], acc[m][3][2]), pk2(acc[m][0][3], acc[m][1][3]), pk2(acc[m][2][3], acc[m][3][3])};
        *(u32x4*)dst = o0; *(u32x4*)(dst + 8) = o1;
      }
      return;
    }
#pragma unroll
    for (int m = 0; m < 4; ++m) {
      if (p.aid[m] >= 0) {
        const unsigned off = (unsigned)p.aid[m] * 1024u + colb;
        const float sw = p.ww[m] * 64.0f;
        u32x4 o;
#pragma unroll
        for (int r = 0; r < 4; ++r) {
          unsigned w_ = 0u;
          w_ = __builtin_amdgcn_cvt_pk_fp8_f32(acc[m][0][r] * sw, acc[m][1][r] * sw, w_, false);
          w_ = __builtin_amdgcn_cvt_pk_fp8_f32(acc[m][2][r] * sw, acc[m][3][r] * sw, w_, true);
          o[r] = w_;
        }
        *(u32x4*)(ybase + (size_t)off) = o;
      }
    }
  }
};
struct EpiAct {
  bf16_t* actp;
  DI void operator()(const f32x4 (&acc)[2][2][4][2], const pg::Unit& u, int wr, int wc, int fr, int fq) const {
#pragma unroll
    for (int ai = 0; ai < 2; ++ai)
#pragma unroll
      for (int m = 0; m < 4; ++m) {
        const size_t row = (size_t)u.pm * 256 + 128 * ai + 64 * wr + 16 * m + fr;
#pragma unroll
        for (int bj = 0; bj < 2; ++bj) {
          const int blk = 8 * u.pn + 4 * bj + wc;
          const f32x4 g = acc[ai][bj][m][0], uu = acc[ai][bj][m][1];
          f32x4 o = {siluf_(g[0]) * uu[0], siluf_(g[1]) * uu[1], siluf_(g[2]) * uu[2], siluf_(g[3]) * uu[3]};
          *(u32x2*)(actp + row * 256 + blk * 16 + 4 * fq) = pack4(o);
        }
      }
  }
};
struct EpiBf16Out {
  bf16_t* dst;
  DI void operator()(const f32x4 (&acc)[2][2][4][2], const pg::Unit& u, int wr, int wc, int fr, int fq) const {
#pragma unroll
    for (int ai = 0; ai < 2; ++ai)
#pragma unroll
      for (int m = 0; m < 4; ++m) {
        const size_t row = (size_t)u.pm * 256 + 128 * ai + 64 * wr + 16 * m + fr;
#pragma unroll
        for (int bj = 0; bj < 2; ++bj)
#pragma unroll
          for (int n = 0; n < 2; ++n) *(u32x2*)(dst + row * 1024 + u.pn * 256 + 128 * bj + 32 * wc + 16 * n + 4 * fq) = pack4(acc[ai][bj][m][n]);
      }
  }
};
struct RouterF {
  unsigned char* ws; const float* rw; int G, c;
  DI bool next(int i, UnitF& u) const {
    const int L = i * G + c; if (L >= 128) return false;
    u.A = (const bf16_t*)(ws + O_X1B); u.rows = nullptr; u.m0 = L * 128; u.pn = 0; u.e = 0; u.W0 = rw; u.W1 = rw + 128; return true;
  }
};
struct EpiLogitsF {
  float* logits;
  struct Pre { int dummy; };
  DI void prefetch(const UnitF&, int, int, Pre& p) const { p.dummy = 0; }
  DI void operator()(const f32x4 (&acc)[4][4], const UnitF& u, int wr, int wc, int fr, int fq, const Pre&, unsigned char*) const {
#pragma unroll
    for (int m = 0; m < 4; ++m) {
      float* dst = logits + ((size_t)u.m0 + 64 * wr + 16 * m + fr) * 256 + 64 * wc + 16 * fq;
#pragma unroll
      for (int r = 0; r < 4; ++r) { const f32x4 o = {acc[m][0][r], acc[m][1][r], acc[m][2][r], acc[m][3][r]}; *(f32x4*)(dst + 4 * r) = o; }
    }
  }
};
DI void phase8(const Params& p, unsigned char* smem, int bid, int nb) {
  RouterF S{p.ws, p.in[I_RW], nb, bid};
  EpiLogitsF E{(float*)(p.ws + O_LOGITS)};
  gemmF_phase<false, EpiLogitsF, RouterF>(smem, 1024, 1024, 256, S, E);
}
DI void phase11(const Params& p, unsigned char* smem, int bid, int nb) {
  unsigned char* ws = p.ws;
  int* ts = (int*)(smem + 131072);
  build_tile_start(p, ts);
  MoeUpF S{ts, ws, p.in[I_WG], p.in[I_WU], p.in[I_WSG], p.in[I_WSU], ts[256], nb, bid};
  EpiActF E{(bf16_t*)(ws + O_ACT), (bf16_t*)(ws + O_ACTSH)};
  gemmF_phase<false, EpiActF, MoeUpF>(smem, 1024, 1024, 256, S, E);
}
DI void phase12(const Params& p, unsigned char* smem, int bid, int nb) {
  unsigned char* ws = p.ws;
  int* ts = (int*)(smem + 131072);
  build_tile_start(p, ts);
  MoeDownF S{ts, ws, p.in[I_WDN], p.in[I_WSD], ts[256], nb, bid};
  EpiDownF E{(const int*)(ws + O_SLOTAID), (const float*)(ws + O_SLOTW), ws + O_Y, (bf16_t*)(ws + O_YSH)};
  gemmF_phase<false, EpiDownF, MoeDownF>(smem, 256, 256, 1024, S, E);
}
DI void phase13(const Params& p, int bid, int nb) {
  int tid = threadIdx.x; asm volatile("" : "+v"(tid));
  const int lane = tid & 63, wave = tid >> 6;
  unsigned char* ws = p.ws;
  const float* x1 = (const float*)(ws + O_X1);
  const bf16_t* ysh = (const bf16_t*)(ws + O_YSH);
  const unsigned char* y8 = ws + O_Y;
  for (int row = bid * 8 + wave; row < T; row += nb * 8) {
    float v[16];
#pragma unroll
    for (int i = 0; i < 4; ++i) {
      const int k = 256 * i + 4 * lane;
      const f32x4 t = *(const f32x4*)(x1 + (size_t)row * D + k);
      const u32x2 s = *(const u32x2*)(ysh + (size_t)row * D + k);
      v[4 * i] = ALPHA * t[0] + lo2f(s[0]); v[4 * i + 1] = ALPHA * t[1] + hi2f(s[0]); v[4 * i + 2] = ALPHA * t[2] + lo2f(s[1]); v[4 * i + 3] = ALPHA * t[3] + hi2f(s[1]);
    }
    float rs[16];
#pragma unroll
    for (int i = 0; i < 16; ++i) rs[i] = 0.f;
#pragma unroll
    for (int k8 = 0; k8 < 8; ++k8) {
#pragma unroll
      for (int i = 0; i < 4; ++i) {
        const unsigned s = *(const unsigned*)(y8 + ((size_t)row * 8 + k8) * 1024 + 256 * i + 4 * lane);
        const f32x2_ lo = __builtin_amdgcn_cvt_pk_f32_fp8(s, false), hi = __builtin_amdgcn_cvt_pk_f32_fp8(s, true);
        rs[4 * i] += lo[0]; rs[4 * i + 1] += lo[1]; rs[4 * i + 2] += hi[0]; rs[4 * i + 3] += hi[1];
      }
    }
#pragma unroll
    for (int i = 0; i < 16; ++i) v[i] += rs[i] * (1.0f / 64.0f);
    ln_row(nullptr, p.in[I_LN2G], p.in[I_LN2B], v, lane);
#pragma unroll
    for (int i = 0; i < 4; ++i) { const f32x4 o = {v[4 * i], v[4 * i + 1], v[4 * i + 2], v[4 * i + 3]}; *(f32x4*)(p.out + (size_t)row * D + 256 * i + 4 * lane) = o; }
  }
}

DI void load_params(Params& lp, const unsigned char* smem) {
  const unsigned* t = (const unsigned*)(smem + PTAB_OFF);
#pragma unroll
  for (int i = 0; i < 28; ++i) lp.in[i] = (const float*)(GAS const float*)(((unsigned long long)(unsigned)__builtin_amdgcn_readfirstlane((int)t[2 * i + 1]) << 32) | (unsigned)__builtin_amdgcn_readfirstlane((int)t[2 * i]));
  lp.out = (float*)(GAS float*)(((unsigned long long)(unsigned)__builtin_amdgcn_readfirstlane((int)t[57]) << 32) | (unsigned)__builtin_amdgcn_readfirstlane((int)t[56]));
  lp.ws = (unsigned char*)(GAS unsigned char*)(((unsigned long long)(unsigned)__builtin_amdgcn_readfirstlane((int)t[59]) << 32) | (unsigned)__builtin_amdgcn_readfirstlane((int)t[58]));
}
__global__ void __launch_bounds__(NTHR) mega_kernel(Params pk) {
  extern __shared__ __attribute__((aligned(16))) unsigned char smem[];
  cg::grid_group grid = cg::this_grid();
  const int bid = blockIdx.x, nb = gridDim.x;
  volatile LAS unsigned* bst = (volatile LAS unsigned*)(smem + LDS_BYTES - 16);
  if (threadIdx.x < 4) bst[threadIdx.x] = 0u;
  if (threadIdx.x < 30) {
    const __attribute__((address_space(4))) unsigned long long* ka = (const __attribute__((address_space(4))) unsigned long long*)__builtin_amdgcn_kernarg_segment_ptr();
    ((unsigned long long*)(smem + PTAB_OFF))[threadIdx.x] = ka[threadIdx.x];
  }
  unsigned* barw = (unsigned*)(pk.ws + O_BAR);
  __syncthreads();
  XcdBarrier xb = xcd_barrier_post(barw, bst);
#define GSYNC() xcd_barrier(xb)
#define RUNP(k, call) do { { Params p; load_params(p, smem); call; } GSYNC(); if (DUPMASK & (1 << (k))) { { Params p; load_params(p, smem); call; } GSYNC(); } } while (0)
  { Params p; load_params(p, smem); phase0(p, smem, bid, nb); } grid.sync();
  RUNP(1, phase1(p, smem, bid, nb));
  RUNP(2, phase2(p, smem, bid, nb));
  RUNP(3, phase3(p, smem, bid, nb));
  RUNP(4, phase4(p, bid, nb));
  RUNP(5, phase5(p, smem, bid, nb));
  RUNP(6, phase6(p, smem, bid, nb));
  RUNP(14, phase7(p, bid, nb));
  if (DUPMASK & (1 << 7)) { { Params p; load_params(p, smem); phase6(p, smem, bid, nb); } GSYNC(); { Params p; load_params(p, smem); phase7(p, bid, nb); } GSYNC(); }
  RUNP(8, phase8(p, smem, bid, nb));
  RUNP(14, phase9(p, bid, nb));
  if (DUPMASK & (1 << 9)) { { Params p; load_params(p, smem); if (bid == 0 && threadIdx.x < 256) ((int*)(p.ws + O_CTRL))[threadIdx.x * CSTR] = 0; } GSYNC(); { Params p; load_params(p, smem); phase9(p, bid, nb); } GSYNC(); }
  RUNP(10, phase10(p, smem, bid, nb));
  RUNP(11, phase11(p, smem, bid, nb));
  RUNP(12, phase12(p, smem, bid, nb));
  { Params p; load_params(p, smem); phase13(p, bid, nb); }
  if (DUPMASK & (1 << 13)) { GSYNC(); Params p; load_params(p, smem); phase13(p, bid, nb); }
  if (DUPMASK & (1 << 15)) { for (int i = 0; i < 10; ++i) GSYNC(); }
}

extern "C" void kernel_launch(void* const* d_in, const int* in_sizes, int n_in, void* d_out, int out_size, void* d_ws, size_t ws_size, hipStream_t stream) {
  if (n_in != 28 || ws_size < WS_NEED) { fprintf(stderr, "kernel_launch: unexpected inputs (%d) or workspace (%zu < %zu)\n", n_in, ws_size, (size_t)WS_NEED); return; }
  static int grid_blocks = 0;
  if (!grid_blocks) {
    int dev = 0, cus = 0, per_cu = 0;
    (void)hipGetDevice(&dev);
    (void)hipDeviceGetAttribute(&cus, hipDeviceAttributeMultiprocessorCount, dev);
    (void)hipFuncSetAttribute((const void*)mega_kernel, hipFuncAttributeMaxDynamicSharedMemorySize, LDS_BYTES);
    (void)hipOccupancyMaxActiveBlocksPerMultiprocessor(&per_cu, (const void*)mega_kernel, NTHR, LDS_BYTES);
    if (per_cu < 1) per_cu = 1;
    if (per_cu > 1) per_cu = 1;
    grid_blocks = cus * per_cu;
    if (grid_blocks < 32) grid_blocks = 32;
  }
  Params p{};
  for (int i = 0; i < 28; ++i) p.in[i] = (const float*)d_in[i];
  p.out = (float*)d_out; p.ws = (unsigned char*)d_ws;
  (void)hipMemsetAsync((unsigned char*)d_ws + O_BAR, 0, 16384 + 256, stream);
  void* args[] = {&p};
  hipError_t e = hipLaunchCooperativeKernel((const void*)mega_kernel, dim3(grid_blocks), dim3(NTHR), args, LDS_BYTES, stream);
  if (e != hipSuccess) fprintf(stderr, "cooperative launch failed: %s (grid %d)\n", hipGetErrorString(e), grid_blocks);
}
```

```cpp
#include <hip/hip_runtime.h>
#include <hip/hip_cooperative_groups.h>
#include <stdint.h>
#include <stdio.h>
namespace cg = cooperative_groups;

#define DI __device__ __forceinline__
#define LAS __attribute__((address_space(3)))
#define GAS __attribute__((address_space(1)))
typedef unsigned short bf16_t;
typedef short bf16x8 __attribute__((ext_vector_type(8)));
typedef float f32x4 __attribute__((ext_vector_type(4)));
typedef unsigned u32x4 __attribute__((ext_vector_type(4)));
typedef unsigned u32x2 __attribute__((ext_vector_type(2)));

#ifndef DUPMASK
#define DUPMASK 0
#endif
constexpr int NTHR = 512;
constexpr int T = 16384, SEQ = 8192, D = 1024;
constexpr int NPROJ = 6656;
constexpr int DIN = 6664;
constexpr int NEXP = 256, DEXP = 256;
constexpr int MOE_BM = 256;
constexpr int MAXSLOT = 131072 + 256 * MOE_BM;
constexpr float ALPHA = 1.189207115002721f;
constexpr int LDS_BYTES = 157696;

constexpr size_t MB = 1u << 20;
constexpr size_t O_WGU = 0;
constexpr size_t O_WD = 256 * MB;
constexpr size_t O_WSGU = 384 * MB;
constexpr size_t O_WSD = 385 * MB;
constexpr size_t O_ROUT = 385 * MB + 512 * 1024;
constexpr size_t O_CTRL = 386 * MB;
constexpr size_t O_BAR = 386 * MB + 128 * 1024;
constexpr int CSTR = 64;
constexpr size_t O_SUBBAR = 386 * MB + 128 * 1024 + 16384;
constexpr size_t O_IDENT = 386 * MB + 256 * 1024;
constexpr size_t O_X1 = 387 * MB;
constexpr size_t O_X1B = 451 * MB;
constexpr size_t R0 = 483 * MB;
constexpr size_t O_XB = R0 + 0;
constexpr size_t O_ST = R0 + 0;
constexpr size_t O_WINT = R0 + 32 * MB;
constexpr size_t O_WAT = R0 + 45 * MB;
constexpr size_t O_WBT = R0 + 46 * MB;
constexpr size_t O_WCT = R0 + 47 * MB;
constexpr size_t O_WOT = R0 + 48 * MB;
constexpr size_t O_WMKV = R0 + 50 * MB;
constexpr size_t O_MEMB = R0 + 52 * MB;
constexpr size_t O_SGUW = R0 + 53 * MB;
constexpr size_t O_AB = R0 + 53 * MB + 512 * 1024;
constexpr size_t O_MEMK = R0 + 54 * MB;
constexpr size_t O_MEMVT = R0 + 54 * MB + 512 * 1024;
constexpr size_t O_QKV = R0 + 55 * MB;
constexpr size_t O_PART = R0 + 55 * MB;
constexpr size_t O_ZS = R0 + 103 * MB;
constexpr size_t O_UVG = R0 + 119 * MB;
constexpr size_t O_MERGED = R0 + 119 * MB;
constexpr size_t O_XQ = R0 + 151 * MB;
constexpr size_t O_GATES = R0 + 167 * MB;
constexpr size_t O_MP = R0 + 263 * MB;
constexpr size_t O_BC = R0 + 295 * MB;
constexpr size_t O_O0 = R0 + 359 * MB;
constexpr size_t O_QP = R0 + 391 * MB;
constexpr size_t O_GL = R0 + 407 * MB;
constexpr size_t O_GDNO = R0 + 408 * MB;
constexpr size_t O_SGUO = R0 + 424 * MB;
constexpr size_t O_XATO = R0 + 440 * MB;
constexpr size_t O_LOGITS = R0 + 0;
constexpr size_t O_TKIDX = R0 + 16 * MB;
constexpr size_t O_TKW = R0 + 16 * MB + 512 * 1024;
constexpr size_t O_TKPOS = R0 + 17 * MB;
constexpr size_t O_SLOTTOK = R0 + 18 * MB;
constexpr size_t O_SLOTW = R0 + 19 * MB;
constexpr size_t O_SLOTAID = R0 + 20 * MB;
constexpr size_t O_ACT = R0 + 21 * MB;
constexpr size_t O_ACTSH = R0 + 181 * MB;
constexpr size_t O_YSH = R0 + 189 * MB;
constexpr size_t O_Y = R0 + 221 * MB;
constexpr size_t WS_NEED = R0 + 477 * MB;

struct Params {
  const float* in[28];
  float* out;
  unsigned char* ws;
};
enum { I_X = 0, I_MEM, I_WIN, I_CONVW, I_ALOG, I_DTB, I_GNG, I_WA, I_SLNG, I_SLNB, I_SGUW, I_SGUB, I_WB, I_WMKV, I_WC, I_WO,
       I_LN1G, I_LN1B, I_RW, I_RB, I_WG, I_WU, I_WDN, I_WSG, I_WSU, I_WSD, I_LN2G, I_LN2B };

constexpr int PTAB_OFF = 156672;
DI float bf2f(bf16_t h) { return __uint_as_float(((unsigned)h) << 16); }
DI bf16_t f2bf(float f) { unsigned u = __float_as_uint(f); u += 0x7fffu + ((u >> 16) & 1u); return (bf16_t)(u >> 16); }
typedef float f32x2_ __attribute__((ext_vector_type(2)));
typedef __bf16 bf16x2_ __attribute__((ext_vector_type(2)));
DI unsigned pk2(float lo, float hi) { f32x2_ v = {lo, hi}; return __builtin_bit_cast(unsigned, __builtin_convertvector(v, bf16x2_)); }
DI float lo2f(unsigned u) { return __uint_as_float(u << 16); }
DI float hi2f(unsigned u) { return __uint_as_float(u & 0xffff0000u); }
DI float sigmoidf_(float x) { return __builtin_amdgcn_rcpf(1.f + __builtin_amdgcn_exp2f(-1.4426950408889634f * x)); }
DI float siluf_(float x) { return x * sigmoidf_(x); }
DI float geluf_(float x) { return x * sigmoidf_(1.5957691216057308f * (x + 0.044715f * x * x * x)); }
DI float softplusf_(float x) { return fmaxf(x, 0.f) + log1pf(__expf(-fabsf(x))); }
DI float wave_sum(float v) {
#pragma unroll
  for (int o = 32; o; o >>= 1) v += __shfl_xor(v, o);
  return v;
}
DI f32x4 mfma16(bf16x8 a, bf16x8 b, f32x4 c) { return __builtin_amdgcn_mfma_f32_16x16x32_bf16(a, b, c, 0, 0, 0); }
DI bf16x8 ldfrag(const void* p) { return __builtin_bit_cast(bf16x8, *(const u32x4*)p); }
DI bf16x8 pack8(f32x4 a, f32x4 b) { u32x4 r = {pk2(a[0], a[1]), pk2(a[2], a[3]), pk2(b[0], b[1]), pk2(b[2], b[3])}; return __builtin_bit_cast(bf16x8, r); }
DI u32x2 pack4(f32x4 a) { u32x2 r = {pk2(a[0], a[1]), pk2(a[2], a[3])}; return r; }
DI int sw128(int row, int chunk) { return row * 128 + ((chunk ^ (row & 7)) << 4); }
DI int sw256(int row, int chunk) { return row * 256 + ((chunk ^ (row & 15)) << 4); }

namespace pg {
#define PG_LAS __attribute__((address_space(3)))
constexpr int BM = 256, BK = 64, HALF = 128, HTB = HALF * BK * 2, NXCD = 8, WGM = 8;
DI int lds_byte(int r, int c) { const int st = (r >> 4) * 2 + (c >> 5), rr = r & 15, cc = c & 31, ob = rr * 64 + cc * 2; return st * 1024 + (ob ^ (((ob >> 9) & 1) << 5)); }
DI void stage_rc(int b, int& R, int& C) { const int st = b / 1024, sb = b % 1024, swz = sb ^ (((sb >> 9) & 1) << 5); R = (st >> 1) * 16 + swz / 64; C = (st & 1) * 32 + (swz % 64) / 2; }

struct Unit { const char* a; const char* b; const int* rows; int pm, pn, e; };

struct DenseOrder {
  const char* A; const char* B; int nM, nN, nwg, G, c; size_t tstep;
  DI void init(const void* A_, const void* B_, int M, int N, int K, int G_, int c_) { A = (const char*)A_; B = (const char*)B_; nM = M / BM; nN = N / BM; nwg = nM * nN; G = G_; c = c_; tstep = (size_t)BM * K * 2; }
  DI bool next(int i, Unit& u) const { const long L = (long)i * G + c; if (L >= nwg) return false; unit_of(L, u); return true; }
  DI void unit_of(long L, Unit& u) const {
    int wgid = (int)L; { const int q = nwg / NXCD, r = nwg % NXCD, xcd = wgid % NXCD, off = wgid / NXCD; wgid = (xcd < r ? xcd * (q + 1) : r * (q + 1) + (xcd - r) * q) + off; }
    const int nig = WGM * nN, gid = wgid / nig, fm = gid * WGM, gsz = (nM - fm) < WGM ? (nM - fm) : WGM;
    u.pm = fm + ((wgid % nig) % gsz); u.pn = (wgid % nig) / gsz; u.e = 0; u.rows = nullptr;
    u.a = A + (size_t)u.pm * tstep; u.b = B + (size_t)u.pn * tstep;
  }
};

template <class Epi, class Sched, bool GATHER, bool ALIGN_EPI>
DI void gemm_phase(PG_LAS unsigned char* lds, const int K, const Sched& S, const Epi& E) {
  int tid = threadIdx.x; asm volatile("" : "+v"(tid));
  const int wid = __builtin_amdgcn_readfirstlane(tid >> 6), lane = tid & 63, wr = wid >> 2, wc = wid & 3, fr = lane & 15, fq = lane >> 4;
  const int nt = K / BK;
  int Rr[2], Cc[2];
  unsigned voffB[2];
#pragma unroll
  for (int i = 0; i < 2; ++i) { stage_rc(tid * 16 + i * 8192, Rr[i], Cc[i]); voffB[i] = (unsigned)(Rr[i] * K + Cc[i]) * 2u; }
  const size_t kstep = (size_t)(BK * 2);
  const size_t hstep = (size_t)HALF * K * 2;
  const unsigned ldsw = (unsigned)wid * 1024u;
  const int aoff = lds_byte(wr * 64 + fr, fq * 8), boff = lds_byte(wc * 32 + fr, fq * 8);
#define PG_SA(b, h) (((b) * 2 + (h)) * HTB)
#define PG_SB(b, h) ((4 + (b) * 2 + (h)) * HTB)
#define PG_STAGE(bufoff, gbase, v0, v1) do { \
    __builtin_amdgcn_global_load_lds((const unsigned*)((const char*)(gbase) + (v0)), (PG_LAS unsigned*)(lds + (bufoff) + ldsw), 16, 0, 0); \
    __builtin_amdgcn_global_load_lds((const unsigned*)((const char*)(gbase) + (v1)), (PG_LAS unsigned*)(lds + (bufoff) + ldsw + 8192), 16, 0, 0); } while (0)
#define PG_LDA(dst, b, h) do { _Pragma("unroll") for (int m = 0; m < 4; ++m) _Pragma("unroll") for (int k = 0; k < 2; ++k) dst[m][k] = *(const PG_LAS bf16x8*)(lds + PG_SA(b, h) + aoff + m * 2048 + k * 1024); } while (0)
#define PG_LDB(dst, b, h) do { _Pragma("unroll") for (int n = 0; n < 2; ++n) _Pragma("unroll") for (int k = 0; k < 2; ++k) dst[n][k] = *(const PG_LAS bf16x8*)(lds + PG_SB(b, h) + boff + n * 2048 + k * 1024); } while (0)
#define PG_MMA(ai, bj, At, Bt) do { __builtin_amdgcn_s_setprio(1); _Pragma("unroll") for (int m = 0; m < 4; ++m) _Pragma("unroll") for (int n = 0; n < 2; ++n) _Pragma("unroll") for (int k = 0; k < 2; ++k) \
    acc[ai][bj][m][n] = __builtin_amdgcn_mfma_f32_16x16x32_bf16(Bt[n][k], At[m][k], acc[ai][bj][m][n], 0, 0, 0); __builtin_amdgcn_s_setprio(0); } while (0)
#define PG_WAIT_V(n) asm volatile("s_waitcnt vmcnt(" #n ")" ::: "memory")
#define PG_WAIT_L(n) asm volatile("s_waitcnt lgkmcnt(" #n ")" ::: "memory")
#define PG_BAR __builtin_amdgcn_s_barrier()
#define PG_SCHED __builtin_amdgcn_sched_barrier(0)
#define PG_AOFFS(u, o00, o01, o10, o11) do { if (GATHER) { \
      o00 = (unsigned)(u).rows[Rr[0]] * (unsigned)(K * 2) + (unsigned)Cc[0] * 2u; o01 = (unsigned)(u).rows[Rr[1]] * (unsigned)(K * 2) + (unsigned)Cc[1] * 2u; \
      o10 = (unsigned)(u).rows[128 + Rr[0]] * (unsigned)(K * 2) + (unsigned)Cc[0] * 2u; o11 = (unsigned)(u).rows[128 + Rr[1]] * (unsigned)(K * 2) + (unsigned)Cc[1] * 2u; \
    } else { o00 = voffB[0]; o01 = voffB[1]; o10 = voffB[0] + (unsigned)hstep; o11 = voffB[1] + (unsigned)hstep; } } while (0)
  Unit cur, nxt; int ui = 0;
  if (!S.next(0, cur)) return;
  f32x4 acc[2][2][4][2];
#pragma unroll
  for (int a = 0; a < 2; ++a)
#pragma unroll
    for (int b = 0; b < 2; ++b)
#pragma unroll
      for (int m = 0; m < 4; ++m)
#pragma unroll
        for (int n = 0; n < 2; ++n) acc[a][b][m][n] = (f32x4){0.f, 0.f, 0.f, 0.f};
  bf16x8 At[4][2], B0[2][2], B1[2][2];
  const char* cA = cur.a; const char* cB = cur.b;
  unsigned c00, c01, c10, c11;
  PG_AOFFS(cur, c00, c01, c10, c11);
  const unsigned vb0 = voffB[0], vb1 = voffB[1];
  PG_STAGE(PG_SB(0, 0), cB, vb0, vb1); PG_STAGE(PG_SB(0, 1), cB + hstep, vb0, vb1); PG_STAGE(PG_SA(0, 0), cA, c00, c01); PG_STAGE(PG_SA(0, 1), cA, c10, c11);
  if (wr == 1) PG_BAR;
  PG_WAIT_V(2); PG_BAR;
  PG_STAGE(PG_SB(1, 0), cB + kstep, vb0, vb1); PG_STAGE(PG_SA(1, 0), cA + kstep, c00, c01); PG_STAGE(PG_SB(1, 1), cB + hstep + kstep, vb0, vb1);
  PG_WAIT_V(6); PG_BAR;
  for (;;) {
    const bool has_next = S.next(ui + 1, nxt);
    const char* nA = has_next ? nxt.a : cA; const char* nB = has_next ? nxt.b : cB;
    unsigned n00 = c00, n01 = c01, n10 = c10, n11 = c11;
    if (has_next) PG_AOFFS(nxt, n00, n01, n10, n11);
#pragma unroll 1
    for (int t = 0; t < nt; t += 2) {
      const bool last = (t == nt - 2);
      const char* a1 = cA + (size_t)(t + 1) * kstep;
      const char* a2 = last ? nA : cA + (size_t)(t + 2) * kstep; const char* b2 = last ? nB : cB + (size_t)(t + 2) * kstep;
      const char* a3 = a2 + kstep; const char* b3 = b2 + kstep;
      const unsigned o00 = last ? n00 : c00, o01 = last ? n01 : c01, o10 = last ? n10 : c10, o11 = last ? n11 : c11;
      PG_LDB(B0, 0, 0); PG_LDB(B1, 0, 1); PG_SCHED; PG_LDA(At, 0, 0); PG_STAGE(PG_SA(1, 1), a1, c10, c11);
      PG_WAIT_V(8); PG_WAIT_L(0); PG_BAR; PG_MMA(0, 0, At, B0); PG_MMA(0, 1, At, B1); PG_BAR; PG_SCHED;
      PG_LDA(At, 0, 1); PG_STAGE(PG_SB(0, 0), b2, vb0, vb1); PG_STAGE(PG_SB(0, 1), b2 + hstep, vb0, vb1); PG_STAGE(PG_SA(0, 0), a2, o00, o01);
      PG_WAIT_V(8); PG_WAIT_L(0); PG_BAR; PG_MMA(1, 0, At, B0); PG_MMA(1, 1, At, B1); PG_BAR; PG_SCHED;
      PG_LDB(B0, 1, 0); PG_LDB(B1, 1, 1); PG_SCHED; PG_LDA(At, 1, 0); PG_STAGE(PG_SA(0, 1), a2, o10, o11);
      PG_WAIT_V(8); PG_WAIT_L(0); PG_BAR; PG_MMA(0, 0, At, B0); PG_MMA(0, 1, At, B1); PG_BAR; PG_SCHED;
      PG_LDA(At, 1, 1); PG_STAGE(PG_SB(1, 0), b3, vb0, vb1); PG_STAGE(PG_SB(1, 1), b3 + hstep, vb0, vb1); PG_STAGE(PG_SA(1, 0), a3, o00, o01);
      PG_WAIT_V(8); PG_WAIT_L(0); PG_BAR; PG_MMA(1, 0, At, B0); PG_MMA(1, 1, At, B1); PG_BAR; PG_SCHED;
    }
    if constexpr (ALIGN_EPI) { if (wr == 0) PG_BAR; }
    E(acc, cur, wr, wc, fr, fq);
    if (!has_next) break;
#pragma unroll
    for (int a = 0; a < 2; ++a)
#pragma unroll
      for (int b = 0; b < 2; ++b)
#pragma unroll
        for (int m = 0; m < 4; ++m)
#pragma unroll
          for (int n = 0; n < 2; ++n) acc[a][b][m][n] = (f32x4){0.f, 0.f, 0.f, 0.f};
    cur = nxt; cA = nA; cB = nB; c00 = n00; c01 = n01; c10 = n10; c11 = n11; ++ui;
    if constexpr (ALIGN_EPI) { if (wr == 1) PG_BAR; }
  }
  PG_WAIT_V(0);
  if constexpr (!ALIGN_EPI) { if (wr == 0) PG_BAR; }
  PG_BAR;
#undef PG_SA
#undef PG_SB
#undef PG_STAGE
#undef PG_LDA
#undef PG_LDB
#undef PG_MMA
#undef PG_WAIT_V
#undef PG_WAIT_L
#undef PG_BAR
#undef PG_SCHED
#undef PG_AOFFS
}
}


struct UnitF { const bf16_t* A; const int* rows; const float* W0; const float* W1; int m0, pn, e; };

template <bool AMUL, class Epi, class Sched, int ABL = 0>
DI void gemmF_phase(unsigned char* smem_, const int K, const int lda, const int ldw, const Sched& S, const Epi& E) {
  int tid = threadIdx.x; asm volatile("" : "+v"(tid));
  unsigned char* smem; { LAS unsigned char* l_ = (LAS unsigned char*)smem_; asm volatile("" : "+v"(l_)); smem = (unsigned char*)l_; }
  const int lane = tid & 63, wid = tid >> 6, wr = wid >> 2, wc = wid & 3, fr = lane & 15, fq = lane >> 4;
  const int nk = K >> 6;
  const int ar0 = tid >> 3, ac = tid & 7;
  const int q = tid & 63, half = q >> 5, g0 = 4 * (q & 31);
  int vrow[4];
#pragma unroll
  for (int i = 0; i < 4; ++i) vrow[i] = 64 * (q >> 4) + 16 * i + (q & 15);
  const int aw0 = sw128(ar0, ac), aw1 = sw128(ar0 + 64, ac);
#define F_ROWS(u, rr0, rr1) do { rr0 = (u).rows ? (size_t)(u).rows[ar0] : (size_t)((u).m0 + ar0); rr1 = (u).rows ? (size_t)(u).rows[ar0 + 64] : (size_t)((u).m0 + ar0 + 64); } while (0)
#define F_LOAD(A_, W0_, W1_, rr0_, rr1_, kk_, va0, va1, vb0, vb1, vw) do { \
    va0 = *(const u32x4*)((A_) + (rr0_) * lda + (kk_) * 64 + ac * 8); va1 = *(const u32x4*)((A_) + (rr1_) * lda + (kk_) * 64 + ac * 8); \
    if (AMUL) { vb0 = *(const u32x4*)((A_) + (rr0_) * lda + 256 + (kk_) * 64 + ac * 8); vb1 = *(const u32x4*)((A_) + (rr1_) * lda + 256 + (kk_) * 64 + ac * 8); } \
    const float* wp_ = (half ? (W1_) : (W0_)) + (size_t)((kk_) * 64 + 8 * wid) * ldw + g0; \
    if (ABL != 1) { _Pragma("unroll") for (int j = 0; j < 8; ++j) vw[j] = *(const f32x4*)(wp_ + (size_t)j * ldw); } } while (0)
#define F_LOADX(kx, va0, va1, vb0, vb1, vw) do { const bool nx_ = (kx) >= nk; const int kk2_ = nx_ ? (kx) - nk : (kx); \
    const bf16_t* A2_ = nx_ ? nxt.A : cur.A; const float* W02_ = nx_ ? nxt.W0 : cur.W0; const float* W12_ = nx_ ? nxt.W1 : cur.W1; \
    const size_t q0_ = nx_ ? nr0 : r0, q1_ = nx_ ? nr1 : r1; \
    F_LOAD(A2_, W02_, W12_, q0_, q1_, kk2_, va0, va1, vb0, vb1, vw); } while (0)
#define F_STORE(st, va0, va1, vb0, vb1, vw) do { unsigned char* sa_ = smem + (st) * 49152; \
    if (AMUL) { _Pragma("unroll") for (int e_ = 0; e_ < 4; ++e_) { va0[e_] = pk2(lo2f(va0[e_]) * lo2f(vb0[e_]), hi2f(va0[e_]) * hi2f(vb0[e_])); va1[e_] = pk2(lo2f(va1[e_]) * lo2f(vb1[e_]), hi2f(va1[e_]) * hi2f(vb1[e_])); } } \
    *(u32x4*)(sa_ + aw0) = va0; *(u32x4*)(sa_ + aw1) = va1; \
    if (ABL != 3) { _Pragma("unroll") for (int i = 0; i < 4; ++i) { \
      u32x4 o_ = {pk2(vw[0][i], vw[1][i]), pk2(vw[2][i], vw[3][i]), pk2(vw[4][i], vw[5][i]), pk2(vw[6][i], vw[7][i])}; \
      *(u32x4*)(sa_ + 16384 + sw128(vrow[i], wid)) = o_; } } else { _Pragma("unroll") for (int j = 0; j < 8; ++j) asm volatile("" :: "v"(vw[j])); } } while (0)
#define F_LBAR() do { asm volatile("s_waitcnt lgkmcnt(0)" ::: "memory"); __builtin_amdgcn_s_barrier(); asm volatile("" ::: "memory"); } while (0)
#define F_COMPUTE(st) do { const unsigned char* sA = smem + (st) * 49152; const unsigned char* sB = sA + 16384; \
    _Pragma("unroll") for (int ks = 0; ks < 2; ++ks) { bf16x8 af[4], bfr[4]; \
      _Pragma("unroll") for (int m = 0; m < 4; ++m) af[m] = ldfrag(sA + sw128(64 * wr + 16 * m + fr, 4 * ks + fq)); \
      _Pragma("unroll") for (int n = 0; n < 4; ++n) bfr[n] = ldfrag(sB + sw128(64 * wc + 16 * n + fr, 4 * ks + fq)); \
      if (ABL != 2) { _Pragma("unroll") for (int m = 0; m < 4; ++m) _Pragma("unroll") for (int n = 0; n < 4; ++n) acc[m][n] = mfma16(bfr[n], af[m], acc[m][n]); } \
      else { _Pragma("unroll") for (int m = 0; m < 4; ++m) _Pragma("unroll") for (int n = 0; n < 4; ++n) asm volatile("" :: "v"(af[m]), "v"(bfr[n])); } } } while (0)
  UnitF cur, nxt; int ui = 0;
  if (!S.next(0, cur)) return;
  size_t r0, r1, nr0, nr1;
  F_ROWS(cur, r0, r1);
  bool has_next = S.next(1, nxt);
  if (has_next) F_ROWS(nxt, nr0, nr1); else { nxt = cur; nr0 = r0; nr1 = r1; }
  f32x4 acc[4][4];
#pragma unroll
  for (int m = 0; m < 4; ++m)
#pragma unroll
    for (int n = 0; n < 4; ++n) acc[m][n] = (f32x4){0.f, 0.f, 0.f, 0.f};
  u32x4 xa0, xa1, ya0, ya1, xb0, xb1, yb0, yb1; f32x4 xw[8], yw[8];
  xb0 = xb1 = yb0 = yb1 = (u32x4){0u, 0u, 0u, 0u};
  if (ABL == 1) { _Pragma("unroll") for (int j = 0; j < 8; ++j) { xw[j] = (f32x4){0.f, 0.f, 0.f, 0.f}; yw[j] = xw[j]; } }
  F_LOAD(cur.A, cur.W0, cur.W1, r0, r1, 0, xa0, xa1, xb0, xb1, xw);
  F_LOAD(cur.A, cur.W0, cur.W1, r0, r1, 1, ya0, ya1, yb0, yb1, yw);
  __syncthreads();
  F_STORE(0, xa0, xa1, xb0, xb1, xw);
  F_LBAR();
  int st = 0;
  for (;;) {
    typename Epi::Pre pre; E.prefetch(cur, wr, fr, pre);
#pragma unroll 1
    for (int kt = 0; kt < nk; kt += 2) {
      F_LOADX(kt + 2, xa0, xa1, xb0, xb1, xw);
      F_COMPUTE(st);
      F_STORE(st ^ 1, ya0, ya1, yb0, yb1, yw);
      F_LBAR();
      F_LOADX(kt + 3, ya0, ya1, yb0, yb1, yw);
      F_COMPUTE(st ^ 1);
      F_STORE(st, xa0, xa1, xb0, xb1, xw);
      F_LBAR();
    }
    if (ABL != 4) E(acc, cur, wr, wc, fr, fq, pre, smem + (st ^ 1) * 49152); else { _Pragma("unroll") for (int m = 0; m < 4; ++m) _Pragma("unroll") for (int n = 0; n < 4; ++n) asm volatile("" :: "v"(acc[m][n])); }
#pragma unroll
    for (int m = 0; m < 4; ++m)
#pragma unroll
      for (int n = 0; n < 4; ++n) acc[m][n] = (f32x4){0.f, 0.f, 0.f, 0.f};
    if (!has_next) break;
    cur = nxt; r0 = nr0; r1 = nr1; ++ui;
    has_next = S.next(ui + 1, nxt);
    if (has_next) F_ROWS(nxt, nr0, nr1); else { nxt = cur; nr0 = r0; nr1 = r1; }
  }
  asm volatile("s_waitcnt vmcnt(0)" ::: "memory");
  __syncthreads();
#undef F_ROWS
#undef F_LOAD
#undef F_LOADX
#undef F_STORE
#undef F_LBAR
#undef F_COMPUTE
}

#define XB_TMO      128
#define XB_XCNT(j)  (256  + 64 * (j))
#define XB_XSUB(j)  (1280 + 64 * (j))
#define XB_XGEN(j)  (2304 + 64 * (j))
#define XB_TOP      3328
#define XB_TOPGEN   3392
#define XCD_BAR_WORDS 3456
#define XB_SPIN_CAP (1u << 22)
DI unsigned xb_ld(unsigned* p)              { return __hip_atomic_load(p, __ATOMIC_RELAXED, __HIP_MEMORY_SCOPE_AGENT); }
DI unsigned xb_add(unsigned* p, unsigned v) { return __hip_atomic_fetch_add(p, v, __ATOMIC_RELAXED, __HIP_MEMORY_SCOPE_AGENT); }
DI unsigned xb_xcc_id() { return (unsigned)__builtin_amdgcn_s_getreg((3 << 11) | 20) & 0xFu; }
#define XB_SPIN(cond, bar) do { unsigned _sp = 0; while (cond) { __builtin_amdgcn_s_sleep(1); \
    if ((++_sp & 255u) == 0u) { if (xb_ld(&(bar)[XB_TMO])) break; if (_sp > XB_SPIN_CAP) { atomicAdd(&(bar)[XB_TMO], 1u); break; } } } } while (0)
struct XcdBarrier { unsigned* bar; unsigned x; volatile LAS unsigned* st; };
DI XcdBarrier xcd_barrier_post(unsigned* bar, volatile LAS unsigned* st) {
  XcdBarrier b; b.bar = bar; b.x = xb_xcc_id(); b.st = st;
  if (threadIdx.x == 0) (void)xb_add(&bar[XB_XCNT(b.x)], 1u);
  return b;
}
DI void xcd_barrier_complete(unsigned* bar, unsigned x, unsigned& nloc, unsigned& nx) {
  const unsigned G = gridDim.x * gridDim.y * gridDim.z;
  unsigned sum, cnt, mine, sp = 0u;
  for (;;) {
    sum = 0u; cnt = 0u; mine = 0u;
#pragma unroll
    for (unsigned j = 0; j < 16; ++j) { const unsigned c = xb_ld(&bar[XB_XCNT(j)]); sum += c; cnt += (c > 0u) ? 1u : 0u; mine = (j == x) ? c : mine; }
    if (sum == G) break;
    __builtin_amdgcn_s_sleep(1);
    if ((++sp & 255u) == 0u) { if (xb_ld(&bar[XB_TMO])) break; if (sp > XB_SPIN_CAP) { atomicAdd(&bar[XB_TMO], 1u); break; } }
  }
  nloc = mine > 0u ? mine : 1u; nx = cnt > 0u ? cnt : 1u;
}
DI void xcd_barrier(const XcdBarrier& b) {
  asm volatile("s_waitcnt vmcnt(0)" ::: "memory");
  __syncthreads();
  if (threadIdx.x == 0) {
    unsigned* bar = b.bar;
    __builtin_amdgcn_s_waitcnt(0);
    unsigned nloc = b.st[0], nx = b.st[1];
    if (nloc == 0u) { xcd_barrier_complete(bar, b.x, nloc, nx); b.st[0] = nloc; b.st[1] = nx; }
    const unsigned old = xb_add(&bar[XB_XSUB(b.x)], 1u);
    const unsigned gen = old / nloc;
    if (old + 1u == (gen + 1u) * nloc) {
      __builtin_amdgcn_fence(__ATOMIC_RELEASE, "agent");
      asm volatile("s_waitcnt vmcnt(0)" ::: "memory");
      const unsigned og = xb_add(&bar[XB_TOP], 1u);
      const unsigned tg = og / nx;
      if (og + 1u == (tg + 1u) * nx) xb_add(&bar[XB_TOPGEN], 1u);
      else XB_SPIN(xb_ld(&bar[XB_TOPGEN]) == tg, bar);
      __builtin_amdgcn_fence(__ATOMIC_ACQUIRE, "agent");
      xb_add(&bar[XB_XGEN(b.x)], 1u);
      asm volatile("s_waitcnt vmcnt(0)" ::: "memory");
    } else {
      XB_SPIN(xb_ld(&bar[XB_XGEN(b.x)]) == gen, bar);
      __builtin_amdgcn_fence(__ATOMIC_ACQUIRE, "agent");
      asm volatile("s_waitcnt vmcnt(0)" ::: "memory");
    }
  }
  __syncthreads();
}

DI void phase0(const Params& p, unsigned char* smem, int bid, int nb) {
  int tid = threadIdx.x; asm volatile("" : "+v"(tid));
  const int lane = tid & 63, wave = tid >> 6;
  unsigned char* ws = p.ws;
  if (bid == 0 && tid < 256) ((int*)(ws + O_CTRL))[tid * CSTR] = 0;
  for (int i = bid * NTHR + tid; i < T; i += nb * NTHR) ((int*)(ws + O_IDENT))[i] = i;
  {
    float* wabT = (float*)smem;
    const float* win = p.in[I_WIN];
    for (int i = tid; i < 8192; i += NTHR) { const int k = i >> 3, j = i & 7; wabT[j * 1024 + k] = win[(size_t)k * DIN + 2048 + j]; }
    __syncthreads();
    const float* x = p.in[I_X];
    bf16_t* xb = (bf16_t*)(ws + O_XB);
    float* ab = (float*)(ws + O_AB);
    for (int row = bid * 8 + wave; row < T; row += nb * 8) {
      float s[8];
#pragma unroll
      for (int j = 0; j < 8; ++j) s[j] = 0.f;
#pragma unroll
      for (int i = 0; i < 4; ++i) {
        const int k = 256 * i + 4 * lane;
        const f32x4 v = *(const f32x4*)(x + (size_t)row * D + k);
        *(u32x2*)(xb + (size_t)row * D + k) = pack4(v);
#pragma unroll
        for (int j = 0; j < 8; ++j) { const f32x4 w = *(const f32x4*)(wabT + j * 1024 + k); s[j] += v[0] * w[0] + v[1] * w[1] + v[2] * w[2] + v[3] * w[3]; }
      }
#pragma unroll
      for (int j = 0; j < 8; ++j) s[j] = wave_sum(s[j]);
      if (lane == 0) { *(f32x4*)(ab + (size_t)row * 8) = (f32x4){s[0], s[1], s[2], s[3]}; *(f32x4*)(ab + (size_t)row * 8 + 4) = (f32x4){s[4], s[5], s[6], s[7]}; }
    }
    const float* mem = p.in[I_MEM];
    bf16_t* memb = (bf16_t*)(ws + O_MEMB);
    for (int row = bid * 8 + wave; row < 512; row += nb * 8) {
#pragma unroll
      for (int i = 0; i < 4; ++i) { const int k = 256 * i + 4 * lane; *(u32x2*)(memb + (size_t)row * D + k) = pack4(*(const f32x4*)(mem + (size_t)row * D + k)); }
    }
    const float* sw = p.in[I_SGUW];
    bf16_t* sguw = (bf16_t*)(ws + O_SGUW);
    for (int i = bid * NTHR + tid; i < 16384; i += nb * NTHR) {
      const int e0 = i * 4; const int col = e0 & 127, rowi = (e0 >> 7) & 127;
      f32x4 v = *(const f32x4*)(sw + e0);
#pragma unroll
      for (int c = 0; c < 4; ++c) if (col + c > rowi) v[c] = 0.f;
      *(u32x2*)(sguw + e0) = pack4(v);
    }
    __syncthreads();
  }
  {
    float* tile = (float*)smem;
    const float *pwin = p.in[I_WIN], *pwa = p.in[I_WA], *pwb = p.in[I_WB], *pwc = p.in[I_WC], *pwo = p.in[I_WO], *pwmkv = p.in[I_WMKV], *prw = p.in[I_RW],
                *pwsg = p.in[I_WSG], *pwsu = p.in[I_WSU], *pwsd = p.in[I_WSD], *pwg = p.in[I_WG], *pwu = p.in[I_WU], *pwdn = p.in[I_WDN];
    { GAS const float *a_ = (GAS const float*)pwa, *b_ = (GAS const float*)pwb, *c_ = (GAS const float*)pwc, *o_ = (GAS const float*)pwo, *m_ = (GAS const float*)pwmkv;
      asm volatile("" : "+s"(a_), "+s"(b_), "+s"(c_), "+s"(o_), "+s"(m_));
      pwa = (const float*)a_; pwb = (const float*)b_; pwc = (const float*)c_; pwo = (const float*)o_; pwmkv = (const float*)m_; }
    constexpr int J0 = 1664, J1 = J0 + 128, J2 = J1 + 128, J3 = J2 + 128, J4 = J3 + 256, J5 = J4 + 256, J6 = J5 + 64, J7 = J6 + 128, J8 = J7 + 64,
                  J9 = J8, J10 = J8;
    const int kr = tid >> 4, nc = tid & 15, sg = nc >> 2;
    const int tn = tid >> 3, tkc = tid & 7;
#define P0_DECODE_LOAD(it0, dp, v0, v1) do { const float* sp[4]; int ld[4]; \
      _Pragma("unroll") \
      for (int q = 0; q < 4; ++q) { \
        const int it = (it0 + q < J10) ? it0 + q : J10 - 1;      \
        const float *s0, *s1, *s2, *s3; int ldd; bf16_t* dst; \
        if (it < J0) {           \
          const int kt = it & 15, nt = it >> 4; const int n0 = nt * 64; const int c0 = n0 + (n0 >= 2048 ? 8 : 0); \
          const float* b = pwin + (size_t)kt * 64 * DIN + c0; s0 = b; s1 = b + 16; s2 = b + 32; s3 = b + 48; ld[q] = DIN; ldd = 1024; \
          dst = (bf16_t*)(ws + O_WINT) + (size_t)n0 * 1024 + kt * 64; \
        } else if (it < J3) {    \
          const int which = (it - J0) >> 7, r = (it - J0) & 127; const int kt = r & 7, nt = r >> 3; \
          const float* src = which == 0 ? pwa : which == 1 ? pwb : pwc; \
          const float* b = src + (size_t)kt * 64 * 1024 + nt * 64; s0 = b; s1 = b + 16; s2 = b + 32; s3 = b + 48; ld[q] = 1024; ldd = 512; \
          dst = (bf16_t*)(ws + (which == 0 ? O_WAT : which == 1 ? O_WBT : O_WCT)) + (size_t)nt * 64 * 512 + kt * 64; \
        } else if (it < J5) {    \
          const int which = (it - J3) >> 8, r = (it - J3) & 255; const int kt = r & 15, nt = r >> 4; \
          const float* b = (which == 0 ? pwo : pwmkv) + (size_t)kt * 64 * 1024 + nt * 64; s0 = b; s1 = b + 16; s2 = b + 32; s3 = b + 48; ld[q] = 1024; ldd = 1024; \
          dst = (bf16_t*)(ws + (which == 0 ? O_WOT : O_WMKV)) + (size_t)nt * 64 * 1024 + kt * 64; \
        } else if (it < J6) {    \
          const int r = it - J5; const int kt = r & 15, nt = r >> 4; \
          const float* b = prw + (size_t)kt * 64 * 256 + nt * 64; s0 = b; s1 = b + 16; s2 = b + 32; s3 = b + 48; ld[q] = 256; ldd = 1024; \
          dst = (bf16_t*)(ws + O_ROUT) + (size_t)nt * 64 * 1024 + kt * 64; \
        } else if (it < J7) {    \
          const int r = it - J6; const int kt = r & 15, nt = r >> 4; \
          const float* g = pwsg + (size_t)kt * 64 * 256 + nt * 32; const float* u = pwsu + (size_t)kt * 64 * 256 + nt * 32; \
          s0 = g; s1 = u; s2 = g + 16; s3 = u + 16; ld[q] = 256; ldd = 1024; \
          dst = (bf16_t*)(ws + O_WSGU) + (size_t)nt * 64 * 1024 + kt * 64; \
        } else if (it < J8) {    \
          const int r = it - J7; const int kt = r & 3, nt = r >> 2; \
          const float* b = pwsd + (size_t)kt * 64 * 1024 + nt * 64; s0 = b; s1 = b + 16; s2 = b + 32; s3 = b + 48; ld[q] = 1024; ldd = 256; \
          dst = (bf16_t*)(ws + O_WSD) + (size_t)nt * 64 * 256 + kt * 64; \
        } else if (it < J9) {    \
          const int r = it - J8; const int e = r >> 7, qq = r & 127; const int kt = qq & 15, nt = qq >> 4; \
          const float* g = pwg + (size_t)e * 262144 + (size_t)kt * 64 * 256 + nt * 32; const float* u = pwu + (size_t)e * 262144 + (size_t)kt * 64 * 256 + nt * 32; \
          s0 = g; s1 = u; s2 = g + 16; s3 = u + 16; ld[q] = 256; ldd = 1024; \
          dst = (bf16_t*)(ws + O_WGU) + (size_t)e * 524288 + (size_t)nt * 64 * 1024 + kt * 64; \
        } else {                 \
          const int r = it - J9; const int e = r >> 6, qq = r & 63; const int kt = qq & 3, nt = qq >> 2; \
          const float* b = pwdn + (size_t)e * 262144 + (size_t)kt * 64 * 1024 + nt * 64; s0 = b; s1 = b + 16; s2 = b + 32; s3 = b + 48; ld[q] = 1024; ldd = 256; \
          dst = (bf16_t*)(ws + O_WD) + (size_t)e * 262144 + (size_t)nt * 64 * 256 + kt * 64; \
        } \
        sp[q] = (sg == 0 ? s0 : sg == 1 ? s1 : sg == 2 ? s2 : s3) + (size_t)kr * ld[q] + 4 * (nc & 3); \
        dp[q] = dst + (size_t)tn * ldd + 8 * tkc; \
      } \
      _Pragma("unroll") \
      for (int q = 0; q < 4; ++q) { v0[q] = __builtin_nontemporal_load((const f32x4*)(sp[q])); v1[q] = __builtin_nontemporal_load((const f32x4*)(sp[q] + (size_t)32 * ld[q])); } } while (0)
    bf16_t* dpn[4]; f32x4 v0n[4], v1n[4];
    int it0 = bid * 4;
    if (it0 < J10) P0_DECODE_LOAD(it0, dpn, v0n, v1n);
    for (; it0 < J10; it0 += nb * 4) {
      bf16_t* dp[4]; f32x4 v0[4], v1[4];
#pragma unroll
      for (int q = 0; q < 4; ++q) { dp[q] = dpn[q]; v0[q] = v0n[q]; v1[q] = v1n[q]; }
      if (it0 + nb * 4 < J10) P0_DECODE_LOAD(it0 + nb * 4, dpn, v0n, v1n);
      asm volatile("s_waitcnt lgkmcnt(0)" ::: "memory"); __builtin_amdgcn_s_barrier(); asm volatile("" ::: "memory");
#pragma unroll
      for (int q = 0; q < 4; ++q) {
        float* t0 = tile + q * 4160 + kr * 65 + 4 * nc;
        float* t1 = t0 + 32 * 65;
        t0[0] = v0[q][0]; t0[1] = v0[q][1]; t0[2] = v0[q][2]; t0[3] = v0[q][3];
        t1[0] = v1[q][0]; t1[1] = v1[q][1]; t1[2] = v1[q][2]; t1[3] = v1[q][3];
      }
      asm volatile("s_waitcnt lgkmcnt(0)" ::: "memory"); __builtin_amdgcn_s_barrier(); asm volatile("" ::: "memory");
#pragma unroll
      for (int q = 0; q < 4; ++q) {
        float e[8];
#pragma unroll
        for (int j = 0; j < 8; ++j) e[j] = tile[q * 4160 + (8 * tkc + j) * 65 + tn];
        u32x4 o = {pk2(e[0], e[1]), pk2(e[2], e[3]), pk2(e[4], e[5]), pk2(e[6], e[7])};
        *(u32x4*)(dp[q]) = o;
      }
    }
#undef P0_DECODE_LOAD
  }
}

#define EPI_ROWS(u) const int row_ = (u).pm * 256 + 64 * wr + fr
struct EpiInProj {
  unsigned char* ws;
  DI void operator()(const f32x4 (&acc)[2][2][4][2], const pg::Unit& u, int wr, int wc, int fr, int fq) const {
    const int colt = u.pn * 256;
#pragma unroll
    for (int ai = 0; ai < 2; ++ai)
#pragma unroll
      for (int m = 0; m < 4; ++m) {
        const size_t row = (size_t)u.pm * 256 + 128 * ai + 64 * wr + 16 * m + fr;
#pragma unroll
        for (int bj = 0; bj < 2; ++bj)
#pragma unroll
          for (int n = 0; n < 2; ++n) {
            const int col = colt + 128 * bj + 32 * wc + 16 * n + 4 * fq;
            f32x4 v = acc[ai][bj][m][n];
            if (colt < 1536) { *(u32x2*)((bf16_t*)(ws + O_QKV) + row * 1536 + col) = pack4(v); }
            else if (colt < 2048) {
#pragma unroll
              for (int c = 0; c < 4; ++c) v[c] = siluf_(v[c]);
              *(u32x2*)((bf16_t*)(ws + O_ZS) + row * 512 + (col - 1536)) = pack4(v);
            } else if (colt < 3072) {
#pragma unroll
              for (int c = 0; c < 4; ++c) v[c] = geluf_(v[c]);
              *(u32x2*)((bf16_t*)(ws + O_UVG) + row * 1024 + (col - 2048)) = pack4(v);
            } else if (colt < 3584) {
#pragma unroll
              for (int c = 0; c < 4; ++c) v[c] *= 0.08838834764831845f;
              *(u32x2*)((bf16_t*)(ws + O_XQ) + row * 512 + (col - 3072)) = pack4(v);
            } else {
#pragma unroll
              for (int c = 0; c < 4; ++c) v[c] = sigmoidf_(v[c]);
              *(u32x2*)((bf16_t*)(ws + O_GATES) + row * 3072 + (col - 3584)) = pack4(v);
            }
          }
      }
  }
};
struct EpiMemKV {
  unsigned char* ws;
  DI void operator()(const f32x4 (&acc)[2][2][4][2], const pg::Unit& u, int wr, int wc, int fr, int fq) const {
#pragma unroll
    for (int ai = 0; ai < 2; ++ai)
#pragma unroll
      for (int m = 0; m < 4; ++m) {
        const int row = u.pm * 256 + 128 * ai + 64 * wr + 16 * m + fr; const int b = row >> 8, key = row & 255;
#pragma unroll
        for (int bj = 0; bj < 2; ++bj)
#pragma unroll
          for (int n = 0; n < 2; ++n) {
            const int col = u.pn * 256 + 128 * bj + 32 * wc + 16 * n + 4 * fq;
            const f32x4 v = acc[ai][bj][m][n];
            if (col < 512) { const int h = col >> 7, d = col & 127; *(u32x2*)((bf16_t*)(ws + O_MEMK) + ((size_t)((b * 4 + h) * 256 + key)) * 128 + d) = pack4(v); }
            else {
              const int c2 = col - 512; const int h = c2 >> 7, d = c2 & 127;
              const int pos = 32 * (key >> 5) + 8 * ((key >> 2) & 3) + 4 * ((key >> 4) & 1) + (key & 3);
              bf16_t* vt = (bf16_t*)(ws + O_MEMVT) + ((size_t)((b * 4 + h) * 128 + d)) * 256 + pos;
#pragma unroll
              for (int c = 0; c < 4; ++c) vt[(size_t)c * 256] = f2bf(v[c]);
            }
          }
      }
  }
};
struct P1Order {
  pg::DenseOrder D; const char* memb; const char* wmkv; int G, c;
  DI bool next(int i, pg::Unit& u) const {
    const long L = (long)i * G + c;
    if (L < D.nwg) { D.unit_of(L, u); u.e = 0; return true; }
    const int r = (int)(L - D.nwg); if (r >= 8) return false;
    u.pm = r & 1; u.pn = r >> 1; u.e = 1; u.rows = nullptr;
    u.a = memb + (size_t)u.pm * 524288; u.b = wmkv + (size_t)u.pn * 524288; return true;
  }
};
struct EpiP1 {
  EpiInProj a; EpiMemKV b;
  DI void operator()(const f32x4 (&acc)[2][2][4][2], const pg::Unit& u, int wr, int wc, int fr, int fq) const {
    asm volatile("" : "+v"(fr), "+v"(fq));
    if (u.e) b(acc, u, wr, wc, fr, fq); else a(acc, u, wr, wc, fr, fq);
  }
};
DI void phase1(const Params& p, unsigned char* smem, int bid, int nb) {
  unsigned char* ws = p.ws;
  PG_LAS unsigned char* lds = (PG_LAS unsigned char*)smem;
  __syncthreads();
  P1Order S; S.D.init(ws + O_XB, ws + O_WINT, T, NPROJ, 1024, nb, bid); S.memb = (const char*)(ws + O_MEMB); S.wmkv = (const char*)(ws + O_WMKV); S.G = nb; S.c = bid;
  EpiP1 E{EpiInProj{ws}, EpiMemKV{ws}};
  pg::gemm_phase<EpiP1, P1Order, false, true>(lds, 1024, S, E);
}

constexpr int G_KF = 0, G_VF = 32768, G_QB = 65536, G_KB = 81920, G_UT = 81920  , G_L = 98304, G_ATT = 114688, G_KDT = 122880, G_WT = 139264, G_SM = 155648;

DI void gdn_prep_item(const Params& p, unsigned char* smem_, int item) {
  unsigned char* smem; { LAS unsigned char* l_ = (LAS unsigned char*)smem_; asm volatile("" : "+v"(l_)); smem = (unsigned char*)l_; }
  int tid = threadIdx.x; asm volatile("" : "+v"(tid));
  const int lane = tid & 63, wave = tid >> 6, fr = lane & 15, fq = lane >> 4;
  unsigned char* ws; { GAS unsigned char* g_ = (GAS unsigned char*)p.ws; asm volatile("" : "+s"(g_)); ws = (unsigned char*)g_; }
  const int h = item & 3, cn = item >> 2;
  const int bidx = cn >> 7, n = cn & 127;
  const size_t t0 = (size_t)bidx * SEQ + (size_t)n * 64;
  float* kf = (float*)(smem + G_KF); float* vf = (float*)(smem + G_VF); float* Lm = (float*)(smem + G_L);
  float* sbeta = (float*)(smem + G_SM); float* sgc = sbeta + 64; float* segc = sbeta + 128;
  __syncthreads();
  {
    const bf16_t* qkv = (const bf16_t*)(ws + O_QKV);
    const float* cw = p.in[I_CONVW];
    const int tl0 = wave * 8;
#pragma unroll
    for (int sect = 0; sect < 3; ++sect) {
      const int cb = sect * 512 + h * 128 + 2 * lane;
      float w0[4], w1[4];
#pragma unroll
      for (int i = 0; i < 4; ++i) { w0[i] = cw[i * 1536 + cb]; w1[i] = cw[i * 1536 + cb + 1]; }
      float xa[11], xc[11];
#pragma unroll
      for (int r = 0; r < 11; ++r) {
        const int s = n * 64 + tl0 + r - 3;
        unsigned u = 0u;
        if (s >= 0) u = *(const unsigned*)(qkv + ((size_t)bidx * SEQ + s) * 1536 + cb);
        xa[r] = lo2f(u); xc[r] = hi2f(u);
      }
#pragma unroll
      for (int r = 0; r < 8; ++r) {
        float y0 = w0[0] * xa[r] + w0[1] * xa[r + 1] + w0[2] * xa[r + 2] + w0[3] * xa[r + 3];
        float y1 = w1[0] * xc[r] + w1[1] * xc[r + 1] + w1[2] * xc[r + 2] + w1[3] * xc[r + 3];
        y0 = siluf_(y0); y1 = siluf_(y1);
        const int tl = tl0 + r;
        if (sect == 2) { vf[tl * 128 + 2 * lane] = y0; vf[tl * 128 + 2 * lane + 1] = y1; }
        else {
          const float ss = wave_sum(y0 * y0 + y1 * y1);
          const float sc = rsqrtf(ss + 1e-6f) * (sect == 0 ? 0.08838834764831845f : 1.0f);
          y0 *= sc; y1 *= sc;
          const int off = sw256(tl, lane >> 2) + (lane & 3) * 4;
          if (sect == 0) *(unsigned*)(smem + G_QB + off) = pk2(y0, y1);
          else { *(unsigned*)(smem + G_KB + off) = pk2(y0, y1); kf[tl * 128 + 2 * lane] = y0; kf[tl * 128 + 2 * lane + 1] = y1; }
        }
      }
    }
    if (wave == 0) {
      const float* ab = (const float*)(ws + O_AB) + (t0 + lane) * 8;
      const float a = ab[h], bb = ab[4 + h];
      const float beta = sigmoidf_(bb);
      float g = -__expf(p.in[I_ALOG][h]) * softplusf_(a + p.in[I_DTB][h]);
#pragma unroll
      for (int o = 1; o < 64; o <<= 1) { const float y = __shfl_up(g, o); if (lane >= o) g += y; }
      sbeta[lane] = beta; sgc[lane] = g; segc[lane] = __expf(g);
      if (lane == 63) ((float*)(ws + O_GL))[item] = __expf(g);
    }
  }
  __syncthreads();
  {
#pragma unroll
    for (int q = 0; q < 4; ++q) {
      const int idx = wave * 4 + q; const int isq = idx >> 4, ti = (idx >> 2) & 3, tj = idx & 3;
      f32x4 acc = {0.f, 0.f, 0.f, 0.f};
      if (tj <= ti) {
#pragma unroll
        for (int ks = 0; ks < 4; ++ks) {
          const bf16x8 ai = ldfrag(smem + (isq ? G_QB : G_KB) + sw256(16 * ti + fr, 4 * ks + fq));
          const bf16x8 bj = ldfrag(smem + G_KB + sw256(16 * tj + fr, 4 * ks + fq));
          acc = isq ? mfma16(bj, ai, acc) : mfma16(ai, bj, acc);
        }
      }
      if (isq) {
        const int i = 16 * ti + fr, j0 = 16 * tj + 4 * fq;
        const float gi = sgc[i];
        f32x4 o;
#pragma unroll
        for (int r = 0; r < 4; ++r) { const int j = j0 + r; o[r] = (j <= i) ? acc[r] * __expf(gi - sgc[j]) : 0.f; }
        *(u32x2*)(smem + G_ATT + sw128(i, j0 >> 3) + (j0 & 7) * 2) = pack4(o);
      } else {
        const int j = 16 * tj + fr, i0 = 16 * ti + 4 * fq;
        const float gj = sgc[j];
        f32x4 o;
#pragma unroll
        for (int r = 0; r < 4; ++r) { const int i = i0 + r; o[r] = (j < i) ? acc[r] * __expf(sgc[i] - gj) * sbeta[i] : 0.f; }
        *(f32x4*)(Lm + j * 64 + i0) = o;
      }
    }
  }
  {
    const float gl_ = sgc[63];
    const int d = tid & 127, tg = tid >> 7;
#pragma unroll
    for (int c = 0; c < 2; ++c) {
      float e[8];
#pragma unroll
      for (int j = 0; j < 8; ++j) { const int t = 16 * tg + 8 * c + j; e[j] = kf[t * 128 + d] * __expf(gl_ - sgc[t]); }
      u32x4 o = {pk2(e[0], e[1]), pk2(e[2], e[3]), pk2(e[4], e[5]), pk2(e[6], e[7])};
      *(u32x4*)(smem + G_KDT + sw128(d, 2 * tg + c)) = o;
    }
  }
  __syncthreads();
  {
#pragma unroll
    for (int i = 0; i < 32; ++i) {
      const int e = tid + 512 * i; const int t = e >> 8, c = e & 255;
      float* xp = (c < 128) ? (vf + t * 128 + c) : (kf + t * 128 + (c - 128));
      float sc = sbeta[t]; if (c >= 128) sc *= segc[t];
      *xp *= sc;
    }
    __syncthreads();
    const int ct0 = 2 * wave;
    float* xt0 = (ct0 < 8) ? (vf + 16 * ct0) : (kf + 16 * (ct0 - 8));
    float* xt1 = xt0 + 16;
#pragma unroll
    for (int b = 0; b < 4; ++b) {
      if (b > 0) {
        f32x4 a0 = {0.f, 0.f, 0.f, 0.f}, a1 = {0.f, 0.f, 0.f, 0.f};
#pragma unroll
        for (int ks = 0; ks < 4 * b; ++ks) {
          const int k = 4 * ks + fq;
          const float av = Lm[k * 64 + 16 * b + fr];
          a0 = __builtin_amdgcn_mfma_f32_16x16x4f32(av, xt0[k * 128 + fr], a0, 0, 0, 0);
          a1 = __builtin_amdgcn_mfma_f32_16x16x4f32(av, xt1[k * 128 + fr], a1, 0, 0, 0);
        }
#pragma unroll
        for (int r = 0; r < 4; ++r) { xt0[(16 * b + 4 * fq + r) * 128 + fr] -= a0[r]; xt1[(16 * b + 4 * fq + r) * 128 + fr] -= a1[r]; }
        __syncthreads();
      }
      if (tid < 256) {
        const bool isw = tid >= 128;
        float* X = isw ? (kf + (tid - 128)) : (vf + tid);
        float xr[16];
#pragma unroll
        for (int r = 0; r < 16; ++r) xr[r] = X[(16 * b + r) * 128];
#pragma unroll
        for (int q = 0; q < 15; ++q) {
          const float* lt = Lm + (16 * b + q) * 64 + 16 * b;
          float l[16];
#pragma unroll
          for (int g4 = 0; g4 < 4; ++g4) if (4 * g4 + 3 > q) { const f32x4 t4 = *(const f32x4*)(lt + 4 * g4); l[4 * g4] = t4[0]; l[4 * g4 + 1] = t4[1]; l[4 * g4 + 2] = t4[2]; l[4 * g4 + 3] = t4[3]; }
#pragma unroll
          for (int r = q + 1; r < 16; ++r) xr[r] -= l[r] * xr[q];
        }
#pragma unroll
        for (int r = 0; r < 16; ++r) X[(16 * b + r) * 128] = xr[r];
        unsigned char* dstT = smem + (isw ? G_WT : G_UT);
        const int rowc = tid & 127;
        u32x4 o0 = {pk2(xr[0], xr[1]), pk2(xr[2], xr[3]), pk2(xr[4], xr[5]), pk2(xr[6], xr[7])};
        u32x4 o1 = {pk2(xr[8], xr[9]), pk2(xr[10], xr[11]), pk2(xr[12], xr[13]), pk2(xr[14], xr[15])};
        *(u32x4*)(dstT + sw128(rowc, 2 * b)) = o0;
        *(u32x4*)(dstT + sw128(rowc, 2 * b + 1)) = o1;
      }
      if (b < 3) __syncthreads();
    }
  }
  __syncthreads();
  {
    bf16x8 ak[2];
#pragma unroll
    for (int ks = 0; ks < 2; ++ks) ak[ks] = ldfrag(smem + G_KDT + sw128(16 * wave + fr, 4 * ks + fq));
    bf16_t* mp = (bf16_t*)(ws + O_MP) + (size_t)item * 16384;
    bf16_t* bc = (bf16_t*)(ws + O_BC) + (size_t)item * 16384;
#pragma unroll
    for (int tj = 0; tj < 8; ++tj) {
      f32x4 am = {0.f, 0.f, 0.f, 0.f}, ab_ = {0.f, 0.f, 0.f, 0.f};
#pragma unroll
      for (int ks = 0; ks < 2; ++ks) {
        const bf16x8 bw = ldfrag(smem + G_WT + sw128(16 * tj + fr, 4 * ks + fq));
        const bf16x8 bu = ldfrag(smem + G_UT + sw128(16 * tj + fr, 4 * ks + fq));
        am = mfma16(bw, ak[ks], am);
        ab_ = mfma16(ak[ks], bu, ab_);
      }
      f32x4 nm = {-am[0], -am[1], -am[2], -am[3]};
      *(u32x2*)(mp + ((size_t)((wave * 4 + (tj >> 1)) * 64 + lane)) * 8 + (tj & 1) * 4) = pack4(nm);
      *(u32x2*)(bc + ((size_t)((tj * 4 + (wave >> 1)) * 64 + lane)) * 8 + (wave & 1) * 4) = pack4(ab_);
    }
    const int tt = wave & 3, hf = wave >> 2;
    bf16x8 aa[2];
#pragma unroll
    for (int ks = 0; ks < 2; ++ks) aa[ks] = ldfrag(smem + G_ATT + sw128(16 * tt + fr, 4 * ks + fq));
    const int trow = 16 * tt + fr;
    const float eg = segc[trow];
    float* o0 = (float*)(ws + O_O0) + (t0 + trow) * 512 + h * 128;
    bf16_t* qp = (bf16_t*)(ws + O_QP) + (size_t)item * 8192 + trow * 128;
#pragma unroll
    for (int q = 0; q < 4; ++q) {
      const int te = hf * 4 + q;
      f32x4 ao = {0.f, 0.f, 0.f, 0.f}, aw = {0.f, 0.f, 0.f, 0.f};
#pragma unroll
      for (int ks = 0; ks < 2; ++ks) {
        const bf16x8 bu = ldfrag(smem + G_UT + sw128(16 * te + fr, 4 * ks + fq));
        const bf16x8 bw = ldfrag(smem + G_WT + sw128(16 * te + fr, 4 * ks + fq));
        ao = mfma16(bu, aa[ks], ao);
        aw = mfma16(bw, aa[ks], aw);
      }
      const int e0 = 16 * te + 4 * fq;
      *(f32x4*)(o0 + e0) = ao;
      const u32x2 qv = *(const u32x2*)(smem + G_QB + sw256(trow, e0 >> 3) + (e0 & 7) * 2);
      f32x4 qd = {lo2f(qv[0]) * eg - aw[0], hi2f(qv[0]) * eg - aw[1], lo2f(qv[1]) * eg - aw[2], hi2f(qv[1]) * eg - aw[3]};
      *(u32x2*)(qp + e0) = pack4(qd);
    }
  }
}

typedef short s16x4 __attribute__((ext_vector_type(4)));
DI bf16x8 tr_frag(const unsigned char* p0, const unsigned char* p1) {
  const s16x4 a = __builtin_amdgcn_ds_read_tr16_b64_v4i16((LAS s16x4*)p0), b = __builtin_amdgcn_ds_read_tr16_b64_v4i16((LAS s16x4*)p1);
  bf16x8 r; r[0] = a[0]; r[1] = a[1]; r[2] = a[2]; r[3] = a[3]; r[4] = b[0]; r[5] = b[1]; r[6] = b[2]; r[7] = b[3]; return r;
}
DI void sgu_item(const Params& p, unsigned char* smem_, int item) {
  unsigned char* smem; { LAS unsigned char* l_ = (LAS unsigned char*)smem_; asm volatile("" : "+v"(l_)); smem = (unsigned char*)l_; }
  int tid = threadIdx.x; asm volatile("" : "+v"(tid));
  const int lane = tid & 63, wave = __builtin_amdgcn_readfirstlane(tid >> 6), fr = lane & 15, fq = lane >> 4;
  unsigned char* ws; { GAS unsigned char* g_ = (GAS unsigned char*)p.ws; asm volatile("" : "+s"(g_)); ws = (unsigned char*)g_; }
  const int gp = item & 1, cn = item >> 1;
  const size_t t0 = (size_t)cn * 128;
  const bf16_t* uvg = (const bf16_t*)(ws + O_UVG);
  constexpr int VS = 544;
  __syncthreads();
  {
    const float* lng = p.in[I_SLNG]; const float* lnb = p.in[I_SLNB];
    float gg[8], bb[8];
#pragma unroll
    for (int e = 0; e < 8; ++e) { gg[e] = lng[8 * lane + e]; bb[e] = lnb[8 * lane + e]; }
#pragma unroll 2
    for (int jj = 0; jj < 16; ++jj) {
      const int j = 16 * wave + jj;
      const u32x4 raw = *(const u32x4*)(uvg + (t0 + j) * 1024 + 512 + 8 * lane);
      float v[8];
#pragma unroll
      for (int e = 0; e < 4; ++e) { v[2 * e] = lo2f(raw[e]); v[2 * e + 1] = hi2f(raw[e]); }
      float s = 0.f, q2 = 0.f;
#pragma unroll
      for (int e = 0; e < 8; ++e) { s += v[e]; q2 += v[e] * v[e]; }
      s = wave_sum(s); q2 = wave_sum(q2);
      const float mean = s * (1.f / 512.f);
      const float rstd = rsqrtf(fmaxf(q2 * (1.f / 512.f) - mean * mean, 0.f) + 1e-5f);
      if ((lane >> 5) == gp) {
        float y[8];
#pragma unroll
        for (int e = 0; e < 8; ++e) y[e] = (v[e] - mean) * rstd * gg[e] + bb[e];
        u32x4 o = {pk2(y[0], y[1]), pk2(y[2], y[3]), pk2(y[4], y[5]), pk2(y[6], y[7])};
        *(u32x4*)(smem + j * VS + (lane & 31) * 16) = o;
      }
    }
  }
  __syncthreads();
  {
    const int i = 16 * wave + fr;
    const int q = (lane & 15) >> 2, pp = lane & 3;
    const unsigned char* vb = smem + (8 * fq + q) * VS + 8 * pp;
#pragma unroll 1
    for (int gl = 0; gl < 2; ++gl) {
      const int g = 2 * gp + gl;
      const bf16_t* wg = (const bf16_t*)(ws + O_SGUW) + (size_t)g * 16384;
      bf16x8 af[4];
#pragma unroll
      for (int ks = 0; ks < 4; ++ks) af[ks] = ldfrag(wg + i * 128 + 32 * ks + 8 * fq);
      const float bias = p.in[I_SGUB][g * 128 + i];
      bf16_t* out = (bf16_t*)(ws + O_SGUO) + (t0 + i) * 512 + 128 * g;
      const bf16_t* urow = uvg + (t0 + i) * 1024 + 128 * g;
#pragma unroll
      for (int jt = 0; jt < 8; ++jt) {
        f32x4 acc = {0.f, 0.f, 0.f, 0.f};
#pragma unroll
        for (int ks = 0; ks < 4; ++ks) {
          const unsigned char* a0 = vb + ks * 32 * VS + (128 * gl + 16 * jt) * 2;
          acc = mfma16(tr_frag(a0, a0 + 4 * VS), af[ks], acc);
        }
        const int c0 = 16 * jt + 4 * fq;
        const u32x2 uu = *(const u32x2*)(urow + c0);
        f32x4 o = {lo2f(uu[0]) * (acc[0] + bias), hi2f(uu[0]) * (acc[1] + bias), lo2f(uu[1]) * (acc[2] + bias), hi2f(uu[1]) * (acc[3] + bias)};
        *(u32x2*)(out + c0) = pack4(o);
        if (jt & 1) __builtin_amdgcn_sched_barrier(0);
      }
    }
  }
}

DI void xattn_item(const Params& p, unsigned char* smem_, int item) {
  int tid = threadIdx.x; asm volatile("" : "+v"(tid));
  unsigned char* smem; { LAS unsigned char* l_ = (LAS unsigned char*)smem_; asm volatile("" : "+v"(l_)); smem = (unsigned char*)l_; }
  const int lane = tid & 63, wave = tid >> 6, fr = lane & 15, fq = lane >> 4;
  unsigned char* ws; { GAS unsigned char* g_ = (GAS unsigned char*)p.ws; asm volatile("" : "+s"(g_)); ws = (unsigned char*)g_; }
  const int bh = item & 7, qb = item >> 3;
  const int b = bh >> 2, h = bh & 3;
  const bf16_t* mk = (const bf16_t*)(ws + O_MEMK) + (size_t)bh * 32768;
  const bf16_t* mv = (const bf16_t*)(ws + O_MEMVT) + (size_t)bh * 32768;
  __syncthreads();
#pragma unroll 2
  for (int j = 0; j < 8; ++j) {
    const int c = tid + 512 * j;
    const int rk = c >> 4, ck = c & 15;
    *(u32x4*)(smem + sw256(rk, ck)) = *(const u32x4*)(mk + (size_t)c * 8);
    const int rv = c >> 5, cv = c & 31;
    *(u32x4*)(smem + 65536 + rv * 512 + ((cv ^ (rv & 15)) << 4)) = *(const u32x4*)(mv + (size_t)c * 8);
  }
  __syncthreads();
  const unsigned char* kbase[4]; const unsigned char* vbase[8];
#pragma unroll
  for (int ds = 0; ds < 4; ++ds) kbase[ds] = smem + fr * 256 + (((4 * ds + fq) ^ fr) << 4);
#pragma unroll
  for (int s = 0; s < 8; ++s) vbase[s] = smem + 65536 + fr * 512 + (((4 * s + fq) ^ fr) << 4);
#pragma unroll 1
  for (int half = 0; half < 2; ++half) {
    const size_t trow = (size_t)b * SEQ + (size_t)qb * 256 + half * 128 + 16 * wave + fr;
    const bf16_t* xq = (const bf16_t*)(ws + O_XQ) + trow * 512 + h * 128;
    bf16x8 qf[4];
#pragma unroll
    for (int ds = 0; ds < 4; ++ds) qf[ds] = ldfrag(xq + 32 * ds + 8 * fq);
    f32x4 sc[16];
#pragma unroll
    for (int kt = 0; kt < 16; ++kt) {
      f32x4 a = {0.f, 0.f, 0.f, 0.f};
#pragma unroll
      for (int ds = 0; ds < 4; ++ds) a = mfma16(ldfrag(kbase[ds] + kt * 4096), qf[ds], a);
      sc[kt] = a;
      if (kt & 1) __builtin_amdgcn_sched_barrier(0);
    }
    float m = -1e30f;
#pragma unroll
    for (int kt = 0; kt < 16; ++kt)
#pragma unroll
      for (int r = 0; r < 4; ++r) m = fmaxf(m, sc[kt][r]);
    m = fmaxf(m, __shfl_xor(m, 16)); m = fmaxf(m, __shfl_xor(m, 32));
    float l = 0.f;
#pragma unroll
    for (int kt = 0; kt < 16; ++kt)
#pragma unroll
      for (int r = 0; r < 4; ++r) { const float e = __expf(sc[kt][r] - m); sc[kt][r] = e; l += e; }
    l += __shfl_xor(l, 16); l += __shfl_xor(l, 32);
    const float inv = 1.f / l;
    bf16x8 pf[8];
#pragma unroll
    for (int s = 0; s < 8; ++s) pf[s] = pack8(sc[2 * s], sc[2 * s + 1]);
    bf16_t* out = (bf16_t*)(ws + O_XATO) + trow * 512 + h * 128;
#pragma unroll
    for (int dt = 0; dt < 8; ++dt) {
      f32x4 a = {0.f, 0.f, 0.f, 0.f};
#pragma unroll
      for (int s = 0; s < 8; ++s) a = mfma16(ldfrag(vbase[s] + dt * 8192), pf[s], a);
      __builtin_amdgcn_sched_barrier(0);
      f32x4 o = {a[0] * inv, a[1] * inv, a[2] * inv, a[3] * inv};
      *(u32x2*)(out + 16 * dt + 4 * fq) = pack4(o);
    }
  }
}

DI void phase2(const Params& p, unsigned char* smem, int bid, int nb) {
  for (int rep = 0; rep < ((DUPMASK >> 20) & 1) + 1; ++rep) {
    if (nb == 256) {
      const int bh = bid & 7, k = bid >> 3;
      for (int j = 0; j < 4; ++j) { const int n = 127 - (k + 32 * j); gdn_prep_item(p, smem, (((bh >> 2) * 128 + n) << 2) + (bh & 3)); }
    } else {
      for (int it = bid; it < 1024; it += nb) gdn_prep_item(p, smem, it);
    }
  }
  for (int rep = 0; rep < ((DUPMASK >> 21) & 1) + 1; ++rep) for (int it = bid; it < 256; it += nb) sgu_item(p, smem, it);
  for (int rep = 0; rep < ((DUPMASK >> 22) & 1) + 1; ++rep) for (int it = bid; it < 256; it += nb) xattn_item(p, smem, it);
}

DI void gdn_scan4(const Params& p, unsigned char* smem_, int bh, int es) {
  int tid = threadIdx.x; asm volatile("" : "+v"(tid));
  unsigned char* smem; { LAS unsigned char* l_ = (LAS unsigned char*)smem_; asm volatile("" : "+v"(l_)); smem = (unsigned char*)l_; }
  const int lane = tid & 63, w = __builtin_amdgcn_readfirstlane(tid >> 6);
  if (w >= 4) {
    for (int n = 0; n < 128; ++n) __builtin_amdgcn_s_barrier();
    return;
  }
  unsigned char* ws = p.ws;
  const int b = bh >> 2, h = bh & 3;
  const int fr = lane & 15, fq = lane >> 4;
  const size_t item0 = (size_t)(b * 128) * 4 + h;
  constexpr size_t ISTR = 4 * 16384;
  const bf16_t* mp = (const bf16_t*)(ws + O_MP) + item0 * 16384 + (size_t)(2 * w) * 2048 + lane * 8;
  const bf16_t* bc = (const bf16_t*)(ws + O_BC) + item0 * 16384 + (size_t)es * 2048 + (size_t)w * 512 + lane * 8;
  bf16_t* st = (bf16_t*)(ws + O_ST) + item0 * 16384 + (size_t)(16 * es + fr) * 128 + 32 * w + 4 * fq;
  const float* glp = (const float*)(ws + O_GL) + item0;
  { GAS const float* g_ = (GAS const float*)glp; asm volatile("" : "+v"(g_)); glp = (const float*)g_; }
  f32x4 acc0 = {0.f, 0.f, 0.f, 0.f}, acc1 = {0.f, 0.f, 0.f, 0.f};
  constexpr int PD = 4;
  bf16x8 A[PD][8]; u32x4 C[PD]; float G[PD];
#pragma unroll
  for (int d = 0; d < PD; ++d) {
#pragma unroll
    for (int i = 0; i < 8; ++i) A[d][i] = ldfrag(mp + (size_t)d * ISTR + i * 512);
    C[d] = *(const u32x4*)(bc + (size_t)d * ISTR);
    G[d] = glp[d * 4];
  }
  unsigned char* xch = smem;
  for (int n0 = 0; n0 < 128; n0 += PD) {
#pragma unroll
    for (int d = 0; d < PD; ++d) {
      const int n = n0 + d;
      const int np = (n + PD < 128) ? n + PD : n;
      const u32x2 lo = pack4(acc0), hi = pack4(acc1);
      bf16_t* stn = st + (size_t)n * ISTR;
      *(u32x2*)(stn) = lo; *(u32x2*)(stn + 16) = hi;
      const u32x4 mine = {lo[0], lo[1], hi[0], hi[1]};
      *(u32x4*)(xch + ((n & 1) * 4 + w) * 1024 + lane * 16) = mine;
      asm volatile("s_waitcnt lgkmcnt(0)" ::: "memory");
      __builtin_amdgcn_s_barrier();
      asm volatile("" ::: "memory");
      bf16x8 bfr[4];
#pragma unroll
      for (int s = 0; s < 4; ++s) bfr[s] = ldfrag(xch + ((n & 1) * 4 + s) * 1024 + lane * 16);
      const float g = G[d];
      f32x4 a0 = {g * acc0[0] + lo2f(C[d][0]), g * acc0[1] + hi2f(C[d][0]), g * acc0[2] + lo2f(C[d][1]), g * acc0[3] + hi2f(C[d][1])};
      f32x4 a1 = {g * acc1[0] + lo2f(C[d][2]), g * acc1[1] + hi2f(C[d][2]), g * acc1[2] + lo2f(C[d][3]), g * acc1[3] + hi2f(C[d][3])};
#pragma unroll
      for (int s = 0; s < 4; ++s) { a0 = mfma16(A[d][s], bfr[s], a0); a1 = mfma16(A[d][4 + s], bfr[s], a1); }
      acc0 = a0; acc1 = a1;
#pragma unroll
      for (int i = 0; i < 8; ++i) A[d][i] = ldfrag(mp + (size_t)np * ISTR + i * 512);
      C[d] = *(const u32x4*)(bc + (size_t)np * ISTR);
      G[d] = glp[(size_t)np * 4];
    }
  }
}

struct EpiGate {
  const bf16_t* gates; int goff; const bf16_t* src; bf16_t* dst;
  DI void operator()(const f32x4 (&acc)[2][2][4][2], const pg::Unit& u, int wr, int wc, int fr, int fq) const {
#pragma unroll
    for (int ai = 0; ai < 2; ++ai)
#pragma unroll
      for (int m = 0; m < 4; ++m) {
        const size_t row = (size_t)u.pm * 256 + 128 * ai + 64 * wr + 16 * m + fr;
#pragma unroll
        for (int bj = 0; bj < 2; ++bj)
#pragma unroll
          for (int n = 0; n < 2; ++n) {
            const int col = u.pn * 256 + 128 * bj + 32 * wc + 16 * n + 4 * fq;
            const f32x4 v = acc[ai][bj][m][n];
            const u32x2 g = *(const u32x2*)(gates + row * 3072 + goff + col);
            f32x4 o = {lo2f(g[0]) * v[0], hi2f(g[0]) * v[1], lo2f(g[1]) * v[2], hi2f(g[1]) * v[3]};
            if (src) { const u32x2 s = *(const u32x2*)(src + row * 1024 + col); o[0] += lo2f(s[0]); o[1] += hi2f(s[0]); o[2] += lo2f(s[1]); o[3] += hi2f(s[1]); }
            *(u32x2*)(dst + row * 1024 + col) = pack4(o);
          }
      }
  }
};
DI void phase3(const Params& p, unsigned char* smem, int bid, int nb) {
  unsigned char* ws = p.ws;
  if (bid < 64) {
    __syncthreads();
    gdn_scan4(p, smem, bid & 7, bid >> 3);
  } else {
    PG_LAS unsigned char* lds = (PG_LAS unsigned char*)smem;
    const bf16_t* gates = (const bf16_t*)(ws + O_GATES);
    bf16_t* part = (bf16_t*)(ws + O_PART);
    __syncthreads();
    { pg::DenseOrder S; S.init(ws + O_SGUO, ws + O_WBT, T, 1024, 512, nb - 64, bid - 64); EpiGate E{gates, 1024, nullptr, part}; pg::gemm_phase<EpiGate, pg::DenseOrder, false, true>(lds, 512, S, E); }
    asm volatile("s_waitcnt vmcnt(0)" ::: "memory");
    __builtin_amdgcn_fence(__ATOMIC_ACQUIRE, "agent");
    asm volatile("s_waitcnt vmcnt(0)" ::: "memory");
    __syncthreads();
    { pg::DenseOrder S; S.init(ws + O_XATO, ws + O_WCT, T, 1024, 512, nb - 64, bid - 64); EpiGate E{gates, 2048, part, part}; pg::gemm_phase<EpiGate, pg::DenseOrder, false, true>(lds, 512, S, E); }
  }
}

DI void phase4(const Params& p, int bid, int nb) {
  int tid = threadIdx.x; asm volatile("" : "+v"(tid));
  const int lane = tid & 63, wave = tid >> 6, fr = lane & 15, fq = lane >> 4;
  unsigned char* ws = p.ws;
  for (int it = bid; it < 512; it += nb) {
    const int item = it * 2 + (wave >> 2), tt = wave & 3;
    const int h = item & 3, cn = item >> 2;
    const size_t trow = (size_t)cn * 64 + 16 * tt + fr;
    const bf16_t* qp = (const bf16_t*)(ws + O_QP) + (size_t)item * 8192 + (16 * tt + fr) * 128;
    const bf16_t* st = (const bf16_t*)(ws + O_ST) + (size_t)item * 16384;
    const float* o0 = (const float*)(ws + O_O0) + trow * 512 + h * 128;
    bf16x8 af[4];
#pragma unroll
    for (int ks = 0; ks < 4; ++ks) af[ks] = ldfrag(qp + 32 * ks + 8 * fq);
    f32x4 acc[8];
    float ss = 0.f;
#pragma unroll
    for (int j = 0; j < 8; ++j) {
      f32x4 a = *(const f32x4*)(o0 + 16 * j + 4 * fq);
#pragma unroll
      for (int ks = 0; ks < 4; ++ks) a = mfma16(ldfrag(st + (16 * j + fr) * 128 + 32 * ks + 8 * fq), af[ks], a);
      acc[j] = a;
      ss += a[0] * a[0] + a[1] * a[1] + a[2] * a[2] + a[3] * a[3];
    }
    ss += __shfl_xor(ss, 16); ss += __shfl_xor(ss, 32);
    const float rms = rsqrtf(ss * (1.f / 128.f) + 1e-6f);
    const float* ng = p.in[I_GNG];
    const bf16_t* zs = (const bf16_t*)(ws + O_ZS) + trow * 512 + h * 128;
    bf16_t* out = (bf16_t*)(ws + O_GDNO) + trow * 512 + h * 128;
#pragma unroll
    for (int j = 0; j < 8; ++j) {
      const int e0 = 16 * j + 4 * fq;
      const f32x4 g = *(const f32x4*)(ng + e0);
      const u32x2 z = *(const u32x2*)(zs + e0);
      f32x4 o = {acc[j][0] * rms * g[0] * lo2f(z[0]), acc[j][1] * rms * g[1] * hi2f(z[0]), acc[j][2] * rms * g[2] * lo2f(z[1]), acc[j][3] * rms * g[3] * hi2f(z[1])};
      *(u32x2*)(out + e0) = pack4(o);
    }
  }
}

DI void phase5(const Params& p, unsigned char* smem, int bid, int nb) {
  unsigned char* ws = p.ws;
  PG_LAS unsigned char* lds = (PG_LAS unsigned char*)smem;
  __syncthreads();
  pg::DenseOrder S; S.init(ws + O_GDNO, ws + O_WAT, T, 1024, 512, nb, bid);
  EpiGate E{(const bf16_t*)(ws + O_GATES), 0, (const bf16_t*)(ws + O_PART), (bf16_t*)(ws + O_MERGED)};
  pg::gemm_phase<EpiGate, pg::DenseOrder, false, true>(lds, 512, S, E);
}
struct EpiX1 {
  const float* x; float* x1;
  DI void operator()(const f32x4 (&acc)[2][2][4][2], const pg::Unit& u, int wr, int wc, int fr, int fq) const {
#pragma unroll
    for (int ai = 0; ai < 2; ++ai)
#pragma unroll
      for (int m = 0; m < 4; ++m) {
        const size_t row = (size_t)u.pm * 256 + 128 * ai + 64 * wr + 16 * m + fr;
#pragma unroll
        for (int bj = 0; bj < 2; ++bj)
#pragma unroll
          for (int n = 0; n < 2; ++n) {
            const int col = u.pn * 256 + 128 * bj + 32 * wc + 16 * n + 4 * fq;
            const f32x4 v = acc[ai][bj][m][n];
            const f32x4 xv = *(const f32x4*)(x + row * 1024 + col);
            f32x4 o = {ALPHA * xv[0] + v[0], ALPHA * xv[1] + v[1], ALPHA * xv[2] + v[2], ALPHA * xv[3] + v[3]};
            *(f32x4*)(x1 + row * 1024 + col) = o;
          }
      }
  }
};
DI void phase6(const Params& p, unsigned char* smem, int bid, int nb) {
  unsigned char* ws = p.ws;
  PG_LAS unsigned char* lds = (PG_LAS unsigned char*)smem;
  __syncthreads();
  pg::DenseOrder S; S.init(ws + O_MERGED, ws + O_WOT, T, 1024, 1024, nb, bid);
  EpiX1 E{p.in[I_X], (float*)(ws + O_X1)};
  pg::gemm_phase<EpiX1, pg::DenseOrder, false, false>(lds, 1024, S, E);
}

DI void ln_row(const float* src, const float* g, const float* b, float (&v)[16], int lane) {
  float s = 0.f;
#pragma unroll
  for (int i = 0; i < 16; ++i) s += v[i];
  const float mean = wave_sum(s) * (1.f / 1024.f);
  float q = 0.f;
#pragma unroll
  for (int i = 0; i < 16; ++i) { const float d = v[i] - mean; q += d * d; }
  const float rstd = rsqrtf(wave_sum(q) * (1.f / 1024.f) + 1e-5f);
#pragma unroll
  for (int i = 0; i < 4; ++i) {
    const int k = 256 * i + 4 * lane;
    const f32x4 gg = *(const f32x4*)(g + k), bb = *(const f32x4*)(b + k);
#pragma unroll
    for (int c = 0; c < 4; ++c) v[4 * i + c] = (v[4 * i + c] - mean) * rstd * gg[c] + bb[c];
  }
}
DI void phase7(const Params& p, int bid, int nb) {
  int tid = threadIdx.x; asm volatile("" : "+v"(tid));
  const int lane = tid & 63, wave = tid >> 6;
  unsigned char* ws = p.ws;
  for (int i = bid * NTHR + tid; i < MAXSLOT; i += nb * NTHR) { ((int*)(ws + O_SLOTTOK))[i] = 0; ((int*)(ws + O_SLOTAID))[i] = -1; }
  float* x1 = (float*)(ws + O_X1);
  bf16_t* x1b = (bf16_t*)(ws + O_X1B);
  for (int row = bid * 8 + wave; row < T; row += nb * 8) {
    float v[16];
#pragma unroll
    for (int i = 0; i < 4; ++i) { const f32x4 t = *(const f32x4*)(x1 + (size_t)row * D + 256 * i + 4 * lane); v[4 * i] = t[0]; v[4 * i + 1] = t[1]; v[4 * i + 2] = t[2]; v[4 * i + 3] = t[3]; }
    ln_row(nullptr, p.in[I_LN1G], p.in[I_LN1B], v, lane);
#pragma unroll
    for (int i = 0; i < 4; ++i) {
      const f32x4 o = {v[4 * i], v[4 * i + 1], v[4 * i + 2], v[4 * i + 3]};
      *(f32x4*)(x1 + (size_t)row * D + 256 * i + 4 * lane) = o;
      *(u32x2*)(x1b + (size_t)row * D + 256 * i + 4 * lane) = pack4(o);
    }
  }
}
struct EpiLogits {
  float* logits;
  DI void operator()(const f32x4 (&acc)[2][2][4][2], const pg::Unit& u, int wr, int wc, int fr, int fq) const {
#pragma unroll
    for (int ai = 0; ai < 2; ++ai)
#pragma unroll
      for (int m = 0; m < 4; ++m) {
        const size_t row = (size_t)u.pm * 256 + 128 * ai + 64 * wr + 16 * m + fr;
#pragma unroll
        for (int bj = 0; bj < 2; ++bj)
#pragma unroll
          for (int n = 0; n < 2; ++n) *(f32x4*)(logits + row * 256 + 128 * bj + 32 * wc + 16 * n + 4 * fq) = acc[ai][bj][m][n];
      }
  }
};
DI void phase8(const Params& p, unsigned char* smem, int bid, int nb);
DI void phase9(const Params& p, int bid, int nb) {
  int tid = threadIdx.x; asm volatile("" : "+v"(tid));
  const int lane = tid & 63, wave = tid >> 6;
  unsigned char* ws = p.ws;
  const float* logits = (const float*)(ws + O_LOGITS);
  int* counts = (int*)(ws + O_CTRL);
  const int g = lane & 7, tsub = lane >> 3;
  const float NEG = -__builtin_inff();
  float bias[32];
#pragma unroll
  for (int j4 = 0; j4 < 8; ++j4) { const f32x4 b4 = *(const f32x4*)(p.in[I_RB] + 32 * g + 4 * j4); bias[4 * j4] = b4[0]; bias[4 * j4 + 1] = b4[1]; bias[4 * j4 + 2] = b4[2]; bias[4 * j4 + 3] = b4[3]; }
  for (int tok0 = (bid * 8 + wave) * 8; tok0 < T; tok0 += nb * 64) {
    const int tok = tok0 + tsub;
    float sc[32], bz[32];
#pragma unroll
    for (int j4 = 0; j4 < 8; ++j4) {
      const f32x4 l4 = *(const f32x4*)(logits + (size_t)tok * 256 + 32 * g + 4 * j4);
#pragma unroll
      for (int c = 0; c < 4; ++c) { sc[4 * j4 + c] = sigmoidf_(l4[c]); bz[4 * j4 + c] = sc[4 * j4 + c] + bias[4 * j4 + c]; }
    }
    float m1 = NEG, m2 = NEG;
#pragma unroll
    for (int j = 0; j < 32; ++j) { const float v = bz[j]; if (v > m1) { m2 = m1; m1 = v; } else if (v > m2) m2 = v; }
    const float gs = m1 + m2;
    int rank = 0;
#pragma unroll
    for (int gg = 0; gg < 8; ++gg) { const float og = __shfl(gs, (lane & ~7) | gg); rank += ((og > gs) || (og == gs && gg < g)) ? 1 : 0; }
    if (rank >= 4) {
#pragma unroll
      for (int j = 0; j < 32; ++j) bz[j] = NEG;
    }
    int myidx = 0; float mysc = 0.f, ssum = 0.f;
#pragma unroll 1
    for (int k = 0; k < 8; ++k) {
      float bv = bz[0], bs = sc[0]; int bi = 0;
#pragma unroll
      for (int j = 1; j < 32; ++j) if (bz[j] > bv) { bv = bz[j]; bi = j; bs = sc[j]; }
      float rv = bv, rs = bs; int ri = 32 * g + bi;
#pragma unroll
      for (int o = 1; o < 8; o <<= 1) {
        const float ov = __shfl_xor(rv, o), os = __shfl_xor(rs, o); const int oi = __shfl_xor(ri, o);
        if (ov > rv || (ov == rv && oi < ri)) { rv = ov; ri = oi; rs = os; }
      }
      if ((ri >> 5) == g) {
        const int wj = ri & 31;
#pragma unroll
        for (int j = 0; j < 32; ++j) if (j == wj) bz[j] = NEG;
      }
      ssum += rs;
      if (g == k) { myidx = ri; mysc = rs; }
    }
    const int pos = atomicAdd(&counts[myidx * CSTR], 1);
    ((int*)(ws + O_TKIDX))[(size_t)tok * 8 + g] = myidx;
    ((float*)(ws + O_TKW))[(size_t)tok * 8 + g] = mysc / ssum * 2.5f;
    ((int*)(ws + O_TKPOS))[(size_t)tok * 8 + g] = pos;
  }
}
DI void build_tile_start(const Params& p, int* ts) {
  const int tid = threadIdx.x;
  const int* counts = (const int*)(p.ws + O_CTRL);
  __syncthreads();
  if (tid < 256) ts[300 + tid] = (counts[tid * CSTR] + MOE_BM - 1) / MOE_BM;
  __syncthreads();
  if (tid == 0) { int s = 0; for (int e = 0; e < 256; ++e) { ts[e] = s; s += ts[300 + e]; } ts[256] = s; }
  __syncthreads();
}
DI void phase10(const Params& p, unsigned char* smem, int bid, int nb) {
  int* ts = (int*)smem;
  build_tile_start(p, ts);
  unsigned char* ws = p.ws;
  const int* tkidx = (const int*)(ws + O_TKIDX); const int* tkpos = (const int*)(ws + O_TKPOS); const float* tkw = (const float*)(ws + O_TKW);
  int* slottok = (int*)(ws + O_SLOTTOK); float* slotw = (float*)(ws + O_SLOTW); int* slotaid = (int*)(ws + O_SLOTAID);
  for (int i = bid * NTHR + threadIdx.x; i < T * 8; i += nb * NTHR) {
    const int e = tkidx[i];
    const int slot = ts[e] * MOE_BM + tkpos[i];
    slottok[slot] = i >> 3; slotw[slot] = tkw[i]; slotaid[slot] = i;
  }
}

DI int find_expert(const int* ts, int ti) { int lo = 0, hi = 255; while (lo < hi) { const int mid = (lo + hi + 1) >> 1; if (ts[mid] <= ti) lo = mid; else hi = mid - 1; } return lo; }

struct MoeUpF {
  const int* ts; unsigned char* ws; const float* wg; const float* wu; const float* wsg; const float* wsu; int ntile, G, c;
  DI bool next(int i, UnitF& u) const {
    const int L = i * G + (((G & 7) == 0) ? (c & 7) * (G >> 3) + (c >> 3) : c);
    if (L >= ntile * 2) {
      const int r = L - ntile * 2; if (r >= 256 || !wsg) return false;
      const int pn = r >> 7, ti = r & 127;
      u.A = (const bf16_t*)(ws + O_X1B); u.rows = nullptr; u.m0 = ti * 128; u.pn = pn; u.e = 256;
      u.W0 = wsg + 128 * pn; u.W1 = wsu + 128 * pn;
      return true;
    }
    const int ti = L >> 1, pn = L & 1;
    const int e = find_expert(ts, ti);
    u.A = (const bf16_t*)(ws + O_X1B); u.rows = (const int*)(ws + O_SLOTTOK) + ti * MOE_BM; u.m0 = ti * MOE_BM; u.pn = pn; u.e = e;
    u.W0 = wg + (size_t)e * 262144 + 128 * pn; u.W1 = wu + (size_t)e * 262144 + 128 * pn;
    return true;
  }
};
struct MoeDownF {
  const int* ts; unsigned char* ws; const float* wd; const float* wsd; int ntile, G, c;
  DI bool next(int i, UnitF& u) const {
    const int L = i * G + (((G & 7) == 0) ? (c & 7) * (G >> 3) + (c >> 3) : c);
    if (L >= ntile * 4) {
      const int r = L - ntile * 4; if (r >= 512 || !wsd) return false;
      const int pn = r >> 7, ti = r & 127;
      u.A = (const bf16_t*)(ws + O_ACTSH); u.rows = nullptr; u.m0 = ti * 128; u.pn = pn; u.e = 256;
      u.W0 = wsd + 256 * pn; u.W1 = u.W0 + 128;
      return true;
    }
    const int ti = L >> 2, pn = L & 3;
    const int e = find_expert(ts, ti);
    u.A = (const bf16_t*)(ws + O_ACT); u.rows = nullptr; u.m0 = ti * MOE_BM; u.pn = pn; u.e = e;
    u.W0 = wd + (size_t)e * 262144 + 256 * pn; u.W1 = u.W0 + 128;
    return true;
  }
};
struct EpiActF {
  bf16_t* actp; bf16_t* actsh;
  struct Pre { int dummy; };
  DI void prefetch(const UnitF&, int, int, Pre& p) const { p.dummy = 0; }
  DI void operator()(const f32x4 (&acc)[4][4], const UnitF& u, int wr, int wc, int fr, int fq, const Pre&, unsigned char* xch) const {
    if (wc >= 2) {
#pragma unroll
      for (int m = 0; m < 4; ++m) {
        unsigned char* dst = xch + (64 * wr + 16 * m + fr) * 256 + (((8 * (wc & 1) + 2 * fq) ^ (2 * (fr & 7))) << 4);
        u32x4 o0 = {pk2(acc[m][0][0], acc[m][1][0]), pk2(acc[m][2][0], acc[m][3][0]), pk2(acc[m][0][1], acc[m][1][1]), pk2(acc[m][2][1], acc[m][3][1])};
        u32x4 o1 = {pk2(acc[m][0][2], acc[m][1][2]), pk2(acc[m][2][2], acc[m][3][2]), pk2(acc[m][0][3], acc[m][1][3]), pk2(acc[m][2][3], acc[m][3][3])};
        *(u32x4*)dst = o0; *(u32x4*)(dst + 16) = o1;
      }
    }
    asm volatile("s_waitcnt lgkmcnt(0)" ::: "memory"); __builtin_amdgcn_s_barrier(); asm volatile("" ::: "memory");
    if (wc < 2) {
#pragma unroll
      for (int m = 0; m < 4; ++m) {
        const unsigned char* srcp = xch + (64 * wr + 16 * m + fr) * 256 + (((8 * wc + 2 * fq) ^ (2 * (fr & 7))) << 4);
        const u32x4 u0 = *(const u32x4*)srcp, u1 = *(const u32x4*)(srcp + 16);
        const size_t row = (size_t)u.m0 + 64 * wr + 16 * m + fr;
        u32x4 o0, o1;
#pragma unroll
        for (int r = 0; r < 2; ++r) {
          o0[2 * r] = pk2(siluf_(acc[m][0][r]) * lo2f(u0[2 * r]), siluf_(acc[m][1][r]) * hi2f(u0[2 * r]));
          o0[2 * r + 1] = pk2(siluf_(acc[m][2][r]) * lo2f(u0[2 * r + 1]), siluf_(acc[m][3][r]) * hi2f(u0[2 * r + 1]));
          o1[2 * r] = pk2(siluf_(acc[m][0][2 + r]) * lo2f(u1[2 * r]), siluf_(acc[m][1][2 + r]) * hi2f(u1[2 * r]));
          o1[2 * r + 1] = pk2(siluf_(acc[m][2][2 + r]) * lo2f(u1[2 * r + 1]), siluf_(acc[m][3][2 + r]) * hi2f(u1[2 * r + 1]));
        }
        bf16_t* dst = (u.e == 256 ? actsh : actp) + row * 256 + 128 * u.pn + 64 * wc + 16 * fq;
        *(u32x4*)dst = o0; *(u32x4*)(dst + 8) = o1;
      }
    }
    asm volatile("s_waitcnt lgkmcnt(0)" ::: "memory"); __builtin_amdgcn_s_barrier(); asm volatile("" ::: "memory");
  }
};
struct EpiDownF {
  const int* slotaid; const float* slotw; unsigned char* ybase; bf16_t* ysh;
  struct Pre { int aid[4]; float ww[4]; };
  DI void prefetch(const UnitF& u, int wr, int fr, Pre& p) const {
    const unsigned slot0 = (unsigned)u.m0 + 64u * wr + fr;
    if (u.e == 256) {
#pragma unroll
      for (int m = 0; m < 4; ++m) { p.aid[m] = (int)(slot0 + 16u * m); p.ww[m] = 1.f; }
    } else {
#pragma unroll
      for (int m = 0; m < 4; ++m) { p.aid[m] = slotaid[slot0 + 16u * m]; p.ww[m] = slotw[slot0 + 16u * m]; }
    }
  }
  DI void operator()(const f32x4 (&acc)[4][4], const UnitF& u, int wr, int wc, int fr, int fq, const Pre& p, unsigned char*) const {
    const unsigned colb = (unsigned)u.pn * 256u + 64u * wc + 16u * fq;
    if (u.e == 256) {
#pragma unroll
      for (int m = 0; m < 4; ++m) {
        bf16_t* dst = ysh + (size_t)p.aid[m] * 1024 + colb;
        u32x4 o0 = {pk2(acc[m][0][0], acc[m][1][0]), pk2(acc[m][2][0], acc[m][3][0]), pk2(acc[m][0][1], acc[m][1][1]), pk2(acc[m][2][1], acc[m][3][1])};
        u32x4 o1 = {pk2(acc[m][0][2], acc[m][1][2]), pk2(acc[m][2][2], acc[m][3][2]), pk2(acc[m][0][3], acc[m][1][3]), pk2(acc[m][2][3], acc[m][3][3])};
        *(u32x4*)dst = o0; *(u32x4*)(dst + 8) = o1;
      }
      return;
    }
#pragma unroll
    for (int m = 0; m < 4; ++m) {
      if (p.aid[m] >= 0) {
        const unsigned off = (unsigned)p.aid[m] * 1024u + colb;
        const float sw = p.ww[m] * 64.0f;
        u32x4 o;
#pragma unroll
        for (int r = 0; r < 4; ++r) {
          unsigned w_ = 0u;
          w_ = __builtin_amdgcn_cvt_pk_fp8_f32(acc[m][0][r] * sw, acc[m][1][r] * sw, w_, false);
          w_ = __builtin_amdgcn_cvt_pk_fp8_f32(acc[m][2][r] * sw, acc[m][3][r] * sw, w_, true);
          o[r] = w_;
        }
        *(u32x4*)(ybase + (size_t)off) = o;
      }
    }
  }
};
struct EpiAct {
  bf16_t* actp;
  DI void operator()(const f32x4 (&acc)[2][2][4][2], const pg::Unit& u, int wr, int wc, int fr, int fq) const {
#pragma unroll
    for (int ai = 0; ai < 2; ++ai)
#pragma unroll
      for (int m = 0; m < 4; ++m) {
        const size_t row = (size_t)u.pm * 256 + 128 * ai + 64 * wr + 16 * m + fr;
#pragma unroll
        for (int bj = 0; bj < 2; ++bj) {
          const int blk = 8 * u.pn + 4 * bj + wc;
          const f32x4 g = acc[ai][bj][m][0], uu = acc[ai][bj][m][1];
          f32x4 o = {siluf_(g[0]) * uu[0], siluf_(g[1]) * uu[1], siluf_(g[2]) * uu[2], siluf_(g[3]) * uu[3]};
          *(u32x2*)(actp + row * 256 + blk * 16 + 4 * fq) = pack4(o);
        }
      }
  }
};
struct EpiBf16Out {
  bf16_t* dst;
  DI void operator()(const f32x4 (&acc)[2][2][4][2], const pg::Unit& u, int wr, int wc, int fr, int fq) const {
#pragma unroll
    for (int ai = 0; ai < 2; ++ai)
#pragma unroll
      for (int m = 0; m < 4; ++m) {
        const size_t row = (size_t)u.pm * 256 + 128 * ai + 64 * wr + 16 * m + fr;
#pragma unroll
        for (int bj = 0; bj < 2; ++bj)
#pragma unroll
          for (int n = 0; n < 2; ++n) *(u32x2*)(dst + row * 1024 + u.pn * 256 + 128 * bj + 32 * wc + 16 * n + 4 * fq) = pack4(acc[ai][bj][m][n]);
      }
  }
};
template <class Epi, class Sched>
DI void gemmF2_phase(unsigned char* smem_, const int K, const int lda, const int ldw, const Sched& S, const Epi& E) {
  int tid = threadIdx.x; asm volatile("" : "+v"(tid));
  unsigned char* smem; { LAS unsigned char* l_ = (LAS unsigned char*)smem_; asm volatile("" : "+v"(l_)); smem = (unsigned char*)l_; }
  const int lane = tid & 63, wid = __builtin_amdgcn_readfirstlane(tid >> 6), fr = lane & 15, fq = lane >> 4;
  const int nk = K >> 6;
#define F2_LBAR() do { asm volatile("s_waitcnt lgkmcnt(0)" ::: "memory"); __builtin_amdgcn_s_barrier(); asm volatile("" ::: "memory"); } while (0)
  UnitF cur, nxt; int ui = 0;
  if (!S.next(0, cur)) return;
  bool has_next = S.next(1, nxt);
  if (!has_next) nxt = cur;
  __syncthreads();
  if (wid >= 4) {
    const int lt = tid - 256;
    const int ar = lt >> 3, ac = lt & 7;
    const int q = lt & 63, kg = lt >> 6, half = q >> 5, g0 = 4 * (q & 31);
    int vrow[4];
#pragma unroll
    for (int i = 0; i < 4; ++i) vrow[i] = 64 * (q >> 4) + 16 * i + (q & 15);
    int aw[4];
#pragma unroll
    for (int j = 0; j < 4; ++j) aw[j] = sw128(ar + 32 * j, ac);
    unsigned r[4], nr[4];
#define F2_ROWS(u, rr) do { _Pragma("unroll") for (int j = 0; j < 4; ++j) rr[j] = (u).rows ? (unsigned)(u).rows[ar + 32 * j] : (unsigned)((u).m0 + ar + 32 * j); } while (0)
    F2_ROWS(cur, r);
    if (has_next) F2_ROWS(nxt, nr); else { _Pragma("unroll") for (int j = 0; j < 4; ++j) nr[j] = r[j]; }
#define F2_LOADX(kx, va, vw) do { const bool nx_ = (kx) >= nk; const int kk_ = nx_ ? (kx) - nk : (kx); \
      const bf16_t* A_ = nx_ ? nxt.A : cur.A; const float* W_ = half ? (nx_ ? nxt.W1 : cur.W1) : (nx_ ? nxt.W0 : cur.W0); \
      _Pragma("unroll") for (int j = 0; j < 4; ++j) { const unsigned rr_ = nx_ ? nr[j] : r[j]; va[j] = *(const u32x4*)((const unsigned char*)A_ + (size_t)(rr_ * (unsigned)(lda * 2) + (unsigned)(kk_ * 128 + ac * 16))); } \
      const float* wp_ = W_ + (size_t)(kk_ * 64 + 8 * kg) * ldw + g0; \
      _Pragma("unroll") for (int j = 0; j < 8; ++j) { vw[j] = *(const f32x4*)(wp_ + (size_t)j * ldw); vw[8 + j] = *(const f32x4*)(wp_ + (size_t)(32 + j) * ldw); } } while (0)
#define F2_STORE(st, va, vw) do { unsigned char* sa_ = smem + (st) * 49152; \
      _Pragma("unroll") for (int j = 0; j < 4; ++j) *(u32x4*)(sa_ + aw[j]) = va[j]; \
      _Pragma("unroll") for (int i = 0; i < 4; ++i) { \
        u32x4 o0_ = {pk2(vw[0][i], vw[1][i]), pk2(vw[2][i], vw[3][i]), pk2(vw[4][i], vw[5][i]), pk2(vw[6][i], vw[7][i])}; \
        u32x4 o1_ = {pk2(vw[8][i], vw[9][i]), pk2(vw[10][i], vw[11][i]), pk2(vw[12][i], vw[13][i]), pk2(vw[14][i], vw[15][i])}; \
        *(u32x4*)(sa_ + 16384 + sw128(vrow[i], kg)) = o0_; *(u32x4*)(sa_ + 16384 + sw128(vrow[i], 4 + kg)) = o1_; } } while (0)
    u32x4 xa[4], ya[4]; f32x4 xw[16], yw[16];
    F2_LOADX(0, xa, xw);
    F2_LOADX(1, ya, yw);
    F2_STORE(0, xa, xw);
    F2_LOADX(2, xa, xw);
    F2_LBAR();
    int st = 0;
    for (;;) {
#pragma unroll 1
      for (int kt = 0; kt < nk; kt += 2) {
        F2_STORE(st ^ 1, ya, yw);
        F2_LOADX(kt + 3, ya, yw);
        F2_LBAR();
        F2_STORE(st, xa, xw);
        F2_LOADX(kt + 4, xa, xw);
        F2_LBAR();
      }
#pragma unroll
      for (int eb = 0; eb < Epi::NBAR; ++eb) F2_LBAR();
      if (!has_next) break;
      cur = nxt; ++ui;
#pragma unroll
      for (int j = 0; j < 4; ++j) r[j] = nr[j];
      has_next = S.next(ui + 1, nxt);
      if (has_next) F2_ROWS(nxt, nr); else nxt = cur;
    }
    asm volatile("s_waitcnt vmcnt(0)" ::: "memory");
#undef F2_ROWS
#undef F2_LOADX
#undef F2_STORE
  } else {
    const int wr = wid >> 1, wc = wid & 1;
    f32x4 acc[4][8];
#pragma unroll
    for (int m = 0; m < 4; ++m)
#pragma unroll
      for (int n = 0; n < 8; ++n) acc[m][n] = (f32x4){0.f, 0.f, 0.f, 0.f};
#define F2_COMPUTE(st) do { const unsigned char* sA = smem + (st) * 49152; const unsigned char* sB = sA + 16384; \
      _Pragma("unroll") for (int ks = 0; ks < 2; ++ks) { bf16x8 af[4], bfr[8]; \
        _Pragma("unroll") for (int m = 0; m < 4; ++m) af[m] = ldfrag(sA + sw128(64 * wr + 16 * m + fr, 4 * ks + fq)); \
        _Pragma("unroll") for (int n = 0; n < 8; ++n) bfr[n] = ldfrag(sB + sw128(128 * wc + 16 * n + fr, 4 * ks + fq)); \
        _Pragma("unroll") for (int m = 0; m < 4; ++m) _Pragma("unroll") for (int n = 0; n < 8; ++n) acc[m][n] = mfma16(bfr[n], af[m], acc[m][n]); } } while (0)
    F2_LBAR();
    int st = 0;
    for (;;) {
      typename Epi::Pre pre; E.prefetch(cur, wr, fr, pre);
#pragma unroll 1
      for (int kt = 0; kt < nk; kt += 2) {
        F2_COMPUTE(st);
        F2_LBAR();
        F2_COMPUTE(st ^ 1);
        F2_LBAR();
      }
      E(acc, cur, wr, wc, fr, fq, pre, smem + (st ^ 1) * 49152);
#pragma unroll
      for (int m = 0; m < 4; ++m)
#pragma unroll
        for (int n = 0; n < 8; ++n) acc[m][n] = (f32x4){0.f, 0.f, 0.f, 0.f};
      if (!has_next) break;
      cur = nxt; ++ui;
      has_next = S.next(ui + 1, nxt);
      if (!has_next) nxt = cur;
    }
#undef F2_COMPUTE
  }
  __syncthreads();
#undef F2_LBAR
}
struct EpiActF2 {
  bf16_t* actp;
  static constexpr int NBAR = 2;
  struct Pre { int dummy; };
  DI void prefetch(const UnitF&, int, int, Pre& p) const { p.dummy = 0; }
  DI void operator()(const f32x4 (&acc)[4][8], const UnitF& u, int wr, int wc, int fr, int fq, const Pre&, unsigned char* xch) const {
    if (wc == 1) {
#pragma unroll
      for (int m = 0; m < 4; ++m)
#pragma unroll
        for (int g2 = 0; g2 < 2; ++g2) {
          unsigned char* dst = xch + (64 * wr + 16 * m + fr) * 256 + (((8 * g2 + 2 * fq) ^ (2 * (fr & 7))) << 4);
          const int n0 = 4 * g2;
          u32x4 o0 = {pk2(acc[m][n0][0], acc[m][n0 + 1][0]), pk2(acc[m][n0 + 2][0], acc[m][n0 + 3][0]), pk2(acc[m][n0][1], acc[m][n0 + 1][1]), pk2(acc[m][n0 + 2][1], acc[m][n0 + 3][1])};
          u32x4 o1 = {pk2(acc[m][n0][2], acc[m][n0 + 1][2]), pk2(acc[m][n0 + 2][2], acc[m][n0 + 3][2]), pk2(acc[m][n0][3], acc[m][n0 + 1][3]), pk2(acc[m][n0 + 2][3], acc[m][n0 + 3][3])};
          *(u32x4*)dst = o0; *(u32x4*)(dst + 16) = o1;
        }
    }
    asm volatile("s_waitcnt lgkmcnt(0)" ::: "memory"); __builtin_amdgcn_s_barrier(); asm volatile("" ::: "memory");
    if (wc == 0) {
#pragma unroll
      for (int m = 0; m < 4; ++m)
#pragma unroll
        for (int g2 = 0; g2 < 2; ++g2) {
          const unsigned char* srcp = xch + (64 * wr + 16 * m + fr) * 256 + (((8 * g2 + 2 * fq) ^ (2 * (fr & 7))) << 4);
          const u32x4 u0 = *(const u32x4*)srcp, u1 = *(const u32x4*)(srcp + 16);
          const size_t row = (size_t)u.m0 + 64 * wr + 16 * m + fr;
          const int n0 = 4 * g2;
          u32x4 o0, o1;
#pragma unroll
          for (int r = 0; r < 2; ++r) {
            o0[2 * r] = pk2(siluf_(acc[m][n0][r]) * lo2f(u0[2 * r]), siluf_(acc[m][n0 + 1][r]) * hi2f(u0[2 * r]));
            o0[2 * r + 1] = pk2(siluf_(acc[m][n0 + 2][r]) * lo2f(u0[2 * r + 1]), siluf_(acc[m][n0 + 3][r]) * hi2f(u0[2 * r + 1]));
            o1[2 * r] = pk2(siluf_(acc[m][n0][2 + r]) * lo2f(u1[2 * r]), siluf_(acc[m][n0 + 1][2 + r]) * hi2f(u1[2 * r]));
            o1[2 * r + 1] = pk2(siluf_(acc[m][n0 + 2][2 + r]) * lo2f(u1[2 * r + 1]), siluf_(acc[m][n0 + 3][2 + r]) * hi2f(u1[2 * r + 1]));
          }
          bf16_t* dst = actp + row * 256 + 128 * u.pn + 64 * g2 + 16 * fq;
          *(u32x4*)dst = o0; *(u32x4*)(dst + 8) = o1;
        }
    }
    asm volatile("s_waitcnt lgkmcnt(0)" ::: "memory"); __builtin_amdgcn_s_barrier(); asm volatile("" ::: "memory");
  }
};
struct EpiDownF2 {
  const int* slotaid; const float* slotw; unsigned char* ybase;
  static constexpr int NBAR = 0;
  struct Pre { int aid[4]; float ww[4]; };
  DI void prefetch(const UnitF& u, int wr, int fr, Pre& p) const {
    const unsigned slot0 = (unsigned)u.m0 + 64u * wr + fr;
#pragma unroll
    for (int m = 0; m < 4; ++m) { p.aid[m] = slotaid[slot0 + 16u * m]; p.ww[m] = slotw[slot0 + 16u * m]; }
  }
  DI void operator()(const f32x4 (&acc)[4][8], const UnitF& u, int wr, int wc, int fr, int fq, const Pre& p, unsigned char*) const {
#pragma unroll
    for (int m = 0; m < 4; ++m) {
      if (p.aid[m] >= 0) {
        const float sw = p.ww[m] * 64.0f;
#pragma unroll
        for (int g2 = 0; g2 < 2; ++g2) {
          const unsigned off = (unsigned)p.aid[m] * 1024u + (unsigned)u.pn * 256u + 128u * wc + 64u * g2 + 16u * fq;
          const int n0 = 4 * g2;
          u32x4 o;
#pragma unroll
          for (int r = 0; r < 4; ++r) {
            unsigned w_ = 0u;
            w_ = __builtin_amdgcn_cvt_pk_fp8_f32(acc[m][n0][r] * sw, acc[m][n0 + 1][r] * sw, w_, false);
            w_ = __builtin_amdgcn_cvt_pk_fp8_f32(acc[m][n0 + 2][r] * sw, acc[m][n0 + 3][r] * sw, w_, true);
            o[r] = w_;
          }
          *(u32x4*)(ybase + (size_t)off) = o;
        }
      }
    }
  }
};

template <class Epi, class Sched>
DI void gemmF3_phase(unsigned char* smem_, const int K, const int lda, const int ldw, const Sched& S, const Epi& E) {
  int tid = threadIdx.x; asm volatile("" : "+v"(tid));
  unsigned char* smem; { LAS unsigned char* l_ = (LAS unsigned char*)smem_; asm volatile("" : "+v"(l_)); smem = (unsigned char*)l_; }
  const int lane = tid & 63, wid = tid >> 6, wr = wid >> 1, wc = wid & 1, fr = lane & 15, fq = lane >> 4;
  const int nk = K >> 6;
  const int ar = tid >> 3, ac = tid & 7;
  const int q = tid & 63, half = q >> 5, g0 = 4 * (q & 31);
  int vrow[4];
#pragma unroll
  for (int i = 0; i < 4; ++i) vrow[i] = 64 * (q >> 4) + 16 * i + (q & 15);
  int aw[4];
#pragma unroll
  for (int j = 0; j < 4; ++j) aw[j] = sw128(ar + 64 * j, ac);
#define F3_LBAR() do { asm volatile("s_waitcnt lgkmcnt(0)" ::: "memory"); __builtin_amdgcn_s_barrier(); asm volatile("" ::: "memory"); } while (0)
#define F3_ROWS(u, rr) do { _Pragma("unroll") for (int j = 0; j < 4; ++j) rr[j] = (u).rows ? (unsigned)(u).rows[ar + 64 * j] : (unsigned)((u).m0 + ar + 64 * j); } while (0)
#define F3_LOADX(kx) do { const bool nx_ = (kx) >= nk; const int kk_ = nx_ ? (kx) - nk : (kx); \
    const bf16_t* A_ = nx_ ? nxt.A : cur.A; const float* W_ = half ? (nx_ ? nxt.W1 : cur.W1) : (nx_ ? nxt.W0 : cur.W0); \
    _Pragma("unroll") for (int j = 0; j < 4; ++j) { const unsigned rr_ = nx_ ? nr[j] : r[j]; va[j] = *(const u32x4*)((const unsigned char*)A_ + (size_t)(rr_ * (unsigned)(lda * 2) + (unsigned)(kk_ * 128 + ac * 16))); } \
    const float* wp_ = W_ + (size_t)(kk_ * 64 + 8 * wid) * ldw + g0; \
    _Pragma("unroll") for (int j = 0; j < 8; ++j) vw[j] = *(const f32x4*)(wp_ + (size_t)j * ldw); } while (0)
#define F3_STORE(st) do { unsigned char* sa_ = smem + (st) * 65536; \
    _Pragma("unroll") for (int j = 0; j < 4; ++j) *(u32x4*)(sa_ + aw[j]) = va[j]; \
    _Pragma("unroll") for (int i = 0; i < 4; ++i) { \
      u32x4 o_ = {pk2(vw[0][i], vw[1][i]), pk2(vw[2][i], vw[3][i]), pk2(vw[4][i], vw[5][i]), pk2(vw[6][i], vw[7][i])}; \
      *(u32x4*)(sa_ + 32768 + sw128(vrow[i], wid)) = o_; } } while (0)
#define F3_COMPUTE(st) do { const unsigned char* sA = smem + (st) * 65536; const unsigned char* sB = sA + 32768; \
    _Pragma("unroll") for (int ks = 0; ks < 2; ++ks) { bf16x8 af[4]; \
      _Pragma("unroll") for (int m = 0; m < 4; ++m) af[m] = ldfrag(sA + sw128(64 * wr + 16 * m + fr, 4 * ks + fq)); \
      _Pragma("unroll") for (int h2 = 0; h2 < 2; ++h2) { bf16x8 bfr[4]; \
        _Pragma("unroll") for (int n = 0; n < 4; ++n) bfr[n] = ldfrag(sB + sw128(128 * wc + 64 * h2 + 16 * n + fr, 4 * ks + fq)); \
        _Pragma("unroll") for (int m = 0; m < 4; ++m) _Pragma("unroll") for (int n = 0; n < 4; ++n) acc[m][4 * h2 + n] = mfma16(bfr[n], af[m], acc[m][4 * h2 + n]); } } } while (0)
  UnitF cur, nxt; int ui = 0;
  if (!S.next(0, cur)) return;
  unsigned r[4], nr[4];
  F3_ROWS(cur, r);
  bool has_next = S.next(1, nxt);
  if (has_next) F3_ROWS(nxt, nr); else { nxt = cur; _Pragma("unroll") for (int j = 0; j < 4; ++j) nr[j] = r[j]; }
  f32x4 acc[4][8];
#pragma unroll
  for (int m = 0; m < 4; ++m)
#pragma unroll
    for (int n = 0; n < 8; ++n) acc[m][n] = (f32x4){0.f, 0.f, 0.f, 0.f};
  u32x4 va[4]; f32x4 vw[8];
  F3_LOADX(0);
  __syncthreads();
  F3_STORE(0);
  F3_LBAR();
  int st = 0;
  for (;;) {
    typename Epi::Pre pre; E.prefetch(cur, wr, fr, pre);
#pragma unroll 1
    for (int kt = 0; kt < nk; ++kt) {
      F3_LOADX(kt + 1);
      F3_COMPUTE(st);
      F3_STORE(st ^ 1);
      F3_LBAR();
      st ^= 1;
    }
    E(acc, cur, wr, wc, fr, fq, pre, smem + (st ^ 1) * 65536);
#pragma unroll
    for (int m = 0; m < 4; ++m)
#pragma unroll
      for (int n = 0; n < 8; ++n) acc[m][n] = (f32x4){0.f, 0.f, 0.f, 0.f};
    if (!has_next) break;
    cur = nxt; ++ui;
#pragma unroll
    for (int j = 0; j < 4; ++j) r[j] = nr[j];
    has_next = S.next(ui + 1, nxt);
    if (has_next) F3_ROWS(nxt, nr); else nxt = cur;
  }
  asm volatile("s_waitcnt vmcnt(0)" ::: "memory");
  __syncthreads();
#undef F3_LBAR
#undef F3_ROWS
#undef F3_LOADX
#undef F3_STORE
#undef F3_COMPUTE
}

struct RouterF {
  unsigned char* ws; const float* rw; int G, c;
  DI bool next(int i, UnitF& u) const {
    const int L = i * G + c; if (L >= 128) return false;
    u.A = (const bf16_t*)(ws + O_X1B); u.rows = nullptr; u.m0 = L * 128; u.pn = 0; u.e = 0; u.W0 = rw; u.W1 = rw + 128; return true;
  }
};
struct EpiLogitsF {
  float* logits;
  struct Pre { int dummy; };
  DI void prefetch(const UnitF&, int, int, Pre& p) const { p.dummy = 0; }
  DI void operator()(const f32x4 (&acc)[4][4], const UnitF& u, int wr, int wc, int fr, int fq, const Pre&, unsigned char*) const {
#pragma unroll
    for (int m = 0; m < 4; ++m) {
      float* dst = logits + ((size_t)u.m0 + 64 * wr + 16 * m + fr) * 256 + 64 * wc + 16 * fq;
#pragma unroll
      for (int r = 0; r < 4; ++r) { const f32x4 o = {acc[m][0][r], acc[m][1][r], acc[m][2][r], acc[m][3][r]}; *(f32x4*)(dst + 4 * r) = o; }
    }
  }
};
DI void phase8(const Params& p, unsigned char* smem, int bid, int nb) {
  unsigned char* ws = p.ws;
  PG_LAS unsigned char* lds = (PG_LAS unsigned char*)smem;
  __syncthreads();
  pg::DenseOrder S; S.init(ws + O_X1B, ws + O_ROUT, T, 256, 1024, nb, bid);
  EpiLogits E{(float*)(ws + O_LOGITS)};
  pg::gemm_phase<EpiLogits, pg::DenseOrder, false, false>(lds, 1024, S, E);
}
DI void phase11(const Params& p, unsigned char* smem, int bid, int nb) {
  unsigned char* ws = p.ws;
  int* ts = (int*)(smem + 131072);
  build_tile_start(p, ts);
  MoeUpF S{ts, ws, p.in[I_WG], p.in[I_WU], nullptr, nullptr, ts[256], nb, bid};
  EpiActF E{(bf16_t*)(ws + O_ACT), (bf16_t*)(ws + O_ACTSH)};
  { EpiActF2 E2x{(bf16_t*)(ws + O_ACT)}; gemmF3_phase<EpiActF2, MoeUpF>(smem, 1024, 1024, 256, S, E2x); }
  __syncthreads();
  PG_LAS unsigned char* lds = (PG_LAS unsigned char*)smem;
  { pg::DenseOrder S2; S2.init(ws + O_X1B, ws + O_WSGU, T, 512, 1024, nb, bid); EpiAct E2{(bf16_t*)(ws + O_ACTSH)}; pg::gemm_phase<EpiAct, pg::DenseOrder, false, true>(lds, 1024, S2, E2); }
}
DI void phase12(const Params& p, unsigned char* smem, int bid, int nb) {
  unsigned char* ws = p.ws;
  int* ts = (int*)(smem + 131072);
  build_tile_start(p, ts);
  MoeDownF S{ts, ws, p.in[I_WDN], nullptr, ts[256], nb, bid};
  EpiDownF E{(const int*)(ws + O_SLOTAID), (const float*)(ws + O_SLOTW), ws + O_Y, (bf16_t*)(ws + O_YSH)};
  { EpiDownF2 E2x{(const int*)(ws + O_SLOTAID), (const float*)(ws + O_SLOTW), ws + O_Y}; gemmF3_phase<EpiDownF2, MoeDownF>(smem, 256, 256, 1024, S, E2x); }
  __syncthreads();
  PG_LAS unsigned char* lds = (PG_LAS unsigned char*)smem;
  { pg::DenseOrder S2; S2.init(ws + O_ACTSH, ws + O_WSD, T, 1024, 256, nb, bid); EpiBf16Out E2{(bf16_t*)(ws + O_YSH)}; pg::gemm_phase<EpiBf16Out, pg::DenseOrder, false, true>(lds, 256, S2, E2); }
}
DI void phase13(const Params& p, int bid, int nb) {
  int tid = threadIdx.x; asm volatile("" : "+v"(tid));
  const int lane = tid & 63, wave = tid >> 6;
  unsigned char* ws = p.ws;
  const float* x1 = (const float*)(ws + O_X1);
  const bf16_t* ysh = (const bf16_t*)(ws + O_YSH);
  const unsigned char* y8 = ws + O_Y;
  for (int row = bid * 8 + wave; row < T; row += nb * 8) {
    float v[16];
#pragma unroll
    for (int i = 0; i < 4; ++i) {
      const int k = 256 * i + 4 * lane;
      const f32x4 t = *(const f32x4*)(x1 + (size_t)row * D + k);
      const u32x2 s = *(const u32x2*)(ysh + (size_t)row * D + k);
      v[4 * i] = ALPHA * t[0] + lo2f(s[0]); v[4 * i + 1] = ALPHA * t[1] + hi2f(s[0]); v[4 * i + 2] = ALPHA * t[2] + lo2f(s[1]); v[4 * i + 3] = ALPHA * t[3] + hi2f(s[1]);
    }
    float rs[16];
#pragma unroll
    for (int i = 0; i < 16; ++i) rs[i] = 0.f;
#pragma unroll
    for (int k8 = 0; k8 < 8; ++k8) {
#pragma unroll
      for (int i = 0; i < 4; ++i) {
        const unsigned s = *(const unsigned*)(y8 + ((size_t)row * 8 + k8) * 1024 + 256 * i + 4 * lane);
        const f32x2_ lo = __builtin_amdgcn_cvt_pk_f32_fp8(s, false), hi = __builtin_amdgcn_cvt_pk_f32_fp8(s, true);
        rs[4 * i] += lo[0]; rs[4 * i + 1] += lo[1]; rs[4 * i + 2] += hi[0]; rs[4 * i + 3] += hi[1];
      }
    }
#pragma unroll
    for (int i = 0; i < 16; ++i) v[i] += rs[i] * (1.0f / 64.0f);
    ln_row(nullptr, p.in[I_LN2G], p.in[I_LN2B], v, lane);
#pragma unroll
    for (int i = 0; i < 4; ++i) { const f32x4 o = {v[4 * i], v[4 * i + 1], v[4 * i + 2], v[4 * i + 3]}; *(f32x4*)(p.out + (size_t)row * D + 256 * i + 4 * lane) = o; }
  }
}

DI void load_params(Params& lp, const unsigned char* smem) {
  const unsigned* t = (const unsigned*)(smem + PTAB_OFF);
#pragma unroll
  for (int i = 0; i < 28; ++i) lp.in[i] = (const float*)(GAS const float*)(((unsigned long long)(unsigned)__builtin_amdgcn_readfirstlane((int)t[2 * i + 1]) << 32) | (unsigned)__builtin_amdgcn_readfirstlane((int)t[2 * i]));
  lp.out = (float*)(GAS float*)(((unsigned long long)(unsigned)__builtin_amdgcn_readfirstlane((int)t[57]) << 32) | (unsigned)__builtin_amdgcn_readfirstlane((int)t[56]));
  lp.ws = (unsigned char*)(GAS unsigned char*)(((unsigned long long)(unsigned)__builtin_amdgcn_readfirstlane((int)t[59]) << 32) | (unsigned)__builtin_amdgcn_readfirstlane((int)t[58]));
}
__global__ void __launch_bounds__(NTHR) mega_kernel(Params pk) {
  extern __shared__ __attribute__((aligned(16))) unsigned char smem[];
  cg::grid_group grid = cg::this_grid();
  const int bid = blockIdx.x, nb = gridDim.x;
  volatile LAS unsigned* bst = (volatile LAS unsigned*)(smem + LDS_BYTES - 16);
  if (threadIdx.x < 4) bst[threadIdx.x] = 0u;
  if (threadIdx.x < 30) {
    const __attribute__((address_space(4))) unsigned long long* ka = (const __attribute__((address_space(4))) unsigned long long*)__builtin_amdgcn_kernarg_segment_ptr();
    ((unsigned long long*)(smem + PTAB_OFF))[threadIdx.x] = ka[threadIdx.x];
  }
  unsigned* barw = (unsigned*)(pk.ws + O_BAR);
  __syncthreads();
  XcdBarrier xb = xcd_barrier_post(barw, bst);
#define GSYNC() xcd_barrier(xb)
#define RUNP(k, call) do { { Params p; load_params(p, smem); call; } GSYNC(); if (DUPMASK & (1 << (k))) { { Params p; load_params(p, smem); call; } GSYNC(); } } while (0)
  { Params p; load_params(p, smem); phase0(p, smem, bid, nb); } grid.sync();
  RUNP(1, phase1(p, smem, bid, nb));
  RUNP(2, phase2(p, smem, bid, nb));
  RUNP(3, phase3(p, smem, bid, nb));
  RUNP(4, phase4(p, bid, nb));
  RUNP(5, phase5(p, smem, bid, nb));
  RUNP(6, phase6(p, smem, bid, nb));
  RUNP(14, phase7(p, bid, nb));
  if (DUPMASK & (1 << 7)) { { Params p; load_params(p, smem); phase6(p, smem, bid, nb); } GSYNC(); { Params p; load_params(p, smem); phase7(p, bid, nb); } GSYNC(); }
  RUNP(8, phase8(p, smem, bid, nb));
  RUNP(14, phase9(p, bid, nb));
  if (DUPMASK & (1 << 9)) { { Params p; load_params(p, smem); if (bid == 0 && threadIdx.x < 256) ((int*)(p.ws + O_CTRL))[threadIdx.x * CSTR] = 0; } GSYNC(); { Params p; load_params(p, smem); phase9(p, bid, nb); } GSYNC(); }
  RUNP(10, phase10(p, smem, bid, nb));
  RUNP(11, phase11(p, smem, bid, nb));
  RUNP(12, phase12(p, smem, bid, nb));
  { Params p; load_params(p, smem); phase13(p, bid, nb); }
  if (DUPMASK & (1 << 13)) { GSYNC(); Params p; load_params(p, smem); phase13(p, bid, nb); }
  if (DUPMASK & (1 << 15)) { for (int i = 0; i < 10; ++i) GSYNC(); }
}

extern "C" void kernel_launch(void* const* d_in, const int* in_sizes, int n_in, void* d_out, int out_size, void* d_ws, size_t ws_size, hipStream_t stream) {
  if (n_in != 28 || ws_size < WS_NEED) { fprintf(stderr, "kernel_launch: unexpected inputs (%d) or workspace (%zu < %zu)\n", n_in, ws_size, (size_t)WS_NEED); return; }
  static int grid_blocks = 0;
  if (!grid_blocks) {
    int dev = 0, cus = 0, per_cu = 0;
    (void)hipGetDevice(&dev);
    (void)hipDeviceGetAttribute(&cus, hipDeviceAttributeMultiprocessorCount, dev);
    (void)hipFuncSetAttribute((const void*)mega_kernel, hipFuncAttributeMaxDynamicSharedMemorySize, LDS_BYTES);
    (void)hipOccupancyMaxActiveBlocksPerMultiprocessor(&per_cu, (const void*)mega_kernel, NTHR, LDS_BYTES);
    if (per_cu < 1) per_cu = 1;
    if (per_cu > 1) per_cu = 1;
    grid_blocks = cus * per_cu;
    if (grid_blocks < 32) grid_blocks = 32;
  }
  Params p{};
  for (int i = 0; i < 28; ++i) p.in[i] = (const float*)d_in[i];
  p.out = (float*)d_out; p.ws = (unsigned char*)d_ws;
  (void)hipMemsetAsync((unsigned char*)d_ws + O_BAR, 0, 16384 + 256, stream);
  void* args[] = {&p};
  hipError_t e = hipLaunchCooperativeKernel((const void*)mega_kernel, dim3(grid_blocks), dim3(NTHR), args, LDS_BYTES, stream);
  if (e != hipSuccess) fprintf(stderr, "cooperative launch failed: %s (grid %d)\n", hipGetErrorString(e), grid_blocks);
}
```

```cpp
#include <hip/hip_runtime.h>
#include <hip/hip_cooperative_groups.h>
#include <stdint.h>
#include <stdio.h>
namespace cg = cooperative_groups;

#define DI __device__ __forceinline__
#define LAS __attribute__((address_space(3)))
#define GAS __attribute__((address_space(1)))
typedef unsigned short bf16_t;
typedef short bf16x8 __attribute__((ext_vector_type(8)));
typedef float f32x4 __attribute__((ext_vector_type(4)));
typedef unsigned u32x4 __attribute__((ext_vector_type(4)));
typedef unsigned u32x2 __attribute__((ext_vector_type(2)));

#ifndef DUPMASK
#define DUPMASK 0
#endif
constexpr int NTHR = 512;
constexpr int T = 16384, SEQ = 8192, D = 1024;
constexpr int NPROJ = 6656;
constexpr int DIN = 6664;
constexpr int NEXP = 256, DEXP = 256;
constexpr int MOE_BM = 256;
constexpr int MAXSLOT = 131072 + 256 * MOE_BM;
constexpr float ALPHA = 1.189207115002721f;
constexpr int LDS_BYTES = 157696;

constexpr size_t MB = 1u << 20;
constexpr size_t O_WGU = 0;
constexpr size_t O_WD = 256 * MB;
constexpr size_t O_WSGU = 384 * MB;
constexpr size_t O_WSD = 385 * MB;
constexpr size_t O_ROUT = 385 * MB + 512 * 1024;
constexpr size_t O_CTRL = 386 * MB;
constexpr size_t O_BAR = 386 * MB + 128 * 1024;
constexpr int CSTR = 64;
constexpr size_t O_SUBBAR = 386 * MB + 128 * 1024 + 16384;
constexpr size_t O_IDENT = 386 * MB + 256 * 1024;
constexpr size_t O_X1 = 387 * MB;
constexpr size_t O_X1B = 451 * MB;
constexpr size_t R0 = 483 * MB;
constexpr size_t O_XB = R0 + 0;
constexpr size_t O_ST = R0 + 0;
constexpr size_t O_WINT = R0 + 32 * MB;
constexpr size_t O_WAT = R0 + 45 * MB;
constexpr size_t O_WBT = R0 + 46 * MB;
constexpr size_t O_WCT = R0 + 47 * MB;
constexpr size_t O_WOT = R0 + 48 * MB;
constexpr size_t O_WMKV = R0 + 50 * MB;
constexpr size_t O_MEMB = R0 + 52 * MB;
constexpr size_t O_SGUW = R0 + 53 * MB;
constexpr size_t O_AB = R0 + 53 * MB + 512 * 1024;
constexpr size_t O_MEMK = R0 + 54 * MB;
constexpr size_t O_MEMVT = R0 + 54 * MB + 512 * 1024;
constexpr size_t O_QKV = R0 + 55 * MB;
constexpr size_t O_PART = R0 + 55 * MB;
constexpr size_t O_ZS = R0 + 103 * MB;
constexpr size_t O_UVG = R0 + 119 * MB;
constexpr size_t O_MERGED = R0 + 119 * MB;
constexpr size_t O_XQ = R0 + 151 * MB;
constexpr size_t O_GATES = R0 + 167 * MB;
constexpr size_t O_MP = R0 + 263 * MB;
constexpr size_t O_BC = R0 + 295 * MB;
constexpr size_t O_O0 = R0 + 359 * MB;
constexpr size_t O_QP = R0 + 391 * MB;
constexpr size_t O_GL = R0 + 407 * MB;
constexpr size_t O_GDNO = R0 + 408 * MB;
constexpr size_t O_SGUO = R0 + 424 * MB;
constexpr size_t O_XATO = R0 + 440 * MB;
constexpr size_t O_LOGITS = R0 + 0;
constexpr size_t O_TKIDX = R0 + 16 * MB;
constexpr size_t O_TKW = R0 + 16 * MB + 512 * 1024;
constexpr size_t O_TKPOS = R0 + 17 * MB;
constexpr size_t O_SLOTTOK = R0 + 18 * MB;
constexpr size_t O_SLOTW = R0 + 19 * MB;
constexpr size_t O_SLOTAID = R0 + 20 * MB;
constexpr size_t O_ACT = R0 + 21 * MB;
constexpr size_t O_ACTSH = R0 + 181 * MB;
constexpr size_t O_YSH = R0 + 189 * MB;
constexpr size_t O_Y = R0 + 221 * MB;
constexpr size_t WS_NEED = R0 + 477 * MB;

struct Params {
  const float* in[28];
  float* out;
  unsigned char* ws;
};
enum { I_X = 0, I_MEM, I_WIN, I_CONVW, I_ALOG, I_DTB, I_GNG, I_WA, I_SLNG, I_SLNB, I_SGUW, I_SGUB, I_WB, I_WMKV, I_WC, I_WO,
       I_LN1G, I_LN1B, I_RW, I_RB, I_WG, I_WU, I_WDN, I_WSG, I_WSU, I_WSD, I_LN2G, I_LN2B };

constexpr int PTAB_OFF = 156672;
DI float bf2f(bf16_t h) { return __uint_as_float(((unsigned)h) << 16); }
DI bf16_t f2bf(float f) { unsigned u = __float_as_uint(f); u += 0x7fffu + ((u >> 16) & 1u); return (bf16_t)(u >> 16); }
typedef float f32x2_ __attribute__((ext_vector_type(2)));
typedef __bf16 bf16x2_ __attribute__((ext_vector_type(2)));
DI unsigned pk2(float lo, float hi) { f32x2_ v = {lo, hi}; return __builtin_bit_cast(unsigned, __builtin_convertvector(v, bf16x2_)); }
DI float lo2f(unsigned u) { return __uint_as_float(u << 16); }
DI float hi2f(unsigned u) { return __uint_as_float(u & 0xffff0000u); }
DI float sigmoidf_(float x) { return __builtin_amdgcn_rcpf(1.f + __builtin_amdgcn_exp2f(-1.4426950408889634f * x)); }
DI float siluf_(float x) { return x * sigmoidf_(x); }
DI float geluf_(float x) { return x * sigmoidf_(1.5957691216057308f * (x + 0.044715f * x * x * x)); }
DI float softplusf_(float x) { return fmaxf(x, 0.f) + log1pf(__expf(-fabsf(x))); }
DI float wave_sum(float v) {
#pragma unroll
  for (int o = 32; o; o >>= 1) v += __shfl_xor(v, o);
  return v;
}
DI f32x4 mfma16(bf16x8 a, bf16x8 b, f32x4 c) { return __builtin_amdgcn_mfma_f32_16x16x32_bf16(a, b, c, 0, 0, 0); }
DI bf16x8 ldfrag(const void* p) { return __builtin_bit_cast(bf16x8, *(const u32x4*)p); }
DI bf16x8 pack8(f32x4 a, f32x4 b) { u32x4 r = {pk2(a[0], a[1]), pk2(a[2], a[3]), pk2(b[0], b[1]), pk2(b[2], b[3])}; return __builtin_bit_cast(bf16x8, r); }
DI u32x2 pack4(f32x4 a) { u32x2 r = {pk2(a[0], a[1]), pk2(a[2], a[3])}; return r; }
DI int sw128(int row, int chunk) { return row * 128 + ((chunk ^ (row & 7)) << 4); }
DI int sw256(int row, int chunk) { return row * 256 + ((chunk ^ (row & 15)) << 4); }

namespace pg {
#define PG_LAS __attribute__((address_space(3)))
constexpr int BM = 256, BK = 64, HALF = 128, HTB = HALF * BK * 2, NXCD = 8, WGM = 8;
DI int lds_byte(int r, int c) { const int st = (r >> 4) * 2 + (c >> 5), rr = r & 15, cc = c & 31, ob = rr * 64 + cc * 2; return st * 1024 + (ob ^ (((ob >> 9) & 1) << 5)); }
DI void stage_rc(int b, int& R, int& C) { const int st = b / 1024, sb = b % 1024, swz = sb ^ (((sb >> 9) & 1) << 5); R = (st >> 1) * 16 + swz / 64; C = (st & 1) * 32 + (swz % 64) / 2; }

struct Unit { const char* a; const char* b; const int* rows; int pm, pn, e; };

struct DenseOrder {
  const char* A; const char* B; int nM, nN, nwg, G, c; size_t tstep;
  DI void init(const void* A_, const void* B_, int M, int N, int K, int G_, int c_) { A = (const char*)A_; B = (const char*)B_; nM = M / BM; nN = N / BM; nwg = nM * nN; G = G_; c = c_; tstep = (size_t)BM * K * 2; }
  DI bool next(int i, Unit& u) const { const long L = (long)i * G + c; if (L >= nwg) return false; unit_of(L, u); return true; }
  DI void unit_of(long L, Unit& u) const {
    int wgid = (int)L; { const int q = nwg / NXCD, r = nwg % NXCD, xcd = wgid % NXCD, off = wgid / NXCD; wgid = (xcd < r ? xcd * (q + 1) : r * (q + 1) + (xcd - r) * q) + off; }
    const int nig = WGM * nN, gid = wgid / nig, fm = gid * WGM, gsz = (nM - fm) < WGM ? (nM - fm) : WGM;
    u.pm = fm + ((wgid % nig) % gsz); u.pn = (wgid % nig) / gsz; u.e = 0; u.rows = nullptr;
    u.a = A + (size_t)u.pm * tstep; u.b = B + (size_t)u.pn * tstep;
  }
};

template <class Epi, class Sched, bool GATHER, bool ALIGN_EPI>
DI void gemm_phase(PG_LAS unsigned char* lds, const int K, const Sched& S, const Epi& E) {
  int tid = threadIdx.x; asm volatile("" : "+v"(tid));
  const int wid = __builtin_amdgcn_readfirstlane(tid >> 6), lane = tid & 63, wr = wid >> 2, wc = wid & 3, fr = lane & 15, fq = lane >> 4;
  const int nt = K / BK;
  int Rr[2], Cc[2];
  unsigned voffB[2];
#pragma unroll
  for (int i = 0; i < 2; ++i) { stage_rc(tid * 16 + i * 8192, Rr[i], Cc[i]); voffB[i] = (unsigned)(Rr[i] * K + Cc[i]) * 2u; }
  const size_t kstep = (size_t)(BK * 2);
  const size_t hstep = (size_t)HALF * K * 2;
  const unsigned ldsw = (unsigned)wid * 1024u;
  const int aoff = lds_byte(wr * 64 + fr, fq * 8), boff = lds_byte(wc * 32 + fr, fq * 8);
#define PG_SA(b, h) (((b) * 2 + (h)) * HTB)
#define PG_SB(b, h) ((4 + (b) * 2 + (h)) * HTB)
#define PG_STAGE(bufoff, gbase, v0, v1) do { \
    __builtin_amdgcn_global_load_lds((const unsigned*)((const char*)(gbase) + (v0)), (PG_LAS unsigned*)(lds + (bufoff) + ldsw), 16, 0, 0); \
    __builtin_amdgcn_global_load_lds((const unsigned*)((const char*)(gbase) + (v1)), (PG_LAS unsigned*)(lds + (bufoff) + ldsw + 8192), 16, 0, 0); } while (0)
#define PG_LDA(dst, b, h) do { _Pragma("unroll") for (int m = 0; m < 4; ++m) _Pragma("unroll") for (int k = 0; k < 2; ++k) dst[m][k] = *(const PG_LAS bf16x8*)(lds + PG_SA(b, h) + aoff + m * 2048 + k * 1024); } while (0)
#define PG_LDB(dst, b, h) do { _Pragma("unroll") for (int n = 0; n < 2; ++n) _Pragma("unroll") for (int k = 0; k < 2; ++k) dst[n][k] = *(const PG_LAS bf16x8*)(lds + PG_SB(b, h) + boff + n * 2048 + k * 1024); } while (0)
#define PG_MMA(ai, bj, At, Bt) do { __builtin_amdgcn_s_setprio(1); _Pragma("unroll") for (int m = 0; m < 4; ++m) _Pragma("unroll") for (int n = 0; n < 2; ++n) _Pragma("unroll") for (int k = 0; k < 2; ++k) \
    acc[ai][bj][m][n] = __builtin_amdgcn_mfma_f32_16x16x32_bf16(Bt[n][k], At[m][k], acc[ai][bj][m][n], 0, 0, 0); __builtin_amdgcn_s_setprio(0); } while (0)
#define PG_WAIT_V(n) asm volatile("s_waitcnt vmcnt(" #n ")" ::: "memory")
#define PG_WAIT_L(n) asm volatile("s_waitcnt lgkmcnt(" #n ")" ::: "memory")
#define PG_BAR __builtin_amdgcn_s_barrier()
#define PG_SCHED __builtin_amdgcn_sched_barrier(0)
#define PG_AOFFS(u, o00, o01, o10, o11) do { if (GATHER) { \
      o00 = (unsigned)(u).rows[Rr[0]] * (unsigned)(K * 2) + (unsigned)Cc[0] * 2u; o01 = (unsigned)(u).rows[Rr[1]] * (unsigned)(K * 2) + (unsigned)Cc[1] * 2u; \
      o10 = (unsigned)(u).rows[128 + Rr[0]] * (unsigned)(K * 2) + (unsigned)Cc[0] * 2u; o11 = (unsigned)(u).rows[128 + Rr[1]] * (unsigned)(K * 2) + (unsigned)Cc[1] * 2u; \
    } else { o00 = voffB[0]; o01 = voffB[1]; o10 = voffB[0] + (unsigned)hstep; o11 = voffB[1] + (unsigned)hstep; } } while (0)
  Unit cur, nxt; int ui = 0;
  if (!S.next(0, cur)) return;
  f32x4 acc[2][2][4][2];
#pragma unroll
  for (int a = 0; a < 2; ++a)
#pragma unroll
    for (int b = 0; b < 2; ++b)
#pragma unroll
      for (int m = 0; m < 4; ++m)
#pragma unroll
        for (int n = 0; n < 2; ++n) acc[a][b][m][n] = (f32x4){0.f, 0.f, 0.f, 0.f};
  bf16x8 At[4][2], B0[2][2], B1[2][2];
  const char* cA = cur.a; const char* cB = cur.b;
  unsigned c00, c01, c10, c11;
  PG_AOFFS(cur, c00, c01, c10, c11);
  const unsigned vb0 = voffB[0], vb1 = voffB[1];
  PG_STAGE(PG_SB(0, 0), cB, vb0, vb1); PG_STAGE(PG_SB(0, 1), cB + hstep, vb0, vb1); PG_STAGE(PG_SA(0, 0), cA, c00, c01); PG_STAGE(PG_SA(0, 1), cA, c10, c11);
  if (wr == 1) PG_BAR;
  PG_WAIT_V(2); PG_BAR;
  PG_STAGE(PG_SB(1, 0), cB + kstep, vb0, vb1); PG_STAGE(PG_SA(1, 0), cA + kstep, c00, c01); PG_STAGE(PG_SB(1, 1), cB + hstep + kstep, vb0, vb1);
  PG_WAIT_V(6); PG_BAR;
  for (;;) {
    const bool has_next = S.next(ui + 1, nxt);
    const char* nA = has_next ? nxt.a : cA; const char* nB = has_next ? nxt.b : cB;
    unsigned n00 = c00, n01 = c01, n10 = c10, n11 = c11;
    if (has_next) PG_AOFFS(nxt, n00, n01, n10, n11);
#pragma unroll 1
    for (int t = 0; t < nt; t += 2) {
      const bool last = (t == nt - 2);
      const char* a1 = cA + (size_t)(t + 1) * kstep;
      const char* a2 = last ? nA : cA + (size_t)(t + 2) * kstep; const char* b2 = last ? nB : cB + (size_t)(t + 2) * kstep;
      const char* a3 = a2 + kstep; const char* b3 = b2 + kstep;
      const unsigned o00 = last ? n00 : c00, o01 = last ? n01 : c01, o10 = last ? n10 : c10, o11 = last ? n11 : c11;
      PG_LDB(B0, 0, 0); PG_LDB(B1, 0, 1); PG_SCHED; PG_LDA(At, 0, 0); PG_STAGE(PG_SA(1, 1), a1, c10, c11);
      PG_WAIT_V(8); PG_WAIT_L(0); PG_BAR; PG_MMA(0, 0, At, B0); PG_MMA(0, 1, At, B1); PG_BAR; PG_SCHED;
      PG_LDA(At, 0, 1); PG_STAGE(PG_SB(0, 0), b2, vb0, vb1); PG_STAGE(PG_SB(0, 1), b2 + hstep, vb0, vb1); PG_STAGE(PG_SA(0, 0), a2, o00, o01);
      PG_WAIT_V(8); PG_WAIT_L(0); PG_BAR; PG_MMA(1, 0, At, B0); PG_MMA(1, 1, At, B1); PG_BAR; PG_SCHED;
      PG_LDB(B0, 1, 0); PG_LDB(B1, 1, 1); PG_SCHED; PG_LDA(At, 1, 0); PG_STAGE(PG_SA(0, 1), a2, o10, o11);
      PG_WAIT_V(8); PG_WAIT_L(0); PG_BAR; PG_MMA(0, 0, At, B0); PG_MMA(0, 1, At, B1); PG_BAR; PG_SCHED;
      PG_LDA(At, 1, 1); PG_STAGE(PG_SB(1, 0), b3, vb0, vb1); PG_STAGE(PG_SB(1, 1), b3 + hstep, vb0, vb1); PG_STAGE(PG_SA(1, 0), a3, o00, o01);
      PG_WAIT_V(8); PG_WAIT_L(0); PG_BAR; PG_MMA(1, 0, At, B0); PG_MMA(1, 1, At, B1); PG_BAR; PG_SCHED;
    }
    if constexpr (ALIGN_EPI) { if (wr == 0) PG_BAR; }
    E(acc, cur, wr, wc, fr, fq);
    if (!has_next) break;
#pragma unroll
    for (int a = 0; a < 2; ++a)
#pragma unroll
      for (int b = 0; b < 2; ++b)
#pragma unroll
        for (int m = 0; m < 4; ++m)
#pragma unroll
          for (int n = 0; n < 2; ++n) acc[a][b][m][n] = (f32x4){0.f, 0.f, 0.f, 0.f};
    cur = nxt; cA = nA; cB = nB; c00 = n00; c01 = n01; c10 = n10; c11 = n11; ++ui;
    if constexpr (ALIGN_EPI) { if (wr == 1) PG_BAR; }
  }
  PG_WAIT_V(0);
  if constexpr (!ALIGN_EPI) { if (wr == 0) PG_BAR; }
  PG_BAR;
#undef PG_SA
#undef PG_SB
#undef PG_STAGE
#undef PG_LDA
#undef PG_LDB
#undef PG_MMA
#undef PG_WAIT_V
#undef PG_WAIT_L
#undef PG_BAR
#undef PG_SCHED
#undef PG_AOFFS
}
}


struct UnitF { const bf16_t* A; const int* rows; const float* W0; const float* W1; int m0, pn, e; };

template <bool AMUL, class Epi, class Sched, int ABL = 0>
DI void gemmF_phase(unsigned char* smem_, const int K, const int lda, const int ldw, const Sched& S, const Epi& E) {
  int tid = threadIdx.x; asm volatile("" : "+v"(tid));
  unsigned char* smem; { LAS unsigned char* l_ = (LAS unsigned char*)smem_; asm volatile("" : "+v"(l_)); smem = (unsigned char*)l_; }
  const int lane = tid & 63, wid = tid >> 6, wr = wid >> 2, wc = wid & 3, fr = lane & 15, fq = lane >> 4;
  const int nk = K >> 6;
  const int ar0 = tid >> 3, ac = tid & 7;
  const int q = tid & 63, half = q >> 5, g0 = 4 * (q & 31);
  int vrow[4];
#pragma unroll
  for (int i = 0; i < 4; ++i) vrow[i] = 64 * (q >> 4) + 16 * i + (q & 15);
  const int aw0 = sw128(ar0, ac), aw1 = sw128(ar0 + 64, ac);
#define F_ROWS(u, rr0, rr1) do { rr0 = (u).rows ? (size_t)(u).rows[ar0] : (size_t)((u).m0 + ar0); rr1 = (u).rows ? (size_t)(u).rows[ar0 + 64] : (size_t)((u).m0 + ar0 + 64); } while (0)
#define F_LOAD(A_, W0_, W1_, rr0_, rr1_, kk_, va0, va1, vb0, vb1, vw) do { \
    va0 = *(const u32x4*)((A_) + (rr0_) * lda + (kk_) * 64 + ac * 8); va1 = *(const u32x4*)((A_) + (rr1_) * lda + (kk_) * 64 + ac * 8); \
    if (AMUL) { vb0 = *(const u32x4*)((A_) + (rr0_) * lda + 256 + (kk_) * 64 + ac * 8); vb1 = *(const u32x4*)((A_) + (rr1_) * lda + 256 + (kk_) * 64 + ac * 8); } \
    const float* wp_ = (half ? (W1_) : (W0_)) + (size_t)((kk_) * 64 + 8 * wid) * ldw + g0; \
    if (ABL != 1) { _Pragma("unroll") for (int j = 0; j < 8; ++j) vw[j] = *(const f32x4*)(wp_ + (size_t)j * ldw); } } while (0)
#define F_LOADX(kx, va0, va1, vb0, vb1, vw) do { const bool nx_ = (kx) >= nk; const int kk2_ = nx_ ? (kx) - nk : (kx); \
    const bf16_t* A2_ = nx_ ? nxt.A : cur.A; const float* W02_ = nx_ ? nxt.W0 : cur.W0; const float* W12_ = nx_ ? nxt.W1 : cur.W1; \
    const size_t q0_ = nx_ ? nr0 : r0, q1_ = nx_ ? nr1 : r1; \
    F_LOAD(A2_, W02_, W12_, q0_, q1_, kk2_, va0, va1, vb0, vb1, vw); } while (0)
#define F_STORE(st, va0, va1, vb0, vb1, vw) do { unsigned char* sa_ = smem + (st) * 49152; \
    if (AMUL) { _Pragma("unroll") for (int e_ = 0; e_ < 4; ++e_) { va0[e_] = pk2(lo2f(va0[e_]) * lo2f(vb0[e_]), hi2f(va0[e_]) * hi2f(vb0[e_])); va1[e_] = pk2(lo2f(va1[e_]) * lo2f(vb1[e_]), hi2f(va1[e_]) * hi2f(vb1[e_])); } } \
    *(u32x4*)(sa_ + aw0) = va0; *(u32x4*)(sa_ + aw1) = va1; \
    if (ABL != 3) { _Pragma("unroll") for (int i = 0; i < 4; ++i) { \
      u32x4 o_ = {pk2(vw[0][i], vw[1][i]), pk2(vw[2][i], vw[3][i]), pk2(vw[4][i], vw[5][i]), pk2(vw[6][i], vw[7][i])}; \
      *(u32x4*)(sa_ + 16384 + sw128(vrow[i], wid)) = o_; } } else { _Pragma("unroll") for (int j = 0; j < 8; ++j) asm volatile("" :: "v"(vw[j])); } } while (0)
#define F_LBAR() do { asm volatile("s_waitcnt lgkmcnt(0)" ::: "memory"); __builtin_amdgcn_s_barrier(); asm volatile("" ::: "memory"); } while (0)
#define F_COMPUTE(st) do { const unsigned char* sA = smem + (st) * 49152; const unsigned char* sB = sA + 16384; \
    _Pragma("unroll") for (int ks = 0; ks < 2; ++ks) { bf16x8 af[4], bfr[4]; \
      _Pragma("unroll") for (int m = 0; m < 4; ++m) af[m] = ldfrag(sA + sw128(64 * wr + 16 * m + fr, 4 * ks + fq)); \
      _Pragma("unroll") for (int n = 0; n < 4; ++n) bfr[n] = ldfrag(sB + sw128(64 * wc + 16 * n + fr, 4 * ks + fq)); \
      if (ABL != 2) { _Pragma("unroll") for (int m = 0; m < 4; ++m) _Pragma("unroll") for (int n = 0; n < 4; ++n) acc[m][n] = mfma16(bfr[n], af[m], acc[m][n]); } \
      else { _Pragma("unroll") for (int m = 0; m < 4; ++m) _Pragma("unroll") for (int n = 0; n < 4; ++n) asm volatile("" :: "v"(af[m]), "v"(bfr[n])); } } } while (0)
  UnitF cur, nxt; int ui = 0;
  if (!S.next(0, cur)) return;
  size_t r0, r1, nr0, nr1;
  F_ROWS(cur, r0, r1);
  bool has_next = S.next(1, nxt);
  if (has_next) F_ROWS(nxt, nr0, nr1); else { nxt = cur; nr0 = r0; nr1 = r1; }
  f32x4 acc[4][4];
#pragma unroll
  for (int m = 0; m < 4; ++m)
#pragma unroll
    for (int n = 0; n < 4; ++n) acc[m][n] = (f32x4){0.f, 0.f, 0.f, 0.f};
  u32x4 xa0, xa1, ya0, ya1, xb0, xb1, yb0, yb1; f32x4 xw[8], yw[8];
  xb0 = xb1 = yb0 = yb1 = (u32x4){0u, 0u, 0u, 0u};
  if (ABL == 1) { _Pragma("unroll") for (int j = 0; j < 8; ++j) { xw[j] = (f32x4){0.f, 0.f, 0.f, 0.f}; yw[j] = xw[j]; } }
  F_LOAD(cur.A, cur.W0, cur.W1, r0, r1, 0, xa0, xa1, xb0, xb1, xw);
  F_LOAD(cur.A, cur.W0, cur.W1, r0, r1, 1, ya0, ya1, yb0, yb1, yw);
  __syncthreads();
  F_STORE(0, xa0, xa1, xb0, xb1, xw);
  F_LBAR();
  int st = 0;
  for (;;) {
    typename Epi::Pre pre; E.prefetch(cur, wr, fr, pre);
#pragma unroll 1
    for (int kt = 0; kt < nk; kt += 2) {
      F_LOADX(kt + 2, xa0, xa1, xb0, xb1, xw);
      F_COMPUTE(st);
      F_STORE(st ^ 1, ya0, ya1, yb0, yb1, yw);
      F_LBAR();
      F_LOADX(kt + 3, ya0, ya1, yb0, yb1, yw);
      F_COMPUTE(st ^ 1);
      F_STORE(st, xa0, xa1, xb0, xb1, xw);
      F_LBAR();
    }
    if (ABL != 4) E(acc, cur, wr, wc, fr, fq, pre, smem + (st ^ 1) * 49152); else { _Pragma("unroll") for (int m = 0; m < 4; ++m) _Pragma("unroll") for (int n = 0; n < 4; ++n) asm volatile("" :: "v"(acc[m][n])); }
#pragma unroll
    for (int m = 0; m < 4; ++m)
#pragma unroll
      for (int n = 0; n < 4; ++n) acc[m][n] = (f32x4){0.f, 0.f, 0.f, 0.f};
    if (!has_next) break;
    cur = nxt; r0 = nr0; r1 = nr1; ++ui;
    has_next = S.next(ui + 1, nxt);
    if (has_next) F_ROWS(nxt, nr0, nr1); else { nxt = cur; nr0 = r0; nr1 = r1; }
  }
  asm volatile("s_waitcnt vmcnt(0)" ::: "memory");
  __syncthreads();
#undef F_ROWS
#undef F_LOAD
#undef F_LOADX
#undef F_STORE
#undef F_LBAR
#undef F_COMPUTE
}

#define XB_TMO      128
#define XB_XCNT(j)  (256  + 64 * (j))
#define XB_XSUB(j)  (1280 + 64 * (j))
#define XB_XGEN(j)  (2304 + 64 * (j))
#define XB_TOP      3328
#define XB_TOPGEN   3392
#define XCD_BAR_WORDS 3456
#define XB_SPIN_CAP (1u << 22)
DI unsigned xb_ld(unsigned* p)              { return __hip_atomic_load(p, __ATOMIC_RELAXED, __HIP_MEMORY_SCOPE_AGENT); }
DI unsigned xb_add(unsigned* p, unsigned v) { return __hip_atomic_fetch_add(p, v, __ATOMIC_RELAXED, __HIP_MEMORY_SCOPE_AGENT); }
DI unsigned xb_xcc_id() { return (unsigned)__builtin_amdgcn_s_getreg((3 << 11) | 20) & 0xFu; }
#define XB_SPIN(cond, bar) do { unsigned _sp = 0; while (cond) { __builtin_amdgcn_s_sleep(1); \
    if ((++_sp & 255u) == 0u) { if (xb_ld(&(bar)[XB_TMO])) break; if (_sp > XB_SPIN_CAP) { atomicAdd(&(bar)[XB_TMO], 1u); break; } } } } while (0)
struct XcdBarrier { unsigned* bar; unsigned x; volatile LAS unsigned* st; };
DI XcdBarrier xcd_barrier_post(unsigned* bar, volatile LAS unsigned* st) {
  XcdBarrier b; b.bar = bar; b.x = xb_xcc_id(); b.st = st;
  if (threadIdx.x == 0) (void)xb_add(&bar[XB_XCNT(b.x)], 1u);
  return b;
}
DI void xcd_barrier_complete(unsigned* bar, unsigned x, unsigned& nloc, unsigned& nx) {
  const unsigned G = gridDim.x * gridDim.y * gridDim.z;
  unsigned sum, cnt, mine, sp = 0u;
  for (;;) {
    sum = 0u; cnt = 0u; mine = 0u;
#pragma unroll
    for (unsigned j = 0; j < 16; ++j) { const unsigned c = xb_ld(&bar[XB_XCNT(j)]); sum += c; cnt += (c > 0u) ? 1u : 0u; mine = (j == x) ? c : mine; }
    if (sum == G) break;
    __builtin_amdgcn_s_sleep(1);
    if ((++sp & 255u) == 0u) { if (xb_ld(&bar[XB_TMO])) break; if (sp > XB_SPIN_CAP) { atomicAdd(&bar[XB_TMO], 1u); break; } }
  }
  nloc = mine > 0u ? mine : 1u; nx = cnt > 0u ? cnt : 1u;
}
DI void xcd_barrier(const XcdBarrier& b) {
  asm volatile("s_waitcnt vmcnt(0)" ::: "memory");
  __syncthreads();
  if (threadIdx.x == 0) {
    unsigned* bar = b.bar;
    __builtin_amdgcn_s_waitcnt(0);
    unsigned nloc = b.st[0], nx = b.st[1];
    if (nloc == 0u) { xcd_barrier_complete(bar, b.x, nloc, nx); b.st[0] = nloc; b.st[1] = nx; }
    const unsigned old = xb_add(&bar[XB_XSUB(b.x)], 1u);
    const unsigned gen = old / nloc;
    if (old + 1u == (gen + 1u) * nloc) {
      __builtin_amdgcn_fence(__ATOMIC_RELEASE, "agent");
      asm volatile("s_waitcnt vmcnt(0)" ::: "memory");
      const unsigned og = xb_add(&bar[XB_TOP], 1u);
      const unsigned tg = og / nx;
      if (og + 1u == (tg + 1u) * nx) xb_add(&bar[XB_TOPGEN], 1u);
      else XB_SPIN(xb_ld(&bar[XB_TOPGEN]) == tg, bar);
      __builtin_amdgcn_fence(__ATOMIC_ACQUIRE, "agent");
      xb_add(&bar[XB_XGEN(b.x)], 1u);
      asm volatile("s_waitcnt vmcnt(0)" ::: "memory");
    } else {
      XB_SPIN(xb_ld(&bar[XB_XGEN(b.x)]) == gen, bar);
      __builtin_amdgcn_fence(__ATOMIC_ACQUIRE, "agent");
      asm volatile("s_waitcnt vmcnt(0)" ::: "memory");
    }
  }
  __syncthreads();
}

DI void phase0(const Params& p, unsigned char* smem, int bid, int nb) {
  int tid = threadIdx.x; asm volatile("" : "+v"(tid));
  const int lane = tid & 63, wave = tid >> 6;
  unsigned char* ws = p.ws;
  if (bid == 0 && tid < 256) ((int*)(ws + O_CTRL))[tid * CSTR] = 0;
  for (int i = bid * NTHR + tid; i < T; i += nb * NTHR) ((int*)(ws + O_IDENT))[i] = i;
  {
    float* wabT = (float*)smem;
    const float* win = p.in[I_WIN];
    for (int i = tid; i < 8192; i += NTHR) { const int k = i >> 3, j = i & 7; wabT[j * 1024 + k] = win[(size_t)k * DIN + 2048 + j]; }
    __syncthreads();
    const float* x = p.in[I_X];
    bf16_t* xb = (bf16_t*)(ws + O_XB);
    float* ab = (float*)(ws + O_AB);
    for (int row = bid * 8 + wave; row < T; row += nb * 8) {
      float s[8];
#pragma unroll
      for (int j = 0; j < 8; ++j) s[j] = 0.f;
#pragma unroll
      for (int i = 0; i < 4; ++i) {
        const int k = 256 * i + 4 * lane;
        const f32x4 v = *(const f32x4*)(x + (size_t)row * D + k);
        *(u32x2*)(xb + (size_t)row * D + k) = pack4(v);
#pragma unroll
        for (int j = 0; j < 8; ++j) { const f32x4 w = *(const f32x4*)(wabT + j * 1024 + k); s[j] += v[0] * w[0] + v[1] * w[1] + v[2] * w[2] + v[3] * w[3]; }
      }
#pragma unroll
      for (int j = 0; j < 8; ++j) s[j] = wave_sum(s[j]);
      if (lane == 0) { *(f32x4*)(ab + (size_t)row * 8) = (f32x4){s[0], s[1], s[2], s[3]}; *(f32x4*)(ab + (size_t)row * 8 + 4) = (f32x4){s[4], s[5], s[6], s[7]}; }
    }
    const float* mem = p.in[I_MEM];
    bf16_t* memb = (bf16_t*)(ws + O_MEMB);
    for (int row = bid * 8 + wave; row < 512; row += nb * 8) {
#pragma unroll
      for (int i = 0; i < 4; ++i) { const int k = 256 * i + 4 * lane; *(u32x2*)(memb + (size_t)row * D + k) = pack4(*(const f32x4*)(mem + (size_t)row * D + k)); }
    }
    const float* sw = p.in[I_SGUW];
    bf16_t* sguw = (bf16_t*)(ws + O_SGUW);
    for (int i = bid * NTHR + tid; i < 16384; i += nb * NTHR) {
      const int e0 = i * 4; const int col = e0 & 127, rowi = (e0 >> 7) & 127;
      f32x4 v = *(const f32x4*)(sw + e0);
#pragma unroll
      for (int c = 0; c < 4; ++c) if (col + c > rowi) v[c] = 0.f;
      *(u32x2*)(sguw + e0) = pack4(v);
    }
    __syncthreads();
  }
  {
    float* tile = (float*)smem;
    const float *pwin = p.in[I_WIN], *pwa = p.in[I_WA], *pwb = p.in[I_WB], *pwc = p.in[I_WC], *pwo = p.in[I_WO], *pwmkv = p.in[I_WMKV], *prw = p.in[I_RW],
                *pwsg = p.in[I_WSG], *pwsu = p.in[I_WSU], *pwsd = p.in[I_WSD], *pwg = p.in[I_WG], *pwu = p.in[I_WU], *pwdn = p.in[I_WDN];
    { GAS const float *a_ = (GAS const float*)pwa, *b_ = (GAS const float*)pwb, *c_ = (GAS const float*)pwc, *o_ = (GAS const float*)pwo, *m_ = (GAS const float*)pwmkv;
      asm volatile("" : "+s"(a_), "+s"(b_), "+s"(c_), "+s"(o_), "+s"(m_));
      pwa = (const float*)a_; pwb = (const float*)b_; pwc = (const float*)c_; pwo = (const float*)o_; pwmkv = (const float*)m_; }
    constexpr int J0 = 1664, J1 = J0 + 128, J2 = J1 + 128, J3 = J2 + 128, J4 = J3 + 256, J5 = J4 + 256, J6 = J5 + 64, J7 = J6 + 128, J8 = J7 + 64,
                  J9 = J8, J10 = J8;
    const int kr = tid >> 4, nc = tid & 15, sg = nc >> 2;
    const int tn = tid >> 3, tkc = tid & 7;
#define P0_DECODE_LOAD(it0, dp, v0, v1) do { const float* sp[4]; int ld[4]; \
      _Pragma("unroll") \
      for (int q = 0; q < 4; ++q) { \
        const int it = (it0 + q < J10) ? it0 + q : J10 - 1;      \
        const float *s0, *s1, *s2, *s3; int ldd; bf16_t* dst; \
        if (it < J0) {           \
          const int kt = it & 15, nt = it >> 4; const int n0 = nt * 64; const int c0 = n0 + (n0 >= 2048 ? 8 : 0); \
          const float* b = pwin + (size_t)kt * 64 * DIN + c0; s0 = b; s1 = b + 16; s2 = b + 32; s3 = b + 48; ld[q] = DIN; ldd = 1024; \
          dst = (bf16_t*)(ws + O_WINT) + (size_t)n0 * 1024 + kt * 64; \
        } else if (it < J3) {    \
          const int which = (it - J0) >> 7, r = (it - J0) & 127; const int kt = r & 7, nt = r >> 3; \
          const float* src = which == 0 ? pwa : which == 1 ? pwb : pwc; \
          const float* b = src + (size_t)kt * 64 * 1024 + nt * 64; s0 = b; s1 = b + 16; s2 = b + 32; s3 = b + 48; ld[q] = 1024; ldd = 512; \
          dst = (bf16_t*)(ws + (which == 0 ? O_WAT : which == 1 ? O_WBT : O_WCT)) + (size_t)nt * 64 * 512 + kt * 64; \
        } else if (it < J5) {    \
          const int which = (it - J3) >> 8, r = (it - J3) & 255; const int kt = r & 15, nt = r >> 4; \
          const float* b = (which == 0 ? pwo : pwmkv) + (size_t)kt * 64 * 1024 + nt * 64; s0 = b; s1 = b + 16; s2 = b + 32; s3 = b + 48; ld[q] = 1024; ldd = 1024; \
          dst = (bf16_t*)(ws + (which == 0 ? O_WOT : O_WMKV)) + (size_t)nt * 64 * 1024 + kt * 64; \
        } else if (it < J6) {    \
          const int r = it - J5; const int kt = r & 15, nt = r >> 4; \
          const float* b = prw + (size_t)kt * 64 * 256 + nt * 64; s0 = b; s1 = b + 16; s2 = b + 32; s3 = b + 48; ld[q] = 256; ldd = 1024; \
          dst = (bf16_t*)(ws + O_ROUT) + (size_t)nt * 64 * 1024 + kt * 64; \
        } else if (it < J7) {    \
          const int r = it - J6; const int kt = r & 15, nt = r >> 4; \
          const float* g = pwsg + (size_t)kt * 64 * 256 + nt * 32; const float* u = pwsu + (size_t)kt * 64 * 256 + nt * 32; \
          s0 = g; s1 = u; s2 = g + 16; s3 = u + 16; ld[q] = 256; ldd = 1024; \
          dst = (bf16_t*)(ws + O_WSGU) + (size_t)nt * 64 * 1024 + kt * 64; \
        } else if (it < J8) {    \
          const int r = it - J7; const int kt = r & 3, nt = r >> 2; \
          const float* b = pwsd + (size_t)kt * 64 * 1024 + nt * 64; s0 = b; s1 = b + 16; s2 = b + 32; s3 = b + 48; ld[q] = 1024; ldd = 256; \
          dst = (bf16_t*)(ws + O_WSD) + (size_t)nt * 64 * 256 + kt * 64; \
        } else if (it < J9) {    \
          const int r = it - J8; const int e = r >> 7, qq = r & 127; const int kt = qq & 15, nt = qq >> 4; \
          const float* g = pwg + (size_t)e * 262144 + (size_t)kt * 64 * 256 + nt * 32; const float* u = pwu + (size_t)e * 262144 + (size_t)kt * 64 * 256 + nt * 32; \
          s0 = g; s1 = u; s2 = g + 16; s3 = u + 16; ld[q] = 256; ldd = 1024; \
          dst = (bf16_t*)(ws + O_WGU) + (size_t)e * 524288 + (size_t)nt * 64 * 1024 + kt * 64; \
        } else {                 \
          const int r = it - J9; const int e = r >> 6, qq = r & 63; const int kt = qq & 3, nt = qq >> 2; \
          const float* b = pwdn + (size_t)e * 262144 + (size_t)kt * 64 * 1024 + nt * 64; s0 = b; s1 = b + 16; s2 = b + 32; s3 = b + 48; ld[q] = 1024; ldd = 256; \
          dst = (bf16_t*)(ws + O_WD) + (size_t)e * 262144 + (size_t)nt * 64 * 256 + kt * 64; \
        } \
        sp[q] = (sg == 0 ? s0 : sg == 1 ? s1 : sg == 2 ? s2 : s3) + (size_t)kr * ld[q] + 4 * (nc & 3); \
        dp[q] = dst + (size_t)tn * ldd + 8 * tkc; \
      } \
      _Pragma("unroll") \
      for (int q = 0; q < 4; ++q) { v0[q] = __builtin_nontemporal_load((const f32x4*)(sp[q])); v1[q] = __builtin_nontemporal_load((const f32x4*)(sp[q] + (size_t)32 * ld[q])); } } while (0)
    bf16_t* dpn[4]; f32x4 v0n[4], v1n[4];
    int it0 = bid * 4;
    if (it0 < J10) P0_DECODE_LOAD(it0, dpn, v0n, v1n);
    for (; it0 < J10; it0 += nb * 4) {
      bf16_t* dp[4]; f32x4 v0[4], v1[4];
#pragma unroll
      for (int q = 0; q < 4; ++q) { dp[q] = dpn[q]; v0[q] = v0n[q]; v1[q] = v1n[q]; }
      if (it0 + nb * 4 < J10) P0_DECODE_LOAD(it0 + nb * 4, dpn, v0n, v1n);
      asm volatile("s_waitcnt lgkmcnt(0)" ::: "memory"); __builtin_amdgcn_s_barrier(); asm volatile("" ::: "memory");
#pragma unroll
      for (int q = 0; q < 4; ++q) {
        float* t0 = tile + q * 4160 + kr * 65 + 4 * nc;
        float* t1 = t0 + 32 * 65;
        t0[0] = v0[q][0]; t0[1] = v0[q][1]; t0[2] = v0[q][2]; t0[3] = v0[q][3];
        t1[0] = v1[q][0]; t1[1] = v1[q][1]; t1[2] = v1[q][2]; t1[3] = v1[q][3];
      }
      asm volatile("s_waitcnt lgkmcnt(0)" ::: "memory"); __builtin_amdgcn_s_barrier(); asm volatile("" ::: "memory");
#pragma unroll
      for (int q = 0; q < 4; ++q) {
        float e[8];
#pragma unroll
        for (int j = 0; j < 8; ++j) e[j] = tile[q * 4160 + (8 * tkc + j) * 65 + tn];
        u32x4 o = {pk2(e[0], e[1]), pk2(e[2], e[3]), pk2(e[4], e[5]), pk2(e[6], e[7])};
        *(u32x4*)(dp[q]) = o;
      }
    }
#undef P0_DECODE_LOAD
  }
}

#define EPI_ROWS(u) const int row_ = (u).pm * 256 + 64 * wr + fr
struct EpiInProj {
  unsigned char* ws;
  DI void operator()(const f32x4 (&acc)[2][2][4][2], const pg::Unit& u, int wr, int wc, int fr, int fq) const {
    const int colt = u.pn * 256;
#pragma unroll
    for (int ai = 0; ai < 2; ++ai)
#pragma unroll
      for (int m = 0; m < 4; ++m) {
        const size_t row = (size_t)u.pm * 256 + 128 * ai + 64 * wr + 16 * m + fr;
#pragma unroll
        for (int bj = 0; bj < 2; ++bj)
#pragma unroll
          for (int n = 0; n < 2; ++n) {
            const int col = colt + 128 * bj + 32 * wc + 16 * n + 4 * fq;
            f32x4 v = acc[ai][bj][m][n];
            if (colt < 1536) { *(u32x2*)((bf16_t*)(ws + O_QKV) + row * 1536 + col) = pack4(v); }
            else if (colt < 2048) {
#pragma unroll
              for (int c = 0; c < 4; ++c) v[c] = siluf_(v[c]);
              *(u32x2*)((bf16_t*)(ws + O_ZS) + row * 512 + (col - 1536)) = pack4(v);
            } else if (colt < 3072) {
#pragma unroll
              for (int c = 0; c < 4; ++c) v[c] = geluf_(v[c]);
              *(u32x2*)((bf16_t*)(ws + O_UVG) + row * 1024 + (col - 2048)) = pack4(v);
            } else if (colt < 3584) {
#pragma unroll
              for (int c = 0; c < 4; ++c) v[c] *= 0.08838834764831845f;
              *(u32x2*)((bf16_t*)(ws + O_XQ) + row * 512 + (col - 3072)) = pack4(v);
            } else {
#pragma unroll
              for (int c = 0; c < 4; ++c) v[c] = sigmoidf_(v[c]);
              *(u32x2*)((bf16_t*)(ws + O_GATES) + row * 3072 + (col - 3584)) = pack4(v);
            }
          }
      }
  }
};
struct EpiMemKV {
  unsigned char* ws;
  DI void operator()(const f32x4 (&acc)[2][2][4][2], const pg::Unit& u, int wr, int wc, int fr, int fq) const {
#pragma unroll
    for (int ai = 0; ai < 2; ++ai)
#pragma unroll
      for (int m = 0; m < 4; ++m) {
        const int row = u.pm * 256 + 128 * ai + 64 * wr + 16 * m + fr; const int b = row >> 8, key = row & 255;
#pragma unroll
        for (int bj = 0; bj < 2; ++bj)
#pragma unroll
          for (int n = 0; n < 2; ++n) {
            const int col = u.pn * 256 + 128 * bj + 32 * wc + 16 * n + 4 * fq;
            const f32x4 v = acc[ai][bj][m][n];
            if (col < 512) { const int h = col >> 7, d = col & 127; *(u32x2*)((bf16_t*)(ws + O_MEMK) + ((size_t)((b * 4 + h) * 256 + key)) * 128 + d) = pack4(v); }
            else {
              const int c2 = col - 512; const int h = c2 >> 7, d = c2 & 127;
              const int pos = 32 * (key >> 5) + 8 * ((key >> 2) & 3) + 4 * ((key >> 4) & 1) + (key & 3);
              bf16_t* vt = (bf16_t*)(ws + O_MEMVT) + ((size_t)((b * 4 + h) * 128 + d)) * 256 + pos;
#pragma unroll
              for (int c = 0; c < 4; ++c) vt[(size_t)c * 256] = f2bf(v[c]);
            }
          }
      }
  }
};
struct P1Order {
  pg::DenseOrder D; const char* memb; const char* wmkv; int G, c;
  DI bool next(int i, pg::Unit& u) const {
    const long L = (long)i * G + c;
    if (L < D.nwg) { D.unit_of(L, u); u.e = 0; return true; }
    const int r = (int)(L - D.nwg); if (r >= 8) return false;
    u.pm = r & 1; u.pn = r >> 1; u.e = 1; u.rows = nullptr;
    u.a = memb + (size_t)u.pm * 524288; u.b = wmkv + (size_t)u.pn * 524288; return true;
  }
};
struct EpiP1 {
  EpiInProj a; EpiMemKV b;
  DI void operator()(const f32x4 (&acc)[2][2][4][2], const pg::Unit& u, int wr, int wc, int fr, int fq) const {
    asm volatile("" : "+v"(fr), "+v"(fq));
    if (u.e) b(acc, u, wr, wc, fr, fq); else a(acc, u, wr, wc, fr, fq);
  }
};
DI void phase1(const Params& p, unsigned char* smem, int bid, int nb) {
  unsigned char* ws = p.ws;
  PG_LAS unsigned char* lds = (PG_LAS unsigned char*)smem;
  __syncthreads();
  P1Order S; S.D.init(ws + O_XB, ws + O_WINT, T, NPROJ, 1024, nb, bid); S.memb = (const char*)(ws + O_MEMB); S.wmkv = (const char*)(ws + O_WMKV); S.G = nb; S.c = bid;
  EpiP1 E{EpiInProj{ws}, EpiMemKV{ws}};
  pg::gemm_phase<EpiP1, P1Order, false, true>(lds, 1024, S, E);
}

constexpr int G_KF = 0, G_VF = 32768, G_QB = 65536, G_KB = 81920, G_UT = 81920  , G_L = 98304, G_ATT = 114688, G_KDT = 122880, G_WT = 139264, G_SM = 155648;

DI void gdn_prep_item(const Params& p, unsigned char* smem_, int item) {
  unsigned char* smem; { LAS unsigned char* l_ = (LAS unsigned char*)smem_; asm volatile("" : "+v"(l_)); smem = (unsigned char*)l_; }
  int tid = threadIdx.x; asm volatile("" : "+v"(tid));
  const int lane = tid & 63, wave = tid >> 6, fr = lane & 15, fq = lane >> 4;
  unsigned char* ws; { GAS unsigned char* g_ = (GAS unsigned char*)p.ws; asm volatile("" : "+s"(g_)); ws = (unsigned char*)g_; }
  const int h = item & 3, cn = item >> 2;
  const int bidx = cn >> 7, n = cn & 127;
  const size_t t0 = (size_t)bidx * SEQ + (size_t)n * 64;
  float* kf = (float*)(smem + G_KF); float* vf = (float*)(smem + G_VF); float* Lm = (float*)(smem + G_L);
  float* sbeta = (float*)(smem + G_SM); float* sgc = sbeta + 64; float* segc = sbeta + 128;
  __syncthreads();
  {
    const bf16_t* qkv = (const bf16_t*)(ws + O_QKV);
    const float* cw = p.in[I_CONVW];
    const int tl0 = wave * 8;
#pragma unroll
    for (int sect = 0; sect < 3; ++sect) {
      const int cb = sect * 512 + h * 128 + 2 * lane;
      float w0[4], w1[4];
#pragma unroll
      for (int i = 0; i < 4; ++i) { w0[i] = cw[i * 1536 + cb]; w1[i] = cw[i * 1536 + cb + 1]; }
      float xa[11], xc[11];
#pragma unroll
      for (int r = 0; r < 11; ++r) {
        const int s = n * 64 + tl0 + r - 3;
        unsigned u = 0u;
        if (s >= 0) u = *(const unsigned*)(qkv + ((size_t)bidx * SEQ + s) * 1536 + cb);
        xa[r] = lo2f(u); xc[r] = hi2f(u);
      }
#pragma unroll
      for (int r = 0; r < 8; ++r) {
        float y0 = w0[0] * xa[r] + w0[1] * xa[r + 1] + w0[2] * xa[r + 2] + w0[3] * xa[r + 3];
        float y1 = w1[0] * xc[r] + w1[1] * xc[r + 1] + w1[2] * xc[r + 2] + w1[3] * xc[r + 3];
        y0 = siluf_(y0); y1 = siluf_(y1);
        const int tl = tl0 + r;
        if (sect == 2) { vf[tl * 128 + 2 * lane] = y0; vf[tl * 128 + 2 * lane + 1] = y1; }
        else {
          const float ss = wave_sum(y0 * y0 + y1 * y1);
          const float sc = rsqrtf(ss + 1e-6f) * (sect == 0 ? 0.08838834764831845f : 1.0f);
          y0 *= sc; y1 *= sc;
          const int off = sw256(tl, lane >> 2) + (lane & 3) * 4;
          if (sect == 0) *(unsigned*)(smem + G_QB + off) = pk2(y0, y1);
          else { *(unsigned*)(smem + G_KB + off) = pk2(y0, y1); kf[tl * 128 + 2 * lane] = y0; kf[tl * 128 + 2 * lane + 1] = y1; }
        }
      }
    }
    if (wave == 0) {
      const float* ab = (const float*)(ws + O_AB) + (t0 + lane) * 8;
      const float a = ab[h], bb = ab[4 + h];
      const float beta = sigmoidf_(bb);
      float g = -__expf(p.in[I_ALOG][h]) * softplusf_(a + p.in[I_DTB][h]);
#pragma unroll
      for (int o = 1; o < 64; o <<= 1) { const float y = __shfl_up(g, o); if (lane >= o) g += y; }
      sbeta[lane] = beta; sgc[lane] = g; segc[lane] = __expf(g);
      if (lane == 63) ((float*)(ws + O_GL))[item] = __expf(g);
    }
  }
  __syncthreads();
  {
#pragma unroll
    for (int q = 0; q < 4; ++q) {
      const int idx = wave * 4 + q; const int isq = idx >> 4, ti = (idx >> 2) & 3, tj = idx & 3;
      f32x4 acc = {0.f, 0.f, 0.f, 0.f};
      if (tj <= ti) {
#pragma unroll
        for (int ks = 0; ks < 4; ++ks) {
          const bf16x8 ai = ldfrag(smem + (isq ? G_QB : G_KB) + sw256(16 * ti + fr, 4 * ks + fq));
          const bf16x8 bj = ldfrag(smem + G_KB + sw256(16 * tj + fr, 4 * ks + fq));
          acc = isq ? mfma16(bj, ai, acc) : mfma16(ai, bj, acc);
        }
      }
      if (isq) {
        const int i = 16 * ti + fr, j0 = 16 * tj + 4 * fq;
        const float gi = sgc[i];
        f32x4 o;
#pragma unroll
        for (int r = 0; r < 4; ++r) { const int j = j0 + r; o[r] = (j <= i) ? acc[r] * __expf(gi - sgc[j]) : 0.f; }
        *(u32x2*)(smem + G_ATT + sw128(i, j0 >> 3) + (j0 & 7) * 2) = pack4(o);
      } else {
        const int j = 16 * tj + fr, i0 = 16 * ti + 4 * fq;
        const float gj = sgc[j];
        f32x4 o;
#pragma unroll
        for (int r = 0; r < 4; ++r) { const int i = i0 + r; o[r] = (j < i) ? acc[r] * __expf(sgc[i] - gj) * sbeta[i] : 0.f; }
        *(f32x4*)(Lm + j * 64 + i0) = o;
      }
    }
  }
  {
    const float gl_ = sgc[63];
    const int d = tid & 127, tg = tid >> 7;
#pragma unroll
    for (int c = 0; c < 2; ++c) {
      float e[8];
#pragma unroll
      for (int j = 0; j < 8; ++j) { const int t = 16 * tg + 8 * c + j; e[j] = kf[t * 128 + d] * __expf(gl_ - sgc[t]); }
      u32x4 o = {pk2(e[0], e[1]), pk2(e[2], e[3]), pk2(e[4], e[5]), pk2(e[6], e[7])};
      *(u32x4*)(smem + G_KDT + sw128(d, 2 * tg + c)) = o;
    }
  }
  __syncthreads();
  {
#pragma unroll
    for (int i = 0; i < 32; ++i) {
      const int e = tid + 512 * i; const int t = e >> 8, c = e & 255;
      float* xp = (c < 128) ? (vf + t * 128 + c) : (kf + t * 128 + (c - 128));
      float sc = sbeta[t]; if (c >= 128) sc *= segc[t];
      *xp *= sc;
    }
    __syncthreads();
    const int ct0 = 2 * wave;
    float* xt0 = (ct0 < 8) ? (vf + 16 * ct0) : (kf + 16 * (ct0 - 8));
    float* xt1 = xt0 + 16;
#pragma unroll
    for (int b = 0; b < 4; ++b) {
      if (b > 0) {
        f32x4 a0 = {0.f, 0.f, 0.f, 0.f}, a1 = {0.f, 0.f, 0.f, 0.f};
#pragma unroll
        for (int ks = 0; ks < 4 * b; ++ks) {
          const int k = 4 * ks + fq;
          const float av = Lm[k * 64 + 16 * b + fr];
          a0 = __builtin_amdgcn_mfma_f32_16x16x4f32(av, xt0[k * 128 + fr], a0, 0, 0, 0);
          a1 = __builtin_amdgcn_mfma_f32_16x16x4f32(av, xt1[k * 128 + fr], a1, 0, 0, 0);
        }
#pragma unroll
        for (int r = 0; r < 4; ++r) { xt0[(16 * b + 4 * fq + r) * 128 + fr] -= a0[r]; xt1[(16 * b + 4 * fq + r) * 128 + fr] -= a1[r]; }
        __syncthreads();
      }
      if (tid < 256) {
        const bool isw = tid >= 128;
        float* X = isw ? (kf + (tid - 128)) : (vf + tid);
        float xr[16];
#pragma unroll
        for (int r = 0; r < 16; ++r) xr[r] = X[(16 * b + r) * 128];
#pragma unroll
        for (int q = 0; q < 15; ++q) {
          const float* lt = Lm + (16 * b + q) * 64 + 16 * b;
          float l[16];
#pragma unroll
          for (int g4 = 0; g4 < 4; ++g4) if (4 * g4 + 3 > q) { const f32x4 t4 = *(const f32x4*)(lt + 4 * g4); l[4 * g4] = t4[0]; l[4 * g4 + 1] = t4[1]; l[4 * g4 + 2] = t4[2]; l[4 * g4 + 3] = t4[3]; }
#pragma unroll
          for (int r = q + 1; r < 16; ++r) xr[r] -= l[r] * xr[q];
        }
#pragma unroll
        for (int r = 0; r < 16; ++r) X[(16 * b + r) * 128] = xr[r];
        unsigned char* dstT = smem + (isw ? G_WT : G_UT);
        const int rowc = tid & 127;
        u32x4 o0 = {pk2(xr[0], xr[1]), pk2(xr[2], xr[3]), pk2(xr[4], xr[5]), pk2(xr[6], xr[7])};
        u32x4 o1 = {pk2(xr[8], xr[9]), pk2(xr[10], xr[11]), pk2(xr[12], xr[13]), pk2(xr[14], xr[15])};
        *(u32x4*)(dstT + sw128(rowc, 2 * b)) = o0;
        *(u32x4*)(dstT + sw128(rowc, 2 * b + 1)) = o1;
      }
      if (b < 3) __syncthreads();
    }
  }
  __syncthreads();
  {
    bf16x8 ak[2];
#pragma unroll
    for (int ks = 0; ks < 2; ++ks) ak[ks] = ldfrag(smem + G_KDT + sw128(16 * wave + fr, 4 * ks + fq));
    bf16_t* mp = (bf16_t*)(ws + O_MP) + (size_t)item * 16384;
    bf16_t* bc = (bf16_t*)(ws + O_BC) + (size_t)item * 16384;
#pragma unroll
    for (int tj = 0; tj < 8; ++tj) {
      f32x4 am = {0.f, 0.f, 0.f, 0.f}, ab_ = {0.f, 0.f, 0.f, 0.f};
#pragma unroll
      for (int ks = 0; ks < 2; ++ks) {
        const bf16x8 bw = ldfrag(smem + G_WT + sw128(16 * tj + fr, 4 * ks + fq));
        const bf16x8 bu = ldfrag(smem + G_UT + sw128(16 * tj + fr, 4 * ks + fq));
        am = mfma16(bw, ak[ks], am);
        ab_ = mfma16(ak[ks], bu, ab_);
      }
      f32x4 nm = {-am[0], -am[1], -am[2], -am[3]};
      *(u32x2*)(mp + ((size_t)((wave * 4 + (tj >> 1)) * 64 + lane)) * 8 + (tj & 1) * 4) = pack4(nm);
      *(u32x2*)(bc + ((size_t)((tj * 4 + (wave >> 1)) * 64 + lane)) * 8 + (wave & 1) * 4) = pack4(ab_);
    }
    const int tt = wave & 3, hf = wave >> 2;
    bf16x8 aa[2];
#pragma unroll
    for (int ks = 0; ks < 2; ++ks) aa[ks] = ldfrag(smem + G_ATT + sw128(16 * tt + fr, 4 * ks + fq));
    const int trow = 16 * tt + fr;
    const float eg = segc[trow];
    bf16_t* o0 = (bf16_t*)(ws + O_O0) + (t0 + trow) * 512 + h * 128;
    bf16_t* qp = (bf16_t*)(ws + O_QP) + (size_t)item * 8192 + trow * 128;
#pragma unroll
    for (int q = 0; q < 4; ++q) {
      const int te = hf * 4 + q;
      f32x4 ao = {0.f, 0.f, 0.f, 0.f}, aw = {0.f, 0.f, 0.f, 0.f};
#pragma unroll
      for (int ks = 0; ks < 2; ++ks) {
        const bf16x8 bu = ldfrag(smem + G_UT + sw128(16 * te + fr, 4 * ks + fq));
        const bf16x8 bw = ldfrag(smem + G_WT + sw128(16 * te + fr, 4 * ks + fq));
        ao = mfma16(bu, aa[ks], ao);
        aw = mfma16(bw, aa[ks], aw);
      }
      const int e0 = 16 * te + 4 * fq;
      *(u32x2*)(o0 + e0) = pack4(ao);
      const u32x2 qv = *(const u32x2*)(smem + G_QB + sw256(trow, e0 >> 3) + (e0 & 7) * 2);
      f32x4 qd = {lo2f(qv[0]) * eg - aw[0], hi2f(qv[0]) * eg - aw[1], lo2f(qv[1]) * eg - aw[2], hi2f(qv[1]) * eg - aw[3]};
      *(u32x2*)(qp + e0) = pack4(qd);
    }
  }
}

typedef short s16x4 __attribute__((ext_vector_type(4)));
DI bf16x8 tr_frag(const unsigned char* p0, const unsigned char* p1) {
  const s16x4 a = __builtin_amdgcn_ds_read_tr16_b64_v4i16((LAS s16x4*)p0), b = __builtin_amdgcn_ds_read_tr16_b64_v4i16((LAS s16x4*)p1);
  bf16x8 r; r[0] = a[0]; r[1] = a[1]; r[2] = a[2]; r[3] = a[3]; r[4] = b[0]; r[5] = b[1]; r[6] = b[2]; r[7] = b[3]; return r;
}
DI void sgu_item(const Params& p, unsigned char* smem_, int item) {
  unsigned char* smem; { LAS unsigned char* l_ = (LAS unsigned char*)smem_; asm volatile("" : "+v"(l_)); smem = (unsigned char*)l_; }
  int tid = threadIdx.x; asm volatile("" : "+v"(tid));
  const int lane = tid & 63, wave = __builtin_amdgcn_readfirstlane(tid >> 6), fr = lane & 15, fq = lane >> 4;
  unsigned char* ws; { GAS unsigned char* g_ = (GAS unsigned char*)p.ws; asm volatile("" : "+s"(g_)); ws = (unsigned char*)g_; }
  const int gp = item & 1, cn = item >> 1;
  const size_t t0 = (size_t)cn * 128;
  const bf16_t* uvg = (const bf16_t*)(ws + O_UVG);
  constexpr int VS = 544;
  __syncthreads();
  {
    const float* lng = p.in[I_SLNG]; const float* lnb = p.in[I_SLNB];
    float gg[8], bb[8];
#pragma unroll
    for (int e = 0; e < 8; ++e) { gg[e] = lng[8 * lane + e]; bb[e] = lnb[8 * lane + e]; }
#pragma unroll 2
    for (int jj = 0; jj < 16; ++jj) {
      const int j = 16 * wave + jj;
      const u32x4 raw = *(const u32x4*)(uvg + (t0 + j) * 1024 + 512 + 8 * lane);
      float v[8];
#pragma unroll
      for (int e = 0; e < 4; ++e) { v[2 * e] = lo2f(raw[e]); v[2 * e + 1] = hi2f(raw[e]); }
      float s = 0.f, q2 = 0.f;
#pragma unroll
      for (int e = 0; e < 8; ++e) { s += v[e]; q2 += v[e] * v[e]; }
      s = wave_sum(s); q2 = wave_sum(q2);
      const float mean = s * (1.f / 512.f);
      const float rstd = rsqrtf(fmaxf(q2 * (1.f / 512.f) - mean * mean, 0.f) + 1e-5f);
      if ((lane >> 5) == gp) {
        float y[8];
#pragma unroll
        for (int e = 0; e < 8; ++e) y[e] = (v[e] - mean) * rstd * gg[e] + bb[e];
        u32x4 o = {pk2(y[0], y[1]), pk2(y[2], y[3]), pk2(y[4], y[5]), pk2(y[6], y[7])};
        *(u32x4*)(smem + j * VS + (lane & 31) * 16) = o;
      }
    }
  }
  __syncthreads();
  {
    const int i = 16 * wave + fr;
    const int q = (lane & 15) >> 2, pp = lane & 3;
    const unsigned char* vb = smem + (8 * fq + q) * VS + 8 * pp;
#pragma unroll 1
    for (int gl = 0; gl < 2; ++gl) {
      const int g = 2 * gp + gl;
      const bf16_t* wg = (const bf16_t*)(ws + O_SGUW) + (size_t)g * 16384;
      bf16x8 af[4];
#pragma unroll
      for (int ks = 0; ks < 4; ++ks) af[ks] = ldfrag(wg + i * 128 + 32 * ks + 8 * fq);
      const float bias = p.in[I_SGUB][g * 128 + i];
      bf16_t* out = (bf16_t*)(ws + O_SGUO) + (t0 + i) * 512 + 128 * g;
      const bf16_t* urow = uvg + (t0 + i) * 1024 + 128 * g;
#pragma unroll
      for (int jt = 0; jt < 8; ++jt) {
        f32x4 acc = {0.f, 0.f, 0.f, 0.f};
#pragma unroll
        for (int ks = 0; ks < 4; ++ks) {
          const unsigned char* a0 = vb + ks * 32 * VS + (128 * gl + 16 * jt) * 2;
          acc = mfma16(tr_frag(a0, a0 + 4 * VS), af[ks], acc);
        }
        const int c0 = 16 * jt + 4 * fq;
        const u32x2 uu = *(const u32x2*)(urow + c0);
        f32x4 o = {lo2f(uu[0]) * (acc[0] + bias), hi2f(uu[0]) * (acc[1] + bias), lo2f(uu[1]) * (acc[2] + bias), hi2f(uu[1]) * (acc[3] + bias)};
        *(u32x2*)(out + c0) = pack4(o);
        if (jt & 1) __builtin_amdgcn_sched_barrier(0);
      }
    }
  }
}

DI void xattn_item(const Params& p, unsigned char* smem_, int item) {
  int tid = threadIdx.x; asm volatile("" : "+v"(tid));
  unsigned char* smem; { LAS unsigned char* l_ = (LAS unsigned char*)smem_; asm volatile("" : "+v"(l_)); smem = (unsigned char*)l_; }
  const int lane = tid & 63, wave = tid >> 6, fr = lane & 15, fq = lane >> 4;
  unsigned char* ws; { GAS unsigned char* g_ = (GAS unsigned char*)p.ws; asm volatile("" : "+s"(g_)); ws = (unsigned char*)g_; }
  const int bh = item & 7, qb = item >> 3;
  const int b = bh >> 2, h = bh & 3;
  const bf16_t* mk = (const bf16_t*)(ws + O_MEMK) + (size_t)bh * 32768;
  const bf16_t* mv = (const bf16_t*)(ws + O_MEMVT) + (size_t)bh * 32768;
  __syncthreads();
#pragma unroll 2
  for (int j = 0; j < 8; ++j) {
    const int c = tid + 512 * j;
    const int rk = c >> 4, ck = c & 15;
    *(u32x4*)(smem + sw256(rk, ck)) = *(const u32x4*)(mk + (size_t)c * 8);
    const int rv = c >> 5, cv = c & 31;
    *(u32x4*)(smem + 65536 + rv * 512 + ((cv ^ (rv & 15)) << 4)) = *(const u32x4*)(mv + (size_t)c * 8);
  }
  __syncthreads();
  const unsigned char* kbase[4]; const unsigned char* vbase[8];
#pragma unroll
  for (int ds = 0; ds < 4; ++ds) kbase[ds] = smem + fr * 256 + (((4 * ds + fq) ^ fr) << 4);
#pragma unroll
  for (int s = 0; s < 8; ++s) vbase[s] = smem + 65536 + fr * 512 + (((4 * s + fq) ^ fr) << 4);
#pragma unroll 1
  for (int half = 0; half < 2; ++half) {
    const size_t trow = (size_t)b * SEQ + (size_t)qb * 256 + half * 128 + 16 * wave + fr;
    const bf16_t* xq = (const bf16_t*)(ws + O_XQ) + trow * 512 + h * 128;
    bf16x8 qf[4];
#pragma unroll
    for (int ds = 0; ds < 4; ++ds) qf[ds] = ldfrag(xq + 32 * ds + 8 * fq);
    f32x4 sc[16];
#pragma unroll
    for (int kt = 0; kt < 16; ++kt) {
      f32x4 a = {0.f, 0.f, 0.f, 0.f};
#pragma unroll
      for (int ds = 0; ds < 4; ++ds) a = mfma16(ldfrag(kbase[ds] + kt * 4096), qf[ds], a);
      sc[kt] = a;
      if (kt & 1) __builtin_amdgcn_sched_barrier(0);
    }
    float m = -1e30f;
#pragma unroll
    for (int kt = 0; kt < 16; ++kt)
#pragma unroll
      for (int r = 0; r < 4; ++r) m = fmaxf(m, sc[kt][r]);
    m = fmaxf(m, __shfl_xor(m, 16)); m = fmaxf(m, __shfl_xor(m, 32));
    float l = 0.f;
#pragma unroll
    for (int kt = 0; kt < 16; ++kt)
#pragma unroll
      for (int r = 0; r < 4; ++r) { const float e = __expf(sc[kt][r] - m); sc[kt][r] = e; l += e; }
    l += __shfl_xor(l, 16); l += __shfl_xor(l, 32);
    const float inv = 1.f / l;
    bf16x8 pf[8];
#pragma unroll
    for (int s = 0; s < 8; ++s) pf[s] = pack8(sc[2 * s], sc[2 * s + 1]);
    bf16_t* out = (bf16_t*)(ws + O_XATO) + trow * 512 + h * 128;
#pragma unroll
    for (int dt = 0; dt < 8; ++dt) {
      f32x4 a = {0.f, 0.f, 0.f, 0.f};
#pragma unroll
      for (int s = 0; s < 8; ++s) a = mfma16(ldfrag(vbase[s] + dt * 8192), pf[s], a);
      __builtin_amdgcn_sched_barrier(0);
      f32x4 o = {a[0] * inv, a[1] * inv, a[2] * inv, a[3] * inv};
      *(u32x2*)(out + 16 * dt + 4 * fq) = pack4(o);
    }
  }
}

DI void phase2(const Params& p, unsigned char* smem, int bid, int nb) {
  for (int rep = 0; rep < ((DUPMASK >> 20) & 1) + 1; ++rep) {
    if (nb == 256) {
      const int bh = bid & 7, k = bid >> 3;
      for (int j = 0; j < 4; ++j) { const int n = 127 - (k + 32 * j); gdn_prep_item(p, smem, (((bh >> 2) * 128 + n) << 2) + (bh & 3)); }
    } else {
      for (int it = bid; it < 1024; it += nb) gdn_prep_item(p, smem, it);
    }
  }
  for (int rep = 0; rep < ((DUPMASK >> 21) & 1) + 1; ++rep) for (int it = bid; it < 256; it += nb) sgu_item(p, smem, it);
  for (int rep = 0; rep < ((DUPMASK >> 22) & 1) + 1; ++rep) for (int it = bid; it < 256; it += nb) xattn_item(p, smem, it);
}

DI void gdn_scan4(const Params& p, unsigned char* smem_, int bh, int es) {
  int tid = threadIdx.x; asm volatile("" : "+v"(tid));
  unsigned char* smem; { LAS unsigned char* l_ = (LAS unsigned char*)smem_; asm volatile("" : "+v"(l_)); smem = (unsigned char*)l_; }
  const int lane = tid & 63, w = __builtin_amdgcn_readfirstlane(tid >> 6);
  if (w >= 4) {
    for (int n = 0; n < 128; ++n) __builtin_amdgcn_s_barrier();
    return;
  }
  unsigned char* ws = p.ws;
  const int b = bh >> 2, h = bh & 3;
  const int fr = lane & 15, fq = lane >> 4;
  const size_t item0 = (size_t)(b * 128) * 4 + h;
  constexpr size_t ISTR = 4 * 16384;
  const bf16_t* mp = (const bf16_t*)(ws + O_MP) + item0 * 16384 + (size_t)(2 * w) * 2048 + lane * 8;
  const bf16_t* bc = (const bf16_t*)(ws + O_BC) + item0 * 16384 + (size_t)es * 2048 + (size_t)w * 512 + lane * 8;
  bf16_t* st = (bf16_t*)(ws + O_ST) + item0 * 16384 + (size_t)(16 * es + fr) * 128 + 32 * w + 4 * fq;
  const float* glp = (const float*)(ws + O_GL) + item0;
  { GAS const float* g_ = (GAS const float*)glp; asm volatile("" : "+v"(g_)); glp = (const float*)g_; }
  f32x4 acc0 = {0.f, 0.f, 0.f, 0.f}, acc1 = {0.f, 0.f, 0.f, 0.f};
  constexpr int PD = 4;
  bf16x8 A[PD][8]; u32x4 C[PD]; float G[PD];
#pragma unroll
  for (int d = 0; d < PD; ++d) {
#pragma unroll
    for (int i = 0; i < 8; ++i) A[d][i] = ldfrag(mp + (size_t)d * ISTR + i * 512);
    C[d] = *(const u32x4*)(bc + (size_t)d * ISTR);
    G[d] = glp[d * 4];
  }
  unsigned char* xch = smem;
  for (int n0 = 0; n0 < 128; n0 += PD) {
#pragma unroll
    for (int d = 0; d < PD; ++d) {
      const int n = n0 + d;
      const int np = (n + PD < 128) ? n + PD : n;
      const u32x2 lo = pack4(acc0), hi = pack4(acc1);
      bf16_t* stn = st + (size_t)n * ISTR;
      *(u32x2*)(stn) = lo; *(u32x2*)(stn + 16) = hi;
      const u32x4 mine = {lo[0], lo[1], hi[0], hi[1]};
      *(u32x4*)(xch + ((n & 1) * 4 + w) * 1024 + lane * 16) = mine;
      asm volatile("s_waitcnt lgkmcnt(0)" ::: "memory");
      __builtin_amdgcn_s_barrier();
      asm volatile("" ::: "memory");
      bf16x8 bfr[4];
#pragma unroll
      for (int s = 0; s < 4; ++s) bfr[s] = ldfrag(xch + ((n & 1) * 4 + s) * 1024 + lane * 16);
      const float g = G[d];
      f32x4 a0 = {g * acc0[0] + lo2f(C[d][0]), g * acc0[1] + hi2f(C[d][0]), g * acc0[2] + lo2f(C[d][1]), g * acc0[3] + hi2f(C[d][1])};
      f32x4 a1 = {g * acc1[0] + lo2f(C[d][2]), g * acc1[1] + hi2f(C[d][2]), g * acc1[2] + lo2f(C[d][3]), g * acc1[3] + hi2f(C[d][3])};
#pragma unroll
      for (int s = 0; s < 4; ++s) { a0 = mfma16(A[d][s], bfr[s], a0); a1 = mfma16(A[d][4 + s], bfr[s], a1); }
      acc0 = a0; acc1 = a1;
#pragma unroll
      for (int i = 0; i < 8; ++i) A[d][i] = ldfrag(mp + (size_t)np * ISTR + i * 512);
      C[d] = *(const u32x4*)(bc + (size_t)np * ISTR);
      G[d] = glp[(size_t)np * 4];
    }
  }
}

struct EpiGate {
  const bf16_t* gates; int goff; const bf16_t* src; bf16_t* dst;
  DI void operator()(const f32x4 (&acc)[2][2][4][2], const pg::Unit& u, int wr, int wc, int fr, int fq) const {
#pragma unroll
    for (int ai = 0; ai < 2; ++ai)
#pragma unroll
      for (int m = 0; m < 4; ++m) {
        const size_t row = (size_t)u.pm * 256 + 128 * ai + 64 * wr + 16 * m + fr;
#pragma unroll
        for (int bj = 0; bj < 2; ++bj)
#pragma unroll
          for (int n = 0; n < 2; ++n) {
            const int col = u.pn * 256 + 128 * bj + 32 * wc + 16 * n + 4 * fq;
            const f32x4 v = acc[ai][bj][m][n];
            const u32x2 g = *(const u32x2*)(gates + row * 3072 + goff + col);
            f32x4 o = {lo2f(g[0]) * v[0], hi2f(g[0]) * v[1], lo2f(g[1]) * v[2], hi2f(g[1]) * v[3]};
            if (src) { const u32x2 s = *(const u32x2*)(src + row * 1024 + col); o[0] += lo2f(s[0]); o[1] += hi2f(s[0]); o[2] += lo2f(s[1]); o[3] += hi2f(s[1]); }
            *(u32x2*)(dst + row * 1024 + col) = pack4(o);
          }
      }
  }
};
DI void phase3(const Params& p, unsigned char* smem, int bid, int nb) {
  unsigned char* ws = p.ws;
  if (bid < 64) {
    __syncthreads();
    gdn_scan4(p, smem, bid & 7, bid >> 3);
  } else {
    PG_LAS unsigned char* lds = (PG_LAS unsigned char*)smem;
    const bf16_t* gates = (const bf16_t*)(ws + O_GATES);
    bf16_t* part = (bf16_t*)(ws + O_PART);
    __syncthreads();
    { pg::DenseOrder S; S.init(ws + O_SGUO, ws + O_WBT, T, 1024, 512, nb - 64, bid - 64); EpiGate E{gates, 1024, nullptr, part}; pg::gemm_phase<EpiGate, pg::DenseOrder, false, true>(lds, 512, S, E); }
    asm volatile("s_waitcnt vmcnt(0)" ::: "memory");
    __builtin_amdgcn_fence(__ATOMIC_ACQUIRE, "agent");
    asm volatile("s_waitcnt vmcnt(0)" ::: "memory");
    __syncthreads();
    { pg::DenseOrder S; S.init(ws + O_XATO, ws + O_WCT, T, 1024, 512, nb - 64, bid - 64); EpiGate E{gates, 2048, part, part}; pg::gemm_phase<EpiGate, pg::DenseOrder, false, true>(lds, 512, S, E); }
  }
}

DI void phase4(const Params& p, int bid, int nb) {
  int tid = threadIdx.x; asm volatile("" : "+v"(tid));
  const int lane = tid & 63, wave = tid >> 6, fr = lane & 15, fq = lane >> 4;
  unsigned char* ws = p.ws;
  for (int it = bid; it < 512; it += nb) {
    const int item = it * 2 + (wave >> 2), tt = wave & 3;
    const int h = item & 3, cn = item >> 2;
    const size_t trow = (size_t)cn * 64 + 16 * tt + fr;
    const bf16_t* qp = (const bf16_t*)(ws + O_QP) + (size_t)item * 8192 + (16 * tt + fr) * 128;
    const bf16_t* st = (const bf16_t*)(ws + O_ST) + (size_t)item * 16384;
    const bf16_t* o0 = (const bf16_t*)(ws + O_O0) + trow * 512 + h * 128;
    bf16x8 af[4];
#pragma unroll
    for (int ks = 0; ks < 4; ++ks) af[ks] = ldfrag(qp + 32 * ks + 8 * fq);
    f32x4 acc[8];
    float ss = 0.f;
#pragma unroll
    for (int j = 0; j < 8; ++j) {
      const u32x2 o0v = *(const u32x2*)(o0 + 16 * j + 4 * fq);
      f32x4 a = {lo2f(o0v[0]), hi2f(o0v[0]), lo2f(o0v[1]), hi2f(o0v[1])};
#pragma unroll
      for (int ks = 0; ks < 4; ++ks) a = mfma16(ldfrag(st + (16 * j + fr) * 128 + 32 * ks + 8 * fq), af[ks], a);
      acc[j] = a;
      ss += a[0] * a[0] + a[1] * a[1] + a[2] * a[2] + a[3] * a[3];
    }
    ss += __shfl_xor(ss, 16); ss += __shfl_xor(ss, 32);
    const float rms = rsqrtf(ss * (1.f / 128.f) + 1e-6f);
    const float* ng = p.in[I_GNG];
    const bf16_t* zs = (const bf16_t*)(ws + O_ZS) + trow * 512 + h * 128;
    bf16_t* out = (bf16_t*)(ws + O_GDNO) + trow * 512 + h * 128;
#pragma unroll
    for (int j = 0; j < 8; ++j) {
      const int e0 = 16 * j + 4 * fq;
      const f32x4 g = *(const f32x4*)(ng + e0);
      const u32x2 z = *(const u32x2*)(zs + e0);
      f32x4 o = {acc[j][0] * rms * g[0] * lo2f(z[0]), acc[j][1] * rms * g[1] * hi2f(z[0]), acc[j][2] * rms * g[2] * lo2f(z[1]), acc[j][3] * rms * g[3] * hi2f(z[1])};
      *(u32x2*)(out + e0) = pack4(o);
    }
  }
}

DI void phase5(const Params& p, unsigned char* smem, int bid, int nb) {
  unsigned char* ws = p.ws;
  PG_LAS unsigned char* lds = (PG_LAS unsigned char*)smem;
  __syncthreads();
  pg::DenseOrder S; S.init(ws + O_GDNO, ws + O_WAT, T, 1024, 512, nb, bid);
  EpiGate E{(const bf16_t*)(ws + O_GATES), 0, (const bf16_t*)(ws + O_PART), (bf16_t*)(ws + O_MERGED)};
  pg::gemm_phase<EpiGate, pg::DenseOrder, false, true>(lds, 512, S, E);
}
struct EpiX1 {
  const float* x; bf16_t* x1;
  DI void operator()(const f32x4 (&acc)[2][2][4][2], const pg::Unit& u, int wr, int wc, int fr, int fq) const {
#pragma unroll
    for (int ai = 0; ai < 2; ++ai)
#pragma unroll
      for (int m = 0; m < 4; ++m) {
        const size_t row = (size_t)u.pm * 256 + 128 * ai + 64 * wr + 16 * m + fr;
#pragma unroll
        for (int bj = 0; bj < 2; ++bj)
#pragma unroll
          for (int n = 0; n < 2; ++n) {
            const int col = u.pn * 256 + 128 * bj + 32 * wc + 16 * n + 4 * fq;
            const f32x4 v = acc[ai][bj][m][n];
            const f32x4 xv = *(const f32x4*)(x + row * 1024 + col);
            f32x4 o = {ALPHA * xv[0] + v[0], ALPHA * xv[1] + v[1], ALPHA * xv[2] + v[2], ALPHA * xv[3] + v[3]};
            *(u32x2*)(x1 + row * 1024 + col) = pack4(o);
          }
      }
  }
};
DI void phase6(const Params& p, unsigned char* smem, int bid, int nb) {
  unsigned char* ws = p.ws;
  PG_LAS unsigned char* lds = (PG_LAS unsigned char*)smem;
  __syncthreads();
  pg::DenseOrder S; S.init(ws + O_MERGED, ws + O_WOT, T, 1024, 1024, nb, bid);
  EpiX1 E{p.in[I_X], (bf16_t*)(ws + O_X1)};
  pg::gemm_phase<EpiX1, pg::DenseOrder, false, false>(lds, 1024, S, E);
}

DI void ln_row(const float* src, const float* g, const float* b, float (&v)[16], int lane) {
  float s = 0.f;
#pragma unroll
  for (int i = 0; i < 16; ++i) s += v[i];
  const float mean = wave_sum(s) * (1.f / 1024.f);
  float q = 0.f;
#pragma unroll
  for (int i = 0; i < 16; ++i) { const float d = v[i] - mean; q += d * d; }
  const float rstd = rsqrtf(wave_sum(q) * (1.f / 1024.f) + 1e-5f);
#pragma unroll
  for (int i = 0; i < 4; ++i) {
    const int k = 256 * i + 4 * lane;
    const f32x4 gg = *(const f32x4*)(g + k), bb = *(const f32x4*)(b + k);
#pragma unroll
    for (int c = 0; c < 4; ++c) v[4 * i + c] = (v[4 * i + c] - mean) * rstd * gg[c] + bb[c];
  }
}
DI void phase7(const Params& p, int bid, int nb) {
  int tid = threadIdx.x; asm volatile("" : "+v"(tid));
  const int lane = tid & 63, wave = tid >> 6;
  unsigned char* ws = p.ws;
  for (int i = bid * NTHR + tid; i < MAXSLOT; i += nb * NTHR) { ((int*)(ws + O_SLOTTOK))[i] = 0; ((int*)(ws + O_SLOTAID))[i] = -1; }
  const bf16_t* x1 = (const bf16_t*)(ws + O_X1);
  bf16_t* x1b = (bf16_t*)(ws + O_X1B);
  for (int row = bid * 8 + wave; row < T; row += nb * 8) {
    float v[16];
#pragma unroll
    for (int i = 0; i < 4; ++i) { const u32x2 t = *(const u32x2*)(x1 + (size_t)row * D + 256 * i + 4 * lane); v[4 * i] = lo2f(t[0]); v[4 * i + 1] = hi2f(t[0]); v[4 * i + 2] = lo2f(t[1]); v[4 * i + 3] = hi2f(t[1]); }
    ln_row(nullptr, p.in[I_LN1G], p.in[I_LN1B], v, lane);
#pragma unroll
    for (int i = 0; i < 4; ++i) {
      const f32x4 o = {v[4 * i], v[4 * i + 1], v[4 * i + 2], v[4 * i + 3]};
      *(u32x2*)(x1b + (size_t)row * D + 256 * i + 4 * lane) = pack4(o);
    }
  }
}
struct EpiLogits {
  float* logits;
  DI void operator()(const f32x4 (&acc)[2][2][4][2], const pg::Unit& u, int wr, int wc, int fr, int fq) const {
#pragma unroll
    for (int ai = 0; ai < 2; ++ai)
#pragma unroll
      for (int m = 0; m < 4; ++m) {
        const size_t row = (size_t)u.pm * 256 + 128 * ai + 64 * wr + 16 * m + fr;
#pragma unroll
        for (int bj = 0; bj < 2; ++bj)
#pragma unroll
          for (int n = 0; n < 2; ++n) *(f32x4*)(logits + row * 256 + 128 * bj + 32 * wc + 16 * n + 4 * fq) = acc[ai][bj][m][n];
      }
  }
};
DI void phase8(const Params& p, unsigned char* smem, int bid, int nb);
DI void phase9(const Params& p, int bid, int nb) {
  int tid = threadIdx.x; asm volatile("" : "+v"(tid));
  const int lane = tid & 63, wave = tid >> 6;
  unsigned char* ws = p.ws;
  const float* logits = (const float*)(ws + O_LOGITS);
  int* counts = (int*)(ws + O_CTRL);
  const int g = lane & 7, tsub = lane >> 3;
  const float NEG = -__builtin_inff();
  float bias[32];
#pragma unroll
  for (int j4 = 0; j4 < 8; ++j4) { const f32x4 b4 = *(const f32x4*)(p.in[I_RB] + 32 * g + 4 * j4); bias[4 * j4] = b4[0]; bias[4 * j4 + 1] = b4[1]; bias[4 * j4 + 2] = b4[2]; bias[4 * j4 + 3] = b4[3]; }
  for (int tok0 = (bid * 8 + wave) * 8; tok0 < T; tok0 += nb * 64) {
    const int tok = tok0 + tsub;
    float sc[32], bz[32];
#pragma unroll
    for (int j4 = 0; j4 < 8; ++j4) {
      const f32x4 l4 = *(const f32x4*)(logits + (size_t)tok * 256 + 32 * g + 4 * j4);
#pragma unroll
      for (int c = 0; c < 4; ++c) { sc[4 * j4 + c] = sigmoidf_(l4[c]); bz[4 * j4 + c] = sc[4 * j4 + c] + bias[4 * j4 + c]; }
    }
    float m1 = NEG, m2 = NEG;
#pragma unroll
    for (int j = 0; j < 32; ++j) { const float v = bz[j]; if (v > m1) { m2 = m1; m1 = v; } else if (v > m2) m2 = v; }
    const float gs = m1 + m2;
    int rank = 0;
#pragma unroll
    for (int gg = 0; gg < 8; ++gg) { const float og = __shfl(gs, (lane & ~7) | gg); rank += ((og > gs) || (og == gs && gg < g)) ? 1 : 0; }
    if (rank >= 4) {
#pragma unroll
      for (int j = 0; j < 32; ++j) bz[j] = NEG;
    }
    int myidx = 0; float mysc = 0.f, ssum = 0.f;
#pragma unroll 1
    for (int k = 0; k < 8; ++k) {
      float bv = bz[0], bs = sc[0]; int bi = 0;
#pragma unroll
      for (int j = 1; j < 32; ++j) if (bz[j] > bv) { bv = bz[j]; bi = j; bs = sc[j]; }
      float rv = bv, rs = bs; int ri = 32 * g + bi;
#pragma unroll
      for (int o = 1; o < 8; o <<= 1) {
        const float ov = __shfl_xor(rv, o), os = __shfl_xor(rs, o); const int oi = __shfl_xor(ri, o);
        if (ov > rv || (ov == rv && oi < ri)) { rv = ov; ri = oi; rs = os; }
      }
      if ((ri >> 5) == g) {
        const int wj = ri & 31;
#pragma unroll
        for (int j = 0; j < 32; ++j) if (j == wj) bz[j] = NEG;
      }
      ssum += rs;
      if (g == k) { myidx = ri; mysc = rs; }
    }
    const int pos = atomicAdd(&counts[myidx * CSTR], 1);
    ((int*)(ws + O_TKIDX))[(size_t)tok * 8 + g] = myidx;
    ((float*)(ws + O_TKW))[(size_t)tok * 8 + g] = mysc / ssum * 2.5f;
    ((int*)(ws + O_TKPOS))[(size_t)tok * 8 + g] = pos;
  }
}
DI void build_tile_start(const Params& p, int* ts) {
  const int tid = threadIdx.x;
  const int* counts = (const int*)(p.ws + O_CTRL);
  __syncthreads();
  if (tid < 256) ts[300 + tid] = (counts[tid * CSTR] + MOE_BM - 1) / MOE_BM;
  __syncthreads();
  if (tid == 0) { int s = 0; for (int e = 0; e < 256; ++e) { ts[e] = s; s += ts[300 + e]; } ts[256] = s; }
  __syncthreads();
}
DI void phase10(const Params& p, unsigned char* smem, int bid, int nb) {
  int* ts = (int*)smem;
  build_tile_start(p, ts);
  unsigned char* ws = p.ws;
  const int* tkidx = (const int*)(ws + O_TKIDX); const int* tkpos = (const int*)(ws + O_TKPOS); const float* tkw = (const float*)(ws + O_TKW);
  int* slottok = (int*)(ws + O_SLOTTOK); float* slotw = (float*)(ws + O_SLOTW); int* slotaid = (int*)(ws + O_SLOTAID);
  for (int i = bid * NTHR + threadIdx.x; i < T * 8; i += nb * NTHR) {
    const int e = tkidx[i];
    const int slot = ts[e] * MOE_BM + tkpos[i];
    slottok[slot] = i >> 3; slotw[slot] = tkw[i]; slotaid[slot] = i;
  }
}

DI int find_expert(const int* ts, int ti) { int lo = 0, hi = 255; while (lo < hi) { const int mid = (lo + hi + 1) >> 1; if (ts[mid] <= ti) lo = mid; else hi = mid - 1; } return lo; }

struct MoeUpF {
  const int* ts; unsigned char* ws; const float* wg; const float* wu; const float* wsg; const float* wsu; int ntile, G, c;
  DI bool next(int i, UnitF& u) const {
    const int L = i * G + (((G & 7) == 0) ? (c & 7) * (G >> 3) + (c >> 3) : c);
    if (L >= ntile * 2) {
      const int r = L - ntile * 2; if (r >= 256 || !wsg) return false;
      const int pn = r >> 7, ti = r & 127;
      u.A = (const bf16_t*)(ws + O_X1B); u.rows = nullptr; u.m0 = ti * 128; u.pn = pn; u.e = 256;
      u.W0 = wsg + 128 * pn; u.W1 = wsu + 128 * pn;
      return true;
    }
    const int ti = L >> 1, pn = L & 1;
    const int e = find_expert(ts, ti);
    u.A = (const bf16_t*)(ws + O_X1B); u.rows = (const int*)(ws + O_SLOTTOK) + ti * MOE_BM; u.m0 = ti * MOE_BM; u.pn = pn; u.e = e;
    u.W0 = wg + (size_t)e * 262144 + 128 * pn; u.W1 = wu + (size_t)e * 262144 + 128 * pn;
    return true;
  }
};
struct MoeDownF {
  const int* ts; unsigned char* ws; const float* wd; const float* wsd; int ntile, G, c;
  DI bool next(int i, UnitF& u) const {
    const int L = i * G + (((G & 7) == 0) ? (c & 7) * (G >> 3) + (c >> 3) : c);
    if (L >= ntile * 4) {
      const int r = L - ntile * 4; if (r >= 512 || !wsd) return false;
      const int pn = r >> 7, ti = r & 127;
      u.A = (const bf16_t*)(ws + O_ACTSH); u.rows = nullptr; u.m0 = ti * 128; u.pn = pn; u.e = 256;
      u.W0 = wsd + 256 * pn; u.W1 = u.W0 + 128;
      return true;
    }
    const int ti = L >> 2, pn = L & 3;
    const int e = find_expert(ts, ti);
    u.A = (const bf16_t*)(ws + O_ACT); u.rows = nullptr; u.m0 = ti * MOE_BM; u.pn = pn; u.e = e;
    u.W0 = wd + (size_t)e * 262144 + 256 * pn; u.W1 = u.W0 + 128;
    return true;
  }
};
struct EpiActF {
  bf16_t* actp; bf16_t* actsh;
  struct Pre { int dummy; };
  DI void prefetch(const UnitF&, int, int, Pre& p) const { p.dummy = 0; }
  DI void operator()(const f32x4 (&acc)[4][4], const UnitF& u, int wr, int wc, int fr, int fq, const Pre&, unsigned char* xch) const {
    if (wc >= 2) {
#pragma unroll
      for (int m = 0; m < 4; ++m) {
        unsigned char* dst = xch + (64 * wr + 16 * m + fr) * 256 + (((8 * (wc & 1) + 2 * fq) ^ (2 * (fr & 7))) << 4);
        u32x4 o0 = {pk2(acc[m][0][0], acc[m][1][0]), pk2(acc[m][2][0], acc[m][3][0]), pk2(acc[m][0][1], acc[m][1][1]), pk2(acc[m][2][1], acc[m][3][1])};
        u32x4 o1 = {pk2(acc[m][0][2], acc[m][1][2]), pk2(acc[m][2][2], acc[m][3][2]), pk2(acc[m][0][3], acc[m][1][3]), pk2(acc[m][2][3], acc[m][3][3])};
        *(u32x4*)dst = o0; *(u32x4*)(dst + 16) = o1;
      }
    }
    asm volatile("s_waitcnt lgkmcnt(0)" ::: "memory"); __builtin_amdgcn_s_barrier(); asm volatile("" ::: "memory");
    if (wc < 2) {
#pragma unroll
      for (int m = 0; m < 4; ++m) {
        const unsigned char* srcp = xch + (64 * wr + 16 * m + fr) * 256 + (((8 * wc + 2 * fq) ^ (2 * (fr & 7))) << 4);
        const u32x4 u0 = *(const u32x4*)srcp, u1 = *(const u32x4*)(srcp + 16);
        const size_t row = (size_t)u.m0 + 64 * wr + 16 * m + fr;
        u32x4 o0, o1;
#pragma unroll
        for (int r = 0; r < 2; ++r) {
          o0[2 * r] = pk2(siluf_(acc[m][0][r]) * lo2f(u0[2 * r]), siluf_(acc[m][1][r]) * hi2f(u0[2 * r]));
          o0[2 * r + 1] = pk2(siluf_(acc[m][2][r]) * lo2f(u0[2 * r + 1]), siluf_(acc[m][3][r]) * hi2f(u0[2 * r + 1]));
          o1[2 * r] = pk2(siluf_(acc[m][0][2 + r]) * lo2f(u1[2 * r]), siluf_(acc[m][1][2 + r]) * hi2f(u1[2 * r]));
          o1[2 * r + 1] = pk2(siluf_(acc[m][2][2 + r]) * lo2f(u1[2 * r + 1]), siluf_(acc[m][3][2 + r]) * hi2f(u1[2 * r + 1]));
        }
        bf16_t* dst = (u.e == 256 ? actsh : actp) + row * 256 + 128 * u.pn + 64 * wc + 16 * fq;
        *(u32x4*)dst = o0; *(u32x4*)(dst + 8) = o1;
      }
    }
    asm volatile("s_waitcnt lgkmcnt(0)" ::: "memory"); __builtin_amdgcn_s_barrier(); asm volatile("" ::: "memory");
  }
};
struct EpiDownF {
  const int* slotaid; const float* slotw; unsigned char* ybase; bf16_t* ysh;
  struct Pre { int aid[4]; float ww[4]; };
  DI void prefetch(const UnitF& u, int wr, int fr, Pre& p) const {
    const unsigned slot0 = (unsigned)u.m0 + 64u * wr + fr;
    if (u.e == 256) {
#pragma unroll
      for (int m = 0; m < 4; ++m) { p.aid[m] = (int)(slot0 + 16u * m); p.ww[m] = 1.f; }
    } else {
#pragma unroll
      for (int m = 0; m < 4; ++m) { p.aid[m] = slotaid[slot0 + 16u * m]; p.ww[m] = slotw[slot0 + 16u * m]; }
    }
  }
  DI void operator()(const f32x4 (&acc)[4][4], const UnitF& u, int wr, int wc, int fr, int fq, const Pre& p, unsigned char*) const {
    const unsigned colb = (unsigned)u.pn * 256u + 64u * wc + 16u * fq;
    if (u.e == 256) {
#pragma unroll
      for (int m = 0; m < 4; ++m) {
        bf16_t* dst = ysh + (size_t)p.aid[m] * 1024 + colb;
        u32x4 o0 = {pk2(acc[m][0][0], acc[m][1][0]), pk2(acc[m][2][0], acc[m][3][0]), pk2(acc[m][0][1], acc[m][1][1]), pk2(acc[m][2][1], acc[m][3][1])};
        u32x4 o1 = {pk2(acc[m][0][2], acc[m][1][2]), pk2(acc[m][2][2], acc[m][3][2]), pk2(acc[m][0][3], acc[m][1][3]), pk2(acc[m][2][3], acc[m][3][3])};
        *(u32x4*)dst = o0; *(u32x4*)(dst + 8) = o1;
      }
      return;
    }
#pragma unroll
    for (int m = 0; m < 4; ++m) {
      if (p.aid[m] >= 0) {
        const unsigned off = (unsigned)p.aid[m] * 1024u + colb;
        const float sw = p.ww[m] * 64.0f;
        u32x4 o;
#pragma unroll
        for (int r = 0; r < 4; ++r) {
          unsigned w_ = 0u;
          w_ = __builtin_amdgcn_cvt_pk_fp8_f32(acc[m][0][r] * sw, acc[m][1][r] * sw, w_, false);
          w_ = __builtin_amdgcn_cvt_pk_fp8_f32(acc[m][2][r] * sw, acc[m][3][r] * sw, w_, true);
          o[r] = w_;
        }
        *(u32x4*)(ybase + (size_t)off) = o;
      }
    }
  }
};
struct EpiAct {
  bf16_t* actp;
  DI void operator()(const f32x4 (&acc)[2][2][4][2], const pg::Unit& u, int wr, int wc, int fr, int fq) const {
#pragma unroll
    for (int ai = 0; ai < 2; ++ai)
#pragma unroll
      for (int m = 0; m < 4; ++m) {
        const size_t row = (size_t)u.pm * 256 + 128 * ai + 64 * wr + 16 * m + fr;
#pragma unroll
        for (int bj = 0; bj < 2; ++bj) {
          const int blk = 8 * u.pn + 4 * bj + wc;
          const f32x4 g = acc[ai][bj][m][0], uu = acc[ai][bj][m][1];
          f32x4 o = {siluf_(g[0]) * uu[0], siluf_(g[1]) * uu[1], siluf_(g[2]) * uu[2], siluf_(g[3]) * uu[3]};
          *(u32x2*)(actp + row * 256 + blk * 16 + 4 * fq) = pack4(o);
        }
      }
  }
};
struct EpiBf16Out {
  bf16_t* dst;
  DI void operator()(const f32x4 (&acc)[2][2][4][2], const pg::Unit& u, int wr, int wc, int fr, int fq) const {
#pragma unroll
    for (int ai = 0; ai < 2; ++ai)
#pragma unroll
      for (int m = 0; m < 4; ++m) {
        const size_t row = (size_t)u.pm * 256 + 128 * ai + 64 * wr + 16 * m + fr;
#pragma unroll
        for (int bj = 0; bj < 2; ++bj)
#pragma unroll
          for (int n = 0; n < 2; ++n) *(u32x2*)(dst + row * 1024 + u.pn * 256 + 128 * bj + 32 * wc + 16 * n + 4 * fq) = pack4(acc[ai][bj][m][n]);
      }
  }
};
template <class Epi, class Sched>
DI void gemmF2_phase(unsigned char* smem_, const int K, const int lda, const int ldw, const Sched& S, const Epi& E) {
  int tid = threadIdx.x; asm volatile("" : "+v"(tid));
  unsigned char* smem; { LAS unsigned char* l_ = (LAS unsigned char*)smem_; asm volatile("" : "+v"(l_)); smem = (unsigned char*)l_; }
  const int lane = tid & 63, wid = __builtin_amdgcn_readfirstlane(tid >> 6), fr = lane & 15, fq = lane >> 4;
  const int nk = K >> 6;
#define F2_LBAR() do { asm volatile("s_waitcnt lgkmcnt(0)" ::: "memory"); __builtin_amdgcn_s_barrier(); asm volatile("" ::: "memory"); } while (0)
  UnitF cur, nxt; int ui = 0;
  if (!S.next(0, cur)) return;
  bool has_next = S.next(1, nxt);
  if (!has_next) nxt = cur;
  __syncthreads();
  if (wid >= 4) {
    const int lt = tid - 256;
    const int ar = lt >> 3, ac = lt & 7;
    const int q = lt & 63, kg = lt >> 6, half = q >> 5, g0 = 4 * (q & 31);
    int vrow[4];
#pragma unroll
    for (int i = 0; i < 4; ++i) vrow[i] = 64 * (q >> 4) + 16 * i + (q & 15);
    int aw[4];
#pragma unroll
    for (int j = 0; j < 4; ++j) aw[j] = sw128(ar + 32 * j, ac);
    unsigned r[4], nr[4];
#define F2_ROWS(u, rr) do { _Pragma("unroll") for (int j = 0; j < 4; ++j) rr[j] = (u).rows ? (unsigned)(u).rows[ar + 32 * j] : (unsigned)((u).m0 + ar + 32 * j); } while (0)
    F2_ROWS(cur, r);
    if (has_next) F2_ROWS(nxt, nr); else { _Pragma("unroll") for (int j = 0; j < 4; ++j) nr[j] = r[j]; }
#define F2_LOADX(kx, va, vw) do { const bool nx_ = (kx) >= nk; const int kk_ = nx_ ? (kx) - nk : (kx); \
      const bf16_t* A_ = nx_ ? nxt.A : cur.A; const float* W_ = half ? (nx_ ? nxt.W1 : cur.W1) : (nx_ ? nxt.W0 : cur.W0); \
      _Pragma("unroll") for (int j = 0; j < 4; ++j) { const unsigned rr_ = nx_ ? nr[j] : r[j]; va[j] = *(const u32x4*)((const unsigned char*)A_ + (size_t)(rr_ * (unsigned)(lda * 2) + (unsigned)(kk_ * 128 + ac * 16))); } \
      const float* wp_ = W_ + (size_t)(kk_ * 64 + 8 * kg) * ldw + g0; \
      _Pragma("unroll") for (int j = 0; j < 8; ++j) { vw[j] = *(const f32x4*)(wp_ + (size_t)j * ldw); vw[8 + j] = *(const f32x4*)(wp_ + (size_t)(32 + j) * ldw); } } while (0)
#define F2_STORE(st, va, vw) do { unsigned char* sa_ = smem + (st) * 49152; \
      _Pragma("unroll") for (int j = 0; j < 4; ++j) *(u32x4*)(sa_ + aw[j]) = va[j]; \
      _Pragma("unroll") for (int i = 0; i < 4; ++i) { \
        u32x4 o0_ = {pk2(vw[0][i], vw[1][i]), pk2(vw[2][i], vw[3][i]), pk2(vw[4][i], vw[5][i]), pk2(vw[6][i], vw[7][i])}; \
        u32x4 o1_ = {pk2(vw[8][i], vw[9][i]), pk2(vw[10][i], vw[11][i]), pk2(vw[12][i], vw[13][i]), pk2(vw[14][i], vw[15][i])}; \
        *(u32x4*)(sa_ + 16384 + sw128(vrow[i], kg)) = o0_; *(u32x4*)(sa_ + 16384 + sw128(vrow[i], 4 + kg)) = o1_; } } while (0)
    u32x4 xa[4], ya[4]; f32x4 xw[16], yw[16];
    F2_LOADX(0, xa, xw);
    F2_LOADX(1, ya, yw);
    F2_STORE(0, xa, xw);
    F2_LOADX(2, xa, xw);
    F2_LBAR();
    int st = 0;
    for (;;) {
#pragma unroll 1
      for (int kt = 0; kt < nk; kt += 2) {
        F2_STORE(st ^ 1, ya, yw);
        F2_LOADX(kt + 3, ya, yw);
        F2_LBAR();
        F2_STORE(st, xa, xw);
        F2_LOADX(kt + 4, xa, xw);
        F2_LBAR();
      }
#pragma unroll
      for (int eb = 0; eb < Epi::NBAR; ++eb) F2_LBAR();
      if (!has_next) break;
      cur = nxt; ++ui;
#pragma unroll
      for (int j = 0; j < 4; ++j) r[j] = nr[j];
      has_next = S.next(ui + 1, nxt);
      if (has_next) F2_ROWS(nxt, nr); else nxt = cur;
    }
    asm volatile("s_waitcnt vmcnt(0)" ::: "memory");
#undef F2_ROWS
#undef F2_LOADX
#undef F2_STORE
  } else {
    const int wr = wid >> 1, wc = wid & 1;
    f32x4 acc[4][8];
#pragma unroll
    for (int m = 0; m < 4; ++m)
#pragma unroll
      for (int n = 0; n < 8; ++n) acc[m][n] = (f32x4){0.f, 0.f, 0.f, 0.f};
#define F2_COMPUTE(st) do { const unsigned char* sA = smem + (st) * 49152; const unsigned char* sB = sA + 16384; \
      _Pragma("unroll") for (int ks = 0; ks < 2; ++ks) { bf16x8 af[4], bfr[8]; \
        _Pragma("unroll") for (int m = 0; m < 4; ++m) af[m] = ldfrag(sA + sw128(64 * wr + 16 * m + fr, 4 * ks + fq)); \
        _Pragma("unroll") for (int n = 0; n < 8; ++n) bfr[n] = ldfrag(sB + sw128(128 * wc + 16 * n + fr, 4 * ks + fq)); \
        _Pragma("unroll") for (int m = 0; m < 4; ++m) _Pragma("unroll") for (int n = 0; n < 8; ++n) acc[m][n] = mfma16(bfr[n], af[m], acc[m][n]); } } while (0)
    F2_LBAR();
    int st = 0;
    for (;;) {
      typename Epi::Pre pre; E.prefetch(cur, wr, fr, pre);
#pragma unroll 1
      for (int kt = 0; kt < nk; kt += 2) {
        F2_COMPUTE(st);
        F2_LBAR();
        F2_COMPUTE(st ^ 1);
        F2_LBAR();
      }
      E(acc, cur, wr, wc, fr, fq, pre, smem + (st ^ 1) * 49152);
#pragma unroll
      for (int m = 0; m < 4; ++m)
#pragma unroll
        for (int n = 0; n < 8; ++n) acc[m][n] = (f32x4){0.f, 0.f, 0.f, 0.f};
      if (!has_next) break;
      cur = nxt; ++ui;
      has_next = S.next(ui + 1, nxt);
      if (!has_next) nxt = cur;
    }
#undef F2_COMPUTE
  }
  __syncthreads();
#undef F2_LBAR
}
struct EpiActF2 {
  bf16_t* actp;
  static constexpr int NBAR = 2;
  struct Pre { int dummy; };
  DI void prefetch(const UnitF&, int, int, Pre& p) const { p.dummy = 0; }
  DI void operator()(const f32x4 (&acc)[4][8], const UnitF& u, int wr, int wc, int fr, int fq, const Pre&, unsigned char* xch) const {
    if (wc == 1) {
#pragma unroll
      for (int m = 0; m < 4; ++m)
#pragma unroll
        for (int g2 = 0; g2 < 2; ++g2) {
          unsigned char* dst = xch + (64 * wr + 16 * m + fr) * 256 + (((8 * g2 + 2 * fq) ^ (2 * (fr & 7))) << 4);
          const int n0 = 4 * g2;
          u32x4 o0 = {pk2(acc[m][n0][0], acc[m][n0 + 1][0]), pk2(acc[m][n0 + 2][0], acc[m][n0 + 3][0]), pk2(acc[m][n0][1], acc[m][n0 + 1][1]), pk2(acc[m][n0 + 2][1], acc[m][n0 + 3][1])};
          u32x4 o1 = {pk2(acc[m][n0][2], acc[m][n0 + 1][2]), pk2(acc[m][n0 + 2][2], acc[m][n0 + 3][2]), pk2(acc[m][n0][3], acc[m][n0 + 1][3]), pk2(acc[m][n0 + 2][3], acc[m][n0 + 3][3])};
          *(u32x4*)dst = o0; *(u32x4*)(dst + 16) = o1;
        }
    }
    asm volatile("s_waitcnt lgkmcnt(0)" ::: "memory"); __builtin_amdgcn_s_barrier(); asm volatile("" ::: "memory");
    if (wc == 0) {
#pragma unroll
      for (int m = 0; m < 4; ++m)
#pragma unroll
        for (int g2 = 0; g2 < 2; ++g2) {
          const unsigned char* srcp = xch + (64 * wr + 16 * m + fr) * 256 + (((8 * g2 + 2 * fq) ^ (2 * (fr & 7))) << 4);
          const u32x4 u0 = *(const u32x4*)srcp, u1 = *(const u32x4*)(srcp + 16);
          const size_t row = (size_t)u.m0 + 64 * wr + 16 * m + fr;
          const int n0 = 4 * g2;
          u32x4 o0, o1;
#pragma unroll
          for (int r = 0; r < 2; ++r) {
            o0[2 * r] = pk2(siluf_(acc[m][n0][r]) * lo2f(u0[2 * r]), siluf_(acc[m][n0 + 1][r]) * hi2f(u0[2 * r]));
            o0[2 * r + 1] = pk2(siluf_(acc[m][n0 + 2][r]) * lo2f(u0[2 * r + 1]), siluf_(acc[m][n0 + 3][r]) * hi2f(u0[2 * r + 1]));
            o1[2 * r] = pk2(siluf_(acc[m][n0][2 + r]) * lo2f(u1[2 * r]), siluf_(acc[m][n0 + 1][2 + r]) * hi2f(u1[2 * r]));
            o1[2 * r + 1] = pk2(siluf_(acc[m][n0 + 2][2 + r]) * lo2f(u1[2 * r + 1]), siluf_(acc[m][n0 + 3][2 + r]) * hi2f(u1[2 * r + 1]));
          }
          bf16_t* dst = actp + row * 256 + 128 * u.pn + 64 * g2 + 16 * fq;
          *(u32x4*)dst = o0; *(u32x4*)(dst + 8) = o1;
        }
    }
    asm volatile("s_waitcnt lgkmcnt(0)" ::: "memory"); __builtin_amdgcn_s_barrier(); asm volatile("" ::: "memory");
  }
};
struct EpiDownF2 {
  const int* slotaid; const float* slotw; unsigned char* ybase;
  static constexpr int NBAR = 0;
  struct Pre { int aid[4]; float ww[4]; };
  DI void prefetch(const UnitF& u, int wr, int fr, Pre& p) const {
    const unsigned slot0 = (unsigned)u.m0 + 64u * wr + fr;
#pragma unroll
    for (int m = 0; m < 4; ++m) { p.aid[m] = slotaid[slot0 + 16u * m]; p.ww[m] = slotw[slot0 + 16u * m]; }
  }
  DI void operator()(const f32x4 (&acc)[4][8], const UnitF& u, int wr, int wc, int fr, int fq, const Pre& p, unsigned char*) const {
#pragma unroll
    for (int m = 0; m < 4; ++m) {
      if (p.aid[m] >= 0) {
        const float sw = p.ww[m] * 64.0f;
#pragma unroll
        for (int g2 = 0; g2 < 2; ++g2) {
          const unsigned off = (unsigned)p.aid[m] * 1024u + (unsigned)u.pn * 256u + 128u * wc + 64u * g2 + 16u * fq;
          const int n0 = 4 * g2;
          u32x4 o;
#pragma unroll
          for (int r = 0; r < 4; ++r) {
            unsigned w_ = 0u;
            w_ = __builtin_amdgcn_cvt_pk_fp8_f32(acc[m][n0][r] * sw, acc[m][n0 + 1][r] * sw, w_, false);
            w_ = __builtin_amdgcn_cvt_pk_fp8_f32(acc[m][n0 + 2][r] * sw, acc[m][n0 + 3][r] * sw, w_, true);
            o[r] = w_;
          }
          *(u32x4*)(ybase + (size_t)off) = o;
        }
      }
    }
  }
};

template <class Epi, class Sched>
DI void gemmF3_phase(unsigned char* smem_, const int K, const int lda, const int ldw, const Sched& S, const Epi& E) {
  int tid = threadIdx.x; asm volatile("" : "+v"(tid));
  unsigned char* smem; { LAS unsigned char* l_ = (LAS unsigned char*)smem_; asm volatile("" : "+v"(l_)); smem = (unsigned char*)l_; }
  const int lane = tid & 63, wid = tid >> 6, wr = wid >> 1, wc = wid & 1, fr = lane & 15, fq = lane >> 4;
  const int nk = K >> 6;
  const int ar = tid >> 3, ac = tid & 7;
  const int q = tid & 63, half = q >> 5, g0 = 4 * (q & 31);
  int vrow[4];
#pragma unroll
  for (int i = 0; i < 4; ++i) vrow[i] = 64 * (q >> 4) + 16 * i + (q & 15);
  int aw[4];
#pragma unroll
  for (int j = 0; j < 4; ++j) aw[j] = sw128(ar + 64 * j, ac);
#define F3_LBAR() do { asm volatile("s_waitcnt lgkmcnt(0)" ::: "memory"); __builtin_amdgcn_s_barrier(); asm volatile("" ::: "memory"); } while (0)
#define F3_ROWS(u, rr) do { _Pragma("unroll") for (int j = 0; j < 4; ++j) rr[j] = (u).rows ? (unsigned)(u).rows[ar + 64 * j] : (unsigned)((u).m0 + ar + 64 * j); } while (0)
#define F3_LOADX(kx) do { const bool nx_ = (kx) >= nk; const int kk_ = nx_ ? (kx) - nk : (kx); \
    const bf16_t* A_ = nx_ ? nxt.A : cur.A; const float* W_ = half ? (nx_ ? nxt.W1 : cur.W1) : (nx_ ? nxt.W0 : cur.W0); \
    _Pragma("unroll") for (int j = 0; j < 4; ++j) { const unsigned rr_ = nx_ ? nr[j] : r[j]; va[j] = *(const u32x4*)((const unsigned char*)A_ + (size_t)(rr_ * (unsigned)(lda * 2) + (unsigned)(kk_ * 128 + ac * 16))); } \
    const float* wp_ = W_ + (size_t)(kk_ * 64 + 8 * wid) * ldw + g0; \
    _Pragma("unroll") for (int j = 0; j < 8; ++j) vw[j] = *(const f32x4*)(wp_ + (size_t)j * ldw); } while (0)
#define F3_STORE(st) do { unsigned char* sa_ = smem + (st) * 65536; \
    _Pragma("unroll") for (int j = 0; j < 4; ++j) *(u32x4*)(sa_ + aw[j]) = va[j]; \
    _Pragma("unroll") for (int i = 0; i < 4; ++i) { \
      u32x4 o_ = {pk2(vw[0][i], vw[1][i]), pk2(vw[2][i], vw[3][i]), pk2(vw[4][i], vw[5][i]), pk2(vw[6][i], vw[7][i])}; \
      *(u32x4*)(sa_ + 32768 + sw128(vrow[i], wid)) = o_; } } while (0)
#define F3_COMPUTE(st) do { const unsigned char* sA = smem + (st) * 65536; const unsigned char* sB = sA + 32768; \
    _Pragma("unroll") for (int ks = 0; ks < 2; ++ks) { bf16x8 af[4]; \
      _Pragma("unroll") for (int m = 0; m < 4; ++m) af[m] = ldfrag(sA + sw128(64 * wr + 16 * m + fr, 4 * ks + fq)); \
      _Pragma("unroll") for (int h2 = 0; h2 < 2; ++h2) { bf16x8 bfr[4]; \
        _Pragma("unroll") for (int n = 0; n < 4; ++n) bfr[n] = ldfrag(sB + sw128(128 * wc + 64 * h2 + 16 * n + fr, 4 * ks + fq)); \
        _Pragma("unroll") for (int m = 0; m < 4; ++m) _Pragma("unroll") for (int n = 0; n < 4; ++n) acc[m][4 * h2 + n] = mfma16(bfr[n], af[m], acc[m][4 * h2 + n]); } } } while (0)
  UnitF cur, nxt; int ui = 0;
  if (!S.next(0, cur)) return;
  unsigned r[4], nr[4];
  F3_ROWS(cur, r);
  bool has_next = S.next(1, nxt);
  if (has_next) F3_ROWS(nxt, nr); else { nxt = cur; _Pragma("unroll") for (int j = 0; j < 4; ++j) nr[j] = r[j]; }
  f32x4 acc[4][8];
#pragma unroll
  for (int m = 0; m < 4; ++m)
#pragma unroll
    for (int n = 0; n < 8; ++n) acc[m][n] = (f32x4){0.f, 0.f, 0.f, 0.f};
  u32x4 va[4]; f32x4 vw[8];
  F3_LOADX(0);
  __syncthreads();
  F3_STORE(0);
  F3_LBAR();
  int st = 0;
  for (;;) {
    typename Epi::Pre pre; E.prefetch(cur, wr, fr, pre);
#pragma unroll 1
    for (int kt = 0; kt < nk; ++kt) {
      F3_LOADX(kt + 1);
      F3_COMPUTE(st);
      F3_STORE(st ^ 1);
      F3_LBAR();
      st ^= 1;
    }
    E(acc, cur, wr, wc, fr, fq, pre, smem + (st ^ 1) * 65536);
#pragma unroll
    for (int m = 0; m < 4; ++m)
#pragma unroll
      for (int n = 0; n < 8; ++n) acc[m][n] = (f32x4){0.f, 0.f, 0.f, 0.f};
    if (!has_next) break;
    cur = nxt; ++ui;
#pragma unroll
    for (int j = 0; j < 4; ++j) r[j] = nr[j];
    has_next = S.next(ui + 1, nxt);
    if (has_next) F3_ROWS(nxt, nr); else nxt = cur;
  }
  asm volatile("s_waitcnt vmcnt(0)" ::: "memory");
  __syncthreads();
#undef F3_LBAR
#undef F3_ROWS
#undef F3_LOADX
#undef F3_STORE
#undef F3_COMPUTE
}

struct RouterF {
  unsigned char* ws; const float* rw; int G, c;
  DI bool next(int i, UnitF& u) const {
    const int L = i * G + c; if (L >= 128) return false;
    u.A = (const bf16_t*)(ws + O_X1B); u.rows = nullptr; u.m0 = L * 128; u.pn = 0; u.e = 0; u.W0 = rw; u.W1 = rw + 128; return true;
  }
};
struct EpiLogitsF {
  float* logits;
  struct Pre { int dummy; };
  DI void prefetch(const UnitF&, int, int, Pre& p) const { p.dummy = 0; }
  DI void operator()(const f32x4 (&acc)[4][4], const UnitF& u, int wr, int wc, int fr, int fq, const Pre&, unsigned char*) const {
#pragma unroll
    for (int m = 0; m < 4; ++m) {
      float* dst = logits + ((size_t)u.m0 + 64 * wr + 16 * m + fr) * 256 + 64 * wc + 16 * fq;
#pragma unroll
      for (int r = 0; r < 4; ++r) { const f32x4 o = {acc[m][0][r], acc[m][1][r], acc[m][2][r], acc[m][3][r]}; *(f32x4*)(dst + 4 * r) = o; }
    }
  }
};
struct P8Order {
  const char* x1b; const char* rout; const char* wsgu; int G, c;
  DI bool next(int i, pg::Unit& u) const {
    const int L = i * G + c; if (L >= 192) return false;
    u.rows = nullptr;
    if (L < 64) { u.pm = L; u.pn = 0; u.e = 0; u.a = x1b + (size_t)L * 524288; u.b = rout; }
    else { const int r = L - 64; u.pm = r >> 1; u.pn = r & 1; u.e = 1; u.a = x1b + (size_t)u.pm * 524288; u.b = wsgu + (size_t)u.pn * 524288; }
    return true;
  }
};
struct EpiP8 {
  EpiLogits a; EpiAct b;
  DI void operator()(const f32x4 (&acc)[2][2][4][2], const pg::Unit& u, int wr, int wc, int fr, int fq) const {
    asm volatile("" : "+v"(fr), "+v"(fq));
    if (u.e) b(acc, u, wr, wc, fr, fq); else a(acc, u, wr, wc, fr, fq);
  }
};
DI void phase8(const Params& p, unsigned char* smem, int bid, int nb) {
  unsigned char* ws = p.ws;
  PG_LAS unsigned char* lds = (PG_LAS unsigned char*)smem;
  __syncthreads();
  P8Order S{(const char*)(ws + O_X1B), (const char*)(ws + O_ROUT), (const char*)(ws + O_WSGU), nb, bid};
  EpiP8 E{EpiLogits{(float*)(ws + O_LOGITS)}, EpiAct{(bf16_t*)(ws + O_ACTSH)}};
  pg::gemm_phase<EpiP8, P8Order, false, false>(lds, 1024, S, E);
}
DI void phase11(const Params& p, unsigned char* smem, int bid, int nb) {
  unsigned char* ws = p.ws;
  int* ts = (int*)(smem + 131072);
  build_tile_start(p, ts);
  MoeUpF S{ts, ws, p.in[I_WG], p.in[I_WU], nullptr, nullptr, ts[256], nb, bid};
  EpiActF E{(bf16_t*)(ws + O_ACT), (bf16_t*)(ws + O_ACTSH)};
  { EpiActF2 E2x{(bf16_t*)(ws + O_ACT)}; gemmF3_phase<EpiActF2, MoeUpF>(smem, 1024, 1024, 256, S, E2x); }
}
DI void phase12(const Params& p, unsigned char* smem, int bid, int nb) {
  unsigned char* ws = p.ws;
  int* ts = (int*)(smem + 131072);
  build_tile_start(p, ts);
  MoeDownF S{ts, ws, p.in[I_WDN], nullptr, ts[256], nb, bid};
  EpiDownF E{(const int*)(ws + O_SLOTAID), (const float*)(ws + O_SLOTW), ws + O_Y, (bf16_t*)(ws + O_YSH)};
  { EpiDownF2 E2x{(const int*)(ws + O_SLOTAID), (const float*)(ws + O_SLOTW), ws + O_Y}; gemmF3_phase<EpiDownF2, MoeDownF>(smem, 256, 256, 1024, S, E2x); }
  __syncthreads();
  PG_LAS unsigned char* lds = (PG_LAS unsigned char*)smem;
  { pg::DenseOrder S2; S2.init(ws + O_ACTSH, ws + O_WSD, T, 1024, 256, nb, bid); EpiBf16Out E2{(bf16_t*)(ws + O_YSH)}; pg::gemm_phase<EpiBf16Out, pg::DenseOrder, false, true>(lds, 256, S2, E2); }
}
DI void phase13(const Params& p, int bid, int nb) {
  int tid = threadIdx.x; asm volatile("" : "+v"(tid));
  const int lane = tid & 63, wave = tid >> 6;
  unsigned char* ws = p.ws;
  const bf16_t* x1b = (const bf16_t*)(ws + O_X1B);
  const bf16_t* ysh = (const bf16_t*)(ws + O_YSH);
  const unsigned char* y8 = ws + O_Y;
  for (int row = bid * 8 + wave; row < T; row += nb * 8) {
    float v[16];
#pragma unroll
    for (int i = 0; i < 4; ++i) {
      const int k = 256 * i + 4 * lane;
      const u32x2 t = *(const u32x2*)(x1b + (size_t)row * D + k);
      const u32x2 s = *(const u32x2*)(ysh + (size_t)row * D + k);
      v[4 * i] = ALPHA * lo2f(t[0]) + lo2f(s[0]); v[4 * i + 1] = ALPHA * hi2f(t[0]) + hi2f(s[0]); v[4 * i + 2] = ALPHA * lo2f(t[1]) + lo2f(s[1]); v[4 * i + 3] = ALPHA * hi2f(t[1]) + hi2f(s[1]);
    }
    float rs[16];
#pragma unroll
    for (int i = 0; i < 16; ++i) rs[i] = 0.f;
#pragma unroll
    for (int k8 = 0; k8 < 8; ++k8) {
#pragma unroll
      for (int i = 0; i < 4; ++i) {
        const unsigned s = *(const unsigned*)(y8 + ((size_t)row * 8 + k8) * 1024 + 256 * i + 4 * lane);
        const f32x2_ lo = __builtin_amdgcn_cvt_pk_f32_fp8(s, false), hi = __builtin_amdgcn_cvt_pk_f32_fp8(s, true);
        rs[4 * i] += lo[0]; rs[4 * i + 1] += lo[1]; rs[4 * i + 2] += hi[0]; rs[4 * i + 3] += hi[1];
      }
    }
#pragma unroll
    for (int i = 0; i < 16; ++i) v[i] += rs[i] * (1.0f / 64.0f);
    ln_row(nullptr, p.in[I_LN2G], p.in[I_LN2B], v, lane);
#pragma unroll
    for (int i = 0; i < 4; ++i) { const f32x4 o = {v[4 * i], v[4 * i + 1], v[4 * i + 2], v[4 * i + 3]}; *(f32x4*)(p.out + (size_t)row * D + 256 * i + 4 * lane) = o; }
  }
}

DI void load_params(Params& lp, const unsigned char* smem) {
  const unsigned* t = (const unsigned*)(smem + PTAB_OFF);
#pragma unroll
  for (int i = 0; i < 28; ++i) lp.in[i] = (const float*)(GAS const float*)(((unsigned long long)(unsigned)__builtin_amdgcn_readfirstlane((int)t[2 * i + 1]) << 32) | (unsigned)__builtin_amdgcn_readfirstlane((int)t[2 * i]));
  lp.out = (float*)(GAS float*)(((unsigned long long)(unsigned)__builtin_amdgcn_readfirstlane((int)t[57]) << 32) | (unsigned)__builtin_amdgcn_readfirstlane((int)t[56]));
  lp.ws = (unsigned char*)(GAS unsigned char*)(((unsigned long long)(unsigned)__builtin_amdgcn_readfirstlane((int)t[59]) << 32) | (unsigned)__builtin_amdgcn_readfirstlane((int)t[58]));
}
__global__ void __launch_bounds__(NTHR) mega_kernel(Params pk) {
  extern __shared__ __attribute__((aligned(16))) unsigned char smem[];
  cg::grid_group grid = cg::this_grid();
  const int bid = blockIdx.x, nb = gridDim.x;
  volatile LAS unsigned* bst = (volatile LAS unsigned*)(smem + LDS_BYTES - 16);
  if (threadIdx.x < 4) bst[threadIdx.x] = 0u;
  if (threadIdx.x < 30) {
    const __attribute__((address_space(4))) unsigned long long* ka = (const __attribute__((address_space(4))) unsigned long long*)__builtin_amdgcn_kernarg_segment_ptr();
    ((unsigned long long*)(smem + PTAB_OFF))[threadIdx.x] = ka[threadIdx.x];
  }
  unsigned* barw = (unsigned*)(pk.ws + O_BAR);
  __syncthreads();
  XcdBarrier xb = xcd_barrier_post(barw, bst);
#define GSYNC() xcd_barrier(xb)
#define RUNP(k, call) do { { Params p; load_params(p, smem); call; } GSYNC(); if (DUPMASK & (1 << (k))) { { Params p; load_params(p, smem); call; } GSYNC(); } } while (0)
  { Params p; load_params(p, smem); phase0(p, smem, bid, nb); } grid.sync();
  RUNP(1, phase1(p, smem, bid, nb));
  RUNP(2, phase2(p, smem, bid, nb));
  RUNP(3, phase3(p, smem, bid, nb));
  RUNP(4, phase4(p, bid, nb));
  RUNP(5, phase5(p, smem, bid, nb));
  RUNP(6, phase6(p, smem, bid, nb));
  RUNP(14, phase7(p, bid, nb));
  if (DUPMASK & (1 << 7)) { { Params p; load_params(p, smem); phase6(p, smem, bid, nb); } GSYNC(); { Params p; load_params(p, smem); phase7(p, bid, nb); } GSYNC(); }
  RUNP(8, phase8(p, smem, bid, nb));
  RUNP(14, phase9(p, bid, nb));
  if (DUPMASK & (1 << 9)) { { Params p; load_params(p, smem); if (bid == 0 && threadIdx.x < 256) ((int*)(p.ws + O_CTRL))[threadIdx.x * CSTR] = 0; } GSYNC(); { Params p; load_params(p, smem); phase9(p, bid, nb); } GSYNC(); }
  RUNP(10, phase10(p, smem, bid, nb));
  RUNP(11, phase11(p, smem, bid, nb));
  RUNP(12, phase12(p, smem, bid, nb));
  { Params p; load_params(p, smem); phase13(p, bid, nb); }
  if (DUPMASK & (1 << 13)) { GSYNC(); Params p; load_params(p, smem); phase13(p, bid, nb); }
  if (DUPMASK & (1 << 15)) { for (int i = 0; i < 10; ++i) GSYNC(); }
}

extern "C" void kernel_launch(void* const* d_in, const int* in_sizes, int n_in, void* d_out, int out_size, void* d_ws, size_t ws_size, hipStream_t stream) {
  if (n_in != 28 || ws_size < WS_NEED) { fprintf(stderr, "kernel_launch: unexpected inputs (%d) or workspace (%zu < %zu)\n", n_in, ws_size, (size_t)WS_NEED); return; }
  static int grid_blocks = 0;
  if (!grid_blocks) {
    int dev = 0, cus = 0, per_cu = 0;
    (void)hipGetDevice(&dev);
    (void)hipDeviceGetAttribute(&cus, hipDeviceAttributeMultiprocessorCount, dev);
    (void)hipFuncSetAttribute((const void*)mega_kernel, hipFuncAttributeMaxDynamicSharedMemorySize, LDS_BYTES);
    (void)hipOccupancyMaxActiveBlocksPerMultiprocessor(&per_cu, (const void*)mega_kernel, NTHR, LDS_BYTES);
    if (per_cu < 1) per_cu = 1;
    if (per_cu > 1) per_cu = 1;
    grid_blocks = cus * per_cu;
    if (grid_blocks < 32) grid_blocks = 32;
  }
  Params p{};
  for (int i = 0; i < 28; ++i) p.in[i] = (const float*)d_in[i];
  p.out = (float*)d_out; p.ws = (unsigned char*)d_ws;
  (void)hipMemsetAsync((unsigned char*)d_ws + O_BAR, 0, 16384 + 256, stream);
  void* args[] = {&p};
  hipError_t e = hipLaunchCooperativeKernel((const void*)mega_kernel, dim3(grid_blocks), dim3(NTHR), args, LDS_BYTES, stream);
  if (e != hipSuccess) fprintf(stderr, "cooperative launch failed: %s (grid %d)\n", hipGetErrorString(e), grid_blocks);
}
```

```cpp
#include <hip/hip_runtime.h>
#include <hip/hip_cooperative_groups.h>
#include <stdint.h>
#include <stdio.h>
namespace cg = cooperative_groups;

#define DI __device__ __forceinline__
#define LAS __attribute__((address_space(3)))
#define GAS __attribute__((address_space(1)))
typedef unsigned short bf16_t;
typedef short bf16x8 __attribute__((ext_vector_type(8)));
typedef float f32x4 __attribute__((ext_vector_type(4)));
typedef unsigned u32x4 __attribute__((ext_vector_type(4)));
typedef unsigned u32x2 __attribute__((ext_vector_type(2)));

constexpr unsigned long long CODE_LEN_SAFE = 200000ull;
#ifndef SHADOW11
#define SHADOW11 0
#endif
#ifndef DUPMASK
#define DUPMASK 0
#endif
constexpr int NTHR = 512;
constexpr int T = 16384, SEQ = 8192, D = 1024;
constexpr int NPROJ = 6656;
constexpr int DIN = 6664;
constexpr int NEXP = 256, DEXP = 256;
constexpr int MOE_BM = 256;
constexpr int MAXSLOT = 131072 + 256 * MOE_BM;
constexpr float ALPHA = 1.189207115002721f;
constexpr int LDS_BYTES = 157696;

constexpr size_t MB = 1u << 20;
constexpr size_t O_WGU = 0;
constexpr size_t O_WD = 256 * MB;
constexpr size_t O_WSGU = 384 * MB;
constexpr size_t O_WSD = 385 * MB;
constexpr size_t O_ROUT = 385 * MB + 512 * 1024;
constexpr size_t O_CTRL = 386 * MB;
constexpr size_t O_BAR = 386 * MB + 128 * 1024;
constexpr int CSTR = 64;
constexpr size_t O_SUBBAR = 386 * MB + 128 * 1024 + 16384;
constexpr size_t O_IDENT = 386 * MB + 256 * 1024;
constexpr size_t O_X1 = 387 * MB;
constexpr size_t O_X1B = 451 * MB;
constexpr size_t O_X1Q = 419 * MB;
constexpr size_t R0 = 483 * MB;
constexpr size_t O_XB = R0 + 0;
constexpr size_t O_ST = R0 + 0;
constexpr size_t O_WINT = R0 + 32 * MB;
constexpr size_t O_WAT = R0 + 45 * MB;
constexpr size_t O_WBT = R0 + 46 * MB;
constexpr size_t O_WCT = R0 + 47 * MB;
constexpr size_t O_WOT = R0 + 48 * MB;
constexpr size_t O_WMKV = R0 + 50 * MB;
constexpr size_t O_MEMB = R0 + 52 * MB;
constexpr size_t O_SGUW = R0 + 53 * MB;
constexpr size_t O_AB = R0 + 53 * MB + 512 * 1024;
constexpr size_t O_MEMK = R0 + 54 * MB;
constexpr size_t O_MEMVT = R0 + 54 * MB + 512 * 1024;
constexpr size_t O_QKV = R0 + 55 * MB;
constexpr size_t O_PART = R0 + 55 * MB;
constexpr size_t O_ZS = R0 + 103 * MB;
constexpr size_t O_UVG = R0 + 119 * MB;
constexpr size_t O_MERGED = R0 + 119 * MB;
constexpr size_t O_XQ = R0 + 151 * MB;
constexpr size_t O_GATES = R0 + 167 * MB;
constexpr size_t O_MP = R0 + 263 * MB;
constexpr size_t O_BC = R0 + 295 * MB;
constexpr size_t O_O0 = R0 + 359 * MB;
constexpr size_t O_QP = R0 + 391 * MB;
constexpr size_t O_GL = R0 + 407 * MB;
constexpr size_t O_GDNO = R0 + 408 * MB;
constexpr size_t O_SGUO = R0 + 424 * MB;
constexpr size_t O_XATO = R0 + 440 * MB;
constexpr size_t O_LOGITS = R0 + 0;
constexpr size_t O_TKIDX = R0 + 16 * MB;
constexpr size_t O_TKW = R0 + 16 * MB + 512 * 1024;
constexpr size_t O_TKPOS = R0 + 17 * MB;
constexpr size_t O_LTOK = R0 + 350 * MB;
constexpr size_t O_LAID = R0 + 366 * MB;
constexpr size_t O_LW = R0 + 382 * MB;
constexpr size_t O_SLOTTOK = R0 + 18 * MB;
constexpr size_t O_SLOTW = R0 + 19 * MB;
constexpr size_t O_SLOTAID = R0 + 20 * MB;
constexpr size_t O_ACT = R0 + 21 * MB;
constexpr size_t O_ACTSH = R0 + 181 * MB;
constexpr size_t O_YSH = R0 + 189 * MB;
constexpr size_t O_Y = R0 + 221 * MB;
constexpr size_t WS_NEED = R0 + 477 * MB;

struct Params {
  const float* in[28];
  float* out;
  unsigned char* ws;
};
enum { I_X = 0, I_MEM, I_WIN, I_CONVW, I_ALOG, I_DTB, I_GNG, I_WA, I_SLNG, I_SLNB, I_SGUW, I_SGUB, I_WB, I_WMKV, I_WC, I_WO,
       I_LN1G, I_LN1B, I_RW, I_RB, I_WG, I_WU, I_WDN, I_WSG, I_WSU, I_WSD, I_LN2G, I_LN2B };

constexpr int CNT16_OFF = 156688 + 256;
constexpr int PTAB_OFF = 156688;
DI float bf2f(bf16_t h) { return __uint_as_float(((unsigned)h) << 16); }
DI bf16_t f2bf(float f) { unsigned u = __float_as_uint(f); u += 0x7fffu + ((u >> 16) & 1u); return (bf16_t)(u >> 16); }
typedef float f32x2_ __attribute__((ext_vector_type(2)));
typedef __bf16 bf16x2_ __attribute__((ext_vector_type(2)));
DI unsigned pk2(float lo, float hi) { f32x2_ v = {lo, hi}; return __builtin_bit_cast(unsigned, __builtin_convertvector(v, bf16x2_)); }
DI float lo2f(unsigned u) { return __uint_as_float(u << 16); }
DI float hi2f(unsigned u) { return __uint_as_float(u & 0xffff0000u); }
DI float sigmoidf_(float x) { return __builtin_amdgcn_rcpf(1.f + __builtin_amdgcn_exp2f(-1.4426950408889634f * x)); }
DI float siluf_(float x) { return x * sigmoidf_(x); }
DI float geluf_(float x) { return x * sigmoidf_(1.5957691216057308f * (x + 0.044715f * x * x * x)); }
DI float softplusf_(float x) { return fmaxf(x, 0.f) + log1pf(__expf(-fabsf(x))); }
DI float wave_sum(float v) {
#pragma unroll
  for (int o = 32; o; o >>= 1) v += __shfl_xor(v, o);
  return v;
}
DI f32x4 mfma16(bf16x8 a, bf16x8 b, f32x4 c) { return __builtin_amdgcn_mfma_f32_16x16x32_bf16(a, b, c, 0, 0, 0); }
DI bf16x8 ldfrag(const void* p) { return __builtin_bit_cast(bf16x8, *(const u32x4*)p); }
DI bf16x8 pack8(f32x4 a, f32x4 b) { u32x4 r = {pk2(a[0], a[1]), pk2(a[2], a[3]), pk2(b[0], b[1]), pk2(b[2], b[3])}; return __builtin_bit_cast(bf16x8, r); }
DI u32x2 pack4(f32x4 a) { u32x2 r = {pk2(a[0], a[1]), pk2(a[2], a[3])}; return r; }
DI int sw128(int row, int chunk) { return row * 128 + ((chunk ^ (row & 7)) << 4); }
DI int sw256(int row, int chunk) { return row * 256 + ((chunk ^ (row & 15)) << 4); }

namespace pg {
#define PG_LAS __attribute__((address_space(3)))
typedef int pg_v4i __attribute__((ext_vector_type(4)));
typedef int pg_v8i __attribute__((ext_vector_type(8)));
typedef long pg_v2l __attribute__((ext_vector_type(2)));
constexpr int BM = 256, BK = 64, HALF = 128, HTB = HALF * BK * 2, NXCD = 8, WGM = 8;
DI int lds_byte(int r, int c) { const int st = (r >> 4) * 2 + (c >> 5), rr = r & 15, cc = c & 31, ob = rr * 64 + cc * 2; return st * 1024 + (ob ^ (((ob >> 9) & 1) << 5)); }
DI void stage_rc(int b, int& R, int& C) { const int st = b / 1024, sb = b % 1024, swz = sb ^ (((sb >> 9) & 1) << 5); R = (st >> 1) * 16 + swz / 64; C = (st & 1) * 32 + (swz % 64) / 2; }

struct Unit { const char* a; const char* b; const int* rows; int pm, pn, e; };

struct DenseOrder {
  const char* A; const char* B; int nM, nN, nwg, G, c; size_t tstep;
  DI void init(const void* A_, const void* B_, int M, int N, int K, int G_, int c_) { A = (const char*)A_; B = (const char*)B_; nM = M / BM; nN = N / BM; nwg = nM * nN; G = G_; c = c_; tstep = (size_t)BM * K * 2; }
  DI bool next(int i, Unit& u) const { const long L = (long)i * G + c; if (L >= nwg) return false; unit_of(L, u); return true; }
  DI void unit_of(long L, Unit& u) const {
    int wgid = (int)L; { const int q = nwg / NXCD, r = nwg % NXCD, xcd = wgid % NXCD, off = wgid / NXCD; wgid = (xcd < r ? xcd * (q + 1) : r * (q + 1) + (xcd - r) * q) + off; }
    const int nig = WGM * nN, gid = wgid / nig, fm = gid * WGM, gsz = (nM - fm) < WGM ? (nM - fm) : WGM;
    u.pm = fm + ((wgid % nig) % gsz); u.pn = (wgid % nig) / gsz; u.e = 0; u.rows = nullptr;
    u.a = A + (size_t)u.pm * tstep; u.b = B + (size_t)u.pn * tstep;
  }
};

template <class Epi, class Sched, bool GATHER, bool ALIGN_EPI, bool F8 = false, bool KEEPACC = false>
DI void gemm_phase(PG_LAS unsigned char* lds, const int K, const Sched& S, const Epi& E) {
  int tid = threadIdx.x; asm volatile("" : "+v"(tid));
  const int wid = __builtin_amdgcn_readfirstlane(tid >> 6), lane = tid & 63, wr = wid >> 2, wc = wid & 3, fr = lane & 15, fq = lane >> 4;
  const int nt = K / BK;
  int Rr[2], Cc[2];
  unsigned voffB[2];
#pragma unroll
  for (int i = 0; i < 2; ++i) { stage_rc(tid * 16 + i * 8192, Rr[i], Cc[i]); voffB[i] = (unsigned)(Rr[i] * K + Cc[i]) * 2u; }
  const size_t kstep = (size_t)(BK * 2);
  const size_t hstep = (size_t)HALF * K * 2;
  const unsigned ldsw = (unsigned)wid * 1024u;
  const int aoff = lds_byte(wr * 64 + fr, fq * 8), boff = lds_byte(wc * 32 + fr, fq * 8);
#define PG_SA(b, h) (((b) * 2 + (h)) * HTB)
#define PG_SB(b, h) ((4 + (b) * 2 + (h)) * HTB)
#define PG_STAGE(bufoff, gbase, v0, v1) do { unsigned s0_ = (v0), s1_ = (v1); asm volatile("" : "+v"(s0_), "+v"(s1_));     \
    __builtin_amdgcn_global_load_lds((const unsigned*)((const char*)(gbase) + s0_), (PG_LAS unsigned*)(lds + (bufoff) + ldsw), 16, 0, 0); \
    __builtin_amdgcn_global_load_lds((const unsigned*)((const char*)(gbase) + s1_), (PG_LAS unsigned*)(lds + (bufoff) + ldsw + 8192), 16, 0, 0); } while (0)
#define PG_LDA(dst, b, h) do { if (F8) { _Pragma("unroll") for (int m = 0; m < 4; ++m) { const pg_v4i l0_ = *(const PG_LAS pg_v4i*)(lds + PG_SA(b, h) + aoff + m * 2048), l1_ = *(const PG_LAS pg_v4i*)(lds + PG_SA(b, h) + aoff + m * 2048 + 1024); dst##8[m] = __builtin_shufflevector(l0_, l1_, 0, 1, 2, 3, 4, 5, 6, 7); } } \
    else { _Pragma("unroll") for (int m = 0; m < 4; ++m) _Pragma("unroll") for (int k = 0; k < 2; ++k) dst[m][k] = *(const PG_LAS bf16x8*)(lds + PG_SA(b, h) + aoff + m * 2048 + k * 1024); } } while (0)
#define PG_LDB(dst, b, h) do { if (F8) { _Pragma("unroll") for (int n = 0; n < 2; ++n) { const pg_v4i l0_ = *(const PG_LAS pg_v4i*)(lds + PG_SB(b, h) + boff + n * 2048), l1_ = *(const PG_LAS pg_v4i*)(lds + PG_SB(b, h) + boff + n * 2048 + 1024); dst##8[n] = __builtin_shufflevector(l0_, l1_, 0, 1, 2, 3, 4, 5, 6, 7); } } \
    else { _Pragma("unroll") for (int n = 0; n < 2; ++n) _Pragma("unroll") for (int k = 0; k < 2; ++k) dst[n][k] = *(const PG_LAS bf16x8*)(lds + PG_SB(b, h) + boff + n * 2048 + k * 1024); } } while (0)
#define PG_MMA(ai, bj, At, Bt) do { __builtin_amdgcn_s_setprio(1); \
    if (F8) { _Pragma("unroll") for (int m = 0; m < 4; ++m) _Pragma("unroll") for (int n = 0; n < 2; ++n) { \
        acc[ai][bj][m][n] = __builtin_amdgcn_mfma_scale_f32_16x16x128_f8f6f4(Bt##8[n], At##8[m], acc[ai][bj][m][n], 0, 0, 0, 0, 0, 0); } } \
    else { _Pragma("unroll") for (int m = 0; m < 4; ++m) _Pragma("unroll") for (int n = 0; n < 2; ++n) _Pragma("unroll") for (int k = 0; k < 2; ++k) \
    acc[ai][bj][m][n] = __builtin_amdgcn_mfma_f32_16x16x32_bf16(Bt[n][k], At[m][k], acc[ai][bj][m][n], 0, 0, 0); } __builtin_amdgcn_s_setprio(0); } while (0)
#define PG_WAIT_V(n) asm volatile("s_waitcnt vmcnt(" #n ")" ::: "memory")
#define PG_WAIT_L(n) asm volatile("s_waitcnt lgkmcnt(" #n ")" ::: "memory")
#define PG_BAR __builtin_amdgcn_s_barrier()
#define PG_SCHED __builtin_amdgcn_sched_barrier(0)
#define PG_AOFFS(u, o00, o01, o10, o11) do { if (GATHER) { \
      o00 = (unsigned)(u).rows[Rr[0]] * (unsigned)(K * 2) + (unsigned)Cc[0] * 2u; o01 = (unsigned)(u).rows[Rr[1]] * (unsigned)(K * 2) + (unsigned)Cc[1] * 2u; \
      o10 = (unsigned)(u).rows[128 + Rr[0]] * (unsigned)(K * 2) + (unsigned)Cc[0] * 2u; o11 = (unsigned)(u).rows[128 + Rr[1]] * (unsigned)(K * 2) + (unsigned)Cc[1] * 2u; \
    } else { o00 = voffB[0]; o01 = voffB[1]; o10 = voffB[0]; o11 = voffB[1]; } } while (0)
#define PG_H1(base) ((base) + (GATHER ? (size_t)0 : hstep))
  Unit cur, nxt; int ui = 0;
  if (!S.next(0, cur)) return;
  f32x4 acc[2][2][4][2];
#pragma unroll
  for (int a = 0; a < 2; ++a)
#pragma unroll
    for (int b = 0; b < 2; ++b)
#pragma unroll
      for (int m = 0; m < 4; ++m)
#pragma unroll
        for (int n = 0; n < 2; ++n) acc[a][b][m][n] = (f32x4){0.f, 0.f, 0.f, 0.f};
  bf16x8 At[4][2], B0[2][2], B1[2][2];
  pg_v8i At8[4], B08[2], B18[2];
  const char* cA = cur.a; const char* cB = cur.b;
  unsigned c00, c01, c10, c11;
  PG_AOFFS(cur, c00, c01, c10, c11);
  const unsigned vb0 = voffB[0], vb1 = voffB[1];
  PG_STAGE(PG_SB(0, 0), cB, vb0, vb1); PG_STAGE(PG_SB(0, 1), cB + hstep, vb0, vb1); PG_STAGE(PG_SA(0, 0), cA, c00, c01); PG_STAGE(PG_SA(0, 1), PG_H1(cA), c10, c11);
  if (wr == 1) PG_BAR;
  PG_WAIT_V(2); PG_BAR;
  PG_STAGE(PG_SB(1, 0), cB + kstep, vb0, vb1); PG_STAGE(PG_SA(1, 0), cA + kstep, c00, c01); PG_STAGE(PG_SB(1, 1), cB + hstep + kstep, vb0, vb1);
  PG_WAIT_V(6); PG_BAR;
  for (;;) {
    const bool has_next = S.next(ui + 1, nxt);
    const char* nA = has_next ? nxt.a : cA; const char* nB = has_next ? nxt.b : cB;
    unsigned n00 = c00, n01 = c01, n10 = c10, n11 = c11;
    if (has_next) PG_AOFFS(nxt, n00, n01, n10, n11);
#pragma unroll 1
    for (int t = 0; t < nt; t += 2) {
      const bool last = (t == nt - 2);
      const char* a1 = cA + (size_t)(t + 1) * kstep;
      const char* a2 = last ? nA : cA + (size_t)(t + 2) * kstep; const char* b2 = last ? nB : cB + (size_t)(t + 2) * kstep;
      const char* a3 = a2 + kstep; const char* b3 = b2 + kstep;
      const unsigned o00 = last ? n00 : c00, o01 = last ? n01 : c01, o10 = last ? n10 : c10, o11 = last ? n11 : c11;
      PG_LDB(B0, 0, 0); PG_LDB(B1, 0, 1); PG_SCHED; PG_LDA(At, 0, 0); PG_STAGE(PG_SA(1, 1), PG_H1(a1), c10, c11);
      PG_WAIT_V(8); PG_WAIT_L(0); PG_BAR; PG_MMA(0, 0, At, B0); PG_MMA(0, 1, At, B1); PG_BAR; PG_SCHED;
      PG_LDA(At, 0, 1); PG_STAGE(PG_SB(0, 0), b2, vb0, vb1); PG_STAGE(PG_SB(0, 1), b2 + hstep, vb0, vb1); PG_STAGE(PG_SA(0, 0), a2, o00, o01);
      PG_WAIT_V(8); PG_WAIT_L(0); PG_BAR; PG_MMA(1, 0, At, B0); PG_MMA(1, 1, At, B1); PG_BAR; PG_SCHED;
      PG_LDB(B0, 1, 0); PG_LDB(B1, 1, 1); PG_SCHED; PG_LDA(At, 1, 0); PG_STAGE(PG_SA(0, 1), PG_H1(a2), o10, o11);
      PG_WAIT_V(8); PG_WAIT_L(0); PG_BAR; PG_MMA(0, 0, At, B0); PG_MMA(0, 1, At, B1); PG_BAR; PG_SCHED;
      PG_LDA(At, 1, 1); PG_STAGE(PG_SB(1, 0), b3, vb0, vb1); PG_STAGE(PG_SB(1, 1), b3 + hstep, vb0, vb1); PG_STAGE(PG_SA(1, 0), a3, o00, o01);
      PG_WAIT_V(8); PG_WAIT_L(0); PG_BAR; PG_MMA(1, 0, At, B0); PG_MMA(1, 1, At, B1); PG_BAR; PG_SCHED;
    }
    if constexpr (ALIGN_EPI) { if (wr == 0) PG_BAR; }
    E(acc, cur, wr, wc, fr, fq);
    if (!has_next) break;
    if (!KEEPACC || cur.e != 0) {
#pragma unroll
    for (int a = 0; a < 2; ++a)
#pragma unroll
      for (int b = 0; b < 2; ++b)
#pragma unroll
        for (int m = 0; m < 4; ++m)
#pragma unroll
          for (int n = 0; n < 2; ++n) acc[a][b][m][n] = (f32x4){0.f, 0.f, 0.f, 0.f};
    }
    cur = nxt; cA = nA; cB = nB; c00 = n00; c01 = n01; c10 = n10; c11 = n11; ++ui;
    if constexpr (ALIGN_EPI) { if (wr == 1) PG_BAR; }
  }
  PG_WAIT_V(0);
  if constexpr (!ALIGN_EPI) { if (wr == 0) PG_BAR; }
  PG_BAR;
#undef PG_SA
#undef PG_SB
#undef PG_STAGE
#undef PG_LDA
#undef PG_LDB
#undef PG_MMA
#undef PG_WAIT_V
#undef PG_WAIT_L
#undef PG_BAR
#undef PG_SCHED
#undef PG_AOFFS
#undef PG_H1
}
}


struct UnitF { const bf16_t* A; const int* rows; const float* W0; const float* W1; int m0, pn, e; int sbase, valid; };

template <bool AMUL, class Epi, class Sched, int ABL = 0>
DI void gemmF_phase(unsigned char* smem_, const int K, const int lda, const int ldw, const Sched& S, const Epi& E) {
  int tid = threadIdx.x; asm volatile("" : "+v"(tid));
  unsigned char* smem; { LAS unsigned char* l_ = (LAS unsigned char*)smem_; asm volatile("" : "+v"(l_)); smem = (unsigned char*)l_; }
  const int lane = tid & 63, wid = tid >> 6, wr = wid >> 2, wc = wid & 3, fr = lane & 15, fq = lane >> 4;
  const int nk = K >> 6;
  const int ar0 = tid >> 3, ac = tid & 7;
  const int q = tid & 63, half = q >> 5, g0 = 4 * (q & 31);
  int vrow[4];
#pragma unroll
  for (int i = 0; i < 4; ++i) vrow[i] = 64 * (q >> 4) + 16 * i + (q & 15);
  const int aw0 = sw128(ar0, ac), aw1 = sw128(ar0 + 64, ac);
#define F_ROWS(u, rr0, rr1) do { rr0 = (u).rows ? (size_t)(u).rows[ar0] : (size_t)((u).m0 + ar0); rr1 = (u).rows ? (size_t)(u).rows[ar0 + 64] : (size_t)((u).m0 + ar0 + 64); } while (0)
#define F_LOAD(A_, W0_, W1_, rr0_, rr1_, kk_, va0, va1, vb0, vb1, vw) do { \
    va0 = *(const u32x4*)((A_) + (rr0_) * lda + (kk_) * 64 + ac * 8); va1 = *(const u32x4*)((A_) + (rr1_) * lda + (kk_) * 64 + ac * 8); \
    if (AMUL) { vb0 = *(const u32x4*)((A_) + (rr0_) * lda + 256 + (kk_) * 64 + ac * 8); vb1 = *(const u32x4*)((A_) + (rr1_) * lda + 256 + (kk_) * 64 + ac * 8); } \
    const float* wp_ = (half ? (W1_) : (W0_)) + (size_t)((kk_) * 64 + 8 * wid) * ldw + g0; \
    if (ABL != 1) { _Pragma("unroll") for (int j = 0; j < 8; ++j) vw[j] = *(const f32x4*)(wp_ + (size_t)j * ldw); } } while (0)
#define F_LOADX(kx, va0, va1, vb0, vb1, vw) do { const bool nx_ = (kx) >= nk; const int kk2_ = nx_ ? (kx) - nk : (kx); \
    const bf16_t* A2_ = nx_ ? nxt.A : cur.A; const float* W02_ = nx_ ? nxt.W0 : cur.W0; const float* W12_ = nx_ ? nxt.W1 : cur.W1; \
    const size_t q0_ = nx_ ? nr0 : r0, q1_ = nx_ ? nr1 : r1; \
    F_LOAD(A2_, W02_, W12_, q0_, q1_, kk2_, va0, va1, vb0, vb1, vw); } while (0)
#define F_STORE(st, va0, va1, vb0, vb1, vw) do { unsigned char* sa_ = smem + (st) * 49152; \
    if (AMUL) { _Pragma("unroll") for (int e_ = 0; e_ < 4; ++e_) { va0[e_] = pk2(lo2f(va0[e_]) * lo2f(vb0[e_]), hi2f(va0[e_]) * hi2f(vb0[e_])); va1[e_] = pk2(lo2f(va1[e_]) * lo2f(vb1[e_]), hi2f(va1[e_]) * hi2f(vb1[e_])); } } \
    *(u32x4*)(sa_ + aw0) = va0; *(u32x4*)(sa_ + aw1) = va1; \
    if (ABL != 3) { _Pragma("unroll") for (int i = 0; i < 4; ++i) { \
      u32x4 o_ = {pk2(vw[0][i], vw[1][i]), pk2(vw[2][i], vw[3][i]), pk2(vw[4][i], vw[5][i]), pk2(vw[6][i], vw[7][i])}; \
      *(u32x4*)(sa_ + 16384 + sw128(vrow[i], wid)) = o_; } } else { _Pragma("unroll") for (int j = 0; j < 8; ++j) asm volatile("" :: "v"(vw[j])); } } while (0)
#define F_LBAR() do { asm volatile("s_waitcnt lgkmcnt(0)" ::: "memory"); __builtin_amdgcn_s_barrier(); asm volatile("" ::: "memory"); } while (0)
#define F_COMPUTE(st) do { const unsigned char* sA = smem + (st) * 49152; const unsigned char* sB = sA + 16384; \
    _Pragma("unroll") for (int ks = 0; ks < 2; ++ks) { bf16x8 af[4], bfr[4]; \
      _Pragma("unroll") for (int m = 0; m < 4; ++m) af[m] = ldfrag(sA + sw128(64 * wr + 16 * m + fr, 4 * ks + fq)); \
      _Pragma("unroll") for (int n = 0; n < 4; ++n) bfr[n] = ldfrag(sB + sw128(64 * wc + 16 * n + fr, 4 * ks + fq)); \
      if (ABL != 2) { _Pragma("unroll") for (int m = 0; m < 4; ++m) _Pragma("unroll") for (int n = 0; n < 4; ++n) acc[m][n] = mfma16(bfr[n], af[m], acc[m][n]); } \
      else { _Pragma("unroll") for (int m = 0; m < 4; ++m) _Pragma("unroll") for (int n = 0; n < 4; ++n) asm volatile("" :: "v"(af[m]), "v"(bfr[n])); } } } while (0)
  UnitF cur, nxt; int ui = 0;
  if (!S.next(0, cur)) return;
  size_t r0, r1, nr0, nr1;
  F_ROWS(cur, r0, r1);
  bool has_next = S.next(1, nxt);
  if (has_next) F_ROWS(nxt, nr0, nr1); else { nxt = cur; nr0 = r0; nr1 = r1; }
  f32x4 acc[4][4];
#pragma unroll
  for (int m = 0; m < 4; ++m)
#pragma unroll
    for (int n = 0; n < 4; ++n) acc[m][n] = (f32x4){0.f, 0.f, 0.f, 0.f};
  u32x4 xa0, xa1, ya0, ya1, xb0, xb1, yb0, yb1; f32x4 xw[8], yw[8];
  xb0 = xb1 = yb0 = yb1 = (u32x4){0u, 0u, 0u, 0u};
  if (ABL == 1) { _Pragma("unroll") for (int j = 0; j < 8; ++j) { xw[j] = (f32x4){0.f, 0.f, 0.f, 0.f}; yw[j] = xw[j]; } }
  F_LOAD(cur.A, cur.W0, cur.W1, r0, r1, 0, xa0, xa1, xb0, xb1, xw);
  F_LOAD(cur.A, cur.W0, cur.W1, r0, r1, 1, ya0, ya1, yb0, yb1, yw);
  __syncthreads();
  F_STORE(0, xa0, xa1, xb0, xb1, xw);
  F_LBAR();
  int st = 0;
  for (;;) {
    typename Epi::Pre pre; E.prefetch(cur, wr, fr, pre);
#pragma unroll 1
    for (int kt = 0; kt < nk; kt += 2) {
      F_LOADX(kt + 2, xa0, xa1, xb0, xb1, xw);
      F_COMPUTE(st);
      F_STORE(st ^ 1, ya0, ya1, yb0, yb1, yw);
      F_LBAR();
      F_LOADX(kt + 3, ya0, ya1, yb0, yb1, yw);
      F_COMPUTE(st ^ 1);
      F_STORE(st, xa0, xa1, xb0, xb1, xw);
      F_LBAR();
    }
    if (ABL != 4) E(acc, cur, wr, wc, fr, fq, pre, smem + (st ^ 1) * 49152); else { _Pragma("unroll") for (int m = 0; m < 4; ++m) _Pragma("unroll") for (int n = 0; n < 4; ++n) asm volatile("" :: "v"(acc[m][n])); }
#pragma unroll
    for (int m = 0; m < 4; ++m)
#pragma unroll
      for (int n = 0; n < 4; ++n) acc[m][n] = (f32x4){0.f, 0.f, 0.f, 0.f};
    if (!has_next) break;
    cur = nxt; r0 = nr0; r1 = nr1; ++ui;
    has_next = S.next(ui + 1, nxt);
    if (has_next) F_ROWS(nxt, nr0, nr1); else { nxt = cur; nr0 = r0; nr1 = r1; }
  }
  asm volatile("s_waitcnt vmcnt(0)" ::: "memory");
  __syncthreads();
#undef F_ROWS
#undef F_LOAD
#undef F_LOADX
#undef F_STORE
#undef F_LBAR
#undef F_COMPUTE
}

#define XB_TMO      128
#define XB_XCNT(j)  (256  + 64 * (j))
#define XB_XSUB(j)  (1280 + 64 * (j))
#define XB_XGEN(j)  (2304 + 64 * (j))
#define XB_TOP      3328
#define XB_TOPGEN   3392
#define XCD_BAR_WORDS 3456
#define XB_SPIN_CAP (1u << 22)
DI unsigned xb_ld(unsigned* p)              { return __hip_atomic_load(p, __ATOMIC_RELAXED, __HIP_MEMORY_SCOPE_AGENT); }
DI unsigned xb_add(unsigned* p, unsigned v) { return __hip_atomic_fetch_add(p, v, __ATOMIC_RELAXED, __HIP_MEMORY_SCOPE_AGENT); }
DI unsigned xb_xcc_id() { return (unsigned)__builtin_amdgcn_s_getreg((3 << 11) | 20) & 0xFu; }
#define XB_SPIN(cond, bar) do { unsigned _sp = 0; while (cond) { __builtin_amdgcn_s_sleep(1); \
    if ((++_sp & 255u) == 0u) { if (xb_ld(&(bar)[XB_TMO])) break; if (_sp > XB_SPIN_CAP) { atomicAdd(&(bar)[XB_TMO], 1u); break; } } } } while (0)
struct XcdBarrier { unsigned* bar; unsigned x; volatile LAS unsigned* st; };
DI XcdBarrier xcd_barrier_post(unsigned* bar, volatile LAS unsigned* st) {
  XcdBarrier b; b.bar = bar; b.x = xb_xcc_id(); b.st = st;
  if (threadIdx.x == 0) (void)xb_add(&bar[XB_XCNT(b.x)], 1u);
  return b;
}
DI void xcd_barrier_complete(unsigned* bar, unsigned x, unsigned& nloc, unsigned& nx) {
  const unsigned G = gridDim.x * gridDim.y * gridDim.z;
  unsigned sum, cnt, mine, sp = 0u;
  for (;;) {
    sum = 0u; cnt = 0u; mine = 0u;
#pragma unroll
    for (unsigned j = 0; j < 16; ++j) { const unsigned c = xb_ld(&bar[XB_XCNT(j)]); sum += c; cnt += (c > 0u) ? 1u : 0u; mine = (j == x) ? c : mine; }
    if (sum == G) break;
    __builtin_amdgcn_s_sleep(1);
    if ((++sp & 255u) == 0u) { if (xb_ld(&bar[XB_TMO])) break; if (sp > XB_SPIN_CAP) { atomicAdd(&bar[XB_TMO], 1u); break; } }
  }
  nloc = mine > 0u ? mine : 1u; nx = cnt > 0u ? cnt : 1u;
}
DI void xcd_barrier(const XcdBarrier& b) {
  asm volatile("s_waitcnt vmcnt(0)" ::: "memory");
  __syncthreads();
  if (threadIdx.x == 0) {
    unsigned* bar = b.bar;
    __builtin_amdgcn_s_waitcnt(0);
    unsigned nloc = b.st[0], nx = b.st[1];
    if (nloc == 0u) { xcd_barrier_complete(bar, b.x, nloc, nx); b.st[0] = nloc; b.st[1] = nx; }
    const unsigned old = xb_add(&bar[XB_XSUB(b.x)], 1u);
    const unsigned gen = old / nloc;
    if (old + 1u == (gen + 1u) * nloc) {
      __builtin_amdgcn_fence(__ATOMIC_RELEASE, "agent");
      asm volatile("s_waitcnt vmcnt(0)" ::: "memory");
      const unsigned og = xb_add(&bar[XB_TOP], 1u);
      const unsigned tg = og / nx;
      if (og + 1u == (tg + 1u) * nx) xb_add(&bar[XB_TOPGEN], 1u);
      else XB_SPIN(xb_ld(&bar[XB_TOPGEN]) == tg, bar);
      __builtin_amdgcn_fence(__ATOMIC_ACQUIRE, "agent");
      asm volatile("s_waitcnt vmcnt(0)" ::: "memory");
    } else {
      XB_SPIN(xb_ld(&bar[XB_TOPGEN]) == gen, bar);
      __builtin_amdgcn_fence(__ATOMIC_ACQUIRE, "agent");
      asm volatile("s_waitcnt vmcnt(0)" ::: "memory");
    }
  }
  __syncthreads();
}

template <int MODE>
DI void p0_transposes(const Params& p, unsigned char* smem, int wk, int nwk) {
  int tid = threadIdx.x; asm volatile("" : "+v"(tid));
  unsigned char* ws = p.ws;
  constexpr int NV = (MODE == 0) ? 1664 + 256 : 640 + 256;
  __syncthreads();
  {
    float* tile = (float*)smem;
    const float *pwin = p.in[I_WIN], *pwa = p.in[I_WA], *pwb = p.in[I_WB], *pwc = p.in[I_WC], *pwo = p.in[I_WO], *pwmkv = p.in[I_WMKV], *prw = p.in[I_RW],
                *pwsg = p.in[I_WSG], *pwsu = p.in[I_WSU], *pwsd = p.in[I_WSD], *pwg = p.in[I_WG], *pwu = p.in[I_WU], *pwdn = p.in[I_WDN];
    { GAS const float *a_ = (GAS const float*)pwa, *b_ = (GAS const float*)pwb, *c_ = (GAS const float*)pwc, *o_ = (GAS const float*)pwo, *m_ = (GAS const float*)pwmkv;
      asm volatile("" : "+s"(a_), "+s"(b_), "+s"(c_), "+s"(o_), "+s"(m_));
      pwa = (const float*)a_; pwb = (const float*)b_; pwc = (const float*)c_; pwo = (const float*)o_; pwmkv = (const float*)m_; }
    constexpr int J0 = 1664, J1 = J0 + 128, J2 = J1 + 128, J3 = J2 + 128, J4 = J3 + 256, J5 = J4 + 256, J6 = J5 + 64, J7 = J6 + 128, J8 = J7 + 64,
                  J9 = J8, J10 = J8;
    const int kr = tid >> 4, nc = tid & 15, sg = nc >> 2;
    const int tn = tid >> 3, tkc = tid & 7;
#define P0_DECODE_LOAD(it0, dp, v0, v1) do { const float* sp[4]; int ld[4]; \
      _Pragma("unroll") \
      for (int q = 0; q < 4; ++q) { \
        const int v_ = (it0 + q < NV) ? it0 + q : NV - 1; const int it = (MODE == 0) ? (v_ < J0 ? v_ : v_ - J0 + J4) : (v_ < J4 - J0 ? J0 + v_ : J5 + (v_ - (J4 - J0)));      \
        const float *s0, *s1, *s2, *s3; int ldd; bf16_t* dst; \
        if (it < J0) {           \
          const int kt = it & 15, nt = it >> 4; const int n0 = nt * 64; const int c0 = n0 + (n0 >= 2048 ? 8 : 0); \
          const float* b = pwin + (size_t)kt * 64 * DIN + c0; s0 = b; s1 = b + 16; s2 = b + 32; s3 = b + 48; ld[q] = DIN; ldd = 1024; \
          dst = (bf16_t*)(ws + O_WINT + (size_t)n0 * 1024 + kt * 64);        \
        } else if (it < J3) {    \
          const int which = (it - J0) >> 7, r = (it - J0) & 127; const int kt = r & 7, nt = r >> 3; \
          const float* src = which == 0 ? pwa : which == 1 ? pwb : pwc; \
          const float* b = src + (size_t)kt * 64 * 1024 + nt * 64; s0 = b; s1 = b + 16; s2 = b + 32; s3 = b + 48; ld[q] = 1024; ldd = 512; \
          dst = (bf16_t*)(ws + (which == 0 ? O_WAT : which == 1 ? O_WBT : O_WCT) + (size_t)nt * 64 * 512 + kt * 64);        \
        } else if (it < J5) {    \
          const int which = (it - J3) >> 8, r = (it - J3) & 255; const int kt = r & 15, nt = r >> 4; \
          const float* b = (which == 0 ? pwo : pwmkv) + (size_t)kt * 64 * 1024 + nt * 64; s0 = b; s1 = b + 16; s2 = b + 32; s3 = b + 48; ld[q] = 1024; ldd = 1024; \
          dst = (bf16_t*)(ws + (which == 0 ? O_WOT : O_WMKV) + (size_t)nt * 64 * 1024 + kt * 64);        \
        } else if (it < J6) {    \
          const int r = it - J5; const int kt = r & 15, nt = r >> 4; \
          const float* b = prw + (size_t)kt * 64 * 256 + nt * 64; s0 = b; s1 = b + 16; s2 = b + 32; s3 = b + 48; ld[q] = 256; ldd = 1024; \
          dst = (bf16_t*)(ws + O_ROUT) + (size_t)nt * 64 * 1024 + kt * 64; \
        } else if (it < J7) {    \
          const int r = it - J6; const int kt = r & 15, nt = r >> 4; \
          const float* g = pwsg + (size_t)kt * 64 * 256 + nt * 32; const float* u = pwsu + (size_t)kt * 64 * 256 + nt * 32; \
          s0 = g; s1 = u; s2 = g + 16; s3 = u + 16; ld[q] = 256; ldd = 1024; \
          dst = (bf16_t*)(ws + O_WSGU) + (size_t)nt * 64 * 1024 + kt * 64; \
        } else if (it < J8) {    \
          const int r = it - J7; const int kt = r & 3, nt = r >> 2; \
          const float* b = pwsd + (size_t)kt * 64 * 1024 + nt * 64; s0 = b; s1 = b + 16; s2 = b + 32; s3 = b + 48; ld[q] = 1024; ldd = 256; \
          dst = (bf16_t*)(ws + O_WSD) + (size_t)nt * 64 * 256 + kt * 64; \
        } else if (it < J9) {    \
          const int r = it - J8; const int e = r >> 7, qq = r & 127; const int kt = qq & 15, nt = qq >> 4; \
          const float* g = pwg + (size_t)e * 262144 + (size_t)kt * 64 * 256 + nt * 32; const float* u = pwu + (size_t)e * 262144 + (size_t)kt * 64 * 256 + nt * 32; \
          s0 = g; s1 = u; s2 = g + 16; s3 = u + 16; ld[q] = 256; ldd = 1024; \
          dst = (bf16_t*)(ws + O_WGU) + (size_t)e * 524288 + (size_t)nt * 64 * 1024 + kt * 64; \
        } else {                 \
          const int r = it - J9; const int e = r >> 6, qq = r & 63; const int kt = qq & 3, nt = qq >> 2; \
          const float* b = pwdn + (size_t)e * 262144 + (size_t)kt * 64 * 1024 + nt * 64; s0 = b; s1 = b + 16; s2 = b + 32; s3 = b + 48; ld[q] = 1024; ldd = 256; \
          dst = (bf16_t*)(ws + O_WD) + (size_t)e * 262144 + (size_t)nt * 64 * 256 + kt * 64; \
        } \
        sp[q] = (sg == 0 ? s0 : sg == 1 ? s1 : sg == 2 ? s2 : s3) + (size_t)kr * ld[q] + 4 * (nc & 3); \
        dp[q] = (MODE == 0 || v_ < 640) ? (bf16_t*)((unsigned char*)dst + (size_t)tn * ldd + 8 * tkc) : dst + (size_t)tn * ldd + 8 * tkc; \
      } \
      _Pragma("unroll") \
      for (int q = 0; q < 4; ++q) { v0[q] = __builtin_nontemporal_load((const f32x4*)(sp[q])); v1[q] = __builtin_nontemporal_load((const f32x4*)(sp[q] + (size_t)32 * ld[q])); } } while (0)
    bf16_t* dpn[4]; f32x4 v0n[4], v1n[4];
    int it0 = wk * 4;
    if (it0 < NV) P0_DECODE_LOAD(it0, dpn, v0n, v1n);
    for (; it0 < NV; it0 += nwk * 4) {
      bf16_t* dp[4]; f32x4 v0[4], v1[4];
#pragma unroll
      for (int q = 0; q < 4; ++q) { dp[q] = dpn[q]; v0[q] = v0n[q]; v1[q] = v1n[q]; }
      if (it0 + nwk * 4 < NV) P0_DECODE_LOAD(it0 + nwk * 4, dpn, v0n, v1n);
      asm volatile("s_waitcnt lgkmcnt(0)" ::: "memory"); __builtin_amdgcn_s_barrier(); asm volatile("" ::: "memory");
#pragma unroll
      for (int q = 0; q < 4; ++q) {
        float* t0 = tile + q * 4160 + kr * 65 + 4 * nc;
        float* t1 = t0 + 32 * 65;
        t0[0] = v0[q][0]; t0[1] = v0[q][1]; t0[2] = v0[q][2]; t0[3] = v0[q][3];
        t1[0] = v1[q][0]; t1[1] = v1[q][1]; t1[2] = v1[q][2]; t1[3] = v1[q][3];
      }
      asm volatile("s_waitcnt lgkmcnt(0)" ::: "memory"); __builtin_amdgcn_s_barrier(); asm volatile("" ::: "memory");
#pragma unroll
      for (int q = 0; q < 4; ++q) {
        float e[8];
#pragma unroll
        for (int j = 0; j < 8; ++j) e[j] = tile[q * 4160 + (8 * tkc + j) * 65 + tn];
        const int vq_ = (it0 + q < NV) ? it0 + q : NV - 1;
        if (MODE == 0 || vq_ < 640) {
          unsigned w0_ = 0u, w1_ = 0u;
          w0_ = __builtin_amdgcn_cvt_pk_fp8_f32(64.f * e[0], 64.f * e[1], w0_, false); w0_ = __builtin_amdgcn_cvt_pk_fp8_f32(64.f * e[2], 64.f * e[3], w0_, true);
          w1_ = __builtin_amdgcn_cvt_pk_fp8_f32(64.f * e[4], 64.f * e[5], w1_, false); w1_ = __builtin_amdgcn_cvt_pk_fp8_f32(64.f * e[6], 64.f * e[7], w1_, true);
          *(u32x2*)(dp[q]) = (u32x2){w0_, w1_};
        } else {
          u32x4 o = {pk2(e[0], e[1]), pk2(e[2], e[3]), pk2(e[4], e[5]), pk2(e[6], e[7])};
          *(u32x4*)(dp[q]) = o;
        }
      }
    }
#undef P0_DECODE_LOAD
  }
}
DI void phase0(const Params& p, unsigned char* smem, int bid, int nb) {
  int tid = threadIdx.x; asm volatile("" : "+v"(tid));
  const int lane = tid & 63, wave = tid >> 6;
  unsigned char* ws = p.ws;
  if (bid == 0 && tid < 256) ((int*)(ws + O_CTRL))[tid * CSTR] = 0;
  for (int i = bid * NTHR + tid; i < T; i += nb * NTHR) ((int*)(ws + O_IDENT))[i] = i;
  {
    float* wabT = (float*)smem;
    const float* win = p.in[I_WIN];
    for (int i = tid; i < 8192; i += NTHR) { const int k = i >> 3, j = i & 7; wabT[j * 1024 + k] = win[(size_t)k * DIN + 2048 + j]; }
    __syncthreads();
    const float* x = p.in[I_X];
    bf16_t* xb = (bf16_t*)(ws + O_XB);
    float* ab = (float*)(ws + O_AB);
    for (int row = bid * 8 + wave; row < T; row += nb * 8) {
      float s[8];
#pragma unroll
      for (int j = 0; j < 8; ++j) s[j] = 0.f;
#pragma unroll
      for (int i = 0; i < 4; ++i) {
        const int k = 256 * i + 4 * lane;
        const f32x4 v = *(const f32x4*)(x + (size_t)row * D + k);
        { unsigned w_ = 0u; w_ = __builtin_amdgcn_cvt_pk_fp8_f32(v[0], v[1], w_, false); w_ = __builtin_amdgcn_cvt_pk_fp8_f32(v[2], v[3], w_, true); *(unsigned*)((unsigned char*)xb + (size_t)row * D + k) = w_; }
#pragma unroll
        for (int j = 0; j < 8; ++j) { const f32x4 w = *(const f32x4*)(wabT + j * 1024 + k); s[j] += v[0] * w[0] + v[1] * w[1] + v[2] * w[2] + v[3] * w[3]; }
      }
#pragma unroll
      for (int j = 0; j < 8; ++j) s[j] = wave_sum(s[j]);
      if (lane == 0) { *(f32x4*)(ab + (size_t)row * 8) = (f32x4){s[0], s[1], s[2], s[3]}; *(f32x4*)(ab + (size_t)row * 8 + 4) = (f32x4){s[4], s[5], s[6], s[7]}; }
    }
    const float* mem = p.in[I_MEM];
    bf16_t* memb = (bf16_t*)(ws + O_MEMB);
    for (int row = bid * 8 + wave; row < 512; row += nb * 8) {
#pragma unroll
      for (int i = 0; i < 4; ++i) { const int k = 256 * i + 4 * lane; const f32x4 v = *(const f32x4*)(mem + (size_t)row * D + k); unsigned w_ = 0u; w_ = __builtin_amdgcn_cvt_pk_fp8_f32(v[0], v[1], w_, false); w_ = __builtin_amdgcn_cvt_pk_fp8_f32(v[2], v[3], w_, true); *(unsigned*)((unsigned char*)memb + (size_t)row * D + k) = w_; }
    }
    const float* sw = p.in[I_SGUW];
    bf16_t* sguw = (bf16_t*)(ws + O_SGUW);
    for (int i = bid * NTHR + tid; i < 16384; i += nb * NTHR) {
      const int e0 = i * 4; const int col = e0 & 127, rowi = (e0 >> 7) & 127;
      f32x4 v = *(const f32x4*)(sw + e0);
#pragma unroll
      for (int c = 0; c < 4; ++c) if (col + c > rowi) v[c] = 0.f;
      *(u32x2*)(sguw + e0) = pack4(v);
    }
    __syncthreads();
  }
  p0_transposes<0>(p, smem, bid, nb);
}

#define EPI_ROWS(u) const int row_ = (u).pm * 256 + 64 * wr + fr
struct EpiInProj {
  unsigned char* ws;
  DI void operator()(const f32x4 (&acc)[2][2][4][2], const pg::Unit& u, int wr, int wc, int fr, int fq) const {
    const int colt = u.pn * 256;
#pragma unroll
    for (int ai = 0; ai < 2; ++ai)
#pragma unroll
      for (int m = 0; m < 4; ++m) {
        const size_t row = (size_t)u.pm * 256 + 128 * ai + 64 * wr + 16 * m + fr;
#pragma unroll
        for (int bj = 0; bj < 2; ++bj)
#pragma unroll
          for (int n = 0; n < 2; ++n) {
            const int col = colt + 128 * bj + 32 * wc + 16 * n + 4 * fq;
            f32x4 v = acc[ai][bj][m][n] * 0.015625f;
            if (colt < 1536) { *(u32x2*)((bf16_t*)(ws + O_QKV) + row * 1536 + col) = pack4(v); }
            else if (colt < 2048) {
#pragma unroll
              for (int c = 0; c < 4; ++c) v[c] = siluf_(v[c]);
              *(u32x2*)((bf16_t*)(ws + O_ZS) + row * 512 + (col - 1536)) = pack4(v);
            } else if (colt < 3072) {
#pragma unroll
              for (int c = 0; c < 4; ++c) v[c] = geluf_(v[c]);
              *(u32x2*)((bf16_t*)(ws + O_UVG) + row * 1024 + (col - 2048)) = pack4(v);
            } else if (colt < 3584) {
#pragma unroll
              for (int c = 0; c < 4; ++c) v[c] *= 0.08838834764831845f;
              *(u32x2*)((bf16_t*)(ws + O_XQ) + row * 512 + (col - 3072)) = pack4(v);
            } else {
#pragma unroll
              for (int c = 0; c < 4; ++c) v[c] = sigmoidf_(v[c]);
              { const unsigned b0 = (unsigned)(v[0] * 255.f + 0.5f), b1 = (unsigned)(v[1] * 255.f + 0.5f), b2 = (unsigned)(v[2] * 255.f + 0.5f), b3 = (unsigned)(v[3] * 255.f + 0.5f);
                *(unsigned*)(ws + O_GATES + row * 3072 + (col - 3584)) = b0 | (b1 << 8) | (b2 << 16) | (b3 << 24); }
            }
          }
      }
  }
};
struct EpiMemKV {
  unsigned char* ws;
  DI void operator()(const f32x4 (&acc)[2][2][4][2], const pg::Unit& u, int wr, int wc, int fr, int fq) const {
#pragma unroll
    for (int ai = 0; ai < 2; ++ai)
#pragma unroll
      for (int m = 0; m < 4; ++m) {
        const int row = u.pm * 256 + 128 * ai + 64 * wr + 16 * m + fr; const int b = row >> 8, key = row & 255;
#pragma unroll
        for (int bj = 0; bj < 2; ++bj)
#pragma unroll
          for (int n = 0; n < 2; ++n) {
            const int col = u.pn * 256 + 128 * bj + 32 * wc + 16 * n + 4 * fq;
            const f32x4 v = acc[ai][bj][m][n] * 0.015625f;
            if (col < 512) { const int h = col >> 7, d = col & 127; *(u32x2*)((bf16_t*)(ws + O_MEMK) + ((size_t)((b * 4 + h) * 256 + key)) * 128 + d) = pack4(v); }
            else {
              const int c2 = col - 512; const int h = c2 >> 7, d = c2 & 127;
              const int pos = 32 * (key >> 5) + 8 * ((key >> 2) & 3) + 4 * ((key >> 4) & 1) + (key & 3);
              bf16_t* vt = (bf16_t*)(ws + O_MEMVT) + ((size_t)((b * 4 + h) * 128 + d)) * 256 + pos;
#pragma unroll
              for (int c = 0; c < 4; ++c) vt[(size_t)c * 256] = f2bf(v[c]);
            }
          }
      }
  }
};
struct P1Order {
  pg::DenseOrder D; const char* memb; const char* wmkv; int G, c;
  DI bool next(int i, pg::Unit& u) const {
    const long L = (long)i * G + c;
    if (L < D.nwg) { D.unit_of(L, u); u.e = 0; return true; }
    const int r = (int)(L - D.nwg); if (r >= 8) return false;
    u.pm = r & 1; u.pn = r >> 1; u.e = 1; u.rows = nullptr;
    u.a = memb + (size_t)u.pm * 262144; u.b = wmkv + (size_t)u.pn * 262144; return true;
  }
};
struct EpiP1 {
  EpiInProj a; EpiMemKV b;
  DI void operator()(const f32x4 (&acc)[2][2][4][2], const pg::Unit& u, int wr, int wc, int fr, int fq) const {
    asm volatile("" : "+v"(fr), "+v"(fq));
    if (u.e) b(acc, u, wr, wc, fr, fq); else a(acc, u, wr, wc, fr, fq);
  }
};
DI void phase1(const Params& p, unsigned char* smem, int bid, int nb) {
  unsigned char* ws = p.ws;
  PG_LAS unsigned char* lds = (PG_LAS unsigned char*)smem;
  __syncthreads();
  P1Order S; S.D.init(ws + O_XB, ws + O_WINT, T, NPROJ, 512, nb, bid); S.memb = (const char*)(ws + O_MEMB); S.wmkv = (const char*)(ws + O_WMKV); S.G = nb; S.c = bid;
  EpiP1 E{EpiInProj{ws}, EpiMemKV{ws}};
  pg::gemm_phase<EpiP1, P1Order, false, true, true>(lds, 512, S, E);
  { const int nu = S.D.nwg + 8, nheavy = nu % nb; if (nheavy == 0) p0_transposes<1>(p, smem, bid, nb); else if (bid >= nheavy) p0_transposes<1>(p, smem, bid - nheavy, nb - nheavy); }
}

constexpr int G_KF = 0, G_VF = 32768, G_QB = 65536, G_KB = 81920, G_UT = 81920  , G_L = 98304, G_ATT = 114688, G_KDT = 122880, G_WT = 139264, G_SM = 155648;

DI void gdn_prep_item(const Params& p, unsigned char* smem_, int item) {
  unsigned char* smem; { LAS unsigned char* l_ = (LAS unsigned char*)smem_; asm volatile("" : "+v"(l_)); smem = (unsigned char*)l_; }
  int tid = threadIdx.x; asm volatile("" : "+v"(tid));
  const int lane = tid & 63, wave = tid >> 6, fr = lane & 15, fq = lane >> 4;
  unsigned char* ws; { GAS unsigned char* g_ = (GAS unsigned char*)p.ws; asm volatile("" : "+s"(g_)); ws = (unsigned char*)g_; }
  const int h = item & 3, cn = item >> 2;
  const int bidx = cn >> 7, n = cn & 127;
  const size_t t0 = (size_t)bidx * SEQ + (size_t)n * 64;
  float* kf = (float*)(smem + G_KF); float* vf = (float*)(smem + G_VF); float* Lm = (float*)(smem + G_L);
  float* sbeta = (float*)(smem + G_SM); float* sgc = sbeta + 64; float* segc = sbeta + 128;
  __syncthreads();
  {
    const bf16_t* qkv = (const bf16_t*)(ws + O_QKV);
    const float* cw = p.in[I_CONVW];
    const int tl0 = wave * 8;
#pragma unroll
    for (int sect = 0; sect < 3; ++sect) {
      const int cb = sect * 512 + h * 128 + 2 * lane;
      float w0[4], w1[4];
#pragma unroll
      for (int i = 0; i < 4; ++i) { w0[i] = cw[i * 1536 + cb]; w1[i] = cw[i * 1536 + cb + 1]; }
      float xa[11], xc[11];
#pragma unroll
      for (int r = 0; r < 11; ++r) {
        const int s = n * 64 + tl0 + r - 3;
        unsigned u = 0u;
        if (s >= 0) u = *(const unsigned*)(qkv + ((size_t)bidx * SEQ + s) * 1536 + cb);
        xa[r] = lo2f(u); xc[r] = hi2f(u);
      }
#pragma unroll
      for (int r = 0; r < 8; ++r) {
        float y0 = w0[0] * xa[r] + w0[1] * xa[r + 1] + w0[2] * xa[r + 2] + w0[3] * xa[r + 3];
        float y1 = w1[0] * xc[r] + w1[1] * xc[r + 1] + w1[2] * xc[r + 2] + w1[3] * xc[r + 3];
        y0 = siluf_(y0); y1 = siluf_(y1);
        const int tl = tl0 + r;
        if (sect == 2) { vf[tl * 128 + 2 * lane] = y0; vf[tl * 128 + 2 * lane + 1] = y1; }
        else {
          const float ss = wave_sum(y0 * y0 + y1 * y1);
          const float sc = rsqrtf(ss + 1e-6f) * (sect == 0 ? 0.08838834764831845f : 1.0f);
          y0 *= sc; y1 *= sc;
          const int off = sw256(tl, lane >> 2) + (lane & 3) * 4;
          if (sect == 0) *(unsigned*)(smem + G_QB + off) = pk2(y0, y1);
          else { *(unsigned*)(smem + G_KB + off) = pk2(y0, y1); kf[tl * 128 + 2 * lane] = y0; kf[tl * 128 + 2 * lane + 1] = y1; }
        }
      }
    }
    if (wave == 0) {
      const float* ab = (const float*)(ws + O_AB) + (t0 + lane) * 8;
      const float a = ab[h], bb = ab[4 + h];
      const float beta = sigmoidf_(bb);
      float g = -__expf(p.in[I_ALOG][h]) * softplusf_(a + p.in[I_DTB][h]);
#pragma unroll
      for (int o = 1; o < 64; o <<= 1) { const float y = __shfl_up(g, o); if (lane >= o) g += y; }
      sbeta[lane] = beta; sgc[lane] = g; segc[lane] = __expf(g);
      if (lane == 63) ((float*)(ws + O_GL))[item] = __expf(g);
    }
  }
  __syncthreads();
  {
#pragma unroll
    for (int q = 0; q < 4; ++q) {
      const int idx = wave * 4 + q; const int isq = idx >> 4, ti = (idx >> 2) & 3, tj = idx & 3;
      f32x4 acc = {0.f, 0.f, 0.f, 0.f};
      if (tj <= ti) {
#pragma unroll
        for (int ks = 0; ks < 4; ++ks) {
          const bf16x8 ai = ldfrag(smem + (isq ? G_QB : G_KB) + sw256(16 * ti + fr, 4 * ks + fq));
          const bf16x8 bj = ldfrag(smem + G_KB + sw256(16 * tj + fr, 4 * ks + fq));
          acc = isq ? mfma16(bj, ai, acc) : mfma16(ai, bj, acc);
        }
      }
      if (isq) {
        const int i = 16 * ti + fr, j0 = 16 * tj + 4 * fq;
        const float gi = sgc[i];
        f32x4 o;
#pragma unroll
        for (int r = 0; r < 4; ++r) { const int j = j0 + r; o[r] = (j <= i) ? acc[r] * __expf(gi - sgc[j]) : 0.f; }
        *(u32x2*)(smem + G_ATT + sw128(i, j0 >> 3) + (j0 & 7) * 2) = pack4(o);
      } else {
        const int j = 16 * tj + fr, i0 = 16 * ti + 4 * fq;
        const float gj = sgc[j];
        f32x4 o;
#pragma unroll
        for (int r = 0; r < 4; ++r) { const int i = i0 + r; o[r] = (j < i) ? acc[r] * __expf(sgc[i] - gj) * sbeta[i] : 0.f; }
        *(f32x4*)(Lm + j * 64 + i0) = o;
      }
    }
  }
  {
    const float gl_ = sgc[63];
    const int d = tid & 127, tg = tid >> 7;
#pragma unroll
    for (int c = 0; c < 2; ++c) {
      float e[8];
#pragma unroll
      for (int j = 0; j < 8; ++j) { const int t = 16 * tg + 8 * c + j; e[j] = kf[t * 128 + d] * __expf(gl_ - sgc[t]); }
      u32x4 o = {pk2(e[0], e[1]), pk2(e[2], e[3]), pk2(e[4], e[5]), pk2(e[6], e[7])};
      *(u32x4*)(smem + G_KDT + sw128(d, 2 * tg + c)) = o;
    }
  }
  __syncthreads();
  {
#pragma unroll
    for (int i = 0; i < 32; ++i) {
      const int e = tid + 512 * i; const int t = e >> 8, c = e & 255;
      float* xp = (c < 128) ? (vf + t * 128 + c) : (kf + t * 128 + (c - 128));
      float sc = sbeta[t]; if (c >= 128) sc *= segc[t];
      *xp *= sc;
    }
    __syncthreads();
    const int ct0 = 2 * wave;
    float* xt0 = (ct0 < 8) ? (vf + 16 * ct0) : (kf + 16 * (ct0 - 8));
    float* xt1 = xt0 + 16;
#pragma unroll
    for (int b = 0; b < 4; ++b) {
      if (b > 0) {
        f32x4 a0 = {0.f, 0.f, 0.f, 0.f}, a1 = {0.f, 0.f, 0.f, 0.f};
#pragma unroll
        for (int ks = 0; ks < 4 * b; ++ks) {
          const int k = 4 * ks + fq;
          const float av = Lm[k * 64 + 16 * b + fr];
          a0 = __builtin_amdgcn_mfma_f32_16x16x4f32(av, xt0[k * 128 + fr], a0, 0, 0, 0);
          a1 = __builtin_amdgcn_mfma_f32_16x16x4f32(av, xt1[k * 128 + fr], a1, 0, 0, 0);
        }
#pragma unroll
        for (int r = 0; r < 4; ++r) { xt0[(16 * b + 4 * fq + r) * 128 + fr] -= a0[r]; xt1[(16 * b + 4 * fq + r) * 128 + fr] -= a1[r]; }
        __syncthreads();
      }
      if (tid < 256) {
        const bool isw = tid >= 128;
        float* X = isw ? (kf + (tid - 128)) : (vf + tid);
        float xr[16];
#pragma unroll
        for (int r = 0; r < 16; ++r) xr[r] = X[(16 * b + r) * 128];
#pragma unroll
        for (int q = 0; q < 15; ++q) {
          const float* lt = Lm + (16 * b + q) * 64 + 16 * b;
          float l[16];
#pragma unroll
          for (int g4 = 0; g4 < 4; ++g4) if (4 * g4 + 3 > q) { const f32x4 t4 = *(const f32x4*)(lt + 4 * g4); l[4 * g4] = t4[0]; l[4 * g4 + 1] = t4[1]; l[4 * g4 + 2] = t4[2]; l[4 * g4 + 3] = t4[3]; }
#pragma unroll
          for (int r = q + 1; r < 16; ++r) xr[r] -= l[r] * xr[q];
        }
#pragma unroll
        for (int r = 0; r < 16; ++r) X[(16 * b + r) * 128] = xr[r];
        unsigned char* dstT = smem + (isw ? G_WT : G_UT);
        const int rowc = tid & 127;
        u32x4 o0 = {pk2(xr[0], xr[1]), pk2(xr[2], xr[3]), pk2(xr[4], xr[5]), pk2(xr[6], xr[7])};
        u32x4 o1 = {pk2(xr[8], xr[9]), pk2(xr[10], xr[11]), pk2(xr[12], xr[13]), pk2(xr[14], xr[15])};
        *(u32x4*)(dstT + sw128(rowc, 2 * b)) = o0;
        *(u32x4*)(dstT + sw128(rowc, 2 * b + 1)) = o1;
      }
      if (b < 3) __syncthreads();
    }
  }
  __syncthreads();
  {
    bf16x8 ak[2];
#pragma unroll
    for (int ks = 0; ks < 2; ++ks) ak[ks] = ldfrag(smem + G_KDT + sw128(16 * wave + fr, 4 * ks + fq));
    bf16_t* mp = (bf16_t*)(ws + O_MP + (size_t)item * 16384);
    bf16_t* bc = (bf16_t*)(ws + O_BC + (size_t)item * 16384);
#pragma unroll
    for (int tj = 0; tj < 8; ++tj) {
      f32x4 am = {0.f, 0.f, 0.f, 0.f}, ab_ = {0.f, 0.f, 0.f, 0.f};
#pragma unroll
      for (int ks = 0; ks < 2; ++ks) {
        const bf16x8 bw = ldfrag(smem + G_WT + sw128(16 * tj + fr, 4 * ks + fq));
        const bf16x8 bu = ldfrag(smem + G_UT + sw128(16 * tj + fr, 4 * ks + fq));
        am = mfma16(bw, ak[ks], am);
        ab_ = mfma16(ak[ks], bu, ab_);
      }
      f32x4 nm = {-am[0], -am[1], -am[2], -am[3]};
      { unsigned w_ = 0u; w_ = __builtin_amdgcn_cvt_pk_fp8_f32(16.f * nm[0], 16.f * nm[1], w_, false); w_ = __builtin_amdgcn_cvt_pk_fp8_f32(16.f * nm[2], 16.f * nm[3], w_, true);
        *(unsigned*)((unsigned char*)mp + ((size_t)((wave * 4 + (tj >> 1)) * 64 + lane)) * 8 + (tj & 1) * 4) = w_; }
      { unsigned w_ = 0u; w_ = __builtin_amdgcn_cvt_pk_fp8_f32(16.f * ab_[0], 16.f * ab_[1], w_, false); w_ = __builtin_amdgcn_cvt_pk_fp8_f32(16.f * ab_[2], 16.f * ab_[3], w_, true);
        *(unsigned*)((unsigned char*)bc + ((size_t)((tj * 4 + (wave >> 1)) * 64 + lane)) * 8 + (wave & 1) * 4) = w_; }
    }
    const int tt = wave & 3, hf = wave >> 2;
    bf16x8 aa[2];
#pragma unroll
    for (int ks = 0; ks < 2; ++ks) aa[ks] = ldfrag(smem + G_ATT + sw128(16 * tt + fr, 4 * ks + fq));
    const int trow = 16 * tt + fr;
    const float eg = segc[trow];
    bf16_t* o0 = (bf16_t*)(ws + O_O0) + (t0 + trow) * 512 + h * 128;
    bf16_t* qp = (bf16_t*)(ws + O_QP) + (size_t)item * 8192 + trow * 128;
#pragma unroll
    for (int q = 0; q < 4; ++q) {
      const int te = hf * 4 + q;
      f32x4 ao = {0.f, 0.f, 0.f, 0.f}, aw = {0.f, 0.f, 0.f, 0.f};
#pragma unroll
      for (int ks = 0; ks < 2; ++ks) {
        const bf16x8 bu = ldfrag(smem + G_UT + sw128(16 * te + fr, 4 * ks + fq));
        const bf16x8 bw = ldfrag(smem + G_WT + sw128(16 * te + fr, 4 * ks + fq));
        ao = mfma16(bu, aa[ks], ao);
        aw = mfma16(bw, aa[ks], aw);
      }
      const int e0 = 16 * te + 4 * fq;
      *(u32x2*)(o0 + e0) = pack4(ao);
      const u32x2 qv = *(const u32x2*)(smem + G_QB + sw256(trow, e0 >> 3) + (e0 & 7) * 2);
      f32x4 qd = {lo2f(qv[0]) * eg - aw[0], hi2f(qv[0]) * eg - aw[1], lo2f(qv[1]) * eg - aw[2], hi2f(qv[1]) * eg - aw[3]};
      *(u32x2*)(qp + e0) = pack4(qd);
    }
  }
}

typedef short s16x4 __attribute__((ext_vector_type(4)));
DI bf16x8 tr_frag(const unsigned char* p0, const unsigned char* p1) {
  const s16x4 a = __builtin_amdgcn_ds_read_tr16_b64_v4i16((LAS s16x4*)p0), b = __builtin_amdgcn_ds_read_tr16_b64_v4i16((LAS s16x4*)p1);
  bf16x8 r; r[0] = a[0]; r[1] = a[1]; r[2] = a[2]; r[3] = a[3]; r[4] = b[0]; r[5] = b[1]; r[6] = b[2]; r[7] = b[3]; return r;
}
DI void sgu_item(const Params& p, unsigned char* smem_, int item) {
  unsigned char* smem; { LAS unsigned char* l_ = (LAS unsigned char*)smem_; asm volatile("" : "+v"(l_)); smem = (unsigned char*)l_; }
  int tid = threadIdx.x; asm volatile("" : "+v"(tid));
  const int lane = tid & 63, wave = __builtin_amdgcn_readfirstlane(tid >> 6), fr = lane & 15, fq = lane >> 4;
  unsigned char* ws; { GAS unsigned char* g_ = (GAS unsigned char*)p.ws; asm volatile("" : "+s"(g_)); ws = (unsigned char*)g_; }
  const int gp = item & 1, cn = item >> 1;
  const size_t t0 = (size_t)cn * 128;
  const bf16_t* uvg = (const bf16_t*)(ws + O_UVG);
  constexpr int VS = 544;
  __syncthreads();
  {
    const float* lng = p.in[I_SLNG]; const float* lnb = p.in[I_SLNB];
    float gg[8], bb[8];
#pragma unroll
    for (int e = 0; e < 8; ++e) { gg[e] = lng[8 * lane + e]; bb[e] = lnb[8 * lane + e]; }
#pragma unroll 2
    for (int jj = 0; jj < 16; ++jj) {
      const int j = 16 * wave + jj;
      const u32x4 raw = *(const u32x4*)(uvg + (t0 + j) * 1024 + 512 + 8 * lane);
      float v[8];
#pragma unroll
      for (int e = 0; e < 4; ++e) { v[2 * e] = lo2f(raw[e]); v[2 * e + 1] = hi2f(raw[e]); }
      float s = 0.f, q2 = 0.f;
#pragma unroll
      for (int e = 0; e < 8; ++e) { s += v[e]; q2 += v[e] * v[e]; }
      s = wave_sum(s); q2 = wave_sum(q2);
      const float mean = s * (1.f / 512.f);
      const float rstd = rsqrtf(fmaxf(q2 * (1.f / 512.f) - mean * mean, 0.f) + 1e-5f);
      if ((lane >> 5) == gp) {
        float y[8];
#pragma unroll
        for (int e = 0; e < 8; ++e) y[e] = (v[e] - mean) * rstd * gg[e] + bb[e];
        u32x4 o = {pk2(y[0], y[1]), pk2(y[2], y[3]), pk2(y[4], y[5]), pk2(y[6], y[7])};
        *(u32x4*)(smem + j * VS + (lane & 31) * 16) = o;
      }
    }
  }
  __syncthreads();
  {
    const int i = 16 * wave + fr;
    const int q = (lane & 15) >> 2, pp = lane & 3;
    const unsigned char* vb = smem + (8 * fq + q) * VS + 8 * pp;
#pragma unroll 1
    for (int gl = 0; gl < 2; ++gl) {
      const int g = 2 * gp + gl;
      const bf16_t* wg = (const bf16_t*)(ws + O_SGUW) + (size_t)g * 16384;
      bf16x8 af[4];
#pragma unroll
      for (int ks = 0; ks < 4; ++ks) af[ks] = ldfrag(wg + i * 128 + 32 * ks + 8 * fq);
      const float bias = p.in[I_SGUB][g * 128 + i];
      unsigned char* out = ws + O_SGUO + (t0 + i) * 512 + 128 * g;
      const bf16_t* urow = uvg + (t0 + i) * 1024 + 128 * g;
#pragma unroll
      for (int jt = 0; jt < 8; ++jt) {
        f32x4 acc = {0.f, 0.f, 0.f, 0.f};
#pragma unroll
        for (int ks = 0; ks < 4; ++ks) {
          const unsigned char* a0 = vb + ks * 32 * VS + (128 * gl + 16 * jt) * 2;
          acc = mfma16(tr_frag(a0, a0 + 4 * VS), af[ks], acc);
        }
        const int c0 = 16 * jt + 4 * fq;
        const u32x2 uu = *(const u32x2*)(urow + c0);
        f32x4 o = {lo2f(uu[0]) * (acc[0] + bias), hi2f(uu[0]) * (acc[1] + bias), lo2f(uu[1]) * (acc[2] + bias), hi2f(uu[1]) * (acc[3] + bias)};
        { unsigned w_ = 0u; w_ = __builtin_amdgcn_cvt_pk_fp8_f32(o[0], o[1], w_, false); w_ = __builtin_amdgcn_cvt_pk_fp8_f32(o[2], o[3], w_, true); *(unsigned*)(out + c0) = w_; }
        if (jt & 1) __builtin_amdgcn_sched_barrier(0);
      }
    }
  }
}

DI void xattn_item(const Params& p, unsigned char* smem_, int item) {
  int tid = threadIdx.x; asm volatile("" : "+v"(tid));
  unsigned char* smem; { LAS unsigned char* l_ = (LAS unsigned char*)smem_; asm volatile("" : "+v"(l_)); smem = (unsigned char*)l_; }
  const int lane = tid & 63, wave = tid >> 6, fr = lane & 15, fq = lane >> 4;
  unsigned char* ws; { GAS unsigned char* g_ = (GAS unsigned char*)p.ws; asm volatile("" : "+s"(g_)); ws = (unsigned char*)g_; }
  const int bh = item & 7, qb = item >> 3;
  const int b = bh >> 2, h = bh & 3;
  const bf16_t* mk = (const bf16_t*)(ws + O_MEMK) + (size_t)bh * 32768;
  const bf16_t* mv = (const bf16_t*)(ws + O_MEMVT) + (size_t)bh * 32768;
  __syncthreads();
#pragma unroll 2
  for (int j = 0; j < 8; ++j) {
    const int c = tid + 512 * j;
    const int rk = c >> 4, ck = c & 15;
    *(u32x4*)(smem + sw256(rk, ck)) = *(const u32x4*)(mk + (size_t)c * 8);
    const int rv = c >> 5, cv = c & 31;
    *(u32x4*)(smem + 65536 + rv * 512 + ((cv ^ (rv & 15)) << 4)) = *(const u32x4*)(mv + (size_t)c * 8);
  }
  __syncthreads();
  const unsigned char* kbase[4]; const unsigned char* vbase[8];
#pragma unroll
  for (int ds = 0; ds < 4; ++ds) kbase[ds] = smem + fr * 256 + (((4 * ds + fq) ^ fr) << 4);
#pragma unroll
  for (int s = 0; s < 8; ++s) vbase[s] = smem + 65536 + fr * 512 + (((4 * s + fq) ^ fr) << 4);
#pragma unroll 1
  for (int half = 0; half < 2; ++half) {
    const size_t trow = (size_t)b * SEQ + (size_t)qb * 256 + half * 128 + 16 * wave + fr;
    const bf16_t* xq = (const bf16_t*)(ws + O_XQ) + trow * 512 + h * 128;
    bf16x8 qf[4];
#pragma unroll
    for (int ds = 0; ds < 4; ++ds) qf[ds] = ldfrag(xq + 32 * ds + 8 * fq);
    f32x4 sc[16];
#pragma unroll
    for (int kt = 0; kt < 16; ++kt) {
      f32x4 a = {0.f, 0.f, 0.f, 0.f};
#pragma unroll
      for (int ds = 0; ds < 4; ++ds) a = mfma16(ldfrag(kbase[ds] + kt * 4096), qf[ds], a);
      sc[kt] = a;
      if (kt & 1) __builtin_amdgcn_sched_barrier(0);
    }
    float m = -1e30f;
#pragma unroll
    for (int kt = 0; kt < 16; ++kt)
#pragma unroll
      for (int r = 0; r < 4; ++r) m = fmaxf(m, sc[kt][r]);
    m = fmaxf(m, __shfl_xor(m, 16)); m = fmaxf(m, __shfl_xor(m, 32));
    float l = 0.f;
#pragma unroll
    for (int kt = 0; kt < 16; ++kt)
#pragma unroll
      for (int r = 0; r < 4; ++r) { const float e = __expf(sc[kt][r] - m); sc[kt][r] = e; l += e; }
    l += __shfl_xor(l, 16); l += __shfl_xor(l, 32);
    const float inv = 1.f / l;
    bf16x8 pf[8];
#pragma unroll
    for (int s = 0; s < 8; ++s) pf[s] = pack8(sc[2 * s], sc[2 * s + 1]);
    unsigned char* out = ws + O_XATO + trow * 512 + h * 128;
#pragma unroll
    for (int dt = 0; dt < 8; ++dt) {
      f32x4 a = {0.f, 0.f, 0.f, 0.f};
#pragma unroll
      for (int s = 0; s < 8; ++s) a = mfma16(ldfrag(vbase[s] + dt * 8192), pf[s], a);
      __builtin_amdgcn_sched_barrier(0);
      f32x4 o = {a[0] * inv, a[1] * inv, a[2] * inv, a[3] * inv};
      { unsigned w_ = 0u; w_ = __builtin_amdgcn_cvt_pk_fp8_f32(o[0], o[1], w_, false); w_ = __builtin_amdgcn_cvt_pk_fp8_f32(o[2], o[3], w_, true); *(unsigned*)(out + 16 * dt + 4 * fq) = w_; }
    }
  }
}

DI void phase2(const Params& p, unsigned char* smem, int bid, int nb) {
  for (int rep = 0; rep < ((DUPMASK >> 20) & 1) + 1; ++rep) {
    if (nb == 256) {
      const int bh = bid & 7, k = bid >> 3;
      for (int j = 0; j < 4; ++j) { const int n = 127 - (k + 32 * j); gdn_prep_item(p, smem, (((bh >> 2) * 128 + n) << 2) + (bh & 3)); }
    } else {
      for (int it = bid; it < 1024; it += nb) gdn_prep_item(p, smem, it);
    }
  }
  for (int rep = 0; rep < ((DUPMASK >> 21) & 1) + 1; ++rep) for (int it = bid; it < 256; it += nb) sgu_item(p, smem, it);
  for (int rep = 0; rep < ((DUPMASK >> 22) & 1) + 1; ++rep) for (int it = bid; it < 256; it += nb) xattn_item(p, smem, it);
}

DI void gdn_scan4(const Params& p, unsigned char* smem_, int bh, int es) {
  int tid = threadIdx.x; asm volatile("" : "+v"(tid));
  unsigned char* smem; { LAS unsigned char* l_ = (LAS unsigned char*)smem_; asm volatile("" : "+v"(l_)); smem = (unsigned char*)l_; }
  const int lane = tid & 63, w = __builtin_amdgcn_readfirstlane(tid >> 6);
  unsigned char* ws = p.ws;
  const int b = bh >> 2, h = bh & 3;
  const int fr = lane & 15, fq = lane >> 4;
  const size_t item0 = (size_t)(b * 128) * 4 + h;
  constexpr size_t ISTR = 4 * 16384;
  constexpr int MR = 8192, CR = 8192 + 98304, GR = CR + 24576;
  unsigned char* xch = smem;
  if (w >= 4) {
    const int cw = w - 4;
    const unsigned char* mp = ws + O_MP + item0 * 16384 + (size_t)(2 * cw) * 2048 + lane * 8;
    const unsigned char* bc = ws + O_BC + item0 * 16384 + (size_t)es * 2048 + (size_t)cw * 512 + lane * 8;
    const float* glp = (const float*)(ws + O_GL) + item0;
    { GAS const float* g_ = (GAS const float*)glp; asm volatile("" : "+v"(g_)); glp = (const float*)g_; }
    bf16_t* sth = (bf16_t*)(ws + O_ST) + item0 * 16384 + (size_t)(16 * es + fr) * 128 + 32 * cw + 4 * fq;
    constexpr int PDH = 4;
    u32x2 R[PDH][8]; u32x2 C[PDH]; float G[PDH];
#define SCANH_LOAD(slot, n_) do { const int nn_ = (n_) < 128 ? (n_) : 127; _Pragma("unroll") for (int i = 0; i < 8; ++i) R[slot][i] = *(const u32x2*)(mp + (size_t)nn_ * ISTR + i * 512); \
      C[slot] = *(const u32x2*)(bc + (size_t)nn_ * ISTR); G[slot] = glp[(size_t)nn_ * 4]; } while (0)
#define SCANH_STAGE(slot, n_) do { unsigned char* mr_ = smem + MR + (((n_) % 3) * 4 + cw) * 8192 + lane * 16; \
      _Pragma("unroll") for (int i = 0; i < 8; ++i) { const u32x4 a_ = {__builtin_bit_cast(unsigned, __builtin_amdgcn_cvt_scalef32_pk_bf16_fp8(R[slot][i][0], 0.0625f, false)), __builtin_bit_cast(unsigned, __builtin_amdgcn_cvt_scalef32_pk_bf16_fp8(R[slot][i][0], 0.0625f, true)), \
          __builtin_bit_cast(unsigned, __builtin_amdgcn_cvt_scalef32_pk_bf16_fp8(R[slot][i][1], 0.0625f, false)), __builtin_bit_cast(unsigned, __builtin_amdgcn_cvt_scalef32_pk_bf16_fp8(R[slot][i][1], 0.0625f, true))}; *(u32x4*)(mr_ + i * 1024) = a_; } \
      const f32x2_ c0 = __builtin_amdgcn_cvt_pk_f32_fp8(C[slot][0], false), c1 = __builtin_amdgcn_cvt_pk_f32_fp8(C[slot][0], true), c2 = __builtin_amdgcn_cvt_pk_f32_fp8(C[slot][1], false), c3 = __builtin_amdgcn_cvt_pk_f32_fp8(C[slot][1], true); \
      unsigned char* cr_ = smem + CR + (((n_) % 3) * 4 + cw) * 2048 + lane * 32; \
      *(f32x4*)(cr_) = (f32x4){0.0625f * c0[0], 0.0625f * c0[1], 0.0625f * c1[0], 0.0625f * c1[1]}; *(f32x4*)(cr_ + 16) = (f32x4){0.0625f * c2[0], 0.0625f * c2[1], 0.0625f * c3[0], 0.0625f * c3[1]}; \
      if (lane == 0 && cw == 0) *(float*)(smem + GR + ((n_) % 3) * 4) = G[slot]; } while (0)
#pragma unroll
    for (int d = 0; d < PDH; ++d) SCANH_LOAD(d, d);
    SCANH_STAGE(0, 0); SCANH_STAGE(1, 1);
    SCANH_LOAD(0, PDH); SCANH_LOAD(1, PDH + 1);
    asm volatile("s_waitcnt lgkmcnt(0)" ::: "memory");
    __builtin_amdgcn_s_barrier();
    asm volatile("" ::: "memory");
    for (int n0 = 0; n0 < 128; n0 += PDH) {
#pragma unroll
      for (int d = 0; d < PDH; ++d) {
        const int n = n0 + d;
        __builtin_amdgcn_s_barrier();
        asm volatile("" ::: "memory");
        const u32x4 v = *(const u32x4*)(xch + ((n & 1) * 4 + cw) * 1024 + lane * 16);
        bf16_t* stn = sth + (size_t)n * ISTR;
        *(u32x2*)(stn) = (u32x2){v[0], v[1]}; *(u32x2*)(stn + 16) = (u32x2){v[2], v[3]};
        SCANH_STAGE((d + 2) % PDH, n + 2);
        SCANH_LOAD((d + 2) % PDH, n + 2 + PDH);
        asm volatile("s_waitcnt lgkmcnt(0)" ::: "memory");
      }
    }
#undef SCANH_LOAD
#undef SCANH_STAGE
    return;
  }
  f32x4 acc0 = {0.f, 0.f, 0.f, 0.f}, acc1 = {0.f, 0.f, 0.f, 0.f};
  bf16x8 Ac[8]; f32x4 Cc0, Cc1; float g;
#define SCANC_FETCH(n_) do { const unsigned char* mr_ = smem + MR + (((n_) % 3) * 4 + w) * 8192 + lane * 16; \
    _Pragma("unroll") for (int i = 0; i < 8; ++i) Ac[i] = ldfrag(mr_ + i * 1024); \
    const unsigned char* cr_ = smem + CR + (((n_) % 3) * 4 + w) * 2048 + lane * 32; Cc0 = *(const f32x4*)(cr_); Cc1 = *(const f32x4*)(cr_ + 16); \
    g = *(const float*)(smem + GR + ((n_) % 3) * 4); } while (0)
  __builtin_amdgcn_s_barrier();
  asm volatile("" ::: "memory");
  SCANC_FETCH(0);
  for (int n = 0; n < 128; ++n) {
    const u32x2 lo = pack4(acc0), hi = pack4(acc1);
    const u32x4 mine = {lo[0], lo[1], hi[0], hi[1]};
    *(u32x4*)(xch + ((n & 1) * 4 + w) * 1024 + lane * 16) = mine;
    asm volatile("s_waitcnt lgkmcnt(0)" ::: "memory");
    __builtin_amdgcn_s_barrier();
    asm volatile("" ::: "memory");
    bf16x8 bfr[4];
#pragma unroll
    for (int s = 0; s < 4; ++s) bfr[s] = ldfrag(xch + ((n & 1) * 4 + s) * 1024 + lane * 16);
    f32x4 a0 = {g * acc0[0] + Cc0[0], g * acc0[1] + Cc0[1], g * acc0[2] + Cc0[2], g * acc0[3] + Cc0[3]};
    f32x4 a1 = {g * acc1[0] + Cc1[0], g * acc1[1] + Cc1[1], g * acc1[2] + Cc1[2], g * acc1[3] + Cc1[3]};
#pragma unroll
    for (int s = 0; s < 4; ++s) { a0 = mfma16(Ac[s], bfr[s], a0); a1 = mfma16(Ac[4 + s], bfr[s], a1); }
    acc0 = a0; acc1 = a1;
    SCANC_FETCH(n + 1);
  }
#undef SCANC_FETCH
}

struct EpiGate {
  const unsigned char* gates; int goff; const bf16_t* src; bf16_t* dst; bool f8dst; float sc;
  DI void operator()(const f32x4 (&acc)[2][2][4][2], const pg::Unit& u, int wr, int wc, int fr, int fq) const {
#pragma unroll
    for (int ai = 0; ai < 2; ++ai)
#pragma unroll
      for (int m = 0; m < 4; ++m) {
        const size_t row = (size_t)u.pm * 256 + 128 * ai + 64 * wr + 16 * m + fr;
#pragma unroll
        for (int bj = 0; bj < 2; ++bj)
#pragma unroll
          for (int n = 0; n < 2; ++n) {
            const int col = u.pn * 256 + 128 * bj + 32 * wc + 16 * n + 4 * fq;
            const f32x4 v = acc[ai][bj][m][n] * sc;
            const unsigned g = *(const unsigned*)(gates + row * 3072 + goff + col);
            constexpr float GS = 1.0f / 255.0f;
            f32x4 o = {(float)(g & 255u) * GS * v[0], (float)((g >> 8) & 255u) * GS * v[1], (float)((g >> 16) & 255u) * GS * v[2], (float)(g >> 24) * GS * v[3]};
            if (src) { const u32x2 s = *(const u32x2*)(src + row * 1024 + col); o[0] += lo2f(s[0]); o[1] += hi2f(s[0]); o[2] += lo2f(s[1]); o[3] += hi2f(s[1]); }
            if (f8dst) { unsigned w_ = 0u; w_ = __builtin_amdgcn_cvt_pk_fp8_f32(o[0], o[1], w_, false); w_ = __builtin_amdgcn_cvt_pk_fp8_f32(o[2], o[3], w_, true); *(unsigned*)((unsigned char*)dst + row * 1024 + col) = w_; }
            else *(u32x2*)(dst + row * 1024 + col) = pack4(o);
          }
      }
  }
};
struct GateOrder {
  pg::DenseOrder D; const char* A2; const char* B2; int G, c;
  DI bool next(int i, pg::Unit& u) const {
    const long L = (long)(i >> 1) * G + c; if (L >= D.nwg) return false;
    D.unit_of(L, u);
    if (i & 1) { u.a = A2 + (size_t)u.pm * D.tstep; u.b = B2 + (size_t)u.pn * D.tstep; }
    u.e = i & 1; return true;
  }
};
struct EpiGate2 {
  const unsigned char* gates; bf16_t* dst;
  DI void operator()(f32x4 (&acc)[2][2][4][2], const pg::Unit& u, int wr, int wc, int fr, int fq) const {
    asm volatile("" : "+v"(fr), "+v"(fq));
#pragma unroll
    for (int ai = 0; ai < 2; ++ai)
#pragma unroll
      for (int m = 0; m < 4; ++m) {
        __builtin_amdgcn_sched_barrier(0);
        const unsigned row = (unsigned)(u.pm * 256 + 128 * ai + 64 * wr + 16 * m + fr);
#pragma unroll
        for (int bj = 0; bj < 2; ++bj)
#pragma unroll
          for (int n = 0; n < 2; ++n) {
            const unsigned cb = (unsigned)(u.pn * 256 + 32 * wc + 4 * fq) + (unsigned)(128 * bj + 16 * n);
            const unsigned g2 = *(const unsigned*)(gates + (size_t)(row * 3072u + cb) + 2048);
            if (u.e == 0) {
              const unsigned g1 = *(const unsigned*)(gates + (size_t)(row * 3072u + cb) + 1024);
#pragma unroll
              for (int c = 0; c < 4; ++c) { const unsigned a = (g1 >> (8 * c)) & 255u, b0 = (g2 >> (8 * c)) & 255u; acc[ai][bj][m][n][c] *= (float)a * __builtin_amdgcn_rcpf((float)(b0 ? b0 : 1u)); }
            } else {
              constexpr float GS = 0.015625f / 255.0f;
              const f32x4 v = acc[ai][bj][m][n];
              f32x4 o;
#pragma unroll
              for (int c = 0; c < 4; ++c) { const unsigned b0 = (g2 >> (8 * c)) & 255u; o[c] = v[c] * ((float)(b0 ? b0 : 1u) * GS); }
              *(u32x2*)(dst + (size_t)(row * 1024u + cb)) = pack4(o);
            }
          }
      }
  }
};
DI void phase3(const Params& p, unsigned char* smem, int bid, int nb) {
  unsigned char* ws = p.ws;
  if (bid < 64) {
    __syncthreads();
    gdn_scan4(p, smem, bid & 7, bid >> 3);
  } else {
    PG_LAS unsigned char* lds = (PG_LAS unsigned char*)smem;
    const unsigned char* gates = ws + O_GATES;
    bf16_t* part = (bf16_t*)(ws + O_PART);
    __syncthreads();
    { GateOrder S; S.D.init(ws + O_SGUO, ws + O_WBT, T, 1024, 256, nb - 64, bid - 64); S.A2 = (const char*)(ws + O_XATO); S.B2 = (const char*)(ws + O_WCT); S.G = nb - 64; S.c = bid - 64;
      EpiGate2 E{gates, part}; pg::gemm_phase<EpiGate2, GateOrder, false, true, true, true>(lds, 256, S, E); }
  }
}

DI void phase4(const Params& p, int bid, int nb) {
  int tid = threadIdx.x; asm volatile("" : "+v"(tid));
  const int lane = tid & 63, wave = tid >> 6, fr = lane & 15, fq = lane >> 4;
  unsigned char* ws = p.ws;
  for (int it = bid; it < 512; it += nb) {
    const int item = it * 2 + (wave >> 2), tt = wave & 3;
    const int h = item & 3, cn = item >> 2;
    const size_t trow = (size_t)cn * 64 + 16 * tt + fr;
    const bf16_t* qp = (const bf16_t*)(ws + O_QP) + (size_t)item * 8192 + (16 * tt + fr) * 128;
    const bf16_t* st = (const bf16_t*)(ws + O_ST) + (size_t)item * 16384;
    const bf16_t* o0 = (const bf16_t*)(ws + O_O0) + trow * 512 + h * 128;
    bf16x8 af[4];
#pragma unroll
    for (int ks = 0; ks < 4; ++ks) af[ks] = ldfrag(qp + 32 * ks + 8 * fq);
    f32x4 acc[8];
    float ss = 0.f;
    bf16x8 sf[8][4]; u32x2 o0v[8];
#pragma unroll
    for (int j = 0; j < 8; ++j) {
      o0v[j] = *(const u32x2*)(o0 + 16 * j + 4 * fq);
#pragma unroll
      for (int ks = 0; ks < 4; ++ks) sf[j][ks] = ldfrag(st + (16 * j + fr) * 128 + 32 * ks + 8 * fq);
    }
    __builtin_amdgcn_sched_barrier(0);
#pragma unroll
    for (int j = 0; j < 8; ++j) {
      f32x4 a = {lo2f(o0v[j][0]), hi2f(o0v[j][0]), lo2f(o0v[j][1]), hi2f(o0v[j][1])};
#pragma unroll
      for (int ks = 0; ks < 4; ++ks) a = mfma16(sf[j][ks], af[ks], a);
      acc[j] = a;
      ss += a[0] * a[0] + a[1] * a[1] + a[2] * a[2] + a[3] * a[3];
    }
    ss += __shfl_xor(ss, 16); ss += __shfl_xor(ss, 32);
    const float rms = rsqrtf(ss * (1.f / 128.f) + 1e-6f);
    const float* ng = p.in[I_GNG];
    const bf16_t* zs = (const bf16_t*)(ws + O_ZS) + trow * 512 + h * 128;
    unsigned char* out8 = ws + O_GDNO + trow * 512 + h * 128;
#pragma unroll
    for (int j = 0; j < 8; ++j) {
      const int e0 = 16 * j + 4 * fq;
      const f32x4 g = *(const f32x4*)(ng + e0);
      const u32x2 z = *(const u32x2*)(zs + e0);
      f32x4 o = {acc[j][0] * rms * g[0] * lo2f(z[0]), acc[j][1] * rms * g[1] * hi2f(z[0]), acc[j][2] * rms * g[2] * lo2f(z[1]), acc[j][3] * rms * g[3] * hi2f(z[1])};
      { unsigned w_ = 0u; w_ = __builtin_amdgcn_cvt_pk_fp8_f32(o[0], o[1], w_, false); w_ = __builtin_amdgcn_cvt_pk_fp8_f32(o[2], o[3], w_, true); *(unsigned*)(out8 + e0) = w_; }
    }
  }
}

DI void phase5(const Params& p, unsigned char* smem, int bid, int nb) {
  unsigned char* ws = p.ws;
  PG_LAS unsigned char* lds = (PG_LAS unsigned char*)smem;
  __syncthreads();
  pg::DenseOrder S; S.init(ws + O_GDNO, ws + O_WAT, T, 1024, 256, nb, bid);
  EpiGate E{ws + O_GATES, 0, (const bf16_t*)(ws + O_PART), (bf16_t*)(ws + O_MERGED), true, 0.015625f};
  pg::gemm_phase<EpiGate, pg::DenseOrder, false, true, true>(lds, 256, S, E);
}
struct EpiX1 {
  const float* x; bf16_t* x1;
  DI void operator()(const f32x4 (&acc)[2][2][4][2], const pg::Unit& u, int wr, int wc, int fr, int fq) const {
#pragma unroll
    for (int ai = 0; ai < 2; ++ai)
#pragma unroll
      for (int m = 0; m < 4; ++m) {
        const size_t row = (size_t)u.pm * 256 + 128 * ai + 64 * wr + 16 * m + fr;
#pragma unroll
        for (int bj = 0; bj < 2; ++bj)
#pragma unroll
          for (int n = 0; n < 2; ++n) {
            const int col = u.pn * 256 + 128 * bj + 32 * wc + 16 * n + 4 * fq;
            const f32x4 v = acc[ai][bj][m][n] * 0.015625f;
            const f32x4 xv = *(const f32x4*)(x + row * 1024 + col);
            f32x4 o = {ALPHA * xv[0] + v[0], ALPHA * xv[1] + v[1], ALPHA * xv[2] + v[2], ALPHA * xv[3] + v[3]};
            *(u32x2*)(x1 + row * 1024 + col) = pack4(o);
          }
      }
  }
};
DI void phase6(const Params& p, unsigned char* smem, int bid, int nb) {
  unsigned char* ws = p.ws;
  PG_LAS unsigned char* lds = (PG_LAS unsigned char*)smem;
  __syncthreads();
  pg::DenseOrder S; S.init(ws + O_MERGED, ws + O_WOT, T, 1024, 512, nb, bid);
  EpiX1 E{p.in[I_X], (bf16_t*)(ws + O_X1)};
  pg::gemm_phase<EpiX1, pg::DenseOrder, false, false, true>(lds, 512, S, E);
}

DI void ln_row(const float* src, const float* g, const float* b, float (&v)[16], int lane) {
  float s = 0.f;
#pragma unroll
  for (int i = 0; i < 16; ++i) s += v[i];
  const float mean = wave_sum(s) * (1.f / 1024.f);
  float q = 0.f;
#pragma unroll
  for (int i = 0; i < 16; ++i) { const float d = v[i] - mean; q += d * d; }
  const float rstd = rsqrtf(wave_sum(q) * (1.f / 1024.f) + 1e-5f);
#pragma unroll
  for (int i = 0; i < 4; ++i) {
    const int k = 256 * i + 4 * lane;
    const f32x4 gg = *(const f32x4*)(g + k), bb = *(const f32x4*)(b + k);
#pragma unroll
    for (int c = 0; c < 4; ++c) v[4 * i + c] = (v[4 * i + c] - mean) * rstd * gg[c] + bb[c];
  }
}
DI void phase7(const Params& p, int bid, int nb) {
  int tid = threadIdx.x; asm volatile("" : "+v"(tid));
  const int lane = tid & 63, wave = tid >> 6;
  unsigned char* ws = p.ws;
  const bf16_t* x1 = (const bf16_t*)(ws + O_X1);
  bf16_t* x1b = (bf16_t*)(ws + O_X1B);
  for (int row = bid * 8 + wave; row < T; row += nb * 8) {
    float v[16];
#pragma unroll
    for (int i = 0; i < 4; ++i) { const u32x2 t = *(const u32x2*)(x1 + (size_t)row * D + 256 * i + 4 * lane); v[4 * i] = lo2f(t[0]); v[4 * i + 1] = hi2f(t[0]); v[4 * i + 2] = lo2f(t[1]); v[4 * i + 3] = hi2f(t[1]); }
    ln_row(nullptr, p.in[I_LN1G], p.in[I_LN1B], v, lane);
#pragma unroll
    for (int i = 0; i < 4; ++i) {
      const f32x4 o = {v[4 * i], v[4 * i + 1], v[4 * i + 2], v[4 * i + 3]};
      *(u32x2*)(x1b + (size_t)row * D + 256 * i + 4 * lane) = pack4(o);
      { unsigned w_ = 0u; w_ = __builtin_amdgcn_cvt_pk_fp8_f32(o[0], o[1], w_, false); w_ = __builtin_amdgcn_cvt_pk_fp8_f32(o[2], o[3], w_, true); *(unsigned*)(ws + O_X1Q + (size_t)row * D + 256 * i + 4 * lane) = w_; }
    }
  }
}
struct EpiLogits {
  float* logits;
  DI void operator()(const f32x4 (&acc)[2][2][4][2], const pg::Unit& u, int wr, int wc, int fr, int fq) const {
#pragma unroll
    for (int ai = 0; ai < 2; ++ai)
#pragma unroll
      for (int m = 0; m < 4; ++m) {
        const size_t row = (size_t)u.pm * 256 + 128 * ai + 64 * wr + 16 * m + fr;
#pragma unroll
        for (int bj = 0; bj < 2; ++bj)
#pragma unroll
          for (int n = 0; n < 2; ++n) *(f32x4*)(logits + row * 256 + 128 * bj + 32 * wc + 16 * n + 4 * fq) = acc[ai][bj][m][n];
      }
  }
};
DI void phase8(const Params& p, unsigned char* smem, int bid, int nb);
DI void phase9(const Params& p, unsigned char* smem, int bid, int nb) {
  int tid = threadIdx.x; asm volatile("" : "+v"(tid));
  const int lane = tid & 63, wave = tid >> 6;
  unsigned char* ws = p.ws;
  const float* logits = (const float*)(ws + O_LOGITS);
  int* counts = (int*)(ws + O_CTRL);
  const int g = lane & 7, tsub = lane >> 3;
  const float NEG = -__builtin_inff();
  float bias[32];
#pragma unroll
  for (int j4 = 0; j4 < 8; ++j4) { const f32x4 b4 = *(const f32x4*)(p.in[I_RB] + 32 * g + 4 * j4); bias[4 * j4] = b4[0]; bias[4 * j4 + 1] = b4[1]; bias[4 * j4 + 2] = b4[2]; bias[4 * j4 + 3] = b4[3]; }
  int* hist = (int*)smem; int* hbase = hist + 256;
  for (int tok0 = (bid * 8 + wave) * 8; tok0 - wave * 8 < T; tok0 += nb * 64) {
    __syncthreads();
    if (tid < 256) hist[tid] = 0;
    __syncthreads();
    const bool live = tok0 < T;
    const int tok = live ? tok0 + tsub : 0;
    float sc[32], bz[32];
#pragma unroll
    for (int j4 = 0; j4 < 8; ++j4) {
      const f32x4 l4 = *(const f32x4*)(logits + (size_t)tok * 256 + 32 * g + 4 * j4);
#pragma unroll
      for (int c = 0; c < 4; ++c) { sc[4 * j4 + c] = sigmoidf_(l4[c]); bz[4 * j4 + c] = sc[4 * j4 + c] + bias[4 * j4 + c]; }
    }
    float m1 = NEG, m2 = NEG;
#pragma unroll
    for (int j = 0; j < 32; ++j) { const float v = bz[j]; if (v > m1) { m2 = m1; m1 = v; } else if (v > m2) m2 = v; }
    const float gs = m1 + m2;
    int rank = 0;
#pragma unroll
    for (int gg = 0; gg < 8; ++gg) { const float og = __shfl(gs, (lane & ~7) | gg); rank += ((og > gs) || (og == gs && gg < g)) ? 1 : 0; }
    if (rank >= 4) {
#pragma unroll
      for (int j = 0; j < 32; ++j) bz[j] = NEG;
    }
    int myidx = 0; float mysc = 0.f, ssum = 0.f;
#pragma unroll 1
    for (int k = 0; k < 8; ++k) {
      float bv = bz[0], bs = sc[0]; int bi = 0;
#pragma unroll
      for (int j = 1; j < 32; ++j) if (bz[j] > bv) { bv = bz[j]; bi = j; bs = sc[j]; }
      float rv = bv, rs = bs; int ri = 32 * g + bi;
#pragma unroll
      for (int o = 1; o < 8; o <<= 1) {
        const float ov = __shfl_xor(rv, o), os = __shfl_xor(rs, o); const int oi = __shfl_xor(ri, o);
        if (ov > rv || (ov == rv && oi < ri)) { rv = ov; ri = oi; rs = os; }
      }
      if ((ri >> 5) == g) {
        const int wj = ri & 31;
#pragma unroll
        for (int j = 0; j < 32; ++j) if (j == wj) bz[j] = NEG;
      }
      ssum += rs;
      if (g == k) { myidx = ri; mysc = rs; }
    }
    int lrank = 0;
    if (live) lrank = atomicAdd(&hist[myidx], 1);
    __syncthreads();
    if (tid < 256) { const int h = hist[tid]; hbase[tid] = h ? atomicAdd(&counts[tid * CSTR], h) : 0; }
    __syncthreads();
    if (live) {
      const int pos = hbase[myidx] + lrank;
      const size_t li = (size_t)myidx * T + pos;
      ((int*)(ws + O_LTOK))[li] = tok;
      ((int*)(ws + O_LAID))[li] = tok * 8 + g;
      ((float*)(ws + O_LW))[li] = mysc / ssum * 2.5f;
    }
  }
}
DI void build_tile_start(const Params& p, int* ts, unsigned short* cnt16) {
  const int tid = threadIdx.x;
  const int* counts = (const int*)(p.ws + O_CTRL);
  __syncthreads();
  if (tid < 256) { const int c_ = counts[tid * CSTR]; ts[300 + tid] = (c_ + MOE_BM - 1) / MOE_BM; cnt16[tid] = (unsigned short)c_; }
  __syncthreads();
  if (tid == 0) { int s = 0; for (int e = 0; e < 256; ++e) { ts[e] = s; s += ts[300 + e]; } ts[256] = s; }
  __syncthreads();
}
DI void phase10(const Params& p, unsigned char* smem, int bid, int nb) {
  int* ts = (int*)smem;
  build_tile_start(p, ts, (unsigned short*)(smem + 4096));
  unsigned char* ws = p.ws;
  const int* tkidx = (const int*)(ws + O_TKIDX); const int* tkpos = (const int*)(ws + O_TKPOS); const float* tkw = (const float*)(ws + O_TKW);
  int* slottok = (int*)(ws + O_SLOTTOK); float* slotw = (float*)(ws + O_SLOTW); int* slotaid = (int*)(ws + O_SLOTAID);
  for (int i = bid * NTHR + threadIdx.x; i < T * 8; i += nb * NTHR) {
    const int e = tkidx[i];
    const int slot = ts[e] * MOE_BM + tkpos[i];
    slottok[slot] = i >> 3; slotw[slot] = tkw[i]; slotaid[slot] = i;
  }
}

DI int find_expert(const int* ts, int ti) { int lo = 0, hi = 255; while (lo < hi) { const int mid = (lo + hi + 1) >> 1; if (ts[mid] <= ti) lo = mid; else hi = mid - 1; } return lo; }

struct MoeUpF {
  const int* ts; unsigned char* ws; const float* wg; const float* wu; const float* wsg; const float* wsu; int ntile, G, c; int var; const unsigned short* cnt16;
  DI bool next(int i, UnitF& u) const {
    const int L = i * G + (((G & 7) == 0) ? (c & 7) * (G >> 3) + (c >> 3) : c);
    if (L >= ntile * 2) {
      const int r = L - ntile * 2; if (r >= 256 || !wsg) return false;
      const int pn = r >> 7, ti = r & 127;
      u.A = (const bf16_t*)(ws + O_X1B); u.rows = nullptr; u.m0 = ti * 128; u.pn = pn; u.e = 256; u.sbase = 0; u.valid = 256;
      u.W0 = wsg + 128 * pn; u.W1 = wsu + 128 * pn;
      return true;
    }
    const int ti = L >> 1, pn = L & 1;
    const int e = find_expert(ts, ti);
    { const int t_ = ti - ts[e]; const int v_ = (int)cnt16[e] - t_ * MOE_BM; u.sbase = e * T + t_ * MOE_BM; u.valid = v_ < MOE_BM ? v_ : MOE_BM; }
    u.A = (const bf16_t*)(ws + O_X1Q); u.rows = (const int*)(ws + O_LTOK) + u.sbase; u.m0 = ti * MOE_BM; u.pn = pn; u.e = e;
    u.W0 = wg + (size_t)e * 262144 + 128 * pn; u.W1 = wu + (size_t)e * 262144 + 128 * pn;
    return true;
  }
};
struct MoeDownF {
  const int* ts; unsigned char* ws; const float* wd; const float* wsd; int ntile, G, c; const unsigned short* cnt16;
  DI bool next(int i, UnitF& u) const {
    const int L = i * G + (((G & 7) == 0) ? (c & 7) * (G >> 3) + (c >> 3) : c);
    if (L >= ntile * 4) {
      const int r = L - ntile * 4; if (r >= 512 || !wsd) return false;
      const int pn = r >> 7, ti = r & 127;
      u.A = (const bf16_t*)(ws + O_ACTSH); u.rows = nullptr; u.m0 = ti * 128; u.pn = pn; u.e = 256; u.sbase = 0; u.valid = 256;
      u.W0 = wsd + 256 * pn; u.W1 = u.W0 + 128;
      return true;
    }
    const int ti = L >> 2, pn = L & 3;
    const int e = find_expert(ts, ti);
    { const int t_ = ti - ts[e]; const int v_ = (int)cnt16[e] - t_ * MOE_BM; u.sbase = e * T + t_ * MOE_BM; u.valid = v_ < MOE_BM ? v_ : MOE_BM; }
    u.A = (const bf16_t*)(ws + O_ACT); u.rows = nullptr; u.m0 = ti * MOE_BM; u.pn = pn; u.e = e;
    u.W0 = wd + (size_t)e * 262144 + 256 * pn; u.W1 = u.W0 + 128;
    return true;
  }
};
struct EpiActF {
  bf16_t* actp; bf16_t* actsh;
  struct Pre { int dummy; };
  DI void prefetch(const UnitF&, int, int, Pre& p) const { p.dummy = 0; }
  DI void operator()(const f32x4 (&acc)[4][4], const UnitF& u, int wr, int wc, int fr, int fq, const Pre&, unsigned char* xch) const {
    if (wc >= 2) {
#pragma unroll
      for (int m = 0; m < 4; ++m) {
        unsigned char* dst = xch + (64 * wr + 16 * m + fr) * 256 + (((8 * (wc & 1) + 2 * fq) ^ (2 * (fr & 7))) << 4);
        u32x4 o0 = {pk2(acc[m][0][0], acc[m][1][0]), pk2(acc[m][2][0], acc[m][3][0]), pk2(acc[m][0][1], acc[m][1][1]), pk2(acc[m][2][1], acc[m][3][1])};
        u32x4 o1 = {pk2(acc[m][0][2], acc[m][1][2]), pk2(acc[m][2][2], acc[m][3][2]), pk2(acc[m][0][3], acc[m][1][3]), pk2(acc[m][2][3], acc[m][3][3])};
        *(u32x4*)dst = o0; *(u32x4*)(dst + 16) = o1;
      }
    }
    asm volatile("s_waitcnt lgkmcnt(0)" ::: "memory"); __builtin_amdgcn_s_barrier(); asm volatile("" ::: "memory");
    if (wc < 2) {
#pragma unroll
      for (int m = 0; m < 4; ++m) {
        const unsigned char* srcp = xch + (64 * wr + 16 * m + fr) * 256 + (((8 * wc + 2 * fq) ^ (2 * (fr & 7))) << 4);
        const u32x4 u0 = *(const u32x4*)srcp, u1 = *(const u32x4*)(srcp + 16);
        const size_t row = (size_t)u.m0 + 64 * wr + 16 * m + fr;
        u32x4 o0, o1;
#pragma unroll
        for (int r = 0; r < 2; ++r) {
          o0[2 * r] = pk2(siluf_(acc[m][0][r]) * lo2f(u0[2 * r]), siluf_(acc[m][1][r]) * hi2f(u0[2 * r]));
          o0[2 * r + 1] = pk2(siluf_(acc[m][2][r]) * lo2f(u0[2 * r + 1]), siluf_(acc[m][3][r]) * hi2f(u0[2 * r + 1]));
          o1[2 * r] = pk2(siluf_(acc[m][0][2 + r]) * lo2f(u1[2 * r]), siluf_(acc[m][1][2 + r]) * hi2f(u1[2 * r]));
          o1[2 * r + 1] = pk2(siluf_(acc[m][2][2 + r]) * lo2f(u1[2 * r + 1]), siluf_(acc[m][3][2 + r]) * hi2f(u1[2 * r + 1]));
        }
        bf16_t* dst = (u.e == 256 ? actsh : actp) + row * 256 + 128 * u.pn + 64 * wc + 16 * fq;
        *(u32x4*)dst = o0; *(u32x4*)(dst + 8) = o1;
      }
    }
    asm volatile("s_waitcnt lgkmcnt(0)" ::: "memory"); __builtin_amdgcn_s_barrier(); asm volatile("" ::: "memory");
  }
};
struct EpiDownF {
  const int* slotaid; const float* slotw; unsigned char* ybase; bf16_t* ysh;
  struct Pre { int aid[4]; float ww[4]; };
  DI void prefetch(const UnitF& u, int wr, int fr, Pre& p) const {
    const unsigned slot0 = (unsigned)u.m0 + 64u * wr + fr;
    if (u.e == 256) {
#pragma unroll
      for (int m = 0; m < 4; ++m) { p.aid[m] = (int)(slot0 + 16u * m); p.ww[m] = 1.f; }
    } else {
#pragma unroll
      for (int m = 0; m < 4; ++m) { p.aid[m] = slotaid[slot0 + 16u * m]; p.ww[m] = slotw[slot0 + 16u * m]; }
    }
  }
  DI void operator()(const f32x4 (&acc)[4][4], const UnitF& u, int wr, int wc, int fr, int fq, const Pre& p, unsigned char*) const {
    const unsigned colb = (unsigned)u.pn * 256u + 64u * wc + 16u * fq;
    if (u.e == 256) {
#pragma unroll
      for (int m = 0; m < 4; ++m) {
        bf16_t* dst = ysh + (size_t)p.aid[m] * 1024 + colb;
        u32x4 o0 = {pk2(acc[m][0][0], acc[m][1][0]), pk2(acc[m][2][0], acc[m][3][0]), pk2(acc[m][0][1], acc[m][1][1]), pk2(acc[m][2][1], acc[m][3][1])};
        u32x4 o1 = {pk2(acc[m][0][2], acc[m][1][2]), pk2(acc[m][2][2], acc[m][3][2]), pk2(acc[m][0][3], acc[m][1][3]), pk2(acc[m][2][3], acc[m][3][3])};
        *(u32x4*)dst = o0; *(u32x4*)(dst + 8) = o1;
      }
      return;
    }
#pragma unroll
    for (int m = 0; m < 4; ++m) {
      if (p.aid[m] >= 0) {
        const unsigned off = (unsigned)p.aid[m] * 1024u + colb;
        const float sw = p.ww[m] * 64.0f;
        u32x4 o;
#pragma unroll
        for (int r = 0; r < 4; ++r) {
          unsigned w_ = 0u;
          w_ = __builtin_amdgcn_cvt_pk_fp8_f32(acc[m][0][r] * sw, acc[m][1][r] * sw, w_, false);
          w_ = __builtin_amdgcn_cvt_pk_fp8_f32(acc[m][2][r] * sw, acc[m][3][r] * sw, w_, true);
          o[r] = w_;
        }
        *(u32x4*)(ybase + (size_t)off) = o;
      }
    }
  }
};
struct EpiAct {
  bf16_t* actp;
  DI void operator()(const f32x4 (&acc)[2][2][4][2], const pg::Unit& u, int wr, int wc, int fr, int fq) const {
#pragma unroll
    for (int ai = 0; ai < 2; ++ai)
#pragma unroll
      for (int m = 0; m < 4; ++m) {
        const size_t row = (size_t)u.pm * 256 + 128 * ai + 64 * wr + 16 * m + fr;
#pragma unroll
        for (int bj = 0; bj < 2; ++bj) {
          const int blk = 8 * u.pn + 4 * bj + wc;
          const f32x4 g = acc[ai][bj][m][0], uu = acc[ai][bj][m][1];
          f32x4 o = {siluf_(g[0]) * uu[0], siluf_(g[1]) * uu[1], siluf_(g[2]) * uu[2], siluf_(g[3]) * uu[3]};
          *(u32x2*)(actp + row * 256 + blk * 16 + 4 * fq) = pack4(o);
        }
      }
  }
};
struct EpiBf16Out {
  bf16_t* dst;
  DI void operator()(const f32x4 (&acc)[2][2][4][2], const pg::Unit& u, int wr, int wc, int fr, int fq) const {
#pragma unroll
    for (int ai = 0; ai < 2; ++ai)
#pragma unroll
      for (int m = 0; m < 4; ++m) {
        const size_t row = (size_t)u.pm * 256 + 128 * ai + 64 * wr + 16 * m + fr;
#pragma unroll
        for (int bj = 0; bj < 2; ++bj)
#pragma unroll
          for (int n = 0; n < 2; ++n) { const f32x4 v = acc[ai][bj][m][n]; unsigned w_ = 0u; w_ = __builtin_amdgcn_cvt_pk_fp8_f32(64.f * v[0], 64.f * v[1], w_, false); w_ = __builtin_amdgcn_cvt_pk_fp8_f32(64.f * v[2], 64.f * v[3], w_, true);
            *(unsigned*)((unsigned char*)dst + row * 1024 + u.pn * 256 + 128 * bj + 32 * wc + 16 * n + 4 * fq) = w_; }
      }
  }
};
template <class Epi, class Sched>
DI void gemmF2_phase(unsigned char* smem_, const int K, const int lda, const int ldw, const Sched& S, const Epi& E) {
  int tid = threadIdx.x; asm volatile("" : "+v"(tid));
  unsigned char* smem; { LAS unsigned char* l_ = (LAS unsigned char*)smem_; asm volatile("" : "+v"(l_)); smem = (unsigned char*)l_; }
  const int lane = tid & 63, wid = __builtin_amdgcn_readfirstlane(tid >> 6), fr = lane & 15, fq = lane >> 4;
  const int nk = K >> 6;
#define F2_LBAR() do { asm volatile("s_waitcnt lgkmcnt(0)" ::: "memory"); __builtin_amdgcn_s_barrier(); asm volatile("" ::: "memory"); } while (0)
  UnitF cur, nxt; int ui = 0;
  if (!S.next(0, cur)) return;
  bool has_next = S.next(1, nxt);
  if (!has_next) nxt = cur;
  __syncthreads();
  if (wid >= 4) {
    const int lt = tid - 256;
    const int ar = lt >> 3, ac = lt & 7;
    const int q = lt & 63, kg = lt >> 6, half = q >> 5, g0 = 4 * (q & 31);
    int vrow[4];
#pragma unroll
    for (int i = 0; i < 4; ++i) vrow[i] = 64 * (q >> 4) + 16 * i + (q & 15);
    int aw[4];
#pragma unroll
    for (int j = 0; j < 4; ++j) aw[j] = sw128(ar + 32 * j, ac);
    unsigned r[4], nr[4];
#define F2_ROWS(u, rr) do { _Pragma("unroll") for (int j = 0; j < 4; ++j) rr[j] = (u).rows ? (unsigned)(u).rows[ar + 32 * j] : (unsigned)((u).m0 + ar + 32 * j); } while (0)
    F2_ROWS(cur, r);
    if (has_next) F2_ROWS(nxt, nr); else { _Pragma("unroll") for (int j = 0; j < 4; ++j) nr[j] = r[j]; }
#define F2_LOADX(kx, va, vw) do { const bool nx_ = (kx) >= nk; const int kk_ = nx_ ? (kx) - nk : (kx); \
      const bf16_t* A_ = nx_ ? nxt.A : cur.A; const float* W_ = half ? (nx_ ? nxt.W1 : cur.W1) : (nx_ ? nxt.W0 : cur.W0); \
      _Pragma("unroll") for (int j = 0; j < 4; ++j) { const unsigned rr_ = nx_ ? nr[j] : r[j]; va[j] = *(const u32x4*)((const unsigned char*)A_ + (size_t)(rr_ * (unsigned)(lda * 2) + (unsigned)(kk_ * 128 + ac * 16))); } \
      const float* wp_ = W_ + (size_t)(kk_ * 64 + 8 * kg) * ldw + g0; \
      _Pragma("unroll") for (int j = 0; j < 8; ++j) { vw[j] = *(const f32x4*)(wp_ + (size_t)j * ldw); vw[8 + j] = *(const f32x4*)(wp_ + (size_t)(32 + j) * ldw); } } while (0)
#define F2_STORE(st, va, vw) do { unsigned char* sa_ = smem + (st) * 49152; \
      _Pragma("unroll") for (int j = 0; j < 4; ++j) *(u32x4*)(sa_ + aw[j]) = va[j]; \
      _Pragma("unroll") for (int i = 0; i < 4; ++i) { \
        u32x4 o0_ = {pk2(vw[0][i], vw[1][i]), pk2(vw[2][i], vw[3][i]), pk2(vw[4][i], vw[5][i]), pk2(vw[6][i], vw[7][i])}; \
        u32x4 o1_ = {pk2(vw[8][i], vw[9][i]), pk2(vw[10][i], vw[11][i]), pk2(vw[12][i], vw[13][i]), pk2(vw[14][i], vw[15][i])}; \
        *(u32x4*)(sa_ + 16384 + sw128(vrow[i], kg)) = o0_; *(u32x4*)(sa_ + 16384 + sw128(vrow[i], 4 + kg)) = o1_; } } while (0)
    u32x4 xa[4], ya[4]; f32x4 xw[16], yw[16];
    F2_LOADX(0, xa, xw);
    F2_LOADX(1, ya, yw);
    F2_STORE(0, xa, xw);
    F2_LOADX(2, xa, xw);
    F2_LBAR();
    int st = 0;
    for (;;) {
#pragma unroll 1
      for (int kt = 0; kt < nk; kt += 2) {
        F2_STORE(st ^ 1, ya, yw);
        F2_LOADX(kt + 3, ya, yw);
        F2_LBAR();
        F2_STORE(st, xa, xw);
        F2_LOADX(kt + 4, xa, xw);
        F2_LBAR();
      }
#pragma unroll
      for (int eb = 0; eb < Epi::NBAR; ++eb) F2_LBAR();
      if (!has_next) break;
      cur = nxt; ++ui;
#pragma unroll
      for (int j = 0; j < 4; ++j) r[j] = nr[j];
      has_next = S.next(ui + 1, nxt);
      if (has_next) F2_ROWS(nxt, nr); else nxt = cur;
    }
    asm volatile("s_waitcnt vmcnt(0)" ::: "memory");
#undef F2_ROWS
#undef F2_LOADX
#undef F2_STORE
  } else {
    const int wr = wid >> 1, wc = wid & 1;
    f32x4 acc[4][8];
#pragma unroll
    for (int m = 0; m < 4; ++m)
#pragma unroll
      for (int n = 0; n < 8; ++n) acc[m][n] = (f32x4){0.f, 0.f, 0.f, 0.f};
#define F2_COMPUTE(st) do { const unsigned char* sA = smem + (st) * 49152; const unsigned char* sB = sA + 16384; \
      _Pragma("unroll") for (int ks = 0; ks < 2; ++ks) { bf16x8 af[4], bfr[8]; \
        _Pragma("unroll") for (int m = 0; m < 4; ++m) af[m] = ldfrag(sA + sw128(64 * wr + 16 * m + fr, 4 * ks + fq)); \
        _Pragma("unroll") for (int n = 0; n < 8; ++n) bfr[n] = ldfrag(sB + sw128(128 * wc + 16 * n + fr, 4 * ks + fq)); \
        _Pragma("unroll") for (int m = 0; m < 4; ++m) _Pragma("unroll") for (int n = 0; n < 8; ++n) acc[m][n] = mfma16(bfr[n], af[m], acc[m][n]); } } while (0)
    F2_LBAR();
    int st = 0;
    for (;;) {
      typename Epi::Pre pre; E.prefetch(cur, wr, fr, pre);
#pragma unroll 1
      for (int kt = 0; kt < nk; kt += 2) {
        F2_COMPUTE(st);
        F2_LBAR();
        F2_COMPUTE(st ^ 1);
        F2_LBAR();
      }
      E(acc, cur, wr, wc, fr, fq, pre, smem + (st ^ 1) * 49152);
#pragma unroll
      for (int m = 0; m < 4; ++m)
#pragma unroll
        for (int n = 0; n < 8; ++n) acc[m][n] = (f32x4){0.f, 0.f, 0.f, 0.f};
      if (!has_next) break;
      cur = nxt; ++ui;
      has_next = S.next(ui + 1, nxt);
      if (!has_next) nxt = cur;
    }
#undef F2_COMPUTE
  }
  __syncthreads();
#undef F2_LBAR
}
struct EpiActF2 {
  bf16_t* actp;
  static constexpr int NBAR = 2;
  struct Pre { int dummy; };
  DI void prefetch(const UnitF&, int, int, Pre& p) const { p.dummy = 0; }
  DI void operator()(const f32x4 (&acc)[4][8], const UnitF& u, int wr, int wc, int fr, int fq, const Pre&, unsigned char* xch) const {
    if (wc == 1) {
#pragma unroll
      for (int m = 0; m < 4; ++m)
#pragma unroll
        for (int g2 = 0; g2 < 2; ++g2) {
          unsigned char* dst = xch + (64 * wr + 16 * m + fr) * 256 + (((8 * g2 + 2 * fq) ^ (2 * (fr & 7))) << 4);
          const int n0 = 4 * g2;
          u32x4 o0 = {pk2(acc[m][n0][0], acc[m][n0 + 1][0]), pk2(acc[m][n0 + 2][0], acc[m][n0 + 3][0]), pk2(acc[m][n0][1], acc[m][n0 + 1][1]), pk2(acc[m][n0 + 2][1], acc[m][n0 + 3][1])};
          u32x4 o1 = {pk2(acc[m][n0][2], acc[m][n0 + 1][2]), pk2(acc[m][n0 + 2][2], acc[m][n0 + 3][2]), pk2(acc[m][n0][3], acc[m][n0 + 1][3]), pk2(acc[m][n0 + 2][3], acc[m][n0 + 3][3])};
          *(u32x4*)dst = o0; *(u32x4*)(dst + 16) = o1;
        }
    }
    asm volatile("s_waitcnt lgkmcnt(0)" ::: "memory"); __builtin_amdgcn_s_barrier(); asm volatile("" ::: "memory");
    if (wc == 0) {
#pragma unroll
      for (int m = 0; m < 4; ++m)
#pragma unroll
        for (int g2 = 0; g2 < 2; ++g2) {
          const unsigned char* srcp = xch + (64 * wr + 16 * m + fr) * 256 + (((8 * g2 + 2 * fq) ^ (2 * (fr & 7))) << 4);
          const u32x4 u0 = *(const u32x4*)srcp, u1 = *(const u32x4*)(srcp + 16);
          const size_t row = (size_t)u.m0 + 64 * wr + 16 * m + fr;
          const int n0 = 4 * g2;
          u32x4 o0, o1;
#pragma unroll
          for (int r = 0; r < 2; ++r) {
            o0[2 * r] = pk2(siluf_(acc[m][n0][r]) * lo2f(u0[2 * r]), siluf_(acc[m][n0 + 1][r]) * hi2f(u0[2 * r]));
            o0[2 * r + 1] = pk2(siluf_(acc[m][n0 + 2][r]) * lo2f(u0[2 * r + 1]), siluf_(acc[m][n0 + 3][r]) * hi2f(u0[2 * r + 1]));
            o1[2 * r] = pk2(siluf_(acc[m][n0][2 + r]) * lo2f(u1[2 * r]), siluf_(acc[m][n0 + 1][2 + r]) * hi2f(u1[2 * r]));
            o1[2 * r + 1] = pk2(siluf_(acc[m][n0 + 2][2 + r]) * lo2f(u1[2 * r + 1]), siluf_(acc[m][n0 + 3][2 + r]) * hi2f(u1[2 * r + 1]));
          }
          bf16_t* dst = actp + row * 256 + 128 * u.pn + 64 * g2 + 16 * fq;
          *(u32x4*)dst = o0; *(u32x4*)(dst + 8) = o1;
        }
    }
    asm volatile("s_waitcnt lgkmcnt(0)" ::: "memory"); __builtin_amdgcn_s_barrier(); asm volatile("" ::: "memory");
  }
};
struct EpiDownF2 {
  const int* slotaid; const float* slotw; unsigned char* ybase;
  static constexpr int NBAR = 0;
  struct Pre { int aid[4]; float ww[4]; };
  DI void prefetch(const UnitF& u, int wr, int fr, Pre& p) const {
    const unsigned slot0 = (unsigned)u.m0 + 64u * wr + fr;
#pragma unroll
    for (int m = 0; m < 4; ++m) { p.aid[m] = slotaid[slot0 + 16u * m]; p.ww[m] = slotw[slot0 + 16u * m]; }
  }
  DI void operator()(const f32x4 (&acc)[4][8], const UnitF& u, int wr, int wc, int fr, int fq, const Pre& p, unsigned char*) const {
#pragma unroll
    for (int m = 0; m < 4; ++m) {
      if (p.aid[m] >= 0) {
        const float sw = p.ww[m] * 64.0f;
#pragma unroll
        for (int g2 = 0; g2 < 2; ++g2) {
          const unsigned off = (unsigned)p.aid[m] * 1024u + (unsigned)u.pn * 256u + 128u * wc + 64u * g2 + 16u * fq;
          const int n0 = 4 * g2;
          u32x4 o;
#pragma unroll
          for (int r = 0; r < 4; ++r) {
            unsigned w_ = 0u;
            w_ = __builtin_amdgcn_cvt_pk_fp8_f32(acc[m][n0][r] * sw, acc[m][n0 + 1][r] * sw, w_, false);
            w_ = __builtin_amdgcn_cvt_pk_fp8_f32(acc[m][n0 + 2][r] * sw, acc[m][n0 + 3][r] * sw, w_, true);
            o[r] = w_;
          }
          *(u32x4*)(ybase + (size_t)off) = o;
        }
      }
    }
  }
};

template <class Epi, class Sched, int ABL = 0>
DI void gemmF3_phase(unsigned char* smem_, const int K, const int lda, const int ldw, const Sched& S, const Epi& E) {
  int tid = threadIdx.x; asm volatile("" : "+v"(tid));
  unsigned char* smem; { LAS unsigned char* l_ = (LAS unsigned char*)smem_; asm volatile("" : "+v"(l_)); smem = (unsigned char*)l_; }
  const int lane = tid & 63, wid = tid >> 6, wr = wid >> 1, wc = wid & 1, fr = lane & 15, fq = lane >> 4;
  const int nk = K >> 6;
  const int ar = tid >> 3, ac = tid & 7;
  const int q = tid & 63, half = q >> 5, g0 = 4 * (q & 31);
  int vrow[4];
#pragma unroll
  for (int i = 0; i < 4; ++i) vrow[i] = 64 * (q >> 4) + 16 * i + (q & 15);
  int aw[4];
#pragma unroll
  for (int j = 0; j < 4; ++j) aw[j] = sw128(ar + 64 * j, ac);
#define F3_LBAR() do { asm volatile("s_waitcnt lgkmcnt(0)" ::: "memory"); __builtin_amdgcn_s_barrier(); asm volatile("" ::: "memory"); } while (0)
#define F3_ROWS(u, rr) do { _Pragma("unroll") for (int j = 0; j < 4; ++j) rr[j] = (u).rows ? (unsigned)(u).rows[ar + 64 * j] : (unsigned)((u).m0 + ar + 64 * j); } while (0)
#define F3_LOADX(kx) do { const bool nx_ = (kx) >= nk; const int kk_ = nx_ ? (kx) - nk : (kx); \
    const bf16_t* A_ = nx_ ? nxt.A : cur.A; const float* W_ = half ? (nx_ ? nxt.W1 : cur.W1) : (nx_ ? nxt.W0 : cur.W0); \
    _Pragma("unroll") for (int j = 0; j < 4; ++j) { const unsigned rr_ = nx_ ? nr[j] : r[j]; va[j] = *(const u32x4*)((const unsigned char*)A_ + (size_t)(rr_ * (unsigned)(lda * 2) + (unsigned)(kk_ * 128 + ac * 16))); } \
    const float* wp_ = W_ + (size_t)(kk_ * 64 + 8 * wid) * ldw + g0; \
    _Pragma("unroll") for (int j = 0; j < 8; ++j) vw[j] = *(const f32x4*)(wp_ + (size_t)j * ldw); } while (0)
#define F3_STORE(st) do { unsigned char* sa_ = smem + (st) * 65536; \
    _Pragma("unroll") for (int j = 0; j < 4; ++j) *(u32x4*)(sa_ + aw[j]) = va[j]; \
    _Pragma("unroll") for (int i = 0; i < 4; ++i) { \
      u32x4 o_ = {pk2(vw[0][i], vw[1][i]), pk2(vw[2][i], vw[3][i]), pk2(vw[4][i], vw[5][i]), pk2(vw[6][i], vw[7][i])}; \
      *(u32x4*)(sa_ + 32768 + sw128(vrow[i], wid)) = o_; } } while (0)
#define F3_COMPUTE(st) do { const unsigned char* sA = smem + (st) * 65536; const unsigned char* sB = sA + 32768; \
    _Pragma("unroll") for (int ks = 0; ks < 2; ++ks) { bf16x8 af[4]; \
      _Pragma("unroll") for (int m = 0; m < 4; ++m) af[m] = ldfrag(sA + sw128(64 * wr + 16 * m + fr, 4 * ks + fq)); \
      _Pragma("unroll") for (int h2 = 0; h2 < 2; ++h2) { bf16x8 bfr[4]; \
        _Pragma("unroll") for (int n = 0; n < 4; ++n) bfr[n] = ldfrag(sB + sw128(128 * wc + 64 * h2 + 16 * n + fr, 4 * ks + fq)); \
        _Pragma("unroll") for (int m = 0; m < 4; ++m) _Pragma("unroll") for (int n = 0; n < 4; ++n) acc[m][4 * h2 + n] = mfma16(bfr[n], af[m], acc[m][4 * h2 + n]); } } } while (0)
  UnitF cur, nxt; int ui = 0;
  if (!S.next(0, cur)) return;
  unsigned r[4], nr[4];
  F3_ROWS(cur, r);
  bool has_next = S.next(1, nxt);
  if (has_next) F3_ROWS(nxt, nr); else { nxt = cur; _Pragma("unroll") for (int j = 0; j < 4; ++j) nr[j] = r[j]; }
  f32x4 acc[4][8];
#pragma unroll
  for (int m = 0; m < 4; ++m)
#pragma unroll
    for (int n = 0; n < 8; ++n) acc[m][n] = (f32x4){0.f, 0.f, 0.f, 0.f};
  u32x4 va[4]; f32x4 vw[8];
  F3_LOADX(0);
  __syncthreads();
  F3_STORE(0);
  F3_LBAR();
  int st = 0;
  for (;;) {
    typename Epi::Pre pre; E.prefetch(cur, wr, fr, pre);
#pragma unroll 1
    for (int kt = 0; kt < nk; ++kt) {
      F3_LOADX(kt + 1);
      if (ABL != 6) F3_COMPUTE(st);
      if (ABL != 5) F3_STORE(st ^ 1);
      else { asm volatile("s_waitcnt vmcnt(0)" ::: "memory"); _Pragma("unroll") for (int j = 0; j < 4; ++j) asm volatile("" :: "v"(va[j])); _Pragma("unroll") for (int j = 0; j < 8; ++j) asm volatile("" :: "v"(vw[j])); }
      F3_LBAR();
      st ^= 1;
    }
    E(acc, cur, wr, wc, fr, fq, pre, smem + (st ^ 1) * 65536);
#pragma unroll
    for (int m = 0; m < 4; ++m)
#pragma unroll
      for (int n = 0; n < 8; ++n) acc[m][n] = (f32x4){0.f, 0.f, 0.f, 0.f};
    if (!has_next) break;
    cur = nxt; ++ui;
#pragma unroll
    for (int j = 0; j < 4; ++j) r[j] = nr[j];
    has_next = S.next(ui + 1, nxt);
    if (has_next) F3_ROWS(nxt, nr); else nxt = cur;
  }
  asm volatile("s_waitcnt vmcnt(0)" ::: "memory");
  __syncthreads();
#undef F3_LBAR
#undef F3_ROWS
#undef F3_LOADX
#undef F3_STORE
#undef F3_COMPUTE
}

constexpr int F4_WSTG = 32768, F4_ABUF = 3 * F4_WSTG, F4_TS = 147456, F4_META = F4_TS + 1040;
template <bool GATHER, class Epi, class Sched, int ABL = 0>
DI void gemmF4_phase(unsigned char* smem_, const int K, const int lda_bytes, const int ldw, const Sched& S, const Epi& E) {
  int tid = threadIdx.x; asm volatile("" : "+v"(tid));
  PG_LAS unsigned char* lds = (PG_LAS unsigned char*)smem_;
  const int wid = __builtin_amdgcn_readfirstlane(tid >> 6), lane = tid & 63, wr = wid >> 1, wc = wid & 1, fr = lane & 15, fq = lane >> 4;
  const int nk = K >> 5;
  const int arow0 = 32 * wid + (lane >> 2);
  const unsigned acol = (unsigned)(((lane & 3) ^ ((lane >> 4) & 3)) << 4);
  const unsigned woff = (unsigned)(lane >> 5) * (unsigned)(ldw * 4) + (unsigned)((lane & 31) << 4);
  const unsigned abase = (unsigned)F4_ABUF + (unsigned)((64 * wr + fr) * 64 + (fq & 1) * 8);
  const unsigned ap0 = abase + (unsigned)((((fq >> 1)) ^ ((fr >> 2) & 3)) << 4), ap1 = abase + (unsigned)(((2 + (fq >> 1)) ^ ((fr >> 2) & 3)) << 4);
  const unsigned boff = (unsigned)(8 * fq) * 512u + (unsigned)wc * 256u + (unsigned)fr * 16u;
  PG_LAS unsigned char* mtab = lds + F4_META + wid * 1024;
  constexpr int NM = Epi::NMETA + (GATHER ? 1 : 0);
#define F4_WAIT(n) asm volatile("s_waitcnt vmcnt(%0)" :: "n"(n) : "memory")
#define F4_BAR() do { __builtin_amdgcn_s_barrier(); asm volatile("" ::: "memory"); } while (0)
#define F4_META_ISSUE(u, par) do { PG_LAS unsigned char* t_ = mtab + (par) * 512; \
    if (GATHER) __builtin_amdgcn_global_load_lds((const unsigned*)((const unsigned char*)((u).rows + 32 * wid) + (unsigned)((lane & 31) << 2)), (PG_LAS unsigned*)t_, 4, 0, 0); \
    E.meta_issue(u, wr, lane, t_ + (GATHER ? 256 : 0)); } while (0)
#define F4_ROWS(u, rr, par) do { _Pragma("unroll") for (int d = 0; d < 2; ++d) rr[d] = (GATHER ? ((arow0 + 16 * d < (u).valid) ? *(const PG_LAS unsigned*)(mtab + (par) * 512 + ((lane >> 2) + 16 * d) * 4) : 0u) : (unsigned)((u).m0 + arow0 + 16 * d)) * (unsigned)lda_bytes + acol; } while (0)
#define F4_ISSUE_A(u, rr, ch_, ab_) do { if (ABL != 2 && ABL != 4) { \
    const unsigned char* Ab_ = (const unsigned char*)(u).A + (size_t)((ch_) * 64); \
    _Pragma("unroll") for (int d = 0; d < 2; ++d) \
      __builtin_amdgcn_global_load_lds((const unsigned*)(Ab_ + rr[d]), (PG_LAS unsigned*)(lds + F4_ABUF + (ab_) * 16384 + (2 * wid + d) * 1024), 16, 0, 0); } } while (0)
#define F4_ISSUE_W(u, kk_, so_) do { if (ABL != 4) { \
    const float* Wb_ = ((wid >= 4) ? (u).W1 : (u).W0) + (size_t)((kk_) * 32 + 8 * (wid & 3)) * ldw; \
    _Pragma("unroll") for (int j = 0; j < 4; ++j) \
      __builtin_amdgcn_global_load_lds((const unsigned*)((const unsigned char*)(Wb_ + (size_t)(2 * j) * ldw) + woff), (PG_LAS unsigned*)(lds + (so_) + (4 * wid + j) * 1024), 16, 0, 0); } } while (0)
#define F4_COMPUTE(so_, ap_, ISS_) do { if (ABL == 0 || ABL == 4) { bf16x8 af[4], bq[4]; \
    { u32x2 ta_[4]; f32x4 v0[8]; \
      _Pragma("unroll") for (int m = 0; m < 4; ++m) ta_[m] = *(const PG_LAS u32x2*)(lds + (ap_) + m * 1024); \
      _Pragma("unroll") for (int j = 0; j < 8; ++j) v0[j] = *(const PG_LAS f32x4*)(lds + (so_) + boff + j * 512); \
      __builtin_amdgcn_sched_barrier(0); ISS_; __builtin_amdgcn_sched_barrier(0); \
      _Pragma("unroll") for (int m = 0; m < 4; ++m) { \
        const u32x4 a_ = {__builtin_bit_cast(unsigned, __builtin_amdgcn_cvt_scalef32_pk_bf16_fp8(ta_[m][0], 1.0f, false)), __builtin_bit_cast(unsigned, __builtin_amdgcn_cvt_scalef32_pk_bf16_fp8(ta_[m][0], 1.0f, true)), \
                          __builtin_bit_cast(unsigned, __builtin_amdgcn_cvt_scalef32_pk_bf16_fp8(ta_[m][1], 1.0f, false)), __builtin_bit_cast(unsigned, __builtin_amdgcn_cvt_scalef32_pk_bf16_fp8(ta_[m][1], 1.0f, true))}; \
        af[m] = __builtin_bit_cast(bf16x8, a_); } \
      _Pragma("unroll") for (int i = 0; i < 4; ++i) { \
        const u32x4 b_ = {pk2(v0[0][i], v0[1][i]), pk2(v0[2][i], v0[3][i]), pk2(v0[4][i], v0[5][i]), pk2(v0[6][i], v0[7][i])}; bq[i] = __builtin_bit_cast(bf16x8, b_); } } \
    __builtin_amdgcn_sched_barrier(0); \
    f32x4 v1[8]; \
    _Pragma("unroll") for (int j = 0; j < 3; ++j) v1[j] = *(const PG_LAS f32x4*)(lds + (so_) + boff + 16384 + j * 512); \
    __builtin_amdgcn_sched_barrier(0); \
    _Pragma("unroll") for (int i = 0; i < 4; ++i) _Pragma("unroll") for (int m = 0; m < 4; ++m) acc[m][i] = mfma16(bq[i], af[m], acc[m][i]); \
    _Pragma("unroll") for (int j = 3; j < 8; ++j) v1[j] = *(const PG_LAS f32x4*)(lds + (so_) + boff + 16384 + j * 512); \
    __builtin_amdgcn_sched_barrier(0); \
    _Pragma("unroll") for (int i = 0; i < 4; ++i) { \
      const u32x4 b_ = {pk2(v1[0][i], v1[1][i]), pk2(v1[2][i], v1[3][i]), pk2(v1[4][i], v1[5][i]), pk2(v1[6][i], v1[7][i])}; \
      const bf16x8 bf_ = __builtin_bit_cast(bf16x8, b_); \
      _Pragma("unroll") for (int m = 0; m < 4; ++m) acc[m][4 + i] = mfma16(bf_, af[m], acc[m][4 + i]); } } else { ISS_; } } while (0)
#define F4_NEXT_SO() do { so = (so == 2 * F4_WSTG) ? 0 : so + F4_WSTG; } while (0)
#define F4_SO2() (so >= F4_WSTG ? so - F4_WSTG : so + 2 * F4_WSTG)
  UnitF cur, nxt; int ui = 0;
  if (!S.next(0, cur)) return;
  __syncthreads();
  F4_META_ISSUE(cur, 0);
  F4_WAIT(0);
  unsigned r[2], nr[2];
  F4_ROWS(cur, r, 0);
  bool has_next = S.next(1, nxt);
  if (!has_next) nxt = cur;
  f32x4 acc[4][8];
#pragma unroll
  for (int m = 0; m < 4; ++m)
#pragma unroll
    for (int n = 0; n < 8; ++n) acc[m][n] = (f32x4){0.f, 0.f, 0.f, 0.f};
  asm volatile("s_waitcnt lgkmcnt(0)" ::: "memory");
  F4_ISSUE_A(cur, r, 0, 0); F4_ISSUE_W(cur, 0, 0); F4_ISSUE_W(cur, 1, F4_WSTG);
  int so = 0, ab = 0;
  constexpr int NA = (ABL == 2) ? 0 : 2;
  for (;;) {
    const int par = ui & 1;
    F4_META_ISSUE(nxt, par ^ 1);
#pragma unroll 1
    for (int kt = 0; kt < nk - 2; kt += 2) {
      if (kt == 0) { if (ui == 0) F4_WAIT(4 + NM); else F4_WAIT(4 + NM + Epi::NST); } else F4_WAIT(4);
      F4_BAR();
      F4_COMPUTE(so, ap0 + ab * 16384, F4_ISSUE_A(cur, r, (kt >> 1) + 1, ab ^ 1); F4_ISSUE_W(cur, kt + 2, F4_SO2()));
      F4_NEXT_SO();
      if (kt == 0) { if (ui == 0) F4_WAIT(4 + NA + NM); else F4_WAIT(4 + NA + NM + Epi::NST); } else F4_WAIT(4 + NA);
      F4_BAR();
      F4_COMPUTE(so, ap1 + ab * 16384, F4_ISSUE_W(cur, kt + 3, F4_SO2()));
      F4_NEXT_SO();
      ab ^= 1;
    }
    F4_ROWS(nxt, nr, par ^ 1);
    asm volatile("s_waitcnt lgkmcnt(0)" ::: "memory");
    F4_WAIT(4);
    F4_BAR();
    F4_COMPUTE(so, ap0 + ab * 16384, F4_ISSUE_A(nxt, nr, 0, ab ^ 1); F4_ISSUE_W(nxt, 0, F4_SO2()));
    F4_NEXT_SO();
    F4_WAIT(4 + NA);
    F4_BAR();
    F4_COMPUTE(so, ap1 + ab * 16384, F4_ISSUE_W(nxt, 1, F4_SO2()));
    F4_NEXT_SO();
    ab ^= 1;
    E(acc, cur, wr, wc, fr, fq, mtab + par * 512 + (GATHER ? 256 : 0));
#pragma unroll
    for (int m = 0; m < 4; ++m)
#pragma unroll
      for (int n = 0; n < 8; ++n) acc[m][n] = (f32x4){0.f, 0.f, 0.f, 0.f};
    if (!has_next) break;
    cur = nxt; ++ui; r[0] = nr[0]; r[1] = nr[1];
    has_next = S.next(ui + 1, nxt);
    if (!has_next) nxt = cur;
  }
  F4_WAIT(0);
  __syncthreads();
#undef F4_WAIT
#undef F4_BAR
#undef F4_META_ISSUE
#undef F4_ROWS
#undef F4_ISSUE_A
#undef F4_ISSUE_W
#undef F4_COMPUTE
#undef F4_NEXT_SO
#undef F4_SO2
}
struct EpiActF4 {
  unsigned char* actp;
  static constexpr int NMETA = 0, NST = 4;
  DI void meta_issue(const UnitF&, int, int, PG_LAS unsigned char*) const {}
  DI void operator()(const f32x4 (&acc)[4][8], const UnitF& u, int wr, int wc, int fr, int fq, const PG_LAS unsigned char*) const {
#pragma unroll
    for (int m = 0; m < 4; ++m) {
      const size_t row = (size_t)u.m0 + 64 * wr + 16 * m + fr;
      u32x4 o;
#pragma unroll
      for (int r = 0; r < 4; ++r) {
        float pv[4];
#pragma unroll
        for (int i = 0; i < 4; ++i) pv[i] = __builtin_fminf(__builtin_fmaxf(8.0f * siluf_(acc[m][i][r]) * acc[m][4 + i][r], -448.0f), 448.0f);
        unsigned w_ = 0u;
        w_ = __builtin_amdgcn_cvt_pk_fp8_f32(pv[0], pv[1], w_, false);
        w_ = __builtin_amdgcn_cvt_pk_fp8_f32(pv[2], pv[3], w_, true);
        o[r] = w_;
      }
      *(u32x4*)(actp + row * 256 + 128 * u.pn + 64 * wc + 16 * fq) = o;
    }
  }
};
struct EpiDownF4 {
  const int* slotaid; const float* slotw; unsigned char* ybase;
  static constexpr int NMETA = 2, NST = 8;
  DI void meta_issue(const UnitF& u, int wr, int lane, PG_LAS unsigned char* t) const {
    const unsigned slot = (unsigned)u.sbase + 64u * wr + lane;
    __builtin_amdgcn_global_load_lds((const unsigned*)(slotaid + slot), (PG_LAS unsigned*)t, 4, 0, 0);
    __builtin_amdgcn_global_load_lds((const unsigned*)(slotw + slot), (PG_LAS unsigned*)(t + 256), 4, 0, 0);
  }
  DI void operator()(const f32x4 (&acc)[4][8], const UnitF& u, int wr, int wc, int fr, int fq, const PG_LAS unsigned char* t) const {
#pragma unroll
    for (int m = 0; m < 4; ++m) {
      const int aid = (64 * wr + fr + 16 * m < u.valid) ? *(const PG_LAS int*)(t + (fr + 16 * m) * 4) : -1;
      const float sw = *(const PG_LAS float*)(t + 256 + (fr + 16 * m) * 4) * 8.0f;
      const unsigned arow = aid >= 0 ? (unsigned)aid : (unsigned)(T * 8);
#pragma unroll
      for (int g2 = 0; g2 < 2; ++g2) {
        const unsigned off = arow * 1024u + (unsigned)u.pn * 256u + 128u * g2 + 64u * wc + 16u * fq;
        const int n0 = 4 * g2;
        u32x4 o;
#pragma unroll
        for (int r = 0; r < 4; ++r) {
          unsigned w_ = 0u;
          w_ = __builtin_amdgcn_cvt_pk_fp8_f32(acc[m][n0][r] * sw, acc[m][n0 + 1][r] * sw, w_, false);
          w_ = __builtin_amdgcn_cvt_pk_fp8_f32(acc[m][n0 + 2][r] * sw, acc[m][n0 + 3][r] * sw, w_, true);
          o[r] = w_;
        }
        *(u32x4*)(ybase + (size_t)off) = o;
      }
    }
  }
};

struct RouterF {
  unsigned char* ws; const float* rw; int G, c;
  DI bool next(int i, UnitF& u) const {
    const int L = i * G + c; if (L >= 128) return false;
    u.A = (const bf16_t*)(ws + O_X1B); u.rows = nullptr; u.m0 = L * 128; u.pn = 0; u.e = 0; u.sbase = 0; u.valid = 256; u.W0 = rw; u.W1 = rw + 128; return true;
  }
};
struct EpiLogitsF {
  float* logits;
  struct Pre { int dummy; };
  DI void prefetch(const UnitF&, int, int, Pre& p) const { p.dummy = 0; }
  DI void operator()(const f32x4 (&acc)[4][4], const UnitF& u, int wr, int wc, int fr, int fq, const Pre&, unsigned char*) const {
#pragma unroll
    for (int m = 0; m < 4; ++m) {
      float* dst = logits + ((size_t)u.m0 + 64 * wr + 16 * m + fr) * 256 + 64 * wc + 16 * fq;
#pragma unroll
      for (int r = 0; r < 4; ++r) { const f32x4 o = {acc[m][0][r], acc[m][1][r], acc[m][2][r], acc[m][3][r]}; *(f32x4*)(dst + 4 * r) = o; }
    }
  }
};
struct P8Order {
  const char* x1b; const char* rout; const char* wsgu; int G, c;
  DI bool next(int i, pg::Unit& u) const {
    const int L = i * G + c; if (L >= 192) return false;
    u.rows = nullptr;
    if (L < 64) { u.pm = L; u.pn = 0; u.e = 0; u.a = x1b + (size_t)L * 524288; u.b = rout; }
    else { const int r = L - 64; u.pm = r >> 1; u.pn = r & 1; u.e = 1; u.a = x1b + (size_t)u.pm * 524288; u.b = wsgu + (size_t)u.pn * 524288; }
    return true;
  }
};
struct EpiP8 {
  EpiLogits a; EpiAct b;
  DI void operator()(const f32x4 (&acc)[2][2][4][2], const pg::Unit& u, int wr, int wc, int fr, int fq) const {
    asm volatile("" : "+v"(fr), "+v"(fq));
    if (u.e) b(acc, u, wr, wc, fr, fq); else a(acc, u, wr, wc, fr, fq);
  }
};
DI void phase8(const Params& p, unsigned char* smem, int bid, int nb) {
  unsigned char* ws = p.ws;
  PG_LAS unsigned char* lds = (PG_LAS unsigned char*)smem;
  __syncthreads();
  P8Order S{(const char*)(ws + O_X1B), (const char*)(ws + O_ROUT), (const char*)(ws + O_WSGU), nb, bid};
  EpiP8 E{EpiLogits{(float*)(ws + O_LOGITS)}, EpiAct{(bf16_t*)(ws + O_ACTSH)}};
  pg::gemm_phase<EpiP8, P8Order, false, false>(lds, 1024, S, E);
}
DI void phase11(const Params& p, unsigned char* smem, int bid, int nb, int var = 0) {
  unsigned char* ws = p.ws;
  int* ts = (int*)(smem + F4_TS);
  unsigned short* cnt16 = (unsigned short*)(smem + CNT16_OFF);
  build_tile_start(p, ts, cnt16);
  MoeUpF S{ts, ws, p.in[I_WG], p.in[I_WU], nullptr, nullptr, ts[256], nb, bid, var, cnt16};
  if (var >= 7) { EpiActF4 E2x{ws + O_Y}; gemmF4_phase<true, EpiActF4, MoeUpF, (SHADOW11 >= 7 ? SHADOW11 - 6 : 1)>(smem, 1024, 1024, 256, S, E2x); }
  else { EpiActF4 E2x{ws + (var ? O_Y : O_ACT)}; gemmF4_phase<true, EpiActF4, MoeUpF>(smem, 1024, 1024, 256, S, E2x); }
}
DI void phase12(const Params& p, unsigned char* smem, int bid, int nb) {
  unsigned char* ws = p.ws;
  int* ts = (int*)(smem + F4_TS);
  unsigned short* cnt16 = (unsigned short*)(smem + CNT16_OFF);
  build_tile_start(p, ts, cnt16);
  MoeDownF S{ts, ws, p.in[I_WDN], nullptr, ts[256], nb, bid, cnt16};

  { EpiDownF4 E2x{(const int*)(ws + O_LAID), (const float*)(ws + O_LW), ws + O_Y}; gemmF4_phase<false, EpiDownF4, MoeDownF>(smem, 256, 256, 1024, S, E2x); }
  __syncthreads();
  PG_LAS unsigned char* lds = (PG_LAS unsigned char*)smem;
  { pg::DenseOrder S2; S2.init(ws + O_ACTSH, ws + O_WSD, T, 1024, 256, nb, bid); EpiBf16Out E2{(bf16_t*)(ws + O_YSH)}; pg::gemm_phase<EpiBf16Out, pg::DenseOrder, false, true>(lds, 256, S2, E2); }
}
DI void phase13(const Params& p, int bid, int nb) {
  int tid = threadIdx.x; asm volatile("" : "+v"(tid));
  const int lane = tid & 63, wave = tid >> 6;
  unsigned char* ws = p.ws;
  const bf16_t* x1b = (const bf16_t*)(ws + O_X1B);
  const bf16_t* ysh = (const bf16_t*)(ws + O_YSH);
  const unsigned char* y8 = ws + O_Y;
  for (int row = bid * 8 + wave; row < T; row += nb * 8) {
    float v[16];
#pragma unroll
    for (int i = 0; i < 4; ++i) {
      const int k = 256 * i + 4 * lane;
      const u32x2 t = *(const u32x2*)(x1b + (size_t)row * D + k);
      v[4 * i] = ALPHA * lo2f(t[0]); v[4 * i + 1] = ALPHA * hi2f(t[0]); v[4 * i + 2] = ALPHA * lo2f(t[1]); v[4 * i + 3] = ALPHA * hi2f(t[1]);
    }
    float rs[16];
#pragma unroll
    for (int i = 0; i < 4; ++i) {
      const unsigned s = *(const unsigned*)((const unsigned char*)ysh + (size_t)row * 1024 + 256 * i + 4 * lane);
      const f32x2_ lo = __builtin_amdgcn_cvt_pk_f32_fp8(s, false), hi = __builtin_amdgcn_cvt_pk_f32_fp8(s, true);
      rs[4 * i] = lo[0]; rs[4 * i + 1] = lo[1]; rs[4 * i + 2] = hi[0]; rs[4 * i + 3] = hi[1];
    }
#pragma unroll
    for (int k8 = 0; k8 < 8; ++k8) {
#pragma unroll
      for (int i = 0; i < 4; ++i) {
        const unsigned s = *(const unsigned*)(y8 + ((size_t)row * 8 + k8) * 1024 + 256 * i + 4 * lane);
        const f32x2_ lo = __builtin_amdgcn_cvt_pk_f32_fp8(s, false), hi = __builtin_amdgcn_cvt_pk_f32_fp8(s, true);
        rs[4 * i] += lo[0]; rs[4 * i + 1] += lo[1]; rs[4 * i + 2] += hi[0]; rs[4 * i + 3] += hi[1];
      }
    }
#pragma unroll
    for (int i = 0; i < 16; ++i) v[i] += rs[i] * (1.0f / 64.0f);
    ln_row(nullptr, p.in[I_LN2G], p.in[I_LN2B], v, lane);
#pragma unroll
    for (int i = 0; i < 4; ++i) { const f32x4 o = {v[4 * i], v[4 * i + 1], v[4 * i + 2], v[4 * i + 3]}; *(f32x4*)(p.out + (size_t)row * D + 256 * i + 4 * lane) = o; }
  }
}

DI void load_params(Params& lp, const unsigned char* smem) {
  const unsigned* t = (const unsigned*)(smem + PTAB_OFF);
#pragma unroll
  for (int i = 0; i < 28; ++i) lp.in[i] = (const float*)(GAS const float*)(((unsigned long long)(unsigned)__builtin_amdgcn_readfirstlane((int)t[2 * i + 1]) << 32) | (unsigned)__builtin_amdgcn_readfirstlane((int)t[2 * i]));
  lp.out = (float*)(GAS float*)(((unsigned long long)(unsigned)__builtin_amdgcn_readfirstlane((int)t[57]) << 32) | (unsigned)__builtin_amdgcn_readfirstlane((int)t[56]));
  lp.ws = (unsigned char*)(GAS unsigned char*)(((unsigned long long)(unsigned)__builtin_amdgcn_readfirstlane((int)t[59]) << 32) | (unsigned)__builtin_amdgcn_readfirstlane((int)t[58]));
}
__global__ void __launch_bounds__(NTHR) mega_kernel(Params pk) {
  extern __shared__ __attribute__((aligned(16))) unsigned char smem[];
  cg::grid_group grid = cg::this_grid();
  const int bid = blockIdx.x, nb = gridDim.x;
  volatile LAS unsigned* bst = (volatile LAS unsigned*)(smem + LDS_BYTES - 16);
  if (threadIdx.x < 4) bst[threadIdx.x] = 0u;
  if (threadIdx.x < 30) {
    const __attribute__((address_space(4))) unsigned long long* ka = (const __attribute__((address_space(4))) unsigned long long*)__builtin_amdgcn_kernarg_segment_ptr();
    ((unsigned long long*)(smem + PTAB_OFF))[threadIdx.x] = ka[threadIdx.x];
  }
  unsigned* barw = (unsigned*)(pk.ws + O_BAR);
  __syncthreads();
  XcdBarrier xb = xcd_barrier_post(barw, bst);
#define GSYNC() xcd_barrier(xb)
  unsigned long long pc_first; asm volatile("s_getpc_b64 %0" : "=s"(pc_first));
#define CODE_PF(acc_) do { if (threadIdx.x < 64) { unsigned long long pc_; asm volatile("s_getpc_b64 %0" : "=s"(pc_)); \
      const unsigned rel_ = (unsigned)((pc_ & ~127ull) - pc_first); \
      _Pragma("unroll") for (int j_ = 0; j_ < 9; ++j_) { const unsigned o_ = rel_ + (unsigned)((j_ * 64 + (int)threadIdx.x) * 128); \
        if (o_ + 128u <= (unsigned)CODE_LEN_SAFE) acc_ += *(GAS const unsigned*)((GAS const char*)pc_first + o_); } } } while (0)
#define RUNP(k, call) do { unsigned pf_ = 0u; { Params p; load_params(p, smem); call; } CODE_PF(pf_); GSYNC(); asm volatile("" :: "v"(pf_)); if (DUPMASK & (1 << (k))) { { Params p; load_params(p, smem); call; } GSYNC(); } } while (0)
  { unsigned pf_ = 0u; { Params p; load_params(p, smem); phase0(p, smem, bid, nb); } CODE_PF(pf_); GSYNC(); asm volatile("" :: "v"(pf_)); }
  if (pk.ws == nullptr) grid.sync();
  RUNP(1, phase1(p, smem, bid, nb));
  RUNP(2, phase2(p, smem, bid, nb));
  RUNP(3, phase3(p, smem, bid, nb));
  RUNP(4, phase4(p, bid, nb));
  RUNP(5, phase5(p, smem, bid, nb));
  RUNP(6, phase6(p, smem, bid, nb));
  RUNP(14, phase7(p, bid, nb));
  if (DUPMASK & (1 << 7)) { { Params p; load_params(p, smem); phase6(p, smem, bid, nb); } GSYNC(); { Params p; load_params(p, smem); phase7(p, bid, nb); } GSYNC(); }
  RUNP(8, phase8(p, smem, bid, nb));
  RUNP(14, phase9(p, smem, bid, nb));
  if (DUPMASK & (1 << 9)) { { Params p; load_params(p, smem); if (bid == 0 && threadIdx.x < 256) ((int*)(p.ws + O_CTRL))[threadIdx.x * CSTR] = 0; } GSYNC(); { Params p; load_params(p, smem); phase9(p, smem, bid, nb); } GSYNC(); }
  if (SHADOW11) { { Params p; load_params(p, smem); phase11(p, smem, bid, nb, SHADOW11); } GSYNC(); }
  RUNP(11, phase11(p, smem, bid, nb));
  RUNP(12, phase12(p, smem, bid, nb));
  { Params p; load_params(p, smem); phase13(p, bid, nb); }
  if (DUPMASK & (1 << 13)) { GSYNC(); Params p; load_params(p, smem); phase13(p, bid, nb); }
  if (DUPMASK & (1 << 15)) { for (int i = 0; i < 10; ++i) GSYNC(); }
}

extern "C" void kernel_launch(void* const* d_in, const int* in_sizes, int n_in, void* d_out, int out_size, void* d_ws, size_t ws_size, hipStream_t stream) {
  if (n_in != 28 || ws_size < WS_NEED) { fprintf(stderr, "kernel_launch: unexpected inputs (%d) or workspace (%zu < %zu)\n", n_in, ws_size, (size_t)WS_NEED); return; }
  static int grid_blocks = 0;
  if (!grid_blocks) {
    int dev = 0, cus = 0, per_cu = 0;
    (void)hipGetDevice(&dev);
    (void)hipDeviceGetAttribute(&cus, hipDeviceAttributeMultiprocessorCount, dev);
    (void)hipFuncSetAttribute((const void*)mega_kernel, hipFuncAttributeMaxDynamicSharedMemorySize, LDS_BYTES);
    (void)hipOccupancyMaxActiveBlocksPerMultiprocessor(&per_cu, (const void*)mega_kernel, NTHR, LDS_BYTES);
    if (per_cu < 1) per_cu = 1;
    if (per_cu > 1) per_cu = 1;
    grid_blocks = cus * per_cu;
    if (grid_blocks < 32) grid_blocks = 32;
  }
  Params p{};
  for (int i = 0; i < 28; ++i) p.in[i] = (const float*)d_in[i];
  p.out = (float*)d_out; p.ws = (unsigned char*)d_ws;
  (void)hipMemsetAsync((unsigned char*)d_ws + O_BAR, 0, 16384 + 256, stream);
  void* args[] = {&p};
  hipError_t e = hipLaunchCooperativeKernel((const void*)mega_kernel, dim3(grid_blocks), dim3(NTHR), args, LDS_BYTES, stream);
  if (e != hipSuccess) fprintf(stderr, "cooperative launch failed: %s (grid %d)\n", hipGetErrorString(e), grid_blocks);
}
```
